# Optimizing an MI355X kernel written in HIP

```python
import math
import jax, jax.numpy as jnp
from jax import lax
import numpy as np

D_MODEL = 2048
BATCH = 8
SEQ = 4096
DEPTH = 1

N_HEADS = 8
HEAD_DIM = 128
N_KV_HEADS = 2
ATTN_WIDTH = N_HEADS * HEAD_DIM
KV_WIDTH = N_KV_HEADS * HEAD_DIM
IDX_HEADS = 16
IDX_DIM = 64
TOPK_MAX = 256
Q_BLOCK = 128
N_BUCKETS = 32
MAX_DISTANCE = 128
POOL_WINDOWS = (2, 4, 8, 16)
N_POOL_GROUPS = 4
POOL_WIDTH = 1024
POOL_GROUP = POOL_WIDTH // N_POOL_GROUPS
PEER_HEADS = 8
PEER_KEYS = 128
PEER_QDIM = 256
PEER_TOPK = 16
N_EXPERTS = PEER_KEYS * PEER_KEYS
PEER_CHUNK = 128
EPS = 1e-6
NEG = -1e30
SPLITS = (ATTN_WIDTH, KV_WIDTH, KV_WIDTH, IDX_HEADS * IDX_DIM, IDX_DIM, IDX_HEADS, POOL_WIDTH, D_MODEL, D_MODEL)
IN_WIDTH = sum(SPLITS)

kernel_name = 'hybrid_dsa_pool_peer_block'


def rms_norm(x, g):
    xf = x.astype(jnp.float32)
    y = xf * lax.rsqrt(jnp.mean(xf * xf, axis=-1, keepdims=True) + EPS)
    return (y * g.astype(jnp.float32)).astype(x.dtype)


def t5_bucket(dist):
    max_exact = N_BUCKETS // 2
    n = jnp.maximum(dist, 0)
    nf = jnp.maximum(n, 1).astype(jnp.float32)
    large = max_exact + (jnp.log(nf / max_exact) / math.log(MAX_DISTANCE / max_exact)
                         * (N_BUCKETS - max_exact)).astype(jnp.int32)
    large = jnp.minimum(large, N_BUCKETS - 1)
    return jnp.where(n < max_exact, n, large)


def dsa_sparse_attention(q, k, v, iq, ik, iw, rel_bias):
    B, S = q.shape[0], q.shape[1]
    k_sel = min(TOPK_MAX, S // 4)
    n_blocks = S // Q_BLOCK
    rep = N_HEADS // N_KV_HEADS
    key_pos = jnp.arange(S)
    scale = HEAD_DIM ** -0.5
    idx_scale = IDX_DIM ** -0.5
    w_scale = IDX_HEADS ** -0.5

    def block(i):
        q0 = i * Q_BLOCK
        qb = lax.dynamic_slice_in_dim(q, q0, Q_BLOCK, axis=1)
        iqb = lax.dynamic_slice_in_dim(iq, q0, Q_BLOCK, axis=1)
        iwb = lax.dynamic_slice_in_dim(iw, q0, Q_BLOCK, axis=1).astype(jnp.float32)
        qpos = q0 + jnp.arange(Q_BLOCK)
        dots = jnp.einsum('bqhd,bsd->bqhs', iqb, ik, preferred_element_type=jnp.float32) * idx_scale
        scores = jnp.einsum('bqh,bqhs->bqs', iwb * w_scale, jax.nn.relu(dots))
        causal = key_pos[None, :] <= qpos[:, None]
        scores = jnp.where(causal[None], scores, -jnp.inf)
        _, sel = lax.top_k(scores, k_sel)
        valid = sel <= qpos[None, :, None]
        kg = jax.vmap(lambda kb, ib: kb[ib])(k, sel)
        vg = jax.vmap(lambda vb, ib: vb[ib])(v, sel)
        qg = qb.reshape(B, Q_BLOCK, N_KV_HEADS, rep, HEAD_DIM)
        logits = jnp.einsum('bqgrd,bqkgd->bqgrk', qg, kg, preferred_element_type=jnp.float32) * scale
        bias = rel_bias[t5_bucket(qpos[None, :, None] - sel)].astype(jnp.float32)
        bias = bias.reshape(B, Q_BLOCK, k_sel, N_KV_HEADS, rep).transpose(0, 1, 3, 4, 2)
        logits = jnp.where(valid[:, :, None, None, :], logits + bias, NEG)
        p = jax.nn.softmax(logits, axis=-1).astype(v.dtype)
        o = jnp.einsum('bqgrk,bqkgd->bqgrd', p, vg)
        return o.reshape(B, Q_BLOCK, ATTN_WIDTH)

    out = lax.map(block, jnp.arange(n_blocks))
    return out.transpose(1, 0, 2, 3).reshape(B, S, ATTN_WIDTH)


def causal_multiscale_pool(p):
    B, S = p.shape[0], p.shape[1]
    pf = p.astype(jnp.float32).reshape(B, S, N_POOL_GROUPS, POOL_GROUP)
    cs = jnp.concatenate([jnp.zeros_like(pf[:, :1]), jnp.cumsum(pf, axis=1)], axis=1)
    t = jnp.arange(S)
    groups = []
    for g, w in enumerate(POOL_WINDOWS):
        start = jnp.maximum(t + 1 - w, 0)
        count = (t + 1 - start).astype(jnp.float32)[None, :, None]
        window_sum = cs[:, t + 1, g] - cs[:, start, g]
        groups.append(window_sum / count - pf[:, :, g])
    return jnp.stack(groups, axis=2)


def token_mixer(h, w_in, g_q, g_k, rel_bias, pool_w, pool_scale, w_attn_br, w_pool_br, w_out):
    B, S = h.shape[0], h.shape[1]
    proj = jnp.einsum('bsd,de->bse', h, w_in)
    offsets = np.cumsum(SPLITS)[:-1].tolist()
    q, k, v, iq, ik, iw, pl, ga, gp = jnp.split(proj, offsets, axis=-1)
    q = rms_norm(q.reshape(B, S, N_HEADS, HEAD_DIM), g_q)
    k = rms_norm(k.reshape(B, S, N_KV_HEADS, HEAD_DIM), g_k)
    v = v.reshape(B, S, N_KV_HEADS, HEAD_DIM)
    iq = iq.reshape(B, S, IDX_HEADS, IDX_DIM)
    attn = dsa_sparse_attention(q, k, v, iq, ik, iw, rel_bias)
    y_attn = jnp.einsum('bse,ed->bsd', attn, w_attn_br)
    pooled = causal_multiscale_pool(pl)
    pooled = jnp.einsum('bsgc,gce->bsge', pooled, pool_w.astype(jnp.float32)).reshape(B, S, POOL_WIDTH)
    pooled = (pooled * pool_scale.astype(jnp.float32)).astype(h.dtype)
    y_pool = jnp.einsum('bse,ed->bsd', pooled, w_pool_br)
    merged = jax.nn.sigmoid(ga) * y_attn + jax.nn.sigmoid(gp) * y_pool
    return jnp.einsum('bsd,de->bse', merged, w_out)


def peer_channel_mixer(h, w_peer_q, peer_keys, peer_u, peer_v):
    B, S, D = h.shape
    q = jnp.einsum('bsd,de->bse', h, w_peer_q).reshape(B, S, PEER_HEADS, 2, PEER_QDIM // 2)
    sub = jnp.einsum('bshpd,hpnd->bshpn', q, peer_keys, preferred_element_type=jnp.float32)
    s_top, i_top = lax.top_k(sub, PEER_TOPK)
    cand = s_top[..., 0, :, None] + s_top[..., 1, None, :]
    cand_idx = i_top[..., 0, :, None] * PEER_KEYS + i_top[..., 1, None, :]
    cand = cand.reshape(B, S, PEER_HEADS, PEER_TOPK * PEER_TOPK)
    cand_idx = cand_idx.reshape(B, S, PEER_HEADS, PEER_TOPK * PEER_TOPK)
    best, pos = lax.top_k(cand, PEER_TOPK)
    experts = jnp.take_along_axis(cand_idx, pos, axis=-1)
    gates = jax.nn.softmax(best, axis=-1)
    n_tok = B * S
    n_chunks = n_tok // PEER_CHUNK
    e_per_tok = PEER_HEADS * PEER_TOPK
    hf = h.reshape(n_chunks, PEER_CHUNK, D)
    ef = experts.reshape(n_chunks, PEER_CHUNK, e_per_tok)
    gf = gates.reshape(n_chunks, PEER_CHUNK, e_per_tok)

    def chunk(args):
        hc, ec, gc = args
        u = peer_u[ec]
        a = jax.nn.gelu(jnp.einsum('cd,ced->ce', hc, u, preferred_element_type=jnp.float32), approximate=False)
        vv = peer_v[ec]
        return jnp.einsum('ce,ced->cd', (a * gc).astype(hc.dtype), vv)

    out = lax.map(chunk, (hf, ef, gf))
    return out.reshape(B, S, D)


def setup_inputs(seed: int = 0) -> dict:
    key = jax.random.key(seed)
    ks = jax.random.split(key, 20)
    f32 = jnp.float32
    nrm = lambda k, shape, s: jax.random.normal(k, shape, f32) * s
    return {
        'x': nrm(ks[0], (BATCH, SEQ, D_MODEL), 1.0),
        'c': nrm(ks[1], (BATCH, D_MODEL), 1.0),
        'w_ada': nrm(ks[2], (DEPTH, D_MODEL, 6 * D_MODEL), 0.5 * D_MODEL ** -0.5),
        'b_ada': nrm(ks[3], (DEPTH, 6 * D_MODEL), 0.01),
        'g_norm1': 1.0 + nrm(ks[4], (DEPTH, D_MODEL), 0.05),
        'g_norm2': 1.0 + nrm(ks[5], (DEPTH, D_MODEL), 0.05),
        'w_in': nrm(ks[6], (DEPTH, D_MODEL, IN_WIDTH), D_MODEL ** -0.5),
        'g_q': 1.0 + nrm(ks[7], (DEPTH, HEAD_DIM), 0.05),
        'g_k': 1.0 + nrm(ks[8], (DEPTH, HEAD_DIM), 0.05),
        'rel_bias': nrm(ks[9], (N_BUCKETS, N_HEADS), 0.5),
        'pool_w': nrm(ks[10], (DEPTH, N_POOL_GROUPS, POOL_GROUP, POOL_GROUP), POOL_GROUP ** -0.5),
        'pool_scale': 1.0 + nrm(ks[11], (DEPTH, POOL_WIDTH), 0.05),
        'w_attn_br': nrm(ks[12], (DEPTH, ATTN_WIDTH, D_MODEL), ATTN_WIDTH ** -0.5),
        'w_pool_br': nrm(ks[13], (DEPTH, POOL_WIDTH, D_MODEL), POOL_WIDTH ** -0.5),
        'w_out': nrm(ks[14], (DEPTH, D_MODEL, D_MODEL), D_MODEL ** -0.5),
        'w_peer_q': nrm(ks[15], (DEPTH, D_MODEL, PEER_HEADS * PEER_QDIM), D_MODEL ** -0.5),
        'peer_keys': nrm(ks[16], (DEPTH, PEER_HEADS, 2, PEER_KEYS, PEER_QDIM // 2), (PEER_QDIM // 2) ** -0.5),
        'peer_u': nrm(ks[17], (DEPTH, N_EXPERTS, D_MODEL), D_MODEL ** -0.5),
        'peer_v': nrm(ks[18], (DEPTH, N_EXPERTS, D_MODEL), PEER_HEADS ** -0.5),
    }


def reference(x, c, w_ada, b_ada, g_norm1, g_norm2, w_in, g_q, g_k, rel_bias, pool_w, pool_scale,
              w_attn_br, w_pool_br, w_out, w_peer_q, peer_keys, peer_u, peer_v):
    c_act = jax.nn.silu(c)
    for l in range(DEPTH):
        mod = jnp.einsum('bd,de->be', c_act, w_ada[l]) + b_ada[l]
        sh1, sc1, gt1, sh2, sc2, gt2 = [m[:, None, :] for m in jnp.split(mod, 6, axis=-1)]
        h = rms_norm(x, g_norm1[l]) * (1.0 + sc1) + sh1
        x = x + gt1 * token_mixer(h, w_in[l], g_q[l], g_k[l], rel_bias, pool_w[l], pool_scale[l],
                                  w_attn_br[l], w_pool_br[l], w_out[l])
        h = rms_norm(x, g_norm2[l]) * (1.0 + sc2) + sh2
        x = x + gt2 * peer_channel_mixer(h, w_peer_q[l], peer_keys[l], peer_u[l], peer_v[l])
    return x
```

```cpp
#include <hip/hip_runtime.h>
#include <cstdio>
#include <cstdint>

#ifndef MK_PER_PHASE
#define MK_PER_PHASE 0
#endif

#define LAS __attribute__((address_space(3)))
typedef unsigned short bf16_t;
typedef short bf16x8 __attribute__((ext_vector_type(8)));
typedef float f32x4 __attribute__((ext_vector_type(4)));
typedef float f32x2 __attribute__((ext_vector_type(2)));
typedef unsigned u32x4 __attribute__((ext_vector_type(4)));
typedef unsigned u32x2 __attribute__((ext_vector_type(2)));

constexpr int BATCH = 8, SEQ = 4096, DM = 2048, MTOK = BATCH * SEQ;
constexpr int NHEAD = 8, HDIM = 128, AW = 1024, KVW = 256, IHEADS = 16, IDIM = 64, KSEL = 256;
constexpr int PW = 1024, PHEADS = 8, NEXP = 16384;
constexpr int INW = 7760, INWP = 7936;
constexpr float EPS = 1e-6f;
constexpr int NPHASE = 11;

constexpr size_t MiB = 1u << 20;
constexpr size_t WS_CTL = 0, CTL_ZERO_BYTES = 256 * 1024;
constexpr size_t WS_MODP = 2 * MiB;
constexpr size_t WS_MODF = 4 * MiB;
constexpr size_t WS_POOLW = 5 * MiB;
constexpr size_t WS_KEYSBD = 6 * MiB;
constexpr size_t WS_WIN = 8 * MiB;
constexpr size_t WS_WAB = 40 * MiB, WS_WPB = 44 * MiB, WS_WOUT = 48 * MiB, WS_WPQ = 56 * MiB;
constexpr size_t WS_PU = 64 * MiB, WS_PV = 128 * MiB;
constexpr size_t WS_R0 = 192 * MiB;
constexpr size_t WS_GA = 320 * MiB, WS_GP = 448 * MiB;
constexpr size_t WS_SUB = 320 * MiB;
constexpr size_t WS_QN = 576 * MiB;
constexpr size_t WS_IQ = 640 * MiB;
constexpr size_t WS_PL = 704 * MiB;
constexpr size_t WS_KN = 768 * MiB, WS_V = 784 * MiB;
constexpr size_t WS_IK = 800 * MiB;
constexpr size_t WS_IW = 804 * MiB;
constexpr size_t WS_SEL = 806 * MiB;
constexpr size_t WS_POOLED = 822 * MiB;
constexpr size_t WS_H2 = 886 * MiB;
constexpr size_t WS_END = 1014 * MiB;
constexpr size_t WS_ATTN = WS_IQ, WS_POOL2 = WS_PL;

constexpr int LDS_BYTES = 160 * 1024;
constexpr int MISC_OFF = 156 * 1024;

__device__ __forceinline__ unsigned cvt_pk_bf16(float lo, float hi) { unsigned r; asm volatile("v_cvt_pk_bf16_f32 %0, %1, %2" : "=v"(r) : "v"(lo), "v"(hi)); return r; }
__device__ __forceinline__ float bf_lo(unsigned w) { return __uint_as_float(w << 16); }
__device__ __forceinline__ float bf_hi(unsigned w) { return __uint_as_float(w & 0xffff0000u); }
__device__ __forceinline__ float wave_sum(float v) {
#pragma unroll
    for (int o = 1; o < 64; o <<= 1) v += __shfl_xor(v, o);
    return v;
}
__device__ __forceinline__ float sigmoidf_(float x) { return __builtin_amdgcn_rcpf(1.0f + __expf(-x)); }
__device__ __forceinline__ float dot8(u32x4 w, const float* h) {
    return bf_lo(w.x) * h[0] + bf_hi(w.x) * h[1] + bf_lo(w.y) * h[2] + bf_hi(w.y) * h[3] + bf_lo(w.z) * h[4] + bf_hi(w.z) * h[5] + bf_lo(w.w) * h[6] + bf_hi(w.w) * h[7];
}

#define XB_TMO      128
#define XB_XCNT(j)  (256  + 64 * (j))
#define XB_XSUB(j)  (1280 + 64 * (j))
#define XB_XGEN(j)  (2304 + 64 * (j))
#define XB_TOP      3328
#define XB_TOPGEN   3392
#define XCD_BAR_WORDS 3456
#define XB_SPIN_CAP (1u << 18)

__device__ __forceinline__ unsigned xb_ld(unsigned* p)              { return __hip_atomic_load(p, __ATOMIC_RELAXED, __HIP_MEMORY_SCOPE_AGENT); }
__device__ __forceinline__ unsigned xb_add(unsigned* p, unsigned v) { return __hip_atomic_fetch_add(p, v, __ATOMIC_RELAXED, __HIP_MEMORY_SCOPE_AGENT); }
__device__ __forceinline__ unsigned xb_xcc_id() { return (unsigned)__builtin_amdgcn_s_getreg((3 << 11) | 20) & 0xFu; }
#define XB_SPIN(cond, bar) do { unsigned _sp = 0; while (cond) { __builtin_amdgcn_s_sleep(1); \
    if ((++_sp & 255u) == 0u) { if (xb_ld(&(bar)[XB_TMO])) break; if (_sp > XB_SPIN_CAP) { atomicAdd(&(bar)[XB_TMO], 1u); break; } } } } while (0)

struct XcdBarrier { unsigned* bar; unsigned x; volatile LAS unsigned* st; };

__device__ __forceinline__ XcdBarrier xcd_barrier_post(unsigned* bar, volatile LAS unsigned* st) {
    XcdBarrier b; b.bar = bar; b.x = xb_xcc_id(); b.st = st;
    if (threadIdx.x == 0) (void)xb_add(&bar[XB_XCNT(b.x)], 1u);
    return b;
}
__device__ __forceinline__ void xcd_barrier_complete(unsigned* bar, unsigned x, unsigned& nloc, unsigned& nx) {
    const unsigned G = gridDim.x * gridDim.y * gridDim.z;
    unsigned sum, cnt, mine, sp = 0u;
    for (;;) {
        sum = 0u; cnt = 0u; mine = 0u;
#pragma unroll
        for (unsigned j = 0; j < 16; ++j) { const unsigned c = xb_ld(&bar[XB_XCNT(j)]); sum += c; cnt += (c > 0u) ? 1u : 0u; mine = (j == x) ? c : mine; }
        if (sum == G) break;
        __builtin_amdgcn_s_sleep(1);
        if ((++sp & 255u) == 0u) { if (xb_ld(&bar[XB_TMO])) break; if (sp > XB_SPIN_CAP) { atomicAdd(&bar[XB_TMO], 1u); break; } }
    }
    nloc = mine > 0u ? mine : 1u; nx = cnt > 0u ? cnt : 1u;
}
__device__ __forceinline__ void xcd_barrier(const XcdBarrier& b) {
    asm volatile("s_waitcnt vmcnt(0)" ::: "memory");
    __syncthreads();
    if (threadIdx.x == 0) {
        unsigned* bar = b.bar;
        __builtin_amdgcn_s_waitcnt(0);
        unsigned nloc = b.st[0], nx = b.st[1];
        if (nloc == 0u) { xcd_barrier_complete(bar, b.x, nloc, nx); b.st[0] = nloc; b.st[1] = nx; }
        const unsigned old = xb_add(&bar[XB_XSUB(b.x)], 1u);
        const unsigned gen = old / nloc;
        if (old + 1u == (gen + 1u) * nloc) {
            __builtin_amdgcn_fence(__ATOMIC_RELEASE, "agent");
            asm volatile("s_waitcnt vmcnt(0)" ::: "memory");
            const unsigned og = xb_add(&bar[XB_TOP], 1u);
            const unsigned tg = og / nx;
            if (og + 1u == (tg + 1u) * nx) xb_add(&bar[XB_TOPGEN], 1u);
            else XB_SPIN(xb_ld(&bar[XB_TOPGEN]) == tg, bar);
            __builtin_amdgcn_fence(__ATOMIC_ACQUIRE, "agent");
            xb_add(&bar[XB_XGEN(b.x)], 1u);
            asm volatile("s_waitcnt vmcnt(0)" ::: "memory");
        } else {
            XB_SPIN(xb_ld(&bar[XB_XGEN(b.x)]) == gen, bar);
            __builtin_amdgcn_fence(__ATOMIC_ACQUIRE, "agent");
            asm volatile("s_waitcnt vmcnt(0)" ::: "memory");
        }
    }
    __syncthreads();
}

namespace pg8 {
constexpr int BM = 256, BK = 64, HALF = 128, HTB = HALF * BK * 2, STAGE_BYTES = 8 * HTB, NXCD = 8, WGM = 8;
__device__ __forceinline__ int lds_byte(int r, int c) { const int st = (r >> 4) * 2 + (c >> 5), rr = r & 15, cc = c & 31, ob = rr * 64 + cc * 2; return st * 1024 + (ob ^ (((ob >> 9) & 1) << 5)); }
__device__ __forceinline__ void stage_rc(int b, int& R, int& C) { const int st = b / 1024, sb = b % 1024, swz = sb ^ (((sb >> 9) & 1) << 5); R = (st >> 1) * 16 + swz / 64; C = (st & 1) * 32 + (swz % 64) / 2; }
__device__ __forceinline__ int perm32(int rho) { const int n = rho >> 4, i = rho & 15; return 8 * (i >> 2) + 4 * n + (i & 3); }

struct Unit { int pm, pn; };
struct Gemm { const bf16_t* A; const bf16_t* Bt; int M, N, K, lda, a_pn_off; };

struct StaticOrder {
    int nM, nN, nwg, G, c;
    __device__ void init(int M, int N, int G_, int c_) { nM = M / BM; nN = N / BM; nwg = nM * nN; G = G_; c = c_; }
    __device__ bool next(int i, Unit& u) const {
        const long L = (long)i * G + c; if (L >= nwg) return false;
        int wgid = (int)L; { const int q = nwg / NXCD, r = nwg % NXCD, xcd = wgid % NXCD, off = wgid / NXCD; wgid = (xcd < r ? xcd * (q + 1) : r * (q + 1) + (xcd - r) * q) + off; }
        const int nig = WGM * nN, gid = wgid / nig, fm = gid * WGM, gsz = (nM - fm) < WGM ? (nM - fm) : WGM;
        u.pm = fm + ((wgid % nig) % gsz); u.pn = (wgid % nig) / gsz; return true;
    }
};

template <class Epi>
__device__ __forceinline__ void gemm_phase(LAS unsigned char* lds, const Gemm g, const StaticOrder& S, const Epi& E) {
    const int tid = threadIdx.x, wid = __builtin_amdgcn_readfirstlane(tid >> 6), lane = tid & 63, wr = wid >> 2, wc = wid & 3, fr = lane & 15, fq = lane >> 4;
    const int K = g.K, nt = K / BK, lda = g.lda;
    unsigned voffA[2], voffB[2];
#pragma unroll
    for (int i = 0; i < 2; ++i) { int R, C; stage_rc(tid * 16 + i * 8192, R, C); const int Rb = Epi::PERM ? ((R & ~31) + perm32(R & 31)) : R;
        voffA[i] = (unsigned)(R * lda + C) * 2u; voffB[i] = (unsigned)(Rb * K + C) * 2u; }
    const size_t kstep = (size_t)(BK * 2);
    const size_t hsA = (size_t)HALF * lda * 2, hsB = (size_t)HALF * K * 2;
    const size_t tsA = 2 * hsA, tsB = 2 * hsB;
    const unsigned ldsw = (unsigned)wid * 1024u;
    const int aoff = lds_byte(wr * 64 + fr, fq * 8), boff = lds_byte(wc * 32 + fr, fq * 8);
#define PG8_SA(b, h) (((b) * 2 + (h)) * HTB)
#define PG8_SB(b, h) ((4 + (b) * 2 + (h)) * HTB)
#define PG8_STAGE(bufoff, gbase, voff) do { _Pragma("unroll") for (int _i = 0; _i < 2; ++_i) \
        __builtin_amdgcn_global_load_lds((const unsigned*)((const char*)(gbase) + (voff)[_i]), (LAS unsigned*)(lds + (bufoff) + ldsw + _i * 8192), 16, 0, 0); } while (0)
#define PG8_LDA(dst, b, h) do { _Pragma("unroll") for (int m = 0; m < 4; ++m) _Pragma("unroll") for (int k = 0; k < 2; ++k) dst[m][k] = *(const LAS bf16x8*)(lds + PG8_SA(b, h) + aoff + m * 2048 + k * 1024); } while (0)
#define PG8_LDB(dst, b, h) do { _Pragma("unroll") for (int n = 0; n < 2; ++n) _Pragma("unroll") for (int k = 0; k < 2; ++k) dst[n][k] = *(const LAS bf16x8*)(lds + PG8_SB(b, h) + boff + n * 2048 + k * 1024); } while (0)
#define PG8_MMA(ai, bj, At, Bt) do { __builtin_amdgcn_s_setprio(1); _Pragma("unroll") for (int m = 0; m < 4; ++m) _Pragma("unroll") for (int n = 0; n < 2; ++n) _Pragma("unroll") for (int k = 0; k < 2; ++k) \
        acc[ai][bj][m][n] = __builtin_amdgcn_mfma_f32_16x16x32_bf16(Bt[n][k], At[m][k], acc[ai][bj][m][n], 0, 0, 0); __builtin_amdgcn_s_setprio(0); } while (0)
#define PG8_WAIT_V(n) asm volatile("s_waitcnt vmcnt(" #n ")" ::: "memory")
#define PG8_WAIT_L(n) asm volatile("s_waitcnt lgkmcnt(" #n ")" ::: "memory")
#define PG8_BAR __builtin_amdgcn_s_barrier()
#define PG8_SCHED __builtin_amdgcn_sched_barrier(0)
    Unit cur, nxt; int ui = 0;
    if (!S.next(0, cur)) return;
    f32x4 acc[2][2][4][2];
#pragma unroll
    for (int a = 0; a < 2; ++a)
#pragma unroll
        for (int b = 0; b < 2; ++b)
#pragma unroll
            for (int m = 0; m < 4; ++m)
#pragma unroll
                for (int n = 0; n < 2; ++n) acc[a][b][m][n] = (f32x4){0.f, 0.f, 0.f, 0.f};
    bf16x8 At[4][2], B0[2][2], B1[2][2];
    const char* cA = (const char*)g.A + (size_t)cur.pm * tsA + (size_t)cur.pn * g.a_pn_off * 2; const char* cB = (const char*)g.Bt + (size_t)cur.pn * tsB;
    PG8_STAGE(PG8_SB(0, 0), cB, voffB); PG8_STAGE(PG8_SA(0, 0), cA, voffA); PG8_STAGE(PG8_SB(0, 1), cB + hsB, voffB); PG8_STAGE(PG8_SA(0, 1), cA + hsA, voffA);
    if (wr == 1) PG8_BAR;
    PG8_WAIT_V(4); PG8_BAR;
    PG8_STAGE(PG8_SB(1, 0), cB + kstep, voffB); PG8_STAGE(PG8_SA(1, 0), cA + kstep, voffA); PG8_STAGE(PG8_SB(1, 1), cB + hsB + kstep, voffB);
    PG8_WAIT_V(6); PG8_BAR;
    for (;;) {
        const bool has_next = S.next(ui + 1, nxt);
        const char* nA = has_next ? (const char*)g.A + (size_t)nxt.pm * tsA + (size_t)nxt.pn * g.a_pn_off * 2 : cA; const char* nB = has_next ? (const char*)g.Bt + (size_t)nxt.pn * tsB : cB;
        for (int t = 0; t < nt; t += 2) {
            const bool last = (t == nt - 2);
            const char* a1 = cA + (size_t)(t + 1) * kstep;
            const char* a2 = last ? nA : cA + (size_t)(t + 2) * kstep; const char* b2 = last ? nB : cB + (size_t)(t + 2) * kstep;
            const char* a3 = a2 + kstep; const char* b3 = b2 + kstep;
            PG8_LDB(B0, 0, 0); PG8_SCHED; PG8_LDA(At, 0, 0); PG8_STAGE(PG8_SA(1, 1), a1 + hsA, voffA);
            PG8_WAIT_L(8); PG8_BAR; PG8_WAIT_L(0); PG8_MMA(0, 0, At, B0); PG8_BAR; PG8_SCHED;
            PG8_LDB(B1, 0, 1); PG8_STAGE(PG8_SB(0, 0), b2, voffB);
            PG8_BAR; PG8_WAIT_L(0); PG8_MMA(0, 1, At, B1); PG8_BAR;
            PG8_LDA(At, 0, 1); PG8_STAGE(PG8_SA(0, 0), a2, voffA);
            PG8_BAR; PG8_WAIT_L(0); PG8_MMA(1, 0, At, B0); PG8_BAR; PG8_SCHED;
            PG8_STAGE(PG8_SB(0, 1), b2 + hsB, voffB);
            PG8_WAIT_V(6); PG8_BAR; PG8_MMA(1, 1, At, B1); PG8_BAR;
            PG8_LDB(B0, 1, 0); PG8_SCHED; PG8_LDA(At, 1, 0); PG8_STAGE(PG8_SA(0, 1), a2 + hsA, voffA);
            PG8_WAIT_L(8); PG8_BAR; PG8_WAIT_L(0); PG8_MMA(0, 0, At, B0); PG8_BAR; PG8_SCHED;
            PG8_LDB(B1, 1, 1); PG8_STAGE(PG8_SB(1, 0), b3, voffB);
            PG8_BAR; PG8_WAIT_L(0); PG8_MMA(0, 1, At, B1); PG8_BAR;
            PG8_LDA(At, 1, 1); PG8_STAGE(PG8_SA(1, 0), a3, voffA);
            PG8_BAR; PG8_WAIT_L(0); PG8_MMA(1, 0, At, B0); PG8_BAR; PG8_SCHED;
            PG8_STAGE(PG8_SB(1, 1), b3 + hsB, voffB);
            PG8_WAIT_V(6); PG8_BAR; PG8_MMA(1, 1, At, B1); PG8_BAR;
        }
        E(acc, cur, wr, wc, fr, fq);
        if (!has_next) break;
#pragma unroll
        for (int a = 0; a < 2; ++a)
#pragma unroll
            for (int b = 0; b < 2; ++b)
#pragma unroll
                for (int m = 0; m < 4; ++m)
#pragma unroll
                    for (int n = 0; n < 2; ++n) acc[a][b][m][n] = (f32x4){0.f, 0.f, 0.f, 0.f};
        cur = nxt; cA = nA; cB = nB; ++ui;
    }
    PG8_WAIT_V(0);
    if (wr == 0) PG8_BAR;
    PG8_BAR;
#undef PG8_SA
#undef PG8_SB
#undef PG8_STAGE
#undef PG8_LDA
#undef PG8_LDB
#undef PG8_MMA
#undef PG8_WAIT_V
#undef PG8_WAIT_L
#undef PG8_BAR
#undef PG8_SCHED
}
}
using pg8::Unit;

typedef f32x4 AccT[2][2][4][2];
__device__ __forceinline__ u32x4 pack8(f32x4 a, f32x4 b) { u32x4 w; w.x = cvt_pk_bf16(a[0], a[1]); w.y = cvt_pk_bf16(a[2], a[3]); w.z = cvt_pk_bf16(b[0], b[1]); w.w = cvt_pk_bf16(b[2], b[3]); return w; }
__device__ __forceinline__ void unpack8(u32x4 w, f32x4& a, f32x4& b) { a = (f32x4){bf_lo(w.x), bf_hi(w.x), bf_lo(w.y), bf_hi(w.y)}; b = (f32x4){bf_lo(w.z), bf_hi(w.z), bf_lo(w.w), bf_hi(w.w)}; }

struct EpiInproj {
    static constexpr bool PERM = true;
    bf16_t *q, *k, *v, *iq, *ik, *pl, *ga, *gp; float* iw;
    __device__ __forceinline__ void operator()(const AccT& acc, const Unit& u, int wr, int wc, int fr, int fq) const {
        const int pn = u.pn, row0 = u.pm * 256 + wr * 64 + fr;
        if (pn == 10) {
            if (wc < 2) {
#pragma unroll
                for (int ai = 0; ai < 2; ++ai)
#pragma unroll
                    for (int m = 0; m < 4; ++m) { const size_t row = (size_t)(row0 + ai * 128 + m * 16);
                        *(u32x4*)(ik + row * 64 + wc * 32 + 8 * fq) = pack8(acc[ai][0][m][0], acc[ai][0][m][1]); }
            } else if (wc == 2) {
                if (fq < 2) {
#pragma unroll
                    for (int ai = 0; ai < 2; ++ai)
#pragma unroll
                        for (int m = 0; m < 4; ++m) { const size_t row = (size_t)(row0 + ai * 128 + m * 16);
                            *(f32x4*)(iw + row * 16 + 8 * fq) = acc[ai][0][m][0]; *(f32x4*)(iw + row * 16 + 8 * fq + 4) = acc[ai][0][m][1]; }
                }
            }
            return;
        }
        bf16_t* dst; int ld, tc; bool sg = false;
        if (pn < 4) { dst = q; ld = 1024; tc = pn * 256; }
        else if (pn == 4) { dst = k; ld = 256; tc = 0; }
        else if (pn == 5) { dst = v; ld = 256; tc = 0; }
        else if (pn < 10) { dst = iq; ld = 1024; tc = (pn - 6) * 256; }
        else if (pn < 15) { dst = pl; ld = 1024; tc = (pn - 11) * 256; }
        else if (pn < 23) { dst = ga; ld = 2048; tc = (pn - 15) * 256; sg = true; }
        else { dst = gp; ld = 2048; tc = (pn - 23) * 256; sg = true; }
        const int col0 = tc + wc * 32 + 8 * fq;
#pragma unroll
        for (int ai = 0; ai < 2; ++ai)
#pragma unroll
            for (int m = 0; m < 4; ++m) { bf16_t* rowp = dst + (size_t)(row0 + ai * 128 + m * 16) * ld + col0;
#pragma unroll
                for (int bj = 0; bj < 2; ++bj) { f32x4 v0 = acc[ai][bj][m][0], v1 = acc[ai][bj][m][1];
                    if (sg) {
#pragma unroll
                        for (int j = 0; j < 4; ++j) { v0[j] = sigmoidf_(v0[j]); v1[j] = sigmoidf_(v1[j]); } }
                    *(u32x4*)(rowp + bj * 128) = pack8(v0, v1); } }
    }
};
struct EpiBf16Scale {
    static constexpr bool PERM = true;
    bf16_t* O; int ldc; const float* cs;
    __device__ __forceinline__ void operator()(const AccT& acc, const Unit& u, int wr, int wc, int fr, int fq) const {
        const int row0 = u.pm * 256 + wr * 64 + fr, col0 = u.pn * 256 + wc * 32 + 8 * fq;
        f32x4 s[2][2];
#pragma unroll
        for (int bj = 0; bj < 2; ++bj)
#pragma unroll
            for (int n = 0; n < 2; ++n) s[bj][n] = cs ? *(const f32x4*)(cs + col0 + bj * 128 + 4 * n) : (f32x4){1.f, 1.f, 1.f, 1.f};
#pragma unroll
        for (int ai = 0; ai < 2; ++ai)
#pragma unroll
            for (int m = 0; m < 4; ++m) { bf16_t* rowp = O + (size_t)(row0 + ai * 128 + m * 16) * ldc + col0;
#pragma unroll
                for (int bj = 0; bj < 2; ++bj) *(u32x4*)(rowp + bj * 128) = pack8(acc[ai][bj][m][0] * s[bj][0], acc[ai][bj][m][1] * s[bj][1]); }
    }
};
template <bool ADD> struct EpiGate {
    static constexpr bool PERM = true;
    bf16_t* O; const bf16_t* gate;
    __device__ __forceinline__ void operator()(const AccT& acc, const Unit& u, int wr, int wc, int fr, int fq) const {
        const int row0 = u.pm * 256 + wr * 64 + fr, col0 = u.pn * 256 + wc * 32 + 8 * fq;
#pragma unroll
        for (int ai = 0; ai < 2; ++ai)
#pragma unroll
            for (int m = 0; m < 4; ++m) { const size_t off = (size_t)(row0 + ai * 128 + m * 16) * 2048 + col0;
#pragma unroll
                for (int bj = 0; bj < 2; ++bj) { f32x4 g0, g1; unpack8(*(const u32x4*)(gate + off + bj * 128), g0, g1);
                    f32x4 r0 = g0 * acc[ai][bj][m][0], r1 = g1 * acc[ai][bj][m][1];
                    if (ADD) { f32x4 o0, o1; unpack8(*(const u32x4*)(O + off + bj * 128), o0, o1); r0 += o0; r1 += o1; }
                    *(u32x4*)(O + off + bj * 128) = pack8(r0, r1); } }
    }
};
struct EpiResid {
    static constexpr bool PERM = false;
    const float* x; float* out; const float* gt;
    __device__ __forceinline__ void operator()(const AccT& acc, const Unit& u, int wr, int wc, int fr, int fq) const {
        const int row0 = u.pm * 256 + wr * 64 + fr, col0 = u.pn * 256 + wc * 32 + 4 * fq;
        const float* gtb = gt + (size_t)(u.pm / 16) * 12288;
        f32x4 g[2][2];
#pragma unroll
        for (int bj = 0; bj < 2; ++bj)
#pragma unroll
            for (int n = 0; n < 2; ++n) g[bj][n] = *(const f32x4*)(gtb + col0 + bj * 128 + n * 16);
#pragma unroll
        for (int ai = 0; ai < 2; ++ai)
#pragma unroll
            for (int m = 0; m < 4; ++m) { const size_t off = (size_t)(row0 + ai * 128 + m * 16) * 2048 + col0;
#pragma unroll
                for (int bj = 0; bj < 2; ++bj)
#pragma unroll
                    for (int n = 0; n < 2; ++n) { const f32x4 xv = *(const f32x4*)(x + off + bj * 128 + n * 16);
                        *(f32x4*)(out + off + bj * 128 + n * 16) = xv + g[bj][n] * acc[ai][bj][m][n]; } }
    }
};
struct EpiF32 {
    static constexpr bool PERM = false;
    float* C; int ldc;
    __device__ __forceinline__ void operator()(const AccT& acc, const Unit& u, int wr, int wc, int fr, int fq) const {
        const int row0 = u.pm * 256 + wr * 64 + fr, col0 = u.pn * 256 + wc * 32 + 4 * fq;
#pragma unroll
        for (int ai = 0; ai < 2; ++ai)
#pragma unroll
            for (int m = 0; m < 4; ++m) { float* rowp = C + (size_t)(row0 + ai * 128 + m * 16) * ldc + col0;
#pragma unroll
                for (int bj = 0; bj < 2; ++bj)
#pragma unroll
                    for (int n = 0; n < 2; ++n) *(f32x4*)(rowp + bj * 128 + n * 16) = acc[ai][bj][m][n]; }
    }
};

struct Args { const float* in[19]; float* out; unsigned char* ws; int ph_lo, ph_hi; int li, pad; };
struct Frame {
    unsigned char* lds; unsigned char* ws;
    int tid, lane, wave, G, bid;
    const float *x, *c, *w_ada, *b_ada, *g1, *g2, *w_in, *g_q, *g_k, *rel_bias, *pool_w, *pool_scale, *w_ab, *w_pb, *w_out, *w_pq, *peer_keys, *peer_u, *peer_v;
    float* out;
};

template <class Fn> __device__ __forceinline__ void transpose_item(const float* W, int K, int N, bf16_t* WT, int ldk, int drow0, int k0, float* scr, int lane, Fn srccol) {
    const int sc = srccol(drow0 + (lane & 31));
#pragma unroll 8
    for (int i = 0; i < 32; ++i) { const int kk = 2 * i + (lane >> 5); scr[kk * 33 + (lane & 31)] = sc >= 0 ? W[(size_t)(k0 + kk) * N + sc] : 0.f; }
    asm volatile("s_waitcnt lgkmcnt(0)" ::: "memory");
    const int c = lane & 7;
#pragma unroll
    for (int j = 0; j < 4; ++j) { const int n = (lane >> 3) + 8 * j; const float* s = scr + (8 * c) * 33 + n;
        u32x4 o; o.x = cvt_pk_bf16(s[0 * 33], s[1 * 33]); o.y = cvt_pk_bf16(s[2 * 33], s[3 * 33]); o.z = cvt_pk_bf16(s[4 * 33], s[5 * 33]); o.w = cvt_pk_bf16(s[6 * 33], s[7 * 33]);
        *(u32x4*)(WT + (size_t)(drow0 + n) * ldk + k0 + 8 * c) = o; }
    asm volatile("s_waitcnt lgkmcnt(0)" ::: "memory");
}
__device__ __forceinline__ void phase0_prep(Frame& F) {
    const int gw = F.bid * 8 + F.wave, NGW = F.G * 8;
    float* scr = (float*)(F.lds + F.wave * 16384);
    constexpr int I_IN = (INWP / 32) * (DM / 64);
    constexpr int I_AB = (2048 / 32) * (1024 / 64), I_OUT = (2048 / 32) * (2048 / 64), I_PW = 4 * 8 * 4;
    constexpr int NIT = I_IN + 2 * I_AB + 2 * I_OUT + I_PW;
    auto ident = [](int j) { return j; };
    for (int it = gw; it < NIT; it += NGW) {
        int r = it;
        if (r < I_IN) { const int nb = r % (INWP / 32), kb = r / (INWP / 32);
            transpose_item(F.w_in, DM, INW, (bf16_t*)(F.ws + WS_WIN), DM, nb * 32, kb * 64, scr, F.lane, [](int j) { return j < 2640 ? j : (j < 2816 ? -1 : j - 176); }); continue; }
        r -= I_IN;
        if (r < I_AB) { transpose_item(F.w_ab, 1024, 2048, (bf16_t*)(F.ws + WS_WAB), 1024, (r % 64) * 32, (r / 64) * 64, scr, F.lane, ident); continue; }
        r -= I_AB;
        if (r < I_AB) { transpose_item(F.w_pb, 1024, 2048, (bf16_t*)(F.ws + WS_WPB), 1024, (r % 64) * 32, (r / 64) * 64, scr, F.lane, ident); continue; }
        r -= I_AB;
        if (r < I_OUT) { transpose_item(F.w_out, 2048, 2048, (bf16_t*)(F.ws + WS_WOUT), 2048, (r % 64) * 32, (r / 64) * 64, scr, F.lane, ident); continue; }
        r -= I_OUT;
        if (r < I_OUT) { transpose_item(F.w_pq, 2048, 2048, (bf16_t*)(F.ws + WS_WPQ), 2048, (r % 64) * 32, (r / 64) * 64, scr, F.lane, ident); continue; }
        r -= I_OUT;
        { const int g = r / 32, q = r % 32, nb = q % 8, kb = q / 8;
          transpose_item(F.pool_w + (size_t)g * 65536, 256, 256, (bf16_t*)(F.ws + WS_POOLW) + (size_t)g * 65536, 256, nb * 32, kb * 64, scr, F.lane, ident); }
    }
    {
        bf16_t* kb = (bf16_t*)(F.ws + WS_KEYSBD);
        for (int i = F.bid * 512 + F.tid; i < 2048 * 32; i += F.G * 512) {
            const int row = i / 32, k8 = (i % 32) * 8, p = (row >> 7) & 1;
            u32x4 o = (u32x4){0u, 0u, 0u, 0u};
            if ((k8 >> 7) == p) { const float* s = F.peer_keys + (size_t)row * 128 + (k8 & 127); const f32x4 a = *(const f32x4*)s, b = *(const f32x4*)(s + 4); o = pack8(a, b); }
            *(u32x4*)(kb + (size_t)row * 256 + k8) = o;
        }
    }
    {
        const size_t n8 = (size_t)NEXP * DM / 8;
        bf16_t* pu = (bf16_t*)(F.ws + WS_PU); bf16_t* pv = (bf16_t*)(F.ws + WS_PV);
        for (size_t i = (size_t)F.bid * 512 + F.tid; i < n8; i += (size_t)F.G * 512) {
            const f32x4 a = *(const f32x4*)(F.peer_u + i * 8), b = *(const f32x4*)(F.peer_u + i * 8 + 4);
            const f32x4 c = *(const f32x4*)(F.peer_v + i * 8), d = *(const f32x4*)(F.peer_v + i * 8 + 4);
            *(u32x4*)(pu + i * 8) = pack8(a, b); *(u32x4*)(pv + i * 8) = pack8(c, d);
        }
    }
    {
        __syncthreads();
        float* cact = (float*)(F.lds + 131072);
        float* red = (float*)F.lds;
        float* mp = (float*)(F.ws + WS_MODP);
        for (int it = F.bid; it < 48 * 4; it += F.G) {
            const int cb = it % 48, ds = it / 48, d0 = ds * 512;
            for (int i = F.tid; i < 8 * 512; i += 512) { const int b = i >> 9, d = i & 511; const float cv = F.c[b * DM + d0 + d]; cact[i] = cv * sigmoidf_(cv); }
            __syncthreads();
            f32x4 a[8];
#pragma unroll
            for (int b = 0; b < 8; ++b) a[b] = (f32x4){0.f, 0.f, 0.f, 0.f};
            const float* wp = F.w_ada + (size_t)(d0 + F.wave * 64) * 12288 + cb * 256 + F.lane * 4;
#pragma unroll 4
            for (int d = 0; d < 64; ++d) { const f32x4 w = *(const f32x4*)(wp + (size_t)d * 12288);
#pragma unroll
                for (int b = 0; b < 8; ++b) a[b] += w * cact[b * 512 + F.wave * 64 + d]; }
#pragma unroll
            for (int b = 0; b < 8; ++b)
#pragma unroll
                for (int j = 0; j < 4; ++j) red[(F.wave * 32 + b * 4 + j) * 64 + F.lane] = a[b][j];
            __syncthreads();
            for (int i = F.tid; i < 2048; i += 512) { const int v = i >> 6, l = i & 63; float s = 0.f;
#pragma unroll
                for (int w = 0; w < 8; ++w) s += red[(w * 32 + v) * 64 + l];
                mp[((size_t)ds * 8 + (v >> 2)) * 12288 + cb * 256 + l * 4 + (v & 3)] = s; }
            __syncthreads();
        }
    }
}

template <bool FIRST> __device__ __forceinline__ void phase_modnorm(Frame& F, const float* xin, const float* gain, int off_sh, int off_sc, bf16_t* dst) {
    const float* mp = (const float*)(F.ws + WS_MODP); float* mf = (float*)(F.ws + WS_MODF);
    if (FIRST) {
        for (int i = F.bid * 512 + F.tid; i < 8 * 12288; i += F.G * 512) {
            float s = F.b_ada[i % 12288];
#pragma unroll
            for (int k = 0; k < 4; ++k) s += mp[(size_t)k * 8 * 12288 + i];
            mf[i] = s; }
    }
    float* cA = (float*)F.lds; float* cB = cA + 2048;
    for (int ch = F.bid; ch < MTOK / 128; ch += F.G) {
        const int b = ch / 32;
        __syncthreads();
        for (int col = F.tid; col < 2048; col += 512) {
            float sc, sh;
            if (FIRST) { sc = F.b_ada[off_sc + col]; sh = F.b_ada[off_sh + col];
#pragma unroll
                for (int k = 0; k < 4; ++k) { sc += mp[((size_t)k * 8 + b) * 12288 + off_sc + col]; sh += mp[((size_t)k * 8 + b) * 12288 + off_sh + col]; } }
            else { sc = mf[b * 12288 + off_sc + col]; sh = mf[b * 12288 + off_sh + col]; }
            cA[col] = gain[col] * (1.f + sc); cB[col] = sh; }
        __syncthreads();
        for (int r = F.wave; r < 128; r += 8) {
            const size_t row = (size_t)ch * 128 + r;
            const float* xr = xin + row * 2048 + F.lane * 8;
            f32x4 v[4][2]; float ss = 0.f;
#pragma unroll
            for (int i = 0; i < 4; ++i) { v[i][0] = *(const f32x4*)(xr + i * 512); v[i][1] = *(const f32x4*)(xr + i * 512 + 4);
#pragma unroll
                for (int j = 0; j < 4; ++j) ss += v[i][0][j] * v[i][0][j] + v[i][1][j] * v[i][1][j]; }
            ss = wave_sum(ss);
            const float rinv = 1.0f / sqrtf(ss * (1.0f / 2048.0f) + EPS);
#pragma unroll
            for (int i = 0; i < 4; ++i) { const int col = i * 512 + F.lane * 8;
                const f32x4 a0 = *(const f32x4*)(cA + col), a1 = *(const f32x4*)(cA + col + 4), b0 = *(const f32x4*)(cB + col), b1 = *(const f32x4*)(cB + col + 4);
                *(u32x4*)(dst + row * 2048 + col) = pack8(v[i][0] * rinv * a0 + b0, v[i][1] * rinv * a1 + b1); }
        }
    }
}

__device__ __forceinline__ void phase3_qknorm(Frame& F) {
    bf16_t* q = (bf16_t*)(F.ws + WS_QN); bf16_t* k = (bf16_t*)(F.ws + WS_KN);
    const int gw = F.bid * 8 + F.wave, NGW = F.G * 8;
    for (int row = gw; row < MTOK; row += NGW) {
#pragma unroll
        for (int i = 0; i < 2; ++i) { const int ci = i * 64 + F.lane; bf16_t* p = q + (size_t)row * 1024 + ci * 8;
            f32x4 a, b; unpack8(*(const u32x4*)p, a, b);
            float ss = a[0] * a[0] + a[1] * a[1] + a[2] * a[2] + a[3] * a[3] + b[0] * b[0] + b[1] * b[1] + b[2] * b[2] + b[3] * b[3];
            ss += __shfl_xor(ss, 1); ss += __shfl_xor(ss, 2); ss += __shfl_xor(ss, 4); ss += __shfl_xor(ss, 8);
            const float rinv = (1.0f / sqrtf(ss * (1.0f / 128.0f) + EPS)) * 0.08838834764831845f;
            const float* gp = F.g_q + (ci & 15) * 8; const f32x4 g0 = *(const f32x4*)gp, g1 = *(const f32x4*)(gp + 4);
            *(u32x4*)p = pack8(a * rinv * g0, b * rinv * g1); }
        if (F.lane < 32) { const int ci = F.lane; bf16_t* p = k + (size_t)row * 256 + ci * 8;
            f32x4 a, b; unpack8(*(const u32x4*)p, a, b);
            float ss = a[0] * a[0] + a[1] * a[1] + a[2] * a[2] + a[3] * a[3] + b[0] * b[0] + b[1] * b[1] + b[2] * b[2] + b[3] * b[3];
            ss += __shfl_xor(ss, 1); ss += __shfl_xor(ss, 2); ss += __shfl_xor(ss, 4); ss += __shfl_xor(ss, 8);
            const float rinv = 1.0f / sqrtf(ss * (1.0f / 128.0f) + EPS);
            const float* gp = F.g_k + (ci & 15) * 8; const f32x4 g0 = *(const f32x4*)gp, g1 = *(const f32x4*)(gp + 4);
            *(u32x4*)p = pack8(a * rinv * g0, b * rinv * g1); }
    }
}
__device__ __forceinline__ void phase3_pooled(Frame& F) {
    const bf16_t* pl = (const bf16_t*)(F.ws + WS_PL); bf16_t* po = (bf16_t*)(F.ws + WS_POOLED);
    for (size_t i = (size_t)F.bid * 512 + F.tid; i < (size_t)MTOK * 128; i += (size_t)F.G * 512) {
        const int row = (int)(i >> 7), c8 = (int)(i & 127) * 8, g = c8 >> 8, w = 2 << g, t = row & (SEQ - 1);
        const int cnt = (t + 1 < w) ? t + 1 : w;
        f32x4 s0 = (f32x4){0.f, 0.f, 0.f, 0.f}, s1 = s0, x0 = s0, x1 = s0;
        for (int j = 0; j < cnt; ++j) { f32x4 a, b; unpack8(*(const u32x4*)(pl + (size_t)(row - j) * 1024 + c8), a, b); s0 += a; s1 += b; if (j == 0) { x0 = a; x1 = b; } }
        const float inv = 1.0f / (float)cnt;
        *(u32x4*)(po + (size_t)row * 1024 + c8) = pack8(s0 * inv - x0, s1 * inv - x1);
    }
}
__device__ __forceinline__ unsigned ordkey(float x) { const unsigned u = __float_as_uint(x); return u ^ ((unsigned)((int)u >> 31) | 0x80000000u); }
__device__ __forceinline__ void indexer_query(Frame& F, int b, int t, unsigned* rowbuf) {
    const bf16_t* iq = (const bf16_t*)(F.ws + WS_IQ); const bf16_t* ik = (const bf16_t*)(F.ws + WS_IK); const float* iw = (const float*)(F.ws + WS_IW);
    unsigned short* sel = (unsigned short*)(F.ws + WS_SEL);
    const int lane = F.lane, row = b * SEQ + t, fr = lane & 15, fq = lane >> 4;
    unsigned short* selrow = sel + (size_t)row * 256;
    if (t < KSEL) {
#pragma unroll
        for (int p = 0; p < 4; ++p) { const int j = p * 64 + lane; selrow[j] = (unsigned short)(j <= t ? j : 0xFFFF); }
        return;
    }
    const bf16_t* iqr = iq + (size_t)row * 1024 + fr * 64 + fq * 8;
    const bf16x8 a0 = *(const bf16x8*)iqr, a1 = *(const bf16x8*)(iqr + 32);
    float wv[4];
#pragma unroll
    for (int r = 0; r < 4; ++r) wv[r] = iw[(size_t)row * 16 + 4 * fq + r];
    const int nch = t / 64 + 1;
    const bf16_t* ikb = ik + (size_t)b * SEQ * 64 + fr * 64 + fq * 8;
    for (int c = 0; c < nch; ++c) {
        float sc = 0.f;
#pragma unroll
        for (int kb = 0; kb < 4; ++kb) {
            const bf16_t* kr = ikb + (size_t)(c * 64 + kb * 16) * 64;
            const bf16x8 b0 = *(const bf16x8*)kr, b1 = *(const bf16x8*)(kr + 32);
            f32x4 d = (f32x4){0.f, 0.f, 0.f, 0.f};
            d = __builtin_amdgcn_mfma_f32_16x16x32_bf16(a0, b0, d, 0, 0, 0);
            d = __builtin_amdgcn_mfma_f32_16x16x32_bf16(a1, b1, d, 0, 0, 0);
            float part = wv[0] * fmaxf(d[0], 0.f) + wv[1] * fmaxf(d[1], 0.f) + wv[2] * fmaxf(d[2], 0.f) + wv[3] * fmaxf(d[3], 0.f);
            part += __shfl_xor(part, 16); part += __shfl_xor(part, 32);
            sc = (fq == kb) ? part : sc;
        }
        const int s = c * 64 + lane;
        rowbuf[((c >> 2) * 64 + lane) * 4 + (c & 3)] = (s <= t) ? ordkey(sc) : 0u;
    }
    for (int c = nch; c < ((nch + 3) & ~3); ++c) rowbuf[((c >> 2) * 64 + lane) * 4 + (c & 3)] = 0u;
    const int n4 = (nch + 3) >> 2;
    const u32x4* rb4 = (const u32x4*)rowbuf;
    unsigned T = 0u;
    for (int bit = 31; bit >= 0; --bit) {
        const unsigned cand = T | (1u << bit); int cnt = 0;
        for (int c4 = 0; c4 < n4; ++c4) { const u32x4 k4 = rb4[c4 * 64 + lane];
            cnt += __popcll(__ballot(k4.x >= cand)) + __popcll(__ballot(k4.y >= cand)) + __popcll(__ballot(k4.z >= cand)) + __popcll(__ballot(k4.w >= cand)); }
        if (cnt >= KSEL) T = cand;
    }
    int cgt = 0;
    for (int c4 = 0; c4 < n4; ++c4) { const u32x4 k4 = rb4[c4 * 64 + lane];
        cgt += __popcll(__ballot(k4.x > T)) + __popcll(__ballot(k4.y > T)) + __popcll(__ballot(k4.z > T)) + __popcll(__ballot(k4.w > T)); }
    const int need_eq = KSEL - cgt;
    const unsigned long long lt_mask = (1ull << lane) - 1ull;
    int pos = 0, eqseen = 0;
    for (int c = 0; c < nch; ++c) {
        const unsigned k = rowbuf[((c >> 2) * 64 + lane) * 4 + (c & 3)];
        const bool gt = k > T, eq = k == T;
        const unsigned long long meq = __ballot(eq);
        const int eqrank = eqseen + __popcll(meq & lt_mask);
        const bool take = gt || (eq && eqrank < need_eq);
        const unsigned long long mt = __ballot(take);
        const int p = pos + __popcll(mt & lt_mask);
        if (take && p < KSEL) selrow[p] = (unsigned short)(c * 64 + lane);
        pos += __popcll(mt); eqseen += __popcll(meq);
    }
}
__device__ __forceinline__ void phase3_indexer(Frame& F) {
    unsigned* rowbuf = (unsigned*)(F.lds + F.wave * 16384);
    const int nit = BATCH * (SEQ / 8);
    for (int k = 0;; ++k) {
        const int l = k * F.G + ((k & 1) ? (F.G - 1 - F.bid) : F.bid);
        if (l >= nit) { if (k * F.G >= nit) break; else continue; }
        const int qb = (SEQ / 8 - 1) - (l >> 3), b = l & 7;
        indexer_query(F, b, qb * 8 + F.wave, rowbuf);
    }
}

__device__ const unsigned char g_bucket[128] = {0, 1, 2, 3, 4, 5, 6, 7, 8, 9, 10, 11, 12, 13, 14, 15, 16, 16, 16, 17, 17, 18, 18, 18, 19, 19, 19, 20, 20, 20, 20, 21, 21, 21, 21, 22, 22, 22, 22, 22, 23, 23, 23, 23, 23, 23, 24, 24, 24, 24, 24, 24, 25, 25, 25, 25, 25, 25, 25, 26, 26, 26, 26, 26, 26, 26, 26, 27, 27, 27, 27, 27, 27, 27, 27, 27, 27, 28, 28, 28, 28, 28, 28, 28, 28, 28, 28, 29, 29, 29, 29, 29, 29, 29, 29, 29, 29, 29, 29, 30, 30, 30, 30, 30, 30, 30, 30, 30, 30, 30, 30, 30, 30, 31, 31, 31, 31, 31, 31, 31, 31, 31, 31, 31, 31, 31, 31, 31};
__device__ __forceinline__ void phase4_attention(Frame& F) {
    const bf16_t* qn = (const bf16_t*)(F.ws + WS_QN); const bf16_t* kn = (const bf16_t*)(F.ws + WS_KN); const bf16_t* vb = (const bf16_t*)(F.ws + WS_V);
    const unsigned short* sel = (const unsigned short*)(F.ws + WS_SEL); bf16_t* ao = (bf16_t*)(F.ws + WS_ATTN);
    float* btab = (float*)F.lds;
    __syncthreads();
    for (int i = F.tid; i < 256; i += 512) btab[i] = F.rel_bias[i];
    __syncthreads();
    float* qf = (float*)(F.lds + 4096 + F.wave * 16384); float* Pl = qf + 1024; int* idl = (int*)(Pl + 2048);
    const int lane = F.lane, gw = F.bid * 8 + F.wave, NGW = F.G * 8;
    for (int row = gw; row < MTOK; row += NGW) {
        const int b = row / SEQ, t = row % SEQ;
#pragma unroll
        for (int p = 0; p < 4; ++p) { idl[p * 64 + lane] = (int)sel[(size_t)row * 256 + p * 64 + lane]; }
#pragma unroll
        for (int i = 0; i < 2; ++i) { const int ci = i * 64 + lane; f32x4 a, c; unpack8(*(const u32x4*)(qn + (size_t)row * 1024 + ci * 8), a, c);
            *(f32x4*)(qf + ci * 8) = a; *(f32x4*)(qf + ci * 8 + 4) = c; }
        float psum[8];
#pragma unroll
        for (int h = 0; h < 8; ++h) psum[h] = 0.f;
#pragma unroll 1
        for (int p = 0; p < 4; ++p) {
            const int key = idl[p * 64 + lane]; const bool valid = key <= t; const int kc = valid ? key : 0;
            const int dist = t - kc; const int bk = dist < 128 ? (int)g_bucket[dist] : 31;
            float lg[8];
#pragma unroll
            for (int g = 0; g < 2; ++g) {
                const bf16_t* kr = kn + ((size_t)b * SEQ + kc) * 256 + g * 128;
                float a4[4] = {0.f, 0.f, 0.f, 0.f};
#pragma unroll 4
                for (int dc = 0; dc < 16; ++dc) {
                    f32x4 k0, k1; unpack8(*(const u32x4*)(kr + dc * 8), k0, k1);
#pragma unroll
                    for (int hh = 0; hh < 4; ++hh) { const float* qp = qf + (g * 4 + hh) * 128 + dc * 8; const f32x4 q0 = *(const f32x4*)qp, q1 = *(const f32x4*)(qp + 4);
                        a4[hh] += k0[0] * q0[0] + k0[1] * q0[1] + k0[2] * q0[2] + k0[3] * q0[3] + k1[0] * q1[0] + k1[1] * q1[1] + k1[2] * q1[2] + k1[3] * q1[3]; }
                }
#pragma unroll
                for (int hh = 0; hh < 4; ++hh) lg[g * 4 + hh] = a4[hh];
            }
#pragma unroll
            for (int h = 0; h < 8; ++h) { const float e = valid ? __expf(lg[h] + btab[bk * 8 + h]) : 0.f; psum[h] += e; Pl[h * 256 + p * 64 + lane] = e; }
        }
#pragma unroll
        for (int h = 0; h < 8; ++h) psum[h] = wave_sum(psum[h]);
        const int ks = lane >> 4, dc = lane & 15;
        float acc[8][8];
#pragma unroll
        for (int h = 0; h < 8; ++h)
#pragma unroll
            for (int j = 0; j < 8; ++j) acc[h][j] = 0.f;
#pragma unroll 2
        for (int it = 0; it < 64; ++it) {
            const int j = it * 4 + ks; const int key = idl[j]; const int kc = key <= t ? key : 0;
            const bf16_t* vr = vb + ((size_t)b * SEQ + kc) * 256 + dc * 8;
#pragma unroll
            for (int g = 0; g < 2; ++g) { f32x4 v0, v1; unpack8(*(const u32x4*)(vr + g * 128), v0, v1);
#pragma unroll
                for (int hh = 0; hh < 4; ++hh) { const int h = g * 4 + hh; const float pj = Pl[h * 256 + j];
#pragma unroll
                    for (int e = 0; e < 4; ++e) { acc[h][e] += pj * v0[e]; acc[h][4 + e] += pj * v1[e]; } } }
        }
#pragma unroll
        for (int h = 0; h < 8; ++h)
#pragma unroll
            for (int j = 0; j < 8; ++j) { float v = acc[h][j]; v += __shfl_xor(v, 16); v += __shfl_xor(v, 32); acc[h][j] = v; }
#pragma unroll
        for (int h = 0; h < 8; ++h) if ((h >> 1) == ks) { const float inv = 1.0f / psum[h];
            f32x4 o0 = (f32x4){acc[h][0], acc[h][1], acc[h][2], acc[h][3]} * inv, o1 = (f32x4){acc[h][4], acc[h][5], acc[h][6], acc[h][7]} * inv;
            *(u32x4*)(ao + (size_t)row * 1024 + h * 128 + dc * 8) = pack8(o0, o1); }
    }
}

__device__ __forceinline__ float gelu_erf(float x) { return 0.5f * x * (1.0f + erff(x * 0.70710678118654752f)); }
__device__ __forceinline__ void phase10_peer(Frame& F) {
    const float* sub = (const float*)(F.ws + WS_SUB); const bf16_t* h2 = (const bf16_t*)(F.ws + WS_H2);
    const bf16_t* pu = (const bf16_t*)(F.ws + WS_PU); const bf16_t* pv = (const bf16_t*)(F.ws + WS_PV);
    const float* mf = (const float*)(F.ws + WS_MODF);
    int* elist = (int*)(F.lds + F.wave * 2048); float* gl = (float*)(elist + 128); float* cl = gl + 128;
    const int lane = F.lane, gw = F.bid * 8 + F.wave, NGW = F.G * 8;
    const unsigned long long lt_mask = (1ull << lane) - 1ull;
    const float NINF = -__builtin_huge_valf();
    for (int row = gw; row < MTOK; row += NGW) {
        const float* srow = sub + (size_t)row * 2048;
#pragma unroll 1
        for (int h = 0; h < 8; ++h) {
            const f32x4 v4 = *(const f32x4*)(srow + h * 256 + lane * 4);
            float v0 = v4[0], v1 = v4[1], v2 = v4[2], v3 = v4[3];
            float myval = NINF; int myidx = 0;
            const int half = lane >> 5, lh = lane & 31;
#pragma unroll 1
            for (int r = 0; r < 16; ++r) {
                float lm = v0; int li = 0;
                if (v1 > lm) { lm = v1; li = 1; } if (v2 > lm) { lm = v2; li = 2; } if (v3 > lm) { lm = v3; li = 3; }
                float gm = lm;
                gm = fmaxf(gm, __shfl_xor(gm, 1)); gm = fmaxf(gm, __shfl_xor(gm, 2)); gm = fmaxf(gm, __shfl_xor(gm, 4)); gm = fmaxf(gm, __shfl_xor(gm, 8)); gm = fmaxf(gm, __shfl_xor(gm, 16));
                const unsigned long long bal = __ballot(lm == gm);
                const unsigned hm = (unsigned)(bal >> (32 * half));
                const int wl = (__ffs((int)hm) - 1) + 32 * half;
                const int widx = __shfl(li, wl) + 4 * (wl & 31);
                if (lh == r) { myval = gm; myidx = widx; }
                if (lane == wl) { if (li == 0) v0 = NINF; else if (li == 1) v1 = NINF; else if (li == 2) v2 = NINF; else v3 = NINF; }
            }
            int ca, cb; const int c = lane;
            if (c < 16) { ca = 0; cb = c; } else if (c < 24) { ca = 1; cb = c - 16; } else if (c < 29) { ca = 2; cb = c - 24; } else if (c < 33) { ca = 3; cb = c - 29; }
            else if (c < 36) { ca = 4; cb = c - 33; } else if (c < 38) { ca = 5; cb = c - 36; } else if (c < 40) { ca = 6; cb = c - 38; } else if (c < 42) { ca = 7; cb = c - 40; }
            else { ca = (c - 42 + 8) & 15; cb = 0; }
            float s = __shfl(myval, ca) + __shfl(myval, 32 + cb);
            const int eid = __shfl(myidx, ca) * 128 + __shfl(myidx, 32 + cb);
            if (c >= 50) s = NINF;
            int rank = 0;
#pragma unroll 10
            for (int j = 0; j < 50; ++j) { const float sj = __shfl(s, j); rank += (sj > s || (sj == s && j < c)) ? 1 : 0; }
            const bool selq = (c < 50) && (rank < 16);
            const float smax = __shfl(s, 0);
            const float e = selq ? __expf(s - smax) : 0.f;
            const float esum = wave_sum(e);
            const unsigned long long ms = __ballot(selq);
            const int pos = __popcll(ms & lt_mask);
            if (selq) { elist[h * 16 + pos] = eid; gl[h * 16 + pos] = e / esum; }
        }
        float hf[32];
#pragma unroll
        for (int i = 0; i < 4; ++i) { f32x4 a, c; unpack8(*(const u32x4*)(h2 + (size_t)row * 2048 + i * 512 + lane * 8), a, c);
#pragma unroll
            for (int j = 0; j < 4; ++j) { hf[i * 8 + j] = a[j]; hf[i * 8 + 4 + j] = c[j]; } }
        float a_lo = 0.f, a_hi = 0.f;
#pragma unroll 4
        for (int j = 0; j < 128; ++j) {
            const int e = __builtin_amdgcn_readfirstlane(elist[j]);
            const bf16_t* ur = pu + (size_t)e * 2048 + lane * 8;
            float part = 0.f;
#pragma unroll
            for (int i = 0; i < 4; ++i) part += dot8(*(const u32x4*)(ur + i * 512), hf + i * 8);
            const float tot = wave_sum(part);
            if ((j & 63) == lane) { if (j < 64) a_lo = tot; else a_hi = tot; }
        }
        cl[lane] = gelu_erf(a_lo) * gl[lane]; cl[64 + lane] = gelu_erf(a_hi) * gl[64 + lane];
        float acc[32];
#pragma unroll
        for (int i = 0; i < 32; ++i) acc[i] = 0.f;
#pragma unroll 4
        for (int j = 0; j < 128; ++j) {
            const int e = __builtin_amdgcn_readfirstlane(elist[j]);
            const float cf = __uint_as_float(__builtin_amdgcn_readfirstlane(__float_as_uint(cl[j])));
            const bf16_t* vr = pv + (size_t)e * 2048 + lane * 8;
#pragma unroll
            for (int i = 0; i < 4; ++i) { f32x4 a, c; unpack8(*(const u32x4*)(vr + i * 512), a, c);
#pragma unroll
                for (int k = 0; k < 4; ++k) { acc[i * 8 + k] += cf * a[k]; acc[i * 8 + 4 + k] += cf * c[k]; } }
        }
        const float* gt2 = mf + (size_t)(row / SEQ) * 12288 + 10240;
#pragma unroll
        for (int i = 0; i < 4; ++i) { const int col = i * 512 + lane * 8; float* op = F.out + (size_t)row * 2048 + col;
            const f32x4 x0 = *(const f32x4*)op, x1 = *(const f32x4*)(op + 4), g0 = *(const f32x4*)(gt2 + col), g1 = *(const f32x4*)(gt2 + col + 4);
            const f32x4 a0 = (f32x4){acc[i * 8], acc[i * 8 + 1], acc[i * 8 + 2], acc[i * 8 + 3]}, a1 = (f32x4){acc[i * 8 + 4], acc[i * 8 + 5], acc[i * 8 + 6], acc[i * 8 + 7]};
            *(f32x4*)op = x0 + g0 * a0; *(f32x4*)(op + 4) = x1 + g1 * a1; }
    }
}

__global__ void __launch_bounds__(512, 2) fwd_kernel(Args args) {
    extern __shared__ __attribute__((aligned(16))) unsigned char lds[];
    Frame F;
    F.lds = lds; F.ws = args.ws; F.tid = threadIdx.x; F.lane = F.tid & 63; F.wave = __builtin_amdgcn_readfirstlane(F.tid >> 6); F.G = gridDim.x; F.bid = blockIdx.x;
    F.x = args.in[0]; F.c = args.in[1]; F.w_ada = args.in[2]; F.b_ada = args.in[3]; F.g1 = args.in[4]; F.g2 = args.in[5]; F.w_in = args.in[6]; F.g_q = args.in[7]; F.g_k = args.in[8];
    F.rel_bias = args.in[9]; F.pool_w = args.in[10]; F.pool_scale = args.in[11]; F.w_ab = args.in[12]; F.w_pb = args.in[13]; F.w_out = args.in[14]; F.w_pq = args.in[15];
    F.peer_keys = args.in[16]; F.peer_u = args.in[17]; F.peer_v = args.in[18]; F.out = args.out;
    LAS unsigned char* ldsl = (LAS unsigned char*)lds;
    volatile LAS unsigned* misc = (volatile LAS unsigned*)(ldsl + MISC_OFF);
    if (F.tid < 4) misc[F.tid] = 0u;
    __syncthreads();
    unsigned* barw = (unsigned*)(args.ws + WS_CTL) + (size_t)args.li * XCD_BAR_WORDS;
    XcdBarrier bar; bar.bar = barw; bar.x = 0; bar.st = misc;
    const int lo = args.ph_lo, hi = args.ph_hi;
    if (hi - lo > 1) bar = xcd_barrier_post(barw, misc);
#define IN(k) (lo <= (k) && (k) < hi)
#define SEAM(k) do { if (IN(k) && IN((k) + 1)) xcd_barrier(bar); } while (0)
    bf16_t* R0 = (bf16_t*)(F.ws + WS_R0);

    if (IN(0)) { phase0_prep(F); }
    SEAM(0);
    if (IN(1)) { phase_modnorm<true>(F, F.x, F.g1, 0, 2048, R0); }
    SEAM(1);
    if (IN(2)) {
        pg8::Gemm g{R0, (const bf16_t*)(F.ws + WS_WIN), MTOK, INWP, DM, DM, 0}; pg8::StaticOrder S; S.init(MTOK, INWP, F.G, F.bid);
        EpiInproj E{(bf16_t*)(F.ws + WS_QN), (bf16_t*)(F.ws + WS_KN), (bf16_t*)(F.ws + WS_V), (bf16_t*)(F.ws + WS_IQ), (bf16_t*)(F.ws + WS_IK), (bf16_t*)(F.ws + WS_PL),
                    (bf16_t*)(F.ws + WS_GA), (bf16_t*)(F.ws + WS_GP), (float*)(F.ws + WS_IW)};
        pg8::gemm_phase<EpiInproj>(ldsl, g, S, E);
    }
    SEAM(2);
    if (IN(3)) { phase3_qknorm(F); phase3_pooled(F); phase3_indexer(F); }
    SEAM(3);
    if (IN(4)) {
        phase4_attention(F);
        __syncthreads();
        pg8::Gemm g{(const bf16_t*)(F.ws + WS_POOLED), (const bf16_t*)(F.ws + WS_POOLW), MTOK, PW, 256, 1024, 256}; pg8::StaticOrder S; S.init(MTOK, PW, F.G, F.bid);
        EpiBf16Scale E{(bf16_t*)(F.ws + WS_POOL2), 1024, F.pool_scale};
        pg8::gemm_phase<EpiBf16Scale>(ldsl, g, S, E);
    }
    SEAM(4);
    if (IN(5)) {
        { pg8::Gemm g{(const bf16_t*)(F.ws + WS_ATTN), (const bf16_t*)(F.ws + WS_WAB), MTOK, DM, 1024, 1024, 0}; pg8::StaticOrder S; S.init(MTOK, DM, F.G, F.bid);
          EpiGate<false> E{R0, (const bf16_t*)(F.ws + WS_GA)}; pg8::gemm_phase<EpiGate<false>>(ldsl, g, S, E); }
        { pg8::Gemm g{(const bf16_t*)(F.ws + WS_POOL2), (const bf16_t*)(F.ws + WS_WPB), MTOK, DM, 1024, 1024, 0}; pg8::StaticOrder S; S.init(MTOK, DM, F.G, F.bid);
          EpiGate<true> E{R0, (const bf16_t*)(F.ws + WS_GP)}; pg8::gemm_phase<EpiGate<true>>(ldsl, g, S, E); }
    }
    SEAM(5);
    if (IN(6)) {
        pg8::Gemm g{R0, (const bf16_t*)(F.ws + WS_WOUT), MTOK, DM, DM, DM, 0}; pg8::StaticOrder S; S.init(MTOK, DM, F.G, F.bid);
        EpiResid E{F.x, F.out, (const float*)(F.ws + WS_MODF) + 4096}; pg8::gemm_phase<EpiResid>(ldsl, g, S, E);
    }
    SEAM(6);
    if (IN(7)) { phase_modnorm<false>(F, F.out, F.g2, 6144, 8192, (bf16_t*)(F.ws + WS_H2)); }
    SEAM(7);
    if (IN(8)) {
        pg8::Gemm g{(const bf16_t*)(F.ws + WS_H2), (const bf16_t*)(F.ws + WS_WPQ), MTOK, DM, DM, DM, 0}; pg8::StaticOrder S; S.init(MTOK, DM, F.G, F.bid);
        EpiBf16Scale E{R0, 2048, nullptr}; pg8::gemm_phase<EpiBf16Scale>(ldsl, g, S, E);
    }
    SEAM(8);
    if (IN(9)) {
        pg8::Gemm g{R0, (const bf16_t*)(F.ws + WS_KEYSBD), MTOK, DM, 256, DM, 256}; pg8::StaticOrder S; S.init(MTOK, DM, F.G, F.bid);
        EpiF32 E{(float*)(F.ws + WS_SUB), 2048}; pg8::gemm_phase<EpiF32>(ldsl, g, S, E);
    }
    SEAM(9);
    if (IN(10)) { phase10_peer(F); }
#undef IN
#undef SEAM
}

extern "C" void kernel_launch(void* const* d_in, const int* in_sizes, int n_in, void* d_out, int out_size, void* d_ws, size_t ws_size, hipStream_t stream) {
    static int grid = 0;
    if (grid == 0) {
        if (n_in != 19 || out_size != MTOK * DM || ws_size < WS_END) { fprintf(stderr, "kernel_launch: unexpected shapes (n_in %d out %d ws %zu)\n", n_in, out_size, ws_size); grid = -1; return; }
        int dev = 0, cus = 0, per_cu = 0;
        if (hipGetDevice(&dev) != hipSuccess || hipDeviceGetAttribute(&cus, hipDeviceAttributeMultiprocessorCount, dev) != hipSuccess) { grid = -1; return; }
        if (hipFuncSetAttribute((const void*)fwd_kernel, hipFuncAttributeMaxDynamicSharedMemorySize, LDS_BYTES) != hipSuccess) { fprintf(stderr, "kernel_launch: hipFuncSetAttribute failed\n"); grid = -1; return; }
        if (hipOccupancyMaxActiveBlocksPerMultiprocessor(&per_cu, (const void*)fwd_kernel, 512, LDS_BYTES) != hipSuccess || per_cu < 1) { fprintf(stderr, "kernel_launch: occupancy query says %d\n", per_cu); }
        (void)hipGetLastError();
        grid = cus;
    }
    if (grid < 0) return;
    (void)in_sizes;
    if (hipMemsetAsync((char*)d_ws + WS_CTL, 0, CTL_ZERO_BYTES, stream) != hipSuccess) return;
    Args a{};
    for (int i = 0; i < 19; ++i) a.in[i] = (const float*)d_in[i];
    a.out = (float*)d_out; a.ws = (unsigned char*)d_ws;
#if MK_PER_PHASE
    for (int p = 0; p < NPHASE; ++p) { a.ph_lo = p; a.ph_hi = p + 1; a.li = p; hipLaunchKernelGGL(fwd_kernel, dim3(grid), dim3(512), LDS_BYTES, stream, a); }
#else
    a.ph_lo = 0; a.ph_hi = NPHASE; a.li = 0;
    hipLaunchKernelGGL(fwd_kernel, dim3(grid), dim3(512), LDS_BYTES, stream, a);
#endif
}
```

```cpp
#include <hip/hip_runtime.h>
#include <cstdio>
#include <cstdint>

#ifndef MK_PER_PHASE
#define MK_PER_PHASE 0
#endif

#define LAS __attribute__((address_space(3)))
typedef unsigned short bf16_t;
typedef short bf16x8 __attribute__((ext_vector_type(8)));
typedef float f32x4 __attribute__((ext_vector_type(4)));
typedef float f32x2 __attribute__((ext_vector_type(2)));
typedef unsigned u32x4 __attribute__((ext_vector_type(4)));
typedef unsigned u32x2 __attribute__((ext_vector_type(2)));

constexpr int BATCH = 8, SEQ = 4096, DM = 2048, MTOK = BATCH * SEQ;
constexpr int NHEAD = 8, HDIM = 128, AW = 1024, KVW = 256, IHEADS = 16, IDIM = 64, KSEL = 256;
constexpr int PW = 1024, PHEADS = 8, NEXP = 16384;
constexpr int INW = 7760, INWP = 7936;
constexpr float EPS = 1e-6f;
constexpr int NPHASE = 11;

constexpr size_t MiB = 1u << 20;
constexpr size_t WS_CTL = 0, CTL_ZERO_BYTES = 256 * 1024;
constexpr size_t WS_MODP = 2 * MiB;
constexpr size_t WS_MODF = 4 * MiB;
constexpr size_t WS_POOLW = 5 * MiB;
constexpr size_t WS_KEYSBD = 6 * MiB;
constexpr size_t WS_WIN = 8 * MiB;
constexpr size_t WS_WAB = 40 * MiB, WS_WPB = 44 * MiB, WS_WOUT = 48 * MiB, WS_WPQ = 56 * MiB;
constexpr size_t WS_PU = 64 * MiB, WS_PV = 128 * MiB;
constexpr size_t WS_R0 = 192 * MiB;
constexpr size_t WS_GA = 320 * MiB, WS_GP = 448 * MiB;
constexpr size_t WS_SUB = 320 * MiB;
constexpr size_t WS_QN = 576 * MiB;
constexpr size_t WS_IQ = 640 * MiB;
constexpr size_t WS_PL = 704 * MiB;
constexpr size_t WS_KN = 768 * MiB, WS_V = 784 * MiB;
constexpr size_t WS_IK = 800 * MiB;
constexpr size_t WS_IW = 804 * MiB;
constexpr size_t WS_SEL = 806 * MiB;
constexpr size_t WS_POOLED = 822 * MiB;
constexpr size_t WS_H2 = 886 * MiB;
constexpr size_t WS_END = 1014 * MiB;
constexpr size_t WS_ATTN = WS_IQ, WS_POOL2 = WS_PL;

constexpr int LDS_BYTES = 160 * 1024;
constexpr int MISC_OFF = 156 * 1024;

__device__ __forceinline__ unsigned cvt_pk_bf16(float lo, float hi) { unsigned r; asm volatile("v_cvt_pk_bf16_f32 %0, %1, %2" : "=v"(r) : "v"(lo), "v"(hi)); return r; }
__device__ __forceinline__ float bf_lo(unsigned w) { return __uint_as_float(w << 16); }
__device__ __forceinline__ float bf_hi(unsigned w) { return __uint_as_float(w & 0xffff0000u); }
template <int CTRL> __device__ __forceinline__ float dpp_f(float x) { return __int_as_float(__builtin_amdgcn_update_dpp(0, __float_as_int(x), CTRL, 0xF, 0xF, true)); }
#define DPP_XOR1 0xB1
#define DPP_XOR2 0x4E
#define DPP_HMIRROR 0x141
#define DPP_MIRROR 0x140
#define DPP_ROR8 0x128
__device__ __forceinline__ float xor16_sum(float x) { const auto r = __builtin_amdgcn_permlane16_swap(__float_as_uint(x), __float_as_uint(x), false, false); return __uint_as_float(r[0]) + __uint_as_float(r[1]); }
__device__ __forceinline__ float xor32_sum(float x) { const auto r = __builtin_amdgcn_permlane32_swap(__float_as_uint(x), __float_as_uint(x), false, false); return __uint_as_float(r[0]) + __uint_as_float(r[1]); }
__device__ __forceinline__ float xor16_max(float x) { const auto r = __builtin_amdgcn_permlane16_swap(__float_as_uint(x), __float_as_uint(x), false, false); return fmaxf(__uint_as_float(r[0]), __uint_as_float(r[1])); }
__device__ __forceinline__ float swap32_pair(float a, float b) { const auto r = __builtin_amdgcn_permlane32_swap(__float_as_uint(a), __float_as_uint(b), false, false); return __uint_as_float(r[0]) + __uint_as_float(r[1]); }
__device__ __forceinline__ float swap16_pair(float a, float b) { const auto r = __builtin_amdgcn_permlane16_swap(__float_as_uint(a), __float_as_uint(b), false, false); return __uint_as_float(r[0]) + __uint_as_float(r[1]); }
__device__ __forceinline__ float row_sum16(float v) { v += dpp_f<DPP_XOR1>(v); v += dpp_f<DPP_XOR2>(v); v += dpp_f<DPP_HMIRROR>(v); v += dpp_f<DPP_MIRROR>(v); return v; }
__device__ __forceinline__ float row_max16(float v) { v = fmaxf(v, dpp_f<DPP_XOR1>(v)); v = fmaxf(v, dpp_f<DPP_XOR2>(v)); v = fmaxf(v, dpp_f<DPP_HMIRROR>(v)); v = fmaxf(v, dpp_f<DPP_MIRROR>(v)); return v; }
__device__ __forceinline__ float wave_sum(float v) { return xor32_sum(xor16_sum(row_sum16(v))); }
__device__ __forceinline__ float sigmoidf_(float x) { return __builtin_amdgcn_rcpf(1.0f + __expf(-x)); }
__device__ __forceinline__ float dot8(u32x4 w, const float* h) {
    return bf_lo(w.x) * h[0] + bf_hi(w.x) * h[1] + bf_lo(w.y) * h[2] + bf_hi(w.y) * h[3] + bf_lo(w.z) * h[4] + bf_hi(w.z) * h[5] + bf_lo(w.w) * h[6] + bf_hi(w.w) * h[7];
}

#define XB_TMO      128
#define XB_XCNT(j)  (256  + 64 * (j))
#define XB_XSUB(j)  (1280 + 64 * (j))
#define XB_XGEN(j)  (2304 + 64 * (j))
#define XB_TOP      3328
#define XB_TOPGEN   3392
#define XCD_BAR_WORDS 3456
#define XB_SPIN_CAP (1u << 18)

__device__ __forceinline__ unsigned xb_ld(unsigned* p)              { return __hip_atomic_load(p, __ATOMIC_RELAXED, __HIP_MEMORY_SCOPE_AGENT); }
__device__ __forceinline__ unsigned xb_add(unsigned* p, unsigned v) { return __hip_atomic_fetch_add(p, v, __ATOMIC_RELAXED, __HIP_MEMORY_SCOPE_AGENT); }
__device__ __forceinline__ unsigned xb_xcc_id() { return (unsigned)__builtin_amdgcn_s_getreg((3 << 11) | 20) & 0xFu; }
#define XB_SPIN(cond, bar) do { unsigned _sp = 0; while (cond) { __builtin_amdgcn_s_sleep(1); \
    if ((++_sp & 255u) == 0u) { if (xb_ld(&(bar)[XB_TMO])) break; if (_sp > XB_SPIN_CAP) { atomicAdd(&(bar)[XB_TMO], 1u); break; } } } } while (0)

struct XcdBarrier { unsigned* bar; unsigned x; volatile LAS unsigned* st; };

__device__ __forceinline__ XcdBarrier xcd_barrier_post(unsigned* bar, volatile LAS unsigned* st) {
    XcdBarrier b; b.bar = bar; b.x = xb_xcc_id(); b.st = st;
    if (threadIdx.x == 0) (void)xb_add(&bar[XB_XCNT(b.x)], 1u);
    return b;
}
__device__ __forceinline__ void xcd_barrier_complete(unsigned* bar, unsigned x, unsigned& nloc, unsigned& nx) {
    const unsigned G = gridDim.x * gridDim.y * gridDim.z;
    unsigned sum, cnt, mine, sp = 0u;
    for (;;) {
        sum = 0u; cnt = 0u; mine = 0u;
#pragma unroll
        for (unsigned j = 0; j < 16; ++j) { const unsigned c = xb_ld(&bar[XB_XCNT(j)]); sum += c; cnt += (c > 0u) ? 1u : 0u; mine = (j == x) ? c : mine; }
        if (sum == G) break;
        __builtin_amdgcn_s_sleep(1);
        if ((++sp & 255u) == 0u) { if (xb_ld(&bar[XB_TMO])) break; if (sp > XB_SPIN_CAP) { atomicAdd(&bar[XB_TMO], 1u); break; } }
    }
    nloc = mine > 0u ? mine : 1u; nx = cnt > 0u ? cnt : 1u;
}
__device__ __forceinline__ void xcd_barrier(const XcdBarrier& b) {
    asm volatile("s_waitcnt vmcnt(0)" ::: "memory");
    __syncthreads();
    if (threadIdx.x == 0) {
        unsigned* bar = b.bar;
        __builtin_amdgcn_s_waitcnt(0);
        unsigned nloc = b.st[0], nx = b.st[1];
        if (nloc == 0u) { xcd_barrier_complete(bar, b.x, nloc, nx); b.st[0] = nloc; b.st[1] = nx; }
        const unsigned old = xb_add(&bar[XB_XSUB(b.x)], 1u);
        const unsigned gen = old / nloc;
        if (old + 1u == (gen + 1u) * nloc) {
            __builtin_amdgcn_fence(__ATOMIC_RELEASE, "agent");
            asm volatile("s_waitcnt vmcnt(0)" ::: "memory");
            const unsigned og = xb_add(&bar[XB_TOP], 1u);
            const unsigned tg = og / nx;
            if (og + 1u == (tg + 1u) * nx) xb_add(&bar[XB_TOPGEN], 1u);
            else XB_SPIN(xb_ld(&bar[XB_TOPGEN]) == tg, bar);
            __builtin_amdgcn_fence(__ATOMIC_ACQUIRE, "agent");
            xb_add(&bar[XB_XGEN(b.x)], 1u);
            asm volatile("s_waitcnt vmcnt(0)" ::: "memory");
        } else {
            XB_SPIN(xb_ld(&bar[XB_XGEN(b.x)]) == gen, bar);
            __builtin_amdgcn_fence(__ATOMIC_ACQUIRE, "agent");
            asm volatile("s_waitcnt vmcnt(0)" ::: "memory");
        }
    }
    __syncthreads();
}

namespace pg8 {
constexpr int BM = 256, BK = 64, HALF = 128, HTB = HALF * BK * 2, STAGE_BYTES = 8 * HTB, NXCD = 8, WGM = 8;
__device__ __forceinline__ int lds_byte(int r, int c) { const int st = (r >> 4) * 2 + (c >> 5), rr = r & 15, cc = c & 31, ob = rr * 64 + cc * 2; return st * 1024 + (ob ^ (((ob >> 9) & 1) << 5)); }
__device__ __forceinline__ void stage_rc(int b, int& R, int& C) { const int st = b / 1024, sb = b % 1024, swz = sb ^ (((sb >> 9) & 1) << 5); R = (st >> 1) * 16 + swz / 64; C = (st & 1) * 32 + (swz % 64) / 2; }
__device__ __forceinline__ int perm32(int rho) { const int n = rho >> 4, i = rho & 15; return 8 * (i >> 2) + 4 * n + (i & 3); }

struct Unit { int pm, pn; };
struct Gemm { const bf16_t* A; const bf16_t* Bt; int M, N, K, lda, a_pn_off; };

struct StaticOrder {
    int nM, nN, nwg, G, c;
    __device__ void init(int M, int N, int G_, int c_) { nM = M / BM; nN = N / BM; nwg = nM * nN; G = G_; c = c_; }
    __device__ bool next(int i, Unit& u) const {
        const long L = (long)i * G + c; if (L >= nwg) return false;
        int wgid = (int)L; { const int q = nwg / NXCD, r = nwg % NXCD, xcd = wgid % NXCD, off = wgid / NXCD; wgid = (xcd < r ? xcd * (q + 1) : r * (q + 1) + (xcd - r) * q) + off; }
        const int nig = WGM * nN, gid = wgid / nig, fm = gid * WGM, gsz = (nM - fm) < WGM ? (nM - fm) : WGM;
        u.pm = fm + ((wgid % nig) % gsz); u.pn = (wgid % nig) / gsz; return true;
    }
};

template <class Epi>
__device__ __forceinline__ void gemm_phase(LAS unsigned char* lds, const Gemm g, const StaticOrder& S, const Epi& E) {
    const int tid = threadIdx.x, wid = __builtin_amdgcn_readfirstlane(tid >> 6), lane = tid & 63, wr = wid >> 2, wc = wid & 3, fr = lane & 15, fq = lane >> 4;
    const int K = g.K, nt = K / BK, lda = g.lda;
    unsigned voffA[2], voffB[2];
#pragma unroll
    for (int i = 0; i < 2; ++i) { int R, C; stage_rc(tid * 16 + i * 8192, R, C); const int Rb = Epi::PERM ? ((R & ~31) + perm32(R & 31)) : R;
        voffA[i] = (unsigned)(R * lda + C) * 2u; voffB[i] = (unsigned)(Rb * K + C) * 2u; }
    const size_t kstep = (size_t)(BK * 2);
    const size_t hsA = (size_t)HALF * lda * 2, hsB = (size_t)HALF * K * 2;
    const size_t tsA = 2 * hsA, tsB = 2 * hsB;
    const unsigned ldsw = (unsigned)wid * 1024u;
    const int aoff = lds_byte(wr * 64 + fr, fq * 8), boff = lds_byte(wc * 32 + fr, fq * 8);
#define PG8_SA(b, h) (((b) * 2 + (h)) * HTB)
#define PG8_SB(b, h) ((4 + (b) * 2 + (h)) * HTB)
#define PG8_STAGE(bufoff, gbase, voff) do { _Pragma("unroll") for (int _i = 0; _i < 2; ++_i) \
        __builtin_amdgcn_global_load_lds((const unsigned*)((const char*)(gbase) + (voff)[_i]), (LAS unsigned*)(lds + (bufoff) + ldsw + _i * 8192), 16, 0, 0); } while (0)
#define PG8_LDA(dst, b, h) do { _Pragma("unroll") for (int m = 0; m < 4; ++m) _Pragma("unroll") for (int k = 0; k < 2; ++k) dst[m][k] = *(const LAS bf16x8*)(lds + PG8_SA(b, h) + aoff + m * 2048 + k * 1024); } while (0)
#define PG8_LDB(dst, b, h) do { _Pragma("unroll") for (int n = 0; n < 2; ++n) _Pragma("unroll") for (int k = 0; k < 2; ++k) dst[n][k] = *(const LAS bf16x8*)(lds + PG8_SB(b, h) + boff + n * 2048 + k * 1024); } while (0)
#define PG8_MMA(ai, bj, At, Bt) do { __builtin_amdgcn_s_setprio(1); _Pragma("unroll") for (int m = 0; m < 4; ++m) _Pragma("unroll") for (int n = 0; n < 2; ++n) _Pragma("unroll") for (int k = 0; k < 2; ++k) \
        acc[ai][bj][m][n] = __builtin_amdgcn_mfma_f32_16x16x32_bf16(Bt[n][k], At[m][k], acc[ai][bj][m][n], 0, 0, 0); __builtin_amdgcn_s_setprio(0); } while (0)
#define PG8_WAIT_V(n) asm volatile("s_waitcnt vmcnt(" #n ")" ::: "memory")
#define PG8_WAIT_L(n) asm volatile("s_waitcnt lgkmcnt(" #n ")" ::: "memory")
#define PG8_BAR __builtin_amdgcn_s_barrier()
#define PG8_SCHED __builtin_amdgcn_sched_barrier(0)
    Unit cur, nxt; int ui = 0;
    if (!S.next(0, cur)) return;
    f32x4 acc[2][2][4][2];
#pragma unroll
    for (int a = 0; a < 2; ++a)
#pragma unroll
        for (int b = 0; b < 2; ++b)
#pragma unroll
            for (int m = 0; m < 4; ++m)
#pragma unroll
                for (int n = 0; n < 2; ++n) acc[a][b][m][n] = (f32x4){0.f, 0.f, 0.f, 0.f};
    bf16x8 At[4][2], B0[2][2], B1[2][2];
    const char* cA = (const char*)g.A + (size_t)cur.pm * tsA + (size_t)cur.pn * g.a_pn_off * 2; const char* cB = (const char*)g.Bt + (size_t)cur.pn * tsB;
    PG8_STAGE(PG8_SB(0, 0), cB, voffB); PG8_STAGE(PG8_SA(0, 0), cA, voffA); PG8_STAGE(PG8_SB(0, 1), cB + hsB, voffB); PG8_STAGE(PG8_SA(0, 1), cA + hsA, voffA);
    if (wr == 1) PG8_BAR;
    PG8_WAIT_V(4); PG8_BAR;
    PG8_STAGE(PG8_SB(1, 0), cB + kstep, voffB); PG8_STAGE(PG8_SA(1, 0), cA + kstep, voffA); PG8_STAGE(PG8_SB(1, 1), cB + hsB + kstep, voffB);
    PG8_WAIT_V(6); PG8_BAR;
    for (;;) {
        const bool has_next = S.next(ui + 1, nxt);
        const char* nA = has_next ? (const char*)g.A + (size_t)nxt.pm * tsA + (size_t)nxt.pn * g.a_pn_off * 2 : cA; const char* nB = has_next ? (const char*)g.Bt + (size_t)nxt.pn * tsB : cB;
        for (int t = 0; t < nt; t += 2) {
            const bool last = (t == nt - 2);
            const char* a1 = cA + (size_t)(t + 1) * kstep;
            const char* a2 = last ? nA : cA + (size_t)(t + 2) * kstep; const char* b2 = last ? nB : cB + (size_t)(t + 2) * kstep;
            const char* a3 = a2 + kstep; const char* b3 = b2 + kstep;
            PG8_LDB(B0, 0, 0); PG8_SCHED; PG8_LDA(At, 0, 0); PG8_STAGE(PG8_SA(1, 1), a1 + hsA, voffA);
            PG8_WAIT_L(8); PG8_BAR; PG8_WAIT_L(0); PG8_MMA(0, 0, At, B0); PG8_BAR; PG8_SCHED;
            PG8_LDB(B1, 0, 1); PG8_STAGE(PG8_SB(0, 0), b2, voffB);
            PG8_BAR; PG8_WAIT_L(0); PG8_MMA(0, 1, At, B1); PG8_BAR;
            PG8_LDA(At, 0, 1); PG8_STAGE(PG8_SA(0, 0), a2, voffA);
            PG8_BAR; PG8_WAIT_L(0); PG8_MMA(1, 0, At, B0); PG8_BAR; PG8_SCHED;
            PG8_STAGE(PG8_SB(0, 1), b2 + hsB, voffB);
            PG8_WAIT_V(6); PG8_BAR; PG8_MMA(1, 1, At, B1); PG8_BAR;
            PG8_LDB(B0, 1, 0); PG8_SCHED; PG8_LDA(At, 1, 0); PG8_STAGE(PG8_SA(0, 1), a2 + hsA, voffA);
            PG8_WAIT_L(8); PG8_BAR; PG8_WAIT_L(0); PG8_MMA(0, 0, At, B0); PG8_BAR; PG8_SCHED;
            PG8_LDB(B1, 1, 1); PG8_STAGE(PG8_SB(1, 0), b3, voffB);
            PG8_BAR; PG8_WAIT_L(0); PG8_MMA(0, 1, At, B1); PG8_BAR;
            PG8_LDA(At, 1, 1); PG8_STAGE(PG8_SA(1, 0), a3, voffA);
            PG8_BAR; PG8_WAIT_L(0); PG8_MMA(1, 0, At, B0); PG8_BAR; PG8_SCHED;
            PG8_STAGE(PG8_SB(1, 1), b3 + hsB, voffB);
            PG8_WAIT_V(6); PG8_BAR; PG8_MMA(1, 1, At, B1); PG8_BAR;
        }
        E(acc, cur, wr, wc, fr, fq);
        if (!has_next) break;
#pragma unroll
        for (int a = 0; a < 2; ++a)
#pragma unroll
            for (int b = 0; b < 2; ++b)
#pragma unroll
                for (int m = 0; m < 4; ++m)
#pragma unroll
                    for (int n = 0; n < 2; ++n) acc[a][b][m][n] = (f32x4){0.f, 0.f, 0.f, 0.f};
        cur = nxt; cA = nA; cB = nB; ++ui;
    }
    PG8_WAIT_V(0);
    if (wr == 0) PG8_BAR;
    PG8_BAR;
#undef PG8_SA
#undef PG8_SB
#undef PG8_STAGE
#undef PG8_LDA
#undef PG8_LDB
#undef PG8_MMA
#undef PG8_WAIT_V
#undef PG8_WAIT_L
#undef PG8_BAR
#undef PG8_SCHED
}
}
using pg8::Unit;

typedef f32x4 AccT[2][2][4][2];
__device__ __forceinline__ u32x4 pack8(f32x4 a, f32x4 b) { u32x4 w; w.x = cvt_pk_bf16(a[0], a[1]); w.y = cvt_pk_bf16(a[2], a[3]); w.z = cvt_pk_bf16(b[0], b[1]); w.w = cvt_pk_bf16(b[2], b[3]); return w; }
__device__ __forceinline__ void unpack8(u32x4 w, f32x4& a, f32x4& b) { a = (f32x4){bf_lo(w.x), bf_hi(w.x), bf_lo(w.y), bf_hi(w.y)}; b = (f32x4){bf_lo(w.z), bf_hi(w.z), bf_lo(w.w), bf_hi(w.w)}; }

struct EpiInproj {
    static constexpr bool PERM = true;
    bf16_t *q, *k, *v, *iq, *ik, *pl, *ga, *gp; float* iw;
    __device__ __forceinline__ void operator()(const AccT& acc, const Unit& u, int wr, int wc, int fr, int fq) const {
        const int pn = u.pn, row0 = u.pm * 256 + wr * 64 + fr;
        if (pn == 10) {
            if (wc < 2) {
#pragma unroll
                for (int ai = 0; ai < 2; ++ai)
#pragma unroll
                    for (int m = 0; m < 4; ++m) { const size_t row = (size_t)(row0 + ai * 128 + m * 16);
                        *(u32x4*)(ik + row * 64 + wc * 32 + 8 * fq) = pack8(acc[ai][0][m][0], acc[ai][0][m][1]); }
            } else if (wc == 2) {
                if (fq < 2) {
#pragma unroll
                    for (int ai = 0; ai < 2; ++ai)
#pragma unroll
                        for (int m = 0; m < 4; ++m) { const size_t row = (size_t)(row0 + ai * 128 + m * 16);
                            *(f32x4*)(iw + row * 16 + 8 * fq) = acc[ai][0][m][0]; *(f32x4*)(iw + row * 16 + 8 * fq + 4) = acc[ai][0][m][1]; }
                }
            }
            return;
        }
        bf16_t* dst; int ld, tc; bool sg = false;
        if (pn < 4) { dst = q; ld = 1024; tc = pn * 256; }
        else if (pn == 4) { dst = k; ld = 256; tc = 0; }
        else if (pn == 5) { dst = v; ld = 256; tc = 0; }
        else if (pn < 10) { dst = iq; ld = 1024; tc = (pn - 6) * 256; }
        else if (pn < 15) { dst = pl; ld = 1024; tc = (pn - 11) * 256; }
        else if (pn < 23) { dst = ga; ld = 2048; tc = (pn - 15) * 256; sg = true; }
        else { dst = gp; ld = 2048; tc = (pn - 23) * 256; sg = true; }
        const int col0 = tc + wc * 32 + 8 * fq;
#pragma unroll
        for (int ai = 0; ai < 2; ++ai)
#pragma unroll
            for (int m = 0; m < 4; ++m) { bf16_t* rowp = dst + (size_t)(row0 + ai * 128 + m * 16) * ld + col0;
#pragma unroll
                for (int bj = 0; bj < 2; ++bj) { f32x4 v0 = acc[ai][bj][m][0], v1 = acc[ai][bj][m][1];
                    if (sg) {
#pragma unroll
                        for (int j = 0; j < 4; ++j) { v0[j] = sigmoidf_(v0[j]); v1[j] = sigmoidf_(v1[j]); } }
                    *(u32x4*)(rowp + bj * 128) = pack8(v0, v1); } }
    }
};
struct EpiBf16Scale {
    static constexpr bool PERM = true;
    bf16_t* O; int ldc; const float* cs;
    __device__ __forceinline__ void operator()(const AccT& acc, const Unit& u, int wr, int wc, int fr, int fq) const {
        const int row0 = u.pm * 256 + wr * 64 + fr, col0 = u.pn * 256 + wc * 32 + 8 * fq;
        f32x4 s[2][2];
#pragma unroll
        for (int bj = 0; bj < 2; ++bj)
#pragma unroll
            for (int n = 0; n < 2; ++n) s[bj][n] = cs ? *(const f32x4*)(cs + col0 + bj * 128 + 4 * n) : (f32x4){1.f, 1.f, 1.f, 1.f};
#pragma unroll
        for (int ai = 0; ai < 2; ++ai)
#pragma unroll
            for (int m = 0; m < 4; ++m) { bf16_t* rowp = O + (size_t)(row0 + ai * 128 + m * 16) * ldc + col0;
#pragma unroll
                for (int bj = 0; bj < 2; ++bj) *(u32x4*)(rowp + bj * 128) = pack8(acc[ai][bj][m][0] * s[bj][0], acc[ai][bj][m][1] * s[bj][1]); }
    }
};
template <bool ADD> struct EpiGate {
    static constexpr bool PERM = true;
    bf16_t* O; const bf16_t* gate;
    __device__ __forceinline__ void operator()(const AccT& acc, const Unit& u, int wr, int wc, int fr, int fq) const {
        const int row0 = u.pm * 256 + wr * 64 + fr, col0 = u.pn * 256 + wc * 32 + 8 * fq;
#pragma unroll
        for (int ai = 0; ai < 2; ++ai)
#pragma unroll
            for (int m = 0; m < 4; ++m) { const size_t off = (size_t)(row0 + ai * 128 + m * 16) * 2048 + col0;
#pragma unroll
                for (int bj = 0; bj < 2; ++bj) { f32x4 g0, g1; unpack8(*(const u32x4*)(gate + off + bj * 128), g0, g1);
                    f32x4 r0 = g0 * acc[ai][bj][m][0], r1 = g1 * acc[ai][bj][m][1];
                    if (ADD) { f32x4 o0, o1; unpack8(*(const u32x4*)(O + off + bj * 128), o0, o1); r0 += o0; r1 += o1; }
                    *(u32x4*)(O + off + bj * 128) = pack8(r0, r1); } }
    }
};
struct EpiResid {
    static constexpr bool PERM = false;
    const float* x; float* out; const float* gt;
    __device__ __forceinline__ void operator()(const AccT& acc, const Unit& u, int wr, int wc, int fr, int fq) const {
        const int row0 = u.pm * 256 + wr * 64 + fr, col0 = u.pn * 256 + wc * 32 + 4 * fq;
        const float* gtb = gt + (size_t)(u.pm / 16) * 12288;
        f32x4 g[2][2];
#pragma unroll
        for (int bj = 0; bj < 2; ++bj)
#pragma unroll
            for (int n = 0; n < 2; ++n) g[bj][n] = *(const f32x4*)(gtb + col0 + bj * 128 + n * 16);
#pragma unroll
        for (int ai = 0; ai < 2; ++ai)
#pragma unroll
            for (int m = 0; m < 4; ++m) { const size_t off = (size_t)(row0 + ai * 128 + m * 16) * 2048 + col0;
#pragma unroll
                for (int bj = 0; bj < 2; ++bj)
#pragma unroll
                    for (int n = 0; n < 2; ++n) { const f32x4 xv = *(const f32x4*)(x + off + bj * 128 + n * 16);
                        *(f32x4*)(out + off + bj * 128 + n * 16) = xv + g[bj][n] * acc[ai][bj][m][n]; } }
    }
};
struct EpiF32 {
    static constexpr bool PERM = false;
    float* C; int ldc;
    __device__ __forceinline__ void operator()(const AccT& acc, const Unit& u, int wr, int wc, int fr, int fq) const {
        const int row0 = u.pm * 256 + wr * 64 + fr, col0 = u.pn * 256 + wc * 32 + 4 * fq;
#pragma unroll
        for (int ai = 0; ai < 2; ++ai)
#pragma unroll
            for (int m = 0; m < 4; ++m) { float* rowp = C + (size_t)(row0 + ai * 128 + m * 16) * ldc + col0;
#pragma unroll
                for (int bj = 0; bj < 2; ++bj)
#pragma unroll
                    for (int n = 0; n < 2; ++n) *(f32x4*)(rowp + bj * 128 + n * 16) = acc[ai][bj][m][n]; }
    }
};

struct Args { const float* in[19]; float* out; unsigned char* ws; int ph_lo, ph_hi; int li, pad; };
struct Frame {
    unsigned char* lds; unsigned char* ws;
    int tid, lane, wave, G, bid;
    const float *x, *c, *w_ada, *b_ada, *g1, *g2, *w_in, *g_q, *g_k, *rel_bias, *pool_w, *pool_scale, *w_ab, *w_pb, *w_out, *w_pq, *peer_keys, *peer_u, *peer_v;
    float* out;
};

template <class Fn> __device__ __forceinline__ void transpose_item(const float* W, int K, int N, bf16_t* WT, int ldk, int drow0, int k0, float* scr, int lane, Fn srccol) {
    const int sc = srccol(drow0 + (lane & 31));
#pragma unroll 8
    for (int i = 0; i < 32; ++i) { const int kk = 2 * i + (lane >> 5); scr[kk * 33 + (lane & 31)] = sc >= 0 ? W[(size_t)(k0 + kk) * N + sc] : 0.f; }
    asm volatile("s_waitcnt lgkmcnt(0)" ::: "memory");
    const int c = lane & 7;
#pragma unroll
    for (int j = 0; j < 4; ++j) { const int n = (lane >> 3) + 8 * j; const float* s = scr + (8 * c) * 33 + n;
        u32x4 o; o.x = cvt_pk_bf16(s[0 * 33], s[1 * 33]); o.y = cvt_pk_bf16(s[2 * 33], s[3 * 33]); o.z = cvt_pk_bf16(s[4 * 33], s[5 * 33]); o.w = cvt_pk_bf16(s[6 * 33], s[7 * 33]);
        *(u32x4*)(WT + (size_t)(drow0 + n) * ldk + k0 + 8 * c) = o; }
    asm volatile("s_waitcnt lgkmcnt(0)" ::: "memory");
}
__device__ __forceinline__ void phase0_prep(Frame& F) {
    const int gw = F.bid * 8 + F.wave, NGW = F.G * 8;
    float* scr = (float*)(F.lds + F.wave * 16384);
    constexpr int I_IN = (INWP / 32) * (DM / 64);
    constexpr int I_AB = (2048 / 32) * (1024 / 64), I_OUT = (2048 / 32) * (2048 / 64), I_PW = 4 * 8 * 4;
    constexpr int NIT = I_IN + 2 * I_AB + 2 * I_OUT + I_PW;
    auto ident = [](int j) { return j; };
    for (int it = gw; it < NIT; it += NGW) {
        int r = it;
        if (r < I_IN) { const int nb = r % (INWP / 32), kb = r / (INWP / 32);
            transpose_item(F.w_in, DM, INW, (bf16_t*)(F.ws + WS_WIN), DM, nb * 32, kb * 64, scr, F.lane, [](int j) { return j < 2640 ? j : (j < 2816 ? -1 : j - 176); }); continue; }
        r -= I_IN;
        if (r < I_AB) { transpose_item(F.w_ab, 1024, 2048, (bf16_t*)(F.ws + WS_WAB), 1024, (r % 64) * 32, (r / 64) * 64, scr, F.lane, ident); continue; }
        r -= I_AB;
        if (r < I_AB) { transpose_item(F.w_pb, 1024, 2048, (bf16_t*)(F.ws + WS_WPB), 1024, (r % 64) * 32, (r / 64) * 64, scr, F.lane, ident); continue; }
        r -= I_AB;
        if (r < I_OUT) { transpose_item(F.w_out, 2048, 2048, (bf16_t*)(F.ws + WS_WOUT), 2048, (r % 64) * 32, (r / 64) * 64, scr, F.lane, ident); continue; }
        r -= I_OUT;
        if (r < I_OUT) { transpose_item(F.w_pq, 2048, 2048, (bf16_t*)(F.ws + WS_WPQ), 2048, (r % 64) * 32, (r / 64) * 64, scr, F.lane, ident); continue; }
        r -= I_OUT;
        { const int g = r / 32, q = r % 32, nb = q % 8, kb = q / 8;
          transpose_item(F.pool_w + (size_t)g * 65536, 256, 256, (bf16_t*)(F.ws + WS_POOLW) + (size_t)g * 65536, 256, nb * 32, kb * 64, scr, F.lane, ident); }
    }
    {
        bf16_t* kb = (bf16_t*)(F.ws + WS_KEYSBD);
        for (int i = F.bid * 512 + F.tid; i < 2048 * 32; i += F.G * 512) {
            const int row = i / 32, k8 = (i % 32) * 8, p = (row >> 7) & 1;
            u32x4 o = (u32x4){0u, 0u, 0u, 0u};
            if ((k8 >> 7) == p) { const float* s = F.peer_keys + (size_t)row * 128 + (k8 & 127); const f32x4 a = *(const f32x4*)s, b = *(const f32x4*)(s + 4); o = pack8(a, b); }
            *(u32x4*)(kb + (size_t)row * 256 + k8) = o;
        }
    }
    {
        const size_t n16 = (size_t)NEXP * DM / 16;
        unsigned char* pu = F.ws + WS_PU; unsigned char* pv = F.ws + WS_PV;
        for (size_t i = (size_t)F.bid * 512 + F.tid; i < n16; i += (size_t)F.G * 512) {
            u32x4 ou, ov;
#pragma unroll
            for (int k = 0; k < 4; ++k) { const f32x4 a = *(const f32x4*)(F.peer_u + i * 16 + k * 4) * 64.0f, c = *(const f32x4*)(F.peer_v + i * 16 + k * 4) * 4.0f;
                int wu = __builtin_amdgcn_cvt_pk_fp8_f32(a[0], a[1], 0, false); wu = __builtin_amdgcn_cvt_pk_fp8_f32(a[2], a[3], wu, true);
                int wv = __builtin_amdgcn_cvt_pk_fp8_f32(c[0], c[1], 0, false); wv = __builtin_amdgcn_cvt_pk_fp8_f32(c[2], c[3], wv, true);
                ou[k] = (unsigned)wu; ov[k] = (unsigned)wv; }
            *(u32x4*)(pu + i * 16) = ou; *(u32x4*)(pv + i * 16) = ov;
        }
    }
    {
        __syncthreads();
        float* cact = (float*)(F.lds + 131072);
        float* red = (float*)F.lds;
        float* mp = (float*)(F.ws + WS_MODP);
        for (int it = F.bid; it < 48 * 4; it += F.G) {
            const int cb = it % 48, ds = it / 48, d0 = ds * 512;
            for (int i = F.tid; i < 8 * 512; i += 512) { const int b = i >> 9, d = i & 511; const float cv = F.c[b * DM + d0 + d]; cact[i] = cv * sigmoidf_(cv); }
            __syncthreads();
            f32x4 a[8];
#pragma unroll
            for (int b = 0; b < 8; ++b) a[b] = (f32x4){0.f, 0.f, 0.f, 0.f};
            const float* wp = F.w_ada + (size_t)(d0 + F.wave * 64) * 12288 + cb * 256 + F.lane * 4;
#pragma unroll 4
            for (int d = 0; d < 64; ++d) { const f32x4 w = *(const f32x4*)(wp + (size_t)d * 12288);
#pragma unroll
                for (int b = 0; b < 8; ++b) a[b] += w * cact[b * 512 + F.wave * 64 + d]; }
#pragma unroll
            for (int b = 0; b < 8; ++b)
#pragma unroll
                for (int j = 0; j < 4; ++j) red[(F.wave * 32 + b * 4 + j) * 64 + F.lane] = a[b][j];
            __syncthreads();
            for (int i = F.tid; i < 2048; i += 512) { const int v = i >> 6, l = i & 63; float s = 0.f;
#pragma unroll
                for (int w = 0; w < 8; ++w) s += red[(w * 32 + v) * 64 + l];
                mp[((size_t)ds * 8 + (v >> 2)) * 12288 + cb * 256 + l * 4 + (v & 3)] = s; }
            __syncthreads();
        }
    }
}

template <bool FIRST> __device__ __forceinline__ void phase_modnorm(Frame& F, const float* xin, const float* gain, int off_sh, int off_sc, bf16_t* dst) {
    const float* mp = (const float*)(F.ws + WS_MODP); float* mf = (float*)(F.ws + WS_MODF);
    if (FIRST) {
        for (int i = F.bid * 512 + F.tid; i < 8 * 12288; i += F.G * 512) {
            float s = F.b_ada[i % 12288];
#pragma unroll
            for (int k = 0; k < 4; ++k) s += mp[(size_t)k * 8 * 12288 + i];
            mf[i] = s; }
    }
    float* cA = (float*)F.lds; float* cB = cA + 2048;
    for (int ch = F.bid; ch < MTOK / 128; ch += F.G) {
        const int b = ch / 32;
        __syncthreads();
        for (int col = F.tid; col < 2048; col += 512) {
            float sc, sh;
            if (FIRST) { sc = F.b_ada[off_sc + col]; sh = F.b_ada[off_sh + col];
#pragma unroll
                for (int k = 0; k < 4; ++k) { sc += mp[((size_t)k * 8 + b) * 12288 + off_sc + col]; sh += mp[((size_t)k * 8 + b) * 12288 + off_sh + col]; } }
            else { sc = mf[b * 12288 + off_sc + col]; sh = mf[b * 12288 + off_sh + col]; }
            cA[col] = gain[col] * (1.f + sc); cB[col] = sh; }
        __syncthreads();
        for (int r = F.wave; r < 128; r += 8) {
            const size_t row = (size_t)ch * 128 + r;
            const float* xr = xin + row * 2048 + F.lane * 8;
            f32x4 v[4][2]; float ss = 0.f;
#pragma unroll
            for (int i = 0; i < 4; ++i) { v[i][0] = *(const f32x4*)(xr + i * 512); v[i][1] = *(const f32x4*)(xr + i * 512 + 4);
#pragma unroll
                for (int j = 0; j < 4; ++j) ss += v[i][0][j] * v[i][0][j] + v[i][1][j] * v[i][1][j]; }
            ss = wave_sum(ss);
            const float rinv = 1.0f / sqrtf(ss * (1.0f / 2048.0f) + EPS);
#pragma unroll
            for (int i = 0; i < 4; ++i) { const int col = i * 512 + F.lane * 8;
                const f32x4 a0 = *(const f32x4*)(cA + col), a1 = *(const f32x4*)(cA + col + 4), b0 = *(const f32x4*)(cB + col), b1 = *(const f32x4*)(cB + col + 4);
                *(u32x4*)(dst + row * 2048 + col) = pack8(v[i][0] * rinv * a0 + b0, v[i][1] * rinv * a1 + b1); }
        }
    }
}

__device__ __forceinline__ void phase3_qknorm(Frame& F) {
    bf16_t* q = (bf16_t*)(F.ws + WS_QN); bf16_t* k = (bf16_t*)(F.ws + WS_KN);
    const int gw = F.bid * 8 + F.wave, NGW = F.G * 8;
    for (int row = gw; row < MTOK; row += NGW) {
#pragma unroll
        for (int i = 0; i < 2; ++i) { const int ci = i * 64 + F.lane; bf16_t* p = q + (size_t)row * 1024 + ci * 8;
            f32x4 a, b; unpack8(*(const u32x4*)p, a, b);
            float ss = a[0] * a[0] + a[1] * a[1] + a[2] * a[2] + a[3] * a[3] + b[0] * b[0] + b[1] * b[1] + b[2] * b[2] + b[3] * b[3];
            ss = row_sum16(ss);
            const float rinv = (1.0f / sqrtf(ss * (1.0f / 128.0f) + EPS)) * 0.08838834764831845f;
            const float* gp = F.g_q + (ci & 15) * 8; const f32x4 g0 = *(const f32x4*)gp, g1 = *(const f32x4*)(gp + 4);
            *(u32x4*)p = pack8(a * rinv * g0, b * rinv * g1); }
        if (F.lane < 32) { const int ci = F.lane; bf16_t* p = k + (size_t)row * 256 + ci * 8;
            f32x4 a, b; unpack8(*(const u32x4*)p, a, b);
            float ss = a[0] * a[0] + a[1] * a[1] + a[2] * a[2] + a[3] * a[3] + b[0] * b[0] + b[1] * b[1] + b[2] * b[2] + b[3] * b[3];
            ss = row_sum16(ss);
            const float rinv = 1.0f / sqrtf(ss * (1.0f / 128.0f) + EPS);
            const float* gp = F.g_k + (ci & 15) * 8; const f32x4 g0 = *(const f32x4*)gp, g1 = *(const f32x4*)(gp + 4);
            *(u32x4*)p = pack8(a * rinv * g0, b * rinv * g1); }
    }
}
__device__ __forceinline__ void phase3_pooled(Frame& F) {
    const bf16_t* pl = (const bf16_t*)(F.ws + WS_PL); bf16_t* po = (bf16_t*)(F.ws + WS_POOLED);
    for (size_t i = (size_t)F.bid * 512 + F.tid; i < (size_t)MTOK * 128; i += (size_t)F.G * 512) {
        const int row = (int)(i >> 7), c8 = (int)(i & 127) * 8, g = c8 >> 8, w = 2 << g, t = row & (SEQ - 1);
        const int cnt = (t + 1 < w) ? t + 1 : w;
        f32x4 s0 = (f32x4){0.f, 0.f, 0.f, 0.f}, s1 = s0, x0 = s0, x1 = s0;
        for (int j = 0; j < cnt; ++j) { f32x4 a, b; unpack8(*(const u32x4*)(pl + (size_t)(row - j) * 1024 + c8), a, b); s0 += a; s1 += b; if (j == 0) { x0 = a; x1 = b; } }
        const float inv = 1.0f / (float)cnt;
        *(u32x4*)(po + (size_t)row * 1024 + c8) = pack8(s0 * inv - x0, s1 * inv - x1);
    }
}
__device__ __forceinline__ unsigned ordkey(float x) { const unsigned u = __float_as_uint(x); return u ^ ((unsigned)((int)u >> 31) | 0x80000000u); }
__device__ __forceinline__ void indexer_query(Frame& F, int b, int t, unsigned* rowbuf) {
    const bf16_t* iq = (const bf16_t*)(F.ws + WS_IQ); const bf16_t* ik = (const bf16_t*)(F.ws + WS_IK); const float* iw = (const float*)(F.ws + WS_IW);
    unsigned short* sel = (unsigned short*)(F.ws + WS_SEL);
    const int lane = F.lane, row = b * SEQ + t, fr = lane & 15, fq = lane >> 4;
    unsigned short* selrow = sel + (size_t)row * 256;
    if (t < KSEL) {
#pragma unroll
        for (int p = 0; p < 4; ++p) { const int j = p * 64 + lane; selrow[j] = (unsigned short)(j <= t ? j : 0xFFFF); }
        return;
    }
    const bf16_t* iqr = iq + (size_t)row * 1024 + fr * 64 + fq * 8;
    const bf16x8 a0 = *(const bf16x8*)iqr, a1 = *(const bf16x8*)(iqr + 32);
    float wv[4];
#pragma unroll
    for (int r = 0; r < 4; ++r) wv[r] = iw[(size_t)row * 16 + 4 * fq + r];
    const int nch = t / 64 + 1;
    const bf16_t* ikb = ik + (size_t)b * SEQ * 64 + fr * 64 + fq * 8;
    for (int c = 0; c < nch; ++c) {
        float sc = 0.f;
#pragma unroll
        for (int kb = 0; kb < 4; ++kb) {
            const bf16_t* kr = ikb + (size_t)(c * 64 + kb * 16) * 64;
            const bf16x8 b0 = *(const bf16x8*)kr, b1 = *(const bf16x8*)(kr + 32);
            f32x4 d = (f32x4){0.f, 0.f, 0.f, 0.f};
            d = __builtin_amdgcn_mfma_f32_16x16x32_bf16(a0, b0, d, 0, 0, 0);
            d = __builtin_amdgcn_mfma_f32_16x16x32_bf16(a1, b1, d, 0, 0, 0);
            float part = wv[0] * fmaxf(d[0], 0.f) + wv[1] * fmaxf(d[1], 0.f) + wv[2] * fmaxf(d[2], 0.f) + wv[3] * fmaxf(d[3], 0.f);
            part = xor32_sum(xor16_sum(part));
            sc = (fq == kb) ? part : sc;
        }
        const int s = c * 64 + lane;
        rowbuf[((c >> 2) * 64 + lane) * 4 + (c & 3)] = (s <= t) ? ordkey(sc) : 0u;
    }
    for (int c = nch; c < ((nch + 3) & ~3); ++c) rowbuf[((c >> 2) * 64 + lane) * 4 + (c & 3)] = 0u;
    const int n4 = (nch + 3) >> 2;
    const u32x4* rb4 = (const u32x4*)rowbuf;
    unsigned T = 0u;
    for (int bit = 31; bit >= 0; --bit) {
        const unsigned cand = T | (1u << bit); int cnt = 0;
        for (int c4 = 0; c4 < n4; ++c4) { const u32x4 k4 = rb4[c4 * 64 + lane];
            cnt += __popcll(__ballot(k4.x >= cand)) + __popcll(__ballot(k4.y >= cand)) + __popcll(__ballot(k4.z >= cand)) + __popcll(__ballot(k4.w >= cand)); }
        if (cnt >= KSEL) T = cand;
    }
    int cgt = 0;
    for (int c4 = 0; c4 < n4; ++c4) { const u32x4 k4 = rb4[c4 * 64 + lane];
        cgt += __popcll(__ballot(k4.x > T)) + __popcll(__ballot(k4.y > T)) + __popcll(__ballot(k4.z > T)) + __popcll(__ballot(k4.w > T)); }
    const int need_eq = KSEL - cgt;
    const unsigned long long lt_mask = (1ull << lane) - 1ull;
    int pos = 0, eqseen = 0;
    for (int c = 0; c < nch; ++c) {
        const unsigned k = rowbuf[((c >> 2) * 64 + lane) * 4 + (c & 3)];
        const bool gt = k > T, eq = k == T;
        const unsigned long long meq = __ballot(eq);
        const int eqrank = eqseen + __popcll(meq & lt_mask);
        const bool take = gt || (eq && eqrank < need_eq);
        const unsigned long long mt = __ballot(take);
        const int p = pos + __popcll(mt & lt_mask);
        if (take && p < KSEL) selrow[p] = (unsigned short)(c * 64 + lane);
        pos += __popcll(mt); eqseen += __popcll(meq);
    }
}
__device__ __forceinline__ void phase3_indexer(Frame& F) {
    unsigned* rowbuf = (unsigned*)(F.lds + F.wave * 16384);
    const int nit = BATCH * (SEQ / 8);
    for (int k = 0;; ++k) {
        const int l = k * F.G + ((k & 1) ? (F.G - 1 - F.bid) : F.bid);
        if (l >= nit) { if (k * F.G >= nit) break; else continue; }
        const int qb = (SEQ / 8 - 1) - (l >> 3), b = l & 7;
        indexer_query(F, b, qb * 8 + F.wave, rowbuf);
    }
}

__device__ const unsigned char g_bucket[128] = {0, 1, 2, 3, 4, 5, 6, 7, 8, 9, 10, 11, 12, 13, 14, 15, 16, 16, 16, 17, 17, 18, 18, 18, 19, 19, 19, 20, 20, 20, 20, 21, 21, 21, 21, 22, 22, 22, 22, 22, 23, 23, 23, 23, 23, 23, 24, 24, 24, 24, 24, 24, 25, 25, 25, 25, 25, 25, 25, 26, 26, 26, 26, 26, 26, 26, 26, 27, 27, 27, 27, 27, 27, 27, 27, 27, 27, 28, 28, 28, 28, 28, 28, 28, 28, 28, 28, 29, 29, 29, 29, 29, 29, 29, 29, 29, 29, 29, 29, 30, 30, 30, 30, 30, 30, 30, 30, 30, 30, 30, 30, 30, 30, 31, 31, 31, 31, 31, 31, 31, 31, 31, 31, 31, 31, 31, 31, 31};
__device__ __forceinline__ void phase4_attention(Frame& F) {
    const bf16_t* qn = (const bf16_t*)(F.ws + WS_QN); const bf16_t* kn = (const bf16_t*)(F.ws + WS_KN); const bf16_t* vb = (const bf16_t*)(F.ws + WS_V);
    const unsigned short* sel = (const unsigned short*)(F.ws + WS_SEL); bf16_t* ao = (bf16_t*)(F.ws + WS_ATTN);
    float* btab = (float*)F.lds;
    __syncthreads();
    for (int i = F.tid; i < 256; i += 512) btab[i] = F.rel_bias[i];
    __syncthreads();
    float* qf = (float*)(F.lds + 4096 + F.wave * 16384); float* Pl = qf + 1024; int* idl = (int*)(Pl + 2048);
    const int lane = F.lane, gw = F.bid * 8 + F.wave, NGW = F.G * 8;
    for (int row = gw; row < MTOK; row += NGW) {
        const int b = row / SEQ, t = row % SEQ;
#pragma unroll
        for (int p = 0; p < 4; ++p) { idl[p * 64 + lane] = (int)sel[(size_t)row * 256 + p * 64 + lane]; }
#pragma unroll
        for (int i = 0; i < 2; ++i) { const int ci = i * 64 + lane; f32x4 a, c; unpack8(*(const u32x4*)(qn + (size_t)row * 1024 + ci * 8), a, c);
            *(f32x4*)(qf + ci * 8) = a; *(f32x4*)(qf + ci * 8 + 4) = c; }
        float psum[8];
#pragma unroll
        for (int h = 0; h < 8; ++h) psum[h] = 0.f;
#pragma unroll 1
        for (int p = 0; p < 4; ++p) {
            const int key = idl[p * 64 + lane]; const bool valid = key <= t; const int kc = valid ? key : 0;
            const int dist = t - kc; const int bk = dist < 128 ? (int)g_bucket[dist] : 31;
            float lg[8];
#pragma unroll
            for (int g = 0; g < 2; ++g) {
                const bf16_t* kr = kn + ((size_t)b * SEQ + kc) * 256 + g * 128;
                float a4[4] = {0.f, 0.f, 0.f, 0.f};
#pragma unroll 4
                for (int dc = 0; dc < 16; ++dc) {
                    f32x4 k0, k1; unpack8(*(const u32x4*)(kr + dc * 8), k0, k1);
#pragma unroll
                    for (int hh = 0; hh < 4; ++hh) { const float* qp = qf + (g * 4 + hh) * 128 + dc * 8; const f32x4 q0 = *(const f32x4*)qp, q1 = *(const f32x4*)(qp + 4);
                        a4[hh] += k0[0] * q0[0] + k0[1] * q0[1] + k0[2] * q0[2] + k0[3] * q0[3] + k1[0] * q1[0] + k1[1] * q1[1] + k1[2] * q1[2] + k1[3] * q1[3]; }
                }
#pragma unroll
                for (int hh = 0; hh < 4; ++hh) lg[g * 4 + hh] = a4[hh];
            }
#pragma unroll
            for (int h = 0; h < 8; ++h) { const float e = valid ? __expf(lg[h] + btab[bk * 8 + h]) : 0.f; psum[h] += e; Pl[h * 256 + p * 64 + lane] = e; }
        }
#pragma unroll
        for (int h = 0; h < 8; ++h) psum[h] = wave_sum(psum[h]);
        const int ks = lane >> 4, dc = lane & 15;
        float acc[8][8];
#pragma unroll
        for (int h = 0; h < 8; ++h)
#pragma unroll
            for (int j = 0; j < 8; ++j) acc[h][j] = 0.f;
#pragma unroll 2
        for (int it = 0; it < 64; ++it) {
            const int j = it * 4 + ks; const int key = idl[j]; const int kc = key <= t ? key : 0;
            const bf16_t* vr = vb + ((size_t)b * SEQ + kc) * 256 + dc * 8;
#pragma unroll
            for (int g = 0; g < 2; ++g) { f32x4 v0, v1; unpack8(*(const u32x4*)(vr + g * 128), v0, v1);
#pragma unroll
                for (int hh = 0; hh < 4; ++hh) { const int h = g * 4 + hh; const float pj = Pl[h * 256 + j];
#pragma unroll
                    for (int e = 0; e < 4; ++e) { acc[h][e] += pj * v0[e]; acc[h][4 + e] += pj * v1[e]; } } }
        }
#pragma unroll
        for (int h = 0; h < 8; ++h)
#pragma unroll
            for (int j = 0; j < 8; ++j) { acc[h][j] = xor32_sum(xor16_sum(acc[h][j])); }
#pragma unroll
        for (int h = 0; h < 8; ++h) if ((h >> 1) == ks) { const float inv = 1.0f / psum[h];
            f32x4 o0 = (f32x4){acc[h][0], acc[h][1], acc[h][2], acc[h][3]} * inv, o1 = (f32x4){acc[h][4], acc[h][5], acc[h][6], acc[h][7]} * inv;
            *(u32x4*)(ao + (size_t)row * 1024 + h * 128 + dc * 8) = pack8(o0, o1); }
    }
}

__device__ __forceinline__ float dot16f8(u32x4 w, const float* h) {
    float s = 0.f;
#pragma unroll
    for (int d = 0; d < 4; ++d) { const f32x2 lo = __builtin_amdgcn_cvt_pk_f32_fp8((int)w[d], false), hi = __builtin_amdgcn_cvt_pk_f32_fp8((int)w[d], true);
        s += lo.x * h[4 * d] + lo.y * h[4 * d + 1] + hi.x * h[4 * d + 2] + hi.y * h[4 * d + 3]; }
    return s;
}
__device__ __forceinline__ void fma16f8(u32x4 w, float cf, float* acc) {
#pragma unroll
    for (int d = 0; d < 4; ++d) { const f32x2 lo = __builtin_amdgcn_cvt_pk_f32_fp8((int)w[d], false), hi = __builtin_amdgcn_cvt_pk_f32_fp8((int)w[d], true);
        acc[4 * d] += cf * lo.x; acc[4 * d + 1] += cf * lo.y; acc[4 * d + 2] += cf * hi.x; acc[4 * d + 3] += cf * hi.y; }
}
__device__ __forceinline__ float gelu_erf(float x) { return 0.5f * x * (1.0f + erff(x * 0.70710678118654752f)); }
__device__ __forceinline__ void phase10_peer(Frame& F) {
    const float* sub = (const float*)(F.ws + WS_SUB); const bf16_t* h2 = (const bf16_t*)(F.ws + WS_H2);
    const unsigned char* pu = F.ws + WS_PU; const unsigned char* pv = F.ws + WS_PV;
    const float* mf = (const float*)(F.ws + WS_MODF);
    int* elist = (int*)(F.lds + F.wave * 2048); float* gl = (float*)(elist + 128); float* cl = gl + 128;
    const int gw = F.bid * 8 + F.wave, NGW = F.G * 8;
    const float NINF = -__builtin_huge_valf();
    for (int row = gw; row < MTOK; row += NGW) {
        int lane = F.lane; asm volatile("" : "+v"(lane));
        const unsigned long long lt_mask = (1ull << lane) - 1ull;
        const float* srow = sub + (size_t)row * 2048;
#pragma unroll 1
        for (int h = 0; h < 8; ++h) {
            const f32x4 v4 = *(const f32x4*)(srow + h * 256 + lane * 4);
            float v0 = v4[0], v1 = v4[1], v2 = v4[2], v3 = v4[3];
            float myval = NINF; int myidx = 0;
            const int half = lane >> 5, lh = lane & 31;
#pragma unroll 1
            for (int r = 0; r < 16; ++r) {
                float lm = v0; int li = 0;
                if (v1 > lm) { lm = v1; li = 1; } if (v2 > lm) { lm = v2; li = 2; } if (v3 > lm) { lm = v3; li = 3; }
                float gm = lm;
                gm = xor16_max(row_max16(gm));
                const unsigned long long bal = __ballot(lm == gm);
                const unsigned hm = (unsigned)(bal >> (32 * half));
                const int wl = (__ffs((int)hm) - 1) + 32 * half;
                const int widx = __shfl(li, wl) + 4 * (wl & 31);
                if (lh == r) { myval = gm; myidx = widx; }
                if (lane == wl) { if (li == 0) v0 = NINF; else if (li == 1) v1 = NINF; else if (li == 2) v2 = NINF; else v3 = NINF; }
            }
            int ca, cb; const int c = lane;
            if (c < 16) { ca = 0; cb = c; } else if (c < 24) { ca = 1; cb = c - 16; } else if (c < 29) { ca = 2; cb = c - 24; } else if (c < 33) { ca = 3; cb = c - 29; }
            else if (c < 36) { ca = 4; cb = c - 33; } else if (c < 38) { ca = 5; cb = c - 36; } else if (c < 40) { ca = 6; cb = c - 38; } else if (c < 42) { ca = 7; cb = c - 40; }
            else { ca = (c - 42 + 8) & 15; cb = 0; }
            float s = __shfl(myval, ca) + __shfl(myval, 32 + cb);
            const int eid = __shfl(myidx, ca) * 128 + __shfl(myidx, 32 + cb);
            if (c >= 50) s = NINF;
            int rank = 0;
#pragma unroll 10
            for (int j = 0; j < 50; ++j) { const float sj = __shfl(s, j); rank += (sj > s || (sj == s && j < c)) ? 1 : 0; }
            const bool selq = (c < 50) && (rank < 16);
            const float smax = __shfl(s, 0);
            const float e = selq ? __expf(s - smax) : 0.f;
            const float esum = wave_sum(e);
            const unsigned long long ms = __ballot(selq);
            const int pos = __popcll(ms & lt_mask);
            if (selq) { elist[h * 16 + pos] = eid; gl[h * 16 + pos] = e / esum; }
        }
        asm volatile("" : "+v"(lane));
        float hf[32];
#pragma unroll
        for (int i = 0; i < 2; ++i)
#pragma unroll
            for (int q = 0; q < 2; ++q) { f32x4 a, c; unpack8(*(const u32x4*)(h2 + (size_t)row * 2048 + i * 1024 + lane * 16 + q * 8), a, c);
#pragma unroll
                for (int j = 0; j < 4; ++j) { hf[i * 16 + q * 8 + j] = a[j]; hf[i * 16 + q * 8 + 4 + j] = c[j]; } }
#pragma unroll 1
        for (int j0 = 0; j0 < 128; j0 += 8) {
            u32x4 w[8][2];
#pragma unroll
            for (int jj = 0; jj < 8; ++jj) { const int e = __builtin_amdgcn_readfirstlane(elist[j0 + jj]); const unsigned char* ur = pu + (size_t)e * 2048 + lane * 16;
                w[jj][0] = *(const u32x4*)ur; w[jj][1] = *(const u32x4*)(ur + 1024); }
            float p[8];
#pragma unroll
            for (int jj = 0; jj < 8; ++jj) { p[jj] = dot16f8(w[jj][0], hf) + dot16f8(w[jj][1], hf + 16); __builtin_amdgcn_sched_barrier(0); }
#pragma unroll
            for (int i = 0; i < 4; ++i) p[i] = swap32_pair(p[i], p[i + 4]);
#pragma unroll
            for (int i = 0; i < 2; ++i) p[i] = swap16_pair(p[i], p[i + 2]);
            const bool b3 = (lane & 8) != 0;
            { const float snd = b3 ? p[0] : p[1], kp = b3 ? p[1] : p[0]; p[0] = kp + dpp_f<DPP_ROR8>(snd); }
            float tot = p[0]; tot += dpp_f<DPP_XOR1>(tot); tot += dpp_f<DPP_XOR2>(tot); tot += dpp_f<DPP_HMIRROR>(tot);
            if ((lane & 7) == 0) cl[j0 + (lane >> 3)] = tot;
        }
        { const float a0 = cl[lane] * (1.0f / 64.0f), a1 = cl[64 + lane] * (1.0f / 64.0f);
          const float c0 = gelu_erf(a0) * gl[lane] * 0.25f, c1 = gelu_erf(a1) * gl[64 + lane] * 0.25f;
          cl[lane] = c0; cl[64 + lane] = c1; }
        asm volatile("" : "+v"(lane));
        float acc[32];
#pragma unroll
        for (int i = 0; i < 32; ++i) acc[i] = 0.f;
#pragma unroll 1
        for (int j0 = 0; j0 < 128; j0 += 4) {
            u32x4 w[4][2];
#pragma unroll
            for (int jj = 0; jj < 4; ++jj) { const int e = __builtin_amdgcn_readfirstlane(elist[j0 + jj]); const unsigned char* vr = pv + (size_t)e * 2048 + lane * 16;
                w[jj][0] = *(const u32x4*)vr; w[jj][1] = *(const u32x4*)(vr + 1024); }
#pragma unroll
            for (int jj = 0; jj < 4; ++jj) { const float cf = __uint_as_float(__builtin_amdgcn_readfirstlane(__float_as_uint(cl[j0 + jj])));
                fma16f8(w[jj][0], cf, acc); fma16f8(w[jj][1], cf, acc + 16); __builtin_amdgcn_sched_barrier(0); }
        }
        asm volatile("" : "+v"(lane));
        const float* gt2 = mf + (size_t)(row / SEQ) * 12288 + 10240;
#pragma unroll
        for (int i = 0; i < 2; ++i)
#pragma unroll
            for (int q = 0; q < 4; ++q) { const int col = i * 1024 + lane * 16 + q * 4; float* op = F.out + (size_t)row * 2048 + col;
                const f32x4 x0 = *(const f32x4*)op, g0 = *(const f32x4*)(gt2 + col);
                const f32x4 a0 = (f32x4){acc[i * 16 + q * 4], acc[i * 16 + q * 4 + 1], acc[i * 16 + q * 4 + 2], acc[i * 16 + q * 4 + 3]};
                *(f32x4*)op = x0 + g0 * a0; }
    }
}

__global__ void __launch_bounds__(512, 2) fwd_kernel(Args args) {
    extern __shared__ __attribute__((aligned(16))) unsigned char lds[];
    Frame F;
    F.lds = lds; F.ws = args.ws; F.tid = threadIdx.x; F.lane = F.tid & 63; F.wave = __builtin_amdgcn_readfirstlane(F.tid >> 6); F.G = gridDim.x; F.bid = blockIdx.x;
    F.x = args.in[0]; F.c = args.in[1]; F.w_ada = args.in[2]; F.b_ada = args.in[3]; F.g1 = args.in[4]; F.g2 = args.in[5]; F.w_in = args.in[6]; F.g_q = args.in[7]; F.g_k = args.in[8];
    F.rel_bias = args.in[9]; F.pool_w = args.in[10]; F.pool_scale = args.in[11]; F.w_ab = args.in[12]; F.w_pb = args.in[13]; F.w_out = args.in[14]; F.w_pq = args.in[15];
    F.peer_keys = args.in[16]; F.peer_u = args.in[17]; F.peer_v = args.in[18]; F.out = args.out;
    LAS unsigned char* ldsl = (LAS unsigned char*)lds;
    volatile LAS unsigned* misc = (volatile LAS unsigned*)(ldsl + MISC_OFF);
    if (F.tid < 4) misc[F.tid] = 0u;
    __syncthreads();
    unsigned* barw = (unsigned*)(args.ws + WS_CTL) + (size_t)args.li * XCD_BAR_WORDS;
    XcdBarrier bar; bar.bar = barw; bar.x = 0; bar.st = misc;
    const int lo = args.ph_lo, hi = args.ph_hi;
    if (hi - lo > 1) bar = xcd_barrier_post(barw, misc);
#define IN(k) (lo <= (k) && (k) < hi)
#define SEAM(k) do { if (IN(k) && IN((k) + 1)) xcd_barrier(bar); } while (0)
    bf16_t* R0 = (bf16_t*)(F.ws + WS_R0);

    if (IN(0)) { phase0_prep(F); }
    SEAM(0);
    if (IN(1)) { phase_modnorm<true>(F, F.x, F.g1, 0, 2048, R0); }
    SEAM(1);
    if (IN(2)) {
        pg8::Gemm g{R0, (const bf16_t*)(F.ws + WS_WIN), MTOK, INWP, DM, DM, 0}; pg8::StaticOrder S; S.init(MTOK, INWP, F.G, F.bid);
        EpiInproj E{(bf16_t*)(F.ws + WS_QN), (bf16_t*)(F.ws + WS_KN), (bf16_t*)(F.ws + WS_V), (bf16_t*)(F.ws + WS_IQ), (bf16_t*)(F.ws + WS_IK), (bf16_t*)(F.ws + WS_PL),
                    (bf16_t*)(F.ws + WS_GA), (bf16_t*)(F.ws + WS_GP), (float*)(F.ws + WS_IW)};
        pg8::gemm_phase<EpiInproj>(ldsl, g, S, E);
    }
    SEAM(2);
    if (IN(3)) { phase3_qknorm(F); phase3_pooled(F); phase3_indexer(F); }
    SEAM(3);
    if (IN(4)) {
        phase4_attention(F);
        __syncthreads();
        pg8::Gemm g{(const bf16_t*)(F.ws + WS_POOLED), (const bf16_t*)(F.ws + WS_POOLW), MTOK, PW, 256, 1024, 256}; pg8::StaticOrder S; S.init(MTOK, PW, F.G, F.bid);
        EpiBf16Scale E{(bf16_t*)(F.ws + WS_POOL2), 1024, F.pool_scale};
        pg8::gemm_phase<EpiBf16Scale>(ldsl, g, S, E);
    }
    SEAM(4);
    if (IN(5)) {
        { pg8::Gemm g{(const bf16_t*)(F.ws + WS_ATTN), (const bf16_t*)(F.ws + WS_WAB), MTOK, DM, 1024, 1024, 0}; pg8::StaticOrder S; S.init(MTOK, DM, F.G, F.bid);
          EpiGate<false> E{R0, (const bf16_t*)(F.ws + WS_GA)}; pg8::gemm_phase<EpiGate<false>>(ldsl, g, S, E); }
        { pg8::Gemm g{(const bf16_t*)(F.ws + WS_POOL2), (const bf16_t*)(F.ws + WS_WPB), MTOK, DM, 1024, 1024, 0}; pg8::StaticOrder S; S.init(MTOK, DM, F.G, F.bid);
          EpiGate<true> E{R0, (const bf16_t*)(F.ws + WS_GP)}; pg8::gemm_phase<EpiGate<true>>(ldsl, g, S, E); }
    }
    SEAM(5);
    if (IN(6)) {
        pg8::Gemm g{R0, (const bf16_t*)(F.ws + WS_WOUT), MTOK, DM, DM, DM, 0}; pg8::StaticOrder S; S.init(MTOK, DM, F.G, F.bid);
        EpiResid E{F.x, F.out, (const float*)(F.ws + WS_MODF) + 4096}; pg8::gemm_phase<EpiResid>(ldsl, g, S, E);
    }
    SEAM(6);
    if (IN(7)) { phase_modnorm<false>(F, F.out, F.g2, 6144, 8192, (bf16_t*)(F.ws + WS_H2)); }
    SEAM(7);
    if (IN(8)) {
        pg8::Gemm g{(const bf16_t*)(F.ws + WS_H2), (const bf16_t*)(F.ws + WS_WPQ), MTOK, DM, DM, DM, 0}; pg8::StaticOrder S; S.init(MTOK, DM, F.G, F.bid);
        EpiBf16Scale E{R0, 2048, nullptr}; pg8::gemm_phase<EpiBf16Scale>(ldsl, g, S, E);
    }
    SEAM(8);
    if (IN(9)) {
        pg8::Gemm g{R0, (const bf16_t*)(F.ws + WS_KEYSBD), MTOK, DM, 256, DM, 256}; pg8::StaticOrder S; S.init(MTOK, DM, F.G, F.bid);
        EpiF32 E{(float*)(F.ws + WS_SUB), 2048}; pg8::gemm_phase<EpiF32>(ldsl, g, S, E);
    }
    SEAM(9);
    if (IN(10)) { phase10_peer(F); }
#undef IN
#undef SEAM
}

extern "C" void kernel_launch(void* const* d_in, const int* in_sizes, int n_in, void* d_out, int out_size, void* d_ws, size_t ws_size, hipStream_t stream) {
    static int grid = 0;
    if (grid == 0) {
        if (n_in != 19 || out_size != MTOK * DM || ws_size < WS_END) { fprintf(stderr, "kernel_launch: unexpected shapes (n_in %d out %d ws %zu)\n", n_in, out_size, ws_size); grid = -1; return; }
        int dev = 0, cus = 0, per_cu = 0;
        if (hipGetDevice(&dev) != hipSuccess || hipDeviceGetAttribute(&cus, hipDeviceAttributeMultiprocessorCount, dev) != hipSuccess) { grid = -1; return; }
        if (hipFuncSetAttribute((const void*)fwd_kernel, hipFuncAttributeMaxDynamicSharedMemorySize, LDS_BYTES) != hipSuccess) { fprintf(stderr, "kernel_launch: hipFuncSetAttribute failed\n"); grid = -1; return; }
        if (hipOccupancyMaxActiveBlocksPerMultiprocessor(&per_cu, (const void*)fwd_kernel, 512, LDS_BYTES) != hipSuccess || per_cu < 1) { fprintf(stderr, "kernel_launch: occupancy query says %d\n", per_cu); }
        (void)hipGetLastError();
        grid = cus;
    }
    if (grid < 0) return;
    (void)in_sizes;
    if (hipMemsetAsync((char*)d_ws + WS_CTL, 0, CTL_ZERO_BYTES, stream) != hipSuccess) return;
    Args a{};
    for (int i = 0; i < 19; ++i) a.in[i] = (const float*)d_in[i];
    a.out = (float*)d_out; a.ws = (unsigned char*)d_ws;
#if MK_PER_PHASE
    for (int p = 0; p < NPHASE; ++p) { a.ph_lo = p; a.ph_hi = p + 1; a.li = p; hipLaunchKernelGGL(fwd_kernel, dim3(grid), dim3(512), LDS_BYTES, stream, a); }
#else
    a.ph_lo = 0; a.ph_hi = NPHASE; a.li = 0;
    hipLaunchKernelGGL(fwd_kernel, dim3(grid), dim3(512), LDS_BYTES, stream, a);
#endif
}
```

```cpp
#include <hip/hip_runtime.h>
#include <cstdio>
#include <cstdint>

#ifndef MK_PER_PHASE
#define MK_PER_PHASE 0
#endif

#ifndef PROBE_REP
#define PROBE_REP 0
#endif
#define LAS __attribute__((address_space(3)))
typedef unsigned short bf16_t;
typedef short bf16x8 __attribute__((ext_vector_type(8)));
typedef float f32x4 __attribute__((ext_vector_type(4)));
typedef float f32x2 __attribute__((ext_vector_type(2)));
typedef unsigned u32x4 __attribute__((ext_vector_type(4)));
typedef unsigned u32x2 __attribute__((ext_vector_type(2)));

constexpr int BATCH = 8, SEQ = 4096, DM = 2048, MTOK = BATCH * SEQ;
constexpr int NHEAD = 8, HDIM = 128, AW = 1024, KVW = 256, IHEADS = 16, IDIM = 64, KSEL = 256;
constexpr int PW = 1024, PHEADS = 8, NEXP = 16384;
constexpr int INW = 7760, INWP = 7936;
constexpr float EPS = 1e-6f;
constexpr int NPHASE = 12;

constexpr size_t MiB = 1u << 20;
constexpr size_t WS_CTL = 0, CTL_ZERO_BYTES = 256 * 1024;
constexpr size_t WS_MODP = 2 * MiB;
constexpr size_t WS_MODF = 4 * MiB;
constexpr size_t WS_POOLW = 5 * MiB;
constexpr size_t WS_KEYSBD = 6 * MiB;
constexpr size_t WS_WIN = 8 * MiB;
constexpr size_t WS_WAB = 40 * MiB, WS_WPB = 44 * MiB, WS_WOUT = 48 * MiB, WS_WPQ = 56 * MiB;
constexpr size_t WS_PU = 64 * MiB, WS_PV = 128 * MiB;
constexpr size_t WS_R0 = 192 * MiB;
constexpr size_t WS_GA = 320 * MiB, WS_GP = 448 * MiB;
constexpr size_t WS_SUB = 320 * MiB;
constexpr size_t WS_QN = 576 * MiB;
constexpr size_t WS_IQ = 640 * MiB;
constexpr size_t WS_PL = 704 * MiB;
constexpr size_t WS_KN = 768 * MiB, WS_V = 784 * MiB;
constexpr size_t WS_IK = 800 * MiB;
constexpr size_t WS_IW = 804 * MiB;
constexpr size_t WS_SEL = 806 * MiB;
constexpr size_t WS_POOLED = 822 * MiB;
constexpr size_t WS_H2 = 886 * MiB;
constexpr size_t WS_END = 1014 * MiB;
constexpr size_t WS_ATTN = WS_IQ, WS_POOL2 = WS_PL, WS_PAIRS = WS_QN;

constexpr int LDS_BYTES = 160 * 1024;
constexpr int MISC_OFF = 159 * 1024;

__device__ __forceinline__ unsigned cvt_pk_bf16(float lo, float hi) { unsigned r; asm volatile("v_cvt_pk_bf16_f32 %0, %1, %2" : "=v"(r) : "v"(lo), "v"(hi)); return r; }
__device__ __forceinline__ float bf_lo(unsigned w) { return __uint_as_float(w << 16); }
__device__ __forceinline__ float bf_hi(unsigned w) { return __uint_as_float(w & 0xffff0000u); }
template <int CTRL> __device__ __forceinline__ float dpp_f(float x) { return __int_as_float(__builtin_amdgcn_update_dpp(0, __float_as_int(x), CTRL, 0xF, 0xF, true)); }
#define DPP_XOR1 0xB1
#define DPP_XOR2 0x4E
#define DPP_HMIRROR 0x141
#define DPP_MIRROR 0x140
#define DPP_ROR8 0x128
__device__ __forceinline__ float xor16_sum(float x) { const auto r = __builtin_amdgcn_permlane16_swap(__float_as_uint(x), __float_as_uint(x), false, false); return __uint_as_float(r[0]) + __uint_as_float(r[1]); }
__device__ __forceinline__ float xor32_sum(float x) { const auto r = __builtin_amdgcn_permlane32_swap(__float_as_uint(x), __float_as_uint(x), false, false); return __uint_as_float(r[0]) + __uint_as_float(r[1]); }
__device__ __forceinline__ float xor16_max(float x) { const auto r = __builtin_amdgcn_permlane16_swap(__float_as_uint(x), __float_as_uint(x), false, false); return fmaxf(__uint_as_float(r[0]), __uint_as_float(r[1])); }
__device__ __forceinline__ float swap32_pair(float a, float b) { const auto r = __builtin_amdgcn_permlane32_swap(__float_as_uint(a), __float_as_uint(b), false, false); return __uint_as_float(r[0]) + __uint_as_float(r[1]); }
__device__ __forceinline__ float swap16_pair(float a, float b) { const auto r = __builtin_amdgcn_permlane16_swap(__float_as_uint(a), __float_as_uint(b), false, false); return __uint_as_float(r[0]) + __uint_as_float(r[1]); }
__device__ __forceinline__ float row_sum16(float v) { v += dpp_f<DPP_XOR1>(v); v += dpp_f<DPP_XOR2>(v); v += dpp_f<DPP_HMIRROR>(v); v += dpp_f<DPP_MIRROR>(v); return v; }
__device__ __forceinline__ float row_max16(float v) { v = fmaxf(v, dpp_f<DPP_XOR1>(v)); v = fmaxf(v, dpp_f<DPP_XOR2>(v)); v = fmaxf(v, dpp_f<DPP_HMIRROR>(v)); v = fmaxf(v, dpp_f<DPP_MIRROR>(v)); return v; }
__device__ __forceinline__ float wave_sum(float v) { return xor32_sum(xor16_sum(row_sum16(v))); }
__device__ __forceinline__ float sigmoidf_(float x) { return __builtin_amdgcn_rcpf(1.0f + __expf(-x)); }
__device__ __forceinline__ float dot8(u32x4 w, const float* h) {
    return bf_lo(w.x) * h[0] + bf_hi(w.x) * h[1] + bf_lo(w.y) * h[2] + bf_hi(w.y) * h[3] + bf_lo(w.z) * h[4] + bf_hi(w.z) * h[5] + bf_lo(w.w) * h[6] + bf_hi(w.w) * h[7];
}

#define XB_TMO      128
#define XB_XCNT(j)  (256  + 64 * (j))
#define XB_XSUB(j)  (1280 + 64 * (j))
#define XB_XGEN(j)  (2304 + 64 * (j))
#define XB_TOP      3328
#define XB_TOPGEN   3392
#define XCD_BAR_WORDS 3456
#define XB_SPIN_CAP (1u << 18)

__device__ __forceinline__ unsigned xb_ld(unsigned* p)              { return __hip_atomic_load(p, __ATOMIC_RELAXED, __HIP_MEMORY_SCOPE_AGENT); }
__device__ __forceinline__ unsigned xb_add(unsigned* p, unsigned v) { return __hip_atomic_fetch_add(p, v, __ATOMIC_RELAXED, __HIP_MEMORY_SCOPE_AGENT); }
__device__ __forceinline__ unsigned xb_xcc_id() { return (unsigned)__builtin_amdgcn_s_getreg((3 << 11) | 20) & 0xFu; }
#define XB_SPIN(cond, bar) do { unsigned _sp = 0; while (cond) { __builtin_amdgcn_s_sleep(1); \
    if ((++_sp & 255u) == 0u) { if (xb_ld(&(bar)[XB_TMO])) break; if (_sp > XB_SPIN_CAP) { atomicAdd(&(bar)[XB_TMO], 1u); break; } } } } while (0)

struct XcdBarrier { unsigned* bar; unsigned x; volatile LAS unsigned* st; };

__device__ __forceinline__ XcdBarrier xcd_barrier_post(unsigned* bar, volatile LAS unsigned* st) {
    XcdBarrier b; b.bar = bar; b.x = xb_xcc_id(); b.st = st;
    if (threadIdx.x == 0) (void)xb_add(&bar[XB_XCNT(b.x)], 1u);
    return b;
}
__device__ __forceinline__ void xcd_barrier_complete(unsigned* bar, unsigned x, unsigned& nloc, unsigned& nx) {
    const unsigned G = gridDim.x * gridDim.y * gridDim.z;
    unsigned sum, cnt, mine, sp = 0u;
    for (;;) {
        sum = 0u; cnt = 0u; mine = 0u;
#pragma unroll
        for (unsigned j = 0; j < 16; ++j) { const unsigned c = xb_ld(&bar[XB_XCNT(j)]); sum += c; cnt += (c > 0u) ? 1u : 0u; mine = (j == x) ? c : mine; }
        if (sum == G) break;
        __builtin_amdgcn_s_sleep(1);
        if ((++sp & 255u) == 0u) { if (xb_ld(&bar[XB_TMO])) break; if (sp > XB_SPIN_CAP) { atomicAdd(&bar[XB_TMO], 1u); break; } }
    }
    nloc = mine > 0u ? mine : 1u; nx = cnt > 0u ? cnt : 1u;
}
__device__ __forceinline__ void xcd_barrier(const XcdBarrier& b) {
    asm volatile("s_waitcnt vmcnt(0)" ::: "memory");
    __syncthreads();
    if (threadIdx.x == 0) {
        unsigned* bar = b.bar;
        __builtin_amdgcn_s_waitcnt(0);
        unsigned nloc = b.st[0], nx = b.st[1];
        if (nloc == 0u) { xcd_barrier_complete(bar, b.x, nloc, nx); b.st[0] = nloc; b.st[1] = nx; }
        const unsigned old = xb_add(&bar[XB_XSUB(b.x)], 1u);
        const unsigned gen = old / nloc;
        if (old + 1u == (gen + 1u) * nloc) {
            __builtin_amdgcn_fence(__ATOMIC_RELEASE, "agent");
            asm volatile("s_waitcnt vmcnt(0)" ::: "memory");
            const unsigned og = xb_add(&bar[XB_TOP], 1u);
            const unsigned tg = og / nx;
            if (og + 1u == (tg + 1u) * nx) xb_add(&bar[XB_TOPGEN], 1u);
            else XB_SPIN(xb_ld(&bar[XB_TOPGEN]) == tg, bar);
            __builtin_amdgcn_fence(__ATOMIC_ACQUIRE, "agent");
            xb_add(&bar[XB_XGEN(b.x)], 1u);
            asm volatile("s_waitcnt vmcnt(0)" ::: "memory");
        } else {
            XB_SPIN(xb_ld(&bar[XB_XGEN(b.x)]) == gen, bar);
            __builtin_amdgcn_fence(__ATOMIC_ACQUIRE, "agent");
            asm volatile("s_waitcnt vmcnt(0)" ::: "memory");
        }
    }
    __syncthreads();
}

namespace pg8 {
constexpr int BM = 256, BK = 64, HALF = 128, HTB = HALF * BK * 2, STAGE_BYTES = 8 * HTB, NXCD = 8, WGM = 8;
__device__ __forceinline__ int lds_byte(int r, int c) { const int st = (r >> 4) * 2 + (c >> 5), rr = r & 15, cc = c & 31, ob = rr * 64 + cc * 2; return st * 1024 + (ob ^ (((ob >> 9) & 1) << 5)); }
__device__ __forceinline__ void stage_rc(int b, int& R, int& C) { const int st = b / 1024, sb = b % 1024, swz = sb ^ (((sb >> 9) & 1) << 5); R = (st >> 1) * 16 + swz / 64; C = (st & 1) * 32 + (swz % 64) / 2; }
__device__ __forceinline__ int perm32(int rho) { const int n = rho >> 4, i = rho & 15; return 8 * (i >> 2) + 4 * n + (i & 3); }

struct Unit { int pm, pn; };
struct Gemm { const bf16_t* A; const bf16_t* Bt; int M, N, K, lda, a_pn_off; };

struct StaticOrder {
    int nM, nN, nwg, G, c;
    __device__ void init(int M, int N, int G_, int c_) { nM = M / BM; nN = N / BM; nwg = nM * nN; G = G_; c = c_; }
    __device__ bool next(int i, Unit& u) const {
        const long L = (long)i * G + c; if (L >= nwg) return false;
        int wgid = (int)L; { const int q = nwg / NXCD, r = nwg % NXCD, xcd = wgid % NXCD, off = wgid / NXCD; wgid = (xcd < r ? xcd * (q + 1) : r * (q + 1) + (xcd - r) * q) + off; }
        const int nig = WGM * nN, gid = wgid / nig, fm = gid * WGM, gsz = (nM - fm) < WGM ? (nM - fm) : WGM;
        u.pm = fm + ((wgid % nig) % gsz); u.pn = (wgid % nig) / gsz; return true;
    }
};

template <class Epi>
__device__ __forceinline__ void gemm_phase(LAS unsigned char* lds, const Gemm g, const StaticOrder& S, const Epi& E) {
    const int tid = threadIdx.x, wid = __builtin_amdgcn_readfirstlane(tid >> 6), lane = tid & 63, wr = wid >> 2, wc = wid & 3, fr = lane & 15, fq = lane >> 4;
    const int K = g.K, nt = K / BK, lda = g.lda;
    unsigned voffA[2], voffB[2];
#pragma unroll
    for (int i = 0; i < 2; ++i) { int R, C; stage_rc(tid * 16 + i * 8192, R, C); const int Rb = Epi::PERM ? ((R & ~31) + perm32(R & 31)) : R;
        voffA[i] = (unsigned)(R * lda + C) * 2u; voffB[i] = (unsigned)(Rb * K + C) * 2u; }
    const size_t kstep = (size_t)(BK * 2);
    const size_t hsA = (size_t)HALF * lda * 2, hsB = (size_t)HALF * K * 2;
    const size_t tsA = 2 * hsA, tsB = 2 * hsB;
    const unsigned ldsw = (unsigned)wid * 1024u;
    const int aoff = lds_byte(wr * 64 + fr, fq * 8), boff = lds_byte(wc * 32 + fr, fq * 8);
#define PG8_SA(b, h) (((b) * 2 + (h)) * HTB)
#define PG8_SB(b, h) ((4 + (b) * 2 + (h)) * HTB)
#define PG8_STAGE(bufoff, gbase, voff) do { _Pragma("unroll") for (int _i = 0; _i < 2; ++_i) \
        __builtin_amdgcn_global_load_lds((const unsigned*)((const char*)(gbase) + (voff)[_i]), (LAS unsigned*)(lds + (bufoff) + ldsw + _i * 8192), 16, 0, 0); } while (0)
#define PG8_LDA(dst, b, h) do { _Pragma("unroll") for (int m = 0; m < 4; ++m) _Pragma("unroll") for (int k = 0; k < 2; ++k) dst[m][k] = *(const LAS bf16x8*)(lds + PG8_SA(b, h) + aoff + m * 2048 + k * 1024); } while (0)
#define PG8_LDB(dst, b, h) do { _Pragma("unroll") for (int n = 0; n < 2; ++n) _Pragma("unroll") for (int k = 0; k < 2; ++k) dst[n][k] = *(const LAS bf16x8*)(lds + PG8_SB(b, h) + boff + n * 2048 + k * 1024); } while (0)
#define PG8_MMA(ai, bj, At, Bt) do { __builtin_amdgcn_s_setprio(1); _Pragma("unroll") for (int m = 0; m < 4; ++m) _Pragma("unroll") for (int n = 0; n < 2; ++n) _Pragma("unroll") for (int k = 0; k < 2; ++k) \
        acc[ai][bj][m][n] = __builtin_amdgcn_mfma_f32_16x16x32_bf16(Bt[n][k], At[m][k], acc[ai][bj][m][n], 0, 0, 0); __builtin_amdgcn_s_setprio(0); } while (0)
#define PG8_WAIT_V(n) asm volatile("s_waitcnt vmcnt(" #n ")" ::: "memory")
#define PG8_WAIT_L(n) asm volatile("s_waitcnt lgkmcnt(" #n ")" ::: "memory")
#define PG8_BAR __builtin_amdgcn_s_barrier()
#define PG8_SCHED __builtin_amdgcn_sched_barrier(0)
    Unit cur, nxt; int ui = 0;
    if (!S.next(0, cur)) return;
    f32x4 acc[2][2][4][2];
#pragma unroll
    for (int a = 0; a < 2; ++a)
#pragma unroll
        for (int b = 0; b < 2; ++b)
#pragma unroll
            for (int m = 0; m < 4; ++m)
#pragma unroll
                for (int n = 0; n < 2; ++n) acc[a][b][m][n] = (f32x4){0.f, 0.f, 0.f, 0.f};
    bf16x8 At[4][2], B0[2][2], B1[2][2];
    const char* cA = (const char*)g.A + (size_t)cur.pm * tsA + (size_t)cur.pn * g.a_pn_off * 2; const char* cB = (const char*)g.Bt + (size_t)cur.pn * tsB;
    PG8_STAGE(PG8_SB(0, 0), cB, voffB); PG8_STAGE(PG8_SA(0, 0), cA, voffA); PG8_STAGE(PG8_SB(0, 1), cB + hsB, voffB); PG8_STAGE(PG8_SA(0, 1), cA + hsA, voffA);
    if (wr == 1) PG8_BAR;
    PG8_WAIT_V(4); PG8_BAR;
    PG8_STAGE(PG8_SB(1, 0), cB + kstep, voffB); PG8_STAGE(PG8_SA(1, 0), cA + kstep, voffA); PG8_STAGE(PG8_SB(1, 1), cB + hsB + kstep, voffB);
    PG8_WAIT_V(6); PG8_BAR;
    for (;;) {
        const bool has_next = S.next(ui + 1, nxt);
        const char* nA = has_next ? (const char*)g.A + (size_t)nxt.pm * tsA + (size_t)nxt.pn * g.a_pn_off * 2 : cA; const char* nB = has_next ? (const char*)g.Bt + (size_t)nxt.pn * tsB : cB;
        for (int t = 0; t < nt; t += 2) {
            const bool last = (t == nt - 2);
            const char* a1 = cA + (size_t)(t + 1) * kstep;
            const char* a2 = last ? nA : cA + (size_t)(t + 2) * kstep; const char* b2 = last ? nB : cB + (size_t)(t + 2) * kstep;
            const char* a3 = a2 + kstep; const char* b3 = b2 + kstep;
            PG8_LDB(B0, 0, 0); PG8_SCHED; PG8_LDA(At, 0, 0); PG8_STAGE(PG8_SA(1, 1), a1 + hsA, voffA);
            PG8_WAIT_L(8); PG8_BAR; PG8_WAIT_L(0); PG8_MMA(0, 0, At, B0); PG8_BAR; PG8_SCHED;
            PG8_LDB(B1, 0, 1); PG8_STAGE(PG8_SB(0, 0), b2, voffB);
            PG8_BAR; PG8_WAIT_L(0); PG8_MMA(0, 1, At, B1); PG8_BAR;
            PG8_LDA(At, 0, 1); PG8_STAGE(PG8_SA(0, 0), a2, voffA);
            PG8_BAR; PG8_WAIT_L(0); PG8_MMA(1, 0, At, B0); PG8_BAR; PG8_SCHED;
            PG8_STAGE(PG8_SB(0, 1), b2 + hsB, voffB);
            PG8_WAIT_V(6); PG8_BAR; PG8_MMA(1, 1, At, B1); PG8_BAR;
            PG8_LDB(B0, 1, 0); PG8_SCHED; PG8_LDA(At, 1, 0); PG8_STAGE(PG8_SA(0, 1), a2 + hsA, voffA);
            PG8_WAIT_L(8); PG8_BAR; PG8_WAIT_L(0); PG8_MMA(0, 0, At, B0); PG8_BAR; PG8_SCHED;
            PG8_LDB(B1, 1, 1); PG8_STAGE(PG8_SB(1, 0), b3, voffB);
            PG8_BAR; PG8_WAIT_L(0); PG8_MMA(0, 1, At, B1); PG8_BAR;
            PG8_LDA(At, 1, 1); PG8_STAGE(PG8_SA(1, 0), a3, voffA);
            PG8_BAR; PG8_WAIT_L(0); PG8_MMA(1, 0, At, B0); PG8_BAR; PG8_SCHED;
            PG8_STAGE(PG8_SB(1, 1), b3 + hsB, voffB);
            PG8_WAIT_V(6); PG8_BAR; PG8_MMA(1, 1, At, B1); PG8_BAR;
        }
        E(acc, cur, wr, wc, fr, fq);
        if (!has_next) break;
#pragma unroll
        for (int a = 0; a < 2; ++a)
#pragma unroll
            for (int b = 0; b < 2; ++b)
#pragma unroll
                for (int m = 0; m < 4; ++m)
#pragma unroll
                    for (int n = 0; n < 2; ++n) acc[a][b][m][n] = (f32x4){0.f, 0.f, 0.f, 0.f};
        cur = nxt; cA = nA; cB = nB; ++ui;
    }
    PG8_WAIT_V(0);
    if (wr == 0) PG8_BAR;
    PG8_BAR;
#undef PG8_SA
#undef PG8_SB
#undef PG8_STAGE
#undef PG8_LDA
#undef PG8_LDB
#undef PG8_MMA
#undef PG8_WAIT_V
#undef PG8_WAIT_L
#undef PG8_BAR
#undef PG8_SCHED
}
}
using pg8::Unit;

typedef f32x4 AccT[2][2][4][2];
__device__ __forceinline__ u32x4 pack8(f32x4 a, f32x4 b) { u32x4 w; w.x = cvt_pk_bf16(a[0], a[1]); w.y = cvt_pk_bf16(a[2], a[3]); w.z = cvt_pk_bf16(b[0], b[1]); w.w = cvt_pk_bf16(b[2], b[3]); return w; }
__device__ __forceinline__ void unpack8(u32x4 w, f32x4& a, f32x4& b) { a = (f32x4){bf_lo(w.x), bf_hi(w.x), bf_lo(w.y), bf_hi(w.y)}; b = (f32x4){bf_lo(w.z), bf_hi(w.z), bf_lo(w.w), bf_hi(w.w)}; }

struct EpiInproj {
    static constexpr bool PERM = true;
    bf16_t *q, *k, *v, *iq, *ik, *pl, *ga, *gp; float* iw;
    __device__ __forceinline__ void operator()(const AccT& acc, const Unit& u, int wr, int wc, int fr, int fq) const {
        const int pn = u.pn, row0 = u.pm * 256 + wr * 64 + fr;
        if (pn == 10) {
            if (wc < 2) {
#pragma unroll
                for (int ai = 0; ai < 2; ++ai)
#pragma unroll
                    for (int m = 0; m < 4; ++m) { const size_t row = (size_t)(row0 + ai * 128 + m * 16);
                        *(u32x4*)(ik + row * 64 + wc * 32 + 8 * fq) = pack8(acc[ai][0][m][0], acc[ai][0][m][1]); }
            } else if (wc == 2) {
                if (fq < 2) {
#pragma unroll
                    for (int ai = 0; ai < 2; ++ai)
#pragma unroll
                        for (int m = 0; m < 4; ++m) { const size_t row = (size_t)(row0 + ai * 128 + m * 16);
                            *(f32x4*)(iw + row * 16 + 8 * fq) = acc[ai][0][m][0]; *(f32x4*)(iw + row * 16 + 8 * fq + 4) = acc[ai][0][m][1]; }
                }
            }
            return;
        }
        bf16_t* dst; int ld, tc; bool sg = false;
        if (pn < 4) { dst = q; ld = 1024; tc = pn * 256; }
        else if (pn == 4) { dst = k; ld = 256; tc = 0; }
        else if (pn == 5) { dst = v; ld = 256; tc = 0; }
        else if (pn < 10) { dst = iq; ld = 1024; tc = (pn - 6) * 256; }
        else if (pn < 15) { dst = pl; ld = 1024; tc = (pn - 11) * 256; }
        else if (pn < 23) { dst = ga; ld = 2048; tc = (pn - 15) * 256; sg = true; }
        else { dst = gp; ld = 2048; tc = (pn - 23) * 256; sg = true; }
        const int col0 = tc + wc * 32 + 8 * fq;
#pragma unroll
        for (int ai = 0; ai < 2; ++ai)
#pragma unroll
            for (int m = 0; m < 4; ++m) { bf16_t* rowp = dst + (size_t)(row0 + ai * 128 + m * 16) * ld + col0;
#pragma unroll
                for (int bj = 0; bj < 2; ++bj) { f32x4 v0 = acc[ai][bj][m][0], v1 = acc[ai][bj][m][1];
                    if (sg) {
#pragma unroll
                        for (int j = 0; j < 4; ++j) { v0[j] = sigmoidf_(v0[j]); v1[j] = sigmoidf_(v1[j]); } }
                    *(u32x4*)(rowp + bj * 128) = pack8(v0, v1); } }
    }
};
struct EpiBf16Scale {
    static constexpr bool PERM = true;
    bf16_t* O; int ldc; const float* cs;
    __device__ __forceinline__ void operator()(const AccT& acc, const Unit& u, int wr, int wc, int fr, int fq) const {
        const int row0 = u.pm * 256 + wr * 64 + fr, col0 = u.pn * 256 + wc * 32 + 8 * fq;
        f32x4 s[2][2];
#pragma unroll
        for (int bj = 0; bj < 2; ++bj)
#pragma unroll
            for (int n = 0; n < 2; ++n) s[bj][n] = cs ? *(const f32x4*)(cs + col0 + bj * 128 + 4 * n) : (f32x4){1.f, 1.f, 1.f, 1.f};
#pragma unroll
        for (int ai = 0; ai < 2; ++ai)
#pragma unroll
            for (int m = 0; m < 4; ++m) { bf16_t* rowp = O + (size_t)(row0 + ai * 128 + m * 16) * ldc + col0;
#pragma unroll
                for (int bj = 0; bj < 2; ++bj) *(u32x4*)(rowp + bj * 128) = pack8(acc[ai][bj][m][0] * s[bj][0], acc[ai][bj][m][1] * s[bj][1]); }
    }
};
template <bool ADD> struct EpiGate {
    static constexpr bool PERM = true;
    bf16_t* O; const bf16_t* gate;
    __device__ __forceinline__ void operator()(const AccT& acc, const Unit& u, int wr, int wc, int fr, int fq) const {
        const int row0 = u.pm * 256 + wr * 64 + fr, col0 = u.pn * 256 + wc * 32 + 8 * fq;
#pragma unroll
        for (int ai = 0; ai < 2; ++ai)
#pragma unroll
            for (int m = 0; m < 4; ++m) { const size_t off = (size_t)(row0 + ai * 128 + m * 16) * 2048 + col0;
#pragma unroll
                for (int bj = 0; bj < 2; ++bj) { f32x4 g0, g1; unpack8(*(const u32x4*)(gate + off + bj * 128), g0, g1);
                    f32x4 r0 = g0 * acc[ai][bj][m][0], r1 = g1 * acc[ai][bj][m][1];
                    if (ADD) { f32x4 o0, o1; unpack8(*(const u32x4*)(O + off + bj * 128), o0, o1); r0 += o0; r1 += o1; }
                    *(u32x4*)(O + off + bj * 128) = pack8(r0, r1); } }
    }
};
struct EpiResid {
    static constexpr bool PERM = false;
    const float* x; float* out; const float* gt;
    __device__ __forceinline__ void operator()(const AccT& acc, const Unit& u, int wr, int wc, int fr, int fq) const {
        const int row0 = u.pm * 256 + wr * 64 + fr, col0 = u.pn * 256 + wc * 32 + 4 * fq;
        const float* gtb = gt + (size_t)(u.pm / 16) * 12288;
        f32x4 g[2][2];
#pragma unroll
        for (int bj = 0; bj < 2; ++bj)
#pragma unroll
            for (int n = 0; n < 2; ++n) g[bj][n] = *(const f32x4*)(gtb + col0 + bj * 128 + n * 16);
#pragma unroll
        for (int ai = 0; ai < 2; ++ai)
#pragma unroll
            for (int m = 0; m < 4; ++m) { const size_t off = (size_t)(row0 + ai * 128 + m * 16) * 2048 + col0;
#pragma unroll
                for (int bj = 0; bj < 2; ++bj)
#pragma unroll
                    for (int n = 0; n < 2; ++n) { const f32x4 xv = *(const f32x4*)(x + off + bj * 128 + n * 16);
                        *(f32x4*)(out + off + bj * 128 + n * 16) = xv + g[bj][n] * acc[ai][bj][m][n]; } }
    }
};
struct EpiF32 {
    static constexpr bool PERM = false;
    float* C; int ldc;
    __device__ __forceinline__ void operator()(const AccT& acc, const Unit& u, int wr, int wc, int fr, int fq) const {
        const int row0 = u.pm * 256 + wr * 64 + fr, col0 = u.pn * 256 + wc * 32 + 4 * fq;
#pragma unroll
        for (int ai = 0; ai < 2; ++ai)
#pragma unroll
            for (int m = 0; m < 4; ++m) { float* rowp = C + (size_t)(row0 + ai * 128 + m * 16) * ldc + col0;
#pragma unroll
                for (int bj = 0; bj < 2; ++bj)
#pragma unroll
                    for (int n = 0; n < 2; ++n) *(f32x4*)(rowp + bj * 128 + n * 16) = acc[ai][bj][m][n]; }
    }
};

struct Args { const float* in[19]; float* out; unsigned char* ws; int ph_lo, ph_hi; int li, pad; };
struct Frame {
    unsigned char* lds; unsigned char* ws;
    int tid, lane, wave, G, bid;
    const float *x, *c, *w_ada, *b_ada, *g1, *g2, *w_in, *g_q, *g_k, *rel_bias, *pool_w, *pool_scale, *w_ab, *w_pb, *w_out, *w_pq, *peer_keys, *peer_u, *peer_v;
    float* out;
};

template <class Fn> __device__ __forceinline__ void transpose_item(const float* W, int K, int N, bf16_t* WT, int ldk, int drow0, int k0, float* scr, int lane, Fn srccol) {
    const int sc = srccol(drow0 + (lane & 31));
#pragma unroll 8
    for (int i = 0; i < 32; ++i) { const int kk = 2 * i + (lane >> 5); scr[kk * 33 + (lane & 31)] = sc >= 0 ? W[(size_t)(k0 + kk) * N + sc] : 0.f; }
    asm volatile("s_waitcnt lgkmcnt(0)" ::: "memory");
    const int c = lane & 7;
#pragma unroll
    for (int j = 0; j < 4; ++j) { const int n = (lane >> 3) + 8 * j; const float* s = scr + (8 * c) * 33 + n;
        u32x4 o; o.x = cvt_pk_bf16(s[0 * 33], s[1 * 33]); o.y = cvt_pk_bf16(s[2 * 33], s[3 * 33]); o.z = cvt_pk_bf16(s[4 * 33], s[5 * 33]); o.w = cvt_pk_bf16(s[6 * 33], s[7 * 33]);
        *(u32x4*)(WT + (size_t)(drow0 + n) * ldk + k0 + 8 * c) = o; }
    asm volatile("s_waitcnt lgkmcnt(0)" ::: "memory");
}
__device__ __forceinline__ void phase0_prep(Frame& F) {
    const int gw = F.bid * 8 + F.wave, NGW = F.G * 8;
    float* scr = (float*)(F.lds + F.wave * 16384);
    constexpr int I_IN = (INWP / 32) * (DM / 64);
    constexpr int I_AB = (2048 / 32) * (1024 / 64), I_OUT = (2048 / 32) * (2048 / 64), I_PW = 4 * 8 * 4;
    constexpr int NIT = I_IN + 2 * I_AB + 2 * I_OUT + I_PW;
    auto ident = [](int j) { return j; };
    for (int it = gw; it < NIT; it += NGW) {
        int r = it;
        if (r < I_IN) { const int nb = r % (INWP / 32), kb = r / (INWP / 32);
            transpose_item(F.w_in, DM, INW, (bf16_t*)(F.ws + WS_WIN), DM, nb * 32, kb * 64, scr, F.lane, [](int j) { return j < 2640 ? j : (j < 2816 ? -1 : j - 176); }); continue; }
        r -= I_IN;
        if (r < I_AB) { transpose_item(F.w_ab, 1024, 2048, (bf16_t*)(F.ws + WS_WAB), 1024, (r % 64) * 32, (r / 64) * 64, scr, F.lane, ident); continue; }
        r -= I_AB;
        if (r < I_AB) { transpose_item(F.w_pb, 1024, 2048, (bf16_t*)(F.ws + WS_WPB), 1024, (r % 64) * 32, (r / 64) * 64, scr, F.lane, ident); continue; }
        r -= I_AB;
        if (r < I_OUT) { transpose_item(F.w_out, 2048, 2048, (bf16_t*)(F.ws + WS_WOUT), 2048, (r % 64) * 32, (r / 64) * 64, scr, F.lane, ident); continue; }
        r -= I_OUT;
        if (r < I_OUT) { transpose_item(F.w_pq, 2048, 2048, (bf16_t*)(F.ws + WS_WPQ), 2048, (r % 64) * 32, (r / 64) * 64, scr, F.lane, ident); continue; }
        r -= I_OUT;
        { const int g = r / 32, q = r % 32, nb = q % 8, kb = q / 8;
          transpose_item(F.pool_w + (size_t)g * 65536, 256, 256, (bf16_t*)(F.ws + WS_POOLW) + (size_t)g * 65536, 256, nb * 32, kb * 64, scr, F.lane, ident); }
    }
    {
        bf16_t* kb = (bf16_t*)(F.ws + WS_KEYSBD);
        for (int i = F.bid * 512 + F.tid; i < 2048 * 32; i += F.G * 512) {
            const int row = i / 32, k8 = (i % 32) * 8, p = (row >> 7) & 1;
            u32x4 o = (u32x4){0u, 0u, 0u, 0u};
            if ((k8 >> 7) == p) { const float* s = F.peer_keys + (size_t)row * 128 + (k8 & 127); const f32x4 a = *(const f32x4*)s, b = *(const f32x4*)(s + 4); o = pack8(a, b); }
            *(u32x4*)(kb + (size_t)row * 256 + k8) = o;
        }
    }
    {
        const size_t n16 = (size_t)NEXP * DM / 16;
        unsigned char* pu = F.ws + WS_PU;
        for (size_t i = (size_t)F.bid * 512 + F.tid; i < n16; i += (size_t)F.G * 512) {
            u32x4 ou;
#pragma unroll
            for (int k = 0; k < 4; ++k) { const f32x4 a = *(const f32x4*)(F.peer_u + i * 16 + k * 4) * 64.0f;
                int wu = __builtin_amdgcn_cvt_pk_fp8_f32(a[0], a[1], 0, false); wu = __builtin_amdgcn_cvt_pk_fp8_f32(a[2], a[3], wu, true); ou[k] = (unsigned)wu; }
            *(u32x4*)(pu + i * 16) = ou;
        }
        unsigned char* pv = F.ws + WS_PV;
        for (int it = gw; it < (NEXP / 64) * 128; it += NGW) {
            const int e = (it >> 7) * 64 + F.lane, ch = it & 127;
            u32x4 ov;
#pragma unroll
            for (int k = 0; k < 4; ++k) { const f32x4 c = *(const f32x4*)(F.peer_v + (size_t)e * DM + ch * 16 + k * 4) * 4.0f;
                int wv = __builtin_amdgcn_cvt_pk_fp8_f32(c[0], c[1], 0, false); wv = __builtin_amdgcn_cvt_pk_fp8_f32(c[2], c[3], wv, true); ov[k] = (unsigned)wv; }
            *(u32x2*)(pv + ((size_t)(2 * ch) * NEXP + e) * 8) = (u32x2){ov[0], ov[1]};
            *(u32x2*)(pv + ((size_t)(2 * ch + 1) * NEXP + e) * 8) = (u32x2){ov[2], ov[3]};
        }
    }
    {
        __syncthreads();
        float* cact = (float*)(F.lds + 131072);
        float* red = (float*)F.lds;
        float* mp = (float*)(F.ws + WS_MODP);
        for (int it = F.bid; it < 48 * 4; it += F.G) {
            const int cb = it % 48, ds = it / 48, d0 = ds * 512;
            for (int i = F.tid; i < 8 * 512; i += 512) { const int b = i >> 9, d = i & 511; const float cv = F.c[b * DM + d0 + d]; cact[i] = cv * sigmoidf_(cv); }
            __syncthreads();
            f32x4 a[8];
#pragma unroll
            for (int b = 0; b < 8; ++b) a[b] = (f32x4){0.f, 0.f, 0.f, 0.f};
            const float* wp = F.w_ada + (size_t)(d0 + F.wave * 64) * 12288 + cb * 256 + F.lane * 4;
#pragma unroll 4
            for (int d = 0; d < 64; ++d) { const f32x4 w = *(const f32x4*)(wp + (size_t)d * 12288);
#pragma unroll
                for (int b = 0; b < 8; ++b) a[b] += w * cact[b * 512 + F.wave * 64 + d]; }
#pragma unroll
            for (int b = 0; b < 8; ++b)
#pragma unroll
                for (int j = 0; j < 4; ++j) red[(F.wave * 32 + b * 4 + j) * 64 + F.lane] = a[b][j];
            __syncthreads();
            for (int i = F.tid; i < 2048; i += 512) { const int v = i >> 6, l = i & 63; float s = 0.f;
#pragma unroll
                for (int w = 0; w < 8; ++w) s += red[(w * 32 + v) * 64 + l];
                mp[((size_t)ds * 8 + (v >> 2)) * 12288 + cb * 256 + l * 4 + (v & 3)] = s; }
            __syncthreads();
        }
    }
}

template <bool FIRST> __device__ __forceinline__ void phase_modnorm(Frame& F, const float* xin, const float* gain, int off_sh, int off_sc, bf16_t* dst) {
    const float* mp = (const float*)(F.ws + WS_MODP); float* mf = (float*)(F.ws + WS_MODF);
    if (FIRST) {
        for (int i = F.bid * 512 + F.tid; i < 8 * 12288; i += F.G * 512) {
            float s = F.b_ada[i % 12288];
#pragma unroll
            for (int k = 0; k < 4; ++k) s += mp[(size_t)k * 8 * 12288 + i];
            mf[i] = s; }
    }
    float* cA = (float*)F.lds; float* cB = cA + 2048;
    for (int ch = F.bid; ch < MTOK / 128; ch += F.G) {
        const int b = ch / 32;
        __syncthreads();
        for (int col = F.tid; col < 2048; col += 512) {
            float sc, sh;
            if (FIRST) { sc = F.b_ada[off_sc + col]; sh = F.b_ada[off_sh + col];
#pragma unroll
                for (int k = 0; k < 4; ++k) { sc += mp[((size_t)k * 8 + b) * 12288 + off_sc + col]; sh += mp[((size_t)k * 8 + b) * 12288 + off_sh + col]; } }
            else { sc = mf[b * 12288 + off_sc + col]; sh = mf[b * 12288 + off_sh + col]; }
            cA[col] = gain[col] * (1.f + sc); cB[col] = sh; }
        __syncthreads();
        for (int r = F.wave; r < 128; r += 8) {
            const size_t row = (size_t)ch * 128 + r;
            const float* xr = xin + row * 2048 + F.lane * 8;
            f32x4 v[4][2]; float ss = 0.f;
#pragma unroll
            for (int i = 0; i < 4; ++i) { v[i][0] = *(const f32x4*)(xr + i * 512); v[i][1] = *(const f32x4*)(xr + i * 512 + 4);
#pragma unroll
                for (int j = 0; j < 4; ++j) ss += v[i][0][j] * v[i][0][j] + v[i][1][j] * v[i][1][j]; }
            ss = wave_sum(ss);
            const float rinv = 1.0f / sqrtf(ss * (1.0f / 2048.0f) + EPS);
#pragma unroll
            for (int i = 0; i < 4; ++i) { const int col = i * 512 + F.lane * 8;
                const f32x4 a0 = *(const f32x4*)(cA + col), a1 = *(const f32x4*)(cA + col + 4), b0 = *(const f32x4*)(cB + col), b1 = *(const f32x4*)(cB + col + 4);
                *(u32x4*)(dst + row * 2048 + col) = pack8(v[i][0] * rinv * a0 + b0, v[i][1] * rinv * a1 + b1); }
        }
    }
}

__device__ __forceinline__ void phase3_qknorm(Frame& F) {
    bf16_t* q = (bf16_t*)(F.ws + WS_QN); bf16_t* k = (bf16_t*)(F.ws + WS_KN);
    const int gw = F.bid * 8 + F.wave, NGW = F.G * 8;
    for (int row = gw; row < MTOK; row += NGW) {
#pragma unroll
        for (int i = 0; i < 2; ++i) { const int ci = i * 64 + F.lane; bf16_t* p = q + (size_t)row * 1024 + ci * 8;
            f32x4 a, b; unpack8(*(const u32x4*)p, a, b);
            float ss = a[0] * a[0] + a[1] * a[1] + a[2] * a[2] + a[3] * a[3] + b[0] * b[0] + b[1] * b[1] + b[2] * b[2] + b[3] * b[3];
            ss = row_sum16(ss);
            const float rinv = (1.0f / sqrtf(ss * (1.0f / 128.0f) + EPS)) * 0.08838834764831845f;
            const float* gp = F.g_q + (ci & 15) * 8; const f32x4 g0 = *(const f32x4*)gp, g1 = *(const f32x4*)(gp + 4);
            *(u32x4*)p = pack8(a * rinv * g0, b * rinv * g1); }
        if (F.lane < 32) { const int ci = F.lane; bf16_t* p = k + (size_t)row * 256 + ci * 8;
            f32x4 a, b; unpack8(*(const u32x4*)p, a, b);
            float ss = a[0] * a[0] + a[1] * a[1] + a[2] * a[2] + a[3] * a[3] + b[0] * b[0] + b[1] * b[1] + b[2] * b[2] + b[3] * b[3];
            ss = row_sum16(ss);
            const float rinv = 1.0f / sqrtf(ss * (1.0f / 128.0f) + EPS);
            const float* gp = F.g_k + (ci & 15) * 8; const f32x4 g0 = *(const f32x4*)gp, g1 = *(const f32x4*)(gp + 4);
            *(u32x4*)p = pack8(a * rinv * g0, b * rinv * g1); }
    }
}
__device__ __forceinline__ void phase3_pooled(Frame& F) {
    const bf16_t* pl = (const bf16_t*)(F.ws + WS_PL); bf16_t* po = (bf16_t*)(F.ws + WS_POOLED);
    for (size_t i = (size_t)F.bid * 512 + F.tid; i < (size_t)MTOK * 128; i += (size_t)F.G * 512) {
        const int row = (int)(i >> 7), c8 = (int)(i & 127) * 8, g = c8 >> 8, w = 2 << g, t = row & (SEQ - 1);
        const int cnt = (t + 1 < w) ? t + 1 : w;
        f32x4 s0 = (f32x4){0.f, 0.f, 0.f, 0.f}, s1 = s0, x0 = s0, x1 = s0;
        for (int j = 0; j < cnt; ++j) { f32x4 a, b; unpack8(*(const u32x4*)(pl + (size_t)(row - j) * 1024 + c8), a, b); s0 += a; s1 += b; if (j == 0) { x0 = a; x1 = b; } }
        const float inv = 1.0f / (float)cnt;
        *(u32x4*)(po + (size_t)row * 1024 + c8) = pack8(s0 * inv - x0, s1 * inv - x1);
    }
}
typedef float f32x16 __attribute__((ext_vector_type(16)));
__device__ __forceinline__ int sel_code(float s, float smin, float scale) { const float c = (s - smin) * scale; return (int)fminf(fmaxf(c, 0.f), 65535.f); }
__device__ __forceinline__ void hist_find(const unsigned* hist, int lane, int K, int& bsel, int& above) {
    const u32x4 h = *(const u32x4*)(hist + lane * 4);
    const int S = (int)(h.x + h.y + h.z + h.w);
    int x = S;
    x += __builtin_amdgcn_update_dpp(0, x, 0x101, 0xF, 0xF, true);
    x += __builtin_amdgcn_update_dpp(0, x, 0x102, 0xF, 0xF, true);
    x += __builtin_amdgcn_update_dpp(0, x, 0x104, 0xF, 0xF, true);
    x += __builtin_amdgcn_update_dpp(0, x, 0x108, 0xF, 0xF, true);
    const int t1 = __builtin_amdgcn_readlane(x, 16), t2 = __builtin_amdgcn_readlane(x, 32), t3 = __builtin_amdgcn_readlane(x, 48);
    const int r = lane >> 4;
    x += (r == 0 ? t1 + t2 + t3 : (r == 1 ? t2 + t3 : (r == 2 ? t3 : 0)));
    const int sufn = x - S;
    const bool mine = (x >= K) && (sufn < K);
    int b = 0, ab = 0;
    { int c = sufn;
      if (c + (int)h.w >= K) { b = 3; ab = c; } else { c += (int)h.w;
      if (c + (int)h.z >= K) { b = 2; ab = c; } else { c += (int)h.z;
      if (c + (int)h.y >= K) { b = 1; ab = c; } else { c += (int)h.y; b = 0; ab = c; } } } }
    const unsigned long long m = __ballot(mine);
    const int src = m ? (int)__builtin_ctzll(m) : 0;
    bsel = __builtin_amdgcn_readlane(lane * 4 + b, src); above = __builtin_amdgcn_readlane(ab, src);
}
__device__ __forceinline__ void indexer_select(Frame& F, int b, int t, const float* rowbuf, unsigned* hist, float* eqv, int* eqi) {
    unsigned short* selrow = (unsigned short*)(F.ws + WS_SEL) + (size_t)(b * SEQ + t) * 256;
    int lane = F.lane; asm volatile("" : "+v"(lane));
    const int nch = t / 64 + 1, n4 = (nch + 3) >> 2;
    const f32x4* rb4 = (const f32x4*)rowbuf;
    float mn = __builtin_huge_valf(), mx = -__builtin_huge_valf();
    for (int c4 = 0; c4 < n4; ++c4) { const f32x4 v = rb4[c4 * 64 + lane];
#pragma unroll
        for (int k = 0; k < 4; ++k) { const bool valid = ((c4 * 4 + k) * 64 + lane) <= t; mn = valid ? fminf(mn, v[k]) : mn; mx = valid ? fmaxf(mx, v[k]) : mx; } }
    mx = xor16_max(row_max16(mx)); { const auto r = __builtin_amdgcn_permlane32_swap(__float_as_uint(mx), __float_as_uint(mx), false, false); mx = fmaxf(__uint_as_float(r[0]), __uint_as_float(r[1])); }
    mn = -mn; mn = xor16_max(row_max16(mn)); { const auto r = __builtin_amdgcn_permlane32_swap(__float_as_uint(mn), __float_as_uint(mn), false, false); mn = -fmaxf(__uint_as_float(r[0]), __uint_as_float(r[1])); }
    const float scale = (mx > mn) ? 65535.0f / (mx - mn) : 0.f;
    *(u32x4*)(hist + lane * 4) = (u32x4){0u, 0u, 0u, 0u};
    for (int c4 = 0; c4 < n4; ++c4) { const f32x4 v = rb4[c4 * 64 + lane];
#pragma unroll
        for (int k = 0; k < 4; ++k) { const bool valid = ((c4 * 4 + k) * 64 + lane) <= t; if (valid) atomicAdd(&hist[sel_code(v[k], mn, scale) >> 8], 1u); } }
    int b1, above1; hist_find(hist, lane, KSEL, b1, above1);
    *(u32x4*)(hist + lane * 4) = (u32x4){0u, 0u, 0u, 0u};
    for (int c4 = 0; c4 < n4; ++c4) { const f32x4 v = rb4[c4 * 64 + lane];
#pragma unroll
        for (int k = 0; k < 4; ++k) { const bool valid = ((c4 * 4 + k) * 64 + lane) <= t; const int code = sel_code(v[k], mn, scale); if (valid && (code >> 8) == b1) atomicAdd(&hist[code & 255], 1u); } }
    int b2, above2; hist_find(hist, lane, KSEL - above1, b2, above2);
    const int T16 = (b1 << 8) | b2, need = KSEL - above1 - above2, ceq = (int)hist[b2];
    const unsigned long long lt_mask = (1ull << lane) - 1ull;
    const bool exact = (ceq != need) && (ceq <= 64);
    if (exact) {
        int pos = 0;
        for (int c = 0; c < nch; ++c) { const float sv = rowbuf[((c >> 2) * 64 + lane) * 4 + (c & 3)]; const int idx = c * 64 + lane;
            const bool eq = (idx <= t) && (sel_code(sv, mn, scale) == T16);
            const unsigned long long m = __ballot(eq);
            if (m) { const int p = pos + __popcll(m & lt_mask); if (eq) { eqv[p] = sv; eqi[p] = idx; } pos += __popcll(m); } }
    }
    int pos = 0, eqseen = 0;
    for (int c = 0; c < nch; ++c) {
        const float sv = rowbuf[((c >> 2) * 64 + lane) * 4 + (c & 3)]; const int idx = c * 64 + lane;
        const int code = sel_code(sv, mn, scale); const bool valid = idx <= t;
        const bool gt = valid && code > T16, eq = valid && code == T16;
        const unsigned long long meq = __ballot(eq);
        bool take = gt;
        if (meq) {
            if (ceq == need) take = take || eq;
            else if (exact) { int rank = 0; for (int m = 0; m < ceq; ++m) { const float ov = eqv[m]; const int oi = eqi[m]; rank += (ov > sv || (ov == sv && oi < idx)) ? 1 : 0; } take = take || (eq && rank < need); }
            else { const int er = eqseen + __popcll(meq & lt_mask); take = take || (eq && er < need); eqseen += __popcll(meq); }
        }
        const unsigned long long mt = __ballot(take);
        const int p = pos + __popcll(mt & lt_mask);
        if (take && p < KSEL) selrow[p] = (unsigned short)idx;
        pos += __popcll(mt);
    }
}
__device__ __forceinline__ void indexer_tile(Frame& F, int b, int t0) {
    const bf16_t* iq = (const bf16_t*)(F.ws + WS_IQ); const bf16_t* ik = (const bf16_t*)(F.ws + WS_IK); const float* iw = (const float*)(F.ws + WS_IW);
    int lane = F.lane; asm volatile("" : "+v"(lane));
    const int w = F.wave;
    if (t0 < KSEL) {
        const int t = t0 + w; unsigned short* selrow = (unsigned short*)(F.ws + WS_SEL) + (size_t)(b * SEQ + t) * 256;
#pragma unroll
        for (int p = 0; p < 4; ++p) { const int j = p * 64 + lane; selrow[j] = (unsigned short)(j <= t ? j : 0xFFFF); }
        return;
    }
    float* rowbuf = (float*)F.lds;
    unsigned char* stage = F.lds + 131072;
    const int p = w & 3, kh = w >> 2, hi = lane >> 5, r = lane & 31;
    const size_t qrow = (size_t)b * SEQ + t0 + 2 * p + (r >> 4);
    bf16x8 a[4];
#pragma unroll
    for (int ks = 0; ks < 4; ++ks) a[ks] = *(const bf16x8*)(iq + qrow * 1024 + (r & 15) * 64 + ks * 16 + 8 * hi);
    float wq[2][8];
#pragma unroll
    for (int q = 0; q < 2; ++q)
#pragma unroll
        for (int i = 0; i < 8; ++i) wq[q][i] = iw[((size_t)b * SEQ + t0 + 2 * p + q) * 16 + (i & 3) + 8 * ((i >> 2) & 1) + 4 * hi];
    const int nchunks = (t0 + 7) / 64 + 1;
    const unsigned char* gsrc = (const unsigned char*)(ik + (size_t)b * SEQ * 64) + F.tid * 16;
    const int skey = F.tid >> 3, sc16 = F.tid & 7, soff = skey * 128 + ((sc16 ^ (skey & 7)) << 4);
    u32x4 sreg = *(const u32x4*)gsrc;
    __syncthreads();
    for (int c = 0; c < nchunks; ++c) {
        unsigned char* sb = stage + (c & 1) * 8192;
        *(u32x4*)(sb + soff) = sreg;
        __syncthreads();
        if (c + 1 < nchunks) sreg = *(const u32x4*)(gsrc + (size_t)(c + 1) * 8192);
        f32x16 d;
#pragma unroll
        for (int i = 0; i < 16; ++i) d[i] = 0.f;
        const int key = kh * 32 + r;
#pragma unroll
        for (int ks = 0; ks < 4; ++ks) { const bf16x8 bf = *(const bf16x8*)(sb + key * 128 + (((ks * 2 + hi) ^ (key & 7)) << 4));
            d = __builtin_amdgcn_mfma_f32_32x32x16_bf16(a[ks], bf, d, 0, 0, 0); }
        float s0 = 0.f, s1 = 0.f;
#pragma unroll
        for (int i = 0; i < 8; ++i) { s0 += wq[0][i] * fmaxf(d[i], 0.f); s1 += wq[1][i] * fmaxf(d[8 + i], 0.f); }
        const float sc = swap32_pair(s0, s1);
        const int kk = kh * 32 + r;
        rowbuf[(2 * p + hi) * 4096 + ((c >> 2) * 64 + kk) * 4 + (c & 3)] = sc;
    }
    __syncthreads();
    indexer_select(F, b, t0 + w, rowbuf + w * 4096, (unsigned*)(F.lds + 147456) + w * 256, (float*)(F.lds + 155648) + w * 64, (int*)(F.lds + 155648 + 2048) + w * 64);
}
__device__ __forceinline__ void phase3_indexer(Frame& F) {
    const int nit = BATCH * (SEQ / 8);
    for (int k = 0;; ++k) {
        const int l = k * F.G + ((k & 1) ? (F.G - 1 - F.bid) : F.bid);
        if (l >= nit) { if (k * F.G >= nit) break; else continue; }
        const int qb = (SEQ / 8 - 1) - (l >> 3), b = l & 7;
        indexer_tile(F, b, qb * 8);
    }
}

__device__ const unsigned char g_bucket[128] = {0, 1, 2, 3, 4, 5, 6, 7, 8, 9, 10, 11, 12, 13, 14, 15, 16, 16, 16, 17, 17, 18, 18, 18, 19, 19, 19, 20, 20, 20, 20, 21, 21, 21, 21, 22, 22, 22, 22, 22, 23, 23, 23, 23, 23, 23, 24, 24, 24, 24, 24, 24, 25, 25, 25, 25, 25, 25, 25, 26, 26, 26, 26, 26, 26, 26, 26, 27, 27, 27, 27, 27, 27, 27, 27, 27, 27, 28, 28, 28, 28, 28, 28, 28, 28, 28, 28, 29, 29, 29, 29, 29, 29, 29, 29, 29, 29, 29, 29, 30, 30, 30, 30, 30, 30, 30, 30, 30, 30, 30, 30, 30, 30, 31, 31, 31, 31, 31, 31, 31, 31, 31, 31, 31, 31, 31, 31, 31};
__device__ __forceinline__ void phase4_attention(Frame& F) {
    const bf16_t* qn = (const bf16_t*)(F.ws + WS_QN); const bf16_t* kn = (const bf16_t*)(F.ws + WS_KN); const bf16_t* vb = (const bf16_t*)(F.ws + WS_V);
    const unsigned short* sel = (const unsigned short*)(F.ws + WS_SEL); bf16_t* ao = (bf16_t*)(F.ws + WS_ATTN);
    float* btab = (float*)F.lds;
    __syncthreads();
    for (int i = F.tid; i < 256; i += 512) btab[i] = F.rel_bias[i];
    __syncthreads();
    float* qf = (float*)(F.lds + 4096 + F.wave * 16384); float* Pl = qf + 1024; int* idl = (int*)(Pl + 2048);
    const int lane = F.lane, gw = F.bid * 8 + F.wave, NGW = F.G * 8;
    for (int row = gw; row < MTOK; row += NGW) {
        const int b = row / SEQ, t = row % SEQ;
#pragma unroll
        for (int p = 0; p < 4; ++p) { idl[p * 64 + lane] = (int)sel[(size_t)row * 256 + p * 64 + lane]; }
#pragma unroll
        for (int i = 0; i < 2; ++i) { const int ci = i * 64 + lane; f32x4 a, c; unpack8(*(const u32x4*)(qn + (size_t)row * 1024 + ci * 8), a, c);
            *(f32x4*)(qf + ci * 8) = a; *(f32x4*)(qf + ci * 8 + 4) = c; }
        float psum[8];
#pragma unroll
        for (int h = 0; h < 8; ++h) psum[h] = 0.f;
#pragma unroll 1
        for (int p = 0; p < 4; ++p) {
            const int key = idl[p * 64 + lane]; const bool valid = key <= t; const int kc = valid ? key : 0;
            const int dist = t - kc; const int bk = dist < 128 ? (int)g_bucket[dist] : 31;
            float lg[8];
#pragma unroll
            for (int g = 0; g < 2; ++g) {
                const bf16_t* kr = kn + ((size_t)b * SEQ + kc) * 256 + g * 128;
                float a4[4] = {0.f, 0.f, 0.f, 0.f};
#pragma unroll 4
                for (int dc = 0; dc < 16; ++dc) {
                    f32x4 k0, k1; unpack8(*(const u32x4*)(kr + dc * 8), k0, k1);
#pragma unroll
                    for (int hh = 0; hh < 4; ++hh) { const float* qp = qf + (g * 4 + hh) * 128 + dc * 8; const f32x4 q0 = *(const f32x4*)qp, q1 = *(const f32x4*)(qp + 4);
                        a4[hh] += k0[0] * q0[0] + k0[1] * q0[1] + k0[2] * q0[2] + k0[3] * q0[3] + k1[0] * q1[0] + k1[1] * q1[1] + k1[2] * q1[2] + k1[3] * q1[3]; }
                }
#pragma unroll
                for (int hh = 0; hh < 4; ++hh) lg[g * 4 + hh] = a4[hh];
            }
#pragma unroll
            for (int h = 0; h < 8; ++h) { const float e = valid ? __expf(lg[h] + btab[bk * 8 + h]) : 0.f; psum[h] += e; Pl[h * 256 + p * 64 + lane] = e; }
        }
#pragma unroll
        for (int h = 0; h < 8; ++h) psum[h] = wave_sum(psum[h]);
        const int ks = lane >> 4, dc = lane & 15;
        float acc[8][8];
#pragma unroll
        for (int h = 0; h < 8; ++h)
#pragma unroll
            for (int j = 0; j < 8; ++j) acc[h][j] = 0.f;
#pragma unroll 2
        for (int it = 0; it < 64; ++it) {
            const int j = it * 4 + ks; const int key = idl[j]; const int kc = key <= t ? key : 0;
            const bf16_t* vr = vb + ((size_t)b * SEQ + kc) * 256 + dc * 8;
#pragma unroll
            for (int g = 0; g < 2; ++g) { f32x4 v0, v1; unpack8(*(const u32x4*)(vr + g * 128), v0, v1);
#pragma unroll
                for (int hh = 0; hh < 4; ++hh) { const int h = g * 4 + hh; const float pj = Pl[h * 256 + j];
#pragma unroll
                    for (int e = 0; e < 4; ++e) { acc[h][e] += pj * v0[e]; acc[h][4 + e] += pj * v1[e]; } } }
        }
#pragma unroll
        for (int h = 0; h < 8; ++h)
#pragma unroll
            for (int j = 0; j < 8; ++j) { acc[h][j] = xor32_sum(xor16_sum(acc[h][j])); }
#pragma unroll
        for (int h = 0; h < 8; ++h) if ((h >> 1) == ks) { const float inv = 1.0f / psum[h];
            f32x4 o0 = (f32x4){acc[h][0], acc[h][1], acc[h][2], acc[h][3]} * inv, o1 = (f32x4){acc[h][4], acc[h][5], acc[h][6], acc[h][7]} * inv;
            *(u32x4*)(ao + (size_t)row * 1024 + h * 128 + dc * 8) = pack8(o0, o1); }
    }
}

__device__ __forceinline__ float dot16f8(u32x4 w, const float* h) {
    float s = 0.f;
#pragma unroll
    for (int d = 0; d < 4; ++d) { const f32x2 lo = __builtin_amdgcn_cvt_pk_f32_fp8((int)w[d], false), hi = __builtin_amdgcn_cvt_pk_f32_fp8((int)w[d], true);
        s += lo.x * h[4 * d] + lo.y * h[4 * d + 1] + hi.x * h[4 * d + 2] + hi.y * h[4 * d + 3]; }
    return s;
}
__device__ __forceinline__ void fma16f8(u32x4 w, float cf, float* acc) {
#pragma unroll
    for (int d = 0; d < 4; ++d) { const f32x2 lo = __builtin_amdgcn_cvt_pk_f32_fp8((int)w[d], false), hi = __builtin_amdgcn_cvt_pk_f32_fp8((int)w[d], true);
        acc[4 * d] += cf * lo.x; acc[4 * d + 1] += cf * lo.y; acc[4 * d + 2] += cf * hi.x; acc[4 * d + 3] += cf * hi.y; }
}
__device__ __forceinline__ float gelu_erf(float x) { return 0.5f * x * (1.0f + erff(x * 0.70710678118654752f)); }
__device__ __forceinline__ void phase10_peer(Frame& F) {
    const float* sub = (const float*)(F.ws + WS_SUB); const bf16_t* h2 = (const bf16_t*)(F.ws + WS_H2);
    const unsigned char* pu = F.ws + WS_PU; unsigned* pairs = (unsigned*)(F.ws + WS_PAIRS);
    int* elist = (int*)(F.lds + F.wave * 2048); float* gl = (float*)(elist + 128); float* cl = gl + 128;
    const int gw = F.bid * 8 + F.wave, NGW = F.G * 8;
    const float NINF = -__builtin_huge_valf();
    for (int row = gw; row < MTOK; row += NGW) {
        int lane = F.lane; asm volatile("" : "+v"(lane));
        const unsigned long long lt_mask = (1ull << lane) - 1ull;
        const float* srow = sub + (size_t)row * 2048;
#pragma unroll 1
        for (int h = 0; h < 8; ++h) {
            const f32x4 v4 = *(const f32x4*)(srow + h * 256 + lane * 4);
            float v0 = v4[0], v1 = v4[1], v2 = v4[2], v3 = v4[3];
            float myval = NINF; int myidx = 0;
            const int half = lane >> 5, lh = lane & 31;
#pragma unroll 1
            for (int r = 0; r < 16; ++r) {
                float lm = v0; int li = 0;
                if (v1 > lm) { lm = v1; li = 1; } if (v2 > lm) { lm = v2; li = 2; } if (v3 > lm) { lm = v3; li = 3; }
                float gm = lm;
                gm = xor16_max(row_max16(gm));
                const unsigned long long bal = __ballot(lm == gm);
                const unsigned hm = (unsigned)(bal >> (32 * half));
                const int wl = (__ffs((int)hm) - 1) + 32 * half;
                const int widx = __shfl(li, wl) + 4 * (wl & 31);
                if (lh == r) { myval = gm; myidx = widx; }
                if (lane == wl) { if (li == 0) v0 = NINF; else if (li == 1) v1 = NINF; else if (li == 2) v2 = NINF; else v3 = NINF; }
            }
            int ca, cb; const int c = lane;
            if (c < 16) { ca = 0; cb = c; } else if (c < 24) { ca = 1; cb = c - 16; } else if (c < 29) { ca = 2; cb = c - 24; } else if (c < 33) { ca = 3; cb = c - 29; }
            else if (c < 36) { ca = 4; cb = c - 33; } else if (c < 38) { ca = 5; cb = c - 36; } else if (c < 40) { ca = 6; cb = c - 38; } else if (c < 42) { ca = 7; cb = c - 40; }
            else { ca = (c - 42 + 8) & 15; cb = 0; }
            float s = __shfl(myval, ca) + __shfl(myval, 32 + cb);
            const int eid = __shfl(myidx, ca) * 128 + __shfl(myidx, 32 + cb);
            if (c >= 50) s = NINF;
            int rank = 0;
#pragma unroll 10
            for (int j = 0; j < 50; ++j) { const float sj = __shfl(s, j); rank += (sj > s || (sj == s && j < c)) ? 1 : 0; }
            const bool selq = (c < 50) && (rank < 16);
            const float smax = __shfl(s, 0);
            const float e = selq ? __expf(s - smax) : 0.f;
            const float esum = wave_sum(e);
            const unsigned long long ms = __ballot(selq);
            const int pos = __popcll(ms & lt_mask);
            if (selq) { elist[h * 16 + pos] = eid; gl[h * 16 + pos] = e / esum; }
        }
        asm volatile("" : "+v"(lane));
        float hf[32];
#pragma unroll
        for (int i = 0; i < 2; ++i)
#pragma unroll
            for (int q = 0; q < 2; ++q) { f32x4 a, c; unpack8(*(const u32x4*)(h2 + (size_t)row * 2048 + i * 1024 + lane * 16 + q * 8), a, c);
#pragma unroll
                for (int j = 0; j < 4; ++j) { hf[i * 16 + q * 8 + j] = a[j]; hf[i * 16 + q * 8 + 4 + j] = c[j]; } }
#pragma unroll 1
        for (int j0 = 0; j0 < 128; j0 += 8) {
            u32x4 w[8][2];
#pragma unroll
            for (int jj = 0; jj < 8; ++jj) { const int e = __builtin_amdgcn_readfirstlane(elist[j0 + jj]); const unsigned char* ur = pu + (size_t)e * 2048 + lane * 16;
                w[jj][0] = *(const u32x4*)ur; w[jj][1] = *(const u32x4*)(ur + 1024); }
            float p[8];
#pragma unroll
            for (int jj = 0; jj < 8; ++jj) { p[jj] = dot16f8(w[jj][0], hf) + dot16f8(w[jj][1], hf + 16); __builtin_amdgcn_sched_barrier(0); }
#pragma unroll
            for (int i = 0; i < 4; ++i) p[i] = swap32_pair(p[i], p[i + 4]);
#pragma unroll
            for (int i = 0; i < 2; ++i) p[i] = swap16_pair(p[i], p[i + 2]);
            const bool b3 = (lane & 8) != 0;
            { const float snd = b3 ? p[0] : p[1], kp = b3 ? p[1] : p[0]; p[0] = kp + dpp_f<DPP_ROR8>(snd); }
            float tot = p[0]; tot += dpp_f<DPP_XOR1>(tot); tot += dpp_f<DPP_XOR2>(tot); tot += dpp_f<DPP_HMIRROR>(tot);
            if ((lane & 7) == 0) cl[j0 + (lane >> 3)] = tot;
        }
        { const float a0 = cl[lane] * (1.0f / 64.0f), a1 = cl[64 + lane] * (1.0f / 64.0f);
          const float c0 = gelu_erf(a0) * gl[lane], c1 = gelu_erf(a1) * gl[64 + lane];
          unsigned* pl = pairs + ((size_t)(row >> 6) * 128) * 64 + (row & 63);
          pl[(size_t)lane * 64] = (cvt_pk_bf16(0.f, c0) & 0xffff0000u) | (unsigned)elist[lane];
          pl[(size_t)(64 + lane) * 64] = (cvt_pk_bf16(0.f, c1) & 0xffff0000u) | (unsigned)elist[64 + lane]; }
    }
}

__device__ __forceinline__ void phase11_peer_v(Frame& F, float* dst) {
    const unsigned* pairs = (const unsigned*)(F.ws + WS_PAIRS); const float* mf = (const float*)(F.ws + WS_MODF);
    unsigned long long* vs = (unsigned long long*)F.lds;
    for (int c = F.bid; c < DM / 8; c += F.G) {
        __syncthreads();
        { const u32x4* src = (const u32x4*)(F.ws + WS_PV + (size_t)c * NEXP * 8); u32x4* dst = (u32x4*)F.lds;
#pragma unroll 4
          for (int i = F.tid; i < NEXP * 8 / 16; i += 512) dst[i] = src[i]; }
        __syncthreads();
        for (int tile = F.wave; tile < MTOK / 64; tile += 8) {
            int lane = F.lane; asm volatile("" : "+v"(lane));
            const unsigned* pp = pairs + (size_t)tile * 128 * 64 + lane;
            f32x2 acc[4];
#pragma unroll
            for (int i = 0; i < 4; ++i) acc[i] = (f32x2){0.f, 0.f};
#define P11_LOAD(dst, j0) do { _Pragma("unroll") for (int jj = 0; jj < 16; ++jj) dst[jj] = pp[((j0) + jj) * 64]; } while (0)
#define P11_COMP(src) do { _Pragma("unroll") for (int jj = 0; jj < 16; ++jj) { const unsigned long long v = vs[src[jj] & 0x3FFFu]; const float cf = __uint_as_float(src[jj] & 0xffff0000u); \
                    const int lo = (int)(unsigned)v, hi = (int)(unsigned)(v >> 32); \
                    acc[0] += __builtin_amdgcn_cvt_pk_f32_fp8(lo, false) * cf; acc[1] += __builtin_amdgcn_cvt_pk_f32_fp8(lo, true) * cf; \
                    acc[2] += __builtin_amdgcn_cvt_pk_f32_fp8(hi, false) * cf; acc[3] += __builtin_amdgcn_cvt_pk_f32_fp8(hi, true) * cf; } } while (0)
            unsigned pa[16], pb[16];
            P11_LOAD(pa, 0);
#pragma unroll 1
            for (int j0 = 0; j0 < 128; j0 += 32) {
                P11_LOAD(pb, j0 + 16);
                P11_COMP(pa);
                if (j0 + 32 < 128) P11_LOAD(pa, j0 + 32);
                P11_COMP(pb);
            }
#undef P11_LOAD
#undef P11_COMP
            const int row = tile * 64 + lane;
            const float* gt2 = mf + (size_t)(tile / (SEQ / 64)) * 12288 + 10240 + c * 8;
            const float* ip = F.out + (size_t)row * 2048 + c * 8; float* op = dst + (size_t)row * 2048 + c * 8;
            const f32x4 x0 = *(const f32x4*)ip, x1 = *(const f32x4*)(ip + 4), g0 = *(const f32x4*)gt2 * 0.25f, g1 = *(const f32x4*)(gt2 + 4) * 0.25f;
            *(f32x4*)op = x0 + g0 * (f32x4){acc[0].x, acc[0].y, acc[1].x, acc[1].y};
            *(f32x4*)(op + 4) = x1 + g1 * (f32x4){acc[2].x, acc[2].y, acc[3].x, acc[3].y};
        }
    }
}

__global__ void __launch_bounds__(512, 2) fwd_kernel(Args args) {
    extern __shared__ __attribute__((aligned(16))) unsigned char lds[];
    Frame F;
    F.lds = lds; F.ws = args.ws; F.tid = threadIdx.x; F.lane = F.tid & 63; F.wave = __builtin_amdgcn_readfirstlane(F.tid >> 6); F.G = gridDim.x; F.bid = blockIdx.x;
    F.x = args.in[0]; F.c = args.in[1]; F.w_ada = args.in[2]; F.b_ada = args.in[3]; F.g1 = args.in[4]; F.g2 = args.in[5]; F.w_in = args.in[6]; F.g_q = args.in[7]; F.g_k = args.in[8];
    F.rel_bias = args.in[9]; F.pool_w = args.in[10]; F.pool_scale = args.in[11]; F.w_ab = args.in[12]; F.w_pb = args.in[13]; F.w_out = args.in[14]; F.w_pq = args.in[15];
    F.peer_keys = args.in[16]; F.peer_u = args.in[17]; F.peer_v = args.in[18]; F.out = args.out;
    LAS unsigned char* ldsl = (LAS unsigned char*)lds;
    volatile LAS unsigned* misc = (volatile LAS unsigned*)(ldsl + MISC_OFF);
    if (F.tid < 4) misc[F.tid] = 0u;
    __syncthreads();
    unsigned* barw = (unsigned*)(args.ws + WS_CTL) + (size_t)args.li * XCD_BAR_WORDS;
    XcdBarrier bar; bar.bar = barw; bar.x = 0; bar.st = misc;
    const int lo = args.ph_lo, hi = args.ph_hi;
    if (hi - lo > 1) bar = xcd_barrier_post(barw, misc);
#define IN(k) (lo <= (k) && (k) < hi)
#define SEAM(k) do { if (IN(k) && IN((k) + 1)) xcd_barrier(bar); } while (0)
    bf16_t* R0 = (bf16_t*)(F.ws + WS_R0);

#define PH2_BODY { \
        pg8::Gemm g{R0, (const bf16_t*)(F.ws + WS_WIN), MTOK, INWP, DM, DM, 0}; pg8::StaticOrder S; S.init(MTOK, INWP, F.G, F.bid); \
        EpiInproj E{(bf16_t*)(F.ws + WS_QN), (bf16_t*)(F.ws + WS_KN), (bf16_t*)(F.ws + WS_V), (bf16_t*)(F.ws + WS_IQ), (bf16_t*)(F.ws + WS_IK), (bf16_t*)(F.ws + WS_PL), \
                    (bf16_t*)(F.ws + WS_GA), (bf16_t*)(F.ws + WS_GP), (float*)(F.ws + WS_IW)}; \
        pg8::gemm_phase<EpiInproj>(ldsl, g, S, E); }
#define PH3_BODY { phase3_pooled(F); phase3_indexer(F); __syncthreads(); }
#define PH4_BODY { \
        phase4_attention(F); \
        __syncthreads(); \
        pg8::Gemm g{(const bf16_t*)(F.ws + WS_POOLED), (const bf16_t*)(F.ws + WS_POOLW), MTOK, PW, 256, 1024, 256}; pg8::StaticOrder S; S.init(MTOK, PW, F.G, F.bid); \
        EpiBf16Scale E{(bf16_t*)(F.ws + WS_POOL2), 1024, F.pool_scale}; \
        pg8::gemm_phase<EpiBf16Scale>(ldsl, g, S, E); }
#define PH5_BODY { \
        { pg8::Gemm g{(const bf16_t*)(F.ws + WS_ATTN), (const bf16_t*)(F.ws + WS_WAB), MTOK, DM, 1024, 1024, 0}; pg8::StaticOrder S; S.init(MTOK, DM, F.G, F.bid); \
          EpiGate<false> E{R0, (const bf16_t*)(F.ws + WS_GA)}; pg8::gemm_phase<EpiGate<false>>(ldsl, g, S, E); } \
        { pg8::Gemm g{(const bf16_t*)(F.ws + WS_POOL2), (const bf16_t*)(F.ws + WS_WPB), MTOK, DM, 1024, 1024, 0}; pg8::StaticOrder S; S.init(MTOK, DM, F.G, F.bid); \
          EpiGate<true> E{R0, (const bf16_t*)(F.ws + WS_GP)}; pg8::gemm_phase<EpiGate<true>>(ldsl, g, S, E); } }
#define PH6_BODY { \
        pg8::Gemm g{R0, (const bf16_t*)(F.ws + WS_WOUT), MTOK, DM, DM, DM, 0}; pg8::StaticOrder S; S.init(MTOK, DM, F.G, F.bid); \
        EpiResid E{F.x, F.out, (const float*)(F.ws + WS_MODF) + 4096}; pg8::gemm_phase<EpiResid>(ldsl, g, S, E); }
#define PH8_BODY { \
        pg8::Gemm g{(const bf16_t*)(F.ws + WS_H2), (const bf16_t*)(F.ws + WS_WPQ), MTOK, DM, DM, DM, 0}; pg8::StaticOrder S; S.init(MTOK, DM, F.G, F.bid); \
        EpiBf16Scale E{R0, 2048, nullptr}; pg8::gemm_phase<EpiBf16Scale>(ldsl, g, S, E); }
#define PH9_BODY { \
        pg8::Gemm g{R0, (const bf16_t*)(F.ws + WS_KEYSBD), MTOK, DM, 256, DM, 256}; pg8::StaticOrder S; S.init(MTOK, DM, F.G, F.bid); \
        EpiF32 E{(float*)(F.ws + WS_SUB), 2048}; pg8::gemm_phase<EpiF32>(ldsl, g, S, E); }
#define REP(k) if constexpr (((PROBE_REP) >> (k)) & 1)

    if (IN(0)) { phase0_prep(F); }
    SEAM(0);
    if (IN(1)) { phase_modnorm<true>(F, F.x, F.g1, 0, 2048, R0); }
    SEAM(1);
    if (IN(2)) { PH2_BODY REP(2) PH2_BODY }
    SEAM(2);
    if (IN(3)) { phase3_qknorm(F); PH3_BODY REP(3) PH3_BODY }
    SEAM(3);
    if (IN(4)) { PH4_BODY REP(4) PH4_BODY }
    SEAM(4);
    if (IN(5)) { PH5_BODY REP(5) PH5_BODY }
    SEAM(5);
    if (IN(6)) { PH6_BODY REP(6) PH6_BODY }
    SEAM(6);
    if (IN(7)) { phase_modnorm<false>(F, F.out, F.g2, 6144, 8192, (bf16_t*)(F.ws + WS_H2)); }
    SEAM(7);
    if (IN(8)) { PH8_BODY REP(8) PH8_BODY }
    SEAM(8);
    if (IN(9)) { PH9_BODY REP(9) PH9_BODY }
    SEAM(9);
    if (IN(10)) { phase10_peer(F); REP(10) phase10_peer(F); }
    SEAM(10);
    if (IN(11)) { REP(11) { phase11_peer_v(F, (float*)(F.ws + WS_SUB)); } phase11_peer_v(F, F.out); }
#undef IN
#undef SEAM
}

extern "C" void kernel_launch(void* const* d_in, const int* in_sizes, int n_in, void* d_out, int out_size, void* d_ws, size_t ws_size, hipStream_t stream) {
    static int grid = 0;
    if (grid == 0) {
        if (n_in != 19 || out_size != MTOK * DM || ws_size < WS_END) { fprintf(stderr, "kernel_launch: unexpected shapes (n_in %d out %d ws %zu)\n", n_in, out_size, ws_size); grid = -1; return; }
        int dev = 0, cus = 0, per_cu = 0;
        if (hipGetDevice(&dev) != hipSuccess || hipDeviceGetAttribute(&cus, hipDeviceAttributeMultiprocessorCount, dev) != hipSuccess) { grid = -1; return; }
        if (hipFuncSetAttribute((const void*)fwd_kernel, hipFuncAttributeMaxDynamicSharedMemorySize, LDS_BYTES) != hipSuccess) { fprintf(stderr, "kernel_launch: hipFuncSetAttribute failed\n"); grid = -1; return; }
        if (hipOccupancyMaxActiveBlocksPerMultiprocessor(&per_cu, (const void*)fwd_kernel, 512, LDS_BYTES) != hipSuccess || per_cu < 1) { fprintf(stderr, "kernel_launch: occupancy query says %d\n", per_cu); }
        (void)hipGetLastError();
        grid = cus;
    }
    if (grid < 0) return;
    (void)in_sizes;
    if (hipMemsetAsync((char*)d_ws + WS_CTL, 0, CTL_ZERO_BYTES, stream) != hipSuccess) return;
    Args a{};
    for (int i = 0; i < 19; ++i) a.in[i] = (const float*)d_in[i];
    a.out = (float*)d_out; a.ws = (unsigned char*)d_ws;
#if MK_PER_PHASE
    for (int p = 0; p < NPHASE; ++p) { a.ph_lo = p; a.ph_hi = p + 1; a.li = p; hipLaunchKernelGGL(fwd_kernel, dim3(grid), dim3(512), LDS_BYTES, stream, a); }
#else
    a.ph_lo = 0; a.ph_hi = NPHASE; a.li = 0;
    hipLaunchKernelGGL(fwd_kernel, dim3(grid), dim3(512), LDS_BYTES, stream, a);
#endif
}
```

```cpp
#include <hip/hip_runtime.h>
#include <cstdio>
#include <cstdint>

#ifndef MK_PER_PHASE
#define MK_PER_PHASE 0
#endif

#ifndef PROBE_REP
#define PROBE_REP 0
#endif
#define LAS __attribute__((address_space(3)))
typedef unsigned short bf16_t;
typedef short bf16x8 __attribute__((ext_vector_type(8)));
typedef float f32x4 __attribute__((ext_vector_type(4)));
typedef float f32x2 __attribute__((ext_vector_type(2)));
typedef unsigned u32x4 __attribute__((ext_vector_type(4)));
typedef unsigned u32x2 __attribute__((ext_vector_type(2)));

constexpr int BATCH = 8, SEQ = 4096, DM = 2048, MTOK = BATCH * SEQ;
constexpr int NHEAD = 8, HDIM = 128, AW = 1024, KVW = 256, IHEADS = 16, IDIM = 64, KSEL = 256;
constexpr int PW = 1024, PHEADS = 8, NEXP = 16384;
constexpr int INW = 7760, INWP = 7936;
constexpr float EPS = 1e-6f;
constexpr int NPHASE = 12;

constexpr size_t MiB = 1u << 20;
constexpr size_t WS_CTL = 0, CTL_ZERO_BYTES = 256 * 1024;
constexpr size_t WS_MODP = 2 * MiB;
constexpr size_t WS_MODF = 4 * MiB;
constexpr size_t WS_POOLW = 5 * MiB;
constexpr size_t WS_KEYSBD = 6 * MiB;
constexpr size_t WS_WIN = 8 * MiB;
constexpr size_t WS_WAB = 40 * MiB, WS_WPB = 44 * MiB, WS_WOUT = 48 * MiB, WS_WPQ = 56 * MiB;
constexpr size_t WS_PU = 64 * MiB, WS_PV = 128 * MiB;
constexpr size_t WS_R0 = 192 * MiB;
constexpr size_t WS_GA = 320 * MiB, WS_GP = 448 * MiB;
constexpr size_t WS_SUB = 320 * MiB;
constexpr size_t WS_QN = 576 * MiB;
constexpr size_t WS_IQ = 640 * MiB;
constexpr size_t WS_PL = 704 * MiB;
constexpr size_t WS_KN = 768 * MiB, WS_V = 784 * MiB;
constexpr size_t WS_IK = 800 * MiB;
constexpr size_t WS_IW = 804 * MiB;
constexpr size_t WS_SEL = 806 * MiB;
constexpr size_t WS_POOLED = 822 * MiB;
constexpr size_t WS_H2 = 886 * MiB;
constexpr size_t WS_END = 1014 * MiB;
constexpr size_t WS_Q8 = WS_H2, WS_K8 = WS_H2 + 32 * MiB, WS_V8 = WS_H2 + 40 * MiB;
constexpr size_t WS_ATTN = WS_IQ, WS_POOL2 = WS_PL, WS_PAIRS = WS_QN;

constexpr int LDS_BYTES = 160 * 1024;
constexpr int MISC_OFF = 159 * 1024;

__device__ __forceinline__ unsigned cvt_pk_bf16(float lo, float hi) { unsigned r; asm volatile("v_cvt_pk_bf16_f32 %0, %1, %2" : "=v"(r) : "v"(lo), "v"(hi)); return r; }
__device__ __forceinline__ float bf_lo(unsigned w) { return __uint_as_float(w << 16); }
__device__ __forceinline__ float bf_hi(unsigned w) { return __uint_as_float(w & 0xffff0000u); }
template <int CTRL> __device__ __forceinline__ float dpp_f(float x) { return __int_as_float(__builtin_amdgcn_update_dpp(0, __float_as_int(x), CTRL, 0xF, 0xF, true)); }
#define DPP_XOR1 0xB1
#define DPP_XOR2 0x4E
#define DPP_HMIRROR 0x141
#define DPP_MIRROR 0x140
#define DPP_ROR8 0x128
__device__ __forceinline__ float xor16_sum(float x) { const auto r = __builtin_amdgcn_permlane16_swap(__float_as_uint(x), __float_as_uint(x), false, false); return __uint_as_float(r[0]) + __uint_as_float(r[1]); }
__device__ __forceinline__ float xor32_sum(float x) { const auto r = __builtin_amdgcn_permlane32_swap(__float_as_uint(x), __float_as_uint(x), false, false); return __uint_as_float(r[0]) + __uint_as_float(r[1]); }
__device__ __forceinline__ float xor16_max(float x) { const auto r = __builtin_amdgcn_permlane16_swap(__float_as_uint(x), __float_as_uint(x), false, false); return fmaxf(__uint_as_float(r[0]), __uint_as_float(r[1])); }
__device__ __forceinline__ float swap32_pair(float a, float b) { const auto r = __builtin_amdgcn_permlane32_swap(__float_as_uint(a), __float_as_uint(b), false, false); return __uint_as_float(r[0]) + __uint_as_float(r[1]); }
__device__ __forceinline__ float swap16_pair(float a, float b) { const auto r = __builtin_amdgcn_permlane16_swap(__float_as_uint(a), __float_as_uint(b), false, false); return __uint_as_float(r[0]) + __uint_as_float(r[1]); }
__device__ __forceinline__ float row_sum16(float v) { v += dpp_f<DPP_XOR1>(v); v += dpp_f<DPP_XOR2>(v); v += dpp_f<DPP_HMIRROR>(v); v += dpp_f<DPP_MIRROR>(v); return v; }
__device__ __forceinline__ float row_max16(float v) { v = fmaxf(v, dpp_f<DPP_XOR1>(v)); v = fmaxf(v, dpp_f<DPP_XOR2>(v)); v = fmaxf(v, dpp_f<DPP_HMIRROR>(v)); v = fmaxf(v, dpp_f<DPP_MIRROR>(v)); return v; }
__device__ __forceinline__ float wave_sum(float v) { return xor32_sum(xor16_sum(row_sum16(v))); }
__device__ __forceinline__ float sigmoidf_(float x) { return __builtin_amdgcn_rcpf(1.0f + __expf(-x)); }
__device__ __forceinline__ float dot8(u32x4 w, const float* h) {
    return bf_lo(w.x) * h[0] + bf_hi(w.x) * h[1] + bf_lo(w.y) * h[2] + bf_hi(w.y) * h[3] + bf_lo(w.z) * h[4] + bf_hi(w.z) * h[5] + bf_lo(w.w) * h[6] + bf_hi(w.w) * h[7];
}

#define XB_TMO      128
#define XB_XCNT(j)  (256  + 64 * (j))
#define XB_XSUB(j)  (1280 + 64 * (j))
#define XB_XGEN(j)  (2304 + 64 * (j))
#define XB_TOP      3328
#define XB_TOPGEN   3392
#define XCD_BAR_WORDS 3456
#define XB_SPIN_CAP (1u << 18)

__device__ __forceinline__ unsigned xb_ld(unsigned* p)              { return __hip_atomic_load(p, __ATOMIC_RELAXED, __HIP_MEMORY_SCOPE_AGENT); }
__device__ __forceinline__ unsigned xb_add(unsigned* p, unsigned v) { return __hip_atomic_fetch_add(p, v, __ATOMIC_RELAXED, __HIP_MEMORY_SCOPE_AGENT); }
__device__ __forceinline__ unsigned xb_xcc_id() { return (unsigned)__builtin_amdgcn_s_getreg((3 << 11) | 20) & 0xFu; }
#define XB_SPIN(cond, bar) do { unsigned _sp = 0; while (cond) { __builtin_amdgcn_s_sleep(1); \
    if ((++_sp & 255u) == 0u) { if (xb_ld(&(bar)[XB_TMO])) break; if (_sp > XB_SPIN_CAP) { atomicAdd(&(bar)[XB_TMO], 1u); break; } } } } while (0)

struct XcdBarrier { unsigned* bar; unsigned x; volatile LAS unsigned* st; };

__device__ __forceinline__ XcdBarrier xcd_barrier_post(unsigned* bar, volatile LAS unsigned* st) {
    XcdBarrier b; b.bar = bar; b.x = xb_xcc_id(); b.st = st;
    if (threadIdx.x == 0) (void)xb_add(&bar[XB_XCNT(b.x)], 1u);
    return b;
}
__device__ __forceinline__ void xcd_barrier_complete(unsigned* bar, unsigned x, unsigned& nloc, unsigned& nx) {
    const unsigned G = gridDim.x * gridDim.y * gridDim.z;
    unsigned sum, cnt, mine, sp = 0u;
    for (;;) {
        sum = 0u; cnt = 0u; mine = 0u;
#pragma unroll
        for (unsigned j = 0; j < 16; ++j) { const unsigned c = xb_ld(&bar[XB_XCNT(j)]); sum += c; cnt += (c > 0u) ? 1u : 0u; mine = (j == x) ? c : mine; }
        if (sum == G) break;
        __builtin_amdgcn_s_sleep(1);
        if ((++sp & 255u) == 0u) { if (xb_ld(&bar[XB_TMO])) break; if (sp > XB_SPIN_CAP) { atomicAdd(&bar[XB_TMO], 1u); break; } }
    }
    nloc = mine > 0u ? mine : 1u; nx = cnt > 0u ? cnt : 1u;
}
__device__ __forceinline__ void xcd_barrier(const XcdBarrier& b) {
    asm volatile("s_waitcnt vmcnt(0)" ::: "memory");
    __syncthreads();
    if (threadIdx.x == 0) {
        unsigned* bar = b.bar;
        __builtin_amdgcn_s_waitcnt(0);
        unsigned nloc = b.st[0], nx = b.st[1];
        if (nloc == 0u) { xcd_barrier_complete(bar, b.x, nloc, nx); b.st[0] = nloc; b.st[1] = nx; }
        const unsigned old = xb_add(&bar[XB_XSUB(b.x)], 1u);
        const unsigned gen = old / nloc;
        if (old + 1u == (gen + 1u) * nloc) {
            __builtin_amdgcn_fence(__ATOMIC_RELEASE, "agent");
            asm volatile("s_waitcnt vmcnt(0)" ::: "memory");
            const unsigned og = xb_add(&bar[XB_TOP], 1u);
            const unsigned tg = og / nx;
            if (og + 1u == (tg + 1u) * nx) xb_add(&bar[XB_TOPGEN], 1u);
            else XB_SPIN(xb_ld(&bar[XB_TOPGEN]) == tg, bar);
            __builtin_amdgcn_fence(__ATOMIC_ACQUIRE, "agent");
            xb_add(&bar[XB_XGEN(b.x)], 1u);
            asm volatile("s_waitcnt vmcnt(0)" ::: "memory");
        } else {
            XB_SPIN(xb_ld(&bar[XB_XGEN(b.x)]) == gen, bar);
            __builtin_amdgcn_fence(__ATOMIC_ACQUIRE, "agent");
            asm volatile("s_waitcnt vmcnt(0)" ::: "memory");
        }
    }
    __syncthreads();
}

namespace pg8 {
constexpr int BM = 256, BK = 64, HALF = 128, HTB = HALF * BK * 2, STAGE_BYTES = 8 * HTB, NXCD = 8, WGM = 8;
__device__ __forceinline__ int lds_byte(int r, int c) { const int st = (r >> 4) * 2 + (c >> 5), rr = r & 15, cc = c & 31, ob = rr * 64 + cc * 2; return st * 1024 + (ob ^ (((ob >> 9) & 1) << 5)); }
__device__ __forceinline__ void stage_rc(int b, int& R, int& C) { const int st = b / 1024, sb = b % 1024, swz = sb ^ (((sb >> 9) & 1) << 5); R = (st >> 1) * 16 + swz / 64; C = (st & 1) * 32 + (swz % 64) / 2; }
__device__ __forceinline__ int perm32(int rho) { const int n = rho >> 4, i = rho & 15; return 8 * (i >> 2) + 4 * n + (i & 3); }

struct Unit { int pm, pn; };
struct Gemm { const bf16_t* A; const bf16_t* Bt; int M, N, K, lda, a_pn_off; };

struct StaticOrder {
    int nM, nN, nwg, G, c;
    __device__ void init(int M, int N, int G_, int c_) { nM = M / BM; nN = N / BM; nwg = nM * nN; G = G_; c = c_; }
    __device__ bool next(int i, Unit& u) const {
        const long L = (long)i * G + c; if (L >= nwg) return false;
        int wgid = (int)L; { const int q = nwg / NXCD, r = nwg % NXCD, xcd = wgid % NXCD, off = wgid / NXCD; wgid = (xcd < r ? xcd * (q + 1) : r * (q + 1) + (xcd - r) * q) + off; }
        const int nig = WGM * nN, gid = wgid / nig, fm = gid * WGM, gsz = (nM - fm) < WGM ? (nM - fm) : WGM;
        u.pm = fm + ((wgid % nig) % gsz); u.pn = (wgid % nig) / gsz; return true;
    }
};

template <class Epi>
__device__ __forceinline__ void gemm_phase(LAS unsigned char* lds, const Gemm g, const StaticOrder& S, const Epi& E) {
    const int tid = threadIdx.x, wid = __builtin_amdgcn_readfirstlane(tid >> 6), lane = tid & 63, wr = wid >> 2, wc = wid & 3, fr = lane & 15, fq = lane >> 4;
    const int K = g.K, nt = K / BK, lda = g.lda;
    unsigned voffA[2], voffB[2];
#pragma unroll
    for (int i = 0; i < 2; ++i) { int R, C; stage_rc(tid * 16 + i * 8192, R, C); const int Rb = Epi::PERM ? ((R & ~31) + perm32(R & 31)) : R;
        voffA[i] = (unsigned)(R * lda + C) * 2u; voffB[i] = (unsigned)(Rb * K + C) * 2u; }
    const size_t kstep = (size_t)(BK * 2);
    const size_t hsA = (size_t)HALF * lda * 2, hsB = (size_t)HALF * K * 2;
    const size_t tsA = 2 * hsA, tsB = 2 * hsB;
    const unsigned ldsw = (unsigned)wid * 1024u;
    const int aoff = lds_byte(wr * 64 + fr, fq * 8), boff = lds_byte(wc * 32 + fr, fq * 8);
#define PG8_SA(b, h) (((b) * 2 + (h)) * HTB)
#define PG8_SB(b, h) ((4 + (b) * 2 + (h)) * HTB)
#define PG8_STAGE(bufoff, gbase, voff) do { _Pragma("unroll") for (int _i = 0; _i < 2; ++_i) \
        __builtin_amdgcn_global_load_lds((const unsigned*)((const char*)(gbase) + (voff)[_i]), (LAS unsigned*)(lds + (bufoff) + ldsw + _i * 8192), 16, 0, 0); } while (0)
#define PG8_LDA(dst, b, h) do { _Pragma("unroll") for (int m = 0; m < 4; ++m) _Pragma("unroll") for (int k = 0; k < 2; ++k) dst[m][k] = *(const LAS bf16x8*)(lds + PG8_SA(b, h) + aoff + m * 2048 + k * 1024); } while (0)
#define PG8_LDB(dst, b, h) do { _Pragma("unroll") for (int n = 0; n < 2; ++n) _Pragma("unroll") for (int k = 0; k < 2; ++k) dst[n][k] = *(const LAS bf16x8*)(lds + PG8_SB(b, h) + boff + n * 2048 + k * 1024); } while (0)
#define PG8_MMA(ai, bj, At, Bt) do { __builtin_amdgcn_s_setprio(1); _Pragma("unroll") for (int m = 0; m < 4; ++m) _Pragma("unroll") for (int n = 0; n < 2; ++n) _Pragma("unroll") for (int k = 0; k < 2; ++k) \
        acc[ai][bj][m][n] = __builtin_amdgcn_mfma_f32_16x16x32_bf16(Bt[n][k], At[m][k], acc[ai][bj][m][n], 0, 0, 0); __builtin_amdgcn_s_setprio(0); } while (0)
#define PG8_WAIT_V(n) asm volatile("s_waitcnt vmcnt(" #n ")" ::: "memory")
#define PG8_WAIT_L(n) asm volatile("s_waitcnt lgkmcnt(" #n ")" ::: "memory")
#define PG8_BAR __builtin_amdgcn_s_barrier()
#define PG8_SCHED __builtin_amdgcn_sched_barrier(0)
    Unit cur, nxt; int ui = 0;
    if (!S.next(0, cur)) return;
    f32x4 acc[2][2][4][2];
#pragma unroll
    for (int a = 0; a < 2; ++a)
#pragma unroll
        for (int b = 0; b < 2; ++b)
#pragma unroll
            for (int m = 0; m < 4; ++m)
#pragma unroll
                for (int n = 0; n < 2; ++n) acc[a][b][m][n] = (f32x4){0.f, 0.f, 0.f, 0.f};
    bf16x8 At[4][2], B0[2][2], B1[2][2];
    const char* cA = (const char*)g.A + (size_t)cur.pm * tsA + (size_t)cur.pn * g.a_pn_off * 2; const char* cB = (const char*)g.Bt + (size_t)cur.pn * tsB;
    PG8_STAGE(PG8_SB(0, 0), cB, voffB); PG8_STAGE(PG8_SA(0, 0), cA, voffA); PG8_STAGE(PG8_SB(0, 1), cB + hsB, voffB); PG8_STAGE(PG8_SA(0, 1), cA + hsA, voffA);
    if (wr == 1) PG8_BAR;
    PG8_WAIT_V(4); PG8_BAR;
    PG8_STAGE(PG8_SB(1, 0), cB + kstep, voffB); PG8_STAGE(PG8_SA(1, 0), cA + kstep, voffA); PG8_STAGE(PG8_SB(1, 1), cB + hsB + kstep, voffB);
    PG8_WAIT_V(6); PG8_BAR;
    for (;;) {
        const bool has_next = S.next(ui + 1, nxt);
        const char* nA = has_next ? (const char*)g.A + (size_t)nxt.pm * tsA + (size_t)nxt.pn * g.a_pn_off * 2 : cA; const char* nB = has_next ? (const char*)g.Bt + (size_t)nxt.pn * tsB : cB;
        for (int t = 0; t < nt; t += 2) {
            const bool last = (t == nt - 2);
            const char* a1 = cA + (size_t)(t + 1) * kstep;
            const char* a2 = last ? nA : cA + (size_t)(t + 2) * kstep; const char* b2 = last ? nB : cB + (size_t)(t + 2) * kstep;
            const char* a3 = a2 + kstep; const char* b3 = b2 + kstep;
            PG8_LDB(B0, 0, 0); PG8_SCHED; PG8_LDA(At, 0, 0); PG8_STAGE(PG8_SA(1, 1), a1 + hsA, voffA);
            PG8_WAIT_L(8); PG8_BAR; PG8_WAIT_L(0); PG8_MMA(0, 0, At, B0); PG8_BAR; PG8_SCHED;
            PG8_LDB(B1, 0, 1); PG8_STAGE(PG8_SB(0, 0), b2, voffB);
            PG8_BAR; PG8_WAIT_L(0); PG8_MMA(0, 1, At, B1); PG8_BAR;
            PG8_LDA(At, 0, 1); PG8_STAGE(PG8_SA(0, 0), a2, voffA);
            PG8_BAR; PG8_WAIT_L(0); PG8_MMA(1, 0, At, B0); PG8_BAR; PG8_SCHED;
            PG8_STAGE(PG8_SB(0, 1), b2 + hsB, voffB);
            PG8_WAIT_V(6); PG8_BAR; PG8_MMA(1, 1, At, B1); PG8_BAR;
            PG8_LDB(B0, 1, 0); PG8_SCHED; PG8_LDA(At, 1, 0); PG8_STAGE(PG8_SA(0, 1), a2 + hsA, voffA);
            PG8_WAIT_L(8); PG8_BAR; PG8_WAIT_L(0); PG8_MMA(0, 0, At, B0); PG8_BAR; PG8_SCHED;
            PG8_LDB(B1, 1, 1); PG8_STAGE(PG8_SB(1, 0), b3, voffB);
            PG8_BAR; PG8_WAIT_L(0); PG8_MMA(0, 1, At, B1); PG8_BAR;
            PG8_LDA(At, 1, 1); PG8_STAGE(PG8_SA(1, 0), a3, voffA);
            PG8_BAR; PG8_WAIT_L(0); PG8_MMA(1, 0, At, B0); PG8_BAR; PG8_SCHED;
            PG8_STAGE(PG8_SB(1, 1), b3 + hsB, voffB);
            PG8_WAIT_V(6); PG8_BAR; PG8_MMA(1, 1, At, B1); PG8_BAR;
        }
        E(acc, cur, wr, wc, fr, fq);
        if (!has_next) break;
#pragma unroll
        for (int a = 0; a < 2; ++a)
#pragma unroll
            for (int b = 0; b < 2; ++b)
#pragma unroll
                for (int m = 0; m < 4; ++m)
#pragma unroll
                    for (int n = 0; n < 2; ++n) acc[a][b][m][n] = (f32x4){0.f, 0.f, 0.f, 0.f};
        cur = nxt; cA = nA; cB = nB; ++ui;
    }
    PG8_WAIT_V(0);
    if (wr == 0) PG8_BAR;
    PG8_BAR;
#undef PG8_SA
#undef PG8_SB
#undef PG8_STAGE
#undef PG8_LDA
#undef PG8_LDB
#undef PG8_MMA
#undef PG8_WAIT_V
#undef PG8_WAIT_L
#undef PG8_BAR
#undef PG8_SCHED
}
}
using pg8::Unit;

typedef f32x4 AccT[2][2][4][2];
__device__ __forceinline__ u32x4 pack8(f32x4 a, f32x4 b) { u32x4 w; w.x = cvt_pk_bf16(a[0], a[1]); w.y = cvt_pk_bf16(a[2], a[3]); w.z = cvt_pk_bf16(b[0], b[1]); w.w = cvt_pk_bf16(b[2], b[3]); return w; }
__device__ __forceinline__ void unpack8(u32x4 w, f32x4& a, f32x4& b) { a = (f32x4){bf_lo(w.x), bf_hi(w.x), bf_lo(w.y), bf_hi(w.y)}; b = (f32x4){bf_lo(w.z), bf_hi(w.z), bf_lo(w.w), bf_hi(w.w)}; }

struct EpiInproj {
    static constexpr bool PERM = true;
    bf16_t *q, *k, *v, *iq, *ik, *pl, *ga, *gp; float* iw;
    __device__ __forceinline__ void operator()(const AccT& acc, const Unit& u, int wr, int wc, int fr, int fq) const {
        const int pn = u.pn, row0 = u.pm * 256 + wr * 64 + fr;
        if (pn == 10) {
            if (wc < 2) {
#pragma unroll
                for (int ai = 0; ai < 2; ++ai)
#pragma unroll
                    for (int m = 0; m < 4; ++m) { const size_t row = (size_t)(row0 + ai * 128 + m * 16);
                        *(u32x4*)(ik + row * 64 + wc * 32 + 8 * fq) = pack8(acc[ai][0][m][0], acc[ai][0][m][1]); }
            } else if (wc == 2) {
                if (fq < 2) {
#pragma unroll
                    for (int ai = 0; ai < 2; ++ai)
#pragma unroll
                        for (int m = 0; m < 4; ++m) { const size_t row = (size_t)(row0 + ai * 128 + m * 16);
                            *(f32x4*)(iw + row * 16 + 8 * fq) = acc[ai][0][m][0]; *(f32x4*)(iw + row * 16 + 8 * fq + 4) = acc[ai][0][m][1]; }
                }
            }
            return;
        }
        bf16_t* dst; int ld, tc; bool sg = false;
        if (pn < 4) { dst = q; ld = 1024; tc = pn * 256; }
        else if (pn == 4) { dst = k; ld = 256; tc = 0; }
        else if (pn == 5) { dst = v; ld = 256; tc = 0; }
        else if (pn < 10) { dst = iq; ld = 1024; tc = (pn - 6) * 256; }
        else if (pn < 15) { dst = pl; ld = 1024; tc = (pn - 11) * 256; }
        else if (pn < 23) { dst = ga; ld = 2048; tc = (pn - 15) * 256; sg = true; }
        else { dst = gp; ld = 2048; tc = (pn - 23) * 256; sg = true; }
        const int col0 = tc + wc * 32 + 8 * fq;
#pragma unroll
        for (int ai = 0; ai < 2; ++ai)
#pragma unroll
            for (int m = 0; m < 4; ++m) { bf16_t* rowp = dst + (size_t)(row0 + ai * 128 + m * 16) * ld + col0;
#pragma unroll
                for (int bj = 0; bj < 2; ++bj) { f32x4 v0 = acc[ai][bj][m][0], v1 = acc[ai][bj][m][1];
                    if (sg) {
#pragma unroll
                        for (int j = 0; j < 4; ++j) { v0[j] = sigmoidf_(v0[j]); v1[j] = sigmoidf_(v1[j]); } }
                    *(u32x4*)(rowp + bj * 128) = pack8(v0, v1); } }
    }
};
struct EpiBf16Scale {
    static constexpr bool PERM = true;
    bf16_t* O; int ldc; const float* cs;
    __device__ __forceinline__ void operator()(const AccT& acc, const Unit& u, int wr, int wc, int fr, int fq) const {
        const int row0 = u.pm * 256 + wr * 64 + fr, col0 = u.pn * 256 + wc * 32 + 8 * fq;
        f32x4 s[2][2];
#pragma unroll
        for (int bj = 0; bj < 2; ++bj)
#pragma unroll
            for (int n = 0; n < 2; ++n) s[bj][n] = cs ? *(const f32x4*)(cs + col0 + bj * 128 + 4 * n) : (f32x4){1.f, 1.f, 1.f, 1.f};
#pragma unroll
        for (int ai = 0; ai < 2; ++ai)
#pragma unroll
            for (int m = 0; m < 4; ++m) { bf16_t* rowp = O + (size_t)(row0 + ai * 128 + m * 16) * ldc + col0;
#pragma unroll
                for (int bj = 0; bj < 2; ++bj) *(u32x4*)(rowp + bj * 128) = pack8(acc[ai][bj][m][0] * s[bj][0], acc[ai][bj][m][1] * s[bj][1]); }
    }
};
template <bool ADD> struct EpiGate {
    static constexpr bool PERM = true;
    bf16_t* O; const bf16_t* gate;
    __device__ __forceinline__ void operator()(const AccT& acc, const Unit& u, int wr, int wc, int fr, int fq) const {
        const int row0 = u.pm * 256 + wr * 64 + fr, col0 = u.pn * 256 + wc * 32 + 8 * fq;
#pragma unroll
        for (int ai = 0; ai < 2; ++ai)
#pragma unroll
            for (int m = 0; m < 4; ++m) { const size_t off = (size_t)(row0 + ai * 128 + m * 16) * 2048 + col0;
#pragma unroll
                for (int bj = 0; bj < 2; ++bj) { f32x4 g0, g1; unpack8(*(const u32x4*)(gate + off + bj * 128), g0, g1);
                    f32x4 r0 = g0 * acc[ai][bj][m][0], r1 = g1 * acc[ai][bj][m][1];
                    if (ADD) { f32x4 o0, o1; unpack8(*(const u32x4*)(O + off + bj * 128), o0, o1); r0 += o0; r1 += o1; }
                    *(u32x4*)(O + off + bj * 128) = pack8(r0, r1); } }
    }
};
struct EpiResid {
    static constexpr bool PERM = false;
    const float* x; float* out; const float* gt;
    __device__ __forceinline__ void operator()(const AccT& acc, const Unit& u, int wr, int wc, int fr, int fq) const {
        const int row0 = u.pm * 256 + wr * 64 + fr, col0 = u.pn * 256 + wc * 32 + 4 * fq;
        const float* gtb = gt + (size_t)(u.pm / 16) * 12288;
        f32x4 g[2][2];
#pragma unroll
        for (int bj = 0; bj < 2; ++bj)
#pragma unroll
            for (int n = 0; n < 2; ++n) g[bj][n] = *(const f32x4*)(gtb + col0 + bj * 128 + n * 16);
#pragma unroll
        for (int ai = 0; ai < 2; ++ai)
#pragma unroll
            for (int m = 0; m < 4; ++m) { const size_t off = (size_t)(row0 + ai * 128 + m * 16) * 2048 + col0;
#pragma unroll
                for (int bj = 0; bj < 2; ++bj)
#pragma unroll
                    for (int n = 0; n < 2; ++n) { const f32x4 xv = *(const f32x4*)(x + off + bj * 128 + n * 16);
                        *(f32x4*)(out + off + bj * 128 + n * 16) = xv + g[bj][n] * acc[ai][bj][m][n]; } }
    }
};
struct EpiF32 {
    static constexpr bool PERM = false;
    float* C; int ldc;
    __device__ __forceinline__ void operator()(const AccT& acc, const Unit& u, int wr, int wc, int fr, int fq) const {
        const int row0 = u.pm * 256 + wr * 64 + fr, col0 = u.pn * 256 + wc * 32 + 4 * fq;
#pragma unroll
        for (int ai = 0; ai < 2; ++ai)
#pragma unroll
            for (int m = 0; m < 4; ++m) { float* rowp = C + (size_t)(row0 + ai * 128 + m * 16) * ldc + col0;
#pragma unroll
                for (int bj = 0; bj < 2; ++bj)
#pragma unroll
                    for (int n = 0; n < 2; ++n) *(f32x4*)(rowp + bj * 128 + n * 16) = acc[ai][bj][m][n]; }
    }
};

struct Args { const float* in[19]; float* out; unsigned char* ws; int ph_lo, ph_hi; int li, pad; };
struct Frame {
    unsigned char* lds; unsigned char* ws;
    int tid, lane, wave, G, bid;
    const float *x, *c, *w_ada, *b_ada, *g1, *g2, *w_in, *g_q, *g_k, *rel_bias, *pool_w, *pool_scale, *w_ab, *w_pb, *w_out, *w_pq, *peer_keys, *peer_u, *peer_v;
    float* out;
};

template <class Fn> __device__ __forceinline__ void transpose_item(const float* W, int K, int N, bf16_t* WT, int ldk, int drow0, int k0, float* scr, int lane, Fn srccol) {
    const int sc = srccol(drow0 + (lane & 31));
#pragma unroll 8
    for (int i = 0; i < 32; ++i) { const int kk = 2 * i + (lane >> 5); scr[kk * 33 + (lane & 31)] = sc >= 0 ? W[(size_t)(k0 + kk) * N + sc] : 0.f; }
    asm volatile("s_waitcnt lgkmcnt(0)" ::: "memory");
    const int c = lane & 7;
#pragma unroll
    for (int j = 0; j < 4; ++j) { const int n = (lane >> 3) + 8 * j; const float* s = scr + (8 * c) * 33 + n;
        u32x4 o; o.x = cvt_pk_bf16(s[0 * 33], s[1 * 33]); o.y = cvt_pk_bf16(s[2 * 33], s[3 * 33]); o.z = cvt_pk_bf16(s[4 * 33], s[5 * 33]); o.w = cvt_pk_bf16(s[6 * 33], s[7 * 33]);
        *(u32x4*)(WT + (size_t)(drow0 + n) * ldk + k0 + 8 * c) = o; }
    asm volatile("s_waitcnt lgkmcnt(0)" ::: "memory");
}
__device__ __forceinline__ void phase0_prep(Frame& F) {
    const int gw = F.bid * 8 + F.wave, NGW = F.G * 8;
    float* scr = (float*)(F.lds + F.wave * 16384);
    constexpr int I_IN = (INWP / 32) * (DM / 64);
    constexpr int I_AB = (2048 / 32) * (1024 / 64), I_OUT = (2048 / 32) * (2048 / 64), I_PW = 4 * 8 * 4;
    constexpr int NIT = I_IN + 2 * I_AB + 2 * I_OUT + I_PW;
    auto ident = [](int j) { return j; };
    for (int it = gw; it < NIT; it += NGW) {
        int r = it;
        if (r < I_IN) { const int nb = r % (INWP / 32), kb = r / (INWP / 32);
            transpose_item(F.w_in, DM, INW, (bf16_t*)(F.ws + WS_WIN), DM, nb * 32, kb * 64, scr, F.lane, [](int j) { return j < 2640 ? j : (j < 2816 ? -1 : j - 176); }); continue; }
        r -= I_IN;
        if (r < I_AB) { transpose_item(F.w_ab, 1024, 2048, (bf16_t*)(F.ws + WS_WAB), 1024, (r % 64) * 32, (r / 64) * 64, scr, F.lane, ident); continue; }
        r -= I_AB;
        if (r < I_AB) { transpose_item(F.w_pb, 1024, 2048, (bf16_t*)(F.ws + WS_WPB), 1024, (r % 64) * 32, (r / 64) * 64, scr, F.lane, ident); continue; }
        r -= I_AB;
        if (r < I_OUT) { transpose_item(F.w_out, 2048, 2048, (bf16_t*)(F.ws + WS_WOUT), 2048, (r % 64) * 32, (r / 64) * 64, scr, F.lane, ident); continue; }
        r -= I_OUT;
        if (r < I_OUT) { transpose_item(F.w_pq, 2048, 2048, (bf16_t*)(F.ws + WS_WPQ), 2048, (r % 64) * 32, (r / 64) * 64, scr, F.lane, ident); continue; }
        r -= I_OUT;
        { const int g = r / 32, q = r % 32, nb = q % 8, kb = q / 8;
          transpose_item(F.pool_w + (size_t)g * 65536, 256, 256, (bf16_t*)(F.ws + WS_POOLW) + (size_t)g * 65536, 256, nb * 32, kb * 64, scr, F.lane, ident); }
    }
    {
        bf16_t* kb = (bf16_t*)(F.ws + WS_KEYSBD);
        for (int i = F.bid * 512 + F.tid; i < 2048 * 32; i += F.G * 512) {
            const int row = i / 32, k8 = (i % 32) * 8, p = (row >> 7) & 1;
            u32x4 o = (u32x4){0u, 0u, 0u, 0u};
            if ((k8 >> 7) == p) { const float* s = F.peer_keys + (size_t)row * 128 + (k8 & 127); const f32x4 a = *(const f32x4*)s, b = *(const f32x4*)(s + 4); o = pack8(a, b); }
            *(u32x4*)(kb + (size_t)row * 256 + k8) = o;
        }
    }
    {
        const size_t n16 = (size_t)NEXP * DM / 16;
        unsigned char* pu = F.ws + WS_PU;
        for (size_t i = (size_t)F.bid * 512 + F.tid; i < n16; i += (size_t)F.G * 512) {
            u32x4 ou;
#pragma unroll
            for (int k = 0; k < 4; ++k) { const f32x4 a = *(const f32x4*)(F.peer_u + i * 16 + k * 4) * 64.0f;
                int wu = __builtin_amdgcn_cvt_pk_fp8_f32(a[0], a[1], 0, false); wu = __builtin_amdgcn_cvt_pk_fp8_f32(a[2], a[3], wu, true); ou[k] = (unsigned)wu; }
            *(u32x4*)(pu + i * 16) = ou;
        }
        unsigned char* pv = F.ws + WS_PV;
        for (int it = gw; it < (NEXP / 64) * 128; it += NGW) {
            const int e = (it >> 7) * 64 + F.lane, ch = it & 127;
            u32x4 ov;
#pragma unroll
            for (int k = 0; k < 4; ++k) { const f32x4 c = *(const f32x4*)(F.peer_v + (size_t)e * DM + ch * 16 + k * 4) * 4.0f;
                int wv = __builtin_amdgcn_cvt_pk_fp8_f32(c[0], c[1], 0, false); wv = __builtin_amdgcn_cvt_pk_fp8_f32(c[2], c[3], wv, true); ov[k] = (unsigned)wv; }
            *(u32x2*)(pv + ((size_t)(2 * ch) * NEXP + e) * 8) = (u32x2){ov[0], ov[1]};
            *(u32x2*)(pv + ((size_t)(2 * ch + 1) * NEXP + e) * 8) = (u32x2){ov[2], ov[3]};
        }
    }
    {
        __syncthreads();
        float* cact = (float*)(F.lds + 131072);
        float* red = (float*)F.lds;
        float* mp = (float*)(F.ws + WS_MODP);
        for (int it = F.bid; it < 48 * 4; it += F.G) {
            const int cb = it % 48, ds = it / 48, d0 = ds * 512;
            for (int i = F.tid; i < 8 * 512; i += 512) { const int b = i >> 9, d = i & 511; const float cv = F.c[b * DM + d0 + d]; cact[i] = cv * sigmoidf_(cv); }
            __syncthreads();
            f32x4 a[8];
#pragma unroll
            for (int b = 0; b < 8; ++b) a[b] = (f32x4){0.f, 0.f, 0.f, 0.f};
            const float* wp = F.w_ada + (size_t)(d0 + F.wave * 64) * 12288 + cb * 256 + F.lane * 4;
#pragma unroll 4
            for (int d = 0; d < 64; ++d) { const f32x4 w = *(const f32x4*)(wp + (size_t)d * 12288);
#pragma unroll
                for (int b = 0; b < 8; ++b) a[b] += w * cact[b * 512 + F.wave * 64 + d]; }
#pragma unroll
            for (int b = 0; b < 8; ++b)
#pragma unroll
                for (int j = 0; j < 4; ++j) red[(F.wave * 32 + b * 4 + j) * 64 + F.lane] = a[b][j];
            __syncthreads();
            for (int i = F.tid; i < 2048; i += 512) { const int v = i >> 6, l = i & 63; float s = 0.f;
#pragma unroll
                for (int w = 0; w < 8; ++w) s += red[(w * 32 + v) * 64 + l];
                mp[((size_t)ds * 8 + (v >> 2)) * 12288 + cb * 256 + l * 4 + (v & 3)] = s; }
            __syncthreads();
        }
    }
}

template <bool FIRST> __device__ __forceinline__ void phase_modnorm(Frame& F, const float* xin, const float* gain, int off_sh, int off_sc, bf16_t* dst) {
    const float* mp = (const float*)(F.ws + WS_MODP); float* mf = (float*)(F.ws + WS_MODF);
    if (FIRST) {
        for (int i = F.bid * 512 + F.tid; i < 8 * 12288; i += F.G * 512) {
            float s = F.b_ada[i % 12288];
#pragma unroll
            for (int k = 0; k < 4; ++k) s += mp[(size_t)k * 8 * 12288 + i];
            mf[i] = s; }
    }
    float* cA = (float*)F.lds; float* cB = cA + 2048;
    for (int ch = F.bid; ch < MTOK / 128; ch += F.G) {
        const int b = ch / 32;
        __syncthreads();
        for (int col = F.tid; col < 2048; col += 512) {
            float sc, sh;
            if (FIRST) { sc = F.b_ada[off_sc + col]; sh = F.b_ada[off_sh + col];
#pragma unroll
                for (int k = 0; k < 4; ++k) { sc += mp[((size_t)k * 8 + b) * 12288 + off_sc + col]; sh += mp[((size_t)k * 8 + b) * 12288 + off_sh + col]; } }
            else { sc = mf[b * 12288 + off_sc + col]; sh = mf[b * 12288 + off_sh + col]; }
            cA[col] = gain[col] * (1.f + sc); cB[col] = sh; }
        __syncthreads();
        for (int r = F.wave; r < 128; r += 8) {
            const size_t row = (size_t)ch * 128 + r;
            const float* xr = xin + row * 2048 + F.lane * 8;
            f32x4 v[4][2]; float ss = 0.f;
#pragma unroll
            for (int i = 0; i < 4; ++i) { v[i][0] = *(const f32x4*)(xr + i * 512); v[i][1] = *(const f32x4*)(xr + i * 512 + 4);
#pragma unroll
                for (int j = 0; j < 4; ++j) ss += v[i][0][j] * v[i][0][j] + v[i][1][j] * v[i][1][j]; }
            ss = wave_sum(ss);
            const float rinv = 1.0f / sqrtf(ss * (1.0f / 2048.0f) + EPS);
#pragma unroll
            for (int i = 0; i < 4; ++i) { const int col = i * 512 + F.lane * 8;
                const f32x4 a0 = *(const f32x4*)(cA + col), a1 = *(const f32x4*)(cA + col + 4), b0 = *(const f32x4*)(cB + col), b1 = *(const f32x4*)(cB + col + 4);
                *(u32x4*)(dst + row * 2048 + col) = pack8(v[i][0] * rinv * a0 + b0, v[i][1] * rinv * a1 + b1); }
        }
    }
}

__device__ __forceinline__ u32x2 pack8_fp8(f32x4 a, f32x4 b) {
    int w0 = __builtin_amdgcn_cvt_pk_fp8_f32(a[0], a[1], 0, false); w0 = __builtin_amdgcn_cvt_pk_fp8_f32(a[2], a[3], w0, true);
    int w1 = __builtin_amdgcn_cvt_pk_fp8_f32(b[0], b[1], 0, false); w1 = __builtin_amdgcn_cvt_pk_fp8_f32(b[2], b[3], w1, true);
    return (u32x2){(unsigned)w0, (unsigned)w1};
}
__device__ __forceinline__ void phase3_qknorm(Frame& F) {
    const bf16_t* q = (const bf16_t*)(F.ws + WS_QN); const bf16_t* k = (const bf16_t*)(F.ws + WS_KN); const bf16_t* v = (const bf16_t*)(F.ws + WS_V);
    unsigned char* q8 = F.ws + WS_Q8; unsigned char* k8 = F.ws + WS_K8; unsigned char* v8 = F.ws + WS_V8;
    const int gw = F.bid * 8 + F.wave, NGW = F.G * 8;
    for (int row = gw; row < MTOK; row += NGW) {
#pragma unroll
        for (int i = 0; i < 2; ++i) { const int ci = i * 64 + F.lane;
            f32x4 a, b; unpack8(*(const u32x4*)(q + (size_t)row * 1024 + ci * 8), a, b);
            float ss = a[0] * a[0] + a[1] * a[1] + a[2] * a[2] + a[3] * a[3] + b[0] * b[0] + b[1] * b[1] + b[2] * b[2] + b[3] * b[3];
            ss = row_sum16(ss);
            const float rinv = 1.0f / sqrtf(ss * (1.0f / 128.0f) + EPS);
            const float* gp = F.g_q + (ci & 15) * 8; const f32x4 g0 = *(const f32x4*)gp, g1 = *(const f32x4*)(gp + 4);
            *(u32x2*)(q8 + (size_t)row * 1024 + ci * 8) = pack8_fp8(a * rinv * g0, b * rinv * g1); }
        { const int ci = F.lane & 31; const bool isk = F.lane < 32;
            f32x4 a, b; unpack8(*(const u32x4*)((isk ? k : v) + (size_t)row * 256 + ci * 8), a, b);
            float ss = a[0] * a[0] + a[1] * a[1] + a[2] * a[2] + a[3] * a[3] + b[0] * b[0] + b[1] * b[1] + b[2] * b[2] + b[3] * b[3];
            ss = row_sum16(ss);
            const float rinv = isk ? 1.0f / sqrtf(ss * (1.0f / 128.0f) + EPS) : 1.0f;
            const float* gp = F.g_k + (ci & 15) * 8; f32x4 g0 = *(const f32x4*)gp, g1 = *(const f32x4*)(gp + 4);
            if (!isk) { g0 = (f32x4){1.f, 1.f, 1.f, 1.f}; g1 = g0; }
            *(u32x2*)((isk ? k8 : v8) + (size_t)row * 256 + ci * 8) = pack8_fp8(a * rinv * g0, b * rinv * g1); }
    }
}
__device__ __forceinline__ void phase3_pooled(Frame& F) {
    const bf16_t* pl = (const bf16_t*)(F.ws + WS_PL); bf16_t* po = (bf16_t*)(F.ws + WS_POOLED);
    for (size_t i = (size_t)F.bid * 512 + F.tid; i < (size_t)MTOK * 128; i += (size_t)F.G * 512) {
        const int row = (int)(i >> 7), c8 = (int)(i & 127) * 8, g = c8 >> 8, w = 2 << g, t = row & (SEQ - 1);
        const int cnt = (t + 1 < w) ? t + 1 : w;
        f32x4 s0 = (f32x4){0.f, 0.f, 0.f, 0.f}, s1 = s0, x0 = s0, x1 = s0;
        for (int j = 0; j < cnt; ++j) { f32x4 a, b; unpack8(*(const u32x4*)(pl + (size_t)(row - j) * 1024 + c8), a, b); s0 += a; s1 += b; if (j == 0) { x0 = a; x1 = b; } }
        const float inv = 1.0f / (float)cnt;
        *(u32x4*)(po + (size_t)row * 1024 + c8) = pack8(s0 * inv - x0, s1 * inv - x1);
    }
}
typedef float f32x16 __attribute__((ext_vector_type(16)));
__device__ __forceinline__ int sel_code(float s, float smin, float scale) { const float c = (s - smin) * scale; return (int)fminf(fmaxf(c, 0.f), 65535.f); }
__device__ __forceinline__ void hist_find(const unsigned* hist, int lane, int K, int& bsel, int& above) {
    const u32x4 h = *(const u32x4*)(hist + lane * 4);
    const int S = (int)(h.x + h.y + h.z + h.w);
    int x = S;
    x += __builtin_amdgcn_update_dpp(0, x, 0x101, 0xF, 0xF, true);
    x += __builtin_amdgcn_update_dpp(0, x, 0x102, 0xF, 0xF, true);
    x += __builtin_amdgcn_update_dpp(0, x, 0x104, 0xF, 0xF, true);
    x += __builtin_amdgcn_update_dpp(0, x, 0x108, 0xF, 0xF, true);
    const int t1 = __builtin_amdgcn_readlane(x, 16), t2 = __builtin_amdgcn_readlane(x, 32), t3 = __builtin_amdgcn_readlane(x, 48);
    const int r = lane >> 4;
    x += (r == 0 ? t1 + t2 + t3 : (r == 1 ? t2 + t3 : (r == 2 ? t3 : 0)));
    const int sufn = x - S;
    const bool mine = (x >= K) && (sufn < K);
    int b = 0, ab = 0;
    { int c = sufn;
      if (c + (int)h.w >= K) { b = 3; ab = c; } else { c += (int)h.w;
      if (c + (int)h.z >= K) { b = 2; ab = c; } else { c += (int)h.z;
      if (c + (int)h.y >= K) { b = 1; ab = c; } else { c += (int)h.y; b = 0; ab = c; } } } }
    const unsigned long long m = __ballot(mine);
    const int src = m ? (int)__builtin_ctzll(m) : 0;
    bsel = __builtin_amdgcn_readlane(lane * 4 + b, src); above = __builtin_amdgcn_readlane(ab, src);
}
__device__ __forceinline__ void indexer_select(Frame& F, int b, int t, const float* rowbuf, unsigned* hist, float* eqv, int* eqi) {
    unsigned short* selrow = (unsigned short*)(F.ws + WS_SEL) + (size_t)(b * SEQ + t) * 256;
    int lane = F.lane; asm volatile("" : "+v"(lane));
    const int nch = t / 64 + 1, n4 = (nch + 3) >> 2;
    const f32x4* rb4 = (const f32x4*)rowbuf;
    float mn = __builtin_huge_valf(), mx = -__builtin_huge_valf();
    for (int c4 = 0; c4 < n4; ++c4) { const f32x4 v = rb4[c4 * 64 + lane];
#pragma unroll
        for (int k = 0; k < 4; ++k) { const bool valid = ((c4 * 4 + k) * 64 + lane) <= t; mn = valid ? fminf(mn, v[k]) : mn; mx = valid ? fmaxf(mx, v[k]) : mx; } }
    mx = xor16_max(row_max16(mx)); { const auto r = __builtin_amdgcn_permlane32_swap(__float_as_uint(mx), __float_as_uint(mx), false, false); mx = fmaxf(__uint_as_float(r[0]), __uint_as_float(r[1])); }
    mn = -mn; mn = xor16_max(row_max16(mn)); { const auto r = __builtin_amdgcn_permlane32_swap(__float_as_uint(mn), __float_as_uint(mn), false, false); mn = -fmaxf(__uint_as_float(r[0]), __uint_as_float(r[1])); }
    const float scale = (mx > mn) ? 65535.0f / (mx - mn) : 0.f;
    *(u32x4*)(hist + lane * 4) = (u32x4){0u, 0u, 0u, 0u};
    for (int c4 = 0; c4 < n4; ++c4) { const f32x4 v = rb4[c4 * 64 + lane];
#pragma unroll
        for (int k = 0; k < 4; ++k) { const bool valid = ((c4 * 4 + k) * 64 + lane) <= t; if (valid) atomicAdd(&hist[sel_code(v[k], mn, scale) >> 8], 1u); } }
    int b1, above1; hist_find(hist, lane, KSEL, b1, above1);
    *(u32x4*)(hist + lane * 4) = (u32x4){0u, 0u, 0u, 0u};
    for (int c4 = 0; c4 < n4; ++c4) { const f32x4 v = rb4[c4 * 64 + lane];
#pragma unroll
        for (int k = 0; k < 4; ++k) { const bool valid = ((c4 * 4 + k) * 64 + lane) <= t; const int code = sel_code(v[k], mn, scale); if (valid && (code >> 8) == b1) atomicAdd(&hist[code & 255], 1u); } }
    int b2, above2; hist_find(hist, lane, KSEL - above1, b2, above2);
    const int T16 = (b1 << 8) | b2, need = KSEL - above1 - above2, ceq = (int)hist[b2];
    const unsigned long long lt_mask = (1ull << lane) - 1ull;
    const bool exact = (ceq != need) && (ceq <= 64);
    if (exact) {
        int pos = 0;
        for (int c = 0; c < nch; ++c) { const float sv = rowbuf[((c >> 2) * 64 + lane) * 4 + (c & 3)]; const int idx = c * 64 + lane;
            const bool eq = (idx <= t) && (sel_code(sv, mn, scale) == T16);
            const unsigned long long m = __ballot(eq);
            if (m) { const int p = pos + __popcll(m & lt_mask); if (eq) { eqv[p] = sv; eqi[p] = idx; } pos += __popcll(m); } }
    }
    int pos = 0, eqseen = 0;
    for (int c = 0; c < nch; ++c) {
        const float sv = rowbuf[((c >> 2) * 64 + lane) * 4 + (c & 3)]; const int idx = c * 64 + lane;
        const int code = sel_code(sv, mn, scale); const bool valid = idx <= t;
        const bool gt = valid && code > T16, eq = valid && code == T16;
        const unsigned long long meq = __ballot(eq);
        bool take = gt;
        if (meq) {
            if (ceq == need) take = take || eq;
            else if (exact) { int rank = 0; for (int m = 0; m < ceq; ++m) { const float ov = eqv[m]; const int oi = eqi[m]; rank += (ov > sv || (ov == sv && oi < idx)) ? 1 : 0; } take = take || (eq && rank < need); }
            else { const int er = eqseen + __popcll(meq & lt_mask); take = take || (eq && er < need); eqseen += __popcll(meq); }
        }
        const unsigned long long mt = __ballot(take);
        const int p = pos + __popcll(mt & lt_mask);
        if (take && p < KSEL) selrow[p] = (unsigned short)idx;
        pos += __popcll(mt);
    }
}
__device__ __forceinline__ void indexer_tile(Frame& F, int b, int t0) {
    const bf16_t* iq = (const bf16_t*)(F.ws + WS_IQ); const bf16_t* ik = (const bf16_t*)(F.ws + WS_IK); const float* iw = (const float*)(F.ws + WS_IW);
    int lane = F.lane; asm volatile("" : "+v"(lane));
    const int w = F.wave;
    if (t0 < KSEL) {
        const int t = t0 + w; unsigned short* selrow = (unsigned short*)(F.ws + WS_SEL) + (size_t)(b * SEQ + t) * 256;
#pragma unroll
        for (int p = 0; p < 4; ++p) { const int j = p * 64 + lane; selrow[j] = (unsigned short)(j <= t ? j : 0xFFFF); }
        return;
    }
    float* rowbuf = (float*)F.lds;
    unsigned char* stage = F.lds + 131072;
    const int p = w & 3, kh = w >> 2, hi = lane >> 5, r = lane & 31;
    const size_t qrow = (size_t)b * SEQ + t0 + 2 * p + (r >> 4);
    bf16x8 a[4];
#pragma unroll
    for (int ks = 0; ks < 4; ++ks) a[ks] = *(const bf16x8*)(iq + qrow * 1024 + (r & 15) * 64 + ks * 16 + 8 * hi);
    float wq[2][8];
#pragma unroll
    for (int q = 0; q < 2; ++q)
#pragma unroll
        for (int i = 0; i < 8; ++i) wq[q][i] = iw[((size_t)b * SEQ + t0 + 2 * p + q) * 16 + (i & 3) + 8 * ((i >> 2) & 1) + 4 * hi];
    const int nchunks = (t0 + 7) / 64 + 1;
    const unsigned char* gsrc = (const unsigned char*)(ik + (size_t)b * SEQ * 64) + F.tid * 16;
    const int skey = F.tid >> 3, sc16 = F.tid & 7, soff = skey * 128 + ((sc16 ^ (skey & 7)) << 4);
    u32x4 sreg = *(const u32x4*)gsrc;
    __syncthreads();
    for (int c = 0; c < nchunks; ++c) {
        unsigned char* sb = stage + (c & 1) * 8192;
        *(u32x4*)(sb + soff) = sreg;
        __syncthreads();
        if (c + 1 < nchunks) sreg = *(const u32x4*)(gsrc + (size_t)(c + 1) * 8192);
        f32x16 d;
#pragma unroll
        for (int i = 0; i < 16; ++i) d[i] = 0.f;
        const int key = kh * 32 + r;
#pragma unroll
        for (int ks = 0; ks < 4; ++ks) { const bf16x8 bf = *(const bf16x8*)(sb + key * 128 + (((ks * 2 + hi) ^ (key & 7)) << 4));
            d = __builtin_amdgcn_mfma_f32_32x32x16_bf16(a[ks], bf, d, 0, 0, 0); }
        float s0 = 0.f, s1 = 0.f;
#pragma unroll
        for (int i = 0; i < 8; ++i) { s0 += wq[0][i] * fmaxf(d[i], 0.f); s1 += wq[1][i] * fmaxf(d[8 + i], 0.f); }
        const float sc = swap32_pair(s0, s1);
        const int kk = kh * 32 + r;
        rowbuf[(2 * p + hi) * 4096 + ((c >> 2) * 64 + kk) * 4 + (c & 3)] = sc;
    }
    __syncthreads();
    indexer_select(F, b, t0 + w, rowbuf + w * 4096, (unsigned*)(F.lds + 147456) + w * 256, (float*)(F.lds + 155648) + w * 64, (int*)(F.lds + 155648 + 2048) + w * 64);
}
__device__ __forceinline__ void phase3_indexer(Frame& F) {
    const int nit = BATCH * (SEQ / 8);
    for (int k = 0;; ++k) {
        const int l = k * F.G + ((k & 1) ? (F.G - 1 - F.bid) : F.bid);
        if (l >= nit) { if (k * F.G >= nit) break; else continue; }
        const int qb = (SEQ / 8 - 1) - (l >> 3), b = l & 7;
        indexer_tile(F, b, qb * 8);
    }
}

__device__ const unsigned char g_bucket[128] = {0, 1, 2, 3, 4, 5, 6, 7, 8, 9, 10, 11, 12, 13, 14, 15, 16, 16, 16, 17, 17, 18, 18, 18, 19, 19, 19, 20, 20, 20, 20, 21, 21, 21, 21, 22, 22, 22, 22, 22, 23, 23, 23, 23, 23, 23, 24, 24, 24, 24, 24, 24, 25, 25, 25, 25, 25, 25, 25, 26, 26, 26, 26, 26, 26, 26, 26, 27, 27, 27, 27, 27, 27, 27, 27, 27, 27, 28, 28, 28, 28, 28, 28, 28, 28, 28, 28, 29, 29, 29, 29, 29, 29, 29, 29, 29, 29, 29, 29, 30, 30, 30, 30, 30, 30, 30, 30, 30, 30, 30, 30, 30, 30, 31, 31, 31, 31, 31, 31, 31, 31, 31, 31, 31, 31, 31, 31, 31};
__device__ __forceinline__ void phase4_attention(Frame& F) {
    const unsigned char* q8 = F.ws + WS_Q8; const unsigned char* k8 = F.ws + WS_K8; const unsigned char* v8 = F.ws + WS_V8;
    const unsigned short* sel = (const unsigned short*)(F.ws + WS_SEL); bf16_t* ao = (bf16_t*)(F.ws + WS_ATTN);
    float* btab = (float*)F.lds;
    __syncthreads();
    for (int i = F.tid; i < 256; i += 512) btab[i] = F.rel_bias[i];
    __syncthreads();
    float* Pl = (float*)(F.lds + 4096 + F.wave * 12288); int* idl = (int*)(Pl + 2048); float* psl = (float*)(idl + 256);
    const bool xmap = (F.G % 8) == 0;
    const int gw = xmap ? (F.bid / 8) * 8 + F.wave : F.bid * 8 + F.wave, NGW = xmap ? F.G : F.G * 8, nrows = xmap ? SEQ : MTOK;
    for (int rr = gw; rr < nrows; rr += NGW) {
        int lane = F.lane; asm volatile("" : "+v"(lane));
        const int row = xmap ? (F.bid & 7) * SEQ + rr : rr;
        const int b = row / SEQ, t = row % SEQ, r = lane & 31, hi = lane >> 5;
#pragma unroll
        for (int p = 0; p < 4; ++p) { idl[p * 64 + lane] = (int)sel[(size_t)row * 256 + p * 64 + lane]; }
        long a0[8], a1[8];
        { u32x4 qa[4];
#pragma unroll
          for (int i = 0; i < 4; ++i) qa[i] = (r < 8) ? *(const u32x4*)(q8 + (size_t)row * 1024 + r * 128 + hi * 64 + i * 16) : (u32x4){0u, 0u, 0u, 0u};
#pragma unroll
          for (int ks = 0; ks < 8; ++ks) { const unsigned lo = qa[ks >> 1][(ks & 1) * 2], hh = qa[ks >> 1][(ks & 1) * 2 + 1]; const long v = (long)(((unsigned long long)hh << 32) | lo);
              a0[ks] = (r < 4) ? v : 0l; a1[ks] = (r >= 4) ? v : 0l; } }
        f32x4 psum = (f32x4){0.f, 0.f, 0.f, 0.f};
#define AT_LOADK(buf, kb) do { const int key_ = idl[(kb) * 32 + r]; const int kc_ = key_ <= t ? key_ : 0; const unsigned char* kr_ = k8 + ((size_t)b * SEQ + kc_) * 256 + hi * 64; \
            _Pragma("unroll") for (int i = 0; i < 4; ++i) { buf[i] = *(const u32x4*)(kr_ + i * 16); buf[4 + i] = *(const u32x4*)(kr_ + 128 + i * 16); } } while (0)
#define AT_QK(buf, kb) do { const int key_ = idl[(kb) * 32 + r]; const bool valid_ = key_ <= t; const int kc_ = valid_ ? key_ : 0; \
            f32x16 d; _Pragma("unroll") for (int i = 0; i < 16; ++i) d[i] = 0.f; \
            _Pragma("unroll") for (int ks = 0; ks < 8; ++ks) { const long bv_ = (long)(((unsigned long long)buf[ks >> 1][(ks & 1) * 2 + 1] << 32) | buf[ks >> 1][(ks & 1) * 2]); d = __builtin_amdgcn_mfma_f32_32x32x16_fp8_fp8(a0[ks], bv_, d, 0, 0, 0); } \
            _Pragma("unroll") for (int ks = 0; ks < 8; ++ks) { const long bv_ = (long)(((unsigned long long)buf[4 + (ks >> 1)][(ks & 1) * 2 + 1] << 32) | buf[4 + (ks >> 1)][(ks & 1) * 2]); d = __builtin_amdgcn_mfma_f32_32x32x16_fp8_fp8(a1[ks], bv_, d, 0, 0, 0); } \
            const int dist_ = t - kc_; const int bkt_ = dist_ < 128 ? (int)g_bucket[dist_] : 31; \
            const f32x4 bias_ = *(const f32x4*)(btab + bkt_ * 8 + 4 * hi); f32x4 e_; \
            _Pragma("unroll") for (int i = 0; i < 4; ++i) e_[i] = valid_ ? __expf(d[i] * 0.08838834764831845f + bias_[i]) : 0.f; \
            psum += e_; *(f32x4*)(Pl + ((kb) * 32 + r) * 8 + 4 * hi) = e_; } while (0)
        {
            u32x4 kA[8], kB[8];
            AT_LOADK(kA, 0);
#pragma unroll 1
            for (int kb = 0; kb < 8; kb += 2) {
                AT_LOADK(kB, kb + 1);
                AT_QK(kA, kb);
                if (kb + 2 < 8) AT_LOADK(kA, kb + 2);
                AT_QK(kB, kb + 1);
            }
        }
#undef AT_LOADK
#undef AT_QK
#pragma unroll
        for (int i = 0; i < 4; ++i) psum[i] = xor16_sum(row_sum16(psum[i]));
        if (r == 0) *(f32x4*)(psl + 4 * hi) = psum;
        const int ks = lane >> 4, g = (lane >> 3) & 1, dc = lane & 7;
        float acc[4][16];
#pragma unroll
        for (int h = 0; h < 4; ++h)
#pragma unroll
            for (int j = 0; j < 16; ++j) acc[h][j] = 0.f;
#define AT_LOADV(buf, it0) do { _Pragma("unroll") for (int u = 0; u < 4; ++u) { const int key_ = idl[((it0) + u) * 4 + ks]; const int kc_ = key_ <= t ? key_ : 0; \
            buf[u] = *(const u32x4*)(v8 + ((size_t)b * SEQ + kc_) * 256 + g * 128 + dc * 16); } } while (0)
#define AT_PV(buf, it0) do { _Pragma("unroll") for (int u = 0; u < 4; ++u) { const int j_ = ((it0) + u) * 4 + ks; const u32x4 w = buf[u]; \
            const f32x4 p = *(const f32x4*)(Pl + j_ * 8 + 4 * g); \
            _Pragma("unroll") for (int dd = 0; dd < 4; ++dd) { const f32x2 lo = __builtin_amdgcn_cvt_pk_f32_fp8((int)w[dd], false), hh_ = __builtin_amdgcn_cvt_pk_f32_fp8((int)w[dd], true); \
                _Pragma("unroll") for (int h = 0; h < 4; ++h) { acc[h][4 * dd] += p[h] * lo.x; acc[h][4 * dd + 1] += p[h] * lo.y; acc[h][4 * dd + 2] += p[h] * hh_.x; acc[h][4 * dd + 3] += p[h] * hh_.y; } } } } while (0)
        {
            u32x4 vA[4], vB[4];
            AT_LOADV(vA, 0);
#pragma unroll 1
            for (int it0 = 0; it0 < 64; it0 += 8) {
                AT_LOADV(vB, it0 + 4);
                AT_PV(vA, it0);
                if (it0 + 8 < 64) AT_LOADV(vA, it0 + 8);
                AT_PV(vB, it0 + 4);
            }
        }
#undef AT_LOADV
#undef AT_PV
#pragma unroll
        for (int h = 0; h < 4; ++h)
#pragma unroll
            for (int j = 0; j < 16; ++j) acc[h][j] = xor32_sum(xor16_sum(acc[h][j]));
#pragma unroll
        for (int h = 0; h < 4; ++h) if (h == ks) { const float inv = 1.0f / psl[4 * g + h];
            bf16_t* op = ao + (size_t)row * 1024 + (4 * g + h) * 128 + dc * 16;
            *(u32x4*)op = pack8((f32x4){acc[h][0], acc[h][1], acc[h][2], acc[h][3]} * inv, (f32x4){acc[h][4], acc[h][5], acc[h][6], acc[h][7]} * inv);
            *(u32x4*)(op + 8) = pack8((f32x4){acc[h][8], acc[h][9], acc[h][10], acc[h][11]} * inv, (f32x4){acc[h][12], acc[h][13], acc[h][14], acc[h][15]} * inv); }
    }
}

__device__ __forceinline__ float dot16f8(u32x4 w, const float* h) {
    float s = 0.f;
#pragma unroll
    for (int d = 0; d < 4; ++d) { const f32x2 lo = __builtin_amdgcn_cvt_pk_f32_fp8((int)w[d], false), hi = __builtin_amdgcn_cvt_pk_f32_fp8((int)w[d], true);
        s += lo.x * h[4 * d] + lo.y * h[4 * d + 1] + hi.x * h[4 * d + 2] + hi.y * h[4 * d + 3]; }
    return s;
}
__device__ __forceinline__ void fma16f8(u32x4 w, float cf, float* acc) {
#pragma unroll
    for (int d = 0; d < 4; ++d) { const f32x2 lo = __builtin_amdgcn_cvt_pk_f32_fp8((int)w[d], false), hi = __builtin_amdgcn_cvt_pk_f32_fp8((int)w[d], true);
        acc[4 * d] += cf * lo.x; acc[4 * d + 1] += cf * lo.y; acc[4 * d + 2] += cf * hi.x; acc[4 * d + 3] += cf * hi.y; }
}
__device__ __forceinline__ float gelu_erf(float x) { return 0.5f * x * (1.0f + erff(x * 0.70710678118654752f)); }
__device__ __forceinline__ void phase10_peer(Frame& F) {
    const float* sub = (const float*)(F.ws + WS_SUB); const bf16_t* h2 = (const bf16_t*)(F.ws + WS_H2);
    const unsigned char* pu = F.ws + WS_PU; unsigned* pairs = (unsigned*)(F.ws + WS_PAIRS);
    int* elist = (int*)(F.lds + F.wave * 2048); float* gl = (float*)(elist + 128); float* cl = gl + 128;
    const int gw = F.bid * 8 + F.wave, NGW = F.G * 8;
    const float NINF = -__builtin_huge_valf();
    for (int row = gw; row < MTOK; row += NGW) {
        int lane = F.lane; asm volatile("" : "+v"(lane));
        const unsigned long long lt_mask = (1ull << lane) - 1ull;
        const float* srow = sub + (size_t)row * 2048;
#pragma unroll 1
        for (int h = 0; h < 8; ++h) {
            const f32x4 v4 = *(const f32x4*)(srow + h * 256 + lane * 4);
            float v0 = v4[0], v1 = v4[1], v2 = v4[2], v3 = v4[3];
            float myval = NINF; int myidx = 0;
            const int half = lane >> 5, lh = lane & 31;
#pragma unroll 1
            for (int r = 0; r < 16; ++r) {
                float lm = v0; int li = 0;
                if (v1 > lm) { lm = v1; li = 1; } if (v2 > lm) { lm = v2; li = 2; } if (v3 > lm) { lm = v3; li = 3; }
                float gm = lm;
                gm = xor16_max(row_max16(gm));
                const unsigned long long bal = __ballot(lm == gm);
                const unsigned hm = (unsigned)(bal >> (32 * half));
                const int wl = (__ffs((int)hm) - 1) + 32 * half;
                const int widx = __shfl(li, wl) + 4 * (wl & 31);
                if (lh == r) { myval = gm; myidx = widx; }
                if (lane == wl) { if (li == 0) v0 = NINF; else if (li == 1) v1 = NINF; else if (li == 2) v2 = NINF; else v3 = NINF; }
            }
            int ca, cb; const int c = lane;
            if (c < 16) { ca = 0; cb = c; } else if (c < 24) { ca = 1; cb = c - 16; } else if (c < 29) { ca = 2; cb = c - 24; } else if (c < 33) { ca = 3; cb = c - 29; }
            else if (c < 36) { ca = 4; cb = c - 33; } else if (c < 38) { ca = 5; cb = c - 36; } else if (c < 40) { ca = 6; cb = c - 38; } else if (c < 42) { ca = 7; cb = c - 40; }
            else { ca = (c - 42 + 8) & 15; cb = 0; }
            float s = __shfl(myval, ca) + __shfl(myval, 32 + cb);
            const int eid = __shfl(myidx, ca) * 128 + __shfl(myidx, 32 + cb);
            if (c >= 50) s = NINF;
            int rank = 0;
#pragma unroll 10
            for (int j = 0; j < 50; ++j) { const float sj = __shfl(s, j); rank += (sj > s || (sj == s && j < c)) ? 1 : 0; }
            const bool selq = (c < 50) && (rank < 16);
            const float smax = __shfl(s, 0);
            const float e = selq ? __expf(s - smax) : 0.f;
            const float esum = wave_sum(e);
            const unsigned long long ms = __ballot(selq);
            const int pos = __popcll(ms & lt_mask);
            if (selq) { elist[h * 16 + pos] = eid; gl[h * 16 + pos] = e / esum; }
        }
        asm volatile("" : "+v"(lane));
        float hf[32];
#pragma unroll
        for (int i = 0; i < 2; ++i)
#pragma unroll
            for (int q = 0; q < 2; ++q) { f32x4 a, c; unpack8(*(const u32x4*)(h2 + (size_t)row * 2048 + i * 1024 + lane * 16 + q * 8), a, c);
#pragma unroll
                for (int j = 0; j < 4; ++j) { hf[i * 16 + q * 8 + j] = a[j]; hf[i * 16 + q * 8 + 4 + j] = c[j]; } }
#pragma unroll 1
        for (int j0 = 0; j0 < 128; j0 += 8) {
            u32x4 w[8][2];
#pragma unroll
            for (int jj = 0; jj < 8; ++jj) { const int e = __builtin_amdgcn_readfirstlane(elist[j0 + jj]); const unsigned char* ur = pu + (size_t)e * 2048 + lane * 16;
                w[jj][0] = *(const u32x4*)ur; w[jj][1] = *(const u32x4*)(ur + 1024); }
            float p[8];
#pragma unroll
            for (int jj = 0; jj < 8; ++jj) { p[jj] = dot16f8(w[jj][0], hf) + dot16f8(w[jj][1], hf + 16); __builtin_amdgcn_sched_barrier(0); }
#pragma unroll
            for (int i = 0; i < 4; ++i) p[i] = swap32_pair(p[i], p[i + 4]);
#pragma unroll
            for (int i = 0; i < 2; ++i) p[i] = swap16_pair(p[i], p[i + 2]);
            const bool b3 = (lane & 8) != 0;
            { const float snd = b3 ? p[0] : p[1], kp = b3 ? p[1] : p[0]; p[0] = kp + dpp_f<DPP_ROR8>(snd); }
            float tot = p[0]; tot += dpp_f<DPP_XOR1>(tot); tot += dpp_f<DPP_XOR2>(tot); tot += dpp_f<DPP_HMIRROR>(tot);
            if ((lane & 7) == 0) cl[j0 + (lane >> 3)] = tot;
        }
        { const float a0 = cl[lane] * (1.0f / 64.0f), a1 = cl[64 + lane] * (1.0f / 64.0f);
          const float c0 = gelu_erf(a0) * gl[lane], c1 = gelu_erf(a1) * gl[64 + lane];
          unsigned* pl = pairs + ((size_t)(row >> 6) * 128) * 64 + (row & 63);
          pl[(size_t)lane * 64] = (cvt_pk_bf16(0.f, c0) & 0xffff0000u) | (unsigned)elist[lane];
          pl[(size_t)(64 + lane) * 64] = (cvt_pk_bf16(0.f, c1) & 0xffff0000u) | (unsigned)elist[64 + lane]; }
    }
}

__device__ __forceinline__ void phase11_peer_v(Frame& F, float* dst) {
    const unsigned* pairs = (const unsigned*)(F.ws + WS_PAIRS); const float* mf = (const float*)(F.ws + WS_MODF);
    unsigned long long* vs = (unsigned long long*)F.lds;
    for (int c = F.bid; c < DM / 8; c += F.G) {
        __syncthreads();
        { const u32x4* src = (const u32x4*)(F.ws + WS_PV + (size_t)c * NEXP * 8); u32x4* dst = (u32x4*)F.lds;
#pragma unroll 4
          for (int i = F.tid; i < NEXP * 8 / 16; i += 512) dst[i] = src[i]; }
        __syncthreads();
        for (int tile = F.wave; tile < MTOK / 64; tile += 8) {
            int lane = F.lane; asm volatile("" : "+v"(lane));
            const unsigned* pp = pairs + (size_t)tile * 128 * 64 + lane;
            f32x2 acc[4];
#pragma unroll
            for (int i = 0; i < 4; ++i) acc[i] = (f32x2){0.f, 0.f};
#define P11_LOAD(dst, j0) do { _Pragma("unroll") for (int jj = 0; jj < 16; ++jj) dst[jj] = pp[((j0) + jj) * 64]; } while (0)
#define P11_COMP(src) do { _Pragma("unroll") for (int jj = 0; jj < 16; ++jj) { const unsigned long long v = vs[src[jj] & 0x3FFFu]; const float cf = __uint_as_float(src[jj] & 0xffff0000u); \
                    const int lo = (int)(unsigned)v, hi = (int)(unsigned)(v >> 32); \
                    acc[0] += __builtin_amdgcn_cvt_pk_f32_fp8(lo, false) * cf; acc[1] += __builtin_amdgcn_cvt_pk_f32_fp8(lo, true) * cf; \
                    acc[2] += __builtin_amdgcn_cvt_pk_f32_fp8(hi, false) * cf; acc[3] += __builtin_amdgcn_cvt_pk_f32_fp8(hi, true) * cf; } } while (0)
            unsigned pa[16], pb[16];
            P11_LOAD(pa, 0);
#pragma unroll 1
            for (int j0 = 0; j0 < 128; j0 += 32) {
                P11_LOAD(pb, j0 + 16);
                P11_COMP(pa);
                if (j0 + 32 < 128) P11_LOAD(pa, j0 + 32);
                P11_COMP(pb);
            }
#undef P11_LOAD
#undef P11_COMP
            const int row = tile * 64 + lane;
            const float* gt2 = mf + (size_t)(tile / (SEQ / 64)) * 12288 + 10240 + c * 8;
            const float* ip = F.out + (size_t)row * 2048 + c * 8; float* op = dst + (size_t)row * 2048 + c * 8;
            const f32x4 x0 = *(const f32x4*)ip, x1 = *(const f32x4*)(ip + 4), g0 = *(const f32x4*)gt2 * 0.25f, g1 = *(const f32x4*)(gt2 + 4) * 0.25f;
            *(f32x4*)op = x0 + g0 * (f32x4){acc[0].x, acc[0].y, acc[1].x, acc[1].y};
            *(f32x4*)(op + 4) = x1 + g1 * (f32x4){acc[2].x, acc[2].y, acc[3].x, acc[3].y};
        }
    }
}

__global__ void __launch_bounds__(512, 2) fwd_kernel(Args args) {
    extern __shared__ __attribute__((aligned(16))) unsigned char lds[];
    Frame F;
    F.lds = lds; F.ws = args.ws; F.tid = threadIdx.x; F.lane = F.tid & 63; F.wave = __builtin_amdgcn_readfirstlane(F.tid >> 6); F.G = gridDim.x; F.bid = blockIdx.x;
    F.x = args.in[0]; F.c = args.in[1]; F.w_ada = args.in[2]; F.b_ada = args.in[3]; F.g1 = args.in[4]; F.g2 = args.in[5]; F.w_in = args.in[6]; F.g_q = args.in[7]; F.g_k = args.in[8];
    F.rel_bias = args.in[9]; F.pool_w = args.in[10]; F.pool_scale = args.in[11]; F.w_ab = args.in[12]; F.w_pb = args.in[13]; F.w_out = args.in[14]; F.w_pq = args.in[15];
    F.peer_keys = args.in[16]; F.peer_u = args.in[17]; F.peer_v = args.in[18]; F.out = args.out;
    LAS unsigned char* ldsl = (LAS unsigned char*)lds;
    volatile LAS unsigned* misc = (volatile LAS unsigned*)(ldsl + MISC_OFF);
    if (F.tid < 4) misc[F.tid] = 0u;
    __syncthreads();
    unsigned* barw = (unsigned*)(args.ws + WS_CTL) + (size_t)args.li * XCD_BAR_WORDS;
    XcdBarrier bar; bar.bar = barw; bar.x = 0; bar.st = misc;
    const int lo = args.ph_lo, hi = args.ph_hi;
    if (hi - lo > 1) bar = xcd_barrier_post(barw, misc);
#define IN(k) (lo <= (k) && (k) < hi)
#define SEAM(k) do { if (IN(k) && IN((k) + 1)) xcd_barrier(bar); } while (0)
    bf16_t* R0 = (bf16_t*)(F.ws + WS_R0);

#define PH2_BODY { \
        pg8::Gemm g{R0, (const bf16_t*)(F.ws + WS_WIN), MTOK, INWP, DM, DM, 0}; pg8::StaticOrder S; S.init(MTOK, INWP, F.G, F.bid); \
        EpiInproj E{(bf16_t*)(F.ws + WS_QN), (bf16_t*)(F.ws + WS_KN), (bf16_t*)(F.ws + WS_V), (bf16_t*)(F.ws + WS_IQ), (bf16_t*)(F.ws + WS_IK), (bf16_t*)(F.ws + WS_PL), \
                    (bf16_t*)(F.ws + WS_GA), (bf16_t*)(F.ws + WS_GP), (float*)(F.ws + WS_IW)}; \
        pg8::gemm_phase<EpiInproj>(ldsl, g, S, E); }
#define PH3_BODY { phase3_pooled(F); phase3_indexer(F); __syncthreads(); }
#define PH4_BODY { \
        phase4_attention(F); \
        __syncthreads(); \
        pg8::Gemm g{(const bf16_t*)(F.ws + WS_POOLED), (const bf16_t*)(F.ws + WS_POOLW), MTOK, PW, 256, 1024, 256}; pg8::StaticOrder S; S.init(MTOK, PW, F.G, F.bid); \
        EpiBf16Scale E{(bf16_t*)(F.ws + WS_POOL2), 1024, F.pool_scale}; \
        pg8::gemm_phase<EpiBf16Scale>(ldsl, g, S, E); }
#define PH5_BODY { \
        { pg8::Gemm g{(const bf16_t*)(F.ws + WS_ATTN), (const bf16_t*)(F.ws + WS_WAB), MTOK, DM, 1024, 1024, 0}; pg8::StaticOrder S; S.init(MTOK, DM, F.G, F.bid); \
          EpiGate<false> E{R0, (const bf16_t*)(F.ws + WS_GA)}; pg8::gemm_phase<EpiGate<false>>(ldsl, g, S, E); } \
        { pg8::Gemm g{(const bf16_t*)(F.ws + WS_POOL2), (const bf16_t*)(F.ws + WS_WPB), MTOK, DM, 1024, 1024, 0}; pg8::StaticOrder S; S.init(MTOK, DM, F.G, F.bid); \
          EpiGate<true> E{R0, (const bf16_t*)(F.ws + WS_GP)}; pg8::gemm_phase<EpiGate<true>>(ldsl, g, S, E); } }
#define PH6_BODY { \
        pg8::Gemm g{R0, (const bf16_t*)(F.ws + WS_WOUT), MTOK, DM, DM, DM, 0}; pg8::StaticOrder S; S.init(MTOK, DM, F.G, F.bid); \
        EpiResid E{F.x, F.out, (const float*)(F.ws + WS_MODF) + 4096}; pg8::gemm_phase<EpiResid>(ldsl, g, S, E); }
#define PH8_BODY { \
        pg8::Gemm g{(const bf16_t*)(F.ws + WS_H2), (const bf16_t*)(F.ws + WS_WPQ), MTOK, DM, DM, DM, 0}; pg8::StaticOrder S; S.init(MTOK, DM, F.G, F.bid); \
        EpiBf16Scale E{R0, 2048, nullptr}; pg8::gemm_phase<EpiBf16Scale>(ldsl, g, S, E); }
#define PH9_BODY { \
        pg8::Gemm g{R0, (const bf16_t*)(F.ws + WS_KEYSBD), MTOK, DM, 256, DM, 256}; pg8::StaticOrder S; S.init(MTOK, DM, F.G, F.bid); \
        EpiF32 E{(float*)(F.ws + WS_SUB), 2048}; pg8::gemm_phase<EpiF32>(ldsl, g, S, E); }
#define REP(k) if constexpr (((PROBE_REP) >> (k)) & 1)

    if (IN(0)) { phase0_prep(F); REP(0) { __syncthreads(); phase0_prep(F); } }
    SEAM(0);
    if (IN(1)) { phase_modnorm<true>(F, F.x, F.g1, 0, 2048, R0); REP(1) { phase_modnorm<true>(F, F.x, F.g1, 0, 2048, R0); } }
    SEAM(1);
    if (IN(2)) { PH2_BODY REP(2) PH2_BODY }
    SEAM(2);
    if (IN(3)) { phase3_qknorm(F); PH3_BODY REP(3) PH3_BODY }
    SEAM(3);
    if (IN(4)) { PH4_BODY REP(4) PH4_BODY }
    SEAM(4);
    if (IN(5)) { PH5_BODY REP(5) PH5_BODY }
    SEAM(5);
    if (IN(6)) { PH6_BODY REP(6) PH6_BODY }
    SEAM(6);
    if (IN(7)) { phase_modnorm<false>(F, F.out, F.g2, 6144, 8192, (bf16_t*)(F.ws + WS_H2)); REP(7) { phase_modnorm<false>(F, F.out, F.g2, 6144, 8192, (bf16_t*)(F.ws + WS_H2)); } }
    SEAM(7);
    if (IN(8)) { PH8_BODY REP(8) PH8_BODY }
    SEAM(8);
    if (IN(9)) { PH9_BODY REP(9) PH9_BODY }
    SEAM(9);
    if (IN(10)) { phase10_peer(F); REP(10) phase10_peer(F); }
    SEAM(10);
    if (IN(11)) { REP(11) { phase11_peer_v(F, (float*)(F.ws + WS_SUB)); } phase11_peer_v(F, F.out); }
#undef IN
#undef SEAM
}

extern "C" void kernel_launch(void* const* d_in, const int* in_sizes, int n_in, void* d_out, int out_size, void* d_ws, size_t ws_size, hipStream_t stream) {
    static int grid = 0;
    if (grid == 0) {
        if (n_in != 19 || out_size != MTOK * DM || ws_size < WS_END) { fprintf(stderr, "kernel_launch: unexpected shapes (n_in %d out %d ws %zu)\n", n_in, out_size, ws_size); grid = -1; return; }
        int dev = 0, cus = 0, per_cu = 0;
        if (hipGetDevice(&dev) != hipSuccess || hipDeviceGetAttribute(&cus, hipDeviceAttributeMultiprocessorCount, dev) != hipSuccess) { grid = -1; return; }
        if (hipFuncSetAttribute((const void*)fwd_kernel, hipFuncAttributeMaxDynamicSharedMemorySize, LDS_BYTES) != hipSuccess) { fprintf(stderr, "kernel_launch: hipFuncSetAttribute failed\n"); grid = -1; return; }
        if (hipOccupancyMaxActiveBlocksPerMultiprocessor(&per_cu, (const void*)fwd_kernel, 512, LDS_BYTES) != hipSuccess || per_cu < 1) { fprintf(stderr, "kernel_launch: occupancy query says %d\n", per_cu); }
        (void)hipGetLastError();
        grid = cus;
    }
    if (grid < 0) return;
    (void)in_sizes;
    if (hipMemsetAsync((char*)d_ws + WS_CTL, 0, CTL_ZERO_BYTES, stream) != hipSuccess) return;
    Args a{};
    for (int i = 0; i < 19; ++i) a.in[i] = (const float*)d_in[i];
    a.out = (float*)d_out; a.ws = (unsigned char*)d_ws;
#if MK_PER_PHASE
    for (int p = 0; p < NPHASE; ++p) { a.ph_lo = p; a.ph_hi = p + 1; a.li = p; hipLaunchKernelGGL(fwd_kernel, dim3(grid), dim3(512), LDS_BYTES, stream, a); }
#else
    a.ph_lo = 0; a.ph_hi = NPHASE; a.li = 0;
    hipLaunchKernelGGL(fwd_kernel, dim3(grid), dim3(512), LDS_BYTES, stream, a);
#endif
}
```

```cpp
#include <hip/hip_runtime.h>
#include <cstdio>
#include <cstdint>

#ifndef MK_PER_PHASE
#define MK_PER_PHASE 0
#endif

#ifndef PROBE_REP
#define PROBE_REP 0
#endif
#ifndef PROBE_SEL
#define PROBE_SEL 0
#endif
#ifndef PROBE_P11X
#define PROBE_P11X 0
#endif
#define LAS __attribute__((address_space(3)))
typedef unsigned short bf16_t;
typedef short bf16x8 __attribute__((ext_vector_type(8)));
typedef float f32x4 __attribute__((ext_vector_type(4)));
typedef float f32x2 __attribute__((ext_vector_type(2)));
typedef unsigned u32x4 __attribute__((ext_vector_type(4)));
typedef unsigned u32x2 __attribute__((ext_vector_type(2)));

constexpr int BATCH = 8, SEQ = 4096, DM = 2048, MTOK = BATCH * SEQ;
constexpr int NHEAD = 8, HDIM = 128, AW = 1024, KVW = 256, IHEADS = 16, IDIM = 64, KSEL = 256;
constexpr int PW = 1024, PHEADS = 8, NEXP = 16384;
constexpr int INW = 7760, INWP = 7936;
constexpr float EPS = 1e-6f;
constexpr int NPHASE = 12;

constexpr size_t MiB = 1u << 20;
constexpr size_t WS_CTL = 0, CTL_ZERO_BYTES = 256 * 1024;
constexpr size_t WS_MODP = 2 * MiB;
constexpr size_t WS_MODF = 4 * MiB;
constexpr size_t WS_POOLW = 5 * MiB;
constexpr size_t WS_KEYSBD = 6 * MiB;
constexpr size_t WS_WIN = 8 * MiB;
constexpr size_t WS_WAB = 40 * MiB, WS_WPB = 44 * MiB, WS_WOUT = 48 * MiB, WS_WPQ = 56 * MiB;
constexpr size_t WS_PU = 64 * MiB, WS_PV = 128 * MiB;
constexpr size_t WS_R0 = 192 * MiB;
constexpr size_t WS_GA = 320 * MiB, WS_GP = 448 * MiB;
constexpr size_t WS_SUB = 320 * MiB;
constexpr size_t WS_QN = 576 * MiB;
constexpr size_t WS_IQ = 640 * MiB;
constexpr size_t WS_PL = 704 * MiB;
constexpr size_t WS_KN = 768 * MiB, WS_V = 784 * MiB;
constexpr size_t WS_IK = 800 * MiB;
constexpr size_t WS_IW = 804 * MiB;
constexpr size_t WS_SEL = 806 * MiB;
constexpr size_t WS_POOLED = 822 * MiB;
constexpr size_t WS_H2 = 886 * MiB;
constexpr size_t WS_END = 1014 * MiB;
constexpr size_t WS_Q8 = WS_H2, WS_K8 = WS_H2 + 32 * MiB, WS_V8 = WS_H2 + 40 * MiB;
constexpr size_t WS_ATTN = WS_IQ, WS_POOL2 = WS_PL, WS_PAIRS = WS_QN, WS_WLS = WS_QN + 32 * MiB;

constexpr int LDS_BYTES = 160 * 1024;
constexpr int MISC_OFF = 159 * 1024;

__device__ __forceinline__ unsigned cvt_pk_bf16(float lo, float hi) { unsigned r; asm volatile("v_cvt_pk_bf16_f32 %0, %1, %2" : "=v"(r) : "v"(lo), "v"(hi)); return r; }
__device__ __forceinline__ float bf_lo(unsigned w) { return __uint_as_float(w << 16); }
__device__ __forceinline__ float bf_hi(unsigned w) { return __uint_as_float(w & 0xffff0000u); }
template <int CTRL> __device__ __forceinline__ float dpp_f(float x) { return __int_as_float(__builtin_amdgcn_update_dpp(0, __float_as_int(x), CTRL, 0xF, 0xF, true)); }
#define DPP_XOR1 0xB1
#define DPP_XOR2 0x4E
#define DPP_HMIRROR 0x141
#define DPP_MIRROR 0x140
#define DPP_ROR8 0x128
__device__ __forceinline__ float xor16_sum(float x) { const auto r = __builtin_amdgcn_permlane16_swap(__float_as_uint(x), __float_as_uint(x), false, false); return __uint_as_float(r[0]) + __uint_as_float(r[1]); }
__device__ __forceinline__ float xor32_sum(float x) { const auto r = __builtin_amdgcn_permlane32_swap(__float_as_uint(x), __float_as_uint(x), false, false); return __uint_as_float(r[0]) + __uint_as_float(r[1]); }
__device__ __forceinline__ float xor16_max(float x) { const auto r = __builtin_amdgcn_permlane16_swap(__float_as_uint(x), __float_as_uint(x), false, false); return fmaxf(__uint_as_float(r[0]), __uint_as_float(r[1])); }
__device__ __forceinline__ float swap32_pair(float a, float b) { const auto r = __builtin_amdgcn_permlane32_swap(__float_as_uint(a), __float_as_uint(b), false, false); return __uint_as_float(r[0]) + __uint_as_float(r[1]); }
__device__ __forceinline__ float swap16_pair(float a, float b) { const auto r = __builtin_amdgcn_permlane16_swap(__float_as_uint(a), __float_as_uint(b), false, false); return __uint_as_float(r[0]) + __uint_as_float(r[1]); }
__device__ __forceinline__ float row_sum16(float v) { v += dpp_f<DPP_XOR1>(v); v += dpp_f<DPP_XOR2>(v); v += dpp_f<DPP_HMIRROR>(v); v += dpp_f<DPP_MIRROR>(v); return v; }
__device__ __forceinline__ float row_max16(float v) { v = fmaxf(v, dpp_f<DPP_XOR1>(v)); v = fmaxf(v, dpp_f<DPP_XOR2>(v)); v = fmaxf(v, dpp_f<DPP_HMIRROR>(v)); v = fmaxf(v, dpp_f<DPP_MIRROR>(v)); return v; }
__device__ __forceinline__ float wave_sum(float v) { return xor32_sum(xor16_sum(row_sum16(v))); }
__device__ __forceinline__ float sigmoidf_(float x) { return __builtin_amdgcn_rcpf(1.0f + __expf(-x)); }
__device__ __forceinline__ float dot8(u32x4 w, const float* h) {
    return bf_lo(w.x) * h[0] + bf_hi(w.x) * h[1] + bf_lo(w.y) * h[2] + bf_hi(w.y) * h[3] + bf_lo(w.z) * h[4] + bf_hi(w.z) * h[5] + bf_lo(w.w) * h[6] + bf_hi(w.w) * h[7];
}

#define XB_TMO      128
#define XB_XCNT(j)  (256  + 64 * (j))
#define XB_XSUB(j)  (1280 + 64 * (j))
#define XB_XGEN(j)  (2304 + 64 * (j))
#define XB_TOP      3328
#define XB_TOPGEN   3392
#define XCD_BAR_WORDS 3456
#define XB_SPIN_CAP (1u << 18)

__device__ __forceinline__ unsigned xb_ld(unsigned* p)              { return __hip_atomic_load(p, __ATOMIC_RELAXED, __HIP_MEMORY_SCOPE_AGENT); }
__device__ __forceinline__ unsigned xb_add(unsigned* p, unsigned v) { return __hip_atomic_fetch_add(p, v, __ATOMIC_RELAXED, __HIP_MEMORY_SCOPE_AGENT); }
__device__ __forceinline__ unsigned xb_xcc_id() { return (unsigned)__builtin_amdgcn_s_getreg((3 << 11) | 20) & 0xFu; }
#define XB_SPIN(cond, bar) do { unsigned _sp = 0; while (cond) { __builtin_amdgcn_s_sleep(1); \
    if ((++_sp & 255u) == 0u) { if (xb_ld(&(bar)[XB_TMO])) break; if (_sp > XB_SPIN_CAP) { atomicAdd(&(bar)[XB_TMO], 1u); break; } } } } while (0)

struct XcdBarrier { unsigned* bar; unsigned x; volatile LAS unsigned* st; };

__device__ __forceinline__ XcdBarrier xcd_barrier_post(unsigned* bar, volatile LAS unsigned* st) {
    XcdBarrier b; b.bar = bar; b.x = xb_xcc_id(); b.st = st;
    if (threadIdx.x == 0) (void)xb_add(&bar[XB_XCNT(b.x)], 1u);
    return b;
}
__device__ __forceinline__ void xcd_barrier_complete(unsigned* bar, unsigned x, unsigned& nloc, unsigned& nx) {
    const unsigned G = gridDim.x * gridDim.y * gridDim.z;
    unsigned sum, cnt, mine, sp = 0u;
    for (;;) {
        sum = 0u; cnt = 0u; mine = 0u;
#pragma unroll
        for (unsigned j = 0; j < 16; ++j) { const unsigned c = xb_ld(&bar[XB_XCNT(j)]); sum += c; cnt += (c > 0u) ? 1u : 0u; mine = (j == x) ? c : mine; }
        if (sum == G) break;
        __builtin_amdgcn_s_sleep(1);
        if ((++sp & 255u) == 0u) { if (xb_ld(&bar[XB_TMO])) break; if (sp > XB_SPIN_CAP) { atomicAdd(&bar[XB_TMO], 1u); break; } }
    }
    nloc = mine > 0u ? mine : 1u; nx = cnt > 0u ? cnt : 1u;
}
__device__ __forceinline__ void xcd_barrier(const XcdBarrier& b) {
    asm volatile("s_waitcnt vmcnt(0)" ::: "memory");
    __syncthreads();
    if (threadIdx.x == 0) {
        unsigned* bar = b.bar;
        __builtin_amdgcn_s_waitcnt(0);
        unsigned nloc = b.st[0], nx = b.st[1];
        if (nloc == 0u) { xcd_barrier_complete(bar, b.x, nloc, nx); b.st[0] = nloc; b.st[1] = nx; }
        const unsigned old = xb_add(&bar[XB_XSUB(b.x)], 1u);
        const unsigned gen = old / nloc;
        if (old + 1u == (gen + 1u) * nloc) {
            __builtin_amdgcn_fence(__ATOMIC_RELEASE, "agent");
            asm volatile("s_waitcnt vmcnt(0)" ::: "memory");
            const unsigned og = xb_add(&bar[XB_TOP], 1u);
            const unsigned tg = og / nx;
            if (og + 1u == (tg + 1u) * nx) xb_add(&bar[XB_TOPGEN], 1u);
            else XB_SPIN(xb_ld(&bar[XB_TOPGEN]) == tg, bar);
            __builtin_amdgcn_fence(__ATOMIC_ACQUIRE, "agent");
            xb_add(&bar[XB_XGEN(b.x)], 1u);
            asm volatile("s_waitcnt vmcnt(0)" ::: "memory");
        } else {
            XB_SPIN(xb_ld(&bar[XB_XGEN(b.x)]) == gen, bar);
            __builtin_amdgcn_fence(__ATOMIC_ACQUIRE, "agent");
            asm volatile("s_waitcnt vmcnt(0)" ::: "memory");
        }
    }
    __syncthreads();
}

namespace pg8 {
constexpr int BM = 256, BK = 64, HALF = 128, HTB = HALF * BK * 2, STAGE_BYTES = 8 * HTB, NXCD = 8, WGM = 8;
__device__ __forceinline__ int lds_byte(int r, int c) { const int st = (r >> 4) * 2 + (c >> 5), rr = r & 15, cc = c & 31, ob = rr * 64 + cc * 2; return st * 1024 + (ob ^ (((ob >> 9) & 1) << 5)); }
__device__ __forceinline__ void stage_rc(int b, int& R, int& C) { const int st = b / 1024, sb = b % 1024, swz = sb ^ (((sb >> 9) & 1) << 5); R = (st >> 1) * 16 + swz / 64; C = (st & 1) * 32 + (swz % 64) / 2; }
__device__ __forceinline__ int perm32(int rho) { const int n = rho >> 4, i = rho & 15; return 8 * (i >> 2) + 4 * n + (i & 3); }

struct Unit { int pm, pn; };
struct Gemm { const bf16_t* A; const bf16_t* Bt; int M, N, K, lda, a_pn_off; };

struct StaticOrder {
    int nM, nN, nwg, G, c;
    __device__ void init(int M, int N, int G_, int c_) { nM = M / BM; nN = N / BM; nwg = nM * nN; G = G_; c = c_; }
    __device__ bool next(int i, Unit& u) const {
        const long L = (long)i * G + c; if (L >= nwg) return false;
        int wgid = (int)L; { const int q = nwg / NXCD, r = nwg % NXCD, xcd = wgid % NXCD, off = wgid / NXCD; wgid = (xcd < r ? xcd * (q + 1) : r * (q + 1) + (xcd - r) * q) + off; }
        const int nig = WGM * nN, gid = wgid / nig, fm = gid * WGM, gsz = (nM - fm) < WGM ? (nM - fm) : WGM;
        u.pm = fm + ((wgid % nig) % gsz); u.pn = (wgid % nig) / gsz; return true;
    }
};

template <class Epi>
__device__ __forceinline__ void gemm_phase(LAS unsigned char* lds, const Gemm g, const StaticOrder& S, const Epi& E) {
    const int tid = threadIdx.x, wid = __builtin_amdgcn_readfirstlane(tid >> 6), lane = tid & 63, wr = wid >> 2, wc = wid & 3, fr = lane & 15, fq = lane >> 4;
    const int K = g.K, nt = K / BK, lda = g.lda;
    unsigned voffA[2], voffB[2];
#pragma unroll
    for (int i = 0; i < 2; ++i) { int R, C; stage_rc(tid * 16 + i * 8192, R, C); const int Rb = Epi::PERM ? ((R & ~31) + perm32(R & 31)) : R;
        voffA[i] = (unsigned)(R * lda + C) * 2u; voffB[i] = (unsigned)(Rb * K + C) * 2u; }
    const size_t kstep = (size_t)(BK * 2);
    const size_t hsA = (size_t)HALF * lda * 2, hsB = (size_t)HALF * K * 2;
    const size_t tsA = 2 * hsA, tsB = 2 * hsB;
    const unsigned ldsw = (unsigned)wid * 1024u;
    const int aoff = lds_byte(wr * 64 + fr, fq * 8), boff = lds_byte(wc * 32 + fr, fq * 8);
#define PG8_SA(b, h) (((b) * 2 + (h)) * HTB)
#define PG8_SB(b, h) ((4 + (b) * 2 + (h)) * HTB)
#define PG8_STAGE(bufoff, gbase, voff) do { _Pragma("unroll") for (int _i = 0; _i < 2; ++_i) \
        __builtin_amdgcn_global_load_lds((const unsigned*)((const char*)(gbase) + (voff)[_i]), (LAS unsigned*)(lds + (bufoff) + ldsw + _i * 8192), 16, 0, 0); } while (0)
#define PG8_LDA(dst, b, h) do { _Pragma("unroll") for (int m = 0; m < 4; ++m) _Pragma("unroll") for (int k = 0; k < 2; ++k) dst[m][k] = *(const LAS bf16x8*)(lds + PG8_SA(b, h) + aoff + m * 2048 + k * 1024); } while (0)
#define PG8_LDB(dst, b, h) do { _Pragma("unroll") for (int n = 0; n < 2; ++n) _Pragma("unroll") for (int k = 0; k < 2; ++k) dst[n][k] = *(const LAS bf16x8*)(lds + PG8_SB(b, h) + boff + n * 2048 + k * 1024); } while (0)
#define PG8_MMA(ai, bj, At, Bt) do { __builtin_amdgcn_s_setprio(1); _Pragma("unroll") for (int m = 0; m < 4; ++m) _Pragma("unroll") for (int n = 0; n < 2; ++n) _Pragma("unroll") for (int k = 0; k < 2; ++k) \
        acc[ai][bj][m][n] = __builtin_amdgcn_mfma_f32_16x16x32_bf16(Bt[n][k], At[m][k], acc[ai][bj][m][n], 0, 0, 0); __builtin_amdgcn_s_setprio(0); } while (0)
#define PG8_WAIT_V(n) asm volatile("s_waitcnt vmcnt(" #n ")" ::: "memory")
#define PG8_WAIT_L(n) asm volatile("s_waitcnt lgkmcnt(" #n ")" ::: "memory")
#define PG8_BAR __builtin_amdgcn_s_barrier()
#define PG8_SCHED __builtin_amdgcn_sched_barrier(0)
    Unit cur, nxt; int ui = 0;
    if (!S.next(0, cur)) return;
    f32x4 acc[2][2][4][2];
#pragma unroll
    for (int a = 0; a < 2; ++a)
#pragma unroll
        for (int b = 0; b < 2; ++b)
#pragma unroll
            for (int m = 0; m < 4; ++m)
#pragma unroll
                for (int n = 0; n < 2; ++n) acc[a][b][m][n] = (f32x4){0.f, 0.f, 0.f, 0.f};
    bf16x8 At[4][2], B0[2][2], B1[2][2];
    const char* cA = (const char*)g.A + (size_t)cur.pm * tsA + (size_t)cur.pn * g.a_pn_off * 2; const char* cB = (const char*)g.Bt + (size_t)cur.pn * tsB;
    PG8_STAGE(PG8_SB(0, 0), cB, voffB); PG8_STAGE(PG8_SB(0, 1), cB + hsB, voffB); PG8_STAGE(PG8_SA(0, 0), cA, voffA); PG8_STAGE(PG8_SA(0, 1), cA + hsA, voffA);
    if (wr == 1) PG8_BAR;
    PG8_WAIT_V(2); PG8_BAR;
    PG8_STAGE(PG8_SB(1, 0), cB + kstep, voffB); PG8_STAGE(PG8_SA(1, 0), cA + kstep, voffA); PG8_STAGE(PG8_SB(1, 1), cB + hsB + kstep, voffB);
    PG8_WAIT_V(6); PG8_BAR;
    for (;;) {
        const bool has_next = S.next(ui + 1, nxt);
        const char* nA = has_next ? (const char*)g.A + (size_t)nxt.pm * tsA + (size_t)nxt.pn * g.a_pn_off * 2 : cA; const char* nB = has_next ? (const char*)g.Bt + (size_t)nxt.pn * tsB : cB;
        for (int t = 0; t < nt; t += 2) {
            const bool last = (t == nt - 2);
            const char* a1 = cA + (size_t)(t + 1) * kstep;
            const char* a2 = last ? nA : cA + (size_t)(t + 2) * kstep; const char* b2 = last ? nB : cB + (size_t)(t + 2) * kstep;
            const char* a3 = a2 + kstep; const char* b3 = b2 + kstep;
            PG8_LDB(B0, 0, 0); PG8_LDB(B1, 0, 1); PG8_SCHED; PG8_LDA(At, 0, 0); PG8_STAGE(PG8_SA(1, 1), a1 + hsA, voffA);
            PG8_WAIT_V(8); PG8_WAIT_L(0); PG8_BAR; PG8_MMA(0, 0, At, B0); PG8_MMA(0, 1, At, B1); PG8_BAR; PG8_SCHED;
            PG8_LDA(At, 0, 1); PG8_STAGE(PG8_SB(0, 0), b2, voffB); PG8_STAGE(PG8_SB(0, 1), b2 + hsB, voffB); PG8_STAGE(PG8_SA(0, 0), a2, voffA);
            PG8_WAIT_V(8); PG8_WAIT_L(0); PG8_BAR; PG8_MMA(1, 0, At, B0); PG8_MMA(1, 1, At, B1); PG8_BAR; PG8_SCHED;
            PG8_LDB(B0, 1, 0); PG8_LDB(B1, 1, 1); PG8_SCHED; PG8_LDA(At, 1, 0); PG8_STAGE(PG8_SA(0, 1), a2 + hsA, voffA);
            PG8_WAIT_V(8); PG8_WAIT_L(0); PG8_BAR; PG8_MMA(0, 0, At, B0); PG8_MMA(0, 1, At, B1); PG8_BAR; PG8_SCHED;
            PG8_LDA(At, 1, 1); PG8_STAGE(PG8_SB(1, 0), b3, voffB); PG8_STAGE(PG8_SB(1, 1), b3 + hsB, voffB); PG8_STAGE(PG8_SA(1, 0), a3, voffA);
            PG8_WAIT_V(8); PG8_WAIT_L(0); PG8_BAR; PG8_MMA(1, 0, At, B0); PG8_MMA(1, 1, At, B1); PG8_BAR; PG8_SCHED;
        }
        if (wr == 0) PG8_BAR;
        E(acc, cur, wr, wc, fr, fq);
        if (!has_next) break;
#pragma unroll
        for (int a = 0; a < 2; ++a)
#pragma unroll
            for (int b = 0; b < 2; ++b)
#pragma unroll
                for (int m = 0; m < 4; ++m)
#pragma unroll
                    for (int n = 0; n < 2; ++n) acc[a][b][m][n] = (f32x4){0.f, 0.f, 0.f, 0.f};
        cur = nxt; cA = nA; cB = nB; ++ui;
        if (wr == 1) PG8_BAR;
    }
    PG8_WAIT_V(0);
    PG8_BAR;
#undef PG8_SA
#undef PG8_SB
#undef PG8_STAGE
#undef PG8_LDA
#undef PG8_LDB
#undef PG8_MMA
#undef PG8_WAIT_V
#undef PG8_WAIT_L
#undef PG8_BAR
#undef PG8_SCHED
}
}
using pg8::Unit;

typedef f32x4 AccT[2][2][4][2];
__device__ __forceinline__ u32x4 pack8(f32x4 a, f32x4 b) { u32x4 w; w.x = cvt_pk_bf16(a[0], a[1]); w.y = cvt_pk_bf16(a[2], a[3]); w.z = cvt_pk_bf16(b[0], b[1]); w.w = cvt_pk_bf16(b[2], b[3]); return w; }
__device__ __forceinline__ void unpack8(u32x4 w, f32x4& a, f32x4& b) { a = (f32x4){bf_lo(w.x), bf_hi(w.x), bf_lo(w.y), bf_hi(w.y)}; b = (f32x4){bf_lo(w.z), bf_hi(w.z), bf_lo(w.w), bf_hi(w.w)}; }

struct EpiInproj {
    static constexpr bool PERM = true;
    bf16_t *q, *k, *v, *iq, *ik, *pl, *ga, *gp; float* iw;
    __device__ __forceinline__ void operator()(const AccT& acc, const Unit& u, int wr, int wc, int fr, int fq) const {
        const int pn = u.pn, row0 = u.pm * 256 + wr * 64 + fr;
        if (pn == 10) {
            if (wc < 2) {
#pragma unroll
                for (int ai = 0; ai < 2; ++ai)
#pragma unroll
                    for (int m = 0; m < 4; ++m) { const size_t row = (size_t)(row0 + ai * 128 + m * 16);
                        *(u32x4*)(ik + row * 64 + wc * 32 + 8 * fq) = pack8(acc[ai][0][m][0], acc[ai][0][m][1]); }
            } else if (wc == 2) {
                if (fq < 2) {
#pragma unroll
                    for (int ai = 0; ai < 2; ++ai)
#pragma unroll
                        for (int m = 0; m < 4; ++m) { const size_t row = (size_t)(row0 + ai * 128 + m * 16);
                            *(f32x4*)(iw + row * 16 + 8 * fq) = acc[ai][0][m][0]; *(f32x4*)(iw + row * 16 + 8 * fq + 4) = acc[ai][0][m][1]; }
                }
            }
            return;
        }
        bf16_t* dst; int ld, tc; bool sg = false;
        if (pn < 4) { dst = q; ld = 1024; tc = pn * 256; }
        else if (pn == 4) { dst = k; ld = 256; tc = 0; }
        else if (pn == 5) { dst = v; ld = 256; tc = 0; }
        else if (pn < 10) { dst = iq; ld = 1024; tc = (pn - 6) * 256; }
        else if (pn < 15) { dst = pl; ld = 1024; tc = (pn - 11) * 256; }
        else if (pn < 23) { dst = ga; ld = 2048; tc = (pn - 15) * 256; sg = true; }
        else { dst = gp; ld = 2048; tc = (pn - 23) * 256; sg = true; }
        const int col0 = tc + wc * 32 + 8 * fq;
#pragma unroll
        for (int ai = 0; ai < 2; ++ai)
#pragma unroll
            for (int m = 0; m < 4; ++m) { bf16_t* rowp = dst + (size_t)(row0 + ai * 128 + m * 16) * ld + col0;
#pragma unroll
                for (int bj = 0; bj < 2; ++bj) { f32x4 v0 = acc[ai][bj][m][0], v1 = acc[ai][bj][m][1];
                    if (sg) {
#pragma unroll
                        for (int j = 0; j < 4; ++j) { v0[j] = sigmoidf_(v0[j]); v1[j] = sigmoidf_(v1[j]); } }
                    *(u32x4*)(rowp + bj * 128) = pack8(v0, v1); } }
    }
};
struct EpiBf16Scale {
    static constexpr bool PERM = true;
    bf16_t* O; int ldc; const float* cs;
    __device__ __forceinline__ void operator()(const AccT& acc, const Unit& u, int wr, int wc, int fr, int fq) const {
        const int row0 = u.pm * 256 + wr * 64 + fr, col0 = u.pn * 256 + wc * 32 + 8 * fq;
        f32x4 s[2][2];
#pragma unroll
        for (int bj = 0; bj < 2; ++bj)
#pragma unroll
            for (int n = 0; n < 2; ++n) s[bj][n] = cs ? *(const f32x4*)(cs + col0 + bj * 128 + 4 * n) : (f32x4){1.f, 1.f, 1.f, 1.f};
#pragma unroll
        for (int ai = 0; ai < 2; ++ai)
#pragma unroll
            for (int m = 0; m < 4; ++m) { bf16_t* rowp = O + (size_t)(row0 + ai * 128 + m * 16) * ldc + col0;
#pragma unroll
                for (int bj = 0; bj < 2; ++bj) *(u32x4*)(rowp + bj * 128) = pack8(acc[ai][bj][m][0] * s[bj][0], acc[ai][bj][m][1] * s[bj][1]); }
    }
};
template <bool ADD> struct EpiGate {
    static constexpr bool PERM = true;
    bf16_t* O; const bf16_t* gate;
    __device__ __forceinline__ void operator()(const AccT& acc, const Unit& u, int wr, int wc, int fr, int fq) const {
        const int row0 = u.pm * 256 + wr * 64 + fr, col0 = u.pn * 256 + wc * 32 + 8 * fq;
#pragma unroll
        for (int ai = 0; ai < 2; ++ai)
#pragma unroll
            for (int m = 0; m < 4; ++m) { const size_t off = (size_t)(row0 + ai * 128 + m * 16) * 2048 + col0;
#pragma unroll
                for (int bj = 0; bj < 2; ++bj) { f32x4 g0, g1; unpack8(*(const u32x4*)(gate + off + bj * 128), g0, g1);
                    f32x4 r0 = g0 * acc[ai][bj][m][0], r1 = g1 * acc[ai][bj][m][1];
                    if (ADD) { f32x4 o0, o1; unpack8(*(const u32x4*)(O + off + bj * 128), o0, o1); r0 += o0; r1 += o1; }
                    *(u32x4*)(O + off + bj * 128) = pack8(r0, r1); } }
    }
};
struct EpiResid {
    static constexpr bool PERM = false;
    const float* x; float* out; const float* gt;
    __device__ __forceinline__ void operator()(const AccT& acc, const Unit& u, int wr, int wc, int fr, int fq) const {
        const int row0 = u.pm * 256 + wr * 64 + fr, col0 = u.pn * 256 + wc * 32 + 4 * fq;
        const float* gtb = gt + (size_t)(u.pm / 16) * 12288;
        f32x4 g[2][2];
#pragma unroll
        for (int bj = 0; bj < 2; ++bj)
#pragma unroll
            for (int n = 0; n < 2; ++n) g[bj][n] = *(const f32x4*)(gtb + col0 + bj * 128 + n * 16);
#pragma unroll
        for (int ai = 0; ai < 2; ++ai)
#pragma unroll
            for (int m = 0; m < 4; ++m) { const size_t off = (size_t)(row0 + ai * 128 + m * 16) * 2048 + col0;
#pragma unroll
                for (int bj = 0; bj < 2; ++bj)
#pragma unroll
                    for (int n = 0; n < 2; ++n) { const f32x4 xv = *(const f32x4*)(x + off + bj * 128 + n * 16);
                        *(f32x4*)(out + off + bj * 128 + n * 16) = xv + g[bj][n] * acc[ai][bj][m][n]; } }
    }
};
struct EpiF32 {
    static constexpr bool PERM = false;
    float* C; int ldc;
    __device__ __forceinline__ void operator()(const AccT& acc, const Unit& u, int wr, int wc, int fr, int fq) const {
        const int row0 = u.pm * 256 + wr * 64 + fr, col0 = u.pn * 256 + wc * 32 + 4 * fq;
#pragma unroll
        for (int ai = 0; ai < 2; ++ai)
#pragma unroll
            for (int m = 0; m < 4; ++m) { float* rowp = C + (size_t)(row0 + ai * 128 + m * 16) * ldc + col0;
#pragma unroll
                for (int bj = 0; bj < 2; ++bj)
#pragma unroll
                    for (int n = 0; n < 2; ++n) *(f32x4*)(rowp + bj * 128 + n * 16) = acc[ai][bj][m][n]; }
    }
};

struct Args { const float* in[19]; float* out; unsigned char* ws; int ph_lo, ph_hi; int li, pad; };
struct Frame {
    unsigned char* lds; unsigned char* ws;
    int tid, lane, wave, G, bid;
    const float *x, *c, *w_ada, *b_ada, *g1, *g2, *w_in, *g_q, *g_k, *rel_bias, *pool_w, *pool_scale, *w_ab, *w_pb, *w_out, *w_pq, *peer_keys, *peer_u, *peer_v;
    float* out;
};

template <class Fn> __device__ __forceinline__ void transpose_item(const float* W, int K, int N, bf16_t* WT, int ldk, int drow0, int k0, float* scr, int lane, Fn srccol) {
    const int sc = srccol(drow0 + (lane & 31));
#pragma unroll 8
    for (int i = 0; i < 32; ++i) { const int kk = 2 * i + (lane >> 5); scr[kk * 33 + (lane & 31)] = sc >= 0 ? W[(size_t)(k0 + kk) * N + sc] : 0.f; }
    asm volatile("s_waitcnt lgkmcnt(0)" ::: "memory");
    const int c = lane & 7;
#pragma unroll
    for (int j = 0; j < 4; ++j) { const int n = (lane >> 3) + 8 * j; const float* s = scr + (8 * c) * 33 + n;
        u32x4 o; o.x = cvt_pk_bf16(s[0 * 33], s[1 * 33]); o.y = cvt_pk_bf16(s[2 * 33], s[3 * 33]); o.z = cvt_pk_bf16(s[4 * 33], s[5 * 33]); o.w = cvt_pk_bf16(s[6 * 33], s[7 * 33]);
        *(u32x4*)(WT + (size_t)(drow0 + n) * ldk + k0 + 8 * c) = o; }
    asm volatile("s_waitcnt lgkmcnt(0)" ::: "memory");
}
__device__ __forceinline__ void phase0_prep(Frame& F) {
    const int gw = F.bid * 8 + F.wave, NGW = F.G * 8;
    float* scr = (float*)(F.lds + F.wave * 16384);
    constexpr int I_IN = (INWP / 32) * (DM / 64);
    constexpr int I_AB = (2048 / 32) * (1024 / 64), I_OUT = (2048 / 32) * (2048 / 64), I_PW = 4 * 8 * 4;
    constexpr int NIT = I_IN + 2 * I_AB + 2 * I_OUT + I_PW;
    auto ident = [](int j) { return j; };
    for (int it = gw; it < NIT; it += NGW) {
        int r = it;
        if (r < I_IN) { const int nb = r % (INWP / 32), kb = r / (INWP / 32);
            transpose_item(F.w_in, DM, INW, (bf16_t*)(F.ws + WS_WIN), DM, nb * 32, kb * 64, scr, F.lane, [](int j) { return j < 2640 ? j : (j < 2816 ? -1 : j - 176); }); continue; }
        r -= I_IN;
        if (r < I_AB) { transpose_item(F.w_ab, 1024, 2048, (bf16_t*)(F.ws + WS_WAB), 1024, (r % 64) * 32, (r / 64) * 64, scr, F.lane, ident); continue; }
        r -= I_AB;
        if (r < I_AB) { transpose_item(F.w_pb, 1024, 2048, (bf16_t*)(F.ws + WS_WPB), 1024, (r % 64) * 32, (r / 64) * 64, scr, F.lane, ident); continue; }
        r -= I_AB;
        if (r < I_OUT) { transpose_item(F.w_out, 2048, 2048, (bf16_t*)(F.ws + WS_WOUT), 2048, (r % 64) * 32, (r / 64) * 64, scr, F.lane, ident); continue; }
        r -= I_OUT;
        if (r < I_OUT) { transpose_item(F.w_pq, 2048, 2048, (bf16_t*)(F.ws + WS_WPQ), 2048, (r % 64) * 32, (r / 64) * 64, scr, F.lane, ident); continue; }
        r -= I_OUT;
        { const int g = r / 32, q = r % 32, nb = q % 8, kb = q / 8;
          transpose_item(F.pool_w + (size_t)g * 65536, 256, 256, (bf16_t*)(F.ws + WS_POOLW) + (size_t)g * 65536, 256, nb * 32, kb * 64, scr, F.lane, ident); }
    }
    {
        bf16_t* kb = (bf16_t*)(F.ws + WS_KEYSBD);
        for (int i = F.bid * 512 + F.tid; i < 2048 * 32; i += F.G * 512) {
            const int row = i / 32, k8 = (i % 32) * 8, p = (row >> 7) & 1;
            u32x4 o = (u32x4){0u, 0u, 0u, 0u};
            if ((k8 >> 7) == p) { const float* s = F.peer_keys + (size_t)row * 128 + (k8 & 127); const f32x4 a = *(const f32x4*)s, b = *(const f32x4*)(s + 4); o = pack8(a, b); }
            *(u32x4*)(kb + (size_t)row * 256 + k8) = o;
        }
    }
    {
        const size_t n16 = (size_t)NEXP * DM / 16;
        unsigned char* pu = F.ws + WS_PU;
        for (size_t i = (size_t)F.bid * 512 + F.tid; i < n16; i += (size_t)F.G * 512) {
            u32x4 ou;
#pragma unroll
            for (int k = 0; k < 4; ++k) { const f32x4 a = *(const f32x4*)(F.peer_u + i * 16 + k * 4) * 64.0f;
                int wu = __builtin_amdgcn_cvt_pk_fp8_f32(a[0], a[1], 0, false); wu = __builtin_amdgcn_cvt_pk_fp8_f32(a[2], a[3], wu, true); ou[k] = (unsigned)wu; }
            *(u32x4*)(pu + i * 16) = ou;
        }
        unsigned char* pv = F.ws + WS_PV;
        for (int it = gw; it < (NEXP / 64) * 128; it += NGW) {
            const int e = (it >> 7) * 64 + F.lane, ch = it & 127;
            u32x4 ov;
#pragma unroll
            for (int k = 0; k < 4; ++k) { const f32x4 c = *(const f32x4*)(F.peer_v + (size_t)e * DM + ch * 16 + k * 4) * 4.0f;
                int wv = __builtin_amdgcn_cvt_pk_fp8_f32(c[0], c[1], 0, false); wv = __builtin_amdgcn_cvt_pk_fp8_f32(c[2], c[3], wv, true); ov[k] = (unsigned)wv; }
            *(u32x2*)(pv + ((size_t)(2 * ch) * NEXP + e) * 8) = (u32x2){ov[0], ov[1]};
            *(u32x2*)(pv + ((size_t)(2 * ch + 1) * NEXP + e) * 8) = (u32x2){ov[2], ov[3]};
        }
    }
    {
        __syncthreads();
        float* cact = (float*)(F.lds + 131072);
        float* red = (float*)F.lds;
        float* mp = (float*)(F.ws + WS_MODP);
        for (int it = F.bid; it < 48 * 4; it += F.G) {
            const int cb = it % 48, ds = it / 48, d0 = ds * 512;
            for (int i = F.tid; i < 8 * 512; i += 512) { const int b = i >> 9, d = i & 511; const float cv = F.c[b * DM + d0 + d]; cact[i] = cv * sigmoidf_(cv); }
            __syncthreads();
            f32x4 a[8];
#pragma unroll
            for (int b = 0; b < 8; ++b) a[b] = (f32x4){0.f, 0.f, 0.f, 0.f};
            const float* wp = F.w_ada + (size_t)(d0 + F.wave * 64) * 12288 + cb * 256 + F.lane * 4;
#pragma unroll 4
            for (int d = 0; d < 64; ++d) { const f32x4 w = *(const f32x4*)(wp + (size_t)d * 12288);
#pragma unroll
                for (int b = 0; b < 8; ++b) a[b] += w * cact[b * 512 + F.wave * 64 + d]; }
#pragma unroll
            for (int b = 0; b < 8; ++b)
#pragma unroll
                for (int j = 0; j < 4; ++j) red[(F.wave * 32 + b * 4 + j) * 64 + F.lane] = a[b][j];
            __syncthreads();
            for (int i = F.tid; i < 2048; i += 512) { const int v = i >> 6, l = i & 63; float s = 0.f;
#pragma unroll
                for (int w = 0; w < 8; ++w) s += red[(w * 32 + v) * 64 + l];
                mp[((size_t)ds * 8 + (v >> 2)) * 12288 + cb * 256 + l * 4 + (v & 3)] = s; }
            __syncthreads();
        }
    }
}

template <bool FIRST> __device__ __forceinline__ void phase_modnorm(Frame& F, const float* xin, const float* gain, int off_sh, int off_sc, bf16_t* dst) {
    const float* mp = (const float*)(F.ws + WS_MODP); float* mf = (float*)(F.ws + WS_MODF);
    if (FIRST) {
        for (int i = F.bid * 512 + F.tid; i < 8 * 12288; i += F.G * 512) {
            float s = F.b_ada[i % 12288];
#pragma unroll
            for (int k = 0; k < 4; ++k) s += mp[(size_t)k * 8 * 12288 + i];
            mf[i] = s; }
    }
    float* cA = (float*)F.lds; float* cB = cA + 2048;
    for (int ch = F.bid; ch < MTOK / 128; ch += F.G) {
        const int b = ch / 32;
        __syncthreads();
        for (int col = F.tid; col < 2048; col += 512) {
            float sc, sh;
            if (FIRST) { sc = F.b_ada[off_sc + col]; sh = F.b_ada[off_sh + col];
#pragma unroll
                for (int k = 0; k < 4; ++k) { sc += mp[((size_t)k * 8 + b) * 12288 + off_sc + col]; sh += mp[((size_t)k * 8 + b) * 12288 + off_sh + col]; } }
            else { sc = mf[b * 12288 + off_sc + col]; sh = mf[b * 12288 + off_sh + col]; }
            cA[col] = gain[col] * (1.f + sc); cB[col] = sh; }
        __syncthreads();
        for (int r = F.wave; r < 128; r += 8) {
            const size_t row = (size_t)ch * 128 + r;
            const float* xr = xin + row * 2048 + F.lane * 8;
            f32x4 v[4][2]; float ss = 0.f;
#pragma unroll
            for (int i = 0; i < 4; ++i) { v[i][0] = *(const f32x4*)(xr + i * 512); v[i][1] = *(const f32x4*)(xr + i * 512 + 4);
#pragma unroll
                for (int j = 0; j < 4; ++j) ss += v[i][0][j] * v[i][0][j] + v[i][1][j] * v[i][1][j]; }
            ss = wave_sum(ss);
            const float rinv = 1.0f / sqrtf(ss * (1.0f / 2048.0f) + EPS);
#pragma unroll
            for (int i = 0; i < 4; ++i) { const int col = i * 512 + F.lane * 8;
                const f32x4 a0 = *(const f32x4*)(cA + col), a1 = *(const f32x4*)(cA + col + 4), b0 = *(const f32x4*)(cB + col), b1 = *(const f32x4*)(cB + col + 4);
                *(u32x4*)(dst + row * 2048 + col) = pack8(v[i][0] * rinv * a0 + b0, v[i][1] * rinv * a1 + b1); }
        }
    }
}

__device__ __forceinline__ u32x2 pack8_fp8(f32x4 a, f32x4 b) {
    int w0 = __builtin_amdgcn_cvt_pk_fp8_f32(a[0], a[1], 0, false); w0 = __builtin_amdgcn_cvt_pk_fp8_f32(a[2], a[3], w0, true);
    int w1 = __builtin_amdgcn_cvt_pk_fp8_f32(b[0], b[1], 0, false); w1 = __builtin_amdgcn_cvt_pk_fp8_f32(b[2], b[3], w1, true);
    return (u32x2){(unsigned)w0, (unsigned)w1};
}
__device__ __forceinline__ void phase3_qknorm(Frame& F) {
    const bf16_t* q = (const bf16_t*)(F.ws + WS_QN); const bf16_t* k = (const bf16_t*)(F.ws + WS_KN); const bf16_t* v = (const bf16_t*)(F.ws + WS_V);
    unsigned char* q8 = F.ws + WS_Q8; unsigned char* k8 = F.ws + WS_K8; unsigned char* v8 = F.ws + WS_V8;
    const int gw = F.bid * 8 + F.wave, NGW = F.G * 8;
    for (int row = gw; row < MTOK; row += NGW) {
#pragma unroll
        for (int i = 0; i < 2; ++i) { const int ci = i * 64 + F.lane;
            f32x4 a, b; unpack8(*(const u32x4*)(q + (size_t)row * 1024 + ci * 8), a, b);
            float ss = a[0] * a[0] + a[1] * a[1] + a[2] * a[2] + a[3] * a[3] + b[0] * b[0] + b[1] * b[1] + b[2] * b[2] + b[3] * b[3];
            ss = row_sum16(ss);
            const float rinv = 1.0f / sqrtf(ss * (1.0f / 128.0f) + EPS);
            const float* gp = F.g_q + (ci & 15) * 8; const f32x4 g0 = *(const f32x4*)gp, g1 = *(const f32x4*)(gp + 4);
            *(u32x2*)(q8 + (size_t)row * 1024 + ci * 8) = pack8_fp8(a * rinv * g0, b * rinv * g1); }
        { const int ci = F.lane & 31; const bool isk = F.lane < 32;
            f32x4 a, b; unpack8(*(const u32x4*)((isk ? k : v) + (size_t)row * 256 + ci * 8), a, b);
            float ss = a[0] * a[0] + a[1] * a[1] + a[2] * a[2] + a[3] * a[3] + b[0] * b[0] + b[1] * b[1] + b[2] * b[2] + b[3] * b[3];
            ss = row_sum16(ss);
            const float rinv = isk ? 1.0f / sqrtf(ss * (1.0f / 128.0f) + EPS) : 1.0f;
            const float* gp = F.g_k + (ci & 15) * 8; f32x4 g0 = *(const f32x4*)gp, g1 = *(const f32x4*)(gp + 4);
            if (!isk) { g0 = (f32x4){1.f, 1.f, 1.f, 1.f}; g1 = g0; }
            *(u32x2*)((isk ? k8 : v8) + (size_t)row * 256 + ci * 8) = pack8_fp8(a * rinv * g0, b * rinv * g1); }
    }
}
__device__ __forceinline__ void phase3_pooled(Frame& F) {
    const bf16_t* pl = (const bf16_t*)(F.ws + WS_PL); bf16_t* po = (bf16_t*)(F.ws + WS_POOLED);
    for (size_t i = (size_t)F.bid * 512 + F.tid; i < (size_t)MTOK * 128; i += (size_t)F.G * 512) {
        const int row = (int)(i >> 7), c8 = (int)(i & 127) * 8, g = c8 >> 8, w = 2 << g, t = row & (SEQ - 1);
        const int cnt = (t + 1 < w) ? t + 1 : w;
        f32x4 s0 = (f32x4){0.f, 0.f, 0.f, 0.f}, s1 = s0, x0 = s0, x1 = s0;
        for (int j = 0; j < cnt; ++j) { f32x4 a, b; unpack8(*(const u32x4*)(pl + (size_t)(row - j) * 1024 + c8), a, b); s0 += a; s1 += b; if (j == 0) { x0 = a; x1 = b; } }
        const float inv = 1.0f / (float)cnt;
        *(u32x4*)(po + (size_t)row * 1024 + c8) = pack8(s0 * inv - x0, s1 * inv - x1);
    }
}
typedef float f32x16 __attribute__((ext_vector_type(16)));
__device__ __forceinline__ int sel_code(float s, float smin, float scale) { const float c = (s - smin) * scale; return (int)fminf(fmaxf(c, 0.f), 65535.f); }
__device__ __forceinline__ void hist_find(const unsigned* hist, int lane, int K, int& bsel, int& above) {
    const u32x4 h = *(const u32x4*)(hist + lane * 4);
    const int S = (int)(h.x + h.y + h.z + h.w);
    int x = S;
    x += __builtin_amdgcn_update_dpp(0, x, 0x101, 0xF, 0xF, true);
    x += __builtin_amdgcn_update_dpp(0, x, 0x102, 0xF, 0xF, true);
    x += __builtin_amdgcn_update_dpp(0, x, 0x104, 0xF, 0xF, true);
    x += __builtin_amdgcn_update_dpp(0, x, 0x108, 0xF, 0xF, true);
    const int t1 = __builtin_amdgcn_readlane(x, 16), t2 = __builtin_amdgcn_readlane(x, 32), t3 = __builtin_amdgcn_readlane(x, 48);
    const int r = lane >> 4;
    x += (r == 0 ? t1 + t2 + t3 : (r == 1 ? t2 + t3 : (r == 2 ? t3 : 0)));
    const int sufn = x - S;
    const bool mine = (x >= K) && (sufn < K);
    int b = 0, ab = 0;
    { int c = sufn;
      if (c + (int)h.w >= K) { b = 3; ab = c; } else { c += (int)h.w;
      if (c + (int)h.z >= K) { b = 2; ab = c; } else { c += (int)h.z;
      if (c + (int)h.y >= K) { b = 1; ab = c; } else { c += (int)h.y; b = 0; ab = c; } } } }
    const unsigned long long m = __ballot(mine);
    const int src = m ? (int)__builtin_ctzll(m) : 0;
    bsel = __builtin_amdgcn_readlane(lane * 4 + b, src); above = __builtin_amdgcn_readlane(ab, src);
}
__device__ __forceinline__ void indexer_select(Frame& F, int b, int t, const float* rowbuf, unsigned* hist, float* eqv, int* eqi) {
    unsigned short* selrow = (unsigned short*)(F.ws + WS_SEL) + (size_t)(b * SEQ + t) * 256;
    int lane = F.lane; asm volatile("" : "+v"(lane));
    const int nch = t / 64 + 1, n4 = (nch + 3) >> 2;
    const f32x4* rb4 = (const f32x4*)rowbuf;
    float mn = __builtin_huge_valf(), mx = -__builtin_huge_valf();
    for (int c4 = 0; c4 < n4; ++c4) { const f32x4 v = rb4[c4 * 64 + lane];
#pragma unroll
        for (int k = 0; k < 4; ++k) { const bool valid = ((c4 * 4 + k) * 64 + lane) <= t; mn = valid ? fminf(mn, v[k]) : mn; mx = valid ? fmaxf(mx, v[k]) : mx; } }
    mx = xor16_max(row_max16(mx)); { const auto r = __builtin_amdgcn_permlane32_swap(__float_as_uint(mx), __float_as_uint(mx), false, false); mx = fmaxf(__uint_as_float(r[0]), __uint_as_float(r[1])); }
    mn = -mn; mn = xor16_max(row_max16(mn)); { const auto r = __builtin_amdgcn_permlane32_swap(__float_as_uint(mn), __float_as_uint(mn), false, false); mn = -fmaxf(__uint_as_float(r[0]), __uint_as_float(r[1])); }
    const float scale = (mx > mn) ? 65535.0f / (mx - mn) : 0.f;
    *(u32x4*)(hist + lane * 4) = (u32x4){0u, 0u, 0u, 0u};
    for (int c4 = 0; c4 < n4; ++c4) { const f32x4 v = rb4[c4 * 64 + lane];
#pragma unroll
        for (int k = 0; k < 4; ++k) { const bool valid = ((c4 * 4 + k) * 64 + lane) <= t; if (valid) atomicAdd(&hist[sel_code(v[k], mn, scale) >> 8], 1u); } }
    int b1, above1; hist_find(hist, lane, KSEL, b1, above1);
    *(u32x4*)(hist + lane * 4) = (u32x4){0u, 0u, 0u, 0u};
    for (int c4 = 0; c4 < n4; ++c4) { const f32x4 v = rb4[c4 * 64 + lane];
#pragma unroll
        for (int k = 0; k < 4; ++k) { const bool valid = ((c4 * 4 + k) * 64 + lane) <= t; const int code = sel_code(v[k], mn, scale); if (valid && (code >> 8) == b1) atomicAdd(&hist[code & 255], 1u); } }
    int b2, above2; hist_find(hist, lane, KSEL - above1, b2, above2);
    const int T16 = (b1 << 8) | b2, need = KSEL - above1 - above2, ceq = (int)hist[b2];
    const unsigned long long lt_mask = (1ull << lane) - 1ull;
    const bool exact = (ceq != need) && (ceq <= 64);
    if (exact) {
        int pos = 0;
        for (int c = 0; c < nch; ++c) { const float sv = rowbuf[((c >> 2) * 64 + lane) * 4 + (c & 3)]; const int idx = c * 64 + lane;
            const bool eq = (idx <= t) && (sel_code(sv, mn, scale) == T16);
            const unsigned long long m = __ballot(eq);
            if (m) { const int p = pos + __popcll(m & lt_mask); if (eq) { eqv[p] = sv; eqi[p] = idx; } pos += __popcll(m); } }
    }
    int pos = 0, eqseen = 0;
    for (int c = 0; c < nch; ++c) {
        const float sv = rowbuf[((c >> 2) * 64 + lane) * 4 + (c & 3)]; const int idx = c * 64 + lane;
        const int code = sel_code(sv, mn, scale); const bool valid = idx <= t;
        const bool gt = valid && code > T16, eq = valid && code == T16;
        const unsigned long long meq = __ballot(eq);
        bool take = gt;
        if (meq) {
            if (ceq == need) take = take || eq;
            else if (exact) { int rank = 0; for (int m = 0; m < ceq; ++m) { const float ov = eqv[m]; const int oi = eqi[m]; rank += (ov > sv || (ov == sv && oi < idx)) ? 1 : 0; } take = take || (eq && rank < need); }
            else { const int er = eqseen + __popcll(meq & lt_mask); take = take || (eq && er < need); eqseen += __popcll(meq); }
        }
        const unsigned long long mt = __ballot(take);
        const int p = pos + __popcll(mt & lt_mask);
        if (take && p < KSEL) selrow[p] = (unsigned short)idx;
        pos += __popcll(mt);
    }
}
__device__ __forceinline__ void indexer_tile(Frame& F, int b, int t0) {
    const bf16_t* iq = (const bf16_t*)(F.ws + WS_IQ); const bf16_t* ik = (const bf16_t*)(F.ws + WS_IK); const float* iw = (const float*)(F.ws + WS_IW);
    int lane = F.lane; asm volatile("" : "+v"(lane));
    const int w = F.wave;
    if (t0 < KSEL) {
        const int t = t0 + w; unsigned short* selrow = (unsigned short*)(F.ws + WS_SEL) + (size_t)(b * SEQ + t) * 256;
#pragma unroll
        for (int p = 0; p < 4; ++p) { const int j = p * 64 + lane; selrow[j] = (unsigned short)(j <= t ? j : 0xFFFF); }
        return;
    }
    float* rowbuf = (float*)F.lds;
    unsigned char* stage = F.lds + 131072;
    const int p = w & 3, kh = w >> 2, hi = lane >> 5, r = lane & 31;
    const size_t qrow = (size_t)b * SEQ + t0 + 2 * p + (r >> 4);
    bf16x8 a[4];
#pragma unroll
    for (int ks = 0; ks < 4; ++ks) a[ks] = *(const bf16x8*)(iq + qrow * 1024 + (r & 15) * 64 + ks * 16 + 8 * hi);
    float wq[2][8];
#pragma unroll
    for (int q = 0; q < 2; ++q)
#pragma unroll
        for (int i = 0; i < 8; ++i) wq[q][i] = iw[((size_t)b * SEQ + t0 + 2 * p + q) * 16 + (i & 3) + 8 * ((i >> 2) & 1) + 4 * hi];
    const int nchunks = (t0 + 7) / 64 + 1;
    const unsigned char* gsrc = (const unsigned char*)(ik + (size_t)b * SEQ * 64) + F.tid * 16;
    const int skey = F.tid >> 3, sc16 = F.tid & 7, soff = skey * 128 + ((sc16 ^ (skey & 7)) << 4);
    u32x4 sreg = *(const u32x4*)gsrc;
    __syncthreads();
    for (int c = 0; c < nchunks; ++c) {
        unsigned char* sb = stage + (c & 1) * 8192;
        *(u32x4*)(sb + soff) = sreg;
        __syncthreads();
        if (c + 1 < nchunks) sreg = *(const u32x4*)(gsrc + (size_t)(c + 1) * 8192);
        f32x16 d;
#pragma unroll
        for (int i = 0; i < 16; ++i) d[i] = 0.f;
        const int key = kh * 32 + r;
#pragma unroll
        for (int ks = 0; ks < 4; ++ks) { const bf16x8 bf = *(const bf16x8*)(sb + key * 128 + (((ks * 2 + hi) ^ (key & 7)) << 4));
            d = __builtin_amdgcn_mfma_f32_32x32x16_bf16(a[ks], bf, d, 0, 0, 0); }
        float s0 = 0.f, s1 = 0.f;
#pragma unroll
        for (int i = 0; i < 8; ++i) { s0 += wq[0][i] * fmaxf(d[i], 0.f); s1 += wq[1][i] * fmaxf(d[8 + i], 0.f); }
        const float sc = swap32_pair(s0, s1);
        const int kk = kh * 32 + r;
        rowbuf[(2 * p + hi) * 4096 + ((c >> 2) * 64 + kk) * 4 + (c & 3)] = sc;
    }
    __syncthreads();
    indexer_select(F, b, t0 + w, rowbuf + w * 4096, (unsigned*)(F.lds + 147456) + w * 256, (float*)(F.lds + 155648) + w * 64, (int*)(F.lds + 155648 + 2048) + w * 64);
}
__device__ __forceinline__ void phase3_indexer(Frame& F) {
    const int nit = BATCH * (SEQ / 8);
    for (int k = 0;; ++k) {
        const int l = k * F.G + ((k & 1) ? (F.G - 1 - F.bid) : F.bid);
        if (l >= nit) { if (k * F.G >= nit) break; else continue; }
        const int qb = (SEQ / 8 - 1) - (l >> 3), b = l & 7;
        indexer_tile(F, b, qb * 8);
    }
}

__device__ const unsigned char g_bucket[128] = {0, 1, 2, 3, 4, 5, 6, 7, 8, 9, 10, 11, 12, 13, 14, 15, 16, 16, 16, 17, 17, 18, 18, 18, 19, 19, 19, 20, 20, 20, 20, 21, 21, 21, 21, 22, 22, 22, 22, 22, 23, 23, 23, 23, 23, 23, 24, 24, 24, 24, 24, 24, 25, 25, 25, 25, 25, 25, 25, 26, 26, 26, 26, 26, 26, 26, 26, 27, 27, 27, 27, 27, 27, 27, 27, 27, 27, 28, 28, 28, 28, 28, 28, 28, 28, 28, 28, 29, 29, 29, 29, 29, 29, 29, 29, 29, 29, 29, 29, 30, 30, 30, 30, 30, 30, 30, 30, 30, 30, 30, 30, 30, 30, 31, 31, 31, 31, 31, 31, 31, 31, 31, 31, 31, 31, 31, 31, 31};
__device__ __forceinline__ void phase4_attention(Frame& F) {
    const unsigned char* q8 = F.ws + WS_Q8; const unsigned char* k8 = F.ws + WS_K8; const unsigned char* v8 = F.ws + WS_V8;
    const unsigned short* sel = (const unsigned short*)(F.ws + WS_SEL); bf16_t* ao = (bf16_t*)(F.ws + WS_ATTN);
    float* btab = (float*)F.lds;
    __syncthreads();
    for (int i = F.tid; i < 256; i += 512) btab[i] = F.rel_bias[i];
    __syncthreads();
    float* Pl = (float*)(F.lds + 4096 + F.wave * 12288); int* idl = (int*)(Pl + 2048); float* psl = (float*)(idl + 256);
    const bool xmap = (F.G % 8) == 0;
    const int gw = xmap ? (F.bid / 8) * 8 + F.wave : F.bid * 8 + F.wave, NGW = xmap ? F.G : F.G * 8, nrows = xmap ? SEQ : MTOK;
    for (int rr = gw; rr < nrows; rr += NGW) {
        int lane = F.lane; asm volatile("" : "+v"(lane));
        const int row = xmap ? (F.bid & 7) * SEQ + rr : rr;
        const int b = row / SEQ, t = row % SEQ, r = lane & 31, hi = lane >> 5;
#pragma unroll
        for (int p = 0; p < 4; ++p) { idl[p * 64 + lane] = (int)sel[(size_t)row * 256 + p * 64 + lane]; }
        long a0[8], a1[8];
        { u32x4 qa[4];
#pragma unroll
          for (int i = 0; i < 4; ++i) qa[i] = (r < 8) ? *(const u32x4*)(q8 + (size_t)row * 1024 + r * 128 + hi * 64 + i * 16) : (u32x4){0u, 0u, 0u, 0u};
#pragma unroll
          for (int ks = 0; ks < 8; ++ks) { const unsigned lo = qa[ks >> 1][(ks & 1) * 2], hh = qa[ks >> 1][(ks & 1) * 2 + 1]; const long v = (long)(((unsigned long long)hh << 32) | lo);
              a0[ks] = (r < 4) ? v : 0l; a1[ks] = (r >= 4) ? v : 0l; } }
        f32x4 psum = (f32x4){0.f, 0.f, 0.f, 0.f};
#define AT_LOADK(buf, kb) do { const int key_ = idl[(kb) * 32 + r]; const int kc_ = key_ <= t ? key_ : 0; const unsigned char* kr_ = k8 + ((size_t)b * SEQ + kc_) * 256 + hi * 64; \
            _Pragma("unroll") for (int i = 0; i < 4; ++i) { buf[i] = *(const u32x4*)(kr_ + i * 16); buf[4 + i] = *(const u32x4*)(kr_ + 128 + i * 16); } } while (0)
#define AT_QK(buf, kb) do { const int key_ = idl[(kb) * 32 + r]; const bool valid_ = key_ <= t; const int kc_ = valid_ ? key_ : 0; \
            f32x16 d; _Pragma("unroll") for (int i = 0; i < 16; ++i) d[i] = 0.f; \
            _Pragma("unroll") for (int ks = 0; ks < 8; ++ks) { const long bv_ = (long)(((unsigned long long)buf[ks >> 1][(ks & 1) * 2 + 1] << 32) | buf[ks >> 1][(ks & 1) * 2]); d = __builtin_amdgcn_mfma_f32_32x32x16_fp8_fp8(a0[ks], bv_, d, 0, 0, 0); } \
            _Pragma("unroll") for (int ks = 0; ks < 8; ++ks) { const long bv_ = (long)(((unsigned long long)buf[4 + (ks >> 1)][(ks & 1) * 2 + 1] << 32) | buf[4 + (ks >> 1)][(ks & 1) * 2]); d = __builtin_amdgcn_mfma_f32_32x32x16_fp8_fp8(a1[ks], bv_, d, 0, 0, 0); } \
            const int dist_ = t - kc_; const int bkt_ = dist_ < 128 ? (int)g_bucket[dist_] : 31; \
            const f32x4 bias_ = *(const f32x4*)(btab + bkt_ * 8 + 4 * hi); f32x4 e_; \
            _Pragma("unroll") for (int i = 0; i < 4; ++i) e_[i] = valid_ ? __expf(d[i] * 0.08838834764831845f + bias_[i]) : 0.f; \
            psum += e_; *(f32x4*)(Pl + ((kb) * 32 + r) * 8 + 4 * hi) = e_; } while (0)
        {
            u32x4 kA[8], kB[8];
            AT_LOADK(kA, 0);
#pragma unroll 1
            for (int kb = 0; kb < 8; kb += 2) {
                AT_LOADK(kB, kb + 1);
                AT_QK(kA, kb);
                if (kb + 2 < 8) AT_LOADK(kA, kb + 2);
                AT_QK(kB, kb + 1);
            }
        }
#undef AT_LOADK
#undef AT_QK
#pragma unroll
        for (int i = 0; i < 4; ++i) psum[i] = xor16_sum(row_sum16(psum[i]));
        if (r == 0) *(f32x4*)(psl + 4 * hi) = psum;
        const int ks = lane >> 4, g = (lane >> 3) & 1, dc = lane & 7;
        float acc[4][16];
#pragma unroll
        for (int h = 0; h < 4; ++h)
#pragma unroll
            for (int j = 0; j < 16; ++j) acc[h][j] = 0.f;
#define AT_LOADV(buf, it0) do { _Pragma("unroll") for (int u = 0; u < 4; ++u) { const int key_ = idl[((it0) + u) * 4 + ks]; const int kc_ = key_ <= t ? key_ : 0; \
            buf[u] = *(const u32x4*)(v8 + ((size_t)b * SEQ + kc_) * 256 + g * 128 + dc * 16); } } while (0)
#define AT_PV(buf, it0) do { _Pragma("unroll") for (int u = 0; u < 4; ++u) { const int j_ = ((it0) + u) * 4 + ks; const u32x4 w = buf[u]; \
            const f32x4 p = *(const f32x4*)(Pl + j_ * 8 + 4 * g); \
            _Pragma("unroll") for (int dd = 0; dd < 4; ++dd) { const f32x2 lo = __builtin_amdgcn_cvt_pk_f32_fp8((int)w[dd], false), hh_ = __builtin_amdgcn_cvt_pk_f32_fp8((int)w[dd], true); \
                _Pragma("unroll") for (int h = 0; h < 4; ++h) { acc[h][4 * dd] += p[h] * lo.x; acc[h][4 * dd + 1] += p[h] * lo.y; acc[h][4 * dd + 2] += p[h] * hh_.x; acc[h][4 * dd + 3] += p[h] * hh_.y; } } } } while (0)
        {
            u32x4 vA[4], vB[4];
            AT_LOADV(vA, 0);
#pragma unroll 1
            for (int it0 = 0; it0 < 64; it0 += 8) {
                AT_LOADV(vB, it0 + 4);
                AT_PV(vA, it0);
                if (it0 + 8 < 64) AT_LOADV(vA, it0 + 8);
                AT_PV(vB, it0 + 4);
            }
        }
#undef AT_LOADV
#undef AT_PV
#pragma unroll
        for (int h = 0; h < 4; ++h)
#pragma unroll
            for (int j = 0; j < 16; ++j) acc[h][j] = xor32_sum(xor16_sum(acc[h][j]));
#pragma unroll
        for (int h = 0; h < 4; ++h) if (h == ks) { const float inv = 1.0f / psl[4 * g + h];
            bf16_t* op = ao + (size_t)row * 1024 + (4 * g + h) * 128 + dc * 16;
            *(u32x4*)op = pack8((f32x4){acc[h][0], acc[h][1], acc[h][2], acc[h][3]} * inv, (f32x4){acc[h][4], acc[h][5], acc[h][6], acc[h][7]} * inv);
            *(u32x4*)(op + 8) = pack8((f32x4){acc[h][8], acc[h][9], acc[h][10], acc[h][11]} * inv, (f32x4){acc[h][12], acc[h][13], acc[h][14], acc[h][15]} * inv); }
    }
}

__device__ __forceinline__ float dot16f8(u32x4 w, const float* h) {
    float s = 0.f;
#pragma unroll
    for (int d = 0; d < 4; ++d) { const f32x2 lo = __builtin_amdgcn_cvt_pk_f32_fp8((int)w[d], false), hi = __builtin_amdgcn_cvt_pk_f32_fp8((int)w[d], true);
        s += lo.x * h[4 * d] + lo.y * h[4 * d + 1] + hi.x * h[4 * d + 2] + hi.y * h[4 * d + 3]; }
    return s;
}
__device__ __forceinline__ void fma16f8(u32x4 w, float cf, float* acc) {
#pragma unroll
    for (int d = 0; d < 4; ++d) { const f32x2 lo = __builtin_amdgcn_cvt_pk_f32_fp8((int)w[d], false), hi = __builtin_amdgcn_cvt_pk_f32_fp8((int)w[d], true);
        acc[4 * d] += cf * lo.x; acc[4 * d + 1] += cf * lo.y; acc[4 * d + 2] += cf * hi.x; acc[4 * d + 3] += cf * hi.y; }
}
__device__ __forceinline__ float gelu_erf(float x) { return 0.5f * x * (1.0f + erff(x * 0.70710678118654752f)); }
__device__ __forceinline__ void peer_select(const bf16_t* srow, int lane, int* elist, float* gl, float* scr) {
    float* selv = scr; int* seli = (int*)(scr + 32); float* srtv = scr + 64; int* srti = (int*)(scr + 96);
    const unsigned long long lt_mask = (1ull << lane) - 1ull;
    const int half = lane >> 5, lh = lane & 31;
    const unsigned long long hmask = half ? 0xFFFFFFFF00000000ull : 0x00000000FFFFFFFFull;
    const float NINF = -__builtin_huge_valf();
#pragma unroll 1
    for (int h = 0; h < 8; ++h) {
        const u32x2 raw = *(const u32x2*)(srow + h * 256 + lane * 4);
        unsigned b[4] = {raw.x & 0xffffu, raw.x >> 16, raw.y & 0xffffu, raw.y >> 16}, k[4];
#pragma unroll
        for (int q = 0; q < 4; ++q) k[q] = (b[q] & 0x8000u) ? (b[q] ^ 0xFFFFu) : (b[q] | 0x8000u);
        unsigned T0 = 0u, T1 = 0u;
#pragma unroll
        for (int bit = 15; bit >= 0; --bit) {
            const unsigned c0 = T0 | (1u << bit), c1 = T1 | (1u << bit), cand = half ? c1 : c0;
            const unsigned long long m0 = __ballot(k[0] >= cand), m1 = __ballot(k[1] >= cand), m2 = __ballot(k[2] >= cand), m3 = __ballot(k[3] >= cand);
            const int n0 = __popc((unsigned)m0) + __popc((unsigned)m1) + __popc((unsigned)m2) + __popc((unsigned)m3);
            const int n1 = __popc((unsigned)(m0 >> 32)) + __popc((unsigned)(m1 >> 32)) + __popc((unsigned)(m2 >> 32)) + __popc((unsigned)(m3 >> 32));
            T0 = (n0 >= 16) ? c0 : T0; T1 = (n1 >= 16) ? c1 : T1;
        }
        const unsigned T = half ? T1 : T0;
        int ngt = 0, eqb = 0; unsigned long long me[4];
#pragma unroll
        for (int q = 0; q < 4; ++q) { const unsigned long long mg = __ballot(k[q] > T) & hmask; me[q] = __ballot(k[q] == T) & hmask; ngt += __popcll(mg); eqb += __popcll(me[q] & lt_mask); }
        const int need = 16 - ngt;
        bool sl[4]; int run = eqb;
#pragma unroll
        for (int q = 0; q < 4; ++q) { const bool eq = k[q] == T; sl[q] = (k[q] > T) || (eq && run < need); run += eq ? 1 : 0; }
        int pos = 0;
#pragma unroll
        for (int q = 0; q < 4; ++q) pos += __popcll(__ballot(sl[q]) & hmask & lt_mask);
#pragma unroll
        for (int q = 0; q < 4; ++q) { if (sl[q]) { selv[half * 16 + pos] = __uint_as_float(b[q] << 16); seli[half * 16 + pos] = 4 * lh + q; } pos += sl[q] ? 1 : 0; }
        const float v = selv[half * 16 + (lh & 15)]; const int ix = seli[half * 16 + (lh & 15)];
        int rank = 0;
#define PS_ROT(R) { const float vo = __int_as_float(__builtin_amdgcn_update_dpp(0, __float_as_int(v), 0x120 + (R), 0xF, 0xF, true)); const int io = __builtin_amdgcn_update_dpp(0, ix, 0x120 + (R), 0xF, 0xF, true); rank += (vo > v || (vo == v && io < ix)) ? 1 : 0; }
        PS_ROT(1) PS_ROT(2) PS_ROT(3) PS_ROT(4) PS_ROT(5) PS_ROT(6) PS_ROT(7) PS_ROT(8) PS_ROT(9) PS_ROT(10) PS_ROT(11) PS_ROT(12) PS_ROT(13) PS_ROT(14) PS_ROT(15)
#undef PS_ROT
        if (lh < 16) { srtv[half * 16 + rank] = v; srti[half * 16 + rank] = ix; }
        int ca, cb; const int c = lane;
        if (c < 16) { ca = 0; cb = c; } else if (c < 24) { ca = 1; cb = c - 16; } else if (c < 29) { ca = 2; cb = c - 24; } else if (c < 33) { ca = 3; cb = c - 29; }
        else if (c < 36) { ca = 4; cb = c - 33; } else if (c < 38) { ca = 5; cb = c - 36; } else if (c < 40) { ca = 6; cb = c - 38; } else if (c < 42) { ca = 7; cb = c - 40; }
        else { ca = (c - 42 + 8) & 15; cb = 0; }
        float s = srtv[ca] + srtv[16 + cb];
        const int eid = srti[ca] * 128 + srti[16 + cb];
        if (c >= 50) s = NINF;
        int rk = 0;
#pragma unroll 10
        for (int j = 0; j < 50; ++j) { const float sj = __shfl(s, j); rk += (sj > s || (sj == s && j < c)) ? 1 : 0; }
        const bool selq = (c < 50) && (rk < 16);
        const float smax = __shfl(s, 0);
        const float e = selq ? __expf(s - smax) : 0.f;
        const float esum = wave_sum(e);
        const unsigned long long ms = __ballot(selq);
        const int p = __popcll(ms & lt_mask);
        if (selq) { elist[h * 16 + p] = eid; gl[h * 16 + p] = e / esum; }
    }
}
__device__ __forceinline__ float dot32_f8(u32x4 wa, u32x4 wb, u32x4 ha, u32x4 hb) {
    float acc = 0.f;
#pragma unroll
    for (int d = 0; d < 4; ++d) {
        acc = __builtin_amdgcn_fdot2_f32_bf16(__builtin_amdgcn_cvt_scalef32_pk_bf16_fp8((int)wa[d], 1.0f, false), __builtin_amdgcn_cvt_scalef32_pk_bf16_fp8((int)ha[d], 1.0f, false), acc, false);
        acc = __builtin_amdgcn_fdot2_f32_bf16(__builtin_amdgcn_cvt_scalef32_pk_bf16_fp8((int)wa[d], 1.0f, true), __builtin_amdgcn_cvt_scalef32_pk_bf16_fp8((int)ha[d], 1.0f, true), acc, false);
        acc = __builtin_amdgcn_fdot2_f32_bf16(__builtin_amdgcn_cvt_scalef32_pk_bf16_fp8((int)wb[d], 1.0f, false), __builtin_amdgcn_cvt_scalef32_pk_bf16_fp8((int)hb[d], 1.0f, false), acc, false);
        acc = __builtin_amdgcn_fdot2_f32_bf16(__builtin_amdgcn_cvt_scalef32_pk_bf16_fp8((int)wb[d], 1.0f, true), __builtin_amdgcn_cvt_scalef32_pk_bf16_fp8((int)hb[d], 1.0f, true), acc, false); }
    return acc;
}
__device__ __forceinline__ void phase10_peer(Frame& F) {
    const bf16_t* sub = (const bf16_t*)(F.ws + WS_SUB); const bf16_t* h2 = (const bf16_t*)(F.ws + WS_H2);
    const unsigned char* pu = F.ws + WS_PU; unsigned* pairs = (unsigned*)(F.ws + WS_PAIRS);
    const int gw = F.bid * 8 + F.wave, NGW = F.G * 8;
    unsigned char* wb = F.lds + F.wave * 18944;
    unsigned char* h2f8 = wb; unsigned short* gl16 = (unsigned short*)(wb + 16384); unsigned* hist = (unsigned*)(wb + 18432); unsigned* base = hist + 32;
    unsigned* tmp = (unsigned*)wb; int* elist = (int*)(wb + 4096); float* gl = (float*)(wb + 4608);
    unsigned* wls = (unsigned*)(F.ws + WS_WLS) + (size_t)gw * 1024;
    const int ntok = (MTOK - gw + NGW - 1) / NGW;
    for (int p0 = 0; p0 < ntok; p0 += 8) {
        int lane = F.lane; asm volatile("" : "+v"(lane));
        const int nt = (ntok - p0) < 8 ? (ntok - p0) : 8, ne = nt * 128;
#pragma unroll 1
        for (int i = 0; i < nt; ++i) {
            const int row = gw + (p0 + i) * NGW;
            peer_select(sub + (size_t)row * 2048, lane, elist, gl, (float*)(wb + 5120));
#if PROBE_SEL
            asm volatile("" : "+v"(lane)); peer_select(sub + (size_t)row * 2048, lane, elist, gl, (float*)(wb + 5120));
#endif
            tmp[i * 128 + lane] = ((unsigned)(i * 128 + lane) << 14) | (unsigned)elist[lane];
            tmp[i * 128 + 64 + lane] = ((unsigned)(i * 128 + 64 + lane) << 14) | (unsigned)elist[64 + lane];
            gl16[i * 128 + lane] = (unsigned short)(cvt_pk_bf16(gl[lane], 0.f) & 0xffffu); gl16[i * 128 + 64 + lane] = (unsigned short)(cvt_pk_bf16(gl[64 + lane], 0.f) & 0xffffu);
        }
        asm volatile("" : "+v"(lane));
        if (lane < 32) hist[lane] = 0u;
        unsigned ent[16]; unsigned rk[16];
#pragma unroll
        for (int q = 0; q < 16; ++q) { const int e = q * 64 + lane; ent[q] = (e < ne) ? tmp[e] : 0u; rk[q] = (e < ne) ? atomicAdd(&hist[(ent[q] & 0x3FFFu) >> 9], 1u) : 0u; }
        { int hv = lane < 32 ? (int)hist[lane] : 0; int x = hv;
          x += __builtin_amdgcn_update_dpp(0, x, 0x111, 0xF, 0xF, true); x += __builtin_amdgcn_update_dpp(0, x, 0x112, 0xF, 0xF, true);
          x += __builtin_amdgcn_update_dpp(0, x, 0x114, 0xF, 0xF, true); x += __builtin_amdgcn_update_dpp(0, x, 0x118, 0xF, 0xF, true);
          const int t0 = __builtin_amdgcn_readlane(x, 15); if (lane >= 16) x += t0;
          if (lane < 32) base[lane] = (unsigned)(x - hv); }
#pragma unroll
        for (int q = 0; q < 16; ++q) { const int e = q * 64 + lane; if (e < ne) wls[base[(ent[q] & 0x3FFFu) >> 9] + rk[q]] = ent[q]; }
#pragma unroll 1
        for (int i = 0; i < nt; ++i) { const bf16_t* hr = h2 + (size_t)(gw + (p0 + i) * NGW) * 2048 + lane * 16;
#pragma unroll
            for (int hh = 0; hh < 2; ++hh) { f32x4 a, b, c, d; unpack8(*(const u32x4*)(hr + hh * 1024), a, b); unpack8(*(const u32x4*)(hr + hh * 1024 + 8), c, d);
                const u32x2 lo = pack8_fp8(a, b), hi = pack8_fp8(c, d);
                *(u32x4*)(h2f8 + i * 2048 + hh * 1024 + lane * 16) = (u32x4){lo.x, lo.y, hi.x, hi.y}; } }
        asm volatile("s_waitcnt vmcnt(0)" ::: "memory");
#pragma unroll 1
        for (int c = 0; c < ne; c += 64) {
            const unsigned ent64 = __hip_atomic_load(wls + c + lane, __ATOMIC_RELAXED, __HIP_MEMORY_SCOPE_AGENT);
#pragma unroll 1
            for (int i0 = 0; i0 < 64; i0 += 8) {
                u32x4 w[8][2]; unsigned en[8];
#pragma unroll
                for (int jj = 0; jj < 8; ++jj) { en[jj] = (unsigned)__builtin_amdgcn_readlane((int)ent64, i0 + jj); const unsigned char* ur = pu + (size_t)(en[jj] & 0x3FFFu) * 2048 + lane * 16;
                    w[jj][0] = *(const u32x4*)ur; w[jj][1] = *(const u32x4*)(ur + 1024); }
                float pr[8];
#pragma unroll
                for (int jj = 0; jj < 8; ++jj) { const unsigned char* hp = h2f8 + (en[jj] >> 21) * 2048 + lane * 16;
                    pr[jj] = dot32_f8(w[jj][0], w[jj][1], *(const u32x4*)hp, *(const u32x4*)(hp + 1024)); __builtin_amdgcn_sched_barrier(0); }
#pragma unroll
                for (int i = 0; i < 4; ++i) pr[i] = swap32_pair(pr[i], pr[i + 4]);
#pragma unroll
                for (int i = 0; i < 2; ++i) pr[i] = swap16_pair(pr[i], pr[i + 2]);
                const bool b3 = (lane & 8) != 0;
                { const float snd = b3 ? pr[0] : pr[1], kp = b3 ? pr[1] : pr[0]; pr[0] = kp + dpp_f<DPP_ROR8>(snd); }
                float tot = pr[0]; tot += dpp_f<DPP_XOR1>(tot); tot += dpp_f<DPP_XOR2>(tot); tot += dpp_f<DPP_HMIRROR>(tot);
                const unsigned em = (unsigned)__shfl((int)ent64, i0 + (lane >> 3));
                if ((lane & 7) == 0) {
                    const int tk = (int)(em >> 21), j = (int)((em >> 14) & 127u), row = gw + (p0 + tk) * NGW;
                    const float cf = gelu_erf(tot * (1.0f / 64.0f)) * __uint_as_float((unsigned)gl16[tk * 128 + j] << 16);
                    pairs[((size_t)(row >> 6) * 128 + j) * 64 + (row & 63)] = (cvt_pk_bf16(0.f, cf) & 0xffff0000u) | (em & 0x3FFFu);
                }
            }
        }
    }
}

__device__ __forceinline__ void phase11_peer_v(Frame& F, float* dst) {
    const unsigned* pairs = (const unsigned*)(F.ws + WS_PAIRS); const float* mf = (const float*)(F.ws + WS_MODF);
    unsigned long long* vs = (unsigned long long*)F.lds;
    for (int c = F.bid; c < DM / 8; c += F.G) {
        __syncthreads();
        { const u32x4* src = (const u32x4*)(F.ws + WS_PV + (size_t)c * NEXP * 8); u32x4* dst = (u32x4*)F.lds;
#pragma unroll 4
          for (int i = F.tid; i < NEXP * 8 / 16; i += 512) dst[i] = src[i]; }
        __syncthreads();
        for (int tile = F.wave; tile < MTOK / 64; tile += 8) {
            int lane = F.lane; asm volatile("" : "+v"(lane));
            const unsigned* pp = pairs + (size_t)tile * 128 * 64 + lane;
            f32x2 acc[4];
#pragma unroll
            for (int i = 0; i < 4; ++i) acc[i] = (f32x2){0.f, 0.f};
#define P11_LOAD(dst, j0) do { _Pragma("unroll") for (int jj = 0; jj < 16; ++jj) dst[jj] = pp[((j0) + jj) * 64]; } while (0)
#define P11_COMP(src) do { _Pragma("unroll") for (int jj = 0; jj < 16; ++jj) { const unsigned long long v = vs[src[jj] & 0x3FFFu]; const float cf = __uint_as_float(src[jj] & 0xffff0000u); \
                    const int lo = (int)(unsigned)v, hi = (int)(unsigned)(v >> 32); \
                    acc[0] += __builtin_amdgcn_cvt_pk_f32_fp8(lo, false) * cf; acc[1] += __builtin_amdgcn_cvt_pk_f32_fp8(lo, true) * cf; \
                    acc[2] += __builtin_amdgcn_cvt_pk_f32_fp8(hi, false) * cf; acc[3] += __builtin_amdgcn_cvt_pk_f32_fp8(hi, true) * cf; } } while (0)
#if PROBE_P11X
            { f32x2 sv[4]; for (int i = 0; i < 4; ++i) sv[i] = acc[i];
            unsigned pa[16], pb[16];
            P11_LOAD(pa, 0);
#pragma unroll 1
            for (int j0 = 0; j0 < 128; j0 += 32) {
                P11_LOAD(pb, j0 + 16);
                P11_COMP(pa);
                if (j0 + 32 < 128) P11_LOAD(pa, j0 + 32);
                P11_COMP(pb);
            }
              asm volatile("" :: "v"(acc[0].x), "v"(acc[1].x), "v"(acc[2].x), "v"(acc[3].x)); for (int i = 0; i < 4; ++i) acc[i] = sv[i] * 0.f; }
#endif
            unsigned pa[16], pb[16];
            P11_LOAD(pa, 0);
#pragma unroll 1
            for (int j0 = 0; j0 < 128; j0 += 32) {
                P11_LOAD(pb, j0 + 16);
                P11_COMP(pa);
                if (j0 + 32 < 128) P11_LOAD(pa, j0 + 32);
                P11_COMP(pb);
            }
#undef P11_LOAD
#undef P11_COMP
            const int row = tile * 64 + lane;
            const float* gt2 = mf + (size_t)(tile / (SEQ / 64)) * 12288 + 10240 + c * 8;
            const float* ip = F.out + (size_t)row * 2048 + c * 8; float* op = dst + (size_t)row * 2048 + c * 8;
            const f32x4 x0 = *(const f32x4*)ip, x1 = *(const f32x4*)(ip + 4), g0 = *(const f32x4*)gt2 * 0.25f, g1 = *(const f32x4*)(gt2 + 4) * 0.25f;
            *(f32x4*)op = x0 + g0 * (f32x4){acc[0].x, acc[0].y, acc[1].x, acc[1].y};
            *(f32x4*)(op + 4) = x1 + g1 * (f32x4){acc[2].x, acc[2].y, acc[3].x, acc[3].y};
        }
    }
}

__global__ void __launch_bounds__(512, 2) fwd_kernel(Args args) {
    extern __shared__ __attribute__((aligned(16))) unsigned char lds[];
    Frame F;
    F.lds = lds; F.ws = args.ws; F.tid = threadIdx.x; F.lane = F.tid & 63; F.wave = __builtin_amdgcn_readfirstlane(F.tid >> 6); F.G = gridDim.x; F.bid = blockIdx.x;
    F.x = args.in[0]; F.c = args.in[1]; F.w_ada = args.in[2]; F.b_ada = args.in[3]; F.g1 = args.in[4]; F.g2 = args.in[5]; F.w_in = args.in[6]; F.g_q = args.in[7]; F.g_k = args.in[8];
    F.rel_bias = args.in[9]; F.pool_w = args.in[10]; F.pool_scale = args.in[11]; F.w_ab = args.in[12]; F.w_pb = args.in[13]; F.w_out = args.in[14]; F.w_pq = args.in[15];
    F.peer_keys = args.in[16]; F.peer_u = args.in[17]; F.peer_v = args.in[18]; F.out = args.out;
    LAS unsigned char* ldsl = (LAS unsigned char*)lds;
    volatile LAS unsigned* misc = (volatile LAS unsigned*)(ldsl + MISC_OFF);
    if (F.tid < 4) misc[F.tid] = 0u;
    __syncthreads();
    unsigned* barw = (unsigned*)(args.ws + WS_CTL) + (size_t)args.li * XCD_BAR_WORDS;
    XcdBarrier bar; bar.bar = barw; bar.x = 0; bar.st = misc;
    const int lo = args.ph_lo, hi = args.ph_hi;
    if (hi - lo > 1) bar = xcd_barrier_post(barw, misc);
#define IN(k) (lo <= (k) && (k) < hi)
#define SEAM(k) do { if (IN(k) && IN((k) + 1)) xcd_barrier(bar); } while (0)
    bf16_t* R0 = (bf16_t*)(F.ws + WS_R0);

#define PH2_BODY { \
        pg8::Gemm g{R0, (const bf16_t*)(F.ws + WS_WIN), MTOK, INWP, DM, DM, 0}; pg8::StaticOrder S; S.init(MTOK, INWP, F.G, F.bid); \
        EpiInproj E{(bf16_t*)(F.ws + WS_QN), (bf16_t*)(F.ws + WS_KN), (bf16_t*)(F.ws + WS_V), (bf16_t*)(F.ws + WS_IQ), (bf16_t*)(F.ws + WS_IK), (bf16_t*)(F.ws + WS_PL), \
                    (bf16_t*)(F.ws + WS_GA), (bf16_t*)(F.ws + WS_GP), (float*)(F.ws + WS_IW)}; \
        pg8::gemm_phase<EpiInproj>(ldsl, g, S, E); }
#define PH3_BODY { phase3_pooled(F); phase3_indexer(F); __syncthreads(); }
#define PH4_BODY { \
        phase4_attention(F); \
        __syncthreads(); \
        pg8::Gemm g{(const bf16_t*)(F.ws + WS_POOLED), (const bf16_t*)(F.ws + WS_POOLW), MTOK, PW, 256, 1024, 256}; pg8::StaticOrder S; S.init(MTOK, PW, F.G, F.bid); \
        EpiBf16Scale E{(bf16_t*)(F.ws + WS_POOL2), 1024, F.pool_scale}; \
        pg8::gemm_phase<EpiBf16Scale>(ldsl, g, S, E); }
#define PH5_BODY { \
        { pg8::Gemm g{(const bf16_t*)(F.ws + WS_ATTN), (const bf16_t*)(F.ws + WS_WAB), MTOK, DM, 1024, 1024, 0}; pg8::StaticOrder S; S.init(MTOK, DM, F.G, F.bid); \
          EpiGate<false> E{R0, (const bf16_t*)(F.ws + WS_GA)}; pg8::gemm_phase<EpiGate<false>>(ldsl, g, S, E); } \
        { pg8::Gemm g{(const bf16_t*)(F.ws + WS_POOL2), (const bf16_t*)(F.ws + WS_WPB), MTOK, DM, 1024, 1024, 0}; pg8::StaticOrder S; S.init(MTOK, DM, F.G, F.bid); \
          EpiGate<true> E{R0, (const bf16_t*)(F.ws + WS_GP)}; pg8::gemm_phase<EpiGate<true>>(ldsl, g, S, E); } }
#define PH6_BODY { \
        pg8::Gemm g{R0, (const bf16_t*)(F.ws + WS_WOUT), MTOK, DM, DM, DM, 0}; pg8::StaticOrder S; S.init(MTOK, DM, F.G, F.bid); \
        EpiResid E{F.x, F.out, (const float*)(F.ws + WS_MODF) + 4096}; pg8::gemm_phase<EpiResid>(ldsl, g, S, E); }
#define PH8_BODY { \
        pg8::Gemm g{(const bf16_t*)(F.ws + WS_H2), (const bf16_t*)(F.ws + WS_WPQ), MTOK, DM, DM, DM, 0}; pg8::StaticOrder S; S.init(MTOK, DM, F.G, F.bid); \
        EpiBf16Scale E{R0, 2048, nullptr}; pg8::gemm_phase<EpiBf16Scale>(ldsl, g, S, E); }
#define PH9_BODY { \
        pg8::Gemm g{R0, (const bf16_t*)(F.ws + WS_KEYSBD), MTOK, DM, 256, DM, 256}; pg8::StaticOrder S; S.init(MTOK, DM, F.G, F.bid); \
        EpiBf16Scale E{(bf16_t*)(F.ws + WS_SUB), 2048, nullptr}; pg8::gemm_phase<EpiBf16Scale>(ldsl, g, S, E); }
#define REP(k) if constexpr (((PROBE_REP) >> (k)) & 1)

    if (IN(0)) { phase0_prep(F); REP(0) { __syncthreads(); phase0_prep(F); } }
    SEAM(0);
    if (IN(1)) { phase_modnorm<true>(F, F.x, F.g1, 0, 2048, R0); REP(1) { phase_modnorm<true>(F, F.x, F.g1, 0, 2048, R0); } }
    SEAM(1);
    if (IN(2)) { PH2_BODY REP(2) PH2_BODY }
    SEAM(2);
    if (IN(3)) { phase3_qknorm(F); PH3_BODY REP(3) PH3_BODY }
    SEAM(3);
    if (IN(4)) { PH4_BODY REP(4) PH4_BODY }
    SEAM(4);
    if (IN(5)) { PH5_BODY REP(5) PH5_BODY }
    SEAM(5);
    if (IN(6)) { PH6_BODY REP(6) PH6_BODY }
    SEAM(6);
    if (IN(7)) { phase_modnorm<false>(F, F.out, F.g2, 6144, 8192, (bf16_t*)(F.ws + WS_H2)); REP(7) { phase_modnorm<false>(F, F.out, F.g2, 6144, 8192, (bf16_t*)(F.ws + WS_H2)); } }
    SEAM(7);
    if (IN(8)) { PH8_BODY REP(8) PH8_BODY }
    SEAM(8);
    if (IN(9)) { PH9_BODY REP(9) PH9_BODY }
    SEAM(9);
    if (IN(10)) { phase10_peer(F); REP(10) phase10_peer(F); }
    SEAM(10);
    if (IN(11)) { REP(11) { phase11_peer_v(F, (float*)(F.ws + WS_SUB)); } phase11_peer_v(F, F.out); }
#undef IN
#undef SEAM
}

extern "C" void kernel_launch(void* const* d_in, const int* in_sizes, int n_in, void* d_out, int out_size, void* d_ws, size_t ws_size, hipStream_t stream) {
    static int grid = 0;
    if (grid == 0) {
        if (n_in != 19 || out_size != MTOK * DM || ws_size < WS_END) { fprintf(stderr, "kernel_launch: unexpected shapes (n_in %d out %d ws %zu)\n", n_in, out_size, ws_size); grid = -1; return; }
        int dev = 0, cus = 0, per_cu = 0;
        if (hipGetDevice(&dev) != hipSuccess || hipDeviceGetAttribute(&cus, hipDeviceAttributeMultiprocessorCount, dev) != hipSuccess) { grid = -1; return; }
        if (hipFuncSetAttribute((const void*)fwd_kernel, hipFuncAttributeMaxDynamicSharedMemorySize, LDS_BYTES) != hipSuccess) { fprintf(stderr, "kernel_launch: hipFuncSetAttribute failed\n"); grid = -1; return; }
        if (hipOccupancyMaxActiveBlocksPerMultiprocessor(&per_cu, (const void*)fwd_kernel, 512, LDS_BYTES) != hipSuccess || per_cu < 1) { fprintf(stderr, "kernel_launch: occupancy query says %d\n", per_cu); }
        (void)hipGetLastError();
        grid = cus;
    }
    if (grid < 0) return;
    (void)in_sizes;
    if (hipMemsetAsync((char*)d_ws + WS_CTL, 0, CTL_ZERO_BYTES, stream) != hipSuccess) return;
    Args a{};
    for (int i = 0; i < 19; ++i) a.in[i] = (const float*)d_in[i];
    a.out = (float*)d_out; a.ws = (unsigned char*)d_ws;
#if MK_PER_PHASE
    for (int p = 0; p < NPHASE; ++p) { a.ph_lo = p; a.ph_hi = p + 1; a.li = p; hipLaunchKernelGGL(fwd_kernel, dim3(grid), dim3(512), LDS_BYTES, stream, a); }
#else
    a.ph_lo = 0; a.ph_hi = NPHASE; a.li = 0;
    hipLaunchKernelGGL(fwd_kernel, dim3(grid), dim3(512), LDS_BYTES, stream, a);
#endif
}
```

```cpp
#include <hip/hip_runtime.h>
#include <cstdio>
#include <cstdint>

#ifndef MK_PER_PHASE
#define MK_PER_PHASE 0
#endif

#ifndef PROBE_REP
#define PROBE_REP 0
#endif
#ifndef PROBE_IDX
#define PROBE_IDX 0
#endif
#ifndef PROBE_SEL
#define PROBE_SEL 0
#endif
#ifndef PROBE_P11X
#define PROBE_P11X 0
#endif
#define LAS __attribute__((address_space(3)))
typedef unsigned short bf16_t;
typedef short bf16x8 __attribute__((ext_vector_type(8)));
typedef float f32x4 __attribute__((ext_vector_type(4)));
typedef float f32x2 __attribute__((ext_vector_type(2)));
typedef unsigned u32x4 __attribute__((ext_vector_type(4)));
typedef unsigned u32x2 __attribute__((ext_vector_type(2)));

constexpr int BATCH = 8, SEQ = 4096, DM = 2048, MTOK = BATCH * SEQ;
constexpr int NHEAD = 8, HDIM = 128, AW = 1024, KVW = 256, IHEADS = 16, IDIM = 64, KSEL = 256;
constexpr int PW = 1024, PHEADS = 8, NEXP = 16384;
constexpr int INW = 7760, INWP = 7936;
constexpr float EPS = 1e-6f;
constexpr int NPHASE = 12;

constexpr size_t MiB = 1u << 20;
constexpr size_t WS_CTL = 0, CTL_ZERO_BYTES = 256 * 1024;
constexpr size_t WS_MODP = 2 * MiB;
constexpr size_t WS_MODF = 4 * MiB;
constexpr size_t WS_POOLW = 5 * MiB;
constexpr size_t WS_KEYSBD = 6 * MiB;
constexpr size_t WS_WIN = 8 * MiB;
constexpr size_t WS_WAB = 40 * MiB, WS_WPB = 44 * MiB, WS_WOUT = 48 * MiB, WS_WPQ = 56 * MiB;
constexpr size_t WS_PU = 64 * MiB, WS_PV = 128 * MiB;
constexpr size_t WS_R0 = 192 * MiB;
constexpr size_t WS_GA = 320 * MiB, WS_GP = 448 * MiB;
constexpr size_t WS_SUB = 320 * MiB;
constexpr size_t WS_QN = 576 * MiB;
constexpr size_t WS_IQ = 640 * MiB;
constexpr size_t WS_PL = 704 * MiB;
constexpr size_t WS_KN = 768 * MiB, WS_V = 784 * MiB;
constexpr size_t WS_IK = 800 * MiB;
constexpr size_t WS_IW = 804 * MiB;
constexpr size_t WS_SEL = 806 * MiB;
constexpr size_t WS_POOLED = 822 * MiB;
constexpr size_t WS_H2 = 886 * MiB;
constexpr size_t WS_END = 1014 * MiB;
constexpr size_t WS_Q8 = WS_H2, WS_K8 = WS_H2 + 32 * MiB, WS_V8 = WS_H2 + 40 * MiB;
constexpr size_t WS_ATTN = WS_IQ, WS_POOL2 = WS_PL, WS_PAIRS = WS_QN, WS_WLS = WS_QN + 32 * MiB;

constexpr int LDS_BYTES = 160 * 1024;
constexpr int MISC_OFF = 159 * 1024;

__device__ __forceinline__ unsigned cvt_pk_bf16(float lo, float hi) { unsigned r; asm volatile("v_cvt_pk_bf16_f32 %0, %1, %2" : "=v"(r) : "v"(lo), "v"(hi)); return r; }
__device__ __forceinline__ float bf_lo(unsigned w) { return __uint_as_float(w << 16); }
__device__ __forceinline__ float bf_hi(unsigned w) { return __uint_as_float(w & 0xffff0000u); }
template <int CTRL> __device__ __forceinline__ float dpp_f(float x) { return __int_as_float(__builtin_amdgcn_update_dpp(0, __float_as_int(x), CTRL, 0xF, 0xF, true)); }
#define DPP_XOR1 0xB1
#define DPP_XOR2 0x4E
#define DPP_HMIRROR 0x141
#define DPP_MIRROR 0x140
#define DPP_ROR8 0x128
__device__ __forceinline__ float xor16_sum(float x) { const auto r = __builtin_amdgcn_permlane16_swap(__float_as_uint(x), __float_as_uint(x), false, false); return __uint_as_float(r[0]) + __uint_as_float(r[1]); }
__device__ __forceinline__ float xor32_sum(float x) { const auto r = __builtin_amdgcn_permlane32_swap(__float_as_uint(x), __float_as_uint(x), false, false); return __uint_as_float(r[0]) + __uint_as_float(r[1]); }
__device__ __forceinline__ float xor16_max(float x) { const auto r = __builtin_amdgcn_permlane16_swap(__float_as_uint(x), __float_as_uint(x), false, false); return fmaxf(__uint_as_float(r[0]), __uint_as_float(r[1])); }
__device__ __forceinline__ float swap32_pair(float a, float b) { const auto r = __builtin_amdgcn_permlane32_swap(__float_as_uint(a), __float_as_uint(b), false, false); return __uint_as_float(r[0]) + __uint_as_float(r[1]); }
__device__ __forceinline__ float swap16_pair(float a, float b) { const auto r = __builtin_amdgcn_permlane16_swap(__float_as_uint(a), __float_as_uint(b), false, false); return __uint_as_float(r[0]) + __uint_as_float(r[1]); }
__device__ __forceinline__ float row_sum16(float v) { v += dpp_f<DPP_XOR1>(v); v += dpp_f<DPP_XOR2>(v); v += dpp_f<DPP_HMIRROR>(v); v += dpp_f<DPP_MIRROR>(v); return v; }
__device__ __forceinline__ float row_max16(float v) { v = fmaxf(v, dpp_f<DPP_XOR1>(v)); v = fmaxf(v, dpp_f<DPP_XOR2>(v)); v = fmaxf(v, dpp_f<DPP_HMIRROR>(v)); v = fmaxf(v, dpp_f<DPP_MIRROR>(v)); return v; }
__device__ __forceinline__ float wave_sum(float v) { return xor32_sum(xor16_sum(row_sum16(v))); }
__device__ __forceinline__ float sigmoidf_(float x) { return __builtin_amdgcn_rcpf(1.0f + __expf(-x)); }
__device__ __forceinline__ float dot8(u32x4 w, const float* h) {
    return bf_lo(w.x) * h[0] + bf_hi(w.x) * h[1] + bf_lo(w.y) * h[2] + bf_hi(w.y) * h[3] + bf_lo(w.z) * h[4] + bf_hi(w.z) * h[5] + bf_lo(w.w) * h[6] + bf_hi(w.w) * h[7];
}

#define XB_TMO      128
#define XB_XCNT(j)  (256  + 64 * (j))
#define XB_XSUB(j)  (1280 + 64 * (j))
#define XB_XGEN(j)  (2304 + 64 * (j))
#define XB_TOP      3328
#define XB_TOPGEN   3392
#define XCD_BAR_WORDS 3456
#define XB_SPIN_CAP (1u << 18)

__device__ __forceinline__ unsigned xb_ld(unsigned* p)              { return __hip_atomic_load(p, __ATOMIC_RELAXED, __HIP_MEMORY_SCOPE_AGENT); }
__device__ __forceinline__ unsigned xb_add(unsigned* p, unsigned v) { return __hip_atomic_fetch_add(p, v, __ATOMIC_RELAXED, __HIP_MEMORY_SCOPE_AGENT); }
__device__ __forceinline__ unsigned xb_xcc_id() { return (unsigned)__builtin_amdgcn_s_getreg((3 << 11) | 20) & 0xFu; }
#define XB_SPIN(cond, bar) do { unsigned _sp = 0; while (cond) { __builtin_amdgcn_s_sleep(1); \
    if ((++_sp & 255u) == 0u) { if (xb_ld(&(bar)[XB_TMO])) break; if (_sp > XB_SPIN_CAP) { atomicAdd(&(bar)[XB_TMO], 1u); break; } } } } while (0)

struct XcdBarrier { unsigned* bar; unsigned x; volatile LAS unsigned* st; };

__device__ __forceinline__ XcdBarrier xcd_barrier_post(unsigned* bar, volatile LAS unsigned* st) {
    XcdBarrier b; b.bar = bar; b.x = xb_xcc_id(); b.st = st;
    if (threadIdx.x == 0) (void)xb_add(&bar[XB_XCNT(b.x)], 1u);
    return b;
}
__device__ __forceinline__ void xcd_barrier_complete(unsigned* bar, unsigned x, unsigned& nloc, unsigned& nx) {
    const unsigned G = gridDim.x * gridDim.y * gridDim.z;
    unsigned sum, cnt, mine, sp = 0u;
    for (;;) {
        sum = 0u; cnt = 0u; mine = 0u;
#pragma unroll
        for (unsigned j = 0; j < 16; ++j) { const unsigned c = xb_ld(&bar[XB_XCNT(j)]); sum += c; cnt += (c > 0u) ? 1u : 0u; mine = (j == x) ? c : mine; }
        if (sum == G) break;
        __builtin_amdgcn_s_sleep(1);
        if ((++sp & 255u) == 0u) { if (xb_ld(&bar[XB_TMO])) break; if (sp > XB_SPIN_CAP) { atomicAdd(&bar[XB_TMO], 1u); break; } }
    }
    nloc = mine > 0u ? mine : 1u; nx = cnt > 0u ? cnt : 1u;
}
__device__ __forceinline__ void xcd_barrier(const XcdBarrier& b) {
    asm volatile("s_waitcnt vmcnt(0)" ::: "memory");
    __syncthreads();
    if (threadIdx.x == 0) {
        unsigned* bar = b.bar;
        __builtin_amdgcn_s_waitcnt(0);
        unsigned nloc = b.st[0], nx = b.st[1];
        if (nloc == 0u) { xcd_barrier_complete(bar, b.x, nloc, nx); b.st[0] = nloc; b.st[1] = nx; }
        const unsigned old = xb_add(&bar[XB_XSUB(b.x)], 1u);
        const unsigned gen = old / nloc;
        if (old + 1u == (gen + 1u) * nloc) {
            __builtin_amdgcn_fence(__ATOMIC_RELEASE, "agent");
            asm volatile("s_waitcnt vmcnt(0)" ::: "memory");
            const unsigned og = xb_add(&bar[XB_TOP], 1u);
            const unsigned tg = og / nx;
            if (og + 1u == (tg + 1u) * nx) xb_add(&bar[XB_TOPGEN], 1u);
            else XB_SPIN(xb_ld(&bar[XB_TOPGEN]) == tg, bar);
            __builtin_amdgcn_fence(__ATOMIC_ACQUIRE, "agent");
            xb_add(&bar[XB_XGEN(b.x)], 1u);
            asm volatile("s_waitcnt vmcnt(0)" ::: "memory");
        } else {
            XB_SPIN(xb_ld(&bar[XB_XGEN(b.x)]) == gen, bar);
            __builtin_amdgcn_fence(__ATOMIC_ACQUIRE, "agent");
            asm volatile("s_waitcnt vmcnt(0)" ::: "memory");
        }
    }
    __syncthreads();
}

namespace pg8 {
constexpr int BM = 256, BK = 64, HALF = 128, HTB = HALF * BK * 2, STAGE_BYTES = 8 * HTB, NXCD = 8, WGM = 8;
__device__ __forceinline__ int lds_byte(int r, int c) { const int st = (r >> 4) * 2 + (c >> 5), rr = r & 15, cc = c & 31, ob = rr * 64 + cc * 2; return st * 1024 + (ob ^ (((ob >> 9) & 1) << 5)); }
__device__ __forceinline__ void stage_rc(int b, int& R, int& C) { const int st = b / 1024, sb = b % 1024, swz = sb ^ (((sb >> 9) & 1) << 5); R = (st >> 1) * 16 + swz / 64; C = (st & 1) * 32 + (swz % 64) / 2; }
__device__ __forceinline__ int perm32(int rho) { const int n = rho >> 4, i = rho & 15; return 8 * (i >> 2) + 4 * n + (i & 3); }

struct Unit { int pm, pn; };
struct Gemm { const bf16_t* A; const bf16_t* Bt; int M, N, K, lda, a_pn_off; };

struct StaticOrder {
    int nM, nN, nwg, G, c;
    __device__ void init(int M, int N, int G_, int c_) { nM = M / BM; nN = N / BM; nwg = nM * nN; G = G_; c = c_; }
    __device__ bool next(int i, Unit& u) const {
        const long L = (long)i * G + c; if (L >= nwg) return false;
        int wgid = (int)L; { const int q = nwg / NXCD, r = nwg % NXCD, xcd = wgid % NXCD, off = wgid / NXCD; wgid = (xcd < r ? xcd * (q + 1) : r * (q + 1) + (xcd - r) * q) + off; }
        const int nig = WGM * nN, gid = wgid / nig, fm = gid * WGM, gsz = (nM - fm) < WGM ? (nM - fm) : WGM;
        u.pm = fm + ((wgid % nig) % gsz); u.pn = (wgid % nig) / gsz; return true;
    }
};

template <class Epi>
__device__ __forceinline__ void gemm_phase(LAS unsigned char* lds, const Gemm g, const StaticOrder& S, const Epi& E) {
    const int tid = threadIdx.x, wid = __builtin_amdgcn_readfirstlane(tid >> 6), lane = tid & 63, wr = wid >> 2, wc = wid & 3, fr = lane & 15, fq = lane >> 4;
    const int K = g.K, nt = K / BK, lda = g.lda;
    unsigned voffA[2], voffB[2];
#pragma unroll
    for (int i = 0; i < 2; ++i) { int R, C; stage_rc(tid * 16 + i * 8192, R, C); const int Rb = Epi::PERM ? ((R & ~31) + perm32(R & 31)) : R;
        voffA[i] = (unsigned)(R * lda + C) * 2u; voffB[i] = (unsigned)(Rb * K + C) * 2u; }
    const size_t kstep = (size_t)(BK * 2);
    const size_t hsA = (size_t)HALF * lda * 2, hsB = (size_t)HALF * K * 2;
    const size_t tsA = 2 * hsA, tsB = 2 * hsB;
    const unsigned ldsw = (unsigned)wid * 1024u;
    const int aoff = lds_byte(wr * 64 + fr, fq * 8), boff = lds_byte(wc * 32 + fr, fq * 8);
#define PG8_SA(b, h) (((b) * 2 + (h)) * HTB)
#define PG8_SB(b, h) ((4 + (b) * 2 + (h)) * HTB)
#define PG8_STAGE(bufoff, gbase, voff) do { _Pragma("unroll") for (int _i = 0; _i < 2; ++_i) \
        __builtin_amdgcn_global_load_lds((const unsigned*)((const char*)(gbase) + (voff)[_i]), (LAS unsigned*)(lds + (bufoff) + ldsw + _i * 8192), 16, 0, 0); } while (0)
#define PG8_LDA(dst, b, h) do { _Pragma("unroll") for (int m = 0; m < 4; ++m) _Pragma("unroll") for (int k = 0; k < 2; ++k) dst[m][k] = *(const LAS bf16x8*)(lds + PG8_SA(b, h) + aoff + m * 2048 + k * 1024); } while (0)
#define PG8_LDB(dst, b, h) do { _Pragma("unroll") for (int n = 0; n < 2; ++n) _Pragma("unroll") for (int k = 0; k < 2; ++k) dst[n][k] = *(const LAS bf16x8*)(lds + PG8_SB(b, h) + boff + n * 2048 + k * 1024); } while (0)
#define PG8_MMA(ai, bj, At, Bt) do { __builtin_amdgcn_s_setprio(1); _Pragma("unroll") for (int m = 0; m < 4; ++m) _Pragma("unroll") for (int n = 0; n < 2; ++n) _Pragma("unroll") for (int k = 0; k < 2; ++k) \
        acc[ai][bj][m][n] = __builtin_amdgcn_mfma_f32_16x16x32_bf16(Bt[n][k], At[m][k], acc[ai][bj][m][n], 0, 0, 0); __builtin_amdgcn_s_setprio(0); } while (0)
#define PG8_WAIT_V(n) asm volatile("s_waitcnt vmcnt(" #n ")" ::: "memory")
#define PG8_WAIT_L(n) asm volatile("s_waitcnt lgkmcnt(" #n ")" ::: "memory")
#define PG8_BAR __builtin_amdgcn_s_barrier()
#define PG8_SCHED __builtin_amdgcn_sched_barrier(0)
    Unit cur, nxt; int ui = 0;
    if (!S.next(0, cur)) return;
    f32x4 acc[2][2][4][2];
#pragma unroll
    for (int a = 0; a < 2; ++a)
#pragma unroll
        for (int b = 0; b < 2; ++b)
#pragma unroll
            for (int m = 0; m < 4; ++m)
#pragma unroll
                for (int n = 0; n < 2; ++n) acc[a][b][m][n] = (f32x4){0.f, 0.f, 0.f, 0.f};
    bf16x8 At[4][2], B0[2][2], B1[2][2];
    const char* cA = (const char*)g.A + (size_t)cur.pm * tsA + (size_t)cur.pn * g.a_pn_off * 2; const char* cB = (const char*)g.Bt + (size_t)cur.pn * tsB;
    PG8_STAGE(PG8_SB(0, 0), cB, voffB); PG8_STAGE(PG8_SB(0, 1), cB + hsB, voffB); PG8_STAGE(PG8_SA(0, 0), cA, voffA); PG8_STAGE(PG8_SA(0, 1), cA + hsA, voffA);
    if (wr == 1) PG8_BAR;
    PG8_WAIT_V(2); PG8_BAR;
    PG8_STAGE(PG8_SB(1, 0), cB + kstep, voffB); PG8_STAGE(PG8_SA(1, 0), cA + kstep, voffA); PG8_STAGE(PG8_SB(1, 1), cB + hsB + kstep, voffB);
    PG8_WAIT_V(6); PG8_BAR;
    for (;;) {
        const bool has_next = S.next(ui + 1, nxt);
        const char* nA = has_next ? (const char*)g.A + (size_t)nxt.pm * tsA + (size_t)nxt.pn * g.a_pn_off * 2 : cA; const char* nB = has_next ? (const char*)g.Bt + (size_t)nxt.pn * tsB : cB;
        for (int t = 0; t < nt; t += 2) {
            const bool last = (t == nt - 2);
            const char* a1 = cA + (size_t)(t + 1) * kstep;
            const char* a2 = last ? nA : cA + (size_t)(t + 2) * kstep; const char* b2 = last ? nB : cB + (size_t)(t + 2) * kstep;
            const char* a3 = a2 + kstep; const char* b3 = b2 + kstep;
            PG8_LDB(B0, 0, 0); PG8_LDB(B1, 0, 1); PG8_SCHED; PG8_LDA(At, 0, 0); PG8_STAGE(PG8_SA(1, 1), a1 + hsA, voffA);
            PG8_WAIT_V(8); PG8_WAIT_L(0); PG8_BAR; PG8_MMA(0, 0, At, B0); PG8_MMA(0, 1, At, B1); PG8_BAR; PG8_SCHED;
            PG8_LDA(At, 0, 1); PG8_STAGE(PG8_SB(0, 0), b2, voffB); PG8_STAGE(PG8_SB(0, 1), b2 + hsB, voffB); PG8_STAGE(PG8_SA(0, 0), a2, voffA);
            PG8_WAIT_V(8); PG8_WAIT_L(0); PG8_BAR; PG8_MMA(1, 0, At, B0); PG8_MMA(1, 1, At, B1); PG8_BAR; PG8_SCHED;
            PG8_LDB(B0, 1, 0); PG8_LDB(B1, 1, 1); PG8_SCHED; PG8_LDA(At, 1, 0); PG8_STAGE(PG8_SA(0, 1), a2 + hsA, voffA);
            PG8_WAIT_V(8); PG8_WAIT_L(0); PG8_BAR; PG8_MMA(0, 0, At, B0); PG8_MMA(0, 1, At, B1); PG8_BAR; PG8_SCHED;
            PG8_LDA(At, 1, 1); PG8_STAGE(PG8_SB(1, 0), b3, voffB); PG8_STAGE(PG8_SB(1, 1), b3 + hsB, voffB); PG8_STAGE(PG8_SA(1, 0), a3, voffA);
            PG8_WAIT_V(8); PG8_WAIT_L(0); PG8_BAR; PG8_MMA(1, 0, At, B0); PG8_MMA(1, 1, At, B1); PG8_BAR; PG8_SCHED;
        }
        if (wr == 0) PG8_BAR;
        E(acc, cur, wr, wc, fr, fq);
        if (!has_next) break;
#pragma unroll
        for (int a = 0; a < 2; ++a)
#pragma unroll
            for (int b = 0; b < 2; ++b)
#pragma unroll
                for (int m = 0; m < 4; ++m)
#pragma unroll
                    for (int n = 0; n < 2; ++n) acc[a][b][m][n] = (f32x4){0.f, 0.f, 0.f, 0.f};
        cur = nxt; cA = nA; cB = nB; ++ui;
        if (wr == 1) PG8_BAR;
    }
    PG8_WAIT_V(0);
    PG8_BAR;
#undef PG8_SA
#undef PG8_SB
#undef PG8_STAGE
#undef PG8_LDA
#undef PG8_LDB
#undef PG8_MMA
#undef PG8_WAIT_V
#undef PG8_WAIT_L
#undef PG8_BAR
#undef PG8_SCHED
}
}
using pg8::Unit;

typedef f32x4 AccT[2][2][4][2];
__device__ __forceinline__ u32x4 pack8(f32x4 a, f32x4 b) { u32x4 w; w.x = cvt_pk_bf16(a[0], a[1]); w.y = cvt_pk_bf16(a[2], a[3]); w.z = cvt_pk_bf16(b[0], b[1]); w.w = cvt_pk_bf16(b[2], b[3]); return w; }
__device__ __forceinline__ void unpack8(u32x4 w, f32x4& a, f32x4& b) { a = (f32x4){bf_lo(w.x), bf_hi(w.x), bf_lo(w.y), bf_hi(w.y)}; b = (f32x4){bf_lo(w.z), bf_hi(w.z), bf_lo(w.w), bf_hi(w.w)}; }

struct EpiInproj {
    static constexpr bool PERM = true;
    bf16_t *q, *k, *v, *iq, *ik, *pl, *ga, *gp; float* iw;
    __device__ __forceinline__ void operator()(const AccT& acc, const Unit& u, int wr, int wc, int fr, int fq) const {
        const int pn = u.pn, row0 = u.pm * 256 + wr * 64 + fr;
        if (pn == 10) {
            if (wc < 2) {
#pragma unroll
                for (int ai = 0; ai < 2; ++ai)
#pragma unroll
                    for (int m = 0; m < 4; ++m) { const size_t row = (size_t)(row0 + ai * 128 + m * 16);
                        *(u32x4*)(ik + row * 64 + wc * 32 + 8 * fq) = pack8(acc[ai][0][m][0], acc[ai][0][m][1]); }
            } else if (wc == 2) {
                if (fq < 2) {
#pragma unroll
                    for (int ai = 0; ai < 2; ++ai)
#pragma unroll
                        for (int m = 0; m < 4; ++m) { const size_t row = (size_t)(row0 + ai * 128 + m * 16);
                            *(f32x4*)(iw + row * 16 + 8 * fq) = acc[ai][0][m][0]; *(f32x4*)(iw + row * 16 + 8 * fq + 4) = acc[ai][0][m][1]; }
                }
            }
            return;
        }
        bf16_t* dst; int ld, tc; bool sg = false;
        if (pn < 4) { dst = q; ld = 1024; tc = pn * 256; }
        else if (pn == 4) { dst = k; ld = 256; tc = 0; }
        else if (pn == 5) { dst = v; ld = 256; tc = 0; }
        else if (pn < 10) { dst = iq; ld = 1024; tc = (pn - 6) * 256; }
        else if (pn < 15) { dst = pl; ld = 1024; tc = (pn - 11) * 256; }
        else if (pn < 23) { dst = ga; ld = 2048; tc = (pn - 15) * 256; sg = true; }
        else { dst = gp; ld = 2048; tc = (pn - 23) * 256; sg = true; }
        const int col0 = tc + wc * 32 + 8 * fq;
#pragma unroll
        for (int ai = 0; ai < 2; ++ai)
#pragma unroll
            for (int m = 0; m < 4; ++m) { bf16_t* rowp = dst + (size_t)(row0 + ai * 128 + m * 16) * ld + col0;
#pragma unroll
                for (int bj = 0; bj < 2; ++bj) { f32x4 v0 = acc[ai][bj][m][0], v1 = acc[ai][bj][m][1];
                    if (sg) {
#pragma unroll
                        for (int j = 0; j < 4; ++j) { v0[j] = sigmoidf_(v0[j]); v1[j] = sigmoidf_(v1[j]); } }
                    *(u32x4*)(rowp + bj * 128) = pack8(v0, v1); } }
    }
};
struct EpiBf16Scale {
    static constexpr bool PERM = true;
    bf16_t* O; int ldc; const float* cs;
    __device__ __forceinline__ void operator()(const AccT& acc, const Unit& u, int wr, int wc, int fr, int fq) const {
        const int row0 = u.pm * 256 + wr * 64 + fr, col0 = u.pn * 256 + wc * 32 + 8 * fq;
        f32x4 s[2][2];
#pragma unroll
        for (int bj = 0; bj < 2; ++bj)
#pragma unroll
            for (int n = 0; n < 2; ++n) s[bj][n] = cs ? *(const f32x4*)(cs + col0 + bj * 128 + 4 * n) : (f32x4){1.f, 1.f, 1.f, 1.f};
#pragma unroll
        for (int ai = 0; ai < 2; ++ai)
#pragma unroll
            for (int m = 0; m < 4; ++m) { bf16_t* rowp = O + (size_t)(row0 + ai * 128 + m * 16) * ldc + col0;
#pragma unroll
                for (int bj = 0; bj < 2; ++bj) *(u32x4*)(rowp + bj * 128) = pack8(acc[ai][bj][m][0] * s[bj][0], acc[ai][bj][m][1] * s[bj][1]); }
    }
};
template <bool ADD> struct EpiGate {
    static constexpr bool PERM = true;
    bf16_t* O; const bf16_t* gate;
    __device__ __forceinline__ void operator()(const AccT& acc, const Unit& u, int wr, int wc, int fr, int fq) const {
        const int row0 = u.pm * 256 + wr * 64 + fr, col0 = u.pn * 256 + wc * 32 + 8 * fq;
#pragma unroll
        for (int ai = 0; ai < 2; ++ai)
#pragma unroll
            for (int m = 0; m < 4; ++m) { const size_t off = (size_t)(row0 + ai * 128 + m * 16) * 2048 + col0;
#pragma unroll
                for (int bj = 0; bj < 2; ++bj) { f32x4 g0, g1; unpack8(*(const u32x4*)(gate + off + bj * 128), g0, g1);
                    f32x4 r0 = g0 * acc[ai][bj][m][0], r1 = g1 * acc[ai][bj][m][1];
                    if (ADD) { f32x4 o0, o1; unpack8(*(const u32x4*)(O + off + bj * 128), o0, o1); r0 += o0; r1 += o1; }
                    *(u32x4*)(O + off + bj * 128) = pack8(r0, r1); } }
    }
};
struct EpiResid {
    static constexpr bool PERM = false;
    const float* x; float* out; const float* gt;
    __device__ __forceinline__ void operator()(const AccT& acc, const Unit& u, int wr, int wc, int fr, int fq) const {
        const int row0 = u.pm * 256 + wr * 64 + fr, col0 = u.pn * 256 + wc * 32 + 4 * fq;
        const float* gtb = gt + (size_t)(u.pm / 16) * 12288;
        f32x4 g[2][2];
#pragma unroll
        for (int bj = 0; bj < 2; ++bj)
#pragma unroll
            for (int n = 0; n < 2; ++n) g[bj][n] = *(const f32x4*)(gtb + col0 + bj * 128 + n * 16);
#pragma unroll
        for (int ai = 0; ai < 2; ++ai)
#pragma unroll
            for (int m = 0; m < 4; ++m) { const size_t off = (size_t)(row0 + ai * 128 + m * 16) * 2048 + col0;
#pragma unroll
                for (int bj = 0; bj < 2; ++bj)
#pragma unroll
                    for (int n = 0; n < 2; ++n) { const f32x4 xv = *(const f32x4*)(x + off + bj * 128 + n * 16);
                        *(f32x4*)(out + off + bj * 128 + n * 16) = xv + g[bj][n] * acc[ai][bj][m][n]; } }
    }
};
struct EpiF32 {
    static constexpr bool PERM = false;
    float* C; int ldc;
    __device__ __forceinline__ void operator()(const AccT& acc, const Unit& u, int wr, int wc, int fr, int fq) const {
        const int row0 = u.pm * 256 + wr * 64 + fr, col0 = u.pn * 256 + wc * 32 + 4 * fq;
#pragma unroll
        for (int ai = 0; ai < 2; ++ai)
#pragma unroll
            for (int m = 0; m < 4; ++m) { float* rowp = C + (size_t)(row0 + ai * 128 + m * 16) * ldc + col0;
#pragma unroll
                for (int bj = 0; bj < 2; ++bj)
#pragma unroll
                    for (int n = 0; n < 2; ++n) *(f32x4*)(rowp + bj * 128 + n * 16) = acc[ai][bj][m][n]; }
    }
};

struct Args { const float* in[19]; float* out; unsigned char* ws; int ph_lo, ph_hi; int li, pad; };
struct Frame {
    unsigned char* lds; unsigned char* ws;
    int tid, lane, wave, G, bid;
    const float *x, *c, *w_ada, *b_ada, *g1, *g2, *w_in, *g_q, *g_k, *rel_bias, *pool_w, *pool_scale, *w_ab, *w_pb, *w_out, *w_pq, *peer_keys, *peer_u, *peer_v;
    float* out;
};

template <class Fn> __device__ __forceinline__ void transpose_item(const float* W, int K, int N, bf16_t* WT, int ldk, int drow0, int k0, float* scr, int lane, Fn srccol) {
    const int sc = srccol(drow0 + (lane & 31));
#pragma unroll 8
    for (int i = 0; i < 32; ++i) { const int kk = 2 * i + (lane >> 5); scr[kk * 33 + (lane & 31)] = sc >= 0 ? W[(size_t)(k0 + kk) * N + sc] : 0.f; }
    asm volatile("s_waitcnt lgkmcnt(0)" ::: "memory");
    const int c = lane & 7;
#pragma unroll
    for (int j = 0; j < 4; ++j) { const int n = (lane >> 3) + 8 * j; const float* s = scr + (8 * c) * 33 + n;
        u32x4 o; o.x = cvt_pk_bf16(s[0 * 33], s[1 * 33]); o.y = cvt_pk_bf16(s[2 * 33], s[3 * 33]); o.z = cvt_pk_bf16(s[4 * 33], s[5 * 33]); o.w = cvt_pk_bf16(s[6 * 33], s[7 * 33]);
        *(u32x4*)(WT + (size_t)(drow0 + n) * ldk + k0 + 8 * c) = o; }
    asm volatile("s_waitcnt lgkmcnt(0)" ::: "memory");
}
__device__ __forceinline__ void phase0_prep(Frame& F) {
    const int gw = F.bid * 8 + F.wave, NGW = F.G * 8;
    float* scr = (float*)(F.lds + F.wave * 16384);
    constexpr int I_IN = (INWP / 32) * (DM / 64);
    constexpr int I_AB = (2048 / 32) * (1024 / 64), I_OUT = (2048 / 32) * (2048 / 64), I_PW = 4 * 8 * 4;
    constexpr int NIT = I_IN + 2 * I_AB + 2 * I_OUT + I_PW;
    auto ident = [](int j) { return j; };
    for (int it = gw; it < NIT; it += NGW) {
        int r = it;
        if (r < I_IN) { const int nb = r % (INWP / 32), kb = r / (INWP / 32);
            transpose_item(F.w_in, DM, INW, (bf16_t*)(F.ws + WS_WIN), DM, nb * 32, kb * 64, scr, F.lane, [](int j) { return j < 2640 ? j : (j < 2816 ? -1 : j - 176); }); continue; }
        r -= I_IN;
        if (r < I_AB) { transpose_item(F.w_ab, 1024, 2048, (bf16_t*)(F.ws + WS_WAB), 1024, (r % 64) * 32, (r / 64) * 64, scr, F.lane, ident); continue; }
        r -= I_AB;
        if (r < I_AB) { transpose_item(F.w_pb, 1024, 2048, (bf16_t*)(F.ws + WS_WPB), 1024, (r % 64) * 32, (r / 64) * 64, scr, F.lane, ident); continue; }
        r -= I_AB;
        if (r < I_OUT) { transpose_item(F.w_out, 2048, 2048, (bf16_t*)(F.ws + WS_WOUT), 2048, (r % 64) * 32, (r / 64) * 64, scr, F.lane, ident); continue; }
        r -= I_OUT;
        if (r < I_OUT) { transpose_item(F.w_pq, 2048, 2048, (bf16_t*)(F.ws + WS_WPQ), 2048, (r % 64) * 32, (r / 64) * 64, scr, F.lane, ident); continue; }
        r -= I_OUT;
        { const int g = r / 32, q = r % 32, nb = q % 8, kb = q / 8;
          transpose_item(F.pool_w + (size_t)g * 65536, 256, 256, (bf16_t*)(F.ws + WS_POOLW) + (size_t)g * 65536, 256, nb * 32, kb * 64, scr, F.lane, ident); }
    }
    {
        bf16_t* kb = (bf16_t*)(F.ws + WS_KEYSBD);
        for (int i = F.bid * 512 + F.tid; i < 2048 * 32; i += F.G * 512) {
            const int row = i / 32, k8 = (i % 32) * 8, p = (row >> 7) & 1;
            u32x4 o = (u32x4){0u, 0u, 0u, 0u};
            if ((k8 >> 7) == p) { const float* s = F.peer_keys + (size_t)row * 128 + (k8 & 127); const f32x4 a = *(const f32x4*)s, b = *(const f32x4*)(s + 4); o = pack8(a, b); }
            *(u32x4*)(kb + (size_t)row * 256 + k8) = o;
        }
    }
    {
        const size_t n16 = (size_t)NEXP * DM / 16;
        unsigned char* pu = F.ws + WS_PU;
        for (size_t i = (size_t)F.bid * 512 + F.tid; i < n16; i += (size_t)F.G * 512) {
            u32x4 ou;
#pragma unroll
            for (int k = 0; k < 4; ++k) { const f32x4 a = *(const f32x4*)(F.peer_u + i * 16 + k * 4) * 64.0f;
                int wu = __builtin_amdgcn_cvt_pk_fp8_f32(a[0], a[1], 0, false); wu = __builtin_amdgcn_cvt_pk_fp8_f32(a[2], a[3], wu, true); ou[k] = (unsigned)wu; }
            *(u32x4*)(pu + i * 16) = ou;
        }
        unsigned char* pv = F.ws + WS_PV;
        for (int it = gw; it < (NEXP / 64) * 128; it += NGW) {
            const int e = (it >> 7) * 64 + F.lane, ch = it & 127;
            u32x4 ov;
#pragma unroll
            for (int k = 0; k < 4; ++k) { const f32x4 c = *(const f32x4*)(F.peer_v + (size_t)e * DM + ch * 16 + k * 4) * 4.0f;
                int wv = __builtin_amdgcn_cvt_pk_fp8_f32(c[0], c[1], 0, false); wv = __builtin_amdgcn_cvt_pk_fp8_f32(c[2], c[3], wv, true); ov[k] = (unsigned)wv; }
            *(u32x2*)(pv + ((size_t)(2 * ch) * NEXP + e) * 8) = (u32x2){ov[0], ov[1]};
            *(u32x2*)(pv + ((size_t)(2 * ch + 1) * NEXP + e) * 8) = (u32x2){ov[2], ov[3]};
        }
    }
    {
        __syncthreads();
        float* cact = (float*)(F.lds + 131072);
        float* red = (float*)F.lds;
        float* mp = (float*)(F.ws + WS_MODP);
        for (int it = F.bid; it < 48 * 4; it += F.G) {
            const int cb = it % 48, ds = it / 48, d0 = ds * 512;
            for (int i = F.tid; i < 8 * 512; i += 512) { const int b = i >> 9, d = i & 511; const float cv = F.c[b * DM + d0 + d]; cact[i] = cv * sigmoidf_(cv); }
            __syncthreads();
            f32x4 a[8];
#pragma unroll
            for (int b = 0; b < 8; ++b) a[b] = (f32x4){0.f, 0.f, 0.f, 0.f};
            const float* wp = F.w_ada + (size_t)(d0 + F.wave * 64) * 12288 + cb * 256 + F.lane * 4;
#pragma unroll 4
            for (int d = 0; d < 64; ++d) { const f32x4 w = *(const f32x4*)(wp + (size_t)d * 12288);
#pragma unroll
                for (int b = 0; b < 8; ++b) a[b] += w * cact[b * 512 + F.wave * 64 + d]; }
#pragma unroll
            for (int b = 0; b < 8; ++b)
#pragma unroll
                for (int j = 0; j < 4; ++j) red[(F.wave * 32 + b * 4 + j) * 64 + F.lane] = a[b][j];
            __syncthreads();
            for (int i = F.tid; i < 2048; i += 512) { const int v = i >> 6, l = i & 63; float s = 0.f;
#pragma unroll
                for (int w = 0; w < 8; ++w) s += red[(w * 32 + v) * 64 + l];
                mp[((size_t)ds * 8 + (v >> 2)) * 12288 + cb * 256 + l * 4 + (v & 3)] = s; }
            __syncthreads();
        }
    }
}

template <bool FIRST> __device__ __forceinline__ void phase_modnorm(Frame& F, const float* xin, const float* gain, int off_sh, int off_sc, bf16_t* dst) {
    const float* mp = (const float*)(F.ws + WS_MODP); float* mf = (float*)(F.ws + WS_MODF);
    if (FIRST) {
        for (int i = F.bid * 512 + F.tid; i < 8 * 12288; i += F.G * 512) {
            float s = F.b_ada[i % 12288];
#pragma unroll
            for (int k = 0; k < 4; ++k) s += mp[(size_t)k * 8 * 12288 + i];
            mf[i] = s; }
    }
    float* cA = (float*)F.lds; float* cB = cA + 2048;
    for (int ch = F.bid; ch < MTOK / 128; ch += F.G) {
        const int b = ch / 32;
        __syncthreads();
        for (int col = F.tid; col < 2048; col += 512) {
            float sc, sh;
            if (FIRST) { sc = F.b_ada[off_sc + col]; sh = F.b_ada[off_sh + col];
#pragma unroll
                for (int k = 0; k < 4; ++k) { sc += mp[((size_t)k * 8 + b) * 12288 + off_sc + col]; sh += mp[((size_t)k * 8 + b) * 12288 + off_sh + col]; } }
            else { sc = mf[b * 12288 + off_sc + col]; sh = mf[b * 12288 + off_sh + col]; }
            cA[col] = gain[col] * (1.f + sc); cB[col] = sh; }
        __syncthreads();
        for (int r = F.wave; r < 128; r += 8) {
            const size_t row = (size_t)ch * 128 + r;
            const float* xr = xin + row * 2048 + F.lane * 8;
            f32x4 v[4][2]; float ss = 0.f;
#pragma unroll
            for (int i = 0; i < 4; ++i) { v[i][0] = *(const f32x4*)(xr + i * 512); v[i][1] = *(const f32x4*)(xr + i * 512 + 4);
#pragma unroll
                for (int j = 0; j < 4; ++j) ss += v[i][0][j] * v[i][0][j] + v[i][1][j] * v[i][1][j]; }
            ss = wave_sum(ss);
            const float rinv = 1.0f / sqrtf(ss * (1.0f / 2048.0f) + EPS);
#pragma unroll
            for (int i = 0; i < 4; ++i) { const int col = i * 512 + F.lane * 8;
                const f32x4 a0 = *(const f32x4*)(cA + col), a1 = *(const f32x4*)(cA + col + 4), b0 = *(const f32x4*)(cB + col), b1 = *(const f32x4*)(cB + col + 4);
                *(u32x4*)(dst + row * 2048 + col) = pack8(v[i][0] * rinv * a0 + b0, v[i][1] * rinv * a1 + b1); }
        }
    }
}

__device__ __forceinline__ u32x2 pack8_fp8(f32x4 a, f32x4 b) {
    int w0 = __builtin_amdgcn_cvt_pk_fp8_f32(a[0], a[1], 0, false); w0 = __builtin_amdgcn_cvt_pk_fp8_f32(a[2], a[3], w0, true);
    int w1 = __builtin_amdgcn_cvt_pk_fp8_f32(b[0], b[1], 0, false); w1 = __builtin_amdgcn_cvt_pk_fp8_f32(b[2], b[3], w1, true);
    return (u32x2){(unsigned)w0, (unsigned)w1};
}
__device__ __forceinline__ void phase3_qknorm(Frame& F) {
    const bf16_t* q = (const bf16_t*)(F.ws + WS_QN); const bf16_t* k = (const bf16_t*)(F.ws + WS_KN); const bf16_t* v = (const bf16_t*)(F.ws + WS_V);
    unsigned char* q8 = F.ws + WS_Q8; unsigned char* k8 = F.ws + WS_K8; unsigned char* v8 = F.ws + WS_V8;
    const int gw = F.bid * 8 + F.wave, NGW = F.G * 8;
    for (int row = gw; row < MTOK; row += NGW) {
#pragma unroll
        for (int i = 0; i < 2; ++i) { const int ci = i * 64 + F.lane;
            f32x4 a, b; unpack8(*(const u32x4*)(q + (size_t)row * 1024 + ci * 8), a, b);
            float ss = a[0] * a[0] + a[1] * a[1] + a[2] * a[2] + a[3] * a[3] + b[0] * b[0] + b[1] * b[1] + b[2] * b[2] + b[3] * b[3];
            ss = row_sum16(ss);
            const float rinv = 1.0f / sqrtf(ss * (1.0f / 128.0f) + EPS);
            const float* gp = F.g_q + (ci & 15) * 8; const f32x4 g0 = *(const f32x4*)gp, g1 = *(const f32x4*)(gp + 4);
            *(u32x2*)(q8 + (size_t)row * 1024 + ci * 8) = pack8_fp8(a * rinv * g0, b * rinv * g1); }
        { const int ci = F.lane & 31; const bool isk = F.lane < 32;
            f32x4 a, b; unpack8(*(const u32x4*)((isk ? k : v) + (size_t)row * 256 + ci * 8), a, b);
            float ss = a[0] * a[0] + a[1] * a[1] + a[2] * a[2] + a[3] * a[3] + b[0] * b[0] + b[1] * b[1] + b[2] * b[2] + b[3] * b[3];
            ss = row_sum16(ss);
            const float rinv = isk ? 1.0f / sqrtf(ss * (1.0f / 128.0f) + EPS) : 1.0f;
            const float* gp = F.g_k + (ci & 15) * 8; f32x4 g0 = *(const f32x4*)gp, g1 = *(const f32x4*)(gp + 4);
            if (!isk) { g0 = (f32x4){1.f, 1.f, 1.f, 1.f}; g1 = g0; }
            *(u32x2*)((isk ? k8 : v8) + (size_t)row * 256 + ci * 8) = pack8_fp8(a * rinv * g0, b * rinv * g1); }
    }
}
template <int W> __device__ __forceinline__ void pooled_item(const bf16_t* pl, bf16_t* po, int row, int c8) {
    const int t = row & (SEQ - 1);
    f32x4 s0 = (f32x4){0.f, 0.f, 0.f, 0.f}, s1 = s0, x0 = s0, x1 = s0;
    u32x4 v[W];
#pragma unroll
    for (int j = 0; j < W; ++j) v[j] = *(const u32x4*)(pl + (size_t)(row - (j <= t ? j : 0)) * 1024 + c8);
#pragma unroll
    for (int j = 0; j < W; ++j) { f32x4 a, b; unpack8(v[j], a, b); if (j == 0) { x0 = a; x1 = b; } if (j <= t) { s0 += a; s1 += b; } }
    const float inv = 1.0f / (float)((t + 1 < W) ? t + 1 : W);
    *(u32x4*)(po + (size_t)row * 1024 + c8) = pack8(s0 * inv - x0, s1 * inv - x1);
}
__device__ __forceinline__ void phase3_pooled(Frame& F) {
    const bf16_t* pl = (const bf16_t*)(F.ws + WS_PL); bf16_t* po = (bf16_t*)(F.ws + WS_POOLED);
    const int gw = F.bid * 8 + F.wave, NGW = F.G * 8;
    for (int it = gw; it < (MTOK / 2) * 4; it += NGW) {
        const int g = it & 3, row = (it >> 2) * 2 + (F.lane >> 5), c8 = g * 256 + (F.lane & 31) * 8;
        if (g == 0) pooled_item<2>(pl, po, row, c8); else if (g == 1) pooled_item<4>(pl, po, row, c8); else if (g == 2) pooled_item<8>(pl, po, row, c8); else pooled_item<16>(pl, po, row, c8);
    }
}
typedef float f32x16 __attribute__((ext_vector_type(16)));
__device__ __forceinline__ int sel_code(float s, float smin, float scale) { const float c = (s - smin) * scale; return (int)fminf(fmaxf(c, 0.f), 65535.f); }
__device__ __forceinline__ void hist_find(const unsigned* hist, int lane, int K, int& bsel, int& above) {
    const u32x4 h = *(const u32x4*)(hist + lane * 4);
    const int S = (int)(h.x + h.y + h.z + h.w);
    int x = S;
    x += __builtin_amdgcn_update_dpp(0, x, 0x101, 0xF, 0xF, true);
    x += __builtin_amdgcn_update_dpp(0, x, 0x102, 0xF, 0xF, true);
    x += __builtin_amdgcn_update_dpp(0, x, 0x104, 0xF, 0xF, true);
    x += __builtin_amdgcn_update_dpp(0, x, 0x108, 0xF, 0xF, true);
    const int t1 = __builtin_amdgcn_readlane(x, 16), t2 = __builtin_amdgcn_readlane(x, 32), t3 = __builtin_amdgcn_readlane(x, 48);
    const int r = lane >> 4;
    x += (r == 0 ? t1 + t2 + t3 : (r == 1 ? t2 + t3 : (r == 2 ? t3 : 0)));
    const int sufn = x - S;
    const bool mine = (x >= K) && (sufn < K);
    int b = 0, ab = 0;
    { int c = sufn;
      if (c + (int)h.w >= K) { b = 3; ab = c; } else { c += (int)h.w;
      if (c + (int)h.z >= K) { b = 2; ab = c; } else { c += (int)h.z;
      if (c + (int)h.y >= K) { b = 1; ab = c; } else { c += (int)h.y; b = 0; ab = c; } } } }
    const unsigned long long m = __ballot(mine);
    const int src = m ? (int)__builtin_ctzll(m) : 0;
    bsel = __builtin_amdgcn_readlane(lane * 4 + b, src); above = __builtin_amdgcn_readlane(ab, src);
}
__device__ __forceinline__ void indexer_select(Frame& F, int b, int t, const float* rowbuf, unsigned* hist, float* eqv, int* eqi) {
    unsigned short* selrow = (unsigned short*)(F.ws + WS_SEL) + (size_t)(b * SEQ + t) * 256;
    int lane = F.lane; asm volatile("" : "+v"(lane));
    const int nch = t / 64 + 1, n4 = (nch + 3) >> 2;
    const f32x4* rb4 = (const f32x4*)rowbuf;
    float mn = __builtin_huge_valf(), mx = -__builtin_huge_valf();
    for (int c4 = 0; c4 < n4; ++c4) { const f32x4 v = rb4[c4 * 64 + lane];
#pragma unroll
        for (int k = 0; k < 4; ++k) { const bool valid = ((c4 * 4 + k) * 64 + lane) <= t; mn = valid ? fminf(mn, v[k]) : mn; mx = valid ? fmaxf(mx, v[k]) : mx; } }
    mx = xor16_max(row_max16(mx)); { const auto r = __builtin_amdgcn_permlane32_swap(__float_as_uint(mx), __float_as_uint(mx), false, false); mx = fmaxf(__uint_as_float(r[0]), __uint_as_float(r[1])); }
    mn = -mn; mn = xor16_max(row_max16(mn)); { const auto r = __builtin_amdgcn_permlane32_swap(__float_as_uint(mn), __float_as_uint(mn), false, false); mn = -fmaxf(__uint_as_float(r[0]), __uint_as_float(r[1])); }
    const float scale = (mx > mn) ? 65535.0f / (mx - mn) : 0.f;
    *(u32x4*)(hist + lane * 4) = (u32x4){0u, 0u, 0u, 0u};
    for (int c4 = 0; c4 < n4; ++c4) { const f32x4 v = rb4[c4 * 64 + lane];
#pragma unroll
        for (int k = 0; k < 4; ++k) { const bool valid = ((c4 * 4 + k) * 64 + lane) <= t; if (valid) atomicAdd(&hist[sel_code(v[k], mn, scale) >> 8], 1u); } }
    int b1, above1; hist_find(hist, lane, KSEL, b1, above1);
    *(u32x4*)(hist + lane * 4) = (u32x4){0u, 0u, 0u, 0u};
    for (int c4 = 0; c4 < n4; ++c4) { const f32x4 v = rb4[c4 * 64 + lane];
#pragma unroll
        for (int k = 0; k < 4; ++k) { const bool valid = ((c4 * 4 + k) * 64 + lane) <= t; const int code = sel_code(v[k], mn, scale); if (valid && (code >> 8) == b1) atomicAdd(&hist[code & 255], 1u); } }
    int b2, above2; hist_find(hist, lane, KSEL - above1, b2, above2);
    const int T16 = (b1 << 8) | b2, need = KSEL - above1 - above2, ceq = (int)hist[b2];
    const unsigned long long lt_mask = (1ull << lane) - 1ull;
    const bool exact = (ceq != need) && (ceq <= 64);
    if (exact) {
        int pos = 0;
        for (int c = 0; c < nch; ++c) { const float sv = rowbuf[((c >> 2) * 64 + lane) * 4 + (c & 3)]; const int idx = c * 64 + lane;
            const bool eq = (idx <= t) && (sel_code(sv, mn, scale) == T16);
            const unsigned long long m = __ballot(eq);
            if (m) { const int p = pos + __popcll(m & lt_mask); if (eq) { eqv[p] = sv; eqi[p] = idx; } pos += __popcll(m); } }
    }
    int pos = 0, eqseen = 0;
    for (int c = 0; c < nch; ++c) {
        const float sv = rowbuf[((c >> 2) * 64 + lane) * 4 + (c & 3)]; const int idx = c * 64 + lane;
        const int code = sel_code(sv, mn, scale); const bool valid = idx <= t;
        const bool gt = valid && code > T16, eq = valid && code == T16;
        const unsigned long long meq = __ballot(eq);
        bool take = gt;
        if (meq) {
            if (ceq == need) take = take || eq;
            else if (exact) { int rank = 0; for (int m = 0; m < ceq; ++m) { const float ov = eqv[m]; const int oi = eqi[m]; rank += (ov > sv || (ov == sv && oi < idx)) ? 1 : 0; } take = take || (eq && rank < need); }
            else { const int er = eqseen + __popcll(meq & lt_mask); take = take || (eq && er < need); eqseen += __popcll(meq); }
        }
        const unsigned long long mt = __ballot(take);
        const int p = pos + __popcll(mt & lt_mask);
        if (take && p < KSEL) selrow[p] = (unsigned short)idx;
        pos += __popcll(mt);
    }
}
__device__ __forceinline__ void indexer_tile(Frame& F, int b, int t0) {
    const bf16_t* iq = (const bf16_t*)(F.ws + WS_IQ); const bf16_t* ik = (const bf16_t*)(F.ws + WS_IK); const float* iw = (const float*)(F.ws + WS_IW);
    int lane = F.lane; asm volatile("" : "+v"(lane));
    const int w = F.wave;
    if (t0 < KSEL) {
        const int t = t0 + w; unsigned short* selrow = (unsigned short*)(F.ws + WS_SEL) + (size_t)(b * SEQ + t) * 256;
#pragma unroll
        for (int p = 0; p < 4; ++p) { const int j = p * 64 + lane; selrow[j] = (unsigned short)(j <= t ? j : 0xFFFF); }
        return;
    }
    float* rowbuf = (float*)F.lds;
    unsigned char* stage = F.lds + 131072;
    const int p = w & 3, kh = w >> 2, hi = lane >> 5, r = lane & 31;
    const size_t qrow = (size_t)b * SEQ + t0 + 2 * p + (r >> 4);
    bf16x8 a[4];
#pragma unroll
    for (int ks = 0; ks < 4; ++ks) a[ks] = *(const bf16x8*)(iq + qrow * 1024 + (r & 15) * 64 + ks * 16 + 8 * hi);
    float wq[2][8];
#pragma unroll
    for (int q = 0; q < 2; ++q)
#pragma unroll
        for (int i = 0; i < 8; ++i) wq[q][i] = iw[((size_t)b * SEQ + t0 + 2 * p + q) * 16 + (i & 3) + 8 * ((i >> 2) & 1) + 4 * hi];
    const int nchunks = (t0 + 7) / 64 + 1;
    const unsigned char* gsrc = (const unsigned char*)(ik + (size_t)b * SEQ * 64) + F.tid * 16;
    const int skey = F.tid >> 3, sc16 = F.tid & 7, soff = skey * 128 + ((sc16 ^ (skey & 7)) << 4);
    u32x4 s0 = *(const u32x4*)gsrc, s1 = s0, s2 = s0, s3 = s0;
    if (1 < nchunks) s1 = *(const u32x4*)(gsrc + (size_t)1 * 8192);
    if (2 < nchunks) s2 = *(const u32x4*)(gsrc + (size_t)2 * 8192);
    if (3 < nchunks) s3 = *(const u32x4*)(gsrc + (size_t)3 * 8192);
    __syncthreads();
#define IDX_STEP(SR, cc) do { const int c = (cc); unsigned char* sb = stage + (c & 1) * 8192; \
        *(u32x4*)(sb + soff) = SR; \
        __syncthreads(); \
        if (c + 4 < nchunks) SR = *(const u32x4*)(gsrc + (size_t)(c + 4) * 8192); \
        f32x16 d; _Pragma("unroll") for (int i = 0; i < 16; ++i) d[i] = 0.f; \
        const int key = kh * 32 + r; \
        _Pragma("unroll") for (int ks = 0; ks < 4; ++ks) { const bf16x8 bf = *(const bf16x8*)(sb + key * 128 + (((ks * 2 + hi) ^ (key & 7)) << 4)); \
            d = __builtin_amdgcn_mfma_f32_32x32x16_bf16(a[ks], bf, d, 0, 0, 0); } \
        float s0_ = 0.f, s1_ = 0.f; \
        _Pragma("unroll") for (int i = 0; i < 8; ++i) { s0_ += wq[0][i] * fmaxf(d[i], 0.f); s1_ += wq[1][i] * fmaxf(d[8 + i], 0.f); } \
        const float sc = swap32_pair(s0_, s1_); \
        rowbuf[(2 * p + hi) * 4096 + ((c >> 2) * 64 + key) * 4 + (c & 3)] = sc; } while (0)
    for (int c4 = 0; c4 < nchunks; c4 += 4) {
        IDX_STEP(s0, c4);
        if (c4 + 1 < nchunks) IDX_STEP(s1, c4 + 1);
        if (c4 + 2 < nchunks) IDX_STEP(s2, c4 + 2);
        if (c4 + 3 < nchunks) IDX_STEP(s3, c4 + 3);
    }
#if PROBE_IDX == 1
    __syncthreads(); s0 = *(const u32x4*)gsrc; s1 = s0; s2 = s0; s3 = s0;
    if (1 < nchunks) s1 = *(const u32x4*)(gsrc + (size_t)1 * 8192);
    if (2 < nchunks) s2 = *(const u32x4*)(gsrc + (size_t)2 * 8192);
    if (3 < nchunks) s3 = *(const u32x4*)(gsrc + (size_t)3 * 8192);
    for (int c4 = 0; c4 < nchunks; c4 += 4) {
        IDX_STEP(s0, c4);
        if (c4 + 1 < nchunks) IDX_STEP(s1, c4 + 1);
        if (c4 + 2 < nchunks) IDX_STEP(s2, c4 + 2);
        if (c4 + 3 < nchunks) IDX_STEP(s3, c4 + 3);
    }
#endif
#undef IDX_STEP
    __syncthreads();
    indexer_select(F, b, t0 + w, rowbuf + w * 4096, (unsigned*)(F.lds + 147456) + w * 256, (float*)(F.lds + 155648) + w * 64, (int*)(F.lds + 155648 + 2048) + w * 64);
#if PROBE_IDX == 2
    indexer_select(F, b, t0 + w, rowbuf + w * 4096, (unsigned*)(F.lds + 147456) + w * 256, (float*)(F.lds + 155648) + w * 64, (int*)(F.lds + 155648 + 2048) + w * 64);
#endif
}
__device__ __forceinline__ void phase3_indexer(Frame& F) {
    const int nit = BATCH * (SEQ / 8);
    for (int k = 0;; ++k) {
        const int l = k * F.G + ((k & 1) ? (F.G - 1 - F.bid) : F.bid);
        if (l >= nit) { if (k * F.G >= nit) break; else continue; }
        const int qb = (SEQ / 8 - 1) - (l >> 3), b = l & 7;
        indexer_tile(F, b, qb * 8);
    }
}

__device__ const unsigned char g_bucket[128] = {0, 1, 2, 3, 4, 5, 6, 7, 8, 9, 10, 11, 12, 13, 14, 15, 16, 16, 16, 17, 17, 18, 18, 18, 19, 19, 19, 20, 20, 20, 20, 21, 21, 21, 21, 22, 22, 22, 22, 22, 23, 23, 23, 23, 23, 23, 24, 24, 24, 24, 24, 24, 25, 25, 25, 25, 25, 25, 25, 26, 26, 26, 26, 26, 26, 26, 26, 27, 27, 27, 27, 27, 27, 27, 27, 27, 27, 28, 28, 28, 28, 28, 28, 28, 28, 28, 28, 29, 29, 29, 29, 29, 29, 29, 29, 29, 29, 29, 29, 30, 30, 30, 30, 30, 30, 30, 30, 30, 30, 30, 30, 30, 30, 31, 31, 31, 31, 31, 31, 31, 31, 31, 31, 31, 31, 31, 31, 31};
__device__ __forceinline__ void phase4_attention(Frame& F) {
    const unsigned char* q8 = F.ws + WS_Q8; const unsigned char* k8 = F.ws + WS_K8; const unsigned char* v8 = F.ws + WS_V8;
    const unsigned short* sel = (const unsigned short*)(F.ws + WS_SEL); bf16_t* ao = (bf16_t*)(F.ws + WS_ATTN);
    float* btab = (float*)F.lds;
    __syncthreads();
    for (int i = F.tid; i < 256; i += 512) btab[i] = F.rel_bias[i];
    __syncthreads();
    float* Pl = (float*)(F.lds + 4096 + F.wave * 12288); int* idl = (int*)(Pl + 2048); float* psl = (float*)(idl + 256);
    const bool xmap = (F.G % 8) == 0;
    const int gw = xmap ? (F.bid / 8) * 8 + F.wave : F.bid * 8 + F.wave, NGW = xmap ? F.G : F.G * 8, nrows = xmap ? SEQ : MTOK;
    for (int rr = gw; rr < nrows; rr += NGW) {
        int lane = F.lane; asm volatile("" : "+v"(lane));
        const int row = xmap ? (F.bid & 7) * SEQ + rr : rr;
        const int b = row / SEQ, t = row % SEQ, r = lane & 31, hi = lane >> 5;
#pragma unroll
        for (int p = 0; p < 4; ++p) { idl[p * 64 + lane] = (int)sel[(size_t)row * 256 + p * 64 + lane]; }
        long a0[8], a1[8];
        { u32x4 qa[4];
#pragma unroll
          for (int i = 0; i < 4; ++i) qa[i] = (r < 8) ? *(const u32x4*)(q8 + (size_t)row * 1024 + r * 128 + hi * 64 + i * 16) : (u32x4){0u, 0u, 0u, 0u};
#pragma unroll
          for (int ks = 0; ks < 8; ++ks) { const unsigned lo = qa[ks >> 1][(ks & 1) * 2], hh = qa[ks >> 1][(ks & 1) * 2 + 1]; const long v = (long)(((unsigned long long)hh << 32) | lo);
              a0[ks] = (r < 4) ? v : 0l; a1[ks] = (r >= 4) ? v : 0l; } }
        f32x4 psum = (f32x4){0.f, 0.f, 0.f, 0.f};
#define AT_LOADK(buf, kb) do { const int key_ = idl[(kb) * 32 + r]; const int kc_ = key_ <= t ? key_ : 0; const unsigned char* kr_ = k8 + ((size_t)b * SEQ + kc_) * 256 + hi * 64; \
            _Pragma("unroll") for (int i = 0; i < 4; ++i) { buf[i] = *(const u32x4*)(kr_ + i * 16); buf[4 + i] = *(const u32x4*)(kr_ + 128 + i * 16); } } while (0)
#define AT_QK(buf, kb) do { const int key_ = idl[(kb) * 32 + r]; const bool valid_ = key_ <= t; const int kc_ = valid_ ? key_ : 0; \
            f32x16 d; _Pragma("unroll") for (int i = 0; i < 16; ++i) d[i] = 0.f; \
            _Pragma("unroll") for (int ks = 0; ks < 8; ++ks) { const long bv_ = (long)(((unsigned long long)buf[ks >> 1][(ks & 1) * 2 + 1] << 32) | buf[ks >> 1][(ks & 1) * 2]); d = __builtin_amdgcn_mfma_f32_32x32x16_fp8_fp8(a0[ks], bv_, d, 0, 0, 0); } \
            _Pragma("unroll") for (int ks = 0; ks < 8; ++ks) { const long bv_ = (long)(((unsigned long long)buf[4 + (ks >> 1)][(ks & 1) * 2 + 1] << 32) | buf[4 + (ks >> 1)][(ks & 1) * 2]); d = __builtin_amdgcn_mfma_f32_32x32x16_fp8_fp8(a1[ks], bv_, d, 0, 0, 0); } \
            const int dist_ = t - kc_; const int bkt_ = dist_ < 128 ? (int)g_bucket[dist_] : 31; \
            const f32x4 bias_ = *(const f32x4*)(btab + bkt_ * 8 + 4 * hi); f32x4 e_; \
            _Pragma("unroll") for (int i = 0; i < 4; ++i) e_[i] = valid_ ? __expf(d[i] * 0.08838834764831845f + bias_[i]) : 0.f; \
            psum += e_; *(f32x4*)(Pl + ((kb) * 32 + r) * 8 + 4 * hi) = e_; } while (0)
        {
            u32x4 kA[8], kB[8];
            AT_LOADK(kA, 0);
#pragma unroll 1
            for (int kb = 0; kb < 8; kb += 2) {
                AT_LOADK(kB, kb + 1);
                AT_QK(kA, kb);
                if (kb + 2 < 8) AT_LOADK(kA, kb + 2);
                AT_QK(kB, kb + 1);
            }
        }
#undef AT_LOADK
#undef AT_QK
#pragma unroll
        for (int i = 0; i < 4; ++i) psum[i] = xor16_sum(row_sum16(psum[i]));
        if (r == 0) *(f32x4*)(psl + 4 * hi) = psum;
        const int ks = lane >> 4, g = (lane >> 3) & 1, dc = lane & 7;
        float acc[4][16];
#pragma unroll
        for (int h = 0; h < 4; ++h)
#pragma unroll
            for (int j = 0; j < 16; ++j) acc[h][j] = 0.f;
#define AT_LOADV(buf, it0) do { _Pragma("unroll") for (int u = 0; u < 4; ++u) { const int key_ = idl[((it0) + u) * 4 + ks]; const int kc_ = key_ <= t ? key_ : 0; \
            buf[u] = *(const u32x4*)(v8 + ((size_t)b * SEQ + kc_) * 256 + g * 128 + dc * 16); } } while (0)
#define AT_PV(buf, it0) do { _Pragma("unroll") for (int u = 0; u < 4; ++u) { const int j_ = ((it0) + u) * 4 + ks; const u32x4 w = buf[u]; \
            const f32x4 p = *(const f32x4*)(Pl + j_ * 8 + 4 * g); \
            _Pragma("unroll") for (int dd = 0; dd < 4; ++dd) { const f32x2 lo = __builtin_amdgcn_cvt_pk_f32_fp8((int)w[dd], false), hh_ = __builtin_amdgcn_cvt_pk_f32_fp8((int)w[dd], true); \
                _Pragma("unroll") for (int h = 0; h < 4; ++h) { acc[h][4 * dd] += p[h] * lo.x; acc[h][4 * dd + 1] += p[h] * lo.y; acc[h][4 * dd + 2] += p[h] * hh_.x; acc[h][4 * dd + 3] += p[h] * hh_.y; } } } } while (0)
        {
            u32x4 vA[4], vB[4];
            AT_LOADV(vA, 0);
#pragma unroll 1
            for (int it0 = 0; it0 < 64; it0 += 8) {
                AT_LOADV(vB, it0 + 4);
                AT_PV(vA, it0);
                if (it0 + 8 < 64) AT_LOADV(vA, it0 + 8);
                AT_PV(vB, it0 + 4);
            }
        }
#undef AT_LOADV
#undef AT_PV
#pragma unroll
        for (int h = 0; h < 4; ++h)
#pragma unroll
            for (int j = 0; j < 16; ++j) acc[h][j] = xor32_sum(xor16_sum(acc[h][j]));
#pragma unroll
        for (int h = 0; h < 4; ++h) if (h == ks) { const float inv = 1.0f / psl[4 * g + h];
            bf16_t* op = ao + (size_t)row * 1024 + (4 * g + h) * 128 + dc * 16;
            *(u32x4*)op = pack8((f32x4){acc[h][0], acc[h][1], acc[h][2], acc[h][3]} * inv, (f32x4){acc[h][4], acc[h][5], acc[h][6], acc[h][7]} * inv);
            *(u32x4*)(op + 8) = pack8((f32x4){acc[h][8], acc[h][9], acc[h][10], acc[h][11]} * inv, (f32x4){acc[h][12], acc[h][13], acc[h][14], acc[h][15]} * inv); }
    }
}

__device__ __forceinline__ float dot16f8(u32x4 w, const float* h) {
    float s = 0.f;
#pragma unroll
    for (int d = 0; d < 4; ++d) { const f32x2 lo = __builtin_amdgcn_cvt_pk_f32_fp8((int)w[d], false), hi = __builtin_amdgcn_cvt_pk_f32_fp8((int)w[d], true);
        s += lo.x * h[4 * d] + lo.y * h[4 * d + 1] + hi.x * h[4 * d + 2] + hi.y * h[4 * d + 3]; }
    return s;
}
__device__ __forceinline__ void fma16f8(u32x4 w, float cf, float* acc) {
#pragma unroll
    for (int d = 0; d < 4; ++d) { const f32x2 lo = __builtin_amdgcn_cvt_pk_f32_fp8((int)w[d], false), hi = __builtin_amdgcn_cvt_pk_f32_fp8((int)w[d], true);
        acc[4 * d] += cf * lo.x; acc[4 * d + 1] += cf * lo.y; acc[4 * d + 2] += cf * hi.x; acc[4 * d + 3] += cf * hi.y; }
}
__device__ __forceinline__ float gelu_erf(float x) { return 0.5f * x * (1.0f + erff(x * 0.70710678118654752f)); }
__device__ __forceinline__ void peer_select(const bf16_t* srow, int lane, int* elist, float* gl, float* scr) {
    float* selv = scr; int* seli = (int*)(scr + 32); float* srtv = scr + 64; int* srti = (int*)(scr + 96);
    const unsigned long long lt_mask = (1ull << lane) - 1ull;
    const int half = lane >> 5, lh = lane & 31;
    const unsigned long long hmask = half ? 0xFFFFFFFF00000000ull : 0x00000000FFFFFFFFull;
    const float NINF = -__builtin_huge_valf();
#pragma unroll 1
    for (int h = 0; h < 8; ++h) {
        const u32x2 raw = *(const u32x2*)(srow + h * 256 + lane * 4);
        unsigned b[4] = {raw.x & 0xffffu, raw.x >> 16, raw.y & 0xffffu, raw.y >> 16}, k[4];
#pragma unroll
        for (int q = 0; q < 4; ++q) k[q] = (b[q] & 0x8000u) ? (b[q] ^ 0xFFFFu) : (b[q] | 0x8000u);
        unsigned T0 = 0u, T1 = 0u;
#pragma unroll
        for (int bit = 15; bit >= 0; --bit) {
            const unsigned c0 = T0 | (1u << bit), c1 = T1 | (1u << bit), cand = half ? c1 : c0;
            const unsigned long long m0 = __ballot(k[0] >= cand), m1 = __ballot(k[1] >= cand), m2 = __ballot(k[2] >= cand), m3 = __ballot(k[3] >= cand);
            const int n0 = __popc((unsigned)m0) + __popc((unsigned)m1) + __popc((unsigned)m2) + __popc((unsigned)m3);
            const int n1 = __popc((unsigned)(m0 >> 32)) + __popc((unsigned)(m1 >> 32)) + __popc((unsigned)(m2 >> 32)) + __popc((unsigned)(m3 >> 32));
            T0 = (n0 >= 16) ? c0 : T0; T1 = (n1 >= 16) ? c1 : T1;
        }
        const unsigned T = half ? T1 : T0;
        int ngt = 0, eqb = 0; unsigned long long me[4];
#pragma unroll
        for (int q = 0; q < 4; ++q) { const unsigned long long mg = __ballot(k[q] > T) & hmask; me[q] = __ballot(k[q] == T) & hmask; ngt += __popcll(mg); eqb += __popcll(me[q] & lt_mask); }
        const int need = 16 - ngt;
        bool sl[4]; int run = eqb;
#pragma unroll
        for (int q = 0; q < 4; ++q) { const bool eq = k[q] == T; sl[q] = (k[q] > T) || (eq && run < need); run += eq ? 1 : 0; }
        int pos = 0;
#pragma unroll
        for (int q = 0; q < 4; ++q) pos += __popcll(__ballot(sl[q]) & hmask & lt_mask);
#pragma unroll
        for (int q = 0; q < 4; ++q) { if (sl[q]) { selv[half * 16 + pos] = __uint_as_float(b[q] << 16); seli[half * 16 + pos] = 4 * lh + q; } pos += sl[q] ? 1 : 0; }
        const float v = selv[half * 16 + (lh & 15)]; const int ix = seli[half * 16 + (lh & 15)];
        int rank = 0;
#define PS_ROT(R) { const float vo = __int_as_float(__builtin_amdgcn_update_dpp(0, __float_as_int(v), 0x120 + (R), 0xF, 0xF, true)); const int io = __builtin_amdgcn_update_dpp(0, ix, 0x120 + (R), 0xF, 0xF, true); rank += (vo > v || (vo == v && io < ix)) ? 1 : 0; }
        PS_ROT(1) PS_ROT(2) PS_ROT(3) PS_ROT(4) PS_ROT(5) PS_ROT(6) PS_ROT(7) PS_ROT(8) PS_ROT(9) PS_ROT(10) PS_ROT(11) PS_ROT(12) PS_ROT(13) PS_ROT(14) PS_ROT(15)
#undef PS_ROT
        if (lh < 16) { srtv[half * 16 + rank] = v; srti[half * 16 + rank] = ix; }
        int ca, cb; const int c = lane;
        if (c < 16) { ca = 0; cb = c; } else if (c < 24) { ca = 1; cb = c - 16; } else if (c < 29) { ca = 2; cb = c - 24; } else if (c < 33) { ca = 3; cb = c - 29; }
        else if (c < 36) { ca = 4; cb = c - 33; } else if (c < 38) { ca = 5; cb = c - 36; } else if (c < 40) { ca = 6; cb = c - 38; } else if (c < 42) { ca = 7; cb = c - 40; }
        else { ca = (c - 42 + 8) & 15; cb = 0; }
        float s = srtv[ca] + srtv[16 + cb];
        const int eid = srti[ca] * 128 + srti[16 + cb];
        if (c >= 50) s = NINF;
        int rk = 0;
#pragma unroll 10
        for (int j = 0; j < 50; ++j) { const float sj = __shfl(s, j); rk += (sj > s || (sj == s && j < c)) ? 1 : 0; }
        const bool selq = (c < 50) && (rk < 16);
        const float smax = __shfl(s, 0);
        const float e = selq ? __expf(s - smax) : 0.f;
        const float esum = wave_sum(e);
        const unsigned long long ms = __ballot(selq);
        const int p = __popcll(ms & lt_mask);
        if (selq) { elist[h * 16 + p] = eid; gl[h * 16 + p] = e / esum; }
    }
}
__device__ __forceinline__ float dot32_f8(u32x4 wa, u32x4 wb, u32x4 ha, u32x4 hb) {
    float acc = 0.f;
#pragma unroll
    for (int d = 0; d < 4; ++d) {
        acc = __builtin_amdgcn_fdot2_f32_bf16(__builtin_amdgcn_cvt_scalef32_pk_bf16_fp8((int)wa[d], 1.0f, false), __builtin_amdgcn_cvt_scalef32_pk_bf16_fp8((int)ha[d], 1.0f, false), acc, false);
        acc = __builtin_amdgcn_fdot2_f32_bf16(__builtin_amdgcn_cvt_scalef32_pk_bf16_fp8((int)wa[d], 1.0f, true), __builtin_amdgcn_cvt_scalef32_pk_bf16_fp8((int)ha[d], 1.0f, true), acc, false);
        acc = __builtin_amdgcn_fdot2_f32_bf16(__builtin_amdgcn_cvt_scalef32_pk_bf16_fp8((int)wb[d], 1.0f, false), __builtin_amdgcn_cvt_scalef32_pk_bf16_fp8((int)hb[d], 1.0f, false), acc, false);
        acc = __builtin_amdgcn_fdot2_f32_bf16(__builtin_amdgcn_cvt_scalef32_pk_bf16_fp8((int)wb[d], 1.0f, true), __builtin_amdgcn_cvt_scalef32_pk_bf16_fp8((int)hb[d], 1.0f, true), acc, false); }
    return acc;
}
__device__ __forceinline__ void phase10_peer(Frame& F) {
    const bf16_t* sub = (const bf16_t*)(F.ws + WS_SUB); const bf16_t* h2 = (const bf16_t*)(F.ws + WS_H2);
    const unsigned char* pu = F.ws + WS_PU; unsigned* pairs = (unsigned*)(F.ws + WS_PAIRS);
    const int gw = F.bid * 8 + F.wave, NGW = F.G * 8;
    unsigned char* wb = F.lds + F.wave * 18944;
    unsigned char* h2f8 = wb; unsigned short* gl16 = (unsigned short*)(wb + 16384); unsigned* hist = (unsigned*)(wb + 18432); unsigned* base = hist + 32;
    unsigned* tmp = (unsigned*)wb; int* elist = (int*)(wb + 4096); float* gl = (float*)(wb + 4608);
    unsigned* wls = (unsigned*)(F.ws + WS_WLS) + (size_t)gw * 1024;
    const int ntok = (MTOK - gw + NGW - 1) / NGW;
    for (int p0 = 0; p0 < ntok; p0 += 8) {
        int lane = F.lane; asm volatile("" : "+v"(lane));
        const int nt = (ntok - p0) < 8 ? (ntok - p0) : 8, ne = nt * 128;
        u32x4 nxt[4];
#pragma unroll
        for (int q = 0; q < 4; ++q) nxt[q] = *(const u32x4*)(sub + (size_t)(gw + p0 * NGW) * 2048 + lane * 32 + q * 8);
#pragma unroll 1
        for (int i = 0; i < nt; ++i) {
            bf16_t* srl = (bf16_t*)(wb + 6144);
#pragma unroll
            for (int q = 0; q < 4; ++q) *(u32x4*)(srl + lane * 32 + q * 8) = nxt[q];
            if (i + 1 < nt) {
#pragma unroll
                for (int q = 0; q < 4; ++q) nxt[q] = *(const u32x4*)(sub + (size_t)(gw + (p0 + i + 1) * NGW) * 2048 + lane * 32 + q * 8); }
            peer_select(srl, lane, elist, gl, (float*)(wb + 5120));
#if PROBE_SEL
            asm volatile("" : "+v"(lane)); peer_select(srl, lane, elist, gl, (float*)(wb + 5120));
#endif
            tmp[i * 128 + lane] = ((unsigned)(i * 128 + lane) << 14) | (unsigned)elist[lane];
            tmp[i * 128 + 64 + lane] = ((unsigned)(i * 128 + 64 + lane) << 14) | (unsigned)elist[64 + lane];
            gl16[i * 128 + lane] = (unsigned short)(cvt_pk_bf16(gl[lane], 0.f) & 0xffffu); gl16[i * 128 + 64 + lane] = (unsigned short)(cvt_pk_bf16(gl[64 + lane], 0.f) & 0xffffu);
        }
        asm volatile("" : "+v"(lane));
        if (lane < 32) hist[lane] = 0u;
        unsigned ent[16]; unsigned rk[16];
#pragma unroll
        for (int q = 0; q < 16; ++q) { const int e = q * 64 + lane; ent[q] = (e < ne) ? tmp[e] : 0u; rk[q] = (e < ne) ? atomicAdd(&hist[(ent[q] & 0x3FFFu) >> 9], 1u) : 0u; }
        { int hv = lane < 32 ? (int)hist[lane] : 0; int x = hv;
          x += __builtin_amdgcn_update_dpp(0, x, 0x111, 0xF, 0xF, true); x += __builtin_amdgcn_update_dpp(0, x, 0x112, 0xF, 0xF, true);
          x += __builtin_amdgcn_update_dpp(0, x, 0x114, 0xF, 0xF, true); x += __builtin_amdgcn_update_dpp(0, x, 0x118, 0xF, 0xF, true);
          const int t0 = __builtin_amdgcn_readlane(x, 15); if (lane >= 16) x += t0;
          if (lane < 32) base[lane] = (unsigned)(x - hv); }
#pragma unroll
        for (int q = 0; q < 16; ++q) { const int e = q * 64 + lane; if (e < ne) wls[base[(ent[q] & 0x3FFFu) >> 9] + rk[q]] = ent[q]; }
#pragma unroll 1
        for (int i = 0; i < nt; ++i) { const bf16_t* hr = h2 + (size_t)(gw + (p0 + i) * NGW) * 2048 + lane * 16;
#pragma unroll
            for (int hh = 0; hh < 2; ++hh) { f32x4 a, b, c, d; unpack8(*(const u32x4*)(hr + hh * 1024), a, b); unpack8(*(const u32x4*)(hr + hh * 1024 + 8), c, d);
                const u32x2 lo = pack8_fp8(a, b), hi = pack8_fp8(c, d);
                *(u32x4*)(h2f8 + i * 2048 + hh * 1024 + lane * 16) = (u32x4){lo.x, lo.y, hi.x, hi.y}; } }
        asm volatile("s_waitcnt vmcnt(0)" ::: "memory");
        unsigned entn = __hip_atomic_load(wls + lane, __ATOMIC_RELAXED, __HIP_MEMORY_SCOPE_AGENT);
#pragma unroll 1
        for (int c = 0; c < ne; c += 64) {
            const unsigned ent64 = entn;
            if (c + 64 < ne) entn = __hip_atomic_load(wls + c + 64 + lane, __ATOMIC_RELAXED, __HIP_MEMORY_SCOPE_AGENT);
#pragma unroll 1
            for (int i0 = 0; i0 < 64; i0 += 8) {
                u32x4 w[8][2]; unsigned en[8];
#pragma unroll
                for (int jj = 0; jj < 8; ++jj) { en[jj] = (unsigned)__builtin_amdgcn_readlane((int)ent64, i0 + jj); const unsigned char* ur = pu + (size_t)(en[jj] & 0x3FFFu) * 2048 + lane * 16;
                    w[jj][0] = *(const u32x4*)ur; w[jj][1] = *(const u32x4*)(ur + 1024); }
                float pr[8];
#pragma unroll
                for (int jj = 0; jj < 8; ++jj) { const unsigned char* hp = h2f8 + (en[jj] >> 21) * 2048 + lane * 16;
                    pr[jj] = dot32_f8(w[jj][0], w[jj][1], *(const u32x4*)hp, *(const u32x4*)(hp + 1024)); __builtin_amdgcn_sched_barrier(0); }
#pragma unroll
                for (int i = 0; i < 4; ++i) pr[i] = swap32_pair(pr[i], pr[i + 4]);
#pragma unroll
                for (int i = 0; i < 2; ++i) pr[i] = swap16_pair(pr[i], pr[i + 2]);
                const bool b3 = (lane & 8) != 0;
                { const float snd = b3 ? pr[0] : pr[1], kp = b3 ? pr[1] : pr[0]; pr[0] = kp + dpp_f<DPP_ROR8>(snd); }
                float tot = pr[0]; tot += dpp_f<DPP_XOR1>(tot); tot += dpp_f<DPP_XOR2>(tot); tot += dpp_f<DPP_HMIRROR>(tot);
                const unsigned em = (unsigned)__shfl((int)ent64, i0 + (lane >> 3));
                if ((lane & 7) == 0) {
                    const int tk = (int)(em >> 21), j = (int)((em >> 14) & 127u), row = gw + (p0 + tk) * NGW;
                    const float cf = gelu_erf(tot * (1.0f / 64.0f)) * __uint_as_float((unsigned)gl16[tk * 128 + j] << 16);
                    pairs[((size_t)(row >> 6) * 128 + j) * 64 + (row & 63)] = (cvt_pk_bf16(0.f, cf) & 0xffff0000u) | (em & 0x3FFFu);
                }
            }
        }
    }
}

__device__ __forceinline__ void phase11_peer_v(Frame& F, float* dst) {
    const unsigned* pairs = (const unsigned*)(F.ws + WS_PAIRS); const float* mf = (const float*)(F.ws + WS_MODF);
    unsigned long long* vs = (unsigned long long*)F.lds;
    for (int c = F.bid; c < DM / 8; c += F.G) {
        __syncthreads();
        { const u32x4* src = (const u32x4*)(F.ws + WS_PV + (size_t)c * NEXP * 8); u32x4* dst = (u32x4*)F.lds;
#pragma unroll 4
          for (int i = F.tid; i < NEXP * 8 / 16; i += 512) dst[i] = src[i]; }
        __syncthreads();
        for (int tile = F.wave; tile < MTOK / 64; tile += 8) {
            int lane = F.lane; asm volatile("" : "+v"(lane));
            const unsigned* pp = pairs + (size_t)tile * 128 * 64 + lane;
            f32x2 acc[4];
#pragma unroll
            for (int i = 0; i < 4; ++i) acc[i] = (f32x2){0.f, 0.f};
#define P11_LOAD(dst, j0) do { _Pragma("unroll") for (int jj = 0; jj < 16; ++jj) dst[jj] = pp[((j0) + jj) * 64]; } while (0)
#define P11_COMP(src) do { _Pragma("unroll") for (int jj = 0; jj < 16; ++jj) { const unsigned long long v = vs[src[jj] & 0x3FFFu]; const float cf = __uint_as_float(src[jj] & 0xffff0000u); \
                    const int lo = (int)(unsigned)v, hi = (int)(unsigned)(v >> 32); \
                    acc[0] += __builtin_amdgcn_cvt_pk_f32_fp8(lo, false) * cf; acc[1] += __builtin_amdgcn_cvt_pk_f32_fp8(lo, true) * cf; \
                    acc[2] += __builtin_amdgcn_cvt_pk_f32_fp8(hi, false) * cf; acc[3] += __builtin_amdgcn_cvt_pk_f32_fp8(hi, true) * cf; } } while (0)
#if PROBE_P11X
            { f32x2 sv[4]; for (int i = 0; i < 4; ++i) sv[i] = acc[i];
            unsigned pa[16], pb[16];
            P11_LOAD(pa, 0);
#pragma unroll 1
            for (int j0 = 0; j0 < 128; j0 += 32) {
                P11_LOAD(pb, j0 + 16);
                P11_COMP(pa);
                if (j0 + 32 < 128) P11_LOAD(pa, j0 + 32);
                P11_COMP(pb);
            }
              asm volatile("" :: "v"(acc[0].x), "v"(acc[1].x), "v"(acc[2].x), "v"(acc[3].x)); for (int i = 0; i < 4; ++i) acc[i] = sv[i] * 0.f; }
#endif
            unsigned pa[16], pb[16];
            P11_LOAD(pa, 0);
#pragma unroll 1
            for (int j0 = 0; j0 < 128; j0 += 32) {
                P11_LOAD(pb, j0 + 16);
                P11_COMP(pa);
                if (j0 + 32 < 128) P11_LOAD(pa, j0 + 32);
                P11_COMP(pb);
            }
#undef P11_LOAD
#undef P11_COMP
            const int row = tile * 64 + lane;
            const float* gt2 = mf + (size_t)(tile / (SEQ / 64)) * 12288 + 10240 + c * 8;
            const float* ip = F.out + (size_t)row * 2048 + c * 8; float* op = dst + (size_t)row * 2048 + c * 8;
            const f32x4 x0 = *(const f32x4*)ip, x1 = *(const f32x4*)(ip + 4), g0 = *(const f32x4*)gt2 * 0.25f, g1 = *(const f32x4*)(gt2 + 4) * 0.25f;
            *(f32x4*)op = x0 + g0 * (f32x4){acc[0].x, acc[0].y, acc[1].x, acc[1].y};
            *(f32x4*)(op + 4) = x1 + g1 * (f32x4){acc[2].x, acc[2].y, acc[3].x, acc[3].y};
        }
    }
}

__global__ void __launch_bounds__(512, 2) fwd_kernel(Args args) {
    extern __shared__ __attribute__((aligned(16))) unsigned char lds[];
    Frame F;
    F.lds = lds; F.ws = args.ws; F.tid = threadIdx.x; F.lane = F.tid & 63; F.wave = __builtin_amdgcn_readfirstlane(F.tid >> 6); F.G = gridDim.x; F.bid = blockIdx.x;
    F.x = args.in[0]; F.c = args.in[1]; F.w_ada = args.in[2]; F.b_ada = args.in[3]; F.g1 = args.in[4]; F.g2 = args.in[5]; F.w_in = args.in[6]; F.g_q = args.in[7]; F.g_k = args.in[8];
    F.rel_bias = args.in[9]; F.pool_w = args.in[10]; F.pool_scale = args.in[11]; F.w_ab = args.in[12]; F.w_pb = args.in[13]; F.w_out = args.in[14]; F.w_pq = args.in[15];
    F.peer_keys = args.in[16]; F.peer_u = args.in[17]; F.peer_v = args.in[18]; F.out = args.out;
    LAS unsigned char* ldsl = (LAS unsigned char*)lds;
    volatile LAS unsigned* misc = (volatile LAS unsigned*)(ldsl + MISC_OFF);
    if (F.tid < 4) misc[F.tid] = 0u;
    __syncthreads();
    unsigned* barw = (unsigned*)(args.ws + WS_CTL) + (size_t)args.li * XCD_BAR_WORDS;
    XcdBarrier bar; bar.bar = barw; bar.x = 0; bar.st = misc;
    const int lo = args.ph_lo, hi = args.ph_hi;
    if (hi - lo > 1) bar = xcd_barrier_post(barw, misc);
#define IN(k) (lo <= (k) && (k) < hi)
#define SEAM(k) do { if (IN(k) && IN((k) + 1)) xcd_barrier(bar); } while (0)
    bf16_t* R0 = (bf16_t*)(F.ws + WS_R0);

#define PH2_BODY { \
        pg8::Gemm g{R0, (const bf16_t*)(F.ws + WS_WIN), MTOK, INWP, DM, DM, 0}; pg8::StaticOrder S; S.init(MTOK, INWP, F.G, F.bid); \
        EpiInproj E{(bf16_t*)(F.ws + WS_QN), (bf16_t*)(F.ws + WS_KN), (bf16_t*)(F.ws + WS_V), (bf16_t*)(F.ws + WS_IQ), (bf16_t*)(F.ws + WS_IK), (bf16_t*)(F.ws + WS_PL), \
                    (bf16_t*)(F.ws + WS_GA), (bf16_t*)(F.ws + WS_GP), (float*)(F.ws + WS_IW)}; \
        pg8::gemm_phase<EpiInproj>(ldsl, g, S, E); }
#define PH3_BODY { phase3_pooled(F); phase3_indexer(F); __syncthreads(); }
#define PH4_BODY { \
        phase4_attention(F); \
        __syncthreads(); \
        pg8::Gemm g{(const bf16_t*)(F.ws + WS_POOLED), (const bf16_t*)(F.ws + WS_POOLW), MTOK, PW, 256, 1024, 256}; pg8::StaticOrder S; S.init(MTOK, PW, F.G, F.bid); \
        EpiBf16Scale E{(bf16_t*)(F.ws + WS_POOL2), 1024, F.pool_scale}; \
        pg8::gemm_phase<EpiBf16Scale>(ldsl, g, S, E); }
#define PH5_BODY { \
        { pg8::Gemm g{(const bf16_t*)(F.ws + WS_ATTN), (const bf16_t*)(F.ws + WS_WAB), MTOK, DM, 1024, 1024, 0}; pg8::StaticOrder S; S.init(MTOK, DM, F.G, F.bid); \
          EpiGate<false> E{R0, (const bf16_t*)(F.ws + WS_GA)}; pg8::gemm_phase<EpiGate<false>>(ldsl, g, S, E); } \
        { pg8::Gemm g{(const bf16_t*)(F.ws + WS_POOL2), (const bf16_t*)(F.ws + WS_WPB), MTOK, DM, 1024, 1024, 0}; pg8::StaticOrder S; S.init(MTOK, DM, F.G, F.bid); \
          EpiGate<true> E{R0, (const bf16_t*)(F.ws + WS_GP)}; pg8::gemm_phase<EpiGate<true>>(ldsl, g, S, E); } }
#define PH6_BODY { \
        pg8::Gemm g{R0, (const bf16_t*)(F.ws + WS_WOUT), MTOK, DM, DM, DM, 0}; pg8::StaticOrder S; S.init(MTOK, DM, F.G, F.bid); \
        EpiResid E{F.x, F.out, (const float*)(F.ws + WS_MODF) + 4096}; pg8::gemm_phase<EpiResid>(ldsl, g, S, E); }
#define PH8_BODY { \
        pg8::Gemm g{(const bf16_t*)(F.ws + WS_H2), (const bf16_t*)(F.ws + WS_WPQ), MTOK, DM, DM, DM, 0}; pg8::StaticOrder S; S.init(MTOK, DM, F.G, F.bid); \
        EpiBf16Scale E{R0, 2048, nullptr}; pg8::gemm_phase<EpiBf16Scale>(ldsl, g, S, E); }
#define PH9_BODY { \
        pg8::Gemm g{R0, (const bf16_t*)(F.ws + WS_KEYSBD), MTOK, DM, 256, DM, 256}; pg8::StaticOrder S; S.init(MTOK, DM, F.G, F.bid); \
        EpiBf16Scale E{(bf16_t*)(F.ws + WS_SUB), 2048, nullptr}; pg8::gemm_phase<EpiBf16Scale>(ldsl, g, S, E); }
#define REP(k) if constexpr (((PROBE_REP) >> (k)) & 1)

    if (IN(0)) { phase0_prep(F); REP(0) { __syncthreads(); phase0_prep(F); } }
    SEAM(0);
    if (IN(1)) { phase_modnorm<true>(F, F.x, F.g1, 0, 2048, R0); REP(1) { phase_modnorm<true>(F, F.x, F.g1, 0, 2048, R0); } }
    SEAM(1);
    if (IN(2)) { PH2_BODY REP(2) PH2_BODY }
    SEAM(2);
    if (IN(3)) { phase3_qknorm(F); PH3_BODY REP(3) PH3_BODY }
    SEAM(3);
    if (IN(4)) { PH4_BODY REP(4) PH4_BODY }
    SEAM(4);
    if (IN(5)) { PH5_BODY REP(5) PH5_BODY }
    SEAM(5);
    if (IN(6)) { PH6_BODY REP(6) PH6_BODY }
    SEAM(6);
    if (IN(7)) { phase_modnorm<false>(F, F.out, F.g2, 6144, 8192, (bf16_t*)(F.ws + WS_H2)); REP(7) { phase_modnorm<false>(F, F.out, F.g2, 6144, 8192, (bf16_t*)(F.ws + WS_H2)); } }
    SEAM(7);
    if (IN(8)) { PH8_BODY REP(8) PH8_BODY }
    SEAM(8);
    if (IN(9)) { PH9_BODY REP(9) PH9_BODY }
    SEAM(9);
    if (IN(10)) { phase10_peer(F); REP(10) phase10_peer(F); }
    SEAM(10);
    if (IN(11)) { REP(11) { phase11_peer_v(F, (float*)(F.ws + WS_SUB)); } phase11_peer_v(F, F.out); }
#undef IN
#undef SEAM
}

extern "C" void kernel_launch(void* const* d_in, const int* in_sizes, int n_in, void* d_out, int out_size, void* d_ws, size_t ws_size, hipStream_t stream) {
    static int grid = 0;
    if (grid == 0) {
        if (n_in != 19 || out_size != MTOK * DM || ws_size < WS_END) { fprintf(stderr, "kernel_launch: unexpected shapes (n_in %d out %d ws %zu)\n", n_in, out_size, ws_size); grid = -1; return; }
        int dev = 0, cus = 0, per_cu = 0;
        if (hipGetDevice(&dev) != hipSuccess || hipDeviceGetAttribute(&cus, hipDeviceAttributeMultiprocessorCount, dev) != hipSuccess) { grid = -1; return; }
        if (hipFuncSetAttribute((const void*)fwd_kernel, hipFuncAttributeMaxDynamicSharedMemorySize, LDS_BYTES) != hipSuccess) { fprintf(stderr, "kernel_launch: hipFuncSetAttribute failed\n"); grid = -1; return; }
        if (hipOccupancyMaxActiveBlocksPerMultiprocessor(&per_cu, (const void*)fwd_kernel, 512, LDS_BYTES) != hipSuccess || per_cu < 1) { fprintf(stderr, "kernel_launch: occupancy query says %d\n", per_cu); }
        (void)hipGetLastError();
        grid = cus;
    }
    if (grid < 0) return;
    (void)in_sizes;
    if (hipMemsetAsync((char*)d_ws + WS_CTL, 0, CTL_ZERO_BYTES, stream) != hipSuccess) return;
    Args a{};
    for (int i = 0; i < 19; ++i) a.in[i] = (const float*)d_in[i];
    a.out = (float*)d_out; a.ws = (unsigned char*)d_ws;
#if MK_PER_PHASE
    for (int p = 0; p < NPHASE; ++p) { a.ph_lo = p; a.ph_hi = p + 1; a.li = p; hipLaunchKernelGGL(fwd_kernel, dim3(grid), dim3(512), LDS_BYTES, stream, a); }
#else
    a.ph_lo = 0; a.ph_hi = NPHASE; a.li = 0;
    hipLaunchKernelGGL(fwd_kernel, dim3(grid), dim3(512), LDS_BYTES, stream, a);
#endif
}
```

```cpp
#include <hip/hip_runtime.h>
#include <cstdio>
#include <cstdint>

#ifndef MK_PER_PHASE
#define MK_PER_PHASE 0
#endif

#ifndef PROBE_REP
#define PROBE_REP 0
#endif
#ifndef PROBE_IDX
#define PROBE_IDX 0
#endif
#ifndef PROBE_SEL
#define PROBE_SEL 0
#endif
#ifndef PROBE_P11X
#define PROBE_P11X 0
#endif
#define LAS __attribute__((address_space(3)))
typedef unsigned short bf16_t;
typedef short bf16x8 __attribute__((ext_vector_type(8)));
typedef float f32x4 __attribute__((ext_vector_type(4)));
typedef float f32x2 __attribute__((ext_vector_type(2)));
typedef unsigned u32x4 __attribute__((ext_vector_type(4)));
typedef unsigned u32x2 __attribute__((ext_vector_type(2)));

constexpr int BATCH = 8, SEQ = 4096, DM = 2048, MTOK = BATCH * SEQ;
constexpr int NHEAD = 8, HDIM = 128, AW = 1024, KVW = 256, IHEADS = 16, IDIM = 64, KSEL = 256;
constexpr int PW = 1024, PHEADS = 8, NEXP = 16384;
constexpr int INW = 7760, INWP = 7936;
constexpr float EPS = 1e-6f;
constexpr int NPHASE = 12;

constexpr size_t MiB = 1u << 20;
constexpr size_t WS_CTL = 0, CTL_ZERO_BYTES = 256 * 1024;
constexpr size_t WS_MODP = 2 * MiB;
constexpr size_t WS_MODF = 4 * MiB;
constexpr size_t WS_POOLW = 5 * MiB;
constexpr size_t WS_KEYSBD = 6 * MiB;
constexpr size_t WS_WIN = 8 * MiB;
constexpr size_t WS_WAB = 40 * MiB, WS_WPB = 44 * MiB, WS_WOUT = 48 * MiB, WS_WPQ = 56 * MiB;
constexpr size_t WS_PU = 64 * MiB, WS_PV = 128 * MiB;
constexpr size_t WS_R0 = 192 * MiB;
constexpr size_t WS_GA = 320 * MiB, WS_GP = 448 * MiB;
constexpr size_t WS_SUB = 320 * MiB;
constexpr size_t WS_QN = 576 * MiB;
constexpr size_t WS_IQ = 640 * MiB;
constexpr size_t WS_PL = 704 * MiB;
constexpr size_t WS_KN = 768 * MiB, WS_V = 784 * MiB;
constexpr size_t WS_IK = 800 * MiB;
constexpr size_t WS_IW = 804 * MiB;
constexpr size_t WS_SEL = 806 * MiB;
constexpr size_t WS_POOLED = 822 * MiB;
constexpr size_t WS_H2 = 886 * MiB;
constexpr size_t WS_END = 1014 * MiB;
constexpr size_t WS_Q8 = WS_H2, WS_K8 = WS_H2 + 32 * MiB, WS_V8 = WS_H2 + 40 * MiB;
constexpr size_t WS_ATTN = WS_IQ, WS_POOL2 = WS_PL, WS_PAIRS = WS_QN, WS_WLS = WS_QN + 32 * MiB;

constexpr int LDS_BYTES = 160 * 1024;
constexpr int MISC_OFF = 159 * 1024;

__device__ __forceinline__ unsigned cvt_pk_bf16(float lo, float hi) { unsigned r; asm volatile("v_cvt_pk_bf16_f32 %0, %1, %2" : "=v"(r) : "v"(lo), "v"(hi)); return r; }
__device__ __forceinline__ float bf_lo(unsigned w) { return __uint_as_float(w << 16); }
__device__ __forceinline__ float bf_hi(unsigned w) { return __uint_as_float(w & 0xffff0000u); }
template <int CTRL> __device__ __forceinline__ float dpp_f(float x) { return __int_as_float(__builtin_amdgcn_update_dpp(0, __float_as_int(x), CTRL, 0xF, 0xF, true)); }
#define DPP_XOR1 0xB1
#define DPP_XOR2 0x4E
#define DPP_HMIRROR 0x141
#define DPP_MIRROR 0x140
#define DPP_ROR8 0x128
__device__ __forceinline__ float xor16_sum(float x) { const auto r = __builtin_amdgcn_permlane16_swap(__float_as_uint(x), __float_as_uint(x), false, false); return __uint_as_float(r[0]) + __uint_as_float(r[1]); }
__device__ __forceinline__ float xor32_sum(float x) { const auto r = __builtin_amdgcn_permlane32_swap(__float_as_uint(x), __float_as_uint(x), false, false); return __uint_as_float(r[0]) + __uint_as_float(r[1]); }
__device__ __forceinline__ float xor16_max(float x) { const auto r = __builtin_amdgcn_permlane16_swap(__float_as_uint(x), __float_as_uint(x), false, false); return fmaxf(__uint_as_float(r[0]), __uint_as_float(r[1])); }
__device__ __forceinline__ float swap32_pair(float a, float b) { const auto r = __builtin_amdgcn_permlane32_swap(__float_as_uint(a), __float_as_uint(b), false, false); return __uint_as_float(r[0]) + __uint_as_float(r[1]); }
__device__ __forceinline__ float swap16_pair(float a, float b) { const auto r = __builtin_amdgcn_permlane16_swap(__float_as_uint(a), __float_as_uint(b), false, false); return __uint_as_float(r[0]) + __uint_as_float(r[1]); }
__device__ __forceinline__ float row_sum16(float v) { v += dpp_f<DPP_XOR1>(v); v += dpp_f<DPP_XOR2>(v); v += dpp_f<DPP_HMIRROR>(v); v += dpp_f<DPP_MIRROR>(v); return v; }
__device__ __forceinline__ float row_max16(float v) { v = fmaxf(v, dpp_f<DPP_XOR1>(v)); v = fmaxf(v, dpp_f<DPP_XOR2>(v)); v = fmaxf(v, dpp_f<DPP_HMIRROR>(v)); v = fmaxf(v, dpp_f<DPP_MIRROR>(v)); return v; }
__device__ __forceinline__ float wave_sum(float v) { return xor32_sum(xor16_sum(row_sum16(v))); }
__device__ __forceinline__ float sigmoidf_(float x) { return __builtin_amdgcn_rcpf(1.0f + __expf(-x)); }
__device__ __forceinline__ float dot8(u32x4 w, const float* h) {
    return bf_lo(w.x) * h[0] + bf_hi(w.x) * h[1] + bf_lo(w.y) * h[2] + bf_hi(w.y) * h[3] + bf_lo(w.z) * h[4] + bf_hi(w.z) * h[5] + bf_lo(w.w) * h[6] + bf_hi(w.w) * h[7];
}

#define XB_TMO      128
#define XB_XCNT(j)  (256  + 64 * (j))
#define XB_XSUB(j)  (1280 + 64 * (j))
#define XB_XGEN(j)  (2304 + 64 * (j))
#define XB_TOP      3328
#define XB_TOPGEN   3392
#define XCD_BAR_WORDS 3456
#define XB_SPIN_CAP (1u << 18)

__device__ __forceinline__ unsigned xb_ld(unsigned* p)              { return __hip_atomic_load(p, __ATOMIC_RELAXED, __HIP_MEMORY_SCOPE_AGENT); }
__device__ __forceinline__ unsigned xb_add(unsigned* p, unsigned v) { return __hip_atomic_fetch_add(p, v, __ATOMIC_RELAXED, __HIP_MEMORY_SCOPE_AGENT); }
__device__ __forceinline__ unsigned xb_xcc_id() { return (unsigned)__builtin_amdgcn_s_getreg((3 << 11) | 20) & 0xFu; }
#define XB_SPIN(cond, bar) do { unsigned _sp = 0; while (cond) { __builtin_amdgcn_s_sleep(1); \
    if ((++_sp & 255u) == 0u) { if (xb_ld(&(bar)[XB_TMO])) break; if (_sp > XB_SPIN_CAP) { atomicAdd(&(bar)[XB_TMO], 1u); break; } } } } while (0)

struct XcdBarrier { unsigned* bar; unsigned x; volatile LAS unsigned* st; };

__device__ __forceinline__ XcdBarrier xcd_barrier_post(unsigned* bar, volatile LAS unsigned* st) {
    XcdBarrier b; b.bar = bar; b.x = xb_xcc_id(); b.st = st;
    if (threadIdx.x == 0) (void)xb_add(&bar[XB_XCNT(b.x)], 1u);
    return b;
}
__device__ __forceinline__ void xcd_barrier_complete(unsigned* bar, unsigned x, unsigned& nloc, unsigned& nx) {
    const unsigned G = gridDim.x * gridDim.y * gridDim.z;
    unsigned sum, cnt, mine, sp = 0u;
    for (;;) {
        sum = 0u; cnt = 0u; mine = 0u;
#pragma unroll
        for (unsigned j = 0; j < 16; ++j) { const unsigned c = xb_ld(&bar[XB_XCNT(j)]); sum += c; cnt += (c > 0u) ? 1u : 0u; mine = (j == x) ? c : mine; }
        if (sum == G) break;
        __builtin_amdgcn_s_sleep(1);
        if ((++sp & 255u) == 0u) { if (xb_ld(&bar[XB_TMO])) break; if (sp > XB_SPIN_CAP) { atomicAdd(&bar[XB_TMO], 1u); break; } }
    }
    nloc = mine > 0u ? mine : 1u; nx = cnt > 0u ? cnt : 1u;
}
__device__ __forceinline__ void xcd_barrier(const XcdBarrier& b) {
    asm volatile("s_waitcnt vmcnt(0)" ::: "memory");
    __syncthreads();
    if (threadIdx.x == 0) {
        unsigned* bar = b.bar;
        __builtin_amdgcn_s_waitcnt(0);
        unsigned nloc = b.st[0], nx = b.st[1];
        if (nloc == 0u) { xcd_barrier_complete(bar, b.x, nloc, nx); b.st[0] = nloc; b.st[1] = nx; }
        const unsigned old = xb_add(&bar[XB_XSUB(b.x)], 1u);
        const unsigned gen = old / nloc;
        if (old + 1u == (gen + 1u) * nloc) {
            __builtin_amdgcn_fence(__ATOMIC_RELEASE, "agent");
            asm volatile("s_waitcnt vmcnt(0)" ::: "memory");
            const unsigned og = xb_add(&bar[XB_TOP], 1u);
            const unsigned tg = og / nx;
            if (og + 1u == (tg + 1u) * nx) xb_add(&bar[XB_TOPGEN], 1u);
            else XB_SPIN(xb_ld(&bar[XB_TOPGEN]) == tg, bar);
            __builtin_amdgcn_fence(__ATOMIC_ACQUIRE, "agent");
            xb_add(&bar[XB_XGEN(b.x)], 1u);
            asm volatile("s_waitcnt vmcnt(0)" ::: "memory");
        } else {
            XB_SPIN(xb_ld(&bar[XB_XGEN(b.x)]) == gen, bar);
            __builtin_amdgcn_fence(__ATOMIC_ACQUIRE, "agent");
            asm volatile("s_waitcnt vmcnt(0)" ::: "memory");
        }
    }
    __syncthreads();
}

namespace pg8 {
constexpr int BM = 256, BK = 64, HALF = 128, HTB = HALF * BK * 2, STAGE_BYTES = 8 * HTB, NXCD = 8, WGM = 8;
__device__ __forceinline__ int lds_byte(int r, int c) { const int st = (r >> 4) * 2 + (c >> 5), rr = r & 15, cc = c & 31, ob = rr * 64 + cc * 2; return st * 1024 + (ob ^ (((ob >> 9) & 1) << 5)); }
__device__ __forceinline__ void stage_rc(int b, int& R, int& C) { const int st = b / 1024, sb = b % 1024, swz = sb ^ (((sb >> 9) & 1) << 5); R = (st >> 1) * 16 + swz / 64; C = (st & 1) * 32 + (swz % 64) / 2; }
__device__ __forceinline__ int perm32(int rho) { const int n = rho >> 4, i = rho & 15; return 8 * (i >> 2) + 4 * n + (i & 3); }

struct Unit { int pm, pn; };
struct Gemm { const bf16_t* A; const bf16_t* Bt; int M, N, K, lda, a_pn_off; const bf16_t* A2; const bf16_t* Bt2; int ksplit, ldb; };

struct StaticOrder {
    int nM, nN, nwg, G, c;
    __device__ void init(int M, int N, int G_, int c_) { nM = M / BM; nN = N / BM; nwg = nM * nN; G = G_; c = c_; }
    __device__ bool next(int i, Unit& u) const {
        const long L = (long)i * G + c; if (L >= nwg) return false;
        int wgid = (int)L; { const int q = nwg / NXCD, r = nwg % NXCD, xcd = wgid % NXCD, off = wgid / NXCD; wgid = (xcd < r ? xcd * (q + 1) : r * (q + 1) + (xcd - r) * q) + off; }
        const int nig = WGM * nN, gid = wgid / nig, fm = gid * WGM, gsz = (nM - fm) < WGM ? (nM - fm) : WGM;
        u.pm = fm + ((wgid % nig) % gsz); u.pn = (wgid % nig) / gsz; return true;
    }
};

template <class Epi>
__device__ __forceinline__ void gemm_phase(LAS unsigned char* lds, const Gemm g, const StaticOrder& S, const Epi& E) {
    const int tid = threadIdx.x, wid = __builtin_amdgcn_readfirstlane(tid >> 6), lane = tid & 63, wr = wid >> 2, wc = wid & 3, fr = lane & 15, fq = lane >> 4;
    const int K = g.K, nt = K / BK, lda = g.lda, ldb = g.ldb ? g.ldb : g.K, ksplit = g.ksplit;
    unsigned voffA[2], voffB[2];
#pragma unroll
    for (int i = 0; i < 2; ++i) { int R, C; stage_rc(tid * 16 + i * 8192, R, C); const int Rb = Epi::PERM ? ((R & ~31) + perm32(R & 31)) : R;
        voffA[i] = (unsigned)(R * lda + C) * 2u; voffB[i] = (unsigned)(Rb * ldb + C) * 2u; }
    const size_t kstep = (size_t)(BK * 2);
    const size_t hsA = (size_t)HALF * lda * 2, hsB = (size_t)HALF * ldb * 2;
    const size_t tsA = 2 * hsA, tsB = 2 * hsB;
    const unsigned ldsw = (unsigned)wid * 1024u;
    const int aoff = lds_byte(wr * 64 + fr, fq * 8), boff = lds_byte(wc * 32 + fr, fq * 8);
#define PG8_SA(b, h) (((b) * 2 + (h)) * HTB)
#define PG8_SB(b, h) ((4 + (b) * 2 + (h)) * HTB)
#define PG8_STAGE(bufoff, gbase, voff) do { _Pragma("unroll") for (int _i = 0; _i < 2; ++_i) \
        __builtin_amdgcn_global_load_lds((const unsigned*)((const char*)(gbase) + (voff)[_i]), (LAS unsigned*)(lds + (bufoff) + ldsw + _i * 8192), 16, 0, 0); } while (0)
#define PG8_LDA(dst, b, h) do { _Pragma("unroll") for (int m = 0; m < 4; ++m) _Pragma("unroll") for (int k = 0; k < 2; ++k) dst[m][k] = *(const LAS bf16x8*)(lds + PG8_SA(b, h) + aoff + m * 2048 + k * 1024); } while (0)
#define PG8_LDB(dst, b, h) do { _Pragma("unroll") for (int n = 0; n < 2; ++n) _Pragma("unroll") for (int k = 0; k < 2; ++k) dst[n][k] = *(const LAS bf16x8*)(lds + PG8_SB(b, h) + boff + n * 2048 + k * 1024); } while (0)
#define PG8_MMA(ai, bj, At, Bt) do { __builtin_amdgcn_s_setprio(1); _Pragma("unroll") for (int m = 0; m < 4; ++m) _Pragma("unroll") for (int n = 0; n < 2; ++n) _Pragma("unroll") for (int k = 0; k < 2; ++k) \
        acc[ai][bj][m][n] = __builtin_amdgcn_mfma_f32_16x16x32_bf16(Bt[n][k], At[m][k], acc[ai][bj][m][n], 0, 0, 0); __builtin_amdgcn_s_setprio(0); } while (0)
#define PG8_WAIT_V(n) asm volatile("s_waitcnt vmcnt(" #n ")" ::: "memory")
#define PG8_WAIT_L(n) asm volatile("s_waitcnt lgkmcnt(" #n ")" ::: "memory")
#define PG8_BAR __builtin_amdgcn_s_barrier()
#define PG8_SCHED __builtin_amdgcn_sched_barrier(0)
    Unit cur, nxt; int ui = 0;
    if (!S.next(0, cur)) return;
    f32x4 acc[2][2][4][2];
#pragma unroll
    for (int a = 0; a < 2; ++a)
#pragma unroll
        for (int b = 0; b < 2; ++b)
#pragma unroll
            for (int m = 0; m < 4; ++m)
#pragma unroll
                for (int n = 0; n < 2; ++n) acc[a][b][m][n] = (f32x4){0.f, 0.f, 0.f, 0.f};
    bf16x8 At[4][2], B0[2][2], B1[2][2];
    const char* cA = (const char*)g.A + (size_t)cur.pm * tsA + (size_t)cur.pn * g.a_pn_off * 2; const char* cB = (const char*)g.Bt + (size_t)cur.pn * tsB;
    PG8_STAGE(PG8_SB(0, 0), cB, voffB); PG8_STAGE(PG8_SB(0, 1), cB + hsB, voffB); PG8_STAGE(PG8_SA(0, 0), cA, voffA); PG8_STAGE(PG8_SA(0, 1), cA + hsA, voffA);
    if (wr == 1) PG8_BAR;
    PG8_WAIT_V(2); PG8_BAR;
    PG8_STAGE(PG8_SB(1, 0), cB + kstep, voffB); PG8_STAGE(PG8_SA(1, 0), cA + kstep, voffA); PG8_STAGE(PG8_SB(1, 1), cB + hsB + kstep, voffB);
    PG8_WAIT_V(6); PG8_BAR;
    for (;;) {
        const bool has_next = S.next(ui + 1, nxt);
        const char* nA = has_next ? (const char*)g.A + (size_t)nxt.pm * tsA + (size_t)nxt.pn * g.a_pn_off * 2 : cA; const char* nB = has_next ? (const char*)g.Bt + (size_t)nxt.pn * tsB : cB;
        const char* cA2 = (const char*)g.A2 + (size_t)cur.pm * tsA; const char* cB2 = (const char*)g.Bt2 + (size_t)cur.pn * tsB;
        for (int t = 0; t < nt; t += 2) {
            const bool last = (t == nt - 2);
            const bool s1 = ksplit && (t >= ksplit), s2 = ksplit && (t + 2 >= ksplit);
            const char* a1 = (s1 ? cA2 + (size_t)(t - ksplit + 1) * kstep : cA + (size_t)(t + 1) * kstep);
            const char* a2 = last ? nA : (s2 ? cA2 + (size_t)(t + 2 - ksplit) * kstep : cA + (size_t)(t + 2) * kstep);
            const char* b2 = last ? nB : (s2 ? cB2 + (size_t)(t + 2 - ksplit) * kstep : cB + (size_t)(t + 2) * kstep);
            const char* a3 = a2 + kstep; const char* b3 = b2 + kstep;
            PG8_LDB(B0, 0, 0); PG8_LDB(B1, 0, 1); PG8_SCHED; PG8_LDA(At, 0, 0); PG8_STAGE(PG8_SA(1, 1), a1 + hsA, voffA);
            PG8_WAIT_V(8); PG8_WAIT_L(0); PG8_BAR; PG8_MMA(0, 0, At, B0); PG8_MMA(0, 1, At, B1); PG8_BAR; PG8_SCHED;
            PG8_LDA(At, 0, 1); PG8_STAGE(PG8_SB(0, 0), b2, voffB); PG8_STAGE(PG8_SB(0, 1), b2 + hsB, voffB); PG8_STAGE(PG8_SA(0, 0), a2, voffA);
            PG8_WAIT_V(8); PG8_WAIT_L(0); PG8_BAR; PG8_MMA(1, 0, At, B0); PG8_MMA(1, 1, At, B1); PG8_BAR; PG8_SCHED;
            PG8_LDB(B0, 1, 0); PG8_LDB(B1, 1, 1); PG8_SCHED; PG8_LDA(At, 1, 0); PG8_STAGE(PG8_SA(0, 1), a2 + hsA, voffA);
            PG8_WAIT_V(8); PG8_WAIT_L(0); PG8_BAR; PG8_MMA(0, 0, At, B0); PG8_MMA(0, 1, At, B1); PG8_BAR; PG8_SCHED;
            PG8_LDA(At, 1, 1); PG8_STAGE(PG8_SB(1, 0), b3, voffB); PG8_STAGE(PG8_SB(1, 1), b3 + hsB, voffB); PG8_STAGE(PG8_SA(1, 0), a3, voffA);
            PG8_WAIT_V(8); PG8_WAIT_L(0); PG8_BAR; PG8_MMA(1, 0, At, B0); PG8_MMA(1, 1, At, B1); PG8_BAR; PG8_SCHED;
            if constexpr (Epi::MID) { if (t + 2 == ksplit) E.mid(acc, cur, wr, wc, fr, fq); }
        }
        if (wr == 0) PG8_BAR;
        E(acc, cur, wr, wc, fr, fq);
        if (!has_next) break;
#pragma unroll
        for (int a = 0; a < 2; ++a)
#pragma unroll
            for (int b = 0; b < 2; ++b)
#pragma unroll
                for (int m = 0; m < 4; ++m)
#pragma unroll
                    for (int n = 0; n < 2; ++n) acc[a][b][m][n] = (f32x4){0.f, 0.f, 0.f, 0.f};
        cur = nxt; cA = nA; cB = nB; ++ui;
        if (wr == 1) PG8_BAR;
    }
    PG8_WAIT_V(0);
    PG8_BAR;
#undef PG8_SA
#undef PG8_SB
#undef PG8_STAGE
#undef PG8_LDA
#undef PG8_LDB
#undef PG8_MMA
#undef PG8_WAIT_V
#undef PG8_WAIT_L
#undef PG8_BAR
#undef PG8_SCHED
}
}
using pg8::Unit;

typedef f32x4 AccT[2][2][4][2];
__device__ __forceinline__ u32x4 pack8(f32x4 a, f32x4 b) { u32x4 w; w.x = cvt_pk_bf16(a[0], a[1]); w.y = cvt_pk_bf16(a[2], a[3]); w.z = cvt_pk_bf16(b[0], b[1]); w.w = cvt_pk_bf16(b[2], b[3]); return w; }
__device__ __forceinline__ void unpack8(u32x4 w, f32x4& a, f32x4& b) { a = (f32x4){bf_lo(w.x), bf_hi(w.x), bf_lo(w.y), bf_hi(w.y)}; b = (f32x4){bf_lo(w.z), bf_hi(w.z), bf_lo(w.w), bf_hi(w.w)}; }

struct EpiInproj {
    static constexpr bool PERM = true, MID = false;
    bf16_t *q, *k, *v, *iq, *ik, *pl, *ga, *gp; float* iw;
    __device__ __forceinline__ void operator()(const AccT& acc, const Unit& u, int wr, int wc, int fr, int fq) const {
        const int pn = u.pn, row0 = u.pm * 256 + wr * 64 + fr;
        if (pn == 10) {
            if (wc < 2) {
#pragma unroll
                for (int ai = 0; ai < 2; ++ai)
#pragma unroll
                    for (int m = 0; m < 4; ++m) { const size_t row = (size_t)(row0 + ai * 128 + m * 16);
                        *(u32x4*)(ik + row * 64 + wc * 32 + 8 * fq) = pack8(acc[ai][0][m][0], acc[ai][0][m][1]); }
            } else if (wc == 2) {
                if (fq < 2) {
#pragma unroll
                    for (int ai = 0; ai < 2; ++ai)
#pragma unroll
                        for (int m = 0; m < 4; ++m) { const size_t row = (size_t)(row0 + ai * 128 + m * 16);
                            *(f32x4*)(iw + row * 16 + 8 * fq) = acc[ai][0][m][0]; *(f32x4*)(iw + row * 16 + 8 * fq + 4) = acc[ai][0][m][1]; }
                }
            }
            return;
        }
        bf16_t* dst; int ld, tc; bool sg = false;
        if (pn < 4) { dst = q; ld = 1024; tc = pn * 256; }
        else if (pn == 4) { dst = k; ld = 256; tc = 0; }
        else if (pn == 5) { dst = v; ld = 256; tc = 0; }
        else if (pn < 10) { dst = iq; ld = 1024; tc = (pn - 6) * 256; }
        else if (pn < 15) { dst = pl; ld = 1024; tc = (pn - 11) * 256; }
        else if (pn < 23) { dst = ga; ld = 2048; tc = (pn - 15) * 256; sg = true; }
        else { dst = gp; ld = 2048; tc = (pn - 23) * 256; sg = true; }
        const int col0 = tc + wc * 32 + 8 * fq;
#pragma unroll
        for (int ai = 0; ai < 2; ++ai)
#pragma unroll
            for (int m = 0; m < 4; ++m) { bf16_t* rowp = dst + (size_t)(row0 + ai * 128 + m * 16) * ld + col0;
#pragma unroll
                for (int bj = 0; bj < 2; ++bj) { f32x4 v0 = acc[ai][bj][m][0], v1 = acc[ai][bj][m][1];
                    if (sg) {
#pragma unroll
                        for (int j = 0; j < 4; ++j) { v0[j] = sigmoidf_(v0[j]); v1[j] = sigmoidf_(v1[j]); } }
                    *(u32x4*)(rowp + bj * 128) = pack8(v0, v1); } }
    }
};
struct EpiBf16Scale {
    static constexpr bool PERM = true, MID = false;
    bf16_t* O; int ldc; const float* cs;
    __device__ __forceinline__ void operator()(const AccT& acc, const Unit& u, int wr, int wc, int fr, int fq) const {
        const int row0 = u.pm * 256 + wr * 64 + fr, col0 = u.pn * 256 + wc * 32 + 8 * fq;
        f32x4 s[2][2];
#pragma unroll
        for (int bj = 0; bj < 2; ++bj)
#pragma unroll
            for (int n = 0; n < 2; ++n) s[bj][n] = cs ? *(const f32x4*)(cs + col0 + bj * 128 + 4 * n) : (f32x4){1.f, 1.f, 1.f, 1.f};
#pragma unroll
        for (int ai = 0; ai < 2; ++ai)
#pragma unroll
            for (int m = 0; m < 4; ++m) { bf16_t* rowp = O + (size_t)(row0 + ai * 128 + m * 16) * ldc + col0;
#pragma unroll
                for (int bj = 0; bj < 2; ++bj) *(u32x4*)(rowp + bj * 128) = pack8(acc[ai][bj][m][0] * s[bj][0], acc[ai][bj][m][1] * s[bj][1]); }
    }
};
template <bool ADD> struct EpiGate {
    static constexpr bool PERM = true, MID = false;
    bf16_t* O; const bf16_t* gate;
    __device__ __forceinline__ void operator()(const AccT& acc, const Unit& u, int wr, int wc, int fr, int fq) const {
        const int row0 = u.pm * 256 + wr * 64 + fr, col0 = u.pn * 256 + wc * 32 + 8 * fq;
#pragma unroll
        for (int ai = 0; ai < 2; ++ai)
#pragma unroll
            for (int m = 0; m < 4; ++m) { const size_t off = (size_t)(row0 + ai * 128 + m * 16) * 2048 + col0;
#pragma unroll
                for (int bj = 0; bj < 2; ++bj) { f32x4 g0, g1; unpack8(*(const u32x4*)(gate + off + bj * 128), g0, g1);
                    f32x4 r0 = g0 * acc[ai][bj][m][0], r1 = g1 * acc[ai][bj][m][1];
                    if (ADD) { f32x4 o0, o1; unpack8(*(const u32x4*)(O + off + bj * 128), o0, o1); r0 += o0; r1 += o1; }
                    *(u32x4*)(O + off + bj * 128) = pack8(r0, r1); } }
    }
};
struct EpiMerge {
    static constexpr bool PERM = true, MID = true;
    bf16_t* O; const bf16_t* ga; const bf16_t* gp;
    __device__ __forceinline__ void mid(AccT& acc, const Unit& u, int wr, int wc, int fr, int fq) const {
        const auto ra = __builtin_amdgcn_make_buffer_rsrc((void*)ga, 0, 0x7FFFFFFF, 0x00020000), rp = __builtin_amdgcn_make_buffer_rsrc((void*)gp, 0, 0x7FFFFFFF, 0x00020000);
        const int voff = ((wr * 64 + fr) * 2048 + wc * 32 + 8 * fq) * 2;
        const int sbase = (u.pm * 256 * 2048 + u.pn * 256) * 2;
#pragma unroll
        for (int ai = 0; ai < 2; ++ai)
#pragma unroll
            for (int m = 0; m < 4; ++m)
#pragma unroll
                for (int bj = 0; bj < 2; ++bj) { const int so = sbase + ((ai * 128 + m * 16) * 2048 + bj * 128) * 2;
                    const u32x4 wa = __builtin_bit_cast(u32x4, __builtin_amdgcn_raw_buffer_load_b128(ra, voff, so, 0)), wp = __builtin_bit_cast(u32x4, __builtin_amdgcn_raw_buffer_load_b128(rp, voff, so, 0));
                    f32x4 a0, a1, p0, p1; unpack8(wa, a0, a1); unpack8(wp, p0, p1);
#pragma unroll
                    for (int j = 0; j < 4; ++j) { acc[ai][bj][m][0][j] *= a0[j] * __builtin_amdgcn_rcpf(p0[j]); acc[ai][bj][m][1][j] *= a1[j] * __builtin_amdgcn_rcpf(p1[j]); }
                    asm volatile("" : "+v"(acc[ai][bj][m][0]), "+v"(acc[ai][bj][m][1]) :: "memory"); }
    }
    __device__ __forceinline__ void operator()(const AccT& acc, const Unit& u, int wr, int wc, int fr, int fq) const {
        const int row0 = u.pm * 256 + wr * 64 + fr, col0 = u.pn * 256 + wc * 32 + 8 * fq;
#pragma unroll
        for (int ai = 0; ai < 2; ++ai)
#pragma unroll
            for (int m = 0; m < 4; ++m) { const size_t off = (size_t)(row0 + ai * 128 + m * 16) * 2048 + col0;
#pragma unroll
                for (int bj = 0; bj < 2; ++bj) { f32x4 p0, p1; unpack8(*(const u32x4*)(gp + off + bj * 128), p0, p1);
                    *(u32x4*)(O + off + bj * 128) = pack8(p0 * acc[ai][bj][m][0], p1 * acc[ai][bj][m][1]); } }
    }
};
struct EpiResid {
    static constexpr bool PERM = false, MID = false;
    const float* x; float* out; const float* gt;
    __device__ __forceinline__ void operator()(const AccT& acc, const Unit& u, int wr, int wc, int fr, int fq) const {
        const int row0 = u.pm * 256 + wr * 64 + fr, col0 = u.pn * 256 + wc * 32 + 4 * fq;
        const float* gtb = gt + (size_t)(u.pm / 16) * 12288;
        f32x4 g[2][2];
#pragma unroll
        for (int bj = 0; bj < 2; ++bj)
#pragma unroll
            for (int n = 0; n < 2; ++n) g[bj][n] = *(const f32x4*)(gtb + col0 + bj * 128 + n * 16);
#pragma unroll
        for (int ai = 0; ai < 2; ++ai)
#pragma unroll
            for (int m = 0; m < 4; ++m) { const size_t off = (size_t)(row0 + ai * 128 + m * 16) * 2048 + col0;
#pragma unroll
                for (int bj = 0; bj < 2; ++bj)
#pragma unroll
                    for (int n = 0; n < 2; ++n) { const f32x4 xv = *(const f32x4*)(x + off + bj * 128 + n * 16);
                        *(f32x4*)(out + off + bj * 128 + n * 16) = xv + g[bj][n] * acc[ai][bj][m][n]; } }
    }
};
struct EpiF32 {
    static constexpr bool PERM = false, MID = false;
    float* C; int ldc;
    __device__ __forceinline__ void operator()(const AccT& acc, const Unit& u, int wr, int wc, int fr, int fq) const {
        const int row0 = u.pm * 256 + wr * 64 + fr, col0 = u.pn * 256 + wc * 32 + 4 * fq;
#pragma unroll
        for (int ai = 0; ai < 2; ++ai)
#pragma unroll
            for (int m = 0; m < 4; ++m) { float* rowp = C + (size_t)(row0 + ai * 128 + m * 16) * ldc + col0;
#pragma unroll
                for (int bj = 0; bj < 2; ++bj)
#pragma unroll
                    for (int n = 0; n < 2; ++n) *(f32x4*)(rowp + bj * 128 + n * 16) = acc[ai][bj][m][n]; }
    }
};

struct Args { const float* in[19]; float* out; unsigned char* ws; int ph_lo, ph_hi; int li, pad; };
struct Frame {
    unsigned char* lds; unsigned char* ws;
    int tid, lane, wave, G, bid;
    const float *x, *c, *w_ada, *b_ada, *g1, *g2, *w_in, *g_q, *g_k, *rel_bias, *pool_w, *pool_scale, *w_ab, *w_pb, *w_out, *w_pq, *peer_keys, *peer_u, *peer_v;
    float* out;
};

template <class Fn> __device__ __forceinline__ void transpose_item(const float* W, int K, int N, bf16_t* WT, int ldk, int drow0, int k0, float* scr, int lane, Fn srccol) {
    const int sc = srccol(drow0 + (lane & 31));
#pragma unroll 8
    for (int i = 0; i < 32; ++i) { const int kk = 2 * i + (lane >> 5); scr[kk * 33 + (lane & 31)] = sc >= 0 ? W[(size_t)(k0 + kk) * N + sc] : 0.f; }
    asm volatile("s_waitcnt lgkmcnt(0)" ::: "memory");
    const int c = lane & 7;
#pragma unroll
    for (int j = 0; j < 4; ++j) { const int n = (lane >> 3) + 8 * j; const float* s = scr + (8 * c) * 33 + n;
        u32x4 o; o.x = cvt_pk_bf16(s[0 * 33], s[1 * 33]); o.y = cvt_pk_bf16(s[2 * 33], s[3 * 33]); o.z = cvt_pk_bf16(s[4 * 33], s[5 * 33]); o.w = cvt_pk_bf16(s[6 * 33], s[7 * 33]);
        *(u32x4*)(WT + (size_t)(drow0 + n) * ldk + k0 + 8 * c) = o; }
    asm volatile("s_waitcnt lgkmcnt(0)" ::: "memory");
}
__device__ __forceinline__ void phase0_prep(Frame& F) {
    const int gw = F.bid * 8 + F.wave, NGW = F.G * 8;
    float* scr = (float*)(F.lds + F.wave * 16384);
    constexpr int I_IN = (INWP / 32) * (DM / 64);
    constexpr int I_AB = (2048 / 32) * (1024 / 64), I_OUT = (2048 / 32) * (2048 / 64), I_PW = 4 * 8 * 4;
    constexpr int NIT = I_IN + 2 * I_AB + 2 * I_OUT + I_PW;
    auto ident = [](int j) { return j; };
    for (int it = gw; it < NIT; it += NGW) {
        int r = it;
        if (r < I_IN) { const int nb = r % (INWP / 32), kb = r / (INWP / 32);
            transpose_item(F.w_in, DM, INW, (bf16_t*)(F.ws + WS_WIN), DM, nb * 32, kb * 64, scr, F.lane, [](int j) { return j < 2640 ? j : (j < 2816 ? -1 : j - 176); }); continue; }
        r -= I_IN;
        if (r < I_AB) { transpose_item(F.w_ab, 1024, 2048, (bf16_t*)(F.ws + WS_WAB), 1024, (r % 64) * 32, (r / 64) * 64, scr, F.lane, ident); continue; }
        r -= I_AB;
        if (r < I_AB) { transpose_item(F.w_pb, 1024, 2048, (bf16_t*)(F.ws + WS_WPB), 1024, (r % 64) * 32, (r / 64) * 64, scr, F.lane, ident); continue; }
        r -= I_AB;
        if (r < I_OUT) { transpose_item(F.w_out, 2048, 2048, (bf16_t*)(F.ws + WS_WOUT), 2048, (r % 64) * 32, (r / 64) * 64, scr, F.lane, ident); continue; }
        r -= I_OUT;
        if (r < I_OUT) { transpose_item(F.w_pq, 2048, 2048, (bf16_t*)(F.ws + WS_WPQ), 2048, (r % 64) * 32, (r / 64) * 64, scr, F.lane, ident); continue; }
        r -= I_OUT;
        { const int g = r / 32, q = r % 32, nb = q % 8, kb = q / 8;
          transpose_item(F.pool_w + (size_t)g * 65536, 256, 256, (bf16_t*)(F.ws + WS_POOLW) + (size_t)g * 65536, 256, nb * 32, kb * 64, scr, F.lane, ident); }
    }
    {
        bf16_t* kb = (bf16_t*)(F.ws + WS_KEYSBD);
        for (int i = F.bid * 512 + F.tid; i < 2048 * 32; i += F.G * 512) {
            const int row = i / 32, k8 = (i % 32) * 8, p = (row >> 7) & 1;
            u32x4 o = (u32x4){0u, 0u, 0u, 0u};
            if ((k8 >> 7) == p) { const float* s = F.peer_keys + (size_t)row * 128 + (k8 & 127); const f32x4 a = *(const f32x4*)s, b = *(const f32x4*)(s + 4); o = pack8(a, b); }
            *(u32x4*)(kb + (size_t)row * 256 + k8) = o;
        }
    }
    {
        const size_t n16 = (size_t)NEXP * DM / 16;
        unsigned char* pu = F.ws + WS_PU;
        for (size_t i = (size_t)F.bid * 512 + F.tid; i < n16; i += (size_t)F.G * 512) {
            u32x4 ou;
#pragma unroll
            for (int k = 0; k < 4; ++k) { const f32x4 a = *(const f32x4*)(F.peer_u + i * 16 + k * 4) * 64.0f;
                int wu = __builtin_amdgcn_cvt_pk_fp8_f32(a[0], a[1], 0, false); wu = __builtin_amdgcn_cvt_pk_fp8_f32(a[2], a[3], wu, true); ou[k] = (unsigned)wu; }
            *(u32x4*)(pu + i * 16) = ou;
        }
        unsigned char* pv = F.ws + WS_PV;
        for (int it = gw; it < (NEXP / 64) * 128; it += NGW) {
            const int e = (it >> 7) * 64 + F.lane, ch = it & 127;
            u32x4 ov;
#pragma unroll
            for (int k = 0; k < 4; ++k) { const f32x4 c = *(const f32x4*)(F.peer_v + (size_t)e * DM + ch * 16 + k * 4) * 4.0f;
                int wv = __builtin_amdgcn_cvt_pk_fp8_f32(c[0], c[1], 0, false); wv = __builtin_amdgcn_cvt_pk_fp8_f32(c[2], c[3], wv, true); ov[k] = (unsigned)wv; }
            *(u32x2*)(pv + ((size_t)(2 * ch) * NEXP + e) * 8) = (u32x2){ov[0], ov[1]};
            *(u32x2*)(pv + ((size_t)(2 * ch + 1) * NEXP + e) * 8) = (u32x2){ov[2], ov[3]};
        }
    }
    {
        __syncthreads();
        float* cact = (float*)(F.lds + 131072);
        float* red = (float*)F.lds;
        float* mp = (float*)(F.ws + WS_MODP);
        for (int it = F.bid; it < 48 * 4; it += F.G) {
            const int cb = it % 48, ds = it / 48, d0 = ds * 512;
            for (int i = F.tid; i < 8 * 512; i += 512) { const int b = i >> 9, d = i & 511; const float cv = F.c[b * DM + d0 + d]; cact[i] = cv * sigmoidf_(cv); }
            __syncthreads();
            f32x4 a[8];
#pragma unroll
            for (int b = 0; b < 8; ++b) a[b] = (f32x4){0.f, 0.f, 0.f, 0.f};
            const float* wp = F.w_ada + (size_t)(d0 + F.wave * 64) * 12288 + cb * 256 + F.lane * 4;
#pragma unroll 4
            for (int d = 0; d < 64; ++d) { const f32x4 w = *(const f32x4*)(wp + (size_t)d * 12288);
#pragma unroll
                for (int b = 0; b < 8; ++b) a[b] += w * cact[b * 512 + F.wave * 64 + d]; }
#pragma unroll
            for (int b = 0; b < 8; ++b)
#pragma unroll
                for (int j = 0; j < 4; ++j) red[(F.wave * 32 + b * 4 + j) * 64 + F.lane] = a[b][j];
            __syncthreads();
            for (int i = F.tid; i < 2048; i += 512) { const int v = i >> 6, l = i & 63; float s = 0.f;
#pragma unroll
                for (int w = 0; w < 8; ++w) s += red[(w * 32 + v) * 64 + l];
                mp[((size_t)ds * 8 + (v >> 2)) * 12288 + cb * 256 + l * 4 + (v & 3)] = s; }
            __syncthreads();
        }
    }
}

template <bool FIRST> __device__ __forceinline__ void phase_modnorm(Frame& F, const float* xin, const float* gain, int off_sh, int off_sc, bf16_t* dst) {
    const float* mp = (const float*)(F.ws + WS_MODP); float* mf = (float*)(F.ws + WS_MODF);
    if (FIRST) {
        for (int i = F.bid * 512 + F.tid; i < 8 * 12288; i += F.G * 512) {
            float s = F.b_ada[i % 12288];
#pragma unroll
            for (int k = 0; k < 4; ++k) s += mp[(size_t)k * 8 * 12288 + i];
            mf[i] = s; }
    }
    float* cA = (float*)F.lds; float* cB = cA + 2048;
    for (int ch = F.bid; ch < MTOK / 128; ch += F.G) {
        const int b = ch / 32;
        __syncthreads();
        for (int col = F.tid; col < 2048; col += 512) {
            float sc, sh;
            if (FIRST) { sc = F.b_ada[off_sc + col]; sh = F.b_ada[off_sh + col];
#pragma unroll
                for (int k = 0; k < 4; ++k) { sc += mp[((size_t)k * 8 + b) * 12288 + off_sc + col]; sh += mp[((size_t)k * 8 + b) * 12288 + off_sh + col]; } }
            else { sc = mf[b * 12288 + off_sc + col]; sh = mf[b * 12288 + off_sh + col]; }
            cA[col] = gain[col] * (1.f + sc); cB[col] = sh; }
        __syncthreads();
        for (int r = F.wave; r < 128; r += 8) {
            const size_t row = (size_t)ch * 128 + r;
            const float* xr = xin + row * 2048 + F.lane * 8;
            f32x4 v[4][2]; float ss = 0.f;
#pragma unroll
            for (int i = 0; i < 4; ++i) { v[i][0] = *(const f32x4*)(xr + i * 512); v[i][1] = *(const f32x4*)(xr + i * 512 + 4);
#pragma unroll
                for (int j = 0; j < 4; ++j) ss += v[i][0][j] * v[i][0][j] + v[i][1][j] * v[i][1][j]; }
            ss = wave_sum(ss);
            const float rinv = 1.0f / sqrtf(ss * (1.0f / 2048.0f) + EPS);
#pragma unroll
            for (int i = 0; i < 4; ++i) { const int col = i * 512 + F.lane * 8;
                const f32x4 a0 = *(const f32x4*)(cA + col), a1 = *(const f32x4*)(cA + col + 4), b0 = *(const f32x4*)(cB + col), b1 = *(const f32x4*)(cB + col + 4);
                *(u32x4*)(dst + row * 2048 + col) = pack8(v[i][0] * rinv * a0 + b0, v[i][1] * rinv * a1 + b1); }
        }
    }
}

__device__ __forceinline__ u32x2 pack8_fp8(f32x4 a, f32x4 b) {
    int w0 = __builtin_amdgcn_cvt_pk_fp8_f32(a[0], a[1], 0, false); w0 = __builtin_amdgcn_cvt_pk_fp8_f32(a[2], a[3], w0, true);
    int w1 = __builtin_amdgcn_cvt_pk_fp8_f32(b[0], b[1], 0, false); w1 = __builtin_amdgcn_cvt_pk_fp8_f32(b[2], b[3], w1, true);
    return (u32x2){(unsigned)w0, (unsigned)w1};
}
__device__ __forceinline__ void phase3_qknorm(Frame& F) {
    const bf16_t* q = (const bf16_t*)(F.ws + WS_QN); const bf16_t* k = (const bf16_t*)(F.ws + WS_KN); const bf16_t* v = (const bf16_t*)(F.ws + WS_V);
    unsigned char* q8 = F.ws + WS_Q8; unsigned char* k8 = F.ws + WS_K8; unsigned char* v8 = F.ws + WS_V8;
    const int gw = F.bid * 8 + F.wave, NGW = F.G * 8;
    for (int row = gw; row < MTOK; row += NGW) {
#pragma unroll
        for (int i = 0; i < 2; ++i) { const int ci = i * 64 + F.lane;
            f32x4 a, b; unpack8(*(const u32x4*)(q + (size_t)row * 1024 + ci * 8), a, b);
            float ss = a[0] * a[0] + a[1] * a[1] + a[2] * a[2] + a[3] * a[3] + b[0] * b[0] + b[1] * b[1] + b[2] * b[2] + b[3] * b[3];
            ss = row_sum16(ss);
            const float rinv = 1.0f / sqrtf(ss * (1.0f / 128.0f) + EPS);
            const float* gp = F.g_q + (ci & 15) * 8; const f32x4 g0 = *(const f32x4*)gp, g1 = *(const f32x4*)(gp + 4);
            *(u32x2*)(q8 + (size_t)row * 1024 + ci * 8) = pack8_fp8(a * rinv * g0, b * rinv * g1); }
        { const int ci = F.lane & 31; const bool isk = F.lane < 32;
            f32x4 a, b; unpack8(*(const u32x4*)((isk ? k : v) + (size_t)row * 256 + ci * 8), a, b);
            float ss = a[0] * a[0] + a[1] * a[1] + a[2] * a[2] + a[3] * a[3] + b[0] * b[0] + b[1] * b[1] + b[2] * b[2] + b[3] * b[3];
            ss = row_sum16(ss);
            const float rinv = isk ? 1.0f / sqrtf(ss * (1.0f / 128.0f) + EPS) : 1.0f;
            const float* gp = F.g_k + (ci & 15) * 8; f32x4 g0 = *(const f32x4*)gp, g1 = *(const f32x4*)(gp + 4);
            if (!isk) { g0 = (f32x4){1.f, 1.f, 1.f, 1.f}; g1 = g0; }
            *(u32x2*)((isk ? k8 : v8) + (size_t)row * 256 + ci * 8) = pack8_fp8(a * rinv * g0, b * rinv * g1); }
    }
}
template <int W> __device__ __forceinline__ void pooled_item(const bf16_t* pl, bf16_t* po, int row, int c8) {
    const int t = row & (SEQ - 1);
    f32x4 s0 = (f32x4){0.f, 0.f, 0.f, 0.f}, s1 = s0, x0 = s0, x1 = s0;
    u32x4 v[W];
#pragma unroll
    for (int j = 0; j < W; ++j) v[j] = *(const u32x4*)(pl + (size_t)(row - (j <= t ? j : 0)) * 1024 + c8);
#pragma unroll
    for (int j = 0; j < W; ++j) { f32x4 a, b; unpack8(v[j], a, b); if (j == 0) { x0 = a; x1 = b; } if (j <= t) { s0 += a; s1 += b; } }
    const float inv = 1.0f / (float)((t + 1 < W) ? t + 1 : W);
    *(u32x4*)(po + (size_t)row * 1024 + c8) = pack8(s0 * inv - x0, s1 * inv - x1);
}
__device__ __forceinline__ void phase3_pooled(Frame& F) {
    const bf16_t* pl = (const bf16_t*)(F.ws + WS_PL); bf16_t* po = (bf16_t*)(F.ws + WS_POOLED);
    const int gw = F.bid * 8 + F.wave, NGW = F.G * 8;
    for (int it = gw; it < (MTOK / 2) * 4; it += NGW) {
        const int g = it & 3, row = (it >> 2) * 2 + (F.lane >> 5), c8 = g * 256 + (F.lane & 31) * 8;
        if (g == 0) pooled_item<2>(pl, po, row, c8); else if (g == 1) pooled_item<4>(pl, po, row, c8); else if (g == 2) pooled_item<8>(pl, po, row, c8); else pooled_item<16>(pl, po, row, c8);
    }
}
typedef float f32x16 __attribute__((ext_vector_type(16)));
__device__ __forceinline__ int sel_code(float s, float smin, float scale) { const float c = (s - smin) * scale; return (int)fminf(fmaxf(c, 0.f), 65535.f); }
__device__ __forceinline__ void hist_find(const unsigned* hist, int lane, int K, int& bsel, int& above) {
    const u32x4 h = *(const u32x4*)(hist + lane * 4);
    const int S = (int)(h.x + h.y + h.z + h.w);
    int x = S;
    x += __builtin_amdgcn_update_dpp(0, x, 0x101, 0xF, 0xF, true);
    x += __builtin_amdgcn_update_dpp(0, x, 0x102, 0xF, 0xF, true);
    x += __builtin_amdgcn_update_dpp(0, x, 0x104, 0xF, 0xF, true);
    x += __builtin_amdgcn_update_dpp(0, x, 0x108, 0xF, 0xF, true);
    const int t1 = __builtin_amdgcn_readlane(x, 16), t2 = __builtin_amdgcn_readlane(x, 32), t3 = __builtin_amdgcn_readlane(x, 48);
    const int r = lane >> 4;
    x += (r == 0 ? t1 + t2 + t3 : (r == 1 ? t2 + t3 : (r == 2 ? t3 : 0)));
    const int sufn = x - S;
    const bool mine = (x >= K) && (sufn < K);
    int b = 0, ab = 0;
    { int c = sufn;
      if (c + (int)h.w >= K) { b = 3; ab = c; } else { c += (int)h.w;
      if (c + (int)h.z >= K) { b = 2; ab = c; } else { c += (int)h.z;
      if (c + (int)h.y >= K) { b = 1; ab = c; } else { c += (int)h.y; b = 0; ab = c; } } } }
    const unsigned long long m = __ballot(mine);
    const int src = m ? (int)__builtin_ctzll(m) : 0;
    bsel = __builtin_amdgcn_readlane(lane * 4 + b, src); above = __builtin_amdgcn_readlane(ab, src);
}
__device__ __forceinline__ void indexer_select(Frame& F, int b, int t, const float* rowbuf, unsigned* hist, float* eqv, int* eqi) {
    unsigned short* selrow = (unsigned short*)(F.ws + WS_SEL) + (size_t)(b * SEQ + t) * 256;
    int lane = F.lane; asm volatile("" : "+v"(lane));
    const int nch = t / 64 + 1, n4 = (nch + 3) >> 2;
    const f32x4* rb4 = (const f32x4*)rowbuf;
    float mn = __builtin_huge_valf(), mx = -__builtin_huge_valf();
    for (int c4 = 0; c4 < n4; ++c4) { const f32x4 v = rb4[c4 * 64 + lane];
#pragma unroll
        for (int k = 0; k < 4; ++k) { const bool valid = ((c4 * 4 + k) * 64 + lane) <= t; mn = valid ? fminf(mn, v[k]) : mn; mx = valid ? fmaxf(mx, v[k]) : mx; } }
    mx = xor16_max(row_max16(mx)); { const auto r = __builtin_amdgcn_permlane32_swap(__float_as_uint(mx), __float_as_uint(mx), false, false); mx = fmaxf(__uint_as_float(r[0]), __uint_as_float(r[1])); }
    mn = -mn; mn = xor16_max(row_max16(mn)); { const auto r = __builtin_amdgcn_permlane32_swap(__float_as_uint(mn), __float_as_uint(mn), false, false); mn = -fmaxf(__uint_as_float(r[0]), __uint_as_float(r[1])); }
    const float scale = (mx > mn) ? 65535.0f / (mx - mn) : 0.f;
    *(u32x4*)(hist + lane * 4) = (u32x4){0u, 0u, 0u, 0u};
    for (int c4 = 0; c4 < n4; ++c4) { const f32x4 v = rb4[c4 * 64 + lane];
#pragma unroll
        for (int k = 0; k < 4; ++k) { const bool valid = ((c4 * 4 + k) * 64 + lane) <= t; if (valid) atomicAdd(&hist[sel_code(v[k], mn, scale) >> 8], 1u); } }
    int b1, above1; hist_find(hist, lane, KSEL, b1, above1);
    *(u32x4*)(hist + lane * 4) = (u32x4){0u, 0u, 0u, 0u};
    for (int c4 = 0; c4 < n4; ++c4) { const f32x4 v = rb4[c4 * 64 + lane];
#pragma unroll
        for (int k = 0; k < 4; ++k) { const bool valid = ((c4 * 4 + k) * 64 + lane) <= t; const int code = sel_code(v[k], mn, scale); if (valid && (code >> 8) == b1) atomicAdd(&hist[code & 255], 1u); } }
    int b2, above2; hist_find(hist, lane, KSEL - above1, b2, above2);
    const int T16 = (b1 << 8) | b2, need = KSEL - above1 - above2, ceq = (int)hist[b2];
    const unsigned long long lt_mask = (1ull << lane) - 1ull;
    const bool exact = (ceq != need) && (ceq <= 64);
    if (exact) {
        int pos = 0;
        for (int c = 0; c < nch; ++c) { const float sv = rowbuf[((c >> 2) * 64 + lane) * 4 + (c & 3)]; const int idx = c * 64 + lane;
            const bool eq = (idx <= t) && (sel_code(sv, mn, scale) == T16);
            const unsigned long long m = __ballot(eq);
            if (m) { const int p = pos + __popcll(m & lt_mask); if (eq) { eqv[p] = sv; eqi[p] = idx; } pos += __popcll(m); } }
    }
    int pos = 0, eqseen = 0;
    for (int c = 0; c < nch; ++c) {
        const float sv = rowbuf[((c >> 2) * 64 + lane) * 4 + (c & 3)]; const int idx = c * 64 + lane;
        const int code = sel_code(sv, mn, scale); const bool valid = idx <= t;
        const bool gt = valid && code > T16, eq = valid && code == T16;
        const unsigned long long meq = __ballot(eq);
        bool take = gt;
        if (meq) {
            if (ceq == need) take = take || eq;
            else if (exact) { int rank = 0; for (int m = 0; m < ceq; ++m) { const float ov = eqv[m]; const int oi = eqi[m]; rank += (ov > sv || (ov == sv && oi < idx)) ? 1 : 0; } take = take || (eq && rank < need); }
            else { const int er = eqseen + __popcll(meq & lt_mask); take = take || (eq && er < need); eqseen += __popcll(meq); }
        }
        const unsigned long long mt = __ballot(take);
        const int p = pos + __popcll(mt & lt_mask);
        if (take && p < KSEL) selrow[p] = (unsigned short)idx;
        pos += __popcll(mt);
    }
}
__device__ __forceinline__ void indexer_tile(Frame& F, int b, int t0) {
    const bf16_t* iq = (const bf16_t*)(F.ws + WS_IQ); const bf16_t* ik = (const bf16_t*)(F.ws + WS_IK); const float* iw = (const float*)(F.ws + WS_IW);
    int lane = F.lane; asm volatile("" : "+v"(lane));
    const int w = F.wave;
    if (t0 < KSEL) {
        const int t = t0 + w; unsigned short* selrow = (unsigned short*)(F.ws + WS_SEL) + (size_t)(b * SEQ + t) * 256;
#pragma unroll
        for (int p = 0; p < 4; ++p) { const int j = p * 64 + lane; selrow[j] = (unsigned short)(j <= t ? j : 0xFFFF); }
        return;
    }
    float* rowbuf = (float*)F.lds;
    unsigned char* stage = F.lds + 131072;
    const int p = w & 3, kh = w >> 2, hi = lane >> 5, r = lane & 31;
    const size_t qrow = (size_t)b * SEQ + t0 + 2 * p + (r >> 4);
    bf16x8 a[4];
#pragma unroll
    for (int ks = 0; ks < 4; ++ks) a[ks] = *(const bf16x8*)(iq + qrow * 1024 + (r & 15) * 64 + ks * 16 + 8 * hi);
    float wq[2][8];
#pragma unroll
    for (int q = 0; q < 2; ++q)
#pragma unroll
        for (int i = 0; i < 8; ++i) wq[q][i] = iw[((size_t)b * SEQ + t0 + 2 * p + q) * 16 + (i & 3) + 8 * ((i >> 2) & 1) + 4 * hi];
    const int nchunks = (t0 + 7) / 64 + 1;
    const unsigned char* gsrc = (const unsigned char*)(ik + (size_t)b * SEQ * 64) + F.tid * 16;
    const int skey = F.tid >> 3, sc16 = F.tid & 7, soff = skey * 128 + ((sc16 ^ (skey & 7)) << 4);
    u32x4 s0 = *(const u32x4*)gsrc, s1 = s0, s2 = s0, s3 = s0;
    if (1 < nchunks) s1 = *(const u32x4*)(gsrc + (size_t)1 * 8192);
    if (2 < nchunks) s2 = *(const u32x4*)(gsrc + (size_t)2 * 8192);
    if (3 < nchunks) s3 = *(const u32x4*)(gsrc + (size_t)3 * 8192);
    __syncthreads();
#define IDX_STEP(SR, cc) do { const int c = (cc); unsigned char* sb = stage + (c & 1) * 8192; \
        *(u32x4*)(sb + soff) = SR; \
        __syncthreads(); \
        if (c + 4 < nchunks) SR = *(const u32x4*)(gsrc + (size_t)(c + 4) * 8192); \
        f32x16 d; _Pragma("unroll") for (int i = 0; i < 16; ++i) d[i] = 0.f; \
        const int key = kh * 32 + r; \
        _Pragma("unroll") for (int ks = 0; ks < 4; ++ks) { const bf16x8 bf = *(const bf16x8*)(sb + key * 128 + (((ks * 2 + hi) ^ (key & 7)) << 4)); \
            d = __builtin_amdgcn_mfma_f32_32x32x16_bf16(a[ks], bf, d, 0, 0, 0); } \
        float s0_ = 0.f, s1_ = 0.f; \
        _Pragma("unroll") for (int i = 0; i < 8; ++i) { s0_ += wq[0][i] * fmaxf(d[i], 0.f); s1_ += wq[1][i] * fmaxf(d[8 + i], 0.f); } \
        const float sc = swap32_pair(s0_, s1_); \
        rowbuf[(2 * p + hi) * 4096 + ((c >> 2) * 64 + key) * 4 + (c & 3)] = sc; } while (0)
    for (int c4 = 0; c4 < nchunks; c4 += 4) {
        IDX_STEP(s0, c4);
        if (c4 + 1 < nchunks) IDX_STEP(s1, c4 + 1);
        if (c4 + 2 < nchunks) IDX_STEP(s2, c4 + 2);
        if (c4 + 3 < nchunks) IDX_STEP(s3, c4 + 3);
    }
#if PROBE_IDX == 1
    __syncthreads(); s0 = *(const u32x4*)gsrc; s1 = s0; s2 = s0; s3 = s0;
    if (1 < nchunks) s1 = *(const u32x4*)(gsrc + (size_t)1 * 8192);
    if (2 < nchunks) s2 = *(const u32x4*)(gsrc + (size_t)2 * 8192);
    if (3 < nchunks) s3 = *(const u32x4*)(gsrc + (size_t)3 * 8192);
    for (int c4 = 0; c4 < nchunks; c4 += 4) {
        IDX_STEP(s0, c4);
        if (c4 + 1 < nchunks) IDX_STEP(s1, c4 + 1);
        if (c4 + 2 < nchunks) IDX_STEP(s2, c4 + 2);
        if (c4 + 3 < nchunks) IDX_STEP(s3, c4 + 3);
    }
#endif
#undef IDX_STEP
    __syncthreads();
    indexer_select(F, b, t0 + w, rowbuf + w * 4096, (unsigned*)(F.lds + 147456) + w * 256, (float*)(F.lds + 155648) + w * 64, (int*)(F.lds + 155648 + 2048) + w * 64);
#if PROBE_IDX == 2
    indexer_select(F, b, t0 + w, rowbuf + w * 4096, (unsigned*)(F.lds + 147456) + w * 256, (float*)(F.lds + 155648) + w * 64, (int*)(F.lds + 155648 + 2048) + w * 64);
#endif
}
__device__ __forceinline__ void phase3_indexer(Frame& F) {
    const int nit = BATCH * (SEQ / 8);
    for (int k = 0;; ++k) {
        const int l = k * F.G + ((k & 1) ? (F.G - 1 - F.bid) : F.bid);
        if (l >= nit) { if (k * F.G >= nit) break; else continue; }
        const int qb = (SEQ / 8 - 1) - (l >> 3), b = l & 7;
        indexer_tile(F, b, qb * 8);
    }
}

__device__ const unsigned char g_bucket[128] = {0, 1, 2, 3, 4, 5, 6, 7, 8, 9, 10, 11, 12, 13, 14, 15, 16, 16, 16, 17, 17, 18, 18, 18, 19, 19, 19, 20, 20, 20, 20, 21, 21, 21, 21, 22, 22, 22, 22, 22, 23, 23, 23, 23, 23, 23, 24, 24, 24, 24, 24, 24, 25, 25, 25, 25, 25, 25, 25, 26, 26, 26, 26, 26, 26, 26, 26, 27, 27, 27, 27, 27, 27, 27, 27, 27, 27, 28, 28, 28, 28, 28, 28, 28, 28, 28, 28, 29, 29, 29, 29, 29, 29, 29, 29, 29, 29, 29, 29, 30, 30, 30, 30, 30, 30, 30, 30, 30, 30, 30, 30, 30, 30, 31, 31, 31, 31, 31, 31, 31, 31, 31, 31, 31, 31, 31, 31, 31};
__device__ __forceinline__ void phase4_attention(Frame& F) {
    const unsigned char* q8 = F.ws + WS_Q8; const unsigned char* k8 = F.ws + WS_K8; const unsigned char* v8 = F.ws + WS_V8;
    const unsigned short* sel = (const unsigned short*)(F.ws + WS_SEL); bf16_t* ao = (bf16_t*)(F.ws + WS_ATTN);
    float* btab = (float*)F.lds;
    __syncthreads();
    for (int i = F.tid; i < 256; i += 512) btab[i] = F.rel_bias[i];
    __syncthreads();
    float* Pl = (float*)(F.lds + 4096 + F.wave * 12288); int* idl = (int*)(Pl + 2048); float* psl = (float*)(idl + 256);
    const bool xmap = (F.G % 8) == 0;
    const int gw = xmap ? (F.bid / 8) * 8 + F.wave : F.bid * 8 + F.wave, NGW = xmap ? F.G : F.G * 8, nrows = xmap ? SEQ : MTOK;
    for (int rr = gw; rr < nrows; rr += NGW) {
        int lane = F.lane; asm volatile("" : "+v"(lane));
        const int row = xmap ? (F.bid & 7) * SEQ + rr : rr;
        const int b = row / SEQ, t = row % SEQ, r = lane & 31, hi = lane >> 5;
#pragma unroll
        for (int p = 0; p < 4; ++p) { idl[p * 64 + lane] = (int)sel[(size_t)row * 256 + p * 64 + lane]; }
        long a0[8], a1[8];
        { u32x4 qa[4];
#pragma unroll
          for (int i = 0; i < 4; ++i) qa[i] = (r < 8) ? *(const u32x4*)(q8 + (size_t)row * 1024 + r * 128 + hi * 64 + i * 16) : (u32x4){0u, 0u, 0u, 0u};
#pragma unroll
          for (int ks = 0; ks < 8; ++ks) { const unsigned lo = qa[ks >> 1][(ks & 1) * 2], hh = qa[ks >> 1][(ks & 1) * 2 + 1]; const long v = (long)(((unsigned long long)hh << 32) | lo);
              a0[ks] = (r < 4) ? v : 0l; a1[ks] = (r >= 4) ? v : 0l; } }
        f32x4 psum = (f32x4){0.f, 0.f, 0.f, 0.f};
#define AT_LOADK(buf, kb) do { const int key_ = idl[(kb) * 32 + r]; const int kc_ = key_ <= t ? key_ : 0; const unsigned char* kr_ = k8 + ((size_t)b * SEQ + kc_) * 256 + hi * 64; \
            _Pragma("unroll") for (int i = 0; i < 4; ++i) { buf[i] = *(const u32x4*)(kr_ + i * 16); buf[4 + i] = *(const u32x4*)(kr_ + 128 + i * 16); } } while (0)
#define AT_QK(buf, kb) do { const int key_ = idl[(kb) * 32 + r]; const bool valid_ = key_ <= t; const int kc_ = valid_ ? key_ : 0; \
            f32x16 d; _Pragma("unroll") for (int i = 0; i < 16; ++i) d[i] = 0.f; \
            _Pragma("unroll") for (int ks = 0; ks < 8; ++ks) { const long bv_ = (long)(((unsigned long long)buf[ks >> 1][(ks & 1) * 2 + 1] << 32) | buf[ks >> 1][(ks & 1) * 2]); d = __builtin_amdgcn_mfma_f32_32x32x16_fp8_fp8(a0[ks], bv_, d, 0, 0, 0); } \
            _Pragma("unroll") for (int ks = 0; ks < 8; ++ks) { const long bv_ = (long)(((unsigned long long)buf[4 + (ks >> 1)][(ks & 1) * 2 + 1] << 32) | buf[4 + (ks >> 1)][(ks & 1) * 2]); d = __builtin_amdgcn_mfma_f32_32x32x16_fp8_fp8(a1[ks], bv_, d, 0, 0, 0); } \
            const int dist_ = t - kc_; const int bkt_ = dist_ < 128 ? (int)g_bucket[dist_] : 31; \
            const f32x4 bias_ = *(const f32x4*)(btab + bkt_ * 8 + 4 * hi); f32x4 e_; \
            _Pragma("unroll") for (int i = 0; i < 4; ++i) e_[i] = valid_ ? __expf(d[i] * 0.08838834764831845f + bias_[i]) : 0.f; \
            psum += e_; *(f32x4*)(Pl + ((kb) * 32 + r) * 8 + 4 * hi) = e_; } while (0)
        {
            u32x4 kA[8], kB[8];
            AT_LOADK(kA, 0);
#pragma unroll 1
            for (int kb = 0; kb < 8; kb += 2) {
                AT_LOADK(kB, kb + 1);
                AT_QK(kA, kb);
                if (kb + 2 < 8) AT_LOADK(kA, kb + 2);
                AT_QK(kB, kb + 1);
            }
        }
#undef AT_LOADK
#undef AT_QK
#pragma unroll
        for (int i = 0; i < 4; ++i) psum[i] = xor16_sum(row_sum16(psum[i]));
        if (r == 0) *(f32x4*)(psl + 4 * hi) = psum;
        const int ks = lane >> 4, g = (lane >> 3) & 1, dc = lane & 7;
        float acc[4][16];
#pragma unroll
        for (int h = 0; h < 4; ++h)
#pragma unroll
            for (int j = 0; j < 16; ++j) acc[h][j] = 0.f;
#define AT_LOADV(buf, it0) do { _Pragma("unroll") for (int u = 0; u < 4; ++u) { const int key_ = idl[((it0) + u) * 4 + ks]; const int kc_ = key_ <= t ? key_ : 0; \
            buf[u] = *(const u32x4*)(v8 + ((size_t)b * SEQ + kc_) * 256 + g * 128 + dc * 16); } } while (0)
#define AT_PV(buf, it0) do { _Pragma("unroll") for (int u = 0; u < 4; ++u) { const int j_ = ((it0) + u) * 4 + ks; const u32x4 w = buf[u]; \
            const f32x4 p = *(const f32x4*)(Pl + j_ * 8 + 4 * g); \
            _Pragma("unroll") for (int dd = 0; dd < 4; ++dd) { const f32x2 lo = __builtin_amdgcn_cvt_pk_f32_fp8((int)w[dd], false), hh_ = __builtin_amdgcn_cvt_pk_f32_fp8((int)w[dd], true); \
                _Pragma("unroll") for (int h = 0; h < 4; ++h) { acc[h][4 * dd] += p[h] * lo.x; acc[h][4 * dd + 1] += p[h] * lo.y; acc[h][4 * dd + 2] += p[h] * hh_.x; acc[h][4 * dd + 3] += p[h] * hh_.y; } } } } while (0)
        {
            u32x4 vA[4], vB[4];
            AT_LOADV(vA, 0);
#pragma unroll 1
            for (int it0 = 0; it0 < 64; it0 += 8) {
                AT_LOADV(vB, it0 + 4);
                AT_PV(vA, it0);
                if (it0 + 8 < 64) AT_LOADV(vA, it0 + 8);
                AT_PV(vB, it0 + 4);
            }
        }
#undef AT_LOADV
#undef AT_PV
#pragma unroll
        for (int h = 0; h < 4; ++h)
#pragma unroll
            for (int j = 0; j < 16; ++j) acc[h][j] = xor32_sum(xor16_sum(acc[h][j]));
#pragma unroll
        for (int h = 0; h < 4; ++h) if (h == ks) { const float inv = 1.0f / psl[4 * g + h];
            bf16_t* op = ao + (size_t)row * 1024 + (4 * g + h) * 128 + dc * 16;
            *(u32x4*)op = pack8((f32x4){acc[h][0], acc[h][1], acc[h][2], acc[h][3]} * inv, (f32x4){acc[h][4], acc[h][5], acc[h][6], acc[h][7]} * inv);
            *(u32x4*)(op + 8) = pack8((f32x4){acc[h][8], acc[h][9], acc[h][10], acc[h][11]} * inv, (f32x4){acc[h][12], acc[h][13], acc[h][14], acc[h][15]} * inv); }
    }
}

__device__ __forceinline__ float dot16f8(u32x4 w, const float* h) {
    float s = 0.f;
#pragma unroll
    for (int d = 0; d < 4; ++d) { const f32x2 lo = __builtin_amdgcn_cvt_pk_f32_fp8((int)w[d], false), hi = __builtin_amdgcn_cvt_pk_f32_fp8((int)w[d], true);
        s += lo.x * h[4 * d] + lo.y * h[4 * d + 1] + hi.x * h[4 * d + 2] + hi.y * h[4 * d + 3]; }
    return s;
}
__device__ __forceinline__ void fma16f8(u32x4 w, float cf, float* acc) {
#pragma unroll
    for (int d = 0; d < 4; ++d) { const f32x2 lo = __builtin_amdgcn_cvt_pk_f32_fp8((int)w[d], false), hi = __builtin_amdgcn_cvt_pk_f32_fp8((int)w[d], true);
        acc[4 * d] += cf * lo.x; acc[4 * d + 1] += cf * lo.y; acc[4 * d + 2] += cf * hi.x; acc[4 * d + 3] += cf * hi.y; }
}
__device__ __forceinline__ float gelu_erf(float x) { return 0.5f * x * (1.0f + erff(x * 0.70710678118654752f)); }
__device__ __forceinline__ void peer_select(const bf16_t* srow, int lane, int* elist, float* gl, float* scr) {
    float* selv = scr; int* seli = (int*)(scr + 32); float* srtv = scr + 64; int* srti = (int*)(scr + 96);
    const unsigned long long lt_mask = (1ull << lane) - 1ull;
    const int half = lane >> 5, lh = lane & 31;
    const unsigned long long hmask = half ? 0xFFFFFFFF00000000ull : 0x00000000FFFFFFFFull;
    const float NINF = -__builtin_huge_valf();
#pragma unroll 1
    for (int h = 0; h < 8; ++h) {
        const u32x2 raw = *(const u32x2*)(srow + h * 256 + lane * 4);
        unsigned b[4] = {raw.x & 0xffffu, raw.x >> 16, raw.y & 0xffffu, raw.y >> 16}, k[4];
#pragma unroll
        for (int q = 0; q < 4; ++q) k[q] = (b[q] & 0x8000u) ? (b[q] ^ 0xFFFFu) : (b[q] | 0x8000u);
        unsigned T0 = 0u, T1 = 0u;
#pragma unroll
        for (int bit = 15; bit >= 0; --bit) {
            const unsigned c0 = T0 | (1u << bit), c1 = T1 | (1u << bit), cand = half ? c1 : c0;
            const unsigned long long m0 = __ballot(k[0] >= cand), m1 = __ballot(k[1] >= cand), m2 = __ballot(k[2] >= cand), m3 = __ballot(k[3] >= cand);
            const int n0 = __popc((unsigned)m0) + __popc((unsigned)m1) + __popc((unsigned)m2) + __popc((unsigned)m3);
            const int n1 = __popc((unsigned)(m0 >> 32)) + __popc((unsigned)(m1 >> 32)) + __popc((unsigned)(m2 >> 32)) + __popc((unsigned)(m3 >> 32));
            T0 = (n0 >= 16) ? c0 : T0; T1 = (n1 >= 16) ? c1 : T1;
        }
        const unsigned T = half ? T1 : T0;
        int ngt = 0, eqb = 0; unsigned long long me[4];
#pragma unroll
        for (int q = 0; q < 4; ++q) { const unsigned long long mg = __ballot(k[q] > T) & hmask; me[q] = __ballot(k[q] == T) & hmask; ngt += __popcll(mg); eqb += __popcll(me[q] & lt_mask); }
        const int need = 16 - ngt;
        bool sl[4]; int run = eqb;
#pragma unroll
        for (int q = 0; q < 4; ++q) { const bool eq = k[q] == T; sl[q] = (k[q] > T) || (eq && run < need); run += eq ? 1 : 0; }
        int pos = 0;
#pragma unroll
        for (int q = 0; q < 4; ++q) pos += __popcll(__ballot(sl[q]) & hmask & lt_mask);
#pragma unroll
        for (int q = 0; q < 4; ++q) { if (sl[q]) { selv[half * 16 + pos] = __uint_as_float(b[q] << 16); seli[half * 16 + pos] = 4 * lh + q; } pos += sl[q] ? 1 : 0; }
        const float v = selv[half * 16 + (lh & 15)]; const int ix = seli[half * 16 + (lh & 15)];
        int rank = 0;
#define PS_ROT(R) { const float vo = __int_as_float(__builtin_amdgcn_update_dpp(0, __float_as_int(v), 0x120 + (R), 0xF, 0xF, true)); const int io = __builtin_amdgcn_update_dpp(0, ix, 0x120 + (R), 0xF, 0xF, true); rank += (vo > v || (vo == v && io < ix)) ? 1 : 0; }
        PS_ROT(1) PS_ROT(2) PS_ROT(3) PS_ROT(4) PS_ROT(5) PS_ROT(6) PS_ROT(7) PS_ROT(8) PS_ROT(9) PS_ROT(10) PS_ROT(11) PS_ROT(12) PS_ROT(13) PS_ROT(14) PS_ROT(15)
#undef PS_ROT
        if (lh < 16) { srtv[half * 16 + rank] = v; srti[half * 16 + rank] = ix; }
        int ca, cb; const int c = lane;
        if (c < 16) { ca = 0; cb = c; } else if (c < 24) { ca = 1; cb = c - 16; } else if (c < 29) { ca = 2; cb = c - 24; } else if (c < 33) { ca = 3; cb = c - 29; }
        else if (c < 36) { ca = 4; cb = c - 33; } else if (c < 38) { ca = 5; cb = c - 36; } else if (c < 40) { ca = 6; cb = c - 38; } else if (c < 42) { ca = 7; cb = c - 40; }
        else { ca = (c - 42 + 8) & 15; cb = 0; }
        float s = srtv[ca] + srtv[16 + cb];
        const int eid = srti[ca] * 128 + srti[16 + cb];
        if (c >= 50) s = NINF;
        int rk = 0;
#pragma unroll 10
        for (int j = 0; j < 50; ++j) { const float sj = __shfl(s, j); rk += (sj > s || (sj == s && j < c)) ? 1 : 0; }
        const bool selq = (c < 50) && (rk < 16);
        const float smax = __shfl(s, 0);
        const float e = selq ? __expf(s - smax) : 0.f;
        const float esum = wave_sum(e);
        const unsigned long long ms = __ballot(selq);
        const int p = __popcll(ms & lt_mask);
        if (selq) { elist[h * 16 + p] = eid; gl[h * 16 + p] = e / esum; }
    }
}
__device__ __forceinline__ float dot32_f8b(u32x4 wa, u32x4 wb, u32x4 ha0, u32x4 ha1, u32x4 hb0, u32x4 hb1) {
    typedef __bf16 bf2 __attribute__((ext_vector_type(2)));
    float acc = 0.f;
#pragma unroll
    for (int d = 0; d < 4; ++d) {
        const unsigned h0 = d < 2 ? ha0[2 * d] : ha1[2 * d - 4], h1 = d < 2 ? ha0[2 * d + 1] : ha1[2 * d - 3];
        const unsigned g0 = d < 2 ? hb0[2 * d] : hb1[2 * d - 4], g1 = d < 2 ? hb0[2 * d + 1] : hb1[2 * d - 3];
        acc = __builtin_amdgcn_fdot2_f32_bf16(__builtin_amdgcn_cvt_scalef32_pk_bf16_fp8((int)wa[d], 1.0f, false), __builtin_bit_cast(bf2, h0), acc, false);
        acc = __builtin_amdgcn_fdot2_f32_bf16(__builtin_amdgcn_cvt_scalef32_pk_bf16_fp8((int)wa[d], 1.0f, true), __builtin_bit_cast(bf2, h1), acc, false);
        acc = __builtin_amdgcn_fdot2_f32_bf16(__builtin_amdgcn_cvt_scalef32_pk_bf16_fp8((int)wb[d], 1.0f, false), __builtin_bit_cast(bf2, g0), acc, false);
        acc = __builtin_amdgcn_fdot2_f32_bf16(__builtin_amdgcn_cvt_scalef32_pk_bf16_fp8((int)wb[d], 1.0f, true), __builtin_bit_cast(bf2, g1), acc, false); }
    return acc;
}
__device__ __forceinline__ void phase10_peer(Frame& F) {
    const bf16_t* sub = (const bf16_t*)(F.ws + WS_SUB); const bf16_t* h2 = (const bf16_t*)(F.ws + WS_H2);
    const unsigned char* pu = F.ws + WS_PU; unsigned* pairs = (unsigned*)(F.ws + WS_PAIRS);
    const int gw = F.bid * 8 + F.wave, NGW = F.G * 8;
    unsigned char* wb = F.lds + F.wave * 17664;
    unsigned char* h2b = wb; unsigned short* gl16 = (unsigned short*)(wb + 16384); unsigned* hist = (unsigned*)(wb + 17408); unsigned* base = hist + 32;
    unsigned* tmp = (unsigned*)wb; int* elist = (int*)(wb + 2048); float* gl = (float*)(wb + 2560); float* sscr = (float*)(wb + 3072); bf16_t* srl = (bf16_t*)(wb + 4096);
    unsigned* wls = (unsigned*)(F.ws + WS_WLS) + (size_t)gw * 512;
    const int ntok = (MTOK - gw + NGW - 1) / NGW;
    for (int p0 = 0; p0 < ntok; p0 += 4) {
        int lane = F.lane; asm volatile("" : "+v"(lane));
        const int nt = (ntok - p0) < 4 ? (ntok - p0) : 4, ne = nt * 128;
        u32x4 nxt[4];
#pragma unroll
        for (int q = 0; q < 4; ++q) nxt[q] = *(const u32x4*)(sub + (size_t)(gw + p0 * NGW) * 2048 + lane * 32 + q * 8);
#pragma unroll 1
        for (int i = 0; i < nt; ++i) {
#pragma unroll
            for (int q = 0; q < 4; ++q) *(u32x4*)(srl + lane * 32 + q * 8) = nxt[q];
            if (i + 1 < nt) {
#pragma unroll
                for (int q = 0; q < 4; ++q) nxt[q] = *(const u32x4*)(sub + (size_t)(gw + (p0 + i + 1) * NGW) * 2048 + lane * 32 + q * 8); }
            peer_select(srl, lane, elist, gl, sscr);
#if PROBE_SEL
            asm volatile("" : "+v"(lane)); peer_select(srl, lane, elist, gl, sscr);
#endif
            tmp[i * 128 + lane] = ((unsigned)(i * 128 + lane) << 14) | (unsigned)elist[lane];
            tmp[i * 128 + 64 + lane] = ((unsigned)(i * 128 + 64 + lane) << 14) | (unsigned)elist[64 + lane];
            gl16[i * 128 + lane] = (unsigned short)(cvt_pk_bf16(gl[lane], 0.f) & 0xffffu); gl16[i * 128 + 64 + lane] = (unsigned short)(cvt_pk_bf16(gl[64 + lane], 0.f) & 0xffffu);
        }
        asm volatile("" : "+v"(lane));
        if (lane < 32) hist[lane] = 0u;
        unsigned ent[8]; unsigned rk[8];
#pragma unroll
        for (int q = 0; q < 8; ++q) { const int e = q * 64 + lane; ent[q] = (e < ne) ? tmp[e] : 0u; rk[q] = (e < ne) ? atomicAdd(&hist[(ent[q] & 0x3FFFu) >> 9], 1u) : 0u; }
        { int hv = lane < 32 ? (int)hist[lane] : 0; int x = hv;
          x += __builtin_amdgcn_update_dpp(0, x, 0x111, 0xF, 0xF, true); x += __builtin_amdgcn_update_dpp(0, x, 0x112, 0xF, 0xF, true);
          x += __builtin_amdgcn_update_dpp(0, x, 0x114, 0xF, 0xF, true); x += __builtin_amdgcn_update_dpp(0, x, 0x118, 0xF, 0xF, true);
          const int t0 = __builtin_amdgcn_readlane(x, 15); if (lane >= 16) x += t0;
          if (lane < 32) base[lane] = (unsigned)(x - hv); }
#pragma unroll
        for (int q = 0; q < 8; ++q) { const int e = q * 64 + lane; if (e < ne) wls[base[(ent[q] & 0x3FFFu) >> 9] + rk[q]] = ent[q]; }
#pragma unroll 1
        for (int i = 0; i < nt; ++i) { const bf16_t* hr = h2 + (size_t)(gw + (p0 + i) * NGW) * 2048 + lane * 16;
#pragma unroll
            for (int hh = 0; hh < 2; ++hh) { const u32x4 a = *(const u32x4*)(hr + hh * 1024), b = *(const u32x4*)(hr + hh * 1024 + 8);
                *(u32x4*)(h2b + i * 4096 + hh * 2048 + lane * 32) = a; *(u32x4*)(h2b + i * 4096 + hh * 2048 + lane * 32 + 16) = b; } }
        asm volatile("s_waitcnt vmcnt(0)" ::: "memory");
        unsigned entn = __hip_atomic_load(wls + lane, __ATOMIC_RELAXED, __HIP_MEMORY_SCOPE_AGENT);
#pragma unroll 1
        for (int c = 0; c < ne; c += 64) {
            const unsigned ent64 = entn;
            if (c + 64 < ne) entn = __hip_atomic_load(wls + c + 64 + lane, __ATOMIC_RELAXED, __HIP_MEMORY_SCOPE_AGENT);
#pragma unroll 1
            for (int i0 = 0; i0 < 64; i0 += 8) {
                u32x4 w[8][2]; unsigned en[8];
#pragma unroll
                for (int jj = 0; jj < 8; ++jj) { en[jj] = (unsigned)__builtin_amdgcn_readlane((int)ent64, i0 + jj); const unsigned char* ur = pu + (size_t)(en[jj] & 0x3FFFu) * 2048 + lane * 16;
                    w[jj][0] = *(const u32x4*)ur; w[jj][1] = *(const u32x4*)(ur + 1024); }
                float pr[8];
#pragma unroll
                for (int jj = 0; jj < 8; ++jj) { const unsigned char* hp = h2b + (en[jj] >> 21) * 4096 + lane * 32;
                    pr[jj] = dot32_f8b(w[jj][0], w[jj][1], *(const u32x4*)hp, *(const u32x4*)(hp + 16), *(const u32x4*)(hp + 2048), *(const u32x4*)(hp + 2064)); __builtin_amdgcn_sched_barrier(0); }
#pragma unroll
                for (int i = 0; i < 4; ++i) pr[i] = swap32_pair(pr[i], pr[i + 4]);
#pragma unroll
                for (int i = 0; i < 2; ++i) pr[i] = swap16_pair(pr[i], pr[i + 2]);
                const bool b3 = (lane & 8) != 0;
                { const float snd = b3 ? pr[0] : pr[1], kp = b3 ? pr[1] : pr[0]; pr[0] = kp + dpp_f<DPP_ROR8>(snd); }
                float tot = pr[0]; tot += dpp_f<DPP_XOR1>(tot); tot += dpp_f<DPP_XOR2>(tot); tot += dpp_f<DPP_HMIRROR>(tot);
                const unsigned em = (unsigned)__shfl((int)ent64, i0 + (lane >> 3));
                if ((lane & 7) == 0) {
                    const int tk = (int)(em >> 21), j = (int)((em >> 14) & 127u), row = gw + (p0 + tk) * NGW;
                    const float cf = gelu_erf(tot * (1.0f / 64.0f)) * __uint_as_float((unsigned)gl16[tk * 128 + j] << 16);
                    pairs[((size_t)(row >> 6) * 128 + j) * 64 + (row & 63)] = (cvt_pk_bf16(0.f, cf) & 0xffff0000u) | (em & 0x3FFFu);
                }
            }
        }
    }
}

__device__ __forceinline__ void phase11_peer_v(Frame& F, float* dst) {
    const unsigned* pairs = (const unsigned*)(F.ws + WS_PAIRS); const float* mf = (const float*)(F.ws + WS_MODF);
    unsigned long long* vs = (unsigned long long*)F.lds;
    for (int c = F.bid; c < DM / 8; c += F.G) {
        __syncthreads();
        { const u32x4* src = (const u32x4*)(F.ws + WS_PV + (size_t)c * NEXP * 8); u32x4* dst = (u32x4*)F.lds;
#pragma unroll 4
          for (int i = F.tid; i < NEXP * 8 / 16; i += 512) dst[i] = src[i]; }
        __syncthreads();
        for (int tile = F.wave; tile < MTOK / 64; tile += 8) {
            int lane = F.lane; asm volatile("" : "+v"(lane));
            const unsigned* pp = pairs + (size_t)tile * 128 * 64 + lane;
            f32x2 acc[4];
#pragma unroll
            for (int i = 0; i < 4; ++i) acc[i] = (f32x2){0.f, 0.f};
#define P11_LOAD(dst, j0) do { _Pragma("unroll") for (int jj = 0; jj < 16; ++jj) dst[jj] = pp[((j0) + jj) * 64]; } while (0)
#define P11_COMP(src) do { _Pragma("unroll") for (int jj = 0; jj < 16; ++jj) { const unsigned long long v = vs[src[jj] & 0x3FFFu]; const float cf = __uint_as_float(src[jj] & 0xffff0000u); \
                    const int lo = (int)(unsigned)v, hi = (int)(unsigned)(v >> 32); \
                    acc[0] += __builtin_amdgcn_cvt_pk_f32_fp8(lo, false) * cf; acc[1] += __builtin_amdgcn_cvt_pk_f32_fp8(lo, true) * cf; \
                    acc[2] += __builtin_amdgcn_cvt_pk_f32_fp8(hi, false) * cf; acc[3] += __builtin_amdgcn_cvt_pk_f32_fp8(hi, true) * cf; } } while (0)
#if PROBE_P11X
            { f32x2 sv[4]; for (int i = 0; i < 4; ++i) sv[i] = acc[i];
            unsigned pa[16], pb[16];
            P11_LOAD(pa, 0);
#pragma unroll 1
            for (int j0 = 0; j0 < 128; j0 += 32) {
                P11_LOAD(pb, j0 + 16);
                P11_COMP(pa);
                if (j0 + 32 < 128) P11_LOAD(pa, j0 + 32);
                P11_COMP(pb);
            }
              asm volatile("" :: "v"(acc[0].x), "v"(acc[1].x), "v"(acc[2].x), "v"(acc[3].x)); for (int i = 0; i < 4; ++i) acc[i] = sv[i] * 0.f; }
#endif
            unsigned pa[16], pb[16];
            P11_LOAD(pa, 0);
#pragma unroll 1
            for (int j0 = 0; j0 < 128; j0 += 32) {
                P11_LOAD(pb, j0 + 16);
                P11_COMP(pa);
                if (j0 + 32 < 128) P11_LOAD(pa, j0 + 32);
                P11_COMP(pb);
            }
#undef P11_LOAD
#undef P11_COMP
            const int row = tile * 64 + lane;
            const float* gt2 = mf + (size_t)(tile / (SEQ / 64)) * 12288 + 10240 + c * 8;
            const float* ip = F.out + (size_t)row * 2048 + c * 8; float* op = dst + (size_t)row * 2048 + c * 8;
            const f32x4 x0 = *(const f32x4*)ip, x1 = *(const f32x4*)(ip + 4), g0 = *(const f32x4*)gt2 * 0.25f, g1 = *(const f32x4*)(gt2 + 4) * 0.25f;
            *(f32x4*)op = x0 + g0 * (f32x4){acc[0].x, acc[0].y, acc[1].x, acc[1].y};
            *(f32x4*)(op + 4) = x1 + g1 * (f32x4){acc[2].x, acc[2].y, acc[3].x, acc[3].y};
        }
    }
}

__global__ void __launch_bounds__(512, 2) fwd_kernel(Args args) {
    extern __shared__ __attribute__((aligned(16))) unsigned char lds[];
    Frame F;
    F.lds = lds; F.ws = args.ws; F.tid = threadIdx.x; F.lane = F.tid & 63; F.wave = __builtin_amdgcn_readfirstlane(F.tid >> 6); F.G = gridDim.x; F.bid = blockIdx.x;
    F.x = args.in[0]; F.c = args.in[1]; F.w_ada = args.in[2]; F.b_ada = args.in[3]; F.g1 = args.in[4]; F.g2 = args.in[5]; F.w_in = args.in[6]; F.g_q = args.in[7]; F.g_k = args.in[8];
    F.rel_bias = args.in[9]; F.pool_w = args.in[10]; F.pool_scale = args.in[11]; F.w_ab = args.in[12]; F.w_pb = args.in[13]; F.w_out = args.in[14]; F.w_pq = args.in[15];
    F.peer_keys = args.in[16]; F.peer_u = args.in[17]; F.peer_v = args.in[18]; F.out = args.out;
    LAS unsigned char* ldsl = (LAS unsigned char*)lds;
    volatile LAS unsigned* misc = (volatile LAS unsigned*)(ldsl + MISC_OFF);
    if (F.tid < 4) misc[F.tid] = 0u;
    __syncthreads();
    unsigned* barw = (unsigned*)(args.ws + WS_CTL) + (size_t)args.li * XCD_BAR_WORDS;
    XcdBarrier bar; bar.bar = barw; bar.x = 0; bar.st = misc;
    const int lo = args.ph_lo, hi = args.ph_hi;
    if (hi - lo > 1) bar = xcd_barrier_post(barw, misc);
#define IN(k) (lo <= (k) && (k) < hi)
#define SEAM(k) do { if (IN(k) && IN((k) + 1)) xcd_barrier(bar); } while (0)
    bf16_t* R0 = (bf16_t*)(F.ws + WS_R0);

#define PH2_BODY { \
        pg8::Gemm g{R0, (const bf16_t*)(F.ws + WS_WIN), MTOK, INWP, DM, DM, 0, nullptr, nullptr, 0, 0}; pg8::StaticOrder S; S.init(MTOK, INWP, F.G, F.bid); \
        EpiInproj E{(bf16_t*)(F.ws + WS_QN), (bf16_t*)(F.ws + WS_KN), (bf16_t*)(F.ws + WS_V), (bf16_t*)(F.ws + WS_IQ), (bf16_t*)(F.ws + WS_IK), (bf16_t*)(F.ws + WS_PL), \
                    (bf16_t*)(F.ws + WS_GA), (bf16_t*)(F.ws + WS_GP), (float*)(F.ws + WS_IW)}; \
        pg8::gemm_phase<EpiInproj>(ldsl, g, S, E); }
#define PH3_BODY { phase3_pooled(F); phase3_indexer(F); __syncthreads(); }
#define PH4_BODY { \
        phase4_attention(F); \
        __syncthreads(); \
        pg8::Gemm g{(const bf16_t*)(F.ws + WS_POOLED), (const bf16_t*)(F.ws + WS_POOLW), MTOK, PW, 256, 1024, 256, nullptr, nullptr, 0, 0}; pg8::StaticOrder S; S.init(MTOK, PW, F.G, F.bid); \
        EpiBf16Scale E{(bf16_t*)(F.ws + WS_POOL2), 1024, F.pool_scale}; \
        pg8::gemm_phase<EpiBf16Scale>(ldsl, g, S, E); }
#define PH5_BODY { \
        pg8::Gemm g{(const bf16_t*)(F.ws + WS_ATTN), (const bf16_t*)(F.ws + WS_WAB), MTOK, DM, 2048, 1024, 0, (const bf16_t*)(F.ws + WS_POOL2), (const bf16_t*)(F.ws + WS_WPB), 16, 1024}; \
        pg8::StaticOrder S; S.init(MTOK, DM, F.G, F.bid); \
        EpiMerge E{R0, (const bf16_t*)(F.ws + WS_GA), (const bf16_t*)(F.ws + WS_GP)}; pg8::gemm_phase<EpiMerge>(ldsl, g, S, E); }
#define PH6_BODY { \
        pg8::Gemm g{R0, (const bf16_t*)(F.ws + WS_WOUT), MTOK, DM, DM, DM, 0, nullptr, nullptr, 0, 0}; pg8::StaticOrder S; S.init(MTOK, DM, F.G, F.bid); \
        EpiResid E{F.x, F.out, (const float*)(F.ws + WS_MODF) + 4096}; pg8::gemm_phase<EpiResid>(ldsl, g, S, E); }
#define PH8_BODY { \
        pg8::Gemm g{(const bf16_t*)(F.ws + WS_H2), (const bf16_t*)(F.ws + WS_WPQ), MTOK, DM, DM, DM, 0, nullptr, nullptr, 0, 0}; pg8::StaticOrder S; S.init(MTOK, DM, F.G, F.bid); \
        EpiBf16Scale E{R0, 2048, nullptr}; pg8::gemm_phase<EpiBf16Scale>(ldsl, g, S, E); }
#define PH9_BODY { \
        pg8::Gemm g{R0, (const bf16_t*)(F.ws + WS_KEYSBD), MTOK, DM, 256, DM, 256, nullptr, nullptr, 0, 0}; pg8::StaticOrder S; S.init(MTOK, DM, F.G, F.bid); \
        EpiBf16Scale E{(bf16_t*)(F.ws + WS_SUB), 2048, nullptr}; pg8::gemm_phase<EpiBf16Scale>(ldsl, g, S, E); }
#define REP(k) if constexpr (((PROBE_REP) >> (k)) & 1)

    if (IN(0)) { phase0_prep(F); REP(0) { __syncthreads(); phase0_prep(F); } }
    SEAM(0);
    if (IN(1)) { phase_modnorm<true>(F, F.x, F.g1, 0, 2048, R0); REP(1) { phase_modnorm<true>(F, F.x, F.g1, 0, 2048, R0); } }
    SEAM(1);
    if (IN(2)) { PH2_BODY REP(2) PH2_BODY }
    SEAM(2);
    if (IN(3)) { phase3_qknorm(F); PH3_BODY REP(3) PH3_BODY }
    SEAM(3);
    if (IN(4)) { PH4_BODY REP(4) PH4_BODY }
    SEAM(4);
    if (IN(5)) { PH5_BODY REP(5) PH5_BODY }
    SEAM(5);
    if (IN(6)) { PH6_BODY REP(6) PH6_BODY }
    SEAM(6);
    if (IN(7)) { phase_modnorm<false>(F, F.out, F.g2, 6144, 8192, (bf16_t*)(F.ws + WS_H2)); REP(7) { phase_modnorm<false>(F, F.out, F.g2, 6144, 8192, (bf16_t*)(F.ws + WS_H2)); } }
    SEAM(7);
    if (IN(8)) { PH8_BODY REP(8) PH8_BODY }
    SEAM(8);
    if (IN(9)) { PH9_BODY REP(9) PH9_BODY }
    SEAM(9);
    if (IN(10)) { phase10_peer(F); REP(10) phase10_peer(F); }
    SEAM(10);
    if (IN(11)) { REP(11) { phase11_peer_v(F, (float*)(F.ws + WS_SUB)); } phase11_peer_v(F, F.out); }
#undef IN
#undef SEAM
}

extern "C" void kernel_launch(void* const* d_in, const int* in_sizes, int n_in, void* d_out, int out_size, void* d_ws, size_t ws_size, hipStream_t stream) {
    static int grid = 0;
    if (grid == 0) {
        if (n_in != 19 || out_size != MTOK * DM || ws_size < WS_END) { fprintf(stderr, "kernel_launch: unexpected shapes (n_in %d out %d ws %zu)\n", n_in, out_size, ws_size); grid = -1; return; }
        int dev = 0, cus = 0, per_cu = 0;
        if (hipGetDevice(&dev) != hipSuccess || hipDeviceGetAttribute(&cus, hipDeviceAttributeMultiprocessorCount, dev) != hipSuccess) { grid = -1; return; }
        if (hipFuncSetAttribute((const void*)fwd_kernel, hipFuncAttributeMaxDynamicSharedMemorySize, LDS_BYTES) != hipSuccess) { fprintf(stderr, "kernel_launch: hipFuncSetAttribute failed\n"); grid = -1; return; }
        if (hipOccupancyMaxActiveBlocksPerMultiprocessor(&per_cu, (const void*)fwd_kernel, 512, LDS_BYTES) != hipSuccess || per_cu < 1) { fprintf(stderr, "kernel_launch: occupancy query says %d\n", per_cu); }
        (void)hipGetLastError();
        grid = cus;
    }
    if (grid < 0) return;
    (void)in_sizes;
    if (hipMemsetAsync((char*)d_ws + WS_CTL, 0, CTL_ZERO_BYTES, stream) != hipSuccess) return;
    Args a{};
    for (int i = 0; i < 19; ++i) a.in[i] = (const float*)d_in[i];
    a.out = (float*)d_out; a.ws = (unsigned char*)d_ws;
#if MK_PER_PHASE
    for (int p = 0; p < NPHASE; ++p) { a.ph_lo = p; a.ph_hi = p + 1; a.li = p; hipLaunchKernelGGL(fwd_kernel, dim3(grid), dim3(512), LDS_BYTES, stream, a); }
#else
    a.ph_lo = 0; a.ph_hi = NPHASE; a.li = 0;
    hipLaunchKernelGGL(fwd_kernel, dim3(grid), dim3(512), LDS_BYTES, stream, a);
#endif
}
```

```cpp
#include <hip/hip_runtime.h>
#include <cstdio>
#include <cstdint>

#ifndef MK_PER_PHASE
#define MK_PER_PHASE 0
#endif

#ifndef PROBE_REP
#define PROBE_REP 0
#endif
#ifndef PROBE_IDX
#define PROBE_IDX 0
#endif
#ifndef PROBE_SEL
#define PROBE_SEL 0
#endif
#ifndef PROBE_P11X
#define PROBE_P11X 0
#endif
#define LAS __attribute__((address_space(3)))
typedef unsigned short bf16_t;
typedef short bf16x8 __attribute__((ext_vector_type(8)));
typedef float f32x4 __attribute__((ext_vector_type(4)));
typedef float f32x2 __attribute__((ext_vector_type(2)));
typedef unsigned u32x4 __attribute__((ext_vector_type(4)));
typedef unsigned u32x2 __attribute__((ext_vector_type(2)));

constexpr int BATCH = 8, SEQ = 4096, DM = 2048, MTOK = BATCH * SEQ;
constexpr int NHEAD = 8, HDIM = 128, AW = 1024, KVW = 256, IHEADS = 16, IDIM = 64, KSEL = 256;
constexpr int PW = 1024, PHEADS = 8, NEXP = 16384;
constexpr int INW = 7760, INWP = 7936;
constexpr float EPS = 1e-6f;
constexpr int NPHASE = 12;

constexpr size_t MiB = 1u << 20;
constexpr size_t WS_CTL = 0, CTL_ZERO_BYTES = 256 * 1024;
constexpr size_t WS_MODP = 2 * MiB;
constexpr size_t WS_MODF = 4 * MiB;
constexpr size_t WS_POOLW = 5 * MiB;
constexpr size_t WS_KEYSBD = 6 * MiB;
constexpr size_t WS_WIN = 8 * MiB;
constexpr size_t WS_WAB = 40 * MiB, WS_WPB = 44 * MiB, WS_WOUT = 48 * MiB, WS_WPQ = 56 * MiB;
constexpr size_t WS_PU = 64 * MiB, WS_PV = 128 * MiB;
constexpr size_t WS_R0 = 192 * MiB;
constexpr size_t WS_GA = 320 * MiB, WS_GP = 448 * MiB;
constexpr size_t WS_SUB = 320 * MiB;
constexpr size_t WS_QN = 576 * MiB;
constexpr size_t WS_IQ = 640 * MiB;
constexpr size_t WS_PL = 704 * MiB;
constexpr size_t WS_KN = 768 * MiB, WS_V = 784 * MiB;
constexpr size_t WS_IK = 800 * MiB;
constexpr size_t WS_IW = 804 * MiB;
constexpr size_t WS_SEL = 806 * MiB;
constexpr size_t WS_POOLED = 822 * MiB;
constexpr size_t WS_H2 = 886 * MiB;
constexpr size_t WS_END = 1014 * MiB;
constexpr size_t WS_Q8 = WS_H2, WS_K8 = WS_H2 + 32 * MiB, WS_V8 = WS_H2 + 40 * MiB;
constexpr size_t WS_ATTN = WS_IQ, WS_POOL2 = WS_PL, WS_PAIRS = WS_QN, WS_WLS = WS_QN + 32 * MiB;

constexpr int LDS_BYTES = 160 * 1024;
constexpr int MISC_OFF = 159 * 1024;

__device__ __forceinline__ unsigned cvt_pk_bf16(float lo, float hi) { unsigned r; asm volatile("v_cvt_pk_bf16_f32 %0, %1, %2" : "=v"(r) : "v"(lo), "v"(hi)); return r; }
__device__ __forceinline__ float bf_lo(unsigned w) { return __uint_as_float(w << 16); }
__device__ __forceinline__ float bf_hi(unsigned w) { return __uint_as_float(w & 0xffff0000u); }
template <int CTRL> __device__ __forceinline__ float dpp_f(float x) { return __int_as_float(__builtin_amdgcn_update_dpp(0, __float_as_int(x), CTRL, 0xF, 0xF, true)); }
#define DPP_XOR1 0xB1
#define DPP_XOR2 0x4E
#define DPP_HMIRROR 0x141
#define DPP_MIRROR 0x140
#define DPP_ROR8 0x128
__device__ __forceinline__ float xor16_sum(float x) { const auto r = __builtin_amdgcn_permlane16_swap(__float_as_uint(x), __float_as_uint(x), false, false); return __uint_as_float(r[0]) + __uint_as_float(r[1]); }
__device__ __forceinline__ float xor32_sum(float x) { const auto r = __builtin_amdgcn_permlane32_swap(__float_as_uint(x), __float_as_uint(x), false, false); return __uint_as_float(r[0]) + __uint_as_float(r[1]); }
__device__ __forceinline__ float xor16_max(float x) { const auto r = __builtin_amdgcn_permlane16_swap(__float_as_uint(x), __float_as_uint(x), false, false); return fmaxf(__uint_as_float(r[0]), __uint_as_float(r[1])); }
__device__ __forceinline__ float swap32_pair(float a, float b) { const auto r = __builtin_amdgcn_permlane32_swap(__float_as_uint(a), __float_as_uint(b), false, false); return __uint_as_float(r[0]) + __uint_as_float(r[1]); }
__device__ __forceinline__ float swap16_pair(float a, float b) { const auto r = __builtin_amdgcn_permlane16_swap(__float_as_uint(a), __float_as_uint(b), false, false); return __uint_as_float(r[0]) + __uint_as_float(r[1]); }
__device__ __forceinline__ float row_sum16(float v) { v += dpp_f<DPP_XOR1>(v); v += dpp_f<DPP_XOR2>(v); v += dpp_f<DPP_HMIRROR>(v); v += dpp_f<DPP_MIRROR>(v); return v; }
__device__ __forceinline__ float row_max16(float v) { v = fmaxf(v, dpp_f<DPP_XOR1>(v)); v = fmaxf(v, dpp_f<DPP_XOR2>(v)); v = fmaxf(v, dpp_f<DPP_HMIRROR>(v)); v = fmaxf(v, dpp_f<DPP_MIRROR>(v)); return v; }
__device__ __forceinline__ float wave_sum(float v) { return xor32_sum(xor16_sum(row_sum16(v))); }
__device__ __forceinline__ float sigmoidf_(float x) { return __builtin_amdgcn_rcpf(1.0f + __expf(-x)); }
__device__ __forceinline__ float dot8(u32x4 w, const float* h) {
    return bf_lo(w.x) * h[0] + bf_hi(w.x) * h[1] + bf_lo(w.y) * h[2] + bf_hi(w.y) * h[3] + bf_lo(w.z) * h[4] + bf_hi(w.z) * h[5] + bf_lo(w.w) * h[6] + bf_hi(w.w) * h[7];
}

#define XB_TMO      128
#define XB_XCNT(j)  (256  + 64 * (j))
#define XB_XSUB(j)  (1280 + 64 * (j))
#define XB_XGEN(j)  (2304 + 64 * (j))
#define XB_TOP      3328
#define XB_TOPGEN   3392
#define XCD_BAR_WORDS 3456
#define XB_SPIN_CAP (1u << 18)

__device__ __forceinline__ unsigned xb_ld(unsigned* p)              { return __hip_atomic_load(p, __ATOMIC_RELAXED, __HIP_MEMORY_SCOPE_AGENT); }
__device__ __forceinline__ unsigned xb_add(unsigned* p, unsigned v) { return __hip_atomic_fetch_add(p, v, __ATOMIC_RELAXED, __HIP_MEMORY_SCOPE_AGENT); }
__device__ __forceinline__ unsigned xb_xcc_id() { return (unsigned)__builtin_amdgcn_s_getreg((3 << 11) | 20) & 0xFu; }
#define XB_SPIN(cond, bar) do { unsigned _sp = 0; while (cond) { __builtin_amdgcn_s_sleep(1); \
    if ((++_sp & 255u) == 0u) { if (xb_ld(&(bar)[XB_TMO])) break; if (_sp > XB_SPIN_CAP) { atomicAdd(&(bar)[XB_TMO], 1u); break; } } } } while (0)

struct XcdBarrier { unsigned* bar; unsigned x; volatile LAS unsigned* st; };

__device__ __forceinline__ XcdBarrier xcd_barrier_post(unsigned* bar, volatile LAS unsigned* st) {
    XcdBarrier b; b.bar = bar; b.x = xb_xcc_id(); b.st = st;
    if (threadIdx.x == 0) (void)xb_add(&bar[XB_XCNT(b.x)], 1u);
    return b;
}
__device__ __forceinline__ void xcd_barrier_complete(unsigned* bar, unsigned x, unsigned& nloc, unsigned& nx) {
    const unsigned G = gridDim.x * gridDim.y * gridDim.z;
    unsigned sum, cnt, mine, sp = 0u;
    for (;;) {
        sum = 0u; cnt = 0u; mine = 0u;
#pragma unroll
        for (unsigned j = 0; j < 16; ++j) { const unsigned c = xb_ld(&bar[XB_XCNT(j)]); sum += c; cnt += (c > 0u) ? 1u : 0u; mine = (j == x) ? c : mine; }
        if (sum == G) break;
        __builtin_amdgcn_s_sleep(1);
        if ((++sp & 255u) == 0u) { if (xb_ld(&bar[XB_TMO])) break; if (sp > XB_SPIN_CAP) { atomicAdd(&bar[XB_TMO], 1u); break; } }
    }
    nloc = mine > 0u ? mine : 1u; nx = cnt > 0u ? cnt : 1u;
}
__device__ __forceinline__ void xcd_barrier(const XcdBarrier& b) {
    asm volatile("s_waitcnt vmcnt(0)" ::: "memory");
    __syncthreads();
    if (threadIdx.x == 0) {
        unsigned* bar = b.bar;
        __builtin_amdgcn_s_waitcnt(0);
        unsigned nloc = b.st[0], nx = b.st[1];
        if (nloc == 0u) { xcd_barrier_complete(bar, b.x, nloc, nx); b.st[0] = nloc; b.st[1] = nx; }
        const unsigned old = xb_add(&bar[XB_XSUB(b.x)], 1u);
        const unsigned gen = old / nloc;
        if (old + 1u == (gen + 1u) * nloc) {
            __builtin_amdgcn_fence(__ATOMIC_RELEASE, "agent");
            asm volatile("s_waitcnt vmcnt(0)" ::: "memory");
            const unsigned og = xb_add(&bar[XB_TOP], 1u);
            const unsigned tg = og / nx;
            if (og + 1u == (tg + 1u) * nx) xb_add(&bar[XB_TOPGEN], 1u);
            else XB_SPIN(xb_ld(&bar[XB_TOPGEN]) == tg, bar);
            __builtin_amdgcn_fence(__ATOMIC_ACQUIRE, "agent");
            xb_add(&bar[XB_XGEN(b.x)], 1u);
            asm volatile("s_waitcnt vmcnt(0)" ::: "memory");
        } else {
            XB_SPIN(xb_ld(&bar[XB_XGEN(b.x)]) == gen, bar);
            __builtin_amdgcn_fence(__ATOMIC_ACQUIRE, "agent");
            asm volatile("s_waitcnt vmcnt(0)" ::: "memory");
        }
    }
    __syncthreads();
}

namespace pg8 {
constexpr int BM = 256, BK = 64, HALF = 128, HTB = HALF * BK * 2, STAGE_BYTES = 8 * HTB, NXCD = 8, WGM = 8;
__device__ __forceinline__ int lds_byte(int r, int c) { const int st = (r >> 4) * 2 + (c >> 5), rr = r & 15, cc = c & 31, ob = rr * 64 + cc * 2; return st * 1024 + (ob ^ (((ob >> 9) & 1) << 5)); }
__device__ __forceinline__ void stage_rc(int b, int& R, int& C) { const int st = b / 1024, sb = b % 1024, swz = sb ^ (((sb >> 9) & 1) << 5); R = (st >> 1) * 16 + swz / 64; C = (st & 1) * 32 + (swz % 64) / 2; }
__device__ __forceinline__ int perm32(int rho) { const int n = rho >> 4, i = rho & 15; return 8 * (i >> 2) + 4 * n + (i & 3); }

struct Unit { int pm, pn; };
struct Gemm { const bf16_t* A; const bf16_t* Bt; int M, N, K, lda, a_pn_off; const bf16_t* A2; const bf16_t* Bt2; int ksplit, ldb; };

struct StaticOrder {
    int nM, nN, nwg, G, c;
    __device__ void init(int M, int N, int G_, int c_) { nM = M / BM; nN = N / BM; nwg = nM * nN; G = G_; c = c_; }
    __device__ bool next(int i, Unit& u) const {
        const long L = (long)i * G + c; if (L >= nwg) return false;
        int wgid = (int)L; { const int q = nwg / NXCD, r = nwg % NXCD, xcd = wgid % NXCD, off = wgid / NXCD; wgid = (xcd < r ? xcd * (q + 1) : r * (q + 1) + (xcd - r) * q) + off; }
        const int nig = WGM * nN, gid = wgid / nig, fm = gid * WGM, gsz = (nM - fm) < WGM ? (nM - fm) : WGM;
        u.pm = fm + ((wgid % nig) % gsz); u.pn = (wgid % nig) / gsz; return true;
    }
};

template <class Epi>
__device__ __forceinline__ void gemm_phase(LAS unsigned char* lds, const Gemm g, const StaticOrder& S, const Epi& E) {
    const int tid = threadIdx.x, wid = __builtin_amdgcn_readfirstlane(tid >> 6), lane = tid & 63, wr = wid >> 2, wc = wid & 3, fr = lane & 15, fq = lane >> 4;
    const int K = g.K, nt = K / BK, lda = g.lda, ldb = g.ldb ? g.ldb : g.K, ksplit = g.ksplit;
    unsigned voffA[2], voffB[2];
#pragma unroll
    for (int i = 0; i < 2; ++i) { int R, C; stage_rc(tid * 16 + i * 8192, R, C); const int Rb = Epi::PERM ? ((R & ~31) + perm32(R & 31)) : R;
        voffA[i] = (unsigned)(R * lda + C) * 2u; voffB[i] = (unsigned)(Rb * ldb + C) * 2u; }
    const size_t kstep = (size_t)(BK * 2);
    const size_t hsA = (size_t)HALF * lda * 2, hsB = (size_t)HALF * ldb * 2;
    const size_t tsA = 2 * hsA, tsB = 2 * hsB;
    const unsigned ldsw = (unsigned)wid * 1024u;
    const int aoff = lds_byte(wr * 64 + fr, fq * 8), boff = lds_byte(wc * 32 + fr, fq * 8);
#define PG8_SA(b, h) (((b) * 2 + (h)) * HTB)
#define PG8_SB(b, h) ((4 + (b) * 2 + (h)) * HTB)
#define PG8_STAGE(bufoff, gbase, voff) do { _Pragma("unroll") for (int _i = 0; _i < 2; ++_i) \
        __builtin_amdgcn_global_load_lds((const unsigned*)((const char*)(gbase) + (voff)[_i]), (LAS unsigned*)(lds + (bufoff) + ldsw + _i * 8192), 16, 0, 0); } while (0)
#define PG8_LDA(dst, b, h) do { _Pragma("unroll") for (int m = 0; m < 4; ++m) _Pragma("unroll") for (int k = 0; k < 2; ++k) dst[m][k] = *(const LAS bf16x8*)(lds + PG8_SA(b, h) + aoff + m * 2048 + k * 1024); } while (0)
#define PG8_LDB(dst, b, h) do { _Pragma("unroll") for (int n = 0; n < 2; ++n) _Pragma("unroll") for (int k = 0; k < 2; ++k) dst[n][k] = *(const LAS bf16x8*)(lds + PG8_SB(b, h) + boff + n * 2048 + k * 1024); } while (0)
#define PG8_MMA(ai, bj, At, Bt) do { __builtin_amdgcn_s_setprio(1); _Pragma("unroll") for (int m = 0; m < 4; ++m) _Pragma("unroll") for (int n = 0; n < 2; ++n) _Pragma("unroll") for (int k = 0; k < 2; ++k) \
        acc[ai][bj][m][n] = __builtin_amdgcn_mfma_f32_16x16x32_bf16(Bt[n][k], At[m][k], acc[ai][bj][m][n], 0, 0, 0); __builtin_amdgcn_s_setprio(0); } while (0)
#define PG8_WAIT_V(n) asm volatile("s_waitcnt vmcnt(" #n ")" ::: "memory")
#define PG8_WAIT_L(n) asm volatile("s_waitcnt lgkmcnt(" #n ")" ::: "memory")
#define PG8_BAR __builtin_amdgcn_s_barrier()
#define PG8_SCHED __builtin_amdgcn_sched_barrier(0)
    Unit cur, nxt; int ui = 0;
    if (!S.next(0, cur)) return;
    f32x4 acc[2][2][4][2];
#pragma unroll
    for (int a = 0; a < 2; ++a)
#pragma unroll
        for (int b = 0; b < 2; ++b)
#pragma unroll
            for (int m = 0; m < 4; ++m)
#pragma unroll
                for (int n = 0; n < 2; ++n) acc[a][b][m][n] = (f32x4){0.f, 0.f, 0.f, 0.f};
    bf16x8 At[4][2], B0[2][2], B1[2][2];
    const char* cA = (const char*)g.A + (size_t)cur.pm * tsA + (size_t)cur.pn * g.a_pn_off * 2; const char* cB = (const char*)g.Bt + (size_t)cur.pn * tsB;
    PG8_STAGE(PG8_SB(0, 0), cB, voffB); PG8_STAGE(PG8_SB(0, 1), cB + hsB, voffB); PG8_STAGE(PG8_SA(0, 0), cA, voffA); PG8_STAGE(PG8_SA(0, 1), cA + hsA, voffA);
    if (wr == 1) PG8_BAR;
    PG8_WAIT_V(2); PG8_BAR;
    PG8_STAGE(PG8_SB(1, 0), cB + kstep, voffB); PG8_STAGE(PG8_SA(1, 0), cA + kstep, voffA); PG8_STAGE(PG8_SB(1, 1), cB + hsB + kstep, voffB);
    PG8_WAIT_V(6); PG8_BAR;
    for (;;) {
        const bool has_next = S.next(ui + 1, nxt);
        const char* nA = has_next ? (const char*)g.A + (size_t)nxt.pm * tsA + (size_t)nxt.pn * g.a_pn_off * 2 : cA; const char* nB = has_next ? (const char*)g.Bt + (size_t)nxt.pn * tsB : cB;
        const char* cA2 = (const char*)g.A2 + (size_t)cur.pm * tsA; const char* cB2 = (const char*)g.Bt2 + (size_t)cur.pn * tsB;
        for (int t = 0; t < nt; t += 2) {
            const bool last = (t == nt - 2);
            const bool s1 = ksplit && (t >= ksplit), s2 = ksplit && (t + 2 >= ksplit);
            const char* a1 = (s1 ? cA2 + (size_t)(t - ksplit + 1) * kstep : cA + (size_t)(t + 1) * kstep);
            const char* a2 = last ? nA : (s2 ? cA2 + (size_t)(t + 2 - ksplit) * kstep : cA + (size_t)(t + 2) * kstep);
            const char* b2 = last ? nB : (s2 ? cB2 + (size_t)(t + 2 - ksplit) * kstep : cB + (size_t)(t + 2) * kstep);
            const char* a3 = a2 + kstep; const char* b3 = b2 + kstep;
            PG8_LDB(B0, 0, 0); PG8_LDB(B1, 0, 1); PG8_SCHED; PG8_LDA(At, 0, 0); PG8_STAGE(PG8_SA(1, 1), a1 + hsA, voffA);
            PG8_WAIT_V(8); PG8_WAIT_L(0); PG8_BAR; PG8_MMA(0, 0, At, B0); PG8_MMA(0, 1, At, B1); PG8_BAR; PG8_SCHED;
            PG8_LDA(At, 0, 1); PG8_STAGE(PG8_SB(0, 0), b2, voffB); PG8_STAGE(PG8_SB(0, 1), b2 + hsB, voffB); PG8_STAGE(PG8_SA(0, 0), a2, voffA);
            PG8_WAIT_V(8); PG8_WAIT_L(0); PG8_BAR; PG8_MMA(1, 0, At, B0); PG8_MMA(1, 1, At, B1); PG8_BAR; PG8_SCHED;
            PG8_LDB(B0, 1, 0); PG8_LDB(B1, 1, 1); PG8_SCHED; PG8_LDA(At, 1, 0); PG8_STAGE(PG8_SA(0, 1), a2 + hsA, voffA);
            PG8_WAIT_V(8); PG8_WAIT_L(0); PG8_BAR; PG8_MMA(0, 0, At, B0); PG8_MMA(0, 1, At, B1); PG8_BAR; PG8_SCHED;
            PG8_LDA(At, 1, 1); PG8_STAGE(PG8_SB(1, 0), b3, voffB); PG8_STAGE(PG8_SB(1, 1), b3 + hsB, voffB); PG8_STAGE(PG8_SA(1, 0), a3, voffA);
            PG8_WAIT_V(8); PG8_WAIT_L(0); PG8_BAR; PG8_MMA(1, 0, At, B0); PG8_MMA(1, 1, At, B1); PG8_BAR; PG8_SCHED;
            if constexpr (Epi::MID) { if (t + 2 == ksplit) E.mid(acc, cur, wr, wc, fr, fq); }
        }
        if (wr == 0) PG8_BAR;
        E(acc, cur, wr, wc, fr, fq);
        if (!has_next) break;
#pragma unroll
        for (int a = 0; a < 2; ++a)
#pragma unroll
            for (int b = 0; b < 2; ++b)
#pragma unroll
                for (int m = 0; m < 4; ++m)
#pragma unroll
                    for (int n = 0; n < 2; ++n) acc[a][b][m][n] = (f32x4){0.f, 0.f, 0.f, 0.f};
        cur = nxt; cA = nA; cB = nB; ++ui;
        if (wr == 1) PG8_BAR;
    }
    PG8_WAIT_V(0);
    PG8_BAR;
#undef PG8_SA
#undef PG8_SB
#undef PG8_STAGE
#undef PG8_LDA
#undef PG8_LDB
#undef PG8_MMA
#undef PG8_WAIT_V
#undef PG8_WAIT_L
#undef PG8_BAR
#undef PG8_SCHED
}
}
using pg8::Unit;

typedef f32x4 AccT[2][2][4][2];
__device__ __forceinline__ u32x4 pack8(f32x4 a, f32x4 b) { u32x4 w; w.x = cvt_pk_bf16(a[0], a[1]); w.y = cvt_pk_bf16(a[2], a[3]); w.z = cvt_pk_bf16(b[0], b[1]); w.w = cvt_pk_bf16(b[2], b[3]); return w; }
__device__ __forceinline__ void unpack8(u32x4 w, f32x4& a, f32x4& b) { a = (f32x4){bf_lo(w.x), bf_hi(w.x), bf_lo(w.y), bf_hi(w.y)}; b = (f32x4){bf_lo(w.z), bf_hi(w.z), bf_lo(w.w), bf_hi(w.w)}; }

struct EpiInproj {
    static constexpr bool PERM = true, MID = false;
    bf16_t *q, *k, *v, *iq, *ik, *pl, *ga, *gp; float* iw;
    __device__ __forceinline__ void operator()(const AccT& acc, const Unit& u, int wr, int wc, int fr, int fq) const {
        const int pn = u.pn, row0 = u.pm * 256 + wr * 64 + fr;
        if (pn == 10) {
            if (wc < 2) {
#pragma unroll
                for (int ai = 0; ai < 2; ++ai)
#pragma unroll
                    for (int m = 0; m < 4; ++m) { const size_t row = (size_t)(row0 + ai * 128 + m * 16);
                        *(u32x4*)(ik + row * 64 + wc * 32 + 8 * fq) = pack8(acc[ai][0][m][0], acc[ai][0][m][1]); }
            } else if (wc == 2) {
                if (fq < 2) {
#pragma unroll
                    for (int ai = 0; ai < 2; ++ai)
#pragma unroll
                        for (int m = 0; m < 4; ++m) { const size_t row = (size_t)(row0 + ai * 128 + m * 16);
                            *(f32x4*)(iw + row * 16 + 8 * fq) = acc[ai][0][m][0]; *(f32x4*)(iw + row * 16 + 8 * fq + 4) = acc[ai][0][m][1]; }
                }
            }
            return;
        }
        bf16_t* dst; int ld, tc; bool sg = false;
        if (pn < 4) { dst = q; ld = 1024; tc = pn * 256; }
        else if (pn == 4) { dst = k; ld = 256; tc = 0; }
        else if (pn == 5) { dst = v; ld = 256; tc = 0; }
        else if (pn < 10) { dst = iq; ld = 1024; tc = (pn - 6) * 256; }
        else if (pn < 15) { dst = pl; ld = 1024; tc = (pn - 11) * 256; }
        else if (pn < 23) { dst = ga; ld = 2048; tc = (pn - 15) * 256; sg = true; }
        else { dst = gp; ld = 2048; tc = (pn - 23) * 256; sg = true; }
        const int col0 = tc + wc * 32 + 8 * fq;
#pragma unroll
        for (int ai = 0; ai < 2; ++ai)
#pragma unroll
            for (int m = 0; m < 4; ++m) { bf16_t* rowp = dst + (size_t)(row0 + ai * 128 + m * 16) * ld + col0;
#pragma unroll
                for (int bj = 0; bj < 2; ++bj) { f32x4 v0 = acc[ai][bj][m][0], v1 = acc[ai][bj][m][1];
                    if (sg) {
#pragma unroll
                        for (int j = 0; j < 4; ++j) { v0[j] = sigmoidf_(v0[j]); v1[j] = sigmoidf_(v1[j]); } }
                    *(u32x4*)(rowp + bj * 128) = pack8(v0, v1); } }
    }
};
struct EpiBf16Scale {
    static constexpr bool PERM = true, MID = false;
    bf16_t* O; int ldc; const float* cs;
    __device__ __forceinline__ void operator()(const AccT& acc, const Unit& u, int wr, int wc, int fr, int fq) const {
        const int row0 = u.pm * 256 + wr * 64 + fr, col0 = u.pn * 256 + wc * 32 + 8 * fq;
        f32x4 s[2][2];
#pragma unroll
        for (int bj = 0; bj < 2; ++bj)
#pragma unroll
            for (int n = 0; n < 2; ++n) s[bj][n] = cs ? *(const f32x4*)(cs + col0 + bj * 128 + 4 * n) : (f32x4){1.f, 1.f, 1.f, 1.f};
#pragma unroll
        for (int ai = 0; ai < 2; ++ai)
#pragma unroll
            for (int m = 0; m < 4; ++m) { bf16_t* rowp = O + (size_t)(row0 + ai * 128 + m * 16) * ldc + col0;
#pragma unroll
                for (int bj = 0; bj < 2; ++bj) *(u32x4*)(rowp + bj * 128) = pack8(acc[ai][bj][m][0] * s[bj][0], acc[ai][bj][m][1] * s[bj][1]); }
    }
};
template <bool ADD> struct EpiGate {
    static constexpr bool PERM = true, MID = false;
    bf16_t* O; const bf16_t* gate;
    __device__ __forceinline__ void operator()(const AccT& acc, const Unit& u, int wr, int wc, int fr, int fq) const {
        const int row0 = u.pm * 256 + wr * 64 + fr, col0 = u.pn * 256 + wc * 32 + 8 * fq;
#pragma unroll
        for (int ai = 0; ai < 2; ++ai)
#pragma unroll
            for (int m = 0; m < 4; ++m) { const size_t off = (size_t)(row0 + ai * 128 + m * 16) * 2048 + col0;
#pragma unroll
                for (int bj = 0; bj < 2; ++bj) { f32x4 g0, g1; unpack8(*(const u32x4*)(gate + off + bj * 128), g0, g1);
                    f32x4 r0 = g0 * acc[ai][bj][m][0], r1 = g1 * acc[ai][bj][m][1];
                    if (ADD) { f32x4 o0, o1; unpack8(*(const u32x4*)(O + off + bj * 128), o0, o1); r0 += o0; r1 += o1; }
                    *(u32x4*)(O + off + bj * 128) = pack8(r0, r1); } }
    }
};
struct EpiMerge {
    static constexpr bool PERM = true, MID = true;
    bf16_t* O; const bf16_t* ga; const bf16_t* gp;
    __device__ __forceinline__ void mid(AccT& acc, const Unit& u, int wr, int wc, int fr, int fq) const {
        const auto ra = __builtin_amdgcn_make_buffer_rsrc((void*)ga, 0, 0x7FFFFFFF, 0x00020000), rp = __builtin_amdgcn_make_buffer_rsrc((void*)gp, 0, 0x7FFFFFFF, 0x00020000);
        const int voff = ((wr * 64 + fr) * 2048 + wc * 32 + 8 * fq) * 2;
        const int sbase = (u.pm * 256 * 2048 + u.pn * 256) * 2;
#pragma unroll
        for (int ai = 0; ai < 2; ++ai)
#pragma unroll
            for (int m = 0; m < 4; ++m)
#pragma unroll
                for (int bj = 0; bj < 2; ++bj) { const int so = sbase + ((ai * 128 + m * 16) * 2048 + bj * 128) * 2;
                    const u32x4 wa = __builtin_bit_cast(u32x4, __builtin_amdgcn_raw_buffer_load_b128(ra, voff, so, 0)), wp = __builtin_bit_cast(u32x4, __builtin_amdgcn_raw_buffer_load_b128(rp, voff, so, 0));
                    f32x4 a0, a1, p0, p1; unpack8(wa, a0, a1); unpack8(wp, p0, p1);
#pragma unroll
                    for (int j = 0; j < 4; ++j) { acc[ai][bj][m][0][j] *= a0[j] * __builtin_amdgcn_rcpf(p0[j]); acc[ai][bj][m][1][j] *= a1[j] * __builtin_amdgcn_rcpf(p1[j]); }
                    asm volatile("" : "+v"(acc[ai][bj][m][0]), "+v"(acc[ai][bj][m][1]) :: "memory"); }
    }
    __device__ __forceinline__ void operator()(const AccT& acc, const Unit& u, int wr, int wc, int fr, int fq) const {
        const int row0 = u.pm * 256 + wr * 64 + fr, col0 = u.pn * 256 + wc * 32 + 8 * fq;
#pragma unroll
        for (int ai = 0; ai < 2; ++ai)
#pragma unroll
            for (int m = 0; m < 4; ++m) { const size_t off = (size_t)(row0 + ai * 128 + m * 16) * 2048 + col0;
#pragma unroll
                for (int bj = 0; bj < 2; ++bj) { f32x4 p0, p1; unpack8(*(const u32x4*)(gp + off + bj * 128), p0, p1);
                    *(u32x4*)(O + off + bj * 128) = pack8(p0 * acc[ai][bj][m][0], p1 * acc[ai][bj][m][1]); } }
    }
};
struct EpiResid {
    static constexpr bool PERM = false, MID = false;
    const float* x; float* out; const float* gt;
    __device__ __forceinline__ void operator()(const AccT& acc, const Unit& u, int wr, int wc, int fr, int fq) const {
        const int row0 = u.pm * 256 + wr * 64 + fr, col0 = u.pn * 256 + wc * 32 + 4 * fq;
        const float* gtb = gt + (size_t)(u.pm / 16) * 12288;
        f32x4 g[2][2];
#pragma unroll
        for (int bj = 0; bj < 2; ++bj)
#pragma unroll
            for (int n = 0; n < 2; ++n) g[bj][n] = *(const f32x4*)(gtb + col0 + bj * 128 + n * 16);
#pragma unroll
        for (int ai = 0; ai < 2; ++ai)
#pragma unroll
            for (int m = 0; m < 4; ++m) { const size_t off = (size_t)(row0 + ai * 128 + m * 16) * 2048 + col0;
#pragma unroll
                for (int bj = 0; bj < 2; ++bj)
#pragma unroll
                    for (int n = 0; n < 2; ++n) { const f32x4 xv = *(const f32x4*)(x + off + bj * 128 + n * 16);
                        *(f32x4*)(out + off + bj * 128 + n * 16) = xv + g[bj][n] * acc[ai][bj][m][n]; } }
    }
};
struct EpiF32 {
    static constexpr bool PERM = false, MID = false;
    float* C; int ldc;
    __device__ __forceinline__ void operator()(const AccT& acc, const Unit& u, int wr, int wc, int fr, int fq) const {
        const int row0 = u.pm * 256 + wr * 64 + fr, col0 = u.pn * 256 + wc * 32 + 4 * fq;
#pragma unroll
        for (int ai = 0; ai < 2; ++ai)
#pragma unroll
            for (int m = 0; m < 4; ++m) { float* rowp = C + (size_t)(row0 + ai * 128 + m * 16) * ldc + col0;
#pragma unroll
                for (int bj = 0; bj < 2; ++bj)
#pragma unroll
                    for (int n = 0; n < 2; ++n) *(f32x4*)(rowp + bj * 128 + n * 16) = acc[ai][bj][m][n]; }
    }
};

struct Args { const float* in[19]; float* out; unsigned char* ws; int ph_lo, ph_hi; int li, pad; };
struct Frame {
    unsigned char* lds; unsigned char* ws;
    int tid, lane, wave, G, bid;
    const float *x, *c, *w_ada, *b_ada, *g1, *g2, *w_in, *g_q, *g_k, *rel_bias, *pool_w, *pool_scale, *w_ab, *w_pb, *w_out, *w_pq, *peer_keys, *peer_u, *peer_v;
    float* out;
};

template <class Fn> __device__ __forceinline__ void transpose_item(const float* W, int K, int N, bf16_t* WT, int ldk, int drow0, int k0, float* scr, int lane, Fn srccol) {
    const int sc = srccol(drow0 + (lane & 31));
#pragma unroll 8
    for (int i = 0; i < 32; ++i) { const int kk = 2 * i + (lane >> 5); scr[kk * 33 + (lane & 31)] = sc >= 0 ? W[(size_t)(k0 + kk) * N + sc] : 0.f; }
    asm volatile("s_waitcnt lgkmcnt(0)" ::: "memory");
    const int c = lane & 7;
#pragma unroll
    for (int j = 0; j < 4; ++j) { const int n = (lane >> 3) + 8 * j; const float* s = scr + (8 * c) * 33 + n;
        u32x4 o; o.x = cvt_pk_bf16(s[0 * 33], s[1 * 33]); o.y = cvt_pk_bf16(s[2 * 33], s[3 * 33]); o.z = cvt_pk_bf16(s[4 * 33], s[5 * 33]); o.w = cvt_pk_bf16(s[6 * 33], s[7 * 33]);
        *(u32x4*)(WT + (size_t)(drow0 + n) * ldk + k0 + 8 * c) = o; }
    asm volatile("s_waitcnt lgkmcnt(0)" ::: "memory");
}
__device__ __forceinline__ void phase0_prep(Frame& F) {
    const int gw = F.bid * 8 + F.wave, NGW = F.G * 8;
    float* scr = (float*)(F.lds + F.wave * 16384);
    constexpr int I_IN = (INWP / 32) * (DM / 64);
    constexpr int I_AB = (2048 / 32) * (1024 / 64), I_OUT = (2048 / 32) * (2048 / 64), I_PW = 4 * 8 * 4;
    constexpr int NIT = I_IN + 2 * I_AB + 2 * I_OUT + I_PW;
    auto ident = [](int j) { return j; };
    for (int it = gw; it < NIT; it += NGW) {
        int r = it;
        if (r < I_IN) { const int nb = r % (INWP / 32), kb = r / (INWP / 32);
            transpose_item(F.w_in, DM, INW, (bf16_t*)(F.ws + WS_WIN), DM, nb * 32, kb * 64, scr, F.lane, [](int j) { return j < 2640 ? j : (j < 2816 ? -1 : j - 176); }); continue; }
        r -= I_IN;
        if (r < I_AB) { transpose_item(F.w_ab, 1024, 2048, (bf16_t*)(F.ws + WS_WAB), 1024, (r % 64) * 32, (r / 64) * 64, scr, F.lane, ident); continue; }
        r -= I_AB;
        if (r < I_AB) { transpose_item(F.w_pb, 1024, 2048, (bf16_t*)(F.ws + WS_WPB), 1024, (r % 64) * 32, (r / 64) * 64, scr, F.lane, ident); continue; }
        r -= I_AB;
        if (r < I_OUT) { transpose_item(F.w_out, 2048, 2048, (bf16_t*)(F.ws + WS_WOUT), 2048, (r % 64) * 32, (r / 64) * 64, scr, F.lane, ident); continue; }
        r -= I_OUT;
        if (r < I_OUT) { transpose_item(F.w_pq, 2048, 2048, (bf16_t*)(F.ws + WS_WPQ), 2048, (r % 64) * 32, (r / 64) * 64, scr, F.lane, ident); continue; }
        r -= I_OUT;
        { const int g = r / 32, q = r % 32, nb = q % 8, kb = q / 8;
          transpose_item(F.pool_w + (size_t)g * 65536, 256, 256, (bf16_t*)(F.ws + WS_POOLW) + (size_t)g * 65536, 256, nb * 32, kb * 64, scr, F.lane, ident); }
    }
    {
        bf16_t* kb = (bf16_t*)(F.ws + WS_KEYSBD);
        for (int i = F.bid * 512 + F.tid; i < 2048 * 32; i += F.G * 512) {
            const int row = i / 32, k8 = (i % 32) * 8, p = (row >> 7) & 1;
            u32x4 o = (u32x4){0u, 0u, 0u, 0u};
            if ((k8 >> 7) == p) { const float* s = F.peer_keys + (size_t)row * 128 + (k8 & 127); const f32x4 a = *(const f32x4*)s, b = *(const f32x4*)(s + 4); o = pack8(a, b); }
            *(u32x4*)(kb + (size_t)row * 256 + k8) = o;
        }
    }
    {
        const size_t n16 = (size_t)NEXP * DM / 16;
        unsigned char* pu = F.ws + WS_PU;
        for (size_t i = (size_t)F.bid * 512 + F.tid; i < n16; i += (size_t)F.G * 512) {
            u32x4 ou;
#pragma unroll
            for (int k = 0; k < 4; ++k) { const f32x4 a = *(const f32x4*)(F.peer_u + i * 16 + k * 4) * 64.0f;
                int wu = __builtin_amdgcn_cvt_pk_fp8_f32(a[0], a[1], 0, false); wu = __builtin_amdgcn_cvt_pk_fp8_f32(a[2], a[3], wu, true); ou[k] = (unsigned)wu; }
            *(u32x4*)(pu + i * 16) = ou;
        }
        unsigned char* pv = F.ws + WS_PV;
        for (int it = gw; it < (NEXP / 64) * 128; it += NGW) {
            const int e = (it >> 7) * 64 + F.lane, ch = it & 127;
            u32x4 ov;
#pragma unroll
            for (int k = 0; k < 4; ++k) { const f32x4 c = *(const f32x4*)(F.peer_v + (size_t)e * DM + ch * 16 + k * 4) * 4.0f;
                int wv = __builtin_amdgcn_cvt_pk_fp8_f32(c[0], c[1], 0, false); wv = __builtin_amdgcn_cvt_pk_fp8_f32(c[2], c[3], wv, true); ov[k] = (unsigned)wv; }
            *(u32x2*)(pv + ((size_t)(2 * ch) * NEXP + e) * 8) = (u32x2){ov[0], ov[1]};
            *(u32x2*)(pv + ((size_t)(2 * ch + 1) * NEXP + e) * 8) = (u32x2){ov[2], ov[3]};
        }
    }
    {
        __syncthreads();
        float* cact = (float*)(F.lds + 131072);
        float* red = (float*)F.lds;
        float* mp = (float*)(F.ws + WS_MODP);
        for (int it = F.bid; it < 48 * 4; it += F.G) {
            const int cb = it % 48, ds = it / 48, d0 = ds * 512;
            for (int i = F.tid; i < 8 * 512; i += 512) { const int b = i >> 9, d = i & 511; const float cv = F.c[b * DM + d0 + d]; cact[i] = cv * sigmoidf_(cv); }
            __syncthreads();
            f32x4 a[8];
#pragma unroll
            for (int b = 0; b < 8; ++b) a[b] = (f32x4){0.f, 0.f, 0.f, 0.f};
            const float* wp = F.w_ada + (size_t)(d0 + F.wave * 64) * 12288 + cb * 256 + F.lane * 4;
#pragma unroll 4
            for (int d = 0; d < 64; ++d) { const f32x4 w = *(const f32x4*)(wp + (size_t)d * 12288);
#pragma unroll
                for (int b = 0; b < 8; ++b) a[b] += w * cact[b * 512 + F.wave * 64 + d]; }
#pragma unroll
            for (int b = 0; b < 8; ++b)
#pragma unroll
                for (int j = 0; j < 4; ++j) red[(F.wave * 32 + b * 4 + j) * 64 + F.lane] = a[b][j];
            __syncthreads();
            for (int i = F.tid; i < 2048; i += 512) { const int v = i >> 6, l = i & 63; float s = 0.f;
#pragma unroll
                for (int w = 0; w < 8; ++w) s += red[(w * 32 + v) * 64 + l];
                mp[((size_t)ds * 8 + (v >> 2)) * 12288 + cb * 256 + l * 4 + (v & 3)] = s; }
            __syncthreads();
        }
    }
}

template <bool FIRST> __device__ __forceinline__ void phase_modnorm(Frame& F, const float* xin, const float* gain, int off_sh, int off_sc, bf16_t* dst) {
    const float* mp = (const float*)(F.ws + WS_MODP); float* mf = (float*)(F.ws + WS_MODF);
    if (FIRST) {
        for (int i = F.bid * 512 + F.tid; i < 8 * 12288; i += F.G * 512) {
            float s = F.b_ada[i % 12288];
#pragma unroll
            for (int k = 0; k < 4; ++k) s += mp[(size_t)k * 8 * 12288 + i];
            mf[i] = s; }
    }
    float* cA = (float*)F.lds; float* cB = cA + 2048;
    for (int ch = F.bid; ch < MTOK / 128; ch += F.G) {
        const int b = ch / 32;
        __syncthreads();
        for (int col = F.tid; col < 2048; col += 512) {
            float sc, sh;
            if (FIRST) { sc = F.b_ada[off_sc + col]; sh = F.b_ada[off_sh + col];
#pragma unroll
                for (int k = 0; k < 4; ++k) { sc += mp[((size_t)k * 8 + b) * 12288 + off_sc + col]; sh += mp[((size_t)k * 8 + b) * 12288 + off_sh + col]; } }
            else { sc = mf[b * 12288 + off_sc + col]; sh = mf[b * 12288 + off_sh + col]; }
            cA[col] = gain[col] * (1.f + sc); cB[col] = sh; }
        __syncthreads();
        for (int r = F.wave; r < 128; r += 8) {
            const size_t row = (size_t)ch * 128 + r;
            const float* xr = xin + row * 2048 + F.lane * 8;
            f32x4 v[4][2]; float ss = 0.f;
#pragma unroll
            for (int i = 0; i < 4; ++i) { v[i][0] = *(const f32x4*)(xr + i * 512); v[i][1] = *(const f32x4*)(xr + i * 512 + 4);
#pragma unroll
                for (int j = 0; j < 4; ++j) ss += v[i][0][j] * v[i][0][j] + v[i][1][j] * v[i][1][j]; }
            ss = wave_sum(ss);
            const float rinv = 1.0f / sqrtf(ss * (1.0f / 2048.0f) + EPS);
#pragma unroll
            for (int i = 0; i < 4; ++i) { const int col = i * 512 + F.lane * 8;
                const f32x4 a0 = *(const f32x4*)(cA + col), a1 = *(const f32x4*)(cA + col + 4), b0 = *(const f32x4*)(cB + col), b1 = *(const f32x4*)(cB + col + 4);
                *(u32x4*)(dst + row * 2048 + col) = pack8(v[i][0] * rinv * a0 + b0, v[i][1] * rinv * a1 + b1); }
        }
    }
}

__device__ __forceinline__ u32x2 pack8_fp8(f32x4 a, f32x4 b) {
    int w0 = __builtin_amdgcn_cvt_pk_fp8_f32(a[0], a[1], 0, false); w0 = __builtin_amdgcn_cvt_pk_fp8_f32(a[2], a[3], w0, true);
    int w1 = __builtin_amdgcn_cvt_pk_fp8_f32(b[0], b[1], 0, false); w1 = __builtin_amdgcn_cvt_pk_fp8_f32(b[2], b[3], w1, true);
    return (u32x2){(unsigned)w0, (unsigned)w1};
}
__device__ __forceinline__ void phase3_qknorm(Frame& F) {
    const bf16_t* q = (const bf16_t*)(F.ws + WS_QN); const bf16_t* k = (const bf16_t*)(F.ws + WS_KN); const bf16_t* v = (const bf16_t*)(F.ws + WS_V);
    unsigned char* q8 = F.ws + WS_Q8; unsigned char* k8 = F.ws + WS_K8; unsigned char* v8 = F.ws + WS_V8;
    const int gw = F.bid * 8 + F.wave, NGW = F.G * 8;
    for (int row = gw; row < MTOK; row += NGW) {
#pragma unroll
        for (int i = 0; i < 2; ++i) { const int ci = i * 64 + F.lane;
            f32x4 a, b; unpack8(*(const u32x4*)(q + (size_t)row * 1024 + ci * 8), a, b);
            float ss = a[0] * a[0] + a[1] * a[1] + a[2] * a[2] + a[3] * a[3] + b[0] * b[0] + b[1] * b[1] + b[2] * b[2] + b[3] * b[3];
            ss = row_sum16(ss);
            const float rinv = 1.0f / sqrtf(ss * (1.0f / 128.0f) + EPS);
            const float* gp = F.g_q + (ci & 15) * 8; const f32x4 g0 = *(const f32x4*)gp, g1 = *(const f32x4*)(gp + 4);
            *(u32x2*)(q8 + (size_t)row * 1024 + ci * 8) = pack8_fp8(a * rinv * g0, b * rinv * g1); }
        { const int ci = F.lane & 31; const bool isk = F.lane < 32;
            f32x4 a, b; unpack8(*(const u32x4*)((isk ? k : v) + (size_t)row * 256 + ci * 8), a, b);
            float ss = a[0] * a[0] + a[1] * a[1] + a[2] * a[2] + a[3] * a[3] + b[0] * b[0] + b[1] * b[1] + b[2] * b[2] + b[3] * b[3];
            ss = row_sum16(ss);
            const float rinv = isk ? 1.0f / sqrtf(ss * (1.0f / 128.0f) + EPS) : 1.0f;
            const float* gp = F.g_k + (ci & 15) * 8; f32x4 g0 = *(const f32x4*)gp, g1 = *(const f32x4*)(gp + 4);
            if (!isk) { g0 = (f32x4){1.f, 1.f, 1.f, 1.f}; g1 = g0; }
            *(u32x2*)((isk ? k8 : v8) + (size_t)row * 256 + ci * 8) = pack8_fp8(a * rinv * g0, b * rinv * g1); }
    }
}
template <int W> __device__ __forceinline__ void pooled_item(const bf16_t* pl, bf16_t* po, int row, int c8) {
    const int t = row & (SEQ - 1);
    f32x4 s0 = (f32x4){0.f, 0.f, 0.f, 0.f}, s1 = s0, x0 = s0, x1 = s0;
    u32x4 v[W];
#pragma unroll
    for (int j = 0; j < W; ++j) v[j] = *(const u32x4*)(pl + (size_t)(row - (j <= t ? j : 0)) * 1024 + c8);
#pragma unroll
    for (int j = 0; j < W; ++j) { f32x4 a, b; unpack8(v[j], a, b); if (j == 0) { x0 = a; x1 = b; } if (j <= t) { s0 += a; s1 += b; } }
    const float inv = 1.0f / (float)((t + 1 < W) ? t + 1 : W);
    *(u32x4*)(po + (size_t)row * 1024 + c8) = pack8(s0 * inv - x0, s1 * inv - x1);
}
__device__ __forceinline__ void phase3_pooled(Frame& F) {
    const bf16_t* pl = (const bf16_t*)(F.ws + WS_PL); bf16_t* po = (bf16_t*)(F.ws + WS_POOLED);
    const int gw = F.bid * 8 + F.wave, NGW = F.G * 8;
    for (int it = gw; it < (MTOK / 2) * 4; it += NGW) {
        const int g = it & 3, row = (it >> 2) * 2 + (F.lane >> 5), c8 = g * 256 + (F.lane & 31) * 8;
        if (g == 0) pooled_item<2>(pl, po, row, c8); else if (g == 1) pooled_item<4>(pl, po, row, c8); else if (g == 2) pooled_item<8>(pl, po, row, c8); else pooled_item<16>(pl, po, row, c8);
    }
}
typedef float f32x16 __attribute__((ext_vector_type(16)));
__device__ __forceinline__ int sel_code(float s, float smin, float scale) { const float c = (s - smin) * scale; return (int)fminf(fmaxf(c, 0.f), 65535.f); }
__device__ __forceinline__ void hist_find(const unsigned* hist, int lane, int K, int& bsel, int& above) {
    const u32x4 h = *(const u32x4*)(hist + lane * 4);
    const int S = (int)(h.x + h.y + h.z + h.w);
    int x = S;
    x += __builtin_amdgcn_update_dpp(0, x, 0x101, 0xF, 0xF, true);
    x += __builtin_amdgcn_update_dpp(0, x, 0x102, 0xF, 0xF, true);
    x += __builtin_amdgcn_update_dpp(0, x, 0x104, 0xF, 0xF, true);
    x += __builtin_amdgcn_update_dpp(0, x, 0x108, 0xF, 0xF, true);
    const int t1 = __builtin_amdgcn_readlane(x, 16), t2 = __builtin_amdgcn_readlane(x, 32), t3 = __builtin_amdgcn_readlane(x, 48);
    const int r = lane >> 4;
    x += (r == 0 ? t1 + t2 + t3 : (r == 1 ? t2 + t3 : (r == 2 ? t3 : 0)));
    const int sufn = x - S;
    const bool mine = (x >= K) && (sufn < K);
    int b = 0, ab = 0;
    { int c = sufn;
      if (c + (int)h.w >= K) { b = 3; ab = c; } else { c += (int)h.w;
      if (c + (int)h.z >= K) { b = 2; ab = c; } else { c += (int)h.z;
      if (c + (int)h.y >= K) { b = 1; ab = c; } else { c += (int)h.y; b = 0; ab = c; } } } }
    const unsigned long long m = __ballot(mine);
    const int src = m ? (int)__builtin_ctzll(m) : 0;
    bsel = __builtin_amdgcn_readlane(lane * 4 + b, src); above = __builtin_amdgcn_readlane(ab, src);
}
__device__ __forceinline__ void indexer_select(Frame& F, int b, int t, const float* rowbuf, unsigned* hist, float* eqv, int* eqi) {
    unsigned short* selrow = (unsigned short*)(F.ws + WS_SEL) + (size_t)(b * SEQ + t) * 256;
    int lane = F.lane; asm volatile("" : "+v"(lane));
    const int nch = t / 64 + 1, n4 = (nch + 3) >> 2;
    const f32x4* rb4 = (const f32x4*)rowbuf;
    float mn = __builtin_huge_valf(), mx = -__builtin_huge_valf();
    for (int c4 = 0; c4 < n4; ++c4) { const f32x4 v = rb4[c4 * 64 + lane];
#pragma unroll
        for (int k = 0; k < 4; ++k) { const bool valid = ((c4 * 4 + k) * 64 + lane) <= t; mn = valid ? fminf(mn, v[k]) : mn; mx = valid ? fmaxf(mx, v[k]) : mx; } }
    mx = xor16_max(row_max16(mx)); { const auto r = __builtin_amdgcn_permlane32_swap(__float_as_uint(mx), __float_as_uint(mx), false, false); mx = fmaxf(__uint_as_float(r[0]), __uint_as_float(r[1])); }
    mn = -mn; mn = xor16_max(row_max16(mn)); { const auto r = __builtin_amdgcn_permlane32_swap(__float_as_uint(mn), __float_as_uint(mn), false, false); mn = -fmaxf(__uint_as_float(r[0]), __uint_as_float(r[1])); }
    const float scale = (mx > mn) ? 65535.0f / (mx - mn) : 0.f;
    *(u32x4*)(hist + lane * 4) = (u32x4){0u, 0u, 0u, 0u};
    for (int c4 = 0; c4 < n4; ++c4) { const f32x4 v = rb4[c4 * 64 + lane];
#pragma unroll
        for (int k = 0; k < 4; ++k) { const bool valid = ((c4 * 4 + k) * 64 + lane) <= t; if (valid) atomicAdd(&hist[sel_code(v[k], mn, scale) >> 8], 1u); } }
    int b1, above1; hist_find(hist, lane, KSEL, b1, above1);
    *(u32x4*)(hist + lane * 4) = (u32x4){0u, 0u, 0u, 0u};
    for (int c4 = 0; c4 < n4; ++c4) { const f32x4 v = rb4[c4 * 64 + lane];
#pragma unroll
        for (int k = 0; k < 4; ++k) { const bool valid = ((c4 * 4 + k) * 64 + lane) <= t; const int code = sel_code(v[k], mn, scale); if (valid && (code >> 8) == b1) atomicAdd(&hist[code & 255], 1u); } }
    int b2, above2; hist_find(hist, lane, KSEL - above1, b2, above2);
    const int T16 = (b1 << 8) | b2, need = KSEL - above1 - above2, ceq = (int)hist[b2];
    const unsigned long long lt_mask = (1ull << lane) - 1ull;
    const bool exact = (ceq != need) && (ceq <= 64);
    if (exact) {
        int pos = 0;
        for (int c = 0; c < nch; ++c) { const float sv = rowbuf[((c >> 2) * 64 + lane) * 4 + (c & 3)]; const int idx = c * 64 + lane;
            const bool eq = (idx <= t) && (sel_code(sv, mn, scale) == T16);
            const unsigned long long m = __ballot(eq);
            if (m) { const int p = pos + __popcll(m & lt_mask); if (eq) { eqv[p] = sv; eqi[p] = idx; } pos += __popcll(m); } }
    }
    int pos = 0, eqseen = 0;
    for (int c = 0; c < nch; ++c) {
        const float sv = rowbuf[((c >> 2) * 64 + lane) * 4 + (c & 3)]; const int idx = c * 64 + lane;
        const int code = sel_code(sv, mn, scale); const bool valid = idx <= t;
        const bool gt = valid && code > T16, eq = valid && code == T16;
        const unsigned long long meq = __ballot(eq);
        bool take = gt;
        if (meq) {
            if (ceq == need) take = take || eq;
            else if (exact) { int rank = 0; for (int m = 0; m < ceq; ++m) { const float ov = eqv[m]; const int oi = eqi[m]; rank += (ov > sv || (ov == sv && oi < idx)) ? 1 : 0; } take = take || (eq && rank < need); }
            else { const int er = eqseen + __popcll(meq & lt_mask); take = take || (eq && er < need); eqseen += __popcll(meq); }
        }
        const unsigned long long mt = __ballot(take);
        const int p = pos + __popcll(mt & lt_mask);
        if (take && p < KSEL) selrow[p] = (unsigned short)idx;
        pos += __popcll(mt);
    }
}
__device__ __forceinline__ void indexer_tile(Frame& F, int b, int t0) {
    const bf16_t* iq = (const bf16_t*)(F.ws + WS_IQ); const bf16_t* ik = (const bf16_t*)(F.ws + WS_IK); const float* iw = (const float*)(F.ws + WS_IW);
    int lane = F.lane; asm volatile("" : "+v"(lane));
    const int w = F.wave;
    if (t0 < KSEL) {
        const int t = t0 + w; unsigned short* selrow = (unsigned short*)(F.ws + WS_SEL) + (size_t)(b * SEQ + t) * 256;
#pragma unroll
        for (int p = 0; p < 4; ++p) { const int j = p * 64 + lane; selrow[j] = (unsigned short)(j <= t ? j : 0xFFFF); }
        return;
    }
    float* rowbuf = (float*)F.lds;
    unsigned char* stage = F.lds + 131072;
    const int p = w & 3, kh = w >> 2, hi = lane >> 5, r = lane & 31;
    const size_t qrow = (size_t)b * SEQ + t0 + 2 * p + (r >> 4);
    bf16x8 a[4];
#pragma unroll
    for (int ks = 0; ks < 4; ++ks) a[ks] = *(const bf16x8*)(iq + qrow * 1024 + (r & 15) * 64 + ks * 16 + 8 * hi);
    float wq[2][8];
#pragma unroll
    for (int q = 0; q < 2; ++q)
#pragma unroll
        for (int i = 0; i < 8; ++i) wq[q][i] = iw[((size_t)b * SEQ + t0 + 2 * p + q) * 16 + (i & 3) + 8 * ((i >> 2) & 1) + 4 * hi];
    const int nchunks = (t0 + 7) / 64 + 1;
    const unsigned char* gsrc = (const unsigned char*)(ik + (size_t)b * SEQ * 64) + F.tid * 16;
    const int skey = F.tid >> 3, sc16 = F.tid & 7, soff = skey * 128 + ((sc16 ^ (skey & 7)) << 4);
    u32x4 s0 = *(const u32x4*)gsrc, s1 = s0, s2 = s0, s3 = s0;
    if (1 < nchunks) s1 = *(const u32x4*)(gsrc + (size_t)1 * 8192);
    if (2 < nchunks) s2 = *(const u32x4*)(gsrc + (size_t)2 * 8192);
    if (3 < nchunks) s3 = *(const u32x4*)(gsrc + (size_t)3 * 8192);
    __syncthreads();
#define IDX_STEP(SR, cc) do { const int c = (cc); unsigned char* sb = stage + (c & 1) * 8192; \
        *(u32x4*)(sb + soff) = SR; \
        __syncthreads(); \
        if (c + 4 < nchunks) SR = *(const u32x4*)(gsrc + (size_t)(c + 4) * 8192); \
        f32x16 d; _Pragma("unroll") for (int i = 0; i < 16; ++i) d[i] = 0.f; \
        const int key = kh * 32 + r; \
        _Pragma("unroll") for (int ks = 0; ks < 4; ++ks) { const bf16x8 bf = *(const bf16x8*)(sb + key * 128 + (((ks * 2 + hi) ^ (key & 7)) << 4)); \
            d = __builtin_amdgcn_mfma_f32_32x32x16_bf16(a[ks], bf, d, 0, 0, 0); } \
        float s0_ = 0.f, s1_ = 0.f; \
        _Pragma("unroll") for (int i = 0; i < 8; ++i) { s0_ += wq[0][i] * fmaxf(d[i], 0.f); s1_ += wq[1][i] * fmaxf(d[8 + i], 0.f); } \
        const float sc = swap32_pair(s0_, s1_); \
        rowbuf[(2 * p + hi) * 4096 + ((c >> 2) * 64 + key) * 4 + (c & 3)] = sc; } while (0)
    for (int c4 = 0; c4 < nchunks; c4 += 4) {
        IDX_STEP(s0, c4);
        if (c4 + 1 < nchunks) IDX_STEP(s1, c4 + 1);
        if (c4 + 2 < nchunks) IDX_STEP(s2, c4 + 2);
        if (c4 + 3 < nchunks) IDX_STEP(s3, c4 + 3);
    }
#if PROBE_IDX == 1
    __syncthreads(); s0 = *(const u32x4*)gsrc; s1 = s0; s2 = s0; s3 = s0;
    if (1 < nchunks) s1 = *(const u32x4*)(gsrc + (size_t)1 * 8192);
    if (2 < nchunks) s2 = *(const u32x4*)(gsrc + (size_t)2 * 8192);
    if (3 < nchunks) s3 = *(const u32x4*)(gsrc + (size_t)3 * 8192);
    for (int c4 = 0; c4 < nchunks; c4 += 4) {
        IDX_STEP(s0, c4);
        if (c4 + 1 < nchunks) IDX_STEP(s1, c4 + 1);
        if (c4 + 2 < nchunks) IDX_STEP(s2, c4 + 2);
        if (c4 + 3 < nchunks) IDX_STEP(s3, c4 + 3);
    }
#endif
#undef IDX_STEP
    __syncthreads();
    indexer_select(F, b, t0 + w, rowbuf + w * 4096, (unsigned*)(F.lds + 147456) + w * 256, (float*)(F.lds + 155648) + w * 64, (int*)(F.lds + 155648 + 2048) + w * 64);
#if PROBE_IDX == 2
    indexer_select(F, b, t0 + w, rowbuf + w * 4096, (unsigned*)(F.lds + 147456) + w * 256, (float*)(F.lds + 155648) + w * 64, (int*)(F.lds + 155648 + 2048) + w * 64);
#endif
}
__device__ __forceinline__ void phase3_indexer(Frame& F) {
    const int nit = BATCH * (SEQ / 8);
    for (int k = 0;; ++k) {
        const int l = k * F.G + ((k & 1) ? (F.G - 1 - F.bid) : F.bid);
        if (l >= nit) { if (k * F.G >= nit) break; else continue; }
        const int qb = (SEQ / 8 - 1) - (l >> 3), b = l & 7;
        indexer_tile(F, b, qb * 8);
    }
}

__device__ const unsigned char g_bucket[128] = {0, 1, 2, 3, 4, 5, 6, 7, 8, 9, 10, 11, 12, 13, 14, 15, 16, 16, 16, 17, 17, 18, 18, 18, 19, 19, 19, 20, 20, 20, 20, 21, 21, 21, 21, 22, 22, 22, 22, 22, 23, 23, 23, 23, 23, 23, 24, 24, 24, 24, 24, 24, 25, 25, 25, 25, 25, 25, 25, 26, 26, 26, 26, 26, 26, 26, 26, 27, 27, 27, 27, 27, 27, 27, 27, 27, 27, 28, 28, 28, 28, 28, 28, 28, 28, 28, 28, 29, 29, 29, 29, 29, 29, 29, 29, 29, 29, 29, 29, 30, 30, 30, 30, 30, 30, 30, 30, 30, 30, 30, 30, 30, 30, 31, 31, 31, 31, 31, 31, 31, 31, 31, 31, 31, 31, 31, 31, 31};
__device__ __forceinline__ void phase4_attention(Frame& F) {
    const unsigned char* q8 = F.ws + WS_Q8; const unsigned char* k8 = F.ws + WS_K8; const unsigned char* v8 = F.ws + WS_V8;
    const unsigned short* sel = (const unsigned short*)(F.ws + WS_SEL); bf16_t* ao = (bf16_t*)(F.ws + WS_ATTN);
    float* btab = (float*)F.lds;
    __syncthreads();
    for (int i = F.tid; i < 256; i += 512) btab[i] = F.rel_bias[i];
    __syncthreads();
    float* Pl = (float*)(F.lds + 4096 + F.wave * 12288); int* idl = (int*)(Pl + 2048); float* psl = (float*)(idl + 256);
    const bool xmap = (F.G % 8) == 0;
    const int gw = xmap ? (F.bid / 8) * 8 + F.wave : F.bid * 8 + F.wave, NGW = xmap ? F.G : F.G * 8, nrows = xmap ? SEQ : MTOK;
    for (int rr = gw; rr < nrows; rr += NGW) {
        int lane = F.lane; asm volatile("" : "+v"(lane));
        const int row = xmap ? (F.bid & 7) * SEQ + rr : rr;
        const int b = row / SEQ, t = row % SEQ, r = lane & 31, hi = lane >> 5;
#pragma unroll
        for (int p = 0; p < 4; ++p) { idl[p * 64 + lane] = (int)sel[(size_t)row * 256 + p * 64 + lane]; }
        long a0[8], a1[8];
        { u32x4 qa[4];
#pragma unroll
          for (int i = 0; i < 4; ++i) qa[i] = (r < 8) ? *(const u32x4*)(q8 + (size_t)row * 1024 + r * 128 + hi * 64 + i * 16) : (u32x4){0u, 0u, 0u, 0u};
#pragma unroll
          for (int ks = 0; ks < 8; ++ks) { const unsigned lo = qa[ks >> 1][(ks & 1) * 2], hh = qa[ks >> 1][(ks & 1) * 2 + 1]; const long v = (long)(((unsigned long long)hh << 32) | lo);
              a0[ks] = (r < 4) ? v : 0l; a1[ks] = (r >= 4) ? v : 0l; } }
        f32x4 psum = (f32x4){0.f, 0.f, 0.f, 0.f};
#define AT_LOADK(buf, kb) do { const int key_ = idl[(kb) * 32 + r]; const int kc_ = key_ <= t ? key_ : 0; const unsigned char* kr_ = k8 + ((size_t)b * SEQ + kc_) * 256 + hi * 64; \
            _Pragma("unroll") for (int i = 0; i < 4; ++i) { buf[i] = *(const u32x4*)(kr_ + i * 16); buf[4 + i] = *(const u32x4*)(kr_ + 128 + i * 16); } } while (0)
#define AT_QK(buf, kb) do { const int key_ = idl[(kb) * 32 + r]; const bool valid_ = key_ <= t; const int kc_ = valid_ ? key_ : 0; \
            f32x16 d; _Pragma("unroll") for (int i = 0; i < 16; ++i) d[i] = 0.f; \
            _Pragma("unroll") for (int ks = 0; ks < 8; ++ks) { const long bv_ = (long)(((unsigned long long)buf[ks >> 1][(ks & 1) * 2 + 1] << 32) | buf[ks >> 1][(ks & 1) * 2]); d = __builtin_amdgcn_mfma_f32_32x32x16_fp8_fp8(a0[ks], bv_, d, 0, 0, 0); } \
            _Pragma("unroll") for (int ks = 0; ks < 8; ++ks) { const long bv_ = (long)(((unsigned long long)buf[4 + (ks >> 1)][(ks & 1) * 2 + 1] << 32) | buf[4 + (ks >> 1)][(ks & 1) * 2]); d = __builtin_amdgcn_mfma_f32_32x32x16_fp8_fp8(a1[ks], bv_, d, 0, 0, 0); } \
            const int dist_ = t - kc_; const int bkt_ = dist_ < 128 ? (int)g_bucket[dist_] : 31; \
            const f32x4 bias_ = *(const f32x4*)(btab + bkt_ * 8 + 4 * hi); f32x4 e_; \
            _Pragma("unroll") for (int i = 0; i < 4; ++i) e_[i] = valid_ ? __expf(d[i] * 0.08838834764831845f + bias_[i]) : 0.f; \
            psum += e_; *(f32x4*)(Pl + ((kb) * 32 + r) * 8 + 4 * hi) = e_; } while (0)
        {
            u32x4 kA[8], kB[8];
            AT_LOADK(kA, 0);
#pragma unroll 1
            for (int kb = 0; kb < 8; kb += 2) {
                AT_LOADK(kB, kb + 1);
                AT_QK(kA, kb);
                if (kb + 2 < 8) AT_LOADK(kA, kb + 2);
                AT_QK(kB, kb + 1);
            }
        }
#undef AT_LOADK
#undef AT_QK
#pragma unroll
        for (int i = 0; i < 4; ++i) psum[i] = xor16_sum(row_sum16(psum[i]));
        if (r == 0) *(f32x4*)(psl + 4 * hi) = psum;
        const int ks = lane >> 4, g = (lane >> 3) & 1, dc = lane & 7;
        float acc[4][16];
#pragma unroll
        for (int h = 0; h < 4; ++h)
#pragma unroll
            for (int j = 0; j < 16; ++j) acc[h][j] = 0.f;
#define AT_LOADV(buf, it0) do { _Pragma("unroll") for (int u = 0; u < 4; ++u) { const int key_ = idl[((it0) + u) * 4 + ks]; const int kc_ = key_ <= t ? key_ : 0; \
            buf[u] = *(const u32x4*)(v8 + ((size_t)b * SEQ + kc_) * 256 + g * 128 + dc * 16); } } while (0)
#define AT_PV(buf, it0) do { _Pragma("unroll") for (int u = 0; u < 4; ++u) { const int j_ = ((it0) + u) * 4 + ks; const u32x4 w = buf[u]; \
            const f32x4 p = *(const f32x4*)(Pl + j_ * 8 + 4 * g); \
            _Pragma("unroll") for (int dd = 0; dd < 4; ++dd) { const f32x2 lo = __builtin_amdgcn_cvt_pk_f32_fp8((int)w[dd], false), hh_ = __builtin_amdgcn_cvt_pk_f32_fp8((int)w[dd], true); \
                _Pragma("unroll") for (int h = 0; h < 4; ++h) { acc[h][4 * dd] += p[h] * lo.x; acc[h][4 * dd + 1] += p[h] * lo.y; acc[h][4 * dd + 2] += p[h] * hh_.x; acc[h][4 * dd + 3] += p[h] * hh_.y; } } } } while (0)
        {
            u32x4 vA[4], vB[4];
            AT_LOADV(vA, 0);
#pragma unroll 1
            for (int it0 = 0; it0 < 64; it0 += 8) {
                AT_LOADV(vB, it0 + 4);
                AT_PV(vA, it0);
                if (it0 + 8 < 64) AT_LOADV(vA, it0 + 8);
                AT_PV(vB, it0 + 4);
            }
        }
#undef AT_LOADV
#undef AT_PV
#pragma unroll
        for (int h = 0; h < 4; ++h)
#pragma unroll
            for (int j = 0; j < 16; ++j) acc[h][j] = xor32_sum(xor16_sum(acc[h][j]));
#pragma unroll
        for (int h = 0; h < 4; ++h) if (h == ks) { const float inv = 1.0f / psl[4 * g + h];
            bf16_t* op = ao + (size_t)row * 1024 + (4 * g + h) * 128 + dc * 16;
            *(u32x4*)op = pack8((f32x4){acc[h][0], acc[h][1], acc[h][2], acc[h][3]} * inv, (f32x4){acc[h][4], acc[h][5], acc[h][6], acc[h][7]} * inv);
            *(u32x4*)(op + 8) = pack8((f32x4){acc[h][8], acc[h][9], acc[h][10], acc[h][11]} * inv, (f32x4){acc[h][12], acc[h][13], acc[h][14], acc[h][15]} * inv); }
    }
}

__device__ __forceinline__ float dot16f8(u32x4 w, const float* h) {
    float s = 0.f;
#pragma unroll
    for (int d = 0; d < 4; ++d) { const f32x2 lo = __builtin_amdgcn_cvt_pk_f32_fp8((int)w[d], false), hi = __builtin_amdgcn_cvt_pk_f32_fp8((int)w[d], true);
        s += lo.x * h[4 * d] + lo.y * h[4 * d + 1] + hi.x * h[4 * d + 2] + hi.y * h[4 * d + 3]; }
    return s;
}
__device__ __forceinline__ void fma16f8(u32x4 w, float cf, float* acc) {
#pragma unroll
    for (int d = 0; d < 4; ++d) { const f32x2 lo = __builtin_amdgcn_cvt_pk_f32_fp8((int)w[d], false), hi = __builtin_amdgcn_cvt_pk_f32_fp8((int)w[d], true);
        acc[4 * d] += cf * lo.x; acc[4 * d + 1] += cf * lo.y; acc[4 * d + 2] += cf * hi.x; acc[4 * d + 3] += cf * hi.y; }
}
__device__ __forceinline__ float gelu_erf(float x) { return 0.5f * x * (1.0f + erff(x * 0.70710678118654752f)); }
__device__ __forceinline__ void peer_select(const bf16_t* srow, int lane, int* elist, float* gl, float* scr) {
    float* selv = scr; int* seli = (int*)(scr + 32); float* srtv = scr + 64; int* srti = (int*)(scr + 96);
    const unsigned long long lt_mask = (1ull << lane) - 1ull;
    const int half = lane >> 5, lh = lane & 31;
    const unsigned long long hmask = half ? 0xFFFFFFFF00000000ull : 0x00000000FFFFFFFFull;
    const float NINF = -__builtin_huge_valf();
#pragma unroll 1
    for (int h = 0; h < 8; ++h) {
        const u32x2 raw = *(const u32x2*)(srow + h * 256 + lane * 4);
        unsigned b[4] = {raw.x & 0xffffu, raw.x >> 16, raw.y & 0xffffu, raw.y >> 16}, k[4];
#pragma unroll
        for (int q = 0; q < 4; ++q) k[q] = (b[q] & 0x8000u) ? (b[q] ^ 0xFFFFu) : (b[q] | 0x8000u);
        unsigned T0 = 0u, T1 = 0u;
#pragma unroll
        for (int bit = 15; bit >= 0; --bit) {
            const unsigned c0 = T0 | (1u << bit), c1 = T1 | (1u << bit), cand = half ? c1 : c0;
            const unsigned long long m0 = __ballot(k[0] >= cand), m1 = __ballot(k[1] >= cand), m2 = __ballot(k[2] >= cand), m3 = __ballot(k[3] >= cand);
            const int n0 = __popc((unsigned)m0) + __popc((unsigned)m1) + __popc((unsigned)m2) + __popc((unsigned)m3);
            const int n1 = __popc((unsigned)(m0 >> 32)) + __popc((unsigned)(m1 >> 32)) + __popc((unsigned)(m2 >> 32)) + __popc((unsigned)(m3 >> 32));
            T0 = (n0 >= 16) ? c0 : T0; T1 = (n1 >= 16) ? c1 : T1;
        }
        const unsigned T = half ? T1 : T0;
        int ngt = 0, eqb = 0; unsigned long long me[4];
#pragma unroll
        for (int q = 0; q < 4; ++q) { const unsigned long long mg = __ballot(k[q] > T) & hmask; me[q] = __ballot(k[q] == T) & hmask; ngt += __popcll(mg); eqb += __popcll(me[q] & lt_mask); }
        const int need = 16 - ngt;
        bool sl[4]; int run = eqb;
#pragma unroll
        for (int q = 0; q < 4; ++q) { const bool eq = k[q] == T; sl[q] = (k[q] > T) || (eq && run < need); run += eq ? 1 : 0; }
        int pos = 0;
#pragma unroll
        for (int q = 0; q < 4; ++q) pos += __popcll(__ballot(sl[q]) & hmask & lt_mask);
#pragma unroll
        for (int q = 0; q < 4; ++q) { if (sl[q]) { selv[half * 16 + pos] = __uint_as_float(b[q] << 16); seli[half * 16 + pos] = 4 * lh + q; } pos += sl[q] ? 1 : 0; }
        const float v = selv[half * 16 + (lh & 15)]; const int ix = seli[half * 16 + (lh & 15)];
        int rank = 0;
#define PS_ROT(R) { const float vo = __int_as_float(__builtin_amdgcn_update_dpp(0, __float_as_int(v), 0x120 + (R), 0xF, 0xF, true)); const int io = __builtin_amdgcn_update_dpp(0, ix, 0x120 + (R), 0xF, 0xF, true); rank += (vo > v || (vo == v && io < ix)) ? 1 : 0; }
        PS_ROT(1) PS_ROT(2) PS_ROT(3) PS_ROT(4) PS_ROT(5) PS_ROT(6) PS_ROT(7) PS_ROT(8) PS_ROT(9) PS_ROT(10) PS_ROT(11) PS_ROT(12) PS_ROT(13) PS_ROT(14) PS_ROT(15)
#undef PS_ROT
        if (lh < 16) { srtv[half * 16 + rank] = v; srti[half * 16 + rank] = ix; }
        int ca, cb; const int c = lane;
        if (c < 16) { ca = 0; cb = c; } else if (c < 24) { ca = 1; cb = c - 16; } else if (c < 29) { ca = 2; cb = c - 24; } else if (c < 33) { ca = 3; cb = c - 29; }
        else if (c < 36) { ca = 4; cb = c - 33; } else if (c < 38) { ca = 5; cb = c - 36; } else if (c < 40) { ca = 6; cb = c - 38; } else if (c < 42) { ca = 7; cb = c - 40; }
        else { ca = (c - 42 + 8) & 15; cb = 0; }
        float s = srtv[ca] + srtv[16 + cb];
        const int eid = srti[ca] * 128 + srti[16 + cb];
        if (c >= 50) s = NINF;
        const unsigned sb_ = __float_as_uint(s), ok_ = sb_ ^ ((unsigned)((int)sb_ >> 31) | 0x80000000u);
        const unsigned key = (c < 50) ? ((ok_ & ~63u) | (unsigned)(63 - c)) : 0u;
        int rk = 0;
#pragma unroll
        for (int j = 0; j < 50; ++j) { const unsigned kj = (unsigned)__builtin_amdgcn_readlane((int)key, j); rk += (kj > key) ? 1 : 0; }
        const bool selq = (c < 50) && (rk < 16);
        const float smax = __shfl(s, 0);
        const float e = selq ? __expf(s - smax) : 0.f;
        const float esum = wave_sum(e);
        const unsigned long long ms = __ballot(selq);
        const int p = __popcll(ms & lt_mask);
        if (selq) { elist[h * 16 + p] = eid; gl[h * 16 + p] = e / esum; }
    }
}
__device__ __forceinline__ float dot32_f8b(u32x4 wa, u32x4 wb, u32x4 ha0, u32x4 ha1, u32x4 hb0, u32x4 hb1) {
    typedef __bf16 bf2 __attribute__((ext_vector_type(2)));
    float acc = 0.f;
#pragma unroll
    for (int d = 0; d < 4; ++d) {
        const unsigned h0 = d < 2 ? ha0[2 * d] : ha1[2 * d - 4], h1 = d < 2 ? ha0[2 * d + 1] : ha1[2 * d - 3];
        const unsigned g0 = d < 2 ? hb0[2 * d] : hb1[2 * d - 4], g1 = d < 2 ? hb0[2 * d + 1] : hb1[2 * d - 3];
        acc = __builtin_amdgcn_fdot2_f32_bf16(__builtin_amdgcn_cvt_scalef32_pk_bf16_fp8((int)wa[d], 1.0f, false), __builtin_bit_cast(bf2, h0), acc, false);
        acc = __builtin_amdgcn_fdot2_f32_bf16(__builtin_amdgcn_cvt_scalef32_pk_bf16_fp8((int)wa[d], 1.0f, true), __builtin_bit_cast(bf2, h1), acc, false);
        acc = __builtin_amdgcn_fdot2_f32_bf16(__builtin_amdgcn_cvt_scalef32_pk_bf16_fp8((int)wb[d], 1.0f, false), __builtin_bit_cast(bf2, g0), acc, false);
        acc = __builtin_amdgcn_fdot2_f32_bf16(__builtin_amdgcn_cvt_scalef32_pk_bf16_fp8((int)wb[d], 1.0f, true), __builtin_bit_cast(bf2, g1), acc, false); }
    return acc;
}
__device__ __forceinline__ void phase10_peer(Frame& F) {
    const bf16_t* sub = (const bf16_t*)(F.ws + WS_SUB); const bf16_t* h2 = (const bf16_t*)(F.ws + WS_H2);
    const unsigned char* pu = F.ws + WS_PU; unsigned* pairs = (unsigned*)(F.ws + WS_PAIRS);
    const int gw = F.bid * 8 + F.wave, NGW = F.G * 8;
    unsigned char* wb = F.lds + F.wave * 17664;
    unsigned char* h2b = wb; unsigned short* gl16 = (unsigned short*)(wb + 16384); unsigned* hist = (unsigned*)(wb + 17408); unsigned* base = hist + 32;
    unsigned* tmp = (unsigned*)wb; int* elist = (int*)(wb + 2048); float* gl = (float*)(wb + 2560); float* sscr = (float*)(wb + 3072); bf16_t* srl = (bf16_t*)(wb + 4096);
    unsigned* wls = (unsigned*)(F.ws + WS_WLS) + (size_t)gw * 512;
    const int ntok = (MTOK - gw + NGW - 1) / NGW;
    for (int p0 = 0; p0 < ntok; p0 += 4) {
        int lane = F.lane; asm volatile("" : "+v"(lane));
        const int nt = (ntok - p0) < 4 ? (ntok - p0) : 4, ne = nt * 128;
        u32x4 nxt[4];
#pragma unroll
        for (int q = 0; q < 4; ++q) nxt[q] = *(const u32x4*)(sub + (size_t)(gw + p0 * NGW) * 2048 + lane * 32 + q * 8);
#pragma unroll 1
        for (int i = 0; i < nt; ++i) {
#pragma unroll
            for (int q = 0; q < 4; ++q) *(u32x4*)(srl + lane * 32 + q * 8) = nxt[q];
            if (i + 1 < nt) {
#pragma unroll
                for (int q = 0; q < 4; ++q) nxt[q] = *(const u32x4*)(sub + (size_t)(gw + (p0 + i + 1) * NGW) * 2048 + lane * 32 + q * 8); }
            peer_select(srl, lane, elist, gl, sscr);
#if PROBE_SEL
            asm volatile("" : "+v"(lane)); peer_select(srl, lane, elist, gl, sscr);
#endif
            tmp[i * 128 + lane] = ((unsigned)(i * 128 + lane) << 14) | (unsigned)elist[lane];
            tmp[i * 128 + 64 + lane] = ((unsigned)(i * 128 + 64 + lane) << 14) | (unsigned)elist[64 + lane];
            gl16[i * 128 + lane] = (unsigned short)(cvt_pk_bf16(gl[lane], 0.f) & 0xffffu); gl16[i * 128 + 64 + lane] = (unsigned short)(cvt_pk_bf16(gl[64 + lane], 0.f) & 0xffffu);
        }
        asm volatile("" : "+v"(lane));
        if (lane < 32) hist[lane] = 0u;
        unsigned ent[8]; unsigned rk[8];
#pragma unroll
        for (int q = 0; q < 8; ++q) { const int e = q * 64 + lane; ent[q] = (e < ne) ? tmp[e] : 0u; rk[q] = (e < ne) ? atomicAdd(&hist[(ent[q] & 0x3FFFu) >> 9], 1u) : 0u; }
        { int hv = lane < 32 ? (int)hist[lane] : 0; int x = hv;
          x += __builtin_amdgcn_update_dpp(0, x, 0x111, 0xF, 0xF, true); x += __builtin_amdgcn_update_dpp(0, x, 0x112, 0xF, 0xF, true);
          x += __builtin_amdgcn_update_dpp(0, x, 0x114, 0xF, 0xF, true); x += __builtin_amdgcn_update_dpp(0, x, 0x118, 0xF, 0xF, true);
          const int t0 = __builtin_amdgcn_readlane(x, 15); if (lane >= 16) x += t0;
          if (lane < 32) base[lane] = (unsigned)(x - hv); }
#pragma unroll
        for (int q = 0; q < 8; ++q) { const int e = q * 64 + lane; if (e < ne) wls[base[(ent[q] & 0x3FFFu) >> 9] + rk[q]] = ent[q]; }
#pragma unroll 1
        for (int i = 0; i < nt; ++i) { const bf16_t* hr = h2 + (size_t)(gw + (p0 + i) * NGW) * 2048 + lane * 16;
#pragma unroll
            for (int hh = 0; hh < 2; ++hh) { const u32x4 a = *(const u32x4*)(hr + hh * 1024), b = *(const u32x4*)(hr + hh * 1024 + 8);
                *(u32x4*)(h2b + i * 4096 + hh * 2048 + lane * 32) = a; *(u32x4*)(h2b + i * 4096 + hh * 2048 + lane * 32 + 16) = b; } }
        asm volatile("s_waitcnt vmcnt(0)" ::: "memory");
        unsigned entn = __hip_atomic_load(wls + lane, __ATOMIC_RELAXED, __HIP_MEMORY_SCOPE_AGENT);
#pragma unroll 1
        for (int c = 0; c < ne; c += 64) {
            const unsigned ent64 = entn;
            if (c + 64 < ne) entn = __hip_atomic_load(wls + c + 64 + lane, __ATOMIC_RELAXED, __HIP_MEMORY_SCOPE_AGENT);
#pragma unroll 1
            for (int i0 = 0; i0 < 64; i0 += 8) {
                u32x4 w[8][2]; unsigned en[8];
#pragma unroll
                for (int jj = 0; jj < 8; ++jj) { en[jj] = (unsigned)__builtin_amdgcn_readlane((int)ent64, i0 + jj); const unsigned char* ur = pu + (size_t)(en[jj] & 0x3FFFu) * 2048 + lane * 16;
                    w[jj][0] = *(const u32x4*)ur; w[jj][1] = *(const u32x4*)(ur + 1024); }
                float pr[8];
#pragma unroll
                for (int jj = 0; jj < 8; ++jj) { const unsigned char* hp = h2b + (en[jj] >> 21) * 4096 + lane * 32;
                    pr[jj] = dot32_f8b(w[jj][0], w[jj][1], *(const u32x4*)hp, *(const u32x4*)(hp + 16), *(const u32x4*)(hp + 2048), *(const u32x4*)(hp + 2064)); __builtin_amdgcn_sched_barrier(0); }
#pragma unroll
                for (int i = 0; i < 4; ++i) pr[i] = swap32_pair(pr[i], pr[i + 4]);
#pragma unroll
                for (int i = 0; i < 2; ++i) pr[i] = swap16_pair(pr[i], pr[i + 2]);
                const bool b3 = (lane & 8) != 0;
                { const float snd = b3 ? pr[0] : pr[1], kp = b3 ? pr[1] : pr[0]; pr[0] = kp + dpp_f<DPP_ROR8>(snd); }
                float tot = pr[0]; tot += dpp_f<DPP_XOR1>(tot); tot += dpp_f<DPP_XOR2>(tot); tot += dpp_f<DPP_HMIRROR>(tot);
                const unsigned em = (unsigned)__shfl((int)ent64, i0 + (lane >> 3));
                if ((lane & 7) == 0) {
                    const int tk = (int)(em >> 21), j = (int)((em >> 14) & 127u), row = gw + (p0 + tk) * NGW;
                    const float cf = gelu_erf(tot * (1.0f / 64.0f)) * __uint_as_float((unsigned)gl16[tk * 128 + j] << 16);
                    pairs[((size_t)(row >> 6) * 128 + j) * 64 + (row & 63)] = (cvt_pk_bf16(0.f, cf) & 0xffff0000u) | (em & 0x3FFFu);
                }
            }
        }
    }
}

__device__ __forceinline__ void phase11_peer_v(Frame& F, float* dst) {
    const unsigned* pairs = (const unsigned*)(F.ws + WS_PAIRS); const float* mf = (const float*)(F.ws + WS_MODF);
    unsigned long long* vs = (unsigned long long*)F.lds;
    for (int c = F.bid; c < DM / 8; c += F.G) {
        __syncthreads();
        { const u32x4* src = (const u32x4*)(F.ws + WS_PV + (size_t)c * NEXP * 8); u32x4* dst = (u32x4*)F.lds;
#pragma unroll 4
          for (int i = F.tid; i < NEXP * 8 / 16; i += 512) dst[i] = src[i]; }
        __syncthreads();
        for (int tile = F.wave; tile < MTOK / 64; tile += 8) {
            int lane = F.lane; asm volatile("" : "+v"(lane));
            const unsigned* pp = pairs + (size_t)tile * 128 * 64 + lane;
            f32x2 acc[4];
#pragma unroll
            for (int i = 0; i < 4; ++i) acc[i] = (f32x2){0.f, 0.f};
#define P11_LOAD(dst, j0) do { _Pragma("unroll") for (int jj = 0; jj < 16; ++jj) dst[jj] = pp[((j0) + jj) * 64]; } while (0)
#define P11_COMP(src) do { _Pragma("unroll") for (int jj = 0; jj < 16; ++jj) { const unsigned long long v = vs[src[jj] & 0x3FFFu]; const float cf = __uint_as_float(src[jj] & 0xffff0000u); \
                    const int lo = (int)(unsigned)v, hi = (int)(unsigned)(v >> 32); \
                    acc[0] += __builtin_amdgcn_cvt_pk_f32_fp8(lo, false) * cf; acc[1] += __builtin_amdgcn_cvt_pk_f32_fp8(lo, true) * cf; \
                    acc[2] += __builtin_amdgcn_cvt_pk_f32_fp8(hi, false) * cf; acc[3] += __builtin_amdgcn_cvt_pk_f32_fp8(hi, true) * cf; } } while (0)
#if PROBE_P11X
            { f32x2 sv[4]; for (int i = 0; i < 4; ++i) sv[i] = acc[i];
            unsigned pa[16], pb[16];
            P11_LOAD(pa, 0);
#pragma unroll 1
            for (int j0 = 0; j0 < 128; j0 += 32) {
                P11_LOAD(pb, j0 + 16);
                P11_COMP(pa);
                if (j0 + 32 < 128) P11_LOAD(pa, j0 + 32);
                P11_COMP(pb);
            }
              asm volatile("" :: "v"(acc[0].x), "v"(acc[1].x), "v"(acc[2].x), "v"(acc[3].x)); for (int i = 0; i < 4; ++i) acc[i] = sv[i] * 0.f; }
#endif
            unsigned pa[16], pb[16];
            P11_LOAD(pa, 0);
#pragma unroll 1
            for (int j0 = 0; j0 < 128; j0 += 32) {
                P11_LOAD(pb, j0 + 16);
                P11_COMP(pa);
                if (j0 + 32 < 128) P11_LOAD(pa, j0 + 32);
                P11_COMP(pb);
            }
#undef P11_LOAD
#undef P11_COMP
            const int row = tile * 64 + lane;
            const float* gt2 = mf + (size_t)(tile / (SEQ / 64)) * 12288 + 10240 + c * 8;
            const float* ip = F.out + (size_t)row * 2048 + c * 8; float* op = dst + (size_t)row * 2048 + c * 8;
            const f32x4 x0 = *(const f32x4*)ip, x1 = *(const f32x4*)(ip + 4), g0 = *(const f32x4*)gt2 * 0.25f, g1 = *(const f32x4*)(gt2 + 4) * 0.25f;
            *(f32x4*)op = x0 + g0 * (f32x4){acc[0].x, acc[0].y, acc[1].x, acc[1].y};
            *(f32x4*)(op + 4) = x1 + g1 * (f32x4){acc[2].x, acc[2].y, acc[3].x, acc[3].y};
        }
    }
}

__global__ void __launch_bounds__(512, 2) fwd_kernel(Args args) {
    extern __shared__ __attribute__((aligned(16))) unsigned char lds[];
    Frame F;
    F.lds = lds; F.ws = args.ws; F.tid = threadIdx.x; F.lane = F.tid & 63; F.wave = __builtin_amdgcn_readfirstlane(F.tid >> 6); F.G = gridDim.x; F.bid = blockIdx.x;
    F.x = args.in[0]; F.c = args.in[1]; F.w_ada = args.in[2]; F.b_ada = args.in[3]; F.g1 = args.in[4]; F.g2 = args.in[5]; F.w_in = args.in[6]; F.g_q = args.in[7]; F.g_k = args.in[8];
    F.rel_bias = args.in[9]; F.pool_w = args.in[10]; F.pool_scale = args.in[11]; F.w_ab = args.in[12]; F.w_pb = args.in[13]; F.w_out = args.in[14]; F.w_pq = args.in[15];
    F.peer_keys = args.in[16]; F.peer_u = args.in[17]; F.peer_v = args.in[18]; F.out = args.out;
    LAS unsigned char* ldsl = (LAS unsigned char*)lds;
    volatile LAS unsigned* misc = (volatile LAS unsigned*)(ldsl + MISC_OFF);
    if (F.tid < 4) misc[F.tid] = 0u;
    __syncthreads();
    unsigned* barw = (unsigned*)(args.ws + WS_CTL) + (size_t)args.li * XCD_BAR_WORDS;
    XcdBarrier bar; bar.bar = barw; bar.x = 0; bar.st = misc;
    const int lo = args.ph_lo, hi = args.ph_hi;
    if (hi - lo > 1) bar = xcd_barrier_post(barw, misc);
#define IN(k) (lo <= (k) && (k) < hi)
#define SEAM(k) do { if (IN(k) && IN((k) + 1)) xcd_barrier(bar); } while (0)
    bf16_t* R0 = (bf16_t*)(F.ws + WS_R0);

#define PH2_BODY { \
        pg8::Gemm g{R0, (const bf16_t*)(F.ws + WS_WIN), MTOK, INWP, DM, DM, 0, nullptr, nullptr, 0, 0}; pg8::StaticOrder S; S.init(MTOK, INWP, F.G, F.bid); \
        EpiInproj E{(bf16_t*)(F.ws + WS_QN), (bf16_t*)(F.ws + WS_KN), (bf16_t*)(F.ws + WS_V), (bf16_t*)(F.ws + WS_IQ), (bf16_t*)(F.ws + WS_IK), (bf16_t*)(F.ws + WS_PL), \
                    (bf16_t*)(F.ws + WS_GA), (bf16_t*)(F.ws + WS_GP), (float*)(F.ws + WS_IW)}; \
        pg8::gemm_phase<EpiInproj>(ldsl, g, S, E); }
#define PH3_BODY { phase3_pooled(F); phase3_indexer(F); __syncthreads(); }
#define PH4_BODY { \
        phase4_attention(F); \
        __syncthreads(); \
        pg8::Gemm g{(const bf16_t*)(F.ws + WS_POOLED), (const bf16_t*)(F.ws + WS_POOLW), MTOK, PW, 256, 1024, 256, nullptr, nullptr, 0, 0}; pg8::StaticOrder S; S.init(MTOK, PW, F.G, F.bid); \
        EpiBf16Scale E{(bf16_t*)(F.ws + WS_POOL2), 1024, F.pool_scale}; \
        pg8::gemm_phase<EpiBf16Scale>(ldsl, g, S, E); }
#define PH5_BODY { \
        pg8::Gemm g{(const bf16_t*)(F.ws + WS_ATTN), (const bf16_t*)(F.ws + WS_WAB), MTOK, DM, 2048, 1024, 0, (const bf16_t*)(F.ws + WS_POOL2), (const bf16_t*)(F.ws + WS_WPB), 16, 1024}; \
        pg8::StaticOrder S; S.init(MTOK, DM, F.G, F.bid); \
        EpiMerge E{R0, (const bf16_t*)(F.ws + WS_GA), (const bf16_t*)(F.ws + WS_GP)}; pg8::gemm_phase<EpiMerge>(ldsl, g, S, E); }
#define PH6_BODY { \
        pg8::Gemm g{R0, (const bf16_t*)(F.ws + WS_WOUT), MTOK, DM, DM, DM, 0, nullptr, nullptr, 0, 0}; pg8::StaticOrder S; S.init(MTOK, DM, F.G, F.bid); \
        EpiResid E{F.x, F.out, (const float*)(F.ws + WS_MODF) + 4096}; pg8::gemm_phase<EpiResid>(ldsl, g, S, E); }
#define PH8_BODY { \
        pg8::Gemm g{(const bf16_t*)(F.ws + WS_H2), (const bf16_t*)(F.ws + WS_WPQ), MTOK, DM, DM, DM, 0, nullptr, nullptr, 0, 0}; pg8::StaticOrder S; S.init(MTOK, DM, F.G, F.bid); \
        EpiBf16Scale E{R0, 2048, nullptr}; pg8::gemm_phase<EpiBf16Scale>(ldsl, g, S, E); }
#define PH9_BODY { \
        pg8::Gemm g{R0, (const bf16_t*)(F.ws + WS_KEYSBD), MTOK, DM, 256, DM, 256, nullptr, nullptr, 0, 0}; pg8::StaticOrder S; S.init(MTOK, DM, F.G, F.bid); \
        EpiBf16Scale E{(bf16_t*)(F.ws + WS_SUB), 2048, nullptr}; pg8::gemm_phase<EpiBf16Scale>(ldsl, g, S, E); }
#define REP(k) if constexpr (((PROBE_REP) >> (k)) & 1)

    if (IN(0)) { phase0_prep(F); REP(0) { __syncthreads(); phase0_prep(F); } }
    SEAM(0);
    if (IN(1)) { phase_modnorm<true>(F, F.x, F.g1, 0, 2048, R0); REP(1) { phase_modnorm<true>(F, F.x, F.g1, 0, 2048, R0); } }
    SEAM(1);
    if (IN(2)) { PH2_BODY REP(2) PH2_BODY }
    SEAM(2);
    if (IN(3)) { phase3_qknorm(F); PH3_BODY REP(3) PH3_BODY }
    SEAM(3);
    if (IN(4)) { PH4_BODY REP(4) PH4_BODY }
    SEAM(4);
    if (IN(5)) { PH5_BODY REP(5) PH5_BODY }
    SEAM(5);
    if (IN(6)) { PH6_BODY REP(6) PH6_BODY }
    SEAM(6);
    if (IN(7)) { phase_modnorm<false>(F, F.out, F.g2, 6144, 8192, (bf16_t*)(F.ws + WS_H2)); REP(7) { phase_modnorm<false>(F, F.out, F.g2, 6144, 8192, (bf16_t*)(F.ws + WS_H2)); } }
    SEAM(7);
    if (IN(8)) { PH8_BODY REP(8) PH8_BODY }
    SEAM(8);
    if (IN(9)) { PH9_BODY REP(9) PH9_BODY }
    SEAM(9);
    if (IN(10)) { phase10_peer(F); REP(10) phase10_peer(F); }
    SEAM(10);
    if (IN(11)) { REP(11) { phase11_peer_v(F, (float*)(F.ws + WS_SUB)); } phase11_peer_v(F, F.out); }
#undef IN
#undef SEAM
}

extern "C" void kernel_launch(void* const* d_in, const int* in_sizes, int n_in, void* d_out, int out_size, void* d_ws, size_t ws_size, hipStream_t stream) {
    static int grid = 0;
    if (grid == 0) {
        if (n_in != 19 || out_size != MTOK * DM || ws_size < WS_END) { fprintf(stderr, "kernel_launch: unexpected shapes (n_in %d out %d ws %zu)\n", n_in, out_size, ws_size); grid = -1; return; }
        int dev = 0, cus = 0, per_cu = 0;
        if (hipGetDevice(&dev) != hipSuccess || hipDeviceGetAttribute(&cus, hipDeviceAttributeMultiprocessorCount, dev) != hipSuccess) { grid = -1; return; }
        if (hipFuncSetAttribute((const void*)fwd_kernel, hipFuncAttributeMaxDynamicSharedMemorySize, LDS_BYTES) != hipSuccess) { fprintf(stderr, "kernel_launch: hipFuncSetAttribute failed\n"); grid = -1; return; }
        if (hipOccupancyMaxActiveBlocksPerMultiprocessor(&per_cu, (const void*)fwd_kernel, 512, LDS_BYTES) != hipSuccess || per_cu < 1) { fprintf(stderr, "kernel_launch: occupancy query says %d\n", per_cu); }
        (void)hipGetLastError();
        grid = cus;
    }
    if (grid < 0) return;
    (void)in_sizes;
    if (hipMemsetAsync((char*)d_ws + WS_CTL, 0, CTL_ZERO_BYTES, stream) != hipSuccess) return;
    Args a{};
    for (int i = 0; i < 19; ++i) a.in[i] = (const float*)d_in[i];
    a.out = (float*)d_out; a.ws = (unsigned char*)d_ws;
#if MK_PER_PHASE
    for (int p = 0; p < NPHASE; ++p) { a.ph_lo = p; a.ph_hi = p + 1; a.li = p; hipLaunchKernelGGL(fwd_kernel, dim3(grid), dim3(512), LDS_BYTES, stream, a); }
#else
    a.ph_lo = 0; a.ph_hi = NPHASE; a.li = 0;
    hipLaunchKernelGGL(fwd_kernel, dim3(grid), dim3(512), LDS_BYTES, stream, a);
#endif
}
```

```cpp
#include <hip/hip_runtime.h>
#include <cstdio>
#include <cstdint>

#ifndef MK_PER_PHASE
#define MK_PER_PHASE 0
#endif

#ifndef PROBE_REP
#define PROBE_REP 0
#endif
#ifndef PROBE_IDX
#define PROBE_IDX 0
#endif
#ifndef PROBE_SEL
#define PROBE_SEL 0
#endif
#ifndef PROBE_P11X
#define PROBE_P11X 0
#endif
#define LAS __attribute__((address_space(3)))
typedef unsigned short bf16_t;
typedef short bf16x8 __attribute__((ext_vector_type(8)));
typedef float f32x4 __attribute__((ext_vector_type(4)));
typedef float f32x2 __attribute__((ext_vector_type(2)));
typedef unsigned u32x4 __attribute__((ext_vector_type(4)));
typedef unsigned u32x2 __attribute__((ext_vector_type(2)));

constexpr int BATCH = 8, SEQ = 4096, DM = 2048, MTOK = BATCH * SEQ;
constexpr int NHEAD = 8, HDIM = 128, AW = 1024, KVW = 256, IHEADS = 16, IDIM = 64, KSEL = 256;
constexpr int PW = 1024, PHEADS = 8, NEXP = 16384;
constexpr int INW = 7760, INWP = 7936;
constexpr float EPS = 1e-6f;
constexpr int NPHASE = 12;

constexpr size_t MiB = 1u << 20;
constexpr size_t WS_CTL = 0, CTL_ZERO_BYTES = 256 * 1024;
constexpr size_t WS_MODP = 2 * MiB;
constexpr size_t WS_MODF = 4 * MiB;
constexpr size_t WS_POOLW = 5 * MiB;
constexpr size_t WS_KEYSBD = 6 * MiB;
constexpr size_t WS_WIN = 8 * MiB;
constexpr size_t WS_WAB = 40 * MiB, WS_WPB = 44 * MiB, WS_WOUT = 48 * MiB, WS_WPQ = 56 * MiB;
constexpr size_t WS_PU = 64 * MiB, WS_PV = 128 * MiB;
constexpr size_t WS_R0 = 192 * MiB;
constexpr size_t WS_GA = 320 * MiB, WS_GP = 448 * MiB;
constexpr size_t WS_SUB = 320 * MiB;
constexpr size_t WS_QN = 576 * MiB;
constexpr size_t WS_IQ = 640 * MiB;
constexpr size_t WS_PL = 704 * MiB;
constexpr size_t WS_KN = 768 * MiB, WS_V = 784 * MiB;
constexpr size_t WS_IK = 800 * MiB;
constexpr size_t WS_IW = 804 * MiB;
constexpr size_t WS_SEL = 806 * MiB;
constexpr size_t WS_POOLED = 822 * MiB;
constexpr size_t WS_H2 = 886 * MiB;
constexpr size_t WS_END = 1014 * MiB;
constexpr size_t WS_Q8 = WS_H2, WS_K8 = WS_H2 + 32 * MiB, WS_V8 = WS_H2 + 40 * MiB;
constexpr size_t WS_ATTN = WS_IQ, WS_POOL2 = WS_PL, WS_PAIRS = WS_QN, WS_WLS = WS_QN + 32 * MiB;

constexpr int LDS_BYTES = 160 * 1024;
constexpr int MISC_OFF = 159 * 1024;

__device__ __forceinline__ unsigned cvt_pk_bf16(float lo, float hi) { unsigned r; asm volatile("v_cvt_pk_bf16_f32 %0, %1, %2" : "=v"(r) : "v"(lo), "v"(hi)); return r; }
__device__ __forceinline__ float bf_lo(unsigned w) { return __uint_as_float(w << 16); }
__device__ __forceinline__ float bf_hi(unsigned w) { return __uint_as_float(w & 0xffff0000u); }
template <int CTRL> __device__ __forceinline__ float dpp_f(float x) { return __int_as_float(__builtin_amdgcn_update_dpp(0, __float_as_int(x), CTRL, 0xF, 0xF, true)); }
#define DPP_XOR1 0xB1
#define DPP_XOR2 0x4E
#define DPP_HMIRROR 0x141
#define DPP_MIRROR 0x140
#define DPP_ROR8 0x128
__device__ __forceinline__ float xor16_sum(float x) { const auto r = __builtin_amdgcn_permlane16_swap(__float_as_uint(x), __float_as_uint(x), false, false); return __uint_as_float(r[0]) + __uint_as_float(r[1]); }
__device__ __forceinline__ float xor32_sum(float x) { const auto r = __builtin_amdgcn_permlane32_swap(__float_as_uint(x), __float_as_uint(x), false, false); return __uint_as_float(r[0]) + __uint_as_float(r[1]); }
__device__ __forceinline__ float xor16_max(float x) { const auto r = __builtin_amdgcn_permlane16_swap(__float_as_uint(x), __float_as_uint(x), false, false); return fmaxf(__uint_as_float(r[0]), __uint_as_float(r[1])); }
__device__ __forceinline__ float swap32_pair(float a, float b) { const auto r = __builtin_amdgcn_permlane32_swap(__float_as_uint(a), __float_as_uint(b), false, false); return __uint_as_float(r[0]) + __uint_as_float(r[1]); }
__device__ __forceinline__ float swap16_pair(float a, float b) { const auto r = __builtin_amdgcn_permlane16_swap(__float_as_uint(a), __float_as_uint(b), false, false); return __uint_as_float(r[0]) + __uint_as_float(r[1]); }
__device__ __forceinline__ float row_sum16(float v) { v += dpp_f<DPP_XOR1>(v); v += dpp_f<DPP_XOR2>(v); v += dpp_f<DPP_HMIRROR>(v); v += dpp_f<DPP_MIRROR>(v); return v; }
__device__ __forceinline__ float row_max16(float v) { v = fmaxf(v, dpp_f<DPP_XOR1>(v)); v = fmaxf(v, dpp_f<DPP_XOR2>(v)); v = fmaxf(v, dpp_f<DPP_HMIRROR>(v)); v = fmaxf(v, dpp_f<DPP_MIRROR>(v)); return v; }
__device__ __forceinline__ float wave_sum(float v) { return xor32_sum(xor16_sum(row_sum16(v))); }
__device__ __forceinline__ float sigmoidf_(float x) { return __builtin_amdgcn_rcpf(1.0f + __expf(-x)); }
__device__ __forceinline__ float dot8(u32x4 w, const float* h) {
    return bf_lo(w.x) * h[0] + bf_hi(w.x) * h[1] + bf_lo(w.y) * h[2] + bf_hi(w.y) * h[3] + bf_lo(w.z) * h[4] + bf_hi(w.z) * h[5] + bf_lo(w.w) * h[6] + bf_hi(w.w) * h[7];
}

#define XB_TMO      128
#define XB_XCNT(j)  (256  + 64 * (j))
#define XB_XSUB(j)  (1280 + 64 * (j))
#define XB_XGEN(j)  (2304 + 64 * (j))
#define XB_TOP      3328
#define XB_TOPGEN   3392
#define XCD_BAR_WORDS 3456
#define XB_SPIN_CAP (1u << 18)

__device__ __forceinline__ unsigned xb_ld(unsigned* p)              { return __hip_atomic_load(p, __ATOMIC_RELAXED, __HIP_MEMORY_SCOPE_AGENT); }
__device__ __forceinline__ unsigned xb_add(unsigned* p, unsigned v) { return __hip_atomic_fetch_add(p, v, __ATOMIC_RELAXED, __HIP_MEMORY_SCOPE_AGENT); }
__device__ __forceinline__ unsigned xb_xcc_id() { return (unsigned)__builtin_amdgcn_s_getreg((3 << 11) | 20) & 0xFu; }
#define XB_SPIN(cond, bar) do { unsigned _sp = 0; while (cond) { __builtin_amdgcn_s_sleep(1); \
    if ((++_sp & 255u) == 0u) { if (xb_ld(&(bar)[XB_TMO])) break; if (_sp > XB_SPIN_CAP) { atomicAdd(&(bar)[XB_TMO], 1u); break; } } } } while (0)

struct XcdBarrier { unsigned* bar; unsigned x; volatile LAS unsigned* st; };

__device__ __forceinline__ XcdBarrier xcd_barrier_post(unsigned* bar, volatile LAS unsigned* st) {
    XcdBarrier b; b.bar = bar; b.x = xb_xcc_id(); b.st = st;
    if (threadIdx.x == 0) (void)xb_add(&bar[XB_XCNT(b.x)], 1u);
    return b;
}
__device__ __forceinline__ void xcd_barrier_complete(unsigned* bar, unsigned x, unsigned& nloc, unsigned& nx) {
    const unsigned G = gridDim.x * gridDim.y * gridDim.z;
    unsigned sum, cnt, mine, sp = 0u;
    for (;;) {
        sum = 0u; cnt = 0u; mine = 0u;
#pragma unroll
        for (unsigned j = 0; j < 16; ++j) { const unsigned c = xb_ld(&bar[XB_XCNT(j)]); sum += c; cnt += (c > 0u) ? 1u : 0u; mine = (j == x) ? c : mine; }
        if (sum == G) break;
        __builtin_amdgcn_s_sleep(1);
        if ((++sp & 255u) == 0u) { if (xb_ld(&bar[XB_TMO])) break; if (sp > XB_SPIN_CAP) { atomicAdd(&bar[XB_TMO], 1u); break; } }
    }
    nloc = mine > 0u ? mine : 1u; nx = cnt > 0u ? cnt : 1u;
}
__device__ __forceinline__ void xcd_barrier(const XcdBarrier& b) {
    asm volatile("s_waitcnt vmcnt(0)" ::: "memory");
    __syncthreads();
    if (threadIdx.x == 0) {
        unsigned* bar = b.bar;
        __builtin_amdgcn_s_waitcnt(0);
        unsigned nloc = b.st[0], nx = b.st[1];
        if (nloc == 0u) { xcd_barrier_complete(bar, b.x, nloc, nx); b.st[0] = nloc; b.st[1] = nx; }
        const unsigned old = xb_add(&bar[XB_XSUB(b.x)], 1u);
        const unsigned gen = old / nloc;
        if (old + 1u == (gen + 1u) * nloc) {
            __builtin_amdgcn_fence(__ATOMIC_RELEASE, "agent");
            asm volatile("s_waitcnt vmcnt(0)" ::: "memory");
            const unsigned og = xb_add(&bar[XB_TOP], 1u);
            const unsigned tg = og / nx;
            if (og + 1u == (tg + 1u) * nx) xb_add(&bar[XB_TOPGEN], 1u);
            else XB_SPIN(xb_ld(&bar[XB_TOPGEN]) == tg, bar);
            __builtin_amdgcn_fence(__ATOMIC_ACQUIRE, "agent");
            xb_add(&bar[XB_XGEN(b.x)], 1u);
            asm volatile("s_waitcnt vmcnt(0)" ::: "memory");
        } else {
            XB_SPIN(xb_ld(&bar[XB_XGEN(b.x)]) == gen, bar);
            __builtin_amdgcn_fence(__ATOMIC_ACQUIRE, "agent");
            asm volatile("s_waitcnt vmcnt(0)" ::: "memory");
        }
    }
    __syncthreads();
}

namespace pg8 {
constexpr int BM = 256, BK = 64, HALF = 128, HTB = HALF * BK * 2, STAGE_BYTES = 8 * HTB, NXCD = 8, WGM = 8;
__device__ __forceinline__ int lds_byte(int r, int c) { const int st = (r >> 4) * 2 + (c >> 5), rr = r & 15, cc = c & 31, ob = rr * 64 + cc * 2; return st * 1024 + (ob ^ (((ob >> 9) & 1) << 5)); }
__device__ __forceinline__ void stage_rc(int b, int& R, int& C) { const int st = b / 1024, sb = b % 1024, swz = sb ^ (((sb >> 9) & 1) << 5); R = (st >> 1) * 16 + swz / 64; C = (st & 1) * 32 + (swz % 64) / 2; }
__device__ __forceinline__ int perm32(int rho) { const int n = rho >> 4, i = rho & 15; return 8 * (i >> 2) + 4 * n + (i & 3); }

struct Unit { int pm, pn; };
struct Gemm { const bf16_t* A; const bf16_t* Bt; int M, N, K, lda, a_pn_off; const bf16_t* A2; const bf16_t* Bt2; int ksplit, ldb; };

struct StaticOrder {
    int nM, nN, nwg, G, c;
    __device__ void init(int M, int N, int G_, int c_) { nM = M / BM; nN = N / BM; nwg = nM * nN; G = G_; c = c_; }
    __device__ bool next(int i, Unit& u) const {
        const long L = (long)i * G + c; if (L >= nwg) return false;
        int wgid = (int)L; { const int q = nwg / NXCD, r = nwg % NXCD, xcd = wgid % NXCD, off = wgid / NXCD; wgid = (xcd < r ? xcd * (q + 1) : r * (q + 1) + (xcd - r) * q) + off; }
        const int nig = WGM * nN, gid = wgid / nig, fm = gid * WGM, gsz = (nM - fm) < WGM ? (nM - fm) : WGM;
        u.pm = fm + ((wgid % nig) % gsz); u.pn = (wgid % nig) / gsz; return true;
    }
};

template <class Epi>
__device__ __forceinline__ void gemm_phase(LAS unsigned char* lds, const Gemm g, const StaticOrder& S, const Epi& E) {
    const int tid = threadIdx.x, wid = __builtin_amdgcn_readfirstlane(tid >> 6), lane = tid & 63, wr = wid >> 2, wc = wid & 3, fr = lane & 15, fq = lane >> 4;
    const int K = g.K, nt = K / BK, lda = g.lda, ldb = g.ldb ? g.ldb : g.K, ksplit = g.ksplit;
    unsigned voffA[2], voffB[2];
#pragma unroll
    for (int i = 0; i < 2; ++i) { int R, C; stage_rc(tid * 16 + i * 8192, R, C); const int Rb = Epi::PERM ? ((R & ~31) + perm32(R & 31)) : R;
        voffA[i] = (unsigned)(R * lda + C) * 2u; voffB[i] = (unsigned)(Rb * ldb + C) * 2u; }
    const size_t kstep = (size_t)(BK * 2);
    const size_t hsA = (size_t)HALF * lda * 2, hsB = (size_t)HALF * ldb * 2;
    const size_t tsA = 2 * hsA, tsB = 2 * hsB;
    const unsigned ldsw = (unsigned)wid * 1024u;
    const int aoff = lds_byte(wr * 64 + fr, fq * 8), boff = lds_byte(wc * 32 + fr, fq * 8);
#define PG8_SA(b, h) (((b) * 2 + (h)) * HTB)
#define PG8_SB(b, h) ((4 + (b) * 2 + (h)) * HTB)
#define PG8_STAGE(bufoff, gbase, voff) do { _Pragma("unroll") for (int _i = 0; _i < 2; ++_i) \
        __builtin_amdgcn_global_load_lds((const unsigned*)((const char*)(gbase) + (voff)[_i]), (LAS unsigned*)(lds + (bufoff) + ldsw + _i * 8192), 16, 0, 0); } while (0)
#define PG8_LDA(dst, b, h) do { _Pragma("unroll") for (int m = 0; m < 4; ++m) _Pragma("unroll") for (int k = 0; k < 2; ++k) dst[m][k] = *(const LAS bf16x8*)(lds + PG8_SA(b, h) + aoff + m * 2048 + k * 1024); } while (0)
#define PG8_LDB(dst, b, h) do { _Pragma("unroll") for (int n = 0; n < 2; ++n) _Pragma("unroll") for (int k = 0; k < 2; ++k) dst[n][k] = *(const LAS bf16x8*)(lds + PG8_SB(b, h) + boff + n * 2048 + k * 1024); } while (0)
#define PG8_MMA(ai, bj, At, Bt) do { __builtin_amdgcn_s_setprio(1); _Pragma("unroll") for (int m = 0; m < 4; ++m) _Pragma("unroll") for (int n = 0; n < 2; ++n) _Pragma("unroll") for (int k = 0; k < 2; ++k) \
        acc[ai][bj][m][n] = __builtin_amdgcn_mfma_f32_16x16x32_bf16(Bt[n][k], At[m][k], acc[ai][bj][m][n], 0, 0, 0); __builtin_amdgcn_s_setprio(0); } while (0)
#define PG8_WAIT_V(n) asm volatile("s_waitcnt vmcnt(" #n ")" ::: "memory")
#define PG8_WAIT_L(n) asm volatile("s_waitcnt lgkmcnt(" #n ")" ::: "memory")
#define PG8_BAR __builtin_amdgcn_s_barrier()
#define PG8_SCHED __builtin_amdgcn_sched_barrier(0)
    Unit cur, nxt; int ui = 0;
    if (!S.next(0, cur)) return;
    f32x4 acc[2][2][4][2];
#pragma unroll
    for (int a = 0; a < 2; ++a)
#pragma unroll
        for (int b = 0; b < 2; ++b)
#pragma unroll
            for (int m = 0; m < 4; ++m)
#pragma unroll
                for (int n = 0; n < 2; ++n) acc[a][b][m][n] = (f32x4){0.f, 0.f, 0.f, 0.f};
    bf16x8 At[4][2], B0[2][2], B1[2][2];
    const char* cA = (const char*)g.A + (size_t)cur.pm * tsA + (size_t)cur.pn * g.a_pn_off * 2; const char* cB = (const char*)g.Bt + (size_t)cur.pn * tsB;
    PG8_STAGE(PG8_SB(0, 0), cB, voffB); PG8_STAGE(PG8_SB(0, 1), cB + hsB, voffB); PG8_STAGE(PG8_SA(0, 0), cA, voffA); PG8_STAGE(PG8_SA(0, 1), cA + hsA, voffA);
    if (wr == 1) PG8_BAR;
    PG8_WAIT_V(2); PG8_BAR;
    PG8_STAGE(PG8_SB(1, 0), cB + kstep, voffB); PG8_STAGE(PG8_SA(1, 0), cA + kstep, voffA); PG8_STAGE(PG8_SB(1, 1), cB + hsB + kstep, voffB);
    PG8_WAIT_V(6); PG8_BAR;
    for (;;) {
        const bool has_next = S.next(ui + 1, nxt);
        const char* nA = has_next ? (const char*)g.A + (size_t)nxt.pm * tsA + (size_t)nxt.pn * g.a_pn_off * 2 : cA; const char* nB = has_next ? (const char*)g.Bt + (size_t)nxt.pn * tsB : cB;
        const char* cA2 = (const char*)g.A2 + (size_t)cur.pm * tsA; const char* cB2 = (const char*)g.Bt2 + (size_t)cur.pn * tsB;
        for (int t = 0; t < nt; t += 2) {
            const bool last = (t == nt - 2);
            const bool s1 = ksplit && (t >= ksplit), s2 = ksplit && (t + 2 >= ksplit);
            const char* a1 = (s1 ? cA2 + (size_t)(t - ksplit + 1) * kstep : cA + (size_t)(t + 1) * kstep);
            const char* a2 = last ? nA : (s2 ? cA2 + (size_t)(t + 2 - ksplit) * kstep : cA + (size_t)(t + 2) * kstep);
            const char* b2 = last ? nB : (s2 ? cB2 + (size_t)(t + 2 - ksplit) * kstep : cB + (size_t)(t + 2) * kstep);
            const char* a3 = a2 + kstep; const char* b3 = b2 + kstep;
            PG8_LDB(B0, 0, 0); PG8_LDB(B1, 0, 1); PG8_SCHED; PG8_LDA(At, 0, 0); PG8_STAGE(PG8_SA(1, 1), a1 + hsA, voffA);
            PG8_WAIT_V(8); PG8_WAIT_L(0); PG8_BAR; PG8_MMA(0, 0, At, B0); PG8_MMA(0, 1, At, B1); PG8_BAR; PG8_SCHED;
            PG8_LDA(At, 0, 1); PG8_STAGE(PG8_SB(0, 0), b2, voffB); PG8_STAGE(PG8_SB(0, 1), b2 + hsB, voffB); PG8_STAGE(PG8_SA(0, 0), a2, voffA);
            PG8_WAIT_V(8); PG8_WAIT_L(0); PG8_BAR; PG8_MMA(1, 0, At, B0); PG8_MMA(1, 1, At, B1); PG8_BAR; PG8_SCHED;
            PG8_LDB(B0, 1, 0); PG8_LDB(B1, 1, 1); PG8_SCHED; PG8_LDA(At, 1, 0); PG8_STAGE(PG8_SA(0, 1), a2 + hsA, voffA);
            PG8_WAIT_V(8); PG8_WAIT_L(0); PG8_BAR; PG8_MMA(0, 0, At, B0); PG8_MMA(0, 1, At, B1); PG8_BAR; PG8_SCHED;
            PG8_LDA(At, 1, 1); PG8_STAGE(PG8_SB(1, 0), b3, voffB); PG8_STAGE(PG8_SB(1, 1), b3 + hsB, voffB); PG8_STAGE(PG8_SA(1, 0), a3, voffA);
            PG8_WAIT_V(8); PG8_WAIT_L(0); PG8_BAR; PG8_MMA(1, 0, At, B0); PG8_MMA(1, 1, At, B1); PG8_BAR; PG8_SCHED;
            if constexpr (Epi::MID) { if (t + 2 == ksplit) E.mid(acc, cur, wr, wc, fr, fq); }
        }
        if (wr == 0) PG8_BAR;
        E(acc, cur, wr, wc, fr, fq);
        if (!has_next) break;
#pragma unroll
        for (int a = 0; a < 2; ++a)
#pragma unroll
            for (int b = 0; b < 2; ++b)
#pragma unroll
                for (int m = 0; m < 4; ++m)
#pragma unroll
                    for (int n = 0; n < 2; ++n) acc[a][b][m][n] = (f32x4){0.f, 0.f, 0.f, 0.f};
        cur = nxt; cA = nA; cB = nB; ++ui;
        if (wr == 1) PG8_BAR;
    }
    PG8_WAIT_V(0);
    PG8_BAR;
#undef PG8_SA
#undef PG8_SB
#undef PG8_STAGE
#undef PG8_LDA
#undef PG8_LDB
#undef PG8_MMA
#undef PG8_WAIT_V
#undef PG8_WAIT_L
#undef PG8_BAR
#undef PG8_SCHED
}
}
using pg8::Unit;

typedef f32x4 AccT[2][2][4][2];
__device__ __forceinline__ u32x4 pack8(f32x4 a, f32x4 b) { u32x4 w; w.x = cvt_pk_bf16(a[0], a[1]); w.y = cvt_pk_bf16(a[2], a[3]); w.z = cvt_pk_bf16(b[0], b[1]); w.w = cvt_pk_bf16(b[2], b[3]); return w; }
__device__ __forceinline__ void unpack8(u32x4 w, f32x4& a, f32x4& b) { a = (f32x4){bf_lo(w.x), bf_hi(w.x), bf_lo(w.y), bf_hi(w.y)}; b = (f32x4){bf_lo(w.z), bf_hi(w.z), bf_lo(w.w), bf_hi(w.w)}; }

struct EpiInproj {
    static constexpr bool PERM = true, MID = false;
    bf16_t *q, *k, *v, *iq, *ik, *pl, *ga, *gp; float* iw;
    __device__ __forceinline__ void operator()(const AccT& acc, const Unit& u, int wr, int wc, int fr, int fq) const {
        const int pn = u.pn, row0 = u.pm * 256 + wr * 64 + fr;
        if (pn == 10) {
            if (wc < 2) {
#pragma unroll
                for (int ai = 0; ai < 2; ++ai)
#pragma unroll
                    for (int m = 0; m < 4; ++m) { const size_t row = (size_t)(row0 + ai * 128 + m * 16);
                        *(u32x4*)(ik + row * 64 + wc * 32 + 8 * fq) = pack8(acc[ai][0][m][0], acc[ai][0][m][1]); }
            } else if (wc == 2) {
                if (fq < 2) {
#pragma unroll
                    for (int ai = 0; ai < 2; ++ai)
#pragma unroll
                        for (int m = 0; m < 4; ++m) { const size_t row = (size_t)(row0 + ai * 128 + m * 16);
                            *(f32x4*)(iw + row * 16 + 8 * fq) = acc[ai][0][m][0]; *(f32x4*)(iw + row * 16 + 8 * fq + 4) = acc[ai][0][m][1]; }
                }
            }
            return;
        }
        bf16_t* dst; int ld, tc; bool sg = false;
        if (pn < 4) { dst = q; ld = 1024; tc = pn * 256; }
        else if (pn == 4) { dst = k; ld = 256; tc = 0; }
        else if (pn == 5) { dst = v; ld = 256; tc = 0; }
        else if (pn < 10) { dst = iq; ld = 1024; tc = (pn - 6) * 256; }
        else if (pn < 15) { dst = pl; ld = 1024; tc = (pn - 11) * 256; }
        else if (pn < 23) { dst = ga; ld = 2048; tc = (pn - 15) * 256; sg = true; }
        else { dst = gp; ld = 2048; tc = (pn - 23) * 256; sg = true; }
        const int col0 = tc + wc * 32 + 8 * fq;
#pragma unroll
        for (int ai = 0; ai < 2; ++ai)
#pragma unroll
            for (int m = 0; m < 4; ++m) { bf16_t* rowp = dst + (size_t)(row0 + ai * 128 + m * 16) * ld + col0;
#pragma unroll
                for (int bj = 0; bj < 2; ++bj) { f32x4 v0 = acc[ai][bj][m][0], v1 = acc[ai][bj][m][1];
                    if (sg) {
#pragma unroll
                        for (int j = 0; j < 4; ++j) { v0[j] = sigmoidf_(v0[j]); v1[j] = sigmoidf_(v1[j]); } }
                    *(u32x4*)(rowp + bj * 128) = pack8(v0, v1); } }
    }
};
struct EpiBf16Scale {
    static constexpr bool PERM = true, MID = false;
    bf16_t* O; int ldc; const float* cs;
    __device__ __forceinline__ void operator()(const AccT& acc, const Unit& u, int wr, int wc, int fr, int fq) const {
        const int row0 = u.pm * 256 + wr * 64 + fr, col0 = u.pn * 256 + wc * 32 + 8 * fq;
        f32x4 s[2][2];
#pragma unroll
        for (int bj = 0; bj < 2; ++bj)
#pragma unroll
            for (int n = 0; n < 2; ++n) s[bj][n] = cs ? *(const f32x4*)(cs + col0 + bj * 128 + 4 * n) : (f32x4){1.f, 1.f, 1.f, 1.f};
#pragma unroll
        for (int ai = 0; ai < 2; ++ai)
#pragma unroll
            for (int m = 0; m < 4; ++m) { bf16_t* rowp = O + (size_t)(row0 + ai * 128 + m * 16) * ldc + col0;
#pragma unroll
                for (int bj = 0; bj < 2; ++bj) *(u32x4*)(rowp + bj * 128) = pack8(acc[ai][bj][m][0] * s[bj][0], acc[ai][bj][m][1] * s[bj][1]); }
    }
};
template <bool ADD> struct EpiGate {
    static constexpr bool PERM = true, MID = false;
    bf16_t* O; const bf16_t* gate;
    __device__ __forceinline__ void operator()(const AccT& acc, const Unit& u, int wr, int wc, int fr, int fq) const {
        const int row0 = u.pm * 256 + wr * 64 + fr, col0 = u.pn * 256 + wc * 32 + 8 * fq;
#pragma unroll
        for (int ai = 0; ai < 2; ++ai)
#pragma unroll
            for (int m = 0; m < 4; ++m) { const size_t off = (size_t)(row0 + ai * 128 + m * 16) * 2048 + col0;
#pragma unroll
                for (int bj = 0; bj < 2; ++bj) { f32x4 g0, g1; unpack8(*(const u32x4*)(gate + off + bj * 128), g0, g1);
                    f32x4 r0 = g0 * acc[ai][bj][m][0], r1 = g1 * acc[ai][bj][m][1];
                    if (ADD) { f32x4 o0, o1; unpack8(*(const u32x4*)(O + off + bj * 128), o0, o1); r0 += o0; r1 += o1; }
                    *(u32x4*)(O + off + bj * 128) = pack8(r0, r1); } }
    }
};
struct EpiMerge {
    static constexpr bool PERM = true, MID = true;
    bf16_t* O; const bf16_t* ga; const bf16_t* gp;
    __device__ __forceinline__ void mid(AccT& acc, const Unit& u, int wr, int wc, int fr, int fq) const {
        const auto ra = __builtin_amdgcn_make_buffer_rsrc((void*)ga, 0, 0x7FFFFFFF, 0x00020000), rp = __builtin_amdgcn_make_buffer_rsrc((void*)gp, 0, 0x7FFFFFFF, 0x00020000);
        const int voff = ((wr * 64 + fr) * 2048 + wc * 32 + 8 * fq) * 2;
        const int sbase = (u.pm * 256 * 2048 + u.pn * 256) * 2;
#pragma unroll
        for (int ai = 0; ai < 2; ++ai)
#pragma unroll
            for (int m = 0; m < 4; ++m)
#pragma unroll
                for (int bj = 0; bj < 2; ++bj) { const int so = sbase + ((ai * 128 + m * 16) * 2048 + bj * 128) * 2;
                    const u32x4 wa = __builtin_bit_cast(u32x4, __builtin_amdgcn_raw_buffer_load_b128(ra, voff, so, 0)), wp = __builtin_bit_cast(u32x4, __builtin_amdgcn_raw_buffer_load_b128(rp, voff, so, 0));
                    f32x4 a0, a1, p0, p1; unpack8(wa, a0, a1); unpack8(wp, p0, p1);
#pragma unroll
                    for (int j = 0; j < 4; ++j) { acc[ai][bj][m][0][j] *= a0[j] * __builtin_amdgcn_rcpf(p0[j]); acc[ai][bj][m][1][j] *= a1[j] * __builtin_amdgcn_rcpf(p1[j]); }
                    asm volatile("" : "+v"(acc[ai][bj][m][0]), "+v"(acc[ai][bj][m][1]) :: "memory"); }
    }
    __device__ __forceinline__ void operator()(const AccT& acc, const Unit& u, int wr, int wc, int fr, int fq) const {
        const int row0 = u.pm * 256 + wr * 64 + fr, col0 = u.pn * 256 + wc * 32 + 8 * fq;
#pragma unroll
        for (int ai = 0; ai < 2; ++ai)
#pragma unroll
            for (int m = 0; m < 4; ++m) { const size_t off = (size_t)(row0 + ai * 128 + m * 16) * 2048 + col0;
#pragma unroll
                for (int bj = 0; bj < 2; ++bj) { f32x4 p0, p1; unpack8(*(const u32x4*)(gp + off + bj * 128), p0, p1);
                    *(u32x4*)(O + off + bj * 128) = pack8(p0 * acc[ai][bj][m][0], p1 * acc[ai][bj][m][1]); } }
    }
};
struct EpiResid {
    static constexpr bool PERM = false, MID = false;
    const float* x; float* out; const float* gt;
    __device__ __forceinline__ void operator()(const AccT& acc, const Unit& u, int wr, int wc, int fr, int fq) const {
        const int row0 = u.pm * 256 + wr * 64 + fr, col0 = u.pn * 256 + wc * 32 + 4 * fq;
        const float* gtb = gt + (size_t)(u.pm / 16) * 12288;
        f32x4 g[2][2];
#pragma unroll
        for (int bj = 0; bj < 2; ++bj)
#pragma unroll
            for (int n = 0; n < 2; ++n) g[bj][n] = *(const f32x4*)(gtb + col0 + bj * 128 + n * 16);
#pragma unroll
        for (int ai = 0; ai < 2; ++ai)
#pragma unroll
            for (int m = 0; m < 4; ++m) { const size_t off = (size_t)(row0 + ai * 128 + m * 16) * 2048 + col0;
#pragma unroll
                for (int bj = 0; bj < 2; ++bj)
#pragma unroll
                    for (int n = 0; n < 2; ++n) { const f32x4 xv = *(const f32x4*)(x + off + bj * 128 + n * 16);
                        *(f32x4*)(out + off + bj * 128 + n * 16) = xv + g[bj][n] * acc[ai][bj][m][n]; } }
    }
};
struct EpiF32 {
    static constexpr bool PERM = false, MID = false;
    float* C; int ldc;
    __device__ __forceinline__ void operator()(const AccT& acc, const Unit& u, int wr, int wc, int fr, int fq) const {
        const int row0 = u.pm * 256 + wr * 64 + fr, col0 = u.pn * 256 + wc * 32 + 4 * fq;
#pragma unroll
        for (int ai = 0; ai < 2; ++ai)
#pragma unroll
            for (int m = 0; m < 4; ++m) { float* rowp = C + (size_t)(row0 + ai * 128 + m * 16) * ldc + col0;
#pragma unroll
                for (int bj = 0; bj < 2; ++bj)
#pragma unroll
                    for (int n = 0; n < 2; ++n) *(f32x4*)(rowp + bj * 128 + n * 16) = acc[ai][bj][m][n]; }
    }
};

struct Args { const float* in[19]; float* out; unsigned char* ws; int ph_lo, ph_hi; int li, pad; };
struct Frame {
    unsigned char* lds; unsigned char* ws;
    int tid, lane, wave, G, bid;
    const float *x, *c, *w_ada, *b_ada, *g1, *g2, *w_in, *g_q, *g_k, *rel_bias, *pool_w, *pool_scale, *w_ab, *w_pb, *w_out, *w_pq, *peer_keys, *peer_u, *peer_v;
    float* out;
};

template <class Fn> __device__ __forceinline__ void transpose_item(const float* W, int K, int N, bf16_t* WT, int ldk, int drow0, int k0, float* scr, int lane, Fn srccol) {
    const int sc = srccol(drow0 + (lane & 31));
#pragma unroll 8
    for (int i = 0; i < 32; ++i) { const int kk = 2 * i + (lane >> 5); scr[kk * 33 + (lane & 31)] = sc >= 0 ? W[(size_t)(k0 + kk) * N + sc] : 0.f; }
    asm volatile("s_waitcnt lgkmcnt(0)" ::: "memory");
    const int c = lane & 7;
#pragma unroll
    for (int j = 0; j < 4; ++j) { const int n = (lane >> 3) + 8 * j; const float* s = scr + (8 * c) * 33 + n;
        u32x4 o; o.x = cvt_pk_bf16(s[0 * 33], s[1 * 33]); o.y = cvt_pk_bf16(s[2 * 33], s[3 * 33]); o.z = cvt_pk_bf16(s[4 * 33], s[5 * 33]); o.w = cvt_pk_bf16(s[6 * 33], s[7 * 33]);
        *(u32x4*)(WT + (size_t)(drow0 + n) * ldk + k0 + 8 * c) = o; }
    asm volatile("s_waitcnt lgkmcnt(0)" ::: "memory");
}
__device__ __forceinline__ void phase0_prep(Frame& F) {
    const int gw = F.bid * 8 + F.wave, NGW = F.G * 8;
    float* scr = (float*)(F.lds + F.wave * 16384);
    constexpr int I_IN = (INWP / 32) * (DM / 64);
    constexpr int I_AB = (2048 / 32) * (1024 / 64), I_OUT = (2048 / 32) * (2048 / 64), I_PW = 4 * 8 * 4;
    constexpr int NIT = I_IN + 2 * I_AB + 2 * I_OUT + I_PW;
    auto ident = [](int j) { return j; };
    for (int it = gw; it < NIT; it += NGW) {
        int r = it;
        if (r < I_IN) { const int nb = r % (INWP / 32), kb = r / (INWP / 32);
            transpose_item(F.w_in, DM, INW, (bf16_t*)(F.ws + WS_WIN), DM, nb * 32, kb * 64, scr, F.lane, [](int j) { return j < 2640 ? j : (j < 2816 ? -1 : j - 176); }); continue; }
        r -= I_IN;
        if (r < I_AB) { transpose_item(F.w_ab, 1024, 2048, (bf16_t*)(F.ws + WS_WAB), 1024, (r % 64) * 32, (r / 64) * 64, scr, F.lane, ident); continue; }
        r -= I_AB;
        if (r < I_AB) { transpose_item(F.w_pb, 1024, 2048, (bf16_t*)(F.ws + WS_WPB), 1024, (r % 64) * 32, (r / 64) * 64, scr, F.lane, ident); continue; }
        r -= I_AB;
        if (r < I_OUT) { transpose_item(F.w_out, 2048, 2048, (bf16_t*)(F.ws + WS_WOUT), 2048, (r % 64) * 32, (r / 64) * 64, scr, F.lane, ident); continue; }
        r -= I_OUT;
        if (r < I_OUT) { transpose_item(F.w_pq, 2048, 2048, (bf16_t*)(F.ws + WS_WPQ), 2048, (r % 64) * 32, (r / 64) * 64, scr, F.lane, ident); continue; }
        r -= I_OUT;
        { const int g = r / 32, q = r % 32, nb = q % 8, kb = q / 8;
          transpose_item(F.pool_w + (size_t)g * 65536, 256, 256, (bf16_t*)(F.ws + WS_POOLW) + (size_t)g * 65536, 256, nb * 32, kb * 64, scr, F.lane, ident); }
    }
    {
        bf16_t* kb = (bf16_t*)(F.ws + WS_KEYSBD);
        for (int i = F.bid * 512 + F.tid; i < 2048 * 32; i += F.G * 512) {
            const int row = i / 32, k8 = (i % 32) * 8, p = (row >> 7) & 1;
            u32x4 o = (u32x4){0u, 0u, 0u, 0u};
            if ((k8 >> 7) == p) { const float* s = F.peer_keys + (size_t)row * 128 + (k8 & 127); const f32x4 a = *(const f32x4*)s, b = *(const f32x4*)(s + 4); o = pack8(a, b); }
            *(u32x4*)(kb + (size_t)row * 256 + k8) = o;
        }
    }
    {
        const size_t n16 = (size_t)NEXP * DM / 16;
        unsigned char* pu = F.ws + WS_PU;
        for (size_t i = (size_t)F.bid * 512 + F.tid; i < n16; i += (size_t)F.G * 512) {
            u32x4 ou;
#pragma unroll
            for (int k = 0; k < 4; ++k) { const f32x4 a = *(const f32x4*)(F.peer_u + i * 16 + k * 4) * 64.0f;
                int wu = __builtin_amdgcn_cvt_pk_fp8_f32(a[0], a[1], 0, false); wu = __builtin_amdgcn_cvt_pk_fp8_f32(a[2], a[3], wu, true); ou[k] = (unsigned)wu; }
            *(u32x4*)(pu + i * 16) = ou;
        }
        unsigned char* pv = F.ws + WS_PV;
        for (int it = gw; it < (NEXP / 64) * 128; it += NGW) {
            const int e = (it >> 7) * 64 + F.lane, ch = it & 127;
            u32x4 ov;
#pragma unroll
            for (int k = 0; k < 4; ++k) { const f32x4 c = *(const f32x4*)(F.peer_v + (size_t)e * DM + ch * 16 + k * 4) * 4.0f;
                int wv = __builtin_amdgcn_cvt_pk_fp8_f32(c[0], c[1], 0, false); wv = __builtin_amdgcn_cvt_pk_fp8_f32(c[2], c[3], wv, true); ov[k] = (unsigned)wv; }
            *(u32x2*)(pv + ((size_t)(2 * ch) * NEXP + e) * 8) = (u32x2){ov[0], ov[1]};
            *(u32x2*)(pv + ((size_t)(2 * ch + 1) * NEXP + e) * 8) = (u32x2){ov[2], ov[3]};
        }
    }
    {
        __syncthreads();
        float* cact = (float*)(F.lds + 131072);
        float* red = (float*)F.lds;
        float* mp = (float*)(F.ws + WS_MODP);
        for (int it = F.bid; it < 48 * 4; it += F.G) {
            const int cb = it % 48, ds = it / 48, d0 = ds * 512;
            for (int i = F.tid; i < 8 * 512; i += 512) { const int b = i >> 9, d = i & 511; const float cv = F.c[b * DM + d0 + d]; cact[i] = cv * sigmoidf_(cv); }
            __syncthreads();
            f32x4 a[8];
#pragma unroll
            for (int b = 0; b < 8; ++b) a[b] = (f32x4){0.f, 0.f, 0.f, 0.f};
            const float* wp = F.w_ada + (size_t)(d0 + F.wave * 64) * 12288 + cb * 256 + F.lane * 4;
#pragma unroll 4
            for (int d = 0; d < 64; ++d) { const f32x4 w = *(const f32x4*)(wp + (size_t)d * 12288);
#pragma unroll
                for (int b = 0; b < 8; ++b) a[b] += w * cact[b * 512 + F.wave * 64 + d]; }
#pragma unroll
            for (int b = 0; b < 8; ++b)
#pragma unroll
                for (int j = 0; j < 4; ++j) red[(F.wave * 32 + b * 4 + j) * 64 + F.lane] = a[b][j];
            __syncthreads();
            for (int i = F.tid; i < 2048; i += 512) { const int v = i >> 6, l = i & 63; float s = 0.f;
#pragma unroll
                for (int w = 0; w < 8; ++w) s += red[(w * 32 + v) * 64 + l];
                mp[((size_t)ds * 8 + (v >> 2)) * 12288 + cb * 256 + l * 4 + (v & 3)] = s; }
            __syncthreads();
        }
    }
}

template <bool FIRST> __device__ __forceinline__ void phase_modnorm(Frame& F, const float* xin, const float* gain, int off_sh, int off_sc, bf16_t* dst) {
    const float* mp = (const float*)(F.ws + WS_MODP); float* mf = (float*)(F.ws + WS_MODF);
    if (FIRST) {
        for (int i = F.bid * 512 + F.tid; i < 8 * 12288; i += F.G * 512) {
            float s = F.b_ada[i % 12288];
#pragma unroll
            for (int k = 0; k < 4; ++k) s += mp[(size_t)k * 8 * 12288 + i];
            mf[i] = s; }
    }
    float* cA = (float*)F.lds; float* cB = cA + 2048;
    for (int ch = F.bid; ch < MTOK / 128; ch += F.G) {
        const int b = ch / 32;
        __syncthreads();
        for (int col = F.tid; col < 2048; col += 512) {
            float sc, sh;
            if (FIRST) { sc = F.b_ada[off_sc + col]; sh = F.b_ada[off_sh + col];
#pragma unroll
                for (int k = 0; k < 4; ++k) { sc += mp[((size_t)k * 8 + b) * 12288 + off_sc + col]; sh += mp[((size_t)k * 8 + b) * 12288 + off_sh + col]; } }
            else { sc = mf[b * 12288 + off_sc + col]; sh = mf[b * 12288 + off_sh + col]; }
            cA[col] = gain[col] * (1.f + sc); cB[col] = sh; }
        __syncthreads();
        for (int r = F.wave; r < 128; r += 8) {
            const size_t row = (size_t)ch * 128 + r;
            const float* xr = xin + row * 2048 + F.lane * 8;
            f32x4 v[4][2]; float ss = 0.f;
#pragma unroll
            for (int i = 0; i < 4; ++i) { v[i][0] = *(const f32x4*)(xr + i * 512); v[i][1] = *(const f32x4*)(xr + i * 512 + 4);
#pragma unroll
                for (int j = 0; j < 4; ++j) ss += v[i][0][j] * v[i][0][j] + v[i][1][j] * v[i][1][j]; }
            ss = wave_sum(ss);
            const float rinv = 1.0f / sqrtf(ss * (1.0f / 2048.0f) + EPS);
#pragma unroll
            for (int i = 0; i < 4; ++i) { const int col = i * 512 + F.lane * 8;
                const f32x4 a0 = *(const f32x4*)(cA + col), a1 = *(const f32x4*)(cA + col + 4), b0 = *(const f32x4*)(cB + col), b1 = *(const f32x4*)(cB + col + 4);
                *(u32x4*)(dst + row * 2048 + col) = pack8(v[i][0] * rinv * a0 + b0, v[i][1] * rinv * a1 + b1); }
        }
    }
}

__device__ __forceinline__ u32x2 pack8_fp8(f32x4 a, f32x4 b) {
    int w0 = __builtin_amdgcn_cvt_pk_fp8_f32(a[0], a[1], 0, false); w0 = __builtin_amdgcn_cvt_pk_fp8_f32(a[2], a[3], w0, true);
    int w1 = __builtin_amdgcn_cvt_pk_fp8_f32(b[0], b[1], 0, false); w1 = __builtin_amdgcn_cvt_pk_fp8_f32(b[2], b[3], w1, true);
    return (u32x2){(unsigned)w0, (unsigned)w1};
}
__device__ __forceinline__ void phase3_qknorm(Frame& F) {
    const bf16_t* q = (const bf16_t*)(F.ws + WS_QN); const bf16_t* k = (const bf16_t*)(F.ws + WS_KN); const bf16_t* v = (const bf16_t*)(F.ws + WS_V);
    unsigned char* q8 = F.ws + WS_Q8; unsigned char* k8 = F.ws + WS_K8; unsigned char* v8 = F.ws + WS_V8;
    const int gw = F.bid * 8 + F.wave, NGW = F.G * 8;
    for (int row = gw; row < MTOK; row += NGW) {
#pragma unroll
        for (int i = 0; i < 2; ++i) { const int ci = i * 64 + F.lane;
            f32x4 a, b; unpack8(*(const u32x4*)(q + (size_t)row * 1024 + ci * 8), a, b);
            float ss = a[0] * a[0] + a[1] * a[1] + a[2] * a[2] + a[3] * a[3] + b[0] * b[0] + b[1] * b[1] + b[2] * b[2] + b[3] * b[3];
            ss = row_sum16(ss);
            const float rinv = 1.0f / sqrtf(ss * (1.0f / 128.0f) + EPS);
            const float* gp = F.g_q + (ci & 15) * 8; const f32x4 g0 = *(const f32x4*)gp, g1 = *(const f32x4*)(gp + 4);
            *(u32x2*)(q8 + (size_t)row * 1024 + ci * 8) = pack8_fp8(a * rinv * g0, b * rinv * g1); }
        { const int ci = F.lane & 31; const bool isk = F.lane < 32;
            f32x4 a, b; unpack8(*(const u32x4*)((isk ? k : v) + (size_t)row * 256 + ci * 8), a, b);
            float ss = a[0] * a[0] + a[1] * a[1] + a[2] * a[2] + a[3] * a[3] + b[0] * b[0] + b[1] * b[1] + b[2] * b[2] + b[3] * b[3];
            ss = row_sum16(ss);
            const float rinv = isk ? 1.0f / sqrtf(ss * (1.0f / 128.0f) + EPS) : 1.0f;
            const float* gp = F.g_k + (ci & 15) * 8; f32x4 g0 = *(const f32x4*)gp, g1 = *(const f32x4*)(gp + 4);
            if (!isk) { g0 = (f32x4){1.f, 1.f, 1.f, 1.f}; g1 = g0; }
            *(u32x2*)((isk ? k8 : v8) + (size_t)row * 256 + ci * 8) = pack8_fp8(a * rinv * g0, b * rinv * g1); }
    }
}
template <int W> __device__ __forceinline__ void pooled_item(const bf16_t* pl, bf16_t* po, int row, int c8) {
    const int t = row & (SEQ - 1);
    f32x4 s0 = (f32x4){0.f, 0.f, 0.f, 0.f}, s1 = s0, x0 = s0, x1 = s0;
    u32x4 v[W];
#pragma unroll
    for (int j = 0; j < W; ++j) v[j] = *(const u32x4*)(pl + (size_t)(row - (j <= t ? j : 0)) * 1024 + c8);
#pragma unroll
    for (int j = 0; j < W; ++j) { f32x4 a, b; unpack8(v[j], a, b); if (j == 0) { x0 = a; x1 = b; } if (j <= t) { s0 += a; s1 += b; } }
    const float inv = 1.0f / (float)((t + 1 < W) ? t + 1 : W);
    *(u32x4*)(po + (size_t)row * 1024 + c8) = pack8(s0 * inv - x0, s1 * inv - x1);
}
__device__ __forceinline__ void phase3_pooled(Frame& F) {
    const bf16_t* pl = (const bf16_t*)(F.ws + WS_PL); bf16_t* po = (bf16_t*)(F.ws + WS_POOLED);
    const int gw = F.bid * 8 + F.wave, NGW = F.G * 8;
    for (int it = gw; it < (MTOK / 2) * 4; it += NGW) {
        const int g = it & 3, row = (it >> 2) * 2 + (F.lane >> 5), c8 = g * 256 + (F.lane & 31) * 8;
        if (g == 0) pooled_item<2>(pl, po, row, c8); else if (g == 1) pooled_item<4>(pl, po, row, c8); else if (g == 2) pooled_item<8>(pl, po, row, c8); else pooled_item<16>(pl, po, row, c8);
    }
}
typedef float f32x16 __attribute__((ext_vector_type(16)));
__device__ __forceinline__ int sel_code(float s, float smin, float scale) { const float c = (s - smin) * scale; return (int)fminf(fmaxf(c, 0.f), 65535.f); }
__device__ __forceinline__ void hist_find(const unsigned* hist, int lane, int K, int& bsel, int& above) {
    const u32x4 h = *(const u32x4*)(hist + lane * 4);
    const int S = (int)(h.x + h.y + h.z + h.w);
    int x = S;
    x += __builtin_amdgcn_update_dpp(0, x, 0x101, 0xF, 0xF, true);
    x += __builtin_amdgcn_update_dpp(0, x, 0x102, 0xF, 0xF, true);
    x += __builtin_amdgcn_update_dpp(0, x, 0x104, 0xF, 0xF, true);
    x += __builtin_amdgcn_update_dpp(0, x, 0x108, 0xF, 0xF, true);
    const int t1 = __builtin_amdgcn_readlane(x, 16), t2 = __builtin_amdgcn_readlane(x, 32), t3 = __builtin_amdgcn_readlane(x, 48);
    const int r = lane >> 4;
    x += (r == 0 ? t1 + t2 + t3 : (r == 1 ? t2 + t3 : (r == 2 ? t3 : 0)));
    const int sufn = x - S;
    const bool mine = (x >= K) && (sufn < K);
    int b = 0, ab = 0;
    { int c = sufn;
      if (c + (int)h.w >= K) { b = 3; ab = c; } else { c += (int)h.w;
      if (c + (int)h.z >= K) { b = 2; ab = c; } else { c += (int)h.z;
      if (c + (int)h.y >= K) { b = 1; ab = c; } else { c += (int)h.y; b = 0; ab = c; } } } }
    const unsigned long long m = __ballot(mine);
    const int src = m ? (int)__builtin_ctzll(m) : 0;
    bsel = __builtin_amdgcn_readlane(lane * 4 + b, src); above = __builtin_amdgcn_readlane(ab, src);
}
__device__ __forceinline__ void indexer_select(Frame& F, int b, int t, const float* rowbuf, unsigned* hist, float* eqv, int* eqi) {
    unsigned short* selrow = (unsigned short*)(F.ws + WS_SEL) + (size_t)(b * SEQ + t) * 256;
    int lane = F.lane; asm volatile("" : "+v"(lane));
    const int nch = t / 64 + 1, n4 = (nch + 3) >> 2;
    const f32x4* rb4 = (const f32x4*)rowbuf;
    float mn = __builtin_huge_valf(), mx = -__builtin_huge_valf();
    for (int c4 = 0; c4 < n4; ++c4) { const f32x4 v = rb4[c4 * 64 + lane];
#pragma unroll
        for (int k = 0; k < 4; ++k) { const bool valid = ((c4 * 4 + k) * 64 + lane) <= t; mn = valid ? fminf(mn, v[k]) : mn; mx = valid ? fmaxf(mx, v[k]) : mx; } }
    mx = xor16_max(row_max16(mx)); { const auto r = __builtin_amdgcn_permlane32_swap(__float_as_uint(mx), __float_as_uint(mx), false, false); mx = fmaxf(__uint_as_float(r[0]), __uint_as_float(r[1])); }
    mn = -mn; mn = xor16_max(row_max16(mn)); { const auto r = __builtin_amdgcn_permlane32_swap(__float_as_uint(mn), __float_as_uint(mn), false, false); mn = -fmaxf(__uint_as_float(r[0]), __uint_as_float(r[1])); }
    const float scale = (mx > mn) ? 65535.0f / (mx - mn) : 0.f;
    *(u32x4*)(hist + lane * 4) = (u32x4){0u, 0u, 0u, 0u};
    for (int c4 = 0; c4 < n4; ++c4) { const f32x4 v = rb4[c4 * 64 + lane];
#pragma unroll
        for (int k = 0; k < 4; ++k) { const bool valid = ((c4 * 4 + k) * 64 + lane) <= t; if (valid) atomicAdd(&hist[sel_code(v[k], mn, scale) >> 8], 1u); } }
    int b1, above1; hist_find(hist, lane, KSEL, b1, above1);
    *(u32x4*)(hist + lane * 4) = (u32x4){0u, 0u, 0u, 0u};
    for (int c4 = 0; c4 < n4; ++c4) { const f32x4 v = rb4[c4 * 64 + lane];
#pragma unroll
        for (int k = 0; k < 4; ++k) { const bool valid = ((c4 * 4 + k) * 64 + lane) <= t; const int code = sel_code(v[k], mn, scale); if (valid && (code >> 8) == b1) atomicAdd(&hist[code & 255], 1u); } }
    int b2, above2; hist_find(hist, lane, KSEL - above1, b2, above2);
    const int T16 = (b1 << 8) | b2, need = KSEL - above1 - above2, ceq = (int)hist[b2];
    const unsigned long long lt_mask = (1ull << lane) - 1ull;
    const bool exact = (ceq != need) && (ceq <= 64);
    if (exact) {
        int pos = 0;
        for (int c = 0; c < nch; ++c) { const float sv = rowbuf[((c >> 2) * 64 + lane) * 4 + (c & 3)]; const int idx = c * 64 + lane;
            const bool eq = (idx <= t) && (sel_code(sv, mn, scale) == T16);
            const unsigned long long m = __ballot(eq);
            if (m) { const int p = pos + __popcll(m & lt_mask); if (eq) { eqv[p] = sv; eqi[p] = idx; } pos += __popcll(m); } }
    }
    int pos = 0, eqseen = 0;
    for (int c = 0; c < nch; ++c) {
        const float sv = rowbuf[((c >> 2) * 64 + lane) * 4 + (c & 3)]; const int idx = c * 64 + lane;
        const int code = sel_code(sv, mn, scale); const bool valid = idx <= t;
        const bool gt = valid && code > T16, eq = valid && code == T16;
        const unsigned long long meq = __ballot(eq);
        bool take = gt;
        if (meq) {
            if (ceq == need) take = take || eq;
            else if (exact) { int rank = 0; for (int m = 0; m < ceq; ++m) { const float ov = eqv[m]; const int oi = eqi[m]; rank += (ov > sv || (ov == sv && oi < idx)) ? 1 : 0; } take = take || (eq && rank < need); }
            else { const int er = eqseen + __popcll(meq & lt_mask); take = take || (eq && er < need); eqseen += __popcll(meq); }
        }
        const unsigned long long mt = __ballot(take);
        const int p = pos + __popcll(mt & lt_mask);
        if (take && p < KSEL) selrow[p] = (unsigned short)idx;
        pos += __popcll(mt);
    }
}
__device__ __forceinline__ void indexer_tile(Frame& F, int b, int t0) {
    const bf16_t* iq = (const bf16_t*)(F.ws + WS_IQ); const bf16_t* ik = (const bf16_t*)(F.ws + WS_IK); const float* iw = (const float*)(F.ws + WS_IW);
    int lane = F.lane; asm volatile("" : "+v"(lane));
    const int w = F.wave;
    if (t0 < KSEL) {
        const int t = t0 + w; unsigned short* selrow = (unsigned short*)(F.ws + WS_SEL) + (size_t)(b * SEQ + t) * 256;
#pragma unroll
        for (int p = 0; p < 4; ++p) { const int j = p * 64 + lane; selrow[j] = (unsigned short)(j <= t ? j : 0xFFFF); }
        return;
    }
    float* rowbuf = (float*)F.lds;
    unsigned char* stage = F.lds + 131072;
    const int p = w & 3, kh = w >> 2, hi = lane >> 5, r = lane & 31;
    const size_t qrow = (size_t)b * SEQ + t0 + 2 * p + (r >> 4);
    bf16x8 a[4];
#pragma unroll
    for (int ks = 0; ks < 4; ++ks) a[ks] = *(const bf16x8*)(iq + qrow * 1024 + (r & 15) * 64 + ks * 16 + 8 * hi);
    float wq[2][8];
#pragma unroll
    for (int q = 0; q < 2; ++q)
#pragma unroll
        for (int i = 0; i < 8; ++i) wq[q][i] = iw[((size_t)b * SEQ + t0 + 2 * p + q) * 16 + (i & 3) + 8 * ((i >> 2) & 1) + 4 * hi];
    const int nchunks = (t0 + 7) / 64 + 1;
    const unsigned char* gsrc = (const unsigned char*)(ik + (size_t)b * SEQ * 64) + F.tid * 16;
    const int skey = F.tid >> 3, sc16 = F.tid & 7, soff = skey * 128 + ((sc16 ^ (skey & 7)) << 4);
    u32x4 s0 = *(const u32x4*)gsrc, s1 = s0, s2 = s0, s3 = s0;
    if (1 < nchunks) s1 = *(const u32x4*)(gsrc + (size_t)1 * 8192);
    if (2 < nchunks) s2 = *(const u32x4*)(gsrc + (size_t)2 * 8192);
    if (3 < nchunks) s3 = *(const u32x4*)(gsrc + (size_t)3 * 8192);
    __syncthreads();
#define IDX_STEP(SR, cc) do { const int c = (cc); unsigned char* sb = stage + (c & 1) * 8192; \
        *(u32x4*)(sb + soff) = SR; \
        __syncthreads(); \
        if (c + 4 < nchunks) SR = *(const u32x4*)(gsrc + (size_t)(c + 4) * 8192); \
        f32x16 d; _Pragma("unroll") for (int i = 0; i < 16; ++i) d[i] = 0.f; \
        const int key = kh * 32 + r; \
        _Pragma("unroll") for (int ks = 0; ks < 4; ++ks) { const bf16x8 bf = *(const bf16x8*)(sb + key * 128 + (((ks * 2 + hi) ^ (key & 7)) << 4)); \
            d = __builtin_amdgcn_mfma_f32_32x32x16_bf16(a[ks], bf, d, 0, 0, 0); } \
        float s0_ = 0.f, s1_ = 0.f; \
        _Pragma("unroll") for (int i = 0; i < 8; ++i) { s0_ += wq[0][i] * fmaxf(d[i], 0.f); s1_ += wq[1][i] * fmaxf(d[8 + i], 0.f); } \
        const float sc = swap32_pair(s0_, s1_); \
        rowbuf[(2 * p + hi) * 4096 + ((c >> 2) * 64 + key) * 4 + (c & 3)] = sc; } while (0)
    for (int c4 = 0; c4 < nchunks; c4 += 4) {
        IDX_STEP(s0, c4);
        if (c4 + 1 < nchunks) IDX_STEP(s1, c4 + 1);
        if (c4 + 2 < nchunks) IDX_STEP(s2, c4 + 2);
        if (c4 + 3 < nchunks) IDX_STEP(s3, c4 + 3);
    }
#if PROBE_IDX == 1
    __syncthreads(); s0 = *(const u32x4*)gsrc; s1 = s0; s2 = s0; s3 = s0;
    if (1 < nchunks) s1 = *(const u32x4*)(gsrc + (size_t)1 * 8192);
    if (2 < nchunks) s2 = *(const u32x4*)(gsrc + (size_t)2 * 8192);
    if (3 < nchunks) s3 = *(const u32x4*)(gsrc + (size_t)3 * 8192);
    for (int c4 = 0; c4 < nchunks; c4 += 4) {
        IDX_STEP(s0, c4);
        if (c4 + 1 < nchunks) IDX_STEP(s1, c4 + 1);
        if (c4 + 2 < nchunks) IDX_STEP(s2, c4 + 2);
        if (c4 + 3 < nchunks) IDX_STEP(s3, c4 + 3);
    }
#endif
#undef IDX_STEP
    __syncthreads();
    indexer_select(F, b, t0 + w, rowbuf + w * 4096, (unsigned*)(F.lds + 147456) + w * 256, (float*)(F.lds + 155648) + w * 64, (int*)(F.lds + 155648 + 2048) + w * 64);
#if PROBE_IDX == 2
    indexer_select(F, b, t0 + w, rowbuf + w * 4096, (unsigned*)(F.lds + 147456) + w * 256, (float*)(F.lds + 155648) + w * 64, (int*)(F.lds + 155648 + 2048) + w * 64);
#endif
}
__device__ __forceinline__ void phase3_indexer(Frame& F) {
    const int nit = BATCH * (SEQ / 8);
    for (int k = 0;; ++k) {
        const int l = k * F.G + ((k & 1) ? (F.G - 1 - F.bid) : F.bid);
        if (l >= nit) { if (k * F.G >= nit) break; else continue; }
        const int qb = (SEQ / 8 - 1) - (l >> 3), b = l & 7;
        indexer_tile(F, b, qb * 8);
    }
}

__device__ const unsigned char g_bucket[128] = {0, 1, 2, 3, 4, 5, 6, 7, 8, 9, 10, 11, 12, 13, 14, 15, 16, 16, 16, 17, 17, 18, 18, 18, 19, 19, 19, 20, 20, 20, 20, 21, 21, 21, 21, 22, 22, 22, 22, 22, 23, 23, 23, 23, 23, 23, 24, 24, 24, 24, 24, 24, 25, 25, 25, 25, 25, 25, 25, 26, 26, 26, 26, 26, 26, 26, 26, 27, 27, 27, 27, 27, 27, 27, 27, 27, 27, 28, 28, 28, 28, 28, 28, 28, 28, 28, 28, 29, 29, 29, 29, 29, 29, 29, 29, 29, 29, 29, 29, 30, 30, 30, 30, 30, 30, 30, 30, 30, 30, 30, 30, 30, 30, 31, 31, 31, 31, 31, 31, 31, 31, 31, 31, 31, 31, 31, 31, 31};
__device__ __forceinline__ void phase4_attention(Frame& F) {
    const unsigned char* q8 = F.ws + WS_Q8; const unsigned char* k8 = F.ws + WS_K8; const unsigned char* v8 = F.ws + WS_V8;
    const unsigned short* sel = (const unsigned short*)(F.ws + WS_SEL); bf16_t* ao = (bf16_t*)(F.ws + WS_ATTN);
    float* btab = (float*)F.lds;
    __syncthreads();
    for (int i = F.tid; i < 256; i += 512) btab[i] = F.rel_bias[i];
    __syncthreads();
    float* Pl = (float*)(F.lds + 4096 + F.wave * 12288); int* idl = (int*)(Pl + 2048); float* psl = (float*)(idl + 256);
    const bool xmap = (F.G % 8) == 0;
    const int gw = xmap ? (F.bid / 8) * 8 + F.wave : F.bid * 8 + F.wave, NGW = xmap ? F.G : F.G * 8, nrows = xmap ? SEQ : MTOK;
    for (int rr = gw; rr < nrows; rr += NGW) {
        int lane = F.lane; asm volatile("" : "+v"(lane));
        const int row = xmap ? (F.bid & 7) * SEQ + rr : rr;
        const int b = row / SEQ, t = row % SEQ, r = lane & 31, hi = lane >> 5;
#pragma unroll
        for (int p = 0; p < 4; ++p) { idl[p * 64 + lane] = (int)sel[(size_t)row * 256 + p * 64 + lane]; }
        long a0[8], a1[8];
        { u32x4 qa[4];
#pragma unroll
          for (int i = 0; i < 4; ++i) qa[i] = (r < 8) ? *(const u32x4*)(q8 + (size_t)row * 1024 + r * 128 + hi * 64 + i * 16) : (u32x4){0u, 0u, 0u, 0u};
#pragma unroll
          for (int ks = 0; ks < 8; ++ks) { const unsigned lo = qa[ks >> 1][(ks & 1) * 2], hh = qa[ks >> 1][(ks & 1) * 2 + 1]; const long v = (long)(((unsigned long long)hh << 32) | lo);
              a0[ks] = (r < 4) ? v : 0l; a1[ks] = (r >= 4) ? v : 0l; } }
        f32x4 psum = (f32x4){0.f, 0.f, 0.f, 0.f};
#define AT_LOADK(buf, kb) do { const int key_ = idl[(kb) * 32 + r]; const int kc_ = key_ <= t ? key_ : 0; const unsigned char* kr_ = k8 + ((size_t)b * SEQ + kc_) * 256 + hi * 64; \
            _Pragma("unroll") for (int i = 0; i < 4; ++i) { buf[i] = *(const u32x4*)(kr_ + i * 16); buf[4 + i] = *(const u32x4*)(kr_ + 128 + i * 16); } } while (0)
#define AT_QK(buf, kb) do { const int key_ = idl[(kb) * 32 + r]; const bool valid_ = key_ <= t; const int kc_ = valid_ ? key_ : 0; \
            f32x16 d; _Pragma("unroll") for (int i = 0; i < 16; ++i) d[i] = 0.f; \
            _Pragma("unroll") for (int ks = 0; ks < 8; ++ks) { const long bv_ = (long)(((unsigned long long)buf[ks >> 1][(ks & 1) * 2 + 1] << 32) | buf[ks >> 1][(ks & 1) * 2]); d = __builtin_amdgcn_mfma_f32_32x32x16_fp8_fp8(a0[ks], bv_, d, 0, 0, 0); } \
            _Pragma("unroll") for (int ks = 0; ks < 8; ++ks) { const long bv_ = (long)(((unsigned long long)buf[4 + (ks >> 1)][(ks & 1) * 2 + 1] << 32) | buf[4 + (ks >> 1)][(ks & 1) * 2]); d = __builtin_amdgcn_mfma_f32_32x32x16_fp8_fp8(a1[ks], bv_, d, 0, 0, 0); } \
            const int dist_ = t - kc_; const int bkt_ = dist_ < 128 ? (int)g_bucket[dist_] : 31; \
            const f32x4 bias_ = *(const f32x4*)(btab + bkt_ * 8 + 4 * hi); f32x4 e_; \
            _Pragma("unroll") for (int i = 0; i < 4; ++i) e_[i] = valid_ ? __expf(d[i] * 0.08838834764831845f + bias_[i]) : 0.f; \
            psum += e_; *(f32x4*)(Pl + ((kb) * 32 + r) * 8 + 4 * hi) = e_; } while (0)
        {
            u32x4 kA[8], kB[8];
            AT_LOADK(kA, 0);
#pragma unroll 1
            for (int kb = 0; kb < 8; kb += 2) {
                AT_LOADK(kB, kb + 1);
                AT_QK(kA, kb);
                if (kb + 2 < 8) AT_LOADK(kA, kb + 2);
                AT_QK(kB, kb + 1);
            }
        }
#undef AT_LOADK
#undef AT_QK
#pragma unroll
        for (int i = 0; i < 4; ++i) psum[i] = xor16_sum(row_sum16(psum[i]));
        if (r == 0) *(f32x4*)(psl + 4 * hi) = psum;
        const int ks = lane >> 4, g = (lane >> 3) & 1, dc = lane & 7;
        float acc[4][16];
#pragma unroll
        for (int h = 0; h < 4; ++h)
#pragma unroll
            for (int j = 0; j < 16; ++j) acc[h][j] = 0.f;
#define AT_LOADV(buf, it0) do { _Pragma("unroll") for (int u = 0; u < 4; ++u) { const int key_ = idl[((it0) + u) * 4 + ks]; const int kc_ = key_ <= t ? key_ : 0; \
            buf[u] = *(const u32x4*)(v8 + ((size_t)b * SEQ + kc_) * 256 + g * 128 + dc * 16); } } while (0)
#define AT_PV(buf, it0) do { _Pragma("unroll") for (int u = 0; u < 4; ++u) { const int j_ = ((it0) + u) * 4 + ks; const u32x4 w = buf[u]; \
            const f32x4 p = *(const f32x4*)(Pl + j_ * 8 + 4 * g); \
            _Pragma("unroll") for (int dd = 0; dd < 4; ++dd) { const f32x2 lo = __builtin_amdgcn_cvt_pk_f32_fp8((int)w[dd], false), hh_ = __builtin_amdgcn_cvt_pk_f32_fp8((int)w[dd], true); \
                _Pragma("unroll") for (int h = 0; h < 4; ++h) { acc[h][4 * dd] += p[h] * lo.x; acc[h][4 * dd + 1] += p[h] * lo.y; acc[h][4 * dd + 2] += p[h] * hh_.x; acc[h][4 * dd + 3] += p[h] * hh_.y; } } } } while (0)
        {
            u32x4 vA[4], vB[4];
            AT_LOADV(vA, 0);
#pragma unroll 1
            for (int it0 = 0; it0 < 64; it0 += 8) {
                AT_LOADV(vB, it0 + 4);
                AT_PV(vA, it0);
                if (it0 + 8 < 64) AT_LOADV(vA, it0 + 8);
                AT_PV(vB, it0 + 4);
            }
        }
#undef AT_LOADV
#undef AT_PV
#pragma unroll
        for (int h = 0; h < 4; ++h)
#pragma unroll
            for (int j = 0; j < 16; ++j) acc[h][j] = xor32_sum(xor16_sum(acc[h][j]));
#pragma unroll
        for (int h = 0; h < 4; ++h) if (h == ks) { const float inv = 1.0f / psl[4 * g + h];
            bf16_t* op = ao + (size_t)row * 1024 + (4 * g + h) * 128 + dc * 16;
            *(u32x4*)op = pack8((f32x4){acc[h][0], acc[h][1], acc[h][2], acc[h][3]} * inv, (f32x4){acc[h][4], acc[h][5], acc[h][6], acc[h][7]} * inv);
            *(u32x4*)(op + 8) = pack8((f32x4){acc[h][8], acc[h][9], acc[h][10], acc[h][11]} * inv, (f32x4){acc[h][12], acc[h][13], acc[h][14], acc[h][15]} * inv); }
    }
}

__device__ __forceinline__ float dot16f8(u32x4 w, const float* h) {
    float s = 0.f;
#pragma unroll
    for (int d = 0; d < 4; ++d) { const f32x2 lo = __builtin_amdgcn_cvt_pk_f32_fp8((int)w[d], false), hi = __builtin_amdgcn_cvt_pk_f32_fp8((int)w[d], true);
        s += lo.x * h[4 * d] + lo.y * h[4 * d + 1] + hi.x * h[4 * d + 2] + hi.y * h[4 * d + 3]; }
    return s;
}
__device__ __forceinline__ void fma16f8(u32x4 w, float cf, float* acc) {
#pragma unroll
    for (int d = 0; d < 4; ++d) { const f32x2 lo = __builtin_amdgcn_cvt_pk_f32_fp8((int)w[d], false), hi = __builtin_amdgcn_cvt_pk_f32_fp8((int)w[d], true);
        acc[4 * d] += cf * lo.x; acc[4 * d + 1] += cf * lo.y; acc[4 * d + 2] += cf * hi.x; acc[4 * d + 3] += cf * hi.y; }
}
__device__ __forceinline__ float gelu_erf(float x) { return 0.5f * x * (1.0f + erff(x * 0.70710678118654752f)); }
__device__ __forceinline__ void hfind2(const unsigned* hist, int lane, int K, int& bsel, int& above) {
    const int half = lane >> 5, lh = lane & 31;
    const u32x4 h0 = *(const u32x4*)(hist + half * 256 + lh * 8), h1 = *(const u32x4*)(hist + half * 256 + lh * 8 + 4);
    const int S = (int)(h0.x + h0.y + h0.z + h0.w + h1.x + h1.y + h1.z + h1.w);
    int x = S;
    x += __builtin_amdgcn_update_dpp(0, x, 0x101, 0xF, 0xF, true); x += __builtin_amdgcn_update_dpp(0, x, 0x102, 0xF, 0xF, true);
    x += __builtin_amdgcn_update_dpp(0, x, 0x104, 0xF, 0xF, true); x += __builtin_amdgcn_update_dpp(0, x, 0x108, 0xF, 0xF, true);
    const int t1 = __builtin_amdgcn_readlane(x, 16), t3 = __builtin_amdgcn_readlane(x, 48);
    if ((lane & 16) == 0) x += half ? t3 : t1;
    const int sufn = x - S;
    const bool mine = (x >= K) && (sufn < K);
    int b = 0, ab = sufn, c = sufn; bool fnd = false;
#define HF_STEP(i, hv) { const int cv = c + (int)(hv); const bool hit = !fnd && (cv >= K); b = hit ? (i) : b; ab = hit ? c : ab; fnd = fnd || hit; c = cv; }
    HF_STEP(7, h1.w) HF_STEP(6, h1.z) HF_STEP(5, h1.y) HF_STEP(4, h1.x) HF_STEP(3, h0.w) HF_STEP(2, h0.z) HF_STEP(1, h0.y) HF_STEP(0, h0.x)
#undef HF_STEP
    const unsigned long long m = __ballot(mine);
    const unsigned mlo = (unsigned)m, mhi = (unsigned)(m >> 32);
    const int src0 = mlo ? __builtin_ctz(mlo) : 0, src1 = 32 + (mhi ? __builtin_ctz(mhi) : 0);
    const int bb = lh * 8 + b;
    const int r0b = __builtin_amdgcn_readlane(bb, src0), r0a = __builtin_amdgcn_readlane(ab, src0), r1b = __builtin_amdgcn_readlane(bb, src1), r1a = __builtin_amdgcn_readlane(ab, src1);
    bsel = half ? r1b : r0b; above = half ? r1a : r0a;
}
__device__ __forceinline__ void peer_select(const bf16_t* srow, int lane, int* elist, float* gl, float* scr, unsigned* hist2) {
    float* selv = scr; int* seli = (int*)(scr + 32); float* srtv = scr + 64; int* srti = (int*)(scr + 96);
    const unsigned long long lt_mask = (1ull << lane) - 1ull;
    const int half = lane >> 5, lh = lane & 31;
    const unsigned long long hmask = half ? 0xFFFFFFFF00000000ull : 0x00000000FFFFFFFFull;
    const float NINF = -__builtin_huge_valf();
#pragma unroll 1
    for (int h = 0; h < 8; ++h) {
        const u32x2 raw = *(const u32x2*)(srow + h * 256 + lane * 4);
        unsigned b[4] = {raw.x & 0xffffu, raw.x >> 16, raw.y & 0xffffu, raw.y >> 16}, k[4];
#pragma unroll
        for (int q = 0; q < 4; ++q) k[q] = (b[q] & 0x8000u) ? (b[q] ^ 0xFFFFu) : (b[q] | 0x8000u);
        *(u32x4*)(hist2 + lane * 8) = (u32x4){0u, 0u, 0u, 0u}; *(u32x4*)(hist2 + lane * 8 + 4) = (u32x4){0u, 0u, 0u, 0u};
#pragma unroll
        for (int q = 0; q < 4; ++q) atomicAdd(&hist2[half * 256 + (k[q] >> 8)], 1u);
        int b1, ab1; hfind2(hist2, lane, 16, b1, ab1);
        *(u32x4*)(hist2 + lane * 8) = (u32x4){0u, 0u, 0u, 0u}; *(u32x4*)(hist2 + lane * 8 + 4) = (u32x4){0u, 0u, 0u, 0u};
#pragma unroll
        for (int q = 0; q < 4; ++q) if ((int)(k[q] >> 8) == b1) atomicAdd(&hist2[half * 256 + (k[q] & 255u)], 1u);
        int b2, ab2; hfind2(hist2, lane, 16 - ab1, b2, ab2);
        const unsigned T = ((unsigned)b1 << 8) | (unsigned)b2;
        int ngt = 0, eqb = 0; unsigned long long me[4];
#pragma unroll
        for (int q = 0; q < 4; ++q) { const unsigned long long mg = __ballot(k[q] > T) & hmask; me[q] = __ballot(k[q] == T) & hmask; ngt += __popcll(mg); eqb += __popcll(me[q] & lt_mask); }
        const int need = 16 - ngt;
        bool sl[4]; int run = eqb;
#pragma unroll
        for (int q = 0; q < 4; ++q) { const bool eq = k[q] == T; sl[q] = (k[q] > T) || (eq && run < need); run += eq ? 1 : 0; }
        int pos = 0;
#pragma unroll
        for (int q = 0; q < 4; ++q) pos += __popcll(__ballot(sl[q]) & hmask & lt_mask);
#pragma unroll
        for (int q = 0; q < 4; ++q) { if (sl[q]) { selv[half * 16 + pos] = __uint_as_float(b[q] << 16); seli[half * 16 + pos] = 4 * lh + q; } pos += sl[q] ? 1 : 0; }
        const float v = selv[half * 16 + (lh & 15)]; const int ix = seli[half * 16 + (lh & 15)];
        int rank = 0;
#define PS_ROT(R) { const float vo = __int_as_float(__builtin_amdgcn_update_dpp(0, __float_as_int(v), 0x120 + (R), 0xF, 0xF, true)); const int io = __builtin_amdgcn_update_dpp(0, ix, 0x120 + (R), 0xF, 0xF, true); rank += (vo > v || (vo == v && io < ix)) ? 1 : 0; }
        PS_ROT(1) PS_ROT(2) PS_ROT(3) PS_ROT(4) PS_ROT(5) PS_ROT(6) PS_ROT(7) PS_ROT(8) PS_ROT(9) PS_ROT(10) PS_ROT(11) PS_ROT(12) PS_ROT(13) PS_ROT(14) PS_ROT(15)
#undef PS_ROT
        if (lh < 16) { srtv[half * 16 + rank] = v; srti[half * 16 + rank] = ix; }
        int ca, cb; const int c = lane;
        if (c < 16) { ca = 0; cb = c; } else if (c < 24) { ca = 1; cb = c - 16; } else if (c < 29) { ca = 2; cb = c - 24; } else if (c < 33) { ca = 3; cb = c - 29; }
        else if (c < 36) { ca = 4; cb = c - 33; } else if (c < 38) { ca = 5; cb = c - 36; } else if (c < 40) { ca = 6; cb = c - 38; } else if (c < 42) { ca = 7; cb = c - 40; }
        else { ca = (c - 42 + 8) & 15; cb = 0; }
        float s = srtv[ca] + srtv[16 + cb];
        const int eid = srti[ca] * 128 + srti[16 + cb];
        if (c >= 50) s = NINF;
        const unsigned sb_ = __float_as_uint(s), ok_ = sb_ ^ ((unsigned)((int)sb_ >> 31) | 0x80000000u);
        const unsigned key = (c < 50) ? ((ok_ & ~63u) | (unsigned)(63 - c)) : 0u;
        int rk = 0;
#pragma unroll
        for (int j = 0; j < 50; ++j) { const unsigned kj = (unsigned)__builtin_amdgcn_readlane((int)key, j); rk += (kj > key) ? 1 : 0; }
        const bool selq = (c < 50) && (rk < 16);
        const float smax = __shfl(s, 0);
        const float e = selq ? __expf(s - smax) : 0.f;
        const float esum = wave_sum(e);
        const unsigned long long ms = __ballot(selq);
        const int p = __popcll(ms & lt_mask);
        if (selq) { elist[h * 16 + p] = eid; gl[h * 16 + p] = e / esum; }
    }
}
__device__ __forceinline__ float dot32_f8b(u32x4 wa, u32x4 wb, u32x4 ha0, u32x4 ha1, u32x4 hb0, u32x4 hb1) {
    typedef __bf16 bf2 __attribute__((ext_vector_type(2)));
    float acc = 0.f;
#pragma unroll
    for (int d = 0; d < 4; ++d) {
        const unsigned h0 = d < 2 ? ha0[2 * d] : ha1[2 * d - 4], h1 = d < 2 ? ha0[2 * d + 1] : ha1[2 * d - 3];
        const unsigned g0 = d < 2 ? hb0[2 * d] : hb1[2 * d - 4], g1 = d < 2 ? hb0[2 * d + 1] : hb1[2 * d - 3];
        acc = __builtin_amdgcn_fdot2_f32_bf16(__builtin_amdgcn_cvt_scalef32_pk_bf16_fp8((int)wa[d], 1.0f, false), __builtin_bit_cast(bf2, h0), acc, false);
        acc = __builtin_amdgcn_fdot2_f32_bf16(__builtin_amdgcn_cvt_scalef32_pk_bf16_fp8((int)wa[d], 1.0f, true), __builtin_bit_cast(bf2, h1), acc, false);
        acc = __builtin_amdgcn_fdot2_f32_bf16(__builtin_amdgcn_cvt_scalef32_pk_bf16_fp8((int)wb[d], 1.0f, false), __builtin_bit_cast(bf2, g0), acc, false);
        acc = __builtin_amdgcn_fdot2_f32_bf16(__builtin_amdgcn_cvt_scalef32_pk_bf16_fp8((int)wb[d], 1.0f, true), __builtin_bit_cast(bf2, g1), acc, false); }
    return acc;
}
__device__ __forceinline__ void phase10_peer(Frame& F) {
    const bf16_t* sub = (const bf16_t*)(F.ws + WS_SUB); const bf16_t* h2 = (const bf16_t*)(F.ws + WS_H2);
    const unsigned char* pu = F.ws + WS_PU; unsigned* pairs = (unsigned*)(F.ws + WS_PAIRS);
    const int gw = F.bid * 8 + F.wave, NGW = F.G * 8;
    unsigned char* wb = F.lds + F.wave * 17664;
    unsigned char* h2b = wb; unsigned short* gl16 = (unsigned short*)(wb + 16384); unsigned* hist = (unsigned*)(wb + 17408); unsigned* base = hist + 32;
    unsigned* tmp = (unsigned*)wb; int* elist = (int*)(wb + 2048); float* gl = (float*)(wb + 2560); float* sscr = (float*)(wb + 3072); bf16_t* srl = (bf16_t*)(wb + 4096);
    unsigned* wls = (unsigned*)(F.ws + WS_WLS) + (size_t)gw * 512;
    const int ntok = (MTOK - gw + NGW - 1) / NGW;
    for (int p0 = 0; p0 < ntok; p0 += 4) {
        int lane = F.lane; asm volatile("" : "+v"(lane));
        const int nt = (ntok - p0) < 4 ? (ntok - p0) : 4, ne = nt * 128;
        u32x4 nxt[4];
#pragma unroll
        for (int q = 0; q < 4; ++q) nxt[q] = *(const u32x4*)(sub + (size_t)(gw + p0 * NGW) * 2048 + lane * 32 + q * 8);
#pragma unroll 1
        for (int i = 0; i < nt; ++i) {
#pragma unroll
            for (int q = 0; q < 4; ++q) *(u32x4*)(srl + lane * 32 + q * 8) = nxt[q];
            if (i + 1 < nt) {
#pragma unroll
                for (int q = 0; q < 4; ++q) nxt[q] = *(const u32x4*)(sub + (size_t)(gw + (p0 + i + 1) * NGW) * 2048 + lane * 32 + q * 8); }
            peer_select(srl, lane, elist, gl, sscr, (unsigned*)(wb + 8192));
#if PROBE_SEL
            asm volatile("" : "+v"(lane)); peer_select(srl, lane, elist, gl, sscr, (unsigned*)(wb + 8192));
#endif
            tmp[i * 128 + lane] = ((unsigned)(i * 128 + lane) << 14) | (unsigned)elist[lane];
            tmp[i * 128 + 64 + lane] = ((unsigned)(i * 128 + 64 + lane) << 14) | (unsigned)elist[64 + lane];
            gl16[i * 128 + lane] = (unsigned short)(cvt_pk_bf16(gl[lane], 0.f) & 0xffffu); gl16[i * 128 + 64 + lane] = (unsigned short)(cvt_pk_bf16(gl[64 + lane], 0.f) & 0xffffu);
        }
        asm volatile("" : "+v"(lane));
        if (lane < 32) hist[lane] = 0u;
        unsigned ent[8]; unsigned rk[8];
#pragma unroll
        for (int q = 0; q < 8; ++q) { const int e = q * 64 + lane; ent[q] = (e < ne) ? tmp[e] : 0u; rk[q] = (e < ne) ? atomicAdd(&hist[(ent[q] & 0x3FFFu) >> 9], 1u) : 0u; }
        { int hv = lane < 32 ? (int)hist[lane] : 0; int x = hv;
          x += __builtin_amdgcn_update_dpp(0, x, 0x111, 0xF, 0xF, true); x += __builtin_amdgcn_update_dpp(0, x, 0x112, 0xF, 0xF, true);
          x += __builtin_amdgcn_update_dpp(0, x, 0x114, 0xF, 0xF, true); x += __builtin_amdgcn_update_dpp(0, x, 0x118, 0xF, 0xF, true);
          const int t0 = __builtin_amdgcn_readlane(x, 15); if (lane >= 16) x += t0;
          if (lane < 32) base[lane] = (unsigned)(x - hv); }
#pragma unroll
        for (int q = 0; q < 8; ++q) { const int e = q * 64 + lane; if (e < ne) wls[base[(ent[q] & 0x3FFFu) >> 9] + rk[q]] = ent[q]; }
#pragma unroll 1
        for (int i = 0; i < nt; ++i) { const bf16_t* hr = h2 + (size_t)(gw + (p0 + i) * NGW) * 2048 + lane * 16;
#pragma unroll
            for (int hh = 0; hh < 2; ++hh) { const u32x4 a = *(const u32x4*)(hr + hh * 1024), b = *(const u32x4*)(hr + hh * 1024 + 8);
                *(u32x4*)(h2b + i * 4096 + hh * 2048 + lane * 32) = a; *(u32x4*)(h2b + i * 4096 + hh * 2048 + lane * 32 + 16) = b; } }
        asm volatile("s_waitcnt vmcnt(0)" ::: "memory");
        unsigned entn = __hip_atomic_load(wls + lane, __ATOMIC_RELAXED, __HIP_MEMORY_SCOPE_AGENT);
#pragma unroll 1
        for (int c = 0; c < ne; c += 64) {
            const unsigned ent64 = entn;
            if (c + 64 < ne) entn = __hip_atomic_load(wls + c + 64 + lane, __ATOMIC_RELAXED, __HIP_MEMORY_SCOPE_AGENT);
#pragma unroll 1
            for (int i0 = 0; i0 < 64; i0 += 8) {
                u32x4 w[8][2]; unsigned en[8];
#pragma unroll
                for (int jj = 0; jj < 8; ++jj) { en[jj] = (unsigned)__builtin_amdgcn_readlane((int)ent64, i0 + jj); const unsigned char* ur = pu + (size_t)(en[jj] & 0x3FFFu) * 2048 + lane * 16;
                    w[jj][0] = *(const u32x4*)ur; w[jj][1] = *(const u32x4*)(ur + 1024); }
                float pr[8];
#pragma unroll
                for (int jj = 0; jj < 8; ++jj) { const unsigned char* hp = h2b + (en[jj] >> 21) * 4096 + lane * 32;
                    pr[jj] = dot32_f8b(w[jj][0], w[jj][1], *(const u32x4*)hp, *(const u32x4*)(hp + 16), *(const u32x4*)(hp + 2048), *(const u32x4*)(hp + 2064)); __builtin_amdgcn_sched_barrier(0); }
#pragma unroll
                for (int i = 0; i < 4; ++i) pr[i] = swap32_pair(pr[i], pr[i + 4]);
#pragma unroll
                for (int i = 0; i < 2; ++i) pr[i] = swap16_pair(pr[i], pr[i + 2]);
                const bool b3 = (lane & 8) != 0;
                { const float snd = b3 ? pr[0] : pr[1], kp = b3 ? pr[1] : pr[0]; pr[0] = kp + dpp_f<DPP_ROR8>(snd); }
                float tot = pr[0]; tot += dpp_f<DPP_XOR1>(tot); tot += dpp_f<DPP_XOR2>(tot); tot += dpp_f<DPP_HMIRROR>(tot);
                const unsigned em = (unsigned)__shfl((int)ent64, i0 + (lane >> 3));
                if ((lane & 7) == 0) {
                    const int tk = (int)(em >> 21), j = (int)((em >> 14) & 127u), row = gw + (p0 + tk) * NGW;
                    const float cf = gelu_erf(tot * (1.0f / 64.0f)) * __uint_as_float((unsigned)gl16[tk * 128 + j] << 16);
                    pairs[((size_t)(row >> 6) * 128 + j) * 64 + (row & 63)] = (cvt_pk_bf16(0.f, cf) & 0xffff0000u) | (em & 0x3FFFu);
                }
            }
        }
    }
}

__device__ __forceinline__ void phase11_peer_v(Frame& F, float* dst) {
    const unsigned* pairs = (const unsigned*)(F.ws + WS_PAIRS); const float* mf = (const float*)(F.ws + WS_MODF);
    unsigned long long* vs = (unsigned long long*)F.lds;
    for (int c = F.bid; c < DM / 8; c += F.G) {
        __syncthreads();
        { const u32x4* src = (const u32x4*)(F.ws + WS_PV + (size_t)c * NEXP * 8); u32x4* dst = (u32x4*)F.lds;
#pragma unroll 4
          for (int i = F.tid; i < NEXP * 8 / 16; i += 512) dst[i] = src[i]; }
        __syncthreads();
        for (int tile = F.wave; tile < MTOK / 64; tile += 8) {
            int lane = F.lane; asm volatile("" : "+v"(lane));
            const unsigned* pp = pairs + (size_t)tile * 128 * 64 + lane;
            f32x2 acc[4];
#pragma unroll
            for (int i = 0; i < 4; ++i) acc[i] = (f32x2){0.f, 0.f};
#define P11_LOAD(dst, j0) do { _Pragma("unroll") for (int jj = 0; jj < 16; ++jj) dst[jj] = pp[((j0) + jj) * 64]; } while (0)
#define P11_COMP(src) do { _Pragma("unroll") for (int jj = 0; jj < 16; ++jj) { const unsigned long long v = vs[src[jj] & 0x3FFFu]; const float cf = __uint_as_float(src[jj] & 0xffff0000u); \
                    const int lo = (int)(unsigned)v, hi = (int)(unsigned)(v >> 32); \
                    acc[0] += __builtin_amdgcn_cvt_pk_f32_fp8(lo, false) * cf; acc[1] += __builtin_amdgcn_cvt_pk_f32_fp8(lo, true) * cf; \
                    acc[2] += __builtin_amdgcn_cvt_pk_f32_fp8(hi, false) * cf; acc[3] += __builtin_amdgcn_cvt_pk_f32_fp8(hi, true) * cf; } } while (0)
#if PROBE_P11X
            { f32x2 sv[4]; for (int i = 0; i < 4; ++i) sv[i] = acc[i];
            unsigned pa[16], pb[16];
            P11_LOAD(pa, 0);
#pragma unroll 1
            for (int j0 = 0; j0 < 128; j0 += 32) {
                P11_LOAD(pb, j0 + 16);
                P11_COMP(pa);
                if (j0 + 32 < 128) P11_LOAD(pa, j0 + 32);
                P11_COMP(pb);
            }
              asm volatile("" :: "v"(acc[0].x), "v"(acc[1].x), "v"(acc[2].x), "v"(acc[3].x)); for (int i = 0; i < 4; ++i) acc[i] = sv[i] * 0.f; }
#endif
            unsigned pa[16], pb[16];
            P11_LOAD(pa, 0);
#pragma unroll 1
            for (int j0 = 0; j0 < 128; j0 += 32) {
                P11_LOAD(pb, j0 + 16);
                P11_COMP(pa);
                if (j0 + 32 < 128) P11_LOAD(pa, j0 + 32);
                P11_COMP(pb);
            }
#undef P11_LOAD
#undef P11_COMP
            const int row = tile * 64 + lane;
            const float* gt2 = mf + (size_t)(tile / (SEQ / 64)) * 12288 + 10240 + c * 8;
            const float* ip = F.out + (size_t)row * 2048 + c * 8; float* op = dst + (size_t)row * 2048 + c * 8;
            const f32x4 x0 = *(const f32x4*)ip, x1 = *(const f32x4*)(ip + 4), g0 = *(const f32x4*)gt2 * 0.25f, g1 = *(const f32x4*)(gt2 + 4) * 0.25f;
            *(f32x4*)op = x0 + g0 * (f32x4){acc[0].x, acc[0].y, acc[1].x, acc[1].y};
            *(f32x4*)(op + 4) = x1 + g1 * (f32x4){acc[2].x, acc[2].y, acc[3].x, acc[3].y};
        }
    }
}

__global__ void __launch_bounds__(512, 2) fwd_kernel(Args args) {
    extern __shared__ __attribute__((aligned(16))) unsigned char lds[];
    Frame F;
    F.lds = lds; F.ws = args.ws; F.tid = threadIdx.x; F.lane = F.tid & 63; F.wave = __builtin_amdgcn_readfirstlane(F.tid >> 6); F.G = gridDim.x; F.bid = blockIdx.x;
    F.x = args.in[0]; F.c = args.in[1]; F.w_ada = args.in[2]; F.b_ada = args.in[3]; F.g1 = args.in[4]; F.g2 = args.in[5]; F.w_in = args.in[6]; F.g_q = args.in[7]; F.g_k = args.in[8];
    F.rel_bias = args.in[9]; F.pool_w = args.in[10]; F.pool_scale = args.in[11]; F.w_ab = args.in[12]; F.w_pb = args.in[13]; F.w_out = args.in[14]; F.w_pq = args.in[15];
    F.peer_keys = args.in[16]; F.peer_u = args.in[17]; F.peer_v = args.in[18]; F.out = args.out;
    LAS unsigned char* ldsl = (LAS unsigned char*)lds;
    volatile LAS unsigned* misc = (volatile LAS unsigned*)(ldsl + MISC_OFF);
    if (F.tid < 4) misc[F.tid] = 0u;
    __syncthreads();
    unsigned* barw = (unsigned*)(args.ws + WS_CTL) + (size_t)args.li * XCD_BAR_WORDS;
    XcdBarrier bar; bar.bar = barw; bar.x = 0; bar.st = misc;
    const int lo = args.ph_lo, hi = args.ph_hi;
    if (hi - lo > 1) bar = xcd_barrier_post(barw, misc);
#define IN(k) (lo <= (k) && (k) < hi)
#define SEAM(k) do { if (IN(k) && IN((k) + 1)) xcd_barrier(bar); } while (0)
    bf16_t* R0 = (bf16_t*)(F.ws + WS_R0);

#define PH2_BODY { \
        pg8::Gemm g{R0, (const bf16_t*)(F.ws + WS_WIN), MTOK, INWP, DM, DM, 0, nullptr, nullptr, 0, 0}; pg8::StaticOrder S; S.init(MTOK, INWP, F.G, F.bid); \
        EpiInproj E{(bf16_t*)(F.ws + WS_QN), (bf16_t*)(F.ws + WS_KN), (bf16_t*)(F.ws + WS_V), (bf16_t*)(F.ws + WS_IQ), (bf16_t*)(F.ws + WS_IK), (bf16_t*)(F.ws + WS_PL), \
                    (bf16_t*)(F.ws + WS_GA), (bf16_t*)(F.ws + WS_GP), (float*)(F.ws + WS_IW)}; \
        pg8::gemm_phase<EpiInproj>(ldsl, g, S, E); }
#define PH3_BODY { phase3_pooled(F); phase3_indexer(F); __syncthreads(); }
#define PH4_BODY { \
        phase4_attention(F); \
        __syncthreads(); \
        pg8::Gemm g{(const bf16_t*)(F.ws + WS_POOLED), (const bf16_t*)(F.ws + WS_POOLW), MTOK, PW, 256, 1024, 256, nullptr, nullptr, 0, 0}; pg8::StaticOrder S; S.init(MTOK, PW, F.G, F.bid); \
        EpiBf16Scale E{(bf16_t*)(F.ws + WS_POOL2), 1024, F.pool_scale}; \
        pg8::gemm_phase<EpiBf16Scale>(ldsl, g, S, E); }
#define PH5_BODY { \
        pg8::Gemm g{(const bf16_t*)(F.ws + WS_ATTN), (const bf16_t*)(F.ws + WS_WAB), MTOK, DM, 2048, 1024, 0, (const bf16_t*)(F.ws + WS_POOL2), (const bf16_t*)(F.ws + WS_WPB), 16, 1024}; \
        pg8::StaticOrder S; S.init(MTOK, DM, F.G, F.bid); \
        EpiMerge E{R0, (const bf16_t*)(F.ws + WS_GA), (const bf16_t*)(F.ws + WS_GP)}; pg8::gemm_phase<EpiMerge>(ldsl, g, S, E); }
#define PH6_BODY { \
        pg8::Gemm g{R0, (const bf16_t*)(F.ws + WS_WOUT), MTOK, DM, DM, DM, 0, nullptr, nullptr, 0, 0}; pg8::StaticOrder S; S.init(MTOK, DM, F.G, F.bid); \
        EpiResid E{F.x, F.out, (const float*)(F.ws + WS_MODF) + 4096}; pg8::gemm_phase<EpiResid>(ldsl, g, S, E); }
#define PH8_BODY { \
        pg8::Gemm g{(const bf16_t*)(F.ws + WS_H2), (const bf16_t*)(F.ws + WS_WPQ), MTOK, DM, DM, DM, 0, nullptr, nullptr, 0, 0}; pg8::StaticOrder S; S.init(MTOK, DM, F.G, F.bid); \
        EpiBf16Scale E{R0, 2048, nullptr}; pg8::gemm_phase<EpiBf16Scale>(ldsl, g, S, E); }
#define PH9_BODY { \
        pg8::Gemm g{R0, (const bf16_t*)(F.ws + WS_KEYSBD), MTOK, DM, 256, DM, 256, nullptr, nullptr, 0, 0}; pg8::StaticOrder S; S.init(MTOK, DM, F.G, F.bid); \
        EpiBf16Scale E{(bf16_t*)(F.ws + WS_SUB), 2048, nullptr}; pg8::gemm_phase<EpiBf16Scale>(ldsl, g, S, E); }
#define REP(k) if constexpr (((PROBE_REP) >> (k)) & 1)

    if (IN(0)) { phase0_prep(F); REP(0) { __syncthreads(); phase0_prep(F); } }
    SEAM(0);
    if (IN(1)) { phase_modnorm<true>(F, F.x, F.g1, 0, 2048, R0); REP(1) { phase_modnorm<true>(F, F.x, F.g1, 0, 2048, R0); } }
    SEAM(1);
    if (IN(2)) { PH2_BODY REP(2) PH2_BODY }
    SEAM(2);
    if (IN(3)) { phase3_qknorm(F); PH3_BODY REP(3) PH3_BODY }
    SEAM(3);
    if (IN(4)) { PH4_BODY REP(4) PH4_BODY }
    SEAM(4);
    if (IN(5)) { PH5_BODY REP(5) PH5_BODY }
    SEAM(5);
    if (IN(6)) { PH6_BODY REP(6) PH6_BODY }
    SEAM(6);
    if (IN(7)) { phase_modnorm<false>(F, F.out, F.g2, 6144, 8192, (bf16_t*)(F.ws + WS_H2)); REP(7) { phase_modnorm<false>(F, F.out, F.g2, 6144, 8192, (bf16_t*)(F.ws + WS_H2)); } }
    SEAM(7);
    if (IN(8)) { PH8_BODY REP(8) PH8_BODY }
    SEAM(8);
    if (IN(9)) { PH9_BODY REP(9) PH9_BODY }
    SEAM(9);
    if (IN(10)) { phase10_peer(F); REP(10) phase10_peer(F); }
    SEAM(10);
    if (IN(11)) { REP(11) { phase11_peer_v(F, (float*)(F.ws + WS_SUB)); } phase11_peer_v(F, F.out); }
#undef IN
#undef SEAM
}

extern "C" void kernel_launch(void* const* d_in, const int* in_sizes, int n_in, void* d_out, int out_size, void* d_ws, size_t ws_size, hipStream_t stream) {
    static int grid = 0;
    if (grid == 0) {
        if (n_in != 19 || out_size != MTOK * DM || ws_size < WS_END) { fprintf(stderr, "kernel_launch: unexpected shapes (n_in %d out %d ws %zu)\n", n_in, out_size, ws_size); grid = -1; return; }
        int dev = 0, cus = 0, per_cu = 0;
        if (hipGetDevice(&dev) != hipSuccess || hipDeviceGetAttribute(&cus, hipDeviceAttributeMultiprocessorCount, dev) != hipSuccess) { grid = -1; return; }
        if (hipFuncSetAttribute((const void*)fwd_kernel, hipFuncAttributeMaxDynamicSharedMemorySize, LDS_BYTES) != hipSuccess) { fprintf(stderr, "kernel_launch: hipFuncSetAttribute failed\n"); grid = -1; return; }
        if (hipOccupancyMaxActiveBlocksPerMultiprocessor(&per_cu, (const void*)fwd_kernel, 512, LDS_BYTES) != hipSuccess || per_cu < 1) { fprintf(stderr, "kernel_launch: occupancy query says %d\n", per_cu); }
        (void)hipGetLastError();
        grid = cus;
    }
    if (grid < 0) return;
    (void)in_sizes;
    if (hipMemsetAsync((char*)d_ws + WS_CTL, 0, CTL_ZERO_BYTES, stream) != hipSuccess) return;
    Args a{};
    for (int i = 0; i < 19; ++i) a.in[i] = (const float*)d_in[i];
    a.out = (float*)d_out; a.ws = (unsigned char*)d_ws;
#if MK_PER_PHASE
    for (int p = 0; p < NPHASE; ++p) { a.ph_lo = p; a.ph_hi = p + 1; a.li = p; hipLaunchKernelGGL(fwd_kernel, dim3(grid), dim3(512), LDS_BYTES, stream, a); }
#else
    a.ph_lo = 0; a.ph_hi = NPHASE; a.li = 0;
    hipLaunchKernelGGL(fwd_kernel, dim3(grid), dim3(512), LDS_BYTES, stream, a);
#endif
}
```

```cpp
#include <hip/hip_runtime.h>
#include <cstdio>
#include <cstdint>

#ifndef MK_PER_PHASE
#define MK_PER_PHASE 0
#endif

#ifndef PROBE_REP
#define PROBE_REP 0
#endif
#ifndef PROBE_IDX
#define PROBE_IDX 0
#endif
#ifndef PROBE_SEL
#define PROBE_SEL 0
#endif
#ifndef PROBE_P11X
#define PROBE_P11X 0
#endif
#define LAS __attribute__((address_space(3)))
typedef unsigned short bf16_t;
typedef short bf16x8 __attribute__((ext_vector_type(8)));
typedef float f32x4 __attribute__((ext_vector_type(4)));
typedef float f32x2 __attribute__((ext_vector_type(2)));
typedef unsigned u32x4 __attribute__((ext_vector_type(4)));
typedef unsigned u32x2 __attribute__((ext_vector_type(2)));

constexpr int BATCH = 8, SEQ = 4096, DM = 2048, MTOK = BATCH * SEQ;
constexpr int NHEAD = 8, HDIM = 128, AW = 1024, KVW = 256, IHEADS = 16, IDIM = 64, KSEL = 256;
constexpr int PW = 1024, PHEADS = 8, NEXP = 16384;
constexpr int INW = 7760, INWP = 7936;
constexpr float EPS = 1e-6f;
constexpr int NPHASE = 12;

constexpr size_t MiB = 1u << 20;
constexpr size_t WS_CTL = 0, CTL_ZERO_BYTES = 256 * 1024;
constexpr size_t WS_MODP = 2 * MiB;
constexpr size_t WS_MODF = 4 * MiB;
constexpr size_t WS_POOLW = 5 * MiB;
constexpr size_t WS_KEYSBD = 6 * MiB;
constexpr size_t WS_WIN = 8 * MiB;
constexpr size_t WS_WAB = 40 * MiB, WS_WPB = 44 * MiB, WS_WOUT = 48 * MiB, WS_WPQ = 56 * MiB;
constexpr size_t WS_PU = 64 * MiB, WS_PV = 128 * MiB;
constexpr size_t WS_R0 = 192 * MiB;
constexpr size_t WS_GA = 320 * MiB, WS_GP = 448 * MiB;
constexpr size_t WS_SUB = 320 * MiB;
constexpr size_t WS_QN = 576 * MiB;
constexpr size_t WS_IQ = 640 * MiB;
constexpr size_t WS_PL = 704 * MiB;
constexpr size_t WS_KN = 768 * MiB, WS_V = 784 * MiB;
constexpr size_t WS_IK = 800 * MiB;
constexpr size_t WS_IW = 804 * MiB;
constexpr size_t WS_SEL = 806 * MiB;
constexpr size_t WS_POOLED = 822 * MiB;
constexpr size_t WS_H2 = 886 * MiB;
constexpr size_t WS_END = 1014 * MiB;
constexpr size_t WS_Q8 = WS_H2, WS_K8 = WS_H2 + 32 * MiB, WS_V8 = WS_H2 + 40 * MiB;
constexpr size_t WS_ATTN = WS_IQ, WS_POOL2 = WS_PL, WS_PAIRS = WS_QN, WS_WLS = WS_QN + 32 * MiB;

constexpr int LDS_BYTES = 160 * 1024;
constexpr int MISC_OFF = 159 * 1024;

__device__ __forceinline__ unsigned cvt_pk_bf16(float lo, float hi) { unsigned r; asm volatile("v_cvt_pk_bf16_f32 %0, %1, %2" : "=v"(r) : "v"(lo), "v"(hi)); return r; }
__device__ __forceinline__ float bf_lo(unsigned w) { return __uint_as_float(w << 16); }
__device__ __forceinline__ float bf_hi(unsigned w) { return __uint_as_float(w & 0xffff0000u); }
template <int CTRL> __device__ __forceinline__ float dpp_f(float x) { return __int_as_float(__builtin_amdgcn_update_dpp(0, __float_as_int(x), CTRL, 0xF, 0xF, true)); }
#define DPP_XOR1 0xB1
#define DPP_XOR2 0x4E
#define DPP_HMIRROR 0x141
#define DPP_MIRROR 0x140
#define DPP_ROR8 0x128
__device__ __forceinline__ float xor16_sum(float x) { const auto r = __builtin_amdgcn_permlane16_swap(__float_as_uint(x), __float_as_uint(x), false, false); return __uint_as_float(r[0]) + __uint_as_float(r[1]); }
__device__ __forceinline__ float xor32_sum(float x) { const auto r = __builtin_amdgcn_permlane32_swap(__float_as_uint(x), __float_as_uint(x), false, false); return __uint_as_float(r[0]) + __uint_as_float(r[1]); }
__device__ __forceinline__ float xor16_max(float x) { const auto r = __builtin_amdgcn_permlane16_swap(__float_as_uint(x), __float_as_uint(x), false, false); return fmaxf(__uint_as_float(r[0]), __uint_as_float(r[1])); }
__device__ __forceinline__ float swap32_pair(float a, float b) { const auto r = __builtin_amdgcn_permlane32_swap(__float_as_uint(a), __float_as_uint(b), false, false); return __uint_as_float(r[0]) + __uint_as_float(r[1]); }
__device__ __forceinline__ float swap16_pair(float a, float b) { const auto r = __builtin_amdgcn_permlane16_swap(__float_as_uint(a), __float_as_uint(b), false, false); return __uint_as_float(r[0]) + __uint_as_float(r[1]); }
__device__ __forceinline__ float row_sum16(float v) { v += dpp_f<DPP_XOR1>(v); v += dpp_f<DPP_XOR2>(v); v += dpp_f<DPP_HMIRROR>(v); v += dpp_f<DPP_MIRROR>(v); return v; }
__device__ __forceinline__ float row_max16(float v) { v = fmaxf(v, dpp_f<DPP_XOR1>(v)); v = fmaxf(v, dpp_f<DPP_XOR2>(v)); v = fmaxf(v, dpp_f<DPP_HMIRROR>(v)); v = fmaxf(v, dpp_f<DPP_MIRROR>(v)); return v; }
__device__ __forceinline__ float wave_sum(float v) { return xor32_sum(xor16_sum(row_sum16(v))); }
__device__ __forceinline__ float sigmoidf_(float x) { return __builtin_amdgcn_rcpf(1.0f + __expf(-x)); }
__device__ __forceinline__ float dot8(u32x4 w, const float* h) {
    return bf_lo(w.x) * h[0] + bf_hi(w.x) * h[1] + bf_lo(w.y) * h[2] + bf_hi(w.y) * h[3] + bf_lo(w.z) * h[4] + bf_hi(w.z) * h[5] + bf_lo(w.w) * h[6] + bf_hi(w.w) * h[7];
}

#define XB_TMO      128
#define XB_XCNT(j)  (256  + 64 * (j))
#define XB_XSUB(j)  (1280 + 64 * (j))
#define XB_XGEN(j)  (2304 + 64 * (j))
#define XB_TOP      3328
#define XB_TOPGEN   3392
#define XCD_BAR_WORDS 3456
#define XB_SPIN_CAP (1u << 18)

__device__ __forceinline__ unsigned xb_ld(unsigned* p)              { return __hip_atomic_load(p, __ATOMIC_RELAXED, __HIP_MEMORY_SCOPE_AGENT); }
__device__ __forceinline__ unsigned xb_add(unsigned* p, unsigned v) { return __hip_atomic_fetch_add(p, v, __ATOMIC_RELAXED, __HIP_MEMORY_SCOPE_AGENT); }
__device__ __forceinline__ unsigned xb_xcc_id() { return (unsigned)__builtin_amdgcn_s_getreg((3 << 11) | 20) & 0xFu; }
#define XB_SPIN(cond, bar) do { unsigned _sp = 0; while (cond) { __builtin_amdgcn_s_sleep(1); \
    if ((++_sp & 255u) == 0u) { if (xb_ld(&(bar)[XB_TMO])) break; if (_sp > XB_SPIN_CAP) { atomicAdd(&(bar)[XB_TMO], 1u); break; } } } } while (0)

struct XcdBarrier { unsigned* bar; unsigned x; volatile LAS unsigned* st; };

__device__ __forceinline__ XcdBarrier xcd_barrier_post(unsigned* bar, volatile LAS unsigned* st) {
    XcdBarrier b; b.bar = bar; b.x = xb_xcc_id(); b.st = st;
    if (threadIdx.x == 0) (void)xb_add(&bar[XB_XCNT(b.x)], 1u);
    return b;
}
__device__ __forceinline__ void xcd_barrier_complete(unsigned* bar, unsigned x, unsigned& nloc, unsigned& nx) {
    const unsigned G = gridDim.x * gridDim.y * gridDim.z;
    unsigned sum, cnt, mine, sp = 0u;
    for (;;) {
        sum = 0u; cnt = 0u; mine = 0u;
#pragma unroll
        for (unsigned j = 0; j < 16; ++j) { const unsigned c = xb_ld(&bar[XB_XCNT(j)]); sum += c; cnt += (c > 0u) ? 1u : 0u; mine = (j == x) ? c : mine; }
        if (sum == G) break;
        __builtin_amdgcn_s_sleep(1);
        if ((++sp & 255u) == 0u) { if (xb_ld(&bar[XB_TMO])) break; if (sp > XB_SPIN_CAP) { atomicAdd(&bar[XB_TMO], 1u); break; } }
    }
    nloc = mine > 0u ? mine : 1u; nx = cnt > 0u ? cnt : 1u;
}
__device__ __forceinline__ void xcd_barrier(const XcdBarrier& b) {
    asm volatile("s_waitcnt vmcnt(0)" ::: "memory");
    __syncthreads();
    if (threadIdx.x == 0) {
        unsigned* bar = b.bar;
        __builtin_amdgcn_s_waitcnt(0);
        unsigned nloc = b.st[0], nx = b.st[1];
        if (nloc == 0u) { xcd_barrier_complete(bar, b.x, nloc, nx); b.st[0] = nloc; b.st[1] = nx; }
        const unsigned old = xb_add(&bar[XB_XSUB(b.x)], 1u);
        const unsigned gen = old / nloc;
        if (old + 1u == (gen + 1u) * nloc) {
            __builtin_amdgcn_fence(__ATOMIC_RELEASE, "agent");
            asm volatile("s_waitcnt vmcnt(0)" ::: "memory");
            const unsigned og = xb_add(&bar[XB_TOP], 1u);
            const unsigned tg = og / nx;
            if (og + 1u == (tg + 1u) * nx) xb_add(&bar[XB_TOPGEN], 1u);
            else XB_SPIN(xb_ld(&bar[XB_TOPGEN]) == tg, bar);
            __builtin_amdgcn_fence(__ATOMIC_ACQUIRE, "agent");
            xb_add(&bar[XB_XGEN(b.x)], 1u);
            asm volatile("s_waitcnt vmcnt(0)" ::: "memory");
        } else {
            XB_SPIN(xb_ld(&bar[XB_XGEN(b.x)]) == gen, bar);
            __builtin_amdgcn_fence(__ATOMIC_ACQUIRE, "agent");
            asm volatile("s_waitcnt vmcnt(0)" ::: "memory");
        }
    }
    __syncthreads();
}

namespace pg8 {
constexpr int BM = 256, BK = 64, HALF = 128, HTB = HALF * BK * 2, STAGE_BYTES = 8 * HTB, NXCD = 8, WGM = 8;
__device__ __forceinline__ int lds_byte(int r, int c) { const int st = (r >> 4) * 2 + (c >> 5), rr = r & 15, cc = c & 31, ob = rr * 64 + cc * 2; return st * 1024 + (ob ^ (((ob >> 9) & 1) << 5)); }
__device__ __forceinline__ void stage_rc(int b, int& R, int& C) { const int st = b / 1024, sb = b % 1024, swz = sb ^ (((sb >> 9) & 1) << 5); R = (st >> 1) * 16 + swz / 64; C = (st & 1) * 32 + (swz % 64) / 2; }
__device__ __forceinline__ int perm32(int rho) { const int n = rho >> 4, i = rho & 15; return 8 * (i >> 2) + 4 * n + (i & 3); }

struct Unit { int pm, pn; };
struct Gemm { const bf16_t* A; const bf16_t* Bt; int M, N, K, lda, a_pn_off; const bf16_t* A2; const bf16_t* Bt2; int ksplit, ldb; };

struct StaticOrder {
    int nM, nN, nwg, G, c;
    __device__ void init(int M, int N, int G_, int c_) { nM = M / BM; nN = N / BM; nwg = nM * nN; G = G_; c = c_; }
    __device__ bool next(int i, Unit& u) const {
        const long L = (long)i * G + c; if (L >= nwg) return false;
        int wgid = (int)L; { const int q = nwg / NXCD, r = nwg % NXCD, xcd = wgid % NXCD, off = wgid / NXCD; wgid = (xcd < r ? xcd * (q + 1) : r * (q + 1) + (xcd - r) * q) + off; }
        const int nig = WGM * nN, gid = wgid / nig, fm = gid * WGM, gsz = (nM - fm) < WGM ? (nM - fm) : WGM;
        u.pm = fm + ((wgid % nig) % gsz); u.pn = (wgid % nig) / gsz; return true;
    }
};

template <class Epi>
__device__ __forceinline__ void gemm_phase(LAS unsigned char* lds, const Gemm g, const StaticOrder& S, const Epi& E) {
    const int tid = threadIdx.x, wid = __builtin_amdgcn_readfirstlane(tid >> 6), lane = tid & 63, wr = wid >> 2, wc = wid & 3, fr = lane & 15, fq = lane >> 4;
    const int K = g.K, nt = K / BK, lda = g.lda, ldb = g.ldb ? g.ldb : g.K, ksplit = g.ksplit;
    unsigned voffA[2], voffB[2];
#pragma unroll
    for (int i = 0; i < 2; ++i) { int R, C; stage_rc(tid * 16 + i * 8192, R, C); const int Rb = Epi::PERM ? ((R & ~31) + perm32(R & 31)) : R;
        voffA[i] = (unsigned)(R * lda + C) * 2u; voffB[i] = (unsigned)(Rb * ldb + C) * 2u; }
    const size_t kstep = (size_t)(BK * 2);
    const size_t hsA = (size_t)HALF * lda * 2, hsB = (size_t)HALF * ldb * 2;
    const size_t tsA = 2 * hsA, tsB = 2 * hsB;
    const unsigned ldsw = (unsigned)wid * 1024u;
    const int aoff = lds_byte(wr * 64 + fr, fq * 8), boff = lds_byte(wc * 32 + fr, fq * 8);
#define PG8_SA(b, h) (((b) * 2 + (h)) * HTB)
#define PG8_SB(b, h) ((4 + (b) * 2 + (h)) * HTB)
#define PG8_STAGE(bufoff, gbase, voff) do { _Pragma("unroll") for (int _i = 0; _i < 2; ++_i) \
        __builtin_amdgcn_global_load_lds((const unsigned*)((const char*)(gbase) + (voff)[_i]), (LAS unsigned*)(lds + (bufoff) + ldsw + _i * 8192), 16, 0, 0); } while (0)
#define PG8_LDA(dst, b, h) do { _Pragma("unroll") for (int m = 0; m < 4; ++m) _Pragma("unroll") for (int k = 0; k < 2; ++k) dst[m][k] = *(const LAS bf16x8*)(lds + PG8_SA(b, h) + aoff + m * 2048 + k * 1024); } while (0)
#define PG8_LDB(dst, b, h) do { _Pragma("unroll") for (int n = 0; n < 2; ++n) _Pragma("unroll") for (int k = 0; k < 2; ++k) dst[n][k] = *(const LAS bf16x8*)(lds + PG8_SB(b, h) + boff + n * 2048 + k * 1024); } while (0)
#define PG8_MMA(ai, bj, At, Bt) do { __builtin_amdgcn_s_setprio(1); _Pragma("unroll") for (int m = 0; m < 4; ++m) _Pragma("unroll") for (int n = 0; n < 2; ++n) _Pragma("unroll") for (int k = 0; k < 2; ++k) \
        acc[ai][bj][m][n] = __builtin_amdgcn_mfma_f32_16x16x32_bf16(Bt[n][k], At[m][k], acc[ai][bj][m][n], 0, 0, 0); __builtin_amdgcn_s_setprio(0); } while (0)
#define PG8_WAIT_V(n) asm volatile("s_waitcnt vmcnt(" #n ")" ::: "memory")
#define PG8_WAIT_L(n) asm volatile("s_waitcnt lgkmcnt(" #n ")" ::: "memory")
#define PG8_BAR __builtin_amdgcn_s_barrier()
#define PG8_SCHED __builtin_amdgcn_sched_barrier(0)
    Unit cur, nxt; int ui = 0;
    if (!S.next(0, cur)) return;
    f32x4 acc[2][2][4][2];
#pragma unroll
    for (int a = 0; a < 2; ++a)
#pragma unroll
        for (int b = 0; b < 2; ++b)
#pragma unroll
            for (int m = 0; m < 4; ++m)
#pragma unroll
                for (int n = 0; n < 2; ++n) acc[a][b][m][n] = (f32x4){0.f, 0.f, 0.f, 0.f};
    bf16x8 At[4][2], B0[2][2], B1[2][2];
    const char* cA = (const char*)g.A + (size_t)cur.pm * tsA + (size_t)cur.pn * g.a_pn_off * 2; const char* cB = (const char*)g.Bt + (size_t)cur.pn * tsB;
    PG8_STAGE(PG8_SB(0, 0), cB, voffB); PG8_STAGE(PG8_SB(0, 1), cB + hsB, voffB); PG8_STAGE(PG8_SA(0, 0), cA, voffA); PG8_STAGE(PG8_SA(0, 1), cA + hsA, voffA);
    if (wr == 1) PG8_BAR;
    PG8_WAIT_V(2); PG8_BAR;
    PG8_STAGE(PG8_SB(1, 0), cB + kstep, voffB); PG8_STAGE(PG8_SA(1, 0), cA + kstep, voffA); PG8_STAGE(PG8_SB(1, 1), cB + hsB + kstep, voffB);
    PG8_WAIT_V(6); PG8_BAR;
    for (;;) {
        const bool has_next = S.next(ui + 1, nxt);
        const char* nA = has_next ? (const char*)g.A + (size_t)nxt.pm * tsA + (size_t)nxt.pn * g.a_pn_off * 2 : cA; const char* nB = has_next ? (const char*)g.Bt + (size_t)nxt.pn * tsB : cB;
        const char* cA2 = (const char*)g.A2 + (size_t)cur.pm * tsA; const char* cB2 = (const char*)g.Bt2 + (size_t)cur.pn * tsB;
        for (int t = 0; t < nt; t += 2) {
            const bool last = (t == nt - 2);
            const bool s1 = ksplit && (t >= ksplit), s2 = ksplit && (t + 2 >= ksplit);
            const char* a1 = (s1 ? cA2 + (size_t)(t - ksplit + 1) * kstep : cA + (size_t)(t + 1) * kstep);
            const char* a2 = last ? nA : (s2 ? cA2 + (size_t)(t + 2 - ksplit) * kstep : cA + (size_t)(t + 2) * kstep);
            const char* b2 = last ? nB : (s2 ? cB2 + (size_t)(t + 2 - ksplit) * kstep : cB + (size_t)(t + 2) * kstep);
            const char* a3 = a2 + kstep; const char* b3 = b2 + kstep;
            PG8_LDB(B0, 0, 0); PG8_LDB(B1, 0, 1); PG8_SCHED; PG8_LDA(At, 0, 0); PG8_STAGE(PG8_SA(1, 1), a1 + hsA, voffA);
            PG8_WAIT_V(8); PG8_WAIT_L(0); PG8_BAR; PG8_MMA(0, 0, At, B0); PG8_MMA(0, 1, At, B1); PG8_BAR; PG8_SCHED;
            PG8_LDA(At, 0, 1); PG8_STAGE(PG8_SB(0, 0), b2, voffB); PG8_STAGE(PG8_SB(0, 1), b2 + hsB, voffB); PG8_STAGE(PG8_SA(0, 0), a2, voffA);
            PG8_WAIT_V(8); PG8_WAIT_L(0); PG8_BAR; PG8_MMA(1, 0, At, B0); PG8_MMA(1, 1, At, B1); PG8_BAR; PG8_SCHED;
            PG8_LDB(B0, 1, 0); PG8_LDB(B1, 1, 1); PG8_SCHED; PG8_LDA(At, 1, 0); PG8_STAGE(PG8_SA(0, 1), a2 + hsA, voffA);
            PG8_WAIT_V(8); PG8_WAIT_L(0); PG8_BAR; PG8_MMA(0, 0, At, B0); PG8_MMA(0, 1, At, B1); PG8_BAR; PG8_SCHED;
            PG8_LDA(At, 1, 1); PG8_STAGE(PG8_SB(1, 0), b3, voffB); PG8_STAGE(PG8_SB(1, 1), b3 + hsB, voffB); PG8_STAGE(PG8_SA(1, 0), a3, voffA);
            PG8_WAIT_V(8); PG8_WAIT_L(0); PG8_BAR; PG8_MMA(1, 0, At, B0); PG8_MMA(1, 1, At, B1); PG8_BAR; PG8_SCHED;
            if constexpr (Epi::MID) { if (t + 2 == ksplit) E.mid(acc, cur, wr, wc, fr, fq); }
        }
        if (wr == 0) PG8_BAR;
        E(acc, cur, wr, wc, fr, fq);
        if (!has_next) break;
#pragma unroll
        for (int a = 0; a < 2; ++a)
#pragma unroll
            for (int b = 0; b < 2; ++b)
#pragma unroll
                for (int m = 0; m < 4; ++m)
#pragma unroll
                    for (int n = 0; n < 2; ++n) acc[a][b][m][n] = (f32x4){0.f, 0.f, 0.f, 0.f};
        cur = nxt; cA = nA; cB = nB; ++ui;
        if (wr == 1) PG8_BAR;
    }
    PG8_WAIT_V(0);
    PG8_BAR;
#undef PG8_SA
#undef PG8_SB
#undef PG8_STAGE
#undef PG8_LDA
#undef PG8_LDB
#undef PG8_MMA
#undef PG8_WAIT_V
#undef PG8_WAIT_L
#undef PG8_BAR
#undef PG8_SCHED
}
}
using pg8::Unit;

typedef f32x4 AccT[2][2][4][2];
__device__ __forceinline__ u32x4 pack8(f32x4 a, f32x4 b) { u32x4 w; w.x = cvt_pk_bf16(a[0], a[1]); w.y = cvt_pk_bf16(a[2], a[3]); w.z = cvt_pk_bf16(b[0], b[1]); w.w = cvt_pk_bf16(b[2], b[3]); return w; }
__device__ __forceinline__ void unpack8(u32x4 w, f32x4& a, f32x4& b) { a = (f32x4){bf_lo(w.x), bf_hi(w.x), bf_lo(w.y), bf_hi(w.y)}; b = (f32x4){bf_lo(w.z), bf_hi(w.z), bf_lo(w.w), bf_hi(w.w)}; }

struct EpiInproj {
    static constexpr bool PERM = true, MID = false;
    bf16_t *q, *k, *v, *iq, *ik, *pl, *ga, *gp; float* iw;
    __device__ __forceinline__ void operator()(const AccT& acc, const Unit& u, int wr, int wc, int fr, int fq) const {
        const int pn = u.pn, row0 = u.pm * 256 + wr * 64 + fr;
        if (pn == 10) {
            if (wc < 2) {
#pragma unroll
                for (int ai = 0; ai < 2; ++ai)
#pragma unroll
                    for (int m = 0; m < 4; ++m) { const size_t row = (size_t)(row0 + ai * 128 + m * 16);
                        *(u32x4*)(ik + row * 64 + wc * 32 + 8 * fq) = pack8(acc[ai][0][m][0], acc[ai][0][m][1]); }
            } else if (wc == 2) {
                if (fq < 2) {
#pragma unroll
                    for (int ai = 0; ai < 2; ++ai)
#pragma unroll
                        for (int m = 0; m < 4; ++m) { const size_t row = (size_t)(row0 + ai * 128 + m * 16);
                            *(f32x4*)(iw + row * 16 + 8 * fq) = acc[ai][0][m][0]; *(f32x4*)(iw + row * 16 + 8 * fq + 4) = acc[ai][0][m][1]; }
                }
            }
            return;
        }
        bf16_t* dst; int ld, tc; bool sg = false;
        if (pn < 4) { dst = q; ld = 1024; tc = pn * 256; }
        else if (pn == 4) { dst = k; ld = 256; tc = 0; }
        else if (pn == 5) { dst = v; ld = 256; tc = 0; }
        else if (pn < 10) { dst = iq; ld = 1024; tc = (pn - 6) * 256; }
        else if (pn < 15) { dst = pl; ld = 1024; tc = (pn - 11) * 256; }
        else if (pn < 23) { dst = ga; ld = 2048; tc = (pn - 15) * 256; sg = true; }
        else { dst = gp; ld = 2048; tc = (pn - 23) * 256; sg = true; }
        const int col0 = tc + wc * 32 + 8 * fq;
#pragma unroll
        for (int ai = 0; ai < 2; ++ai)
#pragma unroll
            for (int m = 0; m < 4; ++m) { bf16_t* rowp = dst + (size_t)(row0 + ai * 128 + m * 16) * ld + col0;
#pragma unroll
                for (int bj = 0; bj < 2; ++bj) { f32x4 v0 = acc[ai][bj][m][0], v1 = acc[ai][bj][m][1];
                    if (sg) {
#pragma unroll
                        for (int j = 0; j < 4; ++j) { v0[j] = sigmoidf_(v0[j]); v1[j] = sigmoidf_(v1[j]); } }
                    *(u32x4*)(rowp + bj * 128) = pack8(v0, v1); } }
    }
};
struct EpiBf16Scale {
    static constexpr bool PERM = true, MID = false;
    bf16_t* O; int ldc; const float* cs;
    __device__ __forceinline__ void operator()(const AccT& acc, const Unit& u, int wr, int wc, int fr, int fq) const {
        const int row0 = u.pm * 256 + wr * 64 + fr, col0 = u.pn * 256 + wc * 32 + 8 * fq;
        f32x4 s[2][2];
#pragma unroll
        for (int bj = 0; bj < 2; ++bj)
#pragma unroll
            for (int n = 0; n < 2; ++n) s[bj][n] = cs ? *(const f32x4*)(cs + col0 + bj * 128 + 4 * n) : (f32x4){1.f, 1.f, 1.f, 1.f};
#pragma unroll
        for (int ai = 0; ai < 2; ++ai)
#pragma unroll
            for (int m = 0; m < 4; ++m) { bf16_t* rowp = O + (size_t)(row0 + ai * 128 + m * 16) * ldc + col0;
#pragma unroll
                for (int bj = 0; bj < 2; ++bj) *(u32x4*)(rowp + bj * 128) = pack8(acc[ai][bj][m][0] * s[bj][0], acc[ai][bj][m][1] * s[bj][1]); }
    }
};
template <bool ADD> struct EpiGate {
    static constexpr bool PERM = true, MID = false;
    bf16_t* O; const bf16_t* gate;
    __device__ __forceinline__ void operator()(const AccT& acc, const Unit& u, int wr, int wc, int fr, int fq) const {
        const int row0 = u.pm * 256 + wr * 64 + fr, col0 = u.pn * 256 + wc * 32 + 8 * fq;
#pragma unroll
        for (int ai = 0; ai < 2; ++ai)
#pragma unroll
            for (int m = 0; m < 4; ++m) { const size_t off = (size_t)(row0 + ai * 128 + m * 16) * 2048 + col0;
#pragma unroll
                for (int bj = 0; bj < 2; ++bj) { f32x4 g0, g1; unpack8(*(const u32x4*)(gate + off + bj * 128), g0, g1);
                    f32x4 r0 = g0 * acc[ai][bj][m][0], r1 = g1 * acc[ai][bj][m][1];
                    if (ADD) { f32x4 o0, o1; unpack8(*(const u32x4*)(O + off + bj * 128), o0, o1); r0 += o0; r1 += o1; }
                    *(u32x4*)(O + off + bj * 128) = pack8(r0, r1); } }
    }
};
struct EpiMerge {
    static constexpr bool PERM = true, MID = true;
    bf16_t* O; const bf16_t* ga; const bf16_t* gp;
    __device__ __forceinline__ void mid(AccT& acc, const Unit& u, int wr, int wc, int fr, int fq) const {
        const auto ra = __builtin_amdgcn_make_buffer_rsrc((void*)ga, 0, 0x7FFFFFFF, 0x00020000), rp = __builtin_amdgcn_make_buffer_rsrc((void*)gp, 0, 0x7FFFFFFF, 0x00020000);
        const int voff = ((wr * 64 + fr) * 2048 + wc * 32 + 8 * fq) * 2;
        const int sbase = (u.pm * 256 * 2048 + u.pn * 256) * 2;
#pragma unroll
        for (int ai = 0; ai < 2; ++ai)
#pragma unroll
            for (int m = 0; m < 4; ++m)
#pragma unroll
                for (int bj = 0; bj < 2; ++bj) { const int so = sbase + ((ai * 128 + m * 16) * 2048 + bj * 128) * 2;
                    const u32x4 wa = __builtin_bit_cast(u32x4, __builtin_amdgcn_raw_buffer_load_b128(ra, voff, so, 0)), wp = __builtin_bit_cast(u32x4, __builtin_amdgcn_raw_buffer_load_b128(rp, voff, so, 0));
                    f32x4 a0, a1, p0, p1; unpack8(wa, a0, a1); unpack8(wp, p0, p1);
#pragma unroll
                    for (int j = 0; j < 4; ++j) { acc[ai][bj][m][0][j] *= a0[j] * __builtin_amdgcn_rcpf(p0[j]); acc[ai][bj][m][1][j] *= a1[j] * __builtin_amdgcn_rcpf(p1[j]); }
                    asm volatile("" : "+v"(acc[ai][bj][m][0]), "+v"(acc[ai][bj][m][1]) :: "memory"); }
    }
    __device__ __forceinline__ void operator()(const AccT& acc, const Unit& u, int wr, int wc, int fr, int fq) const {
        const int row0 = u.pm * 256 + wr * 64 + fr, col0 = u.pn * 256 + wc * 32 + 8 * fq;
#pragma unroll
        for (int ai = 0; ai < 2; ++ai)
#pragma unroll
            for (int m = 0; m < 4; ++m) { const size_t off = (size_t)(row0 + ai * 128 + m * 16) * 2048 + col0;
#pragma unroll
                for (int bj = 0; bj < 2; ++bj) { f32x4 p0, p1; unpack8(*(const u32x4*)(gp + off + bj * 128), p0, p1);
                    *(u32x4*)(O + off + bj * 128) = pack8(p0 * acc[ai][bj][m][0], p1 * acc[ai][bj][m][1]); } }
    }
};
struct EpiResid {
    static constexpr bool PERM = false, MID = false;
    const float* x; float* out; const float* gt;
    __device__ __forceinline__ void operator()(const AccT& acc, const Unit& u, int wr, int wc, int fr, int fq) const {
        const int row0 = u.pm * 256 + wr * 64 + fr, col0 = u.pn * 256 + wc * 32 + 4 * fq;
        const float* gtb = gt + (size_t)(u.pm / 16) * 12288;
        f32x4 g[2][2];
#pragma unroll
        for (int bj = 0; bj < 2; ++bj)
#pragma unroll
            for (int n = 0; n < 2; ++n) g[bj][n] = *(const f32x4*)(gtb + col0 + bj * 128 + n * 16);
#pragma unroll
        for (int ai = 0; ai < 2; ++ai)
#pragma unroll
            for (int m = 0; m < 4; ++m) { const size_t off = (size_t)(row0 + ai * 128 + m * 16) * 2048 + col0;
#pragma unroll
                for (int bj = 0; bj < 2; ++bj)
#pragma unroll
                    for (int n = 0; n < 2; ++n) { const f32x4 xv = *(const f32x4*)(x + off + bj * 128 + n * 16);
                        *(f32x4*)(out + off + bj * 128 + n * 16) = xv + g[bj][n] * acc[ai][bj][m][n]; } }
    }
};
struct EpiF32 {
    static constexpr bool PERM = false, MID = false;
    float* C; int ldc;
    __device__ __forceinline__ void operator()(const AccT& acc, const Unit& u, int wr, int wc, int fr, int fq) const {
        const int row0 = u.pm * 256 + wr * 64 + fr, col0 = u.pn * 256 + wc * 32 + 4 * fq;
#pragma unroll
        for (int ai = 0; ai < 2; ++ai)
#pragma unroll
            for (int m = 0; m < 4; ++m) { float* rowp = C + (size_t)(row0 + ai * 128 + m * 16) * ldc + col0;
#pragma unroll
                for (int bj = 0; bj < 2; ++bj)
#pragma unroll
                    for (int n = 0; n < 2; ++n) *(f32x4*)(rowp + bj * 128 + n * 16) = acc[ai][bj][m][n]; }
    }
};

struct Args { const float* in[19]; float* out; unsigned char* ws; int ph_lo, ph_hi; int li, pad; };
struct Frame {
    unsigned char* lds; unsigned char* ws;
    int tid, lane, wave, G, bid;
    const float *x, *c, *w_ada, *b_ada, *g1, *g2, *w_in, *g_q, *g_k, *rel_bias, *pool_w, *pool_scale, *w_ab, *w_pb, *w_out, *w_pq, *peer_keys, *peer_u, *peer_v;
    float* out;
};

template <class Fn> __device__ __forceinline__ void transpose_item(const float* W, int K, int N, bf16_t* WT, int ldk, int drow0, int k0, float* scr, int lane, Fn srccol) {
    const int sc = srccol(drow0 + (lane & 31));
#pragma unroll 8
    for (int i = 0; i < 32; ++i) { const int kk = 2 * i + (lane >> 5); scr[kk * 33 + (lane & 31)] = sc >= 0 ? W[(size_t)(k0 + kk) * N + sc] : 0.f; }
    asm volatile("s_waitcnt lgkmcnt(0)" ::: "memory");
    const int c = lane & 7;
#pragma unroll
    for (int j = 0; j < 4; ++j) { const int n = (lane >> 3) + 8 * j; const float* s = scr + (8 * c) * 33 + n;
        u32x4 o; o.x = cvt_pk_bf16(s[0 * 33], s[1 * 33]); o.y = cvt_pk_bf16(s[2 * 33], s[3 * 33]); o.z = cvt_pk_bf16(s[4 * 33], s[5 * 33]); o.w = cvt_pk_bf16(s[6 * 33], s[7 * 33]);
        *(u32x4*)(WT + (size_t)(drow0 + n) * ldk + k0 + 8 * c) = o; }
    asm volatile("s_waitcnt lgkmcnt(0)" ::: "memory");
}
__device__ __forceinline__ void phase0_prep(Frame& F) {
    const int gw = F.bid * 8 + F.wave, NGW = F.G * 8;
    float* scr = (float*)(F.lds + F.wave * 16384);
    constexpr int I_IN = (INWP / 32) * (DM / 64);
    constexpr int I_AB = (2048 / 32) * (1024 / 64), I_OUT = (2048 / 32) * (2048 / 64), I_PW = 4 * 8 * 4;
    constexpr int NIT = I_IN + 2 * I_AB + 2 * I_OUT + I_PW;
    auto ident = [](int j) { return j; };
    for (int it = gw; it < NIT; it += NGW) {
        int r = it;
        if (r < I_IN) { const int nb = r % (INWP / 32), kb = r / (INWP / 32);
            transpose_item(F.w_in, DM, INW, (bf16_t*)(F.ws + WS_WIN), DM, nb * 32, kb * 64, scr, F.lane, [](int j) { return j < 2640 ? j : (j < 2816 ? -1 : j - 176); }); continue; }
        r -= I_IN;
        if (r < I_AB) { transpose_item(F.w_ab, 1024, 2048, (bf16_t*)(F.ws + WS_WAB), 1024, (r % 64) * 32, (r / 64) * 64, scr, F.lane, ident); continue; }
        r -= I_AB;
        if (r < I_AB) { transpose_item(F.w_pb, 1024, 2048, (bf16_t*)(F.ws + WS_WPB), 1024, (r % 64) * 32, (r / 64) * 64, scr, F.lane, ident); continue; }
        r -= I_AB;
        if (r < I_OUT) { transpose_item(F.w_out, 2048, 2048, (bf16_t*)(F.ws + WS_WOUT), 2048, (r % 64) * 32, (r / 64) * 64, scr, F.lane, ident); continue; }
        r -= I_OUT;
        if (r < I_OUT) { transpose_item(F.w_pq, 2048, 2048, (bf16_t*)(F.ws + WS_WPQ), 2048, (r % 64) * 32, (r / 64) * 64, scr, F.lane, ident); continue; }
        r -= I_OUT;
        { const int g = r / 32, q = r % 32, nb = q % 8, kb = q / 8;
          transpose_item(F.pool_w + (size_t)g * 65536, 256, 256, (bf16_t*)(F.ws + WS_POOLW) + (size_t)g * 65536, 256, nb * 32, kb * 64, scr, F.lane, ident); }
    }
    {
        bf16_t* kb = (bf16_t*)(F.ws + WS_KEYSBD);
        for (int i = F.bid * 512 + F.tid; i < 2048 * 32; i += F.G * 512) {
            const int row = i / 32, k8 = (i % 32) * 8, p = (row >> 7) & 1;
            u32x4 o = (u32x4){0u, 0u, 0u, 0u};
            if ((k8 >> 7) == p) { const float* s = F.peer_keys + (size_t)row * 128 + (k8 & 127); const f32x4 a = *(const f32x4*)s, b = *(const f32x4*)(s + 4); o = pack8(a, b); }
            *(u32x4*)(kb + (size_t)row * 256 + k8) = o;
        }
    }
    {
        const size_t n16 = (size_t)NEXP * DM / 16;
        unsigned char* pu = F.ws + WS_PU;
        for (size_t i = (size_t)F.bid * 512 + F.tid; i < n16; i += (size_t)F.G * 512) {
            u32x4 ou;
#pragma unroll
            for (int k = 0; k < 4; ++k) { const f32x4 a = *(const f32x4*)(F.peer_u + i * 16 + k * 4) * 64.0f;
                int wu = __builtin_amdgcn_cvt_pk_fp8_f32(a[0], a[1], 0, false); wu = __builtin_amdgcn_cvt_pk_fp8_f32(a[2], a[3], wu, true); ou[k] = (unsigned)wu; }
            *(u32x4*)(pu + i * 16) = ou;
        }
        unsigned char* pv = F.ws + WS_PV;
        for (int it = gw; it < (NEXP / 64) * 128; it += NGW) {
            const int e = (it >> 7) * 64 + F.lane, ch = it & 127;
            u32x4 ov;
#pragma unroll
            for (int k = 0; k < 4; ++k) { const f32x4 c = *(const f32x4*)(F.peer_v + (size_t)e * DM + ch * 16 + k * 4) * 4.0f;
                int wv = __builtin_amdgcn_cvt_pk_fp8_f32(c[0], c[1], 0, false); wv = __builtin_amdgcn_cvt_pk_fp8_f32(c[2], c[3], wv, true); ov[k] = (unsigned)wv; }
            *(u32x2*)(pv + ((size_t)(2 * ch) * NEXP + e) * 8) = (u32x2){ov[0], ov[1]};
            *(u32x2*)(pv + ((size_t)(2 * ch + 1) * NEXP + e) * 8) = (u32x2){ov[2], ov[3]};
        }
    }
    {
        __syncthreads();
        float* cact = (float*)(F.lds + 131072);
        float* red = (float*)F.lds;
        float* mp = (float*)(F.ws + WS_MODP);
        for (int it = F.bid; it < 48 * 4; it += F.G) {
            const int cb = it % 48, ds = it / 48, d0 = ds * 512;
            for (int i = F.tid; i < 8 * 512; i += 512) { const int b = i >> 9, d = i & 511; const float cv = F.c[b * DM + d0 + d]; cact[i] = cv * sigmoidf_(cv); }
            __syncthreads();
            f32x4 a[8];
#pragma unroll
            for (int b = 0; b < 8; ++b) a[b] = (f32x4){0.f, 0.f, 0.f, 0.f};
            const float* wp = F.w_ada + (size_t)(d0 + F.wave * 64) * 12288 + cb * 256 + F.lane * 4;
#pragma unroll 4
            for (int d = 0; d < 64; ++d) { const f32x4 w = *(const f32x4*)(wp + (size_t)d * 12288);
#pragma unroll
                for (int b = 0; b < 8; ++b) a[b] += w * cact[b * 512 + F.wave * 64 + d]; }
#pragma unroll
            for (int b = 0; b < 8; ++b)
#pragma unroll
                for (int j = 0; j < 4; ++j) red[(F.wave * 32 + b * 4 + j) * 64 + F.lane] = a[b][j];
            __syncthreads();
            for (int i = F.tid; i < 2048; i += 512) { const int v = i >> 6, l = i & 63; float s = 0.f;
#pragma unroll
                for (int w = 0; w < 8; ++w) s += red[(w * 32 + v) * 64 + l];
                mp[((size_t)ds * 8 + (v >> 2)) * 12288 + cb * 256 + l * 4 + (v & 3)] = s; }
            __syncthreads();
        }
    }
}

template <bool FIRST> __device__ __forceinline__ void phase_modnorm(Frame& F, const float* xin, const float* gain, int off_sh, int off_sc, bf16_t* dst) {
    const float* mp = (const float*)(F.ws + WS_MODP); float* mf = (float*)(F.ws + WS_MODF);
    if (FIRST) {
        for (int i = F.bid * 512 + F.tid; i < 8 * 12288; i += F.G * 512) {
            float s = F.b_ada[i % 12288];
#pragma unroll
            for (int k = 0; k < 4; ++k) s += mp[(size_t)k * 8 * 12288 + i];
            mf[i] = s; }
    }
    float* cA = (float*)F.lds; float* cB = cA + 2048;
    for (int ch = F.bid; ch < MTOK / 128; ch += F.G) {
        const int b = ch / 32;
        __syncthreads();
        for (int col = F.tid; col < 2048; col += 512) {
            float sc, sh;
            if (FIRST) { sc = F.b_ada[off_sc + col]; sh = F.b_ada[off_sh + col];
#pragma unroll
                for (int k = 0; k < 4; ++k) { sc += mp[((size_t)k * 8 + b) * 12288 + off_sc + col]; sh += mp[((size_t)k * 8 + b) * 12288 + off_sh + col]; } }
            else { sc = mf[b * 12288 + off_sc + col]; sh = mf[b * 12288 + off_sh + col]; }
            cA[col] = gain[col] * (1.f + sc); cB[col] = sh; }
        __syncthreads();
        for (int r = F.wave; r < 128; r += 8) {
            const size_t row = (size_t)ch * 128 + r;
            const float* xr = xin + row * 2048 + F.lane * 8;
            f32x4 v[4][2]; float ss = 0.f;
#pragma unroll
            for (int i = 0; i < 4; ++i) { v[i][0] = *(const f32x4*)(xr + i * 512); v[i][1] = *(const f32x4*)(xr + i * 512 + 4);
#pragma unroll
                for (int j = 0; j < 4; ++j) ss += v[i][0][j] * v[i][0][j] + v[i][1][j] * v[i][1][j]; }
            ss = wave_sum(ss);
            const float rinv = 1.0f / sqrtf(ss * (1.0f / 2048.0f) + EPS);
#pragma unroll
            for (int i = 0; i < 4; ++i) { const int col = i * 512 + F.lane * 8;
                const f32x4 a0 = *(const f32x4*)(cA + col), a1 = *(const f32x4*)(cA + col + 4), b0 = *(const f32x4*)(cB + col), b1 = *(const f32x4*)(cB + col + 4);
                *(u32x4*)(dst + row * 2048 + col) = pack8(v[i][0] * rinv * a0 + b0, v[i][1] * rinv * a1 + b1); }
        }
    }
}

__device__ __forceinline__ u32x2 pack8_fp8(f32x4 a, f32x4 b) {
    int w0 = __builtin_amdgcn_cvt_pk_fp8_f32(a[0], a[1], 0, false); w0 = __builtin_amdgcn_cvt_pk_fp8_f32(a[2], a[3], w0, true);
    int w1 = __builtin_amdgcn_cvt_pk_fp8_f32(b[0], b[1], 0, false); w1 = __builtin_amdgcn_cvt_pk_fp8_f32(b[2], b[3], w1, true);
    return (u32x2){(unsigned)w0, (unsigned)w1};
}
__device__ __forceinline__ void phase3_qknorm(Frame& F) {
    const bf16_t* q = (const bf16_t*)(F.ws + WS_QN); const bf16_t* k = (const bf16_t*)(F.ws + WS_KN); const bf16_t* v = (const bf16_t*)(F.ws + WS_V);
    unsigned char* q8 = F.ws + WS_Q8; unsigned char* k8 = F.ws + WS_K8; unsigned char* v8 = F.ws + WS_V8;
    const int gw = F.bid * 8 + F.wave, NGW = F.G * 8;
    for (int row = gw; row < MTOK; row += NGW) {
#pragma unroll
        for (int i = 0; i < 2; ++i) { const int ci = i * 64 + F.lane;
            f32x4 a, b; unpack8(*(const u32x4*)(q + (size_t)row * 1024 + ci * 8), a, b);
            float ss = a[0] * a[0] + a[1] * a[1] + a[2] * a[2] + a[3] * a[3] + b[0] * b[0] + b[1] * b[1] + b[2] * b[2] + b[3] * b[3];
            ss = row_sum16(ss);
            const float rinv = 1.0f / sqrtf(ss * (1.0f / 128.0f) + EPS);
            const float* gp = F.g_q + (ci & 15) * 8; const f32x4 g0 = *(const f32x4*)gp, g1 = *(const f32x4*)(gp + 4);
            *(u32x2*)(q8 + (size_t)row * 1024 + ci * 8) = pack8_fp8(a * rinv * g0, b * rinv * g1); }
        { const int ci = F.lane & 31; const bool isk = F.lane < 32;
            f32x4 a, b; unpack8(*(const u32x4*)((isk ? k : v) + (size_t)row * 256 + ci * 8), a, b);
            float ss = a[0] * a[0] + a[1] * a[1] + a[2] * a[2] + a[3] * a[3] + b[0] * b[0] + b[1] * b[1] + b[2] * b[2] + b[3] * b[3];
            ss = row_sum16(ss);
            const float rinv = isk ? 1.0f / sqrtf(ss * (1.0f / 128.0f) + EPS) : 1.0f;
            const float* gp = F.g_k + (ci & 15) * 8; f32x4 g0 = *(const f32x4*)gp, g1 = *(const f32x4*)(gp + 4);
            if (!isk) { g0 = (f32x4){1.f, 1.f, 1.f, 1.f}; g1 = g0; }
            *(u32x2*)((isk ? k8 : v8) + (size_t)row * 256 + ci * 8) = pack8_fp8(a * rinv * g0, b * rinv * g1); }
    }
}
template <int W> __device__ __forceinline__ void pooled_item(const bf16_t* pl, bf16_t* po, int row, int c8) {
    const int t = row & (SEQ - 1);
    f32x4 s0 = (f32x4){0.f, 0.f, 0.f, 0.f}, s1 = s0, x0 = s0, x1 = s0;
    u32x4 v[W];
#pragma unroll
    for (int j = 0; j < W; ++j) v[j] = *(const u32x4*)(pl + (size_t)(row - (j <= t ? j : 0)) * 1024 + c8);
#pragma unroll
    for (int j = 0; j < W; ++j) { f32x4 a, b; unpack8(v[j], a, b); if (j == 0) { x0 = a; x1 = b; } if (j <= t) { s0 += a; s1 += b; } }
    const float inv = 1.0f / (float)((t + 1 < W) ? t + 1 : W);
    *(u32x4*)(po + (size_t)row * 1024 + c8) = pack8(s0 * inv - x0, s1 * inv - x1);
}
__device__ __forceinline__ void phase3_pooled(Frame& F) {
    const bf16_t* pl = (const bf16_t*)(F.ws + WS_PL); bf16_t* po = (bf16_t*)(F.ws + WS_POOLED);
    const int gw = F.bid * 8 + F.wave, NGW = F.G * 8;
    for (int it = gw; it < (MTOK / 2) * 4; it += NGW) {
        const int g = it & 3, row = (it >> 2) * 2 + (F.lane >> 5), c8 = g * 256 + (F.lane & 31) * 8;
        if (g == 0) pooled_item<2>(pl, po, row, c8); else if (g == 1) pooled_item<4>(pl, po, row, c8); else if (g == 2) pooled_item<8>(pl, po, row, c8); else pooled_item<16>(pl, po, row, c8);
    }
}
typedef float f32x16 __attribute__((ext_vector_type(16)));
__device__ __forceinline__ int sel_code(float s, float smin, float scale) { const float c = (s - smin) * scale; return (int)fminf(fmaxf(c, 0.f), 65535.f); }
__device__ __forceinline__ void hist_find(const unsigned* hist, int lane, int K, int& bsel, int& above) {
    const u32x4 h = *(const u32x4*)(hist + lane * 4);
    const int S = (int)(h.x + h.y + h.z + h.w);
    int x = S;
    x += __builtin_amdgcn_update_dpp(0, x, 0x101, 0xF, 0xF, true);
    x += __builtin_amdgcn_update_dpp(0, x, 0x102, 0xF, 0xF, true);
    x += __builtin_amdgcn_update_dpp(0, x, 0x104, 0xF, 0xF, true);
    x += __builtin_amdgcn_update_dpp(0, x, 0x108, 0xF, 0xF, true);
    const int t1 = __builtin_amdgcn_readlane(x, 16), t2 = __builtin_amdgcn_readlane(x, 32), t3 = __builtin_amdgcn_readlane(x, 48);
    const int r = lane >> 4;
    x += (r == 0 ? t1 + t2 + t3 : (r == 1 ? t2 + t3 : (r == 2 ? t3 : 0)));
    const int sufn = x - S;
    const bool mine = (x >= K) && (sufn < K);
    int b = 0, ab = 0;
    { int c = sufn;
      if (c + (int)h.w >= K) { b = 3; ab = c; } else { c += (int)h.w;
      if (c + (int)h.z >= K) { b = 2; ab = c; } else { c += (int)h.z;
      if (c + (int)h.y >= K) { b = 1; ab = c; } else { c += (int)h.y; b = 0; ab = c; } } } }
    const unsigned long long m = __ballot(mine);
    const int src = m ? (int)__builtin_ctzll(m) : 0;
    bsel = __builtin_amdgcn_readlane(lane * 4 + b, src); above = __builtin_amdgcn_readlane(ab, src);
}
__device__ __forceinline__ void indexer_select(Frame& F, int b, int t, const float* rowbuf, unsigned* hist, float* eqv, int* eqi) {
    unsigned short* selrow = (unsigned short*)(F.ws + WS_SEL) + (size_t)(b * SEQ + t) * 256;
    int lane = F.lane; asm volatile("" : "+v"(lane));
    const int nch = t / 64 + 1, n4 = (nch + 3) >> 2;
    const f32x4* rb4 = (const f32x4*)rowbuf;
    float mn = __builtin_huge_valf(), mx = -__builtin_huge_valf();
    for (int c4 = 0; c4 < n4; ++c4) { const f32x4 v = rb4[c4 * 64 + lane];
#pragma unroll
        for (int k = 0; k < 4; ++k) { const bool valid = ((c4 * 4 + k) * 64 + lane) <= t; mn = valid ? fminf(mn, v[k]) : mn; mx = valid ? fmaxf(mx, v[k]) : mx; } }
    mx = xor16_max(row_max16(mx)); { const auto r = __builtin_amdgcn_permlane32_swap(__float_as_uint(mx), __float_as_uint(mx), false, false); mx = fmaxf(__uint_as_float(r[0]), __uint_as_float(r[1])); }
    mn = -mn; mn = xor16_max(row_max16(mn)); { const auto r = __builtin_amdgcn_permlane32_swap(__float_as_uint(mn), __float_as_uint(mn), false, false); mn = -fmaxf(__uint_as_float(r[0]), __uint_as_float(r[1])); }
    const float scale = (mx > mn) ? 65535.0f / (mx - mn) : 0.f;
    *(u32x4*)(hist + lane * 4) = (u32x4){0u, 0u, 0u, 0u};
    for (int c4 = 0; c4 < n4; ++c4) { const f32x4 v = rb4[c4 * 64 + lane];
#pragma unroll
        for (int k = 0; k < 4; ++k) { const bool valid = ((c4 * 4 + k) * 64 + lane) <= t; if (valid) atomicAdd(&hist[sel_code(v[k], mn, scale) >> 8], 1u); } }
    int b1, above1; hist_find(hist, lane, KSEL, b1, above1);
    *(u32x4*)(hist + lane * 4) = (u32x4){0u, 0u, 0u, 0u};
    for (int c4 = 0; c4 < n4; ++c4) { const f32x4 v = rb4[c4 * 64 + lane];
#pragma unroll
        for (int k = 0; k < 4; ++k) { const bool valid = ((c4 * 4 + k) * 64 + lane) <= t; const int code = sel_code(v[k], mn, scale); if (valid && (code >> 8) == b1) atomicAdd(&hist[code & 255], 1u); } }
    int b2, above2; hist_find(hist, lane, KSEL - above1, b2, above2);
    const int T16 = (b1 << 8) | b2, need = KSEL - above1 - above2, ceq = (int)hist[b2];
    const unsigned long long lt_mask = (1ull << lane) - 1ull;
    const bool exact = (ceq != need) && (ceq <= 64);
    if (exact) {
        int pos = 0;
        for (int c = 0; c < nch; ++c) { const float sv = rowbuf[((c >> 2) * 64 + lane) * 4 + (c & 3)]; const int idx = c * 64 + lane;
            const bool eq = (idx <= t) && (sel_code(sv, mn, scale) == T16);
            const unsigned long long m = __ballot(eq);
            if (m) { const int p = pos + __popcll(m & lt_mask); if (eq) { eqv[p] = sv; eqi[p] = idx; } pos += __popcll(m); } }
    }
    int pos = 0, eqseen = 0;
    for (int c = 0; c < nch; ++c) {
        const float sv = rowbuf[((c >> 2) * 64 + lane) * 4 + (c & 3)]; const int idx = c * 64 + lane;
        const int code = sel_code(sv, mn, scale); const bool valid = idx <= t;
        const bool gt = valid && code > T16, eq = valid && code == T16;
        const unsigned long long meq = __ballot(eq);
        bool take = gt;
        if (meq) {
            if (ceq == need) take = take || eq;
            else if (exact) { int rank = 0; for (int m = 0; m < ceq; ++m) { const float ov = eqv[m]; const int oi = eqi[m]; rank += (ov > sv || (ov == sv && oi < idx)) ? 1 : 0; } take = take || (eq && rank < need); }
            else { const int er = eqseen + __popcll(meq & lt_mask); take = take || (eq && er < need); eqseen += __popcll(meq); }
        }
        const unsigned long long mt = __ballot(take);
        const int p = pos + __popcll(mt & lt_mask);
        if (take && p < KSEL) selrow[p] = (unsigned short)idx;
        pos += __popcll(mt);
    }
}
__device__ __forceinline__ void indexer_tile(Frame& F, int b, int t0) {
    const bf16_t* iq = (const bf16_t*)(F.ws + WS_IQ); const bf16_t* ik = (const bf16_t*)(F.ws + WS_IK); const float* iw = (const float*)(F.ws + WS_IW);
    int lane = F.lane; asm volatile("" : "+v"(lane));
    const int w = F.wave;
    if (t0 < KSEL) {
        const int t = t0 + w; unsigned short* selrow = (unsigned short*)(F.ws + WS_SEL) + (size_t)(b * SEQ + t) * 256;
#pragma unroll
        for (int p = 0; p < 4; ++p) { const int j = p * 64 + lane; selrow[j] = (unsigned short)(j <= t ? j : 0xFFFF); }
        return;
    }
    float* rowbuf = (float*)F.lds;
    unsigned char* stage = F.lds + 131072;
    const int p = w & 3, kh = w >> 2, hi = lane >> 5, r = lane & 31;
    const size_t qrow = (size_t)b * SEQ + t0 + 2 * p + (r >> 4);
    bf16x8 a[4];
#pragma unroll
    for (int ks = 0; ks < 4; ++ks) a[ks] = *(const bf16x8*)(iq + qrow * 1024 + (r & 15) * 64 + ks * 16 + 8 * hi);
    float wq[2][8];
#pragma unroll
    for (int q = 0; q < 2; ++q)
#pragma unroll
        for (int i = 0; i < 8; ++i) wq[q][i] = iw[((size_t)b * SEQ + t0 + 2 * p + q) * 16 + (i & 3) + 8 * ((i >> 2) & 1) + 4 * hi];
    const int nchunks = (t0 + 7) / 64 + 1;
    const unsigned char* gsrc = (const unsigned char*)(ik + (size_t)b * SEQ * 64) + F.tid * 16;
    const int skey = F.tid >> 3, sc16 = F.tid & 7, soff = skey * 128 + ((sc16 ^ (skey & 7)) << 4);
    u32x4 s0 = *(const u32x4*)gsrc, s1 = s0, s2 = s0, s3 = s0;
    if (1 < nchunks) s1 = *(const u32x4*)(gsrc + (size_t)1 * 8192);
    if (2 < nchunks) s2 = *(const u32x4*)(gsrc + (size_t)2 * 8192);
    if (3 < nchunks) s3 = *(const u32x4*)(gsrc + (size_t)3 * 8192);
    __syncthreads();
#define IDX_STEP(SR, cc) do { const int c = (cc); unsigned char* sb = stage + (c & 1) * 8192; \
        *(u32x4*)(sb + soff) = SR; \
        __syncthreads(); \
        if (c + 4 < nchunks) SR = *(const u32x4*)(gsrc + (size_t)(c + 4) * 8192); \
        f32x16 d; _Pragma("unroll") for (int i = 0; i < 16; ++i) d[i] = 0.f; \
        const int key = kh * 32 + r; \
        _Pragma("unroll") for (int ks = 0; ks < 4; ++ks) { const bf16x8 bf = *(const bf16x8*)(sb + key * 128 + (((ks * 2 + hi) ^ (key & 7)) << 4)); \
            d = __builtin_amdgcn_mfma_f32_32x32x16_bf16(a[ks], bf, d, 0, 0, 0); } \
        float s0_ = 0.f, s1_ = 0.f; \
        _Pragma("unroll") for (int i = 0; i < 8; ++i) { s0_ += wq[0][i] * fmaxf(d[i], 0.f); s1_ += wq[1][i] * fmaxf(d[8 + i], 0.f); } \
        const float sc = swap32_pair(s0_, s1_); \
        rowbuf[(2 * p + hi) * 4096 + ((c >> 2) * 64 + key) * 4 + (c & 3)] = sc; } while (0)
    for (int c4 = 0; c4 < nchunks; c4 += 4) {
        IDX_STEP(s0, c4);
        if (c4 + 1 < nchunks) IDX_STEP(s1, c4 + 1);
        if (c4 + 2 < nchunks) IDX_STEP(s2, c4 + 2);
        if (c4 + 3 < nchunks) IDX_STEP(s3, c4 + 3);
    }
#if PROBE_IDX == 1
    __syncthreads(); s0 = *(const u32x4*)gsrc; s1 = s0; s2 = s0; s3 = s0;
    if (1 < nchunks) s1 = *(const u32x4*)(gsrc + (size_t)1 * 8192);
    if (2 < nchunks) s2 = *(const u32x4*)(gsrc + (size_t)2 * 8192);
    if (3 < nchunks) s3 = *(const u32x4*)(gsrc + (size_t)3 * 8192);
    for (int c4 = 0; c4 < nchunks; c4 += 4) {
        IDX_STEP(s0, c4);
        if (c4 + 1 < nchunks) IDX_STEP(s1, c4 + 1);
        if (c4 + 2 < nchunks) IDX_STEP(s2, c4 + 2);
        if (c4 + 3 < nchunks) IDX_STEP(s3, c4 + 3);
    }
#endif
#undef IDX_STEP
    __syncthreads();
    indexer_select(F, b, t0 + w, rowbuf + w * 4096, (unsigned*)(F.lds + 147456) + w * 256, (float*)(F.lds + 155648) + w * 64, (int*)(F.lds + 155648 + 2048) + w * 64);
#if PROBE_IDX == 2
    indexer_select(F, b, t0 + w, rowbuf + w * 4096, (unsigned*)(F.lds + 147456) + w * 256, (float*)(F.lds + 155648) + w * 64, (int*)(F.lds + 155648 + 2048) + w * 64);
#endif
}
__device__ __forceinline__ void phase3_indexer(Frame& F) {
    const int nit = BATCH * (SEQ / 8);
    for (int k = 0;; ++k) {
        const int l = k * F.G + ((k & 1) ? (F.G - 1 - F.bid) : F.bid);
        if (l >= nit) { if (k * F.G >= nit) break; else continue; }
        const int qb = (SEQ / 8 - 1) - (l >> 3), b = l & 7;
        indexer_tile(F, b, qb * 8);
    }
}

__device__ const unsigned char g_bucket[128] = {0, 1, 2, 3, 4, 5, 6, 7, 8, 9, 10, 11, 12, 13, 14, 15, 16, 16, 16, 17, 17, 18, 18, 18, 19, 19, 19, 20, 20, 20, 20, 21, 21, 21, 21, 22, 22, 22, 22, 22, 23, 23, 23, 23, 23, 23, 24, 24, 24, 24, 24, 24, 25, 25, 25, 25, 25, 25, 25, 26, 26, 26, 26, 26, 26, 26, 26, 27, 27, 27, 27, 27, 27, 27, 27, 27, 27, 28, 28, 28, 28, 28, 28, 28, 28, 28, 28, 29, 29, 29, 29, 29, 29, 29, 29, 29, 29, 29, 29, 30, 30, 30, 30, 30, 30, 30, 30, 30, 30, 30, 30, 30, 30, 31, 31, 31, 31, 31, 31, 31, 31, 31, 31, 31, 31, 31, 31, 31};
__device__ __forceinline__ void phase4_attention(Frame& F) {
    const unsigned char* q8 = F.ws + WS_Q8; const unsigned char* k8 = F.ws + WS_K8; const unsigned char* v8 = F.ws + WS_V8;
    const unsigned short* sel = (const unsigned short*)(F.ws + WS_SEL); bf16_t* ao = (bf16_t*)(F.ws + WS_ATTN);
    float* btab = (float*)F.lds;
    __syncthreads();
    for (int i = F.tid; i < 256; i += 512) btab[i] = F.rel_bias[i];
    __syncthreads();
    float* Pl = (float*)(F.lds + 4096 + F.wave * 12288); int* idl = (int*)(Pl + 2048); float* psl = (float*)(idl + 256);
    const bool xmap = (F.G % 8) == 0;
    const int gw = xmap ? (F.bid / 8) * 8 + F.wave : F.bid * 8 + F.wave, NGW = xmap ? F.G : F.G * 8, nrows = xmap ? SEQ : MTOK;
    for (int rr = gw; rr < nrows; rr += NGW) {
        int lane = F.lane; asm volatile("" : "+v"(lane));
        const int row = xmap ? (F.bid & 7) * SEQ + rr : rr;
        const int b = row / SEQ, t = row % SEQ, r = lane & 31, hi = lane >> 5;
#pragma unroll
        for (int p = 0; p < 4; ++p) { idl[p * 64 + lane] = (int)sel[(size_t)row * 256 + p * 64 + lane]; }
        long a0[8], a1[8];
        { u32x4 qa[4];
#pragma unroll
          for (int i = 0; i < 4; ++i) qa[i] = (r < 8) ? *(const u32x4*)(q8 + (size_t)row * 1024 + r * 128 + hi * 64 + i * 16) : (u32x4){0u, 0u, 0u, 0u};
#pragma unroll
          for (int ks = 0; ks < 8; ++ks) { const unsigned lo = qa[ks >> 1][(ks & 1) * 2], hh = qa[ks >> 1][(ks & 1) * 2 + 1]; const long v = (long)(((unsigned long long)hh << 32) | lo);
              a0[ks] = (r < 4) ? v : 0l; a1[ks] = (r >= 4) ? v : 0l; } }
        f32x4 psum = (f32x4){0.f, 0.f, 0.f, 0.f};
#define AT_LOADK(buf, kb) do { const int key_ = idl[(kb) * 32 + r]; const int kc_ = key_ <= t ? key_ : 0; const unsigned char* kr_ = k8 + ((size_t)b * SEQ + kc_) * 256 + hi * 64; \
            _Pragma("unroll") for (int i = 0; i < 4; ++i) { buf[i] = *(const u32x4*)(kr_ + i * 16); buf[4 + i] = *(const u32x4*)(kr_ + 128 + i * 16); } } while (0)
#define AT_QK(buf, kb) do { const int key_ = idl[(kb) * 32 + r]; const bool valid_ = key_ <= t; const int kc_ = valid_ ? key_ : 0; \
            f32x16 d; _Pragma("unroll") for (int i = 0; i < 16; ++i) d[i] = 0.f; \
            _Pragma("unroll") for (int ks = 0; ks < 8; ++ks) { const long bv_ = (long)(((unsigned long long)buf[ks >> 1][(ks & 1) * 2 + 1] << 32) | buf[ks >> 1][(ks & 1) * 2]); d = __builtin_amdgcn_mfma_f32_32x32x16_fp8_fp8(a0[ks], bv_, d, 0, 0, 0); } \
            _Pragma("unroll") for (int ks = 0; ks < 8; ++ks) { const long bv_ = (long)(((unsigned long long)buf[4 + (ks >> 1)][(ks & 1) * 2 + 1] << 32) | buf[4 + (ks >> 1)][(ks & 1) * 2]); d = __builtin_amdgcn_mfma_f32_32x32x16_fp8_fp8(a1[ks], bv_, d, 0, 0, 0); } \
            const int dist_ = t - kc_; const int bkt_ = dist_ < 128 ? (int)g_bucket[dist_] : 31; \
            const f32x4 bias_ = *(const f32x4*)(btab + bkt_ * 8 + 4 * hi); f32x4 e_; \
            _Pragma("unroll") for (int i = 0; i < 4; ++i) e_[i] = valid_ ? __expf(d[i] * 0.08838834764831845f + bias_[i]) : 0.f; \
            psum += e_; *(f32x4*)(Pl + ((kb) * 32 + r) * 8 + 4 * hi) = e_; } while (0)
        {
            u32x4 kA[8], kB[8];
            AT_LOADK(kA, 0);
#pragma unroll 1
            for (int kb = 0; kb < 8; kb += 2) {
                AT_LOADK(kB, kb + 1);
                AT_QK(kA, kb);
                if (kb + 2 < 8) AT_LOADK(kA, kb + 2);
                AT_QK(kB, kb + 1);
            }
        }
#undef AT_LOADK
#undef AT_QK
#pragma unroll
        for (int i = 0; i < 4; ++i) psum[i] = xor16_sum(row_sum16(psum[i]));
        if (r == 0) *(f32x4*)(psl + 4 * hi) = psum;
        const int ks = lane >> 4, g = (lane >> 3) & 1, dc = lane & 7;
        float acc[4][16];
#pragma unroll
        for (int h = 0; h < 4; ++h)
#pragma unroll
            for (int j = 0; j < 16; ++j) acc[h][j] = 0.f;
#define AT_LOADV(buf, it0) do { _Pragma("unroll") for (int u = 0; u < 4; ++u) { const int key_ = idl[((it0) + u) * 4 + ks]; const int kc_ = key_ <= t ? key_ : 0; \
            buf[u] = *(const u32x4*)(v8 + ((size_t)b * SEQ + kc_) * 256 + g * 128 + dc * 16); } } while (0)
#define AT_PV(buf, it0) do { _Pragma("unroll") for (int u = 0; u < 4; ++u) { const int j_ = ((it0) + u) * 4 + ks; const u32x4 w = buf[u]; \
            const f32x4 p = *(const f32x4*)(Pl + j_ * 8 + 4 * g); \
            _Pragma("unroll") for (int dd = 0; dd < 4; ++dd) { const f32x2 lo = __builtin_amdgcn_cvt_pk_f32_fp8((int)w[dd], false), hh_ = __builtin_amdgcn_cvt_pk_f32_fp8((int)w[dd], true); \
                _Pragma("unroll") for (int h = 0; h < 4; ++h) { acc[h][4 * dd] += p[h] * lo.x; acc[h][4 * dd + 1] += p[h] * lo.y; acc[h][4 * dd + 2] += p[h] * hh_.x; acc[h][4 * dd + 3] += p[h] * hh_.y; } } } } while (0)
        {
            u32x4 vA[4], vB[4];
            AT_LOADV(vA, 0);
#pragma unroll 1
            for (int it0 = 0; it0 < 64; it0 += 8) {
                AT_LOADV(vB, it0 + 4);
                AT_PV(vA, it0);
                if (it0 + 8 < 64) AT_LOADV(vA, it0 + 8);
                AT_PV(vB, it0 + 4);
            }
        }
#undef AT_LOADV
#undef AT_PV
#pragma unroll
        for (int h = 0; h < 4; ++h)
#pragma unroll
            for (int j = 0; j < 16; ++j) acc[h][j] = xor32_sum(xor16_sum(acc[h][j]));
#pragma unroll
        for (int h = 0; h < 4; ++h) if (h == ks) { const float inv = 1.0f / psl[4 * g + h];
            bf16_t* op = ao + (size_t)row * 1024 + (4 * g + h) * 128 + dc * 16;
            *(u32x4*)op = pack8((f32x4){acc[h][0], acc[h][1], acc[h][2], acc[h][3]} * inv, (f32x4){acc[h][4], acc[h][5], acc[h][6], acc[h][7]} * inv);
            *(u32x4*)(op + 8) = pack8((f32x4){acc[h][8], acc[h][9], acc[h][10], acc[h][11]} * inv, (f32x4){acc[h][12], acc[h][13], acc[h][14], acc[h][15]} * inv); }
    }
}

__device__ __forceinline__ float dot16f8(u32x4 w, const float* h) {
    float s = 0.f;
#pragma unroll
    for (int d = 0; d < 4; ++d) { const f32x2 lo = __builtin_amdgcn_cvt_pk_f32_fp8((int)w[d], false), hi = __builtin_amdgcn_cvt_pk_f32_fp8((int)w[d], true);
        s += lo.x * h[4 * d] + lo.y * h[4 * d + 1] + hi.x * h[4 * d + 2] + hi.y * h[4 * d + 3]; }
    return s;
}
__device__ __forceinline__ void fma16f8(u32x4 w, float cf, float* acc) {
#pragma unroll
    for (int d = 0; d < 4; ++d) { const f32x2 lo = __builtin_amdgcn_cvt_pk_f32_fp8((int)w[d], false), hi = __builtin_amdgcn_cvt_pk_f32_fp8((int)w[d], true);
        acc[4 * d] += cf * lo.x; acc[4 * d + 1] += cf * lo.y; acc[4 * d + 2] += cf * hi.x; acc[4 * d + 3] += cf * hi.y; }
}
__device__ __forceinline__ float gelu_erf(float x) { return 0.5f * x * (1.0f + erff(x * 0.70710678118654752f)); }
__device__ __forceinline__ void hfind2(const unsigned* hist, int lane, int K, int& bsel, int& above) {
    const int half = lane >> 5, lh = lane & 31;
    const u32x4 h0 = *(const u32x4*)(hist + half * 256 + lh * 8), h1 = *(const u32x4*)(hist + half * 256 + lh * 8 + 4);
    const int S = (int)(h0.x + h0.y + h0.z + h0.w + h1.x + h1.y + h1.z + h1.w);
    int x = S;
    x += __builtin_amdgcn_update_dpp(0, x, 0x101, 0xF, 0xF, true); x += __builtin_amdgcn_update_dpp(0, x, 0x102, 0xF, 0xF, true);
    x += __builtin_amdgcn_update_dpp(0, x, 0x104, 0xF, 0xF, true); x += __builtin_amdgcn_update_dpp(0, x, 0x108, 0xF, 0xF, true);
    const int t1 = __builtin_amdgcn_readlane(x, 16), t3 = __builtin_amdgcn_readlane(x, 48);
    if ((lane & 16) == 0) x += half ? t3 : t1;
    const int sufn = x - S;
    const bool mine = (x >= K) && (sufn < K);
    int b = 0, ab = sufn, c = sufn; bool fnd = false;
#define HF_STEP(i, hv) { const int cv = c + (int)(hv); const bool hit = !fnd && (cv >= K); b = hit ? (i) : b; ab = hit ? c : ab; fnd = fnd || hit; c = cv; }
    HF_STEP(7, h1.w) HF_STEP(6, h1.z) HF_STEP(5, h1.y) HF_STEP(4, h1.x) HF_STEP(3, h0.w) HF_STEP(2, h0.z) HF_STEP(1, h0.y) HF_STEP(0, h0.x)
#undef HF_STEP
    const unsigned long long m = __ballot(mine);
    const unsigned mlo = (unsigned)m, mhi = (unsigned)(m >> 32);
    const int src0 = mlo ? __builtin_ctz(mlo) : 0, src1 = 32 + (mhi ? __builtin_ctz(mhi) : 0);
    const int bb = lh * 8 + b;
    const int r0b = __builtin_amdgcn_readlane(bb, src0), r0a = __builtin_amdgcn_readlane(ab, src0), r1b = __builtin_amdgcn_readlane(bb, src1), r1a = __builtin_amdgcn_readlane(ab, src1);
    bsel = half ? r1b : r0b; above = half ? r1a : r0a;
}
__device__ __forceinline__ void peer_select(const bf16_t* srow, int lane, int* elist, float* gl, float* scr, unsigned* hist2) {
    float* selv = scr; int* seli = (int*)(scr + 32); float* srtv = scr + 64; int* srti = (int*)(scr + 96);
    const unsigned long long lt_mask = (1ull << lane) - 1ull;
    const int half = lane >> 5, lh = lane & 31;
    const unsigned long long hmask = half ? 0xFFFFFFFF00000000ull : 0x00000000FFFFFFFFull;
    const float NINF = -__builtin_huge_valf();
#pragma unroll 1
    for (int h = 0; h < 8; ++h) {
        const u32x2 raw = *(const u32x2*)(srow + h * 256 + lane * 4);
        unsigned b[4] = {raw.x & 0xffffu, raw.x >> 16, raw.y & 0xffffu, raw.y >> 16}, k[4];
#pragma unroll
        for (int q = 0; q < 4; ++q) k[q] = (b[q] & 0x8000u) ? (b[q] ^ 0xFFFFu) : (b[q] | 0x8000u);
        *(u32x4*)(hist2 + lane * 8) = (u32x4){0u, 0u, 0u, 0u}; *(u32x4*)(hist2 + lane * 8 + 4) = (u32x4){0u, 0u, 0u, 0u};
#pragma unroll
        for (int q = 0; q < 4; ++q) atomicAdd(&hist2[half * 256 + (k[q] >> 8)], 1u);
        int b1, ab1; hfind2(hist2, lane, 16, b1, ab1);
        *(u32x4*)(hist2 + lane * 8) = (u32x4){0u, 0u, 0u, 0u}; *(u32x4*)(hist2 + lane * 8 + 4) = (u32x4){0u, 0u, 0u, 0u};
#pragma unroll
        for (int q = 0; q < 4; ++q) if ((int)(k[q] >> 8) == b1) atomicAdd(&hist2[half * 256 + (k[q] & 255u)], 1u);
        int b2, ab2; hfind2(hist2, lane, 16 - ab1, b2, ab2);
        const unsigned T = ((unsigned)b1 << 8) | (unsigned)b2;
        int ngt = 0, eqb = 0; unsigned long long me[4];
#pragma unroll
        for (int q = 0; q < 4; ++q) { const unsigned long long mg = __ballot(k[q] > T) & hmask; me[q] = __ballot(k[q] == T) & hmask; ngt += __popcll(mg); eqb += __popcll(me[q] & lt_mask); }
        const int need = 16 - ngt;
        bool sl[4]; int run = eqb;
#pragma unroll
        for (int q = 0; q < 4; ++q) { const bool eq = k[q] == T; sl[q] = (k[q] > T) || (eq && run < need); run += eq ? 1 : 0; }
        int pos = 0;
#pragma unroll
        for (int q = 0; q < 4; ++q) pos += __popcll(__ballot(sl[q]) & hmask & lt_mask);
#pragma unroll
        for (int q = 0; q < 4; ++q) { if (sl[q]) { selv[half * 16 + pos] = __uint_as_float(b[q] << 16); seli[half * 16 + pos] = 4 * lh + q; } pos += sl[q] ? 1 : 0; }
        const float v = selv[half * 16 + (lh & 15)]; const int ix = seli[half * 16 + (lh & 15)];
        int rank = 0;
#define PS_ROT(R) { const float vo = __int_as_float(__builtin_amdgcn_update_dpp(0, __float_as_int(v), 0x120 + (R), 0xF, 0xF, true)); const int io = __builtin_amdgcn_update_dpp(0, ix, 0x120 + (R), 0xF, 0xF, true); rank += (vo > v || (vo == v && io < ix)) ? 1 : 0; }
        PS_ROT(1) PS_ROT(2) PS_ROT(3) PS_ROT(4) PS_ROT(5) PS_ROT(6) PS_ROT(7) PS_ROT(8) PS_ROT(9) PS_ROT(10) PS_ROT(11) PS_ROT(12) PS_ROT(13) PS_ROT(14) PS_ROT(15)
#undef PS_ROT
        if (lh < 16) { srtv[half * 16 + rank] = v; srti[half * 16 + rank] = ix; }
        int ca, cb; const int c = lane;
        if (c < 16) { ca = 0; cb = c; } else if (c < 24) { ca = 1; cb = c - 16; } else if (c < 29) { ca = 2; cb = c - 24; } else if (c < 33) { ca = 3; cb = c - 29; }
        else if (c < 36) { ca = 4; cb = c - 33; } else if (c < 38) { ca = 5; cb = c - 36; } else if (c < 40) { ca = 6; cb = c - 38; } else if (c < 42) { ca = 7; cb = c - 40; }
        else { ca = (c - 42 + 8) & 15; cb = 0; }
        float s = srtv[ca] + srtv[16 + cb];
        const int eid = srti[ca] * 128 + srti[16 + cb];
        if (c >= 50) s = NINF;
        const unsigned sb_ = __float_as_uint(s), ok_ = sb_ ^ ((unsigned)((int)sb_ >> 31) | 0x80000000u);
        const unsigned key = (c < 50) ? ((ok_ & ~63u) | (unsigned)(63 - c)) : 0u;
        int rk = 0;
#pragma unroll
        for (int j = 0; j < 50; ++j) { const unsigned kj = (unsigned)__builtin_amdgcn_readlane((int)key, j); rk += (kj > key) ? 1 : 0; }
        const bool selq = (c < 50) && (rk < 16);
        const float smax = __shfl(s, 0);
        const float e = selq ? __expf(s - smax) : 0.f;
        const float esum = wave_sum(e);
        const unsigned long long ms = __ballot(selq);
        const int p = __popcll(ms & lt_mask);
        if (selq) { elist[h * 16 + p] = eid; gl[h * 16 + p] = e / esum; }
    }
}
__device__ __forceinline__ float dot32_f8b(u32x4 wa, u32x4 wb, u32x4 ha0, u32x4 ha1, u32x4 hb0, u32x4 hb1) {
    typedef __bf16 bf2 __attribute__((ext_vector_type(2)));
    float acc = 0.f;
#pragma unroll
    for (int d = 0; d < 4; ++d) {
        const unsigned h0 = d < 2 ? ha0[2 * d] : ha1[2 * d - 4], h1 = d < 2 ? ha0[2 * d + 1] : ha1[2 * d - 3];
        const unsigned g0 = d < 2 ? hb0[2 * d] : hb1[2 * d - 4], g1 = d < 2 ? hb0[2 * d + 1] : hb1[2 * d - 3];
        acc = __builtin_amdgcn_fdot2_f32_bf16(__builtin_amdgcn_cvt_scalef32_pk_bf16_fp8((int)wa[d], 1.0f, false), __builtin_bit_cast(bf2, h0), acc, false);
        acc = __builtin_amdgcn_fdot2_f32_bf16(__builtin_amdgcn_cvt_scalef32_pk_bf16_fp8((int)wa[d], 1.0f, true), __builtin_bit_cast(bf2, h1), acc, false);
        acc = __builtin_amdgcn_fdot2_f32_bf16(__builtin_amdgcn_cvt_scalef32_pk_bf16_fp8((int)wb[d], 1.0f, false), __builtin_bit_cast(bf2, g0), acc, false);
        acc = __builtin_amdgcn_fdot2_f32_bf16(__builtin_amdgcn_cvt_scalef32_pk_bf16_fp8((int)wb[d], 1.0f, true), __builtin_bit_cast(bf2, g1), acc, false); }
    return acc;
}
__device__ __forceinline__ void phase10_peer(Frame& F) {
    const bf16_t* sub = (const bf16_t*)(F.ws + WS_SUB); const bf16_t* h2 = (const bf16_t*)(F.ws + WS_H2);
    const unsigned char* pu = F.ws + WS_PU; unsigned* pairs = (unsigned*)(F.ws + WS_PAIRS);
    const int gw = F.bid * 8 + F.wave, NGW = F.G * 8;
    unsigned char* wb = F.lds + F.wave * 17664;
    unsigned char* h2b = wb; unsigned short* gl16 = (unsigned short*)(wb + 16384); unsigned* hist = (unsigned*)(wb + 17408); unsigned* base = hist + 32;
    unsigned* tmp = (unsigned*)wb; int* elist = (int*)(wb + 2048); float* gl = (float*)(wb + 2560); float* sscr = (float*)(wb + 3072); bf16_t* srl = (bf16_t*)(wb + 4096);
    unsigned* wls = (unsigned*)(F.ws + WS_WLS) + (size_t)gw * 512;
    const int ntok = (MTOK - gw + NGW - 1) / NGW;
    for (int p0 = 0; p0 < ntok; p0 += 4) {
        int lane = F.lane; asm volatile("" : "+v"(lane));
        const int nt = (ntok - p0) < 4 ? (ntok - p0) : 4, ne = nt * 128;
        u32x4 nxt[4];
#pragma unroll
        for (int q = 0; q < 4; ++q) nxt[q] = *(const u32x4*)(sub + (size_t)(gw + p0 * NGW) * 2048 + lane * 32 + q * 8);
#pragma unroll 1
        for (int i = 0; i < nt; ++i) {
#pragma unroll
            for (int q = 0; q < 4; ++q) *(u32x4*)(srl + lane * 32 + q * 8) = nxt[q];
            if (i + 1 < nt) {
#pragma unroll
                for (int q = 0; q < 4; ++q) nxt[q] = *(const u32x4*)(sub + (size_t)(gw + (p0 + i + 1) * NGW) * 2048 + lane * 32 + q * 8); }
            peer_select(srl, lane, elist, gl, sscr, (unsigned*)(wb + 8192));
#if PROBE_SEL
            asm volatile("" : "+v"(lane)); peer_select(srl, lane, elist, gl, sscr, (unsigned*)(wb + 8192));
#endif
            tmp[i * 128 + lane] = ((unsigned)(i * 128 + lane) << 14) | (unsigned)elist[lane];
            tmp[i * 128 + 64 + lane] = ((unsigned)(i * 128 + 64 + lane) << 14) | (unsigned)elist[64 + lane];
            gl16[i * 128 + lane] = (unsigned short)(cvt_pk_bf16(gl[lane], 0.f) & 0xffffu); gl16[i * 128 + 64 + lane] = (unsigned short)(cvt_pk_bf16(gl[64 + lane], 0.f) & 0xffffu);
        }
        asm volatile("" : "+v"(lane));
        if (lane < 32) hist[lane] = 0u;
        unsigned ent[8]; unsigned rk[8];
#pragma unroll
        for (int q = 0; q < 8; ++q) { const int e = q * 64 + lane; ent[q] = (e < ne) ? tmp[e] : 0u; rk[q] = (e < ne) ? atomicAdd(&hist[(ent[q] & 0x3FFFu) >> 9], 1u) : 0u; }
        { int hv = lane < 32 ? (int)hist[lane] : 0; int x = hv;
          x += __builtin_amdgcn_update_dpp(0, x, 0x111, 0xF, 0xF, true); x += __builtin_amdgcn_update_dpp(0, x, 0x112, 0xF, 0xF, true);
          x += __builtin_amdgcn_update_dpp(0, x, 0x114, 0xF, 0xF, true); x += __builtin_amdgcn_update_dpp(0, x, 0x118, 0xF, 0xF, true);
          const int t0 = __builtin_amdgcn_readlane(x, 15); if (lane >= 16) x += t0;
          if (lane < 32) base[lane] = (unsigned)(x - hv); }
#pragma unroll
        for (int q = 0; q < 8; ++q) { const int e = q * 64 + lane; if (e < ne) wls[base[(ent[q] & 0x3FFFu) >> 9] + rk[q]] = ent[q]; }
#pragma unroll 1
        for (int i = 0; i < nt; ++i) { const bf16_t* hr = h2 + (size_t)(gw + (p0 + i) * NGW) * 2048 + lane * 16;
#pragma unroll
            for (int hh = 0; hh < 2; ++hh) { const u32x4 a = *(const u32x4*)(hr + hh * 1024), b = *(const u32x4*)(hr + hh * 1024 + 8);
                *(u32x4*)(h2b + i * 4096 + hh * 2048 + lane * 32) = a; *(u32x4*)(h2b + i * 4096 + hh * 2048 + lane * 32 + 16) = b; } }
        asm volatile("s_waitcnt vmcnt(0)" ::: "memory");
        unsigned entn = __hip_atomic_load(wls + lane, __ATOMIC_RELAXED, __HIP_MEMORY_SCOPE_AGENT);
#pragma unroll 1
        for (int c = 0; c < ne; c += 64) {
            const unsigned ent64 = entn;
            if (c + 64 < ne) entn = __hip_atomic_load(wls + c + 64 + lane, __ATOMIC_RELAXED, __HIP_MEMORY_SCOPE_AGENT);
#pragma unroll 1
            for (int i0 = 0; i0 < 64; i0 += 8) {
                u32x4 w[8][2]; unsigned en[8];
#pragma unroll
                for (int jj = 0; jj < 8; ++jj) { en[jj] = (unsigned)__builtin_amdgcn_readlane((int)ent64, i0 + jj); const unsigned char* ur = pu + (size_t)(en[jj] & 0x3FFFu) * 2048 + lane * 16;
                    w[jj][0] = *(const u32x4*)ur; w[jj][1] = *(const u32x4*)(ur + 1024); }
                float pr[8];
#pragma unroll
                for (int jj = 0; jj < 8; ++jj) { const unsigned char* hp = h2b + (en[jj] >> 21) * 4096 + lane * 32;
                    pr[jj] = dot32_f8b(w[jj][0], w[jj][1], *(const u32x4*)hp, *(const u32x4*)(hp + 16), *(const u32x4*)(hp + 2048), *(const u32x4*)(hp + 2064)); __builtin_amdgcn_sched_barrier(0); }
#pragma unroll
                for (int i = 0; i < 4; ++i) pr[i] = swap32_pair(pr[i], pr[i + 4]);
#pragma unroll
                for (int i = 0; i < 2; ++i) pr[i] = swap16_pair(pr[i], pr[i + 2]);
                const bool b3 = (lane & 8) != 0;
                { const float snd = b3 ? pr[0] : pr[1], kp = b3 ? pr[1] : pr[0]; pr[0] = kp + dpp_f<DPP_ROR8>(snd); }
                float tot = pr[0]; tot += dpp_f<DPP_XOR1>(tot); tot += dpp_f<DPP_XOR2>(tot); tot += dpp_f<DPP_HMIRROR>(tot);
                const unsigned em = (unsigned)__shfl((int)ent64, i0 + (lane >> 3));
                if ((lane & 7) == 0) {
                    const int tk = (int)(em >> 21), j = (int)((em >> 14) & 127u), row = gw + (p0 + tk) * NGW;
                    const float cf = gelu_erf(tot * (1.0f / 64.0f)) * __uint_as_float((unsigned)gl16[tk * 128 + j] << 16);
                    pairs[((size_t)(row >> 6) * 128 + j) * 64 + (row & 63)] = (cvt_pk_bf16(0.f, cf) & 0xffff0000u) | (em & 0x3FFFu);
                }
            }
        }
    }
}

__device__ __forceinline__ void phase11_peer_v(Frame& F, float* dst) {
    const unsigned* pairs = (const unsigned*)(F.ws + WS_PAIRS); const float* mf = (const float*)(F.ws + WS_MODF);
    unsigned long long* vs = (unsigned long long*)F.lds;
    for (int c = F.bid; c < DM / 8; c += F.G) {
        __syncthreads();
        { const u32x4* src = (const u32x4*)(F.ws + WS_PV + (size_t)c * NEXP * 8); u32x4* dst = (u32x4*)F.lds;
#pragma unroll 4
          for (int i = F.tid; i < NEXP * 8 / 16; i += 512) dst[i] = src[i]; }
        __syncthreads();
        for (int tile = F.wave; tile < MTOK / 64; tile += 8) {
            int lane = F.lane; asm volatile("" : "+v"(lane));
            const unsigned* pp = pairs + (size_t)tile * 128 * 64 + lane;
            const int row = tile * 64 + lane;
            const float* gt2 = mf + (size_t)(tile / (SEQ / 64)) * 12288 + 10240 + c * 8;
            const float* ip = F.out + (size_t)row * 2048 + c * 8; float* op = dst + (size_t)row * 2048 + c * 8;
            const f32x4 x0 = *(const f32x4*)ip, x1 = *(const f32x4*)(ip + 4), g0 = *(const f32x4*)gt2 * 0.25f, g1 = *(const f32x4*)(gt2 + 4) * 0.25f;
            f32x2 acc[4];
#pragma unroll
            for (int i = 0; i < 4; ++i) acc[i] = (f32x2){0.f, 0.f};
#define P11_LOAD(dst, j0) do { _Pragma("unroll") for (int jj = 0; jj < 16; ++jj) dst[jj] = pp[((j0) + jj) * 64]; } while (0)
#define P11_COMP(src) do { _Pragma("unroll") for (int jj = 0; jj < 16; ++jj) { const unsigned long long v = vs[src[jj] & 0x3FFFu]; const float cf = __uint_as_float(src[jj] & 0xffff0000u); \
                    const int lo = (int)(unsigned)v, hi = (int)(unsigned)(v >> 32); \
                    acc[0] += __builtin_amdgcn_cvt_pk_f32_fp8(lo, false) * cf; acc[1] += __builtin_amdgcn_cvt_pk_f32_fp8(lo, true) * cf; \
                    acc[2] += __builtin_amdgcn_cvt_pk_f32_fp8(hi, false) * cf; acc[3] += __builtin_amdgcn_cvt_pk_f32_fp8(hi, true) * cf; } } while (0)
#if PROBE_P11X
            { f32x2 sv[4]; for (int i = 0; i < 4; ++i) sv[i] = acc[i];
            unsigned pa[16], pb[16];
            P11_LOAD(pa, 0);
#pragma unroll 1
            for (int j0 = 0; j0 < 128; j0 += 32) {
                P11_LOAD(pb, j0 + 16);
                P11_COMP(pa);
                if (j0 + 32 < 128) P11_LOAD(pa, j0 + 32);
                P11_COMP(pb);
            }
              asm volatile("" :: "v"(acc[0].x), "v"(acc[1].x), "v"(acc[2].x), "v"(acc[3].x)); for (int i = 0; i < 4; ++i) acc[i] = sv[i] * 0.f; }
#endif
            unsigned pa[16], pb[16];
            P11_LOAD(pa, 0);
#pragma unroll 1
            for (int j0 = 0; j0 < 128; j0 += 32) {
                P11_LOAD(pb, j0 + 16);
                P11_COMP(pa);
                if (j0 + 32 < 128) P11_LOAD(pa, j0 + 32);
                P11_COMP(pb);
            }
#undef P11_LOAD
#undef P11_COMP
            *(f32x4*)op = x0 + g0 * (f32x4){acc[0].x, acc[0].y, acc[1].x, acc[1].y};
            *(f32x4*)(op + 4) = x1 + g1 * (f32x4){acc[2].x, acc[2].y, acc[3].x, acc[3].y};
        }
    }
}

__global__ void __launch_bounds__(512, 2) fwd_kernel(Args args) {
    extern __shared__ __attribute__((aligned(16))) unsigned char lds[];
    Frame F;
    F.lds = lds; F.ws = args.ws; F.tid = threadIdx.x; F.lane = F.tid & 63; F.wave = __builtin_amdgcn_readfirstlane(F.tid >> 6); F.G = gridDim.x; F.bid = blockIdx.x;
    F.x = args.in[0]; F.c = args.in[1]; F.w_ada = args.in[2]; F.b_ada = args.in[3]; F.g1 = args.in[4]; F.g2 = args.in[5]; F.w_in = args.in[6]; F.g_q = args.in[7]; F.g_k = args.in[8];
    F.rel_bias = args.in[9]; F.pool_w = args.in[10]; F.pool_scale = args.in[11]; F.w_ab = args.in[12]; F.w_pb = args.in[13]; F.w_out = args.in[14]; F.w_pq = args.in[15];
    F.peer_keys = args.in[16]; F.peer_u = args.in[17]; F.peer_v = args.in[18]; F.out = args.out;
    LAS unsigned char* ldsl = (LAS unsigned char*)lds;
    volatile LAS unsigned* misc = (volatile LAS unsigned*)(ldsl + MISC_OFF);
    if (F.tid < 4) misc[F.tid] = 0u;
    __syncthreads();
    unsigned* barw = (unsigned*)(args.ws + WS_CTL) + (size_t)args.li * XCD_BAR_WORDS;
    XcdBarrier bar; bar.bar = barw; bar.x = 0; bar.st = misc;
    const int lo = args.ph_lo, hi = args.ph_hi;
    if (hi - lo > 1) bar = xcd_barrier_post(barw, misc);
#define IN(k) (lo <= (k) && (k) < hi)
#define SEAM(k) do { if (IN(k) && IN((k) + 1)) xcd_barrier(bar); } while (0)
    bf16_t* R0 = (bf16_t*)(F.ws + WS_R0);

#define PH2_BODY { \
        pg8::Gemm g{R0, (const bf16_t*)(F.ws + WS_WIN), MTOK, INWP, DM, DM, 0, nullptr, nullptr, 0, 0}; pg8::StaticOrder S; S.init(MTOK, INWP, F.G, F.bid); \
        EpiInproj E{(bf16_t*)(F.ws + WS_QN), (bf16_t*)(F.ws + WS_KN), (bf16_t*)(F.ws + WS_V), (bf16_t*)(F.ws + WS_IQ), (bf16_t*)(F.ws + WS_IK), (bf16_t*)(F.ws + WS_PL), \
                    (bf16_t*)(F.ws + WS_GA), (bf16_t*)(F.ws + WS_GP), (float*)(F.ws + WS_IW)}; \
        pg8::gemm_phase<EpiInproj>(ldsl, g, S, E); }
#define PH3_BODY { phase3_pooled(F); phase3_indexer(F); __syncthreads(); }
#define PH4_BODY { \
        phase4_attention(F); \
        __syncthreads(); \
        pg8::Gemm g{(const bf16_t*)(F.ws + WS_POOLED), (const bf16_t*)(F.ws + WS_POOLW), MTOK, PW, 256, 1024, 256, nullptr, nullptr, 0, 0}; pg8::StaticOrder S; S.init(MTOK, PW, F.G, F.bid); \
        EpiBf16Scale E{(bf16_t*)(F.ws + WS_POOL2), 1024, F.pool_scale}; \
        pg8::gemm_phase<EpiBf16Scale>(ldsl, g, S, E); }
#define PH5_BODY { \
        pg8::Gemm g{(const bf16_t*)(F.ws + WS_ATTN), (const bf16_t*)(F.ws + WS_WAB), MTOK, DM, 2048, 1024, 0, (const bf16_t*)(F.ws + WS_POOL2), (const bf16_t*)(F.ws + WS_WPB), 16, 1024}; \
        pg8::StaticOrder S; S.init(MTOK, DM, F.G, F.bid); \
        EpiMerge E{R0, (const bf16_t*)(F.ws + WS_GA), (const bf16_t*)(F.ws + WS_GP)}; pg8::gemm_phase<EpiMerge>(ldsl, g, S, E); }
#define PH6_BODY { \
        pg8::Gemm g{R0, (const bf16_t*)(F.ws + WS_WOUT), MTOK, DM, DM, DM, 0, nullptr, nullptr, 0, 0}; pg8::StaticOrder S; S.init(MTOK, DM, F.G, F.bid); \
        EpiResid E{F.x, F.out, (const float*)(F.ws + WS_MODF) + 4096}; pg8::gemm_phase<EpiResid>(ldsl, g, S, E); }
#define PH8_BODY { \
        pg8::Gemm g{(const bf16_t*)(F.ws + WS_H2), (const bf16_t*)(F.ws + WS_WPQ), MTOK, DM, DM, DM, 0, nullptr, nullptr, 0, 0}; pg8::StaticOrder S; S.init(MTOK, DM, F.G, F.bid); \
        EpiBf16Scale E{R0, 2048, nullptr}; pg8::gemm_phase<EpiBf16Scale>(ldsl, g, S, E); }
#define PH9_BODY { \
        pg8::Gemm g{R0, (const bf16_t*)(F.ws + WS_KEYSBD), MTOK, DM, 256, DM, 256, nullptr, nullptr, 0, 0}; pg8::StaticOrder S; S.init(MTOK, DM, F.G, F.bid); \
        EpiBf16Scale E{(bf16_t*)(F.ws + WS_SUB), 2048, nullptr}; pg8::gemm_phase<EpiBf16Scale>(ldsl, g, S, E); }
#define REP(k) if constexpr (((PROBE_REP) >> (k)) & 1)

    if (IN(0)) { phase0_prep(F); REP(0) { __syncthreads(); phase0_prep(F); } }
    SEAM(0);
    if (IN(1)) { phase_modnorm<true>(F, F.x, F.g1, 0, 2048, R0); REP(1) { phase_modnorm<true>(F, F.x, F.g1, 0, 2048, R0); } }
    SEAM(1);
    if (IN(2)) { PH2_BODY REP(2) PH2_BODY }
    SEAM(2);
    if (IN(3)) { phase3_qknorm(F); PH3_BODY REP(3) PH3_BODY }
    SEAM(3);
    if (IN(4)) { PH4_BODY REP(4) PH4_BODY }
    SEAM(4);
    if (IN(5)) { PH5_BODY REP(5) PH5_BODY }
    SEAM(5);
    if (IN(6)) { PH6_BODY REP(6) PH6_BODY }
    SEAM(6);
    if (IN(7)) { phase_modnorm<false>(F, F.out, F.g2, 6144, 8192, (bf16_t*)(F.ws + WS_H2)); REP(7) { phase_modnorm<false>(F, F.out, F.g2, 6144, 8192, (bf16_t*)(F.ws + WS_H2)); } }
    SEAM(7);
    if (IN(8)) { PH8_BODY REP(8) PH8_BODY }
    SEAM(8);
    if (IN(9)) { PH9_BODY REP(9) PH9_BODY }
    SEAM(9);
    if (IN(10)) { phase10_peer(F); REP(10) phase10_peer(F); }
    SEAM(10);
    if (IN(11)) { REP(11) { phase11_peer_v(F, (float*)(F.ws + WS_SUB)); } phase11_peer_v(F, F.out); }
#undef IN
#undef SEAM
}

extern "C" void kernel_launch(void* const* d_in, const int* in_sizes, int n_in, void* d_out, int out_size, void* d_ws, size_t ws_size, hipStream_t stream) {
    static int grid = 0;
    if (grid == 0) {
        if (n_in != 19 || out_size != MTOK * DM || ws_size < WS_END) { fprintf(stderr, "kernel_launch: unexpected shapes (n_in %d out %d ws %zu)\n", n_in, out_size, ws_size); grid = -1; return; }
        int dev = 0, cus = 0, per_cu = 0;
        if (hipGetDevice(&dev) != hipSuccess || hipDeviceGetAttribute(&cus, hipDeviceAttributeMultiprocessorCount, dev) != hipSuccess) { grid = -1; return; }
        if (hipFuncSetAttribute((const void*)fwd_kernel, hipFuncAttributeMaxDynamicSharedMemorySize, LDS_BYTES) != hipSuccess) { fprintf(stderr, "kernel_launch: hipFuncSetAttribute failed\n"); grid = -1; return; }
        if (hipOccupancyMaxActiveBlocksPerMultiprocessor(&per_cu, (const void*)fwd_kernel, 512, LDS_BYTES) != hipSuccess || per_cu < 1) { fprintf(stderr, "kernel_launch: occupancy query says %d\n", per_cu); }
        (void)hipGetLastError();
        grid = cus;
    }
    if (grid < 0) return;
    (void)in_sizes;
    if (hipMemsetAsync((char*)d_ws + WS_CTL, 0, CTL_ZERO_BYTES, stream) != hipSuccess) return;
    Args a{};
    for (int i = 0; i < 19; ++i) a.in[i] = (const float*)d_in[i];
    a.out = (float*)d_out; a.ws = (unsigned char*)d_ws;
#if MK_PER_PHASE
    for (int p = 0; p < NPHASE; ++p) { a.ph_lo = p; a.ph_hi = p + 1; a.li = p; hipLaunchKernelGGL(fwd_kernel, dim3(grid), dim3(512), LDS_BYTES, stream, a); }
#else
    a.ph_lo = 0; a.ph_hi = NPHASE; a.li = 0;
    hipLaunchKernelGGL(fwd_kernel, dim3(grid), dim3(512), LDS_BYTES, stream, a);
#endif
}
```

```cpp
#include <hip/hip_runtime.h>
#include <cstdio>
#include <cstdint>

#ifndef MK_PER_PHASE
#define MK_PER_PHASE 0
#endif

#ifndef PROBE_REP
#define PROBE_REP 0
#endif
#ifndef PROBE_IDX
#define PROBE_IDX 0
#endif
#ifndef PROBE_SEL
#define PROBE_SEL 0
#endif
#ifndef PROBE_P11X
#define PROBE_P11X 0
#endif
#define LAS __attribute__((address_space(3)))
typedef unsigned short bf16_t;
typedef short bf16x8 __attribute__((ext_vector_type(8)));
typedef float f32x4 __attribute__((ext_vector_type(4)));
typedef float f32x2 __attribute__((ext_vector_type(2)));
typedef unsigned u32x4 __attribute__((ext_vector_type(4)));
typedef unsigned u32x2 __attribute__((ext_vector_type(2)));
typedef unsigned u32x6 __attribute__((ext_vector_type(6)));
typedef unsigned u32x16 __attribute__((ext_vector_type(16)));
typedef __bf16 bf16x32 __attribute__((ext_vector_type(32)));

constexpr int BATCH = 8, SEQ = 4096, DM = 2048, MTOK = BATCH * SEQ;
constexpr int NHEAD = 8, HDIM = 128, AW = 1024, KVW = 256, IHEADS = 16, IDIM = 64, KSEL = 256;
constexpr int PW = 1024, PHEADS = 8, NEXP = 16384;
constexpr int INW = 7760, INWP = 7936;
constexpr float EPS = 1e-6f;
constexpr int NPHASE = 12;

constexpr size_t MiB = 1u << 20;
constexpr size_t WS_CTL = 0, CTL_ZERO_BYTES = 256 * 1024;
constexpr size_t WS_MODP = 2 * MiB;
constexpr size_t WS_MODF = 4 * MiB;
constexpr size_t WS_POOLW = 5 * MiB;
constexpr size_t WS_KEYSBD = 6 * MiB;
constexpr size_t WS_WIN = 8 * MiB;
constexpr size_t WS_WAB = 40 * MiB, WS_WPB = 44 * MiB, WS_WOUT = 48 * MiB, WS_WPQ = 56 * MiB;
constexpr size_t WS_PU = 64 * MiB, WS_PV = 128 * MiB;
constexpr size_t WS_R0 = 192 * MiB;
constexpr size_t WS_GA = 320 * MiB, WS_GP = 448 * MiB;
constexpr size_t WS_SUB = 320 * MiB;
constexpr size_t WS_QN = 576 * MiB;
constexpr size_t WS_IQ = 640 * MiB;
constexpr size_t WS_PL = 704 * MiB;
constexpr size_t WS_KN = 768 * MiB, WS_V = 784 * MiB;
constexpr size_t WS_IK = 800 * MiB;
constexpr size_t WS_IW = 804 * MiB;
constexpr size_t WS_SEL = 806 * MiB;
constexpr size_t WS_POOLED = 822 * MiB;
constexpr size_t WS_H2 = 886 * MiB;
constexpr size_t WS_END = 1014 * MiB;
constexpr size_t WS_Q8 = WS_H2, WS_K8 = WS_H2 + 32 * MiB, WS_V8 = WS_H2 + 40 * MiB;
constexpr size_t WS_ATTN = WS_IQ, WS_POOL2 = WS_PL, WS_PAIRS = WS_QN, WS_WLS = WS_QN + 32 * MiB;

constexpr int LDS_BYTES = 160 * 1024;
constexpr int MISC_OFF = 159 * 1024;

__device__ __forceinline__ unsigned cvt_pk_bf16(float lo, float hi) { unsigned r; asm volatile("v_cvt_pk_bf16_f32 %0, %1, %2" : "=v"(r) : "v"(lo), "v"(hi)); return r; }
__device__ __forceinline__ float bf_lo(unsigned w) { return __uint_as_float(w << 16); }
__device__ __forceinline__ float bf_hi(unsigned w) { return __uint_as_float(w & 0xffff0000u); }
template <int CTRL> __device__ __forceinline__ float dpp_f(float x) { return __int_as_float(__builtin_amdgcn_update_dpp(0, __float_as_int(x), CTRL, 0xF, 0xF, true)); }
#define DPP_XOR1 0xB1
#define DPP_XOR2 0x4E
#define DPP_HMIRROR 0x141
#define DPP_MIRROR 0x140
#define DPP_ROR8 0x128
__device__ __forceinline__ float xor16_sum(float x) { const auto r = __builtin_amdgcn_permlane16_swap(__float_as_uint(x), __float_as_uint(x), false, false); return __uint_as_float(r[0]) + __uint_as_float(r[1]); }
__device__ __forceinline__ float xor32_sum(float x) { const auto r = __builtin_amdgcn_permlane32_swap(__float_as_uint(x), __float_as_uint(x), false, false); return __uint_as_float(r[0]) + __uint_as_float(r[1]); }
__device__ __forceinline__ float xor16_max(float x) { const auto r = __builtin_amdgcn_permlane16_swap(__float_as_uint(x), __float_as_uint(x), false, false); return fmaxf(__uint_as_float(r[0]), __uint_as_float(r[1])); }
__device__ __forceinline__ float swap32_pair(float a, float b) { const auto r = __builtin_amdgcn_permlane32_swap(__float_as_uint(a), __float_as_uint(b), false, false); return __uint_as_float(r[0]) + __uint_as_float(r[1]); }
__device__ __forceinline__ float swap16_pair(float a, float b) { const auto r = __builtin_amdgcn_permlane16_swap(__float_as_uint(a), __float_as_uint(b), false, false); return __uint_as_float(r[0]) + __uint_as_float(r[1]); }
__device__ __forceinline__ float row_sum16(float v) { v += dpp_f<DPP_XOR1>(v); v += dpp_f<DPP_XOR2>(v); v += dpp_f<DPP_HMIRROR>(v); v += dpp_f<DPP_MIRROR>(v); return v; }
__device__ __forceinline__ float row_max16(float v) { v = fmaxf(v, dpp_f<DPP_XOR1>(v)); v = fmaxf(v, dpp_f<DPP_XOR2>(v)); v = fmaxf(v, dpp_f<DPP_HMIRROR>(v)); v = fmaxf(v, dpp_f<DPP_MIRROR>(v)); return v; }
__device__ __forceinline__ float wave_sum(float v) { return xor32_sum(xor16_sum(row_sum16(v))); }
__device__ __forceinline__ float sigmoidf_(float x) { return __builtin_amdgcn_rcpf(1.0f + __expf(-x)); }
__device__ __forceinline__ float dot8(u32x4 w, const float* h) {
    return bf_lo(w.x) * h[0] + bf_hi(w.x) * h[1] + bf_lo(w.y) * h[2] + bf_hi(w.y) * h[3] + bf_lo(w.z) * h[4] + bf_hi(w.z) * h[5] + bf_lo(w.w) * h[6] + bf_hi(w.w) * h[7];
}

#define XB_TMO      128
#define XB_XCNT(j)  (256  + 64 * (j))
#define XB_XSUB(j)  (1280 + 64 * (j))
#define XB_XGEN(j)  (2304 + 64 * (j))
#define XB_TOP      3328
#define XB_TOPGEN   3392
#define XCD_BAR_WORDS 3456
#define XB_SPIN_CAP (1u << 18)

__device__ __forceinline__ unsigned xb_ld(unsigned* p)              { return __hip_atomic_load(p, __ATOMIC_RELAXED, __HIP_MEMORY_SCOPE_AGENT); }
__device__ __forceinline__ unsigned xb_add(unsigned* p, unsigned v) { return __hip_atomic_fetch_add(p, v, __ATOMIC_RELAXED, __HIP_MEMORY_SCOPE_AGENT); }
__device__ __forceinline__ unsigned xb_xcc_id() { return (unsigned)__builtin_amdgcn_s_getreg((3 << 11) | 20) & 0xFu; }
#define XB_SPIN(cond, bar) do { unsigned _sp = 0; while (cond) { __builtin_amdgcn_s_sleep(1); \
    if ((++_sp & 255u) == 0u) { if (xb_ld(&(bar)[XB_TMO])) break; if (_sp > XB_SPIN_CAP) { atomicAdd(&(bar)[XB_TMO], 1u); break; } } } } while (0)

struct XcdBarrier { unsigned* bar; unsigned x; volatile LAS unsigned* st; };

__device__ __forceinline__ XcdBarrier xcd_barrier_post(unsigned* bar, volatile LAS unsigned* st) {
    XcdBarrier b; b.bar = bar; b.x = xb_xcc_id(); b.st = st;
    if (threadIdx.x == 0) (void)xb_add(&bar[XB_XCNT(b.x)], 1u);
    return b;
}
__device__ __forceinline__ void xcd_barrier_complete(unsigned* bar, unsigned x, unsigned& nloc, unsigned& nx) {
    const unsigned G = gridDim.x * gridDim.y * gridDim.z;
    unsigned sum, cnt, mine, sp = 0u;
    for (;;) {
        sum = 0u; cnt = 0u; mine = 0u;
#pragma unroll
        for (unsigned j = 0; j < 16; ++j) { const unsigned c = xb_ld(&bar[XB_XCNT(j)]); sum += c; cnt += (c > 0u) ? 1u : 0u; mine = (j == x) ? c : mine; }
        if (sum == G) break;
        __builtin_amdgcn_s_sleep(1);
        if ((++sp & 255u) == 0u) { if (xb_ld(&bar[XB_TMO])) break; if (sp > XB_SPIN_CAP) { atomicAdd(&bar[XB_TMO], 1u); break; } }
    }
    nloc = mine > 0u ? mine : 1u; nx = cnt > 0u ? cnt : 1u;
}
__device__ __forceinline__ void xcd_barrier(const XcdBarrier& b) {
    asm volatile("s_waitcnt vmcnt(0)" ::: "memory");
    __syncthreads();
    if (threadIdx.x == 0) {
        unsigned* bar = b.bar;
        __builtin_amdgcn_s_waitcnt(0);
        unsigned nloc = b.st[0], nx = b.st[1];
        if (nloc == 0u) { xcd_barrier_complete(bar, b.x, nloc, nx); b.st[0] = nloc; b.st[1] = nx; }
        const unsigned old = xb_add(&bar[XB_XSUB(b.x)], 1u);
        const unsigned gen = old / nloc;
        if (old + 1u == (gen + 1u) * nloc) {
            __builtin_amdgcn_fence(__ATOMIC_RELEASE, "agent");
            asm volatile("s_waitcnt vmcnt(0)" ::: "memory");
            const unsigned og = xb_add(&bar[XB_TOP], 1u);
            const unsigned tg = og / nx;
            if (og + 1u == (tg + 1u) * nx) xb_add(&bar[XB_TOPGEN], 1u);
            else XB_SPIN(xb_ld(&bar[XB_TOPGEN]) == tg, bar);
            __builtin_amdgcn_fence(__ATOMIC_ACQUIRE, "agent");
            xb_add(&bar[XB_XGEN(b.x)], 1u);
            asm volatile("s_waitcnt vmcnt(0)" ::: "memory");
        } else {
            XB_SPIN(xb_ld(&bar[XB_XGEN(b.x)]) == gen, bar);
            __builtin_amdgcn_fence(__ATOMIC_ACQUIRE, "agent");
            asm volatile("s_waitcnt vmcnt(0)" ::: "memory");
        }
    }
    __syncthreads();
}

namespace pg8 {
constexpr int BM = 256, BK = 64, HALF = 128, HTB = HALF * BK * 2, STAGE_BYTES = 8 * HTB, NXCD = 8, WGM = 8;
__device__ __forceinline__ int lds_byte(int r, int c) { const int st = (r >> 4) * 2 + (c >> 5), rr = r & 15, cc = c & 31, ob = rr * 64 + cc * 2; return st * 1024 + (ob ^ (((ob >> 9) & 1) << 5)); }
__device__ __forceinline__ void stage_rc(int b, int& R, int& C) { const int st = b / 1024, sb = b % 1024, swz = sb ^ (((sb >> 9) & 1) << 5); R = (st >> 1) * 16 + swz / 64; C = (st & 1) * 32 + (swz % 64) / 2; }
__device__ __forceinline__ int perm32(int rho) { const int n = rho >> 4, i = rho & 15; return 8 * (i >> 2) + 4 * n + (i & 3); }

struct Unit { int pm, pn; };
struct Gemm { const bf16_t* A; const bf16_t* Bt; int M, N, K, lda, a_pn_off; const bf16_t* A2; const bf16_t* Bt2; int ksplit, ldb; };

struct StaticOrder {
    int nM, nN, nwg, G, c;
    __device__ void init(int M, int N, int G_, int c_) { nM = M / BM; nN = N / BM; nwg = nM * nN; G = G_; c = c_; }
    __device__ bool next(int i, Unit& u) const {
        const long L = (long)i * G + c; if (L >= nwg) return false;
        int wgid = (int)L; { const int q = nwg / NXCD, r = nwg % NXCD, xcd = wgid % NXCD, off = wgid / NXCD; wgid = (xcd < r ? xcd * (q + 1) : r * (q + 1) + (xcd - r) * q) + off; }
        const int nig = WGM * nN, gid = wgid / nig, fm = gid * WGM, gsz = (nM - fm) < WGM ? (nM - fm) : WGM;
        u.pm = fm + ((wgid % nig) % gsz); u.pn = (wgid % nig) / gsz; return true;
    }
};

template <class Epi>
__device__ __forceinline__ void gemm_phase(LAS unsigned char* lds, const Gemm g, const StaticOrder& S, const Epi& E) {
    const int tid = threadIdx.x, wid = __builtin_amdgcn_readfirstlane(tid >> 6), lane = tid & 63, wr = wid >> 2, wc = wid & 3, fr = lane & 15, fq = lane >> 4;
    const int K = g.K, nt = K / BK, lda = g.lda, ldb = g.ldb ? g.ldb : g.K, ksplit = g.ksplit;
    unsigned voffA[2], voffB[2];
#pragma unroll
    for (int i = 0; i < 2; ++i) { int R, C; stage_rc(tid * 16 + i * 8192, R, C); const int Rb = Epi::PERM ? ((R & ~31) + perm32(R & 31)) : R;
        voffA[i] = (unsigned)(R * lda + C) * 2u; voffB[i] = (unsigned)(Rb * ldb + C) * 2u; }
    const size_t kstep = (size_t)(BK * 2);
    const size_t hsA = (size_t)HALF * lda * 2, hsB = (size_t)HALF * ldb * 2;
    const size_t tsA = 2 * hsA, tsB = 2 * hsB;
    const unsigned ldsw = (unsigned)wid * 1024u;
    const int aoff = lds_byte(wr * 64 + fr, fq * 8), boff = lds_byte(wc * 32 + fr, fq * 8);
#define PG8_SA(b, h) (((b) * 2 + (h)) * HTB)
#define PG8_SB(b, h) ((4 + (b) * 2 + (h)) * HTB)
#define PG8_STAGE(bufoff, gbase, voff) do { _Pragma("unroll") for (int _i = 0; _i < 2; ++_i) \
        __builtin_amdgcn_global_load_lds((const unsigned*)((const char*)(gbase) + (voff)[_i]), (LAS unsigned*)(lds + (bufoff) + ldsw + _i * 8192), 16, 0, 0); } while (0)
#define PG8_LDA(dst, b, h) do { _Pragma("unroll") for (int m = 0; m < 4; ++m) _Pragma("unroll") for (int k = 0; k < 2; ++k) dst[m][k] = *(const LAS bf16x8*)(lds + PG8_SA(b, h) + aoff + m * 2048 + k * 1024); } while (0)
#define PG8_LDB(dst, b, h) do { _Pragma("unroll") for (int n = 0; n < 2; ++n) _Pragma("unroll") for (int k = 0; k < 2; ++k) dst[n][k] = *(const LAS bf16x8*)(lds + PG8_SB(b, h) + boff + n * 2048 + k * 1024); } while (0)
#define PG8_MMA(ai, bj, At, Bt) do { __builtin_amdgcn_s_setprio(1); _Pragma("unroll") for (int m = 0; m < 4; ++m) _Pragma("unroll") for (int n = 0; n < 2; ++n) _Pragma("unroll") for (int k = 0; k < 2; ++k) \
        acc[ai][bj][m][n] = __builtin_amdgcn_mfma_f32_16x16x32_bf16(Bt[n][k], At[m][k], acc[ai][bj][m][n], 0, 0, 0); __builtin_amdgcn_s_setprio(0); } while (0)
#define PG8_WAIT_V(n) asm volatile("s_waitcnt vmcnt(" #n ")" ::: "memory")
#define PG8_WAIT_L(n) asm volatile("s_waitcnt lgkmcnt(" #n ")" ::: "memory")
#define PG8_BAR __builtin_amdgcn_s_barrier()
#define PG8_SCHED __builtin_amdgcn_sched_barrier(0)
    Unit cur, nxt; int ui = 0;
    if (!S.next(0, cur)) return;
    f32x4 acc[2][2][4][2];
#pragma unroll
    for (int a = 0; a < 2; ++a)
#pragma unroll
        for (int b = 0; b < 2; ++b)
#pragma unroll
            for (int m = 0; m < 4; ++m)
#pragma unroll
                for (int n = 0; n < 2; ++n) acc[a][b][m][n] = (f32x4){0.f, 0.f, 0.f, 0.f};
    bf16x8 At[4][2], B0[2][2], B1[2][2];
    const char* cA = (const char*)g.A + (size_t)cur.pm * tsA + (size_t)cur.pn * g.a_pn_off * 2; const char* cB = (const char*)g.Bt + (size_t)cur.pn * tsB;
    PG8_STAGE(PG8_SB(0, 0), cB, voffB); PG8_STAGE(PG8_SB(0, 1), cB + hsB, voffB); PG8_STAGE(PG8_SA(0, 0), cA, voffA); PG8_STAGE(PG8_SA(0, 1), cA + hsA, voffA);
    if (wr == 1) PG8_BAR;
    PG8_WAIT_V(2); PG8_BAR;
    PG8_STAGE(PG8_SB(1, 0), cB + kstep, voffB); PG8_STAGE(PG8_SA(1, 0), cA + kstep, voffA); PG8_STAGE(PG8_SB(1, 1), cB + hsB + kstep, voffB);
    PG8_WAIT_V(6); PG8_BAR;
    for (;;) {
        const bool has_next = S.next(ui + 1, nxt);
        const char* nA = has_next ? (const char*)g.A + (size_t)nxt.pm * tsA + (size_t)nxt.pn * g.a_pn_off * 2 : cA; const char* nB = has_next ? (const char*)g.Bt + (size_t)nxt.pn * tsB : cB;
        const char* cA2 = (const char*)g.A2 + (size_t)cur.pm * tsA; const char* cB2 = (const char*)g.Bt2 + (size_t)cur.pn * tsB;
        for (int t = 0; t < nt; t += 2) {
            const bool last = (t == nt - 2);
            const bool s1 = ksplit && (t >= ksplit), s2 = ksplit && (t + 2 >= ksplit);
            const char* a1 = (s1 ? cA2 + (size_t)(t - ksplit + 1) * kstep : cA + (size_t)(t + 1) * kstep);
            const char* a2 = last ? nA : (s2 ? cA2 + (size_t)(t + 2 - ksplit) * kstep : cA + (size_t)(t + 2) * kstep);
            const char* b2 = last ? nB : (s2 ? cB2 + (size_t)(t + 2 - ksplit) * kstep : cB + (size_t)(t + 2) * kstep);
            const char* a3 = a2 + kstep; const char* b3 = b2 + kstep;
            PG8_LDB(B0, 0, 0); PG8_LDB(B1, 0, 1); PG8_SCHED; PG8_LDA(At, 0, 0); PG8_STAGE(PG8_SA(1, 1), a1 + hsA, voffA);
            PG8_WAIT_V(8); PG8_WAIT_L(0); PG8_BAR; PG8_MMA(0, 0, At, B0); PG8_MMA(0, 1, At, B1); PG8_BAR; PG8_SCHED;
            PG8_LDA(At, 0, 1); PG8_STAGE(PG8_SB(0, 0), b2, voffB); PG8_STAGE(PG8_SB(0, 1), b2 + hsB, voffB); PG8_STAGE(PG8_SA(0, 0), a2, voffA);
            PG8_WAIT_V(8); PG8_WAIT_L(0); PG8_BAR; PG8_MMA(1, 0, At, B0); PG8_MMA(1, 1, At, B1); PG8_BAR; PG8_SCHED;
            PG8_LDB(B0, 1, 0); PG8_LDB(B1, 1, 1); PG8_SCHED; PG8_LDA(At, 1, 0); PG8_STAGE(PG8_SA(0, 1), a2 + hsA, voffA);
            PG8_WAIT_V(8); PG8_WAIT_L(0); PG8_BAR; PG8_MMA(0, 0, At, B0); PG8_MMA(0, 1, At, B1); PG8_BAR; PG8_SCHED;
            PG8_LDA(At, 1, 1); PG8_STAGE(PG8_SB(1, 0), b3, voffB); PG8_STAGE(PG8_SB(1, 1), b3 + hsB, voffB); PG8_STAGE(PG8_SA(1, 0), a3, voffA);
            PG8_WAIT_V(8); PG8_WAIT_L(0); PG8_BAR; PG8_MMA(1, 0, At, B0); PG8_MMA(1, 1, At, B1); PG8_BAR; PG8_SCHED;
            if constexpr (Epi::MID) { if (t + 2 == ksplit) E.mid(acc, cur, wr, wc, fr, fq); }
        }
        if (wr == 0) PG8_BAR;
        E(acc, cur, wr, wc, fr, fq);
        if (!has_next) break;
#pragma unroll
        for (int a = 0; a < 2; ++a)
#pragma unroll
            for (int b = 0; b < 2; ++b)
#pragma unroll
                for (int m = 0; m < 4; ++m)
#pragma unroll
                    for (int n = 0; n < 2; ++n) acc[a][b][m][n] = (f32x4){0.f, 0.f, 0.f, 0.f};
        cur = nxt; cA = nA; cB = nB; ++ui;
        if (wr == 1) PG8_BAR;
    }
    PG8_WAIT_V(0);
    PG8_BAR;
#undef PG8_SA
#undef PG8_SB
#undef PG8_STAGE
#undef PG8_LDA
#undef PG8_LDB
#undef PG8_MMA
#undef PG8_WAIT_V
#undef PG8_WAIT_L
#undef PG8_BAR
#undef PG8_SCHED
}
}
using pg8::Unit;

typedef f32x4 AccT[2][2][4][2];
__device__ __forceinline__ u32x4 pack8(f32x4 a, f32x4 b) { u32x4 w; w.x = cvt_pk_bf16(a[0], a[1]); w.y = cvt_pk_bf16(a[2], a[3]); w.z = cvt_pk_bf16(b[0], b[1]); w.w = cvt_pk_bf16(b[2], b[3]); return w; }
__device__ __forceinline__ void unpack8(u32x4 w, f32x4& a, f32x4& b) { a = (f32x4){bf_lo(w.x), bf_hi(w.x), bf_lo(w.y), bf_hi(w.y)}; b = (f32x4){bf_lo(w.z), bf_hi(w.z), bf_lo(w.w), bf_hi(w.w)}; }

struct EpiInproj {
    static constexpr bool PERM = true, MID = false;
    bf16_t *q, *k, *v, *iq, *ik, *pl, *ga, *gp; float* iw;
    __device__ __forceinline__ void operator()(const AccT& acc, const Unit& u, int wr, int wc, int fr, int fq) const {
        const int pn = u.pn, row0 = u.pm * 256 + wr * 64 + fr;
        if (pn == 10) {
            if (wc < 2) {
#pragma unroll
                for (int ai = 0; ai < 2; ++ai)
#pragma unroll
                    for (int m = 0; m < 4; ++m) { const size_t row = (size_t)(row0 + ai * 128 + m * 16);
                        *(u32x4*)(ik + row * 64 + wc * 32 + 8 * fq) = pack8(acc[ai][0][m][0], acc[ai][0][m][1]); }
            } else if (wc == 2) {
                if (fq < 2) {
#pragma unroll
                    for (int ai = 0; ai < 2; ++ai)
#pragma unroll
                        for (int m = 0; m < 4; ++m) { const size_t row = (size_t)(row0 + ai * 128 + m * 16);
                            *(f32x4*)(iw + row * 16 + 8 * fq) = acc[ai][0][m][0]; *(f32x4*)(iw + row * 16 + 8 * fq + 4) = acc[ai][0][m][1]; }
                }
            }
            return;
        }
        bf16_t* dst; int ld, tc; bool sg = false;
        if (pn < 4) { dst = q; ld = 1024; tc = pn * 256; }
        else if (pn == 4) { dst = k; ld = 256; tc = 0; }
        else if (pn == 5) { dst = v; ld = 256; tc = 0; }
        else if (pn < 10) { dst = iq; ld = 1024; tc = (pn - 6) * 256; }
        else if (pn < 15) { dst = pl; ld = 1024; tc = (pn - 11) * 256; }
        else if (pn < 23) { dst = ga; ld = 2048; tc = (pn - 15) * 256; sg = true; }
        else { dst = gp; ld = 2048; tc = (pn - 23) * 256; sg = true; }
        const int col0 = tc + wc * 32 + 8 * fq;
#pragma unroll
        for (int ai = 0; ai < 2; ++ai)
#pragma unroll
            for (int m = 0; m < 4; ++m) { bf16_t* rowp = dst + (size_t)(row0 + ai * 128 + m * 16) * ld + col0;
#pragma unroll
                for (int bj = 0; bj < 2; ++bj) { f32x4 v0 = acc[ai][bj][m][0], v1 = acc[ai][bj][m][1];
                    if (sg) {
#pragma unroll
                        for (int j = 0; j < 4; ++j) { v0[j] = sigmoidf_(v0[j]); v1[j] = sigmoidf_(v1[j]); } }
                    *(u32x4*)(rowp + bj * 128) = pack8(v0, v1); } }
    }
};
struct EpiBf16Scale {
    static constexpr bool PERM = true, MID = false;
    bf16_t* O; int ldc; const float* cs;
    __device__ __forceinline__ void operator()(const AccT& acc, const Unit& u, int wr, int wc, int fr, int fq) const {
        const int row0 = u.pm * 256 + wr * 64 + fr, col0 = u.pn * 256 + wc * 32 + 8 * fq;
        f32x4 s[2][2];
#pragma unroll
        for (int bj = 0; bj < 2; ++bj)
#pragma unroll
            for (int n = 0; n < 2; ++n) s[bj][n] = cs ? *(const f32x4*)(cs + col0 + bj * 128 + 4 * n) : (f32x4){1.f, 1.f, 1.f, 1.f};
#pragma unroll
        for (int ai = 0; ai < 2; ++ai)
#pragma unroll
            for (int m = 0; m < 4; ++m) { bf16_t* rowp = O + (size_t)(row0 + ai * 128 + m * 16) * ldc + col0;
#pragma unroll
                for (int bj = 0; bj < 2; ++bj) *(u32x4*)(rowp + bj * 128) = pack8(acc[ai][bj][m][0] * s[bj][0], acc[ai][bj][m][1] * s[bj][1]); }
    }
};
template <bool ADD> struct EpiGate {
    static constexpr bool PERM = true, MID = false;
    bf16_t* O; const bf16_t* gate;
    __device__ __forceinline__ void operator()(const AccT& acc, const Unit& u, int wr, int wc, int fr, int fq) const {
        const int row0 = u.pm * 256 + wr * 64 + fr, col0 = u.pn * 256 + wc * 32 + 8 * fq;
#pragma unroll
        for (int ai = 0; ai < 2; ++ai)
#pragma unroll
            for (int m = 0; m < 4; ++m) { const size_t off = (size_t)(row0 + ai * 128 + m * 16) * 2048 + col0;
#pragma unroll
                for (int bj = 0; bj < 2; ++bj) { f32x4 g0, g1; unpack8(*(const u32x4*)(gate + off + bj * 128), g0, g1);
                    f32x4 r0 = g0 * acc[ai][bj][m][0], r1 = g1 * acc[ai][bj][m][1];
                    if (ADD) { f32x4 o0, o1; unpack8(*(const u32x4*)(O + off + bj * 128), o0, o1); r0 += o0; r1 += o1; }
                    *(u32x4*)(O + off + bj * 128) = pack8(r0, r1); } }
    }
};
struct EpiMerge {
    static constexpr bool PERM = true, MID = true;
    bf16_t* O; const bf16_t* ga; const bf16_t* gp;
    __device__ __forceinline__ void mid(AccT& acc, const Unit& u, int wr, int wc, int fr, int fq) const {
        const auto ra = __builtin_amdgcn_make_buffer_rsrc((void*)ga, 0, 0x7FFFFFFF, 0x00020000), rp = __builtin_amdgcn_make_buffer_rsrc((void*)gp, 0, 0x7FFFFFFF, 0x00020000);
        const int voff = ((wr * 64 + fr) * 2048 + wc * 32 + 8 * fq) * 2;
        const int sbase = (u.pm * 256 * 2048 + u.pn * 256) * 2;
#pragma unroll
        for (int ai = 0; ai < 2; ++ai)
#pragma unroll
            for (int m = 0; m < 4; ++m)
#pragma unroll
                for (int bj = 0; bj < 2; ++bj) { const int so = sbase + ((ai * 128 + m * 16) * 2048 + bj * 128) * 2;
                    const u32x4 wa = __builtin_bit_cast(u32x4, __builtin_amdgcn_raw_buffer_load_b128(ra, voff, so, 0)), wp = __builtin_bit_cast(u32x4, __builtin_amdgcn_raw_buffer_load_b128(rp, voff, so, 0));
                    f32x4 a0, a1, p0, p1; unpack8(wa, a0, a1); unpack8(wp, p0, p1);
#pragma unroll
                    for (int j = 0; j < 4; ++j) { acc[ai][bj][m][0][j] *= a0[j] * __builtin_amdgcn_rcpf(p0[j]); acc[ai][bj][m][1][j] *= a1[j] * __builtin_amdgcn_rcpf(p1[j]); }
                    asm volatile("" : "+v"(acc[ai][bj][m][0]), "+v"(acc[ai][bj][m][1]) :: "memory"); }
    }
    __device__ __forceinline__ void operator()(const AccT& acc, const Unit& u, int wr, int wc, int fr, int fq) const {
        const int row0 = u.pm * 256 + wr * 64 + fr, col0 = u.pn * 256 + wc * 32 + 8 * fq;
#pragma unroll
        for (int ai = 0; ai < 2; ++ai)
#pragma unroll
            for (int m = 0; m < 4; ++m) { const size_t off = (size_t)(row0 + ai * 128 + m * 16) * 2048 + col0;
#pragma unroll
                for (int bj = 0; bj < 2; ++bj) { f32x4 p0, p1; unpack8(*(const u32x4*)(gp + off + bj * 128), p0, p1);
                    *(u32x4*)(O + off + bj * 128) = pack8(p0 * acc[ai][bj][m][0], p1 * acc[ai][bj][m][1]); } }
    }
};
struct EpiResid {
    static constexpr bool PERM = false, MID = false;
    const float* x; float* out; const float* gt;
    __device__ __forceinline__ void operator()(const AccT& acc, const Unit& u, int wr, int wc, int fr, int fq) const {
        const int row0 = u.pm * 256 + wr * 64 + fr, col0 = u.pn * 256 + wc * 32 + 4 * fq;
        const float* gtb = gt + (size_t)(u.pm / 16) * 12288;
        f32x4 g[2][2];
#pragma unroll
        for (int bj = 0; bj < 2; ++bj)
#pragma unroll
            for (int n = 0; n < 2; ++n) g[bj][n] = *(const f32x4*)(gtb + col0 + bj * 128 + n * 16);
#pragma unroll
        for (int ai = 0; ai < 2; ++ai)
#pragma unroll
            for (int m = 0; m < 4; ++m) { const size_t off = (size_t)(row0 + ai * 128 + m * 16) * 2048 + col0;
#pragma unroll
                for (int bj = 0; bj < 2; ++bj)
#pragma unroll
                    for (int n = 0; n < 2; ++n) { const f32x4 xv = *(const f32x4*)(x + off + bj * 128 + n * 16);
                        *(f32x4*)(out + off + bj * 128 + n * 16) = xv + g[bj][n] * acc[ai][bj][m][n]; } }
    }
};
struct EpiF32 {
    static constexpr bool PERM = false, MID = false;
    float* C; int ldc;
    __device__ __forceinline__ void operator()(const AccT& acc, const Unit& u, int wr, int wc, int fr, int fq) const {
        const int row0 = u.pm * 256 + wr * 64 + fr, col0 = u.pn * 256 + wc * 32 + 4 * fq;
#pragma unroll
        for (int ai = 0; ai < 2; ++ai)
#pragma unroll
            for (int m = 0; m < 4; ++m) { float* rowp = C + (size_t)(row0 + ai * 128 + m * 16) * ldc + col0;
#pragma unroll
                for (int bj = 0; bj < 2; ++bj)
#pragma unroll
                    for (int n = 0; n < 2; ++n) *(f32x4*)(rowp + bj * 128 + n * 16) = acc[ai][bj][m][n]; }
    }
};

struct Args { const float* in[19]; float* out; unsigned char* ws; int ph_lo, ph_hi; int li, pad; };
struct Frame {
    unsigned char* lds; unsigned char* ws;
    int tid, lane, wave, G, bid;
    const float *x, *c, *w_ada, *b_ada, *g1, *g2, *w_in, *g_q, *g_k, *rel_bias, *pool_w, *pool_scale, *w_ab, *w_pb, *w_out, *w_pq, *peer_keys, *peer_u, *peer_v;
    float* out;
};

template <class Fn> __device__ __forceinline__ void transpose_item(const float* W, int K, int N, bf16_t* WT, int ldk, int drow0, int k0, float* scr, int lane, Fn srccol) {
    const int sc = srccol(drow0 + (lane & 31));
#pragma unroll 8
    for (int i = 0; i < 32; ++i) { const int kk = 2 * i + (lane >> 5); scr[kk * 33 + (lane & 31)] = sc >= 0 ? W[(size_t)(k0 + kk) * N + sc] : 0.f; }
    asm volatile("s_waitcnt lgkmcnt(0)" ::: "memory");
    const int c = lane & 7;
#pragma unroll
    for (int j = 0; j < 4; ++j) { const int n = (lane >> 3) + 8 * j; const float* s = scr + (8 * c) * 33 + n;
        u32x4 o; o.x = cvt_pk_bf16(s[0 * 33], s[1 * 33]); o.y = cvt_pk_bf16(s[2 * 33], s[3 * 33]); o.z = cvt_pk_bf16(s[4 * 33], s[5 * 33]); o.w = cvt_pk_bf16(s[6 * 33], s[7 * 33]);
        *(u32x4*)(WT + (size_t)(drow0 + n) * ldk + k0 + 8 * c) = o; }
    asm volatile("s_waitcnt lgkmcnt(0)" ::: "memory");
}
__device__ __forceinline__ void phase0_prep(Frame& F) {
    const int gw = F.bid * 8 + F.wave, NGW = F.G * 8;
    float* scr = (float*)(F.lds + F.wave * 16384);
    constexpr int I_IN = (INWP / 32) * (DM / 64);
    constexpr int I_AB = (2048 / 32) * (1024 / 64), I_OUT = (2048 / 32) * (2048 / 64), I_PW = 4 * 8 * 4;
    constexpr int NIT = I_IN + 2 * I_AB + 2 * I_OUT + I_PW;
    auto ident = [](int j) { return j; };
    for (int it = gw; it < NIT; it += NGW) {
        int r = it;
        if (r < I_IN) { const int nb = r % (INWP / 32), kb = r / (INWP / 32);
            transpose_item(F.w_in, DM, INW, (bf16_t*)(F.ws + WS_WIN), DM, nb * 32, kb * 64, scr, F.lane, [](int j) { return j < 2640 ? j : (j < 2816 ? -1 : j - 176); }); continue; }
        r -= I_IN;
        if (r < I_AB) { transpose_item(F.w_ab, 1024, 2048, (bf16_t*)(F.ws + WS_WAB), 1024, (r % 64) * 32, (r / 64) * 64, scr, F.lane, ident); continue; }
        r -= I_AB;
        if (r < I_AB) { transpose_item(F.w_pb, 1024, 2048, (bf16_t*)(F.ws + WS_WPB), 1024, (r % 64) * 32, (r / 64) * 64, scr, F.lane, ident); continue; }
        r -= I_AB;
        if (r < I_OUT) { transpose_item(F.w_out, 2048, 2048, (bf16_t*)(F.ws + WS_WOUT), 2048, (r % 64) * 32, (r / 64) * 64, scr, F.lane, ident); continue; }
        r -= I_OUT;
        if (r < I_OUT) { transpose_item(F.w_pq, 2048, 2048, (bf16_t*)(F.ws + WS_WPQ), 2048, (r % 64) * 32, (r / 64) * 64, scr, F.lane, ident); continue; }
        r -= I_OUT;
        { const int g = r / 32, q = r % 32, nb = q % 8, kb = q / 8;
          transpose_item(F.pool_w + (size_t)g * 65536, 256, 256, (bf16_t*)(F.ws + WS_POOLW) + (size_t)g * 65536, 256, nb * 32, kb * 64, scr, F.lane, ident); }
    }
    {
        bf16_t* kb = (bf16_t*)(F.ws + WS_KEYSBD);
        for (int i = F.bid * 512 + F.tid; i < 2048 * 32; i += F.G * 512) {
            const int row = i / 32, k8 = (i % 32) * 8, p = (row >> 7) & 1;
            u32x4 o = (u32x4){0u, 0u, 0u, 0u};
            if ((k8 >> 7) == p) { const float* s = F.peer_keys + (size_t)row * 128 + (k8 & 127); const f32x4 a = *(const f32x4*)s, b = *(const f32x4*)(s + 4); o = pack8(a, b); }
            *(u32x4*)(kb + (size_t)row * 256 + k8) = o;
        }
    }
    {
        unsigned char* pu = F.ws + WS_PU;
        for (size_t i = (size_t)F.bid * 512 + F.tid; i < (size_t)NEXP * 64; i += (size_t)F.G * 512) {
            const float* src = F.peer_u + i * 32;
            u32x16 pk;
#pragma unroll
            for (int k = 0; k < 8; ++k) { const f32x4 a = *(const f32x4*)(src + k * 4) * 96.0f; pk[2 * k] = cvt_pk_bf16(a[0], a[1]); pk[2 * k + 1] = cvt_pk_bf16(a[2], a[3]); }
            const u32x6 p6 = __builtin_amdgcn_cvt_scalef32_pk32_fp6_bf16(__builtin_bit_cast(bf16x32, pk), 1.0f);
            unsigned char* dst = pu + i * 24;
            *(u32x2*)dst = (u32x2){p6[0], p6[1]}; *(u32x2*)(dst + 8) = (u32x2){p6[2], p6[3]}; *(u32x2*)(dst + 16) = (u32x2){p6[4], p6[5]};
        }
        unsigned char* pv = F.ws + WS_PV;
        for (int it = gw; it < (NEXP / 64) * 128; it += NGW) {
            const int e = (it >> 7) * 64 + F.lane, ch = it & 127;
            u32x4 ov;
#pragma unroll
            for (int k = 0; k < 4; ++k) { const f32x4 c = *(const f32x4*)(F.peer_v + (size_t)e * DM + ch * 16 + k * 4) * 4.0f;
                int wv = __builtin_amdgcn_cvt_pk_fp8_f32(c[0], c[1], 0, false); wv = __builtin_amdgcn_cvt_pk_fp8_f32(c[2], c[3], wv, true); ov[k] = (unsigned)wv; }
            *(u32x2*)(pv + ((size_t)(2 * ch) * NEXP + e) * 8) = (u32x2){ov[0], ov[1]};
            *(u32x2*)(pv + ((size_t)(2 * ch + 1) * NEXP + e) * 8) = (u32x2){ov[2], ov[3]};
        }
    }
    {
        __syncthreads();
        float* cact = (float*)(F.lds + 131072);
        float* red = (float*)F.lds;
        float* mp = (float*)(F.ws + WS_MODP);
        for (int it = F.bid; it < 48 * 4; it += F.G) {
            const int cb = it % 48, ds = it / 48, d0 = ds * 512;
            for (int i = F.tid; i < 8 * 512; i += 512) { const int b = i >> 9, d = i & 511; const float cv = F.c[b * DM + d0 + d]; cact[i] = cv * sigmoidf_(cv); }
            __syncthreads();
            f32x4 a[8];
#pragma unroll
            for (int b = 0; b < 8; ++b) a[b] = (f32x4){0.f, 0.f, 0.f, 0.f};
            const float* wp = F.w_ada + (size_t)(d0 + F.wave * 64) * 12288 + cb * 256 + F.lane * 4;
#pragma unroll 4
            for (int d = 0; d < 64; ++d) { const f32x4 w = *(const f32x4*)(wp + (size_t)d * 12288);
#pragma unroll
                for (int b = 0; b < 8; ++b) a[b] += w * cact[b * 512 + F.wave * 64 + d]; }
#pragma unroll
            for (int b = 0; b < 8; ++b)
#pragma unroll
                for (int j = 0; j < 4; ++j) red[(F.wave * 32 + b * 4 + j) * 64 + F.lane] = a[b][j];
            __syncthreads();
            for (int i = F.tid; i < 2048; i += 512) { const int v = i >> 6, l = i & 63; float s = 0.f;
#pragma unroll
                for (int w = 0; w < 8; ++w) s += red[(w * 32 + v) * 64 + l];
                mp[((size_t)ds * 8 + (v >> 2)) * 12288 + cb * 256 + l * 4 + (v & 3)] = s; }
            __syncthreads();
        }
    }
}

template <bool FIRST> __device__ __forceinline__ void phase_modnorm(Frame& F, const float* xin, const float* gain, int off_sh, int off_sc, bf16_t* dst) {
    const float* mp = (const float*)(F.ws + WS_MODP); float* mf = (float*)(F.ws + WS_MODF);
    if (FIRST) {
        for (int i = F.bid * 512 + F.tid; i < 8 * 12288; i += F.G * 512) {
            float s = F.b_ada[i % 12288];
#pragma unroll
            for (int k = 0; k < 4; ++k) s += mp[(size_t)k * 8 * 12288 + i];
            mf[i] = s; }
    }
    float* cA = (float*)F.lds; float* cB = cA + 2048;
    for (int ch = F.bid; ch < MTOK / 128; ch += F.G) {
        const int b = ch / 32;
        __syncthreads();
        for (int col = F.tid; col < 2048; col += 512) {
            float sc, sh;
            if (FIRST) { sc = F.b_ada[off_sc + col]; sh = F.b_ada[off_sh + col];
#pragma unroll
                for (int k = 0; k < 4; ++k) { sc += mp[((size_t)k * 8 + b) * 12288 + off_sc + col]; sh += mp[((size_t)k * 8 + b) * 12288 + off_sh + col]; } }
            else { sc = mf[b * 12288 + off_sc + col]; sh = mf[b * 12288 + off_sh + col]; }
            cA[col] = gain[col] * (1.f + sc); cB[col] = sh; }
        __syncthreads();
        for (int r = F.wave; r < 128; r += 8) {
            const size_t row = (size_t)ch * 128 + r;
            const float* xr = xin + row * 2048 + F.lane * 8;
            f32x4 v[4][2]; float ss = 0.f;
#pragma unroll
            for (int i = 0; i < 4; ++i) { v[i][0] = *(const f32x4*)(xr + i * 512); v[i][1] = *(const f32x4*)(xr + i * 512 + 4);
#pragma unroll
                for (int j = 0; j < 4; ++j) ss += v[i][0][j] * v[i][0][j] + v[i][1][j] * v[i][1][j]; }
            ss = wave_sum(ss);
            const float rinv = 1.0f / sqrtf(ss * (1.0f / 2048.0f) + EPS);
#pragma unroll
            for (int i = 0; i < 4; ++i) { const int col = i * 512 + F.lane * 8;
                const f32x4 a0 = *(const f32x4*)(cA + col), a1 = *(const f32x4*)(cA + col + 4), b0 = *(const f32x4*)(cB + col), b1 = *(const f32x4*)(cB + col + 4);
                *(u32x4*)(dst + row * 2048 + col) = pack8(v[i][0] * rinv * a0 + b0, v[i][1] * rinv * a1 + b1); }
        }
    }
}

__device__ __forceinline__ u32x2 pack8_fp8(f32x4 a, f32x4 b) {
    int w0 = __builtin_amdgcn_cvt_pk_fp8_f32(a[0], a[1], 0, false); w0 = __builtin_amdgcn_cvt_pk_fp8_f32(a[2], a[3], w0, true);
    int w1 = __builtin_amdgcn_cvt_pk_fp8_f32(b[0], b[1], 0, false); w1 = __builtin_amdgcn_cvt_pk_fp8_f32(b[2], b[3], w1, true);
    return (u32x2){(unsigned)w0, (unsigned)w1};
}
__device__ __forceinline__ void phase3_qknorm(Frame& F) {
    const bf16_t* q = (const bf16_t*)(F.ws + WS_QN); const bf16_t* k = (const bf16_t*)(F.ws + WS_KN); const bf16_t* v = (const bf16_t*)(F.ws + WS_V);
    unsigned char* q8 = F.ws + WS_Q8; unsigned char* k8 = F.ws + WS_K8; unsigned char* v8 = F.ws + WS_V8;
    const int gw = F.bid * 8 + F.wave, NGW = F.G * 8;
    for (int row = gw; row < MTOK; row += NGW) {
#pragma unroll
        for (int i = 0; i < 2; ++i) { const int ci = i * 64 + F.lane;
            f32x4 a, b; unpack8(*(const u32x4*)(q + (size_t)row * 1024 + ci * 8), a, b);
            float ss = a[0] * a[0] + a[1] * a[1] + a[2] * a[2] + a[3] * a[3] + b[0] * b[0] + b[1] * b[1] + b[2] * b[2] + b[3] * b[3];
            ss = row_sum16(ss);
            const float rinv = 1.0f / sqrtf(ss * (1.0f / 128.0f) + EPS);
            const float* gp = F.g_q + (ci & 15) * 8; const f32x4 g0 = *(const f32x4*)gp, g1 = *(const f32x4*)(gp + 4);
            *(u32x2*)(q8 + (size_t)row * 1024 + ci * 8) = pack8_fp8(a * rinv * g0, b * rinv * g1); }
        { const int ci = F.lane & 31; const bool isk = F.lane < 32;
            f32x4 a, b; unpack8(*(const u32x4*)((isk ? k : v) + (size_t)row * 256 + ci * 8), a, b);
            float ss = a[0] * a[0] + a[1] * a[1] + a[2] * a[2] + a[3] * a[3] + b[0] * b[0] + b[1] * b[1] + b[2] * b[2] + b[3] * b[3];
            ss = row_sum16(ss);
            const float rinv = isk ? 1.0f / sqrtf(ss * (1.0f / 128.0f) + EPS) : 1.0f;
            const float* gp = F.g_k + (ci & 15) * 8; f32x4 g0 = *(const f32x4*)gp, g1 = *(const f32x4*)(gp + 4);
            if (!isk) { g0 = (f32x4){1.f, 1.f, 1.f, 1.f}; g1 = g0; }
            *(u32x2*)((isk ? k8 : v8) + (size_t)row * 256 + ci * 8) = pack8_fp8(a * rinv * g0, b * rinv * g1); }
    }
}
template <int W> __device__ __forceinline__ void pooled_item(const bf16_t* pl, bf16_t* po, int row, int c8) {
    const int t = row & (SEQ - 1);
    f32x4 s0 = (f32x4){0.f, 0.f, 0.f, 0.f}, s1 = s0, x0 = s0, x1 = s0;
    u32x4 v[W];
#pragma unroll
    for (int j = 0; j < W; ++j) v[j] = *(const u32x4*)(pl + (size_t)(row - (j <= t ? j : 0)) * 1024 + c8);
#pragma unroll
    for (int j = 0; j < W; ++j) { f32x4 a, b; unpack8(v[j], a, b); if (j == 0) { x0 = a; x1 = b; } if (j <= t) { s0 += a; s1 += b; } }
    const float inv = 1.0f / (float)((t + 1 < W) ? t + 1 : W);
    *(u32x4*)(po + (size_t)row * 1024 + c8) = pack8(s0 * inv - x0, s1 * inv - x1);
}
__device__ __forceinline__ void phase3_pooled(Frame& F) {
    const bf16_t* pl = (const bf16_t*)(F.ws + WS_PL); bf16_t* po = (bf16_t*)(F.ws + WS_POOLED);
    const int gw = F.bid * 8 + F.wave, NGW = F.G * 8;
    for (int it = gw; it < (MTOK / 2) * 4; it += NGW) {
        const int g = it & 3, row = (it >> 2) * 2 + (F.lane >> 5), c8 = g * 256 + (F.lane & 31) * 8;
        if (g == 0) pooled_item<2>(pl, po, row, c8); else if (g == 1) pooled_item<4>(pl, po, row, c8); else if (g == 2) pooled_item<8>(pl, po, row, c8); else pooled_item<16>(pl, po, row, c8);
    }
}
typedef float f32x16 __attribute__((ext_vector_type(16)));
__device__ __forceinline__ int sel_code(float s, float smin, float scale) { const float c = (s - smin) * scale; return (int)fminf(fmaxf(c, 0.f), 65535.f); }
__device__ __forceinline__ void hist_find(const unsigned* hist, int lane, int K, int& bsel, int& above) {
    const u32x4 h = *(const u32x4*)(hist + lane * 4);
    const int S = (int)(h.x + h.y + h.z + h.w);
    int x = S;
    x += __builtin_amdgcn_update_dpp(0, x, 0x101, 0xF, 0xF, true);
    x += __builtin_amdgcn_update_dpp(0, x, 0x102, 0xF, 0xF, true);
    x += __builtin_amdgcn_update_dpp(0, x, 0x104, 0xF, 0xF, true);
    x += __builtin_amdgcn_update_dpp(0, x, 0x108, 0xF, 0xF, true);
    const int t1 = __builtin_amdgcn_readlane(x, 16), t2 = __builtin_amdgcn_readlane(x, 32), t3 = __builtin_amdgcn_readlane(x, 48);
    const int r = lane >> 4;
    x += (r == 0 ? t1 + t2 + t3 : (r == 1 ? t2 + t3 : (r == 2 ? t3 : 0)));
    const int sufn = x - S;
    const bool mine = (x >= K) && (sufn < K);
    int b = 0, ab = 0;
    { int c = sufn;
      if (c + (int)h.w >= K) { b = 3; ab = c; } else { c += (int)h.w;
      if (c + (int)h.z >= K) { b = 2; ab = c; } else { c += (int)h.z;
      if (c + (int)h.y >= K) { b = 1; ab = c; } else { c += (int)h.y; b = 0; ab = c; } } } }
    const unsigned long long m = __ballot(mine);
    const int src = m ? (int)__builtin_ctzll(m) : 0;
    bsel = __builtin_amdgcn_readlane(lane * 4 + b, src); above = __builtin_amdgcn_readlane(ab, src);
}
__device__ __forceinline__ void indexer_select(Frame& F, int b, int t, const float* rowbuf, unsigned* hist, float* eqv, int* eqi) {
    unsigned short* selrow = (unsigned short*)(F.ws + WS_SEL) + (size_t)(b * SEQ + t) * 256;
    int lane = F.lane; asm volatile("" : "+v"(lane));
    const int nch = t / 64 + 1, n4 = (nch + 3) >> 2;
    const f32x4* rb4 = (const f32x4*)rowbuf;
    float mn = __builtin_huge_valf(), mx = -__builtin_huge_valf();
    for (int c4 = 0; c4 < n4; ++c4) { const f32x4 v = rb4[c4 * 64 + lane];
#pragma unroll
        for (int k = 0; k < 4; ++k) { const bool valid = ((c4 * 4 + k) * 64 + lane) <= t; mn = valid ? fminf(mn, v[k]) : mn; mx = valid ? fmaxf(mx, v[k]) : mx; } }
    mx = xor16_max(row_max16(mx)); { const auto r = __builtin_amdgcn_permlane32_swap(__float_as_uint(mx), __float_as_uint(mx), false, false); mx = fmaxf(__uint_as_float(r[0]), __uint_as_float(r[1])); }
    mn = -mn; mn = xor16_max(row_max16(mn)); { const auto r = __builtin_amdgcn_permlane32_swap(__float_as_uint(mn), __float_as_uint(mn), false, false); mn = -fmaxf(__uint_as_float(r[0]), __uint_as_float(r[1])); }
    const float scale = (mx > mn) ? 65535.0f / (mx - mn) : 0.f;
    *(u32x4*)(hist + lane * 4) = (u32x4){0u, 0u, 0u, 0u};
    for (int c4 = 0; c4 < n4; ++c4) { const f32x4 v = rb4[c4 * 64 + lane];
#pragma unroll
        for (int k = 0; k < 4; ++k) { const bool valid = ((c4 * 4 + k) * 64 + lane) <= t; if (valid) atomicAdd(&hist[sel_code(v[k], mn, scale) >> 8], 1u); } }
    int b1, above1; hist_find(hist, lane, KSEL, b1, above1);
    *(u32x4*)(hist + lane * 4) = (u32x4){0u, 0u, 0u, 0u};
    for (int c4 = 0; c4 < n4; ++c4) { const f32x4 v = rb4[c4 * 64 + lane];
#pragma unroll
        for (int k = 0; k < 4; ++k) { const bool valid = ((c4 * 4 + k) * 64 + lane) <= t; const int code = sel_code(v[k], mn, scale); if (valid && (code >> 8) == b1) atomicAdd(&hist[code & 255], 1u); } }
    int b2, above2; hist_find(hist, lane, KSEL - above1, b2, above2);
    const int T16 = (b1 << 8) | b2, need = KSEL - above1 - above2, ceq = (int)hist[b2];
    const unsigned long long lt_mask = (1ull << lane) - 1ull;
    const bool exact = (ceq != need) && (ceq <= 64);
    if (exact) {
        int pos = 0;
        for (int c = 0; c < nch; ++c) { const float sv = rowbuf[((c >> 2) * 64 + lane) * 4 + (c & 3)]; const int idx = c * 64 + lane;
            const bool eq = (idx <= t) && (sel_code(sv, mn, scale) == T16);
            const unsigned long long m = __ballot(eq);
            if (m) { const int p = pos + __popcll(m & lt_mask); if (eq) { eqv[p] = sv; eqi[p] = idx; } pos += __popcll(m); } }
    }
    int pos = 0, eqseen = 0;
    for (int c = 0; c < nch; ++c) {
        const float sv = rowbuf[((c >> 2) * 64 + lane) * 4 + (c & 3)]; const int idx = c * 64 + lane;
        const int code = sel_code(sv, mn, scale); const bool valid = idx <= t;
        const bool gt = valid && code > T16, eq = valid && code == T16;
        const unsigned long long meq = __ballot(eq);
        bool take = gt;
        if (meq) {
            if (ceq == need) take = take || eq;
            else if (exact) { int rank = 0; for (int m = 0; m < ceq; ++m) { const float ov = eqv[m]; const int oi = eqi[m]; rank += (ov > sv || (ov == sv && oi < idx)) ? 1 : 0; } take = take || (eq && rank < need); }
            else { const int er = eqseen + __popcll(meq & lt_mask); take = take || (eq && er < need); eqseen += __popcll(meq); }
        }
        const unsigned long long mt = __ballot(take);
        const int p = pos + __popcll(mt & lt_mask);
        if (take && p < KSEL) selrow[p] = (unsigned short)idx;
        pos += __popcll(mt);
    }
}
__device__ __forceinline__ void indexer_tile(Frame& F, int b, int t0) {
    const bf16_t* iq = (const bf16_t*)(F.ws + WS_IQ); const bf16_t* ik = (const bf16_t*)(F.ws + WS_IK); const float* iw = (const float*)(F.ws + WS_IW);
    int lane = F.lane; asm volatile("" : "+v"(lane));
    const int w = F.wave;
    if (t0 < KSEL) {
        const int t = t0 + w; unsigned short* selrow = (unsigned short*)(F.ws + WS_SEL) + (size_t)(b * SEQ + t) * 256;
#pragma unroll
        for (int p = 0; p < 4; ++p) { const int j = p * 64 + lane; selrow[j] = (unsigned short)(j <= t ? j : 0xFFFF); }
        return;
    }
    float* rowbuf = (float*)F.lds;
    unsigned char* stage = F.lds + 131072;
    const int p = w & 3, kh = w >> 2, hi = lane >> 5, r = lane & 31;
    const size_t qrow = (size_t)b * SEQ + t0 + 2 * p + (r >> 4);
    bf16x8 a[4];
#pragma unroll
    for (int ks = 0; ks < 4; ++ks) a[ks] = *(const bf16x8*)(iq + qrow * 1024 + (r & 15) * 64 + ks * 16 + 8 * hi);
    float wq[2][8];
#pragma unroll
    for (int q = 0; q < 2; ++q)
#pragma unroll
        for (int i = 0; i < 8; ++i) wq[q][i] = iw[((size_t)b * SEQ + t0 + 2 * p + q) * 16 + (i & 3) + 8 * ((i >> 2) & 1) + 4 * hi];
    const int nchunks = (t0 + 7) / 64 + 1;
    const unsigned char* gsrc = (const unsigned char*)(ik + (size_t)b * SEQ * 64) + F.tid * 16;
    const int skey = F.tid >> 3, sc16 = F.tid & 7, soff = skey * 128 + ((sc16 ^ (skey & 7)) << 4);
    u32x4 s0 = *(const u32x4*)gsrc, s1 = s0, s2 = s0, s3 = s0;
    if (1 < nchunks) s1 = *(const u32x4*)(gsrc + (size_t)1 * 8192);
    if (2 < nchunks) s2 = *(const u32x4*)(gsrc + (size_t)2 * 8192);
    if (3 < nchunks) s3 = *(const u32x4*)(gsrc + (size_t)3 * 8192);
    __syncthreads();
#define IDX_STEP(SR, cc) do { const int c = (cc); unsigned char* sb = stage + (c & 1) * 8192; \
        *(u32x4*)(sb + soff) = SR; \
        __syncthreads(); \
        if (c + 4 < nchunks) SR = *(const u32x4*)(gsrc + (size_t)(c + 4) * 8192); \
        f32x16 d; _Pragma("unroll") for (int i = 0; i < 16; ++i) d[i] = 0.f; \
        const int key = kh * 32 + r; \
        _Pragma("unroll") for (int ks = 0; ks < 4; ++ks) { const bf16x8 bf = *(const bf16x8*)(sb + key * 128 + (((ks * 2 + hi) ^ (key & 7)) << 4)); \
            d = __builtin_amdgcn_mfma_f32_32x32x16_bf16(a[ks], bf, d, 0, 0, 0); } \
        float s0_ = 0.f, s1_ = 0.f; \
        _Pragma("unroll") for (int i = 0; i < 8; ++i) { s0_ += wq[0][i] * fmaxf(d[i], 0.f); s1_ += wq[1][i] * fmaxf(d[8 + i], 0.f); } \
        const float sc = swap32_pair(s0_, s1_); \
        rowbuf[(2 * p + hi) * 4096 + ((c >> 2) * 64 + key) * 4 + (c & 3)] = sc; } while (0)
    for (int c4 = 0; c4 < nchunks; c4 += 4) {
        IDX_STEP(s0, c4);
        if (c4 + 1 < nchunks) IDX_STEP(s1, c4 + 1);
        if (c4 + 2 < nchunks) IDX_STEP(s2, c4 + 2);
        if (c4 + 3 < nchunks) IDX_STEP(s3, c4 + 3);
    }
#if PROBE_IDX == 1
    __syncthreads(); s0 = *(const u32x4*)gsrc; s1 = s0; s2 = s0; s3 = s0;
    if (1 < nchunks) s1 = *(const u32x4*)(gsrc + (size_t)1 * 8192);
    if (2 < nchunks) s2 = *(const u32x4*)(gsrc + (size_t)2 * 8192);
    if (3 < nchunks) s3 = *(const u32x4*)(gsrc + (size_t)3 * 8192);
    for (int c4 = 0; c4 < nchunks; c4 += 4) {
        IDX_STEP(s0, c4);
        if (c4 + 1 < nchunks) IDX_STEP(s1, c4 + 1);
        if (c4 + 2 < nchunks) IDX_STEP(s2, c4 + 2);
        if (c4 + 3 < nchunks) IDX_STEP(s3, c4 + 3);
    }
#endif
#undef IDX_STEP
    __syncthreads();
    indexer_select(F, b, t0 + w, rowbuf + w * 4096, (unsigned*)(F.lds + 147456) + w * 256, (float*)(F.lds + 155648) + w * 64, (int*)(F.lds + 155648 + 2048) + w * 64);
#if PROBE_IDX == 2
    indexer_select(F, b, t0 + w, rowbuf + w * 4096, (unsigned*)(F.lds + 147456) + w * 256, (float*)(F.lds + 155648) + w * 64, (int*)(F.lds + 155648 + 2048) + w * 64);
#endif
}
__device__ __forceinline__ void phase3_indexer(Frame& F) {
    const int nit = BATCH * (SEQ / 8);
    for (int k = 0;; ++k) {
        const int l = k * F.G + ((k & 1) ? (F.G - 1 - F.bid) : F.bid);
        if (l >= nit) { if (k * F.G >= nit) break; else continue; }
        const int qb = (SEQ / 8 - 1) - (l >> 3), b = l & 7;
        indexer_tile(F, b, qb * 8);
    }
}

__device__ const unsigned char g_bucket[128] = {0, 1, 2, 3, 4, 5, 6, 7, 8, 9, 10, 11, 12, 13, 14, 15, 16, 16, 16, 17, 17, 18, 18, 18, 19, 19, 19, 20, 20, 20, 20, 21, 21, 21, 21, 22, 22, 22, 22, 22, 23, 23, 23, 23, 23, 23, 24, 24, 24, 24, 24, 24, 25, 25, 25, 25, 25, 25, 25, 26, 26, 26, 26, 26, 26, 26, 26, 27, 27, 27, 27, 27, 27, 27, 27, 27, 27, 28, 28, 28, 28, 28, 28, 28, 28, 28, 28, 29, 29, 29, 29, 29, 29, 29, 29, 29, 29, 29, 29, 30, 30, 30, 30, 30, 30, 30, 30, 30, 30, 30, 30, 30, 30, 31, 31, 31, 31, 31, 31, 31, 31, 31, 31, 31, 31, 31, 31, 31};
__device__ __forceinline__ void phase4_attention(Frame& F) {
    const unsigned char* q8 = F.ws + WS_Q8; const unsigned char* k8 = F.ws + WS_K8; const unsigned char* v8 = F.ws + WS_V8;
    const unsigned short* sel = (const unsigned short*)(F.ws + WS_SEL); bf16_t* ao = (bf16_t*)(F.ws + WS_ATTN);
    float* btab = (float*)F.lds;
    __syncthreads();
    for (int i = F.tid; i < 256; i += 512) btab[i] = F.rel_bias[i];
    __syncthreads();
    float* Pl = (float*)(F.lds + 4096 + F.wave * 12288); int* idl = (int*)(Pl + 2048); float* psl = (float*)(idl + 256);
    const bool xmap = (F.G % 8) == 0;
    const int gw = xmap ? (F.bid / 8) * 8 + F.wave : F.bid * 8 + F.wave, NGW = xmap ? F.G : F.G * 8, nrows = xmap ? SEQ : MTOK;
    for (int rr = gw; rr < nrows; rr += NGW) {
        int lane = F.lane; asm volatile("" : "+v"(lane));
        const int row = xmap ? (F.bid & 7) * SEQ + rr : rr;
        const int b = row / SEQ, t = row % SEQ, r = lane & 31, hi = lane >> 5;
#pragma unroll
        for (int p = 0; p < 4; ++p) { idl[p * 64 + lane] = (int)sel[(size_t)row * 256 + p * 64 + lane]; }
        long a0[8], a1[8];
        { u32x4 qa[4];
#pragma unroll
          for (int i = 0; i < 4; ++i) qa[i] = (r < 8) ? *(const u32x4*)(q8 + (size_t)row * 1024 + r * 128 + hi * 64 + i * 16) : (u32x4){0u, 0u, 0u, 0u};
#pragma unroll
          for (int ks = 0; ks < 8; ++ks) { const unsigned lo = qa[ks >> 1][(ks & 1) * 2], hh = qa[ks >> 1][(ks & 1) * 2 + 1]; const long v = (long)(((unsigned long long)hh << 32) | lo);
              a0[ks] = (r < 4) ? v : 0l; a1[ks] = (r >= 4) ? v : 0l; } }
        f32x4 psum = (f32x4){0.f, 0.f, 0.f, 0.f};
#define AT_LOADK(buf, kb) do { const int key_ = idl[(kb) * 32 + r]; const int kc_ = key_ <= t ? key_ : 0; const unsigned char* kr_ = k8 + ((size_t)b * SEQ + kc_) * 256 + hi * 64; \
            _Pragma("unroll") for (int i = 0; i < 4; ++i) { buf[i] = *(const u32x4*)(kr_ + i * 16); buf[4 + i] = *(const u32x4*)(kr_ + 128 + i * 16); } } while (0)
#define AT_QK(buf, kb) do { const int key_ = idl[(kb) * 32 + r]; const bool valid_ = key_ <= t; const int kc_ = valid_ ? key_ : 0; \
            f32x16 d; _Pragma("unroll") for (int i = 0; i < 16; ++i) d[i] = 0.f; \
            _Pragma("unroll") for (int ks = 0; ks < 8; ++ks) { const long bv_ = (long)(((unsigned long long)buf[ks >> 1][(ks & 1) * 2 + 1] << 32) | buf[ks >> 1][(ks & 1) * 2]); d = __builtin_amdgcn_mfma_f32_32x32x16_fp8_fp8(a0[ks], bv_, d, 0, 0, 0); } \
            _Pragma("unroll") for (int ks = 0; ks < 8; ++ks) { const long bv_ = (long)(((unsigned long long)buf[4 + (ks >> 1)][(ks & 1) * 2 + 1] << 32) | buf[4 + (ks >> 1)][(ks & 1) * 2]); d = __builtin_amdgcn_mfma_f32_32x32x16_fp8_fp8(a1[ks], bv_, d, 0, 0, 0); } \
            const int dist_ = t - kc_; const int bkt_ = dist_ < 128 ? (int)g_bucket[dist_] : 31; \
            const f32x4 bias_ = *(const f32x4*)(btab + bkt_ * 8 + 4 * hi); f32x4 e_; \
            _Pragma("unroll") for (int i = 0; i < 4; ++i) e_[i] = valid_ ? __expf(d[i] * 0.08838834764831845f + bias_[i]) : 0.f; \
            psum += e_; *(f32x4*)(Pl + ((kb) * 32 + r) * 8 + 4 * hi) = e_; } while (0)
        {
            u32x4 kA[8], kB[8];
            AT_LOADK(kA, 0);
#pragma unroll 1
            for (int kb = 0; kb < 8; kb += 2) {
                AT_LOADK(kB, kb + 1);
                AT_QK(kA, kb);
                if (kb + 2 < 8) AT_LOADK(kA, kb + 2);
                AT_QK(kB, kb + 1);
            }
        }
#undef AT_LOADK
#undef AT_QK
#pragma unroll
        for (int i = 0; i < 4; ++i) psum[i] = xor16_sum(row_sum16(psum[i]));
        if (r == 0) *(f32x4*)(psl + 4 * hi) = psum;
        const int ks = lane >> 4, g = (lane >> 3) & 1, dc = lane & 7;
        float acc[4][16];
#pragma unroll
        for (int h = 0; h < 4; ++h)
#pragma unroll
            for (int j = 0; j < 16; ++j) acc[h][j] = 0.f;
#define AT_LOADV(buf, it0) do { _Pragma("unroll") for (int u = 0; u < 4; ++u) { const int key_ = idl[((it0) + u) * 4 + ks]; const int kc_ = key_ <= t ? key_ : 0; \
            buf[u] = *(const u32x4*)(v8 + ((size_t)b * SEQ + kc_) * 256 + g * 128 + dc * 16); } } while (0)
#define AT_PV(buf, it0) do { _Pragma("unroll") for (int u = 0; u < 4; ++u) { const int j_ = ((it0) + u) * 4 + ks; const u32x4 w = buf[u]; \
            const f32x4 p = *(const f32x4*)(Pl + j_ * 8 + 4 * g); \
            _Pragma("unroll") for (int dd = 0; dd < 4; ++dd) { const f32x2 lo = __builtin_amdgcn_cvt_pk_f32_fp8((int)w[dd], false), hh_ = __builtin_amdgcn_cvt_pk_f32_fp8((int)w[dd], true); \
                _Pragma("unroll") for (int h = 0; h < 4; ++h) { acc[h][4 * dd] += p[h] * lo.x; acc[h][4 * dd + 1] += p[h] * lo.y; acc[h][4 * dd + 2] += p[h] * hh_.x; acc[h][4 * dd + 3] += p[h] * hh_.y; } } } } while (0)
        {
            u32x4 vA[4], vB[4];
            AT_LOADV(vA, 0);
#pragma unroll 1
            for (int it0 = 0; it0 < 64; it0 += 8) {
                AT_LOADV(vB, it0 + 4);
                AT_PV(vA, it0);
                if (it0 + 8 < 64) AT_LOADV(vA, it0 + 8);
                AT_PV(vB, it0 + 4);
            }
        }
#undef AT_LOADV
#undef AT_PV
#pragma unroll
        for (int h = 0; h < 4; ++h)
#pragma unroll
            for (int j = 0; j < 16; ++j) acc[h][j] = xor32_sum(xor16_sum(acc[h][j]));
#pragma unroll
        for (int h = 0; h < 4; ++h) if (h == ks) { const float inv = 1.0f / psl[4 * g + h];
            bf16_t* op = ao + (size_t)row * 1024 + (4 * g + h) * 128 + dc * 16;
            *(u32x4*)op = pack8((f32x4){acc[h][0], acc[h][1], acc[h][2], acc[h][3]} * inv, (f32x4){acc[h][4], acc[h][5], acc[h][6], acc[h][7]} * inv);
            *(u32x4*)(op + 8) = pack8((f32x4){acc[h][8], acc[h][9], acc[h][10], acc[h][11]} * inv, (f32x4){acc[h][12], acc[h][13], acc[h][14], acc[h][15]} * inv); }
    }
}

__device__ __forceinline__ float dot16f8(u32x4 w, const float* h) {
    float s = 0.f;
#pragma unroll
    for (int d = 0; d < 4; ++d) { const f32x2 lo = __builtin_amdgcn_cvt_pk_f32_fp8((int)w[d], false), hi = __builtin_amdgcn_cvt_pk_f32_fp8((int)w[d], true);
        s += lo.x * h[4 * d] + lo.y * h[4 * d + 1] + hi.x * h[4 * d + 2] + hi.y * h[4 * d + 3]; }
    return s;
}
__device__ __forceinline__ void fma16f8(u32x4 w, float cf, float* acc) {
#pragma unroll
    for (int d = 0; d < 4; ++d) { const f32x2 lo = __builtin_amdgcn_cvt_pk_f32_fp8((int)w[d], false), hi = __builtin_amdgcn_cvt_pk_f32_fp8((int)w[d], true);
        acc[4 * d] += cf * lo.x; acc[4 * d + 1] += cf * lo.y; acc[4 * d + 2] += cf * hi.x; acc[4 * d + 3] += cf * hi.y; }
}
__device__ __forceinline__ float gelu_erf(float x) { return 0.5f * x * (1.0f + erff(x * 0.70710678118654752f)); }
__device__ __forceinline__ void hfind2(const unsigned* hist, int lane, int K, int& bsel, int& above) {
    const int half = lane >> 5, lh = lane & 31;
    const u32x4 h0 = *(const u32x4*)(hist + half * 256 + lh * 8), h1 = *(const u32x4*)(hist + half * 256 + lh * 8 + 4);
    const int S = (int)(h0.x + h0.y + h0.z + h0.w + h1.x + h1.y + h1.z + h1.w);
    int x = S;
    x += __builtin_amdgcn_update_dpp(0, x, 0x101, 0xF, 0xF, true); x += __builtin_amdgcn_update_dpp(0, x, 0x102, 0xF, 0xF, true);
    x += __builtin_amdgcn_update_dpp(0, x, 0x104, 0xF, 0xF, true); x += __builtin_amdgcn_update_dpp(0, x, 0x108, 0xF, 0xF, true);
    const int t1 = __builtin_amdgcn_readlane(x, 16), t3 = __builtin_amdgcn_readlane(x, 48);
    if ((lane & 16) == 0) x += half ? t3 : t1;
    const int sufn = x - S;
    const bool mine = (x >= K) && (sufn < K);
    int b = 0, ab = sufn, c = sufn; bool fnd = false;
#define HF_STEP(i, hv) { const int cv = c + (int)(hv); const bool hit = !fnd && (cv >= K); b = hit ? (i) : b; ab = hit ? c : ab; fnd = fnd || hit; c = cv; }
    HF_STEP(7, h1.w) HF_STEP(6, h1.z) HF_STEP(5, h1.y) HF_STEP(4, h1.x) HF_STEP(3, h0.w) HF_STEP(2, h0.z) HF_STEP(1, h0.y) HF_STEP(0, h0.x)
#undef HF_STEP
    const unsigned long long m = __ballot(mine);
    const unsigned mlo = (unsigned)m, mhi = (unsigned)(m >> 32);
    const int src0 = mlo ? __builtin_ctz(mlo) : 0, src1 = 32 + (mhi ? __builtin_ctz(mhi) : 0);
    const int bb = lh * 8 + b;
    const int r0b = __builtin_amdgcn_readlane(bb, src0), r0a = __builtin_amdgcn_readlane(ab, src0), r1b = __builtin_amdgcn_readlane(bb, src1), r1a = __builtin_amdgcn_readlane(ab, src1);
    bsel = half ? r1b : r0b; above = half ? r1a : r0a;
}
__device__ __forceinline__ void peer_select(const bf16_t* srow, int lane, int* elist, float* gl, float* scr, unsigned* hist2) {
    float* selv = scr; int* seli = (int*)(scr + 32); float* srtv = scr + 64; int* srti = (int*)(scr + 96);
    const unsigned long long lt_mask = (1ull << lane) - 1ull;
    const int half = lane >> 5, lh = lane & 31;
    const unsigned long long hmask = half ? 0xFFFFFFFF00000000ull : 0x00000000FFFFFFFFull;
    const float NINF = -__builtin_huge_valf();
#pragma unroll 1
    for (int h = 0; h < 8; ++h) {
        const u32x2 raw = *(const u32x2*)(srow + h * 256 + lane * 4);
        unsigned b[4] = {raw.x & 0xffffu, raw.x >> 16, raw.y & 0xffffu, raw.y >> 16}, k[4];
#pragma unroll
        for (int q = 0; q < 4; ++q) k[q] = (b[q] & 0x8000u) ? (b[q] ^ 0xFFFFu) : (b[q] | 0x8000u);
        *(u32x4*)(hist2 + lane * 8) = (u32x4){0u, 0u, 0u, 0u}; *(u32x4*)(hist2 + lane * 8 + 4) = (u32x4){0u, 0u, 0u, 0u};
#pragma unroll
        for (int q = 0; q < 4; ++q) atomicAdd(&hist2[half * 256 + (k[q] >> 8)], 1u);
        int b1, ab1; hfind2(hist2, lane, 16, b1, ab1);
        *(u32x4*)(hist2 + lane * 8) = (u32x4){0u, 0u, 0u, 0u}; *(u32x4*)(hist2 + lane * 8 + 4) = (u32x4){0u, 0u, 0u, 0u};
#pragma unroll
        for (int q = 0; q < 4; ++q) if ((int)(k[q] >> 8) == b1) atomicAdd(&hist2[half * 256 + (k[q] & 255u)], 1u);
        int b2, ab2; hfind2(hist2, lane, 16 - ab1, b2, ab2);
        const unsigned T = ((unsigned)b1 << 8) | (unsigned)b2;
        int ngt = 0, eqb = 0; unsigned long long me[4];
#pragma unroll
        for (int q = 0; q < 4; ++q) { const unsigned long long mg = __ballot(k[q] > T) & hmask; me[q] = __ballot(k[q] == T) & hmask; ngt += __popcll(mg); eqb += __popcll(me[q] & lt_mask); }
        const int need = 16 - ngt;
        bool sl[4]; int run = eqb;
#pragma unroll
        for (int q = 0; q < 4; ++q) { const bool eq = k[q] == T; sl[q] = (k[q] > T) || (eq && run < need); run += eq ? 1 : 0; }
        int pos = 0;
#pragma unroll
        for (int q = 0; q < 4; ++q) pos += __popcll(__ballot(sl[q]) & hmask & lt_mask);
#pragma unroll
        for (int q = 0; q < 4; ++q) { if (sl[q]) { selv[half * 16 + pos] = __uint_as_float(b[q] << 16); seli[half * 16 + pos] = 4 * lh + q; } pos += sl[q] ? 1 : 0; }
        const float v = selv[half * 16 + (lh & 15)]; const int ix = seli[half * 16 + (lh & 15)];
        int rank = 0;
#define PS_ROT(R) { const float vo = __int_as_float(__builtin_amdgcn_update_dpp(0, __float_as_int(v), 0x120 + (R), 0xF, 0xF, true)); const int io = __builtin_amdgcn_update_dpp(0, ix, 0x120 + (R), 0xF, 0xF, true); rank += (vo > v || (vo == v && io < ix)) ? 1 : 0; }
        PS_ROT(1) PS_ROT(2) PS_ROT(3) PS_ROT(4) PS_ROT(5) PS_ROT(6) PS_ROT(7) PS_ROT(8) PS_ROT(9) PS_ROT(10) PS_ROT(11) PS_ROT(12) PS_ROT(13) PS_ROT(14) PS_ROT(15)
#undef PS_ROT
        if (lh < 16) { srtv[half * 16 + rank] = v; srti[half * 16 + rank] = ix; }
        int ca, cb; const int c = lane;
        if (c < 16) { ca = 0; cb = c; } else if (c < 24) { ca = 1; cb = c - 16; } else if (c < 29) { ca = 2; cb = c - 24; } else if (c < 33) { ca = 3; cb = c - 29; }
        else if (c < 36) { ca = 4; cb = c - 33; } else if (c < 38) { ca = 5; cb = c - 36; } else if (c < 40) { ca = 6; cb = c - 38; } else if (c < 42) { ca = 7; cb = c - 40; }
        else { ca = (c - 42 + 8) & 15; cb = 0; }
        float s = srtv[ca] + srtv[16 + cb];
        const int eid = srti[ca] * 128 + srti[16 + cb];
        if (c >= 50) s = NINF;
        const unsigned sb_ = __float_as_uint(s), ok_ = sb_ ^ ((unsigned)((int)sb_ >> 31) | 0x80000000u);
        const unsigned key = (c < 50) ? ((ok_ & ~63u) | (unsigned)(63 - c)) : 0u;
        int rk = 0;
#pragma unroll
        for (int j = 0; j < 50; ++j) { const unsigned kj = (unsigned)__builtin_amdgcn_readlane((int)key, j); rk += (kj > key) ? 1 : 0; }
        const bool selq = (c < 50) && (rk < 16);
        const float smax = __shfl(s, 0);
        const float e = selq ? __expf(s - smax) : 0.f;
        const float esum = wave_sum(e);
        const unsigned long long ms = __ballot(selq);
        const int p = __popcll(ms & lt_mask);
        if (selq) { elist[h * 16 + p] = eid; gl[h * 16 + p] = e / esum; }
    }
}
typedef __bf16 bf2_t __attribute__((ext_vector_type(2)));
__device__ __forceinline__ float dot2_bf(unsigned a, unsigned b, float c) { return __builtin_amdgcn_fdot2_f32_bf16(__builtin_bit_cast(bf2_t, a), __builtin_bit_cast(bf2_t, b), c, false); }
__device__ __forceinline__ float dot32_f6b(u32x4 wa, u32x2 wb, u32x4 h0, u32x4 h1, u32x4 h2, u32x4 h3) {
    const bf16x32 dec = __builtin_amdgcn_cvt_scalef32_pk32_bf16_fp6((u32x6){wa.x, wa.y, wa.z, wa.w, wb.x, wb.y}, 1.0f);
    const u32x16 ud = __builtin_bit_cast(u32x16, dec);
    float acc = 0.f;
    acc = dot2_bf(ud.s0, h0.x, acc); acc = dot2_bf(ud.s1, h0.y, acc); acc = dot2_bf(ud.s2, h0.z, acc); acc = dot2_bf(ud.s3, h0.w, acc);
    acc = dot2_bf(ud.s4, h1.x, acc); acc = dot2_bf(ud.s5, h1.y, acc); acc = dot2_bf(ud.s6, h1.z, acc); acc = dot2_bf(ud.s7, h1.w, acc);
    acc = dot2_bf(ud.s8, h2.x, acc); acc = dot2_bf(ud.s9, h2.y, acc); acc = dot2_bf(ud.sa, h2.z, acc); acc = dot2_bf(ud.sb, h2.w, acc);
    acc = dot2_bf(ud.sc, h3.x, acc); acc = dot2_bf(ud.sd, h3.y, acc); acc = dot2_bf(ud.se, h3.z, acc); acc = dot2_bf(ud.sf, h3.w, acc);
    return acc;
}
__device__ __forceinline__ void phase10_peer(Frame& F) {
    const bf16_t* sub = (const bf16_t*)(F.ws + WS_SUB); const bf16_t* h2 = (const bf16_t*)(F.ws + WS_H2);
    const unsigned char* pu = F.ws + WS_PU; unsigned* pairs = (unsigned*)(F.ws + WS_PAIRS);
    const int gw = F.bid * 8 + F.wave, NGW = F.G * 8;
    unsigned char* wb = F.lds + F.wave * 17664;
    unsigned char* h2b = wb; unsigned short* gl16 = (unsigned short*)(wb + 16384); unsigned* hist = (unsigned*)(wb + 17408); unsigned* base = hist + 32;
    unsigned* tmp = (unsigned*)wb; int* elist = (int*)(wb + 2048); float* gl = (float*)(wb + 2560); float* sscr = (float*)(wb + 3072); bf16_t* srl = (bf16_t*)(wb + 4096);
    unsigned* wls = (unsigned*)(F.ws + WS_WLS) + (size_t)gw * 512;
    const int ntok = (MTOK - gw + NGW - 1) / NGW;
    for (int p0 = 0; p0 < ntok; p0 += 4) {
        int lane = F.lane; asm volatile("" : "+v"(lane));
        const int nt = (ntok - p0) < 4 ? (ntok - p0) : 4, ne = nt * 128;
        u32x4 nxt[4];
#pragma unroll
        for (int q = 0; q < 4; ++q) nxt[q] = *(const u32x4*)(sub + (size_t)(gw + p0 * NGW) * 2048 + lane * 32 + q * 8);
#pragma unroll 1
        for (int i = 0; i < nt; ++i) {
#pragma unroll
            for (int q = 0; q < 4; ++q) *(u32x4*)(srl + lane * 32 + q * 8) = nxt[q];
            if (i + 1 < nt) {
#pragma unroll
                for (int q = 0; q < 4; ++q) nxt[q] = *(const u32x4*)(sub + (size_t)(gw + (p0 + i + 1) * NGW) * 2048 + lane * 32 + q * 8); }
            peer_select(srl, lane, elist, gl, sscr, (unsigned*)(wb + 8192));
#if PROBE_SEL
            asm volatile("" : "+v"(lane)); peer_select(srl, lane, elist, gl, sscr, (unsigned*)(wb + 8192));
#endif
            tmp[i * 128 + lane] = ((unsigned)(i * 128 + lane) << 14) | (unsigned)elist[lane];
            tmp[i * 128 + 64 + lane] = ((unsigned)(i * 128 + 64 + lane) << 14) | (unsigned)elist[64 + lane];
            gl16[i * 128 + lane] = (unsigned short)(cvt_pk_bf16(gl[lane], 0.f) & 0xffffu); gl16[i * 128 + 64 + lane] = (unsigned short)(cvt_pk_bf16(gl[64 + lane], 0.f) & 0xffffu);
        }
        asm volatile("" : "+v"(lane));
        if (lane < 32) hist[lane] = 0u;
        unsigned ent[8]; unsigned rk[8];
#pragma unroll
        for (int q = 0; q < 8; ++q) { const int e = q * 64 + lane; ent[q] = (e < ne) ? tmp[e] : 0u; rk[q] = (e < ne) ? atomicAdd(&hist[(ent[q] & 0x3FFFu) >> 9], 1u) : 0u; }
        { int hv = lane < 32 ? (int)hist[lane] : 0; int x = hv;
          x += __builtin_amdgcn_update_dpp(0, x, 0x111, 0xF, 0xF, true); x += __builtin_amdgcn_update_dpp(0, x, 0x112, 0xF, 0xF, true);
          x += __builtin_amdgcn_update_dpp(0, x, 0x114, 0xF, 0xF, true); x += __builtin_amdgcn_update_dpp(0, x, 0x118, 0xF, 0xF, true);
          const int t0 = __builtin_amdgcn_readlane(x, 15); if (lane >= 16) x += t0;
          if (lane < 32) base[lane] = (unsigned)(x - hv); }
#pragma unroll
        for (int q = 0; q < 8; ++q) { const int e = q * 64 + lane; if (e < ne) wls[base[(ent[q] & 0x3FFFu) >> 9] + rk[q]] = ent[q]; }
#pragma unroll 1
        for (int i = 0; i < nt; ++i) { const bf16_t* hr = h2 + (size_t)(gw + (p0 + i) * NGW) * 2048 + lane * 32;
#pragma unroll
            for (int q = 0; q < 4; ++q) *(u32x4*)(h2b + i * 4096 + q * 1024 + lane * 16) = *(const u32x4*)(hr + q * 8); }
        asm volatile("s_waitcnt vmcnt(0)" ::: "memory");
        unsigned entn = __hip_atomic_load(wls + lane, __ATOMIC_RELAXED, __HIP_MEMORY_SCOPE_AGENT);
#pragma unroll 1
        for (int c = 0; c < ne; c += 64) {
            const unsigned ent64 = entn;
            if (c + 64 < ne) entn = __hip_atomic_load(wls + c + 64 + lane, __ATOMIC_RELAXED, __HIP_MEMORY_SCOPE_AGENT);
#pragma unroll 1
            for (int i0 = 0; i0 < 64; i0 += 8) {
                u32x4 wA[8]; u32x2 wB[8]; unsigned en[8];
#pragma unroll
                for (int jj = 0; jj < 8; ++jj) { en[jj] = (unsigned)__builtin_amdgcn_readlane((int)ent64, i0 + jj); const unsigned char* ur = pu + (size_t)(en[jj] & 0x3FFFu) * 1536 + lane * 24;
                    const u32x2 t0 = *(const u32x2*)ur, t1 = *(const u32x2*)(ur + 8); wA[jj] = (u32x4){t0.x, t0.y, t1.x, t1.y}; wB[jj] = *(const u32x2*)(ur + 16); }
                float pr[8];
#pragma unroll
                for (int jj = 0; jj < 8; ++jj) { const unsigned char* hp = h2b + (en[jj] >> 21) * 4096 + lane * 16;
                    pr[jj] = dot32_f6b(wA[jj], wB[jj], *(const u32x4*)hp, *(const u32x4*)(hp + 1024), *(const u32x4*)(hp + 2048), *(const u32x4*)(hp + 3072)); __builtin_amdgcn_sched_barrier(0); }
#pragma unroll
                for (int i = 0; i < 4; ++i) pr[i] = swap32_pair(pr[i], pr[i + 4]);
#pragma unroll
                for (int i = 0; i < 2; ++i) pr[i] = swap16_pair(pr[i], pr[i + 2]);
                const bool b3 = (lane & 8) != 0;
                { const float snd = b3 ? pr[0] : pr[1], kp = b3 ? pr[1] : pr[0]; pr[0] = kp + dpp_f<DPP_ROR8>(snd); }
                float tot = pr[0]; tot += dpp_f<DPP_XOR1>(tot); tot += dpp_f<DPP_XOR2>(tot); tot += dpp_f<DPP_HMIRROR>(tot);
                const unsigned em = (unsigned)__shfl((int)ent64, i0 + (lane >> 3));
                if ((lane & 7) == 0) {
                    const int tk = (int)(em >> 21), j = (int)((em >> 14) & 127u), row = gw + (p0 + tk) * NGW;
                    const float cf = gelu_erf(tot * (1.0f / 96.0f)) * __uint_as_float((unsigned)gl16[tk * 128 + j] << 16);
                    pairs[((size_t)(row >> 6) * 128 + j) * 64 + (row & 63)] = (cvt_pk_bf16(0.f, cf) & 0xffff0000u) | (em & 0x3FFFu);
                }
            }
        }
    }
}

__device__ __forceinline__ void phase11_peer_v(Frame& F, float* dst) {
    const unsigned* pairs = (const unsigned*)(F.ws + WS_PAIRS); const float* mf = (const float*)(F.ws + WS_MODF);
    unsigned long long* vs = (unsigned long long*)F.lds;
    for (int c = F.bid; c < DM / 8; c += F.G) {
        __syncthreads();
        { const u32x4* src = (const u32x4*)(F.ws + WS_PV + (size_t)c * NEXP * 8); u32x4* dst = (u32x4*)F.lds;
#pragma unroll 4
          for (int i = F.tid; i < NEXP * 8 / 16; i += 512) dst[i] = src[i]; }
        __syncthreads();
        for (int tile = F.wave; tile < MTOK / 64; tile += 8) {
            int lane = F.lane; asm volatile("" : "+v"(lane));
            const unsigned* pp = pairs + (size_t)tile * 128 * 64 + lane;
            const int row = tile * 64 + lane;
            const float* gt2 = mf + (size_t)(tile / (SEQ / 64)) * 12288 + 10240 + c * 8;
            const float* ip = F.out + (size_t)row * 2048 + c * 8; float* op = dst + (size_t)row * 2048 + c * 8;
            const f32x4 x0 = *(const f32x4*)ip, x1 = *(const f32x4*)(ip + 4), g0 = *(const f32x4*)gt2 * 0.25f, g1 = *(const f32x4*)(gt2 + 4) * 0.25f;
            f32x2 acc[4];
#pragma unroll
            for (int i = 0; i < 4; ++i) acc[i] = (f32x2){0.f, 0.f};
#define P11_LOAD(dst, j0) do { _Pragma("unroll") for (int jj = 0; jj < 16; ++jj) dst[jj] = pp[((j0) + jj) * 64]; } while (0)
#define P11_COMP(src) do { _Pragma("unroll") for (int jj = 0; jj < 16; ++jj) { const unsigned long long v = vs[src[jj] & 0x3FFFu]; const float cf = __uint_as_float(src[jj] & 0xffff0000u); \
                    const int lo = (int)(unsigned)v, hi = (int)(unsigned)(v >> 32); \
                    acc[0] += __builtin_amdgcn_cvt_pk_f32_fp8(lo, false) * cf; acc[1] += __builtin_amdgcn_cvt_pk_f32_fp8(lo, true) * cf; \
                    acc[2] += __builtin_amdgcn_cvt_pk_f32_fp8(hi, false) * cf; acc[3] += __builtin_amdgcn_cvt_pk_f32_fp8(hi, true) * cf; } } while (0)
#if PROBE_P11X
            { f32x2 sv[4]; for (int i = 0; i < 4; ++i) sv[i] = acc[i];
            unsigned pa[16], pb[16];
            P11_LOAD(pa, 0);
#pragma unroll 1
            for (int j0 = 0; j0 < 128; j0 += 32) {
                P11_LOAD(pb, j0 + 16);
                P11_COMP(pa);
                if (j0 + 32 < 128) P11_LOAD(pa, j0 + 32);
                P11_COMP(pb);
            }
              asm volatile("" :: "v"(acc[0].x), "v"(acc[1].x), "v"(acc[2].x), "v"(acc[3].x)); for (int i = 0; i < 4; ++i) acc[i] = sv[i] * 0.f; }
#endif
            unsigned pa[16], pb[16];
            P11_LOAD(pa, 0);
#pragma unroll 1
            for (int j0 = 0; j0 < 128; j0 += 32) {
                P11_LOAD(pb, j0 + 16);
                P11_COMP(pa);
                if (j0 + 32 < 128) P11_LOAD(pa, j0 + 32);
                P11_COMP(pb);
            }
#undef P11_LOAD
#undef P11_COMP
            *(f32x4*)op = x0 + g0 * (f32x4){acc[0].x, acc[0].y, acc[1].x, acc[1].y};
            *(f32x4*)(op + 4) = x1 + g1 * (f32x4){acc[2].x, acc[2].y, acc[3].x, acc[3].y};
        }
    }
}

__global__ void __launch_bounds__(512, 2) fwd_kernel(Args args) {
    extern __shared__ __attribute__((aligned(16))) unsigned char lds[];
    Frame F;
    F.lds = lds; F.ws = args.ws; F.tid = threadIdx.x; F.lane = F.tid & 63; F.wave = __builtin_amdgcn_readfirstlane(F.tid >> 6); F.G = gridDim.x; F.bid = blockIdx.x;
    F.x = args.in[0]; F.c = args.in[1]; F.w_ada = args.in[2]; F.b_ada = args.in[3]; F.g1 = args.in[4]; F.g2 = args.in[5]; F.w_in = args.in[6]; F.g_q = args.in[7]; F.g_k = args.in[8];
    F.rel_bias = args.in[9]; F.pool_w = args.in[10]; F.pool_scale = args.in[11]; F.w_ab = args.in[12]; F.w_pb = args.in[13]; F.w_out = args.in[14]; F.w_pq = args.in[15];
    F.peer_keys = args.in[16]; F.peer_u = args.in[17]; F.peer_v = args.in[18]; F.out = args.out;
    LAS unsigned char* ldsl = (LAS unsigned char*)lds;
    volatile LAS unsigned* misc = (volatile LAS unsigned*)(ldsl + MISC_OFF);
    if (F.tid < 4) misc[F.tid] = 0u;
    __syncthreads();
    unsigned* barw = (unsigned*)(args.ws + WS_CTL) + (size_t)args.li * XCD_BAR_WORDS;
    XcdBarrier bar; bar.bar = barw; bar.x = 0; bar.st = misc;
    const int lo = args.ph_lo, hi = args.ph_hi;
    if (hi - lo > 1) bar = xcd_barrier_post(barw, misc);
#define IN(k) (lo <= (k) && (k) < hi)
#define SEAM(k) do { if (IN(k) && IN((k) + 1)) xcd_barrier(bar); } while (0)
    bf16_t* R0 = (bf16_t*)(F.ws + WS_R0);

#define PH2_BODY { \
        pg8::Gemm g{R0, (const bf16_t*)(F.ws + WS_WIN), MTOK, INWP, DM, DM, 0, nullptr, nullptr, 0, 0}; pg8::StaticOrder S; S.init(MTOK, INWP, F.G, F.bid); \
        EpiInproj E{(bf16_t*)(F.ws + WS_QN), (bf16_t*)(F.ws + WS_KN), (bf16_t*)(F.ws + WS_V), (bf16_t*)(F.ws + WS_IQ), (bf16_t*)(F.ws + WS_IK), (bf16_t*)(F.ws + WS_PL), \
                    (bf16_t*)(F.ws + WS_GA), (bf16_t*)(F.ws + WS_GP), (float*)(F.ws + WS_IW)}; \
        pg8::gemm_phase<EpiInproj>(ldsl, g, S, E); }
#define PH3_BODY { phase3_pooled(F); phase3_indexer(F); __syncthreads(); }
#define PH4_BODY { \
        phase4_attention(F); \
        __syncthreads(); \
        pg8::Gemm g{(const bf16_t*)(F.ws + WS_POOLED), (const bf16_t*)(F.ws + WS_POOLW), MTOK, PW, 256, 1024, 256, nullptr, nullptr, 0, 0}; pg8::StaticOrder S; S.init(MTOK, PW, F.G, F.bid); \
        EpiBf16Scale E{(bf16_t*)(F.ws + WS_POOL2), 1024, F.pool_scale}; \
        pg8::gemm_phase<EpiBf16Scale>(ldsl, g, S, E); }
#define PH5_BODY { \
        pg8::Gemm g{(const bf16_t*)(F.ws + WS_ATTN), (const bf16_t*)(F.ws + WS_WAB), MTOK, DM, 2048, 1024, 0, (const bf16_t*)(F.ws + WS_POOL2), (const bf16_t*)(F.ws + WS_WPB), 16, 1024}; \
        pg8::StaticOrder S; S.init(MTOK, DM, F.G, F.bid); \
        EpiMerge E{R0, (const bf16_t*)(F.ws + WS_GA), (const bf16_t*)(F.ws + WS_GP)}; pg8::gemm_phase<EpiMerge>(ldsl, g, S, E); }
#define PH6_BODY { \
        pg8::Gemm g{R0, (const bf16_t*)(F.ws + WS_WOUT), MTOK, DM, DM, DM, 0, nullptr, nullptr, 0, 0}; pg8::StaticOrder S; S.init(MTOK, DM, F.G, F.bid); \
        EpiResid E{F.x, F.out, (const float*)(F.ws + WS_MODF) + 4096}; pg8::gemm_phase<EpiResid>(ldsl, g, S, E); }
#define PH8_BODY { \
        pg8::Gemm g{(const bf16_t*)(F.ws + WS_H2), (const bf16_t*)(F.ws + WS_WPQ), MTOK, DM, DM, DM, 0, nullptr, nullptr, 0, 0}; pg8::StaticOrder S; S.init(MTOK, DM, F.G, F.bid); \
        EpiBf16Scale E{R0, 2048, nullptr}; pg8::gemm_phase<EpiBf16Scale>(ldsl, g, S, E); }
#define PH9_BODY { \
        pg8::Gemm g{R0, (const bf16_t*)(F.ws + WS_KEYSBD), MTOK, DM, 256, DM, 256, nullptr, nullptr, 0, 0}; pg8::StaticOrder S; S.init(MTOK, DM, F.G, F.bid); \
        EpiBf16Scale E{(bf16_t*)(F.ws + WS_SUB), 2048, nullptr}; pg8::gemm_phase<EpiBf16Scale>(ldsl, g, S, E); }
#define REP(k) if constexpr (((PROBE_REP) >> (k)) & 1)

    if (IN(0)) { phase0_prep(F); REP(0) { __syncthreads(); phase0_prep(F); } }
    SEAM(0);
    if (IN(1)) { phase_modnorm<true>(F, F.x, F.g1, 0, 2048, R0); REP(1) { phase_modnorm<true>(F, F.x, F.g1, 0, 2048, R0); } }
    SEAM(1);
    if (IN(2)) { PH2_BODY REP(2) PH2_BODY }
    SEAM(2);
    if (IN(3)) { phase3_qknorm(F); PH3_BODY REP(3) PH3_BODY }
    SEAM(3);
    if (IN(4)) { PH4_BODY REP(4) PH4_BODY }
    SEAM(4);
    if (IN(5)) { PH5_BODY REP(5) PH5_BODY }
    SEAM(5);
    if (IN(6)) { PH6_BODY REP(6) PH6_BODY }
    SEAM(6);
    if (IN(7)) { phase_modnorm<false>(F, F.out, F.g2, 6144, 8192, (bf16_t*)(F.ws + WS_H2)); REP(7) { phase_modnorm<false>(F, F.out, F.g2, 6144, 8192, (bf16_t*)(F.ws + WS_H2)); } }
    SEAM(7);
    if (IN(8)) { PH8_BODY REP(8) PH8_BODY }
    SEAM(8);
    if (IN(9)) { PH9_BODY REP(9) PH9_BODY }
    SEAM(9);
    if (IN(10)) { phase10_peer(F); REP(10) phase10_peer(F); }
    SEAM(10);
    if (IN(11)) { REP(11) { phase11_peer_v(F, (float*)(F.ws + WS_SUB)); } phase11_peer_v(F, F.out); }
#undef IN
#undef SEAM
}

extern "C" void kernel_launch(void* const* d_in, const int* in_sizes, int n_in, void* d_out, int out_size, void* d_ws, size_t ws_size, hipStream_t stream) {
    static int grid = 0;
    if (grid == 0) {
        if (n_in != 19 || out_size != MTOK * DM || ws_size < WS_END) { fprintf(stderr, "kernel_launch: unexpected shapes (n_in %d out %d ws %zu)\n", n_in, out_size, ws_size); grid = -1; return; }
        int dev = 0, cus = 0, per_cu = 0;
        if (hipGetDevice(&dev) != hipSuccess || hipDeviceGetAttribute(&cus, hipDeviceAttributeMultiprocessorCount, dev) != hipSuccess) { grid = -1; return; }
        if (hipFuncSetAttribute((const void*)fwd_kernel, hipFuncAttributeMaxDynamicSharedMemorySize, LDS_BYTES) != hipSuccess) { fprintf(stderr, "kernel_launch: hipFuncSetAttribute failed\n"); grid = -1; return; }
        if (hipOccupancyMaxActiveBlocksPerMultiprocessor(&per_cu, (const void*)fwd_kernel, 512, LDS_BYTES) != hipSuccess || per_cu < 1) { fprintf(stderr, "kernel_launch: occupancy query says %d\n", per_cu); }
        (void)hipGetLastError();
        grid = cus;
    }
    if (grid < 0) return;
    (void)in_sizes;
    if (hipMemsetAsync((char*)d_ws + WS_CTL, 0, CTL_ZERO_BYTES, stream) != hipSuccess) return;
    Args a{};
    for (int i = 0; i < 19; ++i) a.in[i] = (const float*)d_in[i];
    a.out = (float*)d_out; a.ws = (unsigned char*)d_ws;
#if MK_PER_PHASE
    for (int p = 0; p < NPHASE; ++p) { a.ph_lo = p; a.ph_hi = p + 1; a.li = p; hipLaunchKernelGGL(fwd_kernel, dim3(grid), dim3(512), LDS_BYTES, stream, a); }
#else
    a.ph_lo = 0; a.ph_hi = NPHASE; a.li = 0;
    hipLaunchKernelGGL(fwd_kernel, dim3(grid), dim3(512), LDS_BYTES, stream, a);
#endif
}
```

```cpp
#include <hip/hip_runtime.h>
#include <cstdio>
#include <cstdint>

#ifndef MK_PER_PHASE
#define MK_PER_PHASE 0
#endif

#ifndef PROBE_REP
#define PROBE_REP 0
#endif
#ifndef PROBE_IDX
#define PROBE_IDX 0
#endif
#ifndef PROBE_P11X
#define PROBE_P11X 0
#endif
#define LAS __attribute__((address_space(3)))
typedef unsigned short bf16_t;
typedef short bf16x8 __attribute__((ext_vector_type(8)));
typedef float f32x4 __attribute__((ext_vector_type(4)));
typedef float f32x2 __attribute__((ext_vector_type(2)));
typedef unsigned u32x4 __attribute__((ext_vector_type(4)));
typedef unsigned u32x2 __attribute__((ext_vector_type(2)));
typedef unsigned u32x6 __attribute__((ext_vector_type(6)));
typedef unsigned u32x16 __attribute__((ext_vector_type(16)));
typedef __bf16 bf16x32 __attribute__((ext_vector_type(32)));

constexpr int BATCH = 8, SEQ = 4096, DM = 2048, MTOK = BATCH * SEQ;
constexpr int NHEAD = 8, HDIM = 128, AW = 1024, KVW = 256, IHEADS = 16, IDIM = 64, KSEL = 256;
constexpr int PW = 1024, PHEADS = 8, NEXP = 16384;
constexpr int INW = 7760, INWP = 7936;
constexpr float EPS = 1e-6f;
constexpr int NPHASE = 12;

constexpr size_t MiB = 1u << 20;
constexpr size_t WS_CTL = 0, CTL_ZERO_BYTES = 256 * 1024;
constexpr size_t WS_MODP = 2 * MiB;
constexpr size_t WS_MODF = 4 * MiB;
constexpr size_t WS_POOLW = 5 * MiB;
constexpr size_t WS_KEYSBD = 6 * MiB;
constexpr size_t WS_WIN = 8 * MiB;
constexpr size_t WS_WAB = 40 * MiB, WS_WPB = 44 * MiB, WS_WOUT = 48 * MiB, WS_WPQ = 56 * MiB;
constexpr size_t WS_PU = 64 * MiB, WS_PV = 128 * MiB;
constexpr size_t WS_R0 = 192 * MiB;
constexpr size_t WS_GA = 320 * MiB, WS_GP = 448 * MiB;
constexpr size_t WS_SUB = 320 * MiB;
constexpr size_t WS_QN = 576 * MiB;
constexpr size_t WS_IQ = 640 * MiB;
constexpr size_t WS_PL = 704 * MiB;
constexpr size_t WS_KN = 768 * MiB, WS_V = 784 * MiB;
constexpr size_t WS_IK = 800 * MiB;
constexpr size_t WS_IW = 804 * MiB;
constexpr size_t WS_SEL = 806 * MiB;
constexpr size_t WS_POOLED = 822 * MiB;
constexpr size_t WS_H2 = 886 * MiB;
constexpr size_t WS_END = 1014 * MiB;
constexpr size_t WS_Q8 = WS_H2, WS_K8 = WS_H2 + 32 * MiB, WS_V8 = WS_H2 + 40 * MiB;
constexpr size_t WS_ATTN = WS_IQ, WS_POOL2 = WS_PL, WS_PAIRS = WS_QN, WS_WLS = WS_QN + 32 * MiB;

constexpr int LDS_BYTES = 160 * 1024;
constexpr int MISC_OFF = 159 * 1024;

__device__ __forceinline__ unsigned cvt_pk_bf16(float lo, float hi) { unsigned r; asm volatile("v_cvt_pk_bf16_f32 %0, %1, %2" : "=v"(r) : "v"(lo), "v"(hi)); return r; }
__device__ __forceinline__ float bf_lo(unsigned w) { return __uint_as_float(w << 16); }
__device__ __forceinline__ float bf_hi(unsigned w) { return __uint_as_float(w & 0xffff0000u); }
template <int CTRL> __device__ __forceinline__ float dpp_f(float x) { return __int_as_float(__builtin_amdgcn_update_dpp(0, __float_as_int(x), CTRL, 0xF, 0xF, true)); }
#define DPP_XOR1 0xB1
#define DPP_XOR2 0x4E
#define DPP_HMIRROR 0x141
#define DPP_MIRROR 0x140
#define DPP_ROR8 0x128
__device__ __forceinline__ float xor16_sum(float x) { const auto r = __builtin_amdgcn_permlane16_swap(__float_as_uint(x), __float_as_uint(x), false, false); return __uint_as_float(r[0]) + __uint_as_float(r[1]); }
__device__ __forceinline__ float xor32_sum(float x) { const auto r = __builtin_amdgcn_permlane32_swap(__float_as_uint(x), __float_as_uint(x), false, false); return __uint_as_float(r[0]) + __uint_as_float(r[1]); }
__device__ __forceinline__ float xor16_max(float x) { const auto r = __builtin_amdgcn_permlane16_swap(__float_as_uint(x), __float_as_uint(x), false, false); return fmaxf(__uint_as_float(r[0]), __uint_as_float(r[1])); }
__device__ __forceinline__ float swap32_pair(float a, float b) { const auto r = __builtin_amdgcn_permlane32_swap(__float_as_uint(a), __float_as_uint(b), false, false); return __uint_as_float(r[0]) + __uint_as_float(r[1]); }
__device__ __forceinline__ float swap16_pair(float a, float b) { const auto r = __builtin_amdgcn_permlane16_swap(__float_as_uint(a), __float_as_uint(b), false, false); return __uint_as_float(r[0]) + __uint_as_float(r[1]); }
__device__ __forceinline__ float row_sum16(float v) { v += dpp_f<DPP_XOR1>(v); v += dpp_f<DPP_XOR2>(v); v += dpp_f<DPP_HMIRROR>(v); v += dpp_f<DPP_MIRROR>(v); return v; }
__device__ __forceinline__ float row_max16(float v) { v = fmaxf(v, dpp_f<DPP_XOR1>(v)); v = fmaxf(v, dpp_f<DPP_XOR2>(v)); v = fmaxf(v, dpp_f<DPP_HMIRROR>(v)); v = fmaxf(v, dpp_f<DPP_MIRROR>(v)); return v; }
__device__ __forceinline__ float wave_sum(float v) { return xor32_sum(xor16_sum(row_sum16(v))); }
__device__ __forceinline__ float sigmoidf_(float x) { return __builtin_amdgcn_rcpf(1.0f + __expf(-x)); }
__device__ __forceinline__ float dot8(u32x4 w, const float* h) {
    return bf_lo(w.x) * h[0] + bf_hi(w.x) * h[1] + bf_lo(w.y) * h[2] + bf_hi(w.y) * h[3] + bf_lo(w.z) * h[4] + bf_hi(w.z) * h[5] + bf_lo(w.w) * h[6] + bf_hi(w.w) * h[7];
}

#define XB_TMO      128
#define XB_XCNT(j)  (256  + 64 * (j))
#define XB_XSUB(j)  (1280 + 64 * (j))
#define XB_XGEN(j)  (2304 + 64 * (j))
#define XB_TOP      3328
#define XB_TOPGEN   3392
#define XCD_BAR_WORDS 3456
#define XB_SPIN_CAP (1u << 18)

__device__ __forceinline__ unsigned xb_ld(unsigned* p)              { return __hip_atomic_load(p, __ATOMIC_RELAXED, __HIP_MEMORY_SCOPE_AGENT); }
__device__ __forceinline__ unsigned xb_add(unsigned* p, unsigned v) { return __hip_atomic_fetch_add(p, v, __ATOMIC_RELAXED, __HIP_MEMORY_SCOPE_AGENT); }
__device__ __forceinline__ unsigned xb_xcc_id() { return (unsigned)__builtin_amdgcn_s_getreg((3 << 11) | 20) & 0xFu; }
#define XB_SPIN(cond, bar) do { unsigned _sp = 0; while (cond) { __builtin_amdgcn_s_sleep(1); \
    if ((++_sp & 255u) == 0u) { if (xb_ld(&(bar)[XB_TMO])) break; if (_sp > XB_SPIN_CAP) { atomicAdd(&(bar)[XB_TMO], 1u); break; } } } } while (0)

struct XcdBarrier { unsigned* bar; unsigned x; volatile LAS unsigned* st; };

__device__ __forceinline__ XcdBarrier xcd_barrier_post(unsigned* bar, volatile LAS unsigned* st) {
    XcdBarrier b; b.bar = bar; b.x = xb_xcc_id(); b.st = st;
    if (threadIdx.x == 0) (void)xb_add(&bar[XB_XCNT(b.x)], 1u);
    return b;
}
__device__ __forceinline__ void xcd_barrier_complete(unsigned* bar, unsigned x, unsigned& nloc, unsigned& nx) {
    const unsigned G = gridDim.x * gridDim.y * gridDim.z;
    unsigned sum, cnt, mine, sp = 0u;
    for (;;) {
        sum = 0u; cnt = 0u; mine = 0u;
#pragma unroll
        for (unsigned j = 0; j < 16; ++j) { const unsigned c = xb_ld(&bar[XB_XCNT(j)]); sum += c; cnt += (c > 0u) ? 1u : 0u; mine = (j == x) ? c : mine; }
        if (sum == G) break;
        __builtin_amdgcn_s_sleep(1);
        if ((++sp & 255u) == 0u) { if (xb_ld(&bar[XB_TMO])) break; if (sp > XB_SPIN_CAP) { atomicAdd(&bar[XB_TMO], 1u); break; } }
    }
    nloc = mine > 0u ? mine : 1u; nx = cnt > 0u ? cnt : 1u;
}
__device__ __forceinline__ void xcd_barrier(const XcdBarrier& b) {
    asm volatile("s_waitcnt vmcnt(0)" ::: "memory");
    __syncthreads();
    if (threadIdx.x == 0) {
        unsigned* bar = b.bar;
        __builtin_amdgcn_s_waitcnt(0);
        unsigned nloc = b.st[0], nx = b.st[1];
        if (nloc == 0u) { xcd_barrier_complete(bar, b.x, nloc, nx); b.st[0] = nloc; b.st[1] = nx; }
        const unsigned old = xb_add(&bar[XB_XSUB(b.x)], 1u);
        const unsigned gen = old / nloc;
        if (old + 1u == (gen + 1u) * nloc) {
            __builtin_amdgcn_fence(__ATOMIC_RELEASE, "agent");
            asm volatile("s_waitcnt vmcnt(0)" ::: "memory");
            const unsigned og = xb_add(&bar[XB_TOP], 1u);
            const unsigned tg = og / nx;
            if (og + 1u == (tg + 1u) * nx) xb_add(&bar[XB_TOPGEN], 1u);
            else XB_SPIN(xb_ld(&bar[XB_TOPGEN]) == tg, bar);
            __builtin_amdgcn_fence(__ATOMIC_ACQUIRE, "agent");
            xb_add(&bar[XB_XGEN(b.x)], 1u);
            asm volatile("s_waitcnt vmcnt(0)" ::: "memory");
        } else {
            XB_SPIN(xb_ld(&bar[XB_XGEN(b.x)]) == gen, bar);
            __builtin_amdgcn_fence(__ATOMIC_ACQUIRE, "agent");
            asm volatile("s_waitcnt vmcnt(0)" ::: "memory");
        }
    }
    __syncthreads();
}

namespace pg8 {
constexpr int BM = 256, BK = 64, HALF = 128, HTB = HALF * BK * 2, STAGE_BYTES = 8 * HTB, NXCD = 8, WGM = 8;
__device__ __forceinline__ int lds_byte(int r, int c) { const int st = (r >> 4) * 2 + (c >> 5), rr = r & 15, cc = c & 31, ob = rr * 64 + cc * 2; return st * 1024 + (ob ^ (((ob >> 9) & 1) << 5)); }
__device__ __forceinline__ void stage_rc(int b, int& R, int& C) { const int st = b / 1024, sb = b % 1024, swz = sb ^ (((sb >> 9) & 1) << 5); R = (st >> 1) * 16 + swz / 64; C = (st & 1) * 32 + (swz % 64) / 2; }
__device__ __forceinline__ int perm32(int rho) { const int n = rho >> 4, i = rho & 15; return 8 * (i >> 2) + 4 * n + (i & 3); }

struct Unit { int pm, pn; };
struct Gemm { const bf16_t* A; const bf16_t* Bt; int M, N, K, lda, a_pn_off; const bf16_t* A2; const bf16_t* Bt2; int ksplit, ldb; };

struct StaticOrder {
    int nM, nN, nwg, G, c;
    __device__ void init(int M, int N, int G_, int c_) { nM = M / BM; nN = N / BM; nwg = nM * nN; G = G_; c = c_; }
    __device__ bool next(int i, Unit& u) const {
        const long L = (long)i * G + c; if (L >= nwg) return false;
        int wgid = (int)L; { const int q = nwg / NXCD, r = nwg % NXCD, xcd = wgid % NXCD, off = wgid / NXCD; wgid = (xcd < r ? xcd * (q + 1) : r * (q + 1) + (xcd - r) * q) + off; }
        const int nig = WGM * nN, gid = wgid / nig, fm = gid * WGM, gsz = (nM - fm) < WGM ? (nM - fm) : WGM;
        u.pm = fm + ((wgid % nig) % gsz); u.pn = (wgid % nig) / gsz; return true;
    }
};

template <class Epi>
__device__ __forceinline__ void gemm_phase(LAS unsigned char* lds, const Gemm g, const StaticOrder& S, const Epi& E) {
    const int tid = threadIdx.x, wid = __builtin_amdgcn_readfirstlane(tid >> 6), lane = tid & 63, wr = wid >> 2, wc = wid & 3, fr = lane & 15, fq = lane >> 4;
    const int K = g.K, nt = K / BK, lda = g.lda, ldb = g.ldb ? g.ldb : g.K, ksplit = g.ksplit;
    unsigned voffA[2], voffB[2];
#pragma unroll
    for (int i = 0; i < 2; ++i) { int R, C; stage_rc(tid * 16 + i * 8192, R, C); const int Rb = Epi::PERM ? ((R & ~31) + perm32(R & 31)) : R;
        voffA[i] = (unsigned)(R * lda + C) * 2u; voffB[i] = (unsigned)(Rb * ldb + C) * 2u; }
    const size_t kstep = (size_t)(BK * 2);
    const size_t hsA = (size_t)HALF * lda * 2, hsB = (size_t)HALF * ldb * 2;
    const size_t tsA = 2 * hsA, tsB = 2 * hsB;
    const unsigned ldsw = (unsigned)wid * 1024u;
    const int aoff = lds_byte(wr * 64 + fr, fq * 8), boff = lds_byte(wc * 32 + fr, fq * 8);
#define PG8_SA(b, h) (((b) * 2 + (h)) * HTB)
#define PG8_SB(b, h) ((4 + (b) * 2 + (h)) * HTB)
#define PG8_STAGE(bufoff, gbase, voff) do { _Pragma("unroll") for (int _i = 0; _i < 2; ++_i) \
        __builtin_amdgcn_global_load_lds((const unsigned*)((const char*)(gbase) + (voff)[_i]), (LAS unsigned*)(lds + (bufoff) + ldsw + _i * 8192), 16, 0, 0); } while (0)
#define PG8_LDA(dst, b, h) do { _Pragma("unroll") for (int m = 0; m < 4; ++m) _Pragma("unroll") for (int k = 0; k < 2; ++k) dst[m][k] = *(const LAS bf16x8*)(lds + PG8_SA(b, h) + aoff + m * 2048 + k * 1024); } while (0)
#define PG8_LDB(dst, b, h) do { _Pragma("unroll") for (int n = 0; n < 2; ++n) _Pragma("unroll") for (int k = 0; k < 2; ++k) dst[n][k] = *(const LAS bf16x8*)(lds + PG8_SB(b, h) + boff + n * 2048 + k * 1024); } while (0)
#define PG8_MMA(ai, bj, At, Bt) do { __builtin_amdgcn_s_setprio(1); _Pragma("unroll") for (int m = 0; m < 4; ++m) _Pragma("unroll") for (int n = 0; n < 2; ++n) _Pragma("unroll") for (int k = 0; k < 2; ++k) \
        acc[ai][bj][m][n] = __builtin_amdgcn_mfma_f32_16x16x32_bf16(Bt[n][k], At[m][k], acc[ai][bj][m][n], 0, 0, 0); __builtin_amdgcn_s_setprio(0); } while (0)
#define PG8_WAIT_V(n) asm volatile("s_waitcnt vmcnt(" #n ")" ::: "memory")
#define PG8_WAIT_L(n) asm volatile("s_waitcnt lgkmcnt(" #n ")" ::: "memory")
#define PG8_BAR __builtin_amdgcn_s_barrier()
#define PG8_SCHED __builtin_amdgcn_sched_barrier(0)
    Unit cur, nxt; int ui = 0;
    if (!S.next(0, cur)) return;
    f32x4 acc[2][2][4][2];
#pragma unroll
    for (int a = 0; a < 2; ++a)
#pragma unroll
        for (int b = 0; b < 2; ++b)
#pragma unroll
            for (int m = 0; m < 4; ++m)
#pragma unroll
                for (int n = 0; n < 2; ++n) acc[a][b][m][n] = (f32x4){0.f, 0.f, 0.f, 0.f};
    bf16x8 At[4][2], B0[2][2], B1[2][2];
    const char* cA = (const char*)g.A + (size_t)cur.pm * tsA + (size_t)cur.pn * g.a_pn_off * 2; const char* cB = (const char*)g.Bt + (size_t)cur.pn * tsB;
    PG8_STAGE(PG8_SB(0, 0), cB, voffB); PG8_STAGE(PG8_SB(0, 1), cB + hsB, voffB); PG8_STAGE(PG8_SA(0, 0), cA, voffA); PG8_STAGE(PG8_SA(0, 1), cA + hsA, voffA);
    if (wr == 1) PG8_BAR;
    PG8_WAIT_V(2); PG8_BAR;
    PG8_STAGE(PG8_SB(1, 0), cB + kstep, voffB); PG8_STAGE(PG8_SA(1, 0), cA + kstep, voffA); PG8_STAGE(PG8_SB(1, 1), cB + hsB + kstep, voffB);
    PG8_WAIT_V(6); PG8_BAR;
    for (;;) {
        const bool has_next = S.next(ui + 1, nxt);
        const char* nA = has_next ? (const char*)g.A + (size_t)nxt.pm * tsA + (size_t)nxt.pn * g.a_pn_off * 2 : cA; const char* nB = has_next ? (const char*)g.Bt + (size_t)nxt.pn * tsB : cB;
        const char* cA2 = (const char*)g.A2 + (size_t)cur.pm * tsA; const char* cB2 = (const char*)g.Bt2 + (size_t)cur.pn * tsB;
        for (int t = 0; t < nt; t += 2) {
            const bool last = (t == nt - 2);
            const bool s1 = ksplit && (t >= ksplit), s2 = ksplit && (t + 2 >= ksplit);
            const char* a1 = (s1 ? cA2 + (size_t)(t - ksplit + 1) * kstep : cA + (size_t)(t + 1) * kstep);
            const char* a2 = last ? nA : (s2 ? cA2 + (size_t)(t + 2 - ksplit) * kstep : cA + (size_t)(t + 2) * kstep);
            const char* b2 = last ? nB : (s2 ? cB2 + (size_t)(t + 2 - ksplit) * kstep : cB + (size_t)(t + 2) * kstep);
            const char* a3 = a2 + kstep; const char* b3 = b2 + kstep;
            PG8_LDB(B0, 0, 0); PG8_LDB(B1, 0, 1); PG8_SCHED; PG8_LDA(At, 0, 0); PG8_STAGE(PG8_SA(1, 1), a1 + hsA, voffA);
            PG8_WAIT_V(8); PG8_WAIT_L(0); PG8_BAR; PG8_MMA(0, 0, At, B0); PG8_MMA(0, 1, At, B1); PG8_BAR; PG8_SCHED;
            PG8_LDA(At, 0, 1); PG8_STAGE(PG8_SB(0, 0), b2, voffB); PG8_STAGE(PG8_SB(0, 1), b2 + hsB, voffB); PG8_STAGE(PG8_SA(0, 0), a2, voffA);
            PG8_WAIT_V(8); PG8_WAIT_L(0); PG8_BAR; PG8_MMA(1, 0, At, B0); PG8_MMA(1, 1, At, B1); PG8_BAR; PG8_SCHED;
            PG8_LDB(B0, 1, 0); PG8_LDB(B1, 1, 1); PG8_SCHED; PG8_LDA(At, 1, 0); PG8_STAGE(PG8_SA(0, 1), a2 + hsA, voffA);
            PG8_WAIT_V(8); PG8_WAIT_L(0); PG8_BAR; PG8_MMA(0, 0, At, B0); PG8_MMA(0, 1, At, B1); PG8_BAR; PG8_SCHED;
            PG8_LDA(At, 1, 1); PG8_STAGE(PG8_SB(1, 0), b3, voffB); PG8_STAGE(PG8_SB(1, 1), b3 + hsB, voffB); PG8_STAGE(PG8_SA(1, 0), a3, voffA);
            PG8_WAIT_V(8); PG8_WAIT_L(0); PG8_BAR; PG8_MMA(1, 0, At, B0); PG8_MMA(1, 1, At, B1); PG8_BAR; PG8_SCHED;
            if constexpr (Epi::MID) { if (t + 2 == ksplit) E.mid(acc, cur, wr, wc, fr, fq); }
        }
        if (wr == 0) PG8_BAR;
        E(acc, cur, wr, wc, fr, fq);
        if (!has_next) break;
#pragma unroll
        for (int a = 0; a < 2; ++a)
#pragma unroll
            for (int b = 0; b < 2; ++b)
#pragma unroll
                for (int m = 0; m < 4; ++m)
#pragma unroll
                    for (int n = 0; n < 2; ++n) acc[a][b][m][n] = (f32x4){0.f, 0.f, 0.f, 0.f};
        cur = nxt; cA = nA; cB = nB; ++ui;
        if (wr == 1) PG8_BAR;
    }
    PG8_WAIT_V(0);
    PG8_BAR;
#undef PG8_SA
#undef PG8_SB
#undef PG8_STAGE
#undef PG8_LDA
#undef PG8_LDB
#undef PG8_MMA
#undef PG8_WAIT_V
#undef PG8_WAIT_L
#undef PG8_BAR
#undef PG8_SCHED
}
}
using pg8::Unit;

typedef f32x4 AccT[2][2][4][2];
__device__ __forceinline__ u32x4 pack8(f32x4 a, f32x4 b) { u32x4 w; w.x = cvt_pk_bf16(a[0], a[1]); w.y = cvt_pk_bf16(a[2], a[3]); w.z = cvt_pk_bf16(b[0], b[1]); w.w = cvt_pk_bf16(b[2], b[3]); return w; }
__device__ __forceinline__ void unpack8(u32x4 w, f32x4& a, f32x4& b) { a = (f32x4){bf_lo(w.x), bf_hi(w.x), bf_lo(w.y), bf_hi(w.y)}; b = (f32x4){bf_lo(w.z), bf_hi(w.z), bf_lo(w.w), bf_hi(w.w)}; }

struct EpiInproj {
    static constexpr bool PERM = true, MID = false;
    bf16_t *q, *k, *v, *iq, *ik, *pl, *ga, *gp; float* iw;
    __device__ __forceinline__ void operator()(const AccT& acc, const Unit& u, int wr, int wc, int fr, int fq) const {
        const int pn = u.pn, row0 = u.pm * 256 + wr * 64 + fr;
        if (pn == 10) {
            if (wc < 2) {
#pragma unroll
                for (int ai = 0; ai < 2; ++ai)
#pragma unroll
                    for (int m = 0; m < 4; ++m) { const size_t row = (size_t)(row0 + ai * 128 + m * 16);
                        *(u32x4*)(ik + row * 64 + wc * 32 + 8 * fq) = pack8(acc[ai][0][m][0], acc[ai][0][m][1]); }
            } else if (wc == 2) {
                if (fq < 2) {
#pragma unroll
                    for (int ai = 0; ai < 2; ++ai)
#pragma unroll
                        for (int m = 0; m < 4; ++m) { const size_t row = (size_t)(row0 + ai * 128 + m * 16);
                            *(f32x4*)(iw + row * 16 + 8 * fq) = acc[ai][0][m][0]; *(f32x4*)(iw + row * 16 + 8 * fq + 4) = acc[ai][0][m][1]; }
                }
            }
            return;
        }
        bf16_t* dst; int ld, tc; bool sg = false;
        if (pn < 4) { dst = q; ld = 1024; tc = pn * 256; }
        else if (pn == 4) { dst = k; ld = 256; tc = 0; }
        else if (pn == 5) { dst = v; ld = 256; tc = 0; }
        else if (pn < 10) { dst = iq; ld = 1024; tc = (pn - 6) * 256; }
        else if (pn < 15) { dst = pl; ld = 1024; tc = (pn - 11) * 256; }
        else if (pn < 23) { dst = ga; ld = 2048; tc = (pn - 15) * 256; sg = true; }
        else { dst = gp; ld = 2048; tc = (pn - 23) * 256; sg = true; }
        const int col0 = tc + wc * 32 + 8 * fq;
#pragma unroll
        for (int ai = 0; ai < 2; ++ai)
#pragma unroll
            for (int m = 0; m < 4; ++m) { bf16_t* rowp = dst + (size_t)(row0 + ai * 128 + m * 16) * ld + col0;
#pragma unroll
                for (int bj = 0; bj < 2; ++bj) { f32x4 v0 = acc[ai][bj][m][0], v1 = acc[ai][bj][m][1];
                    if (sg) {
#pragma unroll
                        for (int j = 0; j < 4; ++j) { v0[j] = sigmoidf_(v0[j]); v1[j] = sigmoidf_(v1[j]); } }
                    *(u32x4*)(rowp + bj * 128) = pack8(v0, v1); } }
    }
};
struct EpiBf16Scale {
    static constexpr bool PERM = true, MID = false;
    bf16_t* O; int ldc; const float* cs;
    __device__ __forceinline__ void operator()(const AccT& acc, const Unit& u, int wr, int wc, int fr, int fq) const {
        const int row0 = u.pm * 256 + wr * 64 + fr, col0 = u.pn * 256 + wc * 32 + 8 * fq;
        f32x4 s[2][2];
#pragma unroll
        for (int bj = 0; bj < 2; ++bj)
#pragma unroll
            for (int n = 0; n < 2; ++n) s[bj][n] = cs ? *(const f32x4*)(cs + col0 + bj * 128 + 4 * n) : (f32x4){1.f, 1.f, 1.f, 1.f};
#pragma unroll
        for (int ai = 0; ai < 2; ++ai)
#pragma unroll
            for (int m = 0; m < 4; ++m) { bf16_t* rowp = O + (size_t)(row0 + ai * 128 + m * 16) * ldc + col0;
#pragma unroll
                for (int bj = 0; bj < 2; ++bj) *(u32x4*)(rowp + bj * 128) = pack8(acc[ai][bj][m][0] * s[bj][0], acc[ai][bj][m][1] * s[bj][1]); }
    }
};
template <bool ADD> struct EpiGate {
    static constexpr bool PERM = true, MID = false;
    bf16_t* O; const bf16_t* gate;
    __device__ __forceinline__ void operator()(const AccT& acc, const Unit& u, int wr, int wc, int fr, int fq) const {
        const int row0 = u.pm * 256 + wr * 64 + fr, col0 = u.pn * 256 + wc * 32 + 8 * fq;
#pragma unroll
        for (int ai = 0; ai < 2; ++ai)
#pragma unroll
            for (int m = 0; m < 4; ++m) { const size_t off = (size_t)(row0 + ai * 128 + m * 16) * 2048 + col0;
#pragma unroll
                for (int bj = 0; bj < 2; ++bj) { f32x4 g0, g1; unpack8(*(const u32x4*)(gate + off + bj * 128), g0, g1);
                    f32x4 r0 = g0 * acc[ai][bj][m][0], r1 = g1 * acc[ai][bj][m][1];
                    if (ADD) { f32x4 o0, o1; unpack8(*(const u32x4*)(O + off + bj * 128), o0, o1); r0 += o0; r1 += o1; }
                    *(u32x4*)(O + off + bj * 128) = pack8(r0, r1); } }
    }
};
struct EpiMerge {
    static constexpr bool PERM = true, MID = true;
    bf16_t* O; const bf16_t* ga; const bf16_t* gp;
    __device__ __forceinline__ void mid(AccT& acc, const Unit& u, int wr, int wc, int fr, int fq) const {
        const auto ra = __builtin_amdgcn_make_buffer_rsrc((void*)ga, 0, 0x7FFFFFFF, 0x00020000), rp = __builtin_amdgcn_make_buffer_rsrc((void*)gp, 0, 0x7FFFFFFF, 0x00020000);
        const int voff = ((wr * 64 + fr) * 2048 + wc * 32 + 8 * fq) * 2;
        const int sbase = (u.pm * 256 * 2048 + u.pn * 256) * 2;
#pragma unroll
        for (int ai = 0; ai < 2; ++ai)
#pragma unroll
            for (int m = 0; m < 4; ++m)
#pragma unroll
                for (int bj = 0; bj < 2; ++bj) { const int so = sbase + ((ai * 128 + m * 16) * 2048 + bj * 128) * 2;
                    const u32x4 wa = __builtin_bit_cast(u32x4, __builtin_amdgcn_raw_buffer_load_b128(ra, voff, so, 0)), wp = __builtin_bit_cast(u32x4, __builtin_amdgcn_raw_buffer_load_b128(rp, voff, so, 0));
                    f32x4 a0, a1, p0, p1; unpack8(wa, a0, a1); unpack8(wp, p0, p1);
#pragma unroll
                    for (int j = 0; j < 4; ++j) { acc[ai][bj][m][0][j] *= a0[j] * __builtin_amdgcn_rcpf(p0[j]); acc[ai][bj][m][1][j] *= a1[j] * __builtin_amdgcn_rcpf(p1[j]); }
                    asm volatile("" : "+v"(acc[ai][bj][m][0]), "+v"(acc[ai][bj][m][1]) :: "memory"); }
    }
    __device__ __forceinline__ void operator()(const AccT& acc, const Unit& u, int wr, int wc, int fr, int fq) const {
        const int row0 = u.pm * 256 + wr * 64 + fr, col0 = u.pn * 256 + wc * 32 + 8 * fq;
#pragma unroll
        for (int ai = 0; ai < 2; ++ai)
#pragma unroll
            for (int m = 0; m < 4; ++m) { const size_t off = (size_t)(row0 + ai * 128 + m * 16) * 2048 + col0;
#pragma unroll
                for (int bj = 0; bj < 2; ++bj) { f32x4 p0, p1; unpack8(*(const u32x4*)(gp + off + bj * 128), p0, p1);
                    *(u32x4*)(O + off + bj * 128) = pack8(p0 * acc[ai][bj][m][0], p1 * acc[ai][bj][m][1]); } }
    }
};
struct EpiResid {
    static constexpr bool PERM = false, MID = false;
    const float* x; float* out; const float* gt;
    __device__ __forceinline__ void operator()(const AccT& acc, const Unit& u, int wr, int wc, int fr, int fq) const {
        const int row0 = u.pm * 256 + wr * 64 + fr, col0 = u.pn * 256 + wc * 32 + 4 * fq;
        const float* gtb = gt + (size_t)(u.pm / 16) * 12288;
        f32x4 g[2][2];
#pragma unroll
        for (int bj = 0; bj < 2; ++bj)
#pragma unroll
            for (int n = 0; n < 2; ++n) g[bj][n] = *(const f32x4*)(gtb + col0 + bj * 128 + n * 16);
#pragma unroll
        for (int ai = 0; ai < 2; ++ai)
#pragma unroll
            for (int m = 0; m < 4; ++m) { const size_t off = (size_t)(row0 + ai * 128 + m * 16) * 2048 + col0;
#pragma unroll
                for (int bj = 0; bj < 2; ++bj)
#pragma unroll
                    for (int n = 0; n < 2; ++n) { const f32x4 xv = *(const f32x4*)(x + off + bj * 128 + n * 16);
                        *(f32x4*)(out + off + bj * 128 + n * 16) = xv + g[bj][n] * acc[ai][bj][m][n]; } }
    }
};
struct EpiF32 {
    static constexpr bool PERM = false, MID = false;
    float* C; int ldc;
    __device__ __forceinline__ void operator()(const AccT& acc, const Unit& u, int wr, int wc, int fr, int fq) const {
        const int row0 = u.pm * 256 + wr * 64 + fr, col0 = u.pn * 256 + wc * 32 + 4 * fq;
#pragma unroll
        for (int ai = 0; ai < 2; ++ai)
#pragma unroll
            for (int m = 0; m < 4; ++m) { float* rowp = C + (size_t)(row0 + ai * 128 + m * 16) * ldc + col0;
#pragma unroll
                for (int bj = 0; bj < 2; ++bj)
#pragma unroll
                    for (int n = 0; n < 2; ++n) *(f32x4*)(rowp + bj * 128 + n * 16) = acc[ai][bj][m][n]; }
    }
};

struct Args { const float* in[19]; float* out; unsigned char* ws; int ph_lo, ph_hi; int li, pad; };
struct Frame {
    unsigned char* lds; unsigned char* ws;
    int tid, lane, wave, G, bid;
    const float *x, *c, *w_ada, *b_ada, *g1, *g2, *w_in, *g_q, *g_k, *rel_bias, *pool_w, *pool_scale, *w_ab, *w_pb, *w_out, *w_pq, *peer_keys, *peer_u, *peer_v;
    float* out;
};

template <class Fn> __device__ __forceinline__ void transpose_item(const float* W, int K, int N, bf16_t* WT, int ldk, int drow0, int k0, float* scr, int lane, Fn srccol) {
    const int sc = srccol(drow0 + (lane & 31));
#pragma unroll 8
    for (int i = 0; i < 32; ++i) { const int kk = 2 * i + (lane >> 5); scr[kk * 33 + (lane & 31)] = sc >= 0 ? W[(size_t)(k0 + kk) * N + sc] : 0.f; }
    asm volatile("s_waitcnt lgkmcnt(0)" ::: "memory");
    const int c = lane & 7;
#pragma unroll
    for (int j = 0; j < 4; ++j) { const int n = (lane >> 3) + 8 * j; const float* s = scr + (8 * c) * 33 + n;
        u32x4 o; o.x = cvt_pk_bf16(s[0 * 33], s[1 * 33]); o.y = cvt_pk_bf16(s[2 * 33], s[3 * 33]); o.z = cvt_pk_bf16(s[4 * 33], s[5 * 33]); o.w = cvt_pk_bf16(s[6 * 33], s[7 * 33]);
        *(u32x4*)(WT + (size_t)(drow0 + n) * ldk + k0 + 8 * c) = o; }
    asm volatile("s_waitcnt lgkmcnt(0)" ::: "memory");
}
__device__ __forceinline__ void phase0_prep(Frame& F) {
    const int gw = F.bid * 8 + F.wave, NGW = F.G * 8;
    float* scr = (float*)(F.lds + F.wave * 16384);
    constexpr int I_IN = (INWP / 32) * (DM / 64);
    constexpr int I_AB = (2048 / 32) * (1024 / 64), I_OUT = (2048 / 32) * (2048 / 64), I_PW = 4 * 8 * 4;
    constexpr int NIT = I_IN + 2 * I_AB + 2 * I_OUT + I_PW;
    auto ident = [](int j) { return j; };
    for (int it = gw; it < NIT; it += NGW) {
        int r = it;
        if (r < I_IN) { const int nb = r % (INWP / 32), kb = r / (INWP / 32);
            transpose_item(F.w_in, DM, INW, (bf16_t*)(F.ws + WS_WIN), DM, nb * 32, kb * 64, scr, F.lane, [](int j) { return j < 2640 ? j : (j < 2816 ? -1 : j - 176); }); continue; }
        r -= I_IN;
        if (r < I_AB) { transpose_item(F.w_ab, 1024, 2048, (bf16_t*)(F.ws + WS_WAB), 1024, (r % 64) * 32, (r / 64) * 64, scr, F.lane, ident); continue; }
        r -= I_AB;
        if (r < I_AB) { transpose_item(F.w_pb, 1024, 2048, (bf16_t*)(F.ws + WS_WPB), 1024, (r % 64) * 32, (r / 64) * 64, scr, F.lane, ident); continue; }
        r -= I_AB;
        if (r < I_OUT) { transpose_item(F.w_out, 2048, 2048, (bf16_t*)(F.ws + WS_WOUT), 2048, (r % 64) * 32, (r / 64) * 64, scr, F.lane, ident); continue; }
        r -= I_OUT;
        if (r < I_OUT) { transpose_item(F.w_pq, 2048, 2048, (bf16_t*)(F.ws + WS_WPQ), 2048, (r % 64) * 32, (r / 64) * 64, scr, F.lane, ident); continue; }
        r -= I_OUT;
        { const int g = r / 32, q = r % 32, nb = q % 8, kb = q / 8;
          transpose_item(F.pool_w + (size_t)g * 65536, 256, 256, (bf16_t*)(F.ws + WS_POOLW) + (size_t)g * 65536, 256, nb * 32, kb * 64, scr, F.lane, ident); }
    }
    {
        bf16_t* kb = (bf16_t*)(F.ws + WS_KEYSBD);
        for (int i = F.bid * 512 + F.tid; i < 2048 * 32; i += F.G * 512) {
            const int row = i / 32, k8 = (i % 32) * 8, p = (row >> 7) & 1;
            u32x4 o = (u32x4){0u, 0u, 0u, 0u};
            if ((k8 >> 7) == p) { const float* s = F.peer_keys + (size_t)row * 128 + (k8 & 127); const f32x4 a = *(const f32x4*)s, b = *(const f32x4*)(s + 4); o = pack8(a, b); }
            *(u32x4*)(kb + (size_t)row * 256 + k8) = o;
        }
    }
    {
        unsigned char* pu = F.ws + WS_PU;
        for (size_t i = (size_t)F.bid * 512 + F.tid; i < (size_t)NEXP * 64; i += (size_t)F.G * 512) {
            const float* src = F.peer_u + i * 32;
            u32x16 pk;
#pragma unroll
            for (int k = 0; k < 8; ++k) { const f32x4 a = *(const f32x4*)(src + k * 4) * 96.0f; pk[2 * k] = cvt_pk_bf16(a[0], a[1]); pk[2 * k + 1] = cvt_pk_bf16(a[2], a[3]); }
            const u32x6 p6 = __builtin_amdgcn_cvt_scalef32_pk32_fp6_bf16(__builtin_bit_cast(bf16x32, pk), 1.0f);
            unsigned char* dst = pu + i * 24;
            *(u32x2*)dst = (u32x2){p6[0], p6[1]}; *(u32x2*)(dst + 8) = (u32x2){p6[2], p6[3]}; *(u32x2*)(dst + 16) = (u32x2){p6[4], p6[5]};
        }
        unsigned char* pv = F.ws + WS_PV;
        for (int it = gw; it < (NEXP / 64) * 128; it += NGW) {
            const int e = (it >> 7) * 64 + F.lane, ch = it & 127;
            u32x4 ov;
#pragma unroll
            for (int k = 0; k < 4; ++k) { const f32x4 c = *(const f32x4*)(F.peer_v + (size_t)e * DM + ch * 16 + k * 4) * 4.0f;
                int wv = __builtin_amdgcn_cvt_pk_fp8_f32(c[0], c[1], 0, false); wv = __builtin_amdgcn_cvt_pk_fp8_f32(c[2], c[3], wv, true); ov[k] = (unsigned)wv; }
            *(u32x2*)(pv + ((size_t)(2 * ch) * NEXP + e) * 8) = (u32x2){ov[0], ov[1]};
            *(u32x2*)(pv + ((size_t)(2 * ch + 1) * NEXP + e) * 8) = (u32x2){ov[2], ov[3]};
        }
    }
    {
        __syncthreads();
        float* cact = (float*)(F.lds + 131072);
        float* red = (float*)F.lds;
        float* mp = (float*)(F.ws + WS_MODP);
        for (int it = F.bid; it < 48 * 4; it += F.G) {
            const int cb = it % 48, ds = it / 48, d0 = ds * 512;
            for (int i = F.tid; i < 8 * 512; i += 512) { const int b = i >> 9, d = i & 511; const float cv = F.c[b * DM + d0 + d]; cact[i] = cv * sigmoidf_(cv); }
            __syncthreads();
            f32x4 a[8];
#pragma unroll
            for (int b = 0; b < 8; ++b) a[b] = (f32x4){0.f, 0.f, 0.f, 0.f};
            const float* wp = F.w_ada + (size_t)(d0 + F.wave * 64) * 12288 + cb * 256 + F.lane * 4;
#pragma unroll 4
            for (int d = 0; d < 64; ++d) { const f32x4 w = *(const f32x4*)(wp + (size_t)d * 12288);
#pragma unroll
                for (int b = 0; b < 8; ++b) a[b] += w * cact[b * 512 + F.wave * 64 + d]; }
#pragma unroll
            for (int b = 0; b < 8; ++b)
#pragma unroll
                for (int j = 0; j < 4; ++j) red[(F.wave * 32 + b * 4 + j) * 64 + F.lane] = a[b][j];
            __syncthreads();
            for (int i = F.tid; i < 2048; i += 512) { const int v = i >> 6, l = i & 63; float s = 0.f;
#pragma unroll
                for (int w = 0; w < 8; ++w) s += red[(w * 32 + v) * 64 + l];
                mp[((size_t)ds * 8 + (v >> 2)) * 12288 + cb * 256 + l * 4 + (v & 3)] = s; }
            __syncthreads();
        }
    }
}

template <bool FIRST> __device__ __forceinline__ void phase_modnorm(Frame& F, const float* xin, const float* gain, int off_sh, int off_sc, bf16_t* dst) {
    const float* mp = (const float*)(F.ws + WS_MODP); float* mf = (float*)(F.ws + WS_MODF);
    if (FIRST) {
        for (int i = F.bid * 512 + F.tid; i < 8 * 12288; i += F.G * 512) {
            float s = F.b_ada[i % 12288];
#pragma unroll
            for (int k = 0; k < 4; ++k) s += mp[(size_t)k * 8 * 12288 + i];
            mf[i] = s; }
    }
    float* cA = (float*)F.lds; float* cB = cA + 2048;
    for (int ch = F.bid; ch < MTOK / 128; ch += F.G) {
        const int b = ch / 32;
        __syncthreads();
        for (int col = F.tid; col < 2048; col += 512) {
            float sc, sh;
            if (FIRST) { sc = F.b_ada[off_sc + col]; sh = F.b_ada[off_sh + col];
#pragma unroll
                for (int k = 0; k < 4; ++k) { sc += mp[((size_t)k * 8 + b) * 12288 + off_sc + col]; sh += mp[((size_t)k * 8 + b) * 12288 + off_sh + col]; } }
            else { sc = mf[b * 12288 + off_sc + col]; sh = mf[b * 12288 + off_sh + col]; }
            cA[col] = gain[col] * (1.f + sc); cB[col] = sh; }
        __syncthreads();
        for (int r = F.wave; r < 128; r += 8) {
            const size_t row = (size_t)ch * 128 + r;
            const float* xr = xin + row * 2048 + F.lane * 8;
            f32x4 v[4][2]; float ss = 0.f;
#pragma unroll
            for (int i = 0; i < 4; ++i) { v[i][0] = *(const f32x4*)(xr + i * 512); v[i][1] = *(const f32x4*)(xr + i * 512 + 4);
#pragma unroll
                for (int j = 0; j < 4; ++j) ss += v[i][0][j] * v[i][0][j] + v[i][1][j] * v[i][1][j]; }
            ss = wave_sum(ss);
            const float rinv = 1.0f / sqrtf(ss * (1.0f / 2048.0f) + EPS);
#pragma unroll
            for (int i = 0; i < 4; ++i) { const int col = i * 512 + F.lane * 8;
                const f32x4 a0 = *(const f32x4*)(cA + col), a1 = *(const f32x4*)(cA + col + 4), b0 = *(const f32x4*)(cB + col), b1 = *(const f32x4*)(cB + col + 4);
                *(u32x4*)(dst + row * 2048 + col) = pack8(v[i][0] * rinv * a0 + b0, v[i][1] * rinv * a1 + b1); }
        }
    }
}

__device__ __forceinline__ u32x2 pack8_fp8(f32x4 a, f32x4 b) {
    int w0 = __builtin_amdgcn_cvt_pk_fp8_f32(a[0], a[1], 0, false); w0 = __builtin_amdgcn_cvt_pk_fp8_f32(a[2], a[3], w0, true);
    int w1 = __builtin_amdgcn_cvt_pk_fp8_f32(b[0], b[1], 0, false); w1 = __builtin_amdgcn_cvt_pk_fp8_f32(b[2], b[3], w1, true);
    return (u32x2){(unsigned)w0, (unsigned)w1};
}
__device__ __forceinline__ void phase3_qknorm(Frame& F) {
    const bf16_t* q = (const bf16_t*)(F.ws + WS_QN); const bf16_t* k = (const bf16_t*)(F.ws + WS_KN); const bf16_t* v = (const bf16_t*)(F.ws + WS_V);
    unsigned char* q8 = F.ws + WS_Q8; unsigned char* k8 = F.ws + WS_K8; unsigned char* v8 = F.ws + WS_V8;
    const int gw = F.bid * 8 + F.wave, NGW = F.G * 8;
    for (int row = gw; row < MTOK; row += NGW) {
#pragma unroll
        for (int i = 0; i < 2; ++i) { const int ci = i * 64 + F.lane;
            f32x4 a, b; unpack8(*(const u32x4*)(q + (size_t)row * 1024 + ci * 8), a, b);
            float ss = a[0] * a[0] + a[1] * a[1] + a[2] * a[2] + a[3] * a[3] + b[0] * b[0] + b[1] * b[1] + b[2] * b[2] + b[3] * b[3];
            ss = row_sum16(ss);
            const float rinv = 1.0f / sqrtf(ss * (1.0f / 128.0f) + EPS);
            const float* gp = F.g_q + (ci & 15) * 8; const f32x4 g0 = *(const f32x4*)gp, g1 = *(const f32x4*)(gp + 4);
            *(u32x2*)(q8 + (size_t)row * 1024 + ci * 8) = pack8_fp8(a * rinv * g0, b * rinv * g1); }
        { const int ci = F.lane & 31; const bool isk = F.lane < 32;
            f32x4 a, b; unpack8(*(const u32x4*)((isk ? k : v) + (size_t)row * 256 + ci * 8), a, b);
            float ss = a[0] * a[0] + a[1] * a[1] + a[2] * a[2] + a[3] * a[3] + b[0] * b[0] + b[1] * b[1] + b[2] * b[2] + b[3] * b[3];
            ss = row_sum16(ss);
            const float rinv = isk ? 1.0f / sqrtf(ss * (1.0f / 128.0f) + EPS) : 1.0f;
            const float* gp = F.g_k + (ci & 15) * 8; f32x4 g0 = *(const f32x4*)gp, g1 = *(const f32x4*)(gp + 4);
            if (!isk) { g0 = (f32x4){1.f, 1.f, 1.f, 1.f}; g1 = g0; }
            *(u32x2*)((isk ? k8 : v8) + (size_t)row * 256 + ci * 8) = pack8_fp8(a * rinv * g0, b * rinv * g1); }
    }
}
template <int W> __device__ __forceinline__ void pooled_item(const bf16_t* pl, bf16_t* po, int row, int c8) {
    const int t = row & (SEQ - 1);
    f32x4 s0 = (f32x4){0.f, 0.f, 0.f, 0.f}, s1 = s0, x0 = s0, x1 = s0;
    u32x4 v[W];
#pragma unroll
    for (int j = 0; j < W; ++j) v[j] = *(const u32x4*)(pl + (size_t)(row - (j <= t ? j : 0)) * 1024 + c8);
#pragma unroll
    for (int j = 0; j < W; ++j) { f32x4 a, b; unpack8(v[j], a, b); if (j == 0) { x0 = a; x1 = b; } if (j <= t) { s0 += a; s1 += b; } }
    const float inv = 1.0f / (float)((t + 1 < W) ? t + 1 : W);
    *(u32x4*)(po + (size_t)row * 1024 + c8) = pack8(s0 * inv - x0, s1 * inv - x1);
}
__device__ __forceinline__ void phase3_pooled(Frame& F) {
    const bf16_t* pl = (const bf16_t*)(F.ws + WS_PL); bf16_t* po = (bf16_t*)(F.ws + WS_POOLED);
    const int gw = F.bid * 8 + F.wave, NGW = F.G * 8;
    for (int it = gw; it < (MTOK / 2) * 4; it += NGW) {
        const int g = it & 3, row = (it >> 2) * 2 + (F.lane >> 5), c8 = g * 256 + (F.lane & 31) * 8;
        if (g == 0) pooled_item<2>(pl, po, row, c8); else if (g == 1) pooled_item<4>(pl, po, row, c8); else if (g == 2) pooled_item<8>(pl, po, row, c8); else pooled_item<16>(pl, po, row, c8);
    }
}
typedef float f32x16 __attribute__((ext_vector_type(16)));
__device__ __forceinline__ int sel_code(float s, float smin, float scale) { const float c = (s - smin) * scale; return (int)fminf(fmaxf(c, 0.f), 65535.f); }
__device__ __forceinline__ void hist_find(const unsigned* hist, int lane, int K, int& bsel, int& above) {
    const u32x4 h = *(const u32x4*)(hist + lane * 4);
    const int S = (int)(h.x + h.y + h.z + h.w);
    int x = S;
    x += __builtin_amdgcn_update_dpp(0, x, 0x101, 0xF, 0xF, true);
    x += __builtin_amdgcn_update_dpp(0, x, 0x102, 0xF, 0xF, true);
    x += __builtin_amdgcn_update_dpp(0, x, 0x104, 0xF, 0xF, true);
    x += __builtin_amdgcn_update_dpp(0, x, 0x108, 0xF, 0xF, true);
    const int t1 = __builtin_amdgcn_readlane(x, 16), t2 = __builtin_amdgcn_readlane(x, 32), t3 = __builtin_amdgcn_readlane(x, 48);
    const int r = lane >> 4;
    x += (r == 0 ? t1 + t2 + t3 : (r == 1 ? t2 + t3 : (r == 2 ? t3 : 0)));
    const int sufn = x - S;
    const bool mine = (x >= K) && (sufn < K);
    int b = 0, ab = 0;
    { int c = sufn;
      if (c + (int)h.w >= K) { b = 3; ab = c; } else { c += (int)h.w;
      if (c + (int)h.z >= K) { b = 2; ab = c; } else { c += (int)h.z;
      if (c + (int)h.y >= K) { b = 1; ab = c; } else { c += (int)h.y; b = 0; ab = c; } } } }
    const unsigned long long m = __ballot(mine);
    const int src = m ? (int)__builtin_ctzll(m) : 0;
    bsel = __builtin_amdgcn_readlane(lane * 4 + b, src); above = __builtin_amdgcn_readlane(ab, src);
}
__device__ __forceinline__ void indexer_select(Frame& F, int b, int t, const float* rowbuf, unsigned* hist, float* eqv, int* eqi) {
    unsigned short* selrow = (unsigned short*)(F.ws + WS_SEL) + (size_t)(b * SEQ + t) * 256;
    int lane = F.lane; asm volatile("" : "+v"(lane));
    const int nch = t / 64 + 1, n4 = (nch + 3) >> 2;
    const f32x4* rb4 = (const f32x4*)rowbuf;
    float mn = __builtin_huge_valf(), mx = -__builtin_huge_valf();
    for (int c4 = 0; c4 < n4; ++c4) { const f32x4 v = rb4[c4 * 64 + lane];
#pragma unroll
        for (int k = 0; k < 4; ++k) { const bool valid = ((c4 * 4 + k) * 64 + lane) <= t; mn = valid ? fminf(mn, v[k]) : mn; mx = valid ? fmaxf(mx, v[k]) : mx; } }
    mx = xor16_max(row_max16(mx)); { const auto r = __builtin_amdgcn_permlane32_swap(__float_as_uint(mx), __float_as_uint(mx), false, false); mx = fmaxf(__uint_as_float(r[0]), __uint_as_float(r[1])); }
    mn = -mn; mn = xor16_max(row_max16(mn)); { const auto r = __builtin_amdgcn_permlane32_swap(__float_as_uint(mn), __float_as_uint(mn), false, false); mn = -fmaxf(__uint_as_float(r[0]), __uint_as_float(r[1])); }
    const float scale = (mx > mn) ? 65535.0f / (mx - mn) : 0.f;
    *(u32x4*)(hist + lane * 4) = (u32x4){0u, 0u, 0u, 0u};
    for (int c4 = 0; c4 < n4; ++c4) { const f32x4 v = rb4[c4 * 64 + lane];
#pragma unroll
        for (int k = 0; k < 4; ++k) { const bool valid = ((c4 * 4 + k) * 64 + lane) <= t; if (valid) atomicAdd(&hist[sel_code(v[k], mn, scale) >> 8], 1u); } }
    int b1, above1; hist_find(hist, lane, KSEL, b1, above1);
    *(u32x4*)(hist + lane * 4) = (u32x4){0u, 0u, 0u, 0u};
    for (int c4 = 0; c4 < n4; ++c4) { const f32x4 v = rb4[c4 * 64 + lane];
#pragma unroll
        for (int k = 0; k < 4; ++k) { const bool valid = ((c4 * 4 + k) * 64 + lane) <= t; const int code = sel_code(v[k], mn, scale); if (valid && (code >> 8) == b1) atomicAdd(&hist[code & 255], 1u); } }
    int b2, above2; hist_find(hist, lane, KSEL - above1, b2, above2);
    const int T16 = (b1 << 8) | b2, need = KSEL - above1 - above2, ceq = (int)hist[b2];
    const unsigned long long lt_mask = (1ull << lane) - 1ull;
    const bool exact = (ceq != need) && (ceq <= 64);
    if (exact) {
        int pos = 0;
        for (int c = 0; c < nch; ++c) { const float sv = rowbuf[((c >> 2) * 64 + lane) * 4 + (c & 3)]; const int idx = c * 64 + lane;
            const bool eq = (idx <= t) && (sel_code(sv, mn, scale) == T16);
            const unsigned long long m = __ballot(eq);
            if (m) { const int p = pos + __popcll(m & lt_mask); if (eq) { eqv[p] = sv; eqi[p] = idx; } pos += __popcll(m); } }
    }
    int pos = 0, eqseen = 0;
    for (int c = 0; c < nch; ++c) {
        const float sv = rowbuf[((c >> 2) * 64 + lane) * 4 + (c & 3)]; const int idx = c * 64 + lane;
        const int code = sel_code(sv, mn, scale); const bool valid = idx <= t;
        const bool gt = valid && code > T16, eq = valid && code == T16;
        const unsigned long long meq = __ballot(eq);
        bool take = gt;
        if (meq) {
            if (ceq == need) take = take || eq;
            else if (exact) { int rank = 0; for (int m = 0; m < ceq; ++m) { const float ov = eqv[m]; const int oi = eqi[m]; rank += (ov > sv || (ov == sv && oi < idx)) ? 1 : 0; } take = take || (eq && rank < need); }
            else { const int er = eqseen + __popcll(meq & lt_mask); take = take || (eq && er < need); eqseen += __popcll(meq); }
        }
        const unsigned long long mt = __ballot(take);
        const int p = pos + __popcll(mt & lt_mask);
        if (take && p < KSEL) selrow[p] = (unsigned short)idx;
        pos += __popcll(mt);
    }
}
__device__ __forceinline__ void indexer_tile(Frame& F, int b, int t0) {
    const bf16_t* iq = (const bf16_t*)(F.ws + WS_IQ); const bf16_t* ik = (const bf16_t*)(F.ws + WS_IK); const float* iw = (const float*)(F.ws + WS_IW);
    int lane = F.lane; asm volatile("" : "+v"(lane));
    const int w = F.wave;
    if (t0 < KSEL) {
        const int t = t0 + w; unsigned short* selrow = (unsigned short*)(F.ws + WS_SEL) + (size_t)(b * SEQ + t) * 256;
#pragma unroll
        for (int p = 0; p < 4; ++p) { const int j = p * 64 + lane; selrow[j] = (unsigned short)(j <= t ? j : 0xFFFF); }
        return;
    }
    float* rowbuf = (float*)F.lds;
    unsigned char* stage = F.lds + 131072;
    const int p = w & 3, kh = w >> 2, hi = lane >> 5, r = lane & 31;
    const size_t qrow = (size_t)b * SEQ + t0 + 2 * p + (r >> 4);
    bf16x8 a[4];
#pragma unroll
    for (int ks = 0; ks < 4; ++ks) a[ks] = *(const bf16x8*)(iq + qrow * 1024 + (r & 15) * 64 + ks * 16 + 8 * hi);
    float wq[2][8];
#pragma unroll
    for (int q = 0; q < 2; ++q)
#pragma unroll
        for (int i = 0; i < 8; ++i) wq[q][i] = iw[((size_t)b * SEQ + t0 + 2 * p + q) * 16 + (i & 3) + 8 * ((i >> 2) & 1) + 4 * hi];
    const int nchunks = (t0 + 7) / 64 + 1;
    const unsigned char* gsrc = (const unsigned char*)(ik + (size_t)b * SEQ * 64) + F.tid * 16;
    const int skey = F.tid >> 3, sc16 = F.tid & 7, soff = skey * 128 + ((sc16 ^ (skey & 7)) << 4);
    u32x4 s0 = *(const u32x4*)gsrc, s1 = s0, s2 = s0, s3 = s0;
    if (1 < nchunks) s1 = *(const u32x4*)(gsrc + (size_t)1 * 8192);
    if (2 < nchunks) s2 = *(const u32x4*)(gsrc + (size_t)2 * 8192);
    if (3 < nchunks) s3 = *(const u32x4*)(gsrc + (size_t)3 * 8192);
    __syncthreads();
#define IDX_STEP(SR, cc) do { const int c = (cc); unsigned char* sb = stage + (c & 1) * 8192; \
        *(u32x4*)(sb + soff) = SR; \
        __syncthreads(); \
        if (c + 4 < nchunks) SR = *(const u32x4*)(gsrc + (size_t)(c + 4) * 8192); \
        f32x16 d; _Pragma("unroll") for (int i = 0; i < 16; ++i) d[i] = 0.f; \
        const int key = kh * 32 + r; \
        _Pragma("unroll") for (int ks = 0; ks < 4; ++ks) { const bf16x8 bf = *(const bf16x8*)(sb + key * 128 + (((ks * 2 + hi) ^ (key & 7)) << 4)); \
            d = __builtin_amdgcn_mfma_f32_32x32x16_bf16(a[ks], bf, d, 0, 0, 0); } \
        float s0_ = 0.f, s1_ = 0.f; \
        _Pragma("unroll") for (int i = 0; i < 8; ++i) { s0_ += wq[0][i] * fmaxf(d[i], 0.f); s1_ += wq[1][i] * fmaxf(d[8 + i], 0.f); } \
        const float sc = swap32_pair(s0_, s1_); \
        rowbuf[(2 * p + hi) * 4096 + ((c >> 2) * 64 + key) * 4 + (c & 3)] = sc; } while (0)
    for (int c4 = 0; c4 < nchunks; c4 += 4) {
        IDX_STEP(s0, c4);
        if (c4 + 1 < nchunks) IDX_STEP(s1, c4 + 1);
        if (c4 + 2 < nchunks) IDX_STEP(s2, c4 + 2);
        if (c4 + 3 < nchunks) IDX_STEP(s3, c4 + 3);
    }
#if PROBE_IDX == 1
    __syncthreads(); s0 = *(const u32x4*)gsrc; s1 = s0; s2 = s0; s3 = s0;
    if (1 < nchunks) s1 = *(const u32x4*)(gsrc + (size_t)1 * 8192);
    if (2 < nchunks) s2 = *(const u32x4*)(gsrc + (size_t)2 * 8192);
    if (3 < nchunks) s3 = *(const u32x4*)(gsrc + (size_t)3 * 8192);
    for (int c4 = 0; c4 < nchunks; c4 += 4) {
        IDX_STEP(s0, c4);
        if (c4 + 1 < nchunks) IDX_STEP(s1, c4 + 1);
        if (c4 + 2 < nchunks) IDX_STEP(s2, c4 + 2);
        if (c4 + 3 < nchunks) IDX_STEP(s3, c4 + 3);
    }
#endif
#undef IDX_STEP
    __syncthreads();
    indexer_select(F, b, t0 + w, rowbuf + w * 4096, (unsigned*)(F.lds + 147456) + w * 256, (float*)(F.lds + 155648) + w * 64, (int*)(F.lds + 155648 + 2048) + w * 64);
#if PROBE_IDX == 2
    indexer_select(F, b, t0 + w, rowbuf + w * 4096, (unsigned*)(F.lds + 147456) + w * 256, (float*)(F.lds + 155648) + w * 64, (int*)(F.lds + 155648 + 2048) + w * 64);
#endif
}
__device__ __forceinline__ void phase3_indexer(Frame& F) {
    const int nit = BATCH * (SEQ / 8);
    for (int k = 0;; ++k) {
        const int l = k * F.G + ((k & 1) ? (F.G - 1 - F.bid) : F.bid);
        if (l >= nit) { if (k * F.G >= nit) break; else continue; }
        const int qb = (SEQ / 8 - 1) - (l >> 3), b = l & 7;
        indexer_tile(F, b, qb * 8);
    }
}

__device__ const unsigned char g_bucket[128] = {0, 1, 2, 3, 4, 5, 6, 7, 8, 9, 10, 11, 12, 13, 14, 15, 16, 16, 16, 17, 17, 18, 18, 18, 19, 19, 19, 20, 20, 20, 20, 21, 21, 21, 21, 22, 22, 22, 22, 22, 23, 23, 23, 23, 23, 23, 24, 24, 24, 24, 24, 24, 25, 25, 25, 25, 25, 25, 25, 26, 26, 26, 26, 26, 26, 26, 26, 27, 27, 27, 27, 27, 27, 27, 27, 27, 27, 28, 28, 28, 28, 28, 28, 28, 28, 28, 28, 29, 29, 29, 29, 29, 29, 29, 29, 29, 29, 29, 29, 30, 30, 30, 30, 30, 30, 30, 30, 30, 30, 30, 30, 30, 30, 31, 31, 31, 31, 31, 31, 31, 31, 31, 31, 31, 31, 31, 31, 31};
__device__ __forceinline__ void phase4_attention(Frame& F) {
    const unsigned char* q8 = F.ws + WS_Q8; const unsigned char* k8 = F.ws + WS_K8; const unsigned char* v8 = F.ws + WS_V8;
    const unsigned short* sel = (const unsigned short*)(F.ws + WS_SEL); bf16_t* ao = (bf16_t*)(F.ws + WS_ATTN);
    float* btab = (float*)F.lds;
    __syncthreads();
    for (int i = F.tid; i < 256; i += 512) btab[i] = F.rel_bias[i];
    __syncthreads();
    float* Pl = (float*)(F.lds + 4096 + F.wave * 12288); int* idl = (int*)(Pl + 2048); float* psl = (float*)(idl + 256);
    const bool xmap = (F.G % 8) == 0;
    const int gw = xmap ? (F.bid / 8) * 8 + F.wave : F.bid * 8 + F.wave, NGW = xmap ? F.G : F.G * 8, nrows = xmap ? SEQ : MTOK;
    for (int rr = gw; rr < nrows; rr += NGW) {
        int lane = F.lane; asm volatile("" : "+v"(lane));
        const int row = xmap ? (F.bid & 7) * SEQ + rr : rr;
        const int b = row / SEQ, t = row % SEQ, r = lane & 31, hi = lane >> 5;
#pragma unroll
        for (int p = 0; p < 4; ++p) { idl[p * 64 + lane] = (int)sel[(size_t)row * 256 + p * 64 + lane]; }
        long a0[8], a1[8];
        { u32x4 qa[4];
#pragma unroll
          for (int i = 0; i < 4; ++i) qa[i] = (r < 8) ? *(const u32x4*)(q8 + (size_t)row * 1024 + r * 128 + hi * 64 + i * 16) : (u32x4){0u, 0u, 0u, 0u};
#pragma unroll
          for (int ks = 0; ks < 8; ++ks) { const unsigned lo = qa[ks >> 1][(ks & 1) * 2], hh = qa[ks >> 1][(ks & 1) * 2 + 1]; const long v = (long)(((unsigned long long)hh << 32) | lo);
              a0[ks] = (r < 4) ? v : 0l; a1[ks] = (r >= 4) ? v : 0l; } }
        f32x4 psum = (f32x4){0.f, 0.f, 0.f, 0.f};
#define AT_LOADK(buf, kb) do { const int key_ = idl[(kb) * 32 + r]; const int kc_ = key_ <= t ? key_ : 0; const unsigned char* kr_ = k8 + ((size_t)b * SEQ + kc_) * 256 + hi * 64; \
            _Pragma("unroll") for (int i = 0; i < 4; ++i) { buf[i] = *(const u32x4*)(kr_ + i * 16); buf[4 + i] = *(const u32x4*)(kr_ + 128 + i * 16); } } while (0)
#define AT_QK(buf, kb) do { const int key_ = idl[(kb) * 32 + r]; const bool valid_ = key_ <= t; const int kc_ = valid_ ? key_ : 0; \
            f32x16 d; _Pragma("unroll") for (int i = 0; i < 16; ++i) d[i] = 0.f; \
            _Pragma("unroll") for (int ks = 0; ks < 8; ++ks) { const long bv_ = (long)(((unsigned long long)buf[ks >> 1][(ks & 1) * 2 + 1] << 32) | buf[ks >> 1][(ks & 1) * 2]); d = __builtin_amdgcn_mfma_f32_32x32x16_fp8_fp8(a0[ks], bv_, d, 0, 0, 0); } \
            _Pragma("unroll") for (int ks = 0; ks < 8; ++ks) { const long bv_ = (long)(((unsigned long long)buf[4 + (ks >> 1)][(ks & 1) * 2 + 1] << 32) | buf[4 + (ks >> 1)][(ks & 1) * 2]); d = __builtin_amdgcn_mfma_f32_32x32x16_fp8_fp8(a1[ks], bv_, d, 0, 0, 0); } \
            const int dist_ = t - kc_; const int bkt_ = dist_ < 128 ? (int)g_bucket[dist_] : 31; \
            const f32x4 bias_ = *(const f32x4*)(btab + bkt_ * 8 + 4 * hi); f32x4 e_; \
            _Pragma("unroll") for (int i = 0; i < 4; ++i) e_[i] = valid_ ? __expf(d[i] * 0.08838834764831845f + bias_[i]) : 0.f; \
            psum += e_; *(f32x4*)(Pl + ((kb) * 32 + r) * 8 + 4 * hi) = e_; } while (0)
        {
            u32x4 kA[8], kB[8];
            AT_LOADK(kA, 0);
#pragma unroll 1
            for (int kb = 0; kb < 8; kb += 2) {
                AT_LOADK(kB, kb + 1);
                AT_QK(kA, kb);
                if (kb + 2 < 8) AT_LOADK(kA, kb + 2);
                AT_QK(kB, kb + 1);
            }
        }
#undef AT_LOADK
#undef AT_QK
#pragma unroll
        for (int i = 0; i < 4; ++i) psum[i] = xor16_sum(row_sum16(psum[i]));
        if (r == 0) *(f32x4*)(psl + 4 * hi) = psum;
        const int ks = lane >> 4, g = (lane >> 3) & 1, dc = lane & 7;
        float acc[4][16];
#pragma unroll
        for (int h = 0; h < 4; ++h)
#pragma unroll
            for (int j = 0; j < 16; ++j) acc[h][j] = 0.f;
#define AT_LOADV(buf, it0) do { _Pragma("unroll") for (int u = 0; u < 4; ++u) { const int key_ = idl[((it0) + u) * 4 + ks]; const int kc_ = key_ <= t ? key_ : 0; \
            buf[u] = *(const u32x4*)(v8 + ((size_t)b * SEQ + kc_) * 256 + g * 128 + dc * 16); } } while (0)
#define AT_PV(buf, it0) do { _Pragma("unroll") for (int u = 0; u < 4; ++u) { const int j_ = ((it0) + u) * 4 + ks; const u32x4 w = buf[u]; \
            const f32x4 p = *(const f32x4*)(Pl + j_ * 8 + 4 * g); \
            _Pragma("unroll") for (int dd = 0; dd < 4; ++dd) { const f32x2 lo = __builtin_amdgcn_cvt_pk_f32_fp8((int)w[dd], false), hh_ = __builtin_amdgcn_cvt_pk_f32_fp8((int)w[dd], true); \
                _Pragma("unroll") for (int h = 0; h < 4; ++h) { acc[h][4 * dd] += p[h] * lo.x; acc[h][4 * dd + 1] += p[h] * lo.y; acc[h][4 * dd + 2] += p[h] * hh_.x; acc[h][4 * dd + 3] += p[h] * hh_.y; } } } } while (0)
        {
            u32x4 vA[4], vB[4];
            AT_LOADV(vA, 0);
#pragma unroll 1
            for (int it0 = 0; it0 < 64; it0 += 8) {
                AT_LOADV(vB, it0 + 4);
                AT_PV(vA, it0);
                if (it0 + 8 < 64) AT_LOADV(vA, it0 + 8);
                AT_PV(vB, it0 + 4);
            }
        }
#undef AT_LOADV
#undef AT_PV
#pragma unroll
        for (int h = 0; h < 4; ++h)
#pragma unroll
            for (int j = 0; j < 16; ++j) acc[h][j] = xor32_sum(xor16_sum(acc[h][j]));
#pragma unroll
        for (int h = 0; h < 4; ++h) if (h == ks) { const float inv = 1.0f / psl[4 * g + h];
            bf16_t* op = ao + (size_t)row * 1024 + (4 * g + h) * 128 + dc * 16;
            *(u32x4*)op = pack8((f32x4){acc[h][0], acc[h][1], acc[h][2], acc[h][3]} * inv, (f32x4){acc[h][4], acc[h][5], acc[h][6], acc[h][7]} * inv);
            *(u32x4*)(op + 8) = pack8((f32x4){acc[h][8], acc[h][9], acc[h][10], acc[h][11]} * inv, (f32x4){acc[h][12], acc[h][13], acc[h][14], acc[h][15]} * inv); }
    }
}

__device__ __forceinline__ float dot16f8(u32x4 w, const float* h) {
    float s = 0.f;
#pragma unroll
    for (int d = 0; d < 4; ++d) { const f32x2 lo = __builtin_amdgcn_cvt_pk_f32_fp8((int)w[d], false), hi = __builtin_amdgcn_cvt_pk_f32_fp8((int)w[d], true);
        s += lo.x * h[4 * d] + lo.y * h[4 * d + 1] + hi.x * h[4 * d + 2] + hi.y * h[4 * d + 3]; }
    return s;
}
__device__ __forceinline__ void fma16f8(u32x4 w, float cf, float* acc) {
#pragma unroll
    for (int d = 0; d < 4; ++d) { const f32x2 lo = __builtin_amdgcn_cvt_pk_f32_fp8((int)w[d], false), hi = __builtin_amdgcn_cvt_pk_f32_fp8((int)w[d], true);
        acc[4 * d] += cf * lo.x; acc[4 * d + 1] += cf * lo.y; acc[4 * d + 2] += cf * hi.x; acc[4 * d + 3] += cf * hi.y; }
}
__device__ __forceinline__ float gelu_erf(float x) { return 0.5f * x * (1.0f + erff(x * 0.70710678118654752f)); }
__device__ __forceinline__ void ce_k(unsigned& a, unsigned& b) { const unsigned hi = a > b ? a : b, lo = a > b ? b : a; a = hi; b = lo; }
__device__ __forceinline__ void ce_kp(unsigned& ka, unsigned& pa, unsigned& kb, unsigned& pb) { const bool sw = kb > ka; const unsigned k0 = sw ? kb : ka, k1 = sw ? ka : kb, p0 = sw ? pb : pa, p1 = sw ? pa : pb; ka = k0; kb = k1; pa = p0; pb = p1; }
__device__ __forceinline__ void bmerge16(unsigned (&x)[16]) {
#pragma unroll
    for (int jj = 0; jj < 4; ++jj) { const int j = 8 >> jj;
#pragma unroll
        for (int i = 0; i < 16; ++i) { const int l = i ^ j; if (l > i) ce_k(x[i], x[l]); }
        __builtin_amdgcn_sched_barrier(0); }
}
__device__ __forceinline__ void bmerge16p(unsigned (&x)[16], unsigned (&p)[16]) {
#pragma unroll
    for (int jj = 0; jj < 4; ++jj) { const int j = 8 >> jj;
#pragma unroll
        for (int i = 0; i < 16; ++i) { const int l = i ^ j; if (l > i) ce_kp(x[i], p[i], x[l], p[l]); }
        __builtin_amdgcn_sched_barrier(0); }
}
__device__ __forceinline__ void bsort16(unsigned (&x)[16]) {
#pragma unroll
    for (int kk = 1; kk <= 4; ++kk) { const int k = 1 << kk;
#pragma unroll
        for (int jj = 0; jj < 4; ++jj) { const int j = (k >> 1) >> jj;
            if (j > 0) {
#pragma unroll
                for (int i = 0; i < 16; ++i) { const int l = i ^ j; if (l > i) { if ((i & k) == 0) ce_k(x[i], x[l]); else ce_k(x[l], x[i]); } }
                __builtin_amdgcn_sched_barrier(0); } } }
}
__device__ __forceinline__ void bsort16p(unsigned (&x)[16], unsigned (&p)[16]) {
#pragma unroll
    for (int kk = 1; kk <= 4; ++kk) { const int k = 1 << kk;
#pragma unroll
        for (int jj = 0; jj < 4; ++jj) { const int j = (k >> 1) >> jj;
            if (j > 0) {
#pragma unroll
                for (int i = 0; i < 16; ++i) { const int l = i ^ j; if (l > i) { if ((i & k) == 0) ce_kp(x[i], p[i], x[l], p[l]); else ce_kp(x[l], p[l], x[i], p[i]); } }
                __builtin_amdgcn_sched_barrier(0); } } }
}
__device__ __forceinline__ void top16_row(const unsigned char* rowp, unsigned (&t)[16]) {
#pragma unroll
    for (int i = 0; i < 16; ++i) t[i] = 0u;
#pragma unroll 1
    for (int g = 0; g < 8; ++g) {
        unsigned w[8];
#pragma unroll
        for (int q = 0; q < 4; ++q) { const u32x2 v = *(const u32x2*)(rowp + g * 32 + q * 8); w[2 * q] = v.x; w[2 * q + 1] = v.y; }
        unsigned sk[16];
#pragma unroll
        for (int d = 0; d < 8; ++d) {
            const unsigned lo = w[d] << 16, hi = w[d];
            const unsigned xl = lo ^ ((unsigned)((int)lo >> 31) | 0x80000000u), xh = hi ^ ((unsigned)((int)hi >> 31) | 0x80000000u);
            sk[2 * d] = ((xl >> 9) & 0xFFFFFF80u) | (unsigned)(127 - (g * 16 + 2 * d));
            sk[2 * d + 1] = ((xh >> 9) & 0xFFFFFF80u) | (unsigned)(127 - (g * 16 + 2 * d + 1)); }
        bsort16(sk);
#pragma unroll
        for (int i = 0; i < 16; ++i) t[i] = t[i] > sk[15 - i] ? t[i] : sk[15 - i];
        bmerge16(t);
    }
}
__device__ __forceinline__ float key_val(unsigned key) { const unsigned y = (key << 9) & 0xFFFF0000u; return __uint_as_float((y ^ (~(unsigned)((int)y >> 31) | 0x80000000u)) & 0xFFFF0000u); }
__device__ __forceinline__ unsigned sum_key(float s, int c) { const unsigned u = __float_as_uint(s); return ((u ^ ((unsigned)((int)u >> 31) | 0x80000000u)) & ~63u) | (unsigned)(63 - c); }
__device__ __forceinline__ float sum_val(unsigned k) { const unsigned y = k & ~63u; return __uint_as_float(y ^ (~(unsigned)((int)y >> 31) | 0x80000000u)); }
typedef __bf16 bf2_t __attribute__((ext_vector_type(2)));
__device__ __forceinline__ float dot2_bf(unsigned a, unsigned b, float c) { return __builtin_amdgcn_fdot2_f32_bf16(__builtin_bit_cast(bf2_t, a), __builtin_bit_cast(bf2_t, b), c, false); }
__device__ __forceinline__ float dot32_f6b(u32x4 wa, u32x2 wb, u32x4 h0, u32x4 h1, u32x4 h2, u32x4 h3) {
    const bf16x32 dec = __builtin_amdgcn_cvt_scalef32_pk32_bf16_fp6((u32x6){wa.x, wa.y, wa.z, wa.w, wb.x, wb.y}, 1.0f);
    const u32x16 ud = __builtin_bit_cast(u32x16, dec);
    float acc = 0.f;
    acc = dot2_bf(ud.s0, h0.x, acc); acc = dot2_bf(ud.s1, h0.y, acc); acc = dot2_bf(ud.s2, h0.z, acc); acc = dot2_bf(ud.s3, h0.w, acc);
    acc = dot2_bf(ud.s4, h1.x, acc); acc = dot2_bf(ud.s5, h1.y, acc); acc = dot2_bf(ud.s6, h1.z, acc); acc = dot2_bf(ud.s7, h1.w, acc);
    acc = dot2_bf(ud.s8, h2.x, acc); acc = dot2_bf(ud.s9, h2.y, acc); acc = dot2_bf(ud.sa, h2.z, acc); acc = dot2_bf(ud.sb, h2.w, acc);
    acc = dot2_bf(ud.sc, h3.x, acc); acc = dot2_bf(ud.sd, h3.y, acc); acc = dot2_bf(ud.se, h3.z, acc); acc = dot2_bf(ud.sf, h3.w, acc);
    return acc;
}
__device__ const unsigned char g_cab[64] = {0, 1, 2, 3, 4, 5, 6, 7, 8, 9, 10, 11, 12, 13, 14, 15, 16, 17, 18, 19, 20, 21, 22, 23, 32, 33, 34, 35, 36, 48, 49, 50, 51, 64, 65, 66, 80, 81, 96, 97, 112, 113, 128, 144, 160, 176, 192, 208, 224, 240, 0, 0, 0, 0, 0, 0, 0, 0, 0, 0, 0, 0, 0, 0};
__device__ __forceinline__ void phase10_peer(Frame& F) {
    const bf16_t* sub = (const bf16_t*)(F.ws + WS_SUB); const bf16_t* h2 = (const bf16_t*)(F.ws + WS_H2);
    const unsigned char* pu = F.ws + WS_PU; unsigned* pairs = (unsigned*)(F.ws + WS_PAIRS);
    const int gw = F.bid * 8 + F.wave, NGW = F.G * 8;
    unsigned char* wb = F.lds + F.wave * 19200;
    unsigned char* h2b = wb; unsigned short* gl16 = (unsigned short*)(wb + 16896); unsigned* hist = (unsigned*)(wb + 18944); unsigned* base = hist + 32;
    unsigned* tmp = (unsigned*)wb;
    unsigned* wls0 = (unsigned*)(F.ws + WS_WLS) + (size_t)gw * 1024;
    const int ntok = (MTOK - gw + NGW - 1) / NGW;
    constexpr int CA[50] = {0,0,0,0,0,0,0,0,0,0,0,0,0,0,0,0, 1,1,1,1,1,1,1,1, 2,2,2,2,2, 3,3,3,3, 4,4,4, 5,5, 6,6, 7,7, 8,9,10,11,12,13,14,15};
    constexpr int CB[50] = {0,1,2,3,4,5,6,7,8,9,10,11,12,13,14,15, 0,1,2,3,4,5,6,7, 0,1,2,3,4, 0,1,2,3, 0,1,2, 0,1, 0,1, 0,1, 0,0,0,0,0,0,0,0};
    for (int p0 = 0; p0 < ntok; p0 += 8) {
        int lane = F.lane; asm volatile("" : "+v"(lane));
        const int nt = (ntok - p0) < 8 ? (ntok - p0) : 8;
        {
            u32x4 st[16];
#define SEL_LOAD(half) do { asm volatile("" : "+v"(lane)); const int srow_l = lane >> 4, scol = lane & 15; _Pragma("unroll") for (int it = 0; it < 16; ++it) { const int r_ = it * 4 + srow_l; int ti_ = r_ >> 3; ti_ = ti_ < nt ? ti_ : nt - 1; \
                st[it] = *(const u32x4*)(sub + (size_t)(gw + (p0 + ti_) * NGW) * 2048 + (r_ & 7) * 256 + (half) * 128 + scol * 8); } } while (0)
#define SEL_STORE() do { const int srow_l = lane >> 4, scol = lane & 15; _Pragma("unroll") for (int it = 0; it < 16; ++it) { unsigned char* d_ = wb + (it * 4 + srow_l) * 264 + scol * 16; \
                *(u32x2*)d_ = (u32x2){st[it].x, st[it].y}; *(u32x2*)(d_ + 8) = (u32x2){st[it].z, st[it].w}; } } while (0)
            unsigned tA[16], tB[16];
            SEL_LOAD(0); SEL_STORE();
            __builtin_amdgcn_sched_barrier(0);
            top16_row(wb + lane * 264, tA);
            __builtin_amdgcn_sched_barrier(0);
            asm volatile("" : "+v"(tA[0]), "+v"(tA[1]), "+v"(tA[2]), "+v"(tA[3]), "+v"(tA[4]), "+v"(tA[5]), "+v"(tA[6]), "+v"(tA[7]), "+v"(tA[8]), "+v"(tA[9]), "+v"(tA[10]), "+v"(tA[11]), "+v"(tA[12]), "+v"(tA[13]), "+v"(tA[14]), "+v"(tA[15]) :: "memory");
            SEL_LOAD(1); SEL_STORE();
            __builtin_amdgcn_sched_barrier(0);
            top16_row(wb + lane * 264, tB);
            __builtin_amdgcn_sched_barrier(0);
#undef SEL_LOAD
#undef SEL_STORE
            float vA[16], vB[16];
            { unsigned pa[4] = {0u, 0u, 0u, 0u}, pb[4] = {0u, 0u, 0u, 0u};
#pragma unroll
              for (int i = 0; i < 16; ++i) { vA[i] = key_val(tA[i]); vB[i] = key_val(tB[i]); pa[i >> 2] |= (127u - (tA[i] & 127u)) << (8 * (i & 3)); pb[i >> 2] |= (127u - (tB[i] & 127u)) << (8 * (i & 3)); }
              unsigned char* rp = wb + lane * 264;
              *(u32x2*)rp = (u32x2){pa[0], pa[1]}; *(u32x2*)(rp + 8) = (u32x2){pa[2], pa[3]}; *(u32x2*)(rp + 16) = (u32x2){pb[0], pb[1]}; *(u32x2*)(rp + 24) = (u32x2){pb[2], pb[3]}; }
            unsigned tk[16];
#pragma unroll
            for (int c = 0; c < 16; ++c) tk[c] = sum_key(vA[CA[c]] + vB[CB[c]], c);
            bsort16(tk);
#pragma unroll
            for (int grp = 1; grp < 3; ++grp) {
                unsigned sk[16];
#pragma unroll
                for (int e = 0; e < 16; ++e) { const int c = grp * 16 + e; sk[e] = sum_key(vA[CA[c]] + vB[CB[c]], c); }
                bsort16(sk);
#pragma unroll
                for (int i = 0; i < 16; ++i) tk[i] = tk[i] > sk[15 - i] ? tk[i] : sk[15 - i];
                bmerge16(tk);
            }
#pragma unroll
            for (int c = 48; c < 50; ++c) { unsigned k = sum_key(vA[CA[c]] + vB[CB[c]], c);
#pragma unroll
                for (int i = 0; i < 16; ++i) ce_k(tk[i], k); }
            const float s0 = sum_val(tk[0]); float ev[16], esum = 0.f;
#pragma unroll
            for (int r = 0; r < 16; ++r) { ev[r] = __expf(sum_val(tk[r]) - s0); esum += ev[r]; }
            const float einv = 1.0f / esum;
            unsigned eid[16];
            { const unsigned char* rp = wb + lane * 264;
#pragma unroll
              for (int r = 0; r < 16; ++r) { const unsigned cab = g_cab[63u - (tk[r] & 63u)]; eid[r] = (unsigned)rp[cab >> 4] * 128u + (unsigned)rp[16 + (cab & 15u)]; } }
            if ((lane >> 3) < nt) {
#pragma unroll
                for (int r = 0; r < 16; ++r) { const int e = lane * 16 + r; tmp[e] = ((unsigned)e << 14) | eid[r]; gl16[e] = (unsigned short)(cvt_pk_bf16(ev[r] * einv, 0.f) & 0xffffu); } }
        }
        asm volatile("" : "+v"(lane));
#pragma unroll 1
        for (int grp = 0; grp < 2; ++grp) {
            const int ng = nt - grp * 4; const int ne = (ng <= 0 ? 0 : (ng < 4 ? ng : 4)) * 128;
            if (ne == 0) break;
            unsigned* wls = wls0 + grp * 512;
            if (lane < 32) hist[lane] = 0u;
            unsigned ent[8]; unsigned rk[8];
#pragma unroll
            for (int q = 0; q < 8; ++q) { const int e = q * 64 + lane; ent[q] = (e < ne) ? tmp[grp * 512 + e] : 0u; rk[q] = (e < ne) ? atomicAdd(&hist[(ent[q] & 0x3FFFu) >> 9], 1u) : 0u; }
            { int hv = lane < 32 ? (int)hist[lane] : 0; int x = hv;
              x += __builtin_amdgcn_update_dpp(0, x, 0x111, 0xF, 0xF, true); x += __builtin_amdgcn_update_dpp(0, x, 0x112, 0xF, 0xF, true);
              x += __builtin_amdgcn_update_dpp(0, x, 0x114, 0xF, 0xF, true); x += __builtin_amdgcn_update_dpp(0, x, 0x118, 0xF, 0xF, true);
              const int t0 = __builtin_amdgcn_readlane(x, 15); if (lane >= 16) x += t0;
              if (lane < 32) base[lane] = (unsigned)(x - hv); }
#pragma unroll
            for (int q = 0; q < 8; ++q) { const int e = q * 64 + lane; if (e < ne) wls[base[(ent[q] & 0x3FFFu) >> 9] + rk[q]] = ent[q]; }
        }
        asm volatile("s_waitcnt vmcnt(0)" ::: "memory");
#pragma unroll 1
        for (int grp = 0; grp < 2; ++grp) {
            const int ng = nt - grp * 4; const int ngc = ng <= 0 ? 0 : (ng < 4 ? ng : 4), ne = ngc * 128;
            if (ne == 0) break;
            const unsigned* wls = wls0 + grp * 512;
            asm volatile("" : "+v"(lane));
#pragma unroll 1
            for (int i = 0; i < ngc; ++i) { const bf16_t* hr = h2 + (size_t)(gw + (p0 + grp * 4 + i) * NGW) * 2048 + lane * 32;
#pragma unroll
                for (int q = 0; q < 4; ++q) *(u32x4*)(h2b + i * 4096 + q * 1024 + lane * 16) = *(const u32x4*)(hr + q * 8); }
            unsigned entn = __hip_atomic_load(wls + lane, __ATOMIC_RELAXED, __HIP_MEMORY_SCOPE_AGENT);
#pragma unroll 1
            for (int c = 0; c < ne; c += 64) {
                const unsigned ent64 = entn;
                if (c + 64 < ne) entn = __hip_atomic_load(wls + c + 64 + lane, __ATOMIC_RELAXED, __HIP_MEMORY_SCOPE_AGENT);
#pragma unroll 1
                for (int i0 = 0; i0 < 64; i0 += 8) {
                    u32x4 wA[8]; u32x2 wB[8]; unsigned en[8];
#pragma unroll
                    for (int jj = 0; jj < 8; ++jj) { en[jj] = (unsigned)__builtin_amdgcn_readlane((int)ent64, i0 + jj); const unsigned char* ur = pu + (size_t)(en[jj] & 0x3FFFu) * 1536 + lane * 24;
                        const u32x2 t0 = *(const u32x2*)ur, t1 = *(const u32x2*)(ur + 8); wA[jj] = (u32x4){t0.x, t0.y, t1.x, t1.y}; wB[jj] = *(const u32x2*)(ur + 16); }
                    float pr[8];
#pragma unroll
                    for (int jj = 0; jj < 8; ++jj) { const unsigned char* hp = h2b + ((en[jj] >> 21) & 3u) * 4096 + lane * 16;
                        pr[jj] = dot32_f6b(wA[jj], wB[jj], *(const u32x4*)hp, *(const u32x4*)(hp + 1024), *(const u32x4*)(hp + 2048), *(const u32x4*)(hp + 3072)); __builtin_amdgcn_sched_barrier(0); }
#pragma unroll
                    for (int i = 0; i < 4; ++i) pr[i] = swap32_pair(pr[i], pr[i + 4]);
#pragma unroll
                    for (int i = 0; i < 2; ++i) pr[i] = swap16_pair(pr[i], pr[i + 2]);
                    const bool b3 = (lane & 8) != 0;
                    { const float snd = b3 ? pr[0] : pr[1], kp = b3 ? pr[1] : pr[0]; pr[0] = kp + dpp_f<DPP_ROR8>(snd); }
                    float tot = pr[0]; tot += dpp_f<DPP_XOR1>(tot); tot += dpp_f<DPP_XOR2>(tot); tot += dpp_f<DPP_HMIRROR>(tot);
                    const unsigned em = (unsigned)__shfl((int)ent64, i0 + (lane >> 3));
                    if ((lane & 7) == 0) {
                        const int ti = (int)(em >> 21), j = (int)((em >> 14) & 127u), row = gw + (p0 + ti) * NGW;
                        const float cf = gelu_erf(tot * (1.0f / 96.0f)) * __uint_as_float((unsigned)gl16[(em >> 14) & 1023u] << 16);
                        pairs[((size_t)(row >> 6) * 128 + j) * 64 + (row & 63)] = (cvt_pk_bf16(0.f, cf) & 0xffff0000u) | (em & 0x3FFFu);
                    }
                }
            }
        }
    }
}

__device__ __forceinline__ void phase11_peer_v(Frame& F, float* dst) {
    const unsigned* pairs = (const unsigned*)(F.ws + WS_PAIRS); const float* mf = (const float*)(F.ws + WS_MODF);
    unsigned long long* vs = (unsigned long long*)F.lds;
    for (int c = F.bid; c < DM / 8; c += F.G) {
        __syncthreads();
        { const u32x4* src = (const u32x4*)(F.ws + WS_PV + (size_t)c * NEXP * 8); u32x4* dst = (u32x4*)F.lds;
#pragma unroll 4
          for (int i = F.tid; i < NEXP * 8 / 16; i += 512) dst[i] = src[i]; }
        __syncthreads();
        for (int tile = F.wave; tile < MTOK / 64; tile += 8) {
            int lane = F.lane; asm volatile("" : "+v"(lane));
            const unsigned* pp = pairs + (size_t)tile * 128 * 64 + lane;
            const int row = tile * 64 + lane;
            const float* gt2 = mf + (size_t)(tile / (SEQ / 64)) * 12288 + 10240 + c * 8;
            const float* ip = F.out + (size_t)row * 2048 + c * 8; float* op = dst + (size_t)row * 2048 + c * 8;
            const f32x4 x0 = *(const f32x4*)ip, x1 = *(const f32x4*)(ip + 4), g0 = *(const f32x4*)gt2 * 0.25f, g1 = *(const f32x4*)(gt2 + 4) * 0.25f;
            f32x2 acc[4];
#pragma unroll
            for (int i = 0; i < 4; ++i) acc[i] = (f32x2){0.f, 0.f};
#define P11_LOAD(dst, j0) do { _Pragma("unroll") for (int jj = 0; jj < 16; ++jj) dst[jj] = pp[((j0) + jj) * 64]; } while (0)
#define P11_COMP(src) do { _Pragma("unroll") for (int jj = 0; jj < 16; ++jj) { const unsigned long long v = vs[src[jj] & 0x3FFFu]; const float cf = __uint_as_float(src[jj] & 0xffff0000u); \
                    const int lo = (int)(unsigned)v, hi = (int)(unsigned)(v >> 32); \
                    acc[0] += __builtin_amdgcn_cvt_pk_f32_fp8(lo, false) * cf; acc[1] += __builtin_amdgcn_cvt_pk_f32_fp8(lo, true) * cf; \
                    acc[2] += __builtin_amdgcn_cvt_pk_f32_fp8(hi, false) * cf; acc[3] += __builtin_amdgcn_cvt_pk_f32_fp8(hi, true) * cf; } } while (0)
#if PROBE_P11X
            { f32x2 sv[4]; for (int i = 0; i < 4; ++i) sv[i] = acc[i];
            unsigned pa[16], pb[16];
            P11_LOAD(pa, 0);
#pragma unroll 1
            for (int j0 = 0; j0 < 128; j0 += 32) {
                P11_LOAD(pb, j0 + 16);
                P11_COMP(pa);
                if (j0 + 32 < 128) P11_LOAD(pa, j0 + 32);
                P11_COMP(pb);
            }
              asm volatile("" :: "v"(acc[0].x), "v"(acc[1].x), "v"(acc[2].x), "v"(acc[3].x)); for (int i = 0; i < 4; ++i) acc[i] = sv[i] * 0.f; }
#endif
            unsigned pa[16], pb[16];
            P11_LOAD(pa, 0);
#pragma unroll 1
            for (int j0 = 0; j0 < 128; j0 += 32) {
                P11_LOAD(pb, j0 + 16);
                P11_COMP(pa);
                if (j0 + 32 < 128) P11_LOAD(pa, j0 + 32);
                P11_COMP(pb);
            }
#undef P11_LOAD
#undef P11_COMP
            *(f32x4*)op = x0 + g0 * (f32x4){acc[0].x, acc[0].y, acc[1].x, acc[1].y};
            *(f32x4*)(op + 4) = x1 + g1 * (f32x4){acc[2].x, acc[2].y, acc[3].x, acc[3].y};
        }
    }
}

__global__ void __launch_bounds__(512, 2) fwd_kernel(Args args) {
    extern __shared__ __attribute__((aligned(16))) unsigned char lds[];
    Frame F;
    F.lds = lds; F.ws = args.ws; F.tid = threadIdx.x; F.lane = F.tid & 63; F.wave = __builtin_amdgcn_readfirstlane(F.tid >> 6); F.G = gridDim.x; F.bid = blockIdx.x;
    F.x = args.in[0]; F.c = args.in[1]; F.w_ada = args.in[2]; F.b_ada = args.in[3]; F.g1 = args.in[4]; F.g2 = args.in[5]; F.w_in = args.in[6]; F.g_q = args.in[7]; F.g_k = args.in[8];
    F.rel_bias = args.in[9]; F.pool_w = args.in[10]; F.pool_scale = args.in[11]; F.w_ab = args.in[12]; F.w_pb = args.in[13]; F.w_out = args.in[14]; F.w_pq = args.in[15];
    F.peer_keys = args.in[16]; F.peer_u = args.in[17]; F.peer_v = args.in[18]; F.out = args.out;
    LAS unsigned char* ldsl = (LAS unsigned char*)lds;
    volatile LAS unsigned* misc = (volatile LAS unsigned*)(ldsl + MISC_OFF);
    if (F.tid < 4) misc[F.tid] = 0u;
    __syncthreads();
    unsigned* barw = (unsigned*)(args.ws + WS_CTL) + (size_t)args.li * XCD_BAR_WORDS;
    XcdBarrier bar; bar.bar = barw; bar.x = 0; bar.st = misc;
    const int lo = args.ph_lo, hi = args.ph_hi;
    if (hi - lo > 1) bar = xcd_barrier_post(barw, misc);
#define IN(k) (lo <= (k) && (k) < hi)
#define SEAM(k) do { if (IN(k) && IN((k) + 1)) xcd_barrier(bar); } while (0)
    bf16_t* R0 = (bf16_t*)(F.ws + WS_R0);

#define PH2_BODY { \
        pg8::Gemm g{R0, (const bf16_t*)(F.ws + WS_WIN), MTOK, INWP, DM, DM, 0, nullptr, nullptr, 0, 0}; pg8::StaticOrder S; S.init(MTOK, INWP, F.G, F.bid); \
        EpiInproj E{(bf16_t*)(F.ws + WS_QN), (bf16_t*)(F.ws + WS_KN), (bf16_t*)(F.ws + WS_V), (bf16_t*)(F.ws + WS_IQ), (bf16_t*)(F.ws + WS_IK), (bf16_t*)(F.ws + WS_PL), \
                    (bf16_t*)(F.ws + WS_GA), (bf16_t*)(F.ws + WS_GP), (float*)(F.ws + WS_IW)}; \
        pg8::gemm_phase<EpiInproj>(ldsl, g, S, E); }
#define PH3_BODY { phase3_pooled(F); phase3_indexer(F); __syncthreads(); }
#define PH4_BODY { \
        phase4_attention(F); \
        __syncthreads(); \
        pg8::Gemm g{(const bf16_t*)(F.ws + WS_POOLED), (const bf16_t*)(F.ws + WS_POOLW), MTOK, PW, 256, 1024, 256, nullptr, nullptr, 0, 0}; pg8::StaticOrder S; S.init(MTOK, PW, F.G, F.bid); \
        EpiBf16Scale E{(bf16_t*)(F.ws + WS_POOL2), 1024, F.pool_scale}; \
        pg8::gemm_phase<EpiBf16Scale>(ldsl, g, S, E); }
#define PH5_BODY { \
        pg8::Gemm g{(const bf16_t*)(F.ws + WS_ATTN), (const bf16_t*)(F.ws + WS_WAB), MTOK, DM, 2048, 1024, 0, (const bf16_t*)(F.ws + WS_POOL2), (const bf16_t*)(F.ws + WS_WPB), 16, 1024}; \
        pg8::StaticOrder S; S.init(MTOK, DM, F.G, F.bid); \
        EpiMerge E{R0, (const bf16_t*)(F.ws + WS_GA), (const bf16_t*)(F.ws + WS_GP)}; pg8::gemm_phase<EpiMerge>(ldsl, g, S, E); }
#define PH6_BODY { \
        pg8::Gemm g{R0, (const bf16_t*)(F.ws + WS_WOUT), MTOK, DM, DM, DM, 0, nullptr, nullptr, 0, 0}; pg8::StaticOrder S; S.init(MTOK, DM, F.G, F.bid); \
        EpiResid E{F.x, F.out, (const float*)(F.ws + WS_MODF) + 4096}; pg8::gemm_phase<EpiResid>(ldsl, g, S, E); }
#define PH8_BODY { \
        pg8::Gemm g{(const bf16_t*)(F.ws + WS_H2), (const bf16_t*)(F.ws + WS_WPQ), MTOK, DM, DM, DM, 0, nullptr, nullptr, 0, 0}; pg8::StaticOrder S; S.init(MTOK, DM, F.G, F.bid); \
        EpiBf16Scale E{R0, 2048, nullptr}; pg8::gemm_phase<EpiBf16Scale>(ldsl, g, S, E); }
#define PH9_BODY { \
        pg8::Gemm g{R0, (const bf16_t*)(F.ws + WS_KEYSBD), MTOK, DM, 256, DM, 256, nullptr, nullptr, 0, 0}; pg8::StaticOrder S; S.init(MTOK, DM, F.G, F.bid); \
        EpiBf16Scale E{(bf16_t*)(F.ws + WS_SUB), 2048, nullptr}; pg8::gemm_phase<EpiBf16Scale>(ldsl, g, S, E); }
#define REP(k) if constexpr (((PROBE_REP) >> (k)) & 1)

    if (IN(0)) { phase0_prep(F); REP(0) { __syncthreads(); phase0_prep(F); } }
    SEAM(0);
    if (IN(1)) { phase_modnorm<true>(F, F.x, F.g1, 0, 2048, R0); REP(1) { phase_modnorm<true>(F, F.x, F.g1, 0, 2048, R0); } }
    SEAM(1);
    if (IN(2)) { PH2_BODY REP(2) PH2_BODY }
    SEAM(2);
    if (IN(3)) { phase3_qknorm(F); PH3_BODY REP(3) PH3_BODY }
    SEAM(3);
    if (IN(4)) { PH4_BODY REP(4) PH4_BODY }
    SEAM(4);
    if (IN(5)) { PH5_BODY REP(5) PH5_BODY }
    SEAM(5);
    if (IN(6)) { PH6_BODY REP(6) PH6_BODY }
    SEAM(6);
    if (IN(7)) { phase_modnorm<false>(F, F.out, F.g2, 6144, 8192, (bf16_t*)(F.ws + WS_H2)); REP(7) { phase_modnorm<false>(F, F.out, F.g2, 6144, 8192, (bf16_t*)(F.ws + WS_H2)); } }
    SEAM(7);
    if (IN(8)) { PH8_BODY REP(8) PH8_BODY }
    SEAM(8);
    if (IN(9)) { PH9_BODY REP(9) PH9_BODY }
    SEAM(9);
    if (IN(10)) { phase10_peer(F); REP(10) phase10_peer(F); }
    SEAM(10);
    if (IN(11)) { REP(11) { phase11_peer_v(F, (float*)(F.ws + WS_SUB)); } phase11_peer_v(F, F.out); }
#undef IN
#undef SEAM
}

extern "C" void kernel_launch(void* const* d_in, const int* in_sizes, int n_in, void* d_out, int out_size, void* d_ws, size_t ws_size, hipStream_t stream) {
    static int grid = 0;
    if (grid == 0) {
        if (n_in != 19 || out_size != MTOK * DM || ws_size < WS_END) { fprintf(stderr, "kernel_launch: unexpected shapes (n_in %d out %d ws %zu)\n", n_in, out_size, ws_size); grid = -1; return; }
        int dev = 0, cus = 0, per_cu = 0;
        if (hipGetDevice(&dev) != hipSuccess || hipDeviceGetAttribute(&cus, hipDeviceAttributeMultiprocessorCount, dev) != hipSuccess) { grid = -1; return; }
        if (hipFuncSetAttribute((const void*)fwd_kernel, hipFuncAttributeMaxDynamicSharedMemorySize, LDS_BYTES) != hipSuccess) { fprintf(stderr, "kernel_launch: hipFuncSetAttribute failed\n"); grid = -1; return; }
        if (hipOccupancyMaxActiveBlocksPerMultiprocessor(&per_cu, (const void*)fwd_kernel, 512, LDS_BYTES) != hipSuccess || per_cu < 1) { fprintf(stderr, "kernel_launch: occupancy query says %d\n", per_cu); }
        (void)hipGetLastError();
        grid = cus;
    }
    if (grid < 0) return;
    (void)in_sizes;
    if (hipMemsetAsync((char*)d_ws + WS_CTL, 0, CTL_ZERO_BYTES, stream) != hipSuccess) return;
    Args a{};
    for (int i = 0; i < 19; ++i) a.in[i] = (const float*)d_in[i];
    a.out = (float*)d_out; a.ws = (unsigned char*)d_ws;
#if MK_PER_PHASE
    for (int p = 0; p < NPHASE; ++p) { a.ph_lo = p; a.ph_hi = p + 1; a.li = p; hipLaunchKernelGGL(fwd_kernel, dim3(grid), dim3(512), LDS_BYTES, stream, a); }
#else
    a.ph_lo = 0; a.ph_hi = NPHASE; a.li = 0;
    hipLaunchKernelGGL(fwd_kernel, dim3(grid), dim3(512), LDS_BYTES, stream, a);
#endif
}
```

```cpp
#include <hip/hip_runtime.h>
#include <cstdio>
#include <cstdint>

#ifndef MK_PER_PHASE
#define MK_PER_PHASE 0
#endif

#ifndef PROBE_REP
#define PROBE_REP 0
#endif
#ifndef PROBE_IDX
#define PROBE_IDX 0
#endif
#ifndef PROBE_P11X
#define PROBE_P11X 0
#endif
#define LAS __attribute__((address_space(3)))
typedef unsigned short bf16_t;
typedef short bf16x8 __attribute__((ext_vector_type(8)));
typedef float f32x4 __attribute__((ext_vector_type(4)));
typedef float f32x2 __attribute__((ext_vector_type(2)));
typedef unsigned u32x4 __attribute__((ext_vector_type(4)));
typedef unsigned u32x2 __attribute__((ext_vector_type(2)));
typedef unsigned u32x6 __attribute__((ext_vector_type(6)));
typedef unsigned u32x16 __attribute__((ext_vector_type(16)));
typedef __bf16 bf16x32 __attribute__((ext_vector_type(32)));

constexpr int BATCH = 8, SEQ = 4096, DM = 2048, MTOK = BATCH * SEQ;
constexpr int NHEAD = 8, HDIM = 128, AW = 1024, KVW = 256, IHEADS = 16, IDIM = 64, KSEL = 256;
constexpr int PW = 1024, PHEADS = 8, NEXP = 16384;
constexpr int INW = 7760;
constexpr float EPS = 1e-6f;
constexpr int NPHASE = 12;

constexpr size_t MiB = 1u << 20;
constexpr size_t WS_CTL = 0, CTL_ZERO_BYTES = 256 * 1024;
constexpr size_t WS_MODP = 2 * MiB;
constexpr size_t WS_MODF = 4 * MiB;
constexpr size_t WS_POOLW = 5 * MiB;
constexpr size_t WS_KEYSBD = 6 * MiB;
constexpr size_t WS_WIN16 = 8 * MiB;
constexpr size_t WS_WIN8 = 20 * MiB;
constexpr size_t WS_WAB = 40 * MiB, WS_WPB = 44 * MiB, WS_WOUT = 48 * MiB, WS_WPQ = 56 * MiB;
constexpr size_t WS_PU = 64 * MiB, WS_PV = 128 * MiB;
constexpr size_t WS_R0 = 192 * MiB;
constexpr size_t WS_GA = 320 * MiB, WS_GP = 448 * MiB;
constexpr size_t WS_SUB = 320 * MiB;
constexpr size_t WS_QN = 576 * MiB;
constexpr size_t WS_IQ = 640 * MiB;
constexpr size_t WS_PL = 704 * MiB;
constexpr size_t WS_KN = 768 * MiB, WS_V = 784 * MiB;
constexpr size_t WS_IK = 800 * MiB;
constexpr size_t WS_IW = 804 * MiB;
constexpr size_t WS_SEL = 806 * MiB;
constexpr size_t WS_POOLED = 822 * MiB;
constexpr size_t WS_H2 = 886 * MiB;
constexpr size_t WS_END = 1014 * MiB;
constexpr size_t WS_H1F8 = WS_H2 + 64 * MiB;
constexpr size_t WS_Q8 = WS_H2, WS_K8 = WS_H2 + 32 * MiB, WS_V8 = WS_H2 + 40 * MiB;
constexpr size_t WS_ATTN = WS_IQ, WS_POOL2 = WS_PL, WS_PAIRS = WS_QN, WS_WLS = WS_QN + 32 * MiB;

constexpr int LDS_BYTES = 160 * 1024;
constexpr int MISC_OFF = 159 * 1024;

__device__ __forceinline__ unsigned cvt_pk_bf16(float lo, float hi) { unsigned r; asm volatile("v_cvt_pk_bf16_f32 %0, %1, %2" : "=v"(r) : "v"(lo), "v"(hi)); return r; }
__device__ __forceinline__ float bf_lo(unsigned w) { return __uint_as_float(w << 16); }
__device__ __forceinline__ float bf_hi(unsigned w) { return __uint_as_float(w & 0xffff0000u); }
template <int CTRL> __device__ __forceinline__ float dpp_f(float x) { return __int_as_float(__builtin_amdgcn_update_dpp(0, __float_as_int(x), CTRL, 0xF, 0xF, true)); }
#define DPP_XOR1 0xB1
#define DPP_XOR2 0x4E
#define DPP_HMIRROR 0x141
#define DPP_MIRROR 0x140
#define DPP_ROR8 0x128
__device__ __forceinline__ float xor16_sum(float x) { const auto r = __builtin_amdgcn_permlane16_swap(__float_as_uint(x), __float_as_uint(x), false, false); return __uint_as_float(r[0]) + __uint_as_float(r[1]); }
__device__ __forceinline__ float xor32_sum(float x) { const auto r = __builtin_amdgcn_permlane32_swap(__float_as_uint(x), __float_as_uint(x), false, false); return __uint_as_float(r[0]) + __uint_as_float(r[1]); }
__device__ __forceinline__ float xor16_max(float x) { const auto r = __builtin_amdgcn_permlane16_swap(__float_as_uint(x), __float_as_uint(x), false, false); return fmaxf(__uint_as_float(r[0]), __uint_as_float(r[1])); }
__device__ __forceinline__ float swap32_pair(float a, float b) { const auto r = __builtin_amdgcn_permlane32_swap(__float_as_uint(a), __float_as_uint(b), false, false); return __uint_as_float(r[0]) + __uint_as_float(r[1]); }
__device__ __forceinline__ float swap16_pair(float a, float b) { const auto r = __builtin_amdgcn_permlane16_swap(__float_as_uint(a), __float_as_uint(b), false, false); return __uint_as_float(r[0]) + __uint_as_float(r[1]); }
__device__ __forceinline__ float row_sum16(float v) { v += dpp_f<DPP_XOR1>(v); v += dpp_f<DPP_XOR2>(v); v += dpp_f<DPP_HMIRROR>(v); v += dpp_f<DPP_MIRROR>(v); return v; }
__device__ __forceinline__ float row_max16(float v) { v = fmaxf(v, dpp_f<DPP_XOR1>(v)); v = fmaxf(v, dpp_f<DPP_XOR2>(v)); v = fmaxf(v, dpp_f<DPP_HMIRROR>(v)); v = fmaxf(v, dpp_f<DPP_MIRROR>(v)); return v; }
__device__ __forceinline__ float wave_sum(float v) { return xor32_sum(xor16_sum(row_sum16(v))); }
__device__ __forceinline__ float sigmoidf_(float x) { return __builtin_amdgcn_rcpf(1.0f + __expf(-x)); }
__device__ __forceinline__ float dot8(u32x4 w, const float* h) {
    return bf_lo(w.x) * h[0] + bf_hi(w.x) * h[1] + bf_lo(w.y) * h[2] + bf_hi(w.y) * h[3] + bf_lo(w.z) * h[4] + bf_hi(w.z) * h[5] + bf_lo(w.w) * h[6] + bf_hi(w.w) * h[7];
}

__device__ __forceinline__ int lane_now() { int l; asm volatile("v_mbcnt_lo_u32_b32 %0, -1, 0\n\tv_mbcnt_hi_u32_b32 %0, -1, %0" : "=v"(l)); return l; }

#define XB_TMO      128
#define XB_XCNT(j)  (256  + 64 * (j))
#define XB_XSUB(j)  (1280 + 64 * (j))
#define XB_XGEN(j)  (2304 + 64 * (j))
#define XB_TOP      3328
#define XB_TOPGEN   3392
#define XCD_BAR_WORDS 3456
#define XB_SPIN_CAP (1u << 18)

__device__ __forceinline__ unsigned xb_ld(unsigned* p)              { return __hip_atomic_load(p, __ATOMIC_RELAXED, __HIP_MEMORY_SCOPE_AGENT); }
__device__ __forceinline__ unsigned xb_add(unsigned* p, unsigned v) { return __hip_atomic_fetch_add(p, v, __ATOMIC_RELAXED, __HIP_MEMORY_SCOPE_AGENT); }
__device__ __forceinline__ unsigned xb_xcc_id() { return (unsigned)__builtin_amdgcn_s_getreg((3 << 11) | 20) & 0xFu; }
#define XB_SPIN(cond, bar) do { unsigned _sp = 0; while (cond) { __builtin_amdgcn_s_sleep(1); \
    if ((++_sp & 255u) == 0u) { if (xb_ld(&(bar)[XB_TMO])) break; if (_sp > XB_SPIN_CAP) { atomicAdd(&(bar)[XB_TMO], 1u); break; } } } } while (0)

struct XcdBarrier { unsigned* bar; unsigned x; volatile LAS unsigned* st; };

__device__ __forceinline__ XcdBarrier xcd_barrier_post(unsigned* bar, volatile LAS unsigned* st) {
    XcdBarrier b; b.bar = bar; b.x = xb_xcc_id(); b.st = st;
    if (threadIdx.x == 0) (void)xb_add(&bar[XB_XCNT(b.x)], 1u);
    return b;
}
__device__ __forceinline__ void xcd_barrier_complete(unsigned* bar, unsigned x, unsigned& nloc, unsigned& nx) {
    const unsigned G = gridDim.x * gridDim.y * gridDim.z;
    unsigned sum, cnt, mine, sp = 0u;
    for (;;) {
        sum = 0u; cnt = 0u; mine = 0u;
#pragma unroll
        for (unsigned j = 0; j < 16; ++j) { const unsigned c = xb_ld(&bar[XB_XCNT(j)]); sum += c; cnt += (c > 0u) ? 1u : 0u; mine = (j == x) ? c : mine; }
        if (sum == G) break;
        __builtin_amdgcn_s_sleep(1);
        if ((++sp & 255u) == 0u) { if (xb_ld(&bar[XB_TMO])) break; if (sp > XB_SPIN_CAP) { atomicAdd(&bar[XB_TMO], 1u); break; } }
    }
    nloc = mine > 0u ? mine : 1u; nx = cnt > 0u ? cnt : 1u;
}
__device__ __forceinline__ void xcd_barrier(const XcdBarrier& b, int wave) {
    asm volatile("s_waitcnt vmcnt(0)" ::: "memory");
    __syncthreads();
    if (wave == 0 && lane_now() == 0) {
        unsigned* bar = b.bar;
        __builtin_amdgcn_s_waitcnt(0);
        unsigned nloc = b.st[0], nx = b.st[1];
        if (nloc == 0u) { xcd_barrier_complete(bar, b.x, nloc, nx); b.st[0] = nloc; b.st[1] = nx; }
        const unsigned old = xb_add(&bar[XB_XSUB(b.x)], 1u);
        const unsigned gen = old / nloc;
        if (old + 1u == (gen + 1u) * nloc) {
            __builtin_amdgcn_fence(__ATOMIC_RELEASE, "agent");
            asm volatile("s_waitcnt vmcnt(0)" ::: "memory");
            const unsigned og = xb_add(&bar[XB_TOP], 1u);
            const unsigned tg = og / nx;
            if (og + 1u == (tg + 1u) * nx) xb_add(&bar[XB_TOPGEN], 1u);
            else XB_SPIN(xb_ld(&bar[XB_TOPGEN]) == tg, bar);
            __builtin_amdgcn_fence(__ATOMIC_ACQUIRE, "agent");
            xb_add(&bar[XB_XGEN(b.x)], 1u);
            asm volatile("s_waitcnt vmcnt(0)" ::: "memory");
        } else {
            XB_SPIN(xb_ld(&bar[XB_XGEN(b.x)]) == gen, bar);
            __builtin_amdgcn_fence(__ATOMIC_ACQUIRE, "agent");
            asm volatile("s_waitcnt vmcnt(0)" ::: "memory");
        }
    }
    __syncthreads();
}

namespace pg8 {
constexpr int BM = 256, BK = 64, HALF = 128, HTB = HALF * BK * 2, STAGE_BYTES = 8 * HTB, NXCD = 8, WGM = 8;
__device__ __forceinline__ int lds_byte(int r, int c) { const int st = (r >> 4) * 2 + (c >> 5), rr = r & 15, cc = c & 31, ob = rr * 64 + cc * 2; return st * 1024 + (ob ^ (((ob >> 9) & 1) << 5)); }
__device__ __forceinline__ void stage_rc(int b, int& R, int& C) { const int st = b / 1024, sb = b % 1024, swz = sb ^ (((sb >> 9) & 1) << 5); R = (st >> 1) * 16 + swz / 64; C = (st & 1) * 32 + (swz % 64) / 2; }
__device__ __forceinline__ int perm32(int rho) { const int n = rho >> 4, i = rho & 15; return 8 * (i >> 2) + 4 * n + (i & 3); }

struct Unit { int pm, pn; };
struct Gemm { const bf16_t* A; const bf16_t* Bt; int M, N, K, lda, a_pn_off; const bf16_t* A2; const bf16_t* Bt2; int ksplit, ldb; };

struct StaticOrder {
    int nM, nN, nwg, G, c;
    __device__ void init(int M, int N, int G_, int c_) { nM = M / BM; nN = N / BM; nwg = nM * nN; G = G_; c = c_; }
    __device__ bool next(int i, Unit& u) const {
        const long L = (long)i * G + c; if (L >= nwg) return false;
        int wgid = (int)L; { const int q = nwg / NXCD, r = nwg % NXCD, xcd = wgid % NXCD, off = wgid / NXCD; wgid = (xcd < r ? xcd * (q + 1) : r * (q + 1) + (xcd - r) * q) + off; }
        const int nig = WGM * nN, gid = wgid / nig, fm = gid * WGM, gsz = (nM - fm) < WGM ? (nM - fm) : WGM;
        u.pm = fm + ((wgid % nig) % gsz); u.pn = (wgid % nig) / gsz; return true;
    }
};

typedef int i32x4 __attribute__((ext_vector_type(4)));
typedef int i32x8 __attribute__((ext_vector_type(8)));
__device__ __forceinline__ bf16x8 lo8(i32x8 v) { return __builtin_bit_cast(bf16x8, (i32x4){v.s0, v.s1, v.s2, v.s3}); }
__device__ __forceinline__ bf16x8 hi8(i32x8 v) { return __builtin_bit_cast(bf16x8, (i32x4){v.s4, v.s5, v.s6, v.s7}); }
__device__ __forceinline__ i32x8 cat8(bf16x8 a, bf16x8 b) { const i32x4 x = __builtin_bit_cast(i32x4, a), y = __builtin_bit_cast(i32x4, b); return (i32x8){x.x, x.y, x.z, x.w, y.x, y.y, y.z, y.w}; }
template <class Epi, bool F8 = false>
__device__ __forceinline__ void gemm_phase(LAS unsigned char* lds, const Gemm g, const StaticOrder& S, const Epi& E, int wave) {
    const int lane = lane_now(), wid = wave, tid = wid * 64 + lane, wr = wid >> 2, wc = wid & 3, fr = lane & 15, fq = lane >> 4;
    const int K = g.K, nt = K / BK, lda = g.lda, ldb = g.ldb ? g.ldb : g.K, ksplit = g.ksplit;
    unsigned voffA, voffB;
    { int R, C; stage_rc(tid * 16, R, C); const int Rb = Epi::PERM ? ((R & ~31) + perm32(R & 31)) : R;
      voffA = (unsigned)(R * lda + C) * 2u; voffB = (unsigned)(Rb * ldb + C) * 2u; }
    const unsigned stepA = 64u * (unsigned)lda * 2u, stepB = 64u * (unsigned)ldb * 2u;
    const size_t kstep = (size_t)(BK * 2);
    const size_t hsA = (size_t)HALF * lda * 2, hsB = (size_t)HALF * ldb * 2;
    const size_t tsA = 2 * hsA, tsB = 2 * hsB;
    const unsigned ldsw = (unsigned)wid * 1024u, ldsbase = (unsigned)(unsigned long long)lds;
    const int aoff = lds_byte(wr * 64 + fr, fq * 8), boff = lds_byte(wc * 32 + fr, fq * 8);
#define PG8_SA(b, h) (((b) * 2 + (h)) * HTB)
#define PG8_SB(b, h) ((4 + (b) * 2 + (h)) * HTB)
#define PG8_STAGE(bufoff, gbase, voff) do { _Pragma("unroll") for (int _i = 0; _i < 2; ++_i) { \
        const char* sb_ = (const char*)(gbase) + (size_t)_i * PG8_STEP_##voff; const unsigned m0_ = ldsbase + (unsigned)(bufoff) + ldsw + (unsigned)_i * 8192u; \
        asm volatile("s_mov_b32 m0, %2\n\ts_nop 0\n\tglobal_load_lds_dwordx4 %0, %1" :: "v"(voff), "s"(sb_), "s"(m0_) : "memory"); } } while (0)
#define PG8_STEP_voffA stepA
#define PG8_STEP_voffB stepB
#define PG8_LDA(dst, b, h) do { _Pragma("unroll") for (int m = 0; m < 4; ++m) dst[m] = cat8(*(const LAS bf16x8*)(lds + PG8_SA(b, h) + aoff + m * 2048), *(const LAS bf16x8*)(lds + PG8_SA(b, h) + aoff + m * 2048 + 1024)); } while (0)
#define PG8_LDB(dst, b, h) do { _Pragma("unroll") for (int n = 0; n < 2; ++n) dst[n] = cat8(*(const LAS bf16x8*)(lds + PG8_SB(b, h) + boff + n * 2048), *(const LAS bf16x8*)(lds + PG8_SB(b, h) + boff + n * 2048 + 1024)); } while (0)
#define PG8_MMA(ai, bj, At, Bt) do { __builtin_amdgcn_s_setprio(1); _Pragma("unroll") for (int m = 0; m < 4; ++m) _Pragma("unroll") for (int n = 0; n < 2; ++n) { \
        if constexpr (F8) acc[ai][bj][m][n] = __builtin_amdgcn_mfma_scale_f32_16x16x128_f8f6f4(Bt[n], At[m], acc[ai][bj][m][n], 0, 0, 0, 0x7D7D7D7D  , 0, 0x7D7D7D7D); \
        else { acc[ai][bj][m][n] = __builtin_amdgcn_mfma_f32_16x16x32_bf16(lo8(Bt[n]), lo8(At[m]), acc[ai][bj][m][n], 0, 0, 0); \
               acc[ai][bj][m][n] = __builtin_amdgcn_mfma_f32_16x16x32_bf16(hi8(Bt[n]), hi8(At[m]), acc[ai][bj][m][n], 0, 0, 0); } } \
        __builtin_amdgcn_s_setprio(0); } while (0)
#define PG8_WAIT_V(n) asm volatile("s_waitcnt vmcnt(" #n ")" ::: "memory")
#define PG8_WAIT_L(n) asm volatile("s_waitcnt lgkmcnt(" #n ")" ::: "memory")
#define PG8_BAR __builtin_amdgcn_s_barrier()
#define PG8_SCHED __builtin_amdgcn_sched_barrier(0)
    Unit cur, nxt; int ui = 0;
    if (!S.next(0, cur)) return;
    f32x4 acc[2][2][4][2];
#pragma unroll
    for (int a = 0; a < 2; ++a)
#pragma unroll
        for (int b = 0; b < 2; ++b)
#pragma unroll
            for (int m = 0; m < 4; ++m)
#pragma unroll
                for (int n = 0; n < 2; ++n) acc[a][b][m][n] = (f32x4){0.f, 0.f, 0.f, 0.f};
    i32x8 At[4], B0[2], B1[2];
    const char* cA = (const char*)g.A + (size_t)cur.pm * tsA + (size_t)cur.pn * g.a_pn_off * 2; const char* cB = (const char*)g.Bt + (size_t)cur.pn * tsB;
    PG8_STAGE(PG8_SB(0, 0), cB, voffB); PG8_STAGE(PG8_SB(0, 1), cB + hsB, voffB); PG8_STAGE(PG8_SA(0, 0), cA, voffA); PG8_STAGE(PG8_SA(0, 1), cA + hsA, voffA);
    if (wr == 1) PG8_BAR;
    PG8_WAIT_V(2); PG8_BAR;
    PG8_STAGE(PG8_SB(1, 0), cB + kstep, voffB); PG8_STAGE(PG8_SA(1, 0), cA + kstep, voffA); PG8_STAGE(PG8_SB(1, 1), cB + hsB + kstep, voffB);
    PG8_WAIT_V(6); PG8_BAR;
    for (;;) {
        const bool has_next = S.next(ui + 1, nxt);
        const char* nA = has_next ? (const char*)g.A + (size_t)nxt.pm * tsA + (size_t)nxt.pn * g.a_pn_off * 2 : cA; const char* nB = has_next ? (const char*)g.Bt + (size_t)nxt.pn * tsB : cB;
        const char* cA2 = (const char*)g.A2 + (size_t)cur.pm * tsA; const char* cB2 = (const char*)g.Bt2 + (size_t)cur.pn * tsB;
#pragma clang loop unroll(disable)
        for (int t = 0; t < nt; t += 2) {
            const bool last = (t == nt - 2);
            const bool s1 = ksplit && (t >= ksplit), s2 = ksplit && (t + 2 >= ksplit);
            const char* a1 = (s1 ? cA2 + (size_t)(t - ksplit + 1) * kstep : cA + (size_t)(t + 1) * kstep);
            const char* a2 = last ? nA : (s2 ? cA2 + (size_t)(t + 2 - ksplit) * kstep : cA + (size_t)(t + 2) * kstep);
            const char* b2 = last ? nB : (s2 ? cB2 + (size_t)(t + 2 - ksplit) * kstep : cB + (size_t)(t + 2) * kstep);
            const char* a3 = a2 + kstep; const char* b3 = b2 + kstep;
            PG8_LDB(B0, 0, 0); PG8_LDB(B1, 0, 1); PG8_SCHED; PG8_LDA(At, 0, 0); PG8_STAGE(PG8_SA(1, 1), a1 + hsA, voffA);
            PG8_WAIT_V(8); PG8_WAIT_L(0); PG8_BAR; PG8_MMA(0, 0, At, B0); PG8_MMA(0, 1, At, B1); PG8_BAR; PG8_SCHED;
            PG8_LDA(At, 0, 1); PG8_STAGE(PG8_SB(0, 0), b2, voffB); PG8_STAGE(PG8_SB(0, 1), b2 + hsB, voffB); PG8_STAGE(PG8_SA(0, 0), a2, voffA);
            PG8_WAIT_V(8); PG8_WAIT_L(0); PG8_BAR; PG8_MMA(1, 0, At, B0); PG8_MMA(1, 1, At, B1); PG8_BAR; PG8_SCHED;
            PG8_LDB(B0, 1, 0); PG8_LDB(B1, 1, 1); PG8_SCHED; PG8_LDA(At, 1, 0); PG8_STAGE(PG8_SA(0, 1), a2 + hsA, voffA);
            PG8_WAIT_V(8); PG8_WAIT_L(0); PG8_BAR; PG8_MMA(0, 0, At, B0); PG8_MMA(0, 1, At, B1); PG8_BAR; PG8_SCHED;
            PG8_LDA(At, 1, 1); PG8_STAGE(PG8_SB(1, 0), b3, voffB); PG8_STAGE(PG8_SB(1, 1), b3 + hsB, voffB); PG8_STAGE(PG8_SA(1, 0), a3, voffA);
            PG8_WAIT_V(8); PG8_WAIT_L(0); PG8_BAR; PG8_MMA(1, 0, At, B0); PG8_MMA(1, 1, At, B1); PG8_BAR; PG8_SCHED;
            if constexpr (Epi::MID) { if (t + 2 == ksplit) E.mid(acc, cur, wr, wc, fr, fq); }
        }
        if (wr == 0) PG8_BAR;
        { const int l2 = lane_now(); E(acc, cur, wr, wc, l2 & 15, l2 >> 4); }
        if (!has_next) break;
#pragma unroll
        for (int a = 0; a < 2; ++a)
#pragma unroll
            for (int b = 0; b < 2; ++b)
#pragma unroll
                for (int m = 0; m < 4; ++m)
#pragma unroll
                    for (int n = 0; n < 2; ++n) acc[a][b][m][n] = (f32x4){0.f, 0.f, 0.f, 0.f};
        cur = nxt; cA = nA; cB = nB; ++ui;
        if (wr == 1) PG8_BAR;
    }
    PG8_WAIT_V(0);
    PG8_BAR;
#undef PG8_SA
#undef PG8_SB
#undef PG8_STAGE
#undef PG8_STEP_voffA
#undef PG8_STEP_voffB
#undef PG8_LDA
#undef PG8_LDB
#undef PG8_MMA
#undef PG8_WAIT_V
#undef PG8_WAIT_L
#undef PG8_BAR
#undef PG8_SCHED
}
}
using pg8::Unit;

typedef f32x4 AccT[2][2][4][2];
__device__ __forceinline__ u32x4 pack8(f32x4 a, f32x4 b) { u32x4 w; w.x = cvt_pk_bf16(a[0], a[1]); w.y = cvt_pk_bf16(a[2], a[3]); w.z = cvt_pk_bf16(b[0], b[1]); w.w = cvt_pk_bf16(b[2], b[3]); return w; }
__device__ __forceinline__ u32x2 pack8_fp8(f32x4 a, f32x4 b) {
    int w0 = __builtin_amdgcn_cvt_pk_fp8_f32(a[0], a[1], 0, false); w0 = __builtin_amdgcn_cvt_pk_fp8_f32(a[2], a[3], w0, true);
    int w1 = __builtin_amdgcn_cvt_pk_fp8_f32(b[0], b[1], 0, false); w1 = __builtin_amdgcn_cvt_pk_fp8_f32(b[2], b[3], w1, true);
    return (u32x2){(unsigned)w0, (unsigned)w1};
}
__device__ __forceinline__ void unpack8(u32x4 w, f32x4& a, f32x4& b) { a = (f32x4){bf_lo(w.x), bf_hi(w.x), bf_lo(w.y), bf_hi(w.y)}; b = (f32x4){bf_lo(w.z), bf_hi(w.z), bf_lo(w.w), bf_hi(w.w)}; }

template <bool SET8> struct EpiInproj {
    static constexpr bool PERM = true, MID = false;
    bf16_t *q, *k, *v, *iq, *ik, *pl, *ga, *gp; float* iw;
    __device__ __forceinline__ void operator()(const AccT& acc, const Unit& u, int wr, int wc, int fr, int fq) const {
        const int pn = u.pn, row0 = u.pm * 256 + wr * 64 + fr;
        if (!SET8 && pn == 4) {
            if (wc < 2) {
#pragma unroll
                for (int ai = 0; ai < 2; ++ai)
#pragma unroll
                    for (int m = 0; m < 4; ++m) { const size_t row = (size_t)(row0 + ai * 128 + m * 16);
                        *(u32x4*)(ik + row * 64 + wc * 32 + 8 * fq) = pack8(acc[ai][0][m][0], acc[ai][0][m][1]); }
            } else if (wc == 2) {
                if (fq < 2) {
#pragma unroll
                    for (int ai = 0; ai < 2; ++ai)
#pragma unroll
                        for (int m = 0; m < 4; ++m) { const size_t row = (size_t)(row0 + ai * 128 + m * 16);
                            *(f32x4*)(iw + row * 16 + 8 * fq) = acc[ai][0][m][0]; *(f32x4*)(iw + row * 16 + 8 * fq + 4) = acc[ai][0][m][1]; }
                }
            }
            return;
        }
        bf16_t* dst; int ld, tc; bool sg = false;
        if (SET8) {
            if (pn < 4) { dst = q; ld = 1024; tc = pn * 256; }
            else if (pn == 4) { dst = k; ld = 256; tc = 0; }
            else if (pn == 5) { dst = v; ld = 256; tc = 0; }
            else if (pn < 14) { dst = ga; ld = 2048; tc = (pn - 6) * 256; sg = true; }
            else { dst = gp; ld = 2048; tc = (pn - 14) * 256; sg = true; }
        } else {
            if (pn < 4) { dst = iq; ld = 1024; tc = pn * 256; }
            else { dst = pl; ld = 1024; tc = (pn - 5) * 256; }
        }
        const int col0 = tc + wc * 32 + 8 * fq;
#pragma unroll
        for (int ai = 0; ai < 2; ++ai)
#pragma unroll
            for (int m = 0; m < 4; ++m) { bf16_t* rowp = dst + (size_t)(row0 + ai * 128 + m * 16) * ld + col0;
#pragma unroll
                for (int bj = 0; bj < 2; ++bj) { f32x4 v0 = acc[ai][bj][m][0], v1 = acc[ai][bj][m][1];
                    if (sg) {
#pragma unroll
                        for (int j = 0; j < 4; ++j) { v0[j] = sigmoidf_(v0[j]); v1[j] = sigmoidf_(v1[j]); } }
                    *(u32x4*)(rowp + bj * 128) = pack8(v0, v1); } }
    }
};
struct EpiBf16Scale {
    static constexpr bool PERM = true, MID = false;
    bf16_t* O; int ldc; const float* cs;
    __device__ __forceinline__ void operator()(const AccT& acc, const Unit& u, int wr, int wc, int fr, int fq) const {
        const int row0 = u.pm * 256 + wr * 64 + fr, col0 = u.pn * 256 + wc * 32 + 8 * fq;
        f32x4 s[2][2];
#pragma unroll
        for (int bj = 0; bj < 2; ++bj)
#pragma unroll
            for (int n = 0; n < 2; ++n) s[bj][n] = cs ? *(const f32x4*)(cs + col0 + bj * 128 + 4 * n) : (f32x4){1.f, 1.f, 1.f, 1.f};
#pragma unroll
        for (int ai = 0; ai < 2; ++ai)
#pragma unroll
            for (int m = 0; m < 4; ++m) { bf16_t* rowp = O + (size_t)(row0 + ai * 128 + m * 16) * ldc + col0;
#pragma unroll
                for (int bj = 0; bj < 2; ++bj) *(u32x4*)(rowp + bj * 128) = pack8(acc[ai][bj][m][0] * s[bj][0], acc[ai][bj][m][1] * s[bj][1]); }
    }
};
template <bool ADD> struct EpiGate {
    static constexpr bool PERM = true, MID = false;
    bf16_t* O; const bf16_t* gate;
    __device__ __forceinline__ void operator()(const AccT& acc, const Unit& u, int wr, int wc, int fr, int fq) const {
        const int row0 = u.pm * 256 + wr * 64 + fr, col0 = u.pn * 256 + wc * 32 + 8 * fq;
#pragma unroll
        for (int ai = 0; ai < 2; ++ai)
#pragma unroll
            for (int m = 0; m < 4; ++m) { const size_t off = (size_t)(row0 + ai * 128 + m * 16) * 2048 + col0;
#pragma unroll
                for (int bj = 0; bj < 2; ++bj) { f32x4 g0, g1; unpack8(*(const u32x4*)(gate + off + bj * 128), g0, g1);
                    f32x4 r0 = g0 * acc[ai][bj][m][0], r1 = g1 * acc[ai][bj][m][1];
                    if (ADD) { f32x4 o0, o1; unpack8(*(const u32x4*)(O + off + bj * 128), o0, o1); r0 += o0; r1 += o1; }
                    *(u32x4*)(O + off + bj * 128) = pack8(r0, r1); } }
    }
};
struct EpiMerge {
    static constexpr bool PERM = true, MID = true;
    bf16_t* O; const bf16_t* ga; const bf16_t* gp;
    __device__ __forceinline__ void mid(AccT& acc, const Unit& u, int wr, int wc, int fr, int fq) const {
        const auto ra = __builtin_amdgcn_make_buffer_rsrc((void*)ga, 0, 0x7FFFFFFF, 0x00020000), rp = __builtin_amdgcn_make_buffer_rsrc((void*)gp, 0, 0x7FFFFFFF, 0x00020000);
        const int voff = ((wr * 64 + fr) * 2048 + wc * 32 + 8 * fq) * 2;
        const int sbase = (u.pm * 256 * 2048 + u.pn * 256) * 2;
#pragma unroll
        for (int ai = 0; ai < 2; ++ai)
#pragma unroll
            for (int m = 0; m < 4; ++m)
#pragma unroll
                for (int bj = 0; bj < 2; ++bj) { const int so = sbase + ((ai * 128 + m * 16) * 2048 + bj * 128) * 2;
                    const u32x4 wa = __builtin_bit_cast(u32x4, __builtin_amdgcn_raw_buffer_load_b128(ra, voff, so, 0)), wp = __builtin_bit_cast(u32x4, __builtin_amdgcn_raw_buffer_load_b128(rp, voff, so, 0));
                    f32x4 a0, a1, p0, p1; unpack8(wa, a0, a1); unpack8(wp, p0, p1);
#pragma unroll
                    for (int j = 0; j < 4; ++j) { acc[ai][bj][m][0][j] *= a0[j] * __builtin_amdgcn_rcpf(p0[j]); acc[ai][bj][m][1][j] *= a1[j] * __builtin_amdgcn_rcpf(p1[j]); }
                    asm volatile("" : "+v"(acc[ai][bj][m][0]), "+v"(acc[ai][bj][m][1]) :: "memory"); }
    }
    __device__ __forceinline__ void operator()(const AccT& acc, const Unit& u, int wr, int wc, int fr, int fq) const {
        const int row0 = u.pm * 256 + wr * 64 + fr, col0 = u.pn * 256 + wc * 32 + 8 * fq;
#pragma unroll
        for (int ai = 0; ai < 2; ++ai)
#pragma unroll
            for (int m = 0; m < 4; ++m) { const size_t off = (size_t)(row0 + ai * 128 + m * 16) * 2048 + col0;
#pragma unroll
                for (int bj = 0; bj < 2; ++bj) { f32x4 p0, p1; unpack8(*(const u32x4*)(gp + off + bj * 128), p0, p1);
                    *(u32x4*)(O + off + bj * 128) = pack8(p0 * acc[ai][bj][m][0], p1 * acc[ai][bj][m][1]); } }
    }
};
struct EpiResid {
    static constexpr bool PERM = false, MID = false;
    const float* x; float* out; const float* gt;
    __device__ __forceinline__ void operator()(const AccT& acc, const Unit& u, int wr, int wc, int fr, int fq) const {
        const int row0 = u.pm * 256 + wr * 64 + fr, col0 = u.pn * 256 + wc * 32 + 4 * fq;
        const float* gtb = gt + (size_t)(u.pm / 16) * 12288;
        f32x4 g[2][2];
#pragma unroll
        for (int bj = 0; bj < 2; ++bj)
#pragma unroll
            for (int n = 0; n < 2; ++n) g[bj][n] = *(const f32x4*)(gtb + col0 + bj * 128 + n * 16);
#pragma unroll
        for (int ai = 0; ai < 2; ++ai)
#pragma unroll
            for (int m = 0; m < 4; ++m) { const size_t off = (size_t)(row0 + ai * 128 + m * 16) * 2048 + col0;
#pragma unroll
                for (int bj = 0; bj < 2; ++bj)
#pragma unroll
                    for (int n = 0; n < 2; ++n) { const f32x4 xv = *(const f32x4*)(x + off + bj * 128 + n * 16);
                        *(f32x4*)(out + off + bj * 128 + n * 16) = xv + g[bj][n] * acc[ai][bj][m][n]; } }
    }
};
struct EpiF32 {
    static constexpr bool PERM = false, MID = false;
    float* C; int ldc;
    __device__ __forceinline__ void operator()(const AccT& acc, const Unit& u, int wr, int wc, int fr, int fq) const {
        const int row0 = u.pm * 256 + wr * 64 + fr, col0 = u.pn * 256 + wc * 32 + 4 * fq;
#pragma unroll
        for (int ai = 0; ai < 2; ++ai)
#pragma unroll
            for (int m = 0; m < 4; ++m) { float* rowp = C + (size_t)(row0 + ai * 128 + m * 16) * ldc + col0;
#pragma unroll
                for (int bj = 0; bj < 2; ++bj)
#pragma unroll
                    for (int n = 0; n < 2; ++n) *(f32x4*)(rowp + bj * 128 + n * 16) = acc[ai][bj][m][n]; }
    }
};

struct Args { const float* in[19]; float* out; unsigned char* ws; int ph_lo, ph_hi; int li, pad; };
struct Frame {
    unsigned char* lds; unsigned char* ws;
    int tid, lane, wave, G, bid;
    const float *x, *c, *w_ada, *b_ada, *g1, *g2, *w_in, *g_q, *g_k, *rel_bias, *pool_w, *pool_scale, *w_ab, *w_pb, *w_out, *w_pq, *peer_keys, *peer_u, *peer_v;
    float* out;
};

template <bool F8OUT = false, class Fn> __device__ __forceinline__ void transpose_item(const float* W, int K, int N, void* WTv, int ldk, int drow0, int k0, float* scr, int lane, Fn srccol, float mul = 1.0f) {
    const int sc = srccol(drow0 + (lane & 31));
#pragma unroll 8
    for (int i = 0; i < 32; ++i) { const int kk = 2 * i + (lane >> 5); scr[kk * 33 + (lane & 31)] = sc >= 0 ? W[(size_t)(k0 + kk) * N + sc] * mul : 0.f; }
    asm volatile("s_waitcnt lgkmcnt(0)" ::: "memory");
    const int c = lane & 7;
#pragma unroll
    for (int j = 0; j < 4; ++j) { const int n = (lane >> 3) + 8 * j; const float* s = scr + (8 * c) * 33 + n;
        if constexpr (F8OUT) { *(u32x2*)((unsigned char*)WTv + (size_t)(drow0 + n) * ldk + k0 + 8 * c) = pack8_fp8((f32x4){s[0 * 33], s[1 * 33], s[2 * 33], s[3 * 33]}, (f32x4){s[4 * 33], s[5 * 33], s[6 * 33], s[7 * 33]}); }
        else { u32x4 o; o.x = cvt_pk_bf16(s[0 * 33], s[1 * 33]); o.y = cvt_pk_bf16(s[2 * 33], s[3 * 33]); o.z = cvt_pk_bf16(s[4 * 33], s[5 * 33]); o.w = cvt_pk_bf16(s[6 * 33], s[7 * 33]);
            *(u32x4*)((bf16_t*)WTv + (size_t)(drow0 + n) * ldk + k0 + 8 * c) = o; } }
    asm volatile("s_waitcnt lgkmcnt(0)" ::: "memory");
}
__device__ __forceinline__ void phase0_prep(Frame& F) {
    F.lane = lane_now(); F.tid = F.wave * 64 + F.lane;
    const int gw = F.bid * 8 + F.wave, NGW = F.G * 8;
    float* scr = (float*)(F.lds + F.wave * 16384);
    constexpr int I_IN16 = (2304 / 32) * (DM / 64), I_IN8 = (5632 / 32) * (DM / 64);
    constexpr int I_AB = (2048 / 32) * (1024 / 64), I_OUT = (2048 / 32) * (2048 / 64), I_PW = 4 * 8 * 4;
    constexpr int NIT = I_IN16 + I_IN8 + 2 * I_AB + 2 * I_OUT + I_PW;
    auto ident = [](int j) { return j; };
    for (int it = gw; it < NIT; it += NGW) {
        int r = it;
        if (r < I_IN16) { const int nb = r % 72, kb = r / 72;
            transpose_item(F.w_in, DM, INW, F.ws + WS_WIN16, DM, nb * 32, kb * 64, scr, F.lane, [](int j) { return j < 1104 ? j + 1536 : (j < 1280 ? -1 : j + 1360); }); continue; }
        r -= I_IN16;
        if (r < I_IN8) { const int nb = r % 176, kb = r / 176;
            transpose_item<true>(F.w_in, DM, INW, F.ws + WS_WIN8, DM, nb * 32, kb * 64, scr, F.lane, [](int j) { return j < 1536 ? j : j + 2128; }, 16.0f); continue; }
        r -= I_IN8;
        if (r < I_AB) { transpose_item(F.w_ab, 1024, 2048, (bf16_t*)(F.ws + WS_WAB), 1024, (r % 64) * 32, (r / 64) * 64, scr, F.lane, ident); continue; }
        r -= I_AB;
        if (r < I_AB) { transpose_item(F.w_pb, 1024, 2048, (bf16_t*)(F.ws + WS_WPB), 1024, (r % 64) * 32, (r / 64) * 64, scr, F.lane, ident); continue; }
        r -= I_AB;
        if (r < I_OUT) { transpose_item(F.w_out, 2048, 2048, (bf16_t*)(F.ws + WS_WOUT), 2048, (r % 64) * 32, (r / 64) * 64, scr, F.lane, ident); continue; }
        r -= I_OUT;
        if (r < I_OUT) { transpose_item(F.w_pq, 2048, 2048, (bf16_t*)(F.ws + WS_WPQ), 2048, (r % 64) * 32, (r / 64) * 64, scr, F.lane, ident); continue; }
        r -= I_OUT;
        { const int g = r / 32, q = r % 32, nb = q % 8, kb = q / 8;
          transpose_item(F.pool_w + (size_t)g * 65536, 256, 256, (bf16_t*)(F.ws + WS_POOLW) + (size_t)g * 65536, 256, nb * 32, kb * 64, scr, F.lane, ident); }
    }
    {
        bf16_t* kb = (bf16_t*)(F.ws + WS_KEYSBD);
        for (int i = F.bid * 512 + F.tid; i < 2048 * 32; i += F.G * 512) {
            const int row = i / 32, k8 = (i % 32) * 8, p = (row >> 7) & 1;
            u32x4 o = (u32x4){0u, 0u, 0u, 0u};
            if ((k8 >> 7) == p) { const float* s = F.peer_keys + (size_t)row * 128 + (k8 & 127); const f32x4 a = *(const f32x4*)s, b = *(const f32x4*)(s + 4); o = pack8(a, b); }
            *(u32x4*)(kb + (size_t)row * 256 + k8) = o;
        }
    }
    {
        unsigned char* pu = F.ws + WS_PU;
        for (size_t i = (size_t)F.bid * 512 + F.tid; i < (size_t)NEXP * 64; i += (size_t)F.G * 512) {
            const float* src = F.peer_u + i * 32;
            u32x16 pk;
#pragma unroll
            for (int k = 0; k < 8; ++k) { const f32x4 a = *(const f32x4*)(src + k * 4) * 96.0f; pk[2 * k] = cvt_pk_bf16(a[0], a[1]); pk[2 * k + 1] = cvt_pk_bf16(a[2], a[3]); }
            const u32x6 p6 = __builtin_amdgcn_cvt_scalef32_pk32_fp6_bf16(__builtin_bit_cast(bf16x32, pk), 1.0f);
            unsigned char* dst = pu + i * 24;
            *(u32x2*)dst = (u32x2){p6[0], p6[1]}; *(u32x2*)(dst + 8) = (u32x2){p6[2], p6[3]}; *(u32x2*)(dst + 16) = (u32x2){p6[4], p6[5]};
        }
        unsigned char* pv = F.ws + WS_PV;
        for (int it = gw; it < (NEXP / 64) * 128; it += NGW) {
            const int e = (it >> 7) * 64 + F.lane, ch = it & 127;
            u32x4 ov;
#pragma unroll
            for (int k = 0; k < 4; ++k) { const f32x4 c = *(const f32x4*)(F.peer_v + (size_t)e * DM + ch * 16 + k * 4) * 4.0f;
                int wv = __builtin_amdgcn_cvt_pk_fp8_f32(c[0], c[1], 0, false); wv = __builtin_amdgcn_cvt_pk_fp8_f32(c[2], c[3], wv, true); ov[k] = (unsigned)wv; }
            *(u32x2*)(pv + ((size_t)(2 * ch) * NEXP + e) * 8) = (u32x2){ov[0], ov[1]};
            *(u32x2*)(pv + ((size_t)(2 * ch + 1) * NEXP + e) * 8) = (u32x2){ov[2], ov[3]};
        }
    }
    {
        __syncthreads();
        float* cact = (float*)(F.lds + 131072);
        float* red = (float*)F.lds;
        float* mp = (float*)(F.ws + WS_MODP);
        for (int it = F.bid; it < 48 * 4; it += F.G) {
            const int cb = it % 48, ds = it / 48, d0 = ds * 512;
            for (int i = F.tid; i < 8 * 512; i += 512) { const int b = i >> 9, d = i & 511; const float cv = F.c[b * DM + d0 + d]; cact[i] = cv * sigmoidf_(cv); }
            __syncthreads();
            f32x4 a[8];
#pragma unroll
            for (int b = 0; b < 8; ++b) a[b] = (f32x4){0.f, 0.f, 0.f, 0.f};
            const float* wp = F.w_ada + (size_t)(d0 + F.wave * 64) * 12288 + cb * 256 + F.lane * 4;
#pragma unroll 4
            for (int d = 0; d < 64; ++d) { const f32x4 w = *(const f32x4*)(wp + (size_t)d * 12288);
#pragma unroll
                for (int b = 0; b < 8; ++b) a[b] += w * cact[b * 512 + F.wave * 64 + d]; }
#pragma unroll
            for (int b = 0; b < 8; ++b)
#pragma unroll
                for (int j = 0; j < 4; ++j) red[(F.wave * 32 + b * 4 + j) * 64 + F.lane] = a[b][j];
            __syncthreads();
            for (int i = F.tid; i < 2048; i += 512) { const int v = i >> 6, l = i & 63; float s = 0.f;
#pragma unroll
                for (int w = 0; w < 8; ++w) s += red[(w * 32 + v) * 64 + l];
                mp[((size_t)ds * 8 + (v >> 2)) * 12288 + cb * 256 + l * 4 + (v & 3)] = s; }
            __syncthreads();
        }
    }
}

template <bool FIRST> __device__ __forceinline__ void phase_modnorm(Frame& F, const float* xin, const float* gain, int off_sh, int off_sc, bf16_t* dst, unsigned char* dst8 = nullptr) {
    F.lane = lane_now(); F.tid = F.wave * 64 + F.lane;
    const float* mp = (const float*)(F.ws + WS_MODP); float* mf = (float*)(F.ws + WS_MODF);
    if (FIRST) {
        for (int i = F.bid * 512 + F.tid; i < 8 * 12288; i += F.G * 512) {
            float s = F.b_ada[i % 12288];
#pragma unroll
            for (int k = 0; k < 4; ++k) s += mp[(size_t)k * 8 * 12288 + i];
            mf[i] = s; }
    }
    float* cA = (float*)F.lds; float* cB = cA + 2048;
    for (int ch = F.bid; ch < MTOK / 128; ch += F.G) {
        const int b = ch / 32;
        __syncthreads();
        for (int col = F.tid; col < 2048; col += 512) {
            float sc, sh;
            if (FIRST) { sc = F.b_ada[off_sc + col]; sh = F.b_ada[off_sh + col];
#pragma unroll
                for (int k = 0; k < 4; ++k) { sc += mp[((size_t)k * 8 + b) * 12288 + off_sc + col]; sh += mp[((size_t)k * 8 + b) * 12288 + off_sh + col]; } }
            else { sc = mf[b * 12288 + off_sc + col]; sh = mf[b * 12288 + off_sh + col]; }
            cA[col] = gain[col] * (1.f + sc); cB[col] = sh; }
        __syncthreads();
        for (int r = F.wave; r < 128; r += 8) {
            const size_t row = (size_t)ch * 128 + r;
            const float* xr = xin + row * 2048 + F.lane * 8;
            f32x4 v[4][2]; float ss = 0.f;
#pragma unroll
            for (int i = 0; i < 4; ++i) { v[i][0] = *(const f32x4*)(xr + i * 512); v[i][1] = *(const f32x4*)(xr + i * 512 + 4);
#pragma unroll
                for (int j = 0; j < 4; ++j) ss += v[i][0][j] * v[i][0][j] + v[i][1][j] * v[i][1][j]; }
            ss = wave_sum(ss);
            const float rinv = 1.0f / sqrtf(ss * (1.0f / 2048.0f) + EPS);
#pragma unroll
            for (int i = 0; i < 4; ++i) { const int col = i * 512 + F.lane * 8;
                const f32x4 a0 = *(const f32x4*)(cA + col), a1 = *(const f32x4*)(cA + col + 4), b0 = *(const f32x4*)(cB + col), b1 = *(const f32x4*)(cB + col + 4);
                const f32x4 y0 = v[i][0] * rinv * a0 + b0, y1 = v[i][1] * rinv * a1 + b1;
                *(u32x4*)(dst + row * 2048 + col) = pack8(y0, y1);
                if (FIRST) *(u32x2*)(dst8 + row * 2048 + col) = pack8_fp8(y0, y1); }
        }
    }
}

__device__ __forceinline__ void phase3_qknorm(Frame& F) {
    F.lane = lane_now(); F.tid = F.wave * 64 + F.lane;
    const bf16_t* q = (const bf16_t*)(F.ws + WS_QN); const bf16_t* k = (const bf16_t*)(F.ws + WS_KN); const bf16_t* v = (const bf16_t*)(F.ws + WS_V);
    unsigned char* q8 = F.ws + WS_Q8; unsigned char* k8 = F.ws + WS_K8; unsigned char* v8 = F.ws + WS_V8;
    const int gw = F.bid * 8 + F.wave, NGW = F.G * 8;
    for (int row = gw; row < MTOK; row += NGW) {
#pragma unroll
        for (int i = 0; i < 2; ++i) { const int ci = i * 64 + F.lane;
            f32x4 a, b; unpack8(*(const u32x4*)(q + (size_t)row * 1024 + ci * 8), a, b);
            float ss = a[0] * a[0] + a[1] * a[1] + a[2] * a[2] + a[3] * a[3] + b[0] * b[0] + b[1] * b[1] + b[2] * b[2] + b[3] * b[3];
            ss = row_sum16(ss);
            const float rinv = 1.0f / sqrtf(ss * (1.0f / 128.0f) + EPS);
            const float* gp = F.g_q + (ci & 15) * 8; const f32x4 g0 = *(const f32x4*)gp, g1 = *(const f32x4*)(gp + 4);
            *(u32x2*)(q8 + (size_t)row * 1024 + ci * 8) = pack8_fp8(a * rinv * g0, b * rinv * g1); }
        { const int ci = F.lane & 31; const bool isk = F.lane < 32;
            f32x4 a, b; unpack8(*(const u32x4*)((isk ? k : v) + (size_t)row * 256 + ci * 8), a, b);
            float ss = a[0] * a[0] + a[1] * a[1] + a[2] * a[2] + a[3] * a[3] + b[0] * b[0] + b[1] * b[1] + b[2] * b[2] + b[3] * b[3];
            ss = row_sum16(ss);
            const float rinv = isk ? 1.0f / sqrtf(ss * (1.0f / 128.0f) + EPS) : 1.0f;
            const float* gp = F.g_k + (ci & 15) * 8; f32x4 g0 = *(const f32x4*)gp, g1 = *(const f32x4*)(gp + 4);
            if (!isk) { g0 = (f32x4){1.f, 1.f, 1.f, 1.f}; g1 = g0; }
            *(u32x2*)((isk ? k8 : v8) + (size_t)row * 256 + ci * 8) = pack8_fp8(a * rinv * g0, b * rinv * g1); }
    }
}
template <int W> __device__ __forceinline__ void pooled_item(const bf16_t* pl, bf16_t* po, int row, int c8) {
    const int t = row & (SEQ - 1);
    f32x4 s0 = (f32x4){0.f, 0.f, 0.f, 0.f}, s1 = s0, x0 = s0, x1 = s0;
    u32x4 v[W];
#pragma unroll
    for (int j = 0; j < W; ++j) v[j] = *(const u32x4*)(pl + (size_t)(row - (j <= t ? j : 0)) * 1024 + c8);
#pragma unroll
    for (int j = 0; j < W; ++j) { f32x4 a, b; unpack8(v[j], a, b); if (j == 0) { x0 = a; x1 = b; } if (j <= t) { s0 += a; s1 += b; } }
    const float inv = 1.0f / (float)((t + 1 < W) ? t + 1 : W);
    *(u32x4*)(po + (size_t)row * 1024 + c8) = pack8(s0 * inv - x0, s1 * inv - x1);
}
__device__ __forceinline__ void phase3_pooled(Frame& F) {
    F.lane = lane_now(); F.tid = F.wave * 64 + F.lane;
    const bf16_t* pl = (const bf16_t*)(F.ws + WS_PL); bf16_t* po = (bf16_t*)(F.ws + WS_POOLED);
    const int gw = F.bid * 8 + F.wave, NGW = F.G * 8;
    for (int it = gw; it < (MTOK / 2) * 4; it += NGW) {
        const int g = it & 3, row = (it >> 2) * 2 + (F.lane >> 5), c8 = g * 256 + (F.lane & 31) * 8;
        if (g == 0) pooled_item<2>(pl, po, row, c8); else if (g == 1) pooled_item<4>(pl, po, row, c8); else if (g == 2) pooled_item<8>(pl, po, row, c8); else pooled_item<16>(pl, po, row, c8);
    }
}
typedef float f32x16 __attribute__((ext_vector_type(16)));
__device__ __forceinline__ int sel_code(float s, float smin, float scale) { const float c = (s - smin) * scale; return (int)fminf(fmaxf(c, 0.f), 65535.f); }
__device__ __forceinline__ void hist_find(const unsigned* hist, int lane, int K, int& bsel, int& above) {
    const u32x4 h = *(const u32x4*)(hist + lane * 4);
    const int S = (int)(h.x + h.y + h.z + h.w);
    int x = S;
    x += __builtin_amdgcn_update_dpp(0, x, 0x101, 0xF, 0xF, true);
    x += __builtin_amdgcn_update_dpp(0, x, 0x102, 0xF, 0xF, true);
    x += __builtin_amdgcn_update_dpp(0, x, 0x104, 0xF, 0xF, true);
    x += __builtin_amdgcn_update_dpp(0, x, 0x108, 0xF, 0xF, true);
    const int t1 = __builtin_amdgcn_readlane(x, 16), t2 = __builtin_amdgcn_readlane(x, 32), t3 = __builtin_amdgcn_readlane(x, 48);
    const int r = lane >> 4;
    x += (r == 0 ? t1 + t2 + t3 : (r == 1 ? t2 + t3 : (r == 2 ? t3 : 0)));
    const int sufn = x - S;
    const bool mine = (x >= K) && (sufn < K);
    int b = 0, ab = 0;
    { int c = sufn;
      if (c + (int)h.w >= K) { b = 3; ab = c; } else { c += (int)h.w;
      if (c + (int)h.z >= K) { b = 2; ab = c; } else { c += (int)h.z;
      if (c + (int)h.y >= K) { b = 1; ab = c; } else { c += (int)h.y; b = 0; ab = c; } } } }
    const unsigned long long m = __ballot(mine);
    const int src = m ? (int)__builtin_ctzll(m) : 0;
    bsel = __builtin_amdgcn_readlane(lane * 4 + b, src); above = __builtin_amdgcn_readlane(ab, src);
}
__device__ __forceinline__ void indexer_select(Frame& F, int b, int t, const float* rowbuf, unsigned* hist, float* eqv, int* eqi) {
    unsigned short* selrow = (unsigned short*)(F.ws + WS_SEL) + (size_t)(b * SEQ + t) * 256;
    int lane = F.lane; asm volatile("" : "+v"(lane));
    const int nch = t / 64 + 1, n4 = (nch + 3) >> 2;
    const f32x4* rb4 = (const f32x4*)rowbuf;
    float mn = __builtin_huge_valf(), mx = -__builtin_huge_valf();
    for (int c4 = 0; c4 < n4; ++c4) { const f32x4 v = rb4[c4 * 64 + lane];
#pragma unroll
        for (int k = 0; k < 4; ++k) { const bool valid = ((c4 * 4 + k) * 64 + lane) <= t; mn = valid ? fminf(mn, v[k]) : mn; mx = valid ? fmaxf(mx, v[k]) : mx; } }
    mx = xor16_max(row_max16(mx)); { const auto r = __builtin_amdgcn_permlane32_swap(__float_as_uint(mx), __float_as_uint(mx), false, false); mx = fmaxf(__uint_as_float(r[0]), __uint_as_float(r[1])); }
    mn = -mn; mn = xor16_max(row_max16(mn)); { const auto r = __builtin_amdgcn_permlane32_swap(__float_as_uint(mn), __float_as_uint(mn), false, false); mn = -fmaxf(__uint_as_float(r[0]), __uint_as_float(r[1])); }
    const float scale = (mx > mn) ? 65535.0f / (mx - mn) : 0.f;
    *(u32x4*)(hist + lane * 4) = (u32x4){0u, 0u, 0u, 0u};
    for (int c4 = 0; c4 < n4; ++c4) { const f32x4 v = rb4[c4 * 64 + lane];
#pragma unroll
        for (int k = 0; k < 4; ++k) { const bool valid = ((c4 * 4 + k) * 64 + lane) <= t; if (valid) atomicAdd(&hist[sel_code(v[k], mn, scale) >> 8], 1u); } }
    int b1, above1; hist_find(hist, lane, KSEL, b1, above1);
    *(u32x4*)(hist + lane * 4) = (u32x4){0u, 0u, 0u, 0u};
    for (int c4 = 0; c4 < n4; ++c4) { const f32x4 v = rb4[c4 * 64 + lane];
#pragma unroll
        for (int k = 0; k < 4; ++k) { const bool valid = ((c4 * 4 + k) * 64 + lane) <= t; const int code = sel_code(v[k], mn, scale); if (valid && (code >> 8) == b1) atomicAdd(&hist[code & 255], 1u); } }
    int b2, above2; hist_find(hist, lane, KSEL - above1, b2, above2);
    const int T16 = (b1 << 8) | b2, need = KSEL - above1 - above2, ceq = (int)hist[b2];
    const unsigned long long lt_mask = (1ull << lane) - 1ull;
    const bool exact = (ceq != need) && (ceq <= 64);
    if (exact) {
        int pos = 0;
        for (int c = 0; c < nch; ++c) { const float sv = rowbuf[((c >> 2) * 64 + lane) * 4 + (c & 3)]; const int idx = c * 64 + lane;
            const bool eq = (idx <= t) && (sel_code(sv, mn, scale) == T16);
            const unsigned long long m = __ballot(eq);
            if (m) { const int p = pos + __popcll(m & lt_mask); if (eq) { eqv[p] = sv; eqi[p] = idx; } pos += __popcll(m); } }
    }
    int pos = 0, eqseen = 0;
    for (int c = 0; c < nch; ++c) {
        const float sv = rowbuf[((c >> 2) * 64 + lane) * 4 + (c & 3)]; const int idx = c * 64 + lane;
        const int code = sel_code(sv, mn, scale); const bool valid = idx <= t;
        const bool gt = valid && code > T16, eq = valid && code == T16;
        const unsigned long long meq = __ballot(eq);
        bool take = gt;
        if (meq) {
            if (ceq == need) take = take || eq;
            else if (exact) { int rank = 0; for (int m = 0; m < ceq; ++m) { const float ov = eqv[m]; const int oi = eqi[m]; rank += (ov > sv || (ov == sv && oi < idx)) ? 1 : 0; } take = take || (eq && rank < need); }
            else { const int er = eqseen + __popcll(meq & lt_mask); take = take || (eq && er < need); eqseen += __popcll(meq); }
        }
        const unsigned long long mt = __ballot(take);
        const int p = pos + __popcll(mt & lt_mask);
        if (take && p < KSEL) selrow[p] = (unsigned short)idx;
        pos += __popcll(mt);
    }
}
__device__ __forceinline__ void indexer_tile(Frame& F, int b, int t0) {
    const bf16_t* iq = (const bf16_t*)(F.ws + WS_IQ); const bf16_t* ik = (const bf16_t*)(F.ws + WS_IK); const float* iw = (const float*)(F.ws + WS_IW);
    int lane = F.lane; asm volatile("" : "+v"(lane));
    const int w = F.wave;
    if (t0 < KSEL) {
        const int t = t0 + w; unsigned short* selrow = (unsigned short*)(F.ws + WS_SEL) + (size_t)(b * SEQ + t) * 256;
#pragma unroll
        for (int p = 0; p < 4; ++p) { const int j = p * 64 + lane; selrow[j] = (unsigned short)(j <= t ? j : 0xFFFF); }
        return;
    }
    float* rowbuf = (float*)F.lds;
    unsigned char* stage = F.lds + 131072;
    const int p = w & 3, kh = w >> 2, hi = lane >> 5, r = lane & 31;
    const size_t qrow = (size_t)b * SEQ + t0 + 2 * p + (r >> 4);
    bf16x8 a[4];
#pragma unroll
    for (int ks = 0; ks < 4; ++ks) a[ks] = *(const bf16x8*)(iq + qrow * 1024 + (r & 15) * 64 + ks * 16 + 8 * hi);
    float wq[2][8];
#pragma unroll
    for (int q = 0; q < 2; ++q)
#pragma unroll
        for (int i = 0; i < 8; ++i) wq[q][i] = iw[((size_t)b * SEQ + t0 + 2 * p + q) * 16 + (i & 3) + 8 * ((i >> 2) & 1) + 4 * hi];
    const int nchunks = (t0 + 7) / 64 + 1;
    const unsigned char* gsrc = (const unsigned char*)(ik + (size_t)b * SEQ * 64) + F.tid * 16;
    const int skey = F.tid >> 3, sc16 = F.tid & 7, soff = skey * 128 + ((sc16 ^ (skey & 7)) << 4);
    u32x4 s0 = *(const u32x4*)gsrc, s1 = s0, s2 = s0, s3 = s0;
    if (1 < nchunks) s1 = *(const u32x4*)(gsrc + (size_t)1 * 8192);
    if (2 < nchunks) s2 = *(const u32x4*)(gsrc + (size_t)2 * 8192);
    if (3 < nchunks) s3 = *(const u32x4*)(gsrc + (size_t)3 * 8192);
    __syncthreads();
#define IDX_STEP(SR, cc) do { const int c = (cc); unsigned char* sb = stage + (c & 1) * 8192; \
        *(u32x4*)(sb + soff) = SR; \
        __syncthreads(); \
        if (c + 4 < nchunks) SR = *(const u32x4*)(gsrc + (size_t)(c + 4) * 8192); \
        f32x16 d; _Pragma("unroll") for (int i = 0; i < 16; ++i) d[i] = 0.f; \
        const int key = kh * 32 + r; \
        _Pragma("unroll") for (int ks = 0; ks < 4; ++ks) { const bf16x8 bf = *(const bf16x8*)(sb + key * 128 + (((ks * 2 + hi) ^ (key & 7)) << 4)); \
            d = __builtin_amdgcn_mfma_f32_32x32x16_bf16(a[ks], bf, d, 0, 0, 0); } \
        float s0_ = 0.f, s1_ = 0.f; \
        _Pragma("unroll") for (int i = 0; i < 8; ++i) { s0_ += wq[0][i] * fmaxf(d[i], 0.f); s1_ += wq[1][i] * fmaxf(d[8 + i], 0.f); } \
        const float sc = swap32_pair(s0_, s1_); \
        rowbuf[(2 * p + hi) * 4096 + ((c >> 2) * 64 + key) * 4 + (c & 3)] = sc; } while (0)
    for (int c4 = 0; c4 < nchunks; c4 += 4) {
        IDX_STEP(s0, c4);
        if (c4 + 1 < nchunks) IDX_STEP(s1, c4 + 1);
        if (c4 + 2 < nchunks) IDX_STEP(s2, c4 + 2);
        if (c4 + 3 < nchunks) IDX_STEP(s3, c4 + 3);
    }
#if PROBE_IDX == 1
    __syncthreads(); s0 = *(const u32x4*)gsrc; s1 = s0; s2 = s0; s3 = s0;
    if (1 < nchunks) s1 = *(const u32x4*)(gsrc + (size_t)1 * 8192);
    if (2 < nchunks) s2 = *(const u32x4*)(gsrc + (size_t)2 * 8192);
    if (3 < nchunks) s3 = *(const u32x4*)(gsrc + (size_t)3 * 8192);
    for (int c4 = 0; c4 < nchunks; c4 += 4) {
        IDX_STEP(s0, c4);
        if (c4 + 1 < nchunks) IDX_STEP(s1, c4 + 1);
        if (c4 + 2 < nchunks) IDX_STEP(s2, c4 + 2);
        if (c4 + 3 < nchunks) IDX_STEP(s3, c4 + 3);
    }
#endif
#undef IDX_STEP
    __syncthreads();
    indexer_select(F, b, t0 + w, rowbuf + w * 4096, (unsigned*)(F.lds + 147456) + w * 256, (float*)(F.lds + 155648) + w * 64, (int*)(F.lds + 155648 + 2048) + w * 64);
#if PROBE_IDX == 2
    indexer_select(F, b, t0 + w, rowbuf + w * 4096, (unsigned*)(F.lds + 147456) + w * 256, (float*)(F.lds + 155648) + w * 64, (int*)(F.lds + 155648 + 2048) + w * 64);
#endif
}
__device__ __forceinline__ void phase3_indexer(Frame& F) {
    F.lane = lane_now(); F.tid = F.wave * 64 + F.lane;
    const int nit = BATCH * (SEQ / 8);
    for (int k = 0;; ++k) {
        const int l = k * F.G + ((k & 1) ? (F.G - 1 - F.bid) : F.bid);
        if (l >= nit) { if (k * F.G >= nit) break; else continue; }
        const int qb = (SEQ / 8 - 1) - (l >> 3), b = l & 7;
        indexer_tile(F, b, qb * 8);
    }
}

__device__ const unsigned char g_bucket[128] = {0, 1, 2, 3, 4, 5, 6, 7, 8, 9, 10, 11, 12, 13, 14, 15, 16, 16, 16, 17, 17, 18, 18, 18, 19, 19, 19, 20, 20, 20, 20, 21, 21, 21, 21, 22, 22, 22, 22, 22, 23, 23, 23, 23, 23, 23, 24, 24, 24, 24, 24, 24, 25, 25, 25, 25, 25, 25, 25, 26, 26, 26, 26, 26, 26, 26, 26, 27, 27, 27, 27, 27, 27, 27, 27, 27, 27, 28, 28, 28, 28, 28, 28, 28, 28, 28, 28, 29, 29, 29, 29, 29, 29, 29, 29, 29, 29, 29, 29, 30, 30, 30, 30, 30, 30, 30, 30, 30, 30, 30, 30, 30, 30, 31, 31, 31, 31, 31, 31, 31, 31, 31, 31, 31, 31, 31, 31, 31};
__device__ __forceinline__ void phase4_attention(Frame& F) {
    F.lane = lane_now(); F.tid = F.wave * 64 + F.lane;
    const unsigned char* q8 = F.ws + WS_Q8; const unsigned char* k8 = F.ws + WS_K8; const unsigned char* v8 = F.ws + WS_V8;
    const unsigned short* sel = (const unsigned short*)(F.ws + WS_SEL); bf16_t* ao = (bf16_t*)(F.ws + WS_ATTN);
    float* btab = (float*)F.lds;
    __syncthreads();
    for (int i = F.tid; i < 256; i += 512) btab[i] = F.rel_bias[i];
    __syncthreads();
    float* Pl = (float*)(F.lds + 4096 + F.wave * 12288); int* idl = (int*)(Pl + 2048); float* psl = (float*)(idl + 256);
    const bool xmap = (F.G % 8) == 0;
    const int gw = xmap ? (F.bid / 8) * 8 + F.wave : F.bid * 8 + F.wave, NGW = xmap ? F.G : F.G * 8, nrows = xmap ? SEQ : MTOK;
    for (int rr = gw; rr < nrows; rr += NGW) {
        int lane = F.lane; asm volatile("" : "+v"(lane));
        const int row = xmap ? (F.bid & 7) * SEQ + rr : rr;
        const int b = row / SEQ, t = row % SEQ, r = lane & 31, hi = lane >> 5;
#pragma unroll
        for (int p = 0; p < 4; ++p) { idl[p * 64 + lane] = (int)sel[(size_t)row * 256 + p * 64 + lane]; }
        long a0[8], a1[8];
        { u32x4 qa[4];
#pragma unroll
          for (int i = 0; i < 4; ++i) qa[i] = (r < 8) ? *(const u32x4*)(q8 + (size_t)row * 1024 + r * 128 + hi * 64 + i * 16) : (u32x4){0u, 0u, 0u, 0u};
#pragma unroll
          for (int ks = 0; ks < 8; ++ks) { const unsigned lo = qa[ks >> 1][(ks & 1) * 2], hh = qa[ks >> 1][(ks & 1) * 2 + 1]; const long v = (long)(((unsigned long long)hh << 32) | lo);
              a0[ks] = (r < 4) ? v : 0l; a1[ks] = (r >= 4) ? v : 0l; } }
        f32x4 psum = (f32x4){0.f, 0.f, 0.f, 0.f};
#define AT_LOADK(buf, kb) do { const int key_ = idl[(kb) * 32 + r]; const int kc_ = key_ <= t ? key_ : 0; const unsigned char* kr_ = k8 + ((size_t)b * SEQ + kc_) * 256 + hi * 64; \
            _Pragma("unroll") for (int i = 0; i < 4; ++i) { buf[i] = *(const u32x4*)(kr_ + i * 16); buf[4 + i] = *(const u32x4*)(kr_ + 128 + i * 16); } } while (0)
#define AT_QK(buf, kb) do { const int key_ = idl[(kb) * 32 + r]; const bool valid_ = key_ <= t; const int kc_ = valid_ ? key_ : 0; \
            f32x16 d; _Pragma("unroll") for (int i = 0; i < 16; ++i) d[i] = 0.f; \
            _Pragma("unroll") for (int ks = 0; ks < 8; ++ks) { const long bv_ = (long)(((unsigned long long)buf[ks >> 1][(ks & 1) * 2 + 1] << 32) | buf[ks >> 1][(ks & 1) * 2]); d = __builtin_amdgcn_mfma_f32_32x32x16_fp8_fp8(a0[ks], bv_, d, 0, 0, 0); } \
            _Pragma("unroll") for (int ks = 0; ks < 8; ++ks) { const long bv_ = (long)(((unsigned long long)buf[4 + (ks >> 1)][(ks & 1) * 2 + 1] << 32) | buf[4 + (ks >> 1)][(ks & 1) * 2]); d = __builtin_amdgcn_mfma_f32_32x32x16_fp8_fp8(a1[ks], bv_, d, 0, 0, 0); } \
            const int dist_ = t - kc_; const int bkt_ = dist_ < 128 ? (int)g_bucket[dist_] : 31; \
            const f32x4 bias_ = *(const f32x4*)(btab + bkt_ * 8 + 4 * hi); f32x4 e_; \
            _Pragma("unroll") for (int i = 0; i < 4; ++i) e_[i] = valid_ ? __expf(d[i] * 0.08838834764831845f + bias_[i]) : 0.f; \
            psum += e_; *(f32x4*)(Pl + ((kb) * 32 + r) * 8 + 4 * hi) = e_; } while (0)
        {
            u32x4 kA[8], kB[8];
            AT_LOADK(kA, 0);
#pragma unroll 1
            for (int kb = 0; kb < 8; kb += 2) {
                AT_LOADK(kB, kb + 1);
                AT_QK(kA, kb);
                if (kb + 2 < 8) AT_LOADK(kA, kb + 2);
                AT_QK(kB, kb + 1);
            }
        }
#undef AT_LOADK
#undef AT_QK
#pragma unroll
        for (int i = 0; i < 4; ++i) psum[i] = xor16_sum(row_sum16(psum[i]));
        if (r == 0) *(f32x4*)(psl + 4 * hi) = psum;
        const int ks = lane >> 4, g = (lane >> 3) & 1, dc = lane & 7;
        float acc[4][16];
#pragma unroll
        for (int h = 0; h < 4; ++h)
#pragma unroll
            for (int j = 0; j < 16; ++j) acc[h][j] = 0.f;
#define AT_LOADV(buf, it0) do { _Pragma("unroll") for (int u = 0; u < 4; ++u) { const int key_ = idl[((it0) + u) * 4 + ks]; const int kc_ = key_ <= t ? key_ : 0; \
            buf[u] = *(const u32x4*)(v8 + ((size_t)b * SEQ + kc_) * 256 + g * 128 + dc * 16); } } while (0)
#define AT_PV(buf, it0) do { _Pragma("unroll") for (int u = 0; u < 4; ++u) { const int j_ = ((it0) + u) * 4 + ks; const u32x4 w = buf[u]; \
            const f32x4 p = *(const f32x4*)(Pl + j_ * 8 + 4 * g); \
            _Pragma("unroll") for (int dd = 0; dd < 4; ++dd) { const f32x2 lo = __builtin_amdgcn_cvt_pk_f32_fp8((int)w[dd], false), hh_ = __builtin_amdgcn_cvt_pk_f32_fp8((int)w[dd], true); \
                _Pragma("unroll") for (int h = 0; h < 4; ++h) { acc[h][4 * dd] += p[h] * lo.x; acc[h][4 * dd + 1] += p[h] * lo.y; acc[h][4 * dd + 2] += p[h] * hh_.x; acc[h][4 * dd + 3] += p[h] * hh_.y; } } } } while (0)
        {
            u32x4 vA[4], vB[4];
            AT_LOADV(vA, 0);
#pragma unroll 1
            for (int it0 = 0; it0 < 64; it0 += 8) {
                AT_LOADV(vB, it0 + 4);
                AT_PV(vA, it0);
                if (it0 + 8 < 64) AT_LOADV(vA, it0 + 8);
                AT_PV(vB, it0 + 4);
            }
        }
#undef AT_LOADV
#undef AT_PV
#pragma unroll
        for (int h = 0; h < 4; ++h)
#pragma unroll
            for (int j = 0; j < 16; ++j) acc[h][j] = xor32_sum(xor16_sum(acc[h][j]));
#pragma unroll
        for (int h = 0; h < 4; ++h) if (h == ks) { const float inv = 1.0f / psl[4 * g + h];
            bf16_t* op = ao + (size_t)row * 1024 + (4 * g + h) * 128 + dc * 16;
            *(u32x4*)op = pack8((f32x4){acc[h][0], acc[h][1], acc[h][2], acc[h][3]} * inv, (f32x4){acc[h][4], acc[h][5], acc[h][6], acc[h][7]} * inv);
            *(u32x4*)(op + 8) = pack8((f32x4){acc[h][8], acc[h][9], acc[h][10], acc[h][11]} * inv, (f32x4){acc[h][12], acc[h][13], acc[h][14], acc[h][15]} * inv); }
    }
}

__device__ __forceinline__ float dot16f8(u32x4 w, const float* h) {
    float s = 0.f;
#pragma unroll
    for (int d = 0; d < 4; ++d) { const f32x2 lo = __builtin_amdgcn_cvt_pk_f32_fp8((int)w[d], false), hi = __builtin_amdgcn_cvt_pk_f32_fp8((int)w[d], true);
        s += lo.x * h[4 * d] + lo.y * h[4 * d + 1] + hi.x * h[4 * d + 2] + hi.y * h[4 * d + 3]; }
    return s;
}
__device__ __forceinline__ void fma16f8(u32x4 w, float cf, float* acc) {
#pragma unroll
    for (int d = 0; d < 4; ++d) { const f32x2 lo = __builtin_amdgcn_cvt_pk_f32_fp8((int)w[d], false), hi = __builtin_amdgcn_cvt_pk_f32_fp8((int)w[d], true);
        acc[4 * d] += cf * lo.x; acc[4 * d + 1] += cf * lo.y; acc[4 * d + 2] += cf * hi.x; acc[4 * d + 3] += cf * hi.y; }
}
__device__ __forceinline__ float gelu_erf(float x) { return 0.5f * x * (1.0f + erff(x * 0.70710678118654752f)); }
__device__ __forceinline__ void ce_k(unsigned& a, unsigned& b) { const unsigned hi = a > b ? a : b, lo = a > b ? b : a; a = hi; b = lo; }
__device__ __forceinline__ void ce_kp(unsigned& ka, unsigned& pa, unsigned& kb, unsigned& pb) { const bool sw = kb > ka; const unsigned k0 = sw ? kb : ka, k1 = sw ? ka : kb, p0 = sw ? pb : pa, p1 = sw ? pa : pb; ka = k0; kb = k1; pa = p0; pb = p1; }
__device__ __forceinline__ void bmerge16(unsigned (&x)[16]) {
#pragma unroll
    for (int jj = 0; jj < 4; ++jj) { const int j = 8 >> jj;
#pragma unroll
        for (int i = 0; i < 16; ++i) { const int l = i ^ j; if (l > i) ce_k(x[i], x[l]); }
        __builtin_amdgcn_sched_barrier(0); }
}
__device__ __forceinline__ void bmerge16p(unsigned (&x)[16], unsigned (&p)[16]) {
#pragma unroll
    for (int jj = 0; jj < 4; ++jj) { const int j = 8 >> jj;
#pragma unroll
        for (int i = 0; i < 16; ++i) { const int l = i ^ j; if (l > i) ce_kp(x[i], p[i], x[l], p[l]); }
        __builtin_amdgcn_sched_barrier(0); }
}
__device__ __forceinline__ void bsort16(unsigned (&x)[16]) {
#pragma unroll
    for (int kk = 1; kk <= 4; ++kk) { const int k = 1 << kk;
#pragma unroll
        for (int jj = 0; jj < 4; ++jj) { const int j = (k >> 1) >> jj;
            if (j > 0) {
#pragma unroll
                for (int i = 0; i < 16; ++i) { const int l = i ^ j; if (l > i) { if ((i & k) == 0) ce_k(x[i], x[l]); else ce_k(x[l], x[i]); } }
                __builtin_amdgcn_sched_barrier(0); } } }
}
__device__ __forceinline__ void bsort16p(unsigned (&x)[16], unsigned (&p)[16]) {
#pragma unroll
    for (int kk = 1; kk <= 4; ++kk) { const int k = 1 << kk;
#pragma unroll
        for (int jj = 0; jj < 4; ++jj) { const int j = (k >> 1) >> jj;
            if (j > 0) {
#pragma unroll
                for (int i = 0; i < 16; ++i) { const int l = i ^ j; if (l > i) { if ((i & k) == 0) ce_kp(x[i], p[i], x[l], p[l]); else ce_kp(x[l], p[l], x[i], p[i]); } }
                __builtin_amdgcn_sched_barrier(0); } } }
}
__device__ __forceinline__ void top16_row(const unsigned char* rowp, unsigned (&t)[16]) {
#pragma unroll
    for (int i = 0; i < 16; ++i) t[i] = 0u;
#pragma unroll 1
    for (int g = 0; g < 8; ++g) {
        unsigned w[8];
#pragma unroll
        for (int q = 0; q < 4; ++q) { const u32x2 v = *(const u32x2*)(rowp + g * 32 + q * 8); w[2 * q] = v.x; w[2 * q + 1] = v.y; }
        unsigned sk[16];
#pragma unroll
        for (int d = 0; d < 8; ++d) {
            const unsigned lo = w[d] << 16, hi = w[d];
            const unsigned xl = lo ^ ((unsigned)((int)lo >> 31) | 0x80000000u), xh = hi ^ ((unsigned)((int)hi >> 31) | 0x80000000u);
            sk[2 * d] = ((xl >> 9) & 0xFFFFFF80u) | (unsigned)(127 - (g * 16 + 2 * d));
            sk[2 * d + 1] = ((xh >> 9) & 0xFFFFFF80u) | (unsigned)(127 - (g * 16 + 2 * d + 1)); }
        bsort16(sk);
#pragma unroll
        for (int i = 0; i < 16; ++i) t[i] = t[i] > sk[15 - i] ? t[i] : sk[15 - i];
        bmerge16(t);
    }
}
__device__ __forceinline__ float key_val(unsigned key) { const unsigned y = (key << 9) & 0xFFFF0000u; return __uint_as_float((y ^ (~(unsigned)((int)y >> 31) | 0x80000000u)) & 0xFFFF0000u); }
__device__ __forceinline__ unsigned sum_key(float s, int c) { const unsigned u = __float_as_uint(s); return ((u ^ ((unsigned)((int)u >> 31) | 0x80000000u)) & ~63u) | (unsigned)(63 - c); }
__device__ __forceinline__ float sum_val(unsigned k) { const unsigned y = k & ~63u; return __uint_as_float(y ^ (~(unsigned)((int)y >> 31) | 0x80000000u)); }
typedef __bf16 bf2_t __attribute__((ext_vector_type(2)));
__device__ __forceinline__ float dot2_bf(unsigned a, unsigned b, float c) { return __builtin_amdgcn_fdot2_f32_bf16(__builtin_bit_cast(bf2_t, a), __builtin_bit_cast(bf2_t, b), c, false); }
__device__ __forceinline__ float dot32_f6b(u32x4 wa, u32x2 wb, u32x4 h0, u32x4 h1, u32x4 h2, u32x4 h3) {
    const bf16x32 dec = __builtin_amdgcn_cvt_scalef32_pk32_bf16_fp6((u32x6){wa.x, wa.y, wa.z, wa.w, wb.x, wb.y}, 1.0f);
    const u32x16 ud = __builtin_bit_cast(u32x16, dec);
    float acc = 0.f;
    acc = dot2_bf(ud.s0, h0.x, acc); acc = dot2_bf(ud.s1, h0.y, acc); acc = dot2_bf(ud.s2, h0.z, acc); acc = dot2_bf(ud.s3, h0.w, acc);
    acc = dot2_bf(ud.s4, h1.x, acc); acc = dot2_bf(ud.s5, h1.y, acc); acc = dot2_bf(ud.s6, h1.z, acc); acc = dot2_bf(ud.s7, h1.w, acc);
    acc = dot2_bf(ud.s8, h2.x, acc); acc = dot2_bf(ud.s9, h2.y, acc); acc = dot2_bf(ud.sa, h2.z, acc); acc = dot2_bf(ud.sb, h2.w, acc);
    acc = dot2_bf(ud.sc, h3.x, acc); acc = dot2_bf(ud.sd, h3.y, acc); acc = dot2_bf(ud.se, h3.z, acc); acc = dot2_bf(ud.sf, h3.w, acc);
    return acc;
}
__device__ const unsigned char g_cab[64] = {0, 1, 2, 3, 4, 5, 6, 7, 8, 9, 10, 11, 12, 13, 14, 15, 16, 17, 18, 19, 20, 21, 22, 23, 32, 33, 34, 35, 36, 48, 49, 50, 51, 64, 65, 66, 80, 81, 96, 97, 112, 113, 128, 144, 160, 176, 192, 208, 224, 240, 0, 0, 0, 0, 0, 0, 0, 0, 0, 0, 0, 0, 0, 0};
__device__ __forceinline__ void phase10_peer(Frame& F) {
    F.lane = lane_now(); F.tid = F.wave * 64 + F.lane;
    const bf16_t* sub = (const bf16_t*)(F.ws + WS_SUB); const bf16_t* h2 = (const bf16_t*)(F.ws + WS_H2);
    const unsigned char* pu = F.ws + WS_PU; unsigned* pairs = (unsigned*)(F.ws + WS_PAIRS);
    const int gw = F.bid * 8 + F.wave, NGW = F.G * 8;
    unsigned char* wb = F.lds + F.wave * 19200;
    unsigned char* h2b = wb; unsigned short* gl16 = (unsigned short*)(wb + 16896); unsigned* hist = (unsigned*)(wb + 18944); unsigned* base = hist + 32;
    unsigned* tmp = (unsigned*)wb;
    unsigned* wls0 = (unsigned*)(F.ws + WS_WLS) + (size_t)gw * 1024;
    const int ntok = (MTOK - gw + NGW - 1) / NGW;
    constexpr int CA[50] = {0,0,0,0,0,0,0,0,0,0,0,0,0,0,0,0, 1,1,1,1,1,1,1,1, 2,2,2,2,2, 3,3,3,3, 4,4,4, 5,5, 6,6, 7,7, 8,9,10,11,12,13,14,15};
    constexpr int CB[50] = {0,1,2,3,4,5,6,7,8,9,10,11,12,13,14,15, 0,1,2,3,4,5,6,7, 0,1,2,3,4, 0,1,2,3, 0,1,2, 0,1, 0,1, 0,1, 0,0,0,0,0,0,0,0};
    for (int p0 = 0; p0 < ntok; p0 += 8) {
        int lane = F.lane; asm volatile("" : "+v"(lane));
        const int nt = (ntok - p0) < 8 ? (ntok - p0) : 8;
        {
            u32x4 st[16];
#define SEL_LOAD(half) do { asm volatile("" : "+v"(lane)); const int srow_l = lane >> 4, scol = lane & 15; _Pragma("unroll") for (int it = 0; it < 16; ++it) { const int r_ = it * 4 + srow_l; int ti_ = r_ >> 3; ti_ = ti_ < nt ? ti_ : nt - 1; \
                st[it] = *(const u32x4*)(sub + (size_t)(gw + (p0 + ti_) * NGW) * 2048 + (r_ & 7) * 256 + (half) * 128 + scol * 8); } } while (0)
#define SEL_STORE() do { const int srow_l = lane >> 4, scol = lane & 15; _Pragma("unroll") for (int it = 0; it < 16; ++it) { unsigned char* d_ = wb + (it * 4 + srow_l) * 264 + scol * 16; \
                *(u32x2*)d_ = (u32x2){st[it].x, st[it].y}; *(u32x2*)(d_ + 8) = (u32x2){st[it].z, st[it].w}; } } while (0)
            unsigned tA[16], tB[16];
            SEL_LOAD(0); SEL_STORE();
            __builtin_amdgcn_sched_barrier(0);
            top16_row(wb + lane * 264, tA);
            __builtin_amdgcn_sched_barrier(0);
            asm volatile("" : "+v"(tA[0]), "+v"(tA[1]), "+v"(tA[2]), "+v"(tA[3]), "+v"(tA[4]), "+v"(tA[5]), "+v"(tA[6]), "+v"(tA[7]), "+v"(tA[8]), "+v"(tA[9]), "+v"(tA[10]), "+v"(tA[11]), "+v"(tA[12]), "+v"(tA[13]), "+v"(tA[14]), "+v"(tA[15]) :: "memory");
            SEL_LOAD(1); SEL_STORE();
            __builtin_amdgcn_sched_barrier(0);
            top16_row(wb + lane * 264, tB);
            __builtin_amdgcn_sched_barrier(0);
#undef SEL_LOAD
#undef SEL_STORE
            float vA[16], vB[16];
            { unsigned pa[4] = {0u, 0u, 0u, 0u}, pb[4] = {0u, 0u, 0u, 0u};
#pragma unroll
              for (int i = 0; i < 16; ++i) { vA[i] = key_val(tA[i]); vB[i] = key_val(tB[i]); pa[i >> 2] |= (127u - (tA[i] & 127u)) << (8 * (i & 3)); pb[i >> 2] |= (127u - (tB[i] & 127u)) << (8 * (i & 3)); }
              unsigned char* rp = wb + lane * 264;
              *(u32x2*)rp = (u32x2){pa[0], pa[1]}; *(u32x2*)(rp + 8) = (u32x2){pa[2], pa[3]}; *(u32x2*)(rp + 16) = (u32x2){pb[0], pb[1]}; *(u32x2*)(rp + 24) = (u32x2){pb[2], pb[3]}; }
            unsigned tk[16];
#pragma unroll
            for (int c = 0; c < 16; ++c) tk[c] = sum_key(vA[CA[c]] + vB[CB[c]], c);
            bsort16(tk);
#pragma unroll
            for (int grp = 1; grp < 3; ++grp) {
                unsigned sk[16];
#pragma unroll
                for (int e = 0; e < 16; ++e) { const int c = grp * 16 + e; sk[e] = sum_key(vA[CA[c]] + vB[CB[c]], c); }
                bsort16(sk);
#pragma unroll
                for (int i = 0; i < 16; ++i) tk[i] = tk[i] > sk[15 - i] ? tk[i] : sk[15 - i];
                bmerge16(tk);
            }
#pragma unroll
            for (int c = 48; c < 50; ++c) { unsigned k = sum_key(vA[CA[c]] + vB[CB[c]], c);
#pragma unroll
                for (int i = 0; i < 16; ++i) ce_k(tk[i], k); }
            const float s0 = sum_val(tk[0]); float ev[16], esum = 0.f;
#pragma unroll
            for (int r = 0; r < 16; ++r) { ev[r] = __expf(sum_val(tk[r]) - s0); esum += ev[r]; }
            const float einv = 1.0f / esum;
            unsigned eid[16];
            { const unsigned char* rp = wb + lane * 264;
#pragma unroll
              for (int r = 0; r < 16; ++r) { const unsigned cab = g_cab[63u - (tk[r] & 63u)]; eid[r] = (unsigned)rp[cab >> 4] * 128u + (unsigned)rp[16 + (cab & 15u)]; } }
            if ((lane >> 3) < nt) {
#pragma unroll
                for (int r = 0; r < 16; ++r) { const int e = lane * 16 + r; tmp[e] = ((unsigned)e << 14) | eid[r]; gl16[e] = (unsigned short)(cvt_pk_bf16(ev[r] * einv, 0.f) & 0xffffu); } }
        }
        asm volatile("" : "+v"(lane));
#pragma unroll 1
        for (int grp = 0; grp < 2; ++grp) {
            const int ng = nt - grp * 4; const int ne = (ng <= 0 ? 0 : (ng < 4 ? ng : 4)) * 128;
            if (ne == 0) break;
            unsigned* wls = wls0 + grp * 512;
            if (lane < 32) hist[lane] = 0u;
            unsigned ent[8]; unsigned rk[8];
#pragma unroll
            for (int q = 0; q < 8; ++q) { const int e = q * 64 + lane; ent[q] = (e < ne) ? tmp[grp * 512 + e] : 0u; rk[q] = (e < ne) ? atomicAdd(&hist[(ent[q] & 0x3FFFu) >> 9], 1u) : 0u; }
            { int hv = lane < 32 ? (int)hist[lane] : 0; int x = hv;
              x += __builtin_amdgcn_update_dpp(0, x, 0x111, 0xF, 0xF, true); x += __builtin_amdgcn_update_dpp(0, x, 0x112, 0xF, 0xF, true);
              x += __builtin_amdgcn_update_dpp(0, x, 0x114, 0xF, 0xF, true); x += __builtin_amdgcn_update_dpp(0, x, 0x118, 0xF, 0xF, true);
              const int t0 = __builtin_amdgcn_readlane(x, 15); if (lane >= 16) x += t0;
              if (lane < 32) base[lane] = (unsigned)(x - hv); }
#pragma unroll
            for (int q = 0; q < 8; ++q) { const int e = q * 64 + lane; if (e < ne) wls[base[(ent[q] & 0x3FFFu) >> 9] + rk[q]] = ent[q]; }
        }
        asm volatile("s_waitcnt vmcnt(0)" ::: "memory");
#pragma unroll 1
        for (int grp = 0; grp < 2; ++grp) {
            const int ng = nt - grp * 4; const int ngc = ng <= 0 ? 0 : (ng < 4 ? ng : 4), ne = ngc * 128;
            if (ne == 0) break;
            const unsigned* wls = wls0 + grp * 512;
            asm volatile("" : "+v"(lane));
#pragma unroll 1
            for (int i = 0; i < ngc; ++i) { const bf16_t* hr = h2 + (size_t)(gw + (p0 + grp * 4 + i) * NGW) * 2048 + lane * 32;
#pragma unroll
                for (int q = 0; q < 4; ++q) *(u32x4*)(h2b + i * 4096 + q * 1024 + lane * 16) = *(const u32x4*)(hr + q * 8); }
            unsigned entn = __hip_atomic_load(wls + lane, __ATOMIC_RELAXED, __HIP_MEMORY_SCOPE_AGENT);
#pragma unroll 1
            for (int c = 0; c < ne; c += 64) {
                const unsigned ent64 = entn;
                if (c + 64 < ne) entn = __hip_atomic_load(wls + c + 64 + lane, __ATOMIC_RELAXED, __HIP_MEMORY_SCOPE_AGENT);
#pragma unroll 1
                for (int i0 = 0; i0 < 64; i0 += 8) {
                    u32x4 wA[8]; u32x2 wB[8]; unsigned en[8];
#pragma unroll
                    for (int jj = 0; jj < 8; ++jj) { en[jj] = (unsigned)__builtin_amdgcn_readlane((int)ent64, i0 + jj); const unsigned char* ur = pu + (size_t)(en[jj] & 0x3FFFu) * 1536 + lane * 24;
                        const u32x2 t0 = *(const u32x2*)ur, t1 = *(const u32x2*)(ur + 8); wA[jj] = (u32x4){t0.x, t0.y, t1.x, t1.y}; wB[jj] = *(const u32x2*)(ur + 16); }
                    float pr[8];
#pragma unroll
                    for (int jj = 0; jj < 8; ++jj) { const unsigned char* hp = h2b + ((en[jj] >> 21) & 3u) * 4096 + lane * 16;
                        pr[jj] = dot32_f6b(wA[jj], wB[jj], *(const u32x4*)hp, *(const u32x4*)(hp + 1024), *(const u32x4*)(hp + 2048), *(const u32x4*)(hp + 3072)); __builtin_amdgcn_sched_barrier(0); }
#pragma unroll
                    for (int i = 0; i < 4; ++i) pr[i] = swap32_pair(pr[i], pr[i + 4]);
#pragma unroll
                    for (int i = 0; i < 2; ++i) pr[i] = swap16_pair(pr[i], pr[i + 2]);
                    const bool b3 = (lane & 8) != 0;
                    { const float snd = b3 ? pr[0] : pr[1], kp = b3 ? pr[1] : pr[0]; pr[0] = kp + dpp_f<DPP_ROR8>(snd); }
                    float tot = pr[0]; tot += dpp_f<DPP_XOR1>(tot); tot += dpp_f<DPP_XOR2>(tot); tot += dpp_f<DPP_HMIRROR>(tot);
                    const unsigned em = (unsigned)__shfl((int)ent64, i0 + (lane >> 3));
                    if ((lane & 7) == 0) {
                        const int ti = (int)(em >> 21), j = (int)((em >> 14) & 127u), row = gw + (p0 + ti) * NGW;
                        const float cf = gelu_erf(tot * (1.0f / 96.0f)) * __uint_as_float((unsigned)gl16[(em >> 14) & 1023u] << 16);
                        pairs[((size_t)(row >> 6) * 128 + j) * 64 + (row & 63)] = (cvt_pk_bf16(0.f, cf) & 0xffff0000u) | (em & 0x3FFFu);
                    }
                }
            }
        }
    }
}

__device__ __forceinline__ void phase11_peer_v(Frame& F, float* dst) {
    F.lane = lane_now(); F.tid = F.wave * 64 + F.lane;
    const unsigned* pairs = (const unsigned*)(F.ws + WS_PAIRS); const float* mf = (const float*)(F.ws + WS_MODF);
    unsigned long long* vs = (unsigned long long*)F.lds;
    for (int c = F.bid; c < DM / 8; c += F.G) {
        __syncthreads();
        { const u32x4* src = (const u32x4*)(F.ws + WS_PV + (size_t)c * NEXP * 8); u32x4* dst = (u32x4*)F.lds;
#pragma unroll 4
          for (int i = F.tid; i < NEXP * 8 / 16; i += 512) dst[i] = src[i]; }
        __syncthreads();
        for (int tile = F.wave; tile < MTOK / 64; tile += 8) {
            int lane = F.lane; asm volatile("" : "+v"(lane));
            const unsigned* pp = pairs + (size_t)tile * 128 * 64 + lane;
            const int row = tile * 64 + lane;
            const float* gt2 = mf + (size_t)(tile / (SEQ / 64)) * 12288 + 10240 + c * 8;
            const float* ip = F.out + (size_t)row * 2048 + c * 8; float* op = dst + (size_t)row * 2048 + c * 8;
            const f32x4 x0 = *(const f32x4*)ip, x1 = *(const f32x4*)(ip + 4), g0 = *(const f32x4*)gt2 * 0.25f, g1 = *(const f32x4*)(gt2 + 4) * 0.25f;
            f32x2 acc[4];
#pragma unroll
            for (int i = 0; i < 4; ++i) acc[i] = (f32x2){0.f, 0.f};
#define P11_LOAD(dst, j0) do { _Pragma("unroll") for (int jj = 0; jj < 16; ++jj) dst[jj] = pp[((j0) + jj) * 64]; } while (0)
#define P11_COMP(src) do { _Pragma("unroll") for (int jj = 0; jj < 16; ++jj) { const unsigned long long v = vs[src[jj] & 0x3FFFu]; const float cf = __uint_as_float(src[jj] & 0xffff0000u); \
                    const int lo = (int)(unsigned)v, hi = (int)(unsigned)(v >> 32); \
                    acc[0] += __builtin_amdgcn_cvt_pk_f32_fp8(lo, false) * cf; acc[1] += __builtin_amdgcn_cvt_pk_f32_fp8(lo, true) * cf; \
                    acc[2] += __builtin_amdgcn_cvt_pk_f32_fp8(hi, false) * cf; acc[3] += __builtin_amdgcn_cvt_pk_f32_fp8(hi, true) * cf; } } while (0)
#if PROBE_P11X
            { f32x2 sv[4]; for (int i = 0; i < 4; ++i) sv[i] = acc[i];
            unsigned pa[16], pb[16];
            P11_LOAD(pa, 0);
#pragma unroll 1
            for (int j0 = 0; j0 < 128; j0 += 32) {
                P11_LOAD(pb, j0 + 16);
                P11_COMP(pa);
                if (j0 + 32 < 128) P11_LOAD(pa, j0 + 32);
                P11_COMP(pb);
            }
              asm volatile("" :: "v"(acc[0].x), "v"(acc[1].x), "v"(acc[2].x), "v"(acc[3].x)); for (int i = 0; i < 4; ++i) acc[i] = sv[i] * 0.f; }
#endif
            unsigned pa[16], pb[16];
            P11_LOAD(pa, 0);
#pragma unroll 1
            for (int j0 = 0; j0 < 128; j0 += 32) {
                P11_LOAD(pb, j0 + 16);
                P11_COMP(pa);
                if (j0 + 32 < 128) P11_LOAD(pa, j0 + 32);
                P11_COMP(pb);
            }
#undef P11_LOAD
#undef P11_COMP
            *(f32x4*)op = x0 + g0 * (f32x4){acc[0].x, acc[0].y, acc[1].x, acc[1].y};
            *(f32x4*)(op + 4) = x1 + g1 * (f32x4){acc[2].x, acc[2].y, acc[3].x, acc[3].y};
        }
    }
}

__global__ void __launch_bounds__(512, 2) fwd_kernel(Args args) {
    extern __shared__ __attribute__((aligned(16))) unsigned char lds[];
    Frame F;
    F.lds = lds; F.ws = args.ws; F.tid = threadIdx.x; F.lane = F.tid & 63; F.wave = __builtin_amdgcn_readfirstlane(F.tid >> 6); F.G = gridDim.x; F.bid = blockIdx.x;
    F.x = args.in[0]; F.c = args.in[1]; F.w_ada = args.in[2]; F.b_ada = args.in[3]; F.g1 = args.in[4]; F.g2 = args.in[5]; F.w_in = args.in[6]; F.g_q = args.in[7]; F.g_k = args.in[8];
    F.rel_bias = args.in[9]; F.pool_w = args.in[10]; F.pool_scale = args.in[11]; F.w_ab = args.in[12]; F.w_pb = args.in[13]; F.w_out = args.in[14]; F.w_pq = args.in[15];
    F.peer_keys = args.in[16]; F.peer_u = args.in[17]; F.peer_v = args.in[18]; F.out = args.out;
    LAS unsigned char* ldsl = (LAS unsigned char*)lds;
    volatile LAS unsigned* misc = (volatile LAS unsigned*)(ldsl + MISC_OFF);
    if (F.tid < 4) misc[F.tid] = 0u;
    __syncthreads();
    unsigned* barw = (unsigned*)(args.ws + WS_CTL) + (size_t)args.li * XCD_BAR_WORDS;
    XcdBarrier bar; bar.bar = barw; bar.x = 0; bar.st = misc;
    const int lo = args.ph_lo, hi = args.ph_hi;
    if (hi - lo > 1) bar = xcd_barrier_post(barw, misc);
#define IN(k) (lo <= (k) && (k) < hi)
#define SEAM(k) do { if (IN(k) && IN((k) + 1)) xcd_barrier(bar, F.wave); } while (0)
    bf16_t* R0 = (bf16_t*)(F.ws + WS_R0);

#define PH2_BODY { \
        { pg8::Gemm g{(const bf16_t*)(F.ws + WS_H1F8), (const bf16_t*)(F.ws + WS_WIN8), MTOK, 5632, DM / 2, DM / 2, 0, nullptr, nullptr, 0, 0}; pg8::StaticOrder S; S.init(MTOK, 5632, F.G, F.bid); \
          EpiInproj<true> E{(bf16_t*)(F.ws + WS_QN), (bf16_t*)(F.ws + WS_KN), (bf16_t*)(F.ws + WS_V), (bf16_t*)(F.ws + WS_IQ), (bf16_t*)(F.ws + WS_IK), (bf16_t*)(F.ws + WS_PL), \
                    (bf16_t*)(F.ws + WS_GA), (bf16_t*)(F.ws + WS_GP), (float*)(F.ws + WS_IW)}; \
          pg8::gemm_phase<EpiInproj<true>, true>(ldsl, g, S, E, F.wave); } \
        { pg8::Gemm g{R0, (const bf16_t*)(F.ws + WS_WIN16), MTOK, 2304, DM, DM, 0, nullptr, nullptr, 0, 0}; pg8::StaticOrder S; S.init(MTOK, 2304, F.G, F.bid); \
          EpiInproj<false> E{(bf16_t*)(F.ws + WS_QN), (bf16_t*)(F.ws + WS_KN), (bf16_t*)(F.ws + WS_V), (bf16_t*)(F.ws + WS_IQ), (bf16_t*)(F.ws + WS_IK), (bf16_t*)(F.ws + WS_PL), \
                    (bf16_t*)(F.ws + WS_GA), (bf16_t*)(F.ws + WS_GP), (float*)(F.ws + WS_IW)}; \
          pg8::gemm_phase<EpiInproj<false>>(ldsl, g, S, E, F.wave); } }
#define PH3_BODY { phase3_pooled(F); phase3_indexer(F); __syncthreads(); }
#define PH4_BODY { \
        phase4_attention(F); \
        __syncthreads(); \
        pg8::Gemm g{(const bf16_t*)(F.ws + WS_POOLED), (const bf16_t*)(F.ws + WS_POOLW), MTOK, PW, 256, 1024, 256, nullptr, nullptr, 0, 0}; pg8::StaticOrder S; S.init(MTOK, PW, F.G, F.bid); \
        EpiBf16Scale E{(bf16_t*)(F.ws + WS_POOL2), 1024, F.pool_scale}; \
        pg8::gemm_phase<EpiBf16Scale>(ldsl, g, S, E, F.wave); }
#define PH5_BODY { \
        pg8::Gemm g{(const bf16_t*)(F.ws + WS_ATTN), (const bf16_t*)(F.ws + WS_WAB), MTOK, DM, 2048, 1024, 0, (const bf16_t*)(F.ws + WS_POOL2), (const bf16_t*)(F.ws + WS_WPB), 16, 1024}; \
        pg8::StaticOrder S; S.init(MTOK, DM, F.G, F.bid); \
        EpiMerge E{R0, (const bf16_t*)(F.ws + WS_GA), (const bf16_t*)(F.ws + WS_GP)}; pg8::gemm_phase<EpiMerge>(ldsl, g, S, E, F.wave); }
#define PH6_BODY { \
        pg8::Gemm g{R0, (const bf16_t*)(F.ws + WS_WOUT), MTOK, DM, DM, DM, 0, nullptr, nullptr, 0, 0}; pg8::StaticOrder S; S.init(MTOK, DM, F.G, F.bid); \
        EpiResid E{F.x, F.out, (const float*)(F.ws + WS_MODF) + 4096}; pg8::gemm_phase<EpiResid>(ldsl, g, S, E, F.wave); }
#define PH8_BODY { \
        pg8::Gemm g{(const bf16_t*)(F.ws + WS_H2), (const bf16_t*)(F.ws + WS_WPQ), MTOK, DM, DM, DM, 0, nullptr, nullptr, 0, 0}; pg8::StaticOrder S; S.init(MTOK, DM, F.G, F.bid); \
        EpiBf16Scale E{R0, 2048, nullptr}; pg8::gemm_phase<EpiBf16Scale>(ldsl, g, S, E, F.wave); }
#define PH9_BODY { \
        pg8::Gemm g{R0, (const bf16_t*)(F.ws + WS_KEYSBD), MTOK, DM, 256, DM, 256, nullptr, nullptr, 0, 0}; pg8::StaticOrder S; S.init(MTOK, DM, F.G, F.bid); \
        EpiBf16Scale E{(bf16_t*)(F.ws + WS_SUB), 2048, nullptr}; pg8::gemm_phase<EpiBf16Scale>(ldsl, g, S, E, F.wave); }
#define REP(k) if constexpr (((PROBE_REP) >> (k)) & 1)

    if (IN(0)) { phase0_prep(F); REP(0) { __syncthreads(); phase0_prep(F); } }
    SEAM(0);
    if (IN(1)) { phase_modnorm<true>(F, F.x, F.g1, 0, 2048, R0, F.ws + WS_H1F8); REP(1) { phase_modnorm<true>(F, F.x, F.g1, 0, 2048, R0, F.ws + WS_H1F8); } }
    SEAM(1);
    if (IN(2)) { PH2_BODY REP(2) PH2_BODY }
    SEAM(2);
    if (IN(3)) { phase3_qknorm(F); PH3_BODY REP(3) PH3_BODY }
    SEAM(3);
    if (IN(4)) { PH4_BODY REP(4) PH4_BODY }
    SEAM(4);
    if (IN(5)) { PH5_BODY REP(5) PH5_BODY }
    SEAM(5);
    if (IN(6)) { PH6_BODY REP(6) PH6_BODY }
    SEAM(6);
    if (IN(7)) { phase_modnorm<false>(F, F.out, F.g2, 6144, 8192, (bf16_t*)(F.ws + WS_H2)); REP(7) { phase_modnorm<false>(F, F.out, F.g2, 6144, 8192, (bf16_t*)(F.ws + WS_H2)); } }
    SEAM(7);
    if (IN(8)) { PH8_BODY REP(8) PH8_BODY }
    SEAM(8);
    if (IN(9)) { PH9_BODY REP(9) PH9_BODY }
    SEAM(9);
    if (IN(10)) { phase10_peer(F); REP(10) phase10_peer(F); }
    SEAM(10);
    if (IN(11)) { REP(11) { phase11_peer_v(F, (float*)(F.ws + WS_SUB)); } phase11_peer_v(F, F.out); }
#undef IN
#undef SEAM
}

extern "C" void kernel_launch(void* const* d_in, const int* in_sizes, int n_in, void* d_out, int out_size, void* d_ws, size_t ws_size, hipStream_t stream) {
    static int grid = 0;
    if (grid == 0) {
        if (n_in != 19 || out_size != MTOK * DM || ws_size < WS_END) { fprintf(stderr, "kernel_launch: unexpected shapes (n_in %d out %d ws %zu)\n", n_in, out_size, ws_size); grid = -1; return; }
        int dev = 0, cus = 0, per_cu = 0;
        if (hipGetDevice(&dev) != hipSuccess || hipDeviceGetAttribute(&cus, hipDeviceAttributeMultiprocessorCount, dev) != hipSuccess) { grid = -1; return; }
        if (hipFuncSetAttribute((const void*)fwd_kernel, hipFuncAttributeMaxDynamicSharedMemorySize, LDS_BYTES) != hipSuccess) { fprintf(stderr, "kernel_launch: hipFuncSetAttribute failed\n"); grid = -1; return; }
        if (hipOccupancyMaxActiveBlocksPerMultiprocessor(&per_cu, (const void*)fwd_kernel, 512, LDS_BYTES) != hipSuccess || per_cu < 1) { fprintf(stderr, "kernel_launch: occupancy query says %d\n", per_cu); }
        (void)hipGetLastError();
        grid = cus;
    }
    if (grid < 0) return;
    (void)in_sizes;
    if (hipMemsetAsync((char*)d_ws + WS_CTL, 0, CTL_ZERO_BYTES, stream) != hipSuccess) return;
    Args a{};
    for (int i = 0; i < 19; ++i) a.in[i] = (const float*)d_in[i];
    a.out = (float*)d_out; a.ws = (unsigned char*)d_ws;
#if MK_PER_PHASE
    for (int p = 0; p < NPHASE; ++p) { a.ph_lo = p; a.ph_hi = p + 1; a.li = p; hipLaunchKernelGGL(fwd_kernel, dim3(grid), dim3(512), LDS_BYTES, stream, a); }
#else
    a.ph_lo = 0; a.ph_hi = NPHASE; a.li = 0;
    hipLaunchKernelGGL(fwd_kernel, dim3(grid), dim3(512), LDS_BYTES, stream, a);
#endif
}
```

```cpp
#include <hip/hip_runtime.h>
#include <cstdio>
#include <cstdint>

#ifndef MK_PER_PHASE
#define MK_PER_PHASE 0
#endif

#ifndef PROBE_REP
#define PROBE_REP 0
#endif
#ifndef PROBE_IDX
#define PROBE_IDX 0
#endif
#ifndef PROBE_P11X
#define PROBE_P11X 0
#endif
#define LAS __attribute__((address_space(3)))
typedef unsigned short bf16_t;
typedef short bf16x8 __attribute__((ext_vector_type(8)));
typedef float f32x4 __attribute__((ext_vector_type(4)));
typedef float f32x2 __attribute__((ext_vector_type(2)));
typedef unsigned u32x4 __attribute__((ext_vector_type(4)));
typedef unsigned u32x2 __attribute__((ext_vector_type(2)));
typedef unsigned u32x6 __attribute__((ext_vector_type(6)));
typedef unsigned u32x16 __attribute__((ext_vector_type(16)));
typedef __bf16 bf16x32 __attribute__((ext_vector_type(32)));

constexpr int BATCH = 8, SEQ = 4096, DM = 2048, MTOK = BATCH * SEQ;
constexpr int NHEAD = 8, HDIM = 128, AW = 1024, KVW = 256, IHEADS = 16, IDIM = 64, KSEL = 256;
constexpr int PW = 1024, PHEADS = 8, NEXP = 16384;
constexpr int INW = 7760;
constexpr float EPS = 1e-6f;
constexpr int NPHASE = 12;

constexpr size_t MiB = 1u << 20;
constexpr size_t WS_CTL = 0, CTL_ZERO_BYTES = 256 * 1024;
constexpr size_t WS_MODP = 2 * MiB;
constexpr size_t WS_MODF = 4 * MiB;
constexpr size_t WS_POOLW = 5 * MiB;
constexpr size_t WS_KEYSBD = 6 * MiB;
constexpr size_t WS_WIN16 = 8 * MiB;
constexpr size_t WS_WIN8 = 20 * MiB;
constexpr size_t WS_WAB = 40 * MiB, WS_WPB = 44 * MiB, WS_WOUT = 48 * MiB, WS_WPQ = 56 * MiB;
constexpr size_t WS_PU = 64 * MiB, WS_PV = 128 * MiB;
constexpr size_t WS_R0 = 192 * MiB;
constexpr size_t WS_GA = 320 * MiB, WS_GP = 448 * MiB;
constexpr size_t WS_SUB = 320 * MiB;
constexpr size_t WS_QN = 576 * MiB;
constexpr size_t WS_IQ = 640 * MiB;
constexpr size_t WS_PL = 704 * MiB;
constexpr size_t WS_KN = 768 * MiB, WS_V = 784 * MiB;
constexpr size_t WS_IK = 800 * MiB;
constexpr size_t WS_IW = 804 * MiB;
constexpr size_t WS_SEL = 806 * MiB;
constexpr size_t WS_POOLED = 822 * MiB;
constexpr size_t WS_H2 = 886 * MiB;
constexpr size_t WS_END = 1014 * MiB;
constexpr size_t WS_H1F8 = WS_H2 + 64 * MiB;
constexpr size_t WS_Q8 = WS_H2, WS_K8 = WS_H2 + 32 * MiB, WS_V8 = WS_H2 + 40 * MiB;
constexpr size_t WS_ATTN = WS_IQ, WS_POOL2 = WS_PL, WS_PAIRS = WS_QN, WS_WLS = WS_QN + 32 * MiB;

constexpr int LDS_BYTES = 160 * 1024;
constexpr int MISC_OFF = 159 * 1024;

__device__ __forceinline__ unsigned cvt_pk_bf16(float lo, float hi) { unsigned r; asm volatile("v_cvt_pk_bf16_f32 %0, %1, %2" : "=v"(r) : "v"(lo), "v"(hi)); return r; }
__device__ __forceinline__ float bf_lo(unsigned w) { return __uint_as_float(w << 16); }
__device__ __forceinline__ float bf_hi(unsigned w) { return __uint_as_float(w & 0xffff0000u); }
template <int CTRL> __device__ __forceinline__ float dpp_f(float x) { return __int_as_float(__builtin_amdgcn_update_dpp(0, __float_as_int(x), CTRL, 0xF, 0xF, true)); }
#define DPP_XOR1 0xB1
#define DPP_XOR2 0x4E
#define DPP_HMIRROR 0x141
#define DPP_MIRROR 0x140
#define DPP_ROR8 0x128
__device__ __forceinline__ float xor16_sum(float x) { const auto r = __builtin_amdgcn_permlane16_swap(__float_as_uint(x), __float_as_uint(x), false, false); return __uint_as_float(r[0]) + __uint_as_float(r[1]); }
__device__ __forceinline__ float xor32_sum(float x) { const auto r = __builtin_amdgcn_permlane32_swap(__float_as_uint(x), __float_as_uint(x), false, false); return __uint_as_float(r[0]) + __uint_as_float(r[1]); }
__device__ __forceinline__ float xor16_max(float x) { const auto r = __builtin_amdgcn_permlane16_swap(__float_as_uint(x), __float_as_uint(x), false, false); return fmaxf(__uint_as_float(r[0]), __uint_as_float(r[1])); }
__device__ __forceinline__ float swap32_pair(float a, float b) { const auto r = __builtin_amdgcn_permlane32_swap(__float_as_uint(a), __float_as_uint(b), false, false); return __uint_as_float(r[0]) + __uint_as_float(r[1]); }
__device__ __forceinline__ float swap16_pair(float a, float b) { const auto r = __builtin_amdgcn_permlane16_swap(__float_as_uint(a), __float_as_uint(b), false, false); return __uint_as_float(r[0]) + __uint_as_float(r[1]); }
__device__ __forceinline__ float row_sum16(float v) { v += dpp_f<DPP_XOR1>(v); v += dpp_f<DPP_XOR2>(v); v += dpp_f<DPP_HMIRROR>(v); v += dpp_f<DPP_MIRROR>(v); return v; }
__device__ __forceinline__ float row_max16(float v) { v = fmaxf(v, dpp_f<DPP_XOR1>(v)); v = fmaxf(v, dpp_f<DPP_XOR2>(v)); v = fmaxf(v, dpp_f<DPP_HMIRROR>(v)); v = fmaxf(v, dpp_f<DPP_MIRROR>(v)); return v; }
__device__ __forceinline__ float wave_sum(float v) { return xor32_sum(xor16_sum(row_sum16(v))); }
__device__ __forceinline__ float sigmoidf_(float x) { return __builtin_amdgcn_rcpf(1.0f + __expf(-x)); }
__device__ __forceinline__ float dot8(u32x4 w, const float* h) {
    return bf_lo(w.x) * h[0] + bf_hi(w.x) * h[1] + bf_lo(w.y) * h[2] + bf_hi(w.y) * h[3] + bf_lo(w.z) * h[4] + bf_hi(w.z) * h[5] + bf_lo(w.w) * h[6] + bf_hi(w.w) * h[7];
}

__device__ __forceinline__ int lane_now() { int l; asm volatile("v_mbcnt_lo_u32_b32 %0, -1, 0\n\tv_mbcnt_hi_u32_b32 %0, -1, %0" : "=v"(l)); return l; }

#define XB_TMO      128
#define XB_XCNT(j)  (256  + 64 * (j))
#define XB_XSUB(j)  (1280 + 64 * (j))
#define XB_XGEN(j)  (2304 + 64 * (j))
#define XB_TOP      3328
#define XB_TOPGEN   3392
#define XCD_BAR_WORDS 3456
#define XB_SPIN_CAP (1u << 18)

__device__ __forceinline__ unsigned xb_ld(unsigned* p)              { return __hip_atomic_load(p, __ATOMIC_RELAXED, __HIP_MEMORY_SCOPE_AGENT); }
__device__ __forceinline__ unsigned xb_add(unsigned* p, unsigned v) { return __hip_atomic_fetch_add(p, v, __ATOMIC_RELAXED, __HIP_MEMORY_SCOPE_AGENT); }
__device__ __forceinline__ unsigned xb_xcc_id() { return (unsigned)__builtin_amdgcn_s_getreg((3 << 11) | 20) & 0xFu; }
#define XB_SPIN(cond, bar) do { unsigned _sp = 0; while (cond) { __builtin_amdgcn_s_sleep(1); \
    if ((++_sp & 255u) == 0u) { if (xb_ld(&(bar)[XB_TMO])) break; if (_sp > XB_SPIN_CAP) { atomicAdd(&(bar)[XB_TMO], 1u); break; } } } } while (0)

struct XcdBarrier { unsigned* bar; unsigned x; volatile LAS unsigned* st; };

__device__ __forceinline__ XcdBarrier xcd_barrier_post(unsigned* bar, volatile LAS unsigned* st) {
    XcdBarrier b; b.bar = bar; b.x = xb_xcc_id(); b.st = st;
    if (threadIdx.x == 0) (void)xb_add(&bar[XB_XCNT(b.x)], 1u);
    return b;
}
__device__ __forceinline__ void xcd_barrier_complete(unsigned* bar, unsigned x, unsigned& nloc, unsigned& nx) {
    const unsigned G = gridDim.x * gridDim.y * gridDim.z;
    unsigned sum, cnt, mine, sp = 0u;
    for (;;) {
        sum = 0u; cnt = 0u; mine = 0u;
#pragma unroll
        for (unsigned j = 0; j < 16; ++j) { const unsigned c = xb_ld(&bar[XB_XCNT(j)]); sum += c; cnt += (c > 0u) ? 1u : 0u; mine = (j == x) ? c : mine; }
        if (sum == G) break;
        __builtin_amdgcn_s_sleep(1);
        if ((++sp & 255u) == 0u) { if (xb_ld(&bar[XB_TMO])) break; if (sp > XB_SPIN_CAP) { atomicAdd(&bar[XB_TMO], 1u); break; } }
    }
    nloc = mine > 0u ? mine : 1u; nx = cnt > 0u ? cnt : 1u;
}
__device__ __forceinline__ void xcd_barrier(const XcdBarrier& b, int wave) {
    asm volatile("s_waitcnt vmcnt(0)" ::: "memory");
    __syncthreads();
    if (wave == 0 && lane_now() == 0) {
        unsigned* bar = b.bar;
        __builtin_amdgcn_s_waitcnt(0);
        unsigned nloc = b.st[0], nx = b.st[1];
        if (nloc == 0u) { xcd_barrier_complete(bar, b.x, nloc, nx); b.st[0] = nloc; b.st[1] = nx; }
        const unsigned old = xb_add(&bar[XB_XSUB(b.x)], 1u);
        const unsigned gen = old / nloc;
        if (old + 1u == (gen + 1u) * nloc) {
            __builtin_amdgcn_fence(__ATOMIC_RELEASE, "agent");
            asm volatile("s_waitcnt vmcnt(0)" ::: "memory");
            const unsigned og = xb_add(&bar[XB_TOP], 1u);
            const unsigned tg = og / nx;
            if (og + 1u == (tg + 1u) * nx) xb_add(&bar[XB_TOPGEN], 1u);
            else XB_SPIN(xb_ld(&bar[XB_TOPGEN]) == tg, bar);
            __builtin_amdgcn_fence(__ATOMIC_ACQUIRE, "agent");
            xb_add(&bar[XB_XGEN(b.x)], 1u);
            asm volatile("s_waitcnt vmcnt(0)" ::: "memory");
        } else {
            XB_SPIN(xb_ld(&bar[XB_XGEN(b.x)]) == gen, bar);
            __builtin_amdgcn_fence(__ATOMIC_ACQUIRE, "agent");
            asm volatile("s_waitcnt vmcnt(0)" ::: "memory");
        }
    }
    __syncthreads();
}

namespace pg8 {
constexpr int BM = 256, BK = 64, HALF = 128, HTB = HALF * BK * 2, STAGE_BYTES = 8 * HTB, NXCD = 8, WGM = 8;
__device__ __forceinline__ int lds_byte(int r, int c) { const int st = (r >> 4) * 2 + (c >> 5), rr = r & 15, cc = c & 31, ob = rr * 64 + cc * 2; return st * 1024 + (ob ^ (((ob >> 9) & 1) << 5)); }
__device__ __forceinline__ void stage_rc(int b, int& R, int& C) { const int st = b / 1024, sb = b % 1024, swz = sb ^ (((sb >> 9) & 1) << 5); R = (st >> 1) * 16 + swz / 64; C = (st & 1) * 32 + (swz % 64) / 2; }
__device__ __forceinline__ int perm32(int rho) { const int n = rho >> 4, i = rho & 15; return 8 * (i >> 2) + 4 * n + (i & 3); }

struct Unit { int pm, pn; };
struct Gemm { const bf16_t* A; const bf16_t* Bt; int M, N, K, lda, a_pn_off; const bf16_t* A2; const bf16_t* Bt2; int ksplit, ldb; };

struct StaticOrder {
    int nM, nN, nwg, G, c;
    __device__ void init(int M, int N, int G_, int c_) { nM = M / BM; nN = N / BM; nwg = nM * nN; G = G_; c = c_; }
    __device__ bool next(int i, Unit& u) const {
        const long L = (long)i * G + c; if (L >= nwg) return false;
        int wgid = (int)L; { const int q = nwg / NXCD, r = nwg % NXCD, xcd = wgid % NXCD, off = wgid / NXCD; wgid = (xcd < r ? xcd * (q + 1) : r * (q + 1) + (xcd - r) * q) + off; }
        const int nig = WGM * nN, gid = wgid / nig, fm = gid * WGM, gsz = (nM - fm) < WGM ? (nM - fm) : WGM;
        u.pm = fm + ((wgid % nig) % gsz); u.pn = (wgid % nig) / gsz; return true;
    }
};

typedef int i32x4 __attribute__((ext_vector_type(4)));
typedef int i32x8 __attribute__((ext_vector_type(8)));
__device__ __forceinline__ bf16x8 lo8(i32x8 v) { return __builtin_bit_cast(bf16x8, (i32x4){v.s0, v.s1, v.s2, v.s3}); }
__device__ __forceinline__ bf16x8 hi8(i32x8 v) { return __builtin_bit_cast(bf16x8, (i32x4){v.s4, v.s5, v.s6, v.s7}); }
__device__ __forceinline__ i32x8 cat8(bf16x8 a, bf16x8 b) { const i32x4 x = __builtin_bit_cast(i32x4, a), y = __builtin_bit_cast(i32x4, b); return (i32x8){x.x, x.y, x.z, x.w, y.x, y.y, y.z, y.w}; }
template <class Epi, bool F8 = false>
__device__ __forceinline__ void gemm_phase(LAS unsigned char* lds, const Gemm g, const StaticOrder& S, const Epi& E, int wave) {
    const int lane = lane_now(), wid = wave, tid = wid * 64 + lane, wr = wid >> 2, wc = wid & 3, fr = lane & 15, fq = lane >> 4;
    const int K = g.K, nt = K / BK, lda = g.lda, ldb = g.ldb ? g.ldb : g.K, ksplit = g.ksplit;
    unsigned voffA, voffB;
    { int R, C; stage_rc(tid * 16, R, C); const int Rb = Epi::PERM ? ((R & ~31) + perm32(R & 31)) : R;
      voffA = (unsigned)(R * lda + C) * 2u; voffB = (unsigned)(Rb * ldb + C) * 2u; }
    const unsigned stepA = 64u * (unsigned)lda * 2u, stepB = 64u * (unsigned)ldb * 2u;
    const size_t kstep = (size_t)(BK * 2);
    const size_t hsA = (size_t)HALF * lda * 2, hsB = (size_t)HALF * ldb * 2;
    const size_t tsA = 2 * hsA, tsB = 2 * hsB;
    const unsigned ldsw = (unsigned)wid * 1024u, ldsbase = (unsigned)(unsigned long long)lds;
    const int aoff = lds_byte(wr * 64 + fr, fq * 8), boff = lds_byte(wc * 32 + fr, fq * 8);
#define PG8_SA(b, h) (((b) * 2 + (h)) * HTB)
#define PG8_SB(b, h) ((4 + (b) * 2 + (h)) * HTB)
#define PG8_STAGE(bufoff, gbase, voff) do { _Pragma("unroll") for (int _i = 0; _i < 2; ++_i) { \
        const char* sb_ = (const char*)(gbase) + (size_t)_i * PG8_STEP_##voff; const unsigned m0_ = ldsbase + (unsigned)(bufoff) + ldsw + (unsigned)_i * 8192u; \
        asm volatile("s_mov_b32 m0, %2\n\ts_nop 0\n\tglobal_load_lds_dwordx4 %0, %1" :: "v"(voff), "s"(sb_), "s"(m0_) : "memory"); } } while (0)
#define PG8_STEP_voffA stepA
#define PG8_STEP_voffB stepB
#define PG8_LDA(dst, b, h) do { _Pragma("unroll") for (int m = 0; m < 4; ++m) dst[m] = cat8(*(const LAS bf16x8*)(lds + PG8_SA(b, h) + aoff + m * 2048), *(const LAS bf16x8*)(lds + PG8_SA(b, h) + aoff + m * 2048 + 1024)); } while (0)
#define PG8_LDB(dst, b, h) do { _Pragma("unroll") for (int n = 0; n < 2; ++n) dst[n] = cat8(*(const LAS bf16x8*)(lds + PG8_SB(b, h) + boff + n * 2048), *(const LAS bf16x8*)(lds + PG8_SB(b, h) + boff + n * 2048 + 1024)); } while (0)
#define PG8_MMA(ai, bj, At, Bt) do { __builtin_amdgcn_s_setprio(1); _Pragma("unroll") for (int m = 0; m < 4; ++m) _Pragma("unroll") for (int n = 0; n < 2; ++n) { \
        if constexpr (F8) acc[ai][bj][m][n] = __builtin_amdgcn_mfma_scale_f32_16x16x128_f8f6f4(Bt[n], At[m], acc[ai][bj][m][n], 0, 0, 0, 0x7D7D7D7D  , 0, 0x7D7D7D7D); \
        else { acc[ai][bj][m][n] = __builtin_amdgcn_mfma_f32_16x16x32_bf16(lo8(Bt[n]), lo8(At[m]), acc[ai][bj][m][n], 0, 0, 0); \
               acc[ai][bj][m][n] = __builtin_amdgcn_mfma_f32_16x16x32_bf16(hi8(Bt[n]), hi8(At[m]), acc[ai][bj][m][n], 0, 0, 0); } } \
        __builtin_amdgcn_s_setprio(0); } while (0)
#define PG8_WAIT_V(n) asm volatile("s_waitcnt vmcnt(" #n ")" ::: "memory")
#define PG8_WAIT_L(n) asm volatile("s_waitcnt lgkmcnt(" #n ")" ::: "memory")
#define PG8_BAR __builtin_amdgcn_s_barrier()
#define PG8_SCHED __builtin_amdgcn_sched_barrier(0)
    Unit cur, nxt; int ui = 0;
    if (!S.next(0, cur)) return;
    f32x4 acc[2][2][4][2];
#pragma unroll
    for (int a = 0; a < 2; ++a)
#pragma unroll
        for (int b = 0; b < 2; ++b)
#pragma unroll
            for (int m = 0; m < 4; ++m)
#pragma unroll
                for (int n = 0; n < 2; ++n) acc[a][b][m][n] = (f32x4){0.f, 0.f, 0.f, 0.f};
    i32x8 At[4], B0[2], B1[2];
    const char* cA = (const char*)g.A + (size_t)cur.pm * tsA + (size_t)cur.pn * g.a_pn_off * 2; const char* cB = (const char*)g.Bt + (size_t)cur.pn * tsB;
    PG8_STAGE(PG8_SB(0, 0), cB, voffB); PG8_STAGE(PG8_SB(0, 1), cB + hsB, voffB); PG8_STAGE(PG8_SA(0, 0), cA, voffA); PG8_STAGE(PG8_SA(0, 1), cA + hsA, voffA);
    if (wr == 1) PG8_BAR;
    PG8_WAIT_V(2); PG8_BAR;
    PG8_STAGE(PG8_SB(1, 0), cB + kstep, voffB); PG8_STAGE(PG8_SA(1, 0), cA + kstep, voffA); PG8_STAGE(PG8_SB(1, 1), cB + hsB + kstep, voffB);
    PG8_WAIT_V(6); PG8_BAR;
    for (;;) {
        const bool has_next = S.next(ui + 1, nxt);
        const char* nA = has_next ? (const char*)g.A + (size_t)nxt.pm * tsA + (size_t)nxt.pn * g.a_pn_off * 2 : cA; const char* nB = has_next ? (const char*)g.Bt + (size_t)nxt.pn * tsB : cB;
        const char* cA2 = (const char*)g.A2 + (size_t)cur.pm * tsA; const char* cB2 = (const char*)g.Bt2 + (size_t)cur.pn * tsB;
#pragma clang loop unroll(disable)
        for (int t = 0; t < nt; t += 2) {
            const bool last = (t == nt - 2);
            const bool s1 = ksplit && (t >= ksplit), s2 = ksplit && (t + 2 >= ksplit);
            const char* a1 = (s1 ? cA2 + (size_t)(t - ksplit + 1) * kstep : cA + (size_t)(t + 1) * kstep);
            const char* a2 = last ? nA : (s2 ? cA2 + (size_t)(t + 2 - ksplit) * kstep : cA + (size_t)(t + 2) * kstep);
            const char* b2 = last ? nB : (s2 ? cB2 + (size_t)(t + 2 - ksplit) * kstep : cB + (size_t)(t + 2) * kstep);
            const char* a3 = a2 + kstep; const char* b3 = b2 + kstep;
            PG8_LDB(B0, 0, 0); PG8_LDB(B1, 0, 1); PG8_SCHED; PG8_LDA(At, 0, 0); PG8_STAGE(PG8_SA(1, 1), a1 + hsA, voffA);
            PG8_WAIT_V(8); PG8_WAIT_L(0); PG8_BAR; PG8_MMA(0, 0, At, B0); PG8_MMA(0, 1, At, B1); PG8_BAR; PG8_SCHED;
            PG8_LDA(At, 0, 1); PG8_STAGE(PG8_SB(0, 0), b2, voffB); PG8_STAGE(PG8_SB(0, 1), b2 + hsB, voffB); PG8_STAGE(PG8_SA(0, 0), a2, voffA);
            PG8_WAIT_V(8); PG8_WAIT_L(0); PG8_BAR; PG8_MMA(1, 0, At, B0); PG8_MMA(1, 1, At, B1); PG8_BAR; PG8_SCHED;
            PG8_LDB(B0, 1, 0); PG8_LDB(B1, 1, 1); PG8_SCHED; PG8_LDA(At, 1, 0); PG8_STAGE(PG8_SA(0, 1), a2 + hsA, voffA);
            PG8_WAIT_V(8); PG8_WAIT_L(0); PG8_BAR; PG8_MMA(0, 0, At, B0); PG8_MMA(0, 1, At, B1); PG8_BAR; PG8_SCHED;
            PG8_LDA(At, 1, 1); PG8_STAGE(PG8_SB(1, 0), b3, voffB); PG8_STAGE(PG8_SB(1, 1), b3 + hsB, voffB); PG8_STAGE(PG8_SA(1, 0), a3, voffA);
            PG8_WAIT_V(8); PG8_WAIT_L(0); PG8_BAR; PG8_MMA(1, 0, At, B0); PG8_MMA(1, 1, At, B1); PG8_BAR; PG8_SCHED;
            if constexpr (Epi::MID) { if (t + 2 == ksplit) E.mid(acc, cur, wr, wc, fr, fq); }
        }
        if (wr == 0) PG8_BAR;
        { const int l2 = lane_now(); E(acc, cur, wr, wc, l2 & 15, l2 >> 4); }
        if (!has_next) break;
#pragma unroll
        for (int a = 0; a < 2; ++a)
#pragma unroll
            for (int b = 0; b < 2; ++b)
#pragma unroll
                for (int m = 0; m < 4; ++m)
#pragma unroll
                    for (int n = 0; n < 2; ++n) acc[a][b][m][n] = (f32x4){0.f, 0.f, 0.f, 0.f};
        cur = nxt; cA = nA; cB = nB; ++ui;
        if (wr == 1) PG8_BAR;
    }
    PG8_WAIT_V(0);
    PG8_BAR;
#undef PG8_SA
#undef PG8_SB
#undef PG8_STAGE
#undef PG8_STEP_voffA
#undef PG8_STEP_voffB
#undef PG8_LDA
#undef PG8_LDB
#undef PG8_MMA
#undef PG8_WAIT_V
#undef PG8_WAIT_L
#undef PG8_BAR
#undef PG8_SCHED
}
}
using pg8::Unit;

typedef f32x4 AccT[2][2][4][2];
__device__ __forceinline__ u32x4 pack8(f32x4 a, f32x4 b) { u32x4 w; w.x = cvt_pk_bf16(a[0], a[1]); w.y = cvt_pk_bf16(a[2], a[3]); w.z = cvt_pk_bf16(b[0], b[1]); w.w = cvt_pk_bf16(b[2], b[3]); return w; }
__device__ __forceinline__ u32x2 pack8_fp8(f32x4 a, f32x4 b) {
    int w0 = __builtin_amdgcn_cvt_pk_fp8_f32(a[0], a[1], 0, false); w0 = __builtin_amdgcn_cvt_pk_fp8_f32(a[2], a[3], w0, true);
    int w1 = __builtin_amdgcn_cvt_pk_fp8_f32(b[0], b[1], 0, false); w1 = __builtin_amdgcn_cvt_pk_fp8_f32(b[2], b[3], w1, true);
    return (u32x2){(unsigned)w0, (unsigned)w1};
}
__device__ __forceinline__ void unpack8(u32x4 w, f32x4& a, f32x4& b) { a = (f32x4){bf_lo(w.x), bf_hi(w.x), bf_lo(w.y), bf_hi(w.y)}; b = (f32x4){bf_lo(w.z), bf_hi(w.z), bf_lo(w.w), bf_hi(w.w)}; }

template <bool SET8> struct EpiInproj {
    static constexpr bool PERM = true, MID = false;
    bf16_t *q, *k, *v, *iq, *ik, *pl, *ga, *gp; float* iw;
    __device__ __forceinline__ void operator()(const AccT& acc, const Unit& u, int wr, int wc, int fr, int fq) const {
        const int pn = u.pn, row0 = u.pm * 256 + wr * 64 + fr;
        if (!SET8 && pn == 4) {
            if (wc < 2) {
#pragma unroll
                for (int ai = 0; ai < 2; ++ai)
#pragma unroll
                    for (int m = 0; m < 4; ++m) { const size_t row = (size_t)(row0 + ai * 128 + m * 16);
                        *(u32x4*)(ik + row * 64 + wc * 32 + 8 * fq) = pack8(acc[ai][0][m][0], acc[ai][0][m][1]); }
            } else if (wc == 2) {
                if (fq < 2) {
#pragma unroll
                    for (int ai = 0; ai < 2; ++ai)
#pragma unroll
                        for (int m = 0; m < 4; ++m) { const size_t row = (size_t)(row0 + ai * 128 + m * 16);
                            *(f32x4*)(iw + row * 16 + 8 * fq) = acc[ai][0][m][0]; *(f32x4*)(iw + row * 16 + 8 * fq + 4) = acc[ai][0][m][1]; }
                }
            }
            return;
        }
        bf16_t* dst; int ld, tc; bool sg = false;
        if (SET8) {
            if (pn < 4) { dst = q; ld = 1024; tc = pn * 256; }
            else if (pn == 4) { dst = k; ld = 256; tc = 0; }
            else if (pn == 5) { dst = v; ld = 256; tc = 0; }
            else if (pn < 14) { dst = ga; ld = 2048; tc = (pn - 6) * 256; sg = true; }
            else { dst = gp; ld = 2048; tc = (pn - 14) * 256; sg = true; }
        } else {
            if (pn < 4) { dst = iq; ld = 1024; tc = pn * 256; }
            else { dst = pl; ld = 1024; tc = (pn - 5) * 256; }
        }
        const int col0 = tc + wc * 32 + 8 * fq;
#pragma unroll
        for (int ai = 0; ai < 2; ++ai)
#pragma unroll
            for (int m = 0; m < 4; ++m) { bf16_t* rowp = dst + (size_t)(row0 + ai * 128 + m * 16) * ld + col0;
#pragma unroll
                for (int bj = 0; bj < 2; ++bj) { f32x4 v0 = acc[ai][bj][m][0], v1 = acc[ai][bj][m][1];
                    if (sg) {
#pragma unroll
                        for (int j = 0; j < 4; ++j) { v0[j] = sigmoidf_(v0[j]); v1[j] = sigmoidf_(v1[j]); } }
                    *(u32x4*)(rowp + bj * 128) = pack8(v0, v1); } }
    }
};
struct EpiBf16Scale {
    static constexpr bool PERM = true, MID = false;
    bf16_t* O; int ldc; const float* cs;
    __device__ __forceinline__ void operator()(const AccT& acc, const Unit& u, int wr, int wc, int fr, int fq) const {
        const int row0 = u.pm * 256 + wr * 64 + fr, col0 = u.pn * 256 + wc * 32 + 8 * fq;
        f32x4 s[2][2];
#pragma unroll
        for (int bj = 0; bj < 2; ++bj)
#pragma unroll
            for (int n = 0; n < 2; ++n) s[bj][n] = cs ? *(const f32x4*)(cs + col0 + bj * 128 + 4 * n) : (f32x4){1.f, 1.f, 1.f, 1.f};
#pragma unroll
        for (int ai = 0; ai < 2; ++ai)
#pragma unroll
            for (int m = 0; m < 4; ++m) { bf16_t* rowp = O + (size_t)(row0 + ai * 128 + m * 16) * ldc + col0;
#pragma unroll
                for (int bj = 0; bj < 2; ++bj) *(u32x4*)(rowp + bj * 128) = pack8(acc[ai][bj][m][0] * s[bj][0], acc[ai][bj][m][1] * s[bj][1]); }
    }
};
template <bool ADD> struct EpiGate {
    static constexpr bool PERM = true, MID = false;
    bf16_t* O; const bf16_t* gate;
    __device__ __forceinline__ void operator()(const AccT& acc, const Unit& u, int wr, int wc, int fr, int fq) const {
        const int row0 = u.pm * 256 + wr * 64 + fr, col0 = u.pn * 256 + wc * 32 + 8 * fq;
#pragma unroll
        for (int ai = 0; ai < 2; ++ai)
#pragma unroll
            for (int m = 0; m < 4; ++m) { const size_t off = (size_t)(row0 + ai * 128 + m * 16) * 2048 + col0;
#pragma unroll
                for (int bj = 0; bj < 2; ++bj) { f32x4 g0, g1; unpack8(*(const u32x4*)(gate + off + bj * 128), g0, g1);
                    f32x4 r0 = g0 * acc[ai][bj][m][0], r1 = g1 * acc[ai][bj][m][1];
                    if (ADD) { f32x4 o0, o1; unpack8(*(const u32x4*)(O + off + bj * 128), o0, o1); r0 += o0; r1 += o1; }
                    *(u32x4*)(O + off + bj * 128) = pack8(r0, r1); } }
    }
};
struct EpiMerge {
    static constexpr bool PERM = true, MID = true;
    unsigned char* O; const bf16_t* ga; const bf16_t* gp;
    __device__ __forceinline__ void mid(AccT& acc, const Unit& u, int wr, int wc, int fr, int fq) const {
        const auto ra = __builtin_amdgcn_make_buffer_rsrc((void*)ga, 0, 0x7FFFFFFF, 0x00020000), rp = __builtin_amdgcn_make_buffer_rsrc((void*)gp, 0, 0x7FFFFFFF, 0x00020000);
        const int voff = ((wr * 64 + fr) * 2048 + wc * 32 + 8 * fq) * 2;
        const int sbase = (u.pm * 256 * 2048 + u.pn * 256) * 2;
#pragma unroll
        for (int ai = 0; ai < 2; ++ai)
#pragma unroll
            for (int m = 0; m < 4; ++m)
#pragma unroll
                for (int bj = 0; bj < 2; ++bj) { const int so = sbase + ((ai * 128 + m * 16) * 2048 + bj * 128) * 2;
                    const u32x4 wa = __builtin_bit_cast(u32x4, __builtin_amdgcn_raw_buffer_load_b128(ra, voff, so, 0)), wp = __builtin_bit_cast(u32x4, __builtin_amdgcn_raw_buffer_load_b128(rp, voff, so, 0));
                    f32x4 a0, a1, p0, p1; unpack8(wa, a0, a1); unpack8(wp, p0, p1);
#pragma unroll
                    for (int j = 0; j < 4; ++j) { acc[ai][bj][m][0][j] *= a0[j] * __builtin_amdgcn_rcpf(p0[j]); acc[ai][bj][m][1][j] *= a1[j] * __builtin_amdgcn_rcpf(p1[j]); }
                    asm volatile("" : "+v"(acc[ai][bj][m][0]), "+v"(acc[ai][bj][m][1]) :: "memory"); }
    }
    __device__ __forceinline__ void operator()(const AccT& acc, const Unit& u, int wr, int wc, int fr, int fq) const {
        const int row0 = u.pm * 256 + wr * 64 + fr, col0 = u.pn * 256 + wc * 32 + 8 * fq;
#pragma unroll
        for (int ai = 0; ai < 2; ++ai)
#pragma unroll
            for (int m = 0; m < 4; ++m) { const size_t off = (size_t)(row0 + ai * 128 + m * 16) * 2048 + col0;
#pragma unroll
                for (int bj = 0; bj < 2; ++bj) { f32x4 p0, p1; unpack8(*(const u32x4*)(gp + off + bj * 128), p0, p1);
                    *(u32x2*)(O + off + bj * 128) = pack8_fp8(p0 * acc[ai][bj][m][0], p1 * acc[ai][bj][m][1]); } }
    }
};
struct EpiResid {
    static constexpr bool PERM = false, MID = false;
    const float* x; float* out; const float* gt;
    __device__ __forceinline__ void operator()(const AccT& acc, const Unit& u, int wr, int wc, int fr, int fq) const {
        const int row0 = u.pm * 256 + wr * 64 + fr, col0 = u.pn * 256 + wc * 32 + 4 * fq;
        const float* gtb = gt + (size_t)(u.pm / 16) * 12288;
        f32x4 g[2][2];
#pragma unroll
        for (int bj = 0; bj < 2; ++bj)
#pragma unroll
            for (int n = 0; n < 2; ++n) g[bj][n] = *(const f32x4*)(gtb + col0 + bj * 128 + n * 16);
#pragma unroll
        for (int ai = 0; ai < 2; ++ai)
#pragma unroll
            for (int m = 0; m < 4; ++m) { const size_t off = (size_t)(row0 + ai * 128 + m * 16) * 2048 + col0;
#pragma unroll
                for (int bj = 0; bj < 2; ++bj)
#pragma unroll
                    for (int n = 0; n < 2; ++n) { const f32x4 xv = *(const f32x4*)(x + off + bj * 128 + n * 16);
                        *(f32x4*)(out + off + bj * 128 + n * 16) = xv + g[bj][n] * acc[ai][bj][m][n]; } }
    }
};
struct EpiF32 {
    static constexpr bool PERM = false, MID = false;
    float* C; int ldc;
    __device__ __forceinline__ void operator()(const AccT& acc, const Unit& u, int wr, int wc, int fr, int fq) const {
        const int row0 = u.pm * 256 + wr * 64 + fr, col0 = u.pn * 256 + wc * 32 + 4 * fq;
#pragma unroll
        for (int ai = 0; ai < 2; ++ai)
#pragma unroll
            for (int m = 0; m < 4; ++m) { float* rowp = C + (size_t)(row0 + ai * 128 + m * 16) * ldc + col0;
#pragma unroll
                for (int bj = 0; bj < 2; ++bj)
#pragma unroll
                    for (int n = 0; n < 2; ++n) *(f32x4*)(rowp + bj * 128 + n * 16) = acc[ai][bj][m][n]; }
    }
};

struct Args { const float* in[19]; float* out; unsigned char* ws; int ph_lo, ph_hi; int li, pad; };
struct Frame {
    unsigned char* lds; unsigned char* ws;
    int tid, lane, wave, G, bid;
    const float *x, *c, *w_ada, *b_ada, *g1, *g2, *w_in, *g_q, *g_k, *rel_bias, *pool_w, *pool_scale, *w_ab, *w_pb, *w_out, *w_pq, *peer_keys, *peer_u, *peer_v;
    float* out;
};

template <bool F8OUT = false, class Fn> __device__ __forceinline__ void transpose_item(const float* W, int K, int N, void* WTv, int ldk, int drow0, int k0, float* scr, int lane, Fn srccol, float mul = 1.0f) {
    const int sc = srccol(drow0 + (lane & 31));
#pragma unroll 8
    for (int i = 0; i < 32; ++i) { const int kk = 2 * i + (lane >> 5); scr[kk * 33 + (lane & 31)] = sc >= 0 ? W[(size_t)(k0 + kk) * N + sc] * mul : 0.f; }
    asm volatile("s_waitcnt lgkmcnt(0)" ::: "memory");
    const int c = lane & 7;
#pragma unroll
    for (int j = 0; j < 4; ++j) { const int n = (lane >> 3) + 8 * j; const float* s = scr + (8 * c) * 33 + n;
        if constexpr (F8OUT) { *(u32x2*)((unsigned char*)WTv + (size_t)(drow0 + n) * ldk + k0 + 8 * c) = pack8_fp8((f32x4){s[0 * 33], s[1 * 33], s[2 * 33], s[3 * 33]}, (f32x4){s[4 * 33], s[5 * 33], s[6 * 33], s[7 * 33]}); }
        else { u32x4 o; o.x = cvt_pk_bf16(s[0 * 33], s[1 * 33]); o.y = cvt_pk_bf16(s[2 * 33], s[3 * 33]); o.z = cvt_pk_bf16(s[4 * 33], s[5 * 33]); o.w = cvt_pk_bf16(s[6 * 33], s[7 * 33]);
            *(u32x4*)((bf16_t*)WTv + (size_t)(drow0 + n) * ldk + k0 + 8 * c) = o; } }
    asm volatile("s_waitcnt lgkmcnt(0)" ::: "memory");
}
__device__ __forceinline__ void phase0_prep(Frame& F) {
    F.lane = lane_now(); F.tid = F.wave * 64 + F.lane;
    const int gw = F.bid * 8 + F.wave, NGW = F.G * 8;
    float* scr = (float*)(F.lds + F.wave * 16384);
    constexpr int I_IN16 = (2304 / 32) * (DM / 64), I_IN8 = (5632 / 32) * (DM / 64);
    constexpr int I_AB = (2048 / 32) * (1024 / 64), I_OUT = (2048 / 32) * (2048 / 64), I_PW = 4 * 8 * 4;
    constexpr int NIT = I_IN16 + I_IN8 + 2 * I_AB + 2 * I_OUT + I_PW;
    auto ident = [](int j) { return j; };
    for (int it = gw; it < NIT; it += NGW) {
        int r = it;
        if (r < I_IN16) { const int nb = r % 72, kb = r / 72;
            transpose_item(F.w_in, DM, INW, F.ws + WS_WIN16, DM, nb * 32, kb * 64, scr, F.lane, [](int j) { return j < 1104 ? j + 1536 : (j < 1280 ? -1 : j + 1360); }); continue; }
        r -= I_IN16;
        if (r < I_IN8) { const int nb = r % 176, kb = r / 176;
            transpose_item<true>(F.w_in, DM, INW, F.ws + WS_WIN8, DM, nb * 32, kb * 64, scr, F.lane, [](int j) { return j < 1536 ? j : j + 2128; }, 16.0f); continue; }
        r -= I_IN8;
        if (r < I_AB) { transpose_item(F.w_ab, 1024, 2048, (bf16_t*)(F.ws + WS_WAB), 1024, (r % 64) * 32, (r / 64) * 64, scr, F.lane, ident); continue; }
        r -= I_AB;
        if (r < I_AB) { transpose_item(F.w_pb, 1024, 2048, (bf16_t*)(F.ws + WS_WPB), 1024, (r % 64) * 32, (r / 64) * 64, scr, F.lane, ident); continue; }
        r -= I_AB;
        if (r < I_OUT) { transpose_item<true>(F.w_out, 2048, 2048, F.ws + WS_WOUT, 2048, (r % 64) * 32, (r / 64) * 64, scr, F.lane, ident, 16.0f); continue; }
        r -= I_OUT;
        if (r < I_OUT) { transpose_item(F.w_pq, 2048, 2048, (bf16_t*)(F.ws + WS_WPQ), 2048, (r % 64) * 32, (r / 64) * 64, scr, F.lane, ident); continue; }
        r -= I_OUT;
        { const int g = r / 32, q = r % 32, nb = q % 8, kb = q / 8;
          transpose_item(F.pool_w + (size_t)g * 65536, 256, 256, (bf16_t*)(F.ws + WS_POOLW) + (size_t)g * 65536, 256, nb * 32, kb * 64, scr, F.lane, ident); }
    }
    {
        bf16_t* kb = (bf16_t*)(F.ws + WS_KEYSBD);
        for (int i = F.bid * 512 + F.tid; i < 2048 * 32; i += F.G * 512) {
            const int row = i / 32, k8 = (i % 32) * 8, p = (row >> 7) & 1;
            u32x4 o = (u32x4){0u, 0u, 0u, 0u};
            if ((k8 >> 7) == p) { const float* s = F.peer_keys + (size_t)row * 128 + (k8 & 127); const f32x4 a = *(const f32x4*)s, b = *(const f32x4*)(s + 4); o = pack8(a, b); }
            *(u32x4*)(kb + (size_t)row * 256 + k8) = o;
        }
    }
    {
        unsigned char* pu = F.ws + WS_PU;
        for (size_t i = (size_t)F.bid * 512 + F.tid; i < (size_t)NEXP * 64; i += (size_t)F.G * 512) {
            const float* src = F.peer_u + i * 32;
            u32x16 pk;
#pragma unroll
            for (int k = 0; k < 8; ++k) { const f32x4 a = *(const f32x4*)(src + k * 4) * 96.0f; pk[2 * k] = cvt_pk_bf16(a[0], a[1]); pk[2 * k + 1] = cvt_pk_bf16(a[2], a[3]); }
            const u32x6 p6 = __builtin_amdgcn_cvt_scalef32_pk32_fp6_bf16(__builtin_bit_cast(bf16x32, pk), 1.0f);
            unsigned char* dst = pu + i * 24;
            *(u32x2*)dst = (u32x2){p6[0], p6[1]}; *(u32x2*)(dst + 8) = (u32x2){p6[2], p6[3]}; *(u32x2*)(dst + 16) = (u32x2){p6[4], p6[5]};
        }
        unsigned char* pv = F.ws + WS_PV;
        for (int it = gw; it < (NEXP / 64) * 128; it += NGW) {
            const int e = (it >> 7) * 64 + F.lane, ch = it & 127;
            u32x4 ov;
#pragma unroll
            for (int k = 0; k < 4; ++k) { const f32x4 c = *(const f32x4*)(F.peer_v + (size_t)e * DM + ch * 16 + k * 4) * 4.0f;
                int wv = __builtin_amdgcn_cvt_pk_fp8_f32(c[0], c[1], 0, false); wv = __builtin_amdgcn_cvt_pk_fp8_f32(c[2], c[3], wv, true); ov[k] = (unsigned)wv; }
            *(u32x2*)(pv + ((size_t)(2 * ch) * NEXP + e) * 8) = (u32x2){ov[0], ov[1]};
            *(u32x2*)(pv + ((size_t)(2 * ch + 1) * NEXP + e) * 8) = (u32x2){ov[2], ov[3]};
        }
    }
    {
        __syncthreads();
        float* cact = (float*)(F.lds + 131072);
        float* red = (float*)F.lds;
        float* mp = (float*)(F.ws + WS_MODP);
        for (int it = F.bid; it < 48 * 4; it += F.G) {
            const int cb = it % 48, ds = it / 48, d0 = ds * 512;
            for (int i = F.tid; i < 8 * 512; i += 512) { const int b = i >> 9, d = i & 511; const float cv = F.c[b * DM + d0 + d]; cact[i] = cv * sigmoidf_(cv); }
            __syncthreads();
            f32x4 a[8];
#pragma unroll
            for (int b = 0; b < 8; ++b) a[b] = (f32x4){0.f, 0.f, 0.f, 0.f};
            const float* wp = F.w_ada + (size_t)(d0 + F.wave * 64) * 12288 + cb * 256 + F.lane * 4;
#pragma unroll 4
            for (int d = 0; d < 64; ++d) { const f32x4 w = *(const f32x4*)(wp + (size_t)d * 12288);
#pragma unroll
                for (int b = 0; b < 8; ++b) a[b] += w * cact[b * 512 + F.wave * 64 + d]; }
#pragma unroll
            for (int b = 0; b < 8; ++b)
#pragma unroll
                for (int j = 0; j < 4; ++j) red[(F.wave * 32 + b * 4 + j) * 64 + F.lane] = a[b][j];
            __syncthreads();
            for (int i = F.tid; i < 2048; i += 512) { const int v = i >> 6, l = i & 63; float s = 0.f;
#pragma unroll
                for (int w = 0; w < 8; ++w) s += red[(w * 32 + v) * 64 + l];
                mp[((size_t)ds * 8 + (v >> 2)) * 12288 + cb * 256 + l * 4 + (v & 3)] = s; }
            __syncthreads();
        }
    }
}

template <bool FIRST> __device__ __forceinline__ void phase_modnorm(Frame& F, const float* xin, const float* gain, int off_sh, int off_sc, bf16_t* dst, unsigned char* dst8 = nullptr) {
    F.lane = lane_now(); F.tid = F.wave * 64 + F.lane;
    const float* mp = (const float*)(F.ws + WS_MODP); float* mf = (float*)(F.ws + WS_MODF);
    if (FIRST) {
        for (int i = F.bid * 512 + F.tid; i < 8 * 12288; i += F.G * 512) {
            float s = F.b_ada[i % 12288];
#pragma unroll
            for (int k = 0; k < 4; ++k) s += mp[(size_t)k * 8 * 12288 + i];
            mf[i] = s; }
    }
    float* cA = (float*)F.lds; float* cB = cA + 2048;
    for (int ch = F.bid; ch < MTOK / 128; ch += F.G) {
        const int b = ch / 32;
        __syncthreads();
        for (int col = F.tid; col < 2048; col += 512) {
            float sc, sh;
            if (FIRST) { sc = F.b_ada[off_sc + col]; sh = F.b_ada[off_sh + col];
#pragma unroll
                for (int k = 0; k < 4; ++k) { sc += mp[((size_t)k * 8 + b) * 12288 + off_sc + col]; sh += mp[((size_t)k * 8 + b) * 12288 + off_sh + col]; } }
            else { sc = mf[b * 12288 + off_sc + col]; sh = mf[b * 12288 + off_sh + col]; }
            cA[col] = gain[col] * (1.f + sc); cB[col] = sh; }
        __syncthreads();
        for (int r = F.wave; r < 128; r += 8) {
            const size_t row = (size_t)ch * 128 + r;
            const float* xr = xin + row * 2048 + F.lane * 8;
            f32x4 v[4][2]; float ss = 0.f;
#pragma unroll
            for (int i = 0; i < 4; ++i) { v[i][0] = *(const f32x4*)(xr + i * 512); v[i][1] = *(const f32x4*)(xr + i * 512 + 4);
#pragma unroll
                for (int j = 0; j < 4; ++j) ss += v[i][0][j] * v[i][0][j] + v[i][1][j] * v[i][1][j]; }
            ss = wave_sum(ss);
            const float rinv = 1.0f / sqrtf(ss * (1.0f / 2048.0f) + EPS);
#pragma unroll
            for (int i = 0; i < 4; ++i) { const int col = i * 512 + F.lane * 8;
                const f32x4 a0 = *(const f32x4*)(cA + col), a1 = *(const f32x4*)(cA + col + 4), b0 = *(const f32x4*)(cB + col), b1 = *(const f32x4*)(cB + col + 4);
                const f32x4 y0 = v[i][0] * rinv * a0 + b0, y1 = v[i][1] * rinv * a1 + b1;
                *(u32x4*)(dst + row * 2048 + col) = pack8(y0, y1);
                if (FIRST) *(u32x2*)(dst8 + row * 2048 + col) = pack8_fp8(y0, y1); }
        }
    }
}

__device__ __forceinline__ void phase3_qknorm(Frame& F) {
    F.lane = lane_now(); F.tid = F.wave * 64 + F.lane;
    const bf16_t* q = (const bf16_t*)(F.ws + WS_QN); const bf16_t* k = (const bf16_t*)(F.ws + WS_KN); const bf16_t* v = (const bf16_t*)(F.ws + WS_V);
    unsigned char* q8 = F.ws + WS_Q8; unsigned char* k8 = F.ws + WS_K8; unsigned char* v8 = F.ws + WS_V8;
    const int gw = F.bid * 8 + F.wave, NGW = F.G * 8;
    for (int row = gw; row < MTOK; row += NGW) {
#pragma unroll
        for (int i = 0; i < 2; ++i) { const int ci = i * 64 + F.lane;
            f32x4 a, b; unpack8(*(const u32x4*)(q + (size_t)row * 1024 + ci * 8), a, b);
            float ss = a[0] * a[0] + a[1] * a[1] + a[2] * a[2] + a[3] * a[3] + b[0] * b[0] + b[1] * b[1] + b[2] * b[2] + b[3] * b[3];
            ss = row_sum16(ss);
            const float rinv = 1.0f / sqrtf(ss * (1.0f / 128.0f) + EPS);
            const float* gp = F.g_q + (ci & 15) * 8; const f32x4 g0 = *(const f32x4*)gp, g1 = *(const f32x4*)(gp + 4);
            *(u32x2*)(q8 + (size_t)row * 1024 + ci * 8) = pack8_fp8(a * rinv * g0, b * rinv * g1); }
        { const int ci = F.lane & 31; const bool isk = F.lane < 32;
            f32x4 a, b; unpack8(*(const u32x4*)((isk ? k : v) + (size_t)row * 256 + ci * 8), a, b);
            float ss = a[0] * a[0] + a[1] * a[1] + a[2] * a[2] + a[3] * a[3] + b[0] * b[0] + b[1] * b[1] + b[2] * b[2] + b[3] * b[3];
            ss = row_sum16(ss);
            const float rinv = isk ? 1.0f / sqrtf(ss * (1.0f / 128.0f) + EPS) : 1.0f;
            const float* gp = F.g_k + (ci & 15) * 8; f32x4 g0 = *(const f32x4*)gp, g1 = *(const f32x4*)(gp + 4);
            if (!isk) { g0 = (f32x4){1.f, 1.f, 1.f, 1.f}; g1 = g0; }
            *(u32x2*)((isk ? k8 : v8) + (size_t)row * 256 + ci * 8) = pack8_fp8(a * rinv * g0, b * rinv * g1); }
    }
}
template <int W> __device__ __forceinline__ void pooled_item(const bf16_t* pl, bf16_t* po, int row, int c8) {
    const int t = row & (SEQ - 1);
    f32x4 s0 = (f32x4){0.f, 0.f, 0.f, 0.f}, s1 = s0, x0 = s0, x1 = s0;
    u32x4 v[W];
#pragma unroll
    for (int j = 0; j < W; ++j) v[j] = *(const u32x4*)(pl + (size_t)(row - (j <= t ? j : 0)) * 1024 + c8);
#pragma unroll
    for (int j = 0; j < W; ++j) { f32x4 a, b; unpack8(v[j], a, b); if (j == 0) { x0 = a; x1 = b; } if (j <= t) { s0 += a; s1 += b; } }
    const float inv = 1.0f / (float)((t + 1 < W) ? t + 1 : W);
    *(u32x4*)(po + (size_t)row * 1024 + c8) = pack8(s0 * inv - x0, s1 * inv - x1);
}
__device__ __forceinline__ void phase3_pooled(Frame& F) {
    F.lane = lane_now(); F.tid = F.wave * 64 + F.lane;
    const bf16_t* pl = (const bf16_t*)(F.ws + WS_PL); bf16_t* po = (bf16_t*)(F.ws + WS_POOLED);
    const int gw = F.bid * 8 + F.wave, NGW = F.G * 8;
    for (int it = gw; it < (MTOK / 2) * 4; it += NGW) {
        const int g = it & 3, row = (it >> 2) * 2 + (F.lane >> 5), c8 = g * 256 + (F.lane & 31) * 8;
        if (g == 0) pooled_item<2>(pl, po, row, c8); else if (g == 1) pooled_item<4>(pl, po, row, c8); else if (g == 2) pooled_item<8>(pl, po, row, c8); else pooled_item<16>(pl, po, row, c8);
    }
}
typedef float f32x16 __attribute__((ext_vector_type(16)));
__device__ __forceinline__ int sel_code(float s, float smin, float scale) { const float c = (s - smin) * scale; return (int)fminf(fmaxf(c, 0.f), 65535.f); }
__device__ __forceinline__ void hist_find(const unsigned* hist, int lane, int K, int& bsel, int& above) {
    const u32x4 h = *(const u32x4*)(hist + lane * 4);
    const int S = (int)(h.x + h.y + h.z + h.w);
    int x = S;
    x += __builtin_amdgcn_update_dpp(0, x, 0x101, 0xF, 0xF, true);
    x += __builtin_amdgcn_update_dpp(0, x, 0x102, 0xF, 0xF, true);
    x += __builtin_amdgcn_update_dpp(0, x, 0x104, 0xF, 0xF, true);
    x += __builtin_amdgcn_update_dpp(0, x, 0x108, 0xF, 0xF, true);
    const int t1 = __builtin_amdgcn_readlane(x, 16), t2 = __builtin_amdgcn_readlane(x, 32), t3 = __builtin_amdgcn_readlane(x, 48);
    const int r = lane >> 4;
    x += (r == 0 ? t1 + t2 + t3 : (r == 1 ? t2 + t3 : (r == 2 ? t3 : 0)));
    const int sufn = x - S;
    const bool mine = (x >= K) && (sufn < K);
    int b = 0, ab = 0;
    { int c = sufn;
      if (c + (int)h.w >= K) { b = 3; ab = c; } else { c += (int)h.w;
      if (c + (int)h.z >= K) { b = 2; ab = c; } else { c += (int)h.z;
      if (c + (int)h.y >= K) { b = 1; ab = c; } else { c += (int)h.y; b = 0; ab = c; } } } }
    const unsigned long long m = __ballot(mine);
    const int src = m ? (int)__builtin_ctzll(m) : 0;
    bsel = __builtin_amdgcn_readlane(lane * 4 + b, src); above = __builtin_amdgcn_readlane(ab, src);
}
__device__ __forceinline__ void indexer_select(Frame& F, int b, int t, const float* rowbuf, unsigned* hist, float* eqv, int* eqi) {
    unsigned short* selrow = (unsigned short*)(F.ws + WS_SEL) + (size_t)(b * SEQ + t) * 256;
    int lane = F.lane; asm volatile("" : "+v"(lane));
    const int nch = t / 64 + 1, n4 = (nch + 3) >> 2;
    const f32x4* rb4 = (const f32x4*)rowbuf;
    float mn = __builtin_huge_valf(), mx = -__builtin_huge_valf();
    for (int c4 = 0; c4 < n4; ++c4) { const f32x4 v = rb4[c4 * 64 + lane];
#pragma unroll
        for (int k = 0; k < 4; ++k) { const bool valid = ((c4 * 4 + k) * 64 + lane) <= t; mn = valid ? fminf(mn, v[k]) : mn; mx = valid ? fmaxf(mx, v[k]) : mx; } }
    mx = xor16_max(row_max16(mx)); { const auto r = __builtin_amdgcn_permlane32_swap(__float_as_uint(mx), __float_as_uint(mx), false, false); mx = fmaxf(__uint_as_float(r[0]), __uint_as_float(r[1])); }
    mn = -mn; mn = xor16_max(row_max16(mn)); { const auto r = __builtin_amdgcn_permlane32_swap(__float_as_uint(mn), __float_as_uint(mn), false, false); mn = -fmaxf(__uint_as_float(r[0]), __uint_as_float(r[1])); }
    const float scale = (mx > mn) ? 65535.0f / (mx - mn) : 0.f;
    *(u32x4*)(hist + lane * 4) = (u32x4){0u, 0u, 0u, 0u};
    for (int c4 = 0; c4 < n4; ++c4) { const f32x4 v = rb4[c4 * 64 + lane];
#pragma unroll
        for (int k = 0; k < 4; ++k) { const bool valid = ((c4 * 4 + k) * 64 + lane) <= t; if (valid) atomicAdd(&hist[sel_code(v[k], mn, scale) >> 8], 1u); } }
    int b1, above1; hist_find(hist, lane, KSEL, b1, above1);
    *(u32x4*)(hist + lane * 4) = (u32x4){0u, 0u, 0u, 0u};
    for (int c4 = 0; c4 < n4; ++c4) { const f32x4 v = rb4[c4 * 64 + lane];
#pragma unroll
        for (int k = 0; k < 4; ++k) { const bool valid = ((c4 * 4 + k) * 64 + lane) <= t; const int code = sel_code(v[k], mn, scale); if (valid && (code >> 8) == b1) atomicAdd(&hist[code & 255], 1u); } }
    int b2, above2; hist_find(hist, lane, KSEL - above1, b2, above2);
    const int T16 = (b1 << 8) | b2, need = KSEL - above1 - above2, ceq = (int)hist[b2];
    const unsigned long long lt_mask = (1ull << lane) - 1ull;
    const bool exact = (ceq != need) && (ceq <= 64);
    if (exact) {
        int pos = 0;
        for (int c = 0; c < nch; ++c) { const float sv = rowbuf[((c >> 2) * 64 + lane) * 4 + (c & 3)]; const int idx = c * 64 + lane;
            const bool eq = (idx <= t) && (sel_code(sv, mn, scale) == T16);
            const unsigned long long m = __ballot(eq);
            if (m) { const int p = pos + __popcll(m & lt_mask); if (eq) { eqv[p] = sv; eqi[p] = idx; } pos += __popcll(m); } }
    }
    int pos = 0, eqseen = 0;
    for (int c = 0; c < nch; ++c) {
        const float sv = rowbuf[((c >> 2) * 64 + lane) * 4 + (c & 3)]; const int idx = c * 64 + lane;
        const int code = sel_code(sv, mn, scale); const bool valid = idx <= t;
        const bool gt = valid && code > T16, eq = valid && code == T16;
        const unsigned long long meq = __ballot(eq);
        bool take = gt;
        if (meq) {
            if (ceq == need) take = take || eq;
            else if (exact) { int rank = 0; for (int m = 0; m < ceq; ++m) { const float ov = eqv[m]; const int oi = eqi[m]; rank += (ov > sv || (ov == sv && oi < idx)) ? 1 : 0; } take = take || (eq && rank < need); }
            else { const int er = eqseen + __popcll(meq & lt_mask); take = take || (eq && er < need); eqseen += __popcll(meq); }
        }
        const unsigned long long mt = __ballot(take);
        const int p = pos + __popcll(mt & lt_mask);
        if (take && p < KSEL) selrow[p] = (unsigned short)idx;
        pos += __popcll(mt);
    }
}
__device__ __forceinline__ void indexer_tile(Frame& F, int b, int t0) {
    const bf16_t* iq = (const bf16_t*)(F.ws + WS_IQ); const bf16_t* ik = (const bf16_t*)(F.ws + WS_IK); const float* iw = (const float*)(F.ws + WS_IW);
    int lane = F.lane; asm volatile("" : "+v"(lane));
    const int w = F.wave;
    if (t0 < KSEL) {
        const int t = t0 + w; unsigned short* selrow = (unsigned short*)(F.ws + WS_SEL) + (size_t)(b * SEQ + t) * 256;
#pragma unroll
        for (int p = 0; p < 4; ++p) { const int j = p * 64 + lane; selrow[j] = (unsigned short)(j <= t ? j : 0xFFFF); }
        return;
    }
    float* rowbuf = (float*)F.lds;
    unsigned char* stage = F.lds + 131072;
    const int p = w & 3, kh = w >> 2, hi = lane >> 5, r = lane & 31;
    const size_t qrow = (size_t)b * SEQ + t0 + 2 * p + (r >> 4);
    bf16x8 a[4];
#pragma unroll
    for (int ks = 0; ks < 4; ++ks) a[ks] = *(const bf16x8*)(iq + qrow * 1024 + (r & 15) * 64 + ks * 16 + 8 * hi);
    float wq[2][8];
#pragma unroll
    for (int q = 0; q < 2; ++q)
#pragma unroll
        for (int i = 0; i < 8; ++i) wq[q][i] = iw[((size_t)b * SEQ + t0 + 2 * p + q) * 16 + (i & 3) + 8 * ((i >> 2) & 1) + 4 * hi];
    const int nchunks = (t0 + 7) / 64 + 1;
    const unsigned char* gsrc = (const unsigned char*)(ik + (size_t)b * SEQ * 64) + F.tid * 16;
    const int skey = F.tid >> 3, sc16 = F.tid & 7, soff = skey * 128 + ((sc16 ^ (skey & 7)) << 4);
    u32x4 s0 = *(const u32x4*)gsrc, s1 = s0, s2 = s0, s3 = s0;
    if (1 < nchunks) s1 = *(const u32x4*)(gsrc + (size_t)1 * 8192);
    if (2 < nchunks) s2 = *(const u32x4*)(gsrc + (size_t)2 * 8192);
    if (3 < nchunks) s3 = *(const u32x4*)(gsrc + (size_t)3 * 8192);
    __syncthreads();
#define IDX_STEP(SR, cc) do { const int c = (cc); unsigned char* sb = stage + (c & 1) * 8192; \
        *(u32x4*)(sb + soff) = SR; \
        __syncthreads(); \
        if (c + 4 < nchunks) SR = *(const u32x4*)(gsrc + (size_t)(c + 4) * 8192); \
        f32x16 d; _Pragma("unroll") for (int i = 0; i < 16; ++i) d[i] = 0.f; \
        const int key = kh * 32 + r; \
        _Pragma("unroll") for (int ks = 0; ks < 4; ++ks) { const bf16x8 bf = *(const bf16x8*)(sb + key * 128 + (((ks * 2 + hi) ^ (key & 7)) << 4)); \
            d = __builtin_amdgcn_mfma_f32_32x32x16_bf16(a[ks], bf, d, 0, 0, 0); } \
        float s0_ = 0.f, s1_ = 0.f; \
        _Pragma("unroll") for (int i = 0; i < 8; ++i) { s0_ += wq[0][i] * fmaxf(d[i], 0.f); s1_ += wq[1][i] * fmaxf(d[8 + i], 0.f); } \
        const float sc = swap32_pair(s0_, s1_); \
        rowbuf[(2 * p + hi) * 4096 + ((c >> 2) * 64 + key) * 4 + (c & 3)] = sc; } while (0)
    for (int c4 = 0; c4 < nchunks; c4 += 4) {
        IDX_STEP(s0, c4);
        if (c4 + 1 < nchunks) IDX_STEP(s1, c4 + 1);
        if (c4 + 2 < nchunks) IDX_STEP(s2, c4 + 2);
        if (c4 + 3 < nchunks) IDX_STEP(s3, c4 + 3);
    }
#if PROBE_IDX == 1
    __syncthreads(); s0 = *(const u32x4*)gsrc; s1 = s0; s2 = s0; s3 = s0;
    if (1 < nchunks) s1 = *(const u32x4*)(gsrc + (size_t)1 * 8192);
    if (2 < nchunks) s2 = *(const u32x4*)(gsrc + (size_t)2 * 8192);
    if (3 < nchunks) s3 = *(const u32x4*)(gsrc + (size_t)3 * 8192);
    for (int c4 = 0; c4 < nchunks; c4 += 4) {
        IDX_STEP(s0, c4);
        if (c4 + 1 < nchunks) IDX_STEP(s1, c4 + 1);
        if (c4 + 2 < nchunks) IDX_STEP(s2, c4 + 2);
        if (c4 + 3 < nchunks) IDX_STEP(s3, c4 + 3);
    }
#endif
#undef IDX_STEP
    __syncthreads();
    indexer_select(F, b, t0 + w, rowbuf + w * 4096, (unsigned*)(F.lds + 147456) + w * 256, (float*)(F.lds + 155648) + w * 64, (int*)(F.lds + 155648 + 2048) + w * 64);
#if PROBE_IDX == 2
    indexer_select(F, b, t0 + w, rowbuf + w * 4096, (unsigned*)(F.lds + 147456) + w * 256, (float*)(F.lds + 155648) + w * 64, (int*)(F.lds + 155648 + 2048) + w * 64);
#endif
}
__device__ __forceinline__ void phase3_indexer(Frame& F) {
    F.lane = lane_now(); F.tid = F.wave * 64 + F.lane;
    const int nit = BATCH * (SEQ / 8);
    for (int k = 0;; ++k) {
        const int l = k * F.G + ((k & 1) ? (F.G - 1 - F.bid) : F.bid);
        if (l >= nit) { if (k * F.G >= nit) break; else continue; }
        const int qb = (SEQ / 8 - 1) - (l >> 3), b = l & 7;
        indexer_tile(F, b, qb * 8);
    }
}

__device__ const unsigned char g_bucket[128] = {0, 1, 2, 3, 4, 5, 6, 7, 8, 9, 10, 11, 12, 13, 14, 15, 16, 16, 16, 17, 17, 18, 18, 18, 19, 19, 19, 20, 20, 20, 20, 21, 21, 21, 21, 22, 22, 22, 22, 22, 23, 23, 23, 23, 23, 23, 24, 24, 24, 24, 24, 24, 25, 25, 25, 25, 25, 25, 25, 26, 26, 26, 26, 26, 26, 26, 26, 27, 27, 27, 27, 27, 27, 27, 27, 27, 27, 28, 28, 28, 28, 28, 28, 28, 28, 28, 28, 29, 29, 29, 29, 29, 29, 29, 29, 29, 29, 29, 29, 30, 30, 30, 30, 30, 30, 30, 30, 30, 30, 30, 30, 30, 30, 31, 31, 31, 31, 31, 31, 31, 31, 31, 31, 31, 31, 31, 31, 31};
__device__ __forceinline__ void phase4_attention(Frame& F) {
    F.lane = lane_now(); F.tid = F.wave * 64 + F.lane;
    const unsigned char* q8 = F.ws + WS_Q8; const unsigned char* k8 = F.ws + WS_K8; const unsigned char* v8 = F.ws + WS_V8;
    const unsigned short* sel = (const unsigned short*)(F.ws + WS_SEL); bf16_t* ao = (bf16_t*)(F.ws + WS_ATTN);
    float* btab = (float*)F.lds;
    __syncthreads();
    for (int i = F.tid; i < 256; i += 512) btab[i] = F.rel_bias[i];
    __syncthreads();
    float* Pl = (float*)(F.lds + 4096 + F.wave * 12288); int* idl = (int*)(Pl + 2048); float* psl = (float*)(idl + 256);
    const bool xmap = (F.G % 8) == 0;
    const int gw = xmap ? (F.bid / 8) * 8 + F.wave : F.bid * 8 + F.wave, NGW = xmap ? F.G : F.G * 8, nrows = xmap ? SEQ : MTOK;
    for (int rr = gw; rr < nrows; rr += NGW) {
        int lane = F.lane; asm volatile("" : "+v"(lane));
        const int row = xmap ? (F.bid & 7) * SEQ + rr : rr;
        const int b = row / SEQ, t = row % SEQ, r = lane & 31, hi = lane >> 5;
#pragma unroll
        for (int p = 0; p < 4; ++p) { idl[p * 64 + lane] = (int)sel[(size_t)row * 256 + p * 64 + lane]; }
        long a0[8], a1[8];
        { u32x4 qa[4];
#pragma unroll
          for (int i = 0; i < 4; ++i) qa[i] = (r < 8) ? *(const u32x4*)(q8 + (size_t)row * 1024 + r * 128 + hi * 64 + i * 16) : (u32x4){0u, 0u, 0u, 0u};
#pragma unroll
          for (int ks = 0; ks < 8; ++ks) { const unsigned lo = qa[ks >> 1][(ks & 1) * 2], hh = qa[ks >> 1][(ks & 1) * 2 + 1]; const long v = (long)(((unsigned long long)hh << 32) | lo);
              a0[ks] = (r < 4) ? v : 0l; a1[ks] = (r >= 4) ? v : 0l; } }
        f32x4 psum = (f32x4){0.f, 0.f, 0.f, 0.f};
#define AT_LOADK(buf, kb) do { const int key_ = idl[(kb) * 32 + r]; const int kc_ = key_ <= t ? key_ : 0; const unsigned char* kr_ = k8 + ((size_t)b * SEQ + kc_) * 256 + hi * 64; \
            _Pragma("unroll") for (int i = 0; i < 4; ++i) { buf[i] = *(const u32x4*)(kr_ + i * 16); buf[4 + i] = *(const u32x4*)(kr_ + 128 + i * 16); } } while (0)
#define AT_QK(buf, kb) do { const int key_ = idl[(kb) * 32 + r]; const bool valid_ = key_ <= t; const int kc_ = valid_ ? key_ : 0; \
            f32x16 d; _Pragma("unroll") for (int i = 0; i < 16; ++i) d[i] = 0.f; \
            _Pragma("unroll") for (int ks = 0; ks < 8; ++ks) { const long bv_ = (long)(((unsigned long long)buf[ks >> 1][(ks & 1) * 2 + 1] << 32) | buf[ks >> 1][(ks & 1) * 2]); d = __builtin_amdgcn_mfma_f32_32x32x16_fp8_fp8(a0[ks], bv_, d, 0, 0, 0); } \
            _Pragma("unroll") for (int ks = 0; ks < 8; ++ks) { const long bv_ = (long)(((unsigned long long)buf[4 + (ks >> 1)][(ks & 1) * 2 + 1] << 32) | buf[4 + (ks >> 1)][(ks & 1) * 2]); d = __builtin_amdgcn_mfma_f32_32x32x16_fp8_fp8(a1[ks], bv_, d, 0, 0, 0); } \
            const int dist_ = t - kc_; const int bkt_ = dist_ < 128 ? (int)g_bucket[dist_] : 31; \
            const f32x4 bias_ = *(const f32x4*)(btab + bkt_ * 8 + 4 * hi); f32x4 e_; \
            _Pragma("unroll") for (int i = 0; i < 4; ++i) e_[i] = valid_ ? __expf(d[i] * 0.08838834764831845f + bias_[i]) : 0.f; \
            psum += e_; *(f32x4*)(Pl + ((kb) * 32 + r) * 8 + 4 * hi) = e_; } while (0)
        {
            u32x4 kA[8], kB[8];
            AT_LOADK(kA, 0);
#pragma unroll 1
            for (int kb = 0; kb < 8; kb += 2) {
                AT_LOADK(kB, kb + 1);
                AT_QK(kA, kb);
                if (kb + 2 < 8) AT_LOADK(kA, kb + 2);
                AT_QK(kB, kb + 1);
            }
        }
#undef AT_LOADK
#undef AT_QK
#pragma unroll
        for (int i = 0; i < 4; ++i) psum[i] = xor16_sum(row_sum16(psum[i]));
        if (r == 0) *(f32x4*)(psl + 4 * hi) = psum;
        const int ks = lane >> 4, g = (lane >> 3) & 1, dc = lane & 7;
        float acc[4][16];
#pragma unroll
        for (int h = 0; h < 4; ++h)
#pragma unroll
            for (int j = 0; j < 16; ++j) acc[h][j] = 0.f;
#define AT_LOADV(buf, it0) do { _Pragma("unroll") for (int u = 0; u < 4; ++u) { const int key_ = idl[((it0) + u) * 4 + ks]; const int kc_ = key_ <= t ? key_ : 0; \
            buf[u] = *(const u32x4*)(v8 + ((size_t)b * SEQ + kc_) * 256 + g * 128 + dc * 16); } } while (0)
#define AT_PV(buf, it0) do { _Pragma("unroll") for (int u = 0; u < 4; ++u) { const int j_ = ((it0) + u) * 4 + ks; const u32x4 w = buf[u]; \
            const f32x4 p = *(const f32x4*)(Pl + j_ * 8 + 4 * g); \
            _Pragma("unroll") for (int dd = 0; dd < 4; ++dd) { const f32x2 lo = __builtin_amdgcn_cvt_pk_f32_fp8((int)w[dd], false), hh_ = __builtin_amdgcn_cvt_pk_f32_fp8((int)w[dd], true); \
                _Pragma("unroll") for (int h = 0; h < 4; ++h) { acc[h][4 * dd] += p[h] * lo.x; acc[h][4 * dd + 1] += p[h] * lo.y; acc[h][4 * dd + 2] += p[h] * hh_.x; acc[h][4 * dd + 3] += p[h] * hh_.y; } } } } while (0)
        {
            u32x4 vA[4], vB[4];
            AT_LOADV(vA, 0);
#pragma unroll 1
            for (int it0 = 0; it0 < 64; it0 += 8) {
                AT_LOADV(vB, it0 + 4);
                AT_PV(vA, it0);
                if (it0 + 8 < 64) AT_LOADV(vA, it0 + 8);
                AT_PV(vB, it0 + 4);
            }
        }
#undef AT_LOADV
#undef AT_PV
#pragma unroll
        for (int h = 0; h < 4; ++h)
#pragma unroll
            for (int j = 0; j < 16; ++j) acc[h][j] = xor32_sum(xor16_sum(acc[h][j]));
#pragma unroll
        for (int h = 0; h < 4; ++h) if (h == ks) { const float inv = 1.0f / psl[4 * g + h];
            bf16_t* op = ao + (size_t)row * 1024 + (4 * g + h) * 128 + dc * 16;
            *(u32x4*)op = pack8((f32x4){acc[h][0], acc[h][1], acc[h][2], acc[h][3]} * inv, (f32x4){acc[h][4], acc[h][5], acc[h][6], acc[h][7]} * inv);
            *(u32x4*)(op + 8) = pack8((f32x4){acc[h][8], acc[h][9], acc[h][10], acc[h][11]} * inv, (f32x4){acc[h][12], acc[h][13], acc[h][14], acc[h][15]} * inv); }
    }
}

__device__ __forceinline__ float dot16f8(u32x4 w, const float* h) {
    float s = 0.f;
#pragma unroll
    for (int d = 0; d < 4; ++d) { const f32x2 lo = __builtin_amdgcn_cvt_pk_f32_fp8((int)w[d], false), hi = __builtin_amdgcn_cvt_pk_f32_fp8((int)w[d], true);
        s += lo.x * h[4 * d] + lo.y * h[4 * d + 1] + hi.x * h[4 * d + 2] + hi.y * h[4 * d + 3]; }
    return s;
}
__device__ __forceinline__ void fma16f8(u32x4 w, float cf, float* acc) {
#pragma unroll
    for (int d = 0; d < 4; ++d) { const f32x2 lo = __builtin_amdgcn_cvt_pk_f32_fp8((int)w[d], false), hi = __builtin_amdgcn_cvt_pk_f32_fp8((int)w[d], true);
        acc[4 * d] += cf * lo.x; acc[4 * d + 1] += cf * lo.y; acc[4 * d + 2] += cf * hi.x; acc[4 * d + 3] += cf * hi.y; }
}
__device__ __forceinline__ float gelu_erf(float x) { return 0.5f * x * (1.0f + erff(x * 0.70710678118654752f)); }
__device__ __forceinline__ void ce_k(unsigned& a, unsigned& b) { const unsigned hi = a > b ? a : b, lo = a > b ? b : a; a = hi; b = lo; }
__device__ __forceinline__ void ce_kp(unsigned& ka, unsigned& pa, unsigned& kb, unsigned& pb) { const bool sw = kb > ka; const unsigned k0 = sw ? kb : ka, k1 = sw ? ka : kb, p0 = sw ? pb : pa, p1 = sw ? pa : pb; ka = k0; kb = k1; pa = p0; pb = p1; }
__device__ __forceinline__ void bmerge16(unsigned (&x)[16]) {
#pragma unroll
    for (int jj = 0; jj < 4; ++jj) { const int j = 8 >> jj;
#pragma unroll
        for (int i = 0; i < 16; ++i) { const int l = i ^ j; if (l > i) ce_k(x[i], x[l]); }
        __builtin_amdgcn_sched_barrier(0); }
}
__device__ __forceinline__ void bmerge16p(unsigned (&x)[16], unsigned (&p)[16]) {
#pragma unroll
    for (int jj = 0; jj < 4; ++jj) { const int j = 8 >> jj;
#pragma unroll
        for (int i = 0; i < 16; ++i) { const int l = i ^ j; if (l > i) ce_kp(x[i], p[i], x[l], p[l]); }
        __builtin_amdgcn_sched_barrier(0); }
}
__device__ __forceinline__ void bsort16(unsigned (&x)[16]) {
#pragma unroll
    for (int kk = 1; kk <= 4; ++kk) { const int k = 1 << kk;
#pragma unroll
        for (int jj = 0; jj < 4; ++jj) { const int j = (k >> 1) >> jj;
            if (j > 0) {
#pragma unroll
                for (int i = 0; i < 16; ++i) { const int l = i ^ j; if (l > i) { if ((i & k) == 0) ce_k(x[i], x[l]); else ce_k(x[l], x[i]); } }
                __builtin_amdgcn_sched_barrier(0); } } }
}
__device__ __forceinline__ void bsort16p(unsigned (&x)[16], unsigned (&p)[16]) {
#pragma unroll
    for (int kk = 1; kk <= 4; ++kk) { const int k = 1 << kk;
#pragma unroll
        for (int jj = 0; jj < 4; ++jj) { const int j = (k >> 1) >> jj;
            if (j > 0) {
#pragma unroll
                for (int i = 0; i < 16; ++i) { const int l = i ^ j; if (l > i) { if ((i & k) == 0) ce_kp(x[i], p[i], x[l], p[l]); else ce_kp(x[l], p[l], x[i], p[i]); } }
                __builtin_amdgcn_sched_barrier(0); } } }
}
__device__ __forceinline__ void top16_row(const unsigned char* rowp, unsigned (&t)[16]) {
#pragma unroll
    for (int i = 0; i < 16; ++i) t[i] = 0u;
#pragma unroll 1
    for (int g = 0; g < 8; ++g) {
        unsigned w[8];
#pragma unroll
        for (int q = 0; q < 4; ++q) { const u32x2 v = *(const u32x2*)(rowp + g * 32 + q * 8); w[2 * q] = v.x; w[2 * q + 1] = v.y; }
        unsigned sk[16];
#pragma unroll
        for (int d = 0; d < 8; ++d) {
            const unsigned lo = w[d] << 16, hi = w[d];
            const unsigned xl = lo ^ ((unsigned)((int)lo >> 31) | 0x80000000u), xh = hi ^ ((unsigned)((int)hi >> 31) | 0x80000000u);
            sk[2 * d] = ((xl >> 9) & 0xFFFFFF80u) | (unsigned)(127 - (g * 16 + 2 * d));
            sk[2 * d + 1] = ((xh >> 9) & 0xFFFFFF80u) | (unsigned)(127 - (g * 16 + 2 * d + 1)); }
        bsort16(sk);
#pragma unroll
        for (int i = 0; i < 16; ++i) t[i] = t[i] > sk[15 - i] ? t[i] : sk[15 - i];
        bmerge16(t);
    }
}
__device__ __forceinline__ float key_val(unsigned key) { const unsigned y = (key << 9) & 0xFFFF0000u; return __uint_as_float((y ^ (~(unsigned)((int)y >> 31) | 0x80000000u)) & 0xFFFF0000u); }
__device__ __forceinline__ unsigned sum_key(float s, int c) { const unsigned u = __float_as_uint(s); return ((u ^ ((unsigned)((int)u >> 31) | 0x80000000u)) & ~63u) | (unsigned)(63 - c); }
__device__ __forceinline__ float sum_val(unsigned k) { const unsigned y = k & ~63u; return __uint_as_float(y ^ (~(unsigned)((int)y >> 31) | 0x80000000u)); }
typedef __bf16 bf2_t __attribute__((ext_vector_type(2)));
__device__ __forceinline__ float dot2_bf(unsigned a, unsigned b, float c) { return __builtin_amdgcn_fdot2_f32_bf16(__builtin_bit_cast(bf2_t, a), __builtin_bit_cast(bf2_t, b), c, false); }
__device__ __forceinline__ float dot32_f6b(u32x4 wa, u32x2 wb, u32x4 h0, u32x4 h1, u32x4 h2, u32x4 h3) {
    const bf16x32 dec = __builtin_amdgcn_cvt_scalef32_pk32_bf16_fp6((u32x6){wa.x, wa.y, wa.z, wa.w, wb.x, wb.y}, 1.0f);
    const u32x16 ud = __builtin_bit_cast(u32x16, dec);
    float acc = 0.f;
    acc = dot2_bf(ud.s0, h0.x, acc); acc = dot2_bf(ud.s1, h0.y, acc); acc = dot2_bf(ud.s2, h0.z, acc); acc = dot2_bf(ud.s3, h0.w, acc);
    acc = dot2_bf(ud.s4, h1.x, acc); acc = dot2_bf(ud.s5, h1.y, acc); acc = dot2_bf(ud.s6, h1.z, acc); acc = dot2_bf(ud.s7, h1.w, acc);
    acc = dot2_bf(ud.s8, h2.x, acc); acc = dot2_bf(ud.s9, h2.y, acc); acc = dot2_bf(ud.sa, h2.z, acc); acc = dot2_bf(ud.sb, h2.w, acc);
    acc = dot2_bf(ud.sc, h3.x, acc); acc = dot2_bf(ud.sd, h3.y, acc); acc = dot2_bf(ud.se, h3.z, acc); acc = dot2_bf(ud.sf, h3.w, acc);
    return acc;
}
__device__ const unsigned char g_cab[64] = {0, 1, 2, 3, 4, 5, 6, 7, 8, 9, 10, 11, 12, 13, 14, 15, 16, 17, 18, 19, 20, 21, 22, 23, 32, 33, 34, 35, 36, 48, 49, 50, 51, 64, 65, 66, 80, 81, 96, 97, 112, 113, 128, 144, 160, 176, 192, 208, 224, 240, 0, 0, 0, 0, 0, 0, 0, 0, 0, 0, 0, 0, 0, 0};
__device__ __forceinline__ void phase10_peer(Frame& F) {
    F.lane = lane_now(); F.tid = F.wave * 64 + F.lane;
    const bf16_t* sub = (const bf16_t*)(F.ws + WS_SUB); const bf16_t* h2 = (const bf16_t*)(F.ws + WS_H2);
    const unsigned char* pu = F.ws + WS_PU; unsigned* pairs = (unsigned*)(F.ws + WS_PAIRS);
    const int gw = F.bid * 8 + F.wave, NGW = F.G * 8;
    unsigned char* wb = F.lds + F.wave * 19200;
    unsigned char* h2b = wb; unsigned short* gl16 = (unsigned short*)(wb + 16896); unsigned* hist = (unsigned*)(wb + 18944); unsigned* base = hist + 32;
    unsigned* tmp = (unsigned*)wb;
    unsigned* wls0 = (unsigned*)(F.ws + WS_WLS) + (size_t)gw * 1024;
    const int ntok = (MTOK - gw + NGW - 1) / NGW;
    constexpr int CA[50] = {0,0,0,0,0,0,0,0,0,0,0,0,0,0,0,0, 1,1,1,1,1,1,1,1, 2,2,2,2,2, 3,3,3,3, 4,4,4, 5,5, 6,6, 7,7, 8,9,10,11,12,13,14,15};
    constexpr int CB[50] = {0,1,2,3,4,5,6,7,8,9,10,11,12,13,14,15, 0,1,2,3,4,5,6,7, 0,1,2,3,4, 0,1,2,3, 0,1,2, 0,1, 0,1, 0,1, 0,0,0,0,0,0,0,0};
    for (int p0 = 0; p0 < ntok; p0 += 8) {
        int lane = F.lane; asm volatile("" : "+v"(lane));
        const int nt = (ntok - p0) < 8 ? (ntok - p0) : 8;
        {
            u32x4 st[16];
#define SEL_LOAD(half) do { asm volatile("" : "+v"(lane)); const int srow_l = lane >> 4, scol = lane & 15; _Pragma("unroll") for (int it = 0; it < 16; ++it) { const int r_ = it * 4 + srow_l; int ti_ = r_ >> 3; ti_ = ti_ < nt ? ti_ : nt - 1; \
                st[it] = *(const u32x4*)(sub + (size_t)(gw + (p0 + ti_) * NGW) * 2048 + (r_ & 7) * 256 + (half) * 128 + scol * 8); } } while (0)
#define SEL_STORE() do { const int srow_l = lane >> 4, scol = lane & 15; _Pragma("unroll") for (int it = 0; it < 16; ++it) { unsigned char* d_ = wb + (it * 4 + srow_l) * 264 + scol * 16; \
                *(u32x2*)d_ = (u32x2){st[it].x, st[it].y}; *(u32x2*)(d_ + 8) = (u32x2){st[it].z, st[it].w}; } } while (0)
            unsigned tA[16], tB[16];
            SEL_LOAD(0); SEL_STORE();
            __builtin_amdgcn_sched_barrier(0);
            top16_row(wb + lane * 264, tA);
            __builtin_amdgcn_sched_barrier(0);
            asm volatile("" : "+v"(tA[0]), "+v"(tA[1]), "+v"(tA[2]), "+v"(tA[3]), "+v"(tA[4]), "+v"(tA[5]), "+v"(tA[6]), "+v"(tA[7]), "+v"(tA[8]), "+v"(tA[9]), "+v"(tA[10]), "+v"(tA[11]), "+v"(tA[12]), "+v"(tA[13]), "+v"(tA[14]), "+v"(tA[15]) :: "memory");
            SEL_LOAD(1); SEL_STORE();
            __builtin_amdgcn_sched_barrier(0);
            top16_row(wb + lane * 264, tB);
            __builtin_amdgcn_sched_barrier(0);
#undef SEL_LOAD
#undef SEL_STORE
            float vA[16], vB[16];
            { unsigned pa[4] = {0u, 0u, 0u, 0u}, pb[4] = {0u, 0u, 0u, 0u};
#pragma unroll
              for (int i = 0; i < 16; ++i) { vA[i] = key_val(tA[i]); vB[i] = key_val(tB[i]); pa[i >> 2] |= (127u - (tA[i] & 127u)) << (8 * (i & 3)); pb[i >> 2] |= (127u - (tB[i] & 127u)) << (8 * (i & 3)); }
              unsigned char* rp = wb + lane * 264;
              *(u32x2*)rp = (u32x2){pa[0], pa[1]}; *(u32x2*)(rp + 8) = (u32x2){pa[2], pa[3]}; *(u32x2*)(rp + 16) = (u32x2){pb[0], pb[1]}; *(u32x2*)(rp + 24) = (u32x2){pb[2], pb[3]}; }
            unsigned tk[16];
#pragma unroll
            for (int c = 0; c < 16; ++c) tk[c] = sum_key(vA[CA[c]] + vB[CB[c]], c);
            bsort16(tk);
#pragma unroll
            for (int grp = 1; grp < 3; ++grp) {
                unsigned sk[16];
#pragma unroll
                for (int e = 0; e < 16; ++e) { const int c = grp * 16 + e; sk[e] = sum_key(vA[CA[c]] + vB[CB[c]], c); }
                bsort16(sk);
#pragma unroll
                for (int i = 0; i < 16; ++i) tk[i] = tk[i] > sk[15 - i] ? tk[i] : sk[15 - i];
                bmerge16(tk);
            }
#pragma unroll
            for (int c = 48; c < 50; ++c) { unsigned k = sum_key(vA[CA[c]] + vB[CB[c]], c);
#pragma unroll
                for (int i = 0; i < 16; ++i) ce_k(tk[i], k); }
            const float s0 = sum_val(tk[0]); float ev[16], esum = 0.f;
#pragma unroll
            for (int r = 0; r < 16; ++r) { ev[r] = __expf(sum_val(tk[r]) - s0); esum += ev[r]; }
            const float einv = 1.0f / esum;
            unsigned eid[16];
            { const unsigned char* rp = wb + lane * 264;
#pragma unroll
              for (int r = 0; r < 16; ++r) { const unsigned cab = g_cab[63u - (tk[r] & 63u)]; eid[r] = (unsigned)rp[cab >> 4] * 128u + (unsigned)rp[16 + (cab & 15u)]; } }
            if ((lane >> 3) < nt) {
#pragma unroll
                for (int r = 0; r < 16; ++r) { const int e = lane * 16 + r; tmp[e] = ((unsigned)e << 14) | eid[r]; gl16[e] = (unsigned short)(cvt_pk_bf16(ev[r] * einv, 0.f) & 0xffffu); } }
        }
        asm volatile("" : "+v"(lane));
#pragma unroll 1
        for (int grp = 0; grp < 2; ++grp) {
            const int ng = nt - grp * 4; const int ne = (ng <= 0 ? 0 : (ng < 4 ? ng : 4)) * 128;
            if (ne == 0) break;
            unsigned* wls = wls0 + grp * 512;
            if (lane < 32) hist[lane] = 0u;
            unsigned ent[8]; unsigned rk[8];
#pragma unroll
            for (int q = 0; q < 8; ++q) { const int e = q * 64 + lane; ent[q] = (e < ne) ? tmp[grp * 512 + e] : 0u; rk[q] = (e < ne) ? atomicAdd(&hist[(ent[q] & 0x3FFFu) >> 9], 1u) : 0u; }
            { int hv = lane < 32 ? (int)hist[lane] : 0; int x = hv;
              x += __builtin_amdgcn_update_dpp(0, x, 0x111, 0xF, 0xF, true); x += __builtin_amdgcn_update_dpp(0, x, 0x112, 0xF, 0xF, true);
              x += __builtin_amdgcn_update_dpp(0, x, 0x114, 0xF, 0xF, true); x += __builtin_amdgcn_update_dpp(0, x, 0x118, 0xF, 0xF, true);
              const int t0 = __builtin_amdgcn_readlane(x, 15); if (lane >= 16) x += t0;
              if (lane < 32) base[lane] = (unsigned)(x - hv); }
#pragma unroll
            for (int q = 0; q < 8; ++q) { const int e = q * 64 + lane; if (e < ne) wls[base[(ent[q] & 0x3FFFu) >> 9] + rk[q]] = ent[q]; }
        }
        asm volatile("s_waitcnt vmcnt(0)" ::: "memory");
#pragma unroll 1
        for (int grp = 0; grp < 2; ++grp) {
            const int ng = nt - grp * 4; const int ngc = ng <= 0 ? 0 : (ng < 4 ? ng : 4), ne = ngc * 128;
            if (ne == 0) break;
            const unsigned* wls = wls0 + grp * 512;
            asm volatile("" : "+v"(lane));
#pragma unroll 1
            for (int i = 0; i < ngc; ++i) { const bf16_t* hr = h2 + (size_t)(gw + (p0 + grp * 4 + i) * NGW) * 2048 + lane * 32;
#pragma unroll
                for (int q = 0; q < 4; ++q) *(u32x4*)(h2b + i * 4096 + q * 1024 + lane * 16) = *(const u32x4*)(hr + q * 8); }
            unsigned entn = __hip_atomic_load(wls + lane, __ATOMIC_RELAXED, __HIP_MEMORY_SCOPE_AGENT);
#pragma unroll 1
            for (int c = 0; c < ne; c += 64) {
                const unsigned ent64 = entn;
                if (c + 64 < ne) entn = __hip_atomic_load(wls + c + 64 + lane, __ATOMIC_RELAXED, __HIP_MEMORY_SCOPE_AGENT);
#pragma unroll 1
                for (int i0 = 0; i0 < 64; i0 += 8) {
                    u32x4 wA[8]; u32x2 wB[8]; unsigned en[8];
#pragma unroll
                    for (int jj = 0; jj < 8; ++jj) { en[jj] = (unsigned)__builtin_amdgcn_readlane((int)ent64, i0 + jj); const unsigned char* ur = pu + (size_t)(en[jj] & 0x3FFFu) * 1536 + lane * 24;
                        const u32x2 t0 = *(const u32x2*)ur, t1 = *(const u32x2*)(ur + 8); wA[jj] = (u32x4){t0.x, t0.y, t1.x, t1.y}; wB[jj] = *(const u32x2*)(ur + 16); }
                    float pr[8];
#pragma unroll
                    for (int jj = 0; jj < 8; ++jj) { const unsigned char* hp = h2b + ((en[jj] >> 21) & 3u) * 4096 + lane * 16;
                        pr[jj] = dot32_f6b(wA[jj], wB[jj], *(const u32x4*)hp, *(const u32x4*)(hp + 1024), *(const u32x4*)(hp + 2048), *(const u32x4*)(hp + 3072)); __builtin_amdgcn_sched_barrier(0); }
#pragma unroll
                    for (int i = 0; i < 4; ++i) pr[i] = swap32_pair(pr[i], pr[i + 4]);
#pragma unroll
                    for (int i = 0; i < 2; ++i) pr[i] = swap16_pair(pr[i], pr[i + 2]);
                    const bool b3 = (lane & 8) != 0;
                    { const float snd = b3 ? pr[0] : pr[1], kp = b3 ? pr[1] : pr[0]; pr[0] = kp + dpp_f<DPP_ROR8>(snd); }
                    float tot = pr[0]; tot += dpp_f<DPP_XOR1>(tot); tot += dpp_f<DPP_XOR2>(tot); tot += dpp_f<DPP_HMIRROR>(tot);
                    const unsigned em = (unsigned)__shfl((int)ent64, i0 + (lane >> 3));
                    if ((lane & 7) == 0) {
                        const int ti = (int)(em >> 21), j = (int)((em >> 14) & 127u), row = gw + (p0 + ti) * NGW;
                        const float cf = gelu_erf(tot * (1.0f / 96.0f)) * __uint_as_float((unsigned)gl16[(em >> 14) & 1023u] << 16);
                        pairs[((size_t)(row >> 6) * 128 + j) * 64 + (row & 63)] = ((unsigned)__builtin_bit_cast(unsigned short, (_Float16)cf) << 16) | (em & 0x3FFFu);
                    }
                }
            }
        }
    }
}

__device__ __forceinline__ void phase11_peer_v(Frame& F, float* dst) {
    F.lane = lane_now(); F.tid = F.wave * 64 + F.lane;
    const unsigned* pairs = (const unsigned*)(F.ws + WS_PAIRS); const float* mf = (const float*)(F.ws + WS_MODF);
    unsigned long long* vs = (unsigned long long*)F.lds;
    for (int c = F.bid; c < DM / 8; c += F.G) {
        __syncthreads();
        { const u32x4* src = (const u32x4*)(F.ws + WS_PV + (size_t)c * NEXP * 8); u32x4* dst = (u32x4*)F.lds;
#pragma unroll 4
          for (int i = F.tid; i < NEXP * 8 / 16; i += 512) dst[i] = src[i]; }
        __syncthreads();
        for (int tile = F.wave; tile < MTOK / 64; tile += 8) {
            int lane = F.lane; asm volatile("" : "+v"(lane));
            const unsigned* pp = pairs + (size_t)tile * 128 * 64 + lane;
            const int row = tile * 64 + lane;
            const float* gt2 = mf + (size_t)(tile / (SEQ / 64)) * 12288 + 10240 + c * 8;
            const float* ip = F.out + (size_t)row * 2048 + c * 8; float* op = dst + (size_t)row * 2048 + c * 8;
            const f32x4 x0 = *(const f32x4*)ip, x1 = *(const f32x4*)(ip + 4), g0 = *(const f32x4*)gt2 * 0.25f, g1 = *(const f32x4*)(gt2 + 4) * 0.25f;
            typedef __fp16 h2_t __attribute__((__vector_size__(2 * sizeof(__fp16))));
            h2_t acc[4];
#pragma unroll
            for (int i = 0; i < 4; ++i) acc[i] = (h2_t){(__fp16)0.f, (__fp16)0.f};
#define P11_LOAD(dst, j0) do { _Pragma("unroll") for (int jj = 0; jj < 16; ++jj) dst[jj] = pp[((j0) + jj) * 64]; } while (0)
#define P11_COMP(src) do { _Pragma("unroll") for (int jj = 0; jj < 16; ++jj) { const unsigned long long v = vs[src[jj] & 0x3FFFu]; \
                    const h2_t cf = __builtin_bit_cast(h2_t, __builtin_amdgcn_perm(src[jj], src[jj], 0x03020302u)); \
                    const int lo = (int)(unsigned)v, hi = (int)(unsigned)(v >> 32); \
                    acc[0] = __builtin_elementwise_fma(__builtin_amdgcn_cvt_scalef32_pk_f16_fp8(lo, 1.0f, false), cf, acc[0]); acc[1] = __builtin_elementwise_fma(__builtin_amdgcn_cvt_scalef32_pk_f16_fp8(lo, 1.0f, true), cf, acc[1]); \
                    acc[2] = __builtin_elementwise_fma(__builtin_amdgcn_cvt_scalef32_pk_f16_fp8(hi, 1.0f, false), cf, acc[2]); acc[3] = __builtin_elementwise_fma(__builtin_amdgcn_cvt_scalef32_pk_f16_fp8(hi, 1.0f, true), cf, acc[3]); } } while (0)
            unsigned pa[16], pb[16];
            P11_LOAD(pa, 0);
#pragma unroll 1
            for (int j0 = 0; j0 < 128; j0 += 32) {
                P11_LOAD(pb, j0 + 16);
                P11_COMP(pa);
                if (j0 + 32 < 128) P11_LOAD(pa, j0 + 32);
                P11_COMP(pb);
            }
#if PROBE_P11X == 1
            { h2_t sv[4]; for (int i = 0; i < 4; ++i) sv[i] = acc[i];
#pragma unroll 1
              for (int j0 = 0; j0 < 128; j0 += 32) {
#pragma unroll
                for (int jj = 0; jj < 16; ++jj) { asm volatile("" : "+v"(pa[jj])); asm volatile("" : "+v"(pb[jj])); }
                P11_COMP(pa); P11_COMP(pb); }
              asm volatile("" :: "v"(acc[0]), "v"(acc[1]), "v"(acc[2]), "v"(acc[3])); for (int i = 0; i < 4; ++i) acc[i] = sv[i]; }
#elif PROBE_P11X == 2
            { P11_LOAD(pa, 0);
#pragma unroll 1
              for (int j0 = 0; j0 < 128; j0 += 32) {
                P11_LOAD(pb, j0 + 16);
#pragma unroll
                for (int jj = 0; jj < 16; ++jj) asm volatile("" :: "v"(pa[jj]));
                if (j0 + 32 < 128) P11_LOAD(pa, j0 + 32);
#pragma unroll
                for (int jj = 0; jj < 16; ++jj) asm volatile("" :: "v"(pb[jj]));
              } }
#endif
#undef P11_LOAD
#undef P11_COMP
            *(f32x4*)op = x0 + g0 * (f32x4){(float)acc[0][0], (float)acc[0][1], (float)acc[1][0], (float)acc[1][1]};
            *(f32x4*)(op + 4) = x1 + g1 * (f32x4){(float)acc[2][0], (float)acc[2][1], (float)acc[3][0], (float)acc[3][1]};
        }
    }
}

__global__ void __launch_bounds__(512, 2) fwd_kernel(Args args) {
    extern __shared__ __attribute__((aligned(16))) unsigned char lds[];
    Frame F;
    F.lds = lds; F.ws = args.ws; F.tid = threadIdx.x; F.lane = F.tid & 63; F.wave = __builtin_amdgcn_readfirstlane(F.tid >> 6); F.G = gridDim.x; F.bid = blockIdx.x;
    F.x = args.in[0]; F.c = args.in[1]; F.w_ada = args.in[2]; F.b_ada = args.in[3]; F.g1 = args.in[4]; F.g2 = args.in[5]; F.w_in = args.in[6]; F.g_q = args.in[7]; F.g_k = args.in[8];
    F.rel_bias = args.in[9]; F.pool_w = args.in[10]; F.pool_scale = args.in[11]; F.w_ab = args.in[12]; F.w_pb = args.in[13]; F.w_out = args.in[14]; F.w_pq = args.in[15];
    F.peer_keys = args.in[16]; F.peer_u = args.in[17]; F.peer_v = args.in[18]; F.out = args.out;
    LAS unsigned char* ldsl = (LAS unsigned char*)lds;
    volatile LAS unsigned* misc = (volatile LAS unsigned*)(ldsl + MISC_OFF);
    if (F.tid < 4) misc[F.tid] = 0u;
    __syncthreads();
    unsigned* barw = (unsigned*)(args.ws + WS_CTL) + (size_t)args.li * XCD_BAR_WORDS;
    XcdBarrier bar; bar.bar = barw; bar.x = 0; bar.st = misc;
    const int lo = args.ph_lo, hi = args.ph_hi;
    if (hi - lo > 1) bar = xcd_barrier_post(barw, misc);
#define IN(k) (lo <= (k) && (k) < hi)
#define SEAM(k) do { if (IN(k) && IN((k) + 1)) xcd_barrier(bar, F.wave); } while (0)
    bf16_t* R0 = (bf16_t*)(F.ws + WS_R0);

#define PH2_BODY { \
        { pg8::Gemm g{(const bf16_t*)(F.ws + WS_H1F8), (const bf16_t*)(F.ws + WS_WIN8), MTOK, 5632, DM / 2, DM / 2, 0, nullptr, nullptr, 0, 0}; pg8::StaticOrder S; S.init(MTOK, 5632, F.G, F.bid); \
          EpiInproj<true> E{(bf16_t*)(F.ws + WS_QN), (bf16_t*)(F.ws + WS_KN), (bf16_t*)(F.ws + WS_V), (bf16_t*)(F.ws + WS_IQ), (bf16_t*)(F.ws + WS_IK), (bf16_t*)(F.ws + WS_PL), \
                    (bf16_t*)(F.ws + WS_GA), (bf16_t*)(F.ws + WS_GP), (float*)(F.ws + WS_IW)}; \
          pg8::gemm_phase<EpiInproj<true>, true>(ldsl, g, S, E, F.wave); } \
        { pg8::Gemm g{R0, (const bf16_t*)(F.ws + WS_WIN16), MTOK, 2304, DM, DM, 0, nullptr, nullptr, 0, 0}; pg8::StaticOrder S; S.init(MTOK, 2304, F.G, F.bid); \
          EpiInproj<false> E{(bf16_t*)(F.ws + WS_QN), (bf16_t*)(F.ws + WS_KN), (bf16_t*)(F.ws + WS_V), (bf16_t*)(F.ws + WS_IQ), (bf16_t*)(F.ws + WS_IK), (bf16_t*)(F.ws + WS_PL), \
                    (bf16_t*)(F.ws + WS_GA), (bf16_t*)(F.ws + WS_GP), (float*)(F.ws + WS_IW)}; \
          pg8::gemm_phase<EpiInproj<false>>(ldsl, g, S, E, F.wave); } }
#define PH3_BODY { phase3_pooled(F); phase3_indexer(F); __syncthreads(); }
#define PH4_BODY { \
        phase4_attention(F); \
        __syncthreads(); \
        pg8::Gemm g{(const bf16_t*)(F.ws + WS_POOLED), (const bf16_t*)(F.ws + WS_POOLW), MTOK, PW, 256, 1024, 256, nullptr, nullptr, 0, 0}; pg8::StaticOrder S; S.init(MTOK, PW, F.G, F.bid); \
        EpiBf16Scale E{(bf16_t*)(F.ws + WS_POOL2), 1024, F.pool_scale}; \
        pg8::gemm_phase<EpiBf16Scale>(ldsl, g, S, E, F.wave); }
#define PH5_BODY { \
        pg8::Gemm g{(const bf16_t*)(F.ws + WS_ATTN), (const bf16_t*)(F.ws + WS_WAB), MTOK, DM, 2048, 1024, 0, (const bf16_t*)(F.ws + WS_POOL2), (const bf16_t*)(F.ws + WS_WPB), 16, 1024}; \
        pg8::StaticOrder S; S.init(MTOK, DM, F.G, F.bid); \
        EpiMerge E{(unsigned char*)R0, (const bf16_t*)(F.ws + WS_GA), (const bf16_t*)(F.ws + WS_GP)}; pg8::gemm_phase<EpiMerge>(ldsl, g, S, E, F.wave); }
#define PH6_BODY { \
        pg8::Gemm g{R0, (const bf16_t*)(F.ws + WS_WOUT), MTOK, DM, DM / 2, DM / 2, 0, nullptr, nullptr, 0, 0}; pg8::StaticOrder S; S.init(MTOK, DM, F.G, F.bid); \
        EpiResid E{F.x, F.out, (const float*)(F.ws + WS_MODF) + 4096}; pg8::gemm_phase<EpiResid, true>(ldsl, g, S, E, F.wave); }
#define PH8_BODY { \
        pg8::Gemm g{(const bf16_t*)(F.ws + WS_H2), (const bf16_t*)(F.ws + WS_WPQ), MTOK, DM, DM, DM, 0, nullptr, nullptr, 0, 0}; pg8::StaticOrder S; S.init(MTOK, DM, F.G, F.bid); \
        EpiBf16Scale E{R0, 2048, nullptr}; pg8::gemm_phase<EpiBf16Scale>(ldsl, g, S, E, F.wave); }
#define PH9_BODY { \
        pg8::Gemm g{R0, (const bf16_t*)(F.ws + WS_KEYSBD), MTOK, DM, 256, DM, 256, nullptr, nullptr, 0, 0}; pg8::StaticOrder S; S.init(MTOK, DM, F.G, F.bid); \
        EpiBf16Scale E{(bf16_t*)(F.ws + WS_SUB), 2048, nullptr}; pg8::gemm_phase<EpiBf16Scale>(ldsl, g, S, E, F.wave); }
#define REP(k) if constexpr (((PROBE_REP) >> (k)) & 1)

    if (IN(0)) { phase0_prep(F); REP(0) { __syncthreads(); phase0_prep(F); } }
    SEAM(0);
    if (IN(1)) { phase_modnorm<true>(F, F.x, F.g1, 0, 2048, R0, F.ws + WS_H1F8); REP(1) { phase_modnorm<true>(F, F.x, F.g1, 0, 2048, R0, F.ws + WS_H1F8); } }
    SEAM(1);
    if (IN(2)) { PH2_BODY REP(2) PH2_BODY }
    SEAM(2);
    if (IN(3)) { phase3_qknorm(F); PH3_BODY REP(3) PH3_BODY }
    SEAM(3);
    if (IN(4)) { PH4_BODY REP(4) PH4_BODY }
    SEAM(4);
    if (IN(5)) { PH5_BODY REP(5) PH5_BODY }
    SEAM(5);
    if (IN(6)) { PH6_BODY REP(6) PH6_BODY }
    SEAM(6);
    if (IN(7)) { phase_modnorm<false>(F, F.out, F.g2, 6144, 8192, (bf16_t*)(F.ws + WS_H2)); REP(7) { phase_modnorm<false>(F, F.out, F.g2, 6144, 8192, (bf16_t*)(F.ws + WS_H2)); } }
    SEAM(7);
    if (IN(8)) { PH8_BODY REP(8) PH8_BODY }
    SEAM(8);
    if (IN(9)) { PH9_BODY REP(9) PH9_BODY }
    SEAM(9);
    if (IN(10)) { phase10_peer(F); REP(10) phase10_peer(F); }
    SEAM(10);
    if (IN(11)) { REP(11) { phase11_peer_v(F, (float*)(F.ws + WS_SUB)); } phase11_peer_v(F, F.out); }
#undef IN
#undef SEAM
}

extern "C" void kernel_launch(void* const* d_in, const int* in_sizes, int n_in, void* d_out, int out_size, void* d_ws, size_t ws_size, hipStream_t stream) {
    static int grid = 0;
    if (grid == 0) {
        if (n_in != 19 || out_size != MTOK * DM || ws_size < WS_END) { fprintf(stderr, "kernel_launch: unexpected shapes (n_in %d out %d ws %zu)\n", n_in, out_size, ws_size); grid = -1; return; }
        int dev = 0, cus = 0, per_cu = 0;
        if (hipGetDevice(&dev) != hipSuccess || hipDeviceGetAttribute(&cus, hipDeviceAttributeMultiprocessorCount, dev) != hipSuccess) { grid = -1; return; }
        if (hipFuncSetAttribute((const void*)fwd_kernel, hipFuncAttributeMaxDynamicSharedMemorySize, LDS_BYTES) != hipSuccess) { fprintf(stderr, "kernel_launch: hipFuncSetAttribute failed\n"); grid = -1; return; }
        if (hipOccupancyMaxActiveBlocksPerMultiprocessor(&per_cu, (const void*)fwd_kernel, 512, LDS_BYTES) != hipSuccess || per_cu < 1) { fprintf(stderr, "kernel_launch: occupancy query says %d\n", per_cu); }
        (void)hipGetLastError();
        grid = cus;
    }
    if (grid < 0) return;
    (void)in_sizes;
    if (hipMemsetAsync((char*)d_ws + WS_CTL, 0, CTL_ZERO_BYTES, stream) != hipSuccess) return;
    Args a{};
    for (int i = 0; i < 19; ++i) a.in[i] = (const float*)d_in[i];
    a.out = (float*)d_out; a.ws = (unsigned char*)d_ws;
#if MK_PER_PHASE
    for (int p = 0; p < NPHASE; ++p) { a.ph_lo = p; a.ph_hi = p + 1; a.li = p; hipLaunchKernelGGL(fwd_kernel, dim3(grid), dim3(512), LDS_BYTES, stream, a); }
#else
    a.ph_lo = 0; a.ph_hi = NPHASE; a.li = 0;
    hipLaunchKernelGGL(fwd_kernel, dim3(grid), dim3(512), LDS_BYTES, stream, a);
#endif
}
```

```cpp
#include <hip/hip_runtime.h>
#include <cstdio>
#include <cstdint>

#ifndef MK_PER_PHASE
#define MK_PER_PHASE 0
#endif

#ifndef PROBE_REP
#define PROBE_REP 0
#endif
#ifndef PROBE_IDX
#define PROBE_IDX 0
#endif
#ifndef PROBE_P11X
#define PROBE_P11X 0
#endif
#define LAS __attribute__((address_space(3)))
typedef unsigned short bf16_t;
typedef short bf16x8 __attribute__((ext_vector_type(8)));
typedef float f32x4 __attribute__((ext_vector_type(4)));
typedef float f32x2 __attribute__((ext_vector_type(2)));
typedef unsigned u32x4 __attribute__((ext_vector_type(4)));
typedef unsigned u32x2 __attribute__((ext_vector_type(2)));
typedef unsigned u32x6 __attribute__((ext_vector_type(6)));
typedef unsigned u32x16 __attribute__((ext_vector_type(16)));
typedef __bf16 bf16x32 __attribute__((ext_vector_type(32)));

constexpr int BATCH = 8, SEQ = 4096, DM = 2048, MTOK = BATCH * SEQ;
constexpr int NHEAD = 8, HDIM = 128, AW = 1024, KVW = 256, IHEADS = 16, IDIM = 64, KSEL = 256;
constexpr int PW = 1024, PHEADS = 8, NEXP = 16384;
constexpr int INW = 7760;
constexpr float EPS = 1e-6f;
constexpr int NPHASE = 12;

constexpr size_t MiB = 1u << 20;
constexpr size_t WS_CTL = 0, CTL_ZERO_BYTES = 256 * 1024;
constexpr size_t WS_MODP = 2 * MiB;
constexpr size_t WS_MODF = 4 * MiB;
constexpr size_t WS_POOLW = 5 * MiB;
constexpr size_t WS_KEYSBD = 6 * MiB;
constexpr size_t WS_WIN16 = 8 * MiB;
constexpr size_t WS_WIN8 = 20 * MiB;
constexpr size_t WS_WAB = 40 * MiB, WS_WPB = 44 * MiB, WS_WOUT = 48 * MiB, WS_WPQ = 56 * MiB;
constexpr size_t WS_PU = 64 * MiB, WS_PV = 128 * MiB;
constexpr size_t WS_R0 = 192 * MiB;
constexpr size_t WS_GA = 320 * MiB, WS_GP = 448 * MiB;
constexpr size_t WS_SUB = 320 * MiB;
constexpr size_t WS_QN = 576 * MiB;
constexpr size_t WS_IQ = 640 * MiB;
constexpr size_t WS_PL = 704 * MiB;
constexpr size_t WS_KN = 768 * MiB, WS_V = 784 * MiB;
constexpr size_t WS_IK = 800 * MiB;
constexpr size_t WS_IW = 804 * MiB;
constexpr size_t WS_SEL = 806 * MiB;
constexpr size_t WS_POOLED = 822 * MiB;
constexpr size_t WS_H2 = 886 * MiB;
constexpr size_t WS_END = 1014 * MiB;
constexpr size_t WS_H1F8 = WS_H2 + 64 * MiB;
constexpr size_t WS_Q8 = WS_H2, WS_K8 = WS_H2 + 32 * MiB, WS_V8 = WS_H2 + 40 * MiB;
constexpr size_t WS_ATTN = WS_IQ, WS_POOL2 = WS_PL, WS_PAIRS = WS_QN, WS_WLS = WS_QN + 32 * MiB;

constexpr int LDS_BYTES = 160 * 1024;
constexpr int MISC_OFF = 159 * 1024;

__device__ __forceinline__ unsigned cvt_pk_bf16(float lo, float hi) { unsigned r; asm volatile("v_cvt_pk_bf16_f32 %0, %1, %2" : "=v"(r) : "v"(lo), "v"(hi)); return r; }
__device__ __forceinline__ float bf_lo(unsigned w) { return __uint_as_float(w << 16); }
__device__ __forceinline__ float bf_hi(unsigned w) { return __uint_as_float(w & 0xffff0000u); }
template <int CTRL> __device__ __forceinline__ float dpp_f(float x) { return __int_as_float(__builtin_amdgcn_update_dpp(0, __float_as_int(x), CTRL, 0xF, 0xF, true)); }
#define DPP_XOR1 0xB1
#define DPP_XOR2 0x4E
#define DPP_HMIRROR 0x141
#define DPP_MIRROR 0x140
#define DPP_ROR8 0x128
__device__ __forceinline__ float xor16_sum(float x) { const auto r = __builtin_amdgcn_permlane16_swap(__float_as_uint(x), __float_as_uint(x), false, false); return __uint_as_float(r[0]) + __uint_as_float(r[1]); }
__device__ __forceinline__ float xor32_sum(float x) { const auto r = __builtin_amdgcn_permlane32_swap(__float_as_uint(x), __float_as_uint(x), false, false); return __uint_as_float(r[0]) + __uint_as_float(r[1]); }
__device__ __forceinline__ float xor16_max(float x) { const auto r = __builtin_amdgcn_permlane16_swap(__float_as_uint(x), __float_as_uint(x), false, false); return fmaxf(__uint_as_float(r[0]), __uint_as_float(r[1])); }
__device__ __forceinline__ float swap32_pair(float a, float b) { const auto r = __builtin_amdgcn_permlane32_swap(__float_as_uint(a), __float_as_uint(b), false, false); return __uint_as_float(r[0]) + __uint_as_float(r[1]); }
__device__ __forceinline__ float swap16_pair(float a, float b) { const auto r = __builtin_amdgcn_permlane16_swap(__float_as_uint(a), __float_as_uint(b), false, false); return __uint_as_float(r[0]) + __uint_as_float(r[1]); }
__device__ __forceinline__ float row_sum16(float v) { v += dpp_f<DPP_XOR1>(v); v += dpp_f<DPP_XOR2>(v); v += dpp_f<DPP_HMIRROR>(v); v += dpp_f<DPP_MIRROR>(v); return v; }
__device__ __forceinline__ float row_max16(float v) { v = fmaxf(v, dpp_f<DPP_XOR1>(v)); v = fmaxf(v, dpp_f<DPP_XOR2>(v)); v = fmaxf(v, dpp_f<DPP_HMIRROR>(v)); v = fmaxf(v, dpp_f<DPP_MIRROR>(v)); return v; }
__device__ __forceinline__ float wave_sum(float v) { return xor32_sum(xor16_sum(row_sum16(v))); }
__device__ __forceinline__ float sigmoidf_(float x) { return __builtin_amdgcn_rcpf(1.0f + __expf(-x)); }
__device__ __forceinline__ float dot8(u32x4 w, const float* h) {
    return bf_lo(w.x) * h[0] + bf_hi(w.x) * h[1] + bf_lo(w.y) * h[2] + bf_hi(w.y) * h[3] + bf_lo(w.z) * h[4] + bf_hi(w.z) * h[5] + bf_lo(w.w) * h[6] + bf_hi(w.w) * h[7];
}

__device__ __forceinline__ int lane_now() { int l; asm volatile("v_mbcnt_lo_u32_b32 %0, -1, 0\n\tv_mbcnt_hi_u32_b32 %0, -1, %0" : "=v"(l)); return l; }

#define XB_TMO      128
#define XB_XCNT(j)  (256  + 64 * (j))
#define XB_XSUB(j)  (1280 + 64 * (j))
#define XB_XGEN(j)  (2304 + 64 * (j))
#define XB_TOP      3328
#define XB_TOPGEN   3392
#define XCD_BAR_WORDS 3456
#define XB_SPIN_CAP (1u << 18)

__device__ __forceinline__ unsigned xb_ld(unsigned* p)              { return __hip_atomic_load(p, __ATOMIC_RELAXED, __HIP_MEMORY_SCOPE_AGENT); }
__device__ __forceinline__ unsigned xb_add(unsigned* p, unsigned v) { return __hip_atomic_fetch_add(p, v, __ATOMIC_RELAXED, __HIP_MEMORY_SCOPE_AGENT); }
__device__ __forceinline__ unsigned xb_xcc_id() { return (unsigned)__builtin_amdgcn_s_getreg((3 << 11) | 20) & 0xFu; }
#define XB_SPIN(cond, bar) do { unsigned _sp = 0; while (cond) { __builtin_amdgcn_s_sleep(1); \
    if ((++_sp & 255u) == 0u) { if (xb_ld(&(bar)[XB_TMO])) break; if (_sp > XB_SPIN_CAP) { atomicAdd(&(bar)[XB_TMO], 1u); break; } } } } while (0)

struct XcdBarrier { unsigned* bar; unsigned x; volatile LAS unsigned* st; };

__device__ __forceinline__ XcdBarrier xcd_barrier_post(unsigned* bar, volatile LAS unsigned* st) {
    XcdBarrier b; b.bar = bar; b.x = xb_xcc_id(); b.st = st;
    if (threadIdx.x == 0) (void)xb_add(&bar[XB_XCNT(b.x)], 1u);
    return b;
}
__device__ __forceinline__ void xcd_barrier_complete(unsigned* bar, unsigned x, unsigned& nloc, unsigned& nx) {
    const unsigned G = gridDim.x * gridDim.y * gridDim.z;
    unsigned sum, cnt, mine, sp = 0u;
    for (;;) {
        sum = 0u; cnt = 0u; mine = 0u;
#pragma unroll
        for (unsigned j = 0; j < 16; ++j) { const unsigned c = xb_ld(&bar[XB_XCNT(j)]); sum += c; cnt += (c > 0u) ? 1u : 0u; mine = (j == x) ? c : mine; }
        if (sum == G) break;
        __builtin_amdgcn_s_sleep(1);
        if ((++sp & 255u) == 0u) { if (xb_ld(&bar[XB_TMO])) break; if (sp > XB_SPIN_CAP) { atomicAdd(&bar[XB_TMO], 1u); break; } }
    }
    nloc = mine > 0u ? mine : 1u; nx = cnt > 0u ? cnt : 1u;
}
__device__ __forceinline__ void xcd_barrier(const XcdBarrier& b, int wave) {
    asm volatile("s_waitcnt vmcnt(0)" ::: "memory");
    __syncthreads();
    if (wave == 0 && lane_now() == 0) {
        unsigned* bar = b.bar;
        __builtin_amdgcn_s_waitcnt(0);
        unsigned nloc = b.st[0], nx = b.st[1];
        if (nloc == 0u) { xcd_barrier_complete(bar, b.x, nloc, nx); b.st[0] = nloc; b.st[1] = nx; }
        const unsigned old = xb_add(&bar[XB_XSUB(b.x)], 1u);
        const unsigned gen = old / nloc;
        if (old + 1u == (gen + 1u) * nloc) {
            __builtin_amdgcn_fence(__ATOMIC_RELEASE, "agent");
            asm volatile("s_waitcnt vmcnt(0)" ::: "memory");
            const unsigned og = xb_add(&bar[XB_TOP], 1u);
            const unsigned tg = og / nx;
            if (og + 1u == (tg + 1u) * nx) xb_add(&bar[XB_TOPGEN], 1u);
            else XB_SPIN(xb_ld(&bar[XB_TOPGEN]) == tg, bar);
            __builtin_amdgcn_fence(__ATOMIC_ACQUIRE, "agent");
            xb_add(&bar[XB_XGEN(b.x)], 1u);
            asm volatile("s_waitcnt vmcnt(0)" ::: "memory");
        } else {
            XB_SPIN(xb_ld(&bar[XB_XGEN(b.x)]) == gen, bar);
            __builtin_amdgcn_fence(__ATOMIC_ACQUIRE, "agent");
            asm volatile("s_waitcnt vmcnt(0)" ::: "memory");
        }
    }
    __syncthreads();
}

namespace pg8 {
constexpr int BM = 256, BK = 64, HALF = 128, HTB = HALF * BK * 2, STAGE_BYTES = 8 * HTB, NXCD = 8, WGM = 8;
__device__ __forceinline__ int lds_byte(int r, int c) { const int st = (r >> 4) * 2 + (c >> 5), rr = r & 15, cc = c & 31, ob = rr * 64 + cc * 2; return st * 1024 + (ob ^ (((ob >> 9) & 1) << 5)); }
__device__ __forceinline__ void stage_rc(int b, int& R, int& C) { const int st = b / 1024, sb = b % 1024, swz = sb ^ (((sb >> 9) & 1) << 5); R = (st >> 1) * 16 + swz / 64; C = (st & 1) * 32 + (swz % 64) / 2; }
__device__ __forceinline__ int perm32(int rho) { const int n = rho >> 4, i = rho & 15; return 8 * (i >> 2) + 4 * n + (i & 3); }

struct Unit { int pm, pn; };
struct Gemm { const bf16_t* A; const bf16_t* Bt; int M, N, K, lda, a_pn_off; const bf16_t* A2; const bf16_t* Bt2; int ksplit, ldb; };

struct StaticOrder {
    int nM, nN, nwg, G, c;
    __device__ void init(int M, int N, int G_, int c_) { nM = M / BM; nN = N / BM; nwg = nM * nN; G = G_; c = c_; }
    __device__ bool next(int i, Unit& u) const {
        const long L = (long)i * G + c; if (L >= nwg) return false;
        int wgid = (int)L; { const int q = nwg / NXCD, r = nwg % NXCD, xcd = wgid % NXCD, off = wgid / NXCD; wgid = (xcd < r ? xcd * (q + 1) : r * (q + 1) + (xcd - r) * q) + off; }
        const int nig = WGM * nN, gid = wgid / nig, fm = gid * WGM, gsz = (nM - fm) < WGM ? (nM - fm) : WGM;
        u.pm = fm + ((wgid % nig) % gsz); u.pn = (wgid % nig) / gsz; return true;
    }
};

typedef int i32x4 __attribute__((ext_vector_type(4)));
typedef int i32x8 __attribute__((ext_vector_type(8)));
__device__ __forceinline__ bf16x8 lo8(i32x8 v) { return __builtin_bit_cast(bf16x8, (i32x4){v.s0, v.s1, v.s2, v.s3}); }
__device__ __forceinline__ bf16x8 hi8(i32x8 v) { return __builtin_bit_cast(bf16x8, (i32x4){v.s4, v.s5, v.s6, v.s7}); }
__device__ __forceinline__ i32x8 cat8(bf16x8 a, bf16x8 b) { const i32x4 x = __builtin_bit_cast(i32x4, a), y = __builtin_bit_cast(i32x4, b); return (i32x8){x.x, x.y, x.z, x.w, y.x, y.y, y.z, y.w}; }
template <class Epi, bool F8 = false>
__device__ __forceinline__ void gemm_phase(LAS unsigned char* lds, const Gemm g, const StaticOrder& S, const Epi& E, int wave) {
    const int lane = lane_now(), wid = wave, tid = wid * 64 + lane, wr = wid >> 2, wc = wid & 3, fr = lane & 15, fq = lane >> 4;
    const int K = g.K, nt = K / BK, lda = g.lda, ldb = g.ldb ? g.ldb : g.K, ksplit = g.ksplit;
    unsigned voffA, voffB;
    { int R, C; stage_rc(tid * 16, R, C); const int Rb = Epi::PERM ? ((R & ~31) + perm32(R & 31)) : R;
      voffA = (unsigned)(R * lda + C) * 2u; voffB = (unsigned)(Rb * ldb + C) * 2u; }
    const unsigned stepA = 64u * (unsigned)lda * 2u, stepB = 64u * (unsigned)ldb * 2u;
    const size_t kstep = (size_t)(BK * 2);
    const size_t hsA = (size_t)HALF * lda * 2, hsB = (size_t)HALF * ldb * 2;
    const size_t tsA = 2 * hsA, tsB = 2 * hsB;
    const unsigned ldsw = (unsigned)wid * 1024u, ldsbase = (unsigned)(unsigned long long)lds;
    const int aoff = lds_byte(wr * 64 + fr, fq * 8), boff = lds_byte(wc * 32 + fr, fq * 8);
#define PG8_SA(b, h) (((b) * 2 + (h)) * HTB)
#define PG8_SB(b, h) ((4 + (b) * 2 + (h)) * HTB)
#define PG8_STAGE(bufoff, gbase, voff) do { _Pragma("unroll") for (int _i = 0; _i < 2; ++_i) { \
        const char* sb_ = (const char*)(gbase) + (size_t)_i * PG8_STEP_##voff; const unsigned m0_ = ldsbase + (unsigned)(bufoff) + ldsw + (unsigned)_i * 8192u; \
        asm volatile("s_mov_b32 m0, %2\n\ts_nop 0\n\tglobal_load_lds_dwordx4 %0, %1" :: "v"(voff), "s"(sb_), "s"(m0_) : "memory"); } } while (0)
#define PG8_STEP_voffA stepA
#define PG8_STEP_voffB stepB
#define PG8_LDA(dst, b, h) do { _Pragma("unroll") for (int m = 0; m < 4; ++m) dst[m] = cat8(*(const LAS bf16x8*)(lds + PG8_SA(b, h) + aoff + m * 2048), *(const LAS bf16x8*)(lds + PG8_SA(b, h) + aoff + m * 2048 + 1024)); } while (0)
#define PG8_LDB(dst, b, h) do { _Pragma("unroll") for (int n = 0; n < 2; ++n) dst[n] = cat8(*(const LAS bf16x8*)(lds + PG8_SB(b, h) + boff + n * 2048), *(const LAS bf16x8*)(lds + PG8_SB(b, h) + boff + n * 2048 + 1024)); } while (0)
#define PG8_MMA(ai, bj, At, Bt) do { __builtin_amdgcn_s_setprio(1); _Pragma("unroll") for (int m = 0; m < 4; ++m) _Pragma("unroll") for (int n = 0; n < 2; ++n) { \
        if constexpr (F8) acc[ai][bj][m][n] = __builtin_amdgcn_mfma_scale_f32_16x16x128_f8f6f4(Bt[n], At[m], acc[ai][bj][m][n], 0, 0, 0, 0x7D7D7D7D  , 0, 0x7D7D7D7D); \
        else { acc[ai][bj][m][n] = __builtin_amdgcn_mfma_f32_16x16x32_bf16(lo8(Bt[n]), lo8(At[m]), acc[ai][bj][m][n], 0, 0, 0); \
               acc[ai][bj][m][n] = __builtin_amdgcn_mfma_f32_16x16x32_bf16(hi8(Bt[n]), hi8(At[m]), acc[ai][bj][m][n], 0, 0, 0); } } \
        __builtin_amdgcn_s_setprio(0); } while (0)
#define PG8_WAIT_V(n) asm volatile("s_waitcnt vmcnt(" #n ")" ::: "memory")
#define PG8_WAIT_L(n) asm volatile("s_waitcnt lgkmcnt(" #n ")" ::: "memory")
#define PG8_BAR __builtin_amdgcn_s_barrier()
#define PG8_SCHED __builtin_amdgcn_sched_barrier(0)
    Unit cur, nxt; int ui = 0;
    if (!S.next(0, cur)) return;
    f32x4 acc[2][2][4][2];
#pragma unroll
    for (int a = 0; a < 2; ++a)
#pragma unroll
        for (int b = 0; b < 2; ++b)
#pragma unroll
            for (int m = 0; m < 4; ++m)
#pragma unroll
                for (int n = 0; n < 2; ++n) acc[a][b][m][n] = (f32x4){0.f, 0.f, 0.f, 0.f};
    i32x8 At[4], B0[2], B1[2];
    const char* cA = (const char*)g.A + (size_t)cur.pm * tsA + (size_t)cur.pn * g.a_pn_off * 2; const char* cB = (const char*)g.Bt + (size_t)cur.pn * tsB;
    PG8_STAGE(PG8_SB(0, 0), cB, voffB); PG8_STAGE(PG8_SB(0, 1), cB + hsB, voffB); PG8_STAGE(PG8_SA(0, 0), cA, voffA); PG8_STAGE(PG8_SA(0, 1), cA + hsA, voffA);
    if (wr == 1) PG8_BAR;
    PG8_WAIT_V(2); PG8_BAR;
    PG8_STAGE(PG8_SB(1, 0), cB + kstep, voffB); PG8_STAGE(PG8_SA(1, 0), cA + kstep, voffA); PG8_STAGE(PG8_SB(1, 1), cB + hsB + kstep, voffB);
    PG8_WAIT_V(6); PG8_BAR;
    for (;;) {
        const bool has_next = S.next(ui + 1, nxt);
        const char* nA = has_next ? (const char*)g.A + (size_t)nxt.pm * tsA + (size_t)nxt.pn * g.a_pn_off * 2 : cA; const char* nB = has_next ? (const char*)g.Bt + (size_t)nxt.pn * tsB : cB;
        const char* cA2 = (const char*)g.A2 + (size_t)cur.pm * tsA; const char* cB2 = (const char*)g.Bt2 + (size_t)cur.pn * tsB;
#pragma clang loop unroll(disable)
        for (int t = 0; t < nt; t += 2) {
            const bool last = (t == nt - 2);
            const bool s1 = ksplit && (t >= ksplit), s2 = ksplit && (t + 2 >= ksplit);
            const char* a1 = (s1 ? cA2 + (size_t)(t - ksplit + 1) * kstep : cA + (size_t)(t + 1) * kstep);
            const char* a2 = last ? nA : (s2 ? cA2 + (size_t)(t + 2 - ksplit) * kstep : cA + (size_t)(t + 2) * kstep);
            const char* b2 = last ? nB : (s2 ? cB2 + (size_t)(t + 2 - ksplit) * kstep : cB + (size_t)(t + 2) * kstep);
            const char* a3 = a2 + kstep; const char* b3 = b2 + kstep;
            PG8_LDB(B0, 0, 0); PG8_LDB(B1, 0, 1); PG8_SCHED; PG8_LDA(At, 0, 0); PG8_STAGE(PG8_SA(1, 1), a1 + hsA, voffA);
            PG8_WAIT_V(8); PG8_WAIT_L(0); PG8_BAR; PG8_MMA(0, 0, At, B0); PG8_MMA(0, 1, At, B1); PG8_BAR; PG8_SCHED;
            PG8_LDA(At, 0, 1); PG8_STAGE(PG8_SB(0, 0), b2, voffB); PG8_STAGE(PG8_SB(0, 1), b2 + hsB, voffB); PG8_STAGE(PG8_SA(0, 0), a2, voffA);
            PG8_WAIT_V(8); PG8_WAIT_L(0); PG8_BAR; PG8_MMA(1, 0, At, B0); PG8_MMA(1, 1, At, B1); PG8_BAR; PG8_SCHED;
            PG8_LDB(B0, 1, 0); PG8_LDB(B1, 1, 1); PG8_SCHED; PG8_LDA(At, 1, 0); PG8_STAGE(PG8_SA(0, 1), a2 + hsA, voffA);
            PG8_WAIT_V(8); PG8_WAIT_L(0); PG8_BAR; PG8_MMA(0, 0, At, B0); PG8_MMA(0, 1, At, B1); PG8_BAR; PG8_SCHED;
            PG8_LDA(At, 1, 1); PG8_STAGE(PG8_SB(1, 0), b3, voffB); PG8_STAGE(PG8_SB(1, 1), b3 + hsB, voffB); PG8_STAGE(PG8_SA(1, 0), a3, voffA);
            PG8_WAIT_V(8); PG8_WAIT_L(0); PG8_BAR; PG8_MMA(1, 0, At, B0); PG8_MMA(1, 1, At, B1); PG8_BAR; PG8_SCHED;
            if constexpr (Epi::MID) { if (t + 2 == ksplit) E.mid(acc, cur, wr, wc, fr, fq); }
        }
        if (wr == 0) PG8_BAR;
        { const int l2 = lane_now(); E(acc, cur, wr, wc, l2 & 15, l2 >> 4); }
        if (!has_next) break;
#pragma unroll
        for (int a = 0; a < 2; ++a)
#pragma unroll
            for (int b = 0; b < 2; ++b)
#pragma unroll
                for (int m = 0; m < 4; ++m)
#pragma unroll
                    for (int n = 0; n < 2; ++n) acc[a][b][m][n] = (f32x4){0.f, 0.f, 0.f, 0.f};
        cur = nxt; cA = nA; cB = nB; ++ui;
        if (wr == 1) PG8_BAR;
    }
    PG8_WAIT_V(0);
    PG8_BAR;
#undef PG8_SA
#undef PG8_SB
#undef PG8_STAGE
#undef PG8_STEP_voffA
#undef PG8_STEP_voffB
#undef PG8_LDA
#undef PG8_LDB
#undef PG8_MMA
#undef PG8_WAIT_V
#undef PG8_WAIT_L
#undef PG8_BAR
#undef PG8_SCHED
}
}
using pg8::Unit;

typedef f32x4 AccT[2][2][4][2];
__device__ __forceinline__ u32x4 pack8(f32x4 a, f32x4 b) { u32x4 w; w.x = cvt_pk_bf16(a[0], a[1]); w.y = cvt_pk_bf16(a[2], a[3]); w.z = cvt_pk_bf16(b[0], b[1]); w.w = cvt_pk_bf16(b[2], b[3]); return w; }
__device__ __forceinline__ u32x2 pack8_fp8(f32x4 a, f32x4 b) {
    int w0 = __builtin_amdgcn_cvt_pk_fp8_f32(a[0], a[1], 0, false); w0 = __builtin_amdgcn_cvt_pk_fp8_f32(a[2], a[3], w0, true);
    int w1 = __builtin_amdgcn_cvt_pk_fp8_f32(b[0], b[1], 0, false); w1 = __builtin_amdgcn_cvt_pk_fp8_f32(b[2], b[3], w1, true);
    return (u32x2){(unsigned)w0, (unsigned)w1};
}
__device__ __forceinline__ void unpack8(u32x4 w, f32x4& a, f32x4& b) { a = (f32x4){bf_lo(w.x), bf_hi(w.x), bf_lo(w.y), bf_hi(w.y)}; b = (f32x4){bf_lo(w.z), bf_hi(w.z), bf_lo(w.w), bf_hi(w.w)}; }

template <bool SET8> struct EpiInproj {
    static constexpr bool PERM = true, MID = false;
    bf16_t *q, *k, *v, *iq, *ik, *pl, *ga, *gp; float* iw;
    __device__ __forceinline__ void operator()(const AccT& acc, const Unit& u, int wr, int wc, int fr, int fq) const {
        const int pn = u.pn, row0 = u.pm * 256 + wr * 64 + fr;
        if (!SET8 && pn == 4) {
            if (wc < 2) {
#pragma unroll
                for (int ai = 0; ai < 2; ++ai)
#pragma unroll
                    for (int m = 0; m < 4; ++m) { const size_t row = (size_t)(row0 + ai * 128 + m * 16);
                        *(u32x4*)(ik + row * 64 + wc * 32 + 8 * fq) = pack8(acc[ai][0][m][0], acc[ai][0][m][1]); }
            } else if (wc == 2) {
                if (fq < 2) {
#pragma unroll
                    for (int ai = 0; ai < 2; ++ai)
#pragma unroll
                        for (int m = 0; m < 4; ++m) { const size_t row = (size_t)(row0 + ai * 128 + m * 16);
                            *(f32x4*)(iw + row * 16 + 8 * fq) = acc[ai][0][m][0]; *(f32x4*)(iw + row * 16 + 8 * fq + 4) = acc[ai][0][m][1]; }
                }
            }
            return;
        }
        bf16_t* dst; int ld, tc; bool sg = false;
        if (SET8) {
            if (pn < 4) { dst = q; ld = 1024; tc = pn * 256; }
            else if (pn == 4) { dst = k; ld = 256; tc = 0; }
            else if (pn == 5) { dst = v; ld = 256; tc = 0; }
            else if (pn < 14) { dst = ga; ld = 2048; tc = (pn - 6) * 256; sg = true; }
            else { dst = gp; ld = 2048; tc = (pn - 14) * 256; sg = true; }
        } else {
            if (pn < 4) { dst = iq; ld = 1024; tc = pn * 256; }
            else { dst = pl; ld = 1024; tc = (pn - 5) * 256; }
        }
        const int col0 = tc + wc * 32 + 8 * fq;
#pragma unroll
        for (int ai = 0; ai < 2; ++ai)
#pragma unroll
            for (int m = 0; m < 4; ++m) { bf16_t* rowp = dst + (size_t)(row0 + ai * 128 + m * 16) * ld + col0;
#pragma unroll
                for (int bj = 0; bj < 2; ++bj) { f32x4 v0 = acc[ai][bj][m][0], v1 = acc[ai][bj][m][1];
                    if (sg) {
#pragma unroll
                        for (int j = 0; j < 4; ++j) { v0[j] = sigmoidf_(v0[j]); v1[j] = sigmoidf_(v1[j]); } }
                    *(u32x4*)(rowp + bj * 128) = pack8(v0, v1); } }
    }
};
struct EpiBf16Scale {
    static constexpr bool PERM = true, MID = false;
    bf16_t* O; int ldc; const float* cs;
    __device__ __forceinline__ void operator()(const AccT& acc, const Unit& u, int wr, int wc, int fr, int fq) const {
        const int row0 = u.pm * 256 + wr * 64 + fr, col0 = u.pn * 256 + wc * 32 + 8 * fq;
        f32x4 s[2][2];
#pragma unroll
        for (int bj = 0; bj < 2; ++bj)
#pragma unroll
            for (int n = 0; n < 2; ++n) s[bj][n] = cs ? *(const f32x4*)(cs + col0 + bj * 128 + 4 * n) : (f32x4){1.f, 1.f, 1.f, 1.f};
#pragma unroll
        for (int ai = 0; ai < 2; ++ai)
#pragma unroll
            for (int m = 0; m < 4; ++m) { bf16_t* rowp = O + (size_t)(row0 + ai * 128 + m * 16) * ldc + col0;
#pragma unroll
                for (int bj = 0; bj < 2; ++bj) *(u32x4*)(rowp + bj * 128) = pack8(acc[ai][bj][m][0] * s[bj][0], acc[ai][bj][m][1] * s[bj][1]); }
    }
};
template <bool ADD> struct EpiGate {
    static constexpr bool PERM = true, MID = false;
    bf16_t* O; const bf16_t* gate;
    __device__ __forceinline__ void operator()(const AccT& acc, const Unit& u, int wr, int wc, int fr, int fq) const {
        const int row0 = u.pm * 256 + wr * 64 + fr, col0 = u.pn * 256 + wc * 32 + 8 * fq;
#pragma unroll
        for (int ai = 0; ai < 2; ++ai)
#pragma unroll
            for (int m = 0; m < 4; ++m) { const size_t off = (size_t)(row0 + ai * 128 + m * 16) * 2048 + col0;
#pragma unroll
                for (int bj = 0; bj < 2; ++bj) { f32x4 g0, g1; unpack8(*(const u32x4*)(gate + off + bj * 128), g0, g1);
                    f32x4 r0 = g0 * acc[ai][bj][m][0], r1 = g1 * acc[ai][bj][m][1];
                    if (ADD) { f32x4 o0, o1; unpack8(*(const u32x4*)(O + off + bj * 128), o0, o1); r0 += o0; r1 += o1; }
                    *(u32x4*)(O + off + bj * 128) = pack8(r0, r1); } }
    }
};
struct EpiMerge {
    static constexpr bool PERM = true, MID = true;
    unsigned char* O; const bf16_t* ga; const bf16_t* gp;
    __device__ __forceinline__ void mid(AccT& acc, const Unit& u, int wr, int wc, int fr, int fq) const {
        const auto ra = __builtin_amdgcn_make_buffer_rsrc((void*)ga, 0, 0x7FFFFFFF, 0x00020000), rp = __builtin_amdgcn_make_buffer_rsrc((void*)gp, 0, 0x7FFFFFFF, 0x00020000);
        const int voff = ((wr * 64 + fr) * 2048 + wc * 32 + 8 * fq) * 2;
        const int sbase = (u.pm * 256 * 2048 + u.pn * 256) * 2;
#pragma unroll
        for (int ai = 0; ai < 2; ++ai)
#pragma unroll
            for (int m = 0; m < 4; ++m)
#pragma unroll
                for (int bj = 0; bj < 2; ++bj) { const int so = sbase + ((ai * 128 + m * 16) * 2048 + bj * 128) * 2;
                    const u32x4 wa = __builtin_bit_cast(u32x4, __builtin_amdgcn_raw_buffer_load_b128(ra, voff, so, 0)), wp = __builtin_bit_cast(u32x4, __builtin_amdgcn_raw_buffer_load_b128(rp, voff, so, 0));
                    f32x4 a0, a1, p0, p1; unpack8(wa, a0, a1); unpack8(wp, p0, p1);
#pragma unroll
                    for (int j = 0; j < 4; ++j) { acc[ai][bj][m][0][j] *= a0[j] * __builtin_amdgcn_rcpf(p0[j]); acc[ai][bj][m][1][j] *= a1[j] * __builtin_amdgcn_rcpf(p1[j]); }
                    asm volatile("" : "+v"(acc[ai][bj][m][0]), "+v"(acc[ai][bj][m][1]) :: "memory"); }
    }
    __device__ __forceinline__ void operator()(const AccT& acc, const Unit& u, int wr, int wc, int fr, int fq) const {
        const int row0 = u.pm * 256 + wr * 64 + fr, col0 = u.pn * 256 + wc * 32 + 8 * fq;
#pragma unroll
        for (int ai = 0; ai < 2; ++ai)
#pragma unroll
            for (int m = 0; m < 4; ++m) { const size_t off = (size_t)(row0 + ai * 128 + m * 16) * 2048 + col0;
#pragma unroll
                for (int bj = 0; bj < 2; ++bj) { f32x4 p0, p1; unpack8(*(const u32x4*)(gp + off + bj * 128), p0, p1);
                    *(u32x2*)(O + off + bj * 128) = pack8_fp8(p0 * acc[ai][bj][m][0], p1 * acc[ai][bj][m][1]); } }
    }
};
struct EpiResid {
    static constexpr bool PERM = false, MID = false;
    const float* x; float* out; const float* gt;
    __device__ __forceinline__ void operator()(const AccT& acc, const Unit& u, int wr, int wc, int fr, int fq) const {
        const int row0 = u.pm * 256 + wr * 64 + fr, col0 = u.pn * 256 + wc * 32 + 4 * fq;
        const float* gtb = gt + (size_t)(u.pm / 16) * 12288;
        f32x4 g[2][2];
#pragma unroll
        for (int bj = 0; bj < 2; ++bj)
#pragma unroll
            for (int n = 0; n < 2; ++n) g[bj][n] = *(const f32x4*)(gtb + col0 + bj * 128 + n * 16);
#pragma unroll
        for (int ai = 0; ai < 2; ++ai)
#pragma unroll
            for (int m = 0; m < 4; ++m) { const size_t off = (size_t)(row0 + ai * 128 + m * 16) * 2048 + col0;
#pragma unroll
                for (int bj = 0; bj < 2; ++bj)
#pragma unroll
                    for (int n = 0; n < 2; ++n) { const f32x4 xv = *(const f32x4*)(x + off + bj * 128 + n * 16);
                        *(f32x4*)(out + off + bj * 128 + n * 16) = xv + g[bj][n] * acc[ai][bj][m][n]; } }
    }
};
struct EpiF32 {
    static constexpr bool PERM = false, MID = false;
    float* C; int ldc;
    __device__ __forceinline__ void operator()(const AccT& acc, const Unit& u, int wr, int wc, int fr, int fq) const {
        const int row0 = u.pm * 256 + wr * 64 + fr, col0 = u.pn * 256 + wc * 32 + 4 * fq;
#pragma unroll
        for (int ai = 0; ai < 2; ++ai)
#pragma unroll
            for (int m = 0; m < 4; ++m) { float* rowp = C + (size_t)(row0 + ai * 128 + m * 16) * ldc + col0;
#pragma unroll
                for (int bj = 0; bj < 2; ++bj)
#pragma unroll
                    for (int n = 0; n < 2; ++n) *(f32x4*)(rowp + bj * 128 + n * 16) = acc[ai][bj][m][n]; }
    }
};

struct Args { const float* in[19]; float* out; unsigned char* ws; int ph_lo, ph_hi; int li, pad; };
struct Frame {
    unsigned char* lds; unsigned char* ws;
    int tid, lane, wave, G, bid;
    const float *x, *c, *w_ada, *b_ada, *g1, *g2, *w_in, *g_q, *g_k, *rel_bias, *pool_w, *pool_scale, *w_ab, *w_pb, *w_out, *w_pq, *peer_keys, *peer_u, *peer_v;
    float* out;
};

template <bool F8OUT = false, class Fn> __device__ __forceinline__ void transpose_item(const float* W, int K, int N, void* WTv, int ldk, int drow0, int k0, float* scr, int lane, Fn srccol, float mul = 1.0f) {
    const int sc = srccol(drow0 + (lane & 31));
#pragma unroll 8
    for (int i = 0; i < 32; ++i) { const int kk = 2 * i + (lane >> 5); scr[kk * 33 + (lane & 31)] = sc >= 0 ? W[(size_t)(k0 + kk) * N + sc] * mul : 0.f; }
    asm volatile("s_waitcnt lgkmcnt(0)" ::: "memory");
    const int c = lane & 7;
#pragma unroll
    for (int j = 0; j < 4; ++j) { const int n = (lane >> 3) + 8 * j; const float* s = scr + (8 * c) * 33 + n;
        if constexpr (F8OUT) { *(u32x2*)((unsigned char*)WTv + (size_t)(drow0 + n) * ldk + k0 + 8 * c) = pack8_fp8((f32x4){s[0 * 33], s[1 * 33], s[2 * 33], s[3 * 33]}, (f32x4){s[4 * 33], s[5 * 33], s[6 * 33], s[7 * 33]}); }
        else { u32x4 o; o.x = cvt_pk_bf16(s[0 * 33], s[1 * 33]); o.y = cvt_pk_bf16(s[2 * 33], s[3 * 33]); o.z = cvt_pk_bf16(s[4 * 33], s[5 * 33]); o.w = cvt_pk_bf16(s[6 * 33], s[7 * 33]);
            *(u32x4*)((bf16_t*)WTv + (size_t)(drow0 + n) * ldk + k0 + 8 * c) = o; } }
    asm volatile("s_waitcnt lgkmcnt(0)" ::: "memory");
}
__device__ __forceinline__ void phase0_prep(Frame& F) {
    F.lane = lane_now(); F.tid = F.wave * 64 + F.lane;
    const int gw = F.bid * 8 + F.wave, NGW = F.G * 8;
    float* scr = (float*)(F.lds + F.wave * 16384);
    constexpr int I_IN16 = (2304 / 32) * (DM / 64), I_IN8 = (5632 / 32) * (DM / 64);
    constexpr int I_AB = (2048 / 32) * (1024 / 64), I_OUT = (2048 / 32) * (2048 / 64), I_PW = 4 * 8 * 4;
    constexpr int NIT = I_IN16 + I_IN8 + 2 * I_AB + 2 * I_OUT + I_PW;
    auto ident = [](int j) { return j; };
    for (int it = gw; it < NIT; it += NGW) {
        int r = it;
        if (r < I_IN16) { const int nb = r % 72, kb = r / 72;
            transpose_item(F.w_in, DM, INW, F.ws + WS_WIN16, DM, nb * 32, kb * 64, scr, F.lane, [](int j) { return j < 1104 ? j + 1536 : (j < 1280 ? -1 : j + 1360); }); continue; }
        r -= I_IN16;
        if (r < I_IN8) { const int nb = r % 176, kb = r / 176;
            transpose_item<true>(F.w_in, DM, INW, F.ws + WS_WIN8, DM, nb * 32, kb * 64, scr, F.lane, [](int j) { return j < 1536 ? j : j + 2128; }, 16.0f); continue; }
        r -= I_IN8;
        if (r < I_AB) { transpose_item(F.w_ab, 1024, 2048, (bf16_t*)(F.ws + WS_WAB), 1024, (r % 64) * 32, (r / 64) * 64, scr, F.lane, ident); continue; }
        r -= I_AB;
        if (r < I_AB) { transpose_item(F.w_pb, 1024, 2048, (bf16_t*)(F.ws + WS_WPB), 1024, (r % 64) * 32, (r / 64) * 64, scr, F.lane, ident); continue; }
        r -= I_AB;
        if (r < I_OUT) { transpose_item<true>(F.w_out, 2048, 2048, F.ws + WS_WOUT, 2048, (r % 64) * 32, (r / 64) * 64, scr, F.lane, ident, 16.0f); continue; }
        r -= I_OUT;
        if (r < I_OUT) { transpose_item(F.w_pq, 2048, 2048, (bf16_t*)(F.ws + WS_WPQ), 2048, (r % 64) * 32, (r / 64) * 64, scr, F.lane, ident); continue; }
        r -= I_OUT;
        { const int g = r / 32, q = r % 32, nb = q % 8, kb = q / 8;
          transpose_item(F.pool_w + (size_t)g * 65536, 256, 256, (bf16_t*)(F.ws + WS_POOLW) + (size_t)g * 65536, 256, nb * 32, kb * 64, scr, F.lane, ident); }
    }
    {
        bf16_t* kb = (bf16_t*)(F.ws + WS_KEYSBD);
        for (int i = F.bid * 512 + F.tid; i < 2048 * 32; i += F.G * 512) {
            const int row = i / 32, k8 = (i % 32) * 8, p = (row >> 7) & 1;
            u32x4 o = (u32x4){0u, 0u, 0u, 0u};
            if ((k8 >> 7) == p) { const float* s = F.peer_keys + (size_t)row * 128 + (k8 & 127); const f32x4 a = *(const f32x4*)s, b = *(const f32x4*)(s + 4); o = pack8(a, b); }
            *(u32x4*)(kb + (size_t)row * 256 + k8) = o;
        }
    }
    {
        unsigned char* pu = F.ws + WS_PU;
        for (size_t i = (size_t)F.bid * 512 + F.tid; i < (size_t)NEXP * 64; i += (size_t)F.G * 512) {
            const float* src = F.peer_u + i * 32;
            u32x16 pk;
#pragma unroll
            for (int k = 0; k < 8; ++k) { const f32x4 a = *(const f32x4*)(src + k * 4) * 96.0f; pk[2 * k] = cvt_pk_bf16(a[0], a[1]); pk[2 * k + 1] = cvt_pk_bf16(a[2], a[3]); }
            const u32x6 p6 = __builtin_amdgcn_cvt_scalef32_pk32_fp6_bf16(__builtin_bit_cast(bf16x32, pk), 1.0f);
            unsigned char* dst = pu + i * 24;
            *(u32x2*)dst = (u32x2){p6[0], p6[1]}; *(u32x2*)(dst + 8) = (u32x2){p6[2], p6[3]}; *(u32x2*)(dst + 16) = (u32x2){p6[4], p6[5]};
        }
        unsigned char* pv = F.ws + WS_PV;
        for (int it = gw; it < (NEXP / 64) * 128; it += NGW) {
            const int e = (it >> 7) * 64 + F.lane, ch = it & 127;
            u32x4 ov;
#pragma unroll
            for (int k = 0; k < 4; ++k) { const f32x4 c = *(const f32x4*)(F.peer_v + (size_t)e * DM + ch * 16 + k * 4) * 4.0f;
                int wv = __builtin_amdgcn_cvt_pk_fp8_f32(c[0], c[1], 0, false); wv = __builtin_amdgcn_cvt_pk_fp8_f32(c[2], c[3], wv, true); ov[k] = (unsigned)wv; }
            *(u32x2*)(pv + ((size_t)(2 * ch) * NEXP + e) * 8) = (u32x2){ov[0], ov[1]};
            *(u32x2*)(pv + ((size_t)(2 * ch + 1) * NEXP + e) * 8) = (u32x2){ov[2], ov[3]};
        }
    }
    {
        __syncthreads();
        float* cact = (float*)(F.lds + 131072);
        float* red = (float*)F.lds;
        float* mp = (float*)(F.ws + WS_MODP);
        for (int it = F.bid; it < 48 * 4; it += F.G) {
            const int cb = it % 48, ds = it / 48, d0 = ds * 512;
            for (int i = F.tid; i < 8 * 512; i += 512) { const int b = i >> 9, d = i & 511; const float cv = F.c[b * DM + d0 + d]; cact[i] = cv * sigmoidf_(cv); }
            __syncthreads();
            f32x4 a[8];
#pragma unroll
            for (int b = 0; b < 8; ++b) a[b] = (f32x4){0.f, 0.f, 0.f, 0.f};
            const float* wp = F.w_ada + (size_t)(d0 + F.wave * 64) * 12288 + cb * 256 + F.lane * 4;
#pragma unroll 4
            for (int d = 0; d < 64; ++d) { const f32x4 w = *(const f32x4*)(wp + (size_t)d * 12288);
#pragma unroll
                for (int b = 0; b < 8; ++b) a[b] += w * cact[b * 512 + F.wave * 64 + d]; }
#pragma unroll
            for (int b = 0; b < 8; ++b)
#pragma unroll
                for (int j = 0; j < 4; ++j) red[(F.wave * 32 + b * 4 + j) * 64 + F.lane] = a[b][j];
            __syncthreads();
            for (int i = F.tid; i < 2048; i += 512) { const int v = i >> 6, l = i & 63; float s = 0.f;
#pragma unroll
                for (int w = 0; w < 8; ++w) s += red[(w * 32 + v) * 64 + l];
                mp[((size_t)ds * 8 + (v >> 2)) * 12288 + cb * 256 + l * 4 + (v & 3)] = s; }
            __syncthreads();
        }
    }
}

template <bool FIRST> __device__ __forceinline__ void phase_modnorm(Frame& F, const float* xin, const float* gain, int off_sh, int off_sc, bf16_t* dst, unsigned char* dst8 = nullptr) {
    F.lane = lane_now(); F.tid = F.wave * 64 + F.lane;
    const float* mp = (const float*)(F.ws + WS_MODP); float* mf = (float*)(F.ws + WS_MODF);
    if (FIRST) {
        for (int i = F.bid * 512 + F.tid; i < 8 * 12288; i += F.G * 512) {
            float s = F.b_ada[i % 12288];
#pragma unroll
            for (int k = 0; k < 4; ++k) s += mp[(size_t)k * 8 * 12288 + i];
            mf[i] = s; }
    }
    float* cA = (float*)F.lds; float* cB = cA + 2048;
    for (int ch = F.bid; ch < MTOK / 128; ch += F.G) {
        const int b = ch / 32;
        __syncthreads();
        for (int col = F.tid; col < 2048; col += 512) {
            float sc, sh;
            if (FIRST) { sc = F.b_ada[off_sc + col]; sh = F.b_ada[off_sh + col];
#pragma unroll
                for (int k = 0; k < 4; ++k) { sc += mp[((size_t)k * 8 + b) * 12288 + off_sc + col]; sh += mp[((size_t)k * 8 + b) * 12288 + off_sh + col]; } }
            else { sc = mf[b * 12288 + off_sc + col]; sh = mf[b * 12288 + off_sh + col]; }
            cA[col] = gain[col] * (1.f + sc); cB[col] = sh; }
        __syncthreads();
        for (int r = F.wave; r < 128; r += 8) {
            const size_t row = (size_t)ch * 128 + r;
            const float* xr = xin + row * 2048 + F.lane * 8;
            f32x4 v[4][2]; float ss = 0.f;
#pragma unroll
            for (int i = 0; i < 4; ++i) { v[i][0] = *(const f32x4*)(xr + i * 512); v[i][1] = *(const f32x4*)(xr + i * 512 + 4);
#pragma unroll
                for (int j = 0; j < 4; ++j) ss += v[i][0][j] * v[i][0][j] + v[i][1][j] * v[i][1][j]; }
            ss = wave_sum(ss);
            const float rinv = 1.0f / sqrtf(ss * (1.0f / 2048.0f) + EPS);
#pragma unroll
            for (int i = 0; i < 4; ++i) { const int col = i * 512 + F.lane * 8;
                const f32x4 a0 = *(const f32x4*)(cA + col), a1 = *(const f32x4*)(cA + col + 4), b0 = *(const f32x4*)(cB + col), b1 = *(const f32x4*)(cB + col + 4);
                const f32x4 y0 = v[i][0] * rinv * a0 + b0, y1 = v[i][1] * rinv * a1 + b1;
                *(u32x4*)(dst + row * 2048 + col) = pack8(y0, y1);
                if (FIRST) *(u32x2*)(dst8 + row * 2048 + col) = pack8_fp8(y0, y1); }
        }
    }
}

__device__ __forceinline__ void phase3_qknorm(Frame& F) {
    F.lane = lane_now(); F.tid = F.wave * 64 + F.lane;
    const bf16_t* q = (const bf16_t*)(F.ws + WS_QN); const bf16_t* k = (const bf16_t*)(F.ws + WS_KN); const bf16_t* v = (const bf16_t*)(F.ws + WS_V);
    unsigned char* q8 = F.ws + WS_Q8; unsigned char* k8 = F.ws + WS_K8; unsigned char* v8 = F.ws + WS_V8;
    const int gw = F.bid * 8 + F.wave, NGW = F.G * 8;
    for (int row = gw; row < MTOK; row += NGW) {
#pragma unroll
        for (int i = 0; i < 2; ++i) { const int ci = i * 64 + F.lane;
            f32x4 a, b; unpack8(*(const u32x4*)(q + (size_t)row * 1024 + ci * 8), a, b);
            float ss = a[0] * a[0] + a[1] * a[1] + a[2] * a[2] + a[3] * a[3] + b[0] * b[0] + b[1] * b[1] + b[2] * b[2] + b[3] * b[3];
            ss = row_sum16(ss);
            const float rinv = 1.0f / sqrtf(ss * (1.0f / 128.0f) + EPS);
            const float* gp = F.g_q + (ci & 15) * 8; const f32x4 g0 = *(const f32x4*)gp, g1 = *(const f32x4*)(gp + 4);
            *(u32x2*)(q8 + (size_t)row * 1024 + ci * 8) = pack8_fp8(a * rinv * g0, b * rinv * g1); }
        { const int ci = F.lane & 31; const bool isk = F.lane < 32;
            f32x4 a, b; unpack8(*(const u32x4*)((isk ? k : v) + (size_t)row * 256 + ci * 8), a, b);
            float ss = a[0] * a[0] + a[1] * a[1] + a[2] * a[2] + a[3] * a[3] + b[0] * b[0] + b[1] * b[1] + b[2] * b[2] + b[3] * b[3];
            ss = row_sum16(ss);
            const float rinv = isk ? 1.0f / sqrtf(ss * (1.0f / 128.0f) + EPS) : 1.0f;
            const float* gp = F.g_k + (ci & 15) * 8; f32x4 g0 = *(const f32x4*)gp, g1 = *(const f32x4*)(gp + 4);
            if (!isk) { g0 = (f32x4){1.f, 1.f, 1.f, 1.f}; g1 = g0; }
            *(u32x2*)((isk ? k8 : v8) + (size_t)row * 256 + ci * 8) = pack8_fp8(a * rinv * g0, b * rinv * g1); }
    }
}
template <int W> __device__ __forceinline__ void pooled_item(const bf16_t* pl, bf16_t* po, int row, int c8) {
    const int t = row & (SEQ - 1);
    f32x4 s0 = (f32x4){0.f, 0.f, 0.f, 0.f}, s1 = s0, x0 = s0, x1 = s0;
    u32x4 v[W];
#pragma unroll
    for (int j = 0; j < W; ++j) v[j] = *(const u32x4*)(pl + (size_t)(row - (j <= t ? j : 0)) * 1024 + c8);
#pragma unroll
    for (int j = 0; j < W; ++j) { f32x4 a, b; unpack8(v[j], a, b); if (j == 0) { x0 = a; x1 = b; } if (j <= t) { s0 += a; s1 += b; } }
    const float inv = 1.0f / (float)((t + 1 < W) ? t + 1 : W);
    *(u32x4*)(po + (size_t)row * 1024 + c8) = pack8(s0 * inv - x0, s1 * inv - x1);
}
__device__ __forceinline__ void phase3_pooled(Frame& F) {
    F.lane = lane_now(); F.tid = F.wave * 64 + F.lane;
    const bf16_t* pl = (const bf16_t*)(F.ws + WS_PL); bf16_t* po = (bf16_t*)(F.ws + WS_POOLED);
    const int gw = F.bid * 8 + F.wave, NGW = F.G * 8;
    for (int it = gw; it < (MTOK / 2) * 4; it += NGW) {
        const int g = it & 3, row = (it >> 2) * 2 + (F.lane >> 5), c8 = g * 256 + (F.lane & 31) * 8;
        if (g == 0) pooled_item<2>(pl, po, row, c8); else if (g == 1) pooled_item<4>(pl, po, row, c8); else if (g == 2) pooled_item<8>(pl, po, row, c8); else pooled_item<16>(pl, po, row, c8);
    }
}
typedef float f32x16 __attribute__((ext_vector_type(16)));
__device__ __forceinline__ float wrelu_(float wh, float d, float acc) { return __builtin_fmaf(wh, d, __builtin_fmaf(wh, __builtin_fabsf(d), acc)); }
__device__ __forceinline__ int sel_code(float s, float smin, float scale) { const float c = (s - smin) * scale; return (int)fminf(fmaxf(c, 0.f), 65535.f); }
__device__ __forceinline__ void hist_find(const unsigned* hist, int lane, int K, int& bsel, int& above) {
    const u32x4 h = *(const u32x4*)(hist + lane * 4);
    const int S = (int)(h.x + h.y + h.z + h.w);
    int x = S;
    x += __builtin_amdgcn_update_dpp(0, x, 0x101, 0xF, 0xF, true);
    x += __builtin_amdgcn_update_dpp(0, x, 0x102, 0xF, 0xF, true);
    x += __builtin_amdgcn_update_dpp(0, x, 0x104, 0xF, 0xF, true);
    x += __builtin_amdgcn_update_dpp(0, x, 0x108, 0xF, 0xF, true);
    const int t1 = __builtin_amdgcn_readlane(x, 16), t2 = __builtin_amdgcn_readlane(x, 32), t3 = __builtin_amdgcn_readlane(x, 48);
    const int r = lane >> 4;
    x += (r == 0 ? t1 + t2 + t3 : (r == 1 ? t2 + t3 : (r == 2 ? t3 : 0)));
    const int sufn = x - S;
    const bool mine = (x >= K) && (sufn < K);
    int b = 0, ab = 0;
    { int c = sufn;
      if (c + (int)h.w >= K) { b = 3; ab = c; } else { c += (int)h.w;
      if (c + (int)h.z >= K) { b = 2; ab = c; } else { c += (int)h.z;
      if (c + (int)h.y >= K) { b = 1; ab = c; } else { c += (int)h.y; b = 0; ab = c; } } } }
    const unsigned long long m = __ballot(mine);
    const int src = m ? (int)__builtin_ctzll(m) : 0;
    bsel = __builtin_amdgcn_readlane(lane * 4 + b, src); above = __builtin_amdgcn_readlane(ab, src);
}
__device__ __forceinline__ void indexer_select(Frame& F, int b, int t, const float* rowbuf, unsigned* hist, float* eqv, int* eqi) {
    unsigned short* selrow = (unsigned short*)(F.ws + WS_SEL) + (size_t)(b * SEQ + t) * 256;
    int lane = F.lane; asm volatile("" : "+v"(lane));
    const int nch = t / 64 + 1, n4 = (nch + 3) >> 2;
    const f32x4* rb4 = (const f32x4*)rowbuf;
    float mn = __builtin_huge_valf(), mx = -__builtin_huge_valf();
    for (int c4 = 0; c4 < n4; ++c4) { const f32x4 v = rb4[c4 * 64 + lane];
#pragma unroll
        for (int k = 0; k < 4; ++k) { const bool valid = ((c4 * 4 + k) * 64 + lane) <= t; mn = valid ? fminf(mn, v[k]) : mn; mx = valid ? fmaxf(mx, v[k]) : mx; } }
    mx = xor16_max(row_max16(mx)); { const auto r = __builtin_amdgcn_permlane32_swap(__float_as_uint(mx), __float_as_uint(mx), false, false); mx = fmaxf(__uint_as_float(r[0]), __uint_as_float(r[1])); }
    mn = -mn; mn = xor16_max(row_max16(mn)); { const auto r = __builtin_amdgcn_permlane32_swap(__float_as_uint(mn), __float_as_uint(mn), false, false); mn = -fmaxf(__uint_as_float(r[0]), __uint_as_float(r[1])); }
    const float scale = (mx > mn) ? 65535.0f / (mx - mn) : 0.f;
    *(u32x4*)(hist + lane * 4) = (u32x4){0u, 0u, 0u, 0u};
    for (int c4 = 0; c4 < n4; ++c4) { const f32x4 v = rb4[c4 * 64 + lane];
#pragma unroll
        for (int k = 0; k < 4; ++k) { const bool valid = ((c4 * 4 + k) * 64 + lane) <= t; if (valid) atomicAdd(&hist[sel_code(v[k], mn, scale) >> 8], 1u); } }
    int b1, above1; hist_find(hist, lane, KSEL, b1, above1);
    *(u32x4*)(hist + lane * 4) = (u32x4){0u, 0u, 0u, 0u};
    for (int c4 = 0; c4 < n4; ++c4) { const f32x4 v = rb4[c4 * 64 + lane];
#pragma unroll
        for (int k = 0; k < 4; ++k) { const bool valid = ((c4 * 4 + k) * 64 + lane) <= t; const int code = sel_code(v[k], mn, scale); if (valid && (code >> 8) == b1) atomicAdd(&hist[code & 255], 1u); } }
    int b2, above2; hist_find(hist, lane, KSEL - above1, b2, above2);
    const int T16 = (b1 << 8) | b2, need = KSEL - above1 - above2, ceq = (int)hist[b2];
    const unsigned long long lt_mask = (1ull << lane) - 1ull;
    const bool exact = (ceq != need) && (ceq <= 64);
    if (exact) {
        int pos = 0;
        for (int c = 0; c < nch; ++c) { const float sv = rowbuf[((c >> 2) * 64 + lane) * 4 + (c & 3)]; const int idx = c * 64 + lane;
            const bool eq = (idx <= t) && (sel_code(sv, mn, scale) == T16);
            const unsigned long long m = __ballot(eq);
            if (m) { const int p = pos + __popcll(m & lt_mask); if (eq) { eqv[p] = sv; eqi[p] = idx; } pos += __popcll(m); } }
    }
    int pos = 0, eqseen = 0;
    for (int c = 0; c < nch; ++c) {
        const float sv = rowbuf[((c >> 2) * 64 + lane) * 4 + (c & 3)]; const int idx = c * 64 + lane;
        const int code = sel_code(sv, mn, scale); const bool valid = idx <= t;
        const bool gt = valid && code > T16, eq = valid && code == T16;
        const unsigned long long meq = __ballot(eq);
        bool take = gt;
        if (meq) {
            if (ceq == need) take = take || eq;
            else if (exact) { int rank = 0; for (int m = 0; m < ceq; ++m) { const float ov = eqv[m]; const int oi = eqi[m]; rank += (ov > sv || (ov == sv && oi < idx)) ? 1 : 0; } take = take || (eq && rank < need); }
            else { const int er = eqseen + __popcll(meq & lt_mask); take = take || (eq && er < need); eqseen += __popcll(meq); }
        }
        const unsigned long long mt = __ballot(take);
        const int p = pos + __popcll(mt & lt_mask);
        if (take && p < KSEL) selrow[p] = (unsigned short)idx;
        pos += __popcll(mt);
    }
}
__device__ __forceinline__ void indexer_tile(Frame& F, int b, int t0) {
    const bf16_t* iq = (const bf16_t*)(F.ws + WS_IQ); const bf16_t* ik = (const bf16_t*)(F.ws + WS_IK); const float* iw = (const float*)(F.ws + WS_IW);
    int lane = F.lane; asm volatile("" : "+v"(lane));
    const int w = F.wave;
    if (t0 < KSEL) {
        const int t = t0 + w; unsigned short* selrow = (unsigned short*)(F.ws + WS_SEL) + (size_t)(b * SEQ + t) * 256;
#pragma unroll
        for (int p = 0; p < 4; ++p) { const int j = p * 64 + lane; selrow[j] = (unsigned short)(j <= t ? j : 0xFFFF); }
        return;
    }
    float* rowbuf = (float*)F.lds;
    unsigned char* stage = F.lds + 131072;
    const int p = w & 3, kh = w >> 2, hi = lane >> 5, r = lane & 31;
    const size_t qrow = (size_t)b * SEQ + t0 + 2 * p + (r >> 4);
    bf16x8 a[4];
#pragma unroll
    for (int ks = 0; ks < 4; ++ks) a[ks] = *(const bf16x8*)(iq + qrow * 1024 + (r & 15) * 64 + ks * 16 + 8 * hi);
    float wq[2][8];
#pragma unroll
    for (int q = 0; q < 2; ++q)
#pragma unroll
        for (int i = 0; i < 8; ++i) wq[q][i] = 0.5f * iw[((size_t)b * SEQ + t0 + 2 * p + q) * 16 + (i & 3) + 8 * ((i >> 2) & 1) + 4 * hi];
    const int nchunks = (t0 + 7) / 64 + 1, nsteps = (nchunks + 1) >> 1;
    const unsigned char* gsrc = (const unsigned char*)(ik + (size_t)b * SEQ * 64) + F.tid * 16;
    const int skey = F.tid >> 3, sc16 = F.tid & 7, soff = skey * 128 + ((sc16 ^ ((skey >> 1) & 7)) << 4);
    u32x4 sa0 = *(const u32x4*)gsrc, sb0 = sa0, sa1 = sa0, sb1 = sa0;
    if (1 < nchunks) sb0 = *(const u32x4*)(gsrc + (size_t)1 * 8192);
    if (2 < nchunks) sa1 = *(const u32x4*)(gsrc + (size_t)2 * 8192);
    if (3 < nchunks) sb1 = *(const u32x4*)(gsrc + (size_t)3 * 8192);
    __syncthreads();
#define IDX_STEP2(SA, SB, ss) do { const int s_ = (ss); unsigned char* sb = stage + (s_ & 1) * 16384; \
        *(u32x4*)(sb + soff) = SA; *(u32x4*)(sb + 8192 + soff) = SB; \
        __syncthreads(); \
        if (2 * s_ + 4 < nchunks) SA = *(const u32x4*)(gsrc + (size_t)(2 * s_ + 4) * 8192); \
        if (2 * s_ + 5 < nchunks) SB = *(const u32x4*)(gsrc + (size_t)(2 * s_ + 5) * 8192); \
        f32x16 d0, d1; _Pragma("unroll") for (int i = 0; i < 16; ++i) { d0[i] = 0.f; d1[i] = 0.f; } \
        const int key = kh * 32 + r; \
        _Pragma("unroll") for (int ks = 0; ks < 4; ++ks) { const unsigned char* bp = sb + key * 128 + (((ks * 2 + hi) ^ ((key >> 1) & 7)) << 4); \
            const bf16x8 bf0 = *(const bf16x8*)bp, bf1 = *(const bf16x8*)(bp + 8192); \
            d0 = __builtin_amdgcn_mfma_f32_32x32x16_bf16(a[ks], bf0, d0, 0, 0, 0); d1 = __builtin_amdgcn_mfma_f32_32x32x16_bf16(a[ks], bf1, d1, 0, 0, 0); } \
        float x0_ = 0.f, x1_ = 0.f, y0_ = 0.f, y1_ = 0.f; \
        _Pragma("unroll") for (int i = 0; i < 8; ++i) { x0_ = wrelu_(wq[0][i], d0[i], x0_); x1_ = wrelu_(wq[1][i], d0[8 + i], x1_); y0_ = wrelu_(wq[0][i], d1[i], y0_); y1_ = wrelu_(wq[1][i], d1[8 + i], y1_); } \
        const float scx = swap32_pair(x0_, x1_), scy = swap32_pair(y0_, y1_); \
        *(f32x2*)(rowbuf + (2 * p + hi) * 4096 + ((s_ >> 1) * 64 + key) * 4 + 2 * (s_ & 1)) = (f32x2){scx, scy}; } while (0)
    for (int s2 = 0; s2 < nsteps; s2 += 2) {
        IDX_STEP2(sa0, sb0, s2);
        if (s2 + 1 < nsteps) IDX_STEP2(sa1, sb1, s2 + 1);
    }
#undef IDX_STEP2
    __syncthreads();
    indexer_select(F, b, t0 + w, rowbuf + w * 4096, (unsigned*)(F.lds + 147456) + w * 256, (float*)(F.lds + 155648) + w * 64, (int*)(F.lds + 155648 + 2048) + w * 64);
#if PROBE_IDX == 2
    indexer_select(F, b, t0 + w, rowbuf + w * 4096, (unsigned*)(F.lds + 147456) + w * 256, (float*)(F.lds + 155648) + w * 64, (int*)(F.lds + 155648 + 2048) + w * 64);
#endif
}
__device__ __forceinline__ void phase3_indexer(Frame& F) {
    F.lane = lane_now(); F.tid = F.wave * 64 + F.lane;
    volatile LAS unsigned* misc = (volatile LAS unsigned*)((LAS unsigned char*)F.lds + MISC_OFF);
    const unsigned keep0 = misc[0], keep1 = misc[1];
    __syncthreads();
    const int nit = BATCH * (SEQ / 8);
    for (int k = 0;; ++k) {
        const int l = k * F.G + ((k & 1) ? (F.G - 1 - F.bid) : F.bid);
        if (l >= nit) { if (k * F.G >= nit) break; else continue; }
        const int qb = (SEQ / 8 - 1) - (l >> 3), b = l & 7;
        indexer_tile(F, b, qb * 8);
    }
    __syncthreads();
    if (F.tid == 0) { misc[0] = keep0; misc[1] = keep1; }
}

__device__ const unsigned char g_bucket[128] = {0, 1, 2, 3, 4, 5, 6, 7, 8, 9, 10, 11, 12, 13, 14, 15, 16, 16, 16, 17, 17, 18, 18, 18, 19, 19, 19, 20, 20, 20, 20, 21, 21, 21, 21, 22, 22, 22, 22, 22, 23, 23, 23, 23, 23, 23, 24, 24, 24, 24, 24, 24, 25, 25, 25, 25, 25, 25, 25, 26, 26, 26, 26, 26, 26, 26, 26, 27, 27, 27, 27, 27, 27, 27, 27, 27, 27, 28, 28, 28, 28, 28, 28, 28, 28, 28, 28, 29, 29, 29, 29, 29, 29, 29, 29, 29, 29, 29, 29, 30, 30, 30, 30, 30, 30, 30, 30, 30, 30, 30, 30, 30, 30, 31, 31, 31, 31, 31, 31, 31, 31, 31, 31, 31, 31, 31, 31, 31};
__device__ __forceinline__ void phase4_attention(Frame& F) {
    F.lane = lane_now(); F.tid = F.wave * 64 + F.lane;
    const unsigned char* q8 = F.ws + WS_Q8; const unsigned char* k8 = F.ws + WS_K8; const unsigned char* v8 = F.ws + WS_V8;
    const unsigned short* sel = (const unsigned short*)(F.ws + WS_SEL); bf16_t* ao = (bf16_t*)(F.ws + WS_ATTN);
    float* btab = (float*)F.lds;
    __syncthreads();
    for (int i = F.tid; i < 256; i += 512) btab[i] = F.rel_bias[i];
    __syncthreads();
    float* Pl = (float*)(F.lds + 4096 + F.wave * 12288); int* idl = (int*)(Pl + 2048); float* psl = (float*)(idl + 256);
    const bool xmap = (F.G % 8) == 0;
    const int gw = xmap ? (F.bid / 8) * 8 + F.wave : F.bid * 8 + F.wave, NGW = xmap ? F.G : F.G * 8, nrows = xmap ? SEQ : MTOK;
    for (int rr = gw; rr < nrows; rr += NGW) {
        int lane = F.lane; asm volatile("" : "+v"(lane));
        const int row = xmap ? (F.bid & 7) * SEQ + rr : rr;
        const int b = row / SEQ, t = row % SEQ, r = lane & 31, hi = lane >> 5;
#pragma unroll
        for (int p = 0; p < 4; ++p) { idl[p * 64 + lane] = (int)sel[(size_t)row * 256 + p * 64 + lane]; }
        long a0[8], a1[8];
        { u32x4 qa[4];
#pragma unroll
          for (int i = 0; i < 4; ++i) qa[i] = (r < 8) ? *(const u32x4*)(q8 + (size_t)row * 1024 + r * 128 + hi * 64 + i * 16) : (u32x4){0u, 0u, 0u, 0u};
#pragma unroll
          for (int ks = 0; ks < 8; ++ks) { const unsigned lo = qa[ks >> 1][(ks & 1) * 2], hh = qa[ks >> 1][(ks & 1) * 2 + 1]; const long v = (long)(((unsigned long long)hh << 32) | lo);
              a0[ks] = (r < 4) ? v : 0l; a1[ks] = (r >= 4) ? v : 0l; } }
        f32x4 psum = (f32x4){0.f, 0.f, 0.f, 0.f};
#define AT_LOADK(buf, kb) do { const int key_ = idl[(kb) * 32 + r]; const int kc_ = key_ <= t ? key_ : 0; const unsigned char* kr_ = k8 + ((size_t)b * SEQ + kc_) * 256 + hi * 64; \
            _Pragma("unroll") for (int i = 0; i < 4; ++i) { buf[i] = *(const u32x4*)(kr_ + i * 16); buf[4 + i] = *(const u32x4*)(kr_ + 128 + i * 16); } } while (0)
#define AT_QK(buf, kb) do { const int key_ = idl[(kb) * 32 + r]; const bool valid_ = key_ <= t; const int kc_ = valid_ ? key_ : 0; \
            f32x16 d; _Pragma("unroll") for (int i = 0; i < 16; ++i) d[i] = 0.f; \
            _Pragma("unroll") for (int ks = 0; ks < 8; ++ks) { const long bv_ = (long)(((unsigned long long)buf[ks >> 1][(ks & 1) * 2 + 1] << 32) | buf[ks >> 1][(ks & 1) * 2]); d = __builtin_amdgcn_mfma_f32_32x32x16_fp8_fp8(a0[ks], bv_, d, 0, 0, 0); } \
            _Pragma("unroll") for (int ks = 0; ks < 8; ++ks) { const long bv_ = (long)(((unsigned long long)buf[4 + (ks >> 1)][(ks & 1) * 2 + 1] << 32) | buf[4 + (ks >> 1)][(ks & 1) * 2]); d = __builtin_amdgcn_mfma_f32_32x32x16_fp8_fp8(a1[ks], bv_, d, 0, 0, 0); } \
            const int dist_ = t - kc_; const int bkt_ = dist_ < 128 ? (int)g_bucket[dist_] : 31; \
            const f32x4 bias_ = *(const f32x4*)(btab + bkt_ * 8 + 4 * hi); f32x4 e_; \
            _Pragma("unroll") for (int i = 0; i < 4; ++i) e_[i] = valid_ ? __expf(d[i] * 0.08838834764831845f + bias_[i]) : 0.f; \
            psum += e_; *(f32x4*)(Pl + ((kb) * 32 + r) * 8 + 4 * hi) = e_; } while (0)
        {
            u32x4 kA[8], kB[8];
            AT_LOADK(kA, 0);
#pragma unroll 1
            for (int kb = 0; kb < 8; kb += 2) {
                AT_LOADK(kB, kb + 1);
                AT_QK(kA, kb);
                if (kb + 2 < 8) AT_LOADK(kA, kb + 2);
                AT_QK(kB, kb + 1);
            }
        }
#undef AT_LOADK
#undef AT_QK
#pragma unroll
        for (int i = 0; i < 4; ++i) psum[i] = xor16_sum(row_sum16(psum[i]));
        if (r == 0) *(f32x4*)(psl + 4 * hi) = psum;
        const int ks = lane >> 4, g = (lane >> 3) & 1, dc = lane & 7;
        float acc[4][16];
#pragma unroll
        for (int h = 0; h < 4; ++h)
#pragma unroll
            for (int j = 0; j < 16; ++j) acc[h][j] = 0.f;
#define AT_LOADV(buf, it0) do { _Pragma("unroll") for (int u = 0; u < 4; ++u) { const int key_ = idl[((it0) + u) * 4 + ks]; const int kc_ = key_ <= t ? key_ : 0; \
            buf[u] = *(const u32x4*)(v8 + ((size_t)b * SEQ + kc_) * 256 + g * 128 + dc * 16); } } while (0)
#define AT_PV(buf, it0) do { _Pragma("unroll") for (int u = 0; u < 4; ++u) { const int j_ = ((it0) + u) * 4 + ks; const u32x4 w = buf[u]; \
            const f32x4 p = *(const f32x4*)(Pl + j_ * 8 + 4 * g); \
            _Pragma("unroll") for (int dd = 0; dd < 4; ++dd) { const f32x2 lo = __builtin_amdgcn_cvt_pk_f32_fp8((int)w[dd], false), hh_ = __builtin_amdgcn_cvt_pk_f32_fp8((int)w[dd], true); \
                _Pragma("unroll") for (int h = 0; h < 4; ++h) { acc[h][4 * dd] += p[h] * lo.x; acc[h][4 * dd + 1] += p[h] * lo.y; acc[h][4 * dd + 2] += p[h] * hh_.x; acc[h][4 * dd + 3] += p[h] * hh_.y; } } } } while (0)
        {
            u32x4 vA[4], vB[4];
            AT_LOADV(vA, 0);
#pragma unroll 1
            for (int it0 = 0; it0 < 64; it0 += 8) {
                AT_LOADV(vB, it0 + 4);
                AT_PV(vA, it0);
                if (it0 + 8 < 64) AT_LOADV(vA, it0 + 8);
                AT_PV(vB, it0 + 4);
            }
        }
#undef AT_LOADV
#undef AT_PV
#pragma unroll
        for (int h = 0; h < 4; ++h)
#pragma unroll
            for (int j = 0; j < 16; ++j) acc[h][j] = xor32_sum(xor16_sum(acc[h][j]));
#pragma unroll
        for (int h = 0; h < 4; ++h) if (h == ks) { const float inv = 1.0f / psl[4 * g + h];
            bf16_t* op = ao + (size_t)row * 1024 + (4 * g + h) * 128 + dc * 16;
            *(u32x4*)op = pack8((f32x4){acc[h][0], acc[h][1], acc[h][2], acc[h][3]} * inv, (f32x4){acc[h][4], acc[h][5], acc[h][6], acc[h][7]} * inv);
            *(u32x4*)(op + 8) = pack8((f32x4){acc[h][8], acc[h][9], acc[h][10], acc[h][11]} * inv, (f32x4){acc[h][12], acc[h][13], acc[h][14], acc[h][15]} * inv); }
    }
}

__device__ __forceinline__ float dot16f8(u32x4 w, const float* h) {
    float s = 0.f;
#pragma unroll
    for (int d = 0; d < 4; ++d) { const f32x2 lo = __builtin_amdgcn_cvt_pk_f32_fp8((int)w[d], false), hi = __builtin_amdgcn_cvt_pk_f32_fp8((int)w[d], true);
        s += lo.x * h[4 * d] + lo.y * h[4 * d + 1] + hi.x * h[4 * d + 2] + hi.y * h[4 * d + 3]; }
    return s;
}
__device__ __forceinline__ void fma16f8(u32x4 w, float cf, float* acc) {
#pragma unroll
    for (int d = 0; d < 4; ++d) { const f32x2 lo = __builtin_amdgcn_cvt_pk_f32_fp8((int)w[d], false), hi = __builtin_amdgcn_cvt_pk_f32_fp8((int)w[d], true);
        acc[4 * d] += cf * lo.x; acc[4 * d + 1] += cf * lo.y; acc[4 * d + 2] += cf * hi.x; acc[4 * d + 3] += cf * hi.y; }
}
__device__ __forceinline__ float gelu_erf(float x) { return 0.5f * x * (1.0f + erff(x * 0.70710678118654752f)); }
__device__ __forceinline__ void ce_k(unsigned& a, unsigned& b) { const unsigned hi = a > b ? a : b, lo = a > b ? b : a; a = hi; b = lo; }
__device__ __forceinline__ void ce_kp(unsigned& ka, unsigned& pa, unsigned& kb, unsigned& pb) { const bool sw = kb > ka; const unsigned k0 = sw ? kb : ka, k1 = sw ? ka : kb, p0 = sw ? pb : pa, p1 = sw ? pa : pb; ka = k0; kb = k1; pa = p0; pb = p1; }
__device__ __forceinline__ void bmerge16(unsigned (&x)[16]) {
#pragma unroll
    for (int jj = 0; jj < 4; ++jj) { const int j = 8 >> jj;
#pragma unroll
        for (int i = 0; i < 16; ++i) { const int l = i ^ j; if (l > i) ce_k(x[i], x[l]); }
        __builtin_amdgcn_sched_barrier(0); }
}
__device__ __forceinline__ void bmerge16p(unsigned (&x)[16], unsigned (&p)[16]) {
#pragma unroll
    for (int jj = 0; jj < 4; ++jj) { const int j = 8 >> jj;
#pragma unroll
        for (int i = 0; i < 16; ++i) { const int l = i ^ j; if (l > i) ce_kp(x[i], p[i], x[l], p[l]); }
        __builtin_amdgcn_sched_barrier(0); }
}
__device__ __forceinline__ void bsort16(unsigned (&x)[16]) {
#pragma unroll
    for (int kk = 1; kk <= 4; ++kk) { const int k = 1 << kk;
#pragma unroll
        for (int jj = 0; jj < 4; ++jj) { const int j = (k >> 1) >> jj;
            if (j > 0) {
#pragma unroll
                for (int i = 0; i < 16; ++i) { const int l = i ^ j; if (l > i) { if ((i & k) == 0) ce_k(x[i], x[l]); else ce_k(x[l], x[i]); } }
                __builtin_amdgcn_sched_barrier(0); } } }
}
__device__ __forceinline__ void bsort16p(unsigned (&x)[16], unsigned (&p)[16]) {
#pragma unroll
    for (int kk = 1; kk <= 4; ++kk) { const int k = 1 << kk;
#pragma unroll
        for (int jj = 0; jj < 4; ++jj) { const int j = (k >> 1) >> jj;
            if (j > 0) {
#pragma unroll
                for (int i = 0; i < 16; ++i) { const int l = i ^ j; if (l > i) { if ((i & k) == 0) ce_kp(x[i], p[i], x[l], p[l]); else ce_kp(x[l], p[l], x[i], p[i]); } }
                __builtin_amdgcn_sched_barrier(0); } } }
}
__device__ __forceinline__ void top16_row(const unsigned char* rowp, unsigned (&t)[16]) {
#pragma unroll
    for (int i = 0; i < 16; ++i) t[i] = 0u;
#pragma unroll 1
    for (int g = 0; g < 8; ++g) {
        unsigned w[8];
#pragma unroll
        for (int q = 0; q < 4; ++q) { const u32x2 v = *(const u32x2*)(rowp + g * 32 + q * 8); w[2 * q] = v.x; w[2 * q + 1] = v.y; }
        unsigned sk[16];
#pragma unroll
        for (int d = 0; d < 8; ++d) {
            const unsigned lo = w[d] << 16, hi = w[d];
            const unsigned xl = lo ^ ((unsigned)((int)lo >> 31) | 0x80000000u), xh = hi ^ ((unsigned)((int)hi >> 31) | 0x80000000u);
            sk[2 * d] = ((xl >> 9) & 0xFFFFFF80u) | (unsigned)(127 - (g * 16 + 2 * d));
            sk[2 * d + 1] = ((xh >> 9) & 0xFFFFFF80u) | (unsigned)(127 - (g * 16 + 2 * d + 1)); }
        bsort16(sk);
#pragma unroll
        for (int i = 0; i < 16; ++i) t[i] = t[i] > sk[15 - i] ? t[i] : sk[15 - i];
        bmerge16(t);
    }
}
__device__ __forceinline__ float key_val(unsigned key) { const unsigned y = (key << 9) & 0xFFFF0000u; return __uint_as_float((y ^ (~(unsigned)((int)y >> 31) | 0x80000000u)) & 0xFFFF0000u); }
__device__ __forceinline__ unsigned sum_key(float s, int c) { const unsigned u = __float_as_uint(s); return ((u ^ ((unsigned)((int)u >> 31) | 0x80000000u)) & ~63u) | (unsigned)(63 - c); }
__device__ __forceinline__ float sum_val(unsigned k) { const unsigned y = k & ~63u; return __uint_as_float(y ^ (~(unsigned)((int)y >> 31) | 0x80000000u)); }
typedef __bf16 bf2_t __attribute__((ext_vector_type(2)));
__device__ __forceinline__ float dot2_bf(unsigned a, unsigned b, float c) { return __builtin_amdgcn_fdot2_f32_bf16(__builtin_bit_cast(bf2_t, a), __builtin_bit_cast(bf2_t, b), c, false); }
__device__ __forceinline__ float dot32_f6b(u32x4 wa, u32x2 wb, u32x4 h0, u32x4 h1, u32x4 h2, u32x4 h3) {
    const bf16x32 dec = __builtin_amdgcn_cvt_scalef32_pk32_bf16_fp6((u32x6){wa.x, wa.y, wa.z, wa.w, wb.x, wb.y}, 1.0f);
    const u32x16 ud = __builtin_bit_cast(u32x16, dec);
    float acc = 0.f;
    acc = dot2_bf(ud.s0, h0.x, acc); acc = dot2_bf(ud.s1, h0.y, acc); acc = dot2_bf(ud.s2, h0.z, acc); acc = dot2_bf(ud.s3, h0.w, acc);
    acc = dot2_bf(ud.s4, h1.x, acc); acc = dot2_bf(ud.s5, h1.y, acc); acc = dot2_bf(ud.s6, h1.z, acc); acc = dot2_bf(ud.s7, h1.w, acc);
    acc = dot2_bf(ud.s8, h2.x, acc); acc = dot2_bf(ud.s9, h2.y, acc); acc = dot2_bf(ud.sa, h2.z, acc); acc = dot2_bf(ud.sb, h2.w, acc);
    acc = dot2_bf(ud.sc, h3.x, acc); acc = dot2_bf(ud.sd, h3.y, acc); acc = dot2_bf(ud.se, h3.z, acc); acc = dot2_bf(ud.sf, h3.w, acc);
    return acc;
}
__device__ const unsigned char g_cab[64] = {0, 1, 2, 3, 4, 5, 6, 7, 8, 9, 10, 11, 12, 13, 14, 15, 16, 17, 18, 19, 20, 21, 22, 23, 32, 33, 34, 35, 36, 48, 49, 50, 51, 64, 65, 66, 80, 81, 96, 97, 112, 113, 128, 144, 160, 176, 192, 208, 224, 240, 0, 0, 0, 0, 0, 0, 0, 0, 0, 0, 0, 0, 0, 0};
__device__ __forceinline__ void phase10_peer(Frame& F) {
    F.lane = lane_now(); F.tid = F.wave * 64 + F.lane;
    const bf16_t* sub = (const bf16_t*)(F.ws + WS_SUB); const bf16_t* h2 = (const bf16_t*)(F.ws + WS_H2);
    const unsigned char* pu = F.ws + WS_PU; unsigned* pairs = (unsigned*)(F.ws + WS_PAIRS);
    const int gw = F.bid * 8 + F.wave, NGW = F.G * 8;
    unsigned char* wb = F.lds + F.wave * 19200;
    unsigned char* h2b = wb; unsigned short* gl16 = (unsigned short*)(wb + 16896); unsigned* hist = (unsigned*)(wb + 18944); unsigned* base = hist + 32;
    unsigned* tmp = (unsigned*)wb;
    unsigned* wls0 = (unsigned*)(F.ws + WS_WLS) + (size_t)gw * 1024;
    const int ntok = (MTOK - gw + NGW - 1) / NGW;
    constexpr int CA[50] = {0,0,0,0,0,0,0,0,0,0,0,0,0,0,0,0, 1,1,1,1,1,1,1,1, 2,2,2,2,2, 3,3,3,3, 4,4,4, 5,5, 6,6, 7,7, 8,9,10,11,12,13,14,15};
    constexpr int CB[50] = {0,1,2,3,4,5,6,7,8,9,10,11,12,13,14,15, 0,1,2,3,4,5,6,7, 0,1,2,3,4, 0,1,2,3, 0,1,2, 0,1, 0,1, 0,1, 0,0,0,0,0,0,0,0};
    for (int p0 = 0; p0 < ntok; p0 += 8) {
        int lane = F.lane; asm volatile("" : "+v"(lane));
        const int nt = (ntok - p0) < 8 ? (ntok - p0) : 8;
        {
            u32x4 st[16];
#define SEL_LOAD(half) do { asm volatile("" : "+v"(lane)); const int srow_l = lane >> 4, scol = lane & 15; _Pragma("unroll") for (int it = 0; it < 16; ++it) { const int r_ = it * 4 + srow_l; int ti_ = r_ >> 3; ti_ = ti_ < nt ? ti_ : nt - 1; \
                st[it] = *(const u32x4*)(sub + (size_t)(gw + (p0 + ti_) * NGW) * 2048 + (r_ & 7) * 256 + (half) * 128 + scol * 8); } } while (0)
#define SEL_STORE() do { const int srow_l = lane >> 4, scol = lane & 15; _Pragma("unroll") for (int it = 0; it < 16; ++it) { unsigned char* d_ = wb + (it * 4 + srow_l) * 264 + scol * 16; \
                *(u32x2*)d_ = (u32x2){st[it].x, st[it].y}; *(u32x2*)(d_ + 8) = (u32x2){st[it].z, st[it].w}; } } while (0)
            unsigned tA[16], tB[16];
            SEL_LOAD(0); SEL_STORE();
            __builtin_amdgcn_sched_barrier(0);
            top16_row(wb + lane * 264, tA);
            __builtin_amdgcn_sched_barrier(0);
            asm volatile("" : "+v"(tA[0]), "+v"(tA[1]), "+v"(tA[2]), "+v"(tA[3]), "+v"(tA[4]), "+v"(tA[5]), "+v"(tA[6]), "+v"(tA[7]), "+v"(tA[8]), "+v"(tA[9]), "+v"(tA[10]), "+v"(tA[11]), "+v"(tA[12]), "+v"(tA[13]), "+v"(tA[14]), "+v"(tA[15]) :: "memory");
            SEL_LOAD(1); SEL_STORE();
            __builtin_amdgcn_sched_barrier(0);
            top16_row(wb + lane * 264, tB);
            __builtin_amdgcn_sched_barrier(0);
#undef SEL_LOAD
#undef SEL_STORE
            float vA[16], vB[16];
            { unsigned pa[4] = {0u, 0u, 0u, 0u}, pb[4] = {0u, 0u, 0u, 0u};
#pragma unroll
              for (int i = 0; i < 16; ++i) { vA[i] = key_val(tA[i]); vB[i] = key_val(tB[i]); pa[i >> 2] |= (127u - (tA[i] & 127u)) << (8 * (i & 3)); pb[i >> 2] |= (127u - (tB[i] & 127u)) << (8 * (i & 3)); }
              unsigned char* rp = wb + lane * 264;
              *(u32x2*)rp = (u32x2){pa[0], pa[1]}; *(u32x2*)(rp + 8) = (u32x2){pa[2], pa[3]}; *(u32x2*)(rp + 16) = (u32x2){pb[0], pb[1]}; *(u32x2*)(rp + 24) = (u32x2){pb[2], pb[3]}; }
            unsigned tk[16];
#pragma unroll
            for (int c = 0; c < 16; ++c) tk[c] = sum_key(vA[CA[c]] + vB[CB[c]], c);
            bsort16(tk);
#pragma unroll
            for (int grp = 1; grp < 3; ++grp) {
                unsigned sk[16];
#pragma unroll
                for (int e = 0; e < 16; ++e) { const int c = grp * 16 + e; sk[e] = sum_key(vA[CA[c]] + vB[CB[c]], c); }
                bsort16(sk);
#pragma unroll
                for (int i = 0; i < 16; ++i) tk[i] = tk[i] > sk[15 - i] ? tk[i] : sk[15 - i];
                bmerge16(tk);
            }
#pragma unroll
            for (int c = 48; c < 50; ++c) { unsigned k = sum_key(vA[CA[c]] + vB[CB[c]], c);
#pragma unroll
                for (int i = 0; i < 16; ++i) ce_k(tk[i], k); }
            const float s0 = sum_val(tk[0]); float ev[16], esum = 0.f;
#pragma unroll
            for (int r = 0; r < 16; ++r) { ev[r] = __expf(sum_val(tk[r]) - s0); esum += ev[r]; }
            const float einv = 1.0f / esum;
            unsigned eid[16];
            { const unsigned char* rp = wb + lane * 264;
#pragma unroll
              for (int r = 0; r < 16; ++r) { const unsigned cab = g_cab[63u - (tk[r] & 63u)]; eid[r] = (unsigned)rp[cab >> 4] * 128u + (unsigned)rp[16 + (cab & 15u)]; } }
            if ((lane >> 3) < nt) {
#pragma unroll
                for (int r = 0; r < 16; ++r) { const int e = lane * 16 + r; tmp[e] = ((unsigned)e << 14) | eid[r]; gl16[e] = (unsigned short)(cvt_pk_bf16(ev[r] * einv, 0.f) & 0xffffu); } }
        }
        asm volatile("" : "+v"(lane));
#pragma unroll 1
        for (int grp = 0; grp < 2; ++grp) {
            const int ng = nt - grp * 4; const int ne = (ng <= 0 ? 0 : (ng < 4 ? ng : 4)) * 128;
            if (ne == 0) break;
            unsigned* wls = wls0 + grp * 512;
            if (lane < 32) hist[lane] = 0u;
            unsigned ent[8]; unsigned rk[8];
#pragma unroll
            for (int q = 0; q < 8; ++q) { const int e = q * 64 + lane; ent[q] = (e < ne) ? tmp[grp * 512 + e] : 0u; rk[q] = (e < ne) ? atomicAdd(&hist[(ent[q] & 0x3FFFu) >> 9], 1u) : 0u; }
            { int hv = lane < 32 ? (int)hist[lane] : 0; int x = hv;
              x += __builtin_amdgcn_update_dpp(0, x, 0x111, 0xF, 0xF, true); x += __builtin_amdgcn_update_dpp(0, x, 0x112, 0xF, 0xF, true);
              x += __builtin_amdgcn_update_dpp(0, x, 0x114, 0xF, 0xF, true); x += __builtin_amdgcn_update_dpp(0, x, 0x118, 0xF, 0xF, true);
              const int t0 = __builtin_amdgcn_readlane(x, 15); if (lane >= 16) x += t0;
              if (lane < 32) base[lane] = (unsigned)(x - hv); }
#pragma unroll
            for (int q = 0; q < 8; ++q) { const int e = q * 64 + lane; if (e < ne) wls[base[(ent[q] & 0x3FFFu) >> 9] + rk[q]] = ent[q]; }
        }
        asm volatile("s_waitcnt vmcnt(0)" ::: "memory");
#pragma unroll 1
        for (int grp = 0; grp < 2; ++grp) {
            const int ng = nt - grp * 4; const int ngc = ng <= 0 ? 0 : (ng < 4 ? ng : 4), ne = ngc * 128;
            if (ne == 0) break;
            const unsigned* wls = wls0 + grp * 512;
            asm volatile("" : "+v"(lane));
#pragma unroll 1
            for (int i = 0; i < ngc; ++i) { const bf16_t* hr = h2 + (size_t)(gw + (p0 + grp * 4 + i) * NGW) * 2048 + lane * 32;
#pragma unroll
                for (int q = 0; q < 4; ++q) *(u32x4*)(h2b + i * 4096 + q * 1024 + lane * 16) = *(const u32x4*)(hr + q * 8); }
            unsigned entn = __hip_atomic_load(wls + lane, __ATOMIC_RELAXED, __HIP_MEMORY_SCOPE_AGENT);
#pragma unroll 1
            for (int c = 0; c < ne; c += 64) {
                const unsigned ent64 = entn;
                if (c + 64 < ne) entn = __hip_atomic_load(wls + c + 64 + lane, __ATOMIC_RELAXED, __HIP_MEMORY_SCOPE_AGENT);
#pragma unroll 1
                for (int i0 = 0; i0 < 64; i0 += 8) {
                    u32x4 wA[8]; u32x2 wB[8]; unsigned en[8];
#pragma unroll
                    for (int jj = 0; jj < 8; ++jj) { en[jj] = (unsigned)__builtin_amdgcn_readlane((int)ent64, i0 + jj); const unsigned char* ur = pu + (size_t)(en[jj] & 0x3FFFu) * 1536 + lane * 24;
                        const u32x2 t0 = *(const u32x2*)ur, t1 = *(const u32x2*)(ur + 8); wA[jj] = (u32x4){t0.x, t0.y, t1.x, t1.y}; wB[jj] = *(const u32x2*)(ur + 16); }
                    float pr[8];
#pragma unroll
                    for (int jj = 0; jj < 8; ++jj) { const unsigned char* hp = h2b + ((en[jj] >> 21) & 3u) * 4096 + lane * 16;
                        pr[jj] = dot32_f6b(wA[jj], wB[jj], *(const u32x4*)hp, *(const u32x4*)(hp + 1024), *(const u32x4*)(hp + 2048), *(const u32x4*)(hp + 3072)); __builtin_amdgcn_sched_barrier(0); }
#pragma unroll
                    for (int i = 0; i < 4; ++i) pr[i] = swap32_pair(pr[i], pr[i + 4]);
#pragma unroll
                    for (int i = 0; i < 2; ++i) pr[i] = swap16_pair(pr[i], pr[i + 2]);
                    const bool b3 = (lane & 8) != 0;
                    { const float snd = b3 ? pr[0] : pr[1], kp = b3 ? pr[1] : pr[0]; pr[0] = kp + dpp_f<DPP_ROR8>(snd); }
                    float tot = pr[0]; tot += dpp_f<DPP_XOR1>(tot); tot += dpp_f<DPP_XOR2>(tot); tot += dpp_f<DPP_HMIRROR>(tot);
                    const unsigned em = (unsigned)__shfl((int)ent64, i0 + (lane >> 3));
                    if ((lane & 7) == 0) {
                        const int ti = (int)(em >> 21), j = (int)((em >> 14) & 127u), row = gw + (p0 + ti) * NGW;
                        const float cf = gelu_erf(tot * (1.0f / 96.0f)) * __uint_as_float((unsigned)gl16[(em >> 14) & 1023u] << 16);
                        pairs[((size_t)(row >> 6) * 128 + j) * 64 + (row & 63)] = ((unsigned)__builtin_bit_cast(unsigned short, (_Float16)cf) << 16) | (em & 0x3FFFu);
                    }
                }
            }
        }
    }
}

__device__ __forceinline__ void phase11_peer_v(Frame& F, float* dst) {
    F.lane = lane_now(); F.tid = F.wave * 64 + F.lane;
    const unsigned* pairs = (const unsigned*)(F.ws + WS_PAIRS); const float* mf = (const float*)(F.ws + WS_MODF);
    unsigned long long* vs = (unsigned long long*)F.lds;
    for (int c = F.bid; c < DM / 8; c += F.G) {
        __syncthreads();
        { const u32x4* src = (const u32x4*)(F.ws + WS_PV + (size_t)c * NEXP * 8); u32x4* dst = (u32x4*)F.lds;
#pragma unroll 4
          for (int i = F.tid; i < NEXP * 8 / 16; i += 512) dst[i] = src[i]; }
        __syncthreads();
        for (int tile = F.wave; tile < MTOK / 64; tile += 8) {
            int lane = F.lane; asm volatile("" : "+v"(lane));
            const unsigned* pp = pairs + (size_t)tile * 128 * 64 + lane;
            const int row = tile * 64 + lane;
            const float* gt2 = mf + (size_t)(tile / (SEQ / 64)) * 12288 + 10240 + c * 8;
            const float* ip = F.out + (size_t)row * 2048 + c * 8; float* op = dst + (size_t)row * 2048 + c * 8;
            const f32x4 x0 = *(const f32x4*)ip, x1 = *(const f32x4*)(ip + 4), g0 = *(const f32x4*)gt2 * 0.25f, g1 = *(const f32x4*)(gt2 + 4) * 0.25f;
            typedef __fp16 h2_t __attribute__((__vector_size__(2 * sizeof(__fp16))));
            h2_t acc[4];
#pragma unroll
            for (int i = 0; i < 4; ++i) acc[i] = (h2_t){(__fp16)0.f, (__fp16)0.f};
#define P11_LOAD(dst, j0) do { _Pragma("unroll") for (int jj = 0; jj < 16; ++jj) dst[jj] = pp[((j0) + jj) * 64]; } while (0)
#define P11_COMP(src) do { _Pragma("unroll") for (int jj = 0; jj < 16; ++jj) { const unsigned long long v = vs[src[jj] & 0x3FFFu]; \
                    const h2_t cf = __builtin_bit_cast(h2_t, __builtin_amdgcn_perm(src[jj], src[jj], 0x03020302u)); \
                    const int lo = (int)(unsigned)v, hi = (int)(unsigned)(v >> 32); \
                    acc[0] = __builtin_elementwise_fma(__builtin_amdgcn_cvt_scalef32_pk_f16_fp8(lo, 1.0f, false), cf, acc[0]); acc[1] = __builtin_elementwise_fma(__builtin_amdgcn_cvt_scalef32_pk_f16_fp8(lo, 1.0f, true), cf, acc[1]); \
                    acc[2] = __builtin_elementwise_fma(__builtin_amdgcn_cvt_scalef32_pk_f16_fp8(hi, 1.0f, false), cf, acc[2]); acc[3] = __builtin_elementwise_fma(__builtin_amdgcn_cvt_scalef32_pk_f16_fp8(hi, 1.0f, true), cf, acc[3]); } } while (0)
            unsigned pa[16], pb[16];
            P11_LOAD(pa, 0);
#pragma unroll 1
            for (int j0 = 0; j0 < 128; j0 += 32) {
                P11_LOAD(pb, j0 + 16);
                P11_COMP(pa);
                if (j0 + 32 < 128) P11_LOAD(pa, j0 + 32);
                P11_COMP(pb);
            }
#if PROBE_P11X == 1
            { h2_t sv[4]; for (int i = 0; i < 4; ++i) sv[i] = acc[i];
#pragma unroll 1
              for (int j0 = 0; j0 < 128; j0 += 32) {
#pragma unroll
                for (int jj = 0; jj < 16; ++jj) { asm volatile("" : "+v"(pa[jj])); asm volatile("" : "+v"(pb[jj])); }
                P11_COMP(pa); P11_COMP(pb); }
              asm volatile("" :: "v"(acc[0]), "v"(acc[1]), "v"(acc[2]), "v"(acc[3])); for (int i = 0; i < 4; ++i) acc[i] = sv[i]; }
#elif PROBE_P11X == 2
            { P11_LOAD(pa, 0);
#pragma unroll 1
              for (int j0 = 0; j0 < 128; j0 += 32) {
                P11_LOAD(pb, j0 + 16);
#pragma unroll
                for (int jj = 0; jj < 16; ++jj) asm volatile("" :: "v"(pa[jj]));
                if (j0 + 32 < 128) P11_LOAD(pa, j0 + 32);
#pragma unroll
                for (int jj = 0; jj < 16; ++jj) asm volatile("" :: "v"(pb[jj]));
              } }
#endif
#undef P11_LOAD
#undef P11_COMP
            *(f32x4*)op = x0 + g0 * (f32x4){(float)acc[0][0], (float)acc[0][1], (float)acc[1][0], (float)acc[1][1]};
            *(f32x4*)(op + 4) = x1 + g1 * (f32x4){(float)acc[2][0], (float)acc[2][1], (float)acc[3][0], (float)acc[3][1]};
        }
    }
}

__global__ void __launch_bounds__(512, 2) fwd_kernel(Args args) {
    extern __shared__ __attribute__((aligned(16))) unsigned char lds[];
    Frame F;
    F.lds = lds; F.ws = args.ws; F.tid = threadIdx.x; F.lane = F.tid & 63; F.wave = __builtin_amdgcn_readfirstlane(F.tid >> 6); F.G = gridDim.x; F.bid = blockIdx.x;
    F.x = args.in[0]; F.c = args.in[1]; F.w_ada = args.in[2]; F.b_ada = args.in[3]; F.g1 = args.in[4]; F.g2 = args.in[5]; F.w_in = args.in[6]; F.g_q = args.in[7]; F.g_k = args.in[8];
    F.rel_bias = args.in[9]; F.pool_w = args.in[10]; F.pool_scale = args.in[11]; F.w_ab = args.in[12]; F.w_pb = args.in[13]; F.w_out = args.in[14]; F.w_pq = args.in[15];
    F.peer_keys = args.in[16]; F.peer_u = args.in[17]; F.peer_v = args.in[18]; F.out = args.out;
    LAS unsigned char* ldsl = (LAS unsigned char*)lds;
    volatile LAS unsigned* misc = (volatile LAS unsigned*)(ldsl + MISC_OFF);
    if (F.tid < 4) misc[F.tid] = 0u;
    __syncthreads();
    unsigned* barw = (unsigned*)(args.ws + WS_CTL) + (size_t)args.li * XCD_BAR_WORDS;
    XcdBarrier bar; bar.bar = barw; bar.x = 0; bar.st = misc;
    const int lo = args.ph_lo, hi = args.ph_hi;
    if (hi - lo > 1) bar = xcd_barrier_post(barw, misc);
#define IN(k) (lo <= (k) && (k) < hi)
#define SEAM(k) do { if (IN(k) && IN((k) + 1)) xcd_barrier(bar, F.wave); } while (0)
    bf16_t* R0 = (bf16_t*)(F.ws + WS_R0);

#define PH2_BODY { \
        { pg8::Gemm g{(const bf16_t*)(F.ws + WS_H1F8), (const bf16_t*)(F.ws + WS_WIN8), MTOK, 5632, DM / 2, DM / 2, 0, nullptr, nullptr, 0, 0}; pg8::StaticOrder S; S.init(MTOK, 5632, F.G, F.bid); \
          EpiInproj<true> E{(bf16_t*)(F.ws + WS_QN), (bf16_t*)(F.ws + WS_KN), (bf16_t*)(F.ws + WS_V), (bf16_t*)(F.ws + WS_IQ), (bf16_t*)(F.ws + WS_IK), (bf16_t*)(F.ws + WS_PL), \
                    (bf16_t*)(F.ws + WS_GA), (bf16_t*)(F.ws + WS_GP), (float*)(F.ws + WS_IW)}; \
          pg8::gemm_phase<EpiInproj<true>, true>(ldsl, g, S, E, F.wave); } \
        { pg8::Gemm g{R0, (const bf16_t*)(F.ws + WS_WIN16), MTOK, 2304, DM, DM, 0, nullptr, nullptr, 0, 0}; pg8::StaticOrder S; S.init(MTOK, 2304, F.G, F.bid); \
          EpiInproj<false> E{(bf16_t*)(F.ws + WS_QN), (bf16_t*)(F.ws + WS_KN), (bf16_t*)(F.ws + WS_V), (bf16_t*)(F.ws + WS_IQ), (bf16_t*)(F.ws + WS_IK), (bf16_t*)(F.ws + WS_PL), \
                    (bf16_t*)(F.ws + WS_GA), (bf16_t*)(F.ws + WS_GP), (float*)(F.ws + WS_IW)}; \
          pg8::gemm_phase<EpiInproj<false>>(ldsl, g, S, E, F.wave); } }
#define PH3_BODY { phase3_pooled(F); phase3_indexer(F); __syncthreads(); }
#define PH4_BODY { \
        phase4_attention(F); \
        __syncthreads(); \
        pg8::Gemm g{(const bf16_t*)(F.ws + WS_POOLED), (const bf16_t*)(F.ws + WS_POOLW), MTOK, PW, 256, 1024, 256, nullptr, nullptr, 0, 0}; pg8::StaticOrder S; S.init(MTOK, PW, F.G, F.bid); \
        EpiBf16Scale E{(bf16_t*)(F.ws + WS_POOL2), 1024, F.pool_scale}; \
        pg8::gemm_phase<EpiBf16Scale>(ldsl, g, S, E, F.wave); }
#define PH5_BODY { \
        pg8::Gemm g{(const bf16_t*)(F.ws + WS_ATTN), (const bf16_t*)(F.ws + WS_WAB), MTOK, DM, 2048, 1024, 0, (const bf16_t*)(F.ws + WS_POOL2), (const bf16_t*)(F.ws + WS_WPB), 16, 1024}; \
        pg8::StaticOrder S; S.init(MTOK, DM, F.G, F.bid); \
        EpiMerge E{(unsigned char*)R0, (const bf16_t*)(F.ws + WS_GA), (const bf16_t*)(F.ws + WS_GP)}; pg8::gemm_phase<EpiMerge>(ldsl, g, S, E, F.wave); }
#define PH6_BODY { \
        pg8::Gemm g{R0, (const bf16_t*)(F.ws + WS_WOUT), MTOK, DM, DM / 2, DM / 2, 0, nullptr, nullptr, 0, 0}; pg8::StaticOrder S; S.init(MTOK, DM, F.G, F.bid); \
        EpiResid E{F.x, F.out, (const float*)(F.ws + WS_MODF) + 4096}; pg8::gemm_phase<EpiResid, true>(ldsl, g, S, E, F.wave); }
#define PH8_BODY { \
        pg8::Gemm g{(const bf16_t*)(F.ws + WS_H2), (const bf16_t*)(F.ws + WS_WPQ), MTOK, DM, DM, DM, 0, nullptr, nullptr, 0, 0}; pg8::StaticOrder S; S.init(MTOK, DM, F.G, F.bid); \
        EpiBf16Scale E{R0, 2048, nullptr}; pg8::gemm_phase<EpiBf16Scale>(ldsl, g, S, E, F.wave); }
#define PH9_BODY { \
        pg8::Gemm g{R0, (const bf16_t*)(F.ws + WS_KEYSBD), MTOK, DM, 256, DM, 256, nullptr, nullptr, 0, 0}; pg8::StaticOrder S; S.init(MTOK, DM, F.G, F.bid); \
        EpiBf16Scale E{(bf16_t*)(F.ws + WS_SUB), 2048, nullptr}; pg8::gemm_phase<EpiBf16Scale>(ldsl, g, S, E, F.wave); }
#define REP(k) if constexpr (((PROBE_REP) >> (k)) & 1)

    if (IN(0)) { phase0_prep(F); REP(0) { __syncthreads(); phase0_prep(F); } }
    SEAM(0);
    if (IN(1)) { phase_modnorm<true>(F, F.x, F.g1, 0, 2048, R0, F.ws + WS_H1F8); REP(1) { phase_modnorm<true>(F, F.x, F.g1, 0, 2048, R0, F.ws + WS_H1F8); } }
    SEAM(1);
    if (IN(2)) { PH2_BODY REP(2) PH2_BODY }
    SEAM(2);
    if (IN(3)) { phase3_qknorm(F); PH3_BODY REP(3) PH3_BODY }
    SEAM(3);
    if (IN(4)) { PH4_BODY REP(4) PH4_BODY }
    SEAM(4);
    if (IN(5)) { PH5_BODY REP(5) PH5_BODY }
    SEAM(5);
    if (IN(6)) { PH6_BODY REP(6) PH6_BODY }
    SEAM(6);
    if (IN(7)) { phase_modnorm<false>(F, F.out, F.g2, 6144, 8192, (bf16_t*)(F.ws + WS_H2)); REP(7) { phase_modnorm<false>(F, F.out, F.g2, 6144, 8192, (bf16_t*)(F.ws + WS_H2)); } }
    SEAM(7);
    if (IN(8)) { PH8_BODY REP(8) PH8_BODY }
    SEAM(8);
    if (IN(9)) { PH9_BODY REP(9) PH9_BODY }
    SEAM(9);
    if (IN(10)) { phase10_peer(F); REP(10) phase10_peer(F); }
    SEAM(10);
    if (IN(11)) { REP(11) { phase11_peer_v(F, (float*)(F.ws + WS_SUB)); } phase11_peer_v(F, F.out); }
#undef IN
#undef SEAM
}

extern "C" void kernel_launch(void* const* d_in, const int* in_sizes, int n_in, void* d_out, int out_size, void* d_ws, size_t ws_size, hipStream_t stream) {
    static int grid = 0;
    if (grid == 0) {
        if (n_in != 19 || out_size != MTOK * DM || ws_size < WS_END) { fprintf(stderr, "kernel_launch: unexpected shapes (n_in %d out %d ws %zu)\n", n_in, out_size, ws_size); grid = -1; return; }
        int dev = 0, cus = 0, per_cu = 0;
        if (hipGetDevice(&dev) != hipSuccess || hipDeviceGetAttribute(&cus, hipDeviceAttributeMultiprocessorCount, dev) != hipSuccess) { grid = -1; return; }
        if (hipFuncSetAttribute((const void*)fwd_kernel, hipFuncAttributeMaxDynamicSharedMemorySize, LDS_BYTES) != hipSuccess) { fprintf(stderr, "kernel_launch: hipFuncSetAttribute failed\n"); grid = -1; return; }
        if (hipOccupancyMaxActiveBlocksPerMultiprocessor(&per_cu, (const void*)fwd_kernel, 512, LDS_BYTES) != hipSuccess || per_cu < 1) { fprintf(stderr, "kernel_launch: occupancy query says %d\n", per_cu); }
        (void)hipGetLastError();
        grid = cus;
    }
    if (grid < 0) return;
    (void)in_sizes;
    if (hipMemsetAsync((char*)d_ws + WS_CTL, 0, CTL_ZERO_BYTES, stream) != hipSuccess) return;
    Args a{};
    for (int i = 0; i < 19; ++i) a.in[i] = (const float*)d_in[i];
    a.out = (float*)d_out; a.ws = (unsigned char*)d_ws;
#if MK_PER_PHASE
    for (int p = 0; p < NPHASE; ++p) { a.ph_lo = p; a.ph_hi = p + 1; a.li = p; hipLaunchKernelGGL(fwd_kernel, dim3(grid), dim3(512), LDS_BYTES, stream, a); }
#else
    a.ph_lo = 0; a.ph_hi = NPHASE; a.li = 0;
    hipLaunchKernelGGL(fwd_kernel, dim3(grid), dim3(512), LDS_BYTES, stream, a);
#endif
}
```

```cpp
#include <hip/hip_runtime.h>
#include <cstdio>
#include <cstdint>

#ifndef MK_PER_PHASE
#define MK_PER_PHASE 0
#endif

#ifndef PROBE_REP
#define PROBE_REP 0
#endif
#ifndef PROBE_IDX
#define PROBE_IDX 0
#endif
#ifndef PROBE_P11X
#define PROBE_P11X 0
#endif
#define LAS __attribute__((address_space(3)))
typedef unsigned short bf16_t;
typedef short bf16x8 __attribute__((ext_vector_type(8)));
typedef float f32x4 __attribute__((ext_vector_type(4)));
typedef float f32x2 __attribute__((ext_vector_type(2)));
typedef unsigned u32x4 __attribute__((ext_vector_type(4)));
typedef unsigned u32x2 __attribute__((ext_vector_type(2)));
typedef unsigned u32x6 __attribute__((ext_vector_type(6)));
typedef unsigned u32x16 __attribute__((ext_vector_type(16)));
typedef __bf16 bf16x32 __attribute__((ext_vector_type(32)));

constexpr int BATCH = 8, SEQ = 4096, DM = 2048, MTOK = BATCH * SEQ;
constexpr int NHEAD = 8, HDIM = 128, AW = 1024, KVW = 256, IHEADS = 16, IDIM = 64, KSEL = 256;
constexpr int PW = 1024, PHEADS = 8, NEXP = 16384;
constexpr int INW = 7760;
constexpr float EPS = 1e-6f;
constexpr int NPHASE = 12;

constexpr size_t MiB = 1u << 20;
constexpr size_t WS_CTL = 0, CTL_ZERO_BYTES = 256 * 1024;
constexpr size_t WS_MODP = 2 * MiB;
constexpr size_t WS_MODF = 4 * MiB;
constexpr size_t WS_POOLW = 5 * MiB;
constexpr size_t WS_KEYSBD = 6 * MiB;
constexpr size_t WS_WIN16 = 8 * MiB;
constexpr size_t WS_WIN8 = 20 * MiB;
constexpr size_t WS_WAB = 40 * MiB, WS_WPB = 44 * MiB, WS_WOUT = 48 * MiB, WS_WPQ = 56 * MiB;
constexpr size_t WS_PU = 64 * MiB, WS_PV = 128 * MiB;
constexpr size_t WS_R0 = 192 * MiB;
constexpr size_t WS_GA = 320 * MiB, WS_GP = 448 * MiB;
constexpr size_t WS_SUB = 320 * MiB;
constexpr size_t WS_QN = 576 * MiB;
constexpr size_t WS_IQ = 640 * MiB;
constexpr size_t WS_PL = 704 * MiB;
constexpr size_t WS_KN = 768 * MiB, WS_V = 784 * MiB;
constexpr size_t WS_IK = 800 * MiB;
constexpr size_t WS_IW = 804 * MiB;
constexpr size_t WS_SEL = 806 * MiB;
constexpr size_t WS_POOLED = 822 * MiB;
constexpr size_t WS_H2 = 886 * MiB;
constexpr size_t WS_END = 1014 * MiB;
constexpr size_t WS_H1F8 = WS_H2 + 64 * MiB;
constexpr size_t WS_Q8 = WS_H2, WS_K8 = WS_H2 + 32 * MiB, WS_V8 = WS_H2 + 40 * MiB;
constexpr size_t WS_ATTN = WS_IQ, WS_POOL2 = WS_PL, WS_PAIRS = WS_QN, WS_WLS = WS_QN + 32 * MiB;

constexpr int LDS_BYTES = 160 * 1024;
constexpr int MISC_OFF = 159 * 1024;

__device__ __forceinline__ unsigned cvt_pk_bf16(float lo, float hi) { unsigned r; asm volatile("v_cvt_pk_bf16_f32 %0, %1, %2" : "=v"(r) : "v"(lo), "v"(hi)); return r; }
__device__ __forceinline__ float bf_lo(unsigned w) { return __uint_as_float(w << 16); }
__device__ __forceinline__ float bf_hi(unsigned w) { return __uint_as_float(w & 0xffff0000u); }
template <int CTRL> __device__ __forceinline__ float dpp_f(float x) { return __int_as_float(__builtin_amdgcn_update_dpp(0, __float_as_int(x), CTRL, 0xF, 0xF, true)); }
#define DPP_XOR1 0xB1
#define DPP_XOR2 0x4E
#define DPP_HMIRROR 0x141
#define DPP_MIRROR 0x140
#define DPP_ROR8 0x128
__device__ __forceinline__ float xor16_sum(float x) { const auto r = __builtin_amdgcn_permlane16_swap(__float_as_uint(x), __float_as_uint(x), false, false); return __uint_as_float(r[0]) + __uint_as_float(r[1]); }
__device__ __forceinline__ float xor32_sum(float x) { const auto r = __builtin_amdgcn_permlane32_swap(__float_as_uint(x), __float_as_uint(x), false, false); return __uint_as_float(r[0]) + __uint_as_float(r[1]); }
__device__ __forceinline__ float xor16_max(float x) { const auto r = __builtin_amdgcn_permlane16_swap(__float_as_uint(x), __float_as_uint(x), false, false); return fmaxf(__uint_as_float(r[0]), __uint_as_float(r[1])); }
__device__ __forceinline__ float swap32_pair(float a, float b) { const auto r = __builtin_amdgcn_permlane32_swap(__float_as_uint(a), __float_as_uint(b), false, false); return __uint_as_float(r[0]) + __uint_as_float(r[1]); }
__device__ __forceinline__ float swap16_pair(float a, float b) { const auto r = __builtin_amdgcn_permlane16_swap(__float_as_uint(a), __float_as_uint(b), false, false); return __uint_as_float(r[0]) + __uint_as_float(r[1]); }
__device__ __forceinline__ float row_sum16(float v) { v += dpp_f<DPP_XOR1>(v); v += dpp_f<DPP_XOR2>(v); v += dpp_f<DPP_HMIRROR>(v); v += dpp_f<DPP_MIRROR>(v); return v; }
__device__ __forceinline__ float row_max16(float v) { v = fmaxf(v, dpp_f<DPP_XOR1>(v)); v = fmaxf(v, dpp_f<DPP_XOR2>(v)); v = fmaxf(v, dpp_f<DPP_HMIRROR>(v)); v = fmaxf(v, dpp_f<DPP_MIRROR>(v)); return v; }
__device__ __forceinline__ float wave_sum(float v) { return xor32_sum(xor16_sum(row_sum16(v))); }
__device__ __forceinline__ float sigmoidf_(float x) { return __builtin_amdgcn_rcpf(1.0f + __expf(-x)); }
__device__ __forceinline__ float dot8(u32x4 w, const float* h) {
    return bf_lo(w.x) * h[0] + bf_hi(w.x) * h[1] + bf_lo(w.y) * h[2] + bf_hi(w.y) * h[3] + bf_lo(w.z) * h[4] + bf_hi(w.z) * h[5] + bf_lo(w.w) * h[6] + bf_hi(w.w) * h[7];
}

__device__ __forceinline__ int lane_now() { int l; asm volatile("v_mbcnt_lo_u32_b32 %0, -1, 0\n\tv_mbcnt_hi_u32_b32 %0, -1, %0" : "=v"(l)); return l; }

#define XB_TMO      128
#define XB_XCNT(j)  (256  + 64 * (j))
#define XB_XSUB(j)  (1280 + 64 * (j))
#define XB_XGEN(j)  (2304 + 64 * (j))
#define XB_TOP      3328
#define XB_TOPGEN   3392
#define XCD_BAR_WORDS 3456
#define XB_SPIN_CAP (1u << 18)

__device__ __forceinline__ unsigned xb_ld(unsigned* p)              { return __hip_atomic_load(p, __ATOMIC_RELAXED, __HIP_MEMORY_SCOPE_AGENT); }
__device__ __forceinline__ unsigned xb_add(unsigned* p, unsigned v) { return __hip_atomic_fetch_add(p, v, __ATOMIC_RELAXED, __HIP_MEMORY_SCOPE_AGENT); }
__device__ __forceinline__ unsigned xb_xcc_id() { return (unsigned)__builtin_amdgcn_s_getreg((3 << 11) | 20) & 0xFu; }
#define XB_SPIN(cond, bar) do { unsigned _sp = 0; while (cond) { __builtin_amdgcn_s_sleep(1); \
    if ((++_sp & 255u) == 0u) { if (xb_ld(&(bar)[XB_TMO])) break; if (_sp > XB_SPIN_CAP) { atomicAdd(&(bar)[XB_TMO], 1u); break; } } } } while (0)

struct XcdBarrier { unsigned* bar; unsigned x; volatile LAS unsigned* st; };

__device__ __forceinline__ XcdBarrier xcd_barrier_post(unsigned* bar, volatile LAS unsigned* st) {
    XcdBarrier b; b.bar = bar; b.x = xb_xcc_id(); b.st = st;
    if (threadIdx.x == 0) (void)xb_add(&bar[XB_XCNT(b.x)], 1u);
    return b;
}
__device__ __forceinline__ void xcd_barrier_complete(unsigned* bar, unsigned x, unsigned& nloc, unsigned& nx) {
    const unsigned G = gridDim.x * gridDim.y * gridDim.z;
    unsigned sum, cnt, mine, sp = 0u;
    for (;;) {
        sum = 0u; cnt = 0u; mine = 0u;
#pragma unroll
        for (unsigned j = 0; j < 16; ++j) { const unsigned c = xb_ld(&bar[XB_XCNT(j)]); sum += c; cnt += (c > 0u) ? 1u : 0u; mine = (j == x) ? c : mine; }
        if (sum == G) break;
        __builtin_amdgcn_s_sleep(1);
        if ((++sp & 255u) == 0u) { if (xb_ld(&bar[XB_TMO])) break; if (sp > XB_SPIN_CAP) { atomicAdd(&bar[XB_TMO], 1u); break; } }
    }
    nloc = mine > 0u ? mine : 1u; nx = cnt > 0u ? cnt : 1u;
}
__device__ __forceinline__ void xcd_barrier(const XcdBarrier& b, int wave) {
    asm volatile("s_waitcnt vmcnt(0)" ::: "memory");
    __syncthreads();
    if (wave == 0 && lane_now() == 0) {
        unsigned* bar = b.bar;
        __builtin_amdgcn_s_waitcnt(0);
        unsigned nloc = b.st[0], nx = b.st[1];
        if (nloc == 0u) { xcd_barrier_complete(bar, b.x, nloc, nx); b.st[0] = nloc; b.st[1] = nx; }
        const unsigned old = xb_add(&bar[XB_XSUB(b.x)], 1u);
        const unsigned gen = old / nloc;
        if (old + 1u == (gen + 1u) * nloc) {
            __builtin_amdgcn_fence(__ATOMIC_RELEASE, "agent");
            asm volatile("s_waitcnt vmcnt(0)" ::: "memory");
            const unsigned og = xb_add(&bar[XB_TOP], 1u);
            const unsigned tg = og / nx;
            if (og + 1u == (tg + 1u) * nx) xb_add(&bar[XB_TOPGEN], 1u);
            else XB_SPIN(xb_ld(&bar[XB_TOPGEN]) == tg, bar);
            __builtin_amdgcn_fence(__ATOMIC_ACQUIRE, "agent");
            xb_add(&bar[XB_XGEN(b.x)], 1u);
            asm volatile("s_waitcnt vmcnt(0)" ::: "memory");
        } else {
            XB_SPIN(xb_ld(&bar[XB_XGEN(b.x)]) == gen, bar);
            __builtin_amdgcn_fence(__ATOMIC_ACQUIRE, "agent");
            asm volatile("s_waitcnt vmcnt(0)" ::: "memory");
        }
    }
    __syncthreads();
}

namespace pg8 {
constexpr int BM = 256, BK = 64, HALF = 128, HTB = HALF * BK * 2, STAGE_BYTES = 8 * HTB, NXCD = 8, WGM = 8;
__device__ __forceinline__ int lds_byte(int r, int c) { const int st = (r >> 4) * 2 + (c >> 5), rr = r & 15, cc = c & 31, ob = rr * 64 + cc * 2; return st * 1024 + (ob ^ (((ob >> 9) & 1) << 5)); }
__device__ __forceinline__ void stage_rc(int b, int& R, int& C) { const int st = b / 1024, sb = b % 1024, swz = sb ^ (((sb >> 9) & 1) << 5); R = (st >> 1) * 16 + swz / 64; C = (st & 1) * 32 + (swz % 64) / 2; }
__device__ __forceinline__ int perm32(int rho) { const int n = rho >> 4, i = rho & 15; return 8 * (i >> 2) + 4 * n + (i & 3); }

struct Unit { int pm, pn; };
struct Gemm { const bf16_t* A; const bf16_t* Bt; int M, N, K, lda, a_pn_off; const bf16_t* A2; const bf16_t* Bt2; int ksplit, ldb; };

struct StaticOrder {
    int nM, nN, nwg, G, c;
    __device__ void init(int M, int N, int G_, int c_) { nM = M / BM; nN = N / BM; nwg = nM * nN; G = G_; c = c_; }
    __device__ bool next(int i, Unit& u) const {
        const long L = (long)i * G + c; if (L >= nwg) return false;
        int wgid = (int)L; { const int q = nwg / NXCD, r = nwg % NXCD, xcd = wgid % NXCD, off = wgid / NXCD; wgid = (xcd < r ? xcd * (q + 1) : r * (q + 1) + (xcd - r) * q) + off; }
        const int nig = WGM * nN, gid = wgid / nig, fm = gid * WGM, gsz = (nM - fm) < WGM ? (nM - fm) : WGM;
        u.pm = fm + ((wgid % nig) % gsz); u.pn = (wgid % nig) / gsz; return true;
    }
};

typedef int i32x4 __attribute__((ext_vector_type(4)));
typedef int i32x8 __attribute__((ext_vector_type(8)));
__device__ __forceinline__ bf16x8 lo8(i32x8 v) { return __builtin_bit_cast(bf16x8, (i32x4){v.s0, v.s1, v.s2, v.s3}); }
__device__ __forceinline__ bf16x8 hi8(i32x8 v) { return __builtin_bit_cast(bf16x8, (i32x4){v.s4, v.s5, v.s6, v.s7}); }
__device__ __forceinline__ i32x8 cat8(bf16x8 a, bf16x8 b) { const i32x4 x = __builtin_bit_cast(i32x4, a), y = __builtin_bit_cast(i32x4, b); return (i32x8){x.x, x.y, x.z, x.w, y.x, y.y, y.z, y.w}; }
template <class Epi, bool F8 = false>
__device__ __forceinline__ void gemm_phase(LAS unsigned char* lds, const Gemm g, const StaticOrder& S, const Epi& E, int wave) {
    const int lane = lane_now(), wid = wave, tid = wid * 64 + lane, wr = wid >> 2, wc = wid & 3, fr = lane & 15, fq = lane >> 4;
    const int K = g.K, nt = K / BK, lda = g.lda, ldb = g.ldb ? g.ldb : g.K, ksplit = g.ksplit;
    unsigned voffA, voffB;
    { int R, C; stage_rc(tid * 16, R, C); const int Rb = Epi::PERM ? ((R & ~31) + perm32(R & 31)) : R;
      voffA = (unsigned)(R * lda + C) * 2u; voffB = (unsigned)(Rb * ldb + C) * 2u; }
    const unsigned stepA = 64u * (unsigned)lda * 2u, stepB = 64u * (unsigned)ldb * 2u;
    const size_t kstep = (size_t)(BK * 2);
    const size_t hsA = (size_t)HALF * lda * 2, hsB = (size_t)HALF * ldb * 2;
    const size_t tsA = 2 * hsA, tsB = 2 * hsB;
    const unsigned ldsw = (unsigned)wid * 1024u, ldsbase = (unsigned)(unsigned long long)lds;
    const int aoff = lds_byte(wr * 64 + fr, fq * 8), boff = lds_byte(wc * 32 + fr, fq * 8);
#define PG8_SA(b, h) (((b) * 2 + (h)) * HTB)
#define PG8_SB(b, h) ((4 + (b) * 2 + (h)) * HTB)
#define PG8_STAGE(bufoff, gbase, voff) do { _Pragma("unroll") for (int _i = 0; _i < 2; ++_i) { \
        const char* sb_ = (const char*)(gbase) + (size_t)_i * PG8_STEP_##voff; const unsigned m0_ = ldsbase + (unsigned)(bufoff) + ldsw + (unsigned)_i * 8192u; \
        asm volatile("s_mov_b32 m0, %2\n\ts_nop 0\n\tglobal_load_lds_dwordx4 %0, %1" :: "v"(voff), "s"(sb_), "s"(m0_) : "memory"); } } while (0)
#define PG8_STEP_voffA stepA
#define PG8_STEP_voffB stepB
#define PG8_LDA(dst, b, h) do { _Pragma("unroll") for (int m = 0; m < 4; ++m) dst[m] = cat8(*(const LAS bf16x8*)(lds + PG8_SA(b, h) + aoff + m * 2048), *(const LAS bf16x8*)(lds + PG8_SA(b, h) + aoff + m * 2048 + 1024)); } while (0)
#define PG8_LDB(dst, b, h) do { _Pragma("unroll") for (int n = 0; n < 2; ++n) dst[n] = cat8(*(const LAS bf16x8*)(lds + PG8_SB(b, h) + boff + n * 2048), *(const LAS bf16x8*)(lds + PG8_SB(b, h) + boff + n * 2048 + 1024)); } while (0)
#define PG8_MMA(ai, bj, At, Bt) do { __builtin_amdgcn_s_setprio(1); _Pragma("unroll") for (int m = 0; m < 4; ++m) _Pragma("unroll") for (int n = 0; n < 2; ++n) { \
        if constexpr (F8) acc[ai][bj][m][n] = __builtin_amdgcn_mfma_scale_f32_16x16x128_f8f6f4(Bt[n], At[m], acc[ai][bj][m][n], 0, 0, 0, 0x7D7D7D7D  , 0, 0x7D7D7D7D); \
        else { acc[ai][bj][m][n] = __builtin_amdgcn_mfma_f32_16x16x32_bf16(lo8(Bt[n]), lo8(At[m]), acc[ai][bj][m][n], 0, 0, 0); \
               acc[ai][bj][m][n] = __builtin_amdgcn_mfma_f32_16x16x32_bf16(hi8(Bt[n]), hi8(At[m]), acc[ai][bj][m][n], 0, 0, 0); } } \
        __builtin_amdgcn_s_setprio(0); } while (0)
#define PG8_WAIT_V(n) asm volatile("s_waitcnt vmcnt(" #n ")" ::: "memory")
#define PG8_WAIT_L(n) asm volatile("s_waitcnt lgkmcnt(" #n ")" ::: "memory")
#define PG8_BAR __builtin_amdgcn_s_barrier()
#define PG8_SCHED __builtin_amdgcn_sched_barrier(0)
    Unit cur, nxt; int ui = 0;
    if (!S.next(0, cur)) return;
    f32x4 acc[2][2][4][2];
#pragma unroll
    for (int a = 0; a < 2; ++a)
#pragma unroll
        for (int b = 0; b < 2; ++b)
#pragma unroll
            for (int m = 0; m < 4; ++m)
#pragma unroll
                for (int n = 0; n < 2; ++n) acc[a][b][m][n] = (f32x4){0.f, 0.f, 0.f, 0.f};
    i32x8 At[4], B0[2], B1[2];
    const char* cA = (const char*)g.A + (size_t)cur.pm * tsA + (size_t)cur.pn * g.a_pn_off * 2; const char* cB = (const char*)g.Bt + (size_t)cur.pn * tsB;
    PG8_STAGE(PG8_SB(0, 0), cB, voffB); PG8_STAGE(PG8_SB(0, 1), cB + hsB, voffB); PG8_STAGE(PG8_SA(0, 0), cA, voffA); PG8_STAGE(PG8_SA(0, 1), cA + hsA, voffA);
    if (wr == 1) PG8_BAR;
    PG8_WAIT_V(2); PG8_BAR;
    PG8_STAGE(PG8_SB(1, 0), cB + kstep, voffB); PG8_STAGE(PG8_SA(1, 0), cA + kstep, voffA); PG8_STAGE(PG8_SB(1, 1), cB + hsB + kstep, voffB);
    PG8_WAIT_V(6); PG8_BAR;
    for (;;) {
        const bool has_next = S.next(ui + 1, nxt);
        const char* nA = has_next ? (const char*)g.A + (size_t)nxt.pm * tsA + (size_t)nxt.pn * g.a_pn_off * 2 : cA; const char* nB = has_next ? (const char*)g.Bt + (size_t)nxt.pn * tsB : cB;
        const char* cA2 = (const char*)g.A2 + (size_t)cur.pm * tsA; const char* cB2 = (const char*)g.Bt2 + (size_t)cur.pn * tsB;
#pragma clang loop unroll(disable)
        for (int t = 0; t < nt; t += 2) {
            const bool last = (t == nt - 2);
            const bool s1 = ksplit && (t >= ksplit), s2 = ksplit && (t + 2 >= ksplit);
            const char* a1 = (s1 ? cA2 + (size_t)(t - ksplit + 1) * kstep : cA + (size_t)(t + 1) * kstep);
            const char* a2 = last ? nA : (s2 ? cA2 + (size_t)(t + 2 - ksplit) * kstep : cA + (size_t)(t + 2) * kstep);
            const char* b2 = last ? nB : (s2 ? cB2 + (size_t)(t + 2 - ksplit) * kstep : cB + (size_t)(t + 2) * kstep);
            const char* a3 = a2 + kstep; const char* b3 = b2 + kstep;
            PG8_LDB(B0, 0, 0); PG8_LDB(B1, 0, 1); PG8_SCHED; PG8_LDA(At, 0, 0); PG8_STAGE(PG8_SA(1, 1), a1 + hsA, voffA);
            PG8_WAIT_V(8); PG8_WAIT_L(0); PG8_BAR; PG8_MMA(0, 0, At, B0); PG8_MMA(0, 1, At, B1); PG8_BAR; PG8_SCHED;
            PG8_LDA(At, 0, 1); PG8_STAGE(PG8_SB(0, 0), b2, voffB); PG8_STAGE(PG8_SB(0, 1), b2 + hsB, voffB); PG8_STAGE(PG8_SA(0, 0), a2, voffA);
            PG8_WAIT_V(8); PG8_WAIT_L(0); PG8_BAR; PG8_MMA(1, 0, At, B0); PG8_MMA(1, 1, At, B1); PG8_BAR; PG8_SCHED;
            PG8_LDB(B0, 1, 0); PG8_LDB(B1, 1, 1); PG8_SCHED; PG8_LDA(At, 1, 0); PG8_STAGE(PG8_SA(0, 1), a2 + hsA, voffA);
            PG8_WAIT_V(8); PG8_WAIT_L(0); PG8_BAR; PG8_MMA(0, 0, At, B0); PG8_MMA(0, 1, At, B1); PG8_BAR; PG8_SCHED;
            PG8_LDA(At, 1, 1); PG8_STAGE(PG8_SB(1, 0), b3, voffB); PG8_STAGE(PG8_SB(1, 1), b3 + hsB, voffB); PG8_STAGE(PG8_SA(1, 0), a3, voffA);
            PG8_WAIT_V(8); PG8_WAIT_L(0); PG8_BAR; PG8_MMA(1, 0, At, B0); PG8_MMA(1, 1, At, B1); PG8_BAR; PG8_SCHED;
            if constexpr (Epi::MID) { if (t + 2 == ksplit) E.mid(acc, cur, wr, wc, fr, fq); }
        }
        if (wr == 0) PG8_BAR;
        { const int l2 = lane_now(); E(acc, cur, wr, wc, l2 & 15, l2 >> 4); }
        if (!has_next) break;
#pragma unroll
        for (int a = 0; a < 2; ++a)
#pragma unroll
            for (int b = 0; b < 2; ++b)
#pragma unroll
                for (int m = 0; m < 4; ++m)
#pragma unroll
                    for (int n = 0; n < 2; ++n) acc[a][b][m][n] = (f32x4){0.f, 0.f, 0.f, 0.f};
        cur = nxt; cA = nA; cB = nB; ++ui;
        if (wr == 1) PG8_BAR;
    }
    PG8_WAIT_V(0);
    PG8_BAR;
#undef PG8_SA
#undef PG8_SB
#undef PG8_STAGE
#undef PG8_STEP_voffA
#undef PG8_STEP_voffB
#undef PG8_LDA
#undef PG8_LDB
#undef PG8_MMA
#undef PG8_WAIT_V
#undef PG8_WAIT_L
#undef PG8_BAR
#undef PG8_SCHED
}
}
using pg8::Unit;

typedef f32x4 AccT[2][2][4][2];
__device__ __forceinline__ u32x4 pack8(f32x4 a, f32x4 b) { u32x4 w; w.x = cvt_pk_bf16(a[0], a[1]); w.y = cvt_pk_bf16(a[2], a[3]); w.z = cvt_pk_bf16(b[0], b[1]); w.w = cvt_pk_bf16(b[2], b[3]); return w; }
__device__ __forceinline__ u32x2 pack8_fp8(f32x4 a, f32x4 b) {
    int w0 = __builtin_amdgcn_cvt_pk_fp8_f32(a[0], a[1], 0, false); w0 = __builtin_amdgcn_cvt_pk_fp8_f32(a[2], a[3], w0, true);
    int w1 = __builtin_amdgcn_cvt_pk_fp8_f32(b[0], b[1], 0, false); w1 = __builtin_amdgcn_cvt_pk_fp8_f32(b[2], b[3], w1, true);
    return (u32x2){(unsigned)w0, (unsigned)w1};
}
__device__ __forceinline__ void unpack8(u32x4 w, f32x4& a, f32x4& b) { a = (f32x4){bf_lo(w.x), bf_hi(w.x), bf_lo(w.y), bf_hi(w.y)}; b = (f32x4){bf_lo(w.z), bf_hi(w.z), bf_lo(w.w), bf_hi(w.w)}; }

template <bool SET8> struct EpiInproj {
    static constexpr bool PERM = true, MID = false;
    bf16_t *q, *k, *v, *iq, *ik, *pl, *ga, *gp; float* iw;
    __device__ __forceinline__ void operator()(const AccT& acc, const Unit& u, int wr, int wc, int fr, int fq) const {
        const int pn = u.pn, row0 = u.pm * 256 + wr * 64 + fr;
        if (!SET8 && pn == 4) {
            if (wc < 2) {
#pragma unroll
                for (int ai = 0; ai < 2; ++ai)
#pragma unroll
                    for (int m = 0; m < 4; ++m) { const size_t row = (size_t)(row0 + ai * 128 + m * 16);
                        *(u32x4*)(ik + row * 64 + wc * 32 + 8 * fq) = pack8(acc[ai][0][m][0], acc[ai][0][m][1]); }
            } else if (wc == 2) {
                if (fq < 2) {
#pragma unroll
                    for (int ai = 0; ai < 2; ++ai)
#pragma unroll
                        for (int m = 0; m < 4; ++m) { const size_t row = (size_t)(row0 + ai * 128 + m * 16);
                            *(f32x4*)(iw + row * 16 + 8 * fq) = acc[ai][0][m][0]; *(f32x4*)(iw + row * 16 + 8 * fq + 4) = acc[ai][0][m][1]; }
                }
            }
            return;
        }
        bf16_t* dst; int ld, tc; bool sg = false;
        if (SET8) {
            if (pn < 4) { dst = q; ld = 1024; tc = pn * 256; }
            else if (pn == 4) { dst = k; ld = 256; tc = 0; }
            else if (pn == 5) { dst = v; ld = 256; tc = 0; }
            else if (pn < 14) { dst = ga; ld = 2048; tc = (pn - 6) * 256; sg = true; }
            else { dst = gp; ld = 2048; tc = (pn - 14) * 256; sg = true; }
        } else {
            if (pn < 4) { dst = iq; ld = 1024; tc = pn * 256; }
            else { dst = pl; ld = 1024; tc = (pn - 5) * 256; }
        }
        const int col0 = tc + wc * 32 + 8 * fq;
#pragma unroll
        for (int ai = 0; ai < 2; ++ai)
#pragma unroll
            for (int m = 0; m < 4; ++m) { bf16_t* rowp = dst + (size_t)(row0 + ai * 128 + m * 16) * ld + col0;
#pragma unroll
                for (int bj = 0; bj < 2; ++bj) { f32x4 v0 = acc[ai][bj][m][0], v1 = acc[ai][bj][m][1];
                    if (sg) {
#pragma unroll
                        for (int j = 0; j < 4; ++j) { v0[j] = sigmoidf_(v0[j]); v1[j] = sigmoidf_(v1[j]); } }
                    *(u32x4*)(rowp + bj * 128) = pack8(v0, v1); } }
    }
};
struct EpiBf16Scale {
    static constexpr bool PERM = true, MID = false;
    bf16_t* O; int ldc; const float* cs;
    __device__ __forceinline__ void operator()(const AccT& acc, const Unit& u, int wr, int wc, int fr, int fq) const {
        const int row0 = u.pm * 256 + wr * 64 + fr, col0 = u.pn * 256 + wc * 32 + 8 * fq;
        f32x4 s[2][2];
#pragma unroll
        for (int bj = 0; bj < 2; ++bj)
#pragma unroll
            for (int n = 0; n < 2; ++n) s[bj][n] = cs ? *(const f32x4*)(cs + col0 + bj * 128 + 4 * n) : (f32x4){1.f, 1.f, 1.f, 1.f};
#pragma unroll
        for (int ai = 0; ai < 2; ++ai)
#pragma unroll
            for (int m = 0; m < 4; ++m) { bf16_t* rowp = O + (size_t)(row0 + ai * 128 + m * 16) * ldc + col0;
#pragma unroll
                for (int bj = 0; bj < 2; ++bj) *(u32x4*)(rowp + bj * 128) = pack8(acc[ai][bj][m][0] * s[bj][0], acc[ai][bj][m][1] * s[bj][1]); }
    }
};
template <bool ADD> struct EpiGate {
    static constexpr bool PERM = true, MID = false;
    bf16_t* O; const bf16_t* gate;
    __device__ __forceinline__ void operator()(const AccT& acc, const Unit& u, int wr, int wc, int fr, int fq) const {
        const int row0 = u.pm * 256 + wr * 64 + fr, col0 = u.pn * 256 + wc * 32 + 8 * fq;
#pragma unroll
        for (int ai = 0; ai < 2; ++ai)
#pragma unroll
            for (int m = 0; m < 4; ++m) { const size_t off = (size_t)(row0 + ai * 128 + m * 16) * 2048 + col0;
#pragma unroll
                for (int bj = 0; bj < 2; ++bj) { f32x4 g0, g1; unpack8(*(const u32x4*)(gate + off + bj * 128), g0, g1);
                    f32x4 r0 = g0 * acc[ai][bj][m][0], r1 = g1 * acc[ai][bj][m][1];
                    if (ADD) { f32x4 o0, o1; unpack8(*(const u32x4*)(O + off + bj * 128), o0, o1); r0 += o0; r1 += o1; }
                    *(u32x4*)(O + off + bj * 128) = pack8(r0, r1); } }
    }
};
struct EpiMerge {
    static constexpr bool PERM = true, MID = true;
    unsigned char* O; const bf16_t* ga; const bf16_t* gp;
    __device__ __forceinline__ void mid(AccT& acc, const Unit& u, int wr, int wc, int fr, int fq) const {
        const auto ra = __builtin_amdgcn_make_buffer_rsrc((void*)ga, 0, 0x7FFFFFFF, 0x00020000), rp = __builtin_amdgcn_make_buffer_rsrc((void*)gp, 0, 0x7FFFFFFF, 0x00020000);
        const int voff = ((wr * 64 + fr) * 2048 + wc * 32 + 8 * fq) * 2;
        const int sbase = (u.pm * 256 * 2048 + u.pn * 256) * 2;
#pragma unroll
        for (int ai = 0; ai < 2; ++ai)
#pragma unroll
            for (int m = 0; m < 4; ++m)
#pragma unroll
                for (int bj = 0; bj < 2; ++bj) { const int so = sbase + ((ai * 128 + m * 16) * 2048 + bj * 128) * 2;
                    const u32x4 wa = __builtin_bit_cast(u32x4, __builtin_amdgcn_raw_buffer_load_b128(ra, voff, so, 0)), wp = __builtin_bit_cast(u32x4, __builtin_amdgcn_raw_buffer_load_b128(rp, voff, so, 0));
                    f32x4 a0, a1, p0, p1; unpack8(wa, a0, a1); unpack8(wp, p0, p1);
#pragma unroll
                    for (int j = 0; j < 4; ++j) { acc[ai][bj][m][0][j] *= a0[j] * __builtin_amdgcn_rcpf(p0[j]); acc[ai][bj][m][1][j] *= a1[j] * __builtin_amdgcn_rcpf(p1[j]); }
                    asm volatile("" : "+v"(acc[ai][bj][m][0]), "+v"(acc[ai][bj][m][1]) :: "memory"); }
    }
    __device__ __forceinline__ void operator()(const AccT& acc, const Unit& u, int wr, int wc, int fr, int fq) const {
        const int row0 = u.pm * 256 + wr * 64 + fr, col0 = u.pn * 256 + wc * 32 + 8 * fq;
#pragma unroll
        for (int ai = 0; ai < 2; ++ai)
#pragma unroll
            for (int m = 0; m < 4; ++m) { const size_t off = (size_t)(row0 + ai * 128 + m * 16) * 2048 + col0;
#pragma unroll
                for (int bj = 0; bj < 2; ++bj) { f32x4 p0, p1; unpack8(*(const u32x4*)(gp + off + bj * 128), p0, p1);
                    *(u32x2*)(O + off + bj * 128) = pack8_fp8(p0 * acc[ai][bj][m][0], p1 * acc[ai][bj][m][1]); } }
    }
};
struct EpiResid {
    static constexpr bool PERM = false, MID = false;
    const float* x; float* out; const float* gt;
    __device__ __forceinline__ void operator()(const AccT& acc, const Unit& u, int wr, int wc, int fr, int fq) const {
        const int row0 = u.pm * 256 + wr * 64 + fr, col0 = u.pn * 256 + wc * 32 + 4 * fq;
        const float* gtb = gt + (size_t)(u.pm / 16) * 12288;
        f32x4 g[2][2];
#pragma unroll
        for (int bj = 0; bj < 2; ++bj)
#pragma unroll
            for (int n = 0; n < 2; ++n) g[bj][n] = *(const f32x4*)(gtb + col0 + bj * 128 + n * 16);
#pragma unroll
        for (int ai = 0; ai < 2; ++ai)
#pragma unroll
            for (int m = 0; m < 4; ++m) { const size_t off = (size_t)(row0 + ai * 128 + m * 16) * 2048 + col0;
#pragma unroll
                for (int bj = 0; bj < 2; ++bj)
#pragma unroll
                    for (int n = 0; n < 2; ++n) { const f32x4 xv = *(const f32x4*)(x + off + bj * 128 + n * 16);
                        *(f32x4*)(out + off + bj * 128 + n * 16) = xv + g[bj][n] * acc[ai][bj][m][n]; } }
    }
};
struct EpiF32 {
    static constexpr bool PERM = false, MID = false;
    float* C; int ldc;
    __device__ __forceinline__ void operator()(const AccT& acc, const Unit& u, int wr, int wc, int fr, int fq) const {
        const int row0 = u.pm * 256 + wr * 64 + fr, col0 = u.pn * 256 + wc * 32 + 4 * fq;
#pragma unroll
        for (int ai = 0; ai < 2; ++ai)
#pragma unroll
            for (int m = 0; m < 4; ++m) { float* rowp = C + (size_t)(row0 + ai * 128 + m * 16) * ldc + col0;
#pragma unroll
                for (int bj = 0; bj < 2; ++bj)
#pragma unroll
                    for (int n = 0; n < 2; ++n) *(f32x4*)(rowp + bj * 128 + n * 16) = acc[ai][bj][m][n]; }
    }
};

struct Args { const float* in[19]; float* out; unsigned char* ws; int ph_lo, ph_hi; int li, pad; };
struct Frame {
    unsigned char* lds; unsigned char* ws;
    int tid, lane, wave, G, bid;
    const float *x, *c, *w_ada, *b_ada, *g1, *g2, *w_in, *g_q, *g_k, *rel_bias, *pool_w, *pool_scale, *w_ab, *w_pb, *w_out, *w_pq, *peer_keys, *peer_u, *peer_v;
    float* out;
};

template <bool F8OUT = false, class Fn> __device__ __forceinline__ void transpose_item(const float* W, int K, int N, void* WTv, int ldk, int drow0, int k0, float* scr, int lane, Fn srccol, float mul = 1.0f) {
    const int sc = srccol(drow0 + (lane & 31));
#pragma unroll 8
    for (int i = 0; i < 32; ++i) { const int kk = 2 * i + (lane >> 5); scr[kk * 33 + (lane & 31)] = sc >= 0 ? W[(size_t)(k0 + kk) * N + sc] * mul : 0.f; }
    asm volatile("s_waitcnt lgkmcnt(0)" ::: "memory");
    const int c = lane & 7;
#pragma unroll
    for (int j = 0; j < 4; ++j) { const int n = (lane >> 3) + 8 * j; const float* s = scr + (8 * c) * 33 + n;
        if constexpr (F8OUT) { *(u32x2*)((unsigned char*)WTv + (size_t)(drow0 + n) * ldk + k0 + 8 * c) = pack8_fp8((f32x4){s[0 * 33], s[1 * 33], s[2 * 33], s[3 * 33]}, (f32x4){s[4 * 33], s[5 * 33], s[6 * 33], s[7 * 33]}); }
        else { u32x4 o; o.x = cvt_pk_bf16(s[0 * 33], s[1 * 33]); o.y = cvt_pk_bf16(s[2 * 33], s[3 * 33]); o.z = cvt_pk_bf16(s[4 * 33], s[5 * 33]); o.w = cvt_pk_bf16(s[6 * 33], s[7 * 33]);
            *(u32x4*)((bf16_t*)WTv + (size_t)(drow0 + n) * ldk + k0 + 8 * c) = o; } }
    asm volatile("s_waitcnt lgkmcnt(0)" ::: "memory");
}
__device__ __forceinline__ void phase0_prep(Frame& F) {
    F.lane = lane_now(); F.tid = F.wave * 64 + F.lane;
    const int gw = F.bid * 8 + F.wave, NGW = F.G * 8;
    float* scr = (float*)(F.lds + F.wave * 16384);
    constexpr int I_IN16 = (2304 / 32) * (DM / 64), I_IN8 = (5632 / 32) * (DM / 64);
    constexpr int I_AB = (2048 / 32) * (1024 / 64), I_OUT = (2048 / 32) * (2048 / 64), I_PW = 4 * 8 * 4;
    constexpr int NIT = I_IN16 + I_IN8 + 2 * I_AB + 2 * I_OUT + I_PW;
    auto ident = [](int j) { return j; };
    for (int it = gw; it < NIT; it += NGW) {
        int r = it;
        if (r < I_IN16) { const int nb = r % 72, kb = r / 72;
            transpose_item(F.w_in, DM, INW, F.ws + WS_WIN16, DM, nb * 32, kb * 64, scr, F.lane, [](int j) { return j < 1104 ? j + 1536 : (j < 1280 ? -1 : j + 1360); }); continue; }
        r -= I_IN16;
        if (r < I_IN8) { const int nb = r % 176, kb = r / 176;
            transpose_item<true>(F.w_in, DM, INW, F.ws + WS_WIN8, DM, nb * 32, kb * 64, scr, F.lane, [](int j) { return j < 1536 ? j : j + 2128; }, 16.0f); continue; }
        r -= I_IN8;
        if (r < I_AB) { transpose_item(F.w_ab, 1024, 2048, (bf16_t*)(F.ws + WS_WAB), 1024, (r % 64) * 32, (r / 64) * 64, scr, F.lane, ident); continue; }
        r -= I_AB;
        if (r < I_AB) { transpose_item(F.w_pb, 1024, 2048, (bf16_t*)(F.ws + WS_WPB), 1024, (r % 64) * 32, (r / 64) * 64, scr, F.lane, ident); continue; }
        r -= I_AB;
        if (r < I_OUT) { transpose_item<true>(F.w_out, 2048, 2048, F.ws + WS_WOUT, 2048, (r % 64) * 32, (r / 64) * 64, scr, F.lane, ident, 16.0f); continue; }
        r -= I_OUT;
        if (r < I_OUT) { transpose_item(F.w_pq, 2048, 2048, (bf16_t*)(F.ws + WS_WPQ), 2048, (r % 64) * 32, (r / 64) * 64, scr, F.lane, ident); continue; }
        r -= I_OUT;
        { const int g = r / 32, q = r % 32, nb = q % 8, kb = q / 8;
          transpose_item(F.pool_w + (size_t)g * 65536, 256, 256, (bf16_t*)(F.ws + WS_POOLW) + (size_t)g * 65536, 256, nb * 32, kb * 64, scr, F.lane, ident); }
    }
    {
        bf16_t* kb = (bf16_t*)(F.ws + WS_KEYSBD);
        for (int i = F.bid * 512 + F.tid; i < 2048 * 32; i += F.G * 512) {
            const int row = i / 32, k8 = (i % 32) * 8, p = (row >> 7) & 1;
            u32x4 o = (u32x4){0u, 0u, 0u, 0u};
            if ((k8 >> 7) == p) { const float* s = F.peer_keys + (size_t)row * 128 + (k8 & 127); const f32x4 a = *(const f32x4*)s, b = *(const f32x4*)(s + 4); o = pack8(a, b); }
            *(u32x4*)(kb + (size_t)row * 256 + k8) = o;
        }
    }
    {
        unsigned char* pu = F.ws + WS_PU;
        for (size_t i = (size_t)F.bid * 512 + F.tid; i < (size_t)NEXP * 64; i += (size_t)F.G * 512) {
            const float* src = F.peer_u + i * 32;
            u32x16 pk;
#pragma unroll
            for (int k = 0; k < 8; ++k) { const f32x4 a = *(const f32x4*)(src + k * 4) * 96.0f; pk[2 * k] = cvt_pk_bf16(a[0], a[1]); pk[2 * k + 1] = cvt_pk_bf16(a[2], a[3]); }
            const u32x6 p6 = __builtin_amdgcn_cvt_scalef32_pk32_fp6_bf16(__builtin_bit_cast(bf16x32, pk), 1.0f);
            unsigned char* dst = pu + i * 24;
            *(u32x2*)dst = (u32x2){p6[0], p6[1]}; *(u32x2*)(dst + 8) = (u32x2){p6[2], p6[3]}; *(u32x2*)(dst + 16) = (u32x2){p6[4], p6[5]};
        }
        unsigned char* pv = F.ws + WS_PV;
        for (int it = gw; it < (NEXP / 64) * 128; it += NGW) {
            const int e = (it >> 7) * 64 + F.lane, ch = it & 127;
            u32x4 ov;
#pragma unroll
            for (int k = 0; k < 4; ++k) { const f32x4 c = *(const f32x4*)(F.peer_v + (size_t)e * DM + ch * 16 + k * 4) * 4.0f;
                int wv = __builtin_amdgcn_cvt_pk_fp8_f32(c[0], c[1], 0, false); wv = __builtin_amdgcn_cvt_pk_fp8_f32(c[2], c[3], wv, true); ov[k] = (unsigned)wv; }
            *(u32x2*)(pv + ((size_t)(2 * ch) * NEXP + e) * 8) = (u32x2){ov[0], ov[1]};
            *(u32x2*)(pv + ((size_t)(2 * ch + 1) * NEXP + e) * 8) = (u32x2){ov[2], ov[3]};
        }
    }
    {
        __syncthreads();
        float* cact = (float*)(F.lds + 131072);
        float* red = (float*)F.lds;
        float* mp = (float*)(F.ws + WS_MODP);
        for (int it = F.bid; it < 48 * 4; it += F.G) {
            const int cb = it % 48, ds = it / 48, d0 = ds * 512;
            for (int i = F.tid; i < 8 * 512; i += 512) { const int b = i >> 9, d = i & 511; const float cv = F.c[b * DM + d0 + d]; cact[i] = cv * sigmoidf_(cv); }
            __syncthreads();
            f32x4 a[8];
#pragma unroll
            for (int b = 0; b < 8; ++b) a[b] = (f32x4){0.f, 0.f, 0.f, 0.f};
            const float* wp = F.w_ada + (size_t)(d0 + F.wave * 64) * 12288 + cb * 256 + F.lane * 4;
#pragma unroll 4
            for (int d = 0; d < 64; ++d) { const f32x4 w = *(const f32x4*)(wp + (size_t)d * 12288);
#pragma unroll
                for (int b = 0; b < 8; ++b) a[b] += w * cact[b * 512 + F.wave * 64 + d]; }
#pragma unroll
            for (int b = 0; b < 8; ++b)
#pragma unroll
                for (int j = 0; j < 4; ++j) red[(F.wave * 32 + b * 4 + j) * 64 + F.lane] = a[b][j];
            __syncthreads();
            for (int i = F.tid; i < 2048; i += 512) { const int v = i >> 6, l = i & 63; float s = 0.f;
#pragma unroll
                for (int w = 0; w < 8; ++w) s += red[(w * 32 + v) * 64 + l];
                mp[((size_t)ds * 8 + (v >> 2)) * 12288 + cb * 256 + l * 4 + (v & 3)] = s; }
            __syncthreads();
        }
    }
}

template <bool FIRST> __device__ __forceinline__ void phase_modnorm(Frame& F, const float* xin, const float* gain, int off_sh, int off_sc, bf16_t* dst, unsigned char* dst8 = nullptr) {
    F.lane = lane_now(); F.tid = F.wave * 64 + F.lane;
    const float* mp = (const float*)(F.ws + WS_MODP); float* mf = (float*)(F.ws + WS_MODF);
    if (FIRST) {
        for (int i = F.bid * 512 + F.tid; i < 8 * 12288; i += F.G * 512) {
            float s = F.b_ada[i % 12288];
#pragma unroll
            for (int k = 0; k < 4; ++k) s += mp[(size_t)k * 8 * 12288 + i];
            mf[i] = s; }
    }
    float* cA = (float*)F.lds; float* cB = cA + 2048;
    for (int ch = F.bid; ch < MTOK / 128; ch += F.G) {
        const int b = ch / 32;
        __syncthreads();
        for (int col = F.tid; col < 2048; col += 512) {
            float sc, sh;
            if (FIRST) { sc = F.b_ada[off_sc + col]; sh = F.b_ada[off_sh + col];
#pragma unroll
                for (int k = 0; k < 4; ++k) { sc += mp[((size_t)k * 8 + b) * 12288 + off_sc + col]; sh += mp[((size_t)k * 8 + b) * 12288 + off_sh + col]; } }
            else { sc = mf[b * 12288 + off_sc + col]; sh = mf[b * 12288 + off_sh + col]; }
            cA[col] = gain[col] * (1.f + sc); cB[col] = sh; }
        __syncthreads();
        for (int r = F.wave; r < 128; r += 8) {
            const size_t row = (size_t)ch * 128 + r;
            const float* xr = xin + row * 2048 + F.lane * 8;
            f32x4 v[4][2]; float ss = 0.f;
#pragma unroll
            for (int i = 0; i < 4; ++i) { v[i][0] = *(const f32x4*)(xr + i * 512); v[i][1] = *(const f32x4*)(xr + i * 512 + 4);
#pragma unroll
                for (int j = 0; j < 4; ++j) ss += v[i][0][j] * v[i][0][j] + v[i][1][j] * v[i][1][j]; }
            ss = wave_sum(ss);
            const float rinv = 1.0f / sqrtf(ss * (1.0f / 2048.0f) + EPS);
#pragma unroll
            for (int i = 0; i < 4; ++i) { const int col = i * 512 + F.lane * 8;
                const f32x4 a0 = *(const f32x4*)(cA + col), a1 = *(const f32x4*)(cA + col + 4), b0 = *(const f32x4*)(cB + col), b1 = *(const f32x4*)(cB + col + 4);
                const f32x4 y0 = v[i][0] * rinv * a0 + b0, y1 = v[i][1] * rinv * a1 + b1;
                *(u32x4*)(dst + row * 2048 + col) = pack8(y0, y1);
                if (FIRST) *(u32x2*)(dst8 + row * 2048 + col) = pack8_fp8(y0, y1); }
        }
    }
}

__device__ __forceinline__ void phase3_qknorm(Frame& F) {
    F.lane = lane_now(); F.tid = F.wave * 64 + F.lane;
    const bf16_t* q = (const bf16_t*)(F.ws + WS_QN); const bf16_t* k = (const bf16_t*)(F.ws + WS_KN); const bf16_t* v = (const bf16_t*)(F.ws + WS_V);
    unsigned char* q8 = F.ws + WS_Q8; unsigned char* k8 = F.ws + WS_K8; unsigned char* v8 = F.ws + WS_V8;
    const int gw = F.bid * 8 + F.wave, NGW = F.G * 8;
    for (int row = gw; row < MTOK; row += NGW) {
#pragma unroll
        for (int i = 0; i < 2; ++i) { const int ci = i * 64 + F.lane;
            f32x4 a, b; unpack8(*(const u32x4*)(q + (size_t)row * 1024 + ci * 8), a, b);
            float ss = a[0] * a[0] + a[1] * a[1] + a[2] * a[2] + a[3] * a[3] + b[0] * b[0] + b[1] * b[1] + b[2] * b[2] + b[3] * b[3];
            ss = row_sum16(ss);
            const float rinv = 1.0f / sqrtf(ss * (1.0f / 128.0f) + EPS);
            const float* gp = F.g_q + (ci & 15) * 8; const f32x4 g0 = *(const f32x4*)gp, g1 = *(const f32x4*)(gp + 4);
            *(u32x2*)(q8 + (size_t)row * 1024 + ci * 8) = pack8_fp8(a * rinv * g0, b * rinv * g1); }
        { const int ci = F.lane & 31; const bool isk = F.lane < 32;
            f32x4 a, b; unpack8(*(const u32x4*)((isk ? k : v) + (size_t)row * 256 + ci * 8), a, b);
            float ss = a[0] * a[0] + a[1] * a[1] + a[2] * a[2] + a[3] * a[3] + b[0] * b[0] + b[1] * b[1] + b[2] * b[2] + b[3] * b[3];
            ss = row_sum16(ss);
            const float rinv = isk ? 1.0f / sqrtf(ss * (1.0f / 128.0f) + EPS) : 1.0f;
            const float* gp = F.g_k + (ci & 15) * 8; f32x4 g0 = *(const f32x4*)gp, g1 = *(const f32x4*)(gp + 4);
            if (!isk) { g0 = (f32x4){1.f, 1.f, 1.f, 1.f}; g1 = g0; }
            *(u32x2*)((isk ? k8 : v8) + (size_t)row * 256 + ci * 8) = pack8_fp8(a * rinv * g0, b * rinv * g1); }
    }
}
template <int W> __device__ __forceinline__ void pooled_item(const bf16_t* pl, bf16_t* po, int row, int c8) {
    const int t = row & (SEQ - 1);
    f32x4 s0 = (f32x4){0.f, 0.f, 0.f, 0.f}, s1 = s0, x0 = s0, x1 = s0;
    u32x4 v[W];
#pragma unroll
    for (int j = 0; j < W; ++j) v[j] = *(const u32x4*)(pl + (size_t)(row - (j <= t ? j : 0)) * 1024 + c8);
#pragma unroll
    for (int j = 0; j < W; ++j) { f32x4 a, b; unpack8(v[j], a, b); if (j == 0) { x0 = a; x1 = b; } if (j <= t) { s0 += a; s1 += b; } }
    const float inv = 1.0f / (float)((t + 1 < W) ? t + 1 : W);
    *(u32x4*)(po + (size_t)row * 1024 + c8) = pack8(s0 * inv - x0, s1 * inv - x1);
}
__device__ __forceinline__ void phase3_pooled(Frame& F) {
    F.lane = lane_now(); F.tid = F.wave * 64 + F.lane;
    const bf16_t* pl = (const bf16_t*)(F.ws + WS_PL); bf16_t* po = (bf16_t*)(F.ws + WS_POOLED);
    const int gw = F.bid * 8 + F.wave, NGW = F.G * 8;
    for (int it = gw; it < (MTOK / 2) * 4; it += NGW) {
        const int g = it & 3, row = (it >> 2) * 2 + (F.lane >> 5), c8 = g * 256 + (F.lane & 31) * 8;
        if (g == 0) pooled_item<2>(pl, po, row, c8); else if (g == 1) pooled_item<4>(pl, po, row, c8); else if (g == 2) pooled_item<8>(pl, po, row, c8); else pooled_item<16>(pl, po, row, c8);
    }
}
typedef float f32x16 __attribute__((ext_vector_type(16)));
__device__ __forceinline__ float wrelu_(float wh, float d, float acc) { return __builtin_fmaf(wh, d, __builtin_fmaf(wh, __builtin_fabsf(d), acc)); }
__device__ __forceinline__ int sel_code(float s, float smin, float scale) { const float c = (s - smin) * scale; return (int)fminf(fmaxf(c, 0.f), 65535.f); }
__device__ __forceinline__ void hist_find(const unsigned* hist, int lane, int K, int& bsel, int& above) {
    const u32x4 h = *(const u32x4*)(hist + lane * 4);
    const int S = (int)(h.x + h.y + h.z + h.w);
    int x = S;
    x += __builtin_amdgcn_update_dpp(0, x, 0x101, 0xF, 0xF, true);
    x += __builtin_amdgcn_update_dpp(0, x, 0x102, 0xF, 0xF, true);
    x += __builtin_amdgcn_update_dpp(0, x, 0x104, 0xF, 0xF, true);
    x += __builtin_amdgcn_update_dpp(0, x, 0x108, 0xF, 0xF, true);
    const int t1 = __builtin_amdgcn_readlane(x, 16), t2 = __builtin_amdgcn_readlane(x, 32), t3 = __builtin_amdgcn_readlane(x, 48);
    const int r = lane >> 4;
    x += (r == 0 ? t1 + t2 + t3 : (r == 1 ? t2 + t3 : (r == 2 ? t3 : 0)));
    const int sufn = x - S;
    const bool mine = (x >= K) && (sufn < K);
    int b = 0, ab = 0;
    { int c = sufn;
      if (c + (int)h.w >= K) { b = 3; ab = c; } else { c += (int)h.w;
      if (c + (int)h.z >= K) { b = 2; ab = c; } else { c += (int)h.z;
      if (c + (int)h.y >= K) { b = 1; ab = c; } else { c += (int)h.y; b = 0; ab = c; } } } }
    const unsigned long long m = __ballot(mine);
    const int src = m ? (int)__builtin_ctzll(m) : 0;
    bsel = __builtin_amdgcn_readlane(lane * 4 + b, src); above = __builtin_amdgcn_readlane(ab, src);
}
__device__ __forceinline__ int mask_prefix(unsigned long long m) { return (int)__builtin_amdgcn_mbcnt_hi((unsigned)(m >> 32), __builtin_amdgcn_mbcnt_lo((unsigned)m, 0u)); }
template <class Fn> __device__ __forceinline__ void sel_sweep(const f32x4* rb4, int n4, int lane, int t, Fn fn) {
    f32x4 cur = rb4[lane];
    for (int c4 = 0; c4 < n4 - 1; ++c4) { const f32x4 nxt = rb4[(c4 + 1) * 64 + lane];
#pragma unroll
        for (int k = 0; k < 4; ++k) fn(cur[k], (c4 * 4 + k) * 64 + lane, true);
        cur = nxt; }
    { const int c4 = n4 - 1;
#pragma unroll
      for (int k = 0; k < 4; ++k) { const int idx = (c4 * 4 + k) * 64 + lane; fn(cur[k], idx, idx <= t); } }
}
template <int MODE = 0> __device__ __forceinline__ void indexer_select(Frame& F, int b, int t, const float* rowbuf, unsigned* hist, float* eqv, int* eqi) {
    unsigned short* selrow = (unsigned short*)(F.ws + (MODE ? WS_R0 : WS_SEL)) + (size_t)(b * SEQ + t) * 256;
    int lane = F.lane; asm volatile("" : "+v"(lane));
    const int nch = t / 64 + 1, n4 = (nch + 3) >> 2;
    const f32x4* rb4 = (const f32x4*)rowbuf;
    float mn = __builtin_huge_valf(), mx = -__builtin_huge_valf();
    sel_sweep(rb4, n4, lane, t, [&](float v, int, bool valid) { mn = valid ? fminf(mn, v) : mn; mx = valid ? fmaxf(mx, v) : mx; });
    mx = xor16_max(row_max16(mx)); { const auto r = __builtin_amdgcn_permlane32_swap(__float_as_uint(mx), __float_as_uint(mx), false, false); mx = fmaxf(__uint_as_float(r[0]), __uint_as_float(r[1])); }
    mn = -mn; mn = xor16_max(row_max16(mn)); { const auto r = __builtin_amdgcn_permlane32_swap(__float_as_uint(mn), __float_as_uint(mn), false, false); mn = -fmaxf(__uint_as_float(r[0]), __uint_as_float(r[1])); }
    const float scale = (mx > mn) ? 65535.0f / (mx - mn) : 0.f;
    *(u32x4*)(hist + lane * 4) = (u32x4){0u, 0u, 0u, 0u};
    sel_sweep(rb4, n4, lane, t, [&](float v, int, bool valid) { if (valid) { if (MODE == 2) ((volatile unsigned*)hist)[sel_code(v, mn, scale) >> 8] = 1u; else atomicAdd(&hist[sel_code(v, mn, scale) >> 8], 1u); } });
    int b1, above1; hist_find(hist, lane, KSEL, b1, above1);
    *(u32x4*)(hist + lane * 4) = (u32x4){0u, 0u, 0u, 0u};
    sel_sweep(rb4, n4, lane, t, [&](float v, int, bool valid) { const int code = sel_code(v, mn, scale); if (valid && (code >> 8) == b1) atomicAdd(&hist[code & 255], 1u); });
    int b2, above2; hist_find(hist, lane, KSEL - above1, b2, above2);
    const int T16 = (b1 << 8) | b2, need = KSEL - above1 - above2, ceq = (int)hist[b2];
    const bool all_eq = (ceq == need), collect = !all_eq && (ceq <= 64);
    const int eq_budget = all_eq ? 0x7fffffff : (collect ? 0 : need);
    int pos = 0, eqseen = 0;
    sel_sweep(rb4, n4, lane, t, [&](float v, int idx, bool valid) {
        const int code = sel_code(v, mn, scale);
        const bool gt = valid && code > T16, eq = valid && code == T16;
        const unsigned long long mg = __ballot(gt);
        const unsigned p = (unsigned)(pos + mask_prefix(mg));
        if (gt && p < (unsigned)KSEL) selrow[p] = (unsigned short)idx;
        pos += __popcll(mg);
        const unsigned long long me = __ballot(eq);
        if (me) {
            const int er = eqseen + mask_prefix(me); const bool te = eq && er < eq_budget;
            if (collect && eq) { eqv[er] = v; eqi[er] = idx; }
            eqseen += __popcll(me);
            const unsigned long long mte = __ballot(te);
            const unsigned pe = (unsigned)(pos + mask_prefix(mte));
            if (te && pe < (unsigned)KSEL) selrow[pe] = (unsigned short)idx;
            pos += __popcll(mte);
        }
    });
    if (collect && lane < ceq) {
        const float sv = eqv[lane]; const int idx = eqi[lane]; int rank = 0;
        for (int m = 0; m < ceq; ++m) { const float ov = eqv[m]; const int oi = eqi[m]; rank += (ov > sv || (ov == sv && oi < idx)) ? 1 : 0; }
        if (rank < need) selrow[KSEL - need + rank] = (unsigned short)idx;
    }
}
__device__ __forceinline__ void indexer_tile(Frame& F, int b, int t0) {
    const bf16_t* iq = (const bf16_t*)(F.ws + WS_IQ); const bf16_t* ik = (const bf16_t*)(F.ws + WS_IK); const float* iw = (const float*)(F.ws + WS_IW);
    int lane = F.lane; asm volatile("" : "+v"(lane));
    const int w = F.wave;
    if (t0 < KSEL) {
        const int t = t0 + w; unsigned short* selrow = (unsigned short*)(F.ws + WS_SEL) + (size_t)(b * SEQ + t) * 256;
#pragma unroll
        for (int p = 0; p < 4; ++p) { const int j = p * 64 + lane; selrow[j] = (unsigned short)(j <= t ? j : 0xFFFF); }
        return;
    }
    float* rowbuf = (float*)F.lds;
    unsigned char* stage = F.lds + 131072;
    const int p = w & 3, kh = w >> 2, hi = lane >> 5, r = lane & 31;
    const size_t qrow = (size_t)b * SEQ + t0 + 2 * p + (r >> 4);
    bf16x8 a[4];
#pragma unroll
    for (int ks = 0; ks < 4; ++ks) a[ks] = *(const bf16x8*)(iq + qrow * 1024 + (r & 15) * 64 + ks * 16 + 8 * hi);
    float wq[2][8];
#pragma unroll
    for (int q = 0; q < 2; ++q)
#pragma unroll
        for (int i = 0; i < 8; ++i) wq[q][i] = 0.5f * iw[((size_t)b * SEQ + t0 + 2 * p + q) * 16 + (i & 3) + 8 * ((i >> 2) & 1) + 4 * hi];
    const int nchunks = (t0 + 7) / 64 + 1, nsteps = (nchunks + 1) >> 1;
    const unsigned char* gsrc = (const unsigned char*)(ik + (size_t)b * SEQ * 64) + F.tid * 16;
    const int skey = F.tid >> 3, sc16 = F.tid & 7, soff = skey * 128 + ((sc16 ^ ((skey >> 1) & 7)) << 4);
    u32x4 sa0 = *(const u32x4*)gsrc, sb0 = sa0, sa1 = sa0, sb1 = sa0;
    sb0 = *(const u32x4*)(gsrc + (size_t)min(1, nchunks - 1) * 8192);
    sa1 = *(const u32x4*)(gsrc + (size_t)min(2, nchunks - 1) * 8192);
    sb1 = *(const u32x4*)(gsrc + (size_t)min(3, nchunks - 1) * 8192);
    __syncthreads();
#if PROBE_IDX != 1 && PROBE_IDX != 5
#define IDX_LD(c) (*(const u32x4*)(gsrc + (size_t)(c) * 8192))
#endif
#define IDX_MMA(SA, SB, ss, D0, D1) do { const int s_ = (ss); unsigned char* sb = stage + (s_ & 1) * 16384; \
        *(u32x4*)(sb + soff) = SA; *(u32x4*)(sb + 8192 + soff) = SB; \
        __syncthreads(); \
        SA = IDX_LD(min(2 * s_ + 4, nchunks - 1)); \
        SB = IDX_LD(min(2 * s_ + 5, nchunks - 1)); \
        _Pragma("unroll") for (int i = 0; i < 16; ++i) { D0[i] = 0.f; D1[i] = 0.f; } \
        _Pragma("unroll") for (int ks = 0; ks < 4; ++ks) { const unsigned char* bp = sb + key * 128 + (((ks * 2 + hi) ^ ((key >> 1) & 7)) << 4); \
            const bf16x8 bf0 = *(const bf16x8*)bp, bf1 = *(const bf16x8*)(bp + 8192); \
            D0 = __builtin_amdgcn_mfma_f32_32x32x16_bf16(a[ks], bf0, D0, 0, 0, 0); D1 = __builtin_amdgcn_mfma_f32_32x32x16_bf16(a[ks], bf1, D1, 0, 0, 0); } } while (0)
#define IDX_RED(ss, D0, D1) do { const int s_ = (ss); float x0_ = 0.f, x1_ = 0.f, y0_ = 0.f, y1_ = 0.f; \
        _Pragma("unroll") for (int i = 0; i < 8; ++i) { x0_ = wrelu_(wq[0][i], D0[i], x0_); x1_ = wrelu_(wq[1][i], D0[8 + i], x1_); y0_ = wrelu_(wq[0][i], D1[i], y0_); y1_ = wrelu_(wq[1][i], D1[8 + i], y1_); } \
        const float scx = swap32_pair(x0_, x1_), scy = swap32_pair(y0_, y1_); \
        *(f32x2*)(rowbuf + (2 * p + hi) * 4096 + ((s_ >> 1) * 64 + key) * 4 + 2 * (s_ & 1)) = (f32x2){scx, scy}; } while (0)
    const int key = kh * 32 + r;
    f32x16 dA0, dA1, dB0, dB1;
#if PROBE_IDX == 1
#define IDX_LD(c) (*(const u32x4*)(gsrc + (size_t)(c) * 8192))
#elif PROBE_IDX == 5
#define IDX_LD(c) SAVED
#endif
#if PROBE_IDX == 1 || PROBE_IDX == 5
    { const u32x4 SAVED = sa0;
    IDX_MMA(sa0, sb0, 0, dA0, dA1);
    for (int s2 = 0; s2 < nsteps; s2 += 2) {
        if (s2 + 1 < nsteps) IDX_MMA(sa1, sb1, s2 + 1, dB0, dB1);
        IDX_RED(s2, dA0, dA1);
        if (s2 + 2 < nsteps) IDX_MMA(sa0, sb0, s2 + 2, dA0, dA1);
        if (s2 + 1 < nsteps) IDX_RED(s2 + 1, dB0, dB1);
    }
    __syncthreads();
    sa0 = *(const u32x4*)gsrc;
    sb0 = *(const u32x4*)(gsrc + (size_t)min(1, nchunks - 1) * 8192);
    sa1 = *(const u32x4*)(gsrc + (size_t)min(2, nchunks - 1) * 8192);
    sb1 = *(const u32x4*)(gsrc + (size_t)min(3, nchunks - 1) * 8192); }
#undef IDX_LD
#define IDX_LD(c) (*(const u32x4*)(gsrc + (size_t)(c) * 8192))
#endif
    IDX_MMA(sa0, sb0, 0, dA0, dA1);
    for (int s2 = 0; s2 < nsteps; s2 += 2) {
        if (s2 + 1 < nsteps) IDX_MMA(sa1, sb1, s2 + 1, dB0, dB1);
        IDX_RED(s2, dA0, dA1);
        if (s2 + 2 < nsteps) IDX_MMA(sa0, sb0, s2 + 2, dA0, dA1);
        if (s2 + 1 < nsteps) IDX_RED(s2 + 1, dB0, dB1);
    }
#undef IDX_MMA
#undef IDX_RED
#undef IDX_LD
    __syncthreads();
    indexer_select(F, b, t0 + w, rowbuf + w * 4096, (unsigned*)(F.lds + 147456) + w * 256, (float*)(F.lds + 155648) + w * 64, (int*)(F.lds + 155648 + 2048) + w * 64);
#if PROBE_IDX >= 2
    indexer_select<PROBE_IDX - 1>(F, b, t0 + w, rowbuf + w * 4096, (unsigned*)(F.lds + 147456) + w * 256, (float*)(F.lds + 155648) + w * 64, (int*)(F.lds + 155648 + 2048) + w * 64);
#endif
}
__device__ __forceinline__ void phase3_indexer(Frame& F) {
    F.lane = lane_now(); F.tid = F.wave * 64 + F.lane;
    volatile LAS unsigned* misc = (volatile LAS unsigned*)((LAS unsigned char*)F.lds + MISC_OFF);
    const unsigned keep0 = misc[0], keep1 = misc[1];
    __syncthreads();
    const int nit = BATCH * (SEQ / 8);
    for (int k = 0;; ++k) {
        const int l = k * F.G + ((k & 1) ? (F.G - 1 - F.bid) : F.bid);
        if (l >= nit) { if (k * F.G >= nit) break; else continue; }
        const int qb = (SEQ / 8 - 1) - (l >> 3), b = l & 7;
        indexer_tile(F, b, qb * 8);
    }
    __syncthreads();
    if (F.tid == 0) { misc[0] = keep0; misc[1] = keep1; }
}

__device__ const unsigned char g_bucket[128] = {0, 1, 2, 3, 4, 5, 6, 7, 8, 9, 10, 11, 12, 13, 14, 15, 16, 16, 16, 17, 17, 18, 18, 18, 19, 19, 19, 20, 20, 20, 20, 21, 21, 21, 21, 22, 22, 22, 22, 22, 23, 23, 23, 23, 23, 23, 24, 24, 24, 24, 24, 24, 25, 25, 25, 25, 25, 25, 25, 26, 26, 26, 26, 26, 26, 26, 26, 27, 27, 27, 27, 27, 27, 27, 27, 27, 27, 28, 28, 28, 28, 28, 28, 28, 28, 28, 28, 29, 29, 29, 29, 29, 29, 29, 29, 29, 29, 29, 29, 30, 30, 30, 30, 30, 30, 30, 30, 30, 30, 30, 30, 30, 30, 31, 31, 31, 31, 31, 31, 31, 31, 31, 31, 31, 31, 31, 31, 31};
__device__ __forceinline__ void phase4_attention(Frame& F) {
    F.lane = lane_now(); F.tid = F.wave * 64 + F.lane;
    const unsigned char* q8 = F.ws + WS_Q8; const unsigned char* k8 = F.ws + WS_K8; const unsigned char* v8 = F.ws + WS_V8;
    const unsigned short* sel = (const unsigned short*)(F.ws + WS_SEL); bf16_t* ao = (bf16_t*)(F.ws + WS_ATTN);
    float* btab = (float*)F.lds;
    __syncthreads();
    for (int i = F.tid; i < 256; i += 512) btab[i] = F.rel_bias[i];
    __syncthreads();
    float* Pl = (float*)(F.lds + 4096 + F.wave * 12288); int* idl = (int*)(Pl + 2048); float* psl = (float*)(idl + 256);
    const bool xmap = (F.G % 8) == 0;
    const int gw = xmap ? (F.bid / 8) * 8 + F.wave : F.bid * 8 + F.wave, NGW = xmap ? F.G : F.G * 8, nrows = xmap ? SEQ : MTOK;
    for (int rr = gw; rr < nrows; rr += NGW) {
        int lane = F.lane; asm volatile("" : "+v"(lane));
        const int row = xmap ? (F.bid & 7) * SEQ + rr : rr;
        const int b = row / SEQ, t = row % SEQ, r = lane & 31, hi = lane >> 5;
#pragma unroll
        for (int p = 0; p < 4; ++p) { idl[p * 64 + lane] = (int)sel[(size_t)row * 256 + p * 64 + lane]; }
        long a0[8], a1[8];
        { u32x4 qa[4];
#pragma unroll
          for (int i = 0; i < 4; ++i) qa[i] = (r < 8) ? *(const u32x4*)(q8 + (size_t)row * 1024 + r * 128 + hi * 64 + i * 16) : (u32x4){0u, 0u, 0u, 0u};
#pragma unroll
          for (int ks = 0; ks < 8; ++ks) { const unsigned lo = qa[ks >> 1][(ks & 1) * 2], hh = qa[ks >> 1][(ks & 1) * 2 + 1]; const long v = (long)(((unsigned long long)hh << 32) | lo);
              a0[ks] = (r < 4) ? v : 0l; a1[ks] = (r >= 4) ? v : 0l; } }
        f32x4 psum = (f32x4){0.f, 0.f, 0.f, 0.f};
#define AT_LOADK(buf, kb) do { const int key_ = idl[(kb) * 32 + r]; const int kc_ = key_ <= t ? key_ : 0; const unsigned char* kr_ = k8 + ((size_t)b * SEQ + kc_) * 256 + hi * 64; \
            _Pragma("unroll") for (int i = 0; i < 4; ++i) { buf[i] = *(const u32x4*)(kr_ + i * 16); buf[4 + i] = *(const u32x4*)(kr_ + 128 + i * 16); } } while (0)
#define AT_QK(buf, kb) do { const int key_ = idl[(kb) * 32 + r]; const bool valid_ = key_ <= t; const int kc_ = valid_ ? key_ : 0; \
            f32x16 d; _Pragma("unroll") for (int i = 0; i < 16; ++i) d[i] = 0.f; \
            _Pragma("unroll") for (int ks = 0; ks < 8; ++ks) { const long bv_ = (long)(((unsigned long long)buf[ks >> 1][(ks & 1) * 2 + 1] << 32) | buf[ks >> 1][(ks & 1) * 2]); d = __builtin_amdgcn_mfma_f32_32x32x16_fp8_fp8(a0[ks], bv_, d, 0, 0, 0); } \
            _Pragma("unroll") for (int ks = 0; ks < 8; ++ks) { const long bv_ = (long)(((unsigned long long)buf[4 + (ks >> 1)][(ks & 1) * 2 + 1] << 32) | buf[4 + (ks >> 1)][(ks & 1) * 2]); d = __builtin_amdgcn_mfma_f32_32x32x16_fp8_fp8(a1[ks], bv_, d, 0, 0, 0); } \
            const int dist_ = t - kc_; const int bkt_ = dist_ < 128 ? (int)g_bucket[dist_] : 31; \
            const f32x4 bias_ = *(const f32x4*)(btab + bkt_ * 8 + 4 * hi); f32x4 e_; \
            _Pragma("unroll") for (int i = 0; i < 4; ++i) e_[i] = valid_ ? __expf(d[i] * 0.08838834764831845f + bias_[i]) : 0.f; \
            psum += e_; *(f32x4*)(Pl + ((kb) * 32 + r) * 8 + 4 * hi) = e_; } while (0)
        {
            u32x4 kA[8], kB[8];
            AT_LOADK(kA, 0);
#pragma unroll 1
            for (int kb = 0; kb < 8; kb += 2) {
                AT_LOADK(kB, kb + 1);
                AT_QK(kA, kb);
                if (kb + 2 < 8) AT_LOADK(kA, kb + 2);
                AT_QK(kB, kb + 1);
            }
        }
#undef AT_LOADK
#undef AT_QK
#pragma unroll
        for (int i = 0; i < 4; ++i) psum[i] = xor16_sum(row_sum16(psum[i]));
        if (r == 0) *(f32x4*)(psl + 4 * hi) = psum;
        const int ks = lane >> 4, g = (lane >> 3) & 1, dc = lane & 7;
        float acc[4][16];
#pragma unroll
        for (int h = 0; h < 4; ++h)
#pragma unroll
            for (int j = 0; j < 16; ++j) acc[h][j] = 0.f;
#define AT_LOADV(buf, it0) do { _Pragma("unroll") for (int u = 0; u < 4; ++u) { const int key_ = idl[((it0) + u) * 4 + ks]; const int kc_ = key_ <= t ? key_ : 0; \
            buf[u] = *(const u32x4*)(v8 + ((size_t)b * SEQ + kc_) * 256 + g * 128 + dc * 16); } } while (0)
#define AT_PV(buf, it0) do { _Pragma("unroll") for (int u = 0; u < 4; ++u) { const int j_ = ((it0) + u) * 4 + ks; const u32x4 w = buf[u]; \
            const f32x4 p = *(const f32x4*)(Pl + j_ * 8 + 4 * g); \
            _Pragma("unroll") for (int dd = 0; dd < 4; ++dd) { const f32x2 lo = __builtin_amdgcn_cvt_pk_f32_fp8((int)w[dd], false), hh_ = __builtin_amdgcn_cvt_pk_f32_fp8((int)w[dd], true); \
                _Pragma("unroll") for (int h = 0; h < 4; ++h) { acc[h][4 * dd] += p[h] * lo.x; acc[h][4 * dd + 1] += p[h] * lo.y; acc[h][4 * dd + 2] += p[h] * hh_.x; acc[h][4 * dd + 3] += p[h] * hh_.y; } } } } while (0)
        {
            u32x4 vA[4], vB[4];
            AT_LOADV(vA, 0);
#pragma unroll 1
            for (int it0 = 0; it0 < 64; it0 += 8) {
                AT_LOADV(vB, it0 + 4);
                AT_PV(vA, it0);
                if (it0 + 8 < 64) AT_LOADV(vA, it0 + 8);
                AT_PV(vB, it0 + 4);
            }
        }
#undef AT_LOADV
#undef AT_PV
#pragma unroll
        for (int h = 0; h < 4; ++h)
#pragma unroll
            for (int j = 0; j < 16; ++j) acc[h][j] = xor32_sum(xor16_sum(acc[h][j]));
#pragma unroll
        for (int h = 0; h < 4; ++h) if (h == ks) { const float inv = 1.0f / psl[4 * g + h];
            bf16_t* op = ao + (size_t)row * 1024 + (4 * g + h) * 128 + dc * 16;
            *(u32x4*)op = pack8((f32x4){acc[h][0], acc[h][1], acc[h][2], acc[h][3]} * inv, (f32x4){acc[h][4], acc[h][5], acc[h][6], acc[h][7]} * inv);
            *(u32x4*)(op + 8) = pack8((f32x4){acc[h][8], acc[h][9], acc[h][10], acc[h][11]} * inv, (f32x4){acc[h][12], acc[h][13], acc[h][14], acc[h][15]} * inv); }
    }
}

__device__ __forceinline__ float dot16f8(u32x4 w, const float* h) {
    float s = 0.f;
#pragma unroll
    for (int d = 0; d < 4; ++d) { const f32x2 lo = __builtin_amdgcn_cvt_pk_f32_fp8((int)w[d], false), hi = __builtin_amdgcn_cvt_pk_f32_fp8((int)w[d], true);
        s += lo.x * h[4 * d] + lo.y * h[4 * d + 1] + hi.x * h[4 * d + 2] + hi.y * h[4 * d + 3]; }
    return s;
}
__device__ __forceinline__ void fma16f8(u32x4 w, float cf, float* acc) {
#pragma unroll
    for (int d = 0; d < 4; ++d) { const f32x2 lo = __builtin_amdgcn_cvt_pk_f32_fp8((int)w[d], false), hi = __builtin_amdgcn_cvt_pk_f32_fp8((int)w[d], true);
        acc[4 * d] += cf * lo.x; acc[4 * d + 1] += cf * lo.y; acc[4 * d + 2] += cf * hi.x; acc[4 * d + 3] += cf * hi.y; }
}
__device__ __forceinline__ float gelu_erf(float x) { return 0.5f * x * (1.0f + erff(x * 0.70710678118654752f)); }
__device__ __forceinline__ void ce_k(unsigned& a, unsigned& b) { const unsigned hi = a > b ? a : b, lo = a > b ? b : a; a = hi; b = lo; }
__device__ __forceinline__ void ce_kp(unsigned& ka, unsigned& pa, unsigned& kb, unsigned& pb) { const bool sw = kb > ka; const unsigned k0 = sw ? kb : ka, k1 = sw ? ka : kb, p0 = sw ? pb : pa, p1 = sw ? pa : pb; ka = k0; kb = k1; pa = p0; pb = p1; }
__device__ __forceinline__ void bmerge16(unsigned (&x)[16]) {
#pragma unroll
    for (int jj = 0; jj < 4; ++jj) { const int j = 8 >> jj;
#pragma unroll
        for (int i = 0; i < 16; ++i) { const int l = i ^ j; if (l > i) ce_k(x[i], x[l]); }
        __builtin_amdgcn_sched_barrier(0); }
}
__device__ __forceinline__ void bmerge16p(unsigned (&x)[16], unsigned (&p)[16]) {
#pragma unroll
    for (int jj = 0; jj < 4; ++jj) { const int j = 8 >> jj;
#pragma unroll
        for (int i = 0; i < 16; ++i) { const int l = i ^ j; if (l > i) ce_kp(x[i], p[i], x[l], p[l]); }
        __builtin_amdgcn_sched_barrier(0); }
}
__device__ __forceinline__ void bsort16(unsigned (&x)[16]) {
#pragma unroll
    for (int kk = 1; kk <= 4; ++kk) { const int k = 1 << kk;
#pragma unroll
        for (int jj = 0; jj < 4; ++jj) { const int j = (k >> 1) >> jj;
            if (j > 0) {
#pragma unroll
                for (int i = 0; i < 16; ++i) { const int l = i ^ j; if (l > i) { if ((i & k) == 0) ce_k(x[i], x[l]); else ce_k(x[l], x[i]); } }
                __builtin_amdgcn_sched_barrier(0); } } }
}
__device__ __forceinline__ void bsort16p(unsigned (&x)[16], unsigned (&p)[16]) {
#pragma unroll
    for (int kk = 1; kk <= 4; ++kk) { const int k = 1 << kk;
#pragma unroll
        for (int jj = 0; jj < 4; ++jj) { const int j = (k >> 1) >> jj;
            if (j > 0) {
#pragma unroll
                for (int i = 0; i < 16; ++i) { const int l = i ^ j; if (l > i) { if ((i & k) == 0) ce_kp(x[i], p[i], x[l], p[l]); else ce_kp(x[l], p[l], x[i], p[i]); } }
                __builtin_amdgcn_sched_barrier(0); } } }
}
__device__ __forceinline__ void top16_row(const unsigned char* rowp, unsigned (&t)[16]) {
#pragma unroll
    for (int i = 0; i < 16; ++i) t[i] = 0u;
#pragma unroll 1
    for (int g = 0; g < 8; ++g) {
        unsigned w[8];
#pragma unroll
        for (int q = 0; q < 4; ++q) { const u32x2 v = *(const u32x2*)(rowp + g * 32 + q * 8); w[2 * q] = v.x; w[2 * q + 1] = v.y; }
        unsigned sk[16];
#pragma unroll
        for (int d = 0; d < 8; ++d) {
            const unsigned lo = w[d] << 16, hi = w[d];
            const unsigned xl = lo ^ ((unsigned)((int)lo >> 31) | 0x80000000u), xh = hi ^ ((unsigned)((int)hi >> 31) | 0x80000000u);
            sk[2 * d] = ((xl >> 9) & 0xFFFFFF80u) | (unsigned)(127 - (g * 16 + 2 * d));
            sk[2 * d + 1] = ((xh >> 9) & 0xFFFFFF80u) | (unsigned)(127 - (g * 16 + 2 * d + 1)); }
        bsort16(sk);
#pragma unroll
        for (int i = 0; i < 16; ++i) t[i] = t[i] > sk[15 - i] ? t[i] : sk[15 - i];
        bmerge16(t);
    }
}
__device__ __forceinline__ float key_val(unsigned key) { const unsigned y = (key << 9) & 0xFFFF0000u; return __uint_as_float((y ^ (~(unsigned)((int)y >> 31) | 0x80000000u)) & 0xFFFF0000u); }
__device__ __forceinline__ unsigned sum_key(float s, int c) { const unsigned u = __float_as_uint(s); return ((u ^ ((unsigned)((int)u >> 31) | 0x80000000u)) & ~63u) | (unsigned)(63 - c); }
__device__ __forceinline__ float sum_val(unsigned k) { const unsigned y = k & ~63u; return __uint_as_float(y ^ (~(unsigned)((int)y >> 31) | 0x80000000u)); }
typedef __bf16 bf2_t __attribute__((ext_vector_type(2)));
__device__ __forceinline__ float dot2_bf(unsigned a, unsigned b, float c) { return __builtin_amdgcn_fdot2_f32_bf16(__builtin_bit_cast(bf2_t, a), __builtin_bit_cast(bf2_t, b), c, false); }
__device__ __forceinline__ float dot32_f6b(u32x4 wa, u32x2 wb, u32x4 h0, u32x4 h1, u32x4 h2, u32x4 h3) {
    const bf16x32 dec = __builtin_amdgcn_cvt_scalef32_pk32_bf16_fp6((u32x6){wa.x, wa.y, wa.z, wa.w, wb.x, wb.y}, 1.0f);
    const u32x16 ud = __builtin_bit_cast(u32x16, dec);
    float acc = 0.f;
    acc = dot2_bf(ud.s0, h0.x, acc); acc = dot2_bf(ud.s1, h0.y, acc); acc = dot2_bf(ud.s2, h0.z, acc); acc = dot2_bf(ud.s3, h0.w, acc);
    acc = dot2_bf(ud.s4, h1.x, acc); acc = dot2_bf(ud.s5, h1.y, acc); acc = dot2_bf(ud.s6, h1.z, acc); acc = dot2_bf(ud.s7, h1.w, acc);
    acc = dot2_bf(ud.s8, h2.x, acc); acc = dot2_bf(ud.s9, h2.y, acc); acc = dot2_bf(ud.sa, h2.z, acc); acc = dot2_bf(ud.sb, h2.w, acc);
    acc = dot2_bf(ud.sc, h3.x, acc); acc = dot2_bf(ud.sd, h3.y, acc); acc = dot2_bf(ud.se, h3.z, acc); acc = dot2_bf(ud.sf, h3.w, acc);
    return acc;
}
__device__ const unsigned char g_cab[64] = {0, 1, 2, 3, 4, 5, 6, 7, 8, 9, 10, 11, 12, 13, 14, 15, 16, 17, 18, 19, 20, 21, 22, 23, 32, 33, 34, 35, 36, 48, 49, 50, 51, 64, 65, 66, 80, 81, 96, 97, 112, 113, 128, 144, 160, 176, 192, 208, 224, 240, 0, 0, 0, 0, 0, 0, 0, 0, 0, 0, 0, 0, 0, 0};
__device__ __forceinline__ void phase10_peer(Frame& F) {
    F.lane = lane_now(); F.tid = F.wave * 64 + F.lane;
    const bf16_t* sub = (const bf16_t*)(F.ws + WS_SUB); const bf16_t* h2 = (const bf16_t*)(F.ws + WS_H2);
    const unsigned char* pu = F.ws + WS_PU; unsigned* pairs = (unsigned*)(F.ws + WS_PAIRS);
    const int gw = F.bid * 8 + F.wave, NGW = F.G * 8;
    unsigned char* wb = F.lds + F.wave * 19200;
    unsigned char* h2b = wb; unsigned short* gl16 = (unsigned short*)(wb + 16896); unsigned* hist = (unsigned*)(wb + 18944); unsigned* base = hist + 32;
    unsigned* tmp = (unsigned*)wb;
    unsigned* wls0 = (unsigned*)(F.ws + WS_WLS) + (size_t)gw * 1024;
    const int ntok = (MTOK - gw + NGW - 1) / NGW;
    constexpr int CA[50] = {0,0,0,0,0,0,0,0,0,0,0,0,0,0,0,0, 1,1,1,1,1,1,1,1, 2,2,2,2,2, 3,3,3,3, 4,4,4, 5,5, 6,6, 7,7, 8,9,10,11,12,13,14,15};
    constexpr int CB[50] = {0,1,2,3,4,5,6,7,8,9,10,11,12,13,14,15, 0,1,2,3,4,5,6,7, 0,1,2,3,4, 0,1,2,3, 0,1,2, 0,1, 0,1, 0,1, 0,0,0,0,0,0,0,0};
    for (int p0 = 0; p0 < ntok; p0 += 8) {
        int lane = F.lane; asm volatile("" : "+v"(lane));
        const int nt = (ntok - p0) < 8 ? (ntok - p0) : 8;
        {
            u32x4 st[16];
#define SEL_LOAD(half) do { asm volatile("" : "+v"(lane)); const int srow_l = lane >> 4, scol = lane & 15; _Pragma("unroll") for (int it = 0; it < 16; ++it) { const int r_ = it * 4 + srow_l; int ti_ = r_ >> 3; ti_ = ti_ < nt ? ti_ : nt - 1; \
                st[it] = *(const u32x4*)(sub + (size_t)(gw + (p0 + ti_) * NGW) * 2048 + (r_ & 7) * 256 + (half) * 128 + scol * 8); } } while (0)
#define SEL_STORE() do { const int srow_l = lane >> 4, scol = lane & 15; _Pragma("unroll") for (int it = 0; it < 16; ++it) { unsigned char* d_ = wb + (it * 4 + srow_l) * 264 + scol * 16; \
                *(u32x2*)d_ = (u32x2){st[it].x, st[it].y}; *(u32x2*)(d_ + 8) = (u32x2){st[it].z, st[it].w}; } } while (0)
            unsigned tA[16], tB[16];
            SEL_LOAD(0); SEL_STORE();
            __builtin_amdgcn_sched_barrier(0);
            top16_row(wb + lane * 264, tA);
            __builtin_amdgcn_sched_barrier(0);
            asm volatile("" : "+v"(tA[0]), "+v"(tA[1]), "+v"(tA[2]), "+v"(tA[3]), "+v"(tA[4]), "+v"(tA[5]), "+v"(tA[6]), "+v"(tA[7]), "+v"(tA[8]), "+v"(tA[9]), "+v"(tA[10]), "+v"(tA[11]), "+v"(tA[12]), "+v"(tA[13]), "+v"(tA[14]), "+v"(tA[15]) :: "memory");
            SEL_LOAD(1); SEL_STORE();
            __builtin_amdgcn_sched_barrier(0);
            top16_row(wb + lane * 264, tB);
            __builtin_amdgcn_sched_barrier(0);
#undef SEL_LOAD
#undef SEL_STORE
            float vA[16], vB[16];
            { unsigned pa[4] = {0u, 0u, 0u, 0u}, pb[4] = {0u, 0u, 0u, 0u};
#pragma unroll
              for (int i = 0; i < 16; ++i) { vA[i] = key_val(tA[i]); vB[i] = key_val(tB[i]); pa[i >> 2] |= (127u - (tA[i] & 127u)) << (8 * (i & 3)); pb[i >> 2] |= (127u - (tB[i] & 127u)) << (8 * (i & 3)); }
              unsigned char* rp = wb + lane * 264;
              *(u32x2*)rp = (u32x2){pa[0], pa[1]}; *(u32x2*)(rp + 8) = (u32x2){pa[2], pa[3]}; *(u32x2*)(rp + 16) = (u32x2){pb[0], pb[1]}; *(u32x2*)(rp + 24) = (u32x2){pb[2], pb[3]}; }
            unsigned tk[16];
#pragma unroll
            for (int c = 0; c < 16; ++c) tk[c] = sum_key(vA[CA[c]] + vB[CB[c]], c);
            bsort16(tk);
#pragma unroll
            for (int grp = 1; grp < 3; ++grp) {
                unsigned sk[16];
#pragma unroll
                for (int e = 0; e < 16; ++e) { const int c = grp * 16 + e; sk[e] = sum_key(vA[CA[c]] + vB[CB[c]], c); }
                bsort16(sk);
#pragma unroll
                for (int i = 0; i < 16; ++i) tk[i] = tk[i] > sk[15 - i] ? tk[i] : sk[15 - i];
                bmerge16(tk);
            }
#pragma unroll
            for (int c = 48; c < 50; ++c) { unsigned k = sum_key(vA[CA[c]] + vB[CB[c]], c);
#pragma unroll
                for (int i = 0; i < 16; ++i) ce_k(tk[i], k); }
            const float s0 = sum_val(tk[0]); float ev[16], esum = 0.f;
#pragma unroll
            for (int r = 0; r < 16; ++r) { ev[r] = __expf(sum_val(tk[r]) - s0); esum += ev[r]; }
            const float einv = 1.0f / esum;
            unsigned eid[16];
            { const unsigned char* rp = wb + lane * 264;
#pragma unroll
              for (int r = 0; r < 16; ++r) { const unsigned cab = g_cab[63u - (tk[r] & 63u)]; eid[r] = (unsigned)rp[cab >> 4] * 128u + (unsigned)rp[16 + (cab & 15u)]; } }
            if ((lane >> 3) < nt) {
#pragma unroll
                for (int r = 0; r < 16; ++r) { const int e = lane * 16 + r; tmp[e] = ((unsigned)e << 14) | eid[r]; gl16[e] = (unsigned short)(cvt_pk_bf16(ev[r] * einv, 0.f) & 0xffffu); } }
        }
        asm volatile("" : "+v"(lane));
#pragma unroll 1
        for (int grp = 0; grp < 2; ++grp) {
            const int ng = nt - grp * 4; const int ne = (ng <= 0 ? 0 : (ng < 4 ? ng : 4)) * 128;
            if (ne == 0) break;
            unsigned* wls = wls0 + grp * 512;
            if (lane < 32) hist[lane] = 0u;
            unsigned ent[8]; unsigned rk[8];
#pragma unroll
            for (int q = 0; q < 8; ++q) { const int e = q * 64 + lane; ent[q] = (e < ne) ? tmp[grp * 512 + e] : 0u; rk[q] = (e < ne) ? atomicAdd(&hist[(ent[q] & 0x3FFFu) >> 9], 1u) : 0u; }
            { int hv = lane < 32 ? (int)hist[lane] : 0; int x = hv;
              x += __builtin_amdgcn_update_dpp(0, x, 0x111, 0xF, 0xF, true); x += __builtin_amdgcn_update_dpp(0, x, 0x112, 0xF, 0xF, true);
              x += __builtin_amdgcn_update_dpp(0, x, 0x114, 0xF, 0xF, true); x += __builtin_amdgcn_update_dpp(0, x, 0x118, 0xF, 0xF, true);
              const int t0 = __builtin_amdgcn_readlane(x, 15); if (lane >= 16) x += t0;
              if (lane < 32) base[lane] = (unsigned)(x - hv); }
#pragma unroll
            for (int q = 0; q < 8; ++q) { const int e = q * 64 + lane; if (e < ne) wls[base[(ent[q] & 0x3FFFu) >> 9] + rk[q]] = ent[q]; }
        }
        asm volatile("s_waitcnt vmcnt(0)" ::: "memory");
#pragma unroll 1
        for (int grp = 0; grp < 2; ++grp) {
            const int ng = nt - grp * 4; const int ngc = ng <= 0 ? 0 : (ng < 4 ? ng : 4), ne = ngc * 128;
            if (ne == 0) break;
            const unsigned* wls = wls0 + grp * 512;
            asm volatile("" : "+v"(lane));
#pragma unroll 1
            for (int i = 0; i < ngc; ++i) { const bf16_t* hr = h2 + (size_t)(gw + (p0 + grp * 4 + i) * NGW) * 2048 + lane * 32;
#pragma unroll
                for (int q = 0; q < 4; ++q) *(u32x4*)(h2b + i * 4096 + q * 1024 + lane * 16) = *(const u32x4*)(hr + q * 8); }
            unsigned entn = __hip_atomic_load(wls + lane, __ATOMIC_RELAXED, __HIP_MEMORY_SCOPE_AGENT);
#pragma unroll 1
            for (int c = 0; c < ne; c += 64) {
                const unsigned ent64 = entn;
                if (c + 64 < ne) entn = __hip_atomic_load(wls + c + 64 + lane, __ATOMIC_RELAXED, __HIP_MEMORY_SCOPE_AGENT);
#pragma unroll 1
                for (int i0 = 0; i0 < 64; i0 += 8) {
                    u32x4 wA[8]; u32x2 wB[8]; unsigned en[8];
#pragma unroll
                    for (int jj = 0; jj < 8; ++jj) { en[jj] = (unsigned)__builtin_amdgcn_readlane((int)ent64, i0 + jj); const unsigned char* ur = pu + (size_t)(en[jj] & 0x3FFFu) * 1536 + lane * 24;
                        const u32x2 t0 = *(const u32x2*)ur, t1 = *(const u32x2*)(ur + 8); wA[jj] = (u32x4){t0.x, t0.y, t1.x, t1.y}; wB[jj] = *(const u32x2*)(ur + 16); }
                    float pr[8];
#pragma unroll
                    for (int jj = 0; jj < 8; ++jj) { const unsigned char* hp = h2b + ((en[jj] >> 21) & 3u) * 4096 + lane * 16;
                        pr[jj] = dot32_f6b(wA[jj], wB[jj], *(const u32x4*)hp, *(const u32x4*)(hp + 1024), *(const u32x4*)(hp + 2048), *(const u32x4*)(hp + 3072)); __builtin_amdgcn_sched_barrier(0); }
#pragma unroll
                    for (int i = 0; i < 4; ++i) pr[i] = swap32_pair(pr[i], pr[i + 4]);
#pragma unroll
                    for (int i = 0; i < 2; ++i) pr[i] = swap16_pair(pr[i], pr[i + 2]);
                    const bool b3 = (lane & 8) != 0;
                    { const float snd = b3 ? pr[0] : pr[1], kp = b3 ? pr[1] : pr[0]; pr[0] = kp + dpp_f<DPP_ROR8>(snd); }
                    float tot = pr[0]; tot += dpp_f<DPP_XOR1>(tot); tot += dpp_f<DPP_XOR2>(tot); tot += dpp_f<DPP_HMIRROR>(tot);
                    const unsigned em = (unsigned)__shfl((int)ent64, i0 + (lane >> 3));
                    if ((lane & 7) == 0) {
                        const int ti = (int)(em >> 21), j = (int)((em >> 14) & 127u), row = gw + (p0 + ti) * NGW;
                        const float cf = gelu_erf(tot * (1.0f / 96.0f)) * __uint_as_float((unsigned)gl16[(em >> 14) & 1023u] << 16);
                        pairs[((size_t)(row >> 6) * 128 + j) * 64 + (row & 63)] = ((unsigned)__builtin_bit_cast(unsigned short, (_Float16)cf) << 16) | (em & 0x3FFFu);
                    }
                }
            }
        }
    }
}

__device__ __forceinline__ void phase11_peer_v(Frame& F, float* dst) {
    F.lane = lane_now(); F.tid = F.wave * 64 + F.lane;
    const unsigned* pairs = (const unsigned*)(F.ws + WS_PAIRS); const float* mf = (const float*)(F.ws + WS_MODF);
    unsigned long long* vs = (unsigned long long*)F.lds;
    for (int c = F.bid; c < DM / 8; c += F.G) {
        __syncthreads();
        { const u32x4* src = (const u32x4*)(F.ws + WS_PV + (size_t)c * NEXP * 8); u32x4* dst = (u32x4*)F.lds;
#pragma unroll 4
          for (int i = F.tid; i < NEXP * 8 / 16; i += 512) dst[i] = src[i]; }
        __syncthreads();
        for (int tile = F.wave; tile < MTOK / 64; tile += 8) {
            int lane = F.lane; asm volatile("" : "+v"(lane));
            const unsigned* pp = pairs + (size_t)tile * 128 * 64 + lane;
            const int row = tile * 64 + lane;
            const float* gt2 = mf + (size_t)(tile / (SEQ / 64)) * 12288 + 10240 + c * 8;
            const float* ip = F.out + (size_t)row * 2048 + c * 8; float* op = dst + (size_t)row * 2048 + c * 8;
            const f32x4 x0 = *(const f32x4*)ip, x1 = *(const f32x4*)(ip + 4), g0 = *(const f32x4*)gt2 * 0.25f, g1 = *(const f32x4*)(gt2 + 4) * 0.25f;
            typedef __fp16 h2_t __attribute__((__vector_size__(2 * sizeof(__fp16))));
            h2_t acc[4];
#pragma unroll
            for (int i = 0; i < 4; ++i) acc[i] = (h2_t){(__fp16)0.f, (__fp16)0.f};
#define P11_LOAD(dst, j0) do { _Pragma("unroll") for (int jj = 0; jj < 16; ++jj) dst[jj] = pp[((j0) + jj) * 64]; } while (0)
#define P11_COMP(src) do { _Pragma("unroll") for (int jj = 0; jj < 16; ++jj) { const unsigned long long v = vs[src[jj] & 0x3FFFu]; \
                    const h2_t cf = __builtin_bit_cast(h2_t, __builtin_amdgcn_perm(src[jj], src[jj], 0x03020302u)); \
                    const int lo = (int)(unsigned)v, hi = (int)(unsigned)(v >> 32); \
                    acc[0] = __builtin_elementwise_fma(__builtin_amdgcn_cvt_scalef32_pk_f16_fp8(lo, 1.0f, false), cf, acc[0]); acc[1] = __builtin_elementwise_fma(__builtin_amdgcn_cvt_scalef32_pk_f16_fp8(lo, 1.0f, true), cf, acc[1]); \
                    acc[2] = __builtin_elementwise_fma(__builtin_amdgcn_cvt_scalef32_pk_f16_fp8(hi, 1.0f, false), cf, acc[2]); acc[3] = __builtin_elementwise_fma(__builtin_amdgcn_cvt_scalef32_pk_f16_fp8(hi, 1.0f, true), cf, acc[3]); } } while (0)
            unsigned pa[16], pb[16];
            P11_LOAD(pa, 0);
#pragma unroll 1
            for (int j0 = 0; j0 < 128; j0 += 32) {
                P11_LOAD(pb, j0 + 16);
                P11_COMP(pa);
                if (j0 + 32 < 128) P11_LOAD(pa, j0 + 32);
                P11_COMP(pb);
            }
#if PROBE_P11X == 1
            { h2_t sv[4]; for (int i = 0; i < 4; ++i) sv[i] = acc[i];
#pragma unroll 1
              for (int j0 = 0; j0 < 128; j0 += 32) {
#pragma unroll
                for (int jj = 0; jj < 16; ++jj) { asm volatile("" : "+v"(pa[jj])); asm volatile("" : "+v"(pb[jj])); }
                P11_COMP(pa); P11_COMP(pb); }
              asm volatile("" :: "v"(acc[0]), "v"(acc[1]), "v"(acc[2]), "v"(acc[3])); for (int i = 0; i < 4; ++i) acc[i] = sv[i]; }
#elif PROBE_P11X == 2
            { P11_LOAD(pa, 0);
#pragma unroll 1
              for (int j0 = 0; j0 < 128; j0 += 32) {
                P11_LOAD(pb, j0 + 16);
#pragma unroll
                for (int jj = 0; jj < 16; ++jj) asm volatile("" :: "v"(pa[jj]));
                if (j0 + 32 < 128) P11_LOAD(pa, j0 + 32);
#pragma unroll
                for (int jj = 0; jj < 16; ++jj) asm volatile("" :: "v"(pb[jj]));
              } }
#endif
#undef P11_LOAD
#undef P11_COMP
            *(f32x4*)op = x0 + g0 * (f32x4){(float)acc[0][0], (float)acc[0][1], (float)acc[1][0], (float)acc[1][1]};
            *(f32x4*)(op + 4) = x1 + g1 * (f32x4){(float)acc[2][0], (float)acc[2][1], (float)acc[3][0], (float)acc[3][1]};
        }
    }
}

__global__ void __launch_bounds__(512, 2) fwd_kernel(Args args) {
    extern __shared__ __attribute__((aligned(16))) unsigned char lds[];
    Frame F;
    F.lds = lds; F.ws = args.ws; F.tid = threadIdx.x; F.lane = F.tid & 63; F.wave = __builtin_amdgcn_readfirstlane(F.tid >> 6); F.G = gridDim.x; F.bid = blockIdx.x;
    F.x = args.in[0]; F.c = args.in[1]; F.w_ada = args.in[2]; F.b_ada = args.in[3]; F.g1 = args.in[4]; F.g2 = args.in[5]; F.w_in = args.in[6]; F.g_q = args.in[7]; F.g_k = args.in[8];
    F.rel_bias = args.in[9]; F.pool_w = args.in[10]; F.pool_scale = args.in[11]; F.w_ab = args.in[12]; F.w_pb = args.in[13]; F.w_out = args.in[14]; F.w_pq = args.in[15];
    F.peer_keys = args.in[16]; F.peer_u = args.in[17]; F.peer_v = args.in[18]; F.out = args.out;
    LAS unsigned char* ldsl = (LAS unsigned char*)lds;
    volatile LAS unsigned* misc = (volatile LAS unsigned*)(ldsl + MISC_OFF);
    if (F.tid < 4) misc[F.tid] = 0u;
    __syncthreads();
    unsigned* barw = (unsigned*)(args.ws + WS_CTL) + (size_t)args.li * XCD_BAR_WORDS;
    XcdBarrier bar; bar.bar = barw; bar.x = 0; bar.st = misc;
    const int lo = args.ph_lo, hi = args.ph_hi;
    if (hi - lo > 1) bar = xcd_barrier_post(barw, misc);
#define IN(k) (lo <= (k) && (k) < hi)
#define SEAM(k) do { if (IN(k) && IN((k) + 1)) xcd_barrier(bar, F.wave); } while (0)
    bf16_t* R0 = (bf16_t*)(F.ws + WS_R0);

#define PH2_BODY { \
        { pg8::Gemm g{(const bf16_t*)(F.ws + WS_H1F8), (const bf16_t*)(F.ws + WS_WIN8), MTOK, 5632, DM / 2, DM / 2, 0, nullptr, nullptr, 0, 0}; pg8::StaticOrder S; S.init(MTOK, 5632, F.G, F.bid); \
          EpiInproj<true> E{(bf16_t*)(F.ws + WS_QN), (bf16_t*)(F.ws + WS_KN), (bf16_t*)(F.ws + WS_V), (bf16_t*)(F.ws + WS_IQ), (bf16_t*)(F.ws + WS_IK), (bf16_t*)(F.ws + WS_PL), \
                    (bf16_t*)(F.ws + WS_GA), (bf16_t*)(F.ws + WS_GP), (float*)(F.ws + WS_IW)}; \
          pg8::gemm_phase<EpiInproj<true>, true>(ldsl, g, S, E, F.wave); } \
        { pg8::Gemm g{R0, (const bf16_t*)(F.ws + WS_WIN16), MTOK, 2304, DM, DM, 0, nullptr, nullptr, 0, 0}; pg8::StaticOrder S; S.init(MTOK, 2304, F.G, F.bid); \
          EpiInproj<false> E{(bf16_t*)(F.ws + WS_QN), (bf16_t*)(F.ws + WS_KN), (bf16_t*)(F.ws + WS_V), (bf16_t*)(F.ws + WS_IQ), (bf16_t*)(F.ws + WS_IK), (bf16_t*)(F.ws + WS_PL), \
                    (bf16_t*)(F.ws + WS_GA), (bf16_t*)(F.ws + WS_GP), (float*)(F.ws + WS_IW)}; \
          pg8::gemm_phase<EpiInproj<false>>(ldsl, g, S, E, F.wave); } }
#define PH3_BODY { phase3_pooled(F); phase3_indexer(F); __syncthreads(); }
#define PH4_BODY { \
        phase4_attention(F); \
        __syncthreads(); \
        pg8::Gemm g{(const bf16_t*)(F.ws + WS_POOLED), (const bf16_t*)(F.ws + WS_POOLW), MTOK, PW, 256, 1024, 256, nullptr, nullptr, 0, 0}; pg8::StaticOrder S; S.init(MTOK, PW, F.G, F.bid); \
        EpiBf16Scale E{(bf16_t*)(F.ws + WS_POOL2), 1024, F.pool_scale}; \
        pg8::gemm_phase<EpiBf16Scale>(ldsl, g, S, E, F.wave); }
#define PH5_BODY { \
        pg8::Gemm g{(const bf16_t*)(F.ws + WS_ATTN), (const bf16_t*)(F.ws + WS_WAB), MTOK, DM, 2048, 1024, 0, (const bf16_t*)(F.ws + WS_POOL2), (const bf16_t*)(F.ws + WS_WPB), 16, 1024}; \
        pg8::StaticOrder S; S.init(MTOK, DM, F.G, F.bid); \
        EpiMerge E{(unsigned char*)R0, (const bf16_t*)(F.ws + WS_GA), (const bf16_t*)(F.ws + WS_GP)}; pg8::gemm_phase<EpiMerge>(ldsl, g, S, E, F.wave); }
#define PH6_BODY { \
        pg8::Gemm g{R0, (const bf16_t*)(F.ws + WS_WOUT), MTOK, DM, DM / 2, DM / 2, 0, nullptr, nullptr, 0, 0}; pg8::StaticOrder S; S.init(MTOK, DM, F.G, F.bid); \
        EpiResid E{F.x, F.out, (const float*)(F.ws + WS_MODF) + 4096}; pg8::gemm_phase<EpiResid, true>(ldsl, g, S, E, F.wave); }
#define PH8_BODY { \
        pg8::Gemm g{(const bf16_t*)(F.ws + WS_H2), (const bf16_t*)(F.ws + WS_WPQ), MTOK, DM, DM, DM, 0, nullptr, nullptr, 0, 0}; pg8::StaticOrder S; S.init(MTOK, DM, F.G, F.bid); \
        EpiBf16Scale E{R0, 2048, nullptr}; pg8::gemm_phase<EpiBf16Scale>(ldsl, g, S, E, F.wave); }
#define PH9_BODY { \
        pg8::Gemm g{R0, (const bf16_t*)(F.ws + WS_KEYSBD), MTOK, DM, 256, DM, 256, nullptr, nullptr, 0, 0}; pg8::StaticOrder S; S.init(MTOK, DM, F.G, F.bid); \
        EpiBf16Scale E{(bf16_t*)(F.ws + WS_SUB), 2048, nullptr}; pg8::gemm_phase<EpiBf16Scale>(ldsl, g, S, E, F.wave); }
#define REP(k) if constexpr (((PROBE_REP) >> (k)) & 1)

    if (IN(0)) { phase0_prep(F); REP(0) { __syncthreads(); phase0_prep(F); } }
    SEAM(0);
    if (IN(1)) { phase_modnorm<true>(F, F.x, F.g1, 0, 2048, R0, F.ws + WS_H1F8); REP(1) { phase_modnorm<true>(F, F.x, F.g1, 0, 2048, R0, F.ws + WS_H1F8); } }
    SEAM(1);
    if (IN(2)) { PH2_BODY REP(2) PH2_BODY }
    SEAM(2);
    if (IN(3)) { phase3_qknorm(F); PH3_BODY REP(3) PH3_BODY }
    SEAM(3);
    if (IN(4)) { PH4_BODY REP(4) PH4_BODY }
    SEAM(4);
    if (IN(5)) { PH5_BODY REP(5) PH5_BODY }
    SEAM(5);
    if (IN(6)) { PH6_BODY REP(6) PH6_BODY }
    SEAM(6);
    if (IN(7)) { phase_modnorm<false>(F, F.out, F.g2, 6144, 8192, (bf16_t*)(F.ws + WS_H2)); REP(7) { phase_modnorm<false>(F, F.out, F.g2, 6144, 8192, (bf16_t*)(F.ws + WS_H2)); } }
    SEAM(7);
    if (IN(8)) { PH8_BODY REP(8) PH8_BODY }
    SEAM(8);
    if (IN(9)) { PH9_BODY REP(9) PH9_BODY }
    SEAM(9);
    if (IN(10)) { phase10_peer(F); REP(10) phase10_peer(F); }
    SEAM(10);
    if (IN(11)) { REP(11) { phase11_peer_v(F, (float*)(F.ws + WS_SUB)); } phase11_peer_v(F, F.out); }
#undef IN
#undef SEAM
}

extern "C" void kernel_launch(void* const* d_in, const int* in_sizes, int n_in, void* d_out, int out_size, void* d_ws, size_t ws_size, hipStream_t stream) {
    static int grid = 0;
    if (grid == 0) {
        if (n_in != 19 || out_size != MTOK * DM || ws_size < WS_END) { fprintf(stderr, "kernel_launch: unexpected shapes (n_in %d out %d ws %zu)\n", n_in, out_size, ws_size); grid = -1; return; }
        int dev = 0, cus = 0, per_cu = 0;
        if (hipGetDevice(&dev) != hipSuccess || hipDeviceGetAttribute(&cus, hipDeviceAttributeMultiprocessorCount, dev) != hipSuccess) { grid = -1; return; }
        if (hipFuncSetAttribute((const void*)fwd_kernel, hipFuncAttributeMaxDynamicSharedMemorySize, LDS_BYTES) != hipSuccess) { fprintf(stderr, "kernel_launch: hipFuncSetAttribute failed\n"); grid = -1; return; }
        if (hipOccupancyMaxActiveBlocksPerMultiprocessor(&per_cu, (const void*)fwd_kernel, 512, LDS_BYTES) != hipSuccess || per_cu < 1) { fprintf(stderr, "kernel_launch: occupancy query says %d\n", per_cu); }
        (void)hipGetLastError();
        grid = cus;
    }
    if (grid < 0) return;
    (void)in_sizes;
    if (hipMemsetAsync((char*)d_ws + WS_CTL, 0, CTL_ZERO_BYTES, stream) != hipSuccess) return;
    Args a{};
    for (int i = 0; i < 19; ++i) a.in[i] = (const float*)d_in[i];
    a.out = (float*)d_out; a.ws = (unsigned char*)d_ws;
#if MK_PER_PHASE
    for (int p = 0; p < NPHASE; ++p) { a.ph_lo = p; a.ph_hi = p + 1; a.li = p; hipLaunchKernelGGL(fwd_kernel, dim3(grid), dim3(512), LDS_BYTES, stream, a); }
#else
    a.ph_lo = 0; a.ph_hi = NPHASE; a.li = 0;
    hipLaunchKernelGGL(fwd_kernel, dim3(grid), dim3(512), LDS_BYTES, stream, a);
#endif
}
```

```cpp
#include <hip/hip_runtime.h>
#include <cstdio>
#include <cstdint>

#ifndef MK_PER_PHASE
#define MK_PER_PHASE 0
#endif

#ifndef PROBE_REP
#define PROBE_REP 0
#endif
#ifndef PROBE_IDX
#define PROBE_IDX 0
#endif
#ifndef PROBE_P11X
#define PROBE_P11X 0
#endif
#define LAS __attribute__((address_space(3)))
typedef unsigned short bf16_t;
typedef short bf16x8 __attribute__((ext_vector_type(8)));
typedef float f32x4 __attribute__((ext_vector_type(4)));
typedef float f32x2 __attribute__((ext_vector_type(2)));
typedef int v2i __attribute__((ext_vector_type(2)));
typedef unsigned u32x4 __attribute__((ext_vector_type(4)));
typedef unsigned u32x2 __attribute__((ext_vector_type(2)));
typedef unsigned u32x6 __attribute__((ext_vector_type(6)));
typedef unsigned u32x16 __attribute__((ext_vector_type(16)));
typedef __bf16 bf16x32 __attribute__((ext_vector_type(32)));

constexpr int BATCH = 8, SEQ = 4096, DM = 2048, MTOK = BATCH * SEQ;
constexpr int NHEAD = 8, HDIM = 128, AW = 1024, KVW = 256, IHEADS = 16, IDIM = 64, KSEL = 256;
constexpr int PW = 1024, PHEADS = 8, NEXP = 16384;
constexpr int INW = 7760;
constexpr float EPS = 1e-6f;
constexpr int NPHASE = 12;

constexpr size_t MiB = 1u << 20;
constexpr size_t WS_CTL = 0, CTL_ZERO_BYTES = 256 * 1024;
constexpr size_t WS_MODP = 2 * MiB;
constexpr size_t WS_MODF = 4 * MiB;
constexpr size_t WS_POOLW = 5 * MiB;
constexpr size_t WS_KEYSBD = 6 * MiB;
constexpr size_t WS_WIN16 = 8 * MiB;
constexpr size_t WS_WIN8 = 20 * MiB;
constexpr size_t WS_WAB = 40 * MiB, WS_WPB = 44 * MiB, WS_WOUT = 48 * MiB, WS_WPQ = 56 * MiB;
constexpr size_t WS_PU = 64 * MiB, WS_PV = 128 * MiB;
constexpr size_t WS_R0 = 192 * MiB;
constexpr size_t WS_GA = 320 * MiB, WS_GP = 448 * MiB;
constexpr size_t WS_SUB = 320 * MiB;
constexpr size_t WS_QN = 576 * MiB;
constexpr size_t WS_IQ = 640 * MiB;
constexpr size_t WS_PL = 704 * MiB;
constexpr size_t WS_KN = 768 * MiB, WS_V = 784 * MiB;
constexpr size_t WS_IK = 800 * MiB;
constexpr size_t WS_IW = 804 * MiB;
constexpr size_t WS_SEL = 806 * MiB;
constexpr size_t WS_POOLED = 822 * MiB;
constexpr size_t WS_H2 = 886 * MiB;
constexpr size_t WS_END = 1014 * MiB;
constexpr size_t WS_H1F8 = WS_H2 + 64 * MiB;
constexpr size_t WS_Q8 = WS_H2, WS_K8 = WS_H2 + 32 * MiB, WS_V8 = WS_H2 + 40 * MiB;
constexpr size_t WS_ATTN = WS_IQ, WS_POOL2 = WS_PL, WS_PAIRS = WS_QN, WS_WLS = WS_QN + 32 * MiB;

constexpr int LDS_BYTES = 160 * 1024;
constexpr int MISC_OFF = 159 * 1024;

__device__ __forceinline__ unsigned cvt_pk_bf16(float lo, float hi) { unsigned r; asm volatile("v_cvt_pk_bf16_f32 %0, %1, %2" : "=v"(r) : "v"(lo), "v"(hi)); return r; }
__device__ __forceinline__ float bf_lo(unsigned w) { return __uint_as_float(w << 16); }
__device__ __forceinline__ float bf_hi(unsigned w) { return __uint_as_float(w & 0xffff0000u); }
template <int CTRL> __device__ __forceinline__ float dpp_f(float x) { return __int_as_float(__builtin_amdgcn_update_dpp(0, __float_as_int(x), CTRL, 0xF, 0xF, true)); }
#define DPP_XOR1 0xB1
#define DPP_XOR2 0x4E
#define DPP_HMIRROR 0x141
#define DPP_MIRROR 0x140
#define DPP_ROR8 0x128
__device__ __forceinline__ float xor16_sum(float x) { const auto r = __builtin_amdgcn_permlane16_swap(__float_as_uint(x), __float_as_uint(x), false, false); return __uint_as_float(r[0]) + __uint_as_float(r[1]); }
__device__ __forceinline__ float xor32_sum(float x) { const auto r = __builtin_amdgcn_permlane32_swap(__float_as_uint(x), __float_as_uint(x), false, false); return __uint_as_float(r[0]) + __uint_as_float(r[1]); }
__device__ __forceinline__ float xor16_max(float x) { const auto r = __builtin_amdgcn_permlane16_swap(__float_as_uint(x), __float_as_uint(x), false, false); return fmaxf(__uint_as_float(r[0]), __uint_as_float(r[1])); }
__device__ __forceinline__ float swap32_pair(float a, float b) { const auto r = __builtin_amdgcn_permlane32_swap(__float_as_uint(a), __float_as_uint(b), false, false); return __uint_as_float(r[0]) + __uint_as_float(r[1]); }
__device__ __forceinline__ float swap16_pair(float a, float b) { const auto r = __builtin_amdgcn_permlane16_swap(__float_as_uint(a), __float_as_uint(b), false, false); return __uint_as_float(r[0]) + __uint_as_float(r[1]); }
__device__ __forceinline__ float row_sum16(float v) { v += dpp_f<DPP_XOR1>(v); v += dpp_f<DPP_XOR2>(v); v += dpp_f<DPP_HMIRROR>(v); v += dpp_f<DPP_MIRROR>(v); return v; }
__device__ __forceinline__ float row_max16(float v) { v = fmaxf(v, dpp_f<DPP_XOR1>(v)); v = fmaxf(v, dpp_f<DPP_XOR2>(v)); v = fmaxf(v, dpp_f<DPP_HMIRROR>(v)); v = fmaxf(v, dpp_f<DPP_MIRROR>(v)); return v; }
__device__ __forceinline__ float wave_sum(float v) { return xor32_sum(xor16_sum(row_sum16(v))); }
__device__ __forceinline__ float sigmoidf_(float x) { return __builtin_amdgcn_rcpf(1.0f + __expf(-x)); }
__device__ __forceinline__ float dot8(u32x4 w, const float* h) {
    return bf_lo(w.x) * h[0] + bf_hi(w.x) * h[1] + bf_lo(w.y) * h[2] + bf_hi(w.y) * h[3] + bf_lo(w.z) * h[4] + bf_hi(w.z) * h[5] + bf_lo(w.w) * h[6] + bf_hi(w.w) * h[7];
}

__device__ __forceinline__ int lane_now() { int l; asm volatile("v_mbcnt_lo_u32_b32 %0, -1, 0\n\tv_mbcnt_hi_u32_b32 %0, -1, %0" : "=v"(l)); return l; }

#define XB_TMO      128
#define XB_XCNT(j)  (256  + 64 * (j))
#define XB_XSUB(j)  (1280 + 64 * (j))
#define XB_XGEN(j)  (2304 + 64 * (j))
#define XB_TOP      3328
#define XB_TOPGEN   3392
#define XCD_BAR_WORDS 3456
#define XB_SPIN_CAP (1u << 18)

__device__ __forceinline__ unsigned xb_ld(unsigned* p)              { return __hip_atomic_load(p, __ATOMIC_RELAXED, __HIP_MEMORY_SCOPE_AGENT); }
__device__ __forceinline__ unsigned xb_add(unsigned* p, unsigned v) { return __hip_atomic_fetch_add(p, v, __ATOMIC_RELAXED, __HIP_MEMORY_SCOPE_AGENT); }
__device__ __forceinline__ unsigned xb_xcc_id() { return (unsigned)__builtin_amdgcn_s_getreg((3 << 11) | 20) & 0xFu; }
#define XB_SPIN(cond, bar) do { unsigned _sp = 0; while (cond) { __builtin_amdgcn_s_sleep(1); \
    if ((++_sp & 255u) == 0u) { if (xb_ld(&(bar)[XB_TMO])) break; if (_sp > XB_SPIN_CAP) { atomicAdd(&(bar)[XB_TMO], 1u); break; } } } } while (0)

struct XcdBarrier { unsigned* bar; unsigned x; volatile LAS unsigned* st; };

__device__ __forceinline__ XcdBarrier xcd_barrier_post(unsigned* bar, volatile LAS unsigned* st) {
    XcdBarrier b; b.bar = bar; b.x = xb_xcc_id(); b.st = st;
    if (threadIdx.x == 0) (void)xb_add(&bar[XB_XCNT(b.x)], 1u);
    return b;
}
__device__ __forceinline__ void xcd_barrier_complete(unsigned* bar, unsigned x, unsigned& nloc, unsigned& nx) {
    const unsigned G = gridDim.x * gridDim.y * gridDim.z;
    unsigned sum, cnt, mine, sp = 0u;
    for (;;) {
        sum = 0u; cnt = 0u; mine = 0u;
#pragma unroll
        for (unsigned j = 0; j < 16; ++j) { const unsigned c = xb_ld(&bar[XB_XCNT(j)]); sum += c; cnt += (c > 0u) ? 1u : 0u; mine = (j == x) ? c : mine; }
        if (sum == G) break;
        __builtin_amdgcn_s_sleep(1);
        if ((++sp & 255u) == 0u) { if (xb_ld(&bar[XB_TMO])) break; if (sp > XB_SPIN_CAP) { atomicAdd(&bar[XB_TMO], 1u); break; } }
    }
    nloc = mine > 0u ? mine : 1u; nx = cnt > 0u ? cnt : 1u;
}
__device__ __forceinline__ void xcd_barrier(const XcdBarrier& b, int wave) {
    asm volatile("s_waitcnt vmcnt(0)" ::: "memory");
    __syncthreads();
    if (wave == 0 && lane_now() == 0) {
        unsigned* bar = b.bar;
        __builtin_amdgcn_s_waitcnt(0);
        unsigned nloc = b.st[0], nx = b.st[1];
        if (nloc == 0u) { xcd_barrier_complete(bar, b.x, nloc, nx); b.st[0] = nloc; b.st[1] = nx; }
        const unsigned old = xb_add(&bar[XB_XSUB(b.x)], 1u);
        const unsigned gen = old / nloc;
        if (old + 1u == (gen + 1u) * nloc) {
            __builtin_amdgcn_fence(__ATOMIC_RELEASE, "agent");
            asm volatile("s_waitcnt vmcnt(0)" ::: "memory");
            const unsigned og = xb_add(&bar[XB_TOP], 1u);
            const unsigned tg = og / nx;
            if (og + 1u == (tg + 1u) * nx) xb_add(&bar[XB_TOPGEN], 1u);
            else XB_SPIN(xb_ld(&bar[XB_TOPGEN]) == tg, bar);
            __builtin_amdgcn_fence(__ATOMIC_ACQUIRE, "agent");
            xb_add(&bar[XB_XGEN(b.x)], 1u);
            asm volatile("s_waitcnt vmcnt(0)" ::: "memory");
        } else {
            XB_SPIN(xb_ld(&bar[XB_XGEN(b.x)]) == gen, bar);
            __builtin_amdgcn_fence(__ATOMIC_ACQUIRE, "agent");
            asm volatile("s_waitcnt vmcnt(0)" ::: "memory");
        }
    }
    __syncthreads();
}

namespace pg8 {
constexpr int BM = 256, BK = 64, HALF = 128, HTB = HALF * BK * 2, STAGE_BYTES = 8 * HTB, NXCD = 8, WGM = 8;
__device__ __forceinline__ int lds_byte(int r, int c) { const int st = (r >> 4) * 2 + (c >> 5), rr = r & 15, cc = c & 31, ob = rr * 64 + cc * 2; return st * 1024 + (ob ^ (((ob >> 9) & 1) << 5)); }
__device__ __forceinline__ void stage_rc(int b, int& R, int& C) { const int st = b / 1024, sb = b % 1024, swz = sb ^ (((sb >> 9) & 1) << 5); R = (st >> 1) * 16 + swz / 64; C = (st & 1) * 32 + (swz % 64) / 2; }
__device__ __forceinline__ int perm32(int rho) { const int n = rho >> 4, i = rho & 15; return 8 * (i >> 2) + 4 * n + (i & 3); }

struct Unit { int pm, pn; };
struct Gemm { const bf16_t* A; const bf16_t* Bt; int M, N, K, lda, a_pn_off; const bf16_t* A2; const bf16_t* Bt2; int ksplit, ldb; };

struct StaticOrder {
    int nM, nN, nwg, G, c;
    __device__ void init(int M, int N, int G_, int c_) { nM = M / BM; nN = N / BM; nwg = nM * nN; G = G_; c = c_; }
    __device__ bool next(int i, Unit& u) const {
        const long L = (long)i * G + c; if (L >= nwg) return false;
        int wgid = (int)L; { const int q = nwg / NXCD, r = nwg % NXCD, xcd = wgid % NXCD, off = wgid / NXCD; wgid = (xcd < r ? xcd * (q + 1) : r * (q + 1) + (xcd - r) * q) + off; }
        const int nig = WGM * nN, gid = wgid / nig, fm = gid * WGM, gsz = (nM - fm) < WGM ? (nM - fm) : WGM;
        u.pm = fm + ((wgid % nig) % gsz); u.pn = (wgid % nig) / gsz; return true;
    }
};

typedef int i32x4 __attribute__((ext_vector_type(4)));
typedef int i32x8 __attribute__((ext_vector_type(8)));
__device__ __forceinline__ bf16x8 lo8(i32x8 v) { return __builtin_bit_cast(bf16x8, (i32x4){v.s0, v.s1, v.s2, v.s3}); }
__device__ __forceinline__ bf16x8 hi8(i32x8 v) { return __builtin_bit_cast(bf16x8, (i32x4){v.s4, v.s5, v.s6, v.s7}); }
__device__ __forceinline__ i32x8 cat8(bf16x8 a, bf16x8 b) { const i32x4 x = __builtin_bit_cast(i32x4, a), y = __builtin_bit_cast(i32x4, b); return (i32x8){x.x, x.y, x.z, x.w, y.x, y.y, y.z, y.w}; }
template <class Epi, bool F8 = false>
__device__ __forceinline__ void gemm_phase(LAS unsigned char* lds, const Gemm g, const StaticOrder& S, const Epi& E, int wave) {
    const int lane = lane_now(), wid = wave, tid = wid * 64 + lane, wr = wid >> 2, wc = wid & 3, fr = lane & 15, fq = lane >> 4;
    const int K = g.K, nt = K / BK, lda = g.lda, ldb = g.ldb ? g.ldb : g.K, ksplit = g.ksplit;
    unsigned voffA, voffB;
    { int R, C; stage_rc(tid * 16, R, C); const int Rb = Epi::PERM ? ((R & ~31) + perm32(R & 31)) : R;
      voffA = (unsigned)(R * lda + C) * 2u; voffB = (unsigned)(Rb * ldb + C) * 2u; }
    const unsigned stepA = 64u * (unsigned)lda * 2u, stepB = 64u * (unsigned)ldb * 2u;
    const size_t kstep = (size_t)(BK * 2);
    const size_t hsA = (size_t)HALF * lda * 2, hsB = (size_t)HALF * ldb * 2;
    const size_t tsA = 2 * hsA, tsB = 2 * hsB;
    const unsigned ldsw = (unsigned)wid * 1024u, ldsbase = (unsigned)(unsigned long long)lds;
    const int aoff = lds_byte(wr * 64 + fr, fq * 8), boff = lds_byte(wc * 32 + fr, fq * 8);
#define PG8_SA(b, h) (((b) * 2 + (h)) * HTB)
#define PG8_SB(b, h) ((4 + (b) * 2 + (h)) * HTB)
#define PG8_STAGE(bufoff, gbase, voff) do { _Pragma("unroll") for (int _i = 0; _i < 2; ++_i) { \
        const char* sb_ = (const char*)(gbase) + (size_t)_i * PG8_STEP_##voff; const unsigned m0_ = ldsbase + (unsigned)(bufoff) + ldsw + (unsigned)_i * 8192u; \
        asm volatile("s_mov_b32 m0, %2\n\ts_nop 0\n\tglobal_load_lds_dwordx4 %0, %1" :: "v"(voff), "s"(sb_), "s"(m0_) : "memory"); } } while (0)
#define PG8_STEP_voffA stepA
#define PG8_STEP_voffB stepB
#define PG8_LDA(dst, b, h) do { _Pragma("unroll") for (int m = 0; m < 4; ++m) dst[m] = cat8(*(const LAS bf16x8*)(lds + PG8_SA(b, h) + aoff + m * 2048), *(const LAS bf16x8*)(lds + PG8_SA(b, h) + aoff + m * 2048 + 1024)); } while (0)
#define PG8_LDB(dst, b, h) do { _Pragma("unroll") for (int n = 0; n < 2; ++n) dst[n] = cat8(*(const LAS bf16x8*)(lds + PG8_SB(b, h) + boff + n * 2048), *(const LAS bf16x8*)(lds + PG8_SB(b, h) + boff + n * 2048 + 1024)); } while (0)
#define PG8_MMA(ai, bj, At, Bt) do { __builtin_amdgcn_s_setprio(1); _Pragma("unroll") for (int m = 0; m < 4; ++m) _Pragma("unroll") for (int n = 0; n < 2; ++n) { \
        if constexpr (F8) acc[ai][bj][m][n] = __builtin_amdgcn_mfma_scale_f32_16x16x128_f8f6f4(Bt[n], At[m], acc[ai][bj][m][n], 0, 0, 0, 0x7D7D7D7D  , 0, 0x7D7D7D7D); \
        else { acc[ai][bj][m][n] = __builtin_amdgcn_mfma_f32_16x16x32_bf16(lo8(Bt[n]), lo8(At[m]), acc[ai][bj][m][n], 0, 0, 0); \
               acc[ai][bj][m][n] = __builtin_amdgcn_mfma_f32_16x16x32_bf16(hi8(Bt[n]), hi8(At[m]), acc[ai][bj][m][n], 0, 0, 0); } } \
        __builtin_amdgcn_s_setprio(0); } while (0)
#define PG8_WAIT_V(n) asm volatile("s_waitcnt vmcnt(" #n ")" ::: "memory")
#define PG8_WAIT_L(n) asm volatile("s_waitcnt lgkmcnt(" #n ")" ::: "memory")
#define PG8_BAR __builtin_amdgcn_s_barrier()
#define PG8_SCHED __builtin_amdgcn_sched_barrier(0)
    Unit cur, nxt; int ui = 0;
    if (!S.next(0, cur)) return;
    f32x4 acc[2][2][4][2];
#pragma unroll
    for (int a = 0; a < 2; ++a)
#pragma unroll
        for (int b = 0; b < 2; ++b)
#pragma unroll
            for (int m = 0; m < 4; ++m)
#pragma unroll
                for (int n = 0; n < 2; ++n) acc[a][b][m][n] = (f32x4){0.f, 0.f, 0.f, 0.f};
    i32x8 At[4], B0[2], B1[2];
    const char* cA = (const char*)g.A + (size_t)cur.pm * tsA + (size_t)cur.pn * g.a_pn_off * 2; const char* cB = (const char*)g.Bt + (size_t)cur.pn * tsB;
    PG8_STAGE(PG8_SB(0, 0), cB, voffB); PG8_STAGE(PG8_SB(0, 1), cB + hsB, voffB); PG8_STAGE(PG8_SA(0, 0), cA, voffA); PG8_STAGE(PG8_SA(0, 1), cA + hsA, voffA);
    if (wr == 1) PG8_BAR;
    PG8_WAIT_V(2); PG8_BAR;
    PG8_STAGE(PG8_SB(1, 0), cB + kstep, voffB); PG8_STAGE(PG8_SA(1, 0), cA + kstep, voffA); PG8_STAGE(PG8_SB(1, 1), cB + hsB + kstep, voffB);
    PG8_WAIT_V(6); PG8_BAR;
    for (;;) {
        const bool has_next = S.next(ui + 1, nxt);
        const char* nA = has_next ? (const char*)g.A + (size_t)nxt.pm * tsA + (size_t)nxt.pn * g.a_pn_off * 2 : cA; const char* nB = has_next ? (const char*)g.Bt + (size_t)nxt.pn * tsB : cB;
        const char* cA2 = (const char*)g.A2 + (size_t)cur.pm * tsA; const char* cB2 = (const char*)g.Bt2 + (size_t)cur.pn * tsB;
#pragma clang loop unroll(disable)
        for (int t = 0; t < nt; t += 2) {
            const bool last = (t == nt - 2);
            const bool s1 = ksplit && (t >= ksplit), s2 = ksplit && (t + 2 >= ksplit);
            const char* a1 = (s1 ? cA2 + (size_t)(t - ksplit + 1) * kstep : cA + (size_t)(t + 1) * kstep);
            const char* a2 = last ? nA : (s2 ? cA2 + (size_t)(t + 2 - ksplit) * kstep : cA + (size_t)(t + 2) * kstep);
            const char* b2 = last ? nB : (s2 ? cB2 + (size_t)(t + 2 - ksplit) * kstep : cB + (size_t)(t + 2) * kstep);
            const char* a3 = a2 + kstep; const char* b3 = b2 + kstep;
            PG8_LDB(B0, 0, 0); PG8_LDB(B1, 0, 1); PG8_SCHED; PG8_LDA(At, 0, 0); PG8_STAGE(PG8_SA(1, 1), a1 + hsA, voffA);
            PG8_WAIT_V(8); PG8_WAIT_L(0); PG8_BAR; PG8_MMA(0, 0, At, B0); PG8_MMA(0, 1, At, B1); PG8_BAR; PG8_SCHED;
            PG8_LDA(At, 0, 1); PG8_STAGE(PG8_SB(0, 0), b2, voffB); PG8_STAGE(PG8_SB(0, 1), b2 + hsB, voffB); PG8_STAGE(PG8_SA(0, 0), a2, voffA);
            PG8_WAIT_V(8); PG8_WAIT_L(0); PG8_BAR; PG8_MMA(1, 0, At, B0); PG8_MMA(1, 1, At, B1); PG8_BAR; PG8_SCHED;
            PG8_LDB(B0, 1, 0); PG8_LDB(B1, 1, 1); PG8_SCHED; PG8_LDA(At, 1, 0); PG8_STAGE(PG8_SA(0, 1), a2 + hsA, voffA);
            PG8_WAIT_V(8); PG8_WAIT_L(0); PG8_BAR; PG8_MMA(0, 0, At, B0); PG8_MMA(0, 1, At, B1); PG8_BAR; PG8_SCHED;
            PG8_LDA(At, 1, 1); PG8_STAGE(PG8_SB(1, 0), b3, voffB); PG8_STAGE(PG8_SB(1, 1), b3 + hsB, voffB); PG8_STAGE(PG8_SA(1, 0), a3, voffA);
            PG8_WAIT_V(8); PG8_WAIT_L(0); PG8_BAR; PG8_MMA(1, 0, At, B0); PG8_MMA(1, 1, At, B1); PG8_BAR; PG8_SCHED;
            if constexpr (Epi::MID) { if (t + 2 == ksplit) E.mid(acc, cur, wr, wc, fr, fq); }
        }
        if (wr == 0) PG8_BAR;
        { const int l2 = lane_now(); E(acc, cur, wr, wc, l2 & 15, l2 >> 4); }
        if (!has_next) break;
#pragma unroll
        for (int a = 0; a < 2; ++a)
#pragma unroll
            for (int b = 0; b < 2; ++b)
#pragma unroll
                for (int m = 0; m < 4; ++m)
#pragma unroll
                    for (int n = 0; n < 2; ++n) acc[a][b][m][n] = (f32x4){0.f, 0.f, 0.f, 0.f};
        cur = nxt; cA = nA; cB = nB; ++ui;
        if (wr == 1) PG8_BAR;
    }
    PG8_WAIT_V(0);
    PG8_BAR;
#undef PG8_SA
#undef PG8_SB
#undef PG8_STAGE
#undef PG8_STEP_voffA
#undef PG8_STEP_voffB
#undef PG8_LDA
#undef PG8_LDB
#undef PG8_MMA
#undef PG8_WAIT_V
#undef PG8_WAIT_L
#undef PG8_BAR
#undef PG8_SCHED
}
}
using pg8::Unit;

typedef f32x4 AccT[2][2][4][2];
__device__ __forceinline__ u32x4 pack8(f32x4 a, f32x4 b) { u32x4 w; w.x = cvt_pk_bf16(a[0], a[1]); w.y = cvt_pk_bf16(a[2], a[3]); w.z = cvt_pk_bf16(b[0], b[1]); w.w = cvt_pk_bf16(b[2], b[3]); return w; }
__device__ __forceinline__ u32x2 pack8_fp8(f32x4 a, f32x4 b) {
    int w0 = __builtin_amdgcn_cvt_pk_fp8_f32(a[0], a[1], 0, false); w0 = __builtin_amdgcn_cvt_pk_fp8_f32(a[2], a[3], w0, true);
    int w1 = __builtin_amdgcn_cvt_pk_fp8_f32(b[0], b[1], 0, false); w1 = __builtin_amdgcn_cvt_pk_fp8_f32(b[2], b[3], w1, true);
    return (u32x2){(unsigned)w0, (unsigned)w1};
}
__device__ __forceinline__ void unpack8(u32x4 w, f32x4& a, f32x4& b) { a = (f32x4){bf_lo(w.x), bf_hi(w.x), bf_lo(w.y), bf_hi(w.y)}; b = (f32x4){bf_lo(w.z), bf_hi(w.z), bf_lo(w.w), bf_hi(w.w)}; }

template <bool SET8> struct EpiInproj {
    static constexpr bool PERM = true, MID = false;
    bf16_t *q, *k, *v, *iq, *ik, *pl, *ga, *gp; float* iw;
    __device__ __forceinline__ void operator()(const AccT& acc, const Unit& u, int wr, int wc, int fr, int fq) const {
        const int pn = u.pn, row0 = u.pm * 256 + wr * 64 + fr;
        if (!SET8 && pn == 4) {
            if (wc < 2) {
#pragma unroll
                for (int ai = 0; ai < 2; ++ai)
#pragma unroll
                    for (int m = 0; m < 4; ++m) { const size_t row = (size_t)(row0 + ai * 128 + m * 16);
                        *(u32x4*)(ik + row * 64 + wc * 32 + 8 * fq) = pack8(acc[ai][0][m][0], acc[ai][0][m][1]); }
            } else if (wc == 2) {
                if (fq < 2) {
#pragma unroll
                    for (int ai = 0; ai < 2; ++ai)
#pragma unroll
                        for (int m = 0; m < 4; ++m) { const size_t row = (size_t)(row0 + ai * 128 + m * 16);
                            *(f32x4*)(iw + row * 16 + 8 * fq) = acc[ai][0][m][0]; *(f32x4*)(iw + row * 16 + 8 * fq + 4) = acc[ai][0][m][1]; }
                }
            }
            return;
        }
        bf16_t* dst; int ld, tc; bool sg = false;
        if (SET8) {
            if (pn < 4) { dst = q; ld = 1024; tc = pn * 256; }
            else if (pn == 4) { dst = k; ld = 256; tc = 0; }
            else if (pn == 5) { dst = v; ld = 256; tc = 0; }
            else if (pn < 14) { dst = ga; ld = 2048; tc = (pn - 6) * 256; sg = true; }
            else { dst = gp; ld = 2048; tc = (pn - 14) * 256; sg = true; }
        } else {
            if (pn < 4) { dst = iq; ld = 1024; tc = pn * 256; }
            else { dst = pl; ld = 1024; tc = (pn - 5) * 256; }
        }
        const int col0 = tc + wc * 32 + 8 * fq;
#pragma unroll
        for (int ai = 0; ai < 2; ++ai)
#pragma unroll
            for (int m = 0; m < 4; ++m) { bf16_t* rowp = dst + (size_t)(row0 + ai * 128 + m * 16) * ld + col0;
#pragma unroll
                for (int bj = 0; bj < 2; ++bj) { f32x4 v0 = acc[ai][bj][m][0], v1 = acc[ai][bj][m][1];
                    if (sg) {
#pragma unroll
                        for (int j = 0; j < 4; ++j) { v0[j] = sigmoidf_(v0[j]); v1[j] = sigmoidf_(v1[j]); } }
                    *(u32x4*)(rowp + bj * 128) = pack8(v0, v1); } }
    }
};
struct EpiBf16Scale {
    static constexpr bool PERM = true, MID = false;
    bf16_t* O; int ldc; const float* cs;
    __device__ __forceinline__ void operator()(const AccT& acc, const Unit& u, int wr, int wc, int fr, int fq) const {
        const int row0 = u.pm * 256 + wr * 64 + fr, col0 = u.pn * 256 + wc * 32 + 8 * fq;
        f32x4 s[2][2];
#pragma unroll
        for (int bj = 0; bj < 2; ++bj)
#pragma unroll
            for (int n = 0; n < 2; ++n) s[bj][n] = cs ? *(const f32x4*)(cs + col0 + bj * 128 + 4 * n) : (f32x4){1.f, 1.f, 1.f, 1.f};
#pragma unroll
        for (int ai = 0; ai < 2; ++ai)
#pragma unroll
            for (int m = 0; m < 4; ++m) { bf16_t* rowp = O + (size_t)(row0 + ai * 128 + m * 16) * ldc + col0;
#pragma unroll
                for (int bj = 0; bj < 2; ++bj) *(u32x4*)(rowp + bj * 128) = pack8(acc[ai][bj][m][0] * s[bj][0], acc[ai][bj][m][1] * s[bj][1]); }
    }
};
template <bool ADD> struct EpiGate {
    static constexpr bool PERM = true, MID = false;
    bf16_t* O; const bf16_t* gate;
    __device__ __forceinline__ void operator()(const AccT& acc, const Unit& u, int wr, int wc, int fr, int fq) const {
        const int row0 = u.pm * 256 + wr * 64 + fr, col0 = u.pn * 256 + wc * 32 + 8 * fq;
#pragma unroll
        for (int ai = 0; ai < 2; ++ai)
#pragma unroll
            for (int m = 0; m < 4; ++m) { const size_t off = (size_t)(row0 + ai * 128 + m * 16) * 2048 + col0;
#pragma unroll
                for (int bj = 0; bj < 2; ++bj) { f32x4 g0, g1; unpack8(*(const u32x4*)(gate + off + bj * 128), g0, g1);
                    f32x4 r0 = g0 * acc[ai][bj][m][0], r1 = g1 * acc[ai][bj][m][1];
                    if (ADD) { f32x4 o0, o1; unpack8(*(const u32x4*)(O + off + bj * 128), o0, o1); r0 += o0; r1 += o1; }
                    *(u32x4*)(O + off + bj * 128) = pack8(r0, r1); } }
    }
};
struct EpiMerge {
    static constexpr bool PERM = true, MID = true;
    unsigned char* O; const bf16_t* ga; const bf16_t* gp;
    __device__ __forceinline__ void mid(AccT& acc, const Unit& u, int wr, int wc, int fr, int fq) const {
        const auto ra = __builtin_amdgcn_make_buffer_rsrc((void*)ga, 0, 0x7FFFFFFF, 0x00020000), rp = __builtin_amdgcn_make_buffer_rsrc((void*)gp, 0, 0x7FFFFFFF, 0x00020000);
        const int voff = ((wr * 64 + fr) * 2048 + wc * 32 + 8 * fq) * 2;
        const int sbase = (u.pm * 256 * 2048 + u.pn * 256) * 2;
#pragma unroll
        for (int ai = 0; ai < 2; ++ai)
#pragma unroll
            for (int m = 0; m < 4; ++m)
#pragma unroll
                for (int bj = 0; bj < 2; ++bj) { const int so = sbase + ((ai * 128 + m * 16) * 2048 + bj * 128) * 2;
                    const u32x4 wa = __builtin_bit_cast(u32x4, __builtin_amdgcn_raw_buffer_load_b128(ra, voff, so, 0)), wp = __builtin_bit_cast(u32x4, __builtin_amdgcn_raw_buffer_load_b128(rp, voff, so, 0));
                    f32x4 a0, a1, p0, p1; unpack8(wa, a0, a1); unpack8(wp, p0, p1);
#pragma unroll
                    for (int j = 0; j < 4; ++j) { acc[ai][bj][m][0][j] *= a0[j] * __builtin_amdgcn_rcpf(p0[j]); acc[ai][bj][m][1][j] *= a1[j] * __builtin_amdgcn_rcpf(p1[j]); }
                    asm volatile("" : "+v"(acc[ai][bj][m][0]), "+v"(acc[ai][bj][m][1]) :: "memory"); }
    }
    __device__ __forceinline__ void operator()(const AccT& acc, const Unit& u, int wr, int wc, int fr, int fq) const {
        const int row0 = u.pm * 256 + wr * 64 + fr, col0 = u.pn * 256 + wc * 32 + 8 * fq;
#pragma unroll
        for (int ai = 0; ai < 2; ++ai)
#pragma unroll
            for (int m = 0; m < 4; ++m) { const size_t off = (size_t)(row0 + ai * 128 + m * 16) * 2048 + col0;
#pragma unroll
                for (int bj = 0; bj < 2; ++bj) { f32x4 p0, p1; unpack8(*(const u32x4*)(gp + off + bj * 128), p0, p1);
                    *(u32x2*)(O + off + bj * 128) = pack8_fp8(p0 * acc[ai][bj][m][0], p1 * acc[ai][bj][m][1]); } }
    }
};
struct EpiResid {
    static constexpr bool PERM = false, MID = false;
    const float* x; float* out; const float* gt;
    __device__ __forceinline__ void operator()(const AccT& acc, const Unit& u, int wr, int wc, int fr, int fq) const {
        const int row0 = u.pm * 256 + wr * 64 + fr, col0 = u.pn * 256 + wc * 32 + 4 * fq;
        const float* gtb = gt + (size_t)(u.pm / 16) * 12288;
        f32x4 g[2][2];
#pragma unroll
        for (int bj = 0; bj < 2; ++bj)
#pragma unroll
            for (int n = 0; n < 2; ++n) g[bj][n] = *(const f32x4*)(gtb + col0 + bj * 128 + n * 16);
#pragma unroll
        for (int ai = 0; ai < 2; ++ai)
#pragma unroll
            for (int m = 0; m < 4; ++m) { const size_t off = (size_t)(row0 + ai * 128 + m * 16) * 2048 + col0;
#pragma unroll
                for (int bj = 0; bj < 2; ++bj)
#pragma unroll
                    for (int n = 0; n < 2; ++n) { const f32x4 xv = *(const f32x4*)(x + off + bj * 128 + n * 16);
                        *(f32x4*)(out + off + bj * 128 + n * 16) = xv + g[bj][n] * acc[ai][bj][m][n]; } }
    }
};
struct EpiF32 {
    static constexpr bool PERM = false, MID = false;
    float* C; int ldc;
    __device__ __forceinline__ void operator()(const AccT& acc, const Unit& u, int wr, int wc, int fr, int fq) const {
        const int row0 = u.pm * 256 + wr * 64 + fr, col0 = u.pn * 256 + wc * 32 + 4 * fq;
#pragma unroll
        for (int ai = 0; ai < 2; ++ai)
#pragma unroll
            for (int m = 0; m < 4; ++m) { float* rowp = C + (size_t)(row0 + ai * 128 + m * 16) * ldc + col0;
#pragma unroll
                for (int bj = 0; bj < 2; ++bj)
#pragma unroll
                    for (int n = 0; n < 2; ++n) *(f32x4*)(rowp + bj * 128 + n * 16) = acc[ai][bj][m][n]; }
    }
};

struct Args { const float* in[19]; float* out; unsigned char* ws; int ph_lo, ph_hi; int li, pad; };
struct Frame {
    unsigned char* lds; unsigned char* ws;
    int tid, lane, wave, G, bid;
    const float *x, *c, *w_ada, *b_ada, *g1, *g2, *w_in, *g_q, *g_k, *rel_bias, *pool_w, *pool_scale, *w_ab, *w_pb, *w_out, *w_pq, *peer_keys, *peer_u, *peer_v;
    float* out;
};

template <bool F8OUT = false, class Fn> __device__ __forceinline__ void transpose_item(const float* W, int K, int N, void* WTv, int ldk, int drow0, int k0, float* scr, int lane, Fn srccol, float mul = 1.0f) {
    const int sc = srccol(drow0 + (lane & 31));
#pragma unroll 8
    for (int i = 0; i < 32; ++i) { const int kk = 2 * i + (lane >> 5); scr[kk * 33 + (lane & 31)] = sc >= 0 ? W[(size_t)(k0 + kk) * N + sc] * mul : 0.f; }
    asm volatile("s_waitcnt lgkmcnt(0)" ::: "memory");
    const int c = lane & 7;
#pragma unroll
    for (int j = 0; j < 4; ++j) { const int n = (lane >> 3) + 8 * j; const float* s = scr + (8 * c) * 33 + n;
        if constexpr (F8OUT) { *(u32x2*)((unsigned char*)WTv + (size_t)(drow0 + n) * ldk + k0 + 8 * c) = pack8_fp8((f32x4){s[0 * 33], s[1 * 33], s[2 * 33], s[3 * 33]}, (f32x4){s[4 * 33], s[5 * 33], s[6 * 33], s[7 * 33]}); }
        else { u32x4 o; o.x = cvt_pk_bf16(s[0 * 33], s[1 * 33]); o.y = cvt_pk_bf16(s[2 * 33], s[3 * 33]); o.z = cvt_pk_bf16(s[4 * 33], s[5 * 33]); o.w = cvt_pk_bf16(s[6 * 33], s[7 * 33]);
            *(u32x4*)((bf16_t*)WTv + (size_t)(drow0 + n) * ldk + k0 + 8 * c) = o; } }
    asm volatile("s_waitcnt lgkmcnt(0)" ::: "memory");
}
__device__ __forceinline__ void phase0_prep(Frame& F) {
    F.lane = lane_now(); F.tid = F.wave * 64 + F.lane;
    const int gw = F.bid * 8 + F.wave, NGW = F.G * 8;
    float* scr = (float*)(F.lds + F.wave * 16384);
    constexpr int I_IN16 = (2304 / 32) * (DM / 64), I_IN8 = (5632 / 32) * (DM / 64);
    constexpr int I_AB = (2048 / 32) * (1024 / 64), I_OUT = (2048 / 32) * (2048 / 64), I_PW = 4 * 8 * 4;
    constexpr int NIT = I_IN16 + I_IN8 + 2 * I_AB + 2 * I_OUT + I_PW;
    auto ident = [](int j) { return j; };
    for (int it = gw; it < NIT; it += NGW) {
        int r = it;
        if (r < I_IN16) { const int nb = r % 72, kb = r / 72;
            transpose_item(F.w_in, DM, INW, F.ws + WS_WIN16, DM, nb * 32, kb * 64, scr, F.lane, [](int j) { return j < 1104 ? j + 1536 : (j < 1280 ? -1 : j + 1360); }); continue; }
        r -= I_IN16;
        if (r < I_IN8) { const int nb = r % 176, kb = r / 176;
            transpose_item<true>(F.w_in, DM, INW, F.ws + WS_WIN8, DM, nb * 32, kb * 64, scr, F.lane, [](int j) { return j < 1536 ? j : j + 2128; }, 16.0f); continue; }
        r -= I_IN8;
        if (r < I_AB) { transpose_item(F.w_ab, 1024, 2048, (bf16_t*)(F.ws + WS_WAB), 1024, (r % 64) * 32, (r / 64) * 64, scr, F.lane, ident); continue; }
        r -= I_AB;
        if (r < I_AB) { transpose_item(F.w_pb, 1024, 2048, (bf16_t*)(F.ws + WS_WPB), 1024, (r % 64) * 32, (r / 64) * 64, scr, F.lane, ident); continue; }
        r -= I_AB;
        if (r < I_OUT) { transpose_item<true>(F.w_out, 2048, 2048, F.ws + WS_WOUT, 2048, (r % 64) * 32, (r / 64) * 64, scr, F.lane, ident, 16.0f); continue; }
        r -= I_OUT;
        if (r < I_OUT) { transpose_item(F.w_pq, 2048, 2048, (bf16_t*)(F.ws + WS_WPQ), 2048, (r % 64) * 32, (r / 64) * 64, scr, F.lane, ident); continue; }
        r -= I_OUT;
        { const int g = r / 32, q = r % 32, nb = q % 8, kb = q / 8;
          transpose_item(F.pool_w + (size_t)g * 65536, 256, 256, (bf16_t*)(F.ws + WS_POOLW) + (size_t)g * 65536, 256, nb * 32, kb * 64, scr, F.lane, ident); }
    }
    {
        bf16_t* kb = (bf16_t*)(F.ws + WS_KEYSBD);
        for (int i = F.bid * 512 + F.tid; i < 2048 * 32; i += F.G * 512) {
            const int row = i / 32, k8 = (i % 32) * 8, p = (row >> 7) & 1;
            u32x4 o = (u32x4){0u, 0u, 0u, 0u};
            if ((k8 >> 7) == p) { const float* s = F.peer_keys + (size_t)row * 128 + (k8 & 127); const f32x4 a = *(const f32x4*)s, b = *(const f32x4*)(s + 4); o = pack8(a, b); }
            *(u32x4*)(kb + (size_t)row * 256 + k8) = o;
        }
    }
    {
        unsigned char* pu = F.ws + WS_PU;
        for (size_t i = (size_t)F.bid * 512 + F.tid; i < (size_t)NEXP * 64; i += (size_t)F.G * 512) {
            const float* src = F.peer_u + i * 32;
            u32x16 pk;
#pragma unroll
            for (int k = 0; k < 8; ++k) { const f32x4 a = *(const f32x4*)(src + k * 4) * 96.0f; pk[2 * k] = cvt_pk_bf16(a[0], a[1]); pk[2 * k + 1] = cvt_pk_bf16(a[2], a[3]); }
            const u32x6 p6 = __builtin_amdgcn_cvt_scalef32_pk32_fp6_bf16(__builtin_bit_cast(bf16x32, pk), 1.0f);
            unsigned char* dst = pu + i * 24;
            *(u32x2*)dst = (u32x2){p6[0], p6[1]}; *(u32x2*)(dst + 8) = (u32x2){p6[2], p6[3]}; *(u32x2*)(dst + 16) = (u32x2){p6[4], p6[5]};
        }
        unsigned char* pv = F.ws + WS_PV;
        for (int it = gw; it < (NEXP / 64) * 128; it += NGW) {
            const int e = (it >> 7) * 64 + F.lane, ch = it & 127;
            u32x4 ov;
#pragma unroll
            for (int k = 0; k < 4; ++k) { const f32x4 c = *(const f32x4*)(F.peer_v + (size_t)e * DM + ch * 16 + k * 4) * 4.0f;
                int wv = __builtin_amdgcn_cvt_pk_fp8_f32(c[0], c[1], 0, false); wv = __builtin_amdgcn_cvt_pk_fp8_f32(c[2], c[3], wv, true); ov[k] = (unsigned)wv; }
            *(u32x2*)(pv + ((size_t)(2 * ch) * NEXP + e) * 8) = (u32x2){ov[0], ov[1]};
            *(u32x2*)(pv + ((size_t)(2 * ch + 1) * NEXP + e) * 8) = (u32x2){ov[2], ov[3]};
        }
    }
    {
        __syncthreads();
        float* cact = (float*)(F.lds + 131072);
        float* red = (float*)F.lds;
        float* mp = (float*)(F.ws + WS_MODP);
        for (int it = F.bid; it < 48 * 4; it += F.G) {
            const int cb = it % 48, ds = it / 48, d0 = ds * 512;
            for (int i = F.tid; i < 8 * 512; i += 512) { const int b = i >> 9, d = i & 511; const float cv = F.c[b * DM + d0 + d]; cact[i] = cv * sigmoidf_(cv); }
            __syncthreads();
            f32x4 a[8];
#pragma unroll
            for (int b = 0; b < 8; ++b) a[b] = (f32x4){0.f, 0.f, 0.f, 0.f};
            const float* wp = F.w_ada + (size_t)(d0 + F.wave * 64) * 12288 + cb * 256 + F.lane * 4;
#pragma unroll 4
            for (int d = 0; d < 64; ++d) { const f32x4 w = *(const f32x4*)(wp + (size_t)d * 12288);
#pragma unroll
                for (int b = 0; b < 8; ++b) a[b] += w * cact[b * 512 + F.wave * 64 + d]; }
#pragma unroll
            for (int b = 0; b < 8; ++b)
#pragma unroll
                for (int j = 0; j < 4; ++j) red[(F.wave * 32 + b * 4 + j) * 64 + F.lane] = a[b][j];
            __syncthreads();
            for (int i = F.tid; i < 2048; i += 512) { const int v = i >> 6, l = i & 63; float s = 0.f;
#pragma unroll
                for (int w = 0; w < 8; ++w) s += red[(w * 32 + v) * 64 + l];
                mp[((size_t)ds * 8 + (v >> 2)) * 12288 + cb * 256 + l * 4 + (v & 3)] = s; }
            __syncthreads();
        }
    }
}

template <bool FIRST> __device__ __forceinline__ void phase_modnorm(Frame& F, const float* xin, const float* gain, int off_sh, int off_sc, bf16_t* dst, unsigned char* dst8 = nullptr) {
    F.lane = lane_now(); F.tid = F.wave * 64 + F.lane;
    const float* mp = (const float*)(F.ws + WS_MODP); float* mf = (float*)(F.ws + WS_MODF);
    if (FIRST) {
        for (int i = F.bid * 512 + F.tid; i < 8 * 12288; i += F.G * 512) {
            float s = F.b_ada[i % 12288];
#pragma unroll
            for (int k = 0; k < 4; ++k) s += mp[(size_t)k * 8 * 12288 + i];
            mf[i] = s; }
    }
    float* cA = (float*)F.lds; float* cB = cA + 2048;
    for (int ch = F.bid; ch < MTOK / 128; ch += F.G) {
        const int b = ch / 32;
        __syncthreads();
        for (int col = F.tid; col < 2048; col += 512) {
            float sc, sh;
            if (FIRST) { sc = F.b_ada[off_sc + col]; sh = F.b_ada[off_sh + col];
#pragma unroll
                for (int k = 0; k < 4; ++k) { sc += mp[((size_t)k * 8 + b) * 12288 + off_sc + col]; sh += mp[((size_t)k * 8 + b) * 12288 + off_sh + col]; } }
            else { sc = mf[b * 12288 + off_sc + col]; sh = mf[b * 12288 + off_sh + col]; }
            cA[col] = gain[col] * (1.f + sc); cB[col] = sh; }
        __syncthreads();
        for (int r = F.wave; r < 128; r += 8) {
            const size_t row = (size_t)ch * 128 + r;
            const float* xr = xin + row * 2048 + F.lane * 8;
            f32x4 v[4][2]; float ss = 0.f;
#pragma unroll
            for (int i = 0; i < 4; ++i) { v[i][0] = *(const f32x4*)(xr + i * 512); v[i][1] = *(const f32x4*)(xr + i * 512 + 4);
#pragma unroll
                for (int j = 0; j < 4; ++j) ss += v[i][0][j] * v[i][0][j] + v[i][1][j] * v[i][1][j]; }
            ss = wave_sum(ss);
            const float rinv = 1.0f / sqrtf(ss * (1.0f / 2048.0f) + EPS);
#pragma unroll
            for (int i = 0; i < 4; ++i) { const int col = i * 512 + F.lane * 8;
                const f32x4 a0 = *(const f32x4*)(cA + col), a1 = *(const f32x4*)(cA + col + 4), b0 = *(const f32x4*)(cB + col), b1 = *(const f32x4*)(cB + col + 4);
                const f32x4 y0 = v[i][0] * rinv * a0 + b0, y1 = v[i][1] * rinv * a1 + b1;
                *(u32x4*)(dst + row * 2048 + col) = pack8(y0, y1);
                if (FIRST) *(u32x2*)(dst8 + row * 2048 + col) = pack8_fp8(y0, y1); }
        }
    }
}

__device__ __forceinline__ void phase3_qknorm(Frame& F) {
    F.lane = lane_now(); F.tid = F.wave * 64 + F.lane;
    const bf16_t* q = (const bf16_t*)(F.ws + WS_QN); const bf16_t* k = (const bf16_t*)(F.ws + WS_KN); const bf16_t* v = (const bf16_t*)(F.ws + WS_V);
    unsigned char* q8 = F.ws + WS_Q8; unsigned char* k8 = F.ws + WS_K8; unsigned char* v8 = F.ws + WS_V8;
    const int gw = F.bid * 8 + F.wave, NGW = F.G * 8;
    for (int row = gw; row < MTOK; row += NGW) {
#pragma unroll
        for (int i = 0; i < 2; ++i) { const int ci = i * 64 + F.lane;
            f32x4 a, b; unpack8(*(const u32x4*)(q + (size_t)row * 1024 + ci * 8), a, b);
            float ss = a[0] * a[0] + a[1] * a[1] + a[2] * a[2] + a[3] * a[3] + b[0] * b[0] + b[1] * b[1] + b[2] * b[2] + b[3] * b[3];
            ss = row_sum16(ss);
            const float rinv = 1.0f / sqrtf(ss * (1.0f / 128.0f) + EPS);
            const float* gp = F.g_q + (ci & 15) * 8; const f32x4 g0 = *(const f32x4*)gp, g1 = *(const f32x4*)(gp + 4);
            *(u32x2*)(q8 + (size_t)row * 1024 + ci * 8) = pack8_fp8(a * rinv * g0, b * rinv * g1); }
        { const int ci = F.lane & 31; const bool isk = F.lane < 32;
            f32x4 a, b; unpack8(*(const u32x4*)((isk ? k : v) + (size_t)row * 256 + ci * 8), a, b);
            float ss = a[0] * a[0] + a[1] * a[1] + a[2] * a[2] + a[3] * a[3] + b[0] * b[0] + b[1] * b[1] + b[2] * b[2] + b[3] * b[3];
            ss = row_sum16(ss);
            const float rinv = isk ? 1.0f / sqrtf(ss * (1.0f / 128.0f) + EPS) : 1.0f;
            const float* gp = F.g_k + (ci & 15) * 8; f32x4 g0 = *(const f32x4*)gp, g1 = *(const f32x4*)(gp + 4);
            if (!isk) { g0 = (f32x4){1.f, 1.f, 1.f, 1.f}; g1 = g0; }
            *(u32x2*)((isk ? k8 : v8) + (size_t)row * 256 + ci * 8) = pack8_fp8(a * rinv * g0, b * rinv * g1); }
    }
}
template <int W> __device__ __forceinline__ void pooled_item(const bf16_t* pl, bf16_t* po, int row, int c8) {
    const int t = row & (SEQ - 1);
    f32x4 s0 = (f32x4){0.f, 0.f, 0.f, 0.f}, s1 = s0, x0 = s0, x1 = s0;
    u32x4 v[W];
#pragma unroll
    for (int j = 0; j < W; ++j) v[j] = *(const u32x4*)(pl + (size_t)(row - (j <= t ? j : 0)) * 1024 + c8);
#pragma unroll
    for (int j = 0; j < W; ++j) { f32x4 a, b; unpack8(v[j], a, b); if (j == 0) { x0 = a; x1 = b; } if (j <= t) { s0 += a; s1 += b; } }
    const float inv = 1.0f / (float)((t + 1 < W) ? t + 1 : W);
    *(u32x4*)(po + (size_t)row * 1024 + c8) = pack8(s0 * inv - x0, s1 * inv - x1);
}
__device__ __forceinline__ void phase3_pooled(Frame& F) {
    F.lane = lane_now(); F.tid = F.wave * 64 + F.lane;
    const bf16_t* pl = (const bf16_t*)(F.ws + WS_PL); bf16_t* po = (bf16_t*)(F.ws + WS_POOLED);
    const int gw = F.bid * 8 + F.wave, NGW = F.G * 8;
    for (int it = gw; it < (MTOK / 2) * 4; it += NGW) {
        const int g = it & 3, row = (it >> 2) * 2 + (F.lane >> 5), c8 = g * 256 + (F.lane & 31) * 8;
        if (g == 0) pooled_item<2>(pl, po, row, c8); else if (g == 1) pooled_item<4>(pl, po, row, c8); else if (g == 2) pooled_item<8>(pl, po, row, c8); else pooled_item<16>(pl, po, row, c8);
    }
}
typedef float f32x16 __attribute__((ext_vector_type(16)));
__device__ __forceinline__ float wrelu_(float wh, float d, float acc) { return __builtin_fmaf(wh, d, __builtin_fmaf(wh, __builtin_fabsf(d), acc)); }
__device__ __forceinline__ int sel_code(float s, float smin, float scale) { const float c = (s - smin) * scale; return (int)fminf(fmaxf(c, 0.f), 65535.f); }
__device__ __forceinline__ void hist_find(const unsigned* hist, int lane, int K, int& bsel, int& above) {
    const u32x4 h = *(const u32x4*)(hist + lane * 4);
    const int S = (int)(h.x + h.y + h.z + h.w);
    int x = S;
    x += __builtin_amdgcn_update_dpp(0, x, 0x101, 0xF, 0xF, true);
    x += __builtin_amdgcn_update_dpp(0, x, 0x102, 0xF, 0xF, true);
    x += __builtin_amdgcn_update_dpp(0, x, 0x104, 0xF, 0xF, true);
    x += __builtin_amdgcn_update_dpp(0, x, 0x108, 0xF, 0xF, true);
    const int t1 = __builtin_amdgcn_readlane(x, 16), t2 = __builtin_amdgcn_readlane(x, 32), t3 = __builtin_amdgcn_readlane(x, 48);
    const int r = lane >> 4;
    x += (r == 0 ? t1 + t2 + t3 : (r == 1 ? t2 + t3 : (r == 2 ? t3 : 0)));
    const int sufn = x - S;
    const bool mine = (x >= K) && (sufn < K);
    int b = 0, ab = 0;
    { int c = sufn;
      if (c + (int)h.w >= K) { b = 3; ab = c; } else { c += (int)h.w;
      if (c + (int)h.z >= K) { b = 2; ab = c; } else { c += (int)h.z;
      if (c + (int)h.y >= K) { b = 1; ab = c; } else { c += (int)h.y; b = 0; ab = c; } } } }
    const unsigned long long m = __ballot(mine);
    const int src = m ? (int)__builtin_ctzll(m) : 0;
    bsel = __builtin_amdgcn_readlane(lane * 4 + b, src); above = __builtin_amdgcn_readlane(ab, src);
}
__device__ __forceinline__ int mask_prefix(unsigned long long m) { return (int)__builtin_amdgcn_mbcnt_hi((unsigned)(m >> 32), __builtin_amdgcn_mbcnt_lo((unsigned)m, 0u)); }
template <class Fn> __device__ __forceinline__ void sel_sweep(const f32x4* rb4, int n4, int lane, int t, Fn fn) {
    f32x4 cur = rb4[lane];
    for (int c4 = 0; c4 < n4 - 1; ++c4) { const f32x4 nxt = rb4[(c4 + 1) * 64 + lane];
#pragma unroll
        for (int k = 0; k < 4; ++k) fn(cur[k], (c4 * 4 + k) * 64 + lane, true);
        cur = nxt; }
    { const int c4 = n4 - 1;
#pragma unroll
      for (int k = 0; k < 4; ++k) { const int idx = (c4 * 4 + k) * 64 + lane; fn(cur[k], idx, idx <= t); } }
}
template <int MODE = 0> __device__ __forceinline__ void indexer_select(Frame& F, int b, int t, const float* rowbuf, unsigned* hist, float* eqv, int* eqi) {
    unsigned short* selrow = (unsigned short*)(F.ws + (MODE ? WS_R0 : WS_SEL)) + (size_t)(b * SEQ + t) * 256;
    int lane = F.lane; asm volatile("" : "+v"(lane));
    const int nch = t / 64 + 1, n4 = (nch + 3) >> 2;
    const f32x4* rb4 = (const f32x4*)rowbuf;
    float mn = __builtin_huge_valf(), mx = -__builtin_huge_valf();
    sel_sweep(rb4, n4, lane, t, [&](float v, int, bool valid) { mn = valid ? fminf(mn, v) : mn; mx = valid ? fmaxf(mx, v) : mx; });
    mx = xor16_max(row_max16(mx)); { const auto r = __builtin_amdgcn_permlane32_swap(__float_as_uint(mx), __float_as_uint(mx), false, false); mx = fmaxf(__uint_as_float(r[0]), __uint_as_float(r[1])); }
    mn = -mn; mn = xor16_max(row_max16(mn)); { const auto r = __builtin_amdgcn_permlane32_swap(__float_as_uint(mn), __float_as_uint(mn), false, false); mn = -fmaxf(__uint_as_float(r[0]), __uint_as_float(r[1])); }
    const float scale = (mx > mn) ? 65535.0f / (mx - mn) : 0.f;
    *(u32x4*)(hist + lane * 4) = (u32x4){0u, 0u, 0u, 0u};
    sel_sweep(rb4, n4, lane, t, [&](float v, int, bool valid) { if (valid) { if (MODE == 2) ((volatile unsigned*)hist)[sel_code(v, mn, scale) >> 8] = 1u; else atomicAdd(&hist[sel_code(v, mn, scale) >> 8], 1u); } });
    int b1, above1; hist_find(hist, lane, KSEL, b1, above1);
    *(u32x4*)(hist + lane * 4) = (u32x4){0u, 0u, 0u, 0u};
    sel_sweep(rb4, n4, lane, t, [&](float v, int, bool valid) { const int code = sel_code(v, mn, scale); if (valid && (code >> 8) == b1) atomicAdd(&hist[code & 255], 1u); });
    int b2, above2; hist_find(hist, lane, KSEL - above1, b2, above2);
    const int T16 = (b1 << 8) | b2, need = KSEL - above1 - above2, ceq = (int)hist[b2];
    const bool all_eq = (ceq == need), collect = !all_eq && (ceq <= 64);
    const int eq_budget = all_eq ? 0x7fffffff : (collect ? 0 : need);
    int pos = 0, eqseen = 0;
    sel_sweep(rb4, n4, lane, t, [&](float v, int idx, bool valid) {
        const int code = sel_code(v, mn, scale);
        const bool gt = valid && code > T16, eq = valid && code == T16;
        const unsigned long long mg = __ballot(gt);
        const unsigned p = (unsigned)(pos + mask_prefix(mg));
        if (gt && p < (unsigned)KSEL) selrow[p] = (unsigned short)idx;
        pos += __popcll(mg);
        const unsigned long long me = __ballot(eq);
        if (me) {
            const int er = eqseen + mask_prefix(me); const bool te = eq && er < eq_budget;
            if (collect && eq) { eqv[er] = v; eqi[er] = idx; }
            eqseen += __popcll(me);
            const unsigned long long mte = __ballot(te);
            const unsigned pe = (unsigned)(pos + mask_prefix(mte));
            if (te && pe < (unsigned)KSEL) selrow[pe] = (unsigned short)idx;
            pos += __popcll(mte);
        }
    });
    if (collect && lane < ceq) {
        const float sv = eqv[lane]; const int idx = eqi[lane]; int rank = 0;
        for (int m = 0; m < ceq; ++m) { const float ov = eqv[m]; const int oi = eqi[m]; rank += (ov > sv || (ov == sv && oi < idx)) ? 1 : 0; }
        if (rank < need) selrow[KSEL - need + rank] = (unsigned short)idx;
    }
}
__device__ __forceinline__ void indexer_tile(Frame& F, int b, int t0) {
    const bf16_t* iq = (const bf16_t*)(F.ws + WS_IQ); const bf16_t* ik = (const bf16_t*)(F.ws + WS_IK); const float* iw = (const float*)(F.ws + WS_IW);
    int lane = F.lane; asm volatile("" : "+v"(lane));
    const int w = F.wave;
    if (t0 < KSEL) {
        const int t = t0 + w; unsigned short* selrow = (unsigned short*)(F.ws + WS_SEL) + (size_t)(b * SEQ + t) * 256;
#pragma unroll
        for (int p = 0; p < 4; ++p) { const int j = p * 64 + lane; selrow[j] = (unsigned short)(j <= t ? j : 0xFFFF); }
        return;
    }
    float* rowbuf = (float*)F.lds;
    unsigned char* stage = F.lds + 131072;
    const int p = w & 3, kh = w >> 2, hi = lane >> 5, r = lane & 31;
    const size_t qrow = (size_t)b * SEQ + t0 + 2 * p + (r >> 4);
    bf16x8 a[4];
#pragma unroll
    for (int ks = 0; ks < 4; ++ks) a[ks] = *(const bf16x8*)(iq + qrow * 1024 + (r & 15) * 64 + ks * 16 + 8 * hi);
    float wq[2][8];
#pragma unroll
    for (int q = 0; q < 2; ++q)
#pragma unroll
        for (int i = 0; i < 8; ++i) wq[q][i] = 0.5f * iw[((size_t)b * SEQ + t0 + 2 * p + q) * 16 + (i & 3) + 8 * ((i >> 2) & 1) + 4 * hi];
    const int nchunks = (t0 + 7) / 64 + 1, nsteps = (nchunks + 1) >> 1;
    const unsigned char* gsrc = (const unsigned char*)(ik + (size_t)b * SEQ * 64) + F.tid * 16;
    const int skey = F.tid >> 3, sc16 = F.tid & 7, soff = skey * 128 + ((sc16 ^ ((skey >> 1) & 7)) << 4);
    u32x4 sa0 = *(const u32x4*)gsrc, sb0 = sa0, sa1 = sa0, sb1 = sa0;
    sb0 = *(const u32x4*)(gsrc + (size_t)min(1, nchunks - 1) * 8192);
    sa1 = *(const u32x4*)(gsrc + (size_t)min(2, nchunks - 1) * 8192);
    sb1 = *(const u32x4*)(gsrc + (size_t)min(3, nchunks - 1) * 8192);
    __syncthreads();
#if PROBE_IDX != 1 && PROBE_IDX != 5
#define IDX_LD(c) (*(const u32x4*)(gsrc + (size_t)(c) * 8192))
#endif
#define IDX_MMA(SA, SB, ss, D0, D1) do { const int s_ = (ss); unsigned char* sb = stage + (s_ & 1) * 16384; \
        *(u32x4*)(sb + soff) = SA; *(u32x4*)(sb + 8192 + soff) = SB; \
        __syncthreads(); \
        SA = IDX_LD(min(2 * s_ + 4, nchunks - 1)); \
        SB = IDX_LD(min(2 * s_ + 5, nchunks - 1)); \
        _Pragma("unroll") for (int i = 0; i < 16; ++i) { D0[i] = 0.f; D1[i] = 0.f; } \
        _Pragma("unroll") for (int ks = 0; ks < 4; ++ks) { const unsigned char* bp = sb + key * 128 + (((ks * 2 + hi) ^ ((key >> 1) & 7)) << 4); \
            const bf16x8 bf0 = *(const bf16x8*)bp, bf1 = *(const bf16x8*)(bp + 8192); \
            D0 = __builtin_amdgcn_mfma_f32_32x32x16_bf16(a[ks], bf0, D0, 0, 0, 0); D1 = __builtin_amdgcn_mfma_f32_32x32x16_bf16(a[ks], bf1, D1, 0, 0, 0); } } while (0)
#define IDX_RED(ss, D0, D1) do { const int s_ = (ss); float x0_ = 0.f, x1_ = 0.f, y0_ = 0.f, y1_ = 0.f; \
        _Pragma("unroll") for (int i = 0; i < 8; ++i) { x0_ = wrelu_(wq[0][i], D0[i], x0_); x1_ = wrelu_(wq[1][i], D0[8 + i], x1_); y0_ = wrelu_(wq[0][i], D1[i], y0_); y1_ = wrelu_(wq[1][i], D1[8 + i], y1_); } \
        const float scx = swap32_pair(x0_, x1_), scy = swap32_pair(y0_, y1_); \
        *(f32x2*)(rowbuf + (2 * p + hi) * 4096 + ((s_ >> 1) * 64 + key) * 4 + 2 * (s_ & 1)) = (f32x2){scx, scy}; } while (0)
    const int key = kh * 32 + r;
    f32x16 dA0, dA1, dB0, dB1;
#if PROBE_IDX == 1
#define IDX_LD(c) (*(const u32x4*)(gsrc + (size_t)(c) * 8192))
#elif PROBE_IDX == 5
#define IDX_LD(c) SAVED
#endif
#if PROBE_IDX == 1 || PROBE_IDX == 5
    { const u32x4 SAVED = sa0;
    IDX_MMA(sa0, sb0, 0, dA0, dA1);
    for (int s2 = 0; s2 < nsteps; s2 += 2) {
        if (s2 + 1 < nsteps) IDX_MMA(sa1, sb1, s2 + 1, dB0, dB1);
        IDX_RED(s2, dA0, dA1);
        if (s2 + 2 < nsteps) IDX_MMA(sa0, sb0, s2 + 2, dA0, dA1);
        if (s2 + 1 < nsteps) IDX_RED(s2 + 1, dB0, dB1);
    }
    __syncthreads();
    sa0 = *(const u32x4*)gsrc;
    sb0 = *(const u32x4*)(gsrc + (size_t)min(1, nchunks - 1) * 8192);
    sa1 = *(const u32x4*)(gsrc + (size_t)min(2, nchunks - 1) * 8192);
    sb1 = *(const u32x4*)(gsrc + (size_t)min(3, nchunks - 1) * 8192); }
#undef IDX_LD
#define IDX_LD(c) (*(const u32x4*)(gsrc + (size_t)(c) * 8192))
#endif
    IDX_MMA(sa0, sb0, 0, dA0, dA1);
    for (int s2 = 0; s2 < nsteps; s2 += 2) {
        if (s2 + 1 < nsteps) IDX_MMA(sa1, sb1, s2 + 1, dB0, dB1);
        IDX_RED(s2, dA0, dA1);
        if (s2 + 2 < nsteps) IDX_MMA(sa0, sb0, s2 + 2, dA0, dA1);
        if (s2 + 1 < nsteps) IDX_RED(s2 + 1, dB0, dB1);
    }
#undef IDX_MMA
#undef IDX_RED
#undef IDX_LD
    __syncthreads();
    indexer_select(F, b, t0 + w, rowbuf + w * 4096, (unsigned*)(F.lds + 147456) + w * 256, (float*)(F.lds + 155648) + w * 64, (int*)(F.lds + 155648 + 2048) + w * 64);
#if PROBE_IDX >= 2
    indexer_select<PROBE_IDX - 1>(F, b, t0 + w, rowbuf + w * 4096, (unsigned*)(F.lds + 147456) + w * 256, (float*)(F.lds + 155648) + w * 64, (int*)(F.lds + 155648 + 2048) + w * 64);
#endif
}
__device__ __forceinline__ void phase3_indexer(Frame& F) {
    F.lane = lane_now(); F.tid = F.wave * 64 + F.lane;
    volatile LAS unsigned* misc = (volatile LAS unsigned*)((LAS unsigned char*)F.lds + MISC_OFF);
    const unsigned keep0 = misc[0], keep1 = misc[1];
    __syncthreads();
    const int nit = BATCH * (SEQ / 8);
    for (int k = 0;; ++k) {
        const int l = k * F.G + ((k & 1) ? (F.G - 1 - F.bid) : F.bid);
        if (l >= nit) { if (k * F.G >= nit) break; else continue; }
        const int qb = (SEQ / 8 - 1) - (l >> 3), b = l & 7;
        indexer_tile(F, b, qb * 8);
    }
    __syncthreads();
    if (F.tid == 0) { misc[0] = keep0; misc[1] = keep1; }
}

__device__ const unsigned char g_bucket[128] = {0, 1, 2, 3, 4, 5, 6, 7, 8, 9, 10, 11, 12, 13, 14, 15, 16, 16, 16, 17, 17, 18, 18, 18, 19, 19, 19, 20, 20, 20, 20, 21, 21, 21, 21, 22, 22, 22, 22, 22, 23, 23, 23, 23, 23, 23, 24, 24, 24, 24, 24, 24, 25, 25, 25, 25, 25, 25, 25, 26, 26, 26, 26, 26, 26, 26, 26, 27, 27, 27, 27, 27, 27, 27, 27, 27, 27, 28, 28, 28, 28, 28, 28, 28, 28, 28, 28, 29, 29, 29, 29, 29, 29, 29, 29, 29, 29, 29, 29, 30, 30, 30, 30, 30, 30, 30, 30, 30, 30, 30, 30, 30, 30, 31, 31, 31, 31, 31, 31, 31, 31, 31, 31, 31, 31, 31, 31, 31};
__device__ __forceinline__ void at_pv_step(f32x4 (&D0)[8], f32x4 (&D1)[8], const u32x4 (&buf)[8], LAS unsigned char* vwr, LAS unsigned char* ard, LAS unsigned char* brd) {
#pragma unroll
    for (int c = 0; c < 8; ++c) *(LAS u32x4*)(vwr + c * 16) = buf[c];
    const long pb = __builtin_bit_cast(long, __builtin_amdgcn_ds_read_tr8_b64_v2i32((LAS v2i*)brd));
#pragma unroll
    for (int tl = 0; tl < 8; ++tl) { const long va = __builtin_bit_cast(long, __builtin_amdgcn_ds_read_tr8_b64_v2i32((LAS v2i*)(ard + tl * 16))); D0[tl] = __builtin_amdgcn_mfma_f32_16x16x32_fp8_fp8(va, pb, D0[tl], 0, 0, 0); }
#pragma unroll
    for (int tl = 0; tl < 8; ++tl) { const long va = __builtin_bit_cast(long, __builtin_amdgcn_ds_read_tr8_b64_v2i32((LAS v2i*)(ard + 4608 + tl * 16))); D1[tl] = __builtin_amdgcn_mfma_f32_16x16x32_fp8_fp8(va, pb, D1[tl], 0, 0, 0); }
}
__device__ __forceinline__ void phase4_attention(Frame& F) {
    F.lane = lane_now(); F.tid = F.wave * 64 + F.lane;
    const unsigned char* q8 = F.ws + WS_Q8; const unsigned char* k8 = F.ws + WS_K8; const unsigned char* v8 = F.ws + WS_V8;
    const unsigned short* sel = (const unsigned short*)(F.ws + WS_SEL); bf16_t* ao = (bf16_t*)(F.ws + WS_ATTN);
    float* btab = (float*)F.lds;
    __syncthreads();
    for (int i = F.tid; i < 256; i += 512) btab[i] = F.rel_bias[i];
    __syncthreads();
    float* Pl = (float*)(F.lds + 4096 + F.wave * 12544); int* idl = (int*)((unsigned char*)Pl + 9216); float* psl = (float*)((unsigned char*)Pl + 12288); float* pml = psl + 8;
    LAS unsigned char* wl = (LAS unsigned char*)F.lds + 4096 + F.wave * 12544;
    const bool xmap = (F.G % 8) == 0;
    const int gw = xmap ? (F.bid / 8) * 8 + F.wave : F.bid * 8 + F.wave, NGW = xmap ? F.G : F.G * 8, nrows = xmap ? SEQ : MTOK;
    for (int rr = gw; rr < nrows; rr += NGW) {
        int lane = F.lane; asm volatile("" : "+v"(lane));
        const int row = xmap ? (F.bid & 7) * SEQ + rr : rr;
        const int b = row / SEQ, t = row % SEQ, r = lane & 31, hi = lane >> 5;
#pragma unroll
        for (int p = 0; p < 4; ++p) { idl[p * 64 + lane] = (int)sel[(size_t)row * 256 + p * 64 + lane]; }
        long a0[8], a1[8];
        { u32x4 qa[4];
#pragma unroll
          for (int i = 0; i < 4; ++i) qa[i] = (r < 8) ? *(const u32x4*)(q8 + (size_t)row * 1024 + r * 128 + hi * 64 + i * 16) : (u32x4){0u, 0u, 0u, 0u};
#pragma unroll
          for (int ks = 0; ks < 8; ++ks) { const unsigned lo = qa[ks >> 1][(ks & 1) * 2], hh = qa[ks >> 1][(ks & 1) * 2 + 1]; const long v = (long)(((unsigned long long)hh << 32) | lo);
              a0[ks] = (r < 4) ? v : 0l; a1[ks] = (r >= 4) ? v : 0l; } }
        f32x4 psum = (f32x4){0.f, 0.f, 0.f, 0.f}, pmax = psum;
#define AT_LOADK(buf, kb) do { const int key_ = idl[(kb) * 32 + r]; const int kc_ = key_ <= t ? key_ : 0; const unsigned char* kr_ = k8 + ((size_t)b * SEQ + kc_) * 256 + hi * 64; \
            _Pragma("unroll") for (int i = 0; i < 4; ++i) { buf[i] = *(const u32x4*)(kr_ + i * 16); buf[4 + i] = *(const u32x4*)(kr_ + 128 + i * 16); } } while (0)
#define AT_QK(buf, kb) do { const int key_ = idl[(kb) * 32 + r]; const bool valid_ = key_ <= t; const int kc_ = valid_ ? key_ : 0; \
            f32x16 d; _Pragma("unroll") for (int i = 0; i < 16; ++i) d[i] = 0.f; \
            _Pragma("unroll") for (int ks = 0; ks < 8; ++ks) { const long bv_ = (long)(((unsigned long long)buf[ks >> 1][(ks & 1) * 2 + 1] << 32) | buf[ks >> 1][(ks & 1) * 2]); d = __builtin_amdgcn_mfma_f32_32x32x16_fp8_fp8(a0[ks], bv_, d, 0, 0, 0); } \
            _Pragma("unroll") for (int ks = 0; ks < 8; ++ks) { const long bv_ = (long)(((unsigned long long)buf[4 + (ks >> 1)][(ks & 1) * 2 + 1] << 32) | buf[4 + (ks >> 1)][(ks & 1) * 2]); d = __builtin_amdgcn_mfma_f32_32x32x16_fp8_fp8(a1[ks], bv_, d, 0, 0, 0); } \
            const int dist_ = t - kc_; const int bkt_ = dist_ < 128 ? (int)g_bucket[dist_] : 31; \
            const f32x4 bias_ = *(const f32x4*)(btab + bkt_ * 8 + 4 * hi); f32x4 e_; \
            _Pragma("unroll") for (int i = 0; i < 4; ++i) e_[i] = valid_ ? __expf(d[i] * 0.08838834764831845f + bias_[i]) : 0.f; \
            psum += e_; _Pragma("unroll") for (int i = 0; i < 4; ++i) pmax[i] = fmaxf(pmax[i], e_[i]); *(f32x4*)(Pl + ((kb) * 32 + r) * 8 + 4 * hi) = e_; } while (0)
        {
            u32x4 kA[8], kB[8];
            AT_LOADK(kA, 0);
#pragma unroll 1
            for (int kb = 0; kb < 8; kb += 2) {
                AT_LOADK(kB, kb + 1);
                AT_QK(kA, kb);
                if (kb + 2 < 8) AT_LOADK(kA, kb + 2);
                AT_QK(kB, kb + 1);
            }
        }
#undef AT_LOADK
#undef AT_QK
#pragma unroll
        for (int i = 0; i < 4; ++i) { psum[i] = xor16_sum(row_sum16(psum[i])); pmax[i] = xor16_max(row_max16(pmax[i])); }
        if (r == 0) { *(f32x4*)(psl + 4 * hi) = psum; *(f32x4*)(pml + 4 * hi) = pmax; }
        const int fk = lane & 31, fg = lane >> 5, kq = lane >> 4, tq = (lane >> 1) & 7, tp = lane & 1;
#define AT_LOADV(buf, ks_) do { const int key_ = idl[(ks_) * 32 + fk]; const int kc_ = key_ <= t ? key_ : 0; const unsigned char* vr_ = v8 + ((size_t)b * SEQ + kc_) * 256 + fg * 128; \
            _Pragma("unroll") for (int c = 0; c < 8; ++c) buf[c] = *(const u32x4*)(vr_ + c * 16); } while (0)
        u32x4 vA[8], vB[8];
        AT_LOADV(vA, 0);
        { const f32x4 m0 = *(const f32x4*)pml, m1 = *(const f32x4*)(pml + 4);
          f32x4 r0, r1;
#pragma unroll
          for (int i = 0; i < 4; ++i) { r0[i] = __builtin_amdgcn_rcpf(m0[i]); r1[i] = __builtin_amdgcn_rcpf(m1[i]); }
#pragma unroll
          for (int i = 0; i < 4; ++i) { const int key = i * 64 + lane;
              *(LAS u32x2*)(wl + 10240 + key * 8) = pack8_fp8(*(const f32x4*)(Pl + key * 8) * r0, *(const f32x4*)(Pl + key * 8 + 4) * r1); } }
        f32x4 D0[8], D1[8];
#pragma unroll
        for (int tl = 0; tl < 8; ++tl) { D0[tl] = (f32x4){0.f, 0.f, 0.f, 0.f}; D1[tl] = D0[tl]; }
        LAS unsigned char* vwr = wl + fg * 4608 + fk * 144;
        LAS unsigned char* ard = wl + (kq * 8 + tq) * 144 + 8 * tp;
        LAS unsigned char* brd = wl + 10240 + (kq * 8 + tq) * 8;
#pragma unroll 1
        for (int ks = 0; ks < 8; ks += 2) {
            AT_LOADV(vB, ks + 1);
            at_pv_step(D0, D1, vA, vwr, ard, brd + ks * 256);
            if (ks + 2 < 8) AT_LOADV(vA, ks + 2);
            at_pv_step(D0, D1, vB, vwr, ard, brd + (ks + 1) * 256);
        }
#undef AT_LOADV
        { const int n = lane & 15, q4 = lane >> 4;
          if (n < 8) { const float sc = pml[n] / psl[n]; const bool g1 = n >= 4;
              bf16_t* op = ao + (size_t)row * 1024 + n * 128 + q4 * 4;
#pragma unroll
              for (int tl = 0; tl < 8; ++tl) { const f32x4 d = (g1 ? D1[tl] : D0[tl]) * sc;
                  *(u32x2*)(op + tl * 16) = (u32x2){cvt_pk_bf16(d[0], d[1]), cvt_pk_bf16(d[2], d[3])}; } } }
    }
}

__device__ __forceinline__ float dot16f8(u32x4 w, const float* h) {
    float s = 0.f;
#pragma unroll
    for (int d = 0; d < 4; ++d) { const f32x2 lo = __builtin_amdgcn_cvt_pk_f32_fp8((int)w[d], false), hi = __builtin_amdgcn_cvt_pk_f32_fp8((int)w[d], true);
        s += lo.x * h[4 * d] + lo.y * h[4 * d + 1] + hi.x * h[4 * d + 2] + hi.y * h[4 * d + 3]; }
    return s;
}
__device__ __forceinline__ void fma16f8(u32x4 w, float cf, float* acc) {
#pragma unroll
    for (int d = 0; d < 4; ++d) { const f32x2 lo = __builtin_amdgcn_cvt_pk_f32_fp8((int)w[d], false), hi = __builtin_amdgcn_cvt_pk_f32_fp8((int)w[d], true);
        acc[4 * d] += cf * lo.x; acc[4 * d + 1] += cf * lo.y; acc[4 * d + 2] += cf * hi.x; acc[4 * d + 3] += cf * hi.y; }
}
__device__ __forceinline__ float gelu_erf(float x) { return 0.5f * x * (1.0f + erff(x * 0.70710678118654752f)); }
__device__ __forceinline__ void ce_k(unsigned& a, unsigned& b) { const unsigned hi = a > b ? a : b, lo = a > b ? b : a; a = hi; b = lo; }
__device__ __forceinline__ void ce_kp(unsigned& ka, unsigned& pa, unsigned& kb, unsigned& pb) { const bool sw = kb > ka; const unsigned k0 = sw ? kb : ka, k1 = sw ? ka : kb, p0 = sw ? pb : pa, p1 = sw ? pa : pb; ka = k0; kb = k1; pa = p0; pb = p1; }
__device__ __forceinline__ void bmerge16(unsigned (&x)[16]) {
#pragma unroll
    for (int jj = 0; jj < 4; ++jj) { const int j = 8 >> jj;
#pragma unroll
        for (int i = 0; i < 16; ++i) { const int l = i ^ j; if (l > i) ce_k(x[i], x[l]); }
        __builtin_amdgcn_sched_barrier(0); }
}
__device__ __forceinline__ void bmerge16p(unsigned (&x)[16], unsigned (&p)[16]) {
#pragma unroll
    for (int jj = 0; jj < 4; ++jj) { const int j = 8 >> jj;
#pragma unroll
        for (int i = 0; i < 16; ++i) { const int l = i ^ j; if (l > i) ce_kp(x[i], p[i], x[l], p[l]); }
        __builtin_amdgcn_sched_barrier(0); }
}
__device__ __forceinline__ void bsort16(unsigned (&x)[16]) {
#pragma unroll
    for (int kk = 1; kk <= 4; ++kk) { const int k = 1 << kk;
#pragma unroll
        for (int jj = 0; jj < 4; ++jj) { const int j = (k >> 1) >> jj;
            if (j > 0) {
#pragma unroll
                for (int i = 0; i < 16; ++i) { const int l = i ^ j; if (l > i) { if ((i & k) == 0) ce_k(x[i], x[l]); else ce_k(x[l], x[i]); } }
                __builtin_amdgcn_sched_barrier(0); } } }
}
__device__ __forceinline__ void bsort16p(unsigned (&x)[16], unsigned (&p)[16]) {
#pragma unroll
    for (int kk = 1; kk <= 4; ++kk) { const int k = 1 << kk;
#pragma unroll
        for (int jj = 0; jj < 4; ++jj) { const int j = (k >> 1) >> jj;
            if (j > 0) {
#pragma unroll
                for (int i = 0; i < 16; ++i) { const int l = i ^ j; if (l > i) { if ((i & k) == 0) ce_kp(x[i], p[i], x[l], p[l]); else ce_kp(x[l], p[l], x[i], p[i]); } }
                __builtin_amdgcn_sched_barrier(0); } } }
}
__device__ __forceinline__ void top16_row(const unsigned char* rowp, unsigned (&t)[16]) {
#pragma unroll
    for (int i = 0; i < 16; ++i) t[i] = 0u;
#pragma unroll 1
    for (int g = 0; g < 8; ++g) {
        unsigned w[8];
#pragma unroll
        for (int q = 0; q < 4; ++q) { const u32x2 v = *(const u32x2*)(rowp + g * 32 + q * 8); w[2 * q] = v.x; w[2 * q + 1] = v.y; }
        unsigned sk[16];
#pragma unroll
        for (int d = 0; d < 8; ++d) {
            const unsigned lo = w[d] << 16, hi = w[d];
            const unsigned xl = lo ^ ((unsigned)((int)lo >> 31) | 0x80000000u), xh = hi ^ ((unsigned)((int)hi >> 31) | 0x80000000u);
            sk[2 * d] = ((xl >> 9) & 0xFFFFFF80u) | (unsigned)(127 - (g * 16 + 2 * d));
            sk[2 * d + 1] = ((xh >> 9) & 0xFFFFFF80u) | (unsigned)(127 - (g * 16 + 2 * d + 1)); }
        bsort16(sk);
#pragma unroll
        for (int i = 0; i < 16; ++i) t[i] = t[i] > sk[15 - i] ? t[i] : sk[15 - i];
        bmerge16(t);
    }
}
__device__ __forceinline__ float key_val(unsigned key) { const unsigned y = (key << 9) & 0xFFFF0000u; return __uint_as_float((y ^ (~(unsigned)((int)y >> 31) | 0x80000000u)) & 0xFFFF0000u); }
__device__ __forceinline__ unsigned sum_key(float s, int c) { const unsigned u = __float_as_uint(s); return ((u ^ ((unsigned)((int)u >> 31) | 0x80000000u)) & ~63u) | (unsigned)(63 - c); }
__device__ __forceinline__ float sum_val(unsigned k) { const unsigned y = k & ~63u; return __uint_as_float(y ^ (~(unsigned)((int)y >> 31) | 0x80000000u)); }
typedef __bf16 bf2_t __attribute__((ext_vector_type(2)));
__device__ __forceinline__ float dot2_bf(unsigned a, unsigned b, float c) { return __builtin_amdgcn_fdot2_f32_bf16(__builtin_bit_cast(bf2_t, a), __builtin_bit_cast(bf2_t, b), c, false); }
__device__ __forceinline__ float dot32_f6b(u32x4 wa, u32x2 wb, u32x4 h0, u32x4 h1, u32x4 h2, u32x4 h3) {
    const bf16x32 dec = __builtin_amdgcn_cvt_scalef32_pk32_bf16_fp6((u32x6){wa.x, wa.y, wa.z, wa.w, wb.x, wb.y}, 1.0f);
    const u32x16 ud = __builtin_bit_cast(u32x16, dec);
    float acc = 0.f;
    acc = dot2_bf(ud.s0, h0.x, acc); acc = dot2_bf(ud.s1, h0.y, acc); acc = dot2_bf(ud.s2, h0.z, acc); acc = dot2_bf(ud.s3, h0.w, acc);
    acc = dot2_bf(ud.s4, h1.x, acc); acc = dot2_bf(ud.s5, h1.y, acc); acc = dot2_bf(ud.s6, h1.z, acc); acc = dot2_bf(ud.s7, h1.w, acc);
    acc = dot2_bf(ud.s8, h2.x, acc); acc = dot2_bf(ud.s9, h2.y, acc); acc = dot2_bf(ud.sa, h2.z, acc); acc = dot2_bf(ud.sb, h2.w, acc);
    acc = dot2_bf(ud.sc, h3.x, acc); acc = dot2_bf(ud.sd, h3.y, acc); acc = dot2_bf(ud.se, h3.z, acc); acc = dot2_bf(ud.sf, h3.w, acc);
    return acc;
}
__device__ const unsigned char g_cab[64] = {0, 1, 2, 3, 4, 5, 6, 7, 8, 9, 10, 11, 12, 13, 14, 15, 16, 17, 18, 19, 20, 21, 22, 23, 32, 33, 34, 35, 36, 48, 49, 50, 51, 64, 65, 66, 80, 81, 96, 97, 112, 113, 128, 144, 160, 176, 192, 208, 224, 240, 0, 0, 0, 0, 0, 0, 0, 0, 0, 0, 0, 0, 0, 0};
__device__ __forceinline__ void phase10_peer(Frame& F) {
    F.lane = lane_now(); F.tid = F.wave * 64 + F.lane;
    const bf16_t* sub = (const bf16_t*)(F.ws + WS_SUB); const bf16_t* h2 = (const bf16_t*)(F.ws + WS_H2);
    const unsigned char* pu = F.ws + WS_PU; unsigned* pairs = (unsigned*)(F.ws + WS_PAIRS);
    const int gw = F.bid * 8 + F.wave, NGW = F.G * 8;
    unsigned char* wb = F.lds + F.wave * 19200;
    unsigned char* h2b = wb; unsigned short* gl16 = (unsigned short*)(wb + 16896); unsigned* hist = (unsigned*)(wb + 18944); unsigned* base = hist + 32;
    unsigned* tmp = (unsigned*)wb;
    unsigned* wls0 = (unsigned*)(F.ws + WS_WLS) + (size_t)gw * 1024;
    const int ntok = (MTOK - gw + NGW - 1) / NGW;
    constexpr int CA[50] = {0,0,0,0,0,0,0,0,0,0,0,0,0,0,0,0, 1,1,1,1,1,1,1,1, 2,2,2,2,2, 3,3,3,3, 4,4,4, 5,5, 6,6, 7,7, 8,9,10,11,12,13,14,15};
    constexpr int CB[50] = {0,1,2,3,4,5,6,7,8,9,10,11,12,13,14,15, 0,1,2,3,4,5,6,7, 0,1,2,3,4, 0,1,2,3, 0,1,2, 0,1, 0,1, 0,1, 0,0,0,0,0,0,0,0};
    for (int p0 = 0; p0 < ntok; p0 += 8) {
        int lane = F.lane; asm volatile("" : "+v"(lane));
        const int nt = (ntok - p0) < 8 ? (ntok - p0) : 8;
        {
            u32x4 st[16];
#define SEL_LOAD(half) do { asm volatile("" : "+v"(lane)); const int srow_l = lane >> 4, scol = lane & 15; _Pragma("unroll") for (int it = 0; it < 16; ++it) { const int r_ = it * 4 + srow_l; int ti_ = r_ >> 3; ti_ = ti_ < nt ? ti_ : nt - 1; \
                st[it] = *(const u32x4*)(sub + (size_t)(gw + (p0 + ti_) * NGW) * 2048 + (r_ & 7) * 256 + (half) * 128 + scol * 8); } } while (0)
#define SEL_STORE() do { const int srow_l = lane >> 4, scol = lane & 15; _Pragma("unroll") for (int it = 0; it < 16; ++it) { unsigned char* d_ = wb + (it * 4 + srow_l) * 264 + scol * 16; \
                *(u32x2*)d_ = (u32x2){st[it].x, st[it].y}; *(u32x2*)(d_ + 8) = (u32x2){st[it].z, st[it].w}; } } while (0)
            unsigned tA[16], tB[16];
            SEL_LOAD(0); SEL_STORE();
            __builtin_amdgcn_sched_barrier(0);
            top16_row(wb + lane * 264, tA);
            __builtin_amdgcn_sched_barrier(0);
            asm volatile("" : "+v"(tA[0]), "+v"(tA[1]), "+v"(tA[2]), "+v"(tA[3]), "+v"(tA[4]), "+v"(tA[5]), "+v"(tA[6]), "+v"(tA[7]), "+v"(tA[8]), "+v"(tA[9]), "+v"(tA[10]), "+v"(tA[11]), "+v"(tA[12]), "+v"(tA[13]), "+v"(tA[14]), "+v"(tA[15]) :: "memory");
            SEL_LOAD(1); SEL_STORE();
            __builtin_amdgcn_sched_barrier(0);
            top16_row(wb + lane * 264, tB);
            __builtin_amdgcn_sched_barrier(0);
#undef SEL_LOAD
#undef SEL_STORE
            float vA[16], vB[16];
            { unsigned pa[4] = {0u, 0u, 0u, 0u}, pb[4] = {0u, 0u, 0u, 0u};
#pragma unroll
              for (int i = 0; i < 16; ++i) { vA[i] = key_val(tA[i]); vB[i] = key_val(tB[i]); pa[i >> 2] |= (127u - (tA[i] & 127u)) << (8 * (i & 3)); pb[i >> 2] |= (127u - (tB[i] & 127u)) << (8 * (i & 3)); }
              unsigned char* rp = wb + lane * 264;
              *(u32x2*)rp = (u32x2){pa[0], pa[1]}; *(u32x2*)(rp + 8) = (u32x2){pa[2], pa[3]}; *(u32x2*)(rp + 16) = (u32x2){pb[0], pb[1]}; *(u32x2*)(rp + 24) = (u32x2){pb[2], pb[3]}; }
            unsigned tk[16];
#pragma unroll
            for (int c = 0; c < 16; ++c) tk[c] = sum_key(vA[CA[c]] + vB[CB[c]], c);
            bsort16(tk);
#pragma unroll
            for (int grp = 1; grp < 3; ++grp) {
                unsigned sk[16];
#pragma unroll
                for (int e = 0; e < 16; ++e) { const int c = grp * 16 + e; sk[e] = sum_key(vA[CA[c]] + vB[CB[c]], c); }
                bsort16(sk);
#pragma unroll
                for (int i = 0; i < 16; ++i) tk[i] = tk[i] > sk[15 - i] ? tk[i] : sk[15 - i];
                bmerge16(tk);
            }
#pragma unroll
            for (int c = 48; c < 50; ++c) { unsigned k = sum_key(vA[CA[c]] + vB[CB[c]], c);
#pragma unroll
                for (int i = 0; i < 16; ++i) ce_k(tk[i], k); }
            const float s0 = sum_val(tk[0]); float ev[16], esum = 0.f;
#pragma unroll
            for (int r = 0; r < 16; ++r) { ev[r] = __expf(sum_val(tk[r]) - s0); esum += ev[r]; }
            const float einv = 1.0f / esum;
            unsigned eid[16];
            { const unsigned char* rp = wb + lane * 264;
#pragma unroll
              for (int r = 0; r < 16; ++r) { const unsigned cab = g_cab[63u - (tk[r] & 63u)]; eid[r] = (unsigned)rp[cab >> 4] * 128u + (unsigned)rp[16 + (cab & 15u)]; } }
            if ((lane >> 3) < nt) {
#pragma unroll
                for (int r = 0; r < 16; ++r) { const int e = lane * 16 + r; tmp[e] = ((unsigned)e << 14) | eid[r]; gl16[e] = (unsigned short)(cvt_pk_bf16(ev[r] * einv, 0.f) & 0xffffu); } }
        }
        asm volatile("" : "+v"(lane));
#pragma unroll 1
        for (int grp = 0; grp < 2; ++grp) {
            const int ng = nt - grp * 4; const int ne = (ng <= 0 ? 0 : (ng < 4 ? ng : 4)) * 128;
            if (ne == 0) break;
            unsigned* wls = wls0 + grp * 512;
            if (lane < 32) hist[lane] = 0u;
            unsigned ent[8]; unsigned rk[8];
#pragma unroll
            for (int q = 0; q < 8; ++q) { const int e = q * 64 + lane; ent[q] = (e < ne) ? tmp[grp * 512 + e] : 0u; rk[q] = (e < ne) ? atomicAdd(&hist[(ent[q] & 0x3FFFu) >> 9], 1u) : 0u; }
            { int hv = lane < 32 ? (int)hist[lane] : 0; int x = hv;
              x += __builtin_amdgcn_update_dpp(0, x, 0x111, 0xF, 0xF, true); x += __builtin_amdgcn_update_dpp(0, x, 0x112, 0xF, 0xF, true);
              x += __builtin_amdgcn_update_dpp(0, x, 0x114, 0xF, 0xF, true); x += __builtin_amdgcn_update_dpp(0, x, 0x118, 0xF, 0xF, true);
              const int t0 = __builtin_amdgcn_readlane(x, 15); if (lane >= 16) x += t0;
              if (lane < 32) base[lane] = (unsigned)(x - hv); }
#pragma unroll
            for (int q = 0; q < 8; ++q) { const int e = q * 64 + lane; if (e < ne) wls[base[(ent[q] & 0x3FFFu) >> 9] + rk[q]] = ent[q]; }
        }
        asm volatile("s_waitcnt vmcnt(0)" ::: "memory");
#pragma unroll 1
        for (int grp = 0; grp < 2; ++grp) {
            const int ng = nt - grp * 4; const int ngc = ng <= 0 ? 0 : (ng < 4 ? ng : 4), ne = ngc * 128;
            if (ne == 0) break;
            const unsigned* wls = wls0 + grp * 512;
            asm volatile("" : "+v"(lane));
#pragma unroll 1
            for (int i = 0; i < ngc; ++i) { const bf16_t* hr = h2 + (size_t)(gw + (p0 + grp * 4 + i) * NGW) * 2048 + lane * 32;
#pragma unroll
                for (int q = 0; q < 4; ++q) *(u32x4*)(h2b + i * 4096 + q * 1024 + lane * 16) = *(const u32x4*)(hr + q * 8); }
            unsigned entn = __hip_atomic_load(wls + lane, __ATOMIC_RELAXED, __HIP_MEMORY_SCOPE_AGENT);
#pragma unroll 1
            for (int c = 0; c < ne; c += 64) {
                const unsigned ent64 = entn;
                if (c + 64 < ne) entn = __hip_atomic_load(wls + c + 64 + lane, __ATOMIC_RELAXED, __HIP_MEMORY_SCOPE_AGENT);
#pragma unroll 1
                for (int i0 = 0; i0 < 64; i0 += 8) {
                    u32x4 wA[8]; u32x2 wB[8]; unsigned en[8];
#pragma unroll
                    for (int jj = 0; jj < 8; ++jj) { en[jj] = (unsigned)__builtin_amdgcn_readlane((int)ent64, i0 + jj); const unsigned char* ur = pu + (size_t)(en[jj] & 0x3FFFu) * 1536 + lane * 24;
                        const u32x2 t0 = *(const u32x2*)ur, t1 = *(const u32x2*)(ur + 8); wA[jj] = (u32x4){t0.x, t0.y, t1.x, t1.y}; wB[jj] = *(const u32x2*)(ur + 16); }
                    float pr[8];
#pragma unroll
                    for (int jj = 0; jj < 8; ++jj) { const unsigned char* hp = h2b + ((en[jj] >> 21) & 3u) * 4096 + lane * 16;
                        pr[jj] = dot32_f6b(wA[jj], wB[jj], *(const u32x4*)hp, *(const u32x4*)(hp + 1024), *(const u32x4*)(hp + 2048), *(const u32x4*)(hp + 3072)); __builtin_amdgcn_sched_barrier(0); }
#pragma unroll
                    for (int i = 0; i < 4; ++i) pr[i] = swap32_pair(pr[i], pr[i + 4]);
#pragma unroll
                    for (int i = 0; i < 2; ++i) pr[i] = swap16_pair(pr[i], pr[i + 2]);
                    const bool b3 = (lane & 8) != 0;
                    { const float snd = b3 ? pr[0] : pr[1], kp = b3 ? pr[1] : pr[0]; pr[0] = kp + dpp_f<DPP_ROR8>(snd); }
                    float tot = pr[0]; tot += dpp_f<DPP_XOR1>(tot); tot += dpp_f<DPP_XOR2>(tot); tot += dpp_f<DPP_HMIRROR>(tot);
                    const unsigned em = (unsigned)__shfl((int)ent64, i0 + (lane >> 3));
                    if ((lane & 7) == 0) {
                        const int ti = (int)(em >> 21), j = (int)((em >> 14) & 127u), row = gw + (p0 + ti) * NGW;
                        const float cf = gelu_erf(tot * (1.0f / 96.0f)) * __uint_as_float((unsigned)gl16[(em >> 14) & 1023u] << 16);
                        pairs[((size_t)(row >> 6) * 128 + j) * 64 + (row & 63)] = ((unsigned)__builtin_bit_cast(unsigned short, (_Float16)cf) << 16) | (em & 0x3FFFu);
                    }
                }
            }
        }
    }
}

__device__ __forceinline__ void phase11_peer_v(Frame& F, float* dst) {
    F.lane = lane_now(); F.tid = F.wave * 64 + F.lane;
    const unsigned* pairs = (const unsigned*)(F.ws + WS_PAIRS); const float* mf = (const float*)(F.ws + WS_MODF);
    unsigned long long* vs = (unsigned long long*)F.lds;
    for (int c = F.bid; c < DM / 8; c += F.G) {
        __syncthreads();
        { const u32x4* src = (const u32x4*)(F.ws + WS_PV + (size_t)c * NEXP * 8); u32x4* dst = (u32x4*)F.lds;
#pragma unroll 4
          for (int i = F.tid; i < NEXP * 8 / 16; i += 512) dst[i] = src[i]; }
        __syncthreads();
        for (int tile = F.wave; tile < MTOK / 64; tile += 8) {
            int lane = F.lane; asm volatile("" : "+v"(lane));
            const unsigned* pp = pairs + (size_t)tile * 128 * 64 + lane;
            const int row = tile * 64 + lane;
            const float* gt2 = mf + (size_t)(tile / (SEQ / 64)) * 12288 + 10240 + c * 8;
            const float* ip = F.out + (size_t)row * 2048 + c * 8; float* op = dst + (size_t)row * 2048 + c * 8;
            const f32x4 x0 = *(const f32x4*)ip, x1 = *(const f32x4*)(ip + 4), g0 = *(const f32x4*)gt2 * 0.25f, g1 = *(const f32x4*)(gt2 + 4) * 0.25f;
            typedef __fp16 h2_t __attribute__((__vector_size__(2 * sizeof(__fp16))));
            h2_t acc[4];
#pragma unroll
            for (int i = 0; i < 4; ++i) acc[i] = (h2_t){(__fp16)0.f, (__fp16)0.f};
#define P11_LOAD(dst, j0) do { _Pragma("unroll") for (int jj = 0; jj < 16; ++jj) dst[jj] = pp[((j0) + jj) * 64]; } while (0)
#define P11_COMP(src) do { _Pragma("unroll") for (int jj = 0; jj < 16; ++jj) { const unsigned long long v = vs[src[jj] & 0x3FFFu]; \
                    const h2_t cf = __builtin_bit_cast(h2_t, __builtin_amdgcn_perm(src[jj], src[jj], 0x03020302u)); \
                    const int lo = (int)(unsigned)v, hi = (int)(unsigned)(v >> 32); \
                    acc[0] = __builtin_elementwise_fma(__builtin_amdgcn_cvt_scalef32_pk_f16_fp8(lo, 1.0f, false), cf, acc[0]); acc[1] = __builtin_elementwise_fma(__builtin_amdgcn_cvt_scalef32_pk_f16_fp8(lo, 1.0f, true), cf, acc[1]); \
                    acc[2] = __builtin_elementwise_fma(__builtin_amdgcn_cvt_scalef32_pk_f16_fp8(hi, 1.0f, false), cf, acc[2]); acc[3] = __builtin_elementwise_fma(__builtin_amdgcn_cvt_scalef32_pk_f16_fp8(hi, 1.0f, true), cf, acc[3]); } } while (0)
            unsigned pa[16], pb[16];
            P11_LOAD(pa, 0);
#pragma unroll 1
            for (int j0 = 0; j0 < 128; j0 += 32) {
                P11_LOAD(pb, j0 + 16);
                P11_COMP(pa);
                if (j0 + 32 < 128) P11_LOAD(pa, j0 + 32);
                P11_COMP(pb);
            }
#if PROBE_P11X == 1
            { h2_t sv[4]; for (int i = 0; i < 4; ++i) sv[i] = acc[i];
#pragma unroll 1
              for (int j0 = 0; j0 < 128; j0 += 32) {
#pragma unroll
                for (int jj = 0; jj < 16; ++jj) { asm volatile("" : "+v"(pa[jj])); asm volatile("" : "+v"(pb[jj])); }
                P11_COMP(pa); P11_COMP(pb); }
              asm volatile("" :: "v"(acc[0]), "v"(acc[1]), "v"(acc[2]), "v"(acc[3])); for (int i = 0; i < 4; ++i) acc[i] = sv[i]; }
#elif PROBE_P11X == 2
            { P11_LOAD(pa, 0);
#pragma unroll 1
              for (int j0 = 0; j0 < 128; j0 += 32) {
                P11_LOAD(pb, j0 + 16);
#pragma unroll
                for (int jj = 0; jj < 16; ++jj) asm volatile("" :: "v"(pa[jj]));
                if (j0 + 32 < 128) P11_LOAD(pa, j0 + 32);
#pragma unroll
                for (int jj = 0; jj < 16; ++jj) asm volatile("" :: "v"(pb[jj]));
              } }
#endif
#undef P11_LOAD
#undef P11_COMP
            *(f32x4*)op = x0 + g0 * (f32x4){(float)acc[0][0], (float)acc[0][1], (float)acc[1][0], (float)acc[1][1]};
            *(f32x4*)(op + 4) = x1 + g1 * (f32x4){(float)acc[2][0], (float)acc[2][1], (float)acc[3][0], (float)acc[3][1]};
        }
    }
}

__global__ void __launch_bounds__(512, 2) fwd_kernel(Args args) {
    extern __shared__ __attribute__((aligned(16))) unsigned char lds[];
    Frame F;
    F.lds = lds; F.ws = args.ws; F.tid = threadIdx.x; F.lane = F.tid & 63; F.wave = __builtin_amdgcn_readfirstlane(F.tid >> 6); F.G = gridDim.x; F.bid = blockIdx.x;
    F.x = args.in[0]; F.c = args.in[1]; F.w_ada = args.in[2]; F.b_ada = args.in[3]; F.g1 = args.in[4]; F.g2 = args.in[5]; F.w_in = args.in[6]; F.g_q = args.in[7]; F.g_k = args.in[8];
    F.rel_bias = args.in[9]; F.pool_w = args.in[10]; F.pool_scale = args.in[11]; F.w_ab = args.in[12]; F.w_pb = args.in[13]; F.w_out = args.in[14]; F.w_pq = args.in[15];
    F.peer_keys = args.in[16]; F.peer_u = args.in[17]; F.peer_v = args.in[18]; F.out = args.out;
    LAS unsigned char* ldsl = (LAS unsigned char*)lds;
    volatile LAS unsigned* misc = (volatile LAS unsigned*)(ldsl + MISC_OFF);
    if (F.tid < 4) misc[F.tid] = 0u;
    __syncthreads();
    unsigned* barw = (unsigned*)(args.ws + WS_CTL) + (size_t)args.li * XCD_BAR_WORDS;
    XcdBarrier bar; bar.bar = barw; bar.x = 0; bar.st = misc;
    const int lo = args.ph_lo, hi = args.ph_hi;
    if (hi - lo > 1) bar = xcd_barrier_post(barw, misc);
#define IN(k) (lo <= (k) && (k) < hi)
#define SEAM(k) do { if (IN(k) && IN((k) + 1)) xcd_barrier(bar, F.wave); } while (0)
    bf16_t* R0 = (bf16_t*)(F.ws + WS_R0);

#define PH2_BODY { \
        { pg8::Gemm g{(const bf16_t*)(F.ws + WS_H1F8), (const bf16_t*)(F.ws + WS_WIN8), MTOK, 5632, DM / 2, DM / 2, 0, nullptr, nullptr, 0, 0}; pg8::StaticOrder S; S.init(MTOK, 5632, F.G, F.bid); \
          EpiInproj<true> E{(bf16_t*)(F.ws + WS_QN), (bf16_t*)(F.ws + WS_KN), (bf16_t*)(F.ws + WS_V), (bf16_t*)(F.ws + WS_IQ), (bf16_t*)(F.ws + WS_IK), (bf16_t*)(F.ws + WS_PL), \
                    (bf16_t*)(F.ws + WS_GA), (bf16_t*)(F.ws + WS_GP), (float*)(F.ws + WS_IW)}; \
          pg8::gemm_phase<EpiInproj<true>, true>(ldsl, g, S, E, F.wave); } \
        { pg8::Gemm g{R0, (const bf16_t*)(F.ws + WS_WIN16), MTOK, 2304, DM, DM, 0, nullptr, nullptr, 0, 0}; pg8::StaticOrder S; S.init(MTOK, 2304, F.G, F.bid); \
          EpiInproj<false> E{(bf16_t*)(F.ws + WS_QN), (bf16_t*)(F.ws + WS_KN), (bf16_t*)(F.ws + WS_V), (bf16_t*)(F.ws + WS_IQ), (bf16_t*)(F.ws + WS_IK), (bf16_t*)(F.ws + WS_PL), \
                    (bf16_t*)(F.ws + WS_GA), (bf16_t*)(F.ws + WS_GP), (float*)(F.ws + WS_IW)}; \
          pg8::gemm_phase<EpiInproj<false>>(ldsl, g, S, E, F.wave); } }
#define PH3_BODY { phase3_pooled(F); phase3_indexer(F); __syncthreads(); }
#define PH4_BODY { \
        phase4_attention(F); \
        __syncthreads(); \
        pg8::Gemm g{(const bf16_t*)(F.ws + WS_POOLED), (const bf16_t*)(F.ws + WS_POOLW), MTOK, PW, 256, 1024, 256, nullptr, nullptr, 0, 0}; pg8::StaticOrder S; S.init(MTOK, PW, F.G, F.bid); \
        EpiBf16Scale E{(bf16_t*)(F.ws + WS_POOL2), 1024, F.pool_scale}; \
        pg8::gemm_phase<EpiBf16Scale>(ldsl, g, S, E, F.wave); }
#define PH5_BODY { \
        pg8::Gemm g{(const bf16_t*)(F.ws + WS_ATTN), (const bf16_t*)(F.ws + WS_WAB), MTOK, DM, 2048, 1024, 0, (const bf16_t*)(F.ws + WS_POOL2), (const bf16_t*)(F.ws + WS_WPB), 16, 1024}; \
        pg8::StaticOrder S; S.init(MTOK, DM, F.G, F.bid); \
        EpiMerge E{(unsigned char*)R0, (const bf16_t*)(F.ws + WS_GA), (const bf16_t*)(F.ws + WS_GP)}; pg8::gemm_phase<EpiMerge>(ldsl, g, S, E, F.wave); }
#define PH6_BODY { \
        pg8::Gemm g{R0, (const bf16_t*)(F.ws + WS_WOUT), MTOK, DM, DM / 2, DM / 2, 0, nullptr, nullptr, 0, 0}; pg8::StaticOrder S; S.init(MTOK, DM, F.G, F.bid); \
        EpiResid E{F.x, F.out, (const float*)(F.ws + WS_MODF) + 4096}; pg8::gemm_phase<EpiResid, true>(ldsl, g, S, E, F.wave); }
#define PH8_BODY { \
        pg8::Gemm g{(const bf16_t*)(F.ws + WS_H2), (const bf16_t*)(F.ws + WS_WPQ), MTOK, DM, DM, DM, 0, nullptr, nullptr, 0, 0}; pg8::StaticOrder S; S.init(MTOK, DM, F.G, F.bid); \
        EpiBf16Scale E{R0, 2048, nullptr}; pg8::gemm_phase<EpiBf16Scale>(ldsl, g, S, E, F.wave); }
#define PH9_BODY { \
        pg8::Gemm g{R0, (const bf16_t*)(F.ws + WS_KEYSBD), MTOK, DM, 256, DM, 256, nullptr, nullptr, 0, 0}; pg8::StaticOrder S; S.init(MTOK, DM, F.G, F.bid); \
        EpiBf16Scale E{(bf16_t*)(F.ws + WS_SUB), 2048, nullptr}; pg8::gemm_phase<EpiBf16Scale>(ldsl, g, S, E, F.wave); }
#define REP(k) if constexpr (((PROBE_REP) >> (k)) & 1)

    if (IN(0)) { phase0_prep(F); REP(0) { __syncthreads(); phase0_prep(F); } }
    SEAM(0);
    if (IN(1)) { phase_modnorm<true>(F, F.x, F.g1, 0, 2048, R0, F.ws + WS_H1F8); REP(1) { phase_modnorm<true>(F, F.x, F.g1, 0, 2048, R0, F.ws + WS_H1F8); } }
    SEAM(1);
    if (IN(2)) { PH2_BODY REP(2) PH2_BODY }
    SEAM(2);
    if (IN(3)) { phase3_qknorm(F); PH3_BODY REP(3) PH3_BODY }
    SEAM(3);
    if (IN(4)) { PH4_BODY REP(4) PH4_BODY }
    SEAM(4);
    if (IN(5)) { PH5_BODY REP(5) PH5_BODY }
    SEAM(5);
    if (IN(6)) { PH6_BODY REP(6) PH6_BODY }
    SEAM(6);
    if (IN(7)) { phase_modnorm<false>(F, F.out, F.g2, 6144, 8192, (bf16_t*)(F.ws + WS_H2)); REP(7) { phase_modnorm<false>(F, F.out, F.g2, 6144, 8192, (bf16_t*)(F.ws + WS_H2)); } }
    SEAM(7);
    if (IN(8)) { PH8_BODY REP(8) PH8_BODY }
    SEAM(8);
    if (IN(9)) { PH9_BODY REP(9) PH9_BODY }
    SEAM(9);
    if (IN(10)) { phase10_peer(F); REP(10) phase10_peer(F); }
    SEAM(10);
    if (IN(11)) { REP(11) { phase11_peer_v(F, (float*)(F.ws + WS_SUB)); } phase11_peer_v(F, F.out); }
#undef IN
#undef SEAM
}

extern "C" void kernel_launch(void* const* d_in, const int* in_sizes, int n_in, void* d_out, int out_size, void* d_ws, size_t ws_size, hipStream_t stream) {
    static int grid = 0;
    if (grid == 0) {
        if (n_in != 19 || out_size != MTOK * DM || ws_size < WS_END) { fprintf(stderr, "kernel_launch: unexpected shapes (n_in %d out %d ws %zu)\n", n_in, out_size, ws_size); grid = -1; return; }
        int dev = 0, cus = 0, per_cu = 0;
        if (hipGetDevice(&dev) != hipSuccess || hipDeviceGetAttribute(&cus, hipDeviceAttributeMultiprocessorCount, dev) != hipSuccess) { grid = -1; return; }
        if (hipFuncSetAttribute((const void*)fwd_kernel, hipFuncAttributeMaxDynamicSharedMemorySize, LDS_BYTES) != hipSuccess) { fprintf(stderr, "kernel_launch: hipFuncSetAttribute failed\n"); grid = -1; return; }
        if (hipOccupancyMaxActiveBlocksPerMultiprocessor(&per_cu, (const void*)fwd_kernel, 512, LDS_BYTES) != hipSuccess || per_cu < 1) { fprintf(stderr, "kernel_launch: occupancy query says %d\n", per_cu); }
        (void)hipGetLastError();
        grid = cus;
    }
    if (grid < 0) return;
    (void)in_sizes;
    if (hipMemsetAsync((char*)d_ws + WS_CTL, 0, CTL_ZERO_BYTES, stream) != hipSuccess) return;
    Args a{};
    for (int i = 0; i < 19; ++i) a.in[i] = (const float*)d_in[i];
    a.out = (float*)d_out; a.ws = (unsigned char*)d_ws;
#if MK_PER_PHASE
    for (int p = 0; p < NPHASE; ++p) { a.ph_lo = p; a.ph_hi = p + 1; a.li = p; hipLaunchKernelGGL(fwd_kernel, dim3(grid), dim3(512), LDS_BYTES, stream, a); }
#else
    a.ph_lo = 0; a.ph_hi = NPHASE; a.li = 0;
    hipLaunchKernelGGL(fwd_kernel, dim3(grid), dim3(512), LDS_BYTES, stream, a);
#endif
}
```

```cpp
#include <hip/hip_runtime.h>
#include <cstdio>
#include <cstdint>

#ifndef MK_PER_PHASE
#define MK_PER_PHASE 0
#endif

#ifndef PROBE_REP
#define PROBE_REP 0
#endif
#ifndef PROBE_IDX
#define PROBE_IDX 0
#endif
#ifndef PROBE_P11X
#define PROBE_P11X 0
#endif
#define LAS __attribute__((address_space(3)))
typedef unsigned short bf16_t;
typedef short bf16x8 __attribute__((ext_vector_type(8)));
typedef float f32x4 __attribute__((ext_vector_type(4)));
typedef float f32x2 __attribute__((ext_vector_type(2)));
typedef int v2i __attribute__((ext_vector_type(2)));
typedef unsigned u32x4 __attribute__((ext_vector_type(4)));
typedef unsigned u32x2 __attribute__((ext_vector_type(2)));
typedef unsigned u32x6 __attribute__((ext_vector_type(6)));
typedef unsigned u32x16 __attribute__((ext_vector_type(16)));
typedef __bf16 bf16x32 __attribute__((ext_vector_type(32)));

constexpr int BATCH = 8, SEQ = 4096, DM = 2048, MTOK = BATCH * SEQ;
constexpr int NHEAD = 8, HDIM = 128, AW = 1024, KVW = 256, IHEADS = 16, IDIM = 64, KSEL = 256;
constexpr int PW = 1024, PHEADS = 8, NEXP = 16384;
constexpr int INW = 7760;
constexpr float EPS = 1e-6f;
constexpr int NPHASE = 12;

constexpr size_t MiB = 1u << 20;
constexpr size_t WS_CTL = 0, CTL_ZERO_BYTES = 256 * 1024;
constexpr size_t WS_MODP = 2 * MiB;
constexpr size_t WS_MODF = 4 * MiB;
constexpr size_t WS_POOLW = 5 * MiB;
constexpr size_t WS_KEYSBD = 6 * MiB;
constexpr size_t WS_WIN16 = 8 * MiB;
constexpr size_t WS_WIN8 = 20 * MiB;
constexpr size_t WS_WAB = 40 * MiB, WS_WPB = 44 * MiB, WS_WOUT = 48 * MiB, WS_WPQ = 56 * MiB;
constexpr size_t WS_PU = 64 * MiB, WS_PV = 128 * MiB;
constexpr size_t WS_R0 = 192 * MiB;
constexpr size_t WS_GA = 320 * MiB, WS_GP = 448 * MiB;
constexpr size_t WS_SUB = 320 * MiB;
constexpr size_t WS_QN = 576 * MiB;
constexpr size_t WS_IQ = 640 * MiB;
constexpr size_t WS_PL = 704 * MiB;
constexpr size_t WS_KN = 768 * MiB, WS_V = 784 * MiB;
constexpr size_t WS_IK = 800 * MiB;
constexpr size_t WS_IW = 804 * MiB;
constexpr size_t WS_SEL = 806 * MiB;
constexpr size_t WS_POOLED = 822 * MiB;
constexpr size_t WS_H2 = 886 * MiB;
constexpr size_t WS_END = 1014 * MiB;
constexpr size_t WS_H1F8 = WS_H2 + 64 * MiB;
constexpr size_t WS_Q8 = WS_H2, WS_K8 = WS_H2 + 32 * MiB, WS_V8 = WS_H2 + 40 * MiB;
constexpr size_t WS_ATTN = WS_IQ, WS_POOL2 = WS_PL, WS_PAIRS = WS_QN, WS_WLS = WS_QN + 32 * MiB;

constexpr int LDS_BYTES = 160 * 1024;
constexpr int MISC_OFF = 159 * 1024;

__device__ __forceinline__ unsigned cvt_pk_bf16(float lo, float hi) { unsigned r; asm volatile("v_cvt_pk_bf16_f32 %0, %1, %2" : "=v"(r) : "v"(lo), "v"(hi)); return r; }
__device__ __forceinline__ float bf_lo(unsigned w) { return __uint_as_float(w << 16); }
__device__ __forceinline__ float bf_hi(unsigned w) { return __uint_as_float(w & 0xffff0000u); }
template <int CTRL> __device__ __forceinline__ float dpp_f(float x) { return __int_as_float(__builtin_amdgcn_update_dpp(0, __float_as_int(x), CTRL, 0xF, 0xF, true)); }
#define DPP_XOR1 0xB1
#define DPP_XOR2 0x4E
#define DPP_HMIRROR 0x141
#define DPP_MIRROR 0x140
#define DPP_ROR8 0x128
__device__ __forceinline__ float xor16_sum(float x) { const auto r = __builtin_amdgcn_permlane16_swap(__float_as_uint(x), __float_as_uint(x), false, false); return __uint_as_float(r[0]) + __uint_as_float(r[1]); }
__device__ __forceinline__ float xor32_sum(float x) { const auto r = __builtin_amdgcn_permlane32_swap(__float_as_uint(x), __float_as_uint(x), false, false); return __uint_as_float(r[0]) + __uint_as_float(r[1]); }
__device__ __forceinline__ float xor16_max(float x) { const auto r = __builtin_amdgcn_permlane16_swap(__float_as_uint(x), __float_as_uint(x), false, false); return fmaxf(__uint_as_float(r[0]), __uint_as_float(r[1])); }
__device__ __forceinline__ float swap32_pair(float a, float b) { const auto r = __builtin_amdgcn_permlane32_swap(__float_as_uint(a), __float_as_uint(b), false, false); return __uint_as_float(r[0]) + __uint_as_float(r[1]); }
__device__ __forceinline__ float swap16_pair(float a, float b) { const auto r = __builtin_amdgcn_permlane16_swap(__float_as_uint(a), __float_as_uint(b), false, false); return __uint_as_float(r[0]) + __uint_as_float(r[1]); }
__device__ __forceinline__ float row_sum16(float v) { v += dpp_f<DPP_XOR1>(v); v += dpp_f<DPP_XOR2>(v); v += dpp_f<DPP_HMIRROR>(v); v += dpp_f<DPP_MIRROR>(v); return v; }
__device__ __forceinline__ float row_max16(float v) { v = fmaxf(v, dpp_f<DPP_XOR1>(v)); v = fmaxf(v, dpp_f<DPP_XOR2>(v)); v = fmaxf(v, dpp_f<DPP_HMIRROR>(v)); v = fmaxf(v, dpp_f<DPP_MIRROR>(v)); return v; }
__device__ __forceinline__ float wave_sum(float v) { return xor32_sum(xor16_sum(row_sum16(v))); }
__device__ __forceinline__ float sigmoidf_(float x) { return __builtin_amdgcn_rcpf(1.0f + __expf(-x)); }
__device__ __forceinline__ float dot8(u32x4 w, const float* h) {
    return bf_lo(w.x) * h[0] + bf_hi(w.x) * h[1] + bf_lo(w.y) * h[2] + bf_hi(w.y) * h[3] + bf_lo(w.z) * h[4] + bf_hi(w.z) * h[5] + bf_lo(w.w) * h[6] + bf_hi(w.w) * h[7];
}

__device__ __forceinline__ int lane_now() { int l; asm volatile("v_mbcnt_lo_u32_b32 %0, -1, 0\n\tv_mbcnt_hi_u32_b32 %0, -1, %0" : "=v"(l)); return l; }

#define XB_TMO      128
#define XB_XCNT(j)  (256  + 64 * (j))
#define XB_XSUB(j)  (1280 + 64 * (j))
#define XB_XGEN(j)  (2304 + 64 * (j))
#define XB_TOP      3328
#define XB_TOPGEN   3392
#define XCD_BAR_WORDS 3456
#define XB_SPIN_CAP (1u << 18)

__device__ __forceinline__ unsigned xb_ld(unsigned* p)              { return __hip_atomic_load(p, __ATOMIC_RELAXED, __HIP_MEMORY_SCOPE_AGENT); }
__device__ __forceinline__ unsigned xb_add(unsigned* p, unsigned v) { return __hip_atomic_fetch_add(p, v, __ATOMIC_RELAXED, __HIP_MEMORY_SCOPE_AGENT); }
__device__ __forceinline__ unsigned xb_xcc_id() { return (unsigned)__builtin_amdgcn_s_getreg((3 << 11) | 20) & 0xFu; }
#define XB_SPIN(cond, bar) do { unsigned _sp = 0; while (cond) { __builtin_amdgcn_s_sleep(1); \
    if ((++_sp & 255u) == 0u) { if (xb_ld(&(bar)[XB_TMO])) break; if (_sp > XB_SPIN_CAP) { atomicAdd(&(bar)[XB_TMO], 1u); break; } } } } while (0)

struct XcdBarrier { unsigned* bar; unsigned x; volatile LAS unsigned* st; };

__device__ __forceinline__ XcdBarrier xcd_barrier_post(unsigned* bar, volatile LAS unsigned* st) {
    XcdBarrier b; b.bar = bar; b.x = xb_xcc_id(); b.st = st;
    if (threadIdx.x == 0) (void)xb_add(&bar[XB_XCNT(b.x)], 1u);
    return b;
}
__device__ __forceinline__ void xcd_barrier_complete(unsigned* bar, unsigned x, unsigned& nloc, unsigned& nx) {
    const unsigned G = gridDim.x * gridDim.y * gridDim.z;
    unsigned sum, cnt, mine, sp = 0u;
    for (;;) {
        sum = 0u; cnt = 0u; mine = 0u;
#pragma unroll
        for (unsigned j = 0; j < 16; ++j) { const unsigned c = xb_ld(&bar[XB_XCNT(j)]); sum += c; cnt += (c > 0u) ? 1u : 0u; mine = (j == x) ? c : mine; }
        if (sum == G) break;
        __builtin_amdgcn_s_sleep(1);
        if ((++sp & 255u) == 0u) { if (xb_ld(&bar[XB_TMO])) break; if (sp > XB_SPIN_CAP) { atomicAdd(&bar[XB_TMO], 1u); break; } }
    }
    nloc = mine > 0u ? mine : 1u; nx = cnt > 0u ? cnt : 1u;
}
__device__ __forceinline__ void xcd_barrier(const XcdBarrier& b, int wave) {
    asm volatile("s_waitcnt vmcnt(0)" ::: "memory");
    __syncthreads();
    if (wave == 0 && lane_now() == 0) {
        unsigned* bar = b.bar;
        __builtin_amdgcn_s_waitcnt(0);
        unsigned nloc = b.st[0], nx = b.st[1];
        if (nloc == 0u) { xcd_barrier_complete(bar, b.x, nloc, nx); b.st[0] = nloc; b.st[1] = nx; }
        const unsigned old = xb_add(&bar[XB_XSUB(b.x)], 1u);
        const unsigned gen = old / nloc;
        if (old + 1u == (gen + 1u) * nloc) {
            __builtin_amdgcn_fence(__ATOMIC_RELEASE, "agent");
            asm volatile("s_waitcnt vmcnt(0)" ::: "memory");
            const unsigned og = xb_add(&bar[XB_TOP], 1u);
            const unsigned tg = og / nx;
            if (og + 1u == (tg + 1u) * nx) xb_add(&bar[XB_TOPGEN], 1u);
            else XB_SPIN(xb_ld(&bar[XB_TOPGEN]) == tg, bar);
            __builtin_amdgcn_fence(__ATOMIC_ACQUIRE, "agent");
            xb_add(&bar[XB_XGEN(b.x)], 1u);
            asm volatile("s_waitcnt vmcnt(0)" ::: "memory");
        } else {
            XB_SPIN(xb_ld(&bar[XB_XGEN(b.x)]) == gen, bar);
            __builtin_amdgcn_fence(__ATOMIC_ACQUIRE, "agent");
            asm volatile("s_waitcnt vmcnt(0)" ::: "memory");
        }
    }
    __syncthreads();
}

namespace pg8 {
constexpr int BM = 256, BK = 64, HALF = 128, HTB = HALF * BK * 2, STAGE_BYTES = 8 * HTB, NXCD = 8, WGM = 8;
__device__ __forceinline__ int lds_byte(int r, int c) { const int st = (r >> 4) * 2 + (c >> 5), rr = r & 15, cc = c & 31, ob = rr * 64 + cc * 2; return st * 1024 + (ob ^ (((ob >> 9) & 1) << 5)); }
__device__ __forceinline__ void stage_rc(int b, int& R, int& C) { const int st = b / 1024, sb = b % 1024, swz = sb ^ (((sb >> 9) & 1) << 5); R = (st >> 1) * 16 + swz / 64; C = (st & 1) * 32 + (swz % 64) / 2; }
__device__ __forceinline__ int perm32(int rho) { const int n = rho >> 4, i = rho & 15; return 8 * (i >> 2) + 4 * n + (i & 3); }

struct Unit { int pm, pn; };
struct Gemm { const bf16_t* A; const bf16_t* Bt; int M, N, K, lda, a_pn_off; const bf16_t* A2; const bf16_t* Bt2; int ksplit, ldb; };

struct StaticOrder {
    int nM, nN, nwg, G, c;
    __device__ void init(int M, int N, int G_, int c_) { nM = M / BM; nN = N / BM; nwg = nM * nN; G = G_; c = c_; }
    __device__ bool next(int i, Unit& u) const {
        const long L = (long)i * G + c; if (L >= nwg) return false;
        int wgid = (int)L; { const int q = nwg / NXCD, r = nwg % NXCD, xcd = wgid % NXCD, off = wgid / NXCD; wgid = (xcd < r ? xcd * (q + 1) : r * (q + 1) + (xcd - r) * q) + off; }
        const int nig = WGM * nN, gid = wgid / nig, fm = gid * WGM, gsz = (nM - fm) < WGM ? (nM - fm) : WGM;
        u.pm = fm + ((wgid % nig) % gsz); u.pn = (wgid % nig) / gsz; return true;
    }
};

typedef int i32x4 __attribute__((ext_vector_type(4)));
typedef int i32x8 __attribute__((ext_vector_type(8)));
__device__ __forceinline__ bf16x8 lo8(i32x8 v) { return __builtin_bit_cast(bf16x8, (i32x4){v.s0, v.s1, v.s2, v.s3}); }
__device__ __forceinline__ bf16x8 hi8(i32x8 v) { return __builtin_bit_cast(bf16x8, (i32x4){v.s4, v.s5, v.s6, v.s7}); }
__device__ __forceinline__ i32x8 cat8(bf16x8 a, bf16x8 b) { const i32x4 x = __builtin_bit_cast(i32x4, a), y = __builtin_bit_cast(i32x4, b); return (i32x8){x.x, x.y, x.z, x.w, y.x, y.y, y.z, y.w}; }
template <class Epi, bool F8 = false>
__device__ __forceinline__ void gemm_phase(LAS unsigned char* lds, const Gemm g, const StaticOrder& S, const Epi& E, int wave) {
    const int lane = lane_now(), wid = wave, tid = wid * 64 + lane, wr = wid >> 2, wc = wid & 3, fr = lane & 15, fq = lane >> 4;
    const int K = g.K, nt = K / BK, lda = g.lda, ldb = g.ldb ? g.ldb : g.K, ksplit = g.ksplit;
    unsigned voffA, voffB;
    { int R, C; stage_rc(tid * 16, R, C); const int Rb = Epi::PERM ? ((R & ~31) + perm32(R & 31)) : R;
      voffA = (unsigned)(R * lda + C) * 2u; voffB = (unsigned)(Rb * ldb + C) * 2u; }
    const unsigned stepA = 64u * (unsigned)lda * 2u, stepB = 64u * (unsigned)ldb * 2u;
    const size_t kstep = (size_t)(BK * 2);
    const size_t hsA = (size_t)HALF * lda * 2, hsB = (size_t)HALF * ldb * 2;
    const size_t tsA = 2 * hsA, tsB = 2 * hsB;
    const unsigned ldsw = (unsigned)wid * 1024u, ldsbase = (unsigned)(unsigned long long)lds;
    const int aoff = lds_byte(wr * 64 + fr, fq * 8), boff = lds_byte(wc * 32 + fr, fq * 8);
#define PG8_SA(b, h) (((b) * 2 + (h)) * HTB)
#define PG8_SB(b, h) ((4 + (b) * 2 + (h)) * HTB)
#define PG8_STAGE(bufoff, gbase, voff) do { _Pragma("unroll") for (int _i = 0; _i < 2; ++_i) { \
        const char* sb_ = (const char*)(gbase) + (size_t)_i * PG8_STEP_##voff; const unsigned m0_ = ldsbase + (unsigned)(bufoff) + ldsw + (unsigned)_i * 8192u; \
        asm volatile("s_mov_b32 m0, %2\n\ts_nop 0\n\tglobal_load_lds_dwordx4 %0, %1" :: "v"(voff), "s"(sb_), "s"(m0_) : "memory"); } } while (0)
#define PG8_STEP_voffA stepA
#define PG8_STEP_voffB stepB
#define PG8_LDA(dst, b, h) do { _Pragma("unroll") for (int m = 0; m < 4; ++m) dst[m] = cat8(*(const LAS bf16x8*)(lds + PG8_SA(b, h) + aoff + m * 2048), *(const LAS bf16x8*)(lds + PG8_SA(b, h) + aoff + m * 2048 + 1024)); } while (0)
#define PG8_LDB(dst, b, h) do { _Pragma("unroll") for (int n = 0; n < 2; ++n) dst[n] = cat8(*(const LAS bf16x8*)(lds + PG8_SB(b, h) + boff + n * 2048), *(const LAS bf16x8*)(lds + PG8_SB(b, h) + boff + n * 2048 + 1024)); } while (0)
#define PG8_MMA(ai, bj, At, Bt) do { __builtin_amdgcn_s_setprio(1); _Pragma("unroll") for (int m = 0; m < 4; ++m) _Pragma("unroll") for (int n = 0; n < 2; ++n) { \
        if constexpr (F8) acc[ai][bj][m][n] = __builtin_amdgcn_mfma_scale_f32_16x16x128_f8f6f4(Bt[n], At[m], acc[ai][bj][m][n], 0, 0, 0, 0x7D7D7D7D  , 0, 0x7D7D7D7D); \
        else { acc[ai][bj][m][n] = __builtin_amdgcn_mfma_f32_16x16x32_bf16(lo8(Bt[n]), lo8(At[m]), acc[ai][bj][m][n], 0, 0, 0); \
               acc[ai][bj][m][n] = __builtin_amdgcn_mfma_f32_16x16x32_bf16(hi8(Bt[n]), hi8(At[m]), acc[ai][bj][m][n], 0, 0, 0); } } \
        __builtin_amdgcn_s_setprio(0); } while (0)
#define PG8_WAIT_V(n) asm volatile("s_waitcnt vmcnt(" #n ")" ::: "memory")
#define PG8_WAIT_L(n) asm volatile("s_waitcnt lgkmcnt(" #n ")" ::: "memory")
#define PG8_BAR __builtin_amdgcn_s_barrier()
#define PG8_SCHED __builtin_amdgcn_sched_barrier(0)
    Unit cur, nxt; int ui = 0;
    if (!S.next(0, cur)) return;
    f32x4 acc[2][2][4][2];
#pragma unroll
    for (int a = 0; a < 2; ++a)
#pragma unroll
        for (int b = 0; b < 2; ++b)
#pragma unroll
            for (int m = 0; m < 4; ++m)
#pragma unroll
                for (int n = 0; n < 2; ++n) acc[a][b][m][n] = (f32x4){0.f, 0.f, 0.f, 0.f};
    i32x8 At[4], B0[2], B1[2];
    const char* cA = (const char*)g.A + (size_t)cur.pm * tsA + (size_t)cur.pn * g.a_pn_off * 2; const char* cB = (const char*)g.Bt + (size_t)cur.pn * tsB;
    PG8_STAGE(PG8_SB(0, 0), cB, voffB); PG8_STAGE(PG8_SB(0, 1), cB + hsB, voffB); PG8_STAGE(PG8_SA(0, 0), cA, voffA); PG8_STAGE(PG8_SA(0, 1), cA + hsA, voffA);
    if (wr == 1) PG8_BAR;
    PG8_WAIT_V(2); PG8_BAR;
    PG8_STAGE(PG8_SB(1, 0), cB + kstep, voffB); PG8_STAGE(PG8_SA(1, 0), cA + kstep, voffA); PG8_STAGE(PG8_SB(1, 1), cB + hsB + kstep, voffB);
    PG8_WAIT_V(6); PG8_BAR;
    for (;;) {
        const bool has_next = S.next(ui + 1, nxt);
        const char* nA = has_next ? (const char*)g.A + (size_t)nxt.pm * tsA + (size_t)nxt.pn * g.a_pn_off * 2 : cA; const char* nB = has_next ? (const char*)g.Bt + (size_t)nxt.pn * tsB : cB;
        const char* cA2 = (const char*)g.A2 + (size_t)cur.pm * tsA; const char* cB2 = (const char*)g.Bt2 + (size_t)cur.pn * tsB;
#pragma clang loop unroll(disable)
        for (int t = 0; t < nt; t += 2) {
            const bool last = (t == nt - 2);
            const bool s1 = ksplit && (t >= ksplit), s2 = ksplit && (t + 2 >= ksplit);
            const char* a1 = (s1 ? cA2 + (size_t)(t - ksplit + 1) * kstep : cA + (size_t)(t + 1) * kstep);
            const char* a2 = last ? nA : (s2 ? cA2 + (size_t)(t + 2 - ksplit) * kstep : cA + (size_t)(t + 2) * kstep);
            const char* b2 = last ? nB : (s2 ? cB2 + (size_t)(t + 2 - ksplit) * kstep : cB + (size_t)(t + 2) * kstep);
            const char* a3 = a2 + kstep; const char* b3 = b2 + kstep;
            PG8_LDB(B0, 0, 0); PG8_LDB(B1, 0, 1); PG8_SCHED; PG8_LDA(At, 0, 0); PG8_STAGE(PG8_SA(1, 1), a1 + hsA, voffA);
            PG8_WAIT_V(8); PG8_WAIT_L(0); PG8_BAR; PG8_MMA(0, 0, At, B0); PG8_MMA(0, 1, At, B1); PG8_BAR; PG8_SCHED;
            PG8_LDA(At, 0, 1); PG8_STAGE(PG8_SB(0, 0), b2, voffB); PG8_STAGE(PG8_SB(0, 1), b2 + hsB, voffB); PG8_STAGE(PG8_SA(0, 0), a2, voffA);
            PG8_WAIT_V(8); PG8_WAIT_L(0); PG8_BAR; PG8_MMA(1, 0, At, B0); PG8_MMA(1, 1, At, B1); PG8_BAR; PG8_SCHED;
            PG8_LDB(B0, 1, 0); PG8_LDB(B1, 1, 1); PG8_SCHED; PG8_LDA(At, 1, 0); PG8_STAGE(PG8_SA(0, 1), a2 + hsA, voffA);
            PG8_WAIT_V(8); PG8_WAIT_L(0); PG8_BAR; PG8_MMA(0, 0, At, B0); PG8_MMA(0, 1, At, B1); PG8_BAR; PG8_SCHED;
            PG8_LDA(At, 1, 1); PG8_STAGE(PG8_SB(1, 0), b3, voffB); PG8_STAGE(PG8_SB(1, 1), b3 + hsB, voffB); PG8_STAGE(PG8_SA(1, 0), a3, voffA);
            PG8_WAIT_V(8); PG8_WAIT_L(0); PG8_BAR; PG8_MMA(1, 0, At, B0); PG8_MMA(1, 1, At, B1); PG8_BAR; PG8_SCHED;
            if constexpr (Epi::MID) { if (t + 2 == ksplit) E.mid(acc, cur, wr, wc, fr, fq); }
        }
        if (wr == 0) PG8_BAR;
        { const int l2 = lane_now(); E(acc, cur, wr, wc, l2 & 15, l2 >> 4); }
        if (!has_next) break;
#pragma unroll
        for (int a = 0; a < 2; ++a)
#pragma unroll
            for (int b = 0; b < 2; ++b)
#pragma unroll
                for (int m = 0; m < 4; ++m)
#pragma unroll
                    for (int n = 0; n < 2; ++n) acc[a][b][m][n] = (f32x4){0.f, 0.f, 0.f, 0.f};
        cur = nxt; cA = nA; cB = nB; ++ui;
        if (wr == 1) PG8_BAR;
    }
    PG8_WAIT_V(0);
    PG8_BAR;
#undef PG8_SA
#undef PG8_SB
#undef PG8_STAGE
#undef PG8_STEP_voffA
#undef PG8_STEP_voffB
#undef PG8_LDA
#undef PG8_LDB
#undef PG8_MMA
#undef PG8_WAIT_V
#undef PG8_WAIT_L
#undef PG8_BAR
#undef PG8_SCHED
}
}
using pg8::Unit;

typedef f32x4 AccT[2][2][4][2];
__device__ __forceinline__ u32x4 pack8(f32x4 a, f32x4 b) { u32x4 w; w.x = cvt_pk_bf16(a[0], a[1]); w.y = cvt_pk_bf16(a[2], a[3]); w.z = cvt_pk_bf16(b[0], b[1]); w.w = cvt_pk_bf16(b[2], b[3]); return w; }
__device__ __forceinline__ u32x2 pack8_fp8(f32x4 a, f32x4 b) {
    int w0 = __builtin_amdgcn_cvt_pk_fp8_f32(a[0], a[1], 0, false); w0 = __builtin_amdgcn_cvt_pk_fp8_f32(a[2], a[3], w0, true);
    int w1 = __builtin_amdgcn_cvt_pk_fp8_f32(b[0], b[1], 0, false); w1 = __builtin_amdgcn_cvt_pk_fp8_f32(b[2], b[3], w1, true);
    return (u32x2){(unsigned)w0, (unsigned)w1};
}
__device__ __forceinline__ void unpack8(u32x4 w, f32x4& a, f32x4& b) { a = (f32x4){bf_lo(w.x), bf_hi(w.x), bf_lo(w.y), bf_hi(w.y)}; b = (f32x4){bf_lo(w.z), bf_hi(w.z), bf_lo(w.w), bf_hi(w.w)}; }

template <bool SET8> struct EpiInproj {
    static constexpr bool PERM = true, MID = false;
    bf16_t *q, *k, *v, *iq, *ik, *pl, *ga, *gp; float* iw;
    __device__ __forceinline__ void operator()(const AccT& acc, const Unit& u, int wr, int wc, int fr, int fq) const {
        const int pn = u.pn, row0 = u.pm * 256 + wr * 64 + fr;
        if (!SET8 && pn == 4) {
            if (wc < 2) {
#pragma unroll
                for (int ai = 0; ai < 2; ++ai)
#pragma unroll
                    for (int m = 0; m < 4; ++m) { const size_t row = (size_t)(row0 + ai * 128 + m * 16);
                        *(u32x4*)(ik + row * 64 + wc * 32 + 8 * fq) = pack8(acc[ai][0][m][0], acc[ai][0][m][1]); }
            } else if (wc == 2) {
                if (fq < 2) {
#pragma unroll
                    for (int ai = 0; ai < 2; ++ai)
#pragma unroll
                        for (int m = 0; m < 4; ++m) { const size_t row = (size_t)(row0 + ai * 128 + m * 16);
                            *(f32x4*)(iw + row * 16 + 8 * fq) = acc[ai][0][m][0]; *(f32x4*)(iw + row * 16 + 8 * fq + 4) = acc[ai][0][m][1]; }
                }
            }
            return;
        }
        bf16_t* dst; int ld, tc; bool sg = false;
        if (SET8) {
            if (pn < 4) { dst = q; ld = 1024; tc = pn * 256; }
            else if (pn == 4) { dst = k; ld = 256; tc = 0; }
            else if (pn == 5) { dst = v; ld = 256; tc = 0; }
            else if (pn < 14) { dst = ga; ld = 2048; tc = (pn - 6) * 256; sg = true; }
            else { dst = gp; ld = 2048; tc = (pn - 14) * 256; sg = true; }
        } else {
            if (pn < 4) { dst = iq; ld = 1024; tc = pn * 256; }
            else { dst = pl; ld = 1024; tc = (pn - 5) * 256; }
        }
        const int col0 = tc + wc * 32 + 8 * fq;
#pragma unroll
        for (int ai = 0; ai < 2; ++ai)
#pragma unroll
            for (int m = 0; m < 4; ++m) { bf16_t* rowp = dst + (size_t)(row0 + ai * 128 + m * 16) * ld + col0;
#pragma unroll
                for (int bj = 0; bj < 2; ++bj) { f32x4 v0 = acc[ai][bj][m][0], v1 = acc[ai][bj][m][1];
                    if (sg) {
#pragma unroll
                        for (int j = 0; j < 4; ++j) { v0[j] = sigmoidf_(v0[j]); v1[j] = sigmoidf_(v1[j]); } }
                    *(u32x4*)(rowp + bj * 128) = pack8(v0, v1); } }
    }
};
struct EpiBf16Scale {
    static constexpr bool PERM = true, MID = false;
    bf16_t* O; int ldc; const float* cs;
    __device__ __forceinline__ void operator()(const AccT& acc, const Unit& u, int wr, int wc, int fr, int fq) const {
        const int row0 = u.pm * 256 + wr * 64 + fr, col0 = u.pn * 256 + wc * 32 + 8 * fq;
        f32x4 s[2][2];
#pragma unroll
        for (int bj = 0; bj < 2; ++bj)
#pragma unroll
            for (int n = 0; n < 2; ++n) s[bj][n] = cs ? *(const f32x4*)(cs + col0 + bj * 128 + 4 * n) : (f32x4){1.f, 1.f, 1.f, 1.f};
#pragma unroll
        for (int ai = 0; ai < 2; ++ai)
#pragma unroll
            for (int m = 0; m < 4; ++m) { bf16_t* rowp = O + (size_t)(row0 + ai * 128 + m * 16) * ldc + col0;
#pragma unroll
                for (int bj = 0; bj < 2; ++bj) *(u32x4*)(rowp + bj * 128) = pack8(acc[ai][bj][m][0] * s[bj][0], acc[ai][bj][m][1] * s[bj][1]); }
    }
};
template <bool ADD> struct EpiGate {
    static constexpr bool PERM = true, MID = false;
    bf16_t* O; const bf16_t* gate;
    __device__ __forceinline__ void operator()(const AccT& acc, const Unit& u, int wr, int wc, int fr, int fq) const {
        const int row0 = u.pm * 256 + wr * 64 + fr, col0 = u.pn * 256 + wc * 32 + 8 * fq;
#pragma unroll
        for (int ai = 0; ai < 2; ++ai)
#pragma unroll
            for (int m = 0; m < 4; ++m) { const size_t off = (size_t)(row0 + ai * 128 + m * 16) * 2048 + col0;
#pragma unroll
                for (int bj = 0; bj < 2; ++bj) { f32x4 g0, g1; unpack8(*(const u32x4*)(gate + off + bj * 128), g0, g1);
                    f32x4 r0 = g0 * acc[ai][bj][m][0], r1 = g1 * acc[ai][bj][m][1];
                    if (ADD) { f32x4 o0, o1; unpack8(*(const u32x4*)(O + off + bj * 128), o0, o1); r0 += o0; r1 += o1; }
                    *(u32x4*)(O + off + bj * 128) = pack8(r0, r1); } }
    }
};
struct EpiMerge {
    static constexpr bool PERM = true, MID = true;
    unsigned char* O; const bf16_t* ga; const bf16_t* gp;
    __device__ __forceinline__ void mid(AccT& acc, const Unit& u, int wr, int wc, int fr, int fq) const {
        const auto ra = __builtin_amdgcn_make_buffer_rsrc((void*)ga, 0, 0x7FFFFFFF, 0x00020000), rp = __builtin_amdgcn_make_buffer_rsrc((void*)gp, 0, 0x7FFFFFFF, 0x00020000);
        const int voff = ((wr * 64 + fr) * 2048 + wc * 32 + 8 * fq) * 2;
        const int sbase = (u.pm * 256 * 2048 + u.pn * 256) * 2;
#pragma unroll
        for (int ai = 0; ai < 2; ++ai)
#pragma unroll
            for (int m = 0; m < 4; ++m)
#pragma unroll
                for (int bj = 0; bj < 2; ++bj) { const int so = sbase + ((ai * 128 + m * 16) * 2048 + bj * 128) * 2;
                    const u32x4 wa = __builtin_bit_cast(u32x4, __builtin_amdgcn_raw_buffer_load_b128(ra, voff, so, 0)), wp = __builtin_bit_cast(u32x4, __builtin_amdgcn_raw_buffer_load_b128(rp, voff, so, 0));
                    f32x4 a0, a1, p0, p1; unpack8(wa, a0, a1); unpack8(wp, p0, p1);
#pragma unroll
                    for (int j = 0; j < 4; ++j) { acc[ai][bj][m][0][j] *= a0[j] * __builtin_amdgcn_rcpf(p0[j]); acc[ai][bj][m][1][j] *= a1[j] * __builtin_amdgcn_rcpf(p1[j]); }
                    asm volatile("" : "+v"(acc[ai][bj][m][0]), "+v"(acc[ai][bj][m][1]) :: "memory"); }
    }
    __device__ __forceinline__ void operator()(const AccT& acc, const Unit& u, int wr, int wc, int fr, int fq) const {
        const int row0 = u.pm * 256 + wr * 64 + fr, col0 = u.pn * 256 + wc * 32 + 8 * fq;
#pragma unroll
        for (int ai = 0; ai < 2; ++ai)
#pragma unroll
            for (int m = 0; m < 4; ++m) { const size_t off = (size_t)(row0 + ai * 128 + m * 16) * 2048 + col0;
#pragma unroll
                for (int bj = 0; bj < 2; ++bj) { f32x4 p0, p1; unpack8(*(const u32x4*)(gp + off + bj * 128), p0, p1);
                    *(u32x2*)(O + off + bj * 128) = pack8_fp8(p0 * acc[ai][bj][m][0], p1 * acc[ai][bj][m][1]); } }
    }
};
struct EpiResid {
    static constexpr bool PERM = false, MID = false;
    const float* x; float* out; const float* gt;
    __device__ __forceinline__ void operator()(const AccT& acc, const Unit& u, int wr, int wc, int fr, int fq) const {
        const int row0 = u.pm * 256 + wr * 64 + fr, col0 = u.pn * 256 + wc * 32 + 4 * fq;
        const float* gtb = gt + (size_t)(u.pm / 16) * 12288;
        f32x4 g[2][2];
#pragma unroll
        for (int bj = 0; bj < 2; ++bj)
#pragma unroll
            for (int n = 0; n < 2; ++n) g[bj][n] = *(const f32x4*)(gtb + col0 + bj * 128 + n * 16);
#pragma unroll
        for (int ai = 0; ai < 2; ++ai)
#pragma unroll
            for (int m = 0; m < 4; ++m) { const size_t off = (size_t)(row0 + ai * 128 + m * 16) * 2048 + col0;
#pragma unroll
                for (int bj = 0; bj < 2; ++bj)
#pragma unroll
                    for (int n = 0; n < 2; ++n) { const f32x4 xv = *(const f32x4*)(x + off + bj * 128 + n * 16);
                        *(f32x4*)(out + off + bj * 128 + n * 16) = xv + g[bj][n] * acc[ai][bj][m][n]; } }
    }
};
struct EpiF32 {
    static constexpr bool PERM = false, MID = false;
    float* C; int ldc;
    __device__ __forceinline__ void operator()(const AccT& acc, const Unit& u, int wr, int wc, int fr, int fq) const {
        const int row0 = u.pm * 256 + wr * 64 + fr, col0 = u.pn * 256 + wc * 32 + 4 * fq;
#pragma unroll
        for (int ai = 0; ai < 2; ++ai)
#pragma unroll
            for (int m = 0; m < 4; ++m) { float* rowp = C + (size_t)(row0 + ai * 128 + m * 16) * ldc + col0;
#pragma unroll
                for (int bj = 0; bj < 2; ++bj)
#pragma unroll
                    for (int n = 0; n < 2; ++n) *(f32x4*)(rowp + bj * 128 + n * 16) = acc[ai][bj][m][n]; }
    }
};

struct Args { const float* in[19]; float* out; unsigned char* ws; int ph_lo, ph_hi; int li, pad; };
struct Frame {
    unsigned char* lds; unsigned char* ws;
    int tid, lane, wave, G, bid;
    const float *x, *c, *w_ada, *b_ada, *g1, *g2, *w_in, *g_q, *g_k, *rel_bias, *pool_w, *pool_scale, *w_ab, *w_pb, *w_out, *w_pq, *peer_keys, *peer_u, *peer_v;
    float* out;
};

template <bool F8OUT = false, class Fn> __device__ __forceinline__ void transpose_item(const float* W, int K, int N, void* WTv, int ldk, int drow0, int k0, float* scr, int lane, Fn srccol, float mul = 1.0f) {
    const int sc = srccol(drow0 + (lane & 31));
#pragma unroll 8
    for (int i = 0; i < 32; ++i) { const int kk = 2 * i + (lane >> 5); scr[kk * 33 + (lane & 31)] = sc >= 0 ? W[(size_t)(k0 + kk) * N + sc] * mul : 0.f; }
    asm volatile("s_waitcnt lgkmcnt(0)" ::: "memory");
    const int c = lane & 7;
#pragma unroll
    for (int j = 0; j < 4; ++j) { const int n = (lane >> 3) + 8 * j; const float* s = scr + (8 * c) * 33 + n;
        if constexpr (F8OUT) { *(u32x2*)((unsigned char*)WTv + (size_t)(drow0 + n) * ldk + k0 + 8 * c) = pack8_fp8((f32x4){s[0 * 33], s[1 * 33], s[2 * 33], s[3 * 33]}, (f32x4){s[4 * 33], s[5 * 33], s[6 * 33], s[7 * 33]}); }
        else { u32x4 o; o.x = cvt_pk_bf16(s[0 * 33], s[1 * 33]); o.y = cvt_pk_bf16(s[2 * 33], s[3 * 33]); o.z = cvt_pk_bf16(s[4 * 33], s[5 * 33]); o.w = cvt_pk_bf16(s[6 * 33], s[7 * 33]);
            *(u32x4*)((bf16_t*)WTv + (size_t)(drow0 + n) * ldk + k0 + 8 * c) = o; } }
    asm volatile("s_waitcnt lgkmcnt(0)" ::: "memory");
}
__device__ __forceinline__ void phase0_prep(Frame& F) {
    F.lane = lane_now(); F.tid = F.wave * 64 + F.lane;
    const int gw = F.bid * 8 + F.wave, NGW = F.G * 8;
    float* scr = (float*)(F.lds + F.wave * 16384);
    constexpr int I_IN16 = (2304 / 32) * (DM / 64), I_IN8 = (5632 / 32) * (DM / 64);
    constexpr int I_AB = (2048 / 32) * (1024 / 64), I_OUT = (2048 / 32) * (2048 / 64), I_PW = 4 * 8 * 4;
    constexpr int NIT = I_IN16 + I_IN8 + 2 * I_AB + 2 * I_OUT + I_PW;
    auto ident = [](int j) { return j; };
    for (int it = gw; it < NIT; it += NGW) {
        int r = it;
        if (r < I_IN16) { const int nb = r % 72, kb = r / 72;
            transpose_item(F.w_in, DM, INW, F.ws + WS_WIN16, DM, nb * 32, kb * 64, scr, F.lane, [](int j) { return j < 1104 ? j + 1536 : (j < 1280 ? -1 : j + 1360); }); continue; }
        r -= I_IN16;
        if (r < I_IN8) { const int nb = r % 176, kb = r / 176;
            transpose_item<true>(F.w_in, DM, INW, F.ws + WS_WIN8, DM, nb * 32, kb * 64, scr, F.lane, [](int j) { return j < 1536 ? j : j + 2128; }, 16.0f); continue; }
        r -= I_IN8;
        if (r < I_AB) { transpose_item(F.w_ab, 1024, 2048, (bf16_t*)(F.ws + WS_WAB), 1024, (r % 64) * 32, (r / 64) * 64, scr, F.lane, ident); continue; }
        r -= I_AB;
        if (r < I_AB) { transpose_item(F.w_pb, 1024, 2048, (bf16_t*)(F.ws + WS_WPB), 1024, (r % 64) * 32, (r / 64) * 64, scr, F.lane, ident); continue; }
        r -= I_AB;
        if (r < I_OUT) { transpose_item<true>(F.w_out, 2048, 2048, F.ws + WS_WOUT, 2048, (r % 64) * 32, (r / 64) * 64, scr, F.lane, ident, 16.0f); continue; }
        r -= I_OUT;
        if (r < I_OUT) { transpose_item(F.w_pq, 2048, 2048, (bf16_t*)(F.ws + WS_WPQ), 2048, (r % 64) * 32, (r / 64) * 64, scr, F.lane, ident); continue; }
        r -= I_OUT;
        { const int g = r / 32, q = r % 32, nb = q % 8, kb = q / 8;
          transpose_item(F.pool_w + (size_t)g * 65536, 256, 256, (bf16_t*)(F.ws + WS_POOLW) + (size_t)g * 65536, 256, nb * 32, kb * 64, scr, F.lane, ident); }
    }
    {
        bf16_t* kb = (bf16_t*)(F.ws + WS_KEYSBD);
        for (int i = F.bid * 512 + F.tid; i < 2048 * 32; i += F.G * 512) {
            const int row = i / 32, k8 = (i % 32) * 8, p = (row >> 7) & 1;
            u32x4 o = (u32x4){0u, 0u, 0u, 0u};
            if ((k8 >> 7) == p) { const float* s = F.peer_keys + (size_t)row * 128 + (k8 & 127); const f32x4 a = *(const f32x4*)s, b = *(const f32x4*)(s + 4); o = pack8(a, b); }
            *(u32x4*)(kb + (size_t)row * 256 + k8) = o;
        }
    }
    {
        unsigned char* pu = F.ws + WS_PU;
        for (size_t i = (size_t)F.bid * 512 + F.tid; i < (size_t)NEXP * 64; i += (size_t)F.G * 512) {
            const float* src = F.peer_u + i * 32;
            u32x16 pk;
#pragma unroll
            for (int k = 0; k < 8; ++k) { const f32x4 a = *(const f32x4*)(src + k * 4) * 96.0f; pk[2 * k] = cvt_pk_bf16(a[0], a[1]); pk[2 * k + 1] = cvt_pk_bf16(a[2], a[3]); }
            const u32x6 p6 = __builtin_amdgcn_cvt_scalef32_pk32_fp6_bf16(__builtin_bit_cast(bf16x32, pk), 1.0f);
            unsigned char* dst = pu + i * 24;
            *(u32x2*)dst = (u32x2){p6[0], p6[1]}; *(u32x2*)(dst + 8) = (u32x2){p6[2], p6[3]}; *(u32x2*)(dst + 16) = (u32x2){p6[4], p6[5]};
        }
        unsigned char* pv = F.ws + WS_PV;
        for (int it = gw; it < (NEXP / 64) * 128; it += NGW) {
            const int e = (it >> 7) * 64 + F.lane, ch = it & 127;
            u32x4 ov;
#pragma unroll
            for (int k = 0; k < 4; ++k) { const f32x4 c = *(const f32x4*)(F.peer_v + (size_t)e * DM + ch * 16 + k * 4) * 4.0f;
                int wv = __builtin_amdgcn_cvt_pk_fp8_f32(c[0], c[1], 0, false); wv = __builtin_amdgcn_cvt_pk_fp8_f32(c[2], c[3], wv, true); ov[k] = (unsigned)wv; }
            *(u32x2*)(pv + ((size_t)(2 * ch) * NEXP + e) * 8) = (u32x2){ov[0], ov[1]};
            *(u32x2*)(pv + ((size_t)(2 * ch + 1) * NEXP + e) * 8) = (u32x2){ov[2], ov[3]};
        }
    }
    {
        __syncthreads();
        float* cact = (float*)(F.lds + 131072);
        float* red = (float*)F.lds;
        float* mp = (float*)(F.ws + WS_MODP);
        for (int it = F.bid; it < 48 * 4; it += F.G) {
            const int cb = it % 48, ds = it / 48, d0 = ds * 512;
            for (int i = F.tid; i < 8 * 512; i += 512) { const int b = i >> 9, d = i & 511; const float cv = F.c[b * DM + d0 + d]; cact[i] = cv * sigmoidf_(cv); }
            __syncthreads();
            f32x4 a[8];
#pragma unroll
            for (int b = 0; b < 8; ++b) a[b] = (f32x4){0.f, 0.f, 0.f, 0.f};
            const float* wp = F.w_ada + (size_t)(d0 + F.wave * 64) * 12288 + cb * 256 + F.lane * 4;
#pragma unroll 4
            for (int d = 0; d < 64; ++d) { const f32x4 w = *(const f32x4*)(wp + (size_t)d * 12288);
#pragma unroll
                for (int b = 0; b < 8; ++b) a[b] += w * cact[b * 512 + F.wave * 64 + d]; }
#pragma unroll
            for (int b = 0; b < 8; ++b)
#pragma unroll
                for (int j = 0; j < 4; ++j) red[(F.wave * 32 + b * 4 + j) * 64 + F.lane] = a[b][j];
            __syncthreads();
            for (int i = F.tid; i < 2048; i += 512) { const int v = i >> 6, l = i & 63; float s = 0.f;
#pragma unroll
                for (int w = 0; w < 8; ++w) s += red[(w * 32 + v) * 64 + l];
                mp[((size_t)ds * 8 + (v >> 2)) * 12288 + cb * 256 + l * 4 + (v & 3)] = s; }
            __syncthreads();
        }
    }
}

template <bool FIRST> __device__ __forceinline__ void phase_modnorm(Frame& F, const float* xin, const float* gain, int off_sh, int off_sc, bf16_t* dst, unsigned char* dst8 = nullptr) {
    F.lane = lane_now(); F.tid = F.wave * 64 + F.lane;
    const float* mp = (const float*)(F.ws + WS_MODP); float* mf = (float*)(F.ws + WS_MODF);
    if (FIRST) {
        for (int i = F.bid * 512 + F.tid; i < 8 * 12288; i += F.G * 512) {
            float s = F.b_ada[i % 12288];
#pragma unroll
            for (int k = 0; k < 4; ++k) s += mp[(size_t)k * 8 * 12288 + i];
            mf[i] = s; }
    }
    float* cA = (float*)F.lds; float* cB = cA + 2048;
    for (int ch = F.bid; ch < MTOK / 128; ch += F.G) {
        const int b = ch / 32;
        __syncthreads();
        for (int col = F.tid; col < 2048; col += 512) {
            float sc, sh;
            if (FIRST) { sc = F.b_ada[off_sc + col]; sh = F.b_ada[off_sh + col];
#pragma unroll
                for (int k = 0; k < 4; ++k) { sc += mp[((size_t)k * 8 + b) * 12288 + off_sc + col]; sh += mp[((size_t)k * 8 + b) * 12288 + off_sh + col]; } }
            else { sc = mf[b * 12288 + off_sc + col]; sh = mf[b * 12288 + off_sh + col]; }
            cA[col] = gain[col] * (1.f + sc); cB[col] = sh; }
        __syncthreads();
        for (int r = F.wave; r < 128; r += 8) {
            const size_t row = (size_t)ch * 128 + r;
            const float* xr = xin + row * 2048 + F.lane * 8;
            f32x4 v[4][2]; float ss = 0.f;
#pragma unroll
            for (int i = 0; i < 4; ++i) { v[i][0] = *(const f32x4*)(xr + i * 512); v[i][1] = *(const f32x4*)(xr + i * 512 + 4);
#pragma unroll
                for (int j = 0; j < 4; ++j) ss += v[i][0][j] * v[i][0][j] + v[i][1][j] * v[i][1][j]; }
            ss = wave_sum(ss);
            const float rinv = 1.0f / sqrtf(ss * (1.0f / 2048.0f) + EPS);
#pragma unroll
            for (int i = 0; i < 4; ++i) { const int col = i * 512 + F.lane * 8;
                const f32x4 a0 = *(const f32x4*)(cA + col), a1 = *(const f32x4*)(cA + col + 4), b0 = *(const f32x4*)(cB + col), b1 = *(const f32x4*)(cB + col + 4);
                const f32x4 y0 = v[i][0] * rinv * a0 + b0, y1 = v[i][1] * rinv * a1 + b1;
                *(u32x4*)(dst + row * 2048 + col) = pack8(y0, y1);
                if (FIRST) *(u32x2*)(dst8 + row * 2048 + col) = pack8_fp8(y0, y1); }
        }
    }
}

__device__ __forceinline__ void phase3_qknorm(Frame& F) {
    F.lane = lane_now(); F.tid = F.wave * 64 + F.lane;
    const bf16_t* q = (const bf16_t*)(F.ws + WS_QN); const bf16_t* k = (const bf16_t*)(F.ws + WS_KN); const bf16_t* v = (const bf16_t*)(F.ws + WS_V);
    unsigned char* q8 = F.ws + WS_Q8; unsigned char* k8 = F.ws + WS_K8; unsigned char* v8 = F.ws + WS_V8;
    const int gw = F.bid * 8 + F.wave, NGW = F.G * 8;
    for (int row = gw; row < MTOK; row += NGW) {
#pragma unroll
        for (int i = 0; i < 2; ++i) { const int ci = i * 64 + F.lane;
            f32x4 a, b; unpack8(*(const u32x4*)(q + (size_t)row * 1024 + ci * 8), a, b);
            float ss = a[0] * a[0] + a[1] * a[1] + a[2] * a[2] + a[3] * a[3] + b[0] * b[0] + b[1] * b[1] + b[2] * b[2] + b[3] * b[3];
            ss = row_sum16(ss);
            const float rinv = 1.0f / sqrtf(ss * (1.0f / 128.0f) + EPS);
            const float* gp = F.g_q + (ci & 15) * 8; const f32x4 g0 = *(const f32x4*)gp, g1 = *(const f32x4*)(gp + 4);
            *(u32x2*)(q8 + (size_t)row * 1024 + ci * 8) = pack8_fp8(a * rinv * g0, b * rinv * g1); }
        { const int ci = F.lane & 31; const bool isk = F.lane < 32;
            f32x4 a, b; unpack8(*(const u32x4*)((isk ? k : v) + (size_t)row * 256 + ci * 8), a, b);
            float ss = a[0] * a[0] + a[1] * a[1] + a[2] * a[2] + a[3] * a[3] + b[0] * b[0] + b[1] * b[1] + b[2] * b[2] + b[3] * b[3];
            ss = row_sum16(ss);
            const float rinv = isk ? 1.0f / sqrtf(ss * (1.0f / 128.0f) + EPS) : 1.0f;
            const float* gp = F.g_k + (ci & 15) * 8; f32x4 g0 = *(const f32x4*)gp, g1 = *(const f32x4*)(gp + 4);
            if (!isk) { g0 = (f32x4){1.f, 1.f, 1.f, 1.f}; g1 = g0; }
            *(u32x2*)((isk ? k8 : v8) + (size_t)row * 256 + ci * 8) = pack8_fp8(a * rinv * g0, b * rinv * g1); }
    }
}
template <int W> __device__ __forceinline__ void pooled_item(const bf16_t* pl, bf16_t* po, int row, int c8) {
    const int t = row & (SEQ - 1);
    f32x4 s0 = (f32x4){0.f, 0.f, 0.f, 0.f}, s1 = s0, x0 = s0, x1 = s0;
    u32x4 v[W];
#pragma unroll
    for (int j = 0; j < W; ++j) v[j] = *(const u32x4*)(pl + (size_t)(row - (j <= t ? j : 0)) * 1024 + c8);
#pragma unroll
    for (int j = 0; j < W; ++j) { f32x4 a, b; unpack8(v[j], a, b); if (j == 0) { x0 = a; x1 = b; } if (j <= t) { s0 += a; s1 += b; } }
    const float inv = 1.0f / (float)((t + 1 < W) ? t + 1 : W);
    *(u32x4*)(po + (size_t)row * 1024 + c8) = pack8(s0 * inv - x0, s1 * inv - x1);
}
__device__ __forceinline__ void phase3_pooled(Frame& F) {
    F.lane = lane_now(); F.tid = F.wave * 64 + F.lane;
    const bf16_t* pl = (const bf16_t*)(F.ws + WS_PL); bf16_t* po = (bf16_t*)(F.ws + WS_POOLED);
    const int gw = F.bid * 8 + F.wave, NGW = F.G * 8;
    for (int it = gw; it < (MTOK / 2) * 4; it += NGW) {
        const int g = it & 3, row = (it >> 2) * 2 + (F.lane >> 5), c8 = g * 256 + (F.lane & 31) * 8;
        if (g == 0) pooled_item<2>(pl, po, row, c8); else if (g == 1) pooled_item<4>(pl, po, row, c8); else if (g == 2) pooled_item<8>(pl, po, row, c8); else pooled_item<16>(pl, po, row, c8);
    }
}
typedef float f32x16 __attribute__((ext_vector_type(16)));
__device__ __forceinline__ float wrelu_(float wh, float d, float acc) { return __builtin_fmaf(wh, d, __builtin_fmaf(wh, __builtin_fabsf(d), acc)); }
__device__ __forceinline__ int sel_code(float s, float smin, float scale) { const float c = (s - smin) * scale; return (int)fminf(fmaxf(c, 0.f), 65535.f); }
__device__ __forceinline__ void hist_find(const unsigned* hist, int lane, int K, int& bsel, int& above) {
    const u32x4 h = *(const u32x4*)(hist + lane * 4);
    const int S = (int)(h.x + h.y + h.z + h.w);
    int x = S;
    x += __builtin_amdgcn_update_dpp(0, x, 0x101, 0xF, 0xF, true);
    x += __builtin_amdgcn_update_dpp(0, x, 0x102, 0xF, 0xF, true);
    x += __builtin_amdgcn_update_dpp(0, x, 0x104, 0xF, 0xF, true);
    x += __builtin_amdgcn_update_dpp(0, x, 0x108, 0xF, 0xF, true);
    const int t1 = __builtin_amdgcn_readlane(x, 16), t2 = __builtin_amdgcn_readlane(x, 32), t3 = __builtin_amdgcn_readlane(x, 48);
    const int r = lane >> 4;
    x += (r == 0 ? t1 + t2 + t3 : (r == 1 ? t2 + t3 : (r == 2 ? t3 : 0)));
    const int sufn = x - S;
    const bool mine = (x >= K) && (sufn < K);
    int b = 0, ab = 0;
    { int c = sufn;
      if (c + (int)h.w >= K) { b = 3; ab = c; } else { c += (int)h.w;
      if (c + (int)h.z >= K) { b = 2; ab = c; } else { c += (int)h.z;
      if (c + (int)h.y >= K) { b = 1; ab = c; } else { c += (int)h.y; b = 0; ab = c; } } } }
    const unsigned long long m = __ballot(mine);
    const int src = m ? (int)__builtin_ctzll(m) : 0;
    bsel = __builtin_amdgcn_readlane(lane * 4 + b, src); above = __builtin_amdgcn_readlane(ab, src);
}
__device__ __forceinline__ int mask_prefix(unsigned long long m) { return (int)__builtin_amdgcn_mbcnt_hi((unsigned)(m >> 32), __builtin_amdgcn_mbcnt_lo((unsigned)m, 0u)); }
template <class Fn> __device__ __forceinline__ void sel_sweep(const f32x4* rb4, int n4, int lane, int t, Fn fn) {
    f32x4 cur = rb4[lane];
    for (int c4 = 0; c4 < n4 - 1; ++c4) { const f32x4 nxt = rb4[(c4 + 1) * 64 + lane];
#pragma unroll
        for (int k = 0; k < 4; ++k) fn(cur[k], (c4 * 4 + k) * 64 + lane, true);
        cur = nxt; }
    { const int c4 = n4 - 1;
#pragma unroll
      for (int k = 0; k < 4; ++k) { const int idx = (c4 * 4 + k) * 64 + lane; fn(cur[k], idx, idx <= t); } }
}
template <int MODE = 0> __device__ __forceinline__ void indexer_select(Frame& F, int b, int t, const float* rowbuf, unsigned* hist, float* eqv, int* eqi) {
    unsigned short* selrow = (unsigned short*)(F.ws + (MODE ? WS_R0 : WS_SEL)) + (size_t)(b * SEQ + t) * 256;
    int lane = F.lane; asm volatile("" : "+v"(lane));
    const int nch = t / 64 + 1, n4 = (nch + 3) >> 2;
    const f32x4* rb4 = (const f32x4*)rowbuf;
    float mn = __builtin_huge_valf(), mx = -__builtin_huge_valf();
    sel_sweep(rb4, n4, lane, t, [&](float v, int, bool valid) { mn = valid ? fminf(mn, v) : mn; mx = valid ? fmaxf(mx, v) : mx; });
    mx = xor16_max(row_max16(mx)); { const auto r = __builtin_amdgcn_permlane32_swap(__float_as_uint(mx), __float_as_uint(mx), false, false); mx = fmaxf(__uint_as_float(r[0]), __uint_as_float(r[1])); }
    mn = -mn; mn = xor16_max(row_max16(mn)); { const auto r = __builtin_amdgcn_permlane32_swap(__float_as_uint(mn), __float_as_uint(mn), false, false); mn = -fmaxf(__uint_as_float(r[0]), __uint_as_float(r[1])); }
    const float scale = (mx > mn) ? 65535.0f / (mx - mn) : 0.f;
    *(u32x4*)(hist + lane * 4) = (u32x4){0u, 0u, 0u, 0u};
    sel_sweep(rb4, n4, lane, t, [&](float v, int, bool valid) { if (valid) { if (MODE == 2) ((volatile unsigned*)hist)[sel_code(v, mn, scale) >> 8] = 1u; else atomicAdd(&hist[sel_code(v, mn, scale) >> 8], 1u); } });
    int b1, above1; hist_find(hist, lane, KSEL, b1, above1);
    *(u32x4*)(hist + lane * 4) = (u32x4){0u, 0u, 0u, 0u};
    sel_sweep(rb4, n4, lane, t, [&](float v, int, bool valid) { const int code = sel_code(v, mn, scale); if (valid && (code >> 8) == b1) atomicAdd(&hist[code & 255], 1u); });
    int b2, above2; hist_find(hist, lane, KSEL - above1, b2, above2);
    const int T16 = (b1 << 8) | b2, need = KSEL - above1 - above2, ceq = (int)hist[b2];
    const bool all_eq = (ceq == need), collect = !all_eq && (ceq <= 64);
    const int eq_budget = all_eq ? 0x7fffffff : (collect ? 0 : need);
    int pos = 0, eqseen = 0;
    sel_sweep(rb4, n4, lane, t, [&](float v, int idx, bool valid) {
        const int code = sel_code(v, mn, scale);
        const bool gt = valid && code > T16, eq = valid && code == T16;
        const unsigned long long mg = __ballot(gt);
        const unsigned p = (unsigned)(pos + mask_prefix(mg));
        if (gt && p < (unsigned)KSEL) selrow[p] = (unsigned short)idx;
        pos += __popcll(mg);
        const unsigned long long me = __ballot(eq);
        if (me) {
            const int er = eqseen + mask_prefix(me); const bool te = eq && er < eq_budget;
            if (collect && eq) { eqv[er] = v; eqi[er] = idx; }
            eqseen += __popcll(me);
            const unsigned long long mte = __ballot(te);
            const unsigned pe = (unsigned)(pos + mask_prefix(mte));
            if (te && pe < (unsigned)KSEL) selrow[pe] = (unsigned short)idx;
            pos += __popcll(mte);
        }
    });
    if (collect && lane < ceq) {
        const float sv = eqv[lane]; const int idx = eqi[lane]; int rank = 0;
        for (int m = 0; m < ceq; ++m) { const float ov = eqv[m]; const int oi = eqi[m]; rank += (ov > sv || (ov == sv && oi < idx)) ? 1 : 0; }
        if (rank < need) selrow[KSEL - need + rank] = (unsigned short)idx;
    }
}
__device__ __forceinline__ void indexer_tile(Frame& F, int b, int t0) {
    const bf16_t* iq = (const bf16_t*)(F.ws + WS_IQ); const bf16_t* ik = (const bf16_t*)(F.ws + WS_IK); const float* iw = (const float*)(F.ws + WS_IW);
    int lane = F.lane; asm volatile("" : "+v"(lane));
    const int w = F.wave;
    if (t0 < KSEL) {
        const int t = t0 + w; unsigned short* selrow = (unsigned short*)(F.ws + WS_SEL) + (size_t)(b * SEQ + t) * 256;
#pragma unroll
        for (int p = 0; p < 4; ++p) { const int j = p * 64 + lane; selrow[j] = (unsigned short)(j <= t ? j : 0xFFFF); }
        return;
    }
    float* rowbuf = (float*)F.lds;
    unsigned char* stage = F.lds + 131072;
    const int p = w & 3, kh = w >> 2, hi = lane >> 5, r = lane & 31;
    const size_t qrow = (size_t)b * SEQ + t0 + 2 * p + (r >> 4);
    bf16x8 a[4];
#pragma unroll
    for (int ks = 0; ks < 4; ++ks) a[ks] = *(const bf16x8*)(iq + qrow * 1024 + (r & 15) * 64 + ks * 16 + 8 * hi);
    float wq[2][8];
#pragma unroll
    for (int q = 0; q < 2; ++q)
#pragma unroll
        for (int i = 0; i < 8; ++i) wq[q][i] = 0.5f * iw[((size_t)b * SEQ + t0 + 2 * p + q) * 16 + (i & 3) + 8 * ((i >> 2) & 1) + 4 * hi];
    const int nchunks = (t0 + 7) / 64 + 1, nsteps = (nchunks + 1) >> 1;
    const unsigned char* gsrc = (const unsigned char*)(ik + (size_t)b * SEQ * 64) + F.tid * 16;
    const int skey = F.tid >> 3, sc16 = F.tid & 7, soff = skey * 128 + ((sc16 ^ ((skey >> 1) & 7)) << 4);
    u32x4 sa0 = *(const u32x4*)gsrc, sb0 = sa0, sa1 = sa0, sb1 = sa0;
    sb0 = *(const u32x4*)(gsrc + (size_t)min(1, nchunks - 1) * 8192);
    sa1 = *(const u32x4*)(gsrc + (size_t)min(2, nchunks - 1) * 8192);
    sb1 = *(const u32x4*)(gsrc + (size_t)min(3, nchunks - 1) * 8192);
    __syncthreads();
#if PROBE_IDX != 1 && PROBE_IDX != 5
#define IDX_LD(c) (*(const u32x4*)(gsrc + (size_t)(c) * 8192))
#endif
#define IDX_MMA(SA, SB, ss, D0, D1) do { const int s_ = (ss); unsigned char* sb = stage + (s_ & 1) * 16384; \
        *(u32x4*)(sb + soff) = SA; *(u32x4*)(sb + 8192 + soff) = SB; \
        __syncthreads(); \
        SA = IDX_LD(min(2 * s_ + 4, nchunks - 1)); \
        SB = IDX_LD(min(2 * s_ + 5, nchunks - 1)); \
        _Pragma("unroll") for (int i = 0; i < 16; ++i) { D0[i] = 0.f; D1[i] = 0.f; } \
        _Pragma("unroll") for (int ks = 0; ks < 4; ++ks) { const unsigned char* bp = sb + key * 128 + (((ks * 2 + hi) ^ ((key >> 1) & 7)) << 4); \
            const bf16x8 bf0 = *(const bf16x8*)bp, bf1 = *(const bf16x8*)(bp + 8192); \
            D0 = __builtin_amdgcn_mfma_f32_32x32x16_bf16(a[ks], bf0, D0, 0, 0, 0); D1 = __builtin_amdgcn_mfma_f32_32x32x16_bf16(a[ks], bf1, D1, 0, 0, 0); } } while (0)
#define IDX_RED(ss, D0, D1) do { const int s_ = (ss); float x0_ = 0.f, x1_ = 0.f, y0_ = 0.f, y1_ = 0.f; \
        _Pragma("unroll") for (int i = 0; i < 8; ++i) { x0_ = wrelu_(wq[0][i], D0[i], x0_); x1_ = wrelu_(wq[1][i], D0[8 + i], x1_); y0_ = wrelu_(wq[0][i], D1[i], y0_); y1_ = wrelu_(wq[1][i], D1[8 + i], y1_); } \
        const float scx = swap32_pair(x0_, x1_), scy = swap32_pair(y0_, y1_); \
        *(f32x2*)(rowbuf + (2 * p + hi) * 4096 + ((s_ >> 1) * 64 + key) * 4 + 2 * (s_ & 1)) = (f32x2){scx, scy}; } while (0)
    const int key = kh * 32 + r;
    f32x16 dA0, dA1, dB0, dB1;
#if PROBE_IDX == 1
#define IDX_LD(c) (*(const u32x4*)(gsrc + (size_t)(c) * 8192))
#elif PROBE_IDX == 5
#define IDX_LD(c) SAVED
#endif
#if PROBE_IDX == 1 || PROBE_IDX == 5
    { const u32x4 SAVED = sa0;
    IDX_MMA(sa0, sb0, 0, dA0, dA1);
    for (int s2 = 0; s2 < nsteps; s2 += 2) {
        if (s2 + 1 < nsteps) IDX_MMA(sa1, sb1, s2 + 1, dB0, dB1);
        IDX_RED(s2, dA0, dA1);
        if (s2 + 2 < nsteps) IDX_MMA(sa0, sb0, s2 + 2, dA0, dA1);
        if (s2 + 1 < nsteps) IDX_RED(s2 + 1, dB0, dB1);
    }
    __syncthreads();
    sa0 = *(const u32x4*)gsrc;
    sb0 = *(const u32x4*)(gsrc + (size_t)min(1, nchunks - 1) * 8192);
    sa1 = *(const u32x4*)(gsrc + (size_t)min(2, nchunks - 1) * 8192);
    sb1 = *(const u32x4*)(gsrc + (size_t)min(3, nchunks - 1) * 8192); }
#undef IDX_LD
#define IDX_LD(c) (*(const u32x4*)(gsrc + (size_t)(c) * 8192))
#endif
    IDX_MMA(sa0, sb0, 0, dA0, dA1);
    for (int s2 = 0; s2 < nsteps; s2 += 2) {
        if (s2 + 1 < nsteps) IDX_MMA(sa1, sb1, s2 + 1, dB0, dB1);
        IDX_RED(s2, dA0, dA1);
        if (s2 + 2 < nsteps) IDX_MMA(sa0, sb0, s2 + 2, dA0, dA1);
        if (s2 + 1 < nsteps) IDX_RED(s2 + 1, dB0, dB1);
    }
#undef IDX_MMA
#undef IDX_RED
#undef IDX_LD
    __syncthreads();
    indexer_select(F, b, t0 + w, rowbuf + w * 4096, (unsigned*)(F.lds + 147456) + w * 256, (float*)(F.lds + 155648) + w * 64, (int*)(F.lds + 155648 + 2048) + w * 64);
#if PROBE_IDX >= 2
    indexer_select<PROBE_IDX - 1>(F, b, t0 + w, rowbuf + w * 4096, (unsigned*)(F.lds + 147456) + w * 256, (float*)(F.lds + 155648) + w * 64, (int*)(F.lds + 155648 + 2048) + w * 64);
#endif
}
__device__ __forceinline__ void phase3_indexer(Frame& F) {
    F.lane = lane_now(); F.tid = F.wave * 64 + F.lane;
    volatile LAS unsigned* misc = (volatile LAS unsigned*)((LAS unsigned char*)F.lds + MISC_OFF);
    const unsigned keep0 = misc[0], keep1 = misc[1];
    __syncthreads();
    const int nit = BATCH * (SEQ / 8);
    for (int k = 0;; ++k) {
        const int l = k * F.G + ((k & 1) ? (F.G - 1 - F.bid) : F.bid);
        if (l >= nit) { if (k * F.G >= nit) break; else continue; }
        const int qb = (SEQ / 8 - 1) - (l >> 3), b = l & 7;
        indexer_tile(F, b, qb * 8);
    }
    __syncthreads();
    if (F.tid == 0) { misc[0] = keep0; misc[1] = keep1; }
}

__device__ const unsigned char g_bucket[128] = {0, 1, 2, 3, 4, 5, 6, 7, 8, 9, 10, 11, 12, 13, 14, 15, 16, 16, 16, 17, 17, 18, 18, 18, 19, 19, 19, 20, 20, 20, 20, 21, 21, 21, 21, 22, 22, 22, 22, 22, 23, 23, 23, 23, 23, 23, 24, 24, 24, 24, 24, 24, 25, 25, 25, 25, 25, 25, 25, 26, 26, 26, 26, 26, 26, 26, 26, 27, 27, 27, 27, 27, 27, 27, 27, 27, 27, 28, 28, 28, 28, 28, 28, 28, 28, 28, 28, 29, 29, 29, 29, 29, 29, 29, 29, 29, 29, 29, 29, 30, 30, 30, 30, 30, 30, 30, 30, 30, 30, 30, 30, 30, 30, 31, 31, 31, 31, 31, 31, 31, 31, 31, 31, 31, 31, 31, 31, 31};
__device__ __forceinline__ void at_pv_step(f32x4 (&D0)[8], f32x4 (&D1)[8], const u32x4 (&buf)[8], LAS unsigned char* vwr, LAS unsigned char* ard, LAS unsigned char* brd) {
#pragma unroll
    for (int c = 0; c < 8; ++c) *(LAS u32x4*)(vwr + c * 16) = buf[c];
    const long pb = __builtin_bit_cast(long, __builtin_amdgcn_ds_read_tr8_b64_v2i32((LAS v2i*)brd));
#pragma unroll
    for (int tl = 0; tl < 8; ++tl) { const long va = __builtin_bit_cast(long, __builtin_amdgcn_ds_read_tr8_b64_v2i32((LAS v2i*)(ard + tl * 16))); D0[tl] = __builtin_amdgcn_mfma_f32_16x16x32_fp8_fp8(va, pb, D0[tl], 0, 0, 0); }
#pragma unroll
    for (int tl = 0; tl < 8; ++tl) { const long va = __builtin_bit_cast(long, __builtin_amdgcn_ds_read_tr8_b64_v2i32((LAS v2i*)(ard + 4608 + tl * 16))); D1[tl] = __builtin_amdgcn_mfma_f32_16x16x32_fp8_fp8(va, pb, D1[tl], 0, 0, 0); }
}
__device__ __forceinline__ void phase4_attention(Frame& F) {
    F.lane = lane_now(); F.tid = F.wave * 64 + F.lane;
    const unsigned char* q8 = F.ws + WS_Q8; const unsigned char* k8 = F.ws + WS_K8; const unsigned char* v8 = F.ws + WS_V8;
    const unsigned short* sel = (const unsigned short*)(F.ws + WS_SEL); bf16_t* ao = (bf16_t*)(F.ws + WS_ATTN);
    float* btab = (float*)F.lds;
    __syncthreads();
    for (int i = F.tid; i < 256; i += 512) btab[i] = F.rel_bias[i];
    __syncthreads();
    float* Pl = (float*)(F.lds + 4096 + F.wave * 12544); int* idl = (int*)((unsigned char*)Pl + 9216); float* psl = (float*)((unsigned char*)Pl + 12288); float* pml = psl + 8;
    LAS unsigned char* wl = (LAS unsigned char*)F.lds + 4096 + F.wave * 12544;
    const bool xmap = (F.G % 8) == 0;
    const int gw = xmap ? (F.bid / 8) * 8 + F.wave : F.bid * 8 + F.wave, NGW = xmap ? F.G : F.G * 8, nrows = xmap ? SEQ : MTOK;
    for (int rr = gw; rr < nrows; rr += NGW) {
        int lane = F.lane; asm volatile("" : "+v"(lane));
        const int row = xmap ? (F.bid & 7) * SEQ + rr : rr;
        const int b = row / SEQ, t = row % SEQ, r = lane & 31, hi = lane >> 5;
#pragma unroll
        for (int p = 0; p < 4; ++p) { idl[p * 64 + lane] = (int)sel[(size_t)row * 256 + p * 64 + lane]; }
        long a0[8], a1[8];
        { u32x4 qa[4];
#pragma unroll
          for (int i = 0; i < 4; ++i) qa[i] = (r < 8) ? *(const u32x4*)(q8 + (size_t)row * 1024 + r * 128 + hi * 64 + i * 16) : (u32x4){0u, 0u, 0u, 0u};
#pragma unroll
          for (int ks = 0; ks < 8; ++ks) { const unsigned lo = qa[ks >> 1][(ks & 1) * 2], hh = qa[ks >> 1][(ks & 1) * 2 + 1]; const long v = (long)(((unsigned long long)hh << 32) | lo);
              a0[ks] = (r < 4) ? v : 0l; a1[ks] = (r >= 4) ? v : 0l; } }
        f32x4 psum = (f32x4){0.f, 0.f, 0.f, 0.f}, pmax = psum;
#define AT_LOADK(buf, kb) do { const int key_ = idl[(kb) * 32 + r]; const int kc_ = key_ <= t ? key_ : 0; const unsigned char* kr_ = k8 + ((size_t)b * SEQ + kc_) * 256 + hi * 64; \
            _Pragma("unroll") for (int i = 0; i < 4; ++i) { buf[i] = *(const u32x4*)(kr_ + i * 16); buf[4 + i] = *(const u32x4*)(kr_ + 128 + i * 16); } } while (0)
#define AT_QK(buf, kb) do { const int key_ = idl[(kb) * 32 + r]; const bool valid_ = key_ <= t; const int kc_ = valid_ ? key_ : 0; \
            f32x16 d; _Pragma("unroll") for (int i = 0; i < 16; ++i) d[i] = 0.f; \
            _Pragma("unroll") for (int ks = 0; ks < 8; ++ks) { const long bv_ = (long)(((unsigned long long)buf[ks >> 1][(ks & 1) * 2 + 1] << 32) | buf[ks >> 1][(ks & 1) * 2]); d = __builtin_amdgcn_mfma_f32_32x32x16_fp8_fp8(a0[ks], bv_, d, 0, 0, 0); } \
            _Pragma("unroll") for (int ks = 0; ks < 8; ++ks) { const long bv_ = (long)(((unsigned long long)buf[4 + (ks >> 1)][(ks & 1) * 2 + 1] << 32) | buf[4 + (ks >> 1)][(ks & 1) * 2]); d = __builtin_amdgcn_mfma_f32_32x32x16_fp8_fp8(a1[ks], bv_, d, 0, 0, 0); } \
            const int dist_ = t - kc_; const int bkt_ = dist_ < 128 ? (int)g_bucket[dist_] : 31; \
            const f32x4 bias_ = *(const f32x4*)(btab + bkt_ * 8 + 4 * hi); f32x4 e_; \
            _Pragma("unroll") for (int i = 0; i < 4; ++i) e_[i] = valid_ ? __expf(d[i] * 0.08838834764831845f + bias_[i]) : 0.f; \
            psum += e_; _Pragma("unroll") for (int i = 0; i < 4; ++i) pmax[i] = fmaxf(pmax[i], e_[i]); *(f32x4*)(Pl + ((kb) * 32 + r) * 8 + 4 * hi) = e_; } while (0)
        {
            u32x4 kA[8], kB[8];
            AT_LOADK(kA, 0);
#pragma unroll 1
            for (int kb = 0; kb < 8; kb += 2) {
                AT_LOADK(kB, kb + 1);
                AT_QK(kA, kb);
                if (kb + 2 < 8) AT_LOADK(kA, kb + 2);
                AT_QK(kB, kb + 1);
            }
        }
#undef AT_LOADK
#undef AT_QK
#pragma unroll
        for (int i = 0; i < 4; ++i) { psum[i] = xor16_sum(row_sum16(psum[i])); pmax[i] = xor16_max(row_max16(pmax[i])); }
        if (r == 0) { *(f32x4*)(psl + 4 * hi) = psum; *(f32x4*)(pml + 4 * hi) = pmax; }
        const int fk = lane & 31, fg = lane >> 5, kq = lane >> 4, tq = (lane >> 1) & 7, tp = lane & 1;
#define AT_LOADV(buf, ks_) do { const int key_ = idl[(ks_) * 32 + fk]; const int kc_ = key_ <= t ? key_ : 0; const unsigned char* vr_ = v8 + ((size_t)b * SEQ + kc_) * 256 + fg * 128; \
            _Pragma("unroll") for (int c = 0; c < 8; ++c) buf[c] = *(const u32x4*)(vr_ + c * 16); } while (0)
        u32x4 vA[8], vB[8];
        AT_LOADV(vA, 0);
        { const f32x4 m0 = *(const f32x4*)pml, m1 = *(const f32x4*)(pml + 4);
          f32x4 r0, r1;
#pragma unroll
          for (int i = 0; i < 4; ++i) { r0[i] = __builtin_amdgcn_rcpf(m0[i]); r1[i] = __builtin_amdgcn_rcpf(m1[i]); }
#pragma unroll
          for (int i = 0; i < 4; ++i) { const int key = i * 64 + lane;
              *(LAS u32x2*)(wl + 10240 + key * 8) = pack8_fp8(*(const f32x4*)(Pl + key * 8) * r0, *(const f32x4*)(Pl + key * 8 + 4) * r1); } }
        f32x4 D0[8], D1[8];
#pragma unroll
        for (int tl = 0; tl < 8; ++tl) { D0[tl] = (f32x4){0.f, 0.f, 0.f, 0.f}; D1[tl] = D0[tl]; }
        LAS unsigned char* vwr = wl + fg * 4608 + fk * 144;
        LAS unsigned char* ard = wl + (kq * 8 + tq) * 144 + 8 * tp;
        LAS unsigned char* brd = wl + 10240 + (kq * 8 + tq) * 8;
#pragma unroll 1
        for (int ks = 0; ks < 8; ks += 2) {
            AT_LOADV(vB, ks + 1);
            at_pv_step(D0, D1, vA, vwr, ard, brd + ks * 256);
            if (ks + 2 < 8) AT_LOADV(vA, ks + 2);
            at_pv_step(D0, D1, vB, vwr, ard, brd + (ks + 1) * 256);
        }
#undef AT_LOADV
        { const int n = lane & 15, q4 = lane >> 4;
          if (n < 8) { const float sc = pml[n] / psl[n]; const bool g1 = n >= 4;
              bf16_t* op = ao + (size_t)row * 1024 + n * 128 + q4 * 4;
#pragma unroll
              for (int tl = 0; tl < 8; ++tl) { const f32x4 d = (g1 ? D1[tl] : D0[tl]) * sc;
                  *(u32x2*)(op + tl * 16) = (u32x2){cvt_pk_bf16(d[0], d[1]), cvt_pk_bf16(d[2], d[3])}; } } }
    }
}

__device__ __forceinline__ float dot16f8(u32x4 w, const float* h) {
    float s = 0.f;
#pragma unroll
    for (int d = 0; d < 4; ++d) { const f32x2 lo = __builtin_amdgcn_cvt_pk_f32_fp8((int)w[d], false), hi = __builtin_amdgcn_cvt_pk_f32_fp8((int)w[d], true);
        s += lo.x * h[4 * d] + lo.y * h[4 * d + 1] + hi.x * h[4 * d + 2] + hi.y * h[4 * d + 3]; }
    return s;
}
__device__ __forceinline__ void fma16f8(u32x4 w, float cf, float* acc) {
#pragma unroll
    for (int d = 0; d < 4; ++d) { const f32x2 lo = __builtin_amdgcn_cvt_pk_f32_fp8((int)w[d], false), hi = __builtin_amdgcn_cvt_pk_f32_fp8((int)w[d], true);
        acc[4 * d] += cf * lo.x; acc[4 * d + 1] += cf * lo.y; acc[4 * d + 2] += cf * hi.x; acc[4 * d + 3] += cf * hi.y; }
}
__device__ __forceinline__ float gelu_erf(float x) { return 0.5f * x * (1.0f + erff(x * 0.70710678118654752f)); }
__device__ __forceinline__ void ce_k(unsigned& a, unsigned& b) { const unsigned hi = a > b ? a : b, lo = a > b ? b : a; a = hi; b = lo; }
__device__ __forceinline__ void ce_kp(unsigned& ka, unsigned& pa, unsigned& kb, unsigned& pb) { const bool sw = kb > ka; const unsigned k0 = sw ? kb : ka, k1 = sw ? ka : kb, p0 = sw ? pb : pa, p1 = sw ? pa : pb; ka = k0; kb = k1; pa = p0; pb = p1; }
__device__ __forceinline__ void bmerge16(unsigned (&x)[16]) {
#pragma unroll
    for (int jj = 0; jj < 4; ++jj) { const int j = 8 >> jj;
#pragma unroll
        for (int i = 0; i < 16; ++i) { const int l = i ^ j; if (l > i) ce_k(x[i], x[l]); }
        __builtin_amdgcn_sched_barrier(0); }
}
__device__ __forceinline__ void bmerge16p(unsigned (&x)[16], unsigned (&p)[16]) {
#pragma unroll
    for (int jj = 0; jj < 4; ++jj) { const int j = 8 >> jj;
#pragma unroll
        for (int i = 0; i < 16; ++i) { const int l = i ^ j; if (l > i) ce_kp(x[i], p[i], x[l], p[l]); }
        __builtin_amdgcn_sched_barrier(0); }
}
__device__ __forceinline__ void bsort16(unsigned (&x)[16]) {
#pragma unroll
    for (int kk = 1; kk <= 4; ++kk) { const int k = 1 << kk;
#pragma unroll
        for (int jj = 0; jj < 4; ++jj) { const int j = (k >> 1) >> jj;
            if (j > 0) {
#pragma unroll
                for (int i = 0; i < 16; ++i) { const int l = i ^ j; if (l > i) { if ((i & k) == 0) ce_k(x[i], x[l]); else ce_k(x[l], x[i]); } }
                __builtin_amdgcn_sched_barrier(0); } } }
}
__device__ __forceinline__ void bsort16p(unsigned (&x)[16], unsigned (&p)[16]) {
#pragma unroll
    for (int kk = 1; kk <= 4; ++kk) { const int k = 1 << kk;
#pragma unroll
        for (int jj = 0; jj < 4; ++jj) { const int j = (k >> 1) >> jj;
            if (j > 0) {
#pragma unroll
                for (int i = 0; i < 16; ++i) { const int l = i ^ j; if (l > i) { if ((i & k) == 0) ce_kp(x[i], p[i], x[l], p[l]); else ce_kp(x[l], p[l], x[i], p[i]); } }
                __builtin_amdgcn_sched_barrier(0); } } }
}
__device__ __forceinline__ void top16_row(const unsigned char* rowp, unsigned (&t)[16]) {
#pragma unroll
    for (int i = 0; i < 16; ++i) t[i] = 0u;
#pragma unroll 1
    for (int g = 0; g < 8; ++g) {
        unsigned w[8];
#pragma unroll
        for (int q = 0; q < 4; ++q) { const u32x2 v = *(const u32x2*)(rowp + g * 32 + q * 8); w[2 * q] = v.x; w[2 * q + 1] = v.y; }
        unsigned sk[16];
#pragma unroll
        for (int d = 0; d < 8; ++d) {
            const unsigned lo = w[d] << 16, hi = w[d];
            const unsigned xl = lo ^ ((unsigned)((int)lo >> 31) | 0x80000000u), xh = hi ^ ((unsigned)((int)hi >> 31) | 0x80000000u);
            sk[2 * d] = ((xl >> 9) & 0xFFFFFF80u) | (unsigned)(127 - (g * 16 + 2 * d));
            sk[2 * d + 1] = ((xh >> 9) & 0xFFFFFF80u) | (unsigned)(127 - (g * 16 + 2 * d + 1)); }
        bsort16(sk);
#pragma unroll
        for (int i = 0; i < 16; ++i) t[i] = t[i] > sk[15 - i] ? t[i] : sk[15 - i];
        bmerge16(t);
    }
}
__device__ __forceinline__ float key_val(unsigned key) { const unsigned y = (key << 9) & 0xFFFF0000u; return __uint_as_float((y ^ (~(unsigned)((int)y >> 31) | 0x80000000u)) & 0xFFFF0000u); }
__device__ __forceinline__ unsigned sum_key(float s, int c) { const unsigned u = __float_as_uint(s); return ((u ^ ((unsigned)((int)u >> 31) | 0x80000000u)) & ~63u) | (unsigned)(63 - c); }
__device__ __forceinline__ float sum_val(unsigned k) { const unsigned y = k & ~63u; return __uint_as_float(y ^ (~(unsigned)((int)y >> 31) | 0x80000000u)); }
typedef __bf16 bf2_t __attribute__((ext_vector_type(2)));
__device__ __forceinline__ float dot2_bf(unsigned a, unsigned b, float c) { return __builtin_amdgcn_fdot2_f32_bf16(__builtin_bit_cast(bf2_t, a), __builtin_bit_cast(bf2_t, b), c, false); }
__device__ __forceinline__ float dot32_f6b(u32x4 wa, u32x2 wb, u32x4 h0, u32x4 h1, u32x4 h2, u32x4 h3) {
    const bf16x32 dec = __builtin_amdgcn_cvt_scalef32_pk32_bf16_fp6((u32x6){wa.x, wa.y, wa.z, wa.w, wb.x, wb.y}, 1.0f);
    const u32x16 ud = __builtin_bit_cast(u32x16, dec);
    float acc = 0.f;
    acc = dot2_bf(ud.s0, h0.x, acc); acc = dot2_bf(ud.s1, h0.y, acc); acc = dot2_bf(ud.s2, h0.z, acc); acc = dot2_bf(ud.s3, h0.w, acc);
    acc = dot2_bf(ud.s4, h1.x, acc); acc = dot2_bf(ud.s5, h1.y, acc); acc = dot2_bf(ud.s6, h1.z, acc); acc = dot2_bf(ud.s7, h1.w, acc);
    acc = dot2_bf(ud.s8, h2.x, acc); acc = dot2_bf(ud.s9, h2.y, acc); acc = dot2_bf(ud.sa, h2.z, acc); acc = dot2_bf(ud.sb, h2.w, acc);
    acc = dot2_bf(ud.sc, h3.x, acc); acc = dot2_bf(ud.sd, h3.y, acc); acc = dot2_bf(ud.se, h3.z, acc); acc = dot2_bf(ud.sf, h3.w, acc);
    return acc;
}
__device__ const unsigned char g_cab[64] = {0, 1, 2, 3, 4, 5, 6, 7, 8, 9, 10, 11, 12, 13, 14, 15, 16, 17, 18, 19, 20, 21, 22, 23, 32, 33, 34, 35, 36, 48, 49, 50, 51, 64, 65, 66, 80, 81, 96, 97, 112, 113, 128, 144, 160, 176, 192, 208, 224, 240, 0, 0, 0, 0, 0, 0, 0, 0, 0, 0, 0, 0, 0, 0};
__device__ __forceinline__ void phase10_peer(Frame& F) {
    F.lane = lane_now(); F.tid = F.wave * 64 + F.lane;
    const bf16_t* sub = (const bf16_t*)(F.ws + WS_SUB); const bf16_t* h2 = (const bf16_t*)(F.ws + WS_H2);
    const unsigned char* pu = F.ws + WS_PU; unsigned* pairs = (unsigned*)(F.ws + WS_PAIRS);
    const int gw = F.bid * 8 + F.wave, NGW = F.G * 8;
    unsigned char* wb = F.lds + F.wave * 19200;
    unsigned char* h2b = wb; unsigned short* gl16 = (unsigned short*)(wb + 16896); unsigned* hist = (unsigned*)(wb + 18944); unsigned* base = hist + 32;
    unsigned* tmp = (unsigned*)wb;
    unsigned* wls0 = (unsigned*)(F.ws + WS_WLS) + (size_t)gw * 1024;
    const int ntok = (MTOK - gw + NGW - 1) / NGW;
    constexpr int CA[50] = {0,0,0,0,0,0,0,0,0,0,0,0,0,0,0,0, 1,1,1,1,1,1,1,1, 2,2,2,2,2, 3,3,3,3, 4,4,4, 5,5, 6,6, 7,7, 8,9,10,11,12,13,14,15};
    constexpr int CB[50] = {0,1,2,3,4,5,6,7,8,9,10,11,12,13,14,15, 0,1,2,3,4,5,6,7, 0,1,2,3,4, 0,1,2,3, 0,1,2, 0,1, 0,1, 0,1, 0,0,0,0,0,0,0,0};
    for (int p0 = 0; p0 < ntok; p0 += 8) {
        int lane = F.lane; asm volatile("" : "+v"(lane));
        const int nt = (ntok - p0) < 8 ? (ntok - p0) : 8;
        {
            u32x4 st[16];
#define SEL_LOAD(half) do { asm volatile("" : "+v"(lane)); const int srow_l = lane >> 4, scol = lane & 15; _Pragma("unroll") for (int it = 0; it < 16; ++it) { const int r_ = it * 4 + srow_l; int ti_ = r_ >> 3; ti_ = ti_ < nt ? ti_ : nt - 1; \
                st[it] = *(const u32x4*)(sub + (size_t)(gw + (p0 + ti_) * NGW) * 2048 + (r_ & 7) * 256 + (half) * 128 + scol * 8); } } while (0)
#define SEL_STORE() do { const int srow_l = lane >> 4, scol = lane & 15; _Pragma("unroll") for (int it = 0; it < 16; ++it) { unsigned char* d_ = wb + (it * 4 + srow_l) * 264 + scol * 16; \
                *(u32x2*)d_ = (u32x2){st[it].x, st[it].y}; *(u32x2*)(d_ + 8) = (u32x2){st[it].z, st[it].w}; } } while (0)
            unsigned tA[16], tB[16];
            SEL_LOAD(0); SEL_STORE();
            __builtin_amdgcn_sched_barrier(0);
            top16_row(wb + lane * 264, tA);
            __builtin_amdgcn_sched_barrier(0);
            asm volatile("" : "+v"(tA[0]), "+v"(tA[1]), "+v"(tA[2]), "+v"(tA[3]), "+v"(tA[4]), "+v"(tA[5]), "+v"(tA[6]), "+v"(tA[7]), "+v"(tA[8]), "+v"(tA[9]), "+v"(tA[10]), "+v"(tA[11]), "+v"(tA[12]), "+v"(tA[13]), "+v"(tA[14]), "+v"(tA[15]) :: "memory");
            SEL_LOAD(1); SEL_STORE();
            __builtin_amdgcn_sched_barrier(0);
            top16_row(wb + lane * 264, tB);
            __builtin_amdgcn_sched_barrier(0);
#undef SEL_LOAD
#undef SEL_STORE
            float vA[16], vB[16];
            { unsigned pa[4] = {0u, 0u, 0u, 0u}, pb[4] = {0u, 0u, 0u, 0u};
#pragma unroll
              for (int i = 0; i < 16; ++i) { vA[i] = key_val(tA[i]); vB[i] = key_val(tB[i]); pa[i >> 2] |= (127u - (tA[i] & 127u)) << (8 * (i & 3)); pb[i >> 2] |= (127u - (tB[i] & 127u)) << (8 * (i & 3)); }
              unsigned char* rp = wb + lane * 264;
              *(u32x2*)rp = (u32x2){pa[0], pa[1]}; *(u32x2*)(rp + 8) = (u32x2){pa[2], pa[3]}; *(u32x2*)(rp + 16) = (u32x2){pb[0], pb[1]}; *(u32x2*)(rp + 24) = (u32x2){pb[2], pb[3]}; }
            unsigned tk[16];
#pragma unroll
            for (int c = 0; c < 16; ++c) tk[c] = sum_key(vA[CA[c]] + vB[CB[c]], c);
            bsort16(tk);
#pragma unroll
            for (int grp = 1; grp < 3; ++grp) {
                unsigned sk[16];
#pragma unroll
                for (int e = 0; e < 16; ++e) { const int c = grp * 16 + e; sk[e] = sum_key(vA[CA[c]] + vB[CB[c]], c); }
                bsort16(sk);
#pragma unroll
                for (int i = 0; i < 16; ++i) tk[i] = tk[i] > sk[15 - i] ? tk[i] : sk[15 - i];
                bmerge16(tk);
            }
#pragma unroll
            for (int c = 48; c < 50; ++c) { unsigned k = sum_key(vA[CA[c]] + vB[CB[c]], c);
#pragma unroll
                for (int i = 0; i < 16; ++i) ce_k(tk[i], k); }
            const float s0 = sum_val(tk[0]); float ev[16], esum = 0.f;
#pragma unroll
            for (int r = 0; r < 16; ++r) { ev[r] = __expf(sum_val(tk[r]) - s0); esum += ev[r]; }
            const float einv = 1.0f / esum;
            unsigned eid[16];
            { const unsigned char* rp = wb + lane * 264;
#pragma unroll
              for (int r = 0; r < 16; ++r) { const unsigned cab = g_cab[63u - (tk[r] & 63u)]; eid[r] = (unsigned)rp[cab >> 4] * 128u + (unsigned)rp[16 + (cab & 15u)]; } }
            if ((lane >> 3) < nt) {
#pragma unroll
                for (int r = 0; r < 16; ++r) { const int e = lane * 16 + r; tmp[e] = ((unsigned)e << 14) | eid[r]; gl16[e] = (unsigned short)(cvt_pk_bf16(ev[r] * einv, 0.f) & 0xffffu); } }
        }
        asm volatile("" : "+v"(lane));
#pragma unroll 1
        for (int grp = 0; grp < 2; ++grp) {
            const int ng = nt - grp * 4; const int ne = (ng <= 0 ? 0 : (ng < 4 ? ng : 4)) * 128;
            if (ne == 0) break;
            unsigned* wls = wls0 + grp * 512;
            if (lane < 32) hist[lane] = 0u;
            unsigned ent[8]; unsigned rk[8];
#pragma unroll
            for (int q = 0; q < 8; ++q) { const int e = q * 64 + lane; ent[q] = (e < ne) ? tmp[grp * 512 + e] : 0u; rk[q] = (e < ne) ? atomicAdd(&hist[(ent[q] & 0x3FFFu) >> 9], 1u) : 0u; }
            { int hv = lane < 32 ? (int)hist[lane] : 0; int x = hv;
              x += __builtin_amdgcn_update_dpp(0, x, 0x111, 0xF, 0xF, true); x += __builtin_amdgcn_update_dpp(0, x, 0x112, 0xF, 0xF, true);
              x += __builtin_amdgcn_update_dpp(0, x, 0x114, 0xF, 0xF, true); x += __builtin_amdgcn_update_dpp(0, x, 0x118, 0xF, 0xF, true);
              const int t0 = __builtin_amdgcn_readlane(x, 15); if (lane >= 16) x += t0;
              if (lane < 32) base[lane] = (unsigned)(x - hv); }
#pragma unroll
            for (int q = 0; q < 8; ++q) { const int e = q * 64 + lane; if (e < ne) wls[base[(ent[q] & 0x3FFFu) >> 9] + rk[q]] = ent[q]; }
        }
        asm volatile("s_waitcnt vmcnt(0)" ::: "memory");
#pragma unroll 1
        for (int grp = 0; grp < 2; ++grp) {
            const int ng = nt - grp * 4; const int ngc = ng <= 0 ? 0 : (ng < 4 ? ng : 4), ne = ngc * 128;
            if (ne == 0) break;
            const unsigned* wls = wls0 + grp * 512;
            asm volatile("" : "+v"(lane));
#pragma unroll 1
            for (int i = 0; i < ngc; ++i) { const bf16_t* hr = h2 + (size_t)(gw + (p0 + grp * 4 + i) * NGW) * 2048 + lane * 32;
#pragma unroll
                for (int q = 0; q < 4; ++q) *(u32x4*)(h2b + i * 4096 + q * 1024 + lane * 16) = *(const u32x4*)(hr + q * 8); }
            unsigned entn = __hip_atomic_load(wls + lane, __ATOMIC_RELAXED, __HIP_MEMORY_SCOPE_AGENT);
#pragma unroll 1
            for (int c = 0; c < ne; c += 64) {
                const unsigned ent64 = entn;
                if (c + 64 < ne) entn = __hip_atomic_load(wls + c + 64 + lane, __ATOMIC_RELAXED, __HIP_MEMORY_SCOPE_AGENT);
#pragma unroll 1
                for (int i0 = 0; i0 < 64; i0 += 8) {
                    u32x4 wA[8]; u32x2 wB[8]; unsigned en[8];
#pragma unroll
                    for (int jj = 0; jj < 8; ++jj) { en[jj] = (unsigned)__builtin_amdgcn_readlane((int)ent64, i0 + jj); const unsigned char* ur = pu + (size_t)(en[jj] & 0x3FFFu) * 1536 + lane * 24;
                        const u32x2 t0 = *(const u32x2*)ur, t1 = *(const u32x2*)(ur + 8); wA[jj] = (u32x4){t0.x, t0.y, t1.x, t1.y}; wB[jj] = *(const u32x2*)(ur + 16); }
                    float pr[8];
#pragma unroll
                    for (int jj = 0; jj < 8; ++jj) { const unsigned char* hp = h2b + ((en[jj] >> 21) & 3u) * 4096 + lane * 16;
                        pr[jj] = dot32_f6b(wA[jj], wB[jj], *(const u32x4*)hp, *(const u32x4*)(hp + 1024), *(const u32x4*)(hp + 2048), *(const u32x4*)(hp + 3072)); __builtin_amdgcn_sched_barrier(0); }
#pragma unroll
                    for (int i = 0; i < 4; ++i) pr[i] = swap32_pair(pr[i], pr[i + 4]);
#pragma unroll
                    for (int i = 0; i < 2; ++i) pr[i] = swap16_pair(pr[i], pr[i + 2]);
                    const bool b3 = (lane & 8) != 0;
                    { const float snd = b3 ? pr[0] : pr[1], kp = b3 ? pr[1] : pr[0]; pr[0] = kp + dpp_f<DPP_ROR8>(snd); }
                    float tot = pr[0]; tot += dpp_f<DPP_XOR1>(tot); tot += dpp_f<DPP_XOR2>(tot); tot += dpp_f<DPP_HMIRROR>(tot);
                    const unsigned em = (unsigned)__shfl((int)ent64, i0 + (lane >> 3));
                    if ((lane & 7) == 0) {
                        const int ti = (int)(em >> 21), j = (int)((em >> 14) & 127u), row = gw + (p0 + ti) * NGW;
                        const float cf = gelu_erf(tot * (1.0f / 96.0f)) * __uint_as_float((unsigned)gl16[(em >> 14) & 1023u] << 16);
                        pairs[((size_t)(row >> 6) * 128 + j) * 64 + (row & 63)] = ((unsigned)__builtin_bit_cast(unsigned short, (_Float16)cf) << 16) | (em & 0x3FFFu);
                    }
                }
            }
        }
    }
}

__device__ __forceinline__ void phase11_peer_v(Frame& F, float* dst) {
    F.lane = lane_now(); F.tid = F.wave * 64 + F.lane;
    const unsigned* pairs = (const unsigned*)(F.ws + WS_PAIRS); const float* mf = (const float*)(F.ws + WS_MODF);
    unsigned long long* vs = (unsigned long long*)F.lds;
    for (int c0 = F.bid; c0 < DM / 8; c0 += F.G) {
        const int c = (c0 & 7) * 32 + (c0 >> 3);
        __syncthreads();
        { const u32x4* src = (const u32x4*)(F.ws + WS_PV + (size_t)c * NEXP * 8); u32x4* dst = (u32x4*)F.lds;
#pragma unroll 4
          for (int i = F.tid; i < NEXP * 8 / 16; i += 512) dst[i] = src[i]; }
        __syncthreads();
        for (int tile = F.wave; tile < MTOK / 64; tile += 8) {
            int lane = F.lane; asm volatile("" : "+v"(lane));
            const unsigned* pp = pairs + (size_t)tile * 128 * 64 + lane;
            const int row = tile * 64 + lane;
            const float* gt2 = mf + (size_t)(tile / (SEQ / 64)) * 12288 + 10240 + c * 8;
            const float* ip = F.out + (size_t)row * 2048 + c * 8; float* op = dst + (size_t)row * 2048 + c * 8;
            const f32x4 x0 = *(const f32x4*)ip, x1 = *(const f32x4*)(ip + 4), g0 = *(const f32x4*)gt2 * 0.25f, g1 = *(const f32x4*)(gt2 + 4) * 0.25f;
            typedef __fp16 h2_t __attribute__((__vector_size__(2 * sizeof(__fp16))));
            h2_t acc[4];
#pragma unroll
            for (int i = 0; i < 4; ++i) acc[i] = (h2_t){(__fp16)0.f, (__fp16)0.f};
#define P11_LOAD(dst, j0) do { _Pragma("unroll") for (int jj = 0; jj < 16; ++jj) dst[jj] = pp[((j0) + jj) * 64]; } while (0)
#define P11_COMP(src) do { _Pragma("unroll") for (int jj = 0; jj < 16; ++jj) { const unsigned long long v = vs[src[jj] & 0x3FFFu]; \
                    const h2_t cf = __builtin_bit_cast(h2_t, __builtin_amdgcn_perm(src[jj], src[jj], 0x03020302u)); \
                    const int lo = (int)(unsigned)v, hi = (int)(unsigned)(v >> 32); \
                    acc[0] = __builtin_elementwise_fma(__builtin_amdgcn_cvt_scalef32_pk_f16_fp8(lo, 1.0f, false), cf, acc[0]); acc[1] = __builtin_elementwise_fma(__builtin_amdgcn_cvt_scalef32_pk_f16_fp8(lo, 1.0f, true), cf, acc[1]); \
                    acc[2] = __builtin_elementwise_fma(__builtin_amdgcn_cvt_scalef32_pk_f16_fp8(hi, 1.0f, false), cf, acc[2]); acc[3] = __builtin_elementwise_fma(__builtin_amdgcn_cvt_scalef32_pk_f16_fp8(hi, 1.0f, true), cf, acc[3]); } } while (0)
            unsigned pa[16], pb[16];
            P11_LOAD(pa, 0);
#pragma unroll 1
            for (int j0 = 0; j0 < 128; j0 += 32) {
                P11_LOAD(pb, j0 + 16);
                P11_COMP(pa);
                if (j0 + 32 < 128) P11_LOAD(pa, j0 + 32);
                P11_COMP(pb);
            }
#if PROBE_P11X == 1
            { h2_t sv[4]; for (int i = 0; i < 4; ++i) sv[i] = acc[i];
#pragma unroll 1
              for (int j0 = 0; j0 < 128; j0 += 32) {
#pragma unroll
                for (int jj = 0; jj < 16; ++jj) { asm volatile("" : "+v"(pa[jj])); asm volatile("" : "+v"(pb[jj])); }
                P11_COMP(pa); P11_COMP(pb); }
              asm volatile("" :: "v"(acc[0]), "v"(acc[1]), "v"(acc[2]), "v"(acc[3])); for (int i = 0; i < 4; ++i) acc[i] = sv[i]; }
#elif PROBE_P11X == 2
            { P11_LOAD(pa, 0);
#pragma unroll 1
              for (int j0 = 0; j0 < 128; j0 += 32) {
                P11_LOAD(pb, j0 + 16);
#pragma unroll
                for (int jj = 0; jj < 16; ++jj) asm volatile("" :: "v"(pa[jj]));
                if (j0 + 32 < 128) P11_LOAD(pa, j0 + 32);
#pragma unroll
                for (int jj = 0; jj < 16; ++jj) asm volatile("" :: "v"(pb[jj]));
              } }
#endif
#undef P11_LOAD
#undef P11_COMP
            *(f32x4*)op = x0 + g0 * (f32x4){(float)acc[0][0], (float)acc[0][1], (float)acc[1][0], (float)acc[1][1]};
            *(f32x4*)(op + 4) = x1 + g1 * (f32x4){(float)acc[2][0], (float)acc[2][1], (float)acc[3][0], (float)acc[3][1]};
        }
    }
}

__global__ void __launch_bounds__(512, 2) fwd_kernel(Args args) {
    extern __shared__ __attribute__((aligned(16))) unsigned char lds[];
    Frame F;
    F.lds = lds; F.ws = args.ws; F.tid = threadIdx.x; F.lane = F.tid & 63; F.wave = __builtin_amdgcn_readfirstlane(F.tid >> 6); F.G = gridDim.x; F.bid = blockIdx.x;
    F.x = args.in[0]; F.c = args.in[1]; F.w_ada = args.in[2]; F.b_ada = args.in[3]; F.g1 = args.in[4]; F.g2 = args.in[5]; F.w_in = args.in[6]; F.g_q = args.in[7]; F.g_k = args.in[8];
    F.rel_bias = args.in[9]; F.pool_w = args.in[10]; F.pool_scale = args.in[11]; F.w_ab = args.in[12]; F.w_pb = args.in[13]; F.w_out = args.in[14]; F.w_pq = args.in[15];
    F.peer_keys = args.in[16]; F.peer_u = args.in[17]; F.peer_v = args.in[18]; F.out = args.out;
    LAS unsigned char* ldsl = (LAS unsigned char*)lds;
    volatile LAS unsigned* misc = (volatile LAS unsigned*)(ldsl + MISC_OFF);
    if (F.tid < 4) misc[F.tid] = 0u;
    __syncthreads();
    unsigned* barw = (unsigned*)(args.ws + WS_CTL) + (size_t)args.li * XCD_BAR_WORDS;
    XcdBarrier bar; bar.bar = barw; bar.x = 0; bar.st = misc;
    const int lo = args.ph_lo, hi = args.ph_hi;
    if (hi - lo > 1) bar = xcd_barrier_post(barw, misc);
#define IN(k) (lo <= (k) && (k) < hi)
#define SEAM(k) do { if (IN(k) && IN((k) + 1)) xcd_barrier(bar, F.wave); } while (0)
    bf16_t* R0 = (bf16_t*)(F.ws + WS_R0);

#define PH2_BODY { \
        { pg8::Gemm g{(const bf16_t*)(F.ws + WS_H1F8), (const bf16_t*)(F.ws + WS_WIN8), MTOK, 5632, DM / 2, DM / 2, 0, nullptr, nullptr, 0, 0}; pg8::StaticOrder S; S.init(MTOK, 5632, F.G, F.bid); \
          EpiInproj<true> E{(bf16_t*)(F.ws + WS_QN), (bf16_t*)(F.ws + WS_KN), (bf16_t*)(F.ws + WS_V), (bf16_t*)(F.ws + WS_IQ), (bf16_t*)(F.ws + WS_IK), (bf16_t*)(F.ws + WS_PL), \
                    (bf16_t*)(F.ws + WS_GA), (bf16_t*)(F.ws + WS_GP), (float*)(F.ws + WS_IW)}; \
          pg8::gemm_phase<EpiInproj<true>, true>(ldsl, g, S, E, F.wave); } \
        { pg8::Gemm g{R0, (const bf16_t*)(F.ws + WS_WIN16), MTOK, 2304, DM, DM, 0, nullptr, nullptr, 0, 0}; pg8::StaticOrder S; S.init(MTOK, 2304, F.G, F.bid); \
          EpiInproj<false> E{(bf16_t*)(F.ws + WS_QN), (bf16_t*)(F.ws + WS_KN), (bf16_t*)(F.ws + WS_V), (bf16_t*)(F.ws + WS_IQ), (bf16_t*)(F.ws + WS_IK), (bf16_t*)(F.ws + WS_PL), \
                    (bf16_t*)(F.ws + WS_GA), (bf16_t*)(F.ws + WS_GP), (float*)(F.ws + WS_IW)}; \
          pg8::gemm_phase<EpiInproj<false>>(ldsl, g, S, E, F.wave); } }
#define PH3_BODY { phase3_pooled(F); phase3_indexer(F); __syncthreads(); }
#define PH4_BODY { \
        phase4_attention(F); \
        __syncthreads(); \
        pg8::Gemm g{(const bf16_t*)(F.ws + WS_POOLED), (const bf16_t*)(F.ws + WS_POOLW), MTOK, PW, 256, 1024, 256, nullptr, nullptr, 0, 0}; pg8::StaticOrder S; S.init(MTOK, PW, F.G, F.bid); \
        EpiBf16Scale E{(bf16_t*)(F.ws + WS_POOL2), 1024, F.pool_scale}; \
        pg8::gemm_phase<EpiBf16Scale>(ldsl, g, S, E, F.wave); }
#define PH5_BODY { \
        pg8::Gemm g{(const bf16_t*)(F.ws + WS_ATTN), (const bf16_t*)(F.ws + WS_WAB), MTOK, DM, 2048, 1024, 0, (const bf16_t*)(F.ws + WS_POOL2), (const bf16_t*)(F.ws + WS_WPB), 16, 1024}; \
        pg8::StaticOrder S; S.init(MTOK, DM, F.G, F.bid); \
        EpiMerge E{(unsigned char*)R0, (const bf16_t*)(F.ws + WS_GA), (const bf16_t*)(F.ws + WS_GP)}; pg8::gemm_phase<EpiMerge>(ldsl, g, S, E, F.wave); }
#define PH6_BODY { \
        pg8::Gemm g{R0, (const bf16_t*)(F.ws + WS_WOUT), MTOK, DM, DM / 2, DM / 2, 0, nullptr, nullptr, 0, 0}; pg8::StaticOrder S; S.init(MTOK, DM, F.G, F.bid); \
        EpiResid E{F.x, F.out, (const float*)(F.ws + WS_MODF) + 4096}; pg8::gemm_phase<EpiResid, true>(ldsl, g, S, E, F.wave); }
#define PH8_BODY { \
        pg8::Gemm g{(const bf16_t*)(F.ws + WS_H2), (const bf16_t*)(F.ws + WS_WPQ), MTOK, DM, DM, DM, 0, nullptr, nullptr, 0, 0}; pg8::StaticOrder S; S.init(MTOK, DM, F.G, F.bid); \
        EpiBf16Scale E{R0, 2048, nullptr}; pg8::gemm_phase<EpiBf16Scale>(ldsl, g, S, E, F.wave); }
#define PH9_BODY { \
        pg8::Gemm g{R0, (const bf16_t*)(F.ws + WS_KEYSBD), MTOK, DM, 256, DM, 256, nullptr, nullptr, 0, 0}; pg8::StaticOrder S; S.init(MTOK, DM, F.G, F.bid); \
        EpiBf16Scale E{(bf16_t*)(F.ws + WS_SUB), 2048, nullptr}; pg8::gemm_phase<EpiBf16Scale>(ldsl, g, S, E, F.wave); }
#define REP(k) if constexpr (((PROBE_REP) >> (k)) & 1)

    if (IN(0)) { phase0_prep(F); REP(0) { __syncthreads(); phase0_prep(F); } }
    SEAM(0);
    if (IN(1)) { phase_modnorm<true>(F, F.x, F.g1, 0, 2048, R0, F.ws + WS_H1F8); REP(1) { phase_modnorm<true>(F, F.x, F.g1, 0, 2048, R0, F.ws + WS_H1F8); } }
    SEAM(1);
    if (IN(2)) { PH2_BODY REP(2) PH2_BODY }
    SEAM(2);
    if (IN(3)) { phase3_qknorm(F); PH3_BODY REP(3) PH3_BODY }
    SEAM(3);
    if (IN(4)) { PH4_BODY REP(4) PH4_BODY }
    SEAM(4);
    if (IN(5)) { PH5_BODY REP(5) PH5_BODY }
    SEAM(5);
    if (IN(6)) { PH6_BODY REP(6) PH6_BODY }
    SEAM(6);
    if (IN(7)) { phase_modnorm<false>(F, F.out, F.g2, 6144, 8192, (bf16_t*)(F.ws + WS_H2)); REP(7) { phase_modnorm<false>(F, F.out, F.g2, 6144, 8192, (bf16_t*)(F.ws + WS_H2)); } }
    SEAM(7);
    if (IN(8)) { PH8_BODY REP(8) PH8_BODY }
    SEAM(8);
    if (IN(9)) { PH9_BODY REP(9) PH9_BODY }
    SEAM(9);
    if (IN(10)) { phase10_peer(F); REP(10) phase10_peer(F); }
    SEAM(10);
    if (IN(11)) { REP(11) { phase11_peer_v(F, (float*)(F.ws + WS_SUB)); } phase11_peer_v(F, F.out); }
#undef IN
#undef SEAM
}

extern "C" void kernel_launch(void* const* d_in, const int* in_sizes, int n_in, void* d_out, int out_size, void* d_ws, size_t ws_size, hipStream_t stream) {
    static int grid = 0;
    if (grid == 0) {
        if (n_in != 19 || out_size != MTOK * DM || ws_size < WS_END) { fprintf(stderr, "kernel_launch: unexpected shapes (n_in %d out %d ws %zu)\n", n_in, out_size, ws_size); grid = -1; return; }
        int dev = 0, cus = 0, per_cu = 0;
        if (hipGetDevice(&dev) != hipSuccess || hipDeviceGetAttribute(&cus, hipDeviceAttributeMultiprocessorCount, dev) != hipSuccess) { grid = -1; return; }
        if (hipFuncSetAttribute((const void*)fwd_kernel, hipFuncAttributeMaxDynamicSharedMemorySize, LDS_BYTES) != hipSuccess) { fprintf(stderr, "kernel_launch: hipFuncSetAttribute failed\n"); grid = -1; return; }
        if (hipOccupancyMaxActiveBlocksPerMultiprocessor(&per_cu, (const void*)fwd_kernel, 512, LDS_BYTES) != hipSuccess || per_cu < 1) { fprintf(stderr, "kernel_launch: occupancy query says %d\n", per_cu); }
        (void)hipGetLastError();
        grid = cus;
    }
    if (grid < 0) return;
    (void)in_sizes;
    if (hipMemsetAsync((char*)d_ws + WS_CTL, 0, CTL_ZERO_BYTES, stream) != hipSuccess) return;
    Args a{};
    for (int i = 0; i < 19; ++i) a.in[i] = (const float*)d_in[i];
    a.out = (float*)d_out; a.ws = (unsigned char*)d_ws;
#if MK_PER_PHASE
    for (int p = 0; p < NPHASE; ++p) { a.ph_lo = p; a.ph_hi = p + 1; a.li = p; hipLaunchKernelGGL(fwd_kernel, dim3(grid), dim3(512), LDS_BYTES, stream, a); }
#else
    a.ph_lo = 0; a.ph_hi = NPHASE; a.li = 0;
    hipLaunchKernelGGL(fwd_kernel, dim3(grid), dim3(512), LDS_BYTES, stream, a);
#endif
}
```

```cpp
#include <hip/hip_runtime.h>
#include <cstdio>
#include <cstdint>

#ifndef MK_PER_PHASE
#define MK_PER_PHASE 0
#endif

#ifndef PROBE_REP
#define PROBE_REP 0
#endif
#ifndef PROBE_IDX
#define PROBE_IDX 0
#endif
#ifndef PROBE_P11X
#define PROBE_P11X 0
#endif
#define LAS __attribute__((address_space(3)))
typedef unsigned short bf16_t;
typedef short bf16x8 __attribute__((ext_vector_type(8)));
typedef float f32x4 __attribute__((ext_vector_type(4)));
typedef float f32x2 __attribute__((ext_vector_type(2)));
typedef int v2i __attribute__((ext_vector_type(2)));
typedef unsigned u32x4 __attribute__((ext_vector_type(4)));
typedef unsigned u32x2 __attribute__((ext_vector_type(2)));
typedef unsigned u32x6 __attribute__((ext_vector_type(6)));
typedef unsigned u32x16 __attribute__((ext_vector_type(16)));
typedef __bf16 bf16x32 __attribute__((ext_vector_type(32)));

constexpr int BATCH = 8, SEQ = 4096, DM = 2048, MTOK = BATCH * SEQ;
constexpr int NHEAD = 8, HDIM = 128, AW = 1024, KVW = 256, IHEADS = 16, IDIM = 64, KSEL = 256;
constexpr int PW = 1024, PHEADS = 8, NEXP = 16384;
constexpr int INW = 7760;
constexpr float EPS = 1e-6f;
constexpr int NPHASE = 12;

constexpr size_t MiB = 1u << 20;
constexpr size_t WS_CTL = 0, CTL_ZERO_BYTES = 256 * 1024;
constexpr size_t WS_MODP = 2 * MiB;
constexpr size_t WS_MODF = 4 * MiB;
constexpr size_t WS_POOLW = 5 * MiB;
constexpr size_t WS_KEYSBD = 6 * MiB;
constexpr size_t WS_WIN16 = 8 * MiB;
constexpr size_t WS_WIN8 = 20 * MiB;
constexpr size_t WS_WAB = 40 * MiB, WS_WPB = 44 * MiB, WS_WOUT = 48 * MiB, WS_WPQ = 56 * MiB;
constexpr size_t WS_PU = 64 * MiB, WS_PV = 128 * MiB;
constexpr size_t WS_R0 = 192 * MiB;
constexpr size_t WS_GA = 320 * MiB, WS_GP = 448 * MiB;
constexpr size_t WS_SUB = 320 * MiB;
constexpr size_t WS_QN = 576 * MiB;
constexpr size_t WS_IQ = 640 * MiB;
constexpr size_t WS_PL = 704 * MiB;
constexpr size_t WS_KN = 768 * MiB, WS_V = 784 * MiB;
constexpr size_t WS_IK = 800 * MiB;
constexpr size_t WS_IW = 804 * MiB;
constexpr size_t WS_SEL = 806 * MiB;
constexpr size_t WS_POOLED = 822 * MiB;
constexpr size_t WS_H2 = 886 * MiB;
constexpr size_t WS_END = 1014 * MiB;
constexpr size_t WS_H1F8 = WS_H2 + 64 * MiB;
constexpr size_t WS_Q8 = WS_H2, WS_K8 = WS_H2 + 32 * MiB, WS_V8 = WS_H2 + 40 * MiB;
constexpr size_t WS_ATTN = WS_IQ, WS_POOL2 = WS_PL, WS_PAIRS = WS_QN, WS_WLS = WS_QN + 32 * MiB;

constexpr int LDS_BYTES = 160 * 1024;
constexpr int MISC_OFF = 159 * 1024;

__device__ __forceinline__ unsigned cvt_pk_bf16(float lo, float hi) { unsigned r; asm volatile("v_cvt_pk_bf16_f32 %0, %1, %2" : "=v"(r) : "v"(lo), "v"(hi)); return r; }
__device__ __forceinline__ float bf_lo(unsigned w) { return __uint_as_float(w << 16); }
__device__ __forceinline__ float bf_hi(unsigned w) { return __uint_as_float(w & 0xffff0000u); }
template <int CTRL> __device__ __forceinline__ float dpp_f(float x) { return __int_as_float(__builtin_amdgcn_update_dpp(0, __float_as_int(x), CTRL, 0xF, 0xF, true)); }
#define DPP_XOR1 0xB1
#define DPP_XOR2 0x4E
#define DPP_HMIRROR 0x141
#define DPP_MIRROR 0x140
#define DPP_ROR8 0x128
__device__ __forceinline__ float xor16_sum(float x) { const auto r = __builtin_amdgcn_permlane16_swap(__float_as_uint(x), __float_as_uint(x), false, false); return __uint_as_float(r[0]) + __uint_as_float(r[1]); }
__device__ __forceinline__ float xor32_sum(float x) { const auto r = __builtin_amdgcn_permlane32_swap(__float_as_uint(x), __float_as_uint(x), false, false); return __uint_as_float(r[0]) + __uint_as_float(r[1]); }
__device__ __forceinline__ float xor16_max(float x) { const auto r = __builtin_amdgcn_permlane16_swap(__float_as_uint(x), __float_as_uint(x), false, false); return fmaxf(__uint_as_float(r[0]), __uint_as_float(r[1])); }
__device__ __forceinline__ float swap32_pair(float a, float b) { const auto r = __builtin_amdgcn_permlane32_swap(__float_as_uint(a), __float_as_uint(b), false, false); return __uint_as_float(r[0]) + __uint_as_float(r[1]); }
__device__ __forceinline__ float swap16_pair(float a, float b) { const auto r = __builtin_amdgcn_permlane16_swap(__float_as_uint(a), __float_as_uint(b), false, false); return __uint_as_float(r[0]) + __uint_as_float(r[1]); }
__device__ __forceinline__ float row_sum16(float v) { v += dpp_f<DPP_XOR1>(v); v += dpp_f<DPP_XOR2>(v); v += dpp_f<DPP_HMIRROR>(v); v += dpp_f<DPP_MIRROR>(v); return v; }
__device__ __forceinline__ float row_max16(float v) { v = fmaxf(v, dpp_f<DPP_XOR1>(v)); v = fmaxf(v, dpp_f<DPP_XOR2>(v)); v = fmaxf(v, dpp_f<DPP_HMIRROR>(v)); v = fmaxf(v, dpp_f<DPP_MIRROR>(v)); return v; }
__device__ __forceinline__ float wave_sum(float v) { return xor32_sum(xor16_sum(row_sum16(v))); }
__device__ __forceinline__ float sigmoidf_(float x) { return __builtin_amdgcn_rcpf(1.0f + __expf(-x)); }
__device__ __forceinline__ float dot8(u32x4 w, const float* h) {
    return bf_lo(w.x) * h[0] + bf_hi(w.x) * h[1] + bf_lo(w.y) * h[2] + bf_hi(w.y) * h[3] + bf_lo(w.z) * h[4] + bf_hi(w.z) * h[5] + bf_lo(w.w) * h[6] + bf_hi(w.w) * h[7];
}

__device__ __forceinline__ int lane_now() { int l; asm volatile("v_mbcnt_lo_u32_b32 %0, -1, 0\n\tv_mbcnt_hi_u32_b32 %0, -1, %0" : "=v"(l)); return l; }

#define XB_TMO      128
#define XB_XCNT(j)  (256  + 64 * (j))
#define XB_XSUB(j)  (1280 + 64 * (j))
#define XB_XGEN(j)  (2304 + 64 * (j))
#define XB_TOP      3328
#define XB_TOPGEN   3392
#define XCD_BAR_WORDS 3456
#define XB_SPIN_CAP (1u << 18)

__device__ __forceinline__ unsigned xb_ld(unsigned* p)              { return __hip_atomic_load(p, __ATOMIC_RELAXED, __HIP_MEMORY_SCOPE_AGENT); }
__device__ __forceinline__ unsigned xb_add(unsigned* p, unsigned v) { return __hip_atomic_fetch_add(p, v, __ATOMIC_RELAXED, __HIP_MEMORY_SCOPE_AGENT); }
__device__ __forceinline__ unsigned xb_xcc_id() { return (unsigned)__builtin_amdgcn_s_getreg((3 << 11) | 20) & 0xFu; }
#define XB_SPIN(cond, bar) do { unsigned _sp = 0; while (cond) { __builtin_amdgcn_s_sleep(1); \
    if ((++_sp & 255u) == 0u) { if (xb_ld(&(bar)[XB_TMO])) break; if (_sp > XB_SPIN_CAP) { atomicAdd(&(bar)[XB_TMO], 1u); break; } } } } while (0)

struct XcdBarrier { unsigned* bar; unsigned x; volatile LAS unsigned* st; };

__device__ __forceinline__ XcdBarrier xcd_barrier_post(unsigned* bar, volatile LAS unsigned* st) {
    XcdBarrier b; b.bar = bar; b.x = xb_xcc_id(); b.st = st;
    if (threadIdx.x == 0) (void)xb_add(&bar[XB_XCNT(b.x)], 1u);
    return b;
}
__device__ __forceinline__ void xcd_barrier_complete(unsigned* bar, unsigned x, unsigned& nloc, unsigned& nx) {
    const unsigned G = gridDim.x * gridDim.y * gridDim.z;
    unsigned sum, cnt, mine, sp = 0u;
    for (;;) {
        sum = 0u; cnt = 0u; mine = 0u;
#pragma unroll
        for (unsigned j = 0; j < 16; ++j) { const unsigned c = xb_ld(&bar[XB_XCNT(j)]); sum += c; cnt += (c > 0u) ? 1u : 0u; mine = (j == x) ? c : mine; }
        if (sum == G) break;
        __builtin_amdgcn_s_sleep(1);
        if ((++sp & 255u) == 0u) { if (xb_ld(&bar[XB_TMO])) break; if (sp > XB_SPIN_CAP) { atomicAdd(&bar[XB_TMO], 1u); break; } }
    }
    nloc = mine > 0u ? mine : 1u; nx = cnt > 0u ? cnt : 1u;
}
__device__ __forceinline__ void xcd_barrier(const XcdBarrier& b, int wave) {
    asm volatile("s_waitcnt vmcnt(0)" ::: "memory");
    __syncthreads();
    if (wave == 0 && lane_now() == 0) {
        unsigned* bar = b.bar;
        __builtin_amdgcn_s_waitcnt(0);
        unsigned nloc = b.st[0], nx = b.st[1];
        if (nloc == 0u) { xcd_barrier_complete(bar, b.x, nloc, nx); b.st[0] = nloc; b.st[1] = nx; }
        const unsigned old = xb_add(&bar[XB_XSUB(b.x)], 1u);
        const unsigned gen = old / nloc;
        if (old + 1u == (gen + 1u) * nloc) {
            __builtin_amdgcn_fence(__ATOMIC_RELEASE, "agent");
            asm volatile("s_waitcnt vmcnt(0)" ::: "memory");
            const unsigned og = xb_add(&bar[XB_TOP], 1u);
            const unsigned tg = og / nx;
            if (og + 1u == (tg + 1u) * nx) xb_add(&bar[XB_TOPGEN], 1u);
            else XB_SPIN(xb_ld(&bar[XB_TOPGEN]) == tg, bar);
            __builtin_amdgcn_fence(__ATOMIC_ACQUIRE, "agent");
            xb_add(&bar[XB_XGEN(b.x)], 1u);
            asm volatile("s_waitcnt vmcnt(0)" ::: "memory");
        } else {
            XB_SPIN(xb_ld(&bar[XB_XGEN(b.x)]) == gen, bar);
            __builtin_amdgcn_fence(__ATOMIC_ACQUIRE, "agent");
            asm volatile("s_waitcnt vmcnt(0)" ::: "memory");
        }
    }
    __syncthreads();
}

namespace pg8 {
constexpr int BM = 256, BK = 64, HALF = 128, HTB = HALF * BK * 2, STAGE_BYTES = 8 * HTB, NXCD = 8, WGM = 8;
__device__ __forceinline__ int lds_byte(int r, int c) { const int st = (r >> 4) * 2 + (c >> 5), rr = r & 15, cc = c & 31, ob = rr * 64 + cc * 2; return st * 1024 + (ob ^ (((ob >> 9) & 1) << 5)); }
__device__ __forceinline__ void stage_rc(int b, int& R, int& C) { const int st = b / 1024, sb = b % 1024, swz = sb ^ (((sb >> 9) & 1) << 5); R = (st >> 1) * 16 + swz / 64; C = (st & 1) * 32 + (swz % 64) / 2; }
__device__ __forceinline__ int perm32(int rho) { const int n = rho >> 4, i = rho & 15; return 8 * (i >> 2) + 4 * n + (i & 3); }

struct Unit { int pm, pn; };
struct Gemm { const bf16_t* A; const bf16_t* Bt; int M, N, K, lda, a_pn_off; const bf16_t* A2; const bf16_t* Bt2; int ksplit, ldb; };

struct StaticOrder {
    int nM, nN, nwg, G, c;
    __device__ void init(int M, int N, int G_, int c_) { nM = M / BM; nN = N / BM; nwg = nM * nN; G = G_; c = c_; }
    __device__ bool next(int i, Unit& u) const {
        const long L = (long)i * G + c; if (L >= nwg) return false;
        int wgid = (int)L; { const int q = nwg / NXCD, r = nwg % NXCD, xcd = wgid % NXCD, off = wgid / NXCD; wgid = (xcd < r ? xcd * (q + 1) : r * (q + 1) + (xcd - r) * q) + off; }
        const int nig = WGM * nN, gid = wgid / nig, fm = gid * WGM, gsz = (nM - fm) < WGM ? (nM - fm) : WGM;
        u.pm = fm + ((wgid % nig) % gsz); u.pn = (wgid % nig) / gsz; return true;
    }
};

typedef int i32x4 __attribute__((ext_vector_type(4)));
typedef int i32x8 __attribute__((ext_vector_type(8)));
__device__ __forceinline__ bf16x8 lo8(i32x8 v) { return __builtin_bit_cast(bf16x8, (i32x4){v.s0, v.s1, v.s2, v.s3}); }
__device__ __forceinline__ bf16x8 hi8(i32x8 v) { return __builtin_bit_cast(bf16x8, (i32x4){v.s4, v.s5, v.s6, v.s7}); }
__device__ __forceinline__ i32x8 cat8(bf16x8 a, bf16x8 b) { const i32x4 x = __builtin_bit_cast(i32x4, a), y = __builtin_bit_cast(i32x4, b); return (i32x8){x.x, x.y, x.z, x.w, y.x, y.y, y.z, y.w}; }
template <class Epi, bool F8 = false>
__device__ __forceinline__ void gemm_phase(LAS unsigned char* lds, const Gemm g, const StaticOrder& S, const Epi& E, int wave) {
    const int lane = lane_now(), wid = wave, tid = wid * 64 + lane, wr = wid >> 2, wc = wid & 3, fr = lane & 15, fq = lane >> 4;
    const int K = g.K, nt = K / BK, lda = g.lda, ldb = g.ldb ? g.ldb : g.K, ksplit = g.ksplit;
    unsigned voffA, voffB;
    { int R, C; stage_rc(tid * 16, R, C); const int Rb = Epi::PERM ? ((R & ~31) + perm32(R & 31)) : R;
      voffA = (unsigned)(R * lda + C) * 2u; voffB = (unsigned)(Rb * ldb + C) * 2u; }
    const unsigned stepA = 64u * (unsigned)lda * 2u, stepB = 64u * (unsigned)ldb * 2u;
    const size_t kstep = (size_t)(BK * 2);
    const size_t hsA = (size_t)HALF * lda * 2, hsB = (size_t)HALF * ldb * 2;
    const size_t tsA = 2 * hsA, tsB = 2 * hsB;
    const unsigned ldsw = (unsigned)wid * 1024u, ldsbase = (unsigned)(unsigned long long)lds;
    const int aoff = lds_byte(wr * 64 + fr, fq * 8), boff = lds_byte(wc * 32 + fr, fq * 8);
#define PG8_SA(b, h) (((b) * 2 + (h)) * HTB)
#define PG8_SB(b, h) ((4 + (b) * 2 + (h)) * HTB)
#define PG8_STAGE(bufoff, gbase, voff) do { _Pragma("unroll") for (int _i = 0; _i < 2; ++_i) { \
        const char* sb_ = (const char*)(gbase) + (size_t)_i * PG8_STEP_##voff; const unsigned m0_ = ldsbase + (unsigned)(bufoff) + ldsw + (unsigned)_i * 8192u; \
        asm volatile("s_mov_b32 m0, %2\n\ts_nop 0\n\tglobal_load_lds_dwordx4 %0, %1" :: "v"(voff), "s"(sb_), "s"(m0_) : "memory"); } } while (0)
#define PG8_STEP_voffA stepA
#define PG8_STEP_voffB stepB
#define PG8_LDA(dst, b, h) do { _Pragma("unroll") for (int m = 0; m < 4; ++m) dst[m] = cat8(*(const LAS bf16x8*)(lds + PG8_SA(b, h) + aoff + m * 2048), *(const LAS bf16x8*)(lds + PG8_SA(b, h) + aoff + m * 2048 + 1024)); } while (0)
#define PG8_LDB(dst, b, h) do { _Pragma("unroll") for (int n = 0; n < 2; ++n) dst[n] = cat8(*(const LAS bf16x8*)(lds + PG8_SB(b, h) + boff + n * 2048), *(const LAS bf16x8*)(lds + PG8_SB(b, h) + boff + n * 2048 + 1024)); } while (0)
#define PG8_MMA(ai, bj, At, Bt) do { __builtin_amdgcn_s_setprio(1); _Pragma("unroll") for (int m = 0; m < 4; ++m) _Pragma("unroll") for (int n = 0; n < 2; ++n) { \
        if constexpr (F8) acc[ai][bj][m][n] = __builtin_amdgcn_mfma_scale_f32_16x16x128_f8f6f4(Bt[n], At[m], acc[ai][bj][m][n], 0, 0, 0, 0x7D7D7D7D  , 0, 0x7D7D7D7D); \
        else { acc[ai][bj][m][n] = __builtin_amdgcn_mfma_f32_16x16x32_bf16(lo8(Bt[n]), lo8(At[m]), acc[ai][bj][m][n], 0, 0, 0); \
               acc[ai][bj][m][n] = __builtin_amdgcn_mfma_f32_16x16x32_bf16(hi8(Bt[n]), hi8(At[m]), acc[ai][bj][m][n], 0, 0, 0); } } \
        __builtin_amdgcn_s_setprio(0); } while (0)
#define PG8_WAIT_V(n) asm volatile("s_waitcnt vmcnt(" #n ")" ::: "memory")
#define PG8_WAIT_L(n) asm volatile("s_waitcnt lgkmcnt(" #n ")" ::: "memory")
#define PG8_BAR __builtin_amdgcn_s_barrier()
#define PG8_SCHED __builtin_amdgcn_sched_barrier(0)
    Unit cur, nxt; int ui = 0;
    if (!S.next(0, cur)) return;
    f32x4 acc[2][2][4][2];
#pragma unroll
    for (int a = 0; a < 2; ++a)
#pragma unroll
        for (int b = 0; b < 2; ++b)
#pragma unroll
            for (int m = 0; m < 4; ++m)
#pragma unroll
                for (int n = 0; n < 2; ++n) acc[a][b][m][n] = (f32x4){0.f, 0.f, 0.f, 0.f};
    i32x8 At[4], B0[2], B1[2];
    const char* cA = (const char*)g.A + (size_t)cur.pm * tsA + (size_t)cur.pn * g.a_pn_off * 2; const char* cB = (const char*)g.Bt + (size_t)cur.pn * tsB;
    PG8_STAGE(PG8_SB(0, 0), cB, voffB); PG8_STAGE(PG8_SB(0, 1), cB + hsB, voffB); PG8_STAGE(PG8_SA(0, 0), cA, voffA); PG8_STAGE(PG8_SA(0, 1), cA + hsA, voffA);
    if (wr == 1) PG8_BAR;
    PG8_WAIT_V(2); PG8_BAR;
    PG8_STAGE(PG8_SB(1, 0), cB + kstep, voffB); PG8_STAGE(PG8_SA(1, 0), cA + kstep, voffA); PG8_STAGE(PG8_SB(1, 1), cB + hsB + kstep, voffB);
    PG8_WAIT_V(6); PG8_BAR;
    for (;;) {
        const bool has_next = S.next(ui + 1, nxt);
        const char* nA = has_next ? (const char*)g.A + (size_t)nxt.pm * tsA + (size_t)nxt.pn * g.a_pn_off * 2 : cA; const char* nB = has_next ? (const char*)g.Bt + (size_t)nxt.pn * tsB : cB;
        const char* cA2 = (const char*)g.A2 + (size_t)cur.pm * tsA; const char* cB2 = (const char*)g.Bt2 + (size_t)cur.pn * tsB;
#pragma clang loop unroll(disable)
        for (int t = 0; t < nt; t += 2) {
            const bool last = (t == nt - 2);
            const bool s1 = ksplit && (t >= ksplit), s2 = ksplit && (t + 2 >= ksplit);
            const char* a1 = (s1 ? cA2 + (size_t)(t - ksplit + 1) * kstep : cA + (size_t)(t + 1) * kstep);
            const char* a2 = last ? nA : (s2 ? cA2 + (size_t)(t + 2 - ksplit) * kstep : cA + (size_t)(t + 2) * kstep);
            const char* b2 = last ? nB : (s2 ? cB2 + (size_t)(t + 2 - ksplit) * kstep : cB + (size_t)(t + 2) * kstep);
            const char* a3 = a2 + kstep; const char* b3 = b2 + kstep;
            PG8_LDB(B0, 0, 0); PG8_LDB(B1, 0, 1); PG8_SCHED; PG8_LDA(At, 0, 0); PG8_STAGE(PG8_SA(1, 1), a1 + hsA, voffA);
            PG8_WAIT_V(8); PG8_WAIT_L(0); PG8_BAR; PG8_MMA(0, 0, At, B0); PG8_MMA(0, 1, At, B1); PG8_BAR; PG8_SCHED;
            PG8_LDA(At, 0, 1); PG8_STAGE(PG8_SB(0, 0), b2, voffB); PG8_STAGE(PG8_SB(0, 1), b2 + hsB, voffB); PG8_STAGE(PG8_SA(0, 0), a2, voffA);
            PG8_WAIT_V(8); PG8_WAIT_L(0); PG8_BAR; PG8_MMA(1, 0, At, B0); PG8_MMA(1, 1, At, B1); PG8_BAR; PG8_SCHED;
            PG8_LDB(B0, 1, 0); PG8_LDB(B1, 1, 1); PG8_SCHED; PG8_LDA(At, 1, 0); PG8_STAGE(PG8_SA(0, 1), a2 + hsA, voffA);
            PG8_WAIT_V(8); PG8_WAIT_L(0); PG8_BAR; PG8_MMA(0, 0, At, B0); PG8_MMA(0, 1, At, B1); PG8_BAR; PG8_SCHED;
            PG8_LDA(At, 1, 1); PG8_STAGE(PG8_SB(1, 0), b3, voffB); PG8_STAGE(PG8_SB(1, 1), b3 + hsB, voffB); PG8_STAGE(PG8_SA(1, 0), a3, voffA);
            PG8_WAIT_V(8); PG8_WAIT_L(0); PG8_BAR; PG8_MMA(1, 0, At, B0); PG8_MMA(1, 1, At, B1); PG8_BAR; PG8_SCHED;
            if constexpr (Epi::MID) { if (t + 2 == ksplit) E.mid(acc, cur, wr, wc, fr, fq); }
        }
        if (wr == 0) PG8_BAR;
        { const int l2 = lane_now(); E(acc, cur, wr, wc, l2 & 15, l2 >> 4); }
        if (!has_next) break;
#pragma unroll
        for (int a = 0; a < 2; ++a)
#pragma unroll
            for (int b = 0; b < 2; ++b)
#pragma unroll
                for (int m = 0; m < 4; ++m)
#pragma unroll
                    for (int n = 0; n < 2; ++n) acc[a][b][m][n] = (f32x4){0.f, 0.f, 0.f, 0.f};
        cur = nxt; cA = nA; cB = nB; ++ui;
        if (wr == 1) PG8_BAR;
    }
    PG8_WAIT_V(0);
    PG8_BAR;
#undef PG8_SA
#undef PG8_SB
#undef PG8_STAGE
#undef PG8_STEP_voffA
#undef PG8_STEP_voffB
#undef PG8_LDA
#undef PG8_LDB
#undef PG8_MMA
#undef PG8_WAIT_V
#undef PG8_WAIT_L
#undef PG8_BAR
#undef PG8_SCHED
}
}
using pg8::Unit;

typedef f32x4 AccT[2][2][4][2];
__device__ __forceinline__ u32x4 pack8(f32x4 a, f32x4 b) { u32x4 w; w.x = cvt_pk_bf16(a[0], a[1]); w.y = cvt_pk_bf16(a[2], a[3]); w.z = cvt_pk_bf16(b[0], b[1]); w.w = cvt_pk_bf16(b[2], b[3]); return w; }
__device__ __forceinline__ u32x2 pack8_fp8(f32x4 a, f32x4 b) {
    int w0 = __builtin_amdgcn_cvt_pk_fp8_f32(a[0], a[1], 0, false); w0 = __builtin_amdgcn_cvt_pk_fp8_f32(a[2], a[3], w0, true);
    int w1 = __builtin_amdgcn_cvt_pk_fp8_f32(b[0], b[1], 0, false); w1 = __builtin_amdgcn_cvt_pk_fp8_f32(b[2], b[3], w1, true);
    return (u32x2){(unsigned)w0, (unsigned)w1};
}
__device__ __forceinline__ void unpack8(u32x4 w, f32x4& a, f32x4& b) { a = (f32x4){bf_lo(w.x), bf_hi(w.x), bf_lo(w.y), bf_hi(w.y)}; b = (f32x4){bf_lo(w.z), bf_hi(w.z), bf_lo(w.w), bf_hi(w.w)}; }

template <bool SET8> struct EpiInproj {
    static constexpr bool PERM = true, MID = false;
    bf16_t *q, *k, *v, *iq, *ik, *pl, *ga, *gp; float* iw;
    __device__ __forceinline__ void operator()(const AccT& acc, const Unit& u, int wr, int wc, int fr, int fq) const {
        const int pn = u.pn, row0 = u.pm * 256 + wr * 64 + fr;
        if (!SET8 && pn == 4) {
            if (wc < 2) {
#pragma unroll
                for (int ai = 0; ai < 2; ++ai)
#pragma unroll
                    for (int m = 0; m < 4; ++m) { const size_t row = (size_t)(row0 + ai * 128 + m * 16);
                        *(u32x4*)(ik + row * 64 + wc * 32 + 8 * fq) = pack8(acc[ai][0][m][0], acc[ai][0][m][1]); }
            } else if (wc == 2) {
                if (fq < 2) {
#pragma unroll
                    for (int ai = 0; ai < 2; ++ai)
#pragma unroll
                        for (int m = 0; m < 4; ++m) { const size_t row = (size_t)(row0 + ai * 128 + m * 16);
                            *(f32x4*)(iw + row * 16 + 8 * fq) = acc[ai][0][m][0]; *(f32x4*)(iw + row * 16 + 8 * fq + 4) = acc[ai][0][m][1]; }
                }
            }
            return;
        }
        bf16_t* dst; int ld, tc; bool sg = false;
        if (SET8) {
            if (pn < 4) { dst = q; ld = 1024; tc = pn * 256; }
            else if (pn == 4) { dst = k; ld = 256; tc = 0; }
            else if (pn == 5) { dst = v; ld = 256; tc = 0; }
            else if (pn < 14) { dst = ga; ld = 2048; tc = (pn - 6) * 256; sg = true; }
            else { dst = gp; ld = 2048; tc = (pn - 14) * 256; sg = true; }
        } else {
            if (pn < 4) { dst = iq; ld = 1024; tc = pn * 256; }
            else { dst = pl; ld = 1024; tc = (pn - 5) * 256; }
        }
        const int col0 = tc + wc * 32 + 8 * fq;
#pragma unroll
        for (int ai = 0; ai < 2; ++ai)
#pragma unroll
            for (int m = 0; m < 4; ++m) { bf16_t* rowp = dst + (size_t)(row0 + ai * 128 + m * 16) * ld + col0;
#pragma unroll
                for (int bj = 0; bj < 2; ++bj) { f32x4 v0 = acc[ai][bj][m][0], v1 = acc[ai][bj][m][1];
                    if (sg) {
#pragma unroll
                        for (int j = 0; j < 4; ++j) { v0[j] = sigmoidf_(v0[j]); v1[j] = sigmoidf_(v1[j]); } }
                    *(u32x4*)(rowp + bj * 128) = pack8(v0, v1); } }
    }
};
struct EpiBf16Scale {
    static constexpr bool PERM = true, MID = false;
    bf16_t* O; int ldc; const float* cs;
    __device__ __forceinline__ void operator()(const AccT& acc, const Unit& u, int wr, int wc, int fr, int fq) const {
        const int row0 = u.pm * 256 + wr * 64 + fr, col0 = u.pn * 256 + wc * 32 + 8 * fq;
        f32x4 s[2][2];
#pragma unroll
        for (int bj = 0; bj < 2; ++bj)
#pragma unroll
            for (int n = 0; n < 2; ++n) s[bj][n] = cs ? *(const f32x4*)(cs + col0 + bj * 128 + 4 * n) : (f32x4){1.f, 1.f, 1.f, 1.f};
#pragma unroll
        for (int ai = 0; ai < 2; ++ai)
#pragma unroll
            for (int m = 0; m < 4; ++m) { bf16_t* rowp = O + (size_t)(row0 + ai * 128 + m * 16) * ldc + col0;
#pragma unroll
                for (int bj = 0; bj < 2; ++bj) *(u32x4*)(rowp + bj * 128) = pack8(acc[ai][bj][m][0] * s[bj][0], acc[ai][bj][m][1] * s[bj][1]); }
    }
};
template <bool ADD> struct EpiGate {
    static constexpr bool PERM = true, MID = false;
    bf16_t* O; const bf16_t* gate;
    __device__ __forceinline__ void operator()(const AccT& acc, const Unit& u, int wr, int wc, int fr, int fq) const {
        const int row0 = u.pm * 256 + wr * 64 + fr, col0 = u.pn * 256 + wc * 32 + 8 * fq;
#pragma unroll
        for (int ai = 0; ai < 2; ++ai)
#pragma unroll
            for (int m = 0; m < 4; ++m) { const size_t off = (size_t)(row0 + ai * 128 + m * 16) * 2048 + col0;
#pragma unroll
                for (int bj = 0; bj < 2; ++bj) { f32x4 g0, g1; unpack8(*(const u32x4*)(gate + off + bj * 128), g0, g1);
                    f32x4 r0 = g0 * acc[ai][bj][m][0], r1 = g1 * acc[ai][bj][m][1];
                    if (ADD) { f32x4 o0, o1; unpack8(*(const u32x4*)(O + off + bj * 128), o0, o1); r0 += o0; r1 += o1; }
                    *(u32x4*)(O + off + bj * 128) = pack8(r0, r1); } }
    }
};
struct EpiMerge {
    static constexpr bool PERM = true, MID = true;
    unsigned char* O; const bf16_t* ga; const bf16_t* gp;
    __device__ __forceinline__ void mid(AccT& acc, const Unit& u, int wr, int wc, int fr, int fq) const {
        const auto ra = __builtin_amdgcn_make_buffer_rsrc((void*)ga, 0, 0x7FFFFFFF, 0x00020000), rp = __builtin_amdgcn_make_buffer_rsrc((void*)gp, 0, 0x7FFFFFFF, 0x00020000);
        const int voff = ((wr * 64 + fr) * 2048 + wc * 32 + 8 * fq) * 2;
        const int sbase = (u.pm * 256 * 2048 + u.pn * 256) * 2;
#pragma unroll
        for (int ai = 0; ai < 2; ++ai)
#pragma unroll
            for (int m = 0; m < 4; ++m)
#pragma unroll
                for (int bj = 0; bj < 2; ++bj) { const int so = sbase + ((ai * 128 + m * 16) * 2048 + bj * 128) * 2;
                    const u32x4 wa = __builtin_bit_cast(u32x4, __builtin_amdgcn_raw_buffer_load_b128(ra, voff, so, 0)), wp = __builtin_bit_cast(u32x4, __builtin_amdgcn_raw_buffer_load_b128(rp, voff, so, 0));
                    f32x4 a0, a1, p0, p1; unpack8(wa, a0, a1); unpack8(wp, p0, p1);
#pragma unroll
                    for (int j = 0; j < 4; ++j) { acc[ai][bj][m][0][j] *= a0[j] * __builtin_amdgcn_rcpf(p0[j]); acc[ai][bj][m][1][j] *= a1[j] * __builtin_amdgcn_rcpf(p1[j]); }
                    asm volatile("" : "+v"(acc[ai][bj][m][0]), "+v"(acc[ai][bj][m][1]) :: "memory"); }
    }
    __device__ __forceinline__ void operator()(const AccT& acc, const Unit& u, int wr, int wc, int fr, int fq) const {
        const int row0 = u.pm * 256 + wr * 64 + fr, col0 = u.pn * 256 + wc * 32 + 8 * fq;
#pragma unroll
        for (int ai = 0; ai < 2; ++ai)
#pragma unroll
            for (int m = 0; m < 4; ++m) { const size_t off = (size_t)(row0 + ai * 128 + m * 16) * 2048 + col0;
#pragma unroll
                for (int bj = 0; bj < 2; ++bj) { f32x4 p0, p1; unpack8(*(const u32x4*)(gp + off + bj * 128), p0, p1);
                    *(u32x2*)(O + off + bj * 128) = pack8_fp8(p0 * acc[ai][bj][m][0], p1 * acc[ai][bj][m][1]); } }
    }
};
struct EpiResid {
    static constexpr bool PERM = false, MID = false;
    const float* x; float* out; const float* gt;
    __device__ __forceinline__ void operator()(const AccT& acc, const Unit& u, int wr, int wc, int fr, int fq) const {
        const int row0 = u.pm * 256 + wr * 64 + fr, col0 = u.pn * 256 + wc * 32 + 4 * fq;
        const float* gtb = gt + (size_t)(u.pm / 16) * 12288;
        f32x4 g[2][2];
#pragma unroll
        for (int bj = 0; bj < 2; ++bj)
#pragma unroll
            for (int n = 0; n < 2; ++n) g[bj][n] = *(const f32x4*)(gtb + col0 + bj * 128 + n * 16);
#pragma unroll
        for (int ai = 0; ai < 2; ++ai)
#pragma unroll
            for (int m = 0; m < 4; ++m) { const size_t off = (size_t)(row0 + ai * 128 + m * 16) * 2048 + col0;
#pragma unroll
                for (int bj = 0; bj < 2; ++bj)
#pragma unroll
                    for (int n = 0; n < 2; ++n) { const f32x4 xv = *(const f32x4*)(x + off + bj * 128 + n * 16);
                        *(f32x4*)(out + off + bj * 128 + n * 16) = xv + g[bj][n] * acc[ai][bj][m][n]; } }
    }
};
struct EpiF32 {
    static constexpr bool PERM = false, MID = false;
    float* C; int ldc;
    __device__ __forceinline__ void operator()(const AccT& acc, const Unit& u, int wr, int wc, int fr, int fq) const {
        const int row0 = u.pm * 256 + wr * 64 + fr, col0 = u.pn * 256 + wc * 32 + 4 * fq;
#pragma unroll
        for (int ai = 0; ai < 2; ++ai)
#pragma unroll
            for (int m = 0; m < 4; ++m) { float* rowp = C + (size_t)(row0 + ai * 128 + m * 16) * ldc + col0;
#pragma unroll
                for (int bj = 0; bj < 2; ++bj)
#pragma unroll
                    for (int n = 0; n < 2; ++n) *(f32x4*)(rowp + bj * 128 + n * 16) = acc[ai][bj][m][n]; }
    }
};

struct Args { const float* in[19]; float* out; unsigned char* ws; int ph_lo, ph_hi; int li, pad; };
struct Frame {
    unsigned char* lds; unsigned char* ws;
    int tid, lane, wave, G, bid;
    const float *x, *c, *w_ada, *b_ada, *g1, *g2, *w_in, *g_q, *g_k, *rel_bias, *pool_w, *pool_scale, *w_ab, *w_pb, *w_out, *w_pq, *peer_keys, *peer_u, *peer_v;
    float* out;
};

template <bool F8OUT = false, class Fn> __device__ __forceinline__ void transpose_item(const float* W, int K, int N, void* WTv, int ldk, int drow0, int k0, float* scr, int lane, Fn srccol, float mul = 1.0f) {
    const int sc = srccol(drow0 + (lane & 31));
#pragma unroll 8
    for (int i = 0; i < 32; ++i) { const int kk = 2 * i + (lane >> 5); scr[kk * 33 + (lane & 31)] = sc >= 0 ? W[(size_t)(k0 + kk) * N + sc] * mul : 0.f; }
    asm volatile("s_waitcnt lgkmcnt(0)" ::: "memory");
    const int c = lane & 7;
#pragma unroll
    for (int j = 0; j < 4; ++j) { const int n = (lane >> 3) + 8 * j; const float* s = scr + (8 * c) * 33 + n;
        if constexpr (F8OUT) { *(u32x2*)((unsigned char*)WTv + (size_t)(drow0 + n) * ldk + k0 + 8 * c) = pack8_fp8((f32x4){s[0 * 33], s[1 * 33], s[2 * 33], s[3 * 33]}, (f32x4){s[4 * 33], s[5 * 33], s[6 * 33], s[7 * 33]}); }
        else { u32x4 o; o.x = cvt_pk_bf16(s[0 * 33], s[1 * 33]); o.y = cvt_pk_bf16(s[2 * 33], s[3 * 33]); o.z = cvt_pk_bf16(s[4 * 33], s[5 * 33]); o.w = cvt_pk_bf16(s[6 * 33], s[7 * 33]);
            *(u32x4*)((bf16_t*)WTv + (size_t)(drow0 + n) * ldk + k0 + 8 * c) = o; } }
    asm volatile("s_waitcnt lgkmcnt(0)" ::: "memory");
}
__device__ __forceinline__ void phase0_prep(Frame& F) {
    F.lane = lane_now(); F.tid = F.wave * 64 + F.lane;
    const int gw = F.bid * 8 + F.wave, NGW = F.G * 8;
    float* scr = (float*)(F.lds + F.wave * 16384);
    constexpr int I_IN16 = (2304 / 32) * (DM / 64), I_IN8 = (5632 / 32) * (DM / 64);
    constexpr int I_AB = (2048 / 32) * (1024 / 64), I_OUT = (2048 / 32) * (2048 / 64), I_PW = 4 * 8 * 4;
    constexpr int NIT = I_IN16 + I_IN8 + 2 * I_AB + 2 * I_OUT + I_PW;
    auto ident = [](int j) { return j; };
    for (int it = gw; it < NIT; it += NGW) {
        int r = it;
        if (r < I_IN16) { const int nb = r % 72, kb = r / 72;
            transpose_item(F.w_in, DM, INW, F.ws + WS_WIN16, DM, nb * 32, kb * 64, scr, F.lane, [](int j) { return j < 1104 ? j + 1536 : (j < 1280 ? -1 : j + 1360); }); continue; }
        r -= I_IN16;
        if (r < I_IN8) { const int nb = r % 176, kb = r / 176;
            transpose_item<true>(F.w_in, DM, INW, F.ws + WS_WIN8, DM, nb * 32, kb * 64, scr, F.lane, [](int j) { return j < 1536 ? j : j + 2128; }, 16.0f); continue; }
        r -= I_IN8;
        if (r < I_AB) { transpose_item(F.w_ab, 1024, 2048, (bf16_t*)(F.ws + WS_WAB), 1024, (r % 64) * 32, (r / 64) * 64, scr, F.lane, ident); continue; }
        r -= I_AB;
        if (r < I_AB) { transpose_item(F.w_pb, 1024, 2048, (bf16_t*)(F.ws + WS_WPB), 1024, (r % 64) * 32, (r / 64) * 64, scr, F.lane, ident); continue; }
        r -= I_AB;
        if (r < I_OUT) { transpose_item<true>(F.w_out, 2048, 2048, F.ws + WS_WOUT, 2048, (r % 64) * 32, (r / 64) * 64, scr, F.lane, ident, 16.0f); continue; }
        r -= I_OUT;
        if (r < I_OUT) { transpose_item(F.w_pq, 2048, 2048, (bf16_t*)(F.ws + WS_WPQ), 2048, (r % 64) * 32, (r / 64) * 64, scr, F.lane, ident); continue; }
        r -= I_OUT;
        { const int g = r / 32, q = r % 32, nb = q % 8, kb = q / 8;
          transpose_item(F.pool_w + (size_t)g * 65536, 256, 256, (bf16_t*)(F.ws + WS_POOLW) + (size_t)g * 65536, 256, nb * 32, kb * 64, scr, F.lane, ident); }
    }
    {
        bf16_t* kb = (bf16_t*)(F.ws + WS_KEYSBD);
        for (int i = F.bid * 512 + F.tid; i < 2048 * 32; i += F.G * 512) {
            const int row = i / 32, k8 = (i % 32) * 8, p = (row >> 7) & 1;
            u32x4 o = (u32x4){0u, 0u, 0u, 0u};
            if ((k8 >> 7) == p) { const float* s = F.peer_keys + (size_t)row * 128 + (k8 & 127); const f32x4 a = *(const f32x4*)s, b = *(const f32x4*)(s + 4); o = pack8(a, b); }
            *(u32x4*)(kb + (size_t)row * 256 + k8) = o;
        }
    }
    {
        unsigned char* pu = F.ws + WS_PU;
        for (size_t i = (size_t)F.bid * 512 + F.tid; i < (size_t)NEXP * 64; i += (size_t)F.G * 512) {
            const float* src = F.peer_u + i * 32;
            u32x16 pk;
#pragma unroll
            for (int k = 0; k < 8; ++k) { const f32x4 a = *(const f32x4*)(src + k * 4) * 96.0f; pk[2 * k] = cvt_pk_bf16(a[0], a[1]); pk[2 * k + 1] = cvt_pk_bf16(a[2], a[3]); }
            const u32x6 p6 = __builtin_amdgcn_cvt_scalef32_pk32_fp6_bf16(__builtin_bit_cast(bf16x32, pk), 1.0f);
            unsigned char* dst = pu + i * 24;
            *(u32x2*)dst = (u32x2){p6[0], p6[1]}; *(u32x2*)(dst + 8) = (u32x2){p6[2], p6[3]}; *(u32x2*)(dst + 16) = (u32x2){p6[4], p6[5]};
        }
        unsigned char* pv = F.ws + WS_PV;
        for (int it = gw; it < (NEXP / 64) * 128; it += NGW) {
            const int e = (it >> 7) * 64 + F.lane, ch = it & 127;
            u32x4 ov;
#pragma unroll
            for (int k = 0; k < 4; ++k) { const f32x4 c = *(const f32x4*)(F.peer_v + (size_t)e * DM + ch * 16 + k * 4) * 4.0f;
                int wv = __builtin_amdgcn_cvt_pk_fp8_f32(c[0], c[1], 0, false); wv = __builtin_amdgcn_cvt_pk_fp8_f32(c[2], c[3], wv, true); ov[k] = (unsigned)wv; }
            *(u32x2*)(pv + ((size_t)(2 * ch) * NEXP + e) * 8) = (u32x2){ov[0], ov[1]};
            *(u32x2*)(pv + ((size_t)(2 * ch + 1) * NEXP + e) * 8) = (u32x2){ov[2], ov[3]};
        }
    }
    {
        __syncthreads();
        float* cact = (float*)(F.lds + 131072);
        float* red = (float*)F.lds;
        float* mp = (float*)(F.ws + WS_MODP);
        for (int it = F.bid; it < 48 * 4; it += F.G) {
            const int cb = it % 48, ds = it / 48, d0 = ds * 512;
            for (int i = F.tid; i < 8 * 512; i += 512) { const int b = i >> 9, d = i & 511; const float cv = F.c[b * DM + d0 + d]; cact[i] = cv * sigmoidf_(cv); }
            __syncthreads();
            f32x4 a[8];
#pragma unroll
            for (int b = 0; b < 8; ++b) a[b] = (f32x4){0.f, 0.f, 0.f, 0.f};
            const float* wp = F.w_ada + (size_t)(d0 + F.wave * 64) * 12288 + cb * 256 + F.lane * 4;
#pragma unroll 4
            for (int d = 0; d < 64; ++d) { const f32x4 w = *(const f32x4*)(wp + (size_t)d * 12288);
#pragma unroll
                for (int b = 0; b < 8; ++b) a[b] += w * cact[b * 512 + F.wave * 64 + d]; }
#pragma unroll
            for (int b = 0; b < 8; ++b)
#pragma unroll
                for (int j = 0; j < 4; ++j) red[(F.wave * 32 + b * 4 + j) * 64 + F.lane] = a[b][j];
            __syncthreads();
            for (int i = F.tid; i < 2048; i += 512) { const int v = i >> 6, l = i & 63; float s = 0.f;
#pragma unroll
                for (int w = 0; w < 8; ++w) s += red[(w * 32 + v) * 64 + l];
                mp[((size_t)ds * 8 + (v >> 2)) * 12288 + cb * 256 + l * 4 + (v & 3)] = s; }
            __syncthreads();
        }
    }
}

template <bool FIRST> __device__ __forceinline__ void phase_modnorm(Frame& F, const float* xin, const float* gain, int off_sh, int off_sc, bf16_t* dst, unsigned char* dst8 = nullptr) {
    F.lane = lane_now(); F.tid = F.wave * 64 + F.lane;
    const float* mp = (const float*)(F.ws + WS_MODP); float* mf = (float*)(F.ws + WS_MODF);
    if (FIRST) {
        for (int i = F.bid * 512 + F.tid; i < 8 * 12288; i += F.G * 512) {
            float s = F.b_ada[i % 12288];
#pragma unroll
            for (int k = 0; k < 4; ++k) s += mp[(size_t)k * 8 * 12288 + i];
            mf[i] = s; }
    }
    float* cA = (float*)F.lds; float* cB = cA + 2048;
    for (int ch = F.bid; ch < MTOK / 128; ch += F.G) {
        const int b = ch / 32;
        __syncthreads();
        for (int col = F.tid; col < 2048; col += 512) {
            float sc, sh;
            if (FIRST) { sc = F.b_ada[off_sc + col]; sh = F.b_ada[off_sh + col];
#pragma unroll
                for (int k = 0; k < 4; ++k) { sc += mp[((size_t)k * 8 + b) * 12288 + off_sc + col]; sh += mp[((size_t)k * 8 + b) * 12288 + off_sh + col]; } }
            else { sc = mf[b * 12288 + off_sc + col]; sh = mf[b * 12288 + off_sh + col]; }
            cA[col] = gain[col] * (1.f + sc); cB[col] = sh; }
        __syncthreads();
        for (int r = F.wave; r < 128; r += 8) {
            const size_t row = (size_t)ch * 128 + r;
            const float* xr = xin + row * 2048 + F.lane * 8;
            f32x4 v[4][2]; float ss = 0.f;
#pragma unroll
            for (int i = 0; i < 4; ++i) { v[i][0] = *(const f32x4*)(xr + i * 512); v[i][1] = *(const f32x4*)(xr + i * 512 + 4);
#pragma unroll
                for (int j = 0; j < 4; ++j) ss += v[i][0][j] * v[i][0][j] + v[i][1][j] * v[i][1][j]; }
            ss = wave_sum(ss);
            const float rinv = 1.0f / sqrtf(ss * (1.0f / 2048.0f) + EPS);
#pragma unroll
            for (int i = 0; i < 4; ++i) { const int col = i * 512 + F.lane * 8;
                const f32x4 a0 = *(const f32x4*)(cA + col), a1 = *(const f32x4*)(cA + col + 4), b0 = *(const f32x4*)(cB + col), b1 = *(const f32x4*)(cB + col + 4);
                const f32x4 y0 = v[i][0] * rinv * a0 + b0, y1 = v[i][1] * rinv * a1 + b1;
                *(u32x4*)(dst + row * 2048 + col) = pack8(y0, y1);
                if (FIRST) *(u32x2*)(dst8 + row * 2048 + col) = pack8_fp8(y0, y1); }
        }
    }
}

__device__ __forceinline__ void phase3_qknorm(Frame& F) {
    F.lane = lane_now(); F.tid = F.wave * 64 + F.lane;
    const bf16_t* q = (const bf16_t*)(F.ws + WS_QN); const bf16_t* k = (const bf16_t*)(F.ws + WS_KN); const bf16_t* v = (const bf16_t*)(F.ws + WS_V);
    unsigned char* q8 = F.ws + WS_Q8; unsigned char* k8 = F.ws + WS_K8; unsigned char* v8 = F.ws + WS_V8;
    const int gw = F.bid * 8 + F.wave, NGW = F.G * 8;
    for (int row = gw; row < MTOK; row += NGW) {
#pragma unroll
        for (int i = 0; i < 2; ++i) { const int ci = i * 64 + F.lane;
            f32x4 a, b; unpack8(*(const u32x4*)(q + (size_t)row * 1024 + ci * 8), a, b);
            float ss = a[0] * a[0] + a[1] * a[1] + a[2] * a[2] + a[3] * a[3] + b[0] * b[0] + b[1] * b[1] + b[2] * b[2] + b[3] * b[3];
            ss = row_sum16(ss);
            const float rinv = 1.0f / sqrtf(ss * (1.0f / 128.0f) + EPS);
            const float* gp = F.g_q + (ci & 15) * 8; const f32x4 g0 = *(const f32x4*)gp, g1 = *(const f32x4*)(gp + 4);
            *(u32x2*)(q8 + (size_t)row * 1024 + ci * 8) = pack8_fp8(a * rinv * g0, b * rinv * g1); }
        { const int ci = F.lane & 31; const bool isk = F.lane < 32;
            f32x4 a, b; unpack8(*(const u32x4*)((isk ? k : v) + (size_t)row * 256 + ci * 8), a, b);
            float ss = a[0] * a[0] + a[1] * a[1] + a[2] * a[2] + a[3] * a[3] + b[0] * b[0] + b[1] * b[1] + b[2] * b[2] + b[3] * b[3];
            ss = row_sum16(ss);
            const float rinv = isk ? 1.0f / sqrtf(ss * (1.0f / 128.0f) + EPS) : 1.0f;
            const float* gp = F.g_k + (ci & 15) * 8; f32x4 g0 = *(const f32x4*)gp, g1 = *(const f32x4*)(gp + 4);
            if (!isk) { g0 = (f32x4){1.f, 1.f, 1.f, 1.f}; g1 = g0; }
            *(u32x2*)((isk ? k8 : v8) + (size_t)row * 256 + ci * 8) = pack8_fp8(a * rinv * g0, b * rinv * g1); }
    }
}
template <int W> __device__ __forceinline__ void pooled_item(const bf16_t* pl, bf16_t* po, int row, int c8) {
    const int t = row & (SEQ - 1);
    f32x4 s0 = (f32x4){0.f, 0.f, 0.f, 0.f}, s1 = s0, x0 = s0, x1 = s0;
    u32x4 v[W];
#pragma unroll
    for (int j = 0; j < W; ++j) v[j] = *(const u32x4*)(pl + (size_t)(row - (j <= t ? j : 0)) * 1024 + c8);
#pragma unroll
    for (int j = 0; j < W; ++j) { f32x4 a, b; unpack8(v[j], a, b); if (j == 0) { x0 = a; x1 = b; } if (j <= t) { s0 += a; s1 += b; } }
    const float inv = 1.0f / (float)((t + 1 < W) ? t + 1 : W);
    *(u32x4*)(po + (size_t)row * 1024 + c8) = pack8(s0 * inv - x0, s1 * inv - x1);
}
__device__ __forceinline__ void phase3_pooled(Frame& F) {
    F.lane = lane_now(); F.tid = F.wave * 64 + F.lane;
    const bf16_t* pl = (const bf16_t*)(F.ws + WS_PL); bf16_t* po = (bf16_t*)(F.ws + WS_POOLED);
    const int gw = F.bid * 8 + F.wave, NGW = F.G * 8;
    for (int it = gw; it < (MTOK / 2) * 4; it += NGW) {
        const int g = it & 3, row = (it >> 2) * 2 + (F.lane >> 5), c8 = g * 256 + (F.lane & 31) * 8;
        if (g == 0) pooled_item<2>(pl, po, row, c8); else if (g == 1) pooled_item<4>(pl, po, row, c8); else if (g == 2) pooled_item<8>(pl, po, row, c8); else pooled_item<16>(pl, po, row, c8);
    }
}
typedef float f32x16 __attribute__((ext_vector_type(16)));
__device__ __forceinline__ float wrelu_(float wh, float d, float acc) { return __builtin_fmaf(wh, d, __builtin_fmaf(wh, __builtin_fabsf(d), acc)); }
__device__ __forceinline__ int sel_code(float s, float smin, float scale) { const float c = (s - smin) * scale; return (int)fminf(fmaxf(c, 0.f), 65535.f); }
__device__ __forceinline__ void hist_find(const unsigned* hist, int lane, int K, int& bsel, int& above) {
    const u32x4 h = *(const u32x4*)(hist + lane * 4);
    const int S = (int)(h.x + h.y + h.z + h.w);
    int x = S;
    x += __builtin_amdgcn_update_dpp(0, x, 0x101, 0xF, 0xF, true);
    x += __builtin_amdgcn_update_dpp(0, x, 0x102, 0xF, 0xF, true);
    x += __builtin_amdgcn_update_dpp(0, x, 0x104, 0xF, 0xF, true);
    x += __builtin_amdgcn_update_dpp(0, x, 0x108, 0xF, 0xF, true);
    const int t1 = __builtin_amdgcn_readlane(x, 16), t2 = __builtin_amdgcn_readlane(x, 32), t3 = __builtin_amdgcn_readlane(x, 48);
    const int r = lane >> 4;
    x += (r == 0 ? t1 + t2 + t3 : (r == 1 ? t2 + t3 : (r == 2 ? t3 : 0)));
    const int sufn = x - S;
    const bool mine = (x >= K) && (sufn < K);
    int b = 0, ab = 0;
    { int c = sufn;
      if (c + (int)h.w >= K) { b = 3; ab = c; } else { c += (int)h.w;
      if (c + (int)h.z >= K) { b = 2; ab = c; } else { c += (int)h.z;
      if (c + (int)h.y >= K) { b = 1; ab = c; } else { c += (int)h.y; b = 0; ab = c; } } } }
    const unsigned long long m = __ballot(mine);
    const int src = m ? (int)__builtin_ctzll(m) : 0;
    bsel = __builtin_amdgcn_readlane(lane * 4 + b, src); above = __builtin_amdgcn_readlane(ab, src);
}
__device__ __forceinline__ int mask_prefix(unsigned long long m) { return (int)__builtin_amdgcn_mbcnt_hi((unsigned)(m >> 32), __builtin_amdgcn_mbcnt_lo((unsigned)m, 0u)); }
template <class Fn> __device__ __forceinline__ void sel_sweep(const f32x4* rb4, int n4, int lane, int t, Fn fn) {
    f32x4 cur = rb4[lane];
    for (int c4 = 0; c4 < n4 - 1; ++c4) { const f32x4 nxt = rb4[(c4 + 1) * 64 + lane];
#pragma unroll
        for (int k = 0; k < 4; ++k) fn(cur[k], (c4 * 4 + k) * 64 + lane, true);
        cur = nxt; }
    { const int c4 = n4 - 1;
#pragma unroll
      for (int k = 0; k < 4; ++k) { const int idx = (c4 * 4 + k) * 64 + lane; fn(cur[k], idx, idx <= t); } }
}
template <int MODE = 0> __device__ __forceinline__ void indexer_select(Frame& F, int b, int t, const float* rowbuf, unsigned* hist, float* eqv, int* eqi) {
    unsigned short* selrow = (unsigned short*)(F.ws + (MODE ? WS_R0 : WS_SEL)) + (size_t)(b * SEQ + t) * 256;
    int lane = F.lane; asm volatile("" : "+v"(lane));
    const int nch = t / 64 + 1, n4 = (nch + 3) >> 2;
    const f32x4* rb4 = (const f32x4*)rowbuf;
    float mn = __builtin_huge_valf(), mx = -__builtin_huge_valf();
    sel_sweep(rb4, n4, lane, t, [&](float v, int, bool valid) { mn = valid ? fminf(mn, v) : mn; mx = valid ? fmaxf(mx, v) : mx; });
    mx = xor16_max(row_max16(mx)); { const auto r = __builtin_amdgcn_permlane32_swap(__float_as_uint(mx), __float_as_uint(mx), false, false); mx = fmaxf(__uint_as_float(r[0]), __uint_as_float(r[1])); }
    mn = -mn; mn = xor16_max(row_max16(mn)); { const auto r = __builtin_amdgcn_permlane32_swap(__float_as_uint(mn), __float_as_uint(mn), false, false); mn = -fmaxf(__uint_as_float(r[0]), __uint_as_float(r[1])); }
    const float scale = (mx > mn) ? 65535.0f / (mx - mn) : 0.f;
    *(u32x4*)(hist + lane * 4) = (u32x4){0u, 0u, 0u, 0u};
    sel_sweep(rb4, n4, lane, t, [&](float v, int, bool valid) { if (valid) { if (MODE == 2) ((volatile unsigned*)hist)[sel_code(v, mn, scale) >> 8] = 1u; else atomicAdd(&hist[sel_code(v, mn, scale) >> 8], 1u); } });
    int b1, above1; hist_find(hist, lane, KSEL, b1, above1);
    *(u32x4*)(hist + lane * 4) = (u32x4){0u, 0u, 0u, 0u};
    sel_sweep(rb4, n4, lane, t, [&](float v, int, bool valid) { const int code = sel_code(v, mn, scale); if (valid && (code >> 8) == b1) atomicAdd(&hist[code & 255], 1u); });
    int b2, above2; hist_find(hist, lane, KSEL - above1, b2, above2);
    const int T16 = (b1 << 8) | b2, need = KSEL - above1 - above2, ceq = (int)hist[b2];
    const bool all_eq = (ceq == need), collect = !all_eq && (ceq <= 64);
    const int eq_budget = all_eq ? 0x7fffffff : (collect ? 0 : need);
    int pos = 0, eqseen = 0;
    sel_sweep(rb4, n4, lane, t, [&](float v, int idx, bool valid) {
        const int code = sel_code(v, mn, scale);
        const bool gt = valid && code > T16, eq = valid && code == T16;
        const unsigned long long mg = __ballot(gt);
        const unsigned p = (unsigned)(pos + mask_prefix(mg));
        if (gt && p < (unsigned)KSEL) selrow[p] = (unsigned short)idx;
        pos += __popcll(mg);
        const unsigned long long me = __ballot(eq);
        if (me) {
            const int er = eqseen + mask_prefix(me); const bool te = eq && er < eq_budget;
            if (collect && eq) { eqv[er] = v; eqi[er] = idx; }
            eqseen += __popcll(me);
            const unsigned long long mte = __ballot(te);
            const unsigned pe = (unsigned)(pos + mask_prefix(mte));
            if (te && pe < (unsigned)KSEL) selrow[pe] = (unsigned short)idx;
            pos += __popcll(mte);
        }
    });
    if (collect && lane < ceq) {
        const float sv = eqv[lane]; const int idx = eqi[lane]; int rank = 0;
        for (int m = 0; m < ceq; ++m) { const float ov = eqv[m]; const int oi = eqi[m]; rank += (ov > sv || (ov == sv && oi < idx)) ? 1 : 0; }
        if (rank < need) selrow[KSEL - need + rank] = (unsigned short)idx;
    }
}
__device__ __forceinline__ void indexer_tile(Frame& F, int b, int t0) {
    const bf16_t* iq = (const bf16_t*)(F.ws + WS_IQ); const bf16_t* ik = (const bf16_t*)(F.ws + WS_IK); const float* iw = (const float*)(F.ws + WS_IW);
    int lane = F.lane; asm volatile("" : "+v"(lane));
    const int w = F.wave;
    if (t0 < KSEL) {
        const int t = t0 + w; unsigned short* selrow = (unsigned short*)(F.ws + WS_SEL) + (size_t)(b * SEQ + t) * 256;
#pragma unroll
        for (int p = 0; p < 4; ++p) { const int j = p * 64 + lane; selrow[j] = (unsigned short)(j <= t ? j : 0xFFFF); }
        return;
    }
    float* rowbuf = (float*)F.lds;
    unsigned char* stage = F.lds + 131072;
    const int p = w & 3, kh = w >> 2, hi = lane >> 5, r = lane & 31;
    const size_t qrow = (size_t)b * SEQ + t0 + 2 * p + (r >> 4);
    bf16x8 a[4];
#pragma unroll
    for (int ks = 0; ks < 4; ++ks) a[ks] = *(const bf16x8*)(iq + qrow * 1024 + (r & 15) * 64 + ks * 16 + 8 * hi);
    float wq[2][8];
#pragma unroll
    for (int q = 0; q < 2; ++q)
#pragma unroll
        for (int i = 0; i < 8; ++i) wq[q][i] = 0.5f * iw[((size_t)b * SEQ + t0 + 2 * p + q) * 16 + (i & 3) + 8 * ((i >> 2) & 1) + 4 * hi];
    const int nchunks = (t0 + 7) / 64 + 1, nsteps = (nchunks + 1) >> 1;
    const unsigned char* gsrc = (const unsigned char*)(ik + (size_t)b * SEQ * 64) + F.tid * 16;
    const int skey = F.tid >> 3, sc16 = F.tid & 7, soff = skey * 128 + ((sc16 ^ ((skey >> 1) & 7)) << 4);
    u32x4 sa0 = *(const u32x4*)gsrc, sb0 = sa0, sa1 = sa0, sb1 = sa0;
    sb0 = *(const u32x4*)(gsrc + (size_t)min(1, nchunks - 1) * 8192);
    sa1 = *(const u32x4*)(gsrc + (size_t)min(2, nchunks - 1) * 8192);
    sb1 = *(const u32x4*)(gsrc + (size_t)min(3, nchunks - 1) * 8192);
    __syncthreads();
#if PROBE_IDX != 1 && PROBE_IDX != 5
#define IDX_LD(c) (*(const u32x4*)(gsrc + (size_t)(c) * 8192))
#endif
#define IDX_MMA(SA, SB, ss, D0, D1) do { const int s_ = (ss); unsigned char* sb = stage + (s_ & 1) * 16384; \
        *(u32x4*)(sb + soff) = SA; *(u32x4*)(sb + 8192 + soff) = SB; \
        __syncthreads(); \
        SA = IDX_LD(min(2 * s_ + 4, nchunks - 1)); \
        SB = IDX_LD(min(2 * s_ + 5, nchunks - 1)); \
        _Pragma("unroll") for (int i = 0; i < 16; ++i) { D0[i] = 0.f; D1[i] = 0.f; } \
        _Pragma("unroll") for (int ks = 0; ks < 4; ++ks) { const unsigned char* bp = sb + key * 128 + (((ks * 2 + hi) ^ ((key >> 1) & 7)) << 4); \
            const bf16x8 bf0 = *(const bf16x8*)bp, bf1 = *(const bf16x8*)(bp + 8192); \
            D0 = __builtin_amdgcn_mfma_f32_32x32x16_bf16(a[ks], bf0, D0, 0, 0, 0); D1 = __builtin_amdgcn_mfma_f32_32x32x16_bf16(a[ks], bf1, D1, 0, 0, 0); } } while (0)
#define IDX_RED(ss, D0, D1) do { const int s_ = (ss); float x0_ = 0.f, x1_ = 0.f, y0_ = 0.f, y1_ = 0.f; \
        _Pragma("unroll") for (int i = 0; i < 8; ++i) { x0_ = wrelu_(wq[0][i], D0[i], x0_); x1_ = wrelu_(wq[1][i], D0[8 + i], x1_); y0_ = wrelu_(wq[0][i], D1[i], y0_); y1_ = wrelu_(wq[1][i], D1[8 + i], y1_); } \
        const float scx = swap32_pair(x0_, x1_), scy = swap32_pair(y0_, y1_); \
        *(f32x2*)(rowbuf + (2 * p + hi) * 4096 + ((s_ >> 1) * 64 + key) * 4 + 2 * (s_ & 1)) = (f32x2){scx, scy}; } while (0)
    const int key = kh * 32 + r;
    f32x16 dA0, dA1, dB0, dB1;
#if PROBE_IDX == 1
#define IDX_LD(c) (*(const u32x4*)(gsrc + (size_t)(c) * 8192))
#elif PROBE_IDX == 5
#define IDX_LD(c) SAVED
#endif
#if PROBE_IDX == 1 || PROBE_IDX == 5
    { const u32x4 SAVED = sa0;
    IDX_MMA(sa0, sb0, 0, dA0, dA1);
    for (int s2 = 0; s2 < nsteps; s2 += 2) {
        if (s2 + 1 < nsteps) IDX_MMA(sa1, sb1, s2 + 1, dB0, dB1);
        IDX_RED(s2, dA0, dA1);
        if (s2 + 2 < nsteps) IDX_MMA(sa0, sb0, s2 + 2, dA0, dA1);
        if (s2 + 1 < nsteps) IDX_RED(s2 + 1, dB0, dB1);
    }
    __syncthreads();
    sa0 = *(const u32x4*)gsrc;
    sb0 = *(const u32x4*)(gsrc + (size_t)min(1, nchunks - 1) * 8192);
    sa1 = *(const u32x4*)(gsrc + (size_t)min(2, nchunks - 1) * 8192);
    sb1 = *(const u32x4*)(gsrc + (size_t)min(3, nchunks - 1) * 8192); }
#undef IDX_LD
#define IDX_LD(c) (*(const u32x4*)(gsrc + (size_t)(c) * 8192))
#endif
    IDX_MMA(sa0, sb0, 0, dA0, dA1);
    for (int s2 = 0; s2 < nsteps; s2 += 2) {
        if (s2 + 1 < nsteps) IDX_MMA(sa1, sb1, s2 + 1, dB0, dB1);
        IDX_RED(s2, dA0, dA1);
        if (s2 + 2 < nsteps) IDX_MMA(sa0, sb0, s2 + 2, dA0, dA1);
        if (s2 + 1 < nsteps) IDX_RED(s2 + 1, dB0, dB1);
    }
#undef IDX_MMA
#undef IDX_RED
#undef IDX_LD
    __syncthreads();
    indexer_select(F, b, t0 + w, rowbuf + w * 4096, (unsigned*)(F.lds + 147456) + w * 256, (float*)(F.lds + 155648) + w * 64, (int*)(F.lds + 155648 + 2048) + w * 64);
#if PROBE_IDX >= 2
    indexer_select<PROBE_IDX - 1>(F, b, t0 + w, rowbuf + w * 4096, (unsigned*)(F.lds + 147456) + w * 256, (float*)(F.lds + 155648) + w * 64, (int*)(F.lds + 155648 + 2048) + w * 64);
#endif
}
__device__ __forceinline__ void phase3_indexer(Frame& F) {
    F.lane = lane_now(); F.tid = F.wave * 64 + F.lane;
    volatile LAS unsigned* misc = (volatile LAS unsigned*)((LAS unsigned char*)F.lds + MISC_OFF);
    const unsigned keep0 = misc[0], keep1 = misc[1];
    __syncthreads();
    const int nit = BATCH * (SEQ / 8);
    for (int k = 0;; ++k) {
        const int l = k * F.G + ((k & 1) ? (F.G - 1 - F.bid) : F.bid);
        if (l >= nit) { if (k * F.G >= nit) break; else continue; }
        const int qb = (SEQ / 8 - 1) - (l >> 3), b = l & 7;
        indexer_tile(F, b, qb * 8);
    }
    __syncthreads();
    if (F.tid == 0) { misc[0] = keep0; misc[1] = keep1; }
}

__device__ const unsigned char g_bucket[128] = {0, 1, 2, 3, 4, 5, 6, 7, 8, 9, 10, 11, 12, 13, 14, 15, 16, 16, 16, 17, 17, 18, 18, 18, 19, 19, 19, 20, 20, 20, 20, 21, 21, 21, 21, 22, 22, 22, 22, 22, 23, 23, 23, 23, 23, 23, 24, 24, 24, 24, 24, 24, 25, 25, 25, 25, 25, 25, 25, 26, 26, 26, 26, 26, 26, 26, 26, 27, 27, 27, 27, 27, 27, 27, 27, 27, 27, 28, 28, 28, 28, 28, 28, 28, 28, 28, 28, 29, 29, 29, 29, 29, 29, 29, 29, 29, 29, 29, 29, 30, 30, 30, 30, 30, 30, 30, 30, 30, 30, 30, 30, 30, 30, 31, 31, 31, 31, 31, 31, 31, 31, 31, 31, 31, 31, 31, 31, 31};
__device__ __forceinline__ void at_pv_step(f32x4 (&D0)[8], f32x4 (&D1)[8], const u32x4 (&buf)[8], LAS unsigned char* vwr, LAS unsigned char* ard, LAS unsigned char* brd) {
#pragma unroll
    for (int c = 0; c < 8; ++c) *(LAS u32x4*)(vwr + c * 16) = buf[c];
    const long pb = __builtin_bit_cast(long, __builtin_amdgcn_ds_read_tr8_b64_v2i32((LAS v2i*)brd));
#pragma unroll
    for (int tl = 0; tl < 8; ++tl) { const long va = __builtin_bit_cast(long, __builtin_amdgcn_ds_read_tr8_b64_v2i32((LAS v2i*)(ard + tl * 16))); D0[tl] = __builtin_amdgcn_mfma_f32_16x16x32_fp8_fp8(va, pb, D0[tl], 0, 0, 0); }
#pragma unroll
    for (int tl = 0; tl < 8; ++tl) { const long va = __builtin_bit_cast(long, __builtin_amdgcn_ds_read_tr8_b64_v2i32((LAS v2i*)(ard + 4608 + tl * 16))); D1[tl] = __builtin_amdgcn_mfma_f32_16x16x32_fp8_fp8(va, pb, D1[tl], 0, 0, 0); }
}
__device__ __forceinline__ void phase4_attention(Frame& F) {
    F.lane = lane_now(); F.tid = F.wave * 64 + F.lane;
    const unsigned char* q8 = F.ws + WS_Q8; const unsigned char* k8 = F.ws + WS_K8; const unsigned char* v8 = F.ws + WS_V8;
    const unsigned short* sel = (const unsigned short*)(F.ws + WS_SEL); bf16_t* ao = (bf16_t*)(F.ws + WS_ATTN);
    float* btab = (float*)F.lds;
    __syncthreads();
    for (int i = F.tid; i < 256; i += 512) btab[i] = F.rel_bias[i];
    __syncthreads();
    float* Pl = (float*)(F.lds + 4096 + F.wave * 12544); int* idl = (int*)((unsigned char*)Pl + 9216); float* psl = (float*)((unsigned char*)Pl + 12288); float* pml = psl + 8;
    LAS unsigned char* wl = (LAS unsigned char*)F.lds + 4096 + F.wave * 12544;
    const bool xmap = (F.G % 8) == 0;
    const int gw = xmap ? (F.bid / 8) * 8 + F.wave : F.bid * 8 + F.wave, NGW = xmap ? F.G : F.G * 8, nrows = xmap ? SEQ : MTOK;
    for (int rr = gw; rr < nrows; rr += NGW) {
        int lane = F.lane; asm volatile("" : "+v"(lane));
        const int row = xmap ? (F.bid & 7) * SEQ + rr : rr;
        const int b = row / SEQ, t = row % SEQ, r = lane & 31, hi = lane >> 5;
#pragma unroll
        for (int p = 0; p < 4; ++p) { idl[p * 64 + lane] = (int)sel[(size_t)row * 256 + p * 64 + lane]; }
        long a0[8], a1[8];
        { u32x4 qa[4];
#pragma unroll
          for (int i = 0; i < 4; ++i) qa[i] = (r < 8) ? *(const u32x4*)(q8 + (size_t)row * 1024 + r * 128 + hi * 64 + i * 16) : (u32x4){0u, 0u, 0u, 0u};
#pragma unroll
          for (int ks = 0; ks < 8; ++ks) { const unsigned lo = qa[ks >> 1][(ks & 1) * 2], hh = qa[ks >> 1][(ks & 1) * 2 + 1]; const long v = (long)(((unsigned long long)hh << 32) | lo);
              a0[ks] = (r < 4) ? v : 0l; a1[ks] = (r >= 4) ? v : 0l; } }
        f32x4 psum = (f32x4){0.f, 0.f, 0.f, 0.f}, pmax = psum;
#define AT_LOADK(buf, kb) do { const int key_ = idl[(kb) * 32 + r]; const int kc_ = key_ <= t ? key_ : 0; const unsigned char* kr_ = k8 + ((size_t)b * SEQ + kc_) * 256 + hi * 64; \
            _Pragma("unroll") for (int i = 0; i < 4; ++i) { buf[i] = *(const u32x4*)(kr_ + i * 16); buf[4 + i] = *(const u32x4*)(kr_ + 128 + i * 16); } } while (0)
#define AT_QK(buf, kb) do { const int key_ = idl[(kb) * 32 + r]; const bool valid_ = key_ <= t; const int kc_ = valid_ ? key_ : 0; \
            f32x16 d; _Pragma("unroll") for (int i = 0; i < 16; ++i) d[i] = 0.f; \
            _Pragma("unroll") for (int ks = 0; ks < 8; ++ks) { const long bv_ = (long)(((unsigned long long)buf[ks >> 1][(ks & 1) * 2 + 1] << 32) | buf[ks >> 1][(ks & 1) * 2]); d = __builtin_amdgcn_mfma_f32_32x32x16_fp8_fp8(a0[ks], bv_, d, 0, 0, 0); } \
            _Pragma("unroll") for (int ks = 0; ks < 8; ++ks) { const long bv_ = (long)(((unsigned long long)buf[4 + (ks >> 1)][(ks & 1) * 2 + 1] << 32) | buf[4 + (ks >> 1)][(ks & 1) * 2]); d = __builtin_amdgcn_mfma_f32_32x32x16_fp8_fp8(a1[ks], bv_, d, 0, 0, 0); } \
            const int dist_ = t - kc_; const int bkt_ = dist_ < 128 ? (int)g_bucket[dist_] : 31; \
            const f32x4 bias_ = *(const f32x4*)(btab + bkt_ * 8 + 4 * hi); f32x4 e_; \
            _Pragma("unroll") for (int i = 0; i < 4; ++i) e_[i] = valid_ ? __expf(d[i] * 0.08838834764831845f + bias_[i]) : 0.f; \
            psum += e_; _Pragma("unroll") for (int i = 0; i < 4; ++i) pmax[i] = fmaxf(pmax[i], e_[i]); *(f32x4*)(Pl + ((kb) * 32 + r) * 8 + 4 * hi) = e_; } while (0)
        {
            u32x4 kA[8], kB[8];
            AT_LOADK(kA, 0);
#pragma unroll 1
            for (int kb = 0; kb < 8; kb += 2) {
                AT_LOADK(kB, kb + 1);
                AT_QK(kA, kb);
                if (kb + 2 < 8) AT_LOADK(kA, kb + 2);
                AT_QK(kB, kb + 1);
            }
        }
#undef AT_LOADK
#undef AT_QK
#pragma unroll
        for (int i = 0; i < 4; ++i) { psum[i] = xor16_sum(row_sum16(psum[i])); pmax[i] = xor16_max(row_max16(pmax[i])); }
        if (r == 0) { *(f32x4*)(psl + 4 * hi) = psum; *(f32x4*)(pml + 4 * hi) = pmax; }
        const int fk = lane & 31, fg = lane >> 5, kq = lane >> 4, tq = (lane >> 1) & 7, tp = lane & 1;
#define AT_LOADV(buf, ks_) do { const int key_ = idl[(ks_) * 32 + fk]; const int kc_ = key_ <= t ? key_ : 0; const unsigned char* vr_ = v8 + ((size_t)b * SEQ + kc_) * 256 + fg * 128; \
            _Pragma("unroll") for (int c = 0; c < 8; ++c) buf[c] = *(const u32x4*)(vr_ + c * 16); } while (0)
        u32x4 vA[8], vB[8];
        AT_LOADV(vA, 0);
        { const f32x4 m0 = *(const f32x4*)pml, m1 = *(const f32x4*)(pml + 4);
          f32x4 r0, r1;
#pragma unroll
          for (int i = 0; i < 4; ++i) { r0[i] = __builtin_amdgcn_rcpf(m0[i]); r1[i] = __builtin_amdgcn_rcpf(m1[i]); }
#pragma unroll
          for (int i = 0; i < 4; ++i) { const int key = i * 64 + lane;
              *(LAS u32x2*)(wl + 10240 + key * 8) = pack8_fp8(*(const f32x4*)(Pl + key * 8) * r0, *(const f32x4*)(Pl + key * 8 + 4) * r1); } }
        f32x4 D0[8], D1[8];
#pragma unroll
        for (int tl = 0; tl < 8; ++tl) { D0[tl] = (f32x4){0.f, 0.f, 0.f, 0.f}; D1[tl] = D0[tl]; }
        LAS unsigned char* vwr = wl + fg * 4608 + fk * 144;
        LAS unsigned char* ard = wl + (kq * 8 + tq) * 144 + 8 * tp;
        LAS unsigned char* brd = wl + 10240 + (kq * 8 + tq) * 8;
#pragma unroll 1
        for (int ks = 0; ks < 8; ks += 2) {
            AT_LOADV(vB, ks + 1);
            at_pv_step(D0, D1, vA, vwr, ard, brd + ks * 256);
            if (ks + 2 < 8) AT_LOADV(vA, ks + 2);
            at_pv_step(D0, D1, vB, vwr, ard, brd + (ks + 1) * 256);
        }
#undef AT_LOADV
        { const int n = lane & 15, q4 = lane >> 4;
          if (n < 8) { const float sc = pml[n] / psl[n]; const bool g1 = n >= 4;
              bf16_t* op = ao + (size_t)row * 1024 + n * 128 + q4 * 4;
#pragma unroll
              for (int tl = 0; tl < 8; ++tl) { const f32x4 d = (g1 ? D1[tl] : D0[tl]) * sc;
                  *(u32x2*)(op + tl * 16) = (u32x2){cvt_pk_bf16(d[0], d[1]), cvt_pk_bf16(d[2], d[3])}; } } }
    }
}

__device__ __forceinline__ float dot16f8(u32x4 w, const float* h) {
    float s = 0.f;
#pragma unroll
    for (int d = 0; d < 4; ++d) { const f32x2 lo = __builtin_amdgcn_cvt_pk_f32_fp8((int)w[d], false), hi = __builtin_amdgcn_cvt_pk_f32_fp8((int)w[d], true);
        s += lo.x * h[4 * d] + lo.y * h[4 * d + 1] + hi.x * h[4 * d + 2] + hi.y * h[4 * d + 3]; }
    return s;
}
__device__ __forceinline__ void fma16f8(u32x4 w, float cf, float* acc) {
#pragma unroll
    for (int d = 0; d < 4; ++d) { const f32x2 lo = __builtin_amdgcn_cvt_pk_f32_fp8((int)w[d], false), hi = __builtin_amdgcn_cvt_pk_f32_fp8((int)w[d], true);
        acc[4 * d] += cf * lo.x; acc[4 * d + 1] += cf * lo.y; acc[4 * d + 2] += cf * hi.x; acc[4 * d + 3] += cf * hi.y; }
}
__device__ __forceinline__ float gelu_erf(float x) { return 0.5f * x * (1.0f + erff(x * 0.70710678118654752f)); }
__device__ __forceinline__ void ce_k(unsigned& a, unsigned& b) { const unsigned hi = a > b ? a : b, lo = a > b ? b : a; a = hi; b = lo; }
__device__ __forceinline__ void ce_kp(unsigned& ka, unsigned& pa, unsigned& kb, unsigned& pb) { const bool sw = kb > ka; const unsigned k0 = sw ? kb : ka, k1 = sw ? ka : kb, p0 = sw ? pb : pa, p1 = sw ? pa : pb; ka = k0; kb = k1; pa = p0; pb = p1; }
__device__ __forceinline__ void bmerge16(unsigned (&x)[16]) {
#pragma unroll
    for (int jj = 0; jj < 4; ++jj) { const int j = 8 >> jj;
#pragma unroll
        for (int i = 0; i < 16; ++i) { const int l = i ^ j; if (l > i) ce_k(x[i], x[l]); }
        __builtin_amdgcn_sched_barrier(0); }
}
__device__ __forceinline__ void bmerge16p(unsigned (&x)[16], unsigned (&p)[16]) {
#pragma unroll
    for (int jj = 0; jj < 4; ++jj) { const int j = 8 >> jj;
#pragma unroll
        for (int i = 0; i < 16; ++i) { const int l = i ^ j; if (l > i) ce_kp(x[i], p[i], x[l], p[l]); }
        __builtin_amdgcn_sched_barrier(0); }
}
__device__ __forceinline__ void bsort16(unsigned (&x)[16]) {
#pragma unroll
    for (int kk = 1; kk <= 4; ++kk) { const int k = 1 << kk;
#pragma unroll
        for (int jj = 0; jj < 4; ++jj) { const int j = (k >> 1) >> jj;
            if (j > 0) {
#pragma unroll
                for (int i = 0; i < 16; ++i) { const int l = i ^ j; if (l > i) { if ((i & k) == 0) ce_k(x[i], x[l]); else ce_k(x[l], x[i]); } }
                __builtin_amdgcn_sched_barrier(0); } } }
}
__device__ __forceinline__ void bsort16p(unsigned (&x)[16], unsigned (&p)[16]) {
#pragma unroll
    for (int kk = 1; kk <= 4; ++kk) { const int k = 1 << kk;
#pragma unroll
        for (int jj = 0; jj < 4; ++jj) { const int j = (k >> 1) >> jj;
            if (j > 0) {
#pragma unroll
                for (int i = 0; i < 16; ++i) { const int l = i ^ j; if (l > i) { if ((i & k) == 0) ce_kp(x[i], p[i], x[l], p[l]); else ce_kp(x[l], p[l], x[i], p[i]); } }
                __builtin_amdgcn_sched_barrier(0); } } }
}
__device__ __forceinline__ void top16_row(const unsigned char* rowp, unsigned (&t)[16]) {
#pragma unroll
    for (int i = 0; i < 16; ++i) t[i] = 0u;
#pragma unroll 1
    for (int g = 0; g < 8; ++g) {
        unsigned w[8];
#pragma unroll
        for (int q = 0; q < 4; ++q) { const u32x2 v = *(const u32x2*)(rowp + g * 32 + q * 8); w[2 * q] = v.x; w[2 * q + 1] = v.y; }
        unsigned sk[16];
#pragma unroll
        for (int d = 0; d < 8; ++d) {
            const unsigned lo = w[d] << 16, hi = w[d];
            const unsigned xl = lo ^ ((unsigned)((int)lo >> 31) | 0x80000000u), xh = hi ^ ((unsigned)((int)hi >> 31) | 0x80000000u);
            sk[2 * d] = ((xl >> 9) & 0xFFFFFF80u) | (unsigned)(127 - (g * 16 + 2 * d));
            sk[2 * d + 1] = ((xh >> 9) & 0xFFFFFF80u) | (unsigned)(127 - (g * 16 + 2 * d + 1)); }
        bsort16(sk);
#pragma unroll
        for (int i = 0; i < 16; ++i) t[i] = t[i] > sk[15 - i] ? t[i] : sk[15 - i];
        bmerge16(t);
    }
}
__device__ __forceinline__ float key_val(unsigned key) { const unsigned y = (key << 9) & 0xFFFF0000u; return __uint_as_float((y ^ (~(unsigned)((int)y >> 31) | 0x80000000u)) & 0xFFFF0000u); }
__device__ __forceinline__ unsigned sum_key(float s, int c) { const unsigned u = __float_as_uint(s); return ((u ^ ((unsigned)((int)u >> 31) | 0x80000000u)) & ~63u) | (unsigned)(63 - c); }
__device__ __forceinline__ float sum_val(unsigned k) { const unsigned y = k & ~63u; return __uint_as_float(y ^ (~(unsigned)((int)y >> 31) | 0x80000000u)); }
typedef __bf16 bf2_t __attribute__((ext_vector_type(2)));
__device__ __forceinline__ float dot2_bf(unsigned a, unsigned b, float c) { return __builtin_amdgcn_fdot2_f32_bf16(__builtin_bit_cast(bf2_t, a), __builtin_bit_cast(bf2_t, b), c, false); }
__device__ __forceinline__ float dot32_f6b(u32x4 wa, u32x2 wb, u32x4 h0, u32x4 h1, u32x4 h2, u32x4 h3) {
    const bf16x32 dec = __builtin_amdgcn_cvt_scalef32_pk32_bf16_fp6((u32x6){wa.x, wa.y, wa.z, wa.w, wb.x, wb.y}, 1.0f);
    const u32x16 ud = __builtin_bit_cast(u32x16, dec);
    float acc = 0.f;
    acc = dot2_bf(ud.s0, h0.x, acc); acc = dot2_bf(ud.s1, h0.y, acc); acc = dot2_bf(ud.s2, h0.z, acc); acc = dot2_bf(ud.s3, h0.w, acc);
    acc = dot2_bf(ud.s4, h1.x, acc); acc = dot2_bf(ud.s5, h1.y, acc); acc = dot2_bf(ud.s6, h1.z, acc); acc = dot2_bf(ud.s7, h1.w, acc);
    acc = dot2_bf(ud.s8, h2.x, acc); acc = dot2_bf(ud.s9, h2.y, acc); acc = dot2_bf(ud.sa, h2.z, acc); acc = dot2_bf(ud.sb, h2.w, acc);
    acc = dot2_bf(ud.sc, h3.x, acc); acc = dot2_bf(ud.sd, h3.y, acc); acc = dot2_bf(ud.se, h3.z, acc); acc = dot2_bf(ud.sf, h3.w, acc);
    return acc;
}
__device__ const unsigned char g_cab[64] = {0, 1, 2, 3, 4, 5, 6, 7, 8, 9, 10, 11, 12, 13, 14, 15, 16, 17, 18, 19, 20, 21, 22, 23, 32, 33, 34, 35, 36, 48, 49, 50, 51, 64, 65, 66, 80, 81, 96, 97, 112, 113, 128, 144, 160, 176, 192, 208, 224, 240, 0, 0, 0, 0, 0, 0, 0, 0, 0, 0, 0, 0, 0, 0};
__device__ __forceinline__ void phase10_peer(Frame& F) {
    F.lane = lane_now(); F.tid = F.wave * 64 + F.lane;
    const bf16_t* sub = (const bf16_t*)(F.ws + WS_SUB); const bf16_t* h2 = (const bf16_t*)(F.ws + WS_H2);
    const unsigned char* pu = F.ws + WS_PU; unsigned* pairs = (unsigned*)(F.ws + WS_PAIRS);
    const int gw = F.bid * 8 + F.wave, NGW = F.G * 8;
    unsigned char* wb = F.lds + F.wave * 19200;
    unsigned char* h2b = wb; unsigned short* gl16 = (unsigned short*)(wb + 16896); unsigned* hist = (unsigned*)(wb + 18944); unsigned* base = hist + 32;
    unsigned* tmp = (unsigned*)wb;
    unsigned* wls0 = (unsigned*)(F.ws + WS_WLS) + (size_t)gw * 1024;
    const int ntok = (MTOK - gw + NGW - 1) / NGW;
    constexpr int CA[50] = {0,0,0,0,0,0,0,0,0,0,0,0,0,0,0,0, 1,1,1,1,1,1,1,1, 2,2,2,2,2, 3,3,3,3, 4,4,4, 5,5, 6,6, 7,7, 8,9,10,11,12,13,14,15};
    constexpr int CB[50] = {0,1,2,3,4,5,6,7,8,9,10,11,12,13,14,15, 0,1,2,3,4,5,6,7, 0,1,2,3,4, 0,1,2,3, 0,1,2, 0,1, 0,1, 0,1, 0,0,0,0,0,0,0,0};
    for (int p0 = 0; p0 < ntok; p0 += 8) {
        int lane = F.lane; asm volatile("" : "+v"(lane));
        const int nt = (ntok - p0) < 8 ? (ntok - p0) : 8;
        {
            u32x4 st[16];
#define SEL_LOAD(half) do { asm volatile("" : "+v"(lane)); const int srow_l = lane >> 4, scol = lane & 15; _Pragma("unroll") for (int it = 0; it < 16; ++it) { const int r_ = it * 4 + srow_l; int ti_ = r_ >> 3; ti_ = ti_ < nt ? ti_ : nt - 1; \
                st[it] = *(const u32x4*)(sub + (size_t)(gw + (p0 + ti_) * NGW) * 2048 + (r_ & 7) * 256 + (half) * 128 + scol * 8); } } while (0)
#define SEL_STORE() do { const int srow_l = lane >> 4, scol = lane & 15; _Pragma("unroll") for (int it = 0; it < 16; ++it) { unsigned char* d_ = wb + (it * 4 + srow_l) * 264 + scol * 16; \
                *(u32x2*)d_ = (u32x2){st[it].x, st[it].y}; *(u32x2*)(d_ + 8) = (u32x2){st[it].z, st[it].w}; } } while (0)
            unsigned tA[16], tB[16];
            SEL_LOAD(0); SEL_STORE();
            __builtin_amdgcn_sched_barrier(0);
            top16_row(wb + lane * 264, tA);
            __builtin_amdgcn_sched_barrier(0);
            asm volatile("" : "+v"(tA[0]), "+v"(tA[1]), "+v"(tA[2]), "+v"(tA[3]), "+v"(tA[4]), "+v"(tA[5]), "+v"(tA[6]), "+v"(tA[7]), "+v"(tA[8]), "+v"(tA[9]), "+v"(tA[10]), "+v"(tA[11]), "+v"(tA[12]), "+v"(tA[13]), "+v"(tA[14]), "+v"(tA[15]) :: "memory");
            SEL_LOAD(1); SEL_STORE();
            __builtin_amdgcn_sched_barrier(0);
            top16_row(wb + lane * 264, tB);
            __builtin_amdgcn_sched_barrier(0);
#undef SEL_LOAD
#undef SEL_STORE
            float vA[16], vB[16];
            { unsigned pa[4] = {0u, 0u, 0u, 0u}, pb[4] = {0u, 0u, 0u, 0u};
#pragma unroll
              for (int i = 0; i < 16; ++i) { vA[i] = key_val(tA[i]); vB[i] = key_val(tB[i]); pa[i >> 2] |= (127u - (tA[i] & 127u)) << (8 * (i & 3)); pb[i >> 2] |= (127u - (tB[i] & 127u)) << (8 * (i & 3)); }
              unsigned char* rp = wb + lane * 264;
              *(u32x2*)rp = (u32x2){pa[0], pa[1]}; *(u32x2*)(rp + 8) = (u32x2){pa[2], pa[3]}; *(u32x2*)(rp + 16) = (u32x2){pb[0], pb[1]}; *(u32x2*)(rp + 24) = (u32x2){pb[2], pb[3]}; }
            unsigned tk[16];
#pragma unroll
            for (int c = 0; c < 16; ++c) tk[c] = sum_key(vA[CA[c]] + vB[CB[c]], c);
            bsort16(tk);
#pragma unroll
            for (int grp = 1; grp < 3; ++grp) {
                unsigned sk[16];
#pragma unroll
                for (int e = 0; e < 16; ++e) { const int c = grp * 16 + e; sk[e] = sum_key(vA[CA[c]] + vB[CB[c]], c); }
                bsort16(sk);
#pragma unroll
                for (int i = 0; i < 16; ++i) tk[i] = tk[i] > sk[15 - i] ? tk[i] : sk[15 - i];
                bmerge16(tk);
            }
#pragma unroll
            for (int c = 48; c < 50; ++c) { unsigned k = sum_key(vA[CA[c]] + vB[CB[c]], c);
#pragma unroll
                for (int i = 0; i < 16; ++i) ce_k(tk[i], k); }
            const float s0 = sum_val(tk[0]); float ev[16], esum = 0.f;
#pragma unroll
            for (int r = 0; r < 16; ++r) { ev[r] = __expf(sum_val(tk[r]) - s0); esum += ev[r]; }
            const float einv = 1.0f / esum;
            unsigned eid[16];
            { const unsigned char* rp = wb + lane * 264;
#pragma unroll
              for (int r = 0; r < 16; ++r) { const unsigned cab = g_cab[63u - (tk[r] & 63u)]; eid[r] = (unsigned)rp[cab >> 4] * 128u + (unsigned)rp[16 + (cab & 15u)]; } }
            if ((lane >> 3) < nt) {
#pragma unroll
                for (int r = 0; r < 16; ++r) { const int e = lane * 16 + r; tmp[e] = ((unsigned)e << 14) | eid[r]; gl16[e] = (unsigned short)(cvt_pk_bf16(ev[r] * einv, 0.f) & 0xffffu); } }
        }
        asm volatile("" : "+v"(lane));
#pragma unroll 1
        for (int grp = 0; grp < 2; ++grp) {
            const int ng = nt - grp * 4; const int ne = (ng <= 0 ? 0 : (ng < 4 ? ng : 4)) * 128;
            if (ne == 0) break;
            unsigned* wls = wls0 + grp * 512;
            if (lane < 32) hist[lane] = 0u;
            unsigned ent[8]; unsigned rk[8];
#pragma unroll
            for (int q = 0; q < 8; ++q) { const int e = q * 64 + lane; ent[q] = (e < ne) ? tmp[grp * 512 + e] : 0u; rk[q] = (e < ne) ? atomicAdd(&hist[(ent[q] & 0x3FFFu) >> 9], 1u) : 0u; }
            { int hv = lane < 32 ? (int)hist[lane] : 0; int x = hv;
              x += __builtin_amdgcn_update_dpp(0, x, 0x111, 0xF, 0xF, true); x += __builtin_amdgcn_update_dpp(0, x, 0x112, 0xF, 0xF, true);
              x += __builtin_amdgcn_update_dpp(0, x, 0x114, 0xF, 0xF, true); x += __builtin_amdgcn_update_dpp(0, x, 0x118, 0xF, 0xF, true);
              const int t0 = __builtin_amdgcn_readlane(x, 15); if (lane >= 16) x += t0;
              if (lane < 32) base[lane] = (unsigned)(x - hv); }
#pragma unroll
            for (int q = 0; q < 8; ++q) { const int e = q * 64 + lane; if (e < ne) wls[base[(ent[q] & 0x3FFFu) >> 9] + rk[q]] = ent[q]; }
        }
        asm volatile("s_waitcnt vmcnt(0)" ::: "memory");
#pragma unroll 1
        for (int grp = 0; grp < 2; ++grp) {
            const int ng = nt - grp * 4; const int ngc = ng <= 0 ? 0 : (ng < 4 ? ng : 4), ne = ngc * 128;
            if (ne == 0) break;
            const unsigned* wls = wls0 + grp * 512;
            asm volatile("" : "+v"(lane));
#pragma unroll 1
            for (int i = 0; i < ngc; ++i) { const bf16_t* hr = h2 + (size_t)(gw + (p0 + grp * 4 + i) * NGW) * 2048 + lane * 32;
#pragma unroll
                for (int q = 0; q < 4; ++q) *(u32x4*)(h2b + i * 4096 + q * 1024 + lane * 16) = *(const u32x4*)(hr + q * 8); }
            unsigned entn = __hip_atomic_load(wls + lane, __ATOMIC_RELAXED, __HIP_MEMORY_SCOPE_AGENT);
#pragma unroll 1
            for (int c = 0; c < ne; c += 64) {
                const unsigned ent64 = entn;
                if (c + 64 < ne) entn = __hip_atomic_load(wls + c + 64 + lane, __ATOMIC_RELAXED, __HIP_MEMORY_SCOPE_AGENT);
#pragma unroll 1
                for (int i0 = 0; i0 < 64; i0 += 8) {
                    u32x4 wA[8]; u32x2 wB[8]; unsigned en[8];
#pragma unroll
                    for (int jj = 0; jj < 8; ++jj) { en[jj] = (unsigned)__builtin_amdgcn_readlane((int)ent64, i0 + jj); const unsigned char* ur = pu + (size_t)(en[jj] & 0x3FFFu) * 1536 + lane * 24;
                        const u32x2 t0 = *(const u32x2*)ur, t1 = *(const u32x2*)(ur + 8); wA[jj] = (u32x4){t0.x, t0.y, t1.x, t1.y}; wB[jj] = *(const u32x2*)(ur + 16); }
                    float pr[8];
#pragma unroll
                    for (int jj = 0; jj < 8; ++jj) { const unsigned char* hp = h2b + ((en[jj] >> 21) & 3u) * 4096 + lane * 16;
                        pr[jj] = dot32_f6b(wA[jj], wB[jj], *(const u32x4*)hp, *(const u32x4*)(hp + 1024), *(const u32x4*)(hp + 2048), *(const u32x4*)(hp + 3072)); __builtin_amdgcn_sched_barrier(0); }
#pragma unroll
                    for (int i = 0; i < 4; ++i) pr[i] = swap32_pair(pr[i], pr[i + 4]);
#pragma unroll
                    for (int i = 0; i < 2; ++i) pr[i] = swap16_pair(pr[i], pr[i + 2]);
                    const bool b3 = (lane & 8) != 0;
                    { const float snd = b3 ? pr[0] : pr[1], kp = b3 ? pr[1] : pr[0]; pr[0] = kp + dpp_f<DPP_ROR8>(snd); }
                    float tot = pr[0]; tot += dpp_f<DPP_XOR1>(tot); tot += dpp_f<DPP_XOR2>(tot); tot += dpp_f<DPP_HMIRROR>(tot);
                    const unsigned em = (unsigned)__shfl((int)ent64, i0 + (lane >> 3));
                    if ((lane & 7) == 0) {
                        const int ti = (int)(em >> 21), j = (int)((em >> 14) & 127u), row = gw + (p0 + ti) * NGW;
                        const float cf = gelu_erf(tot * (1.0f / 96.0f)) * __uint_as_float((unsigned)gl16[(em >> 14) & 1023u] << 16);
                        pairs[((size_t)(row >> 6) * 128 + j) * 64 + (row & 63)] = (((unsigned)__builtin_bit_cast(unsigned short, (_Float16)cf) << 16) & 0xFFFE0000u) | ((em & 0x3FFFu) << 3);
                    }
                }
            }
        }
    }
}

__device__ __forceinline__ void phase11_peer_v(Frame& F, float* dst) {
    F.lane = lane_now(); F.tid = F.wave * 64 + F.lane;
    const unsigned* pairs = (const unsigned*)(F.ws + WS_PAIRS); const float* mf = (const float*)(F.ws + WS_MODF);
    unsigned long long* vs = (unsigned long long*)F.lds;
    for (int c0 = F.bid; c0 < DM / 8; c0 += F.G) {
        const int c = (c0 & 7) * 32 + (c0 >> 3);
        __syncthreads();
        { const u32x4* src = (const u32x4*)(F.ws + WS_PV + (size_t)c * NEXP * 8);
#pragma unroll 4
          for (int i = F.tid; i < NEXP * 8 / 16; i += 512) *(LAS u32x4*)(unsigned long long)(unsigned)(i * 16) = src[i]; }
        __syncthreads();
        typedef __fp16 h2_t __attribute__((__vector_size__(2 * sizeof(__fp16))));
#define P11_LOAD(dst, ptr) do { _Pragma("unroll") for (int jj = 0; jj < 16; ++jj) dst[jj] = (ptr)[jj * 64]; } while (0)
#define P11_FMA(A, X, C) asm("v_pk_fma_f16 %0, %1, %2, %0 op_sel:[0,1,0] op_sel_hi:[1,1,1]" : "+v"(C) : "v"(A), "v"(X))
#define P11_COMP(src) do { unsigned long long vv_[16]; \
                    _Pragma("unroll") for (int jj = 0; jj < 16; ++jj) vv_[jj] = *(const LAS unsigned long long*)(unsigned long long)(src[jj] & 0x1FFF8u);     \
                    __builtin_amdgcn_sched_barrier(0); \
                    _Pragma("unroll") for (int jj = 0; jj < 16; ++jj) { const int lo = (int)(unsigned)vv_[jj], hi = (int)(unsigned)(vv_[jj] >> 32); \
                    const h2_t c0_ = __builtin_amdgcn_cvt_scalef32_pk_f16_fp8(lo, 1.0f, false), c1_ = __builtin_amdgcn_cvt_scalef32_pk_f16_fp8(lo, 1.0f, true); \
                    const h2_t c2_ = __builtin_amdgcn_cvt_scalef32_pk_f16_fp8(hi, 1.0f, false), c3_ = __builtin_amdgcn_cvt_scalef32_pk_f16_fp8(hi, 1.0f, true); \
                    P11_FMA(c0_, src[jj], acc[0]); P11_FMA(c1_, src[jj], acc[1]); P11_FMA(c2_, src[jj], acc[2]); P11_FMA(c3_, src[jj], acc[3]); } } while (0)
        int lane = F.lane; asm volatile("" : "+v"(lane));
        unsigned pa[16], pb[16];
        f32x4 x0, x1;
        { const unsigned* pp = pairs + (size_t)F.wave * 128 * 64 + lane; P11_LOAD(pa, pp);
          const float* ip = F.out + (size_t)(F.wave * 64 + lane) * 2048 + c * 8; x0 = *(const f32x4*)ip; x1 = *(const f32x4*)(ip + 4); }
        for (int tile = F.wave; tile < MTOK / 64; tile += 8) {
            const unsigned* pp = pairs + (size_t)tile * 128 * 64 + lane;
            const int ntile = tile + 8 < MTOK / 64 ? tile + 8 : tile;
            const unsigned* npp = pairs + (size_t)ntile * 128 * 64 + lane;
            const int row = tile * 64 + lane;
            const float* gt2 = mf + (size_t)(tile / (SEQ / 64)) * 12288 + 10240 + c * 8;
            float* op = dst + (size_t)row * 2048 + c * 8;
            const f32x4 g0 = *(const f32x4*)gt2 * 0.25f, g1 = *(const f32x4*)(gt2 + 4) * 0.25f;
            h2_t acc[4];
#pragma unroll
            for (int i = 0; i < 4; ++i) acc[i] = (h2_t){(__fp16)0.f, (__fp16)0.f};
            f32x4 nx0 = x0, nx1 = x1;
#pragma unroll 1
            for (int j0 = 0; j0 < 128; j0 += 32) {
                P11_LOAD(pb, pp + (j0 + 16) * 64);
                P11_COMP(pa);
                const bool lastb = j0 + 32 >= 128;
                { const unsigned* np_ = lastb ? npp : pp + (j0 + 32) * 64; P11_LOAD(pa, np_); }
                if (lastb) { const float* nip = F.out + (size_t)(ntile * 64 + lane) * 2048 + c * 8; nx0 = *(const f32x4*)nip; nx1 = *(const f32x4*)(nip + 4); }
                P11_COMP(pb);
            }
            *(f32x4*)op = x0 + g0 * (f32x4){(float)acc[0][0], (float)acc[0][1], (float)acc[1][0], (float)acc[1][1]};
            *(f32x4*)(op + 4) = x1 + g1 * (f32x4){(float)acc[2][0], (float)acc[2][1], (float)acc[3][0], (float)acc[3][1]};
            x0 = nx0; x1 = nx1;
        }
#undef P11_LOAD
#undef P11_COMP
#undef P11_FMA
    }
}

__global__ void __launch_bounds__(512, 2) fwd_kernel(Args args) {
    extern __shared__ __attribute__((aligned(16))) unsigned char lds[];
    Frame F;
    F.lds = lds; F.ws = args.ws; F.tid = threadIdx.x; F.lane = F.tid & 63; F.wave = __builtin_amdgcn_readfirstlane(F.tid >> 6); F.G = gridDim.x; F.bid = blockIdx.x;
    F.x = args.in[0]; F.c = args.in[1]; F.w_ada = args.in[2]; F.b_ada = args.in[3]; F.g1 = args.in[4]; F.g2 = args.in[5]; F.w_in = args.in[6]; F.g_q = args.in[7]; F.g_k = args.in[8];
    F.rel_bias = args.in[9]; F.pool_w = args.in[10]; F.pool_scale = args.in[11]; F.w_ab = args.in[12]; F.w_pb = args.in[13]; F.w_out = args.in[14]; F.w_pq = args.in[15];
    F.peer_keys = args.in[16]; F.peer_u = args.in[17]; F.peer_v = args.in[18]; F.out = args.out;
    LAS unsigned char* ldsl = (LAS unsigned char*)lds;
    volatile LAS unsigned* misc = (volatile LAS unsigned*)(ldsl + MISC_OFF);
    if (F.tid < 4) misc[F.tid] = 0u;
    __syncthreads();
    unsigned* barw = (unsigned*)(args.ws + WS_CTL) + (size_t)args.li * XCD_BAR_WORDS;
    XcdBarrier bar; bar.bar = barw; bar.x = 0; bar.st = misc;
    const int lo = args.ph_lo, hi = args.ph_hi;
    if (hi - lo > 1) bar = xcd_barrier_post(barw, misc);
#define IN(k) (lo <= (k) && (k) < hi)
#define SEAM(k) do { if (IN(k) && IN((k) + 1)) xcd_barrier(bar, F.wave); } while (0)
    bf16_t* R0 = (bf16_t*)(F.ws + WS_R0);

#define PH2_BODY { \
        { pg8::Gemm g{(const bf16_t*)(F.ws + WS_H1F8), (const bf16_t*)(F.ws + WS_WIN8), MTOK, 5632, DM / 2, DM / 2, 0, nullptr, nullptr, 0, 0}; pg8::StaticOrder S; S.init(MTOK, 5632, F.G, F.bid); \
          EpiInproj<true> E{(bf16_t*)(F.ws + WS_QN), (bf16_t*)(F.ws + WS_KN), (bf16_t*)(F.ws + WS_V), (bf16_t*)(F.ws + WS_IQ), (bf16_t*)(F.ws + WS_IK), (bf16_t*)(F.ws + WS_PL), \
                    (bf16_t*)(F.ws + WS_GA), (bf16_t*)(F.ws + WS_GP), (float*)(F.ws + WS_IW)}; \
          pg8::gemm_phase<EpiInproj<true>, true>(ldsl, g, S, E, F.wave); } \
        { pg8::Gemm g{R0, (const bf16_t*)(F.ws + WS_WIN16), MTOK, 2304, DM, DM, 0, nullptr, nullptr, 0, 0}; pg8::StaticOrder S; S.init(MTOK, 2304, F.G, F.bid); \
          EpiInproj<false> E{(bf16_t*)(F.ws + WS_QN), (bf16_t*)(F.ws + WS_KN), (bf16_t*)(F.ws + WS_V), (bf16_t*)(F.ws + WS_IQ), (bf16_t*)(F.ws + WS_IK), (bf16_t*)(F.ws + WS_PL), \
                    (bf16_t*)(F.ws + WS_GA), (bf16_t*)(F.ws + WS_GP), (float*)(F.ws + WS_IW)}; \
          pg8::gemm_phase<EpiInproj<false>>(ldsl, g, S, E, F.wave); } }
#define PH3_BODY { phase3_pooled(F); phase3_indexer(F); __syncthreads(); }
#define PH4_BODY { \
        phase4_attention(F); \
        __syncthreads(); \
        pg8::Gemm g{(const bf16_t*)(F.ws + WS_POOLED), (const bf16_t*)(F.ws + WS_POOLW), MTOK, PW, 256, 1024, 256, nullptr, nullptr, 0, 0}; pg8::StaticOrder S; S.init(MTOK, PW, F.G, F.bid); \
        EpiBf16Scale E{(bf16_t*)(F.ws + WS_POOL2), 1024, F.pool_scale}; \
        pg8::gemm_phase<EpiBf16Scale>(ldsl, g, S, E, F.wave); }
#define PH5_BODY { \
        pg8::Gemm g{(const bf16_t*)(F.ws + WS_ATTN), (const bf16_t*)(F.ws + WS_WAB), MTOK, DM, 2048, 1024, 0, (const bf16_t*)(F.ws + WS_POOL2), (const bf16_t*)(F.ws + WS_WPB), 16, 1024}; \
        pg8::StaticOrder S; S.init(MTOK, DM, F.G, F.bid); \
        EpiMerge E{(unsigned char*)R0, (const bf16_t*)(F.ws + WS_GA), (const bf16_t*)(F.ws + WS_GP)}; pg8::gemm_phase<EpiMerge>(ldsl, g, S, E, F.wave); }
#define PH6_BODY { \
        pg8::Gemm g{R0, (const bf16_t*)(F.ws + WS_WOUT), MTOK, DM, DM / 2, DM / 2, 0, nullptr, nullptr, 0, 0}; pg8::StaticOrder S; S.init(MTOK, DM, F.G, F.bid); \
        EpiResid E{F.x, F.out, (const float*)(F.ws + WS_MODF) + 4096}; pg8::gemm_phase<EpiResid, true>(ldsl, g, S, E, F.wave); }
#define PH8_BODY { \
        pg8::Gemm g{(const bf16_t*)(F.ws + WS_H2), (const bf16_t*)(F.ws + WS_WPQ), MTOK, DM, DM, DM, 0, nullptr, nullptr, 0, 0}; pg8::StaticOrder S; S.init(MTOK, DM, F.G, F.bid); \
        EpiBf16Scale E{R0, 2048, nullptr}; pg8::gemm_phase<EpiBf16Scale>(ldsl, g, S, E, F.wave); }
#define PH9_BODY { \
        pg8::Gemm g{R0, (const bf16_t*)(F.ws + WS_KEYSBD), MTOK, DM, 256, DM, 256, nullptr, nullptr, 0, 0}; pg8::StaticOrder S; S.init(MTOK, DM, F.G, F.bid); \
        EpiBf16Scale E{(bf16_t*)(F.ws + WS_SUB), 2048, nullptr}; pg8::gemm_phase<EpiBf16Scale>(ldsl, g, S, E, F.wave); }
#define REP(k) if constexpr (((PROBE_REP) >> (k)) & 1)

    if (IN(0)) { phase0_prep(F); REP(0) { __syncthreads(); phase0_prep(F); } }
    SEAM(0);
    if (IN(1)) { phase_modnorm<true>(F, F.x, F.g1, 0, 2048, R0, F.ws + WS_H1F8); REP(1) { phase_modnorm<true>(F, F.x, F.g1, 0, 2048, R0, F.ws + WS_H1F8); } }
    SEAM(1);
    if (IN(2)) { PH2_BODY REP(2) PH2_BODY }
    SEAM(2);
    if (IN(3)) { phase3_qknorm(F); PH3_BODY REP(3) PH3_BODY }
    SEAM(3);
    if (IN(4)) { PH4_BODY REP(4) PH4_BODY }
    SEAM(4);
    if (IN(5)) { PH5_BODY REP(5) PH5_BODY }
    SEAM(5);
    if (IN(6)) { PH6_BODY REP(6) PH6_BODY }
    SEAM(6);
    if (IN(7)) { phase_modnorm<false>(F, F.out, F.g2, 6144, 8192, (bf16_t*)(F.ws + WS_H2)); REP(7) { phase_modnorm<false>(F, F.out, F.g2, 6144, 8192, (bf16_t*)(F.ws + WS_H2)); } }
    SEAM(7);
    if (IN(8)) { PH8_BODY REP(8) PH8_BODY }
    SEAM(8);
    if (IN(9)) { PH9_BODY REP(9) PH9_BODY }
    SEAM(9);
    if (IN(10)) { phase10_peer(F); REP(10) phase10_peer(F); }
    SEAM(10);
    if (IN(11)) { REP(11) { phase11_peer_v(F, (float*)(F.ws + WS_SUB)); } phase11_peer_v(F, F.out); }
#undef IN
#undef SEAM
}

extern "C" void kernel_launch(void* const* d_in, const int* in_sizes, int n_in, void* d_out, int out_size, void* d_ws, size_t ws_size, hipStream_t stream) {
    static int grid = 0;
    if (grid == 0) {
        if (n_in != 19 || out_size != MTOK * DM || ws_size < WS_END) { fprintf(stderr, "kernel_launch: unexpected shapes (n_in %d out %d ws %zu)\n", n_in, out_size, ws_size); grid = -1; return; }
        int dev = 0, cus = 0, per_cu = 0;
        if (hipGetDevice(&dev) != hipSuccess || hipDeviceGetAttribute(&cus, hipDeviceAttributeMultiprocessorCount, dev) != hipSuccess) { grid = -1; return; }
        if (hipFuncSetAttribute((const void*)fwd_kernel, hipFuncAttributeMaxDynamicSharedMemorySize, LDS_BYTES) != hipSuccess) { fprintf(stderr, "kernel_launch: hipFuncSetAttribute failed\n"); grid = -1; return; }
        if (hipOccupancyMaxActiveBlocksPerMultiprocessor(&per_cu, (const void*)fwd_kernel, 512, LDS_BYTES) != hipSuccess || per_cu < 1) { fprintf(stderr, "kernel_launch: occupancy query says %d\n", per_cu); }
        (void)hipGetLastError();
        grid = cus;
    }
    if (grid < 0) return;
    (void)in_sizes;
    if (hipMemsetAsync((char*)d_ws + WS_CTL, 0, CTL_ZERO_BYTES, stream) != hipSuccess) return;
    Args a{};
    for (int i = 0; i < 19; ++i) a.in[i] = (const float*)d_in[i];
    a.out = (float*)d_out; a.ws = (unsigned char*)d_ws;
#if MK_PER_PHASE
    for (int p = 0; p < NPHASE; ++p) { a.ph_lo = p; a.ph_hi = p + 1; a.li = p; hipLaunchKernelGGL(fwd_kernel, dim3(grid), dim3(512), LDS_BYTES, stream, a); }
#else
    a.ph_lo = 0; a.ph_hi = NPHASE; a.li = 0;
    hipLaunchKernelGGL(fwd_kernel, dim3(grid), dim3(512), LDS_BYTES, stream, a);
#endif
}
```

```cpp
#include <hip/hip_runtime.h>
#include <cstdio>
#include <cstdint>

#ifndef MK_PER_PHASE
#define MK_PER_PHASE 0
#endif

#ifndef PROBE_REP
#define PROBE_REP 0
#endif
#ifndef PROBE_IDX
#define PROBE_IDX 0
#endif
#ifndef PROBE_P11X
#define PROBE_P11X 0
#endif
#define LAS __attribute__((address_space(3)))
typedef unsigned short bf16_t;
typedef short bf16x8 __attribute__((ext_vector_type(8)));
typedef float f32x4 __attribute__((ext_vector_type(4)));
typedef float f32x2 __attribute__((ext_vector_type(2)));
typedef int v2i __attribute__((ext_vector_type(2)));
typedef unsigned u32x4 __attribute__((ext_vector_type(4)));
typedef unsigned u32x2 __attribute__((ext_vector_type(2)));
typedef unsigned u32x6 __attribute__((ext_vector_type(6)));
typedef unsigned u32x16 __attribute__((ext_vector_type(16)));
typedef __bf16 bf16x32 __attribute__((ext_vector_type(32)));

constexpr int BATCH = 8, SEQ = 4096, DM = 2048, MTOK = BATCH * SEQ;
constexpr int NHEAD = 8, HDIM = 128, AW = 1024, KVW = 256, IHEADS = 16, IDIM = 64, KSEL = 256;
constexpr int PW = 1024, PHEADS = 8, NEXP = 16384;
constexpr int INW = 7760;
constexpr float EPS = 1e-6f;
constexpr int NPHASE = 12;

constexpr size_t MiB = 1u << 20;
constexpr size_t WS_CTL = 0, CTL_ZERO_BYTES = 256 * 1024;
constexpr size_t WS_MODP = 2 * MiB;
constexpr size_t WS_MODF = 4 * MiB;
constexpr size_t WS_POOLW = 5 * MiB;
constexpr size_t WS_KEYSBD = 6 * MiB;
constexpr size_t WS_WIN16 = 8 * MiB;
constexpr size_t WS_WIN8 = 20 * MiB;
constexpr size_t WS_WAB = 40 * MiB, WS_WPB = 44 * MiB, WS_WOUT = 48 * MiB, WS_WPQ = 56 * MiB;
constexpr size_t WS_PU = 64 * MiB, WS_PV = 128 * MiB;
constexpr size_t WS_R0 = 192 * MiB;
constexpr size_t WS_GA = 320 * MiB, WS_GP = 448 * MiB;
constexpr size_t WS_SUB = 320 * MiB;
constexpr size_t WS_QN = 576 * MiB;
constexpr size_t WS_IQ = 640 * MiB;
constexpr size_t WS_PL = 704 * MiB;
constexpr size_t WS_KN = 768 * MiB, WS_V = 784 * MiB;
constexpr size_t WS_IK = 800 * MiB;
constexpr size_t WS_IW = 804 * MiB;
constexpr size_t WS_SEL = 806 * MiB;
constexpr size_t WS_POOLED = 822 * MiB;
constexpr size_t WS_H2 = 886 * MiB;
constexpr size_t WS_END = 1014 * MiB;
constexpr size_t WS_H1F8 = WS_H2 + 64 * MiB;
constexpr size_t WS_Q8 = WS_H2, WS_K8 = WS_H2 + 32 * MiB, WS_V8 = WS_H2 + 40 * MiB;
constexpr size_t WS_ATTN = WS_IQ, WS_POOL2 = WS_PL, WS_PAIRS = WS_QN, WS_WLS = WS_QN + 32 * MiB;

constexpr int LDS_BYTES = 160 * 1024;
constexpr int MISC_OFF = 159 * 1024;

__device__ __forceinline__ unsigned cvt_pk_bf16(float lo, float hi) { unsigned r; asm volatile("v_cvt_pk_bf16_f32 %0, %1, %2" : "=v"(r) : "v"(lo), "v"(hi)); return r; }
__device__ __forceinline__ float bf_lo(unsigned w) { return __uint_as_float(w << 16); }
__device__ __forceinline__ float bf_hi(unsigned w) { return __uint_as_float(w & 0xffff0000u); }
template <int CTRL> __device__ __forceinline__ float dpp_f(float x) { return __int_as_float(__builtin_amdgcn_update_dpp(0, __float_as_int(x), CTRL, 0xF, 0xF, true)); }
#define DPP_XOR1 0xB1
#define DPP_XOR2 0x4E
#define DPP_HMIRROR 0x141
#define DPP_MIRROR 0x140
#define DPP_ROR8 0x128
__device__ __forceinline__ float xor16_sum(float x) { const auto r = __builtin_amdgcn_permlane16_swap(__float_as_uint(x), __float_as_uint(x), false, false); return __uint_as_float(r[0]) + __uint_as_float(r[1]); }
__device__ __forceinline__ float xor32_sum(float x) { const auto r = __builtin_amdgcn_permlane32_swap(__float_as_uint(x), __float_as_uint(x), false, false); return __uint_as_float(r[0]) + __uint_as_float(r[1]); }
__device__ __forceinline__ float xor16_max(float x) { const auto r = __builtin_amdgcn_permlane16_swap(__float_as_uint(x), __float_as_uint(x), false, false); return fmaxf(__uint_as_float(r[0]), __uint_as_float(r[1])); }
__device__ __forceinline__ float swap32_pair(float a, float b) { const auto r = __builtin_amdgcn_permlane32_swap(__float_as_uint(a), __float_as_uint(b), false, false); return __uint_as_float(r[0]) + __uint_as_float(r[1]); }
__device__ __forceinline__ float swap16_pair(float a, float b) { const auto r = __builtin_amdgcn_permlane16_swap(__float_as_uint(a), __float_as_uint(b), false, false); return __uint_as_float(r[0]) + __uint_as_float(r[1]); }
__device__ __forceinline__ float row_sum16(float v) { v += dpp_f<DPP_XOR1>(v); v += dpp_f<DPP_XOR2>(v); v += dpp_f<DPP_HMIRROR>(v); v += dpp_f<DPP_MIRROR>(v); return v; }
__device__ __forceinline__ float row_max16(float v) { v = fmaxf(v, dpp_f<DPP_XOR1>(v)); v = fmaxf(v, dpp_f<DPP_XOR2>(v)); v = fmaxf(v, dpp_f<DPP_HMIRROR>(v)); v = fmaxf(v, dpp_f<DPP_MIRROR>(v)); return v; }
__device__ __forceinline__ float wave_sum(float v) { return xor32_sum(xor16_sum(row_sum16(v))); }
__device__ __forceinline__ float sigmoidf_(float x) { return __builtin_amdgcn_rcpf(1.0f + __expf(-x)); }
__device__ __forceinline__ float dot8(u32x4 w, const float* h) {
    return bf_lo(w.x) * h[0] + bf_hi(w.x) * h[1] + bf_lo(w.y) * h[2] + bf_hi(w.y) * h[3] + bf_lo(w.z) * h[4] + bf_hi(w.z) * h[5] + bf_lo(w.w) * h[6] + bf_hi(w.w) * h[7];
}

__device__ __forceinline__ int lane_now() { int l; asm volatile("v_mbcnt_lo_u32_b32 %0, -1, 0\n\tv_mbcnt_hi_u32_b32 %0, -1, %0" : "=v"(l)); return l; }

#define XB_TMO      128
#define XB_XCNT(j)  (256  + 64 * (j))
#define XB_XSUB(j)  (1280 + 64 * (j))
#define XB_XGEN(j)  (2304 + 64 * (j))
#define XB_TOP      3328
#define XB_TOPGEN   3392
#define XCD_BAR_WORDS 3456
#define XB_SPIN_CAP (1u << 18)

__device__ __forceinline__ unsigned xb_ld(unsigned* p)              { return __hip_atomic_load(p, __ATOMIC_RELAXED, __HIP_MEMORY_SCOPE_AGENT); }
__device__ __forceinline__ unsigned xb_add(unsigned* p, unsigned v) { return __hip_atomic_fetch_add(p, v, __ATOMIC_RELAXED, __HIP_MEMORY_SCOPE_AGENT); }
__device__ __forceinline__ unsigned xb_xcc_id() { return (unsigned)__builtin_amdgcn_s_getreg((3 << 11) | 20) & 0xFu; }
#define XB_SPIN(cond, bar) do { unsigned _sp = 0; while (cond) { __builtin_amdgcn_s_sleep(1); \
    if ((++_sp & 255u) == 0u) { if (xb_ld(&(bar)[XB_TMO])) break; if (_sp > XB_SPIN_CAP) { atomicAdd(&(bar)[XB_TMO], 1u); break; } } } } while (0)

struct XcdBarrier { unsigned* bar; unsigned x; volatile LAS unsigned* st; };

__device__ __forceinline__ XcdBarrier xcd_barrier_post(unsigned* bar, volatile LAS unsigned* st) {
    XcdBarrier b; b.bar = bar; b.x = xb_xcc_id(); b.st = st;
    if (threadIdx.x == 0) (void)xb_add(&bar[XB_XCNT(b.x)], 1u);
    return b;
}
__device__ __forceinline__ void xcd_barrier_complete(unsigned* bar, unsigned x, unsigned& nloc, unsigned& nx) {
    const unsigned G = gridDim.x * gridDim.y * gridDim.z;
    unsigned sum, cnt, mine, sp = 0u;
    for (;;) {
        sum = 0u; cnt = 0u; mine = 0u;
#pragma unroll
        for (unsigned j = 0; j < 16; ++j) { const unsigned c = xb_ld(&bar[XB_XCNT(j)]); sum += c; cnt += (c > 0u) ? 1u : 0u; mine = (j == x) ? c : mine; }
        if (sum == G) break;
        __builtin_amdgcn_s_sleep(1);
        if ((++sp & 255u) == 0u) { if (xb_ld(&bar[XB_TMO])) break; if (sp > XB_SPIN_CAP) { atomicAdd(&bar[XB_TMO], 1u); break; } }
    }
    nloc = mine > 0u ? mine : 1u; nx = cnt > 0u ? cnt : 1u;
}
__device__ __forceinline__ void xcd_barrier(const XcdBarrier& b, int wave) {
    asm volatile("s_waitcnt vmcnt(0)" ::: "memory");
    __syncthreads();
    if (wave == 0 && lane_now() == 0) {
        unsigned* bar = b.bar;
        __builtin_amdgcn_s_waitcnt(0);
        unsigned nloc = b.st[0], nx = b.st[1];
        if (nloc == 0u) { xcd_barrier_complete(bar, b.x, nloc, nx); b.st[0] = nloc; b.st[1] = nx; }
        const unsigned old = xb_add(&bar[XB_XSUB(b.x)], 1u);
        const unsigned gen = old / nloc;
        if (old + 1u == (gen + 1u) * nloc) {
            __builtin_amdgcn_fence(__ATOMIC_RELEASE, "agent");
            asm volatile("s_waitcnt vmcnt(0)" ::: "memory");
            const unsigned og = xb_add(&bar[XB_TOP], 1u);
            const unsigned tg = og / nx;
            if (og + 1u == (tg + 1u) * nx) xb_add(&bar[XB_TOPGEN], 1u);
            else XB_SPIN(xb_ld(&bar[XB_TOPGEN]) == tg, bar);
            __builtin_amdgcn_fence(__ATOMIC_ACQUIRE, "agent");
            xb_add(&bar[XB_XGEN(b.x)], 1u);
            asm volatile("s_waitcnt vmcnt(0)" ::: "memory");
        } else {
            XB_SPIN(xb_ld(&bar[XB_XGEN(b.x)]) == gen, bar);
            __builtin_amdgcn_fence(__ATOMIC_ACQUIRE, "agent");
            asm volatile("s_waitcnt vmcnt(0)" ::: "memory");
        }
    }
    __syncthreads();
}

namespace pg8 {
constexpr int BM = 256, BK = 64, HALF = 128, HTB = HALF * BK * 2, STAGE_BYTES = 8 * HTB, NXCD = 8, WGM = 8;
__device__ __forceinline__ int lds_byte(int r, int c) { const int st = (r >> 4) * 2 + (c >> 5), rr = r & 15, cc = c & 31, ob = rr * 64 + cc * 2; return st * 1024 + (ob ^ (((ob >> 9) & 1) << 5)); }
__device__ __forceinline__ void stage_rc(int b, int& R, int& C) { const int st = b / 1024, sb = b % 1024, swz = sb ^ (((sb >> 9) & 1) << 5); R = (st >> 1) * 16 + swz / 64; C = (st & 1) * 32 + (swz % 64) / 2; }
__device__ __forceinline__ int perm32(int rho) { const int n = rho >> 4, i = rho & 15; return 8 * (i >> 2) + 4 * n + (i & 3); }

struct Unit { int pm, pn; };
struct Gemm { const bf16_t* A; const bf16_t* Bt; int M, N, K, lda, a_pn_off; const bf16_t* A2; const bf16_t* Bt2; int ksplit, ldb; };

struct StaticOrder {
    int nM, nN, nwg, G, c;
    __device__ void init(int M, int N, int G_, int c_) { nM = M / BM; nN = N / BM; nwg = nM * nN; G = G_; c = c_; }
    __device__ bool next(int i, Unit& u) const {
        const long L = (long)i * G + c; if (L >= nwg) return false;
        int wgid = (int)L; { const int q = nwg / NXCD, r = nwg % NXCD, xcd = wgid % NXCD, off = wgid / NXCD; wgid = (xcd < r ? xcd * (q + 1) : r * (q + 1) + (xcd - r) * q) + off; }
        const int nig = WGM * nN, gid = wgid / nig, fm = gid * WGM, gsz = (nM - fm) < WGM ? (nM - fm) : WGM;
        u.pm = fm + ((wgid % nig) % gsz); u.pn = (wgid % nig) / gsz; return true;
    }
};

typedef int i32x4 __attribute__((ext_vector_type(4)));
typedef int i32x8 __attribute__((ext_vector_type(8)));
__device__ __forceinline__ bf16x8 lo8(i32x8 v) { return __builtin_bit_cast(bf16x8, (i32x4){v.s0, v.s1, v.s2, v.s3}); }
__device__ __forceinline__ bf16x8 hi8(i32x8 v) { return __builtin_bit_cast(bf16x8, (i32x4){v.s4, v.s5, v.s6, v.s7}); }
__device__ __forceinline__ i32x8 cat8(bf16x8 a, bf16x8 b) { const i32x4 x = __builtin_bit_cast(i32x4, a), y = __builtin_bit_cast(i32x4, b); return (i32x8){x.x, x.y, x.z, x.w, y.x, y.y, y.z, y.w}; }
template <class Epi, bool F8 = false>
__device__ __forceinline__ void gemm_phase(LAS unsigned char* lds, const Gemm g, const StaticOrder& S, const Epi& E, int wave) {
    const int lane = lane_now(), wid = wave, tid = wid * 64 + lane, wr = wid >> 2, wc = wid & 3, fr = lane & 15, fq = lane >> 4;
    const int K = g.K, nt = K / BK, lda = g.lda, ldb = g.ldb ? g.ldb : g.K, ksplit = g.ksplit;
    unsigned voffA, voffB;
    { int R, C; stage_rc(tid * 16, R, C); const int Rb = Epi::PERM ? ((R & ~31) + perm32(R & 31)) : R;
      voffA = (unsigned)(R * lda + C) * 2u; voffB = (unsigned)(Rb * ldb + C) * 2u; }
    const unsigned stepA = 64u * (unsigned)lda * 2u, stepB = 64u * (unsigned)ldb * 2u;
    const size_t kstep = (size_t)(BK * 2);
    const size_t hsA = (size_t)HALF * lda * 2, hsB = (size_t)HALF * ldb * 2;
    const size_t tsA = 2 * hsA, tsB = 2 * hsB;
    const unsigned ldsw = (unsigned)wid * 1024u, ldsbase = (unsigned)(unsigned long long)lds;
    const int aoff = lds_byte(wr * 64 + fr, fq * 8), boff = lds_byte(wc * 32 + fr, fq * 8);
#define PG8_SA(b, h) (((b) * 2 + (h)) * HTB)
#define PG8_SB(b, h) ((4 + (b) * 2 + (h)) * HTB)
#define PG8_STAGE(bufoff, gbase, voff) do { _Pragma("unroll") for (int _i = 0; _i < 2; ++_i) { \
        const char* sb_ = (const char*)(gbase) + (size_t)_i * PG8_STEP_##voff; const unsigned m0_ = ldsbase + (unsigned)(bufoff) + ldsw + (unsigned)_i * 8192u; \
        asm volatile("s_mov_b32 m0, %2\n\ts_nop 0\n\tglobal_load_lds_dwordx4 %0, %1" :: "v"(voff), "s"(sb_), "s"(m0_) : "memory"); } } while (0)
#define PG8_STEP_voffA stepA
#define PG8_STEP_voffB stepB
#define PG8_LDA(dst, b, h) do { _Pragma("unroll") for (int m = 0; m < 4; ++m) dst[m] = cat8(*(const LAS bf16x8*)(lds + PG8_SA(b, h) + aoff + m * 2048), *(const LAS bf16x8*)(lds + PG8_SA(b, h) + aoff + m * 2048 + 1024)); } while (0)
#define PG8_LDB(dst, b, h) do { _Pragma("unroll") for (int n = 0; n < 2; ++n) dst[n] = cat8(*(const LAS bf16x8*)(lds + PG8_SB(b, h) + boff + n * 2048), *(const LAS bf16x8*)(lds + PG8_SB(b, h) + boff + n * 2048 + 1024)); } while (0)
#define PG8_MMA(ai, bj, At, Bt) do { __builtin_amdgcn_s_setprio(1); _Pragma("unroll") for (int m = 0; m < 4; ++m) _Pragma("unroll") for (int n = 0; n < 2; ++n) { \
        if constexpr (F8) acc[ai][bj][m][n] = __builtin_amdgcn_mfma_scale_f32_16x16x128_f8f6f4(Bt[n], At[m], acc[ai][bj][m][n], 0, 0, 0, 0x7D7D7D7D  , 0, 0x7D7D7D7D); \
        else { acc[ai][bj][m][n] = __builtin_amdgcn_mfma_f32_16x16x32_bf16(lo8(Bt[n]), lo8(At[m]), acc[ai][bj][m][n], 0, 0, 0); \
               acc[ai][bj][m][n] = __builtin_amdgcn_mfma_f32_16x16x32_bf16(hi8(Bt[n]), hi8(At[m]), acc[ai][bj][m][n], 0, 0, 0); } } \
        __builtin_amdgcn_s_setprio(0); } while (0)
#define PG8_WAIT_V(n) asm volatile("s_waitcnt vmcnt(" #n ")" ::: "memory")
#define PG8_WAIT_L(n) asm volatile("s_waitcnt lgkmcnt(" #n ")" ::: "memory")
#define PG8_BAR __builtin_amdgcn_s_barrier()
#define PG8_SCHED __builtin_amdgcn_sched_barrier(0)
    Unit cur, nxt; int ui = 0;
    if (!S.next(0, cur)) return;
    f32x4 acc[2][2][4][2];
#pragma unroll
    for (int a = 0; a < 2; ++a)
#pragma unroll
        for (int b = 0; b < 2; ++b)
#pragma unroll
            for (int m = 0; m < 4; ++m)
#pragma unroll
                for (int n = 0; n < 2; ++n) acc[a][b][m][n] = (f32x4){0.f, 0.f, 0.f, 0.f};
    i32x8 At[4], B0[2], B1[2];
    const char* cA = (const char*)g.A + (size_t)cur.pm * tsA + (size_t)cur.pn * g.a_pn_off * 2; const char* cB = (const char*)g.Bt + (size_t)cur.pn * tsB;
    PG8_STAGE(PG8_SB(0, 0), cB, voffB); PG8_STAGE(PG8_SB(0, 1), cB + hsB, voffB); PG8_STAGE(PG8_SA(0, 0), cA, voffA); PG8_STAGE(PG8_SA(0, 1), cA + hsA, voffA);
    if (wr == 1) PG8_BAR;
    PG8_WAIT_V(2); PG8_BAR;
    PG8_STAGE(PG8_SB(1, 0), cB + kstep, voffB); PG8_STAGE(PG8_SA(1, 0), cA + kstep, voffA); PG8_STAGE(PG8_SB(1, 1), cB + hsB + kstep, voffB);
    PG8_WAIT_V(6); PG8_BAR;
    for (;;) {
        const bool has_next = S.next(ui + 1, nxt);
        const char* nA = has_next ? (const char*)g.A + (size_t)nxt.pm * tsA + (size_t)nxt.pn * g.a_pn_off * 2 : cA; const char* nB = has_next ? (const char*)g.Bt + (size_t)nxt.pn * tsB : cB;
        const char* cA2 = (const char*)g.A2 + (size_t)cur.pm * tsA; const char* cB2 = (const char*)g.Bt2 + (size_t)cur.pn * tsB;
#pragma clang loop unroll(disable)
        for (int t = 0; t < nt; t += 2) {
            const bool last = (t == nt - 2);
            const bool s1 = ksplit && (t >= ksplit), s2 = ksplit && (t + 2 >= ksplit);
            const char* a1 = (s1 ? cA2 + (size_t)(t - ksplit + 1) * kstep : cA + (size_t)(t + 1) * kstep);
            const char* a2 = last ? nA : (s2 ? cA2 + (size_t)(t + 2 - ksplit) * kstep : cA + (size_t)(t + 2) * kstep);
            const char* b2 = last ? nB : (s2 ? cB2 + (size_t)(t + 2 - ksplit) * kstep : cB + (size_t)(t + 2) * kstep);
            const char* a3 = a2 + kstep; const char* b3 = b2 + kstep;
            PG8_LDB(B0, 0, 0); PG8_LDB(B1, 0, 1); PG8_SCHED; PG8_LDA(At, 0, 0); PG8_STAGE(PG8_SA(1, 1), a1 + hsA, voffA);
            PG8_WAIT_V(8); PG8_WAIT_L(0); PG8_BAR; PG8_MMA(0, 0, At, B0); PG8_MMA(0, 1, At, B1); PG8_BAR; PG8_SCHED;
            PG8_LDA(At, 0, 1); PG8_STAGE(PG8_SB(0, 0), b2, voffB); PG8_STAGE(PG8_SB(0, 1), b2 + hsB, voffB); PG8_STAGE(PG8_SA(0, 0), a2, voffA);
            PG8_WAIT_V(8); PG8_WAIT_L(0); PG8_BAR; PG8_MMA(1, 0, At, B0); PG8_MMA(1, 1, At, B1); PG8_BAR; PG8_SCHED;
            PG8_LDB(B0, 1, 0); PG8_LDB(B1, 1, 1); PG8_SCHED; PG8_LDA(At, 1, 0); PG8_STAGE(PG8_SA(0, 1), a2 + hsA, voffA);
            PG8_WAIT_V(8); PG8_WAIT_L(0); PG8_BAR; PG8_MMA(0, 0, At, B0); PG8_MMA(0, 1, At, B1); PG8_BAR; PG8_SCHED;
            PG8_LDA(At, 1, 1); PG8_STAGE(PG8_SB(1, 0), b3, voffB); PG8_STAGE(PG8_SB(1, 1), b3 + hsB, voffB); PG8_STAGE(PG8_SA(1, 0), a3, voffA);
            PG8_WAIT_V(8); PG8_WAIT_L(0); PG8_BAR; PG8_MMA(1, 0, At, B0); PG8_MMA(1, 1, At, B1); PG8_BAR; PG8_SCHED;
            if constexpr (Epi::MID) { if (t + 2 == ksplit) E.mid(acc, cur, wr, wc, fr, fq); }
        }
        if (wr == 0) PG8_BAR;
        { const int l2 = lane_now(); E(acc, cur, wr, wc, l2 & 15, l2 >> 4); }
        if (!has_next) break;
#pragma unroll
        for (int a = 0; a < 2; ++a)
#pragma unroll
            for (int b = 0; b < 2; ++b)
#pragma unroll
                for (int m = 0; m < 4; ++m)
#pragma unroll
                    for (int n = 0; n < 2; ++n) acc[a][b][m][n] = (f32x4){0.f, 0.f, 0.f, 0.f};
        cur = nxt; cA = nA; cB = nB; ++ui;
        if (wr == 1) PG8_BAR;
    }
    PG8_WAIT_V(0);
    PG8_BAR;
#undef PG8_SA
#undef PG8_SB
#undef PG8_STAGE
#undef PG8_STEP_voffA
#undef PG8_STEP_voffB
#undef PG8_LDA
#undef PG8_LDB
#undef PG8_MMA
#undef PG8_WAIT_V
#undef PG8_WAIT_L
#undef PG8_BAR
#undef PG8_SCHED
}
}
using pg8::Unit;

typedef f32x4 AccT[2][2][4][2];
__device__ __forceinline__ u32x4 pack8(f32x4 a, f32x4 b) { u32x4 w; w.x = cvt_pk_bf16(a[0], a[1]); w.y = cvt_pk_bf16(a[2], a[3]); w.z = cvt_pk_bf16(b[0], b[1]); w.w = cvt_pk_bf16(b[2], b[3]); return w; }
__device__ __forceinline__ u32x2 pack8_fp8(f32x4 a, f32x4 b) {
    int w0 = __builtin_amdgcn_cvt_pk_fp8_f32(a[0], a[1], 0, false); w0 = __builtin_amdgcn_cvt_pk_fp8_f32(a[2], a[3], w0, true);
    int w1 = __builtin_amdgcn_cvt_pk_fp8_f32(b[0], b[1], 0, false); w1 = __builtin_amdgcn_cvt_pk_fp8_f32(b[2], b[3], w1, true);
    return (u32x2){(unsigned)w0, (unsigned)w1};
}
__device__ __forceinline__ void unpack8(u32x4 w, f32x4& a, f32x4& b) { a = (f32x4){bf_lo(w.x), bf_hi(w.x), bf_lo(w.y), bf_hi(w.y)}; b = (f32x4){bf_lo(w.z), bf_hi(w.z), bf_lo(w.w), bf_hi(w.w)}; }

template <bool SET8> struct EpiInproj {
    static constexpr bool PERM = true, MID = false;
    bf16_t *q, *k, *v, *iq, *ik, *pl, *ga, *gp; float* iw;
    __device__ __forceinline__ void operator()(const AccT& acc, const Unit& u, int wr, int wc, int fr, int fq) const {
        const int pn = u.pn, row0 = u.pm * 256 + wr * 64 + fr;
        if (!SET8 && pn == 4) {
            if (wc < 2) {
#pragma unroll
                for (int ai = 0; ai < 2; ++ai)
#pragma unroll
                    for (int m = 0; m < 4; ++m) { const size_t row = (size_t)(row0 + ai * 128 + m * 16);
                        *(u32x4*)(ik + row * 64 + wc * 32 + 8 * fq) = pack8(acc[ai][0][m][0], acc[ai][0][m][1]); }
            } else if (wc == 2) {
                if (fq < 2) {
#pragma unroll
                    for (int ai = 0; ai < 2; ++ai)
#pragma unroll
                        for (int m = 0; m < 4; ++m) { const size_t row = (size_t)(row0 + ai * 128 + m * 16);
                            *(f32x4*)(iw + row * 16 + 8 * fq) = acc[ai][0][m][0]; *(f32x4*)(iw + row * 16 + 8 * fq + 4) = acc[ai][0][m][1]; }
                }
            }
            return;
        }
        bf16_t* dst; int ld, tc; bool sg = false;
        if (SET8) {
            if (pn < 4) { dst = q; ld = 1024; tc = pn * 256; }
            else if (pn == 4) { dst = k; ld = 256; tc = 0; }
            else if (pn == 5) { dst = v; ld = 256; tc = 0; }
            else if (pn < 14) { dst = ga; ld = 2048; tc = (pn - 6) * 256; sg = true; }
            else { dst = gp; ld = 2048; tc = (pn - 14) * 256; sg = true; }
        } else {
            if (pn < 4) { dst = iq; ld = 1024; tc = pn * 256; }
            else { dst = pl; ld = 1024; tc = (pn - 5) * 256; }
        }
        const int col0 = tc + wc * 32 + 8 * fq;
#pragma unroll
        for (int ai = 0; ai < 2; ++ai)
#pragma unroll
            for (int m = 0; m < 4; ++m) { bf16_t* rowp = dst + (size_t)(row0 + ai * 128 + m * 16) * ld + col0;
#pragma unroll
                for (int bj = 0; bj < 2; ++bj) { f32x4 v0 = acc[ai][bj][m][0], v1 = acc[ai][bj][m][1];
                    if (sg) {
#pragma unroll
                        for (int j = 0; j < 4; ++j) { v0[j] = sigmoidf_(v0[j]); v1[j] = sigmoidf_(v1[j]); } }
                    *(u32x4*)(rowp + bj * 128) = pack8(v0, v1); } }
    }
};
struct EpiBf16Scale {
    static constexpr bool PERM = true, MID = false;
    bf16_t* O; int ldc; const float* cs;
    __device__ __forceinline__ void operator()(const AccT& acc, const Unit& u, int wr, int wc, int fr, int fq) const {
        const int row0 = u.pm * 256 + wr * 64 + fr, col0 = u.pn * 256 + wc * 32 + 8 * fq;
        f32x4 s[2][2];
#pragma unroll
        for (int bj = 0; bj < 2; ++bj)
#pragma unroll
            for (int n = 0; n < 2; ++n) s[bj][n] = cs ? *(const f32x4*)(cs + col0 + bj * 128 + 4 * n) : (f32x4){1.f, 1.f, 1.f, 1.f};
#pragma unroll
        for (int ai = 0; ai < 2; ++ai)
#pragma unroll
            for (int m = 0; m < 4; ++m) { bf16_t* rowp = O + (size_t)(row0 + ai * 128 + m * 16) * ldc + col0;
#pragma unroll
                for (int bj = 0; bj < 2; ++bj) *(u32x4*)(rowp + bj * 128) = pack8(acc[ai][bj][m][0] * s[bj][0], acc[ai][bj][m][1] * s[bj][1]); }
    }
};
template <bool ADD> struct EpiGate {
    static constexpr bool PERM = true, MID = false;
    bf16_t* O; const bf16_t* gate;
    __device__ __forceinline__ void operator()(const AccT& acc, const Unit& u, int wr, int wc, int fr, int fq) const {
        const int row0 = u.pm * 256 + wr * 64 + fr, col0 = u.pn * 256 + wc * 32 + 8 * fq;
#pragma unroll
        for (int ai = 0; ai < 2; ++ai)
#pragma unroll
            for (int m = 0; m < 4; ++m) { const size_t off = (size_t)(row0 + ai * 128 + m * 16) * 2048 + col0;
#pragma unroll
                for (int bj = 0; bj < 2; ++bj) { f32x4 g0, g1; unpack8(*(const u32x4*)(gate + off + bj * 128), g0, g1);
                    f32x4 r0 = g0 * acc[ai][bj][m][0], r1 = g1 * acc[ai][bj][m][1];
                    if (ADD) { f32x4 o0, o1; unpack8(*(const u32x4*)(O + off + bj * 128), o0, o1); r0 += o0; r1 += o1; }
                    *(u32x4*)(O + off + bj * 128) = pack8(r0, r1); } }
    }
};
struct EpiMerge {
    static constexpr bool PERM = true, MID = true;
    unsigned char* O; const bf16_t* ga; const bf16_t* gp;
    __device__ __forceinline__ void mid(AccT& acc, const Unit& u, int wr, int wc, int fr, int fq) const {
        const auto ra = __builtin_amdgcn_make_buffer_rsrc((void*)ga, 0, 0x7FFFFFFF, 0x00020000), rp = __builtin_amdgcn_make_buffer_rsrc((void*)gp, 0, 0x7FFFFFFF, 0x00020000);
        const int voff = ((wr * 64 + fr) * 2048 + wc * 32 + 8 * fq) * 2;
        const int sbase = (u.pm * 256 * 2048 + u.pn * 256) * 2;
#pragma unroll
        for (int ai = 0; ai < 2; ++ai)
#pragma unroll
            for (int m = 0; m < 4; ++m)
#pragma unroll
                for (int bj = 0; bj < 2; ++bj) { const int so = sbase + ((ai * 128 + m * 16) * 2048 + bj * 128) * 2;
                    const u32x4 wa = __builtin_bit_cast(u32x4, __builtin_amdgcn_raw_buffer_load_b128(ra, voff, so, 0)), wp = __builtin_bit_cast(u32x4, __builtin_amdgcn_raw_buffer_load_b128(rp, voff, so, 0));
                    f32x4 a0, a1, p0, p1; unpack8(wa, a0, a1); unpack8(wp, p0, p1);
#pragma unroll
                    for (int j = 0; j < 4; ++j) { acc[ai][bj][m][0][j] *= a0[j] * __builtin_amdgcn_rcpf(p0[j]); acc[ai][bj][m][1][j] *= a1[j] * __builtin_amdgcn_rcpf(p1[j]); }
                    asm volatile("" : "+v"(acc[ai][bj][m][0]), "+v"(acc[ai][bj][m][1]) :: "memory"); }
    }
    __device__ __forceinline__ void operator()(const AccT& acc, const Unit& u, int wr, int wc, int fr, int fq) const {
        const int row0 = u.pm * 256 + wr * 64 + fr, col0 = u.pn * 256 + wc * 32 + 8 * fq;
#pragma unroll
        for (int ai = 0; ai < 2; ++ai)
#pragma unroll
            for (int m = 0; m < 4; ++m) { const size_t off = (size_t)(row0 + ai * 128 + m * 16) * 2048 + col0;
#pragma unroll
                for (int bj = 0; bj < 2; ++bj) { f32x4 p0, p1; unpack8(*(const u32x4*)(gp + off + bj * 128), p0, p1);
                    *(u32x2*)(O + off + bj * 128) = pack8_fp8(p0 * acc[ai][bj][m][0], p1 * acc[ai][bj][m][1]); } }
    }
};
struct EpiResid {
    static constexpr bool PERM = false, MID = false;
    const float* x; float* out; const float* gt;
    __device__ __forceinline__ void operator()(const AccT& acc, const Unit& u, int wr, int wc, int fr, int fq) const {
        const int row0 = u.pm * 256 + wr * 64 + fr, col0 = u.pn * 256 + wc * 32 + 4 * fq;
        const float* gtb = gt + (size_t)(u.pm / 16) * 12288;
        f32x4 g[2][2];
#pragma unroll
        for (int bj = 0; bj < 2; ++bj)
#pragma unroll
            for (int n = 0; n < 2; ++n) g[bj][n] = *(const f32x4*)(gtb + col0 + bj * 128 + n * 16);
#pragma unroll
        for (int ai = 0; ai < 2; ++ai)
#pragma unroll
            for (int m = 0; m < 4; ++m) { const size_t off = (size_t)(row0 + ai * 128 + m * 16) * 2048 + col0;
#pragma unroll
                for (int bj = 0; bj < 2; ++bj)
#pragma unroll
                    for (int n = 0; n < 2; ++n) { const f32x4 xv = *(const f32x4*)(x + off + bj * 128 + n * 16);
                        *(f32x4*)(out + off + bj * 128 + n * 16) = xv + g[bj][n] * acc[ai][bj][m][n]; } }
    }
};
struct EpiF32 {
    static constexpr bool PERM = false, MID = false;
    float* C; int ldc;
    __device__ __forceinline__ void operator()(const AccT& acc, const Unit& u, int wr, int wc, int fr, int fq) const {
        const int row0 = u.pm * 256 + wr * 64 + fr, col0 = u.pn * 256 + wc * 32 + 4 * fq;
#pragma unroll
        for (int ai = 0; ai < 2; ++ai)
#pragma unroll
            for (int m = 0; m < 4; ++m) { float* rowp = C + (size_t)(row0 + ai * 128 + m * 16) * ldc + col0;
#pragma unroll
                for (int bj = 0; bj < 2; ++bj)
#pragma unroll
                    for (int n = 0; n < 2; ++n) *(f32x4*)(rowp + bj * 128 + n * 16) = acc[ai][bj][m][n]; }
    }
};

struct Args { const float* in[19]; float* out; unsigned char* ws; int ph_lo, ph_hi; int li, pad; };
struct Frame {
    unsigned char* lds; unsigned char* ws;
    int tid, lane, wave, G, bid;
    const float *x, *c, *w_ada, *b_ada, *g1, *g2, *w_in, *g_q, *g_k, *rel_bias, *pool_w, *pool_scale, *w_ab, *w_pb, *w_out, *w_pq, *peer_keys, *peer_u, *peer_v;
    float* out;
};

template <bool F8OUT = false, class Fn> __device__ __forceinline__ void transpose_item(const float* W, int K, int N, void* WTv, int ldk, int drow0, int k0, float* scr, int lane, Fn srccol, float mul = 1.0f) {
    const int sc = srccol(drow0 + (lane & 31));
#pragma unroll 8
    for (int i = 0; i < 32; ++i) { const int kk = 2 * i + (lane >> 5); scr[kk * 33 + (lane & 31)] = sc >= 0 ? W[(size_t)(k0 + kk) * N + sc] * mul : 0.f; }
    asm volatile("s_waitcnt lgkmcnt(0)" ::: "memory");
    const int c = lane & 7;
#pragma unroll
    for (int j = 0; j < 4; ++j) { const int n = (lane >> 3) + 8 * j; const float* s = scr + (8 * c) * 33 + n;
        if constexpr (F8OUT) { *(u32x2*)((unsigned char*)WTv + (size_t)(drow0 + n) * ldk + k0 + 8 * c) = pack8_fp8((f32x4){s[0 * 33], s[1 * 33], s[2 * 33], s[3 * 33]}, (f32x4){s[4 * 33], s[5 * 33], s[6 * 33], s[7 * 33]}); }
        else { u32x4 o; o.x = cvt_pk_bf16(s[0 * 33], s[1 * 33]); o.y = cvt_pk_bf16(s[2 * 33], s[3 * 33]); o.z = cvt_pk_bf16(s[4 * 33], s[5 * 33]); o.w = cvt_pk_bf16(s[6 * 33], s[7 * 33]);
            *(u32x4*)((bf16_t*)WTv + (size_t)(drow0 + n) * ldk + k0 + 8 * c) = o; } }
    asm volatile("s_waitcnt lgkmcnt(0)" ::: "memory");
}
__device__ __forceinline__ void phase0_prep(Frame& F) {
    F.lane = lane_now(); F.tid = F.wave * 64 + F.lane;
    const int gw = F.bid * 8 + F.wave, NGW = F.G * 8;
    float* scr = (float*)(F.lds + F.wave * 16384);
    constexpr int I_IN16 = (2304 / 32) * (DM / 64), I_IN8 = (5632 / 32) * (DM / 64);
    constexpr int I_AB = (2048 / 32) * (1024 / 64), I_OUT = (2048 / 32) * (2048 / 64), I_PW = 4 * 8 * 4;
    constexpr int NIT = I_IN16 + I_IN8 + 2 * I_AB + 2 * I_OUT + I_PW;
    auto ident = [](int j) { return j; };
    for (int it = gw; it < NIT; it += NGW) {
        int r = it;
        if (r < I_IN16) { const int nb = r % 72, kb = r / 72;
            transpose_item(F.w_in, DM, INW, F.ws + WS_WIN16, DM, nb * 32, kb * 64, scr, F.lane, [](int j) { return j < 1104 ? j + 1536 : (j < 1280 ? -1 : j + 1360); }); continue; }
        r -= I_IN16;
        if (r < I_IN8) { const int nb = r % 176, kb = r / 176;
            transpose_item<true>(F.w_in, DM, INW, F.ws + WS_WIN8, DM, nb * 32, kb * 64, scr, F.lane, [](int j) { return j < 1536 ? j : j + 2128; }, 16.0f); continue; }
        r -= I_IN8;
        if (r < I_AB) { transpose_item(F.w_ab, 1024, 2048, (bf16_t*)(F.ws + WS_WAB), 1024, (r % 64) * 32, (r / 64) * 64, scr, F.lane, ident); continue; }
        r -= I_AB;
        if (r < I_AB) { transpose_item(F.w_pb, 1024, 2048, (bf16_t*)(F.ws + WS_WPB), 1024, (r % 64) * 32, (r / 64) * 64, scr, F.lane, ident); continue; }
        r -= I_AB;
        if (r < I_OUT) { transpose_item<true>(F.w_out, 2048, 2048, F.ws + WS_WOUT, 2048, (r % 64) * 32, (r / 64) * 64, scr, F.lane, ident, 16.0f); continue; }
        r -= I_OUT;
        if (r < I_OUT) { transpose_item(F.w_pq, 2048, 2048, (bf16_t*)(F.ws + WS_WPQ), 2048, (r % 64) * 32, (r / 64) * 64, scr, F.lane, ident); continue; }
        r -= I_OUT;
        { const int g = r / 32, q = r % 32, nb = q % 8, kb = q / 8;
          transpose_item(F.pool_w + (size_t)g * 65536, 256, 256, (bf16_t*)(F.ws + WS_POOLW) + (size_t)g * 65536, 256, nb * 32, kb * 64, scr, F.lane, ident); }
    }
    {
        bf16_t* kb = (bf16_t*)(F.ws + WS_KEYSBD);
        for (int i = F.bid * 512 + F.tid; i < 2048 * 32; i += F.G * 512) {
            const int row = i / 32, k8 = (i % 32) * 8, p = (row >> 7) & 1;
            u32x4 o = (u32x4){0u, 0u, 0u, 0u};
            if ((k8 >> 7) == p) { const float* s = F.peer_keys + (size_t)row * 128 + (k8 & 127); const f32x4 a = *(const f32x4*)s, b = *(const f32x4*)(s + 4); o = pack8(a, b); }
            *(u32x4*)(kb + (size_t)row * 256 + k8) = o;
        }
    }
    {
        unsigned char* pu = F.ws + WS_PU;
        for (size_t i = (size_t)F.bid * 512 + F.tid; i < (size_t)NEXP * 64; i += (size_t)F.G * 512) {
            const float* src = F.peer_u + i * 32;
            u32x16 pk;
#pragma unroll
            for (int k = 0; k < 8; ++k) { const f32x4 a = *(const f32x4*)(src + k * 4) * 96.0f; pk[2 * k] = cvt_pk_bf16(a[0], a[1]); pk[2 * k + 1] = cvt_pk_bf16(a[2], a[3]); }
            const u32x6 p6 = __builtin_amdgcn_cvt_scalef32_pk32_fp6_bf16(__builtin_bit_cast(bf16x32, pk), 1.0f);
            const int ci = (int)(i & 63), lp = (ci >> 2) + 16 * (ci & 3);
            unsigned char* dst = pu + (i >> 6) * 1536;
            *(u32x4*)(dst + lp * 16) = (u32x4){p6[0], p6[1], p6[2], p6[3]}; *(u32x2*)(dst + 1024 + lp * 8) = (u32x2){p6[4], p6[5]};
        }
        unsigned char* pv = F.ws + WS_PV;
        for (int it = gw; it < (NEXP / 64) * 128; it += NGW) {
            const int e = (it >> 7) * 64 + F.lane, ch = it & 127;
            u32x4 ov;
#pragma unroll
            for (int k = 0; k < 4; ++k) { const f32x4 c = *(const f32x4*)(F.peer_v + (size_t)e * DM + ch * 16 + k * 4) * 4.0f;
                int wv = __builtin_amdgcn_cvt_pk_fp8_f32(c[0], c[1], 0, false); wv = __builtin_amdgcn_cvt_pk_fp8_f32(c[2], c[3], wv, true); ov[k] = (unsigned)wv; }
            *(u32x2*)(pv + ((size_t)(2 * ch) * NEXP + e) * 8) = (u32x2){ov[0], ov[1]};
            *(u32x2*)(pv + ((size_t)(2 * ch + 1) * NEXP + e) * 8) = (u32x2){ov[2], ov[3]};
        }
    }
    {
        __syncthreads();
        float* cact = (float*)(F.lds + 131072);
        float* red = (float*)F.lds;
        float* mp = (float*)(F.ws + WS_MODP);
        for (int it = F.bid; it < 48 * 4; it += F.G) {
            const int cb = it % 48, ds = it / 48, d0 = ds * 512;
            for (int i = F.tid; i < 8 * 512; i += 512) { const int b = i >> 9, d = i & 511; const float cv = F.c[b * DM + d0 + d]; cact[i] = cv * sigmoidf_(cv); }
            __syncthreads();
            f32x4 a[8];
#pragma unroll
            for (int b = 0; b < 8; ++b) a[b] = (f32x4){0.f, 0.f, 0.f, 0.f};
            const float* wp = F.w_ada + (size_t)(d0 + F.wave * 64) * 12288 + cb * 256 + F.lane * 4;
#pragma unroll 4
            for (int d = 0; d < 64; ++d) { const f32x4 w = *(const f32x4*)(wp + (size_t)d * 12288);
#pragma unroll
                for (int b = 0; b < 8; ++b) a[b] += w * cact[b * 512 + F.wave * 64 + d]; }
#pragma unroll
            for (int b = 0; b < 8; ++b)
#pragma unroll
                for (int j = 0; j < 4; ++j) red[(F.wave * 32 + b * 4 + j) * 64 + F.lane] = a[b][j];
            __syncthreads();
            for (int i = F.tid; i < 2048; i += 512) { const int v = i >> 6, l = i & 63; float s = 0.f;
#pragma unroll
                for (int w = 0; w < 8; ++w) s += red[(w * 32 + v) * 64 + l];
                mp[((size_t)ds * 8 + (v >> 2)) * 12288 + cb * 256 + l * 4 + (v & 3)] = s; }
            __syncthreads();
        }
    }
}

template <bool FIRST> __device__ __forceinline__ void phase_modnorm(Frame& F, const float* xin, const float* gain, int off_sh, int off_sc, bf16_t* dst, unsigned char* dst8 = nullptr) {
    F.lane = lane_now(); F.tid = F.wave * 64 + F.lane;
    const float* mp = (const float*)(F.ws + WS_MODP); float* mf = (float*)(F.ws + WS_MODF);
    if (FIRST) {
        for (int i = F.bid * 512 + F.tid; i < 8 * 12288; i += F.G * 512) {
            float s = F.b_ada[i % 12288];
#pragma unroll
            for (int k = 0; k < 4; ++k) s += mp[(size_t)k * 8 * 12288 + i];
            mf[i] = s; }
    }
    float* cA = (float*)F.lds; float* cB = cA + 2048;
    for (int ch = F.bid; ch < MTOK / 128; ch += F.G) {
        const int b = ch / 32;
        __syncthreads();
        for (int col = F.tid; col < 2048; col += 512) {
            float sc, sh;
            if (FIRST) { sc = F.b_ada[off_sc + col]; sh = F.b_ada[off_sh + col];
#pragma unroll
                for (int k = 0; k < 4; ++k) { sc += mp[((size_t)k * 8 + b) * 12288 + off_sc + col]; sh += mp[((size_t)k * 8 + b) * 12288 + off_sh + col]; } }
            else { sc = mf[b * 12288 + off_sc + col]; sh = mf[b * 12288 + off_sh + col]; }
            cA[col] = gain[col] * (1.f + sc); cB[col] = sh; }
        __syncthreads();
        for (int r = F.wave; r < 128; r += 8) {
            const size_t row = (size_t)ch * 128 + r;
            const float* xr = xin + row * 2048 + F.lane * 8;
            f32x4 v[4][2]; float ss = 0.f;
#pragma unroll
            for (int i = 0; i < 4; ++i) { v[i][0] = *(const f32x4*)(xr + i * 512); v[i][1] = *(const f32x4*)(xr + i * 512 + 4);
#pragma unroll
                for (int j = 0; j < 4; ++j) ss += v[i][0][j] * v[i][0][j] + v[i][1][j] * v[i][1][j]; }
            ss = wave_sum(ss);
            const float rinv = 1.0f / sqrtf(ss * (1.0f / 2048.0f) + EPS);
#pragma unroll
            for (int i = 0; i < 4; ++i) { const int col = i * 512 + F.lane * 8;
                const f32x4 a0 = *(const f32x4*)(cA + col), a1 = *(const f32x4*)(cA + col + 4), b0 = *(const f32x4*)(cB + col), b1 = *(const f32x4*)(cB + col + 4);
                const f32x4 y0 = v[i][0] * rinv * a0 + b0, y1 = v[i][1] * rinv * a1 + b1;
                *(u32x4*)(dst + row * 2048 + col) = pack8(y0, y1);
                if (FIRST) *(u32x2*)(dst8 + row * 2048 + col) = pack8_fp8(y0, y1); }
        }
    }
}

__device__ __forceinline__ void phase3_qknorm(Frame& F) {
    F.lane = lane_now(); F.tid = F.wave * 64 + F.lane;
    const bf16_t* q = (const bf16_t*)(F.ws + WS_QN); const bf16_t* k = (const bf16_t*)(F.ws + WS_KN); const bf16_t* v = (const bf16_t*)(F.ws + WS_V);
    unsigned char* q8 = F.ws + WS_Q8; unsigned char* k8 = F.ws + WS_K8; unsigned char* v8 = F.ws + WS_V8;
    const int gw = F.bid * 8 + F.wave, NGW = F.G * 8;
    for (int row = gw; row < MTOK; row += NGW) {
#pragma unroll
        for (int i = 0; i < 2; ++i) { const int ci = i * 64 + F.lane;
            f32x4 a, b; unpack8(*(const u32x4*)(q + (size_t)row * 1024 + ci * 8), a, b);
            float ss = a[0] * a[0] + a[1] * a[1] + a[2] * a[2] + a[3] * a[3] + b[0] * b[0] + b[1] * b[1] + b[2] * b[2] + b[3] * b[3];
            ss = row_sum16(ss);
            const float rinv = 1.0f / sqrtf(ss * (1.0f / 128.0f) + EPS);
            const float* gp = F.g_q + (ci & 15) * 8; const f32x4 g0 = *(const f32x4*)gp, g1 = *(const f32x4*)(gp + 4);
            *(u32x2*)(q8 + (size_t)row * 1024 + ci * 8) = pack8_fp8(a * rinv * g0, b * rinv * g1); }
        { const int ci = F.lane & 31; const bool isk = F.lane < 32;
            f32x4 a, b; unpack8(*(const u32x4*)((isk ? k : v) + (size_t)row * 256 + ci * 8), a, b);
            float ss = a[0] * a[0] + a[1] * a[1] + a[2] * a[2] + a[3] * a[3] + b[0] * b[0] + b[1] * b[1] + b[2] * b[2] + b[3] * b[3];
            ss = row_sum16(ss);
            const float rinv = isk ? 1.0f / sqrtf(ss * (1.0f / 128.0f) + EPS) : 1.0f;
            const float* gp = F.g_k + (ci & 15) * 8; f32x4 g0 = *(const f32x4*)gp, g1 = *(const f32x4*)(gp + 4);
            if (!isk) { g0 = (f32x4){1.f, 1.f, 1.f, 1.f}; g1 = g0; }
            *(u32x2*)((isk ? k8 : v8) + (size_t)row * 256 + ci * 8) = pack8_fp8(a * rinv * g0, b * rinv * g1); }
    }
}
template <int W> __device__ __forceinline__ void pooled_item(const bf16_t* pl, bf16_t* po, int row, int c8) {
    const int t = row & (SEQ - 1);
    f32x4 s0 = (f32x4){0.f, 0.f, 0.f, 0.f}, s1 = s0, x0 = s0, x1 = s0;
    u32x4 v[W];
#pragma unroll
    for (int j = 0; j < W; ++j) v[j] = *(const u32x4*)(pl + (size_t)(row - (j <= t ? j : 0)) * 1024 + c8);
#pragma unroll
    for (int j = 0; j < W; ++j) { f32x4 a, b; unpack8(v[j], a, b); if (j == 0) { x0 = a; x1 = b; } if (j <= t) { s0 += a; s1 += b; } }
    const float inv = 1.0f / (float)((t + 1 < W) ? t + 1 : W);
    *(u32x4*)(po + (size_t)row * 1024 + c8) = pack8(s0 * inv - x0, s1 * inv - x1);
}
__device__ __forceinline__ void phase3_pooled(Frame& F) {
    F.lane = lane_now(); F.tid = F.wave * 64 + F.lane;
    const bf16_t* pl = (const bf16_t*)(F.ws + WS_PL); bf16_t* po = (bf16_t*)(F.ws + WS_POOLED);
    const int gw = F.bid * 8 + F.wave, NGW = F.G * 8;
    for (int it = gw; it < (MTOK / 2) * 4; it += NGW) {
        const int g = it & 3, row = (it >> 2) * 2 + (F.lane >> 5), c8 = g * 256 + (F.lane & 31) * 8;
        if (g == 0) pooled_item<2>(pl, po, row, c8); else if (g == 1) pooled_item<4>(pl, po, row, c8); else if (g == 2) pooled_item<8>(pl, po, row, c8); else pooled_item<16>(pl, po, row, c8);
    }
}
typedef float f32x16 __attribute__((ext_vector_type(16)));
__device__ __forceinline__ float wrelu_(float wh, float d, float acc) { return __builtin_fmaf(wh, d, __builtin_fmaf(wh, __builtin_fabsf(d), acc)); }
__device__ __forceinline__ int sel_code(float s, float smin, float scale) { const float c = (s - smin) * scale; return (int)fminf(fmaxf(c, 0.f), 65535.f); }
__device__ __forceinline__ void hist_find(const unsigned* hist, int lane, int K, int& bsel, int& above) {
    const u32x4 h = *(const u32x4*)(hist + lane * 4);
    const int S = (int)(h.x + h.y + h.z + h.w);
    int x = S;
    x += __builtin_amdgcn_update_dpp(0, x, 0x101, 0xF, 0xF, true);
    x += __builtin_amdgcn_update_dpp(0, x, 0x102, 0xF, 0xF, true);
    x += __builtin_amdgcn_update_dpp(0, x, 0x104, 0xF, 0xF, true);
    x += __builtin_amdgcn_update_dpp(0, x, 0x108, 0xF, 0xF, true);
    const int t1 = __builtin_amdgcn_readlane(x, 16), t2 = __builtin_amdgcn_readlane(x, 32), t3 = __builtin_amdgcn_readlane(x, 48);
    const int r = lane >> 4;
    x += (r == 0 ? t1 + t2 + t3 : (r == 1 ? t2 + t3 : (r == 2 ? t3 : 0)));
    const int sufn = x - S;
    const bool mine = (x >= K) && (sufn < K);
    int b = 0, ab = 0;
    { int c = sufn;
      if (c + (int)h.w >= K) { b = 3; ab = c; } else { c += (int)h.w;
      if (c + (int)h.z >= K) { b = 2; ab = c; } else { c += (int)h.z;
      if (c + (int)h.y >= K) { b = 1; ab = c; } else { c += (int)h.y; b = 0; ab = c; } } } }
    const unsigned long long m = __ballot(mine);
    const int src = m ? (int)__builtin_ctzll(m) : 0;
    bsel = __builtin_amdgcn_readlane(lane * 4 + b, src); above = __builtin_amdgcn_readlane(ab, src);
}
__device__ __forceinline__ int mask_prefix(unsigned long long m) { return (int)__builtin_amdgcn_mbcnt_hi((unsigned)(m >> 32), __builtin_amdgcn_mbcnt_lo((unsigned)m, 0u)); }
template <class Fn> __device__ __forceinline__ void sel_sweep(const f32x4* rb4, int n4, int lane, int t, Fn fn) {
    f32x4 cur = rb4[lane];
    for (int c4 = 0; c4 < n4 - 1; ++c4) { const f32x4 nxt = rb4[(c4 + 1) * 64 + lane];
#pragma unroll
        for (int k = 0; k < 4; ++k) fn(cur[k], (c4 * 4 + k) * 64 + lane, true);
        cur = nxt; }
    { const int c4 = n4 - 1;
#pragma unroll
      for (int k = 0; k < 4; ++k) { const int idx = (c4 * 4 + k) * 64 + lane; fn(cur[k], idx, idx <= t); } }
}
template <int MODE = 0> __device__ __forceinline__ void indexer_select(Frame& F, int b, int t, const float* rowbuf, unsigned* hist, float* eqv, int* eqi) {
    unsigned short* selrow = (unsigned short*)(F.ws + (MODE ? WS_R0 : WS_SEL)) + (size_t)(b * SEQ + t) * 256;
    int lane = F.lane; asm volatile("" : "+v"(lane));
    const int nch = t / 64 + 1, n4 = (nch + 3) >> 2;
    const f32x4* rb4 = (const f32x4*)rowbuf;
    float mn = __builtin_huge_valf(), mx = -__builtin_huge_valf();
    sel_sweep(rb4, n4, lane, t, [&](float v, int, bool valid) { mn = valid ? fminf(mn, v) : mn; mx = valid ? fmaxf(mx, v) : mx; });
    mx = xor16_max(row_max16(mx)); { const auto r = __builtin_amdgcn_permlane32_swap(__float_as_uint(mx), __float_as_uint(mx), false, false); mx = fmaxf(__uint_as_float(r[0]), __uint_as_float(r[1])); }
    mn = -mn; mn = xor16_max(row_max16(mn)); { const auto r = __builtin_amdgcn_permlane32_swap(__float_as_uint(mn), __float_as_uint(mn), false, false); mn = -fmaxf(__uint_as_float(r[0]), __uint_as_float(r[1])); }
    const float scale = (mx > mn) ? 65535.0f / (mx - mn) : 0.f;
    *(u32x4*)(hist + lane * 4) = (u32x4){0u, 0u, 0u, 0u};
    sel_sweep(rb4, n4, lane, t, [&](float v, int, bool valid) { if (valid) { if (MODE == 2) ((volatile unsigned*)hist)[sel_code(v, mn, scale) >> 8] = 1u; else atomicAdd(&hist[sel_code(v, mn, scale) >> 8], 1u); } });
    int b1, above1; hist_find(hist, lane, KSEL, b1, above1);
    *(u32x4*)(hist + lane * 4) = (u32x4){0u, 0u, 0u, 0u};
    sel_sweep(rb4, n4, lane, t, [&](float v, int, bool valid) { const int code = sel_code(v, mn, scale); if (valid && (code >> 8) == b1) atomicAdd(&hist[code & 255], 1u); });
    int b2, above2; hist_find(hist, lane, KSEL - above1, b2, above2);
    const int T16 = (b1 << 8) | b2, need = KSEL - above1 - above2, ceq = (int)hist[b2];
    const bool all_eq = (ceq == need), collect = !all_eq && (ceq <= 64);
    const int eq_budget = all_eq ? 0x7fffffff : (collect ? 0 : need);
    int pos = 0, eqseen = 0;
    sel_sweep(rb4, n4, lane, t, [&](float v, int idx, bool valid) {
        const int code = sel_code(v, mn, scale);
        const bool gt = valid && code > T16, eq = valid && code == T16;
        const unsigned long long mg = __ballot(gt);
        const unsigned p = (unsigned)(pos + mask_prefix(mg));
        if (gt && p < (unsigned)KSEL) selrow[p] = (unsigned short)idx;
        pos += __popcll(mg);
        const unsigned long long me = __ballot(eq);
        if (me) {
            const int er = eqseen + mask_prefix(me); const bool te = eq && er < eq_budget;
            if (collect && eq) { eqv[er] = v; eqi[er] = idx; }
            eqseen += __popcll(me);
            const unsigned long long mte = __ballot(te);
            const unsigned pe = (unsigned)(pos + mask_prefix(mte));
            if (te && pe < (unsigned)KSEL) selrow[pe] = (unsigned short)idx;
            pos += __popcll(mte);
        }
    });
    if (collect && lane < ceq) {
        const float sv = eqv[lane]; const int idx = eqi[lane]; int rank = 0;
        for (int m = 0; m < ceq; ++m) { const float ov = eqv[m]; const int oi = eqi[m]; rank += (ov > sv || (ov == sv && oi < idx)) ? 1 : 0; }
        if (rank < need) selrow[KSEL - need + rank] = (unsigned short)idx;
    }
}
__device__ __forceinline__ void indexer_tile(Frame& F, int b, int t0) {
    const bf16_t* iq = (const bf16_t*)(F.ws + WS_IQ); const bf16_t* ik = (const bf16_t*)(F.ws + WS_IK); const float* iw = (const float*)(F.ws + WS_IW);
    int lane = F.lane; asm volatile("" : "+v"(lane));
    const int w = F.wave;
    if (t0 < KSEL) {
        const int t = t0 + w; unsigned short* selrow = (unsigned short*)(F.ws + WS_SEL) + (size_t)(b * SEQ + t) * 256;
#pragma unroll
        for (int p = 0; p < 4; ++p) { const int j = p * 64 + lane; selrow[j] = (unsigned short)(j <= t ? j : 0xFFFF); }
        return;
    }
    float* rowbuf = (float*)F.lds;
    unsigned char* stage = F.lds + 131072;
    const int p = w & 3, kh = w >> 2, hi = lane >> 5, r = lane & 31;
    const size_t qrow = (size_t)b * SEQ + t0 + 2 * p + (r >> 4);
    bf16x8 a[4];
#pragma unroll
    for (int ks = 0; ks < 4; ++ks) a[ks] = *(const bf16x8*)(iq + qrow * 1024 + (r & 15) * 64 + ks * 16 + 8 * hi);
    float wq[2][8];
#pragma unroll
    for (int q = 0; q < 2; ++q)
#pragma unroll
        for (int i = 0; i < 8; ++i) wq[q][i] = 0.5f * iw[((size_t)b * SEQ + t0 + 2 * p + q) * 16 + (i & 3) + 8 * ((i >> 2) & 1) + 4 * hi];
    const int nchunks = (t0 + 7) / 64 + 1, nsteps = (nchunks + 1) >> 1;
    const unsigned char* gsrc = (const unsigned char*)(ik + (size_t)b * SEQ * 64) + F.tid * 16;
    const int skey = F.tid >> 3, sc16 = F.tid & 7, soff = skey * 128 + ((sc16 ^ ((skey >> 1) & 7)) << 4);
    u32x4 sa0 = *(const u32x4*)gsrc, sb0 = sa0, sa1 = sa0, sb1 = sa0;
    sb0 = *(const u32x4*)(gsrc + (size_t)min(1, nchunks - 1) * 8192);
    sa1 = *(const u32x4*)(gsrc + (size_t)min(2, nchunks - 1) * 8192);
    sb1 = *(const u32x4*)(gsrc + (size_t)min(3, nchunks - 1) * 8192);
    __syncthreads();
#if PROBE_IDX != 1 && PROBE_IDX != 5
#define IDX_LD(c) (*(const u32x4*)(gsrc + (size_t)(c) * 8192))
#endif
#define IDX_MMA(SA, SB, ss, D0, D1) do { const int s_ = (ss); unsigned char* sb = stage + (s_ & 1) * 16384; \
        *(u32x4*)(sb + soff) = SA; *(u32x4*)(sb + 8192 + soff) = SB; \
        __syncthreads(); \
        SA = IDX_LD(min(2 * s_ + 4, nchunks - 1)); \
        SB = IDX_LD(min(2 * s_ + 5, nchunks - 1)); \
        _Pragma("unroll") for (int i = 0; i < 16; ++i) { D0[i] = 0.f; D1[i] = 0.f; } \
        _Pragma("unroll") for (int ks = 0; ks < 4; ++ks) { const unsigned char* bp = sb + key * 128 + (((ks * 2 + hi) ^ ((key >> 1) & 7)) << 4); \
            const bf16x8 bf0 = *(const bf16x8*)bp, bf1 = *(const bf16x8*)(bp + 8192); \
            D0 = __builtin_amdgcn_mfma_f32_32x32x16_bf16(a[ks], bf0, D0, 0, 0, 0); D1 = __builtin_amdgcn_mfma_f32_32x32x16_bf16(a[ks], bf1, D1, 0, 0, 0); } } while (0)
#define IDX_RED(ss, D0, D1) do { const int s_ = (ss); float x0_ = 0.f, x1_ = 0.f, y0_ = 0.f, y1_ = 0.f; \
        _Pragma("unroll") for (int i = 0; i < 8; ++i) { x0_ = wrelu_(wq[0][i], D0[i], x0_); x1_ = wrelu_(wq[1][i], D0[8 + i], x1_); y0_ = wrelu_(wq[0][i], D1[i], y0_); y1_ = wrelu_(wq[1][i], D1[8 + i], y1_); } \
        const float scx = swap32_pair(x0_, x1_), scy = swap32_pair(y0_, y1_); \
        *(f32x2*)(rowbuf + (2 * p + hi) * 4096 + ((s_ >> 1) * 64 + key) * 4 + 2 * (s_ & 1)) = (f32x2){scx, scy}; } while (0)
    const int key = kh * 32 + r;
    f32x16 dA0, dA1, dB0, dB1;
#if PROBE_IDX == 1
#define IDX_LD(c) (*(const u32x4*)(gsrc + (size_t)(c) * 8192))
#elif PROBE_IDX == 5
#define IDX_LD(c) SAVED
#endif
#if PROBE_IDX == 1 || PROBE_IDX == 5
    { const u32x4 SAVED = sa0;
    IDX_MMA(sa0, sb0, 0, dA0, dA1);
    for (int s2 = 0; s2 < nsteps; s2 += 2) {
        if (s2 + 1 < nsteps) IDX_MMA(sa1, sb1, s2 + 1, dB0, dB1);
        IDX_RED(s2, dA0, dA1);
        if (s2 + 2 < nsteps) IDX_MMA(sa0, sb0, s2 + 2, dA0, dA1);
        if (s2 + 1 < nsteps) IDX_RED(s2 + 1, dB0, dB1);
    }
    __syncthreads();
    sa0 = *(const u32x4*)gsrc;
    sb0 = *(const u32x4*)(gsrc + (size_t)min(1, nchunks - 1) * 8192);
    sa1 = *(const u32x4*)(gsrc + (size_t)min(2, nchunks - 1) * 8192);
    sb1 = *(const u32x4*)(gsrc + (size_t)min(3, nchunks - 1) * 8192); }
#undef IDX_LD
#define IDX_LD(c) (*(const u32x4*)(gsrc + (size_t)(c) * 8192))
#endif
    IDX_MMA(sa0, sb0, 0, dA0, dA1);
    for (int s2 = 0; s2 < nsteps; s2 += 2) {
        if (s2 + 1 < nsteps) IDX_MMA(sa1, sb1, s2 + 1, dB0, dB1);
        IDX_RED(s2, dA0, dA1);
        if (s2 + 2 < nsteps) IDX_MMA(sa0, sb0, s2 + 2, dA0, dA1);
        if (s2 + 1 < nsteps) IDX_RED(s2 + 1, dB0, dB1);
    }
#undef IDX_MMA
#undef IDX_RED
#undef IDX_LD
    __syncthreads();
    indexer_select(F, b, t0 + w, rowbuf + w * 4096, (unsigned*)(F.lds + 147456) + w * 256, (float*)(F.lds + 155648) + w * 64, (int*)(F.lds + 155648 + 2048) + w * 64);
#if PROBE_IDX >= 2
    indexer_select<PROBE_IDX - 1>(F, b, t0 + w, rowbuf + w * 4096, (unsigned*)(F.lds + 147456) + w * 256, (float*)(F.lds + 155648) + w * 64, (int*)(F.lds + 155648 + 2048) + w * 64);
#endif
}
__device__ __forceinline__ void phase3_indexer(Frame& F) {
    F.lane = lane_now(); F.tid = F.wave * 64 + F.lane;
    volatile LAS unsigned* misc = (volatile LAS unsigned*)((LAS unsigned char*)F.lds + MISC_OFF);
    const unsigned keep0 = misc[0], keep1 = misc[1];
    __syncthreads();
    const int nit = BATCH * (SEQ / 8);
    for (int k = 0;; ++k) {
        const int l = k * F.G + ((k & 1) ? (F.G - 1 - F.bid) : F.bid);
        if (l >= nit) { if (k * F.G >= nit) break; else continue; }
        const int qb = (SEQ / 8 - 1) - (l >> 3), b = l & 7;
        indexer_tile(F, b, qb * 8);
    }
    __syncthreads();
    if (F.tid == 0) { misc[0] = keep0; misc[1] = keep1; }
}

__device__ const unsigned char g_bucket[128] = {0, 1, 2, 3, 4, 5, 6, 7, 8, 9, 10, 11, 12, 13, 14, 15, 16, 16, 16, 17, 17, 18, 18, 18, 19, 19, 19, 20, 20, 20, 20, 21, 21, 21, 21, 22, 22, 22, 22, 22, 23, 23, 23, 23, 23, 23, 24, 24, 24, 24, 24, 24, 25, 25, 25, 25, 25, 25, 25, 26, 26, 26, 26, 26, 26, 26, 26, 27, 27, 27, 27, 27, 27, 27, 27, 27, 27, 28, 28, 28, 28, 28, 28, 28, 28, 28, 28, 29, 29, 29, 29, 29, 29, 29, 29, 29, 29, 29, 29, 30, 30, 30, 30, 30, 30, 30, 30, 30, 30, 30, 30, 30, 30, 31, 31, 31, 31, 31, 31, 31, 31, 31, 31, 31, 31, 31, 31, 31};
__device__ __forceinline__ void at_pv_step(f32x4 (&D0)[8], f32x4 (&D1)[8], const u32x4 (&buf)[8], LAS unsigned char* vwr, LAS unsigned char* ard, LAS unsigned char* brd) {
#pragma unroll
    for (int c = 0; c < 8; ++c) *(LAS u32x4*)(vwr + c * 16) = buf[c];
    const long pb = __builtin_bit_cast(long, __builtin_amdgcn_ds_read_tr8_b64_v2i32((LAS v2i*)brd));
#pragma unroll
    for (int tl = 0; tl < 8; ++tl) { const long va = __builtin_bit_cast(long, __builtin_amdgcn_ds_read_tr8_b64_v2i32((LAS v2i*)(ard + tl * 16))); D0[tl] = __builtin_amdgcn_mfma_f32_16x16x32_fp8_fp8(va, pb, D0[tl], 0, 0, 0); }
#pragma unroll
    for (int tl = 0; tl < 8; ++tl) { const long va = __builtin_bit_cast(long, __builtin_amdgcn_ds_read_tr8_b64_v2i32((LAS v2i*)(ard + 4608 + tl * 16))); D1[tl] = __builtin_amdgcn_mfma_f32_16x16x32_fp8_fp8(va, pb, D1[tl], 0, 0, 0); }
}
__device__ __forceinline__ void phase4_attention(Frame& F) {
    F.lane = lane_now(); F.tid = F.wave * 64 + F.lane;
    const unsigned char* q8 = F.ws + WS_Q8; const unsigned char* k8 = F.ws + WS_K8; const unsigned char* v8 = F.ws + WS_V8;
    const unsigned short* sel = (const unsigned short*)(F.ws + WS_SEL); bf16_t* ao = (bf16_t*)(F.ws + WS_ATTN);
    float* btab = (float*)F.lds;
    __syncthreads();
    for (int i = F.tid; i < 256; i += 512) btab[i] = F.rel_bias[i];
    __syncthreads();
    float* Pl = (float*)(F.lds + 4096 + F.wave * 12544); int* idl = (int*)((unsigned char*)Pl + 9216); float* psl = (float*)((unsigned char*)Pl + 12288); float* pml = psl + 8;
    LAS unsigned char* wl = (LAS unsigned char*)F.lds + 4096 + F.wave * 12544;
    const bool xmap = (F.G % 8) == 0;
    const int gw = xmap ? (F.bid / 8) * 8 + F.wave : F.bid * 8 + F.wave, NGW = xmap ? F.G : F.G * 8, nrows = xmap ? SEQ : MTOK;
    for (int rr = gw; rr < nrows; rr += NGW) {
        int lane = F.lane; asm volatile("" : "+v"(lane));
        const int row = xmap ? (F.bid & 7) * SEQ + rr : rr;
        const int b = row / SEQ, t = row % SEQ, r = lane & 31, hi = lane >> 5;
#pragma unroll
        for (int p = 0; p < 4; ++p) { idl[p * 64 + lane] = (int)sel[(size_t)row * 256 + p * 64 + lane]; }
        long a0[8], a1[8];
        { u32x4 qa[4];
#pragma unroll
          for (int i = 0; i < 4; ++i) qa[i] = (r < 8) ? *(const u32x4*)(q8 + (size_t)row * 1024 + r * 128 + hi * 64 + i * 16) : (u32x4){0u, 0u, 0u, 0u};
#pragma unroll
          for (int ks = 0; ks < 8; ++ks) { const unsigned lo = qa[ks >> 1][(ks & 1) * 2], hh = qa[ks >> 1][(ks & 1) * 2 + 1]; const long v = (long)(((unsigned long long)hh << 32) | lo);
              a0[ks] = (r < 4) ? v : 0l; a1[ks] = (r >= 4) ? v : 0l; } }
        f32x4 psum = (f32x4){0.f, 0.f, 0.f, 0.f}, pmax = psum;
#define AT_LOADK(buf, kb) do { const int key_ = idl[(kb) * 32 + r]; const int kc_ = key_ <= t ? key_ : 0; const unsigned char* kr_ = k8 + ((size_t)b * SEQ + kc_) * 256 + hi * 64; \
            _Pragma("unroll") for (int i = 0; i < 4; ++i) { buf[i] = *(const u32x4*)(kr_ + i * 16); buf[4 + i] = *(const u32x4*)(kr_ + 128 + i * 16); } } while (0)
#define AT_QK(buf, kb) do { const int key_ = idl[(kb) * 32 + r]; const bool valid_ = key_ <= t; const int kc_ = valid_ ? key_ : 0; \
            f32x16 d; _Pragma("unroll") for (int i = 0; i < 16; ++i) d[i] = 0.f; \
            _Pragma("unroll") for (int ks = 0; ks < 8; ++ks) { const long bv_ = (long)(((unsigned long long)buf[ks >> 1][(ks & 1) * 2 + 1] << 32) | buf[ks >> 1][(ks & 1) * 2]); d = __builtin_amdgcn_mfma_f32_32x32x16_fp8_fp8(a0[ks], bv_, d, 0, 0, 0); } \
            _Pragma("unroll") for (int ks = 0; ks < 8; ++ks) { const long bv_ = (long)(((unsigned long long)buf[4 + (ks >> 1)][(ks & 1) * 2 + 1] << 32) | buf[4 + (ks >> 1)][(ks & 1) * 2]); d = __builtin_amdgcn_mfma_f32_32x32x16_fp8_fp8(a1[ks], bv_, d, 0, 0, 0); } \
            const int dist_ = t - kc_; const int bkt_ = dist_ < 128 ? (int)g_bucket[dist_] : 31; \
            const f32x4 bias_ = *(const f32x4*)(btab + bkt_ * 8 + 4 * hi); f32x4 e_; \
            _Pragma("unroll") for (int i = 0; i < 4; ++i) e_[i] = valid_ ? __expf(d[i] * 0.08838834764831845f + bias_[i]) : 0.f; \
            psum += e_; _Pragma("unroll") for (int i = 0; i < 4; ++i) pmax[i] = fmaxf(pmax[i], e_[i]); *(f32x4*)(Pl + ((kb) * 32 + r) * 8 + 4 * hi) = e_; } while (0)
        {
            u32x4 kA[8], kB[8];
            AT_LOADK(kA, 0);
#pragma unroll 1
            for (int kb = 0; kb < 8; kb += 2) {
                AT_LOADK(kB, kb + 1);
                AT_QK(kA, kb);
                if (kb + 2 < 8) AT_LOADK(kA, kb + 2);
                AT_QK(kB, kb + 1);
            }
        }
#undef AT_LOADK
#undef AT_QK
#pragma unroll
        for (int i = 0; i < 4; ++i) { psum[i] = xor16_sum(row_sum16(psum[i])); pmax[i] = xor16_max(row_max16(pmax[i])); }
        if (r == 0) { *(f32x4*)(psl + 4 * hi) = psum; *(f32x4*)(pml + 4 * hi) = pmax; }
        const int fk = lane & 31, fg = lane >> 5, kq = lane >> 4, tq = (lane >> 1) & 7, tp = lane & 1;
#define AT_LOADV(buf, ks_) do { const int key_ = idl[(ks_) * 32 + fk]; const int kc_ = key_ <= t ? key_ : 0; const unsigned char* vr_ = v8 + ((size_t)b * SEQ + kc_) * 256 + fg * 128; \
            _Pragma("unroll") for (int c = 0; c < 8; ++c) buf[c] = *(const u32x4*)(vr_ + c * 16); } while (0)
        u32x4 vA[8], vB[8];
        AT_LOADV(vA, 0);
        { const f32x4 m0 = *(const f32x4*)pml, m1 = *(const f32x4*)(pml + 4);
          f32x4 r0, r1;
#pragma unroll
          for (int i = 0; i < 4; ++i) { r0[i] = __builtin_amdgcn_rcpf(m0[i]); r1[i] = __builtin_amdgcn_rcpf(m1[i]); }
#pragma unroll
          for (int i = 0; i < 4; ++i) { const int key = i * 64 + lane;
              *(LAS u32x2*)(wl + 10240 + key * 8) = pack8_fp8(*(const f32x4*)(Pl + key * 8) * r0, *(const f32x4*)(Pl + key * 8 + 4) * r1); } }
        f32x4 D0[8], D1[8];
#pragma unroll
        for (int tl = 0; tl < 8; ++tl) { D0[tl] = (f32x4){0.f, 0.f, 0.f, 0.f}; D1[tl] = D0[tl]; }
        LAS unsigned char* vwr = wl + fg * 4608 + fk * 144;
        LAS unsigned char* ard = wl + (kq * 8 + tq) * 144 + 8 * tp;
        LAS unsigned char* brd = wl + 10240 + (kq * 8 + tq) * 8;
#pragma unroll 1
        for (int ks = 0; ks < 8; ks += 2) {
            AT_LOADV(vB, ks + 1);
            at_pv_step(D0, D1, vA, vwr, ard, brd + ks * 256);
            if (ks + 2 < 8) AT_LOADV(vA, ks + 2);
            at_pv_step(D0, D1, vB, vwr, ard, brd + (ks + 1) * 256);
        }
#undef AT_LOADV
        { const int n = lane & 15, q4 = lane >> 4;
          if (n < 8) { const float sc = pml[n] / psl[n]; const bool g1 = n >= 4;
              bf16_t* op = ao + (size_t)row * 1024 + n * 128 + q4 * 4;
#pragma unroll
              for (int tl = 0; tl < 8; ++tl) { const f32x4 d = (g1 ? D1[tl] : D0[tl]) * sc;
                  *(u32x2*)(op + tl * 16) = (u32x2){cvt_pk_bf16(d[0], d[1]), cvt_pk_bf16(d[2], d[3])}; } } }
    }
}

__device__ __forceinline__ float dot16f8(u32x4 w, const float* h) {
    float s = 0.f;
#pragma unroll
    for (int d = 0; d < 4; ++d) { const f32x2 lo = __builtin_amdgcn_cvt_pk_f32_fp8((int)w[d], false), hi = __builtin_amdgcn_cvt_pk_f32_fp8((int)w[d], true);
        s += lo.x * h[4 * d] + lo.y * h[4 * d + 1] + hi.x * h[4 * d + 2] + hi.y * h[4 * d + 3]; }
    return s;
}
__device__ __forceinline__ void fma16f8(u32x4 w, float cf, float* acc) {
#pragma unroll
    for (int d = 0; d < 4; ++d) { const f32x2 lo = __builtin_amdgcn_cvt_pk_f32_fp8((int)w[d], false), hi = __builtin_amdgcn_cvt_pk_f32_fp8((int)w[d], true);
        acc[4 * d] += cf * lo.x; acc[4 * d + 1] += cf * lo.y; acc[4 * d + 2] += cf * hi.x; acc[4 * d + 3] += cf * hi.y; }
}
__device__ __forceinline__ float gelu_erf(float x) { return 0.5f * x * (1.0f + erff(x * 0.70710678118654752f)); }
__device__ __forceinline__ void ce_k(unsigned& a, unsigned& b) { const unsigned hi = a > b ? a : b, lo = a > b ? b : a; a = hi; b = lo; }
__device__ __forceinline__ void ce_kp(unsigned& ka, unsigned& pa, unsigned& kb, unsigned& pb) { const bool sw = kb > ka; const unsigned k0 = sw ? kb : ka, k1 = sw ? ka : kb, p0 = sw ? pb : pa, p1 = sw ? pa : pb; ka = k0; kb = k1; pa = p0; pb = p1; }
__device__ __forceinline__ void bmerge16(unsigned (&x)[16]) {
#pragma unroll
    for (int jj = 0; jj < 4; ++jj) { const int j = 8 >> jj;
#pragma unroll
        for (int i = 0; i < 16; ++i) { const int l = i ^ j; if (l > i) ce_k(x[i], x[l]); }
        __builtin_amdgcn_sched_barrier(0); }
}
__device__ __forceinline__ void bmerge16p(unsigned (&x)[16], unsigned (&p)[16]) {
#pragma unroll
    for (int jj = 0; jj < 4; ++jj) { const int j = 8 >> jj;
#pragma unroll
        for (int i = 0; i < 16; ++i) { const int l = i ^ j; if (l > i) ce_kp(x[i], p[i], x[l], p[l]); }
        __builtin_amdgcn_sched_barrier(0); }
}
__device__ __forceinline__ void bsort16(unsigned (&x)[16]) {
#pragma unroll
    for (int kk = 1; kk <= 4; ++kk) { const int k = 1 << kk;
#pragma unroll
        for (int jj = 0; jj < 4; ++jj) { const int j = (k >> 1) >> jj;
            if (j > 0) {
#pragma unroll
                for (int i = 0; i < 16; ++i) { const int l = i ^ j; if (l > i) { if ((i & k) == 0) ce_k(x[i], x[l]); else ce_k(x[l], x[i]); } }
                __builtin_amdgcn_sched_barrier(0); } } }
}
__device__ __forceinline__ void bsort16p(unsigned (&x)[16], unsigned (&p)[16]) {
#pragma unroll
    for (int kk = 1; kk <= 4; ++kk) { const int k = 1 << kk;
#pragma unroll
        for (int jj = 0; jj < 4; ++jj) { const int j = (k >> 1) >> jj;
            if (j > 0) {
#pragma unroll
                for (int i = 0; i < 16; ++i) { const int l = i ^ j; if (l > i) { if ((i & k) == 0) ce_kp(x[i], p[i], x[l], p[l]); else ce_kp(x[l], p[l], x[i], p[i]); } }
                __builtin_amdgcn_sched_barrier(0); } } }
}
__device__ __forceinline__ void top16_row(const unsigned char* rowp, unsigned (&t)[16]) {
#pragma unroll
    for (int i = 0; i < 16; ++i) t[i] = 0u;
#pragma unroll 1
    for (int g = 0; g < 8; ++g) {
        unsigned w[8];
#pragma unroll
        for (int q = 0; q < 4; ++q) { const u32x2 v = *(const u32x2*)(rowp + g * 32 + q * 8); w[2 * q] = v.x; w[2 * q + 1] = v.y; }
        unsigned sk[16];
#pragma unroll
        for (int d = 0; d < 8; ++d) {
            const unsigned lo = w[d] << 16, hi = w[d];
            const unsigned xl = lo ^ ((unsigned)((int)lo >> 31) | 0x80000000u), xh = hi ^ ((unsigned)((int)hi >> 31) | 0x80000000u);
            sk[2 * d] = ((xl >> 9) & 0xFFFFFF80u) | (unsigned)(127 - (g * 16 + 2 * d));
            sk[2 * d + 1] = ((xh >> 9) & 0xFFFFFF80u) | (unsigned)(127 - (g * 16 + 2 * d + 1)); }
        bsort16(sk);
#pragma unroll
        for (int i = 0; i < 16; ++i) t[i] = t[i] > sk[15 - i] ? t[i] : sk[15 - i];
        bmerge16(t);
    }
}
__device__ __forceinline__ float key_val(unsigned key) { const unsigned y = (key << 9) & 0xFFFF0000u; return __uint_as_float((y ^ (~(unsigned)((int)y >> 31) | 0x80000000u)) & 0xFFFF0000u); }
__device__ __forceinline__ unsigned sum_key(float s, int c) { const unsigned u = __float_as_uint(s); return ((u ^ ((unsigned)((int)u >> 31) | 0x80000000u)) & ~63u) | (unsigned)(63 - c); }
__device__ __forceinline__ float sum_val(unsigned k) { const unsigned y = k & ~63u; return __uint_as_float(y ^ (~(unsigned)((int)y >> 31) | 0x80000000u)); }
typedef __bf16 bf2_t __attribute__((ext_vector_type(2)));
__device__ __forceinline__ float dot2_bf(unsigned a, unsigned b, float c) { return __builtin_amdgcn_fdot2_f32_bf16(__builtin_bit_cast(bf2_t, a), __builtin_bit_cast(bf2_t, b), c, false); }
__device__ __forceinline__ float dot32_f6b(u32x4 wa, u32x2 wb, u32x4 h0, u32x4 h1, u32x4 h2, u32x4 h3) {
    const bf16x32 dec = __builtin_amdgcn_cvt_scalef32_pk32_bf16_fp6((u32x6){wa.x, wa.y, wa.z, wa.w, wb.x, wb.y}, 1.0f);
    const u32x16 ud = __builtin_bit_cast(u32x16, dec);
    float acc = 0.f;
    acc = dot2_bf(ud.s0, h0.x, acc); acc = dot2_bf(ud.s1, h0.y, acc); acc = dot2_bf(ud.s2, h0.z, acc); acc = dot2_bf(ud.s3, h0.w, acc);
    acc = dot2_bf(ud.s4, h1.x, acc); acc = dot2_bf(ud.s5, h1.y, acc); acc = dot2_bf(ud.s6, h1.z, acc); acc = dot2_bf(ud.s7, h1.w, acc);
    acc = dot2_bf(ud.s8, h2.x, acc); acc = dot2_bf(ud.s9, h2.y, acc); acc = dot2_bf(ud.sa, h2.z, acc); acc = dot2_bf(ud.sb, h2.w, acc);
    acc = dot2_bf(ud.sc, h3.x, acc); acc = dot2_bf(ud.sd, h3.y, acc); acc = dot2_bf(ud.se, h3.z, acc); acc = dot2_bf(ud.sf, h3.w, acc);
    return acc;
}
__device__ const unsigned char g_cab[64] = {0, 1, 2, 3, 4, 5, 6, 7, 8, 9, 10, 11, 12, 13, 14, 15, 16, 17, 18, 19, 20, 21, 22, 23, 32, 33, 34, 35, 36, 48, 49, 50, 51, 64, 65, 66, 80, 81, 96, 97, 112, 113, 128, 144, 160, 176, 192, 208, 224, 240, 0, 0, 0, 0, 0, 0, 0, 0, 0, 0, 0, 0, 0, 0};
__device__ __forceinline__ void phase10_peer(Frame& F) {
    F.lane = lane_now(); F.tid = F.wave * 64 + F.lane;
    const bf16_t* sub = (const bf16_t*)(F.ws + WS_SUB); const bf16_t* h2 = (const bf16_t*)(F.ws + WS_H2);
    const unsigned char* pu = F.ws + WS_PU; unsigned* pairs = (unsigned*)(F.ws + WS_PAIRS);
    const int gw = F.bid * 8 + F.wave, NGW = F.G * 8;
    unsigned char* wb = F.lds + F.wave * 19200;
    unsigned char* h2b = wb; unsigned short* gl16 = (unsigned short*)(wb + 16896); unsigned* hist = (unsigned*)(wb + 18944); unsigned* base = hist + 32;
    unsigned* tmp = (unsigned*)wb;
    unsigned* wls0 = (unsigned*)(F.ws + WS_WLS) + (size_t)gw * 1024;
    const int ntok = (MTOK - gw + NGW - 1) / NGW;
    constexpr int CA[50] = {0,0,0,0,0,0,0,0,0,0,0,0,0,0,0,0, 1,1,1,1,1,1,1,1, 2,2,2,2,2, 3,3,3,3, 4,4,4, 5,5, 6,6, 7,7, 8,9,10,11,12,13,14,15};
    constexpr int CB[50] = {0,1,2,3,4,5,6,7,8,9,10,11,12,13,14,15, 0,1,2,3,4,5,6,7, 0,1,2,3,4, 0,1,2,3, 0,1,2, 0,1, 0,1, 0,1, 0,0,0,0,0,0,0,0};
    for (int p0 = 0; p0 < ntok; p0 += 8) {
        int lane = F.lane; asm volatile("" : "+v"(lane));
        const int nt = (ntok - p0) < 8 ? (ntok - p0) : 8;
        {
            u32x4 st[16];
#define SEL_LOAD(half) do { asm volatile("" : "+v"(lane)); const int srow_l = lane >> 4, scol = lane & 15; _Pragma("unroll") for (int it = 0; it < 16; ++it) { const int r_ = it * 4 + srow_l; int ti_ = r_ >> 3; ti_ = ti_ < nt ? ti_ : nt - 1; \
                st[it] = *(const u32x4*)(sub + (size_t)(gw + (p0 + ti_) * NGW) * 2048 + (r_ & 7) * 256 + (half) * 128 + scol * 8); } } while (0)
#define SEL_STORE() do { const int srow_l = lane >> 4, scol = lane & 15; _Pragma("unroll") for (int it = 0; it < 16; ++it) { unsigned char* d_ = wb + (it * 4 + srow_l) * 264 + scol * 16; \
                *(u32x2*)d_ = (u32x2){st[it].x, st[it].y}; *(u32x2*)(d_ + 8) = (u32x2){st[it].z, st[it].w}; } } while (0)
            unsigned tA[16], tB[16];
            SEL_LOAD(0); SEL_STORE();
            __builtin_amdgcn_sched_barrier(0);
            top16_row(wb + lane * 264, tA);
            __builtin_amdgcn_sched_barrier(0);
            asm volatile("" : "+v"(tA[0]), "+v"(tA[1]), "+v"(tA[2]), "+v"(tA[3]), "+v"(tA[4]), "+v"(tA[5]), "+v"(tA[6]), "+v"(tA[7]), "+v"(tA[8]), "+v"(tA[9]), "+v"(tA[10]), "+v"(tA[11]), "+v"(tA[12]), "+v"(tA[13]), "+v"(tA[14]), "+v"(tA[15]) :: "memory");
            SEL_LOAD(1); SEL_STORE();
            __builtin_amdgcn_sched_barrier(0);
            top16_row(wb + lane * 264, tB);
            __builtin_amdgcn_sched_barrier(0);
#undef SEL_LOAD
#undef SEL_STORE
            float vA[16], vB[16];
            { unsigned pa[4] = {0u, 0u, 0u, 0u}, pb[4] = {0u, 0u, 0u, 0u};
#pragma unroll
              for (int i = 0; i < 16; ++i) { vA[i] = key_val(tA[i]); vB[i] = key_val(tB[i]); pa[i >> 2] |= (127u - (tA[i] & 127u)) << (8 * (i & 3)); pb[i >> 2] |= (127u - (tB[i] & 127u)) << (8 * (i & 3)); }
              unsigned char* rp = wb + lane * 264;
              *(u32x2*)rp = (u32x2){pa[0], pa[1]}; *(u32x2*)(rp + 8) = (u32x2){pa[2], pa[3]}; *(u32x2*)(rp + 16) = (u32x2){pb[0], pb[1]}; *(u32x2*)(rp + 24) = (u32x2){pb[2], pb[3]}; }
            unsigned tk[16];
#pragma unroll
            for (int c = 0; c < 16; ++c) tk[c] = sum_key(vA[CA[c]] + vB[CB[c]], c);
            bsort16(tk);
#pragma unroll
            for (int grp = 1; grp < 3; ++grp) {
                unsigned sk[16];
#pragma unroll
                for (int e = 0; e < 16; ++e) { const int c = grp * 16 + e; sk[e] = sum_key(vA[CA[c]] + vB[CB[c]], c); }
                bsort16(sk);
#pragma unroll
                for (int i = 0; i < 16; ++i) tk[i] = tk[i] > sk[15 - i] ? tk[i] : sk[15 - i];
                bmerge16(tk);
            }
#pragma unroll
            for (int c = 48; c < 50; ++c) { unsigned k = sum_key(vA[CA[c]] + vB[CB[c]], c);
#pragma unroll
                for (int i = 0; i < 16; ++i) ce_k(tk[i], k); }
            const float s0 = sum_val(tk[0]); float ev[16], esum = 0.f;
#pragma unroll
            for (int r = 0; r < 16; ++r) { ev[r] = __expf(sum_val(tk[r]) - s0); esum += ev[r]; }
            const float einv = 1.0f / esum;
            unsigned eid[16];
            { const unsigned char* rp = wb + lane * 264;
#pragma unroll
              for (int r = 0; r < 16; ++r) { const unsigned cab = g_cab[63u - (tk[r] & 63u)]; eid[r] = (unsigned)rp[cab >> 4] * 128u + (unsigned)rp[16 + (cab & 15u)]; } }
            if ((lane >> 3) < nt) {
#pragma unroll
                for (int r = 0; r < 16; ++r) { const int e = lane * 16 + r; tmp[e] = ((unsigned)e << 14) | eid[r]; gl16[e] = (unsigned short)(cvt_pk_bf16(ev[r] * einv, 0.f) & 0xffffu); } }
        }
        asm volatile("" : "+v"(lane));
        const int ne = nt * 128;
        {
            if (lane < 32) hist[lane] = 0u;
            unsigned ent[16]; unsigned rk[16];
#pragma unroll
            for (int q = 0; q < 16; ++q) { const int e = q * 64 + lane; ent[q] = (e < ne) ? tmp[e] : 0u; rk[q] = (e < ne) ? atomicAdd(&hist[(ent[q] & 0x3FFFu) >> 9], 1u) : 0u; }
            { int hv = lane < 32 ? (int)hist[lane] : 0; int x = hv;
              x += __builtin_amdgcn_update_dpp(0, x, 0x111, 0xF, 0xF, true); x += __builtin_amdgcn_update_dpp(0, x, 0x112, 0xF, 0xF, true);
              x += __builtin_amdgcn_update_dpp(0, x, 0x114, 0xF, 0xF, true); x += __builtin_amdgcn_update_dpp(0, x, 0x118, 0xF, 0xF, true);
              const int t0 = __builtin_amdgcn_readlane(x, 15); if (lane >= 16) x += t0;
              if (lane < 32) base[lane] = (unsigned)(x - hv); }
#pragma unroll
            for (int q = 0; q < 16; ++q) { const int e = q * 64 + lane; if (e < ne) wls0[base[(ent[q] & 0x3FFFu) >> 9] + rk[q]] = ent[q]; }
        }
        asm volatile("s_waitcnt vmcnt(0)" ::: "memory");
        asm volatile("" : "+v"(lane));
#pragma unroll 1
        for (int i = 0; i < nt; ++i) { const bf16_t* hr = h2 + (size_t)(gw + (p0 + i) * NGW) * 2048 + lane * 32;
            f32x4 v[8]; float m = 0.f;
#pragma unroll
            for (int q = 0; q < 4; ++q) { unpack8(*(const u32x4*)(hr + q * 8), v[2 * q], v[2 * q + 1]); }
#pragma unroll
            for (int q = 0; q < 8; ++q)
#pragma unroll
                for (int k = 0; k < 4; ++k) m = fmaxf(m, __builtin_fabsf(v[q][k]));
            int sb = (int)((__float_as_uint(m * 1.0666667f) >> 23) & 0xFFu) - 2; sb = sb < 1 ? 1 : (sb > 253 ? 253 : sb);
            const float inv = __uint_as_float((unsigned)(254 - sb) << 23);
            u32x16 pk;
#pragma unroll
            for (int q = 0; q < 8; ++q) { const f32x4 a = v[q] * inv; pk[2 * q] = cvt_pk_bf16(a[0], a[1]); pk[2 * q + 1] = cvt_pk_bf16(a[2], a[3]); }
            const u32x6 p6 = __builtin_amdgcn_cvt_scalef32_pk32_fp6_bf16(__builtin_bit_cast(bf16x32, pk), 1.0f);
            const int lp = (lane >> 2) + 16 * (lane & 3);
            *(u32x4*)(h2b + i * 2048 + lp * 16) = (u32x4){p6[0], p6[1], p6[2], p6[3]};
            *(u32x4*)(h2b + i * 2048 + 1024 + lp * 16) = (u32x4){p6[4], p6[5], (unsigned)sb, 0u}; }
        {
            const int dg = lane >> 4, dc = lane & 15;
            const bool dv = (dc >> 2) == dg; const int dr = dc & 3;
            const float w0 = (dv && dr == 0) ? 1.f : 0.f, w1 = (dv && dr == 1) ? 1.f : 0.f, w2 = (dv && dr == 2) ? 1.f : 0.f, w3 = (dv && dr == 3) ? 1.f : 0.f;
            unsigned entn = __hip_atomic_load(wls0 + lane, __ATOMIC_RELAXED, __HIP_MEMORY_SCOPE_AGENT);
#pragma unroll 1
            for (int c = 0; c < ne; c += 64) {
                const unsigned ent64 = entn;
                if (c + 64 < ne) entn = __hip_atomic_load(wls0 + c + 64 + lane, __ATOMIC_RELAXED, __HIP_MEMORY_SCOPE_AGENT);
                float keep = 0.f;
#pragma unroll 1
                for (int i0 = 0; i0 < 64; i0 += 8) {
                    u32x4 wA[8]; u32x2 wB[8]; unsigned en[8];
#pragma unroll
                    for (int jj = 0; jj < 8; ++jj) { en[jj] = (unsigned)__builtin_amdgcn_readlane((int)ent64, i0 + jj); const unsigned char* ur = pu + (size_t)(en[jj] & 0x3FFFu) * 1536;
                        wA[jj] = *(const u32x4*)(ur + lane * 16); wB[jj] = *(const u32x2*)(ur + 1024 + lane * 8); }
                    float pr[8];
#pragma unroll
                    for (int jj = 0; jj < 8; ++jj) { const unsigned char* hp = h2b + ((en[jj] >> 21) & 7u) * 2048 + lane * 16;
                        const u32x4 b0 = *(const u32x4*)hp, b1 = *(const u32x4*)(hp + 1024);
                        const pg8::i32x8 A = (pg8::i32x8){(int)wA[jj].x, (int)wA[jj].y, (int)wA[jj].z, (int)wA[jj].w, (int)wB[jj].x, (int)wB[jj].y, 0, 0};
                        const pg8::i32x8 B = (pg8::i32x8){(int)b0.x, (int)b0.y, (int)b0.z, (int)b0.w, (int)b1.x, (int)b1.y, 0, 0};
                        const f32x4 D = __builtin_amdgcn_mfma_scale_f32_16x16x128_f8f6f4(A, B, (f32x4){0.f, 0.f, 0.f, 0.f}, 2  , 2  , 0, 0x7F7F7F7F, 0, (int)b1.z);
                        pr[jj] = w0 * D[0] + w1 * D[1] + w2 * D[2] + w3 * D[3]; }
#pragma unroll
                    for (int i = 0; i < 4; ++i) pr[i] = swap32_pair(pr[i], pr[i + 4]);
#pragma unroll
                    for (int i = 0; i < 2; ++i) pr[i] = swap16_pair(pr[i], pr[i + 2]);
                    const bool b3 = (lane & 8) != 0;
                    { const float snd = b3 ? pr[0] : pr[1], kp = b3 ? pr[1] : pr[0]; pr[0] = kp + dpp_f<DPP_ROR8>(snd); }
                    float tot = pr[0]; tot += dpp_f<DPP_XOR1>(tot); tot += dpp_f<DPP_XOR2>(tot); tot += dpp_f<DPP_HMIRROR>(tot);
                    keep = ((lane & 7) == (i0 >> 3)) ? tot : keep;
                }
                {
                    const unsigned em = (unsigned)__shfl((int)ent64, 8 * (lane & 7) + (lane >> 3));
                    const int ti = (int)(em >> 21), j = (int)((em >> 14) & 127u), row = gw + (p0 + ti) * NGW;
                    const float cf = gelu_erf(keep * (1.0f / 96.0f)) * __uint_as_float((unsigned)gl16[(em >> 14) & 1023u] << 16);
                    pairs[((size_t)(row >> 6) * 128 + j) * 64 + (row & 63)] = (((unsigned)__builtin_bit_cast(unsigned short, (_Float16)cf) << 16) & 0xFFFE0000u) | ((em & 0x3FFFu) << 3);
                }
            }
        }
    }
}

__device__ __forceinline__ void phase11_peer_v(Frame& F, float* dst) {
    F.lane = lane_now(); F.tid = F.wave * 64 + F.lane;
    const unsigned* pairs = (const unsigned*)(F.ws + WS_PAIRS); const float* mf = (const float*)(F.ws + WS_MODF);
    unsigned long long* vs = (unsigned long long*)F.lds;
    for (int c0 = F.bid; c0 < DM / 8; c0 += F.G) {
        const int c = (c0 & 7) * 32 + (c0 >> 3);
        __syncthreads();
        { const u32x4* src = (const u32x4*)(F.ws + WS_PV + (size_t)c * NEXP * 8);
#pragma unroll 4
          for (int i = F.tid; i < NEXP * 8 / 16; i += 512) *(LAS u32x4*)(unsigned long long)(unsigned)(i * 16) = src[i]; }
        __syncthreads();
        typedef __fp16 h2_t __attribute__((__vector_size__(2 * sizeof(__fp16))));
#define P11_LOAD(dst, ptr) do { _Pragma("unroll") for (int jj = 0; jj < 16; ++jj) dst[jj] = (ptr)[jj * 64]; } while (0)
#define P11_FMA(A, X, C) asm("v_pk_fma_f16 %0, %1, %2, %0 op_sel:[0,1,0] op_sel_hi:[1,1,1]" : "+v"(C) : "v"(A), "v"(X))
#define P11_COMP(src) do { unsigned long long vv_[16]; \
                    _Pragma("unroll") for (int jj = 0; jj < 16; ++jj) vv_[jj] = *(const LAS unsigned long long*)(unsigned long long)(src[jj] & 0x1FFF8u);     \
                    __builtin_amdgcn_sched_barrier(0); \
                    _Pragma("unroll") for (int jj = 0; jj < 16; ++jj) { const int lo = (int)(unsigned)vv_[jj], hi = (int)(unsigned)(vv_[jj] >> 32); \
                    const h2_t c0_ = __builtin_amdgcn_cvt_scalef32_pk_f16_fp8(lo, 1.0f, false), c1_ = __builtin_amdgcn_cvt_scalef32_pk_f16_fp8(lo, 1.0f, true); \
                    const h2_t c2_ = __builtin_amdgcn_cvt_scalef32_pk_f16_fp8(hi, 1.0f, false), c3_ = __builtin_amdgcn_cvt_scalef32_pk_f16_fp8(hi, 1.0f, true); \
                    P11_FMA(c0_, src[jj], acc[0]); P11_FMA(c1_, src[jj], acc[1]); P11_FMA(c2_, src[jj], acc[2]); P11_FMA(c3_, src[jj], acc[3]); } } while (0)
#define P11_COMPX(src) do { unsigned long long vv_[16]; \
                    _Pragma("unroll") for (int jj = 0; jj < 16; ++jj) vv_[jj] = *(const LAS unsigned long long*)(unsigned long long)(src[jj] & 0x1FFF8u); \
                    __builtin_amdgcn_sched_barrier(0); \
                    _Pragma("unroll") for (int jj = 0; jj < 16; ++jj) { const int lo = (int)(unsigned)vv_[jj], hi = (int)(unsigned)(vv_[jj] >> 32); \
                    P11_FMA(lo, src[jj], acc[0]); P11_FMA(hi, src[jj], acc[1]); P11_FMA(lo, src[jj], acc[2]); P11_FMA(hi, src[jj], acc[3]); } } while (0)
        int lane = F.lane; asm volatile("" : "+v"(lane));
        unsigned pa[16], pb[16];
        f32x4 x0, x1;
        { const unsigned* pp = pairs + (size_t)F.wave * 128 * 64 + lane; P11_LOAD(pa, pp);
          const float* ip = F.out + (size_t)(F.wave * 64 + lane) * 2048 + c * 8; x0 = *(const f32x4*)ip; x1 = *(const f32x4*)(ip + 4); }
        for (int tile = F.wave; tile < MTOK / 64; tile += 8) {
            const unsigned* pp = pairs + (size_t)tile * 128 * 64 + lane;
            const int ntile = tile + 8 < MTOK / 64 ? tile + 8 : tile;
            const unsigned* npp = pairs + (size_t)ntile * 128 * 64 + lane;
            const int row = tile * 64 + lane;
            const float* gt2 = mf + (size_t)(tile / (SEQ / 64)) * 12288 + 10240 + c * 8;
            float* op = dst + (size_t)row * 2048 + c * 8;
            const f32x4 g0 = *(const f32x4*)gt2 * 0.25f, g1 = *(const f32x4*)(gt2 + 4) * 0.25f;
            h2_t acc[4];
#pragma unroll
            for (int i = 0; i < 4; ++i) acc[i] = (h2_t){(__fp16)0.f, (__fp16)0.f};
            f32x4 nx0 = x0, nx1 = x1;
#pragma unroll 1
            for (int j0 = 0; j0 < 128; j0 += 32) {
                P11_LOAD(pb, pp + (j0 + 16) * 64);
                P11_COMP(pa);
                const bool lastb = j0 + 32 >= 128;
                { const unsigned* np_ = lastb ? npp : pp + (j0 + 32) * 64; P11_LOAD(pa, np_); }
                if (lastb) { const float* nip = F.out + (size_t)(ntile * 64 + lane) * 2048 + c * 8; nx0 = *(const f32x4*)nip; nx1 = *(const f32x4*)(nip + 4); }
                P11_COMP(pb);
            }
#if PROBE_P11X == 1 || PROBE_P11X == 3
            { h2_t sv[4]; for (int i = 0; i < 4; ++i) sv[i] = acc[i];
#pragma unroll 1
              for (int j0 = 0; j0 < 128; j0 += 32) {
#pragma unroll
                for (int jj = 0; jj < 16; ++jj) { asm volatile("" : "+v"(pa[jj])); asm volatile("" : "+v"(pb[jj])); }
#if PROBE_P11X == 1
                P11_COMP(pa); P11_COMP(pb);
#else
                P11_COMPX(pa); P11_COMPX(pb);
#endif
              }
              asm volatile("" :: "v"(acc[0]), "v"(acc[1]), "v"(acc[2]), "v"(acc[3])); for (int i = 0; i < 4; ++i) acc[i] = sv[i]; }
#endif
            *(f32x4*)op = x0 + g0 * (f32x4){(float)acc[0][0], (float)acc[0][1], (float)acc[1][0], (float)acc[1][1]};
            *(f32x4*)(op + 4) = x1 + g1 * (f32x4){(float)acc[2][0], (float)acc[2][1], (float)acc[3][0], (float)acc[3][1]};
            x0 = nx0; x1 = nx1;
        }
#undef P11_LOAD
#undef P11_COMP
#undef P11_FMA
    }
}

__global__ void __launch_bounds__(512, 2) fwd_kernel(Args args) {
    extern __shared__ __attribute__((aligned(16))) unsigned char lds[];
    Frame F;
    F.lds = lds; F.ws = args.ws; F.tid = threadIdx.x; F.lane = F.tid & 63; F.wave = __builtin_amdgcn_readfirstlane(F.tid >> 6); F.G = gridDim.x; F.bid = blockIdx.x;
    F.x = args.in[0]; F.c = args.in[1]; F.w_ada = args.in[2]; F.b_ada = args.in[3]; F.g1 = args.in[4]; F.g2 = args.in[5]; F.w_in = args.in[6]; F.g_q = args.in[7]; F.g_k = args.in[8];
    F.rel_bias = args.in[9]; F.pool_w = args.in[10]; F.pool_scale = args.in[11]; F.w_ab = args.in[12]; F.w_pb = args.in[13]; F.w_out = args.in[14]; F.w_pq = args.in[15];
    F.peer_keys = args.in[16]; F.peer_u = args.in[17]; F.peer_v = args.in[18]; F.out = args.out;
    LAS unsigned char* ldsl = (LAS unsigned char*)lds;
    volatile LAS unsigned* misc = (volatile LAS unsigned*)(ldsl + MISC_OFF);
    if (F.tid < 4) misc[F.tid] = 0u;
    __syncthreads();
    unsigned* barw = (unsigned*)(args.ws + WS_CTL) + (size_t)args.li * XCD_BAR_WORDS;
    XcdBarrier bar; bar.bar = barw; bar.x = 0; bar.st = misc;
    const int lo = args.ph_lo, hi = args.ph_hi;
    if (hi - lo > 1) bar = xcd_barrier_post(barw, misc);
#define IN(k) (lo <= (k) && (k) < hi)
#define SEAM(k) do { if (IN(k) && IN((k) + 1)) xcd_barrier(bar, F.wave); } while (0)
    bf16_t* R0 = (bf16_t*)(F.ws + WS_R0);

#define PH2_BODY { \
        { pg8::Gemm g{(const bf16_t*)(F.ws + WS_H1F8), (const bf16_t*)(F.ws + WS_WIN8), MTOK, 5632, DM / 2, DM / 2, 0, nullptr, nullptr, 0, 0}; pg8::StaticOrder S; S.init(MTOK, 5632, F.G, F.bid); \
          EpiInproj<true> E{(bf16_t*)(F.ws + WS_QN), (bf16_t*)(F.ws + WS_KN), (bf16_t*)(F.ws + WS_V), (bf16_t*)(F.ws + WS_IQ), (bf16_t*)(F.ws + WS_IK), (bf16_t*)(F.ws + WS_PL), \
                    (bf16_t*)(F.ws + WS_GA), (bf16_t*)(F.ws + WS_GP), (float*)(F.ws + WS_IW)}; \
          pg8::gemm_phase<EpiInproj<true>, true>(ldsl, g, S, E, F.wave); } \
        { pg8::Gemm g{R0, (const bf16_t*)(F.ws + WS_WIN16), MTOK, 2304, DM, DM, 0, nullptr, nullptr, 0, 0}; pg8::StaticOrder S; S.init(MTOK, 2304, F.G, F.bid); \
          EpiInproj<false> E{(bf16_t*)(F.ws + WS_QN), (bf16_t*)(F.ws + WS_KN), (bf16_t*)(F.ws + WS_V), (bf16_t*)(F.ws + WS_IQ), (bf16_t*)(F.ws + WS_IK), (bf16_t*)(F.ws + WS_PL), \
                    (bf16_t*)(F.ws + WS_GA), (bf16_t*)(F.ws + WS_GP), (float*)(F.ws + WS_IW)}; \
          pg8::gemm_phase<EpiInproj<false>>(ldsl, g, S, E, F.wave); } }
#define PH3_BODY { phase3_pooled(F); phase3_indexer(F); __syncthreads(); }
#define PH4_BODY { \
        phase4_attention(F); \
        __syncthreads(); \
        pg8::Gemm g{(const bf16_t*)(F.ws + WS_POOLED), (const bf16_t*)(F.ws + WS_POOLW), MTOK, PW, 256, 1024, 256, nullptr, nullptr, 0, 0}; pg8::StaticOrder S; S.init(MTOK, PW, F.G, F.bid); \
        EpiBf16Scale E{(bf16_t*)(F.ws + WS_POOL2), 1024, F.pool_scale}; \
        pg8::gemm_phase<EpiBf16Scale>(ldsl, g, S, E, F.wave); }
#define PH5_BODY { \
        pg8::Gemm g{(const bf16_t*)(F.ws + WS_ATTN), (const bf16_t*)(F.ws + WS_WAB), MTOK, DM, 2048, 1024, 0, (const bf16_t*)(F.ws + WS_POOL2), (const bf16_t*)(F.ws + WS_WPB), 16, 1024}; \
        pg8::StaticOrder S; S.init(MTOK, DM, F.G, F.bid); \
        EpiMerge E{(unsigned char*)R0, (const bf16_t*)(F.ws + WS_GA), (const bf16_t*)(F.ws + WS_GP)}; pg8::gemm_phase<EpiMerge>(ldsl, g, S, E, F.wave); }
#define PH6_BODY { \
        pg8::Gemm g{R0, (const bf16_t*)(F.ws + WS_WOUT), MTOK, DM, DM / 2, DM / 2, 0, nullptr, nullptr, 0, 0}; pg8::StaticOrder S; S.init(MTOK, DM, F.G, F.bid); \
        EpiResid E{F.x, F.out, (const float*)(F.ws + WS_MODF) + 4096}; pg8::gemm_phase<EpiResid, true>(ldsl, g, S, E, F.wave); }
#define PH8_BODY { \
        pg8::Gemm g{(const bf16_t*)(F.ws + WS_H2), (const bf16_t*)(F.ws + WS_WPQ), MTOK, DM, DM, DM, 0, nullptr, nullptr, 0, 0}; pg8::StaticOrder S; S.init(MTOK, DM, F.G, F.bid); \
        EpiBf16Scale E{R0, 2048, nullptr}; pg8::gemm_phase<EpiBf16Scale>(ldsl, g, S, E, F.wave); }
#define PH9_BODY { \
        pg8::Gemm g{R0, (const bf16_t*)(F.ws + WS_KEYSBD), MTOK, DM, 256, DM, 256, nullptr, nullptr, 0, 0}; pg8::StaticOrder S; S.init(MTOK, DM, F.G, F.bid); \
        EpiBf16Scale E{(bf16_t*)(F.ws + WS_SUB), 2048, nullptr}; pg8::gemm_phase<EpiBf16Scale>(ldsl, g, S, E, F.wave); }
#define REP(k) if constexpr (((PROBE_REP) >> (k)) & 1)

    if (IN(0)) { phase0_prep(F); REP(0) { __syncthreads(); phase0_prep(F); } }
    SEAM(0);
    if (IN(1)) { phase_modnorm<true>(F, F.x, F.g1, 0, 2048, R0, F.ws + WS_H1F8); REP(1) { phase_modnorm<true>(F, F.x, F.g1, 0, 2048, R0, F.ws + WS_H1F8); } }
    SEAM(1);
    if (IN(2)) { PH2_BODY REP(2) PH2_BODY }
    SEAM(2);
    if (IN(3)) { phase3_qknorm(F); PH3_BODY REP(3) PH3_BODY }
    SEAM(3);
    if (IN(4)) { PH4_BODY REP(4) PH4_BODY }
    SEAM(4);
    if (IN(5)) { PH5_BODY REP(5) PH5_BODY }
    SEAM(5);
    if (IN(6)) { PH6_BODY REP(6) PH6_BODY }
    SEAM(6);
    if (IN(7)) { phase_modnorm<false>(F, F.out, F.g2, 6144, 8192, (bf16_t*)(F.ws + WS_H2)); REP(7) { phase_modnorm<false>(F, F.out, F.g2, 6144, 8192, (bf16_t*)(F.ws + WS_H2)); } }
    SEAM(7);
    if (IN(8)) { PH8_BODY REP(8) PH8_BODY }
    SEAM(8);
    if (IN(9)) { PH9_BODY REP(9) PH9_BODY }
    SEAM(9);
    if (IN(10)) { phase10_peer(F); REP(10) phase10_peer(F); }
    SEAM(10);
    if (IN(11)) { REP(11) { phase11_peer_v(F, (float*)(F.ws + WS_SUB)); } phase11_peer_v(F, F.out); }
#undef IN
#undef SEAM
}

extern "C" void kernel_launch(void* const* d_in, const int* in_sizes, int n_in, void* d_out, int out_size, void* d_ws, size_t ws_size, hipStream_t stream) {
    static int grid = 0;
    if (grid == 0) {
        if (n_in != 19 || out_size != MTOK * DM || ws_size < WS_END) { fprintf(stderr, "kernel_launch: unexpected shapes (n_in %d out %d ws %zu)\n", n_in, out_size, ws_size); grid = -1; return; }
        int dev = 0, cus = 0, per_cu = 0;
        if (hipGetDevice(&dev) != hipSuccess || hipDeviceGetAttribute(&cus, hipDeviceAttributeMultiprocessorCount, dev) != hipSuccess) { grid = -1; return; }
        if (hipFuncSetAttribute((const void*)fwd_kernel, hipFuncAttributeMaxDynamicSharedMemorySize, LDS_BYTES) != hipSuccess) { fprintf(stderr, "kernel_launch: hipFuncSetAttribute failed\n"); grid = -1; return; }
        if (hipOccupancyMaxActiveBlocksPerMultiprocessor(&per_cu, (const void*)fwd_kernel, 512, LDS_BYTES) != hipSuccess || per_cu < 1) { fprintf(stderr, "kernel_launch: occupancy query says %d\n", per_cu); }
        (void)hipGetLastError();
        grid = cus;
    }
    if (grid < 0) return;
    (void)in_sizes;
    if (hipMemsetAsync((char*)d_ws + WS_CTL, 0, CTL_ZERO_BYTES, stream) != hipSuccess) return;
    Args a{};
    for (int i = 0; i < 19; ++i) a.in[i] = (const float*)d_in[i];
    a.out = (float*)d_out; a.ws = (unsigned char*)d_ws;
#if MK_PER_PHASE
    for (int p = 0; p < NPHASE; ++p) { a.ph_lo = p; a.ph_hi = p + 1; a.li = p; hipLaunchKernelGGL(fwd_kernel, dim3(grid), dim3(512), LDS_BYTES, stream, a); }
#else
    a.ph_lo = 0; a.ph_hi = NPHASE; a.li = 0;
    hipLaunchKernelGGL(fwd_kernel, dim3(grid), dim3(512), LDS_BYTES, stream, a);
#endif
}
```

```cpp
#include <hip/hip_runtime.h>
#include <cstdio>
#include <cstdint>

#ifndef MK_PER_PHASE
#define MK_PER_PHASE 0
#endif

#ifndef PROBE_REP
#define PROBE_REP 0
#endif
#ifndef PROBE_IDX
#define PROBE_IDX 0
#endif
#ifndef PROBE_P10M
#define PROBE_P10M 0
#endif
#ifndef PROBE_P11X
#define PROBE_P11X 0
#endif
#define LAS __attribute__((address_space(3)))
typedef unsigned short bf16_t;
typedef short bf16x8 __attribute__((ext_vector_type(8)));
typedef float f32x4 __attribute__((ext_vector_type(4)));
typedef float f32x2 __attribute__((ext_vector_type(2)));
typedef int v2i __attribute__((ext_vector_type(2)));
typedef unsigned u32x4 __attribute__((ext_vector_type(4)));
typedef unsigned u32x2 __attribute__((ext_vector_type(2)));
typedef unsigned u32x6 __attribute__((ext_vector_type(6)));
typedef unsigned u32x16 __attribute__((ext_vector_type(16)));
typedef __bf16 bf16x32 __attribute__((ext_vector_type(32)));

constexpr int BATCH = 8, SEQ = 4096, DM = 2048, MTOK = BATCH * SEQ;
constexpr int NHEAD = 8, HDIM = 128, AW = 1024, KVW = 256, IHEADS = 16, IDIM = 64, KSEL = 256;
constexpr int PW = 1024, PHEADS = 8, NEXP = 16384;
constexpr int INW = 7760;
constexpr float EPS = 1e-6f;
constexpr int NPHASE = 12;

constexpr size_t MiB = 1u << 20;
constexpr size_t WS_CTL = 0, CTL_ZERO_BYTES = 256 * 1024;
constexpr size_t WS_MODP = 2 * MiB;
constexpr size_t WS_MODF = 4 * MiB;
constexpr size_t WS_POOLW = 5 * MiB;
constexpr size_t WS_KEYSBD = 6 * MiB;
constexpr size_t WS_WIN16 = 8 * MiB;
constexpr size_t WS_WIN8 = 20 * MiB;
constexpr size_t WS_WAB = 40 * MiB, WS_WPB = 44 * MiB, WS_WOUT = 48 * MiB, WS_WPQ = 56 * MiB;
constexpr size_t WS_PU = 64 * MiB, WS_PV = 128 * MiB;
constexpr size_t WS_R0 = 192 * MiB;
constexpr size_t WS_GA = 320 * MiB, WS_GP = 448 * MiB;
constexpr size_t WS_SUB = 320 * MiB;
constexpr size_t WS_QN = 576 * MiB;
constexpr size_t WS_IQ = 640 * MiB;
constexpr size_t WS_PL = 704 * MiB;
constexpr size_t WS_KN = 768 * MiB, WS_V = 784 * MiB;
constexpr size_t WS_IK = 800 * MiB;
constexpr size_t WS_IW = 804 * MiB;
constexpr size_t WS_SEL = 806 * MiB;
constexpr size_t WS_POOLED = 822 * MiB;
constexpr size_t WS_H2 = 886 * MiB;
constexpr size_t WS_END = 1014 * MiB;
constexpr size_t WS_H1F8 = WS_H2 + 64 * MiB;
constexpr size_t WS_Q8 = WS_H2, WS_K8 = WS_H2 + 32 * MiB, WS_V8 = WS_H2 + 40 * MiB;
constexpr size_t WS_ATTN = WS_IQ, WS_POOL2 = WS_PL, WS_PAIRS = WS_QN, WS_WLS = WS_QN + 32 * MiB;

constexpr int LDS_BYTES = 160 * 1024;
constexpr int MISC_OFF = 159 * 1024;

__device__ __forceinline__ unsigned cvt_pk_bf16(float lo, float hi) { unsigned r; asm volatile("v_cvt_pk_bf16_f32 %0, %1, %2" : "=v"(r) : "v"(lo), "v"(hi)); return r; }
__device__ __forceinline__ float bf_lo(unsigned w) { return __uint_as_float(w << 16); }
__device__ __forceinline__ float bf_hi(unsigned w) { return __uint_as_float(w & 0xffff0000u); }
template <int CTRL> __device__ __forceinline__ float dpp_f(float x) { return __int_as_float(__builtin_amdgcn_update_dpp(0, __float_as_int(x), CTRL, 0xF, 0xF, true)); }
#define DPP_XOR1 0xB1
#define DPP_XOR2 0x4E
#define DPP_HMIRROR 0x141
#define DPP_MIRROR 0x140
#define DPP_ROR8 0x128
__device__ __forceinline__ float xor16_sum(float x) { const auto r = __builtin_amdgcn_permlane16_swap(__float_as_uint(x), __float_as_uint(x), false, false); return __uint_as_float(r[0]) + __uint_as_float(r[1]); }
__device__ __forceinline__ float xor32_sum(float x) { const auto r = __builtin_amdgcn_permlane32_swap(__float_as_uint(x), __float_as_uint(x), false, false); return __uint_as_float(r[0]) + __uint_as_float(r[1]); }
__device__ __forceinline__ float xor16_max(float x) { const auto r = __builtin_amdgcn_permlane16_swap(__float_as_uint(x), __float_as_uint(x), false, false); return fmaxf(__uint_as_float(r[0]), __uint_as_float(r[1])); }
__device__ __forceinline__ float swap32_pair(float a, float b) { const auto r = __builtin_amdgcn_permlane32_swap(__float_as_uint(a), __float_as_uint(b), false, false); return __uint_as_float(r[0]) + __uint_as_float(r[1]); }
__device__ __forceinline__ float swap16_pair(float a, float b) { const auto r = __builtin_amdgcn_permlane16_swap(__float_as_uint(a), __float_as_uint(b), false, false); return __uint_as_float(r[0]) + __uint_as_float(r[1]); }
__device__ __forceinline__ float row_sum16(float v) { v += dpp_f<DPP_XOR1>(v); v += dpp_f<DPP_XOR2>(v); v += dpp_f<DPP_HMIRROR>(v); v += dpp_f<DPP_MIRROR>(v); return v; }
__device__ __forceinline__ float row_max16(float v) { v = fmaxf(v, dpp_f<DPP_XOR1>(v)); v = fmaxf(v, dpp_f<DPP_XOR2>(v)); v = fmaxf(v, dpp_f<DPP_HMIRROR>(v)); v = fmaxf(v, dpp_f<DPP_MIRROR>(v)); return v; }
__device__ __forceinline__ float wave_sum(float v) { return xor32_sum(xor16_sum(row_sum16(v))); }
__device__ __forceinline__ float sigmoidf_(float x) { return __builtin_amdgcn_rcpf(1.0f + __expf(-x)); }
__device__ __forceinline__ float dot8(u32x4 w, const float* h) {
    return bf_lo(w.x) * h[0] + bf_hi(w.x) * h[1] + bf_lo(w.y) * h[2] + bf_hi(w.y) * h[3] + bf_lo(w.z) * h[4] + bf_hi(w.z) * h[5] + bf_lo(w.w) * h[6] + bf_hi(w.w) * h[7];
}

__device__ __forceinline__ int lane_now() { int l; asm volatile("v_mbcnt_lo_u32_b32 %0, -1, 0\n\tv_mbcnt_hi_u32_b32 %0, -1, %0" : "=v"(l)); return l; }

#define XB_TMO      128
#define XB_XCNT(j)  (256  + 64 * (j))
#define XB_XSUB(j)  (1280 + 64 * (j))
#define XB_XGEN(j)  (2304 + 64 * (j))
#define XB_TOP      3328
#define XB_TOPGEN   3392
#define XCD_BAR_WORDS 3456
#define XB_SPIN_CAP (1u << 18)

__device__ __forceinline__ unsigned xb_ld(unsigned* p)              { return __hip_atomic_load(p, __ATOMIC_RELAXED, __HIP_MEMORY_SCOPE_AGENT); }
__device__ __forceinline__ unsigned xb_add(unsigned* p, unsigned v) { return __hip_atomic_fetch_add(p, v, __ATOMIC_RELAXED, __HIP_MEMORY_SCOPE_AGENT); }
__device__ __forceinline__ unsigned xb_xcc_id() { return (unsigned)__builtin_amdgcn_s_getreg((3 << 11) | 20) & 0xFu; }
#define XB_SPIN(cond, bar) do { unsigned _sp = 0; while (cond) { __builtin_amdgcn_s_sleep(1); \
    if ((++_sp & 255u) == 0u) { if (xb_ld(&(bar)[XB_TMO])) break; if (_sp > XB_SPIN_CAP) { atomicAdd(&(bar)[XB_TMO], 1u); break; } } } } while (0)

struct XcdBarrier { unsigned* bar; unsigned x; volatile LAS unsigned* st; };

__device__ __forceinline__ XcdBarrier xcd_barrier_post(unsigned* bar, volatile LAS unsigned* st) {
    XcdBarrier b; b.bar = bar; b.x = xb_xcc_id(); b.st = st;
    if (threadIdx.x == 0) (void)xb_add(&bar[XB_XCNT(b.x)], 1u);
    return b;
}
__device__ __forceinline__ void xcd_barrier_complete(unsigned* bar, unsigned x, unsigned& nloc, unsigned& nx) {
    const unsigned G = gridDim.x * gridDim.y * gridDim.z;
    unsigned sum, cnt, mine, sp = 0u;
    for (;;) {
        sum = 0u; cnt = 0u; mine = 0u;
#pragma unroll
        for (unsigned j = 0; j < 16; ++j) { const unsigned c = xb_ld(&bar[XB_XCNT(j)]); sum += c; cnt += (c > 0u) ? 1u : 0u; mine = (j == x) ? c : mine; }
        if (sum == G) break;
        __builtin_amdgcn_s_sleep(1);
        if ((++sp & 255u) == 0u) { if (xb_ld(&bar[XB_TMO])) break; if (sp > XB_SPIN_CAP) { atomicAdd(&bar[XB_TMO], 1u); break; } }
    }
    nloc = mine > 0u ? mine : 1u; nx = cnt > 0u ? cnt : 1u;
}
__device__ __forceinline__ void xcd_barrier(const XcdBarrier& b, int wave) {
    asm volatile("s_waitcnt vmcnt(0)" ::: "memory");
    __syncthreads();
    if (wave == 0 && lane_now() == 0) {
        unsigned* bar = b.bar;
        __builtin_amdgcn_s_waitcnt(0);
        unsigned nloc = b.st[0], nx = b.st[1];
        if (nloc == 0u) { xcd_barrier_complete(bar, b.x, nloc, nx); b.st[0] = nloc; b.st[1] = nx; }
        const unsigned old = xb_add(&bar[XB_XSUB(b.x)], 1u);
        const unsigned gen = old / nloc;
        if (old + 1u == (gen + 1u) * nloc) {
            __builtin_amdgcn_fence(__ATOMIC_RELEASE, "agent");
            asm volatile("s_waitcnt vmcnt(0)" ::: "memory");
            const unsigned og = xb_add(&bar[XB_TOP], 1u);
            const unsigned tg = og / nx;
            if (og + 1u == (tg + 1u) * nx) xb_add(&bar[XB_TOPGEN], 1u);
            else XB_SPIN(xb_ld(&bar[XB_TOPGEN]) == tg, bar);
            __builtin_amdgcn_fence(__ATOMIC_ACQUIRE, "agent");
            xb_add(&bar[XB_XGEN(b.x)], 1u);
            asm volatile("s_waitcnt vmcnt(0)" ::: "memory");
        } else {
            XB_SPIN(xb_ld(&bar[XB_XGEN(b.x)]) == gen, bar);
            __builtin_amdgcn_fence(__ATOMIC_ACQUIRE, "agent");
            asm volatile("s_waitcnt vmcnt(0)" ::: "memory");
        }
    }
    __syncthreads();
}

namespace pg8 {
constexpr int BM = 256, BK = 64, HALF = 128, HTB = HALF * BK * 2, STAGE_BYTES = 8 * HTB, NXCD = 8, WGM = 8;
__device__ __forceinline__ int lds_byte(int r, int c) { const int st = (r >> 4) * 2 + (c >> 5), rr = r & 15, cc = c & 31, ob = rr * 64 + cc * 2; return st * 1024 + (ob ^ (((ob >> 9) & 1) << 5)); }
__device__ __forceinline__ void stage_rc(int b, int& R, int& C) { const int st = b / 1024, sb = b % 1024, swz = sb ^ (((sb >> 9) & 1) << 5); R = (st >> 1) * 16 + swz / 64; C = (st & 1) * 32 + (swz % 64) / 2; }
__device__ __forceinline__ int perm32(int rho) { const int n = rho >> 4, i = rho & 15; return 8 * (i >> 2) + 4 * n + (i & 3); }

struct Unit { int pm, pn; };
struct Gemm { const bf16_t* A; const bf16_t* Bt; int M, N, K, lda, a_pn_off; const bf16_t* A2; const bf16_t* Bt2; int ksplit, ldb; };

struct StaticOrder {
    int nM, nN, nwg, G, c;
    __device__ void init(int M, int N, int G_, int c_) { nM = M / BM; nN = N / BM; nwg = nM * nN; G = G_; c = c_; }
    __device__ bool next(int i, Unit& u) const {
        const long L = (long)i * G + c; if (L >= nwg) return false;
        int wgid = (int)L; { const int q = nwg / NXCD, r = nwg % NXCD, xcd = wgid % NXCD, off = wgid / NXCD; wgid = (xcd < r ? xcd * (q + 1) : r * (q + 1) + (xcd - r) * q) + off; }
        const int nig = WGM * nN, gid = wgid / nig, fm = gid * WGM, gsz = (nM - fm) < WGM ? (nM - fm) : WGM;
        u.pm = fm + ((wgid % nig) % gsz); u.pn = (wgid % nig) / gsz; return true;
    }
};

typedef int i32x4 __attribute__((ext_vector_type(4)));
typedef int i32x8 __attribute__((ext_vector_type(8)));
__device__ __forceinline__ bf16x8 lo8(i32x8 v) { return __builtin_bit_cast(bf16x8, (i32x4){v.s0, v.s1, v.s2, v.s3}); }
__device__ __forceinline__ bf16x8 hi8(i32x8 v) { return __builtin_bit_cast(bf16x8, (i32x4){v.s4, v.s5, v.s6, v.s7}); }
__device__ __forceinline__ i32x8 cat8(bf16x8 a, bf16x8 b) { const i32x4 x = __builtin_bit_cast(i32x4, a), y = __builtin_bit_cast(i32x4, b); return (i32x8){x.x, x.y, x.z, x.w, y.x, y.y, y.z, y.w}; }
template <class Epi, bool F8 = false>
__device__ __forceinline__ void gemm_phase(LAS unsigned char* lds, const Gemm g, const StaticOrder& S, const Epi& E, int wave) {
    const int lane = lane_now(), wid = wave, tid = wid * 64 + lane, wr = wid >> 2, wc = wid & 3, fr = lane & 15, fq = lane >> 4;
    const int K = g.K, nt = K / BK, lda = g.lda, ldb = g.ldb ? g.ldb : g.K, ksplit = g.ksplit;
    unsigned voffA, voffB;
    { int R, C; stage_rc(tid * 16, R, C); const int Rb = Epi::PERM ? ((R & ~31) + perm32(R & 31)) : R;
      voffA = (unsigned)(R * lda + C) * 2u; voffB = (unsigned)(Rb * ldb + C) * 2u; }
    const unsigned stepA = 64u * (unsigned)lda * 2u, stepB = 64u * (unsigned)ldb * 2u;
    const size_t kstep = (size_t)(BK * 2);
    const size_t hsA = (size_t)HALF * lda * 2, hsB = (size_t)HALF * ldb * 2;
    const size_t tsA = 2 * hsA, tsB = 2 * hsB;
    const unsigned ldsw = (unsigned)wid * 1024u, ldsbase = (unsigned)(unsigned long long)lds;
    const int aoff = lds_byte(wr * 64 + fr, fq * 8), boff = lds_byte(wc * 32 + fr, fq * 8);
#define PG8_SA(b, h) (((b) * 2 + (h)) * HTB)
#define PG8_SB(b, h) ((4 + (b) * 2 + (h)) * HTB)
#define PG8_STAGE(bufoff, gbase, voff) do { _Pragma("unroll") for (int _i = 0; _i < 2; ++_i) { \
        const char* sb_ = (const char*)(gbase) + (size_t)_i * PG8_STEP_##voff; const unsigned m0_ = ldsbase + (unsigned)(bufoff) + ldsw + (unsigned)_i * 8192u; \
        asm volatile("s_mov_b32 m0, %2\n\ts_nop 0\n\tglobal_load_lds_dwordx4 %0, %1" :: "v"(voff), "s"(sb_), "s"(m0_) : "memory"); } } while (0)
#define PG8_STEP_voffA stepA
#define PG8_STEP_voffB stepB
#define PG8_LDA(dst, b, h) do { _Pragma("unroll") for (int m = 0; m < 4; ++m) dst[m] = cat8(*(const LAS bf16x8*)(lds + PG8_SA(b, h) + aoff + m * 2048), *(const LAS bf16x8*)(lds + PG8_SA(b, h) + aoff + m * 2048 + 1024)); } while (0)
#define PG8_LDB(dst, b, h) do { _Pragma("unroll") for (int n = 0; n < 2; ++n) dst[n] = cat8(*(const LAS bf16x8*)(lds + PG8_SB(b, h) + boff + n * 2048), *(const LAS bf16x8*)(lds + PG8_SB(b, h) + boff + n * 2048 + 1024)); } while (0)
#define PG8_MMA(ai, bj, At, Bt) do { __builtin_amdgcn_s_setprio(1); _Pragma("unroll") for (int m = 0; m < 4; ++m) _Pragma("unroll") for (int n = 0; n < 2; ++n) { \
        if constexpr (F8) acc[ai][bj][m][n] = __builtin_amdgcn_mfma_scale_f32_16x16x128_f8f6f4(Bt[n], At[m], acc[ai][bj][m][n], 0, 0, 0, 0x7D7D7D7D  , 0, 0x7D7D7D7D); \
        else { acc[ai][bj][m][n] = __builtin_amdgcn_mfma_f32_16x16x32_bf16(lo8(Bt[n]), lo8(At[m]), acc[ai][bj][m][n], 0, 0, 0); \
               acc[ai][bj][m][n] = __builtin_amdgcn_mfma_f32_16x16x32_bf16(hi8(Bt[n]), hi8(At[m]), acc[ai][bj][m][n], 0, 0, 0); } } \
        __builtin_amdgcn_s_setprio(0); } while (0)
#define PG8_WAIT_V(n) asm volatile("s_waitcnt vmcnt(" #n ")" ::: "memory")
#define PG8_WAIT_L(n) asm volatile("s_waitcnt lgkmcnt(" #n ")" ::: "memory")
#define PG8_BAR __builtin_amdgcn_s_barrier()
#define PG8_SCHED __builtin_amdgcn_sched_barrier(0)
    Unit cur, nxt; int ui = 0;
    if (!S.next(0, cur)) return;
    f32x4 acc[2][2][4][2];
#pragma unroll
    for (int a = 0; a < 2; ++a)
#pragma unroll
        for (int b = 0; b < 2; ++b)
#pragma unroll
            for (int m = 0; m < 4; ++m)
#pragma unroll
                for (int n = 0; n < 2; ++n) acc[a][b][m][n] = (f32x4){0.f, 0.f, 0.f, 0.f};
    i32x8 At[4], B0[2], B1[2];
    const char* cA = (const char*)g.A + (size_t)cur.pm * tsA + (size_t)cur.pn * g.a_pn_off * 2; const char* cB = (const char*)g.Bt + (size_t)cur.pn * tsB;
    PG8_STAGE(PG8_SB(0, 0), cB, voffB); PG8_STAGE(PG8_SB(0, 1), cB + hsB, voffB); PG8_STAGE(PG8_SA(0, 0), cA, voffA); PG8_STAGE(PG8_SA(0, 1), cA + hsA, voffA);
    if (wr == 1) PG8_BAR;
    PG8_WAIT_V(2); PG8_BAR;
    PG8_STAGE(PG8_SB(1, 0), cB + kstep, voffB); PG8_STAGE(PG8_SA(1, 0), cA + kstep, voffA); PG8_STAGE(PG8_SB(1, 1), cB + hsB + kstep, voffB);
    PG8_WAIT_V(6); PG8_BAR;
    for (;;) {
        const bool has_next = S.next(ui + 1, nxt);
        const char* nA = has_next ? (const char*)g.A + (size_t)nxt.pm * tsA + (size_t)nxt.pn * g.a_pn_off * 2 : cA; const char* nB = has_next ? (const char*)g.Bt + (size_t)nxt.pn * tsB : cB;
        const char* cA2 = (const char*)g.A2 + (size_t)cur.pm * tsA; const char* cB2 = (const char*)g.Bt2 + (size_t)cur.pn * tsB;
#pragma clang loop unroll(disable)
        for (int t = 0; t < nt; t += 2) {
            const bool last = (t == nt - 2);
            const bool s1 = ksplit && (t >= ksplit), s2 = ksplit && (t + 2 >= ksplit);
            const char* a1 = (s1 ? cA2 + (size_t)(t - ksplit + 1) * kstep : cA + (size_t)(t + 1) * kstep);
            const char* a2 = last ? nA : (s2 ? cA2 + (size_t)(t + 2 - ksplit) * kstep : cA + (size_t)(t + 2) * kstep);
            const char* b2 = last ? nB : (s2 ? cB2 + (size_t)(t + 2 - ksplit) * kstep : cB + (size_t)(t + 2) * kstep);
            const char* a3 = a2 + kstep; const char* b3 = b2 + kstep;
            PG8_LDB(B0, 0, 0); PG8_LDB(B1, 0, 1); PG8_SCHED; PG8_LDA(At, 0, 0); PG8_STAGE(PG8_SA(1, 1), a1 + hsA, voffA);
            PG8_WAIT_V(8); PG8_WAIT_L(0); PG8_BAR; PG8_MMA(0, 0, At, B0); PG8_MMA(0, 1, At, B1); PG8_BAR; PG8_SCHED;
            PG8_LDA(At, 0, 1); PG8_STAGE(PG8_SB(0, 0), b2, voffB); PG8_STAGE(PG8_SB(0, 1), b2 + hsB, voffB); PG8_STAGE(PG8_SA(0, 0), a2, voffA);
            PG8_WAIT_V(8); PG8_WAIT_L(0); PG8_BAR; PG8_MMA(1, 0, At, B0); PG8_MMA(1, 1, At, B1); PG8_BAR; PG8_SCHED;
            PG8_LDB(B0, 1, 0); PG8_LDB(B1, 1, 1); PG8_SCHED; PG8_LDA(At, 1, 0); PG8_STAGE(PG8_SA(0, 1), a2 + hsA, voffA);
            PG8_WAIT_V(8); PG8_WAIT_L(0); PG8_BAR; PG8_MMA(0, 0, At, B0); PG8_MMA(0, 1, At, B1); PG8_BAR; PG8_SCHED;
            PG8_LDA(At, 1, 1); PG8_STAGE(PG8_SB(1, 0), b3, voffB); PG8_STAGE(PG8_SB(1, 1), b3 + hsB, voffB); PG8_STAGE(PG8_SA(1, 0), a3, voffA);
            PG8_WAIT_V(8); PG8_WAIT_L(0); PG8_BAR; PG8_MMA(1, 0, At, B0); PG8_MMA(1, 1, At, B1); PG8_BAR; PG8_SCHED;
            if constexpr (Epi::MID) { if (t + 2 == ksplit) E.mid(acc, cur, wr, wc, fr, fq); }
        }
        if (wr == 0) PG8_BAR;
        { const int l2 = lane_now(); E(acc, cur, wr, wc, l2 & 15, l2 >> 4); }
        if (!has_next) break;
#pragma unroll
        for (int a = 0; a < 2; ++a)
#pragma unroll
            for (int b = 0; b < 2; ++b)
#pragma unroll
                for (int m = 0; m < 4; ++m)
#pragma unroll
                    for (int n = 0; n < 2; ++n) acc[a][b][m][n] = (f32x4){0.f, 0.f, 0.f, 0.f};
        cur = nxt; cA = nA; cB = nB; ++ui;
        if (wr == 1) PG8_BAR;
    }
    PG8_WAIT_V(0);
    PG8_BAR;
#undef PG8_SA
#undef PG8_SB
#undef PG8_STAGE
#undef PG8_STEP_voffA
#undef PG8_STEP_voffB
#undef PG8_LDA
#undef PG8_LDB
#undef PG8_MMA
#undef PG8_WAIT_V
#undef PG8_WAIT_L
#undef PG8_BAR
#undef PG8_SCHED
}
}
using pg8::Unit;

typedef f32x4 AccT[2][2][4][2];
__device__ __forceinline__ u32x4 pack8(f32x4 a, f32x4 b) { u32x4 w; w.x = cvt_pk_bf16(a[0], a[1]); w.y = cvt_pk_bf16(a[2], a[3]); w.z = cvt_pk_bf16(b[0], b[1]); w.w = cvt_pk_bf16(b[2], b[3]); return w; }
__device__ __forceinline__ u32x2 pack8_fp8(f32x4 a, f32x4 b) {
    int w0 = __builtin_amdgcn_cvt_pk_fp8_f32(a[0], a[1], 0, false); w0 = __builtin_amdgcn_cvt_pk_fp8_f32(a[2], a[3], w0, true);
    int w1 = __builtin_amdgcn_cvt_pk_fp8_f32(b[0], b[1], 0, false); w1 = __builtin_amdgcn_cvt_pk_fp8_f32(b[2], b[3], w1, true);
    return (u32x2){(unsigned)w0, (unsigned)w1};
}
__device__ __forceinline__ void unpack8(u32x4 w, f32x4& a, f32x4& b) { a = (f32x4){bf_lo(w.x), bf_hi(w.x), bf_lo(w.y), bf_hi(w.y)}; b = (f32x4){bf_lo(w.z), bf_hi(w.z), bf_lo(w.w), bf_hi(w.w)}; }

template <bool SET8> struct EpiInproj {
    static constexpr bool PERM = true, MID = false;
    bf16_t *q, *k, *v, *iq, *ik, *pl, *ga, *gp; float* iw;
    __device__ __forceinline__ void operator()(const AccT& acc, const Unit& u, int wr, int wc, int fr, int fq) const {
        const int pn = u.pn, row0 = u.pm * 256 + wr * 64 + fr;
        if (!SET8 && pn == 4) {
            if (wc < 2) {
#pragma unroll
                for (int ai = 0; ai < 2; ++ai)
#pragma unroll
                    for (int m = 0; m < 4; ++m) { const size_t row = (size_t)(row0 + ai * 128 + m * 16);
                        *(u32x4*)(ik + row * 64 + wc * 32 + 8 * fq) = pack8(acc[ai][0][m][0], acc[ai][0][m][1]); }
            } else if (wc == 2) {
                if (fq < 2) {
#pragma unroll
                    for (int ai = 0; ai < 2; ++ai)
#pragma unroll
                        for (int m = 0; m < 4; ++m) { const size_t row = (size_t)(row0 + ai * 128 + m * 16);
                            *(f32x4*)(iw + row * 16 + 8 * fq) = acc[ai][0][m][0]; *(f32x4*)(iw + row * 16 + 8 * fq + 4) = acc[ai][0][m][1]; }
                }
            }
            return;
        }
        bf16_t* dst; int ld, tc; bool sg = false;
        if (SET8) {
            if (pn < 4) { dst = q; ld = 1024; tc = pn * 256; }
            else if (pn == 4) { dst = k; ld = 256; tc = 0; }
            else if (pn == 5) { dst = v; ld = 256; tc = 0; }
            else if (pn < 14) { dst = ga; ld = 2048; tc = (pn - 6) * 256; sg = true; }
            else { dst = gp; ld = 2048; tc = (pn - 14) * 256; sg = true; }
        } else {
            if (pn < 4) { dst = iq; ld = 1024; tc = pn * 256; }
            else { dst = pl; ld = 1024; tc = (pn - 5) * 256; }
        }
        const int col0 = tc + wc * 32 + 8 * fq;
#pragma unroll
        for (int ai = 0; ai < 2; ++ai)
#pragma unroll
            for (int m = 0; m < 4; ++m) { bf16_t* rowp = dst + (size_t)(row0 + ai * 128 + m * 16) * ld + col0;
#pragma unroll
                for (int bj = 0; bj < 2; ++bj) { f32x4 v0 = acc[ai][bj][m][0], v1 = acc[ai][bj][m][1];
                    if (sg) {
#pragma unroll
                        for (int j = 0; j < 4; ++j) { v0[j] = sigmoidf_(v0[j]); v1[j] = sigmoidf_(v1[j]); } }
                    *(u32x4*)(rowp + bj * 128) = pack8(v0, v1); } }
    }
};
struct EpiBf16Scale {
    static constexpr bool PERM = true, MID = false;
    bf16_t* O; int ldc; const float* cs;
    __device__ __forceinline__ void operator()(const AccT& acc, const Unit& u, int wr, int wc, int fr, int fq) const {
        const int row0 = u.pm * 256 + wr * 64 + fr, col0 = u.pn * 256 + wc * 32 + 8 * fq;
        f32x4 s[2][2];
#pragma unroll
        for (int bj = 0; bj < 2; ++bj)
#pragma unroll
            for (int n = 0; n < 2; ++n) s[bj][n] = cs ? *(const f32x4*)(cs + col0 + bj * 128 + 4 * n) : (f32x4){1.f, 1.f, 1.f, 1.f};
#pragma unroll
        for (int ai = 0; ai < 2; ++ai)
#pragma unroll
            for (int m = 0; m < 4; ++m) { bf16_t* rowp = O + (size_t)(row0 + ai * 128 + m * 16) * ldc + col0;
#pragma unroll
                for (int bj = 0; bj < 2; ++bj) *(u32x4*)(rowp + bj * 128) = pack8(acc[ai][bj][m][0] * s[bj][0], acc[ai][bj][m][1] * s[bj][1]); }
    }
};
struct EpiF8Scale {
    static constexpr bool PERM = true, MID = false;
    unsigned char* O; int ldc; const float* cs;
    __device__ __forceinline__ void operator()(const AccT& acc, const Unit& u, int wr, int wc, int fr, int fq) const {
        const int row0 = u.pm * 256 + wr * 64 + fr, col0 = u.pn * 256 + wc * 32 + 8 * fq;
        f32x4 s[2][2];
#pragma unroll
        for (int bj = 0; bj < 2; ++bj)
#pragma unroll
            for (int n = 0; n < 2; ++n) s[bj][n] = *(const f32x4*)(cs + col0 + bj * 128 + 4 * n);
#pragma unroll
        for (int ai = 0; ai < 2; ++ai)
#pragma unroll
            for (int m = 0; m < 4; ++m) { unsigned char* rowp = O + (size_t)(row0 + ai * 128 + m * 16) * ldc + col0;
#pragma unroll
                for (int bj = 0; bj < 2; ++bj) *(u32x2*)(rowp + bj * 128) = pack8_fp8(acc[ai][bj][m][0] * s[bj][0], acc[ai][bj][m][1] * s[bj][1]); }
    }
};
template <bool ADD> struct EpiGate {
    static constexpr bool PERM = true, MID = false;
    bf16_t* O; const bf16_t* gate;
    __device__ __forceinline__ void operator()(const AccT& acc, const Unit& u, int wr, int wc, int fr, int fq) const {
        const int row0 = u.pm * 256 + wr * 64 + fr, col0 = u.pn * 256 + wc * 32 + 8 * fq;
#pragma unroll
        for (int ai = 0; ai < 2; ++ai)
#pragma unroll
            for (int m = 0; m < 4; ++m) { const size_t off = (size_t)(row0 + ai * 128 + m * 16) * 2048 + col0;
#pragma unroll
                for (int bj = 0; bj < 2; ++bj) { f32x4 g0, g1; unpack8(*(const u32x4*)(gate + off + bj * 128), g0, g1);
                    f32x4 r0 = g0 * acc[ai][bj][m][0], r1 = g1 * acc[ai][bj][m][1];
                    if (ADD) { f32x4 o0, o1; unpack8(*(const u32x4*)(O + off + bj * 128), o0, o1); r0 += o0; r1 += o1; }
                    *(u32x4*)(O + off + bj * 128) = pack8(r0, r1); } }
    }
};
struct EpiMerge {
    static constexpr bool PERM = true, MID = true;
    unsigned char* O; const bf16_t* ga; const bf16_t* gp;
    __device__ __forceinline__ void mid(AccT& acc, const Unit& u, int wr, int wc, int fr, int fq) const {
        const auto ra = __builtin_amdgcn_make_buffer_rsrc((void*)ga, 0, 0x7FFFFFFF, 0x00020000), rp = __builtin_amdgcn_make_buffer_rsrc((void*)gp, 0, 0x7FFFFFFF, 0x00020000);
        const int voff = ((wr * 64 + fr) * 2048 + wc * 32 + 8 * fq) * 2;
        const int sbase = (u.pm * 256 * 2048 + u.pn * 256) * 2;
#pragma unroll
        for (int ai = 0; ai < 2; ++ai)
#pragma unroll
            for (int m = 0; m < 4; ++m)
#pragma unroll
                for (int bj = 0; bj < 2; ++bj) { const int so = sbase + ((ai * 128 + m * 16) * 2048 + bj * 128) * 2;
                    const u32x4 wa = __builtin_bit_cast(u32x4, __builtin_amdgcn_raw_buffer_load_b128(ra, voff, so, 0)), wp = __builtin_bit_cast(u32x4, __builtin_amdgcn_raw_buffer_load_b128(rp, voff, so, 0));
                    f32x4 a0, a1, p0, p1; unpack8(wa, a0, a1); unpack8(wp, p0, p1);
#pragma unroll
                    for (int j = 0; j < 4; ++j) { acc[ai][bj][m][0][j] *= a0[j] * __builtin_amdgcn_rcpf(p0[j]); acc[ai][bj][m][1][j] *= a1[j] * __builtin_amdgcn_rcpf(p1[j]); }
                    asm volatile("" : "+v"(acc[ai][bj][m][0]), "+v"(acc[ai][bj][m][1]) :: "memory"); }
    }
    __device__ __forceinline__ void operator()(const AccT& acc, const Unit& u, int wr, int wc, int fr, int fq) const {
        const int row0 = u.pm * 256 + wr * 64 + fr, col0 = u.pn * 256 + wc * 32 + 8 * fq;
#pragma unroll
        for (int ai = 0; ai < 2; ++ai)
#pragma unroll
            for (int m = 0; m < 4; ++m) { const size_t off = (size_t)(row0 + ai * 128 + m * 16) * 2048 + col0;
#pragma unroll
                for (int bj = 0; bj < 2; ++bj) { f32x4 p0, p1; unpack8(*(const u32x4*)(gp + off + bj * 128), p0, p1);
                    *(u32x2*)(O + off + bj * 128) = pack8_fp8(p0 * acc[ai][bj][m][0], p1 * acc[ai][bj][m][1]); } }
    }
};
struct EpiResid {
    static constexpr bool PERM = false, MID = false;
    const float* x; float* out; const float* gt;
    __device__ __forceinline__ void operator()(const AccT& acc, const Unit& u, int wr, int wc, int fr, int fq) const {
        const int row0 = u.pm * 256 + wr * 64 + fr, col0 = u.pn * 256 + wc * 32 + 4 * fq;
        const float* gtb = gt + (size_t)(u.pm / 16) * 12288;
        f32x4 g[2][2];
#pragma unroll
        for (int bj = 0; bj < 2; ++bj)
#pragma unroll
            for (int n = 0; n < 2; ++n) g[bj][n] = *(const f32x4*)(gtb + col0 + bj * 128 + n * 16);
#pragma unroll
        for (int ai = 0; ai < 2; ++ai)
#pragma unroll
            for (int m = 0; m < 4; ++m) { const size_t off = (size_t)(row0 + ai * 128 + m * 16) * 2048 + col0;
#pragma unroll
                for (int bj = 0; bj < 2; ++bj)
#pragma unroll
                    for (int n = 0; n < 2; ++n) { const f32x4 xv = *(const f32x4*)(x + off + bj * 128 + n * 16);
                        *(f32x4*)(out + off + bj * 128 + n * 16) = xv + g[bj][n] * acc[ai][bj][m][n]; } }
    }
};
struct EpiF32 {
    static constexpr bool PERM = false, MID = false;
    float* C; int ldc;
    __device__ __forceinline__ void operator()(const AccT& acc, const Unit& u, int wr, int wc, int fr, int fq) const {
        const int row0 = u.pm * 256 + wr * 64 + fr, col0 = u.pn * 256 + wc * 32 + 4 * fq;
#pragma unroll
        for (int ai = 0; ai < 2; ++ai)
#pragma unroll
            for (int m = 0; m < 4; ++m) { float* rowp = C + (size_t)(row0 + ai * 128 + m * 16) * ldc + col0;
#pragma unroll
                for (int bj = 0; bj < 2; ++bj)
#pragma unroll
                    for (int n = 0; n < 2; ++n) *(f32x4*)(rowp + bj * 128 + n * 16) = acc[ai][bj][m][n]; }
    }
};

struct Args { const float* in[19]; float* out; unsigned char* ws; int ph_lo, ph_hi; int li, pad; };
struct Frame {
    unsigned char* lds; unsigned char* ws;
    int tid, lane, wave, G, bid;
    const float *x, *c, *w_ada, *b_ada, *g1, *g2, *w_in, *g_q, *g_k, *rel_bias, *pool_w, *pool_scale, *w_ab, *w_pb, *w_out, *w_pq, *peer_keys, *peer_u, *peer_v;
    float* out;
};

template <bool F8OUT = false, class Fn> __device__ __forceinline__ void transpose_item(const float* W, int K, int N, void* WTv, int ldk, int drow0, int k0, float* scr, int lane, Fn srccol, float mul = 1.0f) {
    const int sc = srccol(drow0 + (lane & 31));
#pragma unroll 8
    for (int i = 0; i < 32; ++i) { const int kk = 2 * i + (lane >> 5); scr[kk * 33 + (lane & 31)] = sc >= 0 ? W[(size_t)(k0 + kk) * N + sc] * mul : 0.f; }
    asm volatile("s_waitcnt lgkmcnt(0)" ::: "memory");
    const int c = lane & 7;
#pragma unroll
    for (int j = 0; j < 4; ++j) { const int n = (lane >> 3) + 8 * j; const float* s = scr + (8 * c) * 33 + n;
        if constexpr (F8OUT) { *(u32x2*)((unsigned char*)WTv + (size_t)(drow0 + n) * ldk + k0 + 8 * c) = pack8_fp8((f32x4){s[0 * 33], s[1 * 33], s[2 * 33], s[3 * 33]}, (f32x4){s[4 * 33], s[5 * 33], s[6 * 33], s[7 * 33]}); }
        else { u32x4 o; o.x = cvt_pk_bf16(s[0 * 33], s[1 * 33]); o.y = cvt_pk_bf16(s[2 * 33], s[3 * 33]); o.z = cvt_pk_bf16(s[4 * 33], s[5 * 33]); o.w = cvt_pk_bf16(s[6 * 33], s[7 * 33]);
            *(u32x4*)((bf16_t*)WTv + (size_t)(drow0 + n) * ldk + k0 + 8 * c) = o; } }
    asm volatile("s_waitcnt lgkmcnt(0)" ::: "memory");
}
__device__ __forceinline__ void phase0_prep(Frame& F) {
    F.lane = lane_now(); F.tid = F.wave * 64 + F.lane;
    const int gw = F.bid * 8 + F.wave, NGW = F.G * 8;
    float* scr = (float*)(F.lds + F.wave * 16384);
    constexpr int I_IN16 = (2304 / 32) * (DM / 64), I_IN8 = (5632 / 32) * (DM / 64);
    constexpr int I_AB = (2048 / 32) * (1024 / 64), I_OUT = (2048 / 32) * (2048 / 64), I_PW = 4 * 8 * 4;
    constexpr int NIT = I_IN16 + I_IN8 + 2 * I_AB + 2 * I_OUT + I_PW;
    auto ident = [](int j) { return j; };
    for (int it = gw; it < NIT; it += NGW) {
        int r = it;
        if (r < I_IN16) { const int nb = r % 72, kb = r / 72;
            transpose_item(F.w_in, DM, INW, F.ws + WS_WIN16, DM, nb * 32, kb * 64, scr, F.lane, [](int j) { return j < 1104 ? j + 1536 : (j < 1280 ? -1 : j + 1360); }); continue; }
        r -= I_IN16;
        if (r < I_IN8) { const int nb = r % 176, kb = r / 176;
            transpose_item<true>(F.w_in, DM, INW, F.ws + WS_WIN8, DM, nb * 32, kb * 64, scr, F.lane, [](int j) { return j < 1536 ? j : j + 2128; }, 16.0f); continue; }
        r -= I_IN8;
        if (r < I_AB) { transpose_item<true>(F.w_ab, 1024, 2048, F.ws + WS_WAB, 1024, (r % 64) * 32, (r / 64) * 64, scr, F.lane, ident, 16.0f); continue; }
        r -= I_AB;
        if (r < I_AB) { transpose_item<true>(F.w_pb, 1024, 2048, F.ws + WS_WPB, 1024, (r % 64) * 32, (r / 64) * 64, scr, F.lane, ident, 16.0f); continue; }
        r -= I_AB;
        if (r < I_OUT) { transpose_item<true>(F.w_out, 2048, 2048, F.ws + WS_WOUT, 2048, (r % 64) * 32, (r / 64) * 64, scr, F.lane, ident, 16.0f); continue; }
        r -= I_OUT;
        if (r < I_OUT) { transpose_item(F.w_pq, 2048, 2048, (bf16_t*)(F.ws + WS_WPQ), 2048, (r % 64) * 32, (r / 64) * 64, scr, F.lane, ident); continue; }
        r -= I_OUT;
        { const int g = r / 32, q = r % 32, nb = q % 8, kb = q / 8;
          transpose_item(F.pool_w + (size_t)g * 65536, 256, 256, (bf16_t*)(F.ws + WS_POOLW) + (size_t)g * 65536, 256, nb * 32, kb * 64, scr, F.lane, ident); }
    }
    {
        bf16_t* kb = (bf16_t*)(F.ws + WS_KEYSBD);
        for (int i = F.bid * 512 + F.tid; i < 2048 * 32; i += F.G * 512) {
            const int row = i / 32, k8 = (i % 32) * 8, p = (row >> 7) & 1;
            u32x4 o = (u32x4){0u, 0u, 0u, 0u};
            if ((k8 >> 7) == p) { const float* s = F.peer_keys + (size_t)row * 128 + (k8 & 127); const f32x4 a = *(const f32x4*)s, b = *(const f32x4*)(s + 4); o = pack8(a, b); }
            *(u32x4*)(kb + (size_t)row * 256 + k8) = o;
        }
    }
    {
        unsigned char* pu = F.ws + WS_PU;
        for (size_t i = (size_t)F.bid * 512 + F.tid; i < (size_t)NEXP * 64; i += (size_t)F.G * 512) {
            const float* src = F.peer_u + i * 32;
            u32x16 pk;
#pragma unroll
            for (int k = 0; k < 8; ++k) { const f32x4 a = *(const f32x4*)(src + k * 4) * 96.0f; pk[2 * k] = cvt_pk_bf16(a[0], a[1]); pk[2 * k + 1] = cvt_pk_bf16(a[2], a[3]); }
            const u32x6 p6 = __builtin_amdgcn_cvt_scalef32_pk32_fp6_bf16(__builtin_bit_cast(bf16x32, pk), 1.0f);
            const int ci = (int)(i & 63), lp = (ci >> 2) + 16 * (ci & 3);
            unsigned char* dst = pu + (i >> 6) * 1536;
            *(u32x4*)(dst + lp * 16) = (u32x4){p6[0], p6[1], p6[2], p6[3]}; *(u32x2*)(dst + 1024 + lp * 8) = (u32x2){p6[4], p6[5]};
        }
        unsigned char* pv = F.ws + WS_PV;
        for (int it = gw; it < (NEXP / 64) * 128; it += NGW) {
            const int e = (it >> 7) * 64 + F.lane, ch = it & 127;
            u32x4 ov;
#pragma unroll
            for (int k = 0; k < 4; ++k) { const f32x4 c = *(const f32x4*)(F.peer_v + (size_t)e * DM + ch * 16 + k * 4) * 4.0f;
                int wv = __builtin_amdgcn_cvt_pk_fp8_f32(c[0], c[1], 0, false); wv = __builtin_amdgcn_cvt_pk_fp8_f32(c[2], c[3], wv, true); ov[k] = (unsigned)wv; }
            *(u32x2*)(pv + ((size_t)(2 * ch) * NEXP + e) * 8) = (u32x2){ov[0], ov[1]};
            *(u32x2*)(pv + ((size_t)(2 * ch + 1) * NEXP + e) * 8) = (u32x2){ov[2], ov[3]};
        }
    }
    {
        __syncthreads();
        float* cact = (float*)(F.lds + 131072);
        float* red = (float*)F.lds;
        float* mp = (float*)(F.ws + WS_MODP);
        for (int it = F.bid; it < 48 * 4; it += F.G) {
            const int cb = it % 48, ds = it / 48, d0 = ds * 512;
            for (int i = F.tid; i < 8 * 512; i += 512) { const int b = i >> 9, d = i & 511; const float cv = F.c[b * DM + d0 + d]; cact[i] = cv * sigmoidf_(cv); }
            __syncthreads();
            f32x4 a[8];
#pragma unroll
            for (int b = 0; b < 8; ++b) a[b] = (f32x4){0.f, 0.f, 0.f, 0.f};
            const float* wp = F.w_ada + (size_t)(d0 + F.wave * 64) * 12288 + cb * 256 + F.lane * 4;
#pragma unroll 4
            for (int d = 0; d < 64; ++d) { const f32x4 w = *(const f32x4*)(wp + (size_t)d * 12288);
#pragma unroll
                for (int b = 0; b < 8; ++b) a[b] += w * cact[b * 512 + F.wave * 64 + d]; }
#pragma unroll
            for (int b = 0; b < 8; ++b)
#pragma unroll
                for (int j = 0; j < 4; ++j) red[(F.wave * 32 + b * 4 + j) * 64 + F.lane] = a[b][j];
            __syncthreads();
            for (int i = F.tid; i < 2048; i += 512) { const int v = i >> 6, l = i & 63; float s = 0.f;
#pragma unroll
                for (int w = 0; w < 8; ++w) s += red[(w * 32 + v) * 64 + l];
                mp[((size_t)ds * 8 + (v >> 2)) * 12288 + cb * 256 + l * 4 + (v & 3)] = s; }
            __syncthreads();
        }
    }
}

template <bool FIRST> __device__ __forceinline__ void phase_modnorm(Frame& F, const float* xin, const float* gain, int off_sh, int off_sc, bf16_t* dst, unsigned char* dst8 = nullptr) {
    F.lane = lane_now(); F.tid = F.wave * 64 + F.lane;
    const float* mp = (const float*)(F.ws + WS_MODP); float* mf = (float*)(F.ws + WS_MODF);
    if (FIRST) {
        for (int i = F.bid * 512 + F.tid; i < 8 * 12288; i += F.G * 512) {
            float s = F.b_ada[i % 12288];
#pragma unroll
            for (int k = 0; k < 4; ++k) s += mp[(size_t)k * 8 * 12288 + i];
            mf[i] = s; }
    }
    float* cA = (float*)F.lds; float* cB = cA + 2048;
    for (int ch = F.bid; ch < MTOK / 128; ch += F.G) {
        const int b = ch / 32;
        __syncthreads();
        for (int col = F.tid; col < 2048; col += 512) {
            float sc, sh;
            if (FIRST) { sc = F.b_ada[off_sc + col]; sh = F.b_ada[off_sh + col];
#pragma unroll
                for (int k = 0; k < 4; ++k) { sc += mp[((size_t)k * 8 + b) * 12288 + off_sc + col]; sh += mp[((size_t)k * 8 + b) * 12288 + off_sh + col]; } }
            else { sc = mf[b * 12288 + off_sc + col]; sh = mf[b * 12288 + off_sh + col]; }
            cA[col] = gain[col] * (1.f + sc); cB[col] = sh; }
        __syncthreads();
        for (int r = F.wave; r < 128; r += 8) {
            const size_t row = (size_t)ch * 128 + r;
            const float* xr = xin + row * 2048 + F.lane * 8;
            f32x4 v[4][2]; float ss = 0.f;
#pragma unroll
            for (int i = 0; i < 4; ++i) { v[i][0] = *(const f32x4*)(xr + i * 512); v[i][1] = *(const f32x4*)(xr + i * 512 + 4);
#pragma unroll
                for (int j = 0; j < 4; ++j) ss += v[i][0][j] * v[i][0][j] + v[i][1][j] * v[i][1][j]; }
            ss = wave_sum(ss);
            const float rinv = 1.0f / sqrtf(ss * (1.0f / 2048.0f) + EPS);
#pragma unroll
            for (int i = 0; i < 4; ++i) { const int col = i * 512 + F.lane * 8;
                const f32x4 a0 = *(const f32x4*)(cA + col), a1 = *(const f32x4*)(cA + col + 4), b0 = *(const f32x4*)(cB + col), b1 = *(const f32x4*)(cB + col + 4);
                const f32x4 y0 = v[i][0] * rinv * a0 + b0, y1 = v[i][1] * rinv * a1 + b1;
                *(u32x4*)(dst + row * 2048 + col) = pack8(y0, y1);
                if (FIRST) *(u32x2*)(dst8 + row * 2048 + col) = pack8_fp8(y0, y1); }
        }
    }
}

__device__ __forceinline__ void phase3_qknorm(Frame& F) {
    F.lane = lane_now(); F.tid = F.wave * 64 + F.lane;
    const bf16_t* q = (const bf16_t*)(F.ws + WS_QN); const bf16_t* k = (const bf16_t*)(F.ws + WS_KN); const bf16_t* v = (const bf16_t*)(F.ws + WS_V);
    unsigned char* q8 = F.ws + WS_Q8; unsigned char* k8 = F.ws + WS_K8; unsigned char* v8 = F.ws + WS_V8;
    const int gw = F.bid * 8 + F.wave, NGW = F.G * 8;
    for (int row = gw; row < MTOK; row += NGW) {
#pragma unroll
        for (int i = 0; i < 2; ++i) { const int ci = i * 64 + F.lane;
            f32x4 a, b; unpack8(*(const u32x4*)(q + (size_t)row * 1024 + ci * 8), a, b);
            float ss = a[0] * a[0] + a[1] * a[1] + a[2] * a[2] + a[3] * a[3] + b[0] * b[0] + b[1] * b[1] + b[2] * b[2] + b[3] * b[3];
            ss = row_sum16(ss);
            const float rinv = 1.0f / sqrtf(ss * (1.0f / 128.0f) + EPS);
            const float* gp = F.g_q + (ci & 15) * 8; const f32x4 g0 = *(const f32x4*)gp, g1 = *(const f32x4*)(gp + 4);
            *(u32x2*)(q8 + (size_t)row * 1024 + ci * 8) = pack8_fp8(a * rinv * g0, b * rinv * g1); }
        { const int ci = F.lane & 31; const bool isk = F.lane < 32;
            f32x4 a, b; unpack8(*(const u32x4*)((isk ? k : v) + (size_t)row * 256 + ci * 8), a, b);
            float ss = a[0] * a[0] + a[1] * a[1] + a[2] * a[2] + a[3] * a[3] + b[0] * b[0] + b[1] * b[1] + b[2] * b[2] + b[3] * b[3];
            ss = row_sum16(ss);
            const float rinv = isk ? 1.0f / sqrtf(ss * (1.0f / 128.0f) + EPS) : 1.0f;
            const float* gp = F.g_k + (ci & 15) * 8; f32x4 g0 = *(const f32x4*)gp, g1 = *(const f32x4*)(gp + 4);
            if (!isk) { g0 = (f32x4){1.f, 1.f, 1.f, 1.f}; g1 = g0; }
            *(u32x2*)((isk ? k8 : v8) + (size_t)row * 256 + ci * 8) = pack8_fp8(a * rinv * g0, b * rinv * g1); }
    }
}
template <int W> __device__ __forceinline__ void pooled_item(const bf16_t* pl, bf16_t* po, int row, int c8) {
    const int t = row & (SEQ - 1);
    f32x4 s0 = (f32x4){0.f, 0.f, 0.f, 0.f}, s1 = s0, x0 = s0, x1 = s0;
    u32x4 v[W];
#pragma unroll
    for (int j = 0; j < W; ++j) v[j] = *(const u32x4*)(pl + (size_t)(row - (j <= t ? j : 0)) * 1024 + c8);
#pragma unroll
    for (int j = 0; j < W; ++j) { f32x4 a, b; unpack8(v[j], a, b); if (j == 0) { x0 = a; x1 = b; } if (j <= t) { s0 += a; s1 += b; } }
    const float inv = 1.0f / (float)((t + 1 < W) ? t + 1 : W);
    *(u32x4*)(po + (size_t)row * 1024 + c8) = pack8(s0 * inv - x0, s1 * inv - x1);
}
__device__ __forceinline__ void phase3_pooled(Frame& F) {
    F.lane = lane_now(); F.tid = F.wave * 64 + F.lane;
    const bf16_t* pl = (const bf16_t*)(F.ws + WS_PL); bf16_t* po = (bf16_t*)(F.ws + WS_POOLED);
    const int gw = F.bid * 8 + F.wave, NGW = F.G * 8;
    for (int it = gw; it < (MTOK / 2) * 4; it += NGW) {
        const int g = it & 3, row = (it >> 2) * 2 + (F.lane >> 5), c8 = g * 256 + (F.lane & 31) * 8;
        if (g == 0) pooled_item<2>(pl, po, row, c8); else if (g == 1) pooled_item<4>(pl, po, row, c8); else if (g == 2) pooled_item<8>(pl, po, row, c8); else pooled_item<16>(pl, po, row, c8);
    }
}
typedef float f32x16 __attribute__((ext_vector_type(16)));
__device__ __forceinline__ float wrelu_(float wh, float d, float acc) { return __builtin_fmaf(wh, d, __builtin_fmaf(wh, __builtin_fabsf(d), acc)); }
__device__ __forceinline__ int sel_code(float s, float smin, float scale) { const float c = (s - smin) * scale; return (int)fminf(fmaxf(c, 0.f), 65535.f); }
__device__ __forceinline__ void hist_find(const unsigned* hist, int lane, int K, int& bsel, int& above) {
    const u32x4 h = *(const u32x4*)(hist + lane * 4);
    const int S = (int)(h.x + h.y + h.z + h.w);
    int x = S;
    x += __builtin_amdgcn_update_dpp(0, x, 0x101, 0xF, 0xF, true);
    x += __builtin_amdgcn_update_dpp(0, x, 0x102, 0xF, 0xF, true);
    x += __builtin_amdgcn_update_dpp(0, x, 0x104, 0xF, 0xF, true);
    x += __builtin_amdgcn_update_dpp(0, x, 0x108, 0xF, 0xF, true);
    const int t1 = __builtin_amdgcn_readlane(x, 16), t2 = __builtin_amdgcn_readlane(x, 32), t3 = __builtin_amdgcn_readlane(x, 48);
    const int r = lane >> 4;
    x += (r == 0 ? t1 + t2 + t3 : (r == 1 ? t2 + t3 : (r == 2 ? t3 : 0)));
    const int sufn = x - S;
    const bool mine = (x >= K) && (sufn < K);
    int b = 0, ab = 0;
    { int c = sufn;
      if (c + (int)h.w >= K) { b = 3; ab = c; } else { c += (int)h.w;
      if (c + (int)h.z >= K) { b = 2; ab = c; } else { c += (int)h.z;
      if (c + (int)h.y >= K) { b = 1; ab = c; } else { c += (int)h.y; b = 0; ab = c; } } } }
    const unsigned long long m = __ballot(mine);
    const int src = m ? (int)__builtin_ctzll(m) : 0;
    bsel = __builtin_amdgcn_readlane(lane * 4 + b, src); above = __builtin_amdgcn_readlane(ab, src);
}
__device__ __forceinline__ int mask_prefix(unsigned long long m) { return (int)__builtin_amdgcn_mbcnt_hi((unsigned)(m >> 32), __builtin_amdgcn_mbcnt_lo((unsigned)m, 0u)); }
template <class Fn> __device__ __forceinline__ void sel_sweep(const f32x4* rb4, int n4, int lane, int t, Fn fn) {
    f32x4 cur = rb4[lane];
    for (int c4 = 0; c4 < n4 - 1; ++c4) { const f32x4 nxt = rb4[(c4 + 1) * 64 + lane];
#pragma unroll
        for (int k = 0; k < 4; ++k) fn(cur[k], (c4 * 4 + k) * 64 + lane, true);
        cur = nxt; }
    { const int c4 = n4 - 1;
#pragma unroll
      for (int k = 0; k < 4; ++k) { const int idx = (c4 * 4 + k) * 64 + lane; fn(cur[k], idx, idx <= t); } }
}
template <int MODE = 0> __device__ __forceinline__ void indexer_select(Frame& F, int b, int t, const float* rowbuf, unsigned* hist, float* eqv, int* eqi) {
    unsigned short* selrow = (unsigned short*)(F.ws + (MODE ? WS_R0 : WS_SEL)) + (size_t)(b * SEQ + t) * 256;
    int lane = F.lane; asm volatile("" : "+v"(lane));
    const int nch = t / 64 + 1, n4 = (nch + 3) >> 2;
    const f32x4* rb4 = (const f32x4*)rowbuf;
    float mn = __builtin_huge_valf(), mx = -__builtin_huge_valf();
    sel_sweep(rb4, n4, lane, t, [&](float v, int, bool valid) { mn = valid ? fminf(mn, v) : mn; mx = valid ? fmaxf(mx, v) : mx; });
    mx = xor16_max(row_max16(mx)); { const auto r = __builtin_amdgcn_permlane32_swap(__float_as_uint(mx), __float_as_uint(mx), false, false); mx = fmaxf(__uint_as_float(r[0]), __uint_as_float(r[1])); }
    mn = -mn; mn = xor16_max(row_max16(mn)); { const auto r = __builtin_amdgcn_permlane32_swap(__float_as_uint(mn), __float_as_uint(mn), false, false); mn = -fmaxf(__uint_as_float(r[0]), __uint_as_float(r[1])); }
    const float scale = (mx > mn) ? 65535.0f / (mx - mn) : 0.f;
    *(u32x4*)(hist + lane * 4) = (u32x4){0u, 0u, 0u, 0u};
    sel_sweep(rb4, n4, lane, t, [&](float v, int, bool valid) { if (valid) { if (MODE == 2) ((volatile unsigned*)hist)[sel_code(v, mn, scale) >> 8] = 1u; else atomicAdd(&hist[sel_code(v, mn, scale) >> 8], 1u); } });
    int b1, above1; hist_find(hist, lane, KSEL, b1, above1);
    *(u32x4*)(hist + lane * 4) = (u32x4){0u, 0u, 0u, 0u};
    sel_sweep(rb4, n4, lane, t, [&](float v, int, bool valid) { const int code = sel_code(v, mn, scale); if (valid && (code >> 8) == b1) atomicAdd(&hist[code & 255], 1u); });
    int b2, above2; hist_find(hist, lane, KSEL - above1, b2, above2);
    const int T16 = (b1 << 8) | b2, need = KSEL - above1 - above2, ceq = (int)hist[b2];
    const bool all_eq = (ceq == need), collect = !all_eq && (ceq <= 64);
    const int eq_budget = all_eq ? 0x7fffffff : (collect ? 0 : need);
    int pos = 0, eqseen = 0;
    sel_sweep(rb4, n4, lane, t, [&](float v, int idx, bool valid) {
        const int code = sel_code(v, mn, scale);
        const bool gt = valid && code > T16, eq = valid && code == T16;
        const unsigned long long mg = __ballot(gt);
        const unsigned p = (unsigned)(pos + mask_prefix(mg));
        if (gt && p < (unsigned)KSEL) selrow[p] = (unsigned short)idx;
        pos += __popcll(mg);
        const unsigned long long me = __ballot(eq);
        if (me) {
            const int er = eqseen + mask_prefix(me); const bool te = eq && er < eq_budget;
            if (collect && eq) { eqv[er] = v; eqi[er] = idx; }
            eqseen += __popcll(me);
            const unsigned long long mte = __ballot(te);
            const unsigned pe = (unsigned)(pos + mask_prefix(mte));
            if (te && pe < (unsigned)KSEL) selrow[pe] = (unsigned short)idx;
            pos += __popcll(mte);
        }
    });
    if (collect && lane < ceq) {
        const float sv = eqv[lane]; const int idx = eqi[lane]; int rank = 0;
        for (int m = 0; m < ceq; ++m) { const float ov = eqv[m]; const int oi = eqi[m]; rank += (ov > sv || (ov == sv && oi < idx)) ? 1 : 0; }
        if (rank < need) selrow[KSEL - need + rank] = (unsigned short)idx;
    }
}
__device__ __forceinline__ void indexer_tile(Frame& F, int b, int t0) {
    const bf16_t* iq = (const bf16_t*)(F.ws + WS_IQ); const bf16_t* ik = (const bf16_t*)(F.ws + WS_IK); const float* iw = (const float*)(F.ws + WS_IW);
    int lane = F.lane; asm volatile("" : "+v"(lane));
    const int w = F.wave;
    if (t0 < KSEL) {
        const int t = t0 + w; unsigned short* selrow = (unsigned short*)(F.ws + WS_SEL) + (size_t)(b * SEQ + t) * 256;
#pragma unroll
        for (int p = 0; p < 4; ++p) { const int j = p * 64 + lane; selrow[j] = (unsigned short)(j <= t ? j : 0xFFFF); }
        return;
    }
    float* rowbuf = (float*)F.lds;
    unsigned char* stage = F.lds + 131072;
    const int p = w & 3, kh = w >> 2, hi = lane >> 5, r = lane & 31;
    const size_t qrow = (size_t)b * SEQ + t0 + 2 * p + (r >> 4);
    bf16x8 a[4];
#pragma unroll
    for (int ks = 0; ks < 4; ++ks) a[ks] = *(const bf16x8*)(iq + qrow * 1024 + (r & 15) * 64 + ks * 16 + 8 * hi);
    float wq[2][8];
#pragma unroll
    for (int q = 0; q < 2; ++q)
#pragma unroll
        for (int i = 0; i < 8; ++i) wq[q][i] = 0.5f * iw[((size_t)b * SEQ + t0 + 2 * p + q) * 16 + (i & 3) + 8 * ((i >> 2) & 1) + 4 * hi];
    const int nchunks = (t0 + 7) / 64 + 1, nsteps = (nchunks + 1) >> 1;
    const unsigned char* gsrc = (const unsigned char*)(ik + (size_t)b * SEQ * 64) + F.tid * 16;
    const int skey = F.tid >> 3, sc16 = F.tid & 7, soff = skey * 128 + ((sc16 ^ ((skey >> 1) & 7)) << 4);
    u32x4 sa0 = *(const u32x4*)gsrc, sb0 = sa0, sa1 = sa0, sb1 = sa0;
    sb0 = *(const u32x4*)(gsrc + (size_t)min(1, nchunks - 1) * 8192);
    sa1 = *(const u32x4*)(gsrc + (size_t)min(2, nchunks - 1) * 8192);
    sb1 = *(const u32x4*)(gsrc + (size_t)min(3, nchunks - 1) * 8192);
    __syncthreads();
#if PROBE_IDX != 1 && PROBE_IDX != 5
#define IDX_LD(c) (*(const u32x4*)(gsrc + (size_t)(c) * 8192))
#endif
#define IDX_MMA(SA, SB, ss, D0, D1) do { const int s_ = (ss); unsigned char* sb = stage + (s_ & 1) * 16384; \
        *(u32x4*)(sb + soff) = SA; *(u32x4*)(sb + 8192 + soff) = SB; \
        __syncthreads(); \
        SA = IDX_LD(min(2 * s_ + 4, nchunks - 1)); \
        SB = IDX_LD(min(2 * s_ + 5, nchunks - 1)); \
        _Pragma("unroll") for (int i = 0; i < 16; ++i) { D0[i] = 0.f; D1[i] = 0.f; } \
        _Pragma("unroll") for (int ks = 0; ks < 4; ++ks) { const unsigned char* bp = sb + key * 128 + (((ks * 2 + hi) ^ ((key >> 1) & 7)) << 4); \
            const bf16x8 bf0 = *(const bf16x8*)bp, bf1 = *(const bf16x8*)(bp + 8192); \
            D0 = __builtin_amdgcn_mfma_f32_32x32x16_bf16(a[ks], bf0, D0, 0, 0, 0); D1 = __builtin_amdgcn_mfma_f32_32x32x16_bf16(a[ks], bf1, D1, 0, 0, 0); } } while (0)
#define IDX_RED(ss, D0, D1) do { const int s_ = (ss); float x0_ = 0.f, x1_ = 0.f, y0_ = 0.f, y1_ = 0.f; \
        _Pragma("unroll") for (int i = 0; i < 8; ++i) { x0_ = wrelu_(wq[0][i], D0[i], x0_); x1_ = wrelu_(wq[1][i], D0[8 + i], x1_); y0_ = wrelu_(wq[0][i], D1[i], y0_); y1_ = wrelu_(wq[1][i], D1[8 + i], y1_); } \
        const float scx = swap32_pair(x0_, x1_), scy = swap32_pair(y0_, y1_); \
        *(f32x2*)(rowbuf + (2 * p + hi) * 4096 + ((s_ >> 1) * 64 + key) * 4 + 2 * (s_ & 1)) = (f32x2){scx, scy}; } while (0)
    const int key = kh * 32 + r;
    f32x16 dA0, dA1, dB0, dB1;
#if PROBE_IDX == 1
#define IDX_LD(c) (*(const u32x4*)(gsrc + (size_t)(c) * 8192))
#elif PROBE_IDX == 5
#define IDX_LD(c) SAVED
#endif
#if PROBE_IDX == 1 || PROBE_IDX == 5
    { const u32x4 SAVED = sa0;
    IDX_MMA(sa0, sb0, 0, dA0, dA1);
    for (int s2 = 0; s2 < nsteps; s2 += 2) {
        if (s2 + 1 < nsteps) IDX_MMA(sa1, sb1, s2 + 1, dB0, dB1);
        IDX_RED(s2, dA0, dA1);
        if (s2 + 2 < nsteps) IDX_MMA(sa0, sb0, s2 + 2, dA0, dA1);
        if (s2 + 1 < nsteps) IDX_RED(s2 + 1, dB0, dB1);
    }
    __syncthreads();
    sa0 = *(const u32x4*)gsrc;
    sb0 = *(const u32x4*)(gsrc + (size_t)min(1, nchunks - 1) * 8192);
    sa1 = *(const u32x4*)(gsrc + (size_t)min(2, nchunks - 1) * 8192);
    sb1 = *(const u32x4*)(gsrc + (size_t)min(3, nchunks - 1) * 8192); }
#undef IDX_LD
#define IDX_LD(c) (*(const u32x4*)(gsrc + (size_t)(c) * 8192))
#endif
    IDX_MMA(sa0, sb0, 0, dA0, dA1);
    for (int s2 = 0; s2 < nsteps; s2 += 2) {
        if (s2 + 1 < nsteps) IDX_MMA(sa1, sb1, s2 + 1, dB0, dB1);
        IDX_RED(s2, dA0, dA1);
        if (s2 + 2 < nsteps) IDX_MMA(sa0, sb0, s2 + 2, dA0, dA1);
        if (s2 + 1 < nsteps) IDX_RED(s2 + 1, dB0, dB1);
    }
#undef IDX_MMA
#undef IDX_RED
#undef IDX_LD
    __syncthreads();
    indexer_select(F, b, t0 + w, rowbuf + w * 4096, (unsigned*)(F.lds + 147456) + w * 256, (float*)(F.lds + 155648) + w * 64, (int*)(F.lds + 155648 + 2048) + w * 64);
#if PROBE_IDX >= 2
    indexer_select<PROBE_IDX - 1>(F, b, t0 + w, rowbuf + w * 4096, (unsigned*)(F.lds + 147456) + w * 256, (float*)(F.lds + 155648) + w * 64, (int*)(F.lds + 155648 + 2048) + w * 64);
#endif
}
__device__ __forceinline__ void phase3_indexer(Frame& F) {
    F.lane = lane_now(); F.tid = F.wave * 64 + F.lane;
    volatile LAS unsigned* misc = (volatile LAS unsigned*)((LAS unsigned char*)F.lds + MISC_OFF);
    const unsigned keep0 = misc[0], keep1 = misc[1];
    __syncthreads();
    const int nit = BATCH * (SEQ / 8);
    for (int k = 0;; ++k) {
        const int l = k * F.G + ((k & 1) ? (F.G - 1 - F.bid) : F.bid);
        if (l >= nit) { if (k * F.G >= nit) break; else continue; }
        const int qb = (SEQ / 8 - 1) - (l >> 3), b = l & 7;
        indexer_tile(F, b, qb * 8);
    }
    __syncthreads();
    if (F.tid == 0) { misc[0] = keep0; misc[1] = keep1; }
}

__device__ const unsigned char g_bucket[128] = {0, 1, 2, 3, 4, 5, 6, 7, 8, 9, 10, 11, 12, 13, 14, 15, 16, 16, 16, 17, 17, 18, 18, 18, 19, 19, 19, 20, 20, 20, 20, 21, 21, 21, 21, 22, 22, 22, 22, 22, 23, 23, 23, 23, 23, 23, 24, 24, 24, 24, 24, 24, 25, 25, 25, 25, 25, 25, 25, 26, 26, 26, 26, 26, 26, 26, 26, 27, 27, 27, 27, 27, 27, 27, 27, 27, 27, 28, 28, 28, 28, 28, 28, 28, 28, 28, 28, 29, 29, 29, 29, 29, 29, 29, 29, 29, 29, 29, 29, 30, 30, 30, 30, 30, 30, 30, 30, 30, 30, 30, 30, 30, 30, 31, 31, 31, 31, 31, 31, 31, 31, 31, 31, 31, 31, 31, 31, 31};
__device__ __forceinline__ void at_pv_step(f32x4 (&D0)[8], f32x4 (&D1)[8], const u32x4 (&buf)[8], LAS unsigned char* vwr, LAS unsigned char* ard, LAS unsigned char* brd) {
#pragma unroll
    for (int c = 0; c < 8; ++c) *(LAS u32x4*)(vwr + c * 16) = buf[c];
    const long pb = __builtin_bit_cast(long, __builtin_amdgcn_ds_read_tr8_b64_v2i32((LAS v2i*)brd));
#pragma unroll
    for (int tl = 0; tl < 8; ++tl) { const long va = __builtin_bit_cast(long, __builtin_amdgcn_ds_read_tr8_b64_v2i32((LAS v2i*)(ard + tl * 16))); D0[tl] = __builtin_amdgcn_mfma_f32_16x16x32_fp8_fp8(va, pb, D0[tl], 0, 0, 0); }
#pragma unroll
    for (int tl = 0; tl < 8; ++tl) { const long va = __builtin_bit_cast(long, __builtin_amdgcn_ds_read_tr8_b64_v2i32((LAS v2i*)(ard + 4608 + tl * 16))); D1[tl] = __builtin_amdgcn_mfma_f32_16x16x32_fp8_fp8(va, pb, D1[tl], 0, 0, 0); }
}
__device__ __forceinline__ void phase4_attention(Frame& F) {
    F.lane = lane_now(); F.tid = F.wave * 64 + F.lane;
    const unsigned char* q8 = F.ws + WS_Q8; const unsigned char* k8 = F.ws + WS_K8; const unsigned char* v8 = F.ws + WS_V8;
    const unsigned short* sel = (const unsigned short*)(F.ws + WS_SEL); unsigned char* ao = F.ws + WS_ATTN;
    float* btab = (float*)F.lds;
    __syncthreads();
    for (int i = F.tid; i < 256; i += 512) btab[i] = F.rel_bias[i];
    __syncthreads();
    float* Pl = (float*)(F.lds + 4096 + F.wave * 12544); int* idl = (int*)((unsigned char*)Pl + 9216); float* psl = (float*)((unsigned char*)Pl + 12288); float* pml = psl + 8;
    LAS unsigned char* wl = (LAS unsigned char*)F.lds + 4096 + F.wave * 12544;
    const bool xmap = (F.G % 8) == 0;
    const int gw = xmap ? (F.bid / 8) * 8 + F.wave : F.bid * 8 + F.wave, NGW = xmap ? F.G : F.G * 8, nrows = xmap ? SEQ : MTOK;
    for (int rr = gw; rr < nrows; rr += NGW) {
        int lane = F.lane; asm volatile("" : "+v"(lane));
        const int row = xmap ? (F.bid & 7) * SEQ + rr : rr;
        const int b = row / SEQ, t = row % SEQ, r = lane & 31, hi = lane >> 5;
#pragma unroll
        for (int p = 0; p < 4; ++p) { idl[p * 64 + lane] = (int)sel[(size_t)row * 256 + p * 64 + lane]; }
        long a0[8], a1[8];
        { u32x4 qa[4];
#pragma unroll
          for (int i = 0; i < 4; ++i) qa[i] = (r < 8) ? *(const u32x4*)(q8 + (size_t)row * 1024 + r * 128 + hi * 64 + i * 16) : (u32x4){0u, 0u, 0u, 0u};
#pragma unroll
          for (int ks = 0; ks < 8; ++ks) { const unsigned lo = qa[ks >> 1][(ks & 1) * 2], hh = qa[ks >> 1][(ks & 1) * 2 + 1]; const long v = (long)(((unsigned long long)hh << 32) | lo);
              a0[ks] = (r < 4) ? v : 0l; a1[ks] = (r >= 4) ? v : 0l; } }
        f32x4 psum = (f32x4){0.f, 0.f, 0.f, 0.f}, pmax = psum;
#define AT_LOADK(buf, kb) do { const int key_ = idl[(kb) * 32 + r]; const int kc_ = key_ <= t ? key_ : 0; const unsigned char* kr_ = k8 + ((size_t)b * SEQ + kc_) * 256 + hi * 64; \
            _Pragma("unroll") for (int i = 0; i < 4; ++i) { buf[i] = *(const u32x4*)(kr_ + i * 16); buf[4 + i] = *(const u32x4*)(kr_ + 128 + i * 16); } } while (0)
#define AT_QK(buf, kb) do { const int key_ = idl[(kb) * 32 + r]; const bool valid_ = key_ <= t; const int kc_ = valid_ ? key_ : 0; \
            f32x16 d; _Pragma("unroll") for (int i = 0; i < 16; ++i) d[i] = 0.f; \
            _Pragma("unroll") for (int ks = 0; ks < 8; ++ks) { const long bv_ = (long)(((unsigned long long)buf[ks >> 1][(ks & 1) * 2 + 1] << 32) | buf[ks >> 1][(ks & 1) * 2]); d = __builtin_amdgcn_mfma_f32_32x32x16_fp8_fp8(a0[ks], bv_, d, 0, 0, 0); } \
            _Pragma("unroll") for (int ks = 0; ks < 8; ++ks) { const long bv_ = (long)(((unsigned long long)buf[4 + (ks >> 1)][(ks & 1) * 2 + 1] << 32) | buf[4 + (ks >> 1)][(ks & 1) * 2]); d = __builtin_amdgcn_mfma_f32_32x32x16_fp8_fp8(a1[ks], bv_, d, 0, 0, 0); } \
            const int dist_ = t - kc_; const int bkt_ = dist_ < 128 ? (int)g_bucket[dist_] : 31; \
            const f32x4 bias_ = *(const f32x4*)(btab + bkt_ * 8 + 4 * hi); f32x4 e_; \
            _Pragma("unroll") for (int i = 0; i < 4; ++i) e_[i] = valid_ ? __expf(d[i] * 0.08838834764831845f + bias_[i]) : 0.f; \
            psum += e_; _Pragma("unroll") for (int i = 0; i < 4; ++i) pmax[i] = fmaxf(pmax[i], e_[i]); *(f32x4*)(Pl + ((kb) * 32 + r) * 8 + 4 * hi) = e_; } while (0)
        {
            u32x4 kA[8], kB[8];
            AT_LOADK(kA, 0);
#pragma unroll 1
            for (int kb = 0; kb < 8; kb += 2) {
                AT_LOADK(kB, kb + 1);
                AT_QK(kA, kb);
                if (kb + 2 < 8) AT_LOADK(kA, kb + 2);
                AT_QK(kB, kb + 1);
            }
        }
#undef AT_LOADK
#undef AT_QK
#pragma unroll
        for (int i = 0; i < 4; ++i) { psum[i] = xor16_sum(row_sum16(psum[i])); pmax[i] = xor16_max(row_max16(pmax[i])); }
        if (r == 0) { *(f32x4*)(psl + 4 * hi) = psum; *(f32x4*)(pml + 4 * hi) = pmax; }
        const int fk = lane & 31, fg = lane >> 5, kq = lane >> 4, tq = (lane >> 1) & 7, tp = lane & 1;
#define AT_LOADV(buf, ks_) do { const int key_ = idl[(ks_) * 32 + fk]; const int kc_ = key_ <= t ? key_ : 0; const unsigned char* vr_ = v8 + ((size_t)b * SEQ + kc_) * 256 + fg * 128; \
            _Pragma("unroll") for (int c = 0; c < 8; ++c) buf[c] = *(const u32x4*)(vr_ + c * 16); } while (0)
        u32x4 vA[8], vB[8];
        AT_LOADV(vA, 0);
        { const f32x4 m0 = *(const f32x4*)pml, m1 = *(const f32x4*)(pml + 4);
          f32x4 r0, r1;
#pragma unroll
          for (int i = 0; i < 4; ++i) { r0[i] = __builtin_amdgcn_rcpf(m0[i]); r1[i] = __builtin_amdgcn_rcpf(m1[i]); }
#pragma unroll
          for (int i = 0; i < 4; ++i) { const int key = i * 64 + lane;
              *(LAS u32x2*)(wl + 10240 + key * 8) = pack8_fp8(*(const f32x4*)(Pl + key * 8) * r0, *(const f32x4*)(Pl + key * 8 + 4) * r1); } }
        f32x4 D0[8], D1[8];
#pragma unroll
        for (int tl = 0; tl < 8; ++tl) { D0[tl] = (f32x4){0.f, 0.f, 0.f, 0.f}; D1[tl] = D0[tl]; }
        LAS unsigned char* vwr = wl + fg * 4608 + fk * 144;
        LAS unsigned char* ard = wl + (kq * 8 + tq) * 144 + 8 * tp;
        LAS unsigned char* brd = wl + 10240 + (kq * 8 + tq) * 8;
#pragma unroll 1
        for (int ks = 0; ks < 8; ks += 2) {
            AT_LOADV(vB, ks + 1);
            at_pv_step(D0, D1, vA, vwr, ard, brd + ks * 256);
            if (ks + 2 < 8) AT_LOADV(vA, ks + 2);
            at_pv_step(D0, D1, vB, vwr, ard, brd + (ks + 1) * 256);
        }
#undef AT_LOADV
        { const int n = lane & 15, q4 = lane >> 4;
          if (n < 8) { const float sc = pml[n] / psl[n]; const bool g1 = n >= 4;
              unsigned char* op = ao + (size_t)row * 1024 + n * 128 + q4 * 4;
#pragma unroll
              for (int tl = 0; tl < 8; ++tl) { const f32x4 d = (g1 ? D1[tl] : D0[tl]) * sc;
                  int w = __builtin_amdgcn_cvt_pk_fp8_f32(d[0], d[1], 0, false); w = __builtin_amdgcn_cvt_pk_fp8_f32(d[2], d[3], w, true);
                  *(unsigned*)(op + tl * 16) = (unsigned)w; } } }
    }
}

__device__ __forceinline__ float dot16f8(u32x4 w, const float* h) {
    float s = 0.f;
#pragma unroll
    for (int d = 0; d < 4; ++d) { const f32x2 lo = __builtin_amdgcn_cvt_pk_f32_fp8((int)w[d], false), hi = __builtin_amdgcn_cvt_pk_f32_fp8((int)w[d], true);
        s += lo.x * h[4 * d] + lo.y * h[4 * d + 1] + hi.x * h[4 * d + 2] + hi.y * h[4 * d + 3]; }
    return s;
}
__device__ __forceinline__ void fma16f8(u32x4 w, float cf, float* acc) {
#pragma unroll
    for (int d = 0; d < 4; ++d) { const f32x2 lo = __builtin_amdgcn_cvt_pk_f32_fp8((int)w[d], false), hi = __builtin_amdgcn_cvt_pk_f32_fp8((int)w[d], true);
        acc[4 * d] += cf * lo.x; acc[4 * d + 1] += cf * lo.y; acc[4 * d + 2] += cf * hi.x; acc[4 * d + 3] += cf * hi.y; }
}
__device__ __forceinline__ float gelu_erf(float x) { return 0.5f * x * (1.0f + erff(x * 0.70710678118654752f)); }
__device__ __forceinline__ void ce_k(unsigned& a, unsigned& b) { const unsigned hi = a > b ? a : b, lo = a > b ? b : a; a = hi; b = lo; }
__device__ __forceinline__ void ce_kp(unsigned& ka, unsigned& pa, unsigned& kb, unsigned& pb) { const bool sw = kb > ka; const unsigned k0 = sw ? kb : ka, k1 = sw ? ka : kb, p0 = sw ? pb : pa, p1 = sw ? pa : pb; ka = k0; kb = k1; pa = p0; pb = p1; }
__device__ __forceinline__ void bmerge16(unsigned (&x)[16]) {
#pragma unroll
    for (int jj = 0; jj < 4; ++jj) { const int j = 8 >> jj;
#pragma unroll
        for (int i = 0; i < 16; ++i) { const int l = i ^ j; if (l > i) ce_k(x[i], x[l]); }
        __builtin_amdgcn_sched_barrier(0); }
}
__device__ __forceinline__ void bmerge16p(unsigned (&x)[16], unsigned (&p)[16]) {
#pragma unroll
    for (int jj = 0; jj < 4; ++jj) { const int j = 8 >> jj;
#pragma unroll
        for (int i = 0; i < 16; ++i) { const int l = i ^ j; if (l > i) ce_kp(x[i], p[i], x[l], p[l]); }
        __builtin_amdgcn_sched_barrier(0); }
}
__device__ __forceinline__ void bsort16(unsigned (&x)[16]) {
#pragma unroll
    for (int kk = 1; kk <= 4; ++kk) { const int k = 1 << kk;
#pragma unroll
        for (int jj = 0; jj < 4; ++jj) { const int j = (k >> 1) >> jj;
            if (j > 0) {
#pragma unroll
                for (int i = 0; i < 16; ++i) { const int l = i ^ j; if (l > i) { if ((i & k) == 0) ce_k(x[i], x[l]); else ce_k(x[l], x[i]); } }
                __builtin_amdgcn_sched_barrier(0); } } }
}
__device__ __forceinline__ void bsort16p(unsigned (&x)[16], unsigned (&p)[16]) {
#pragma unroll
    for (int kk = 1; kk <= 4; ++kk) { const int k = 1 << kk;
#pragma unroll
        for (int jj = 0; jj < 4; ++jj) { const int j = (k >> 1) >> jj;
            if (j > 0) {
#pragma unroll
                for (int i = 0; i < 16; ++i) { const int l = i ^ j; if (l > i) { if ((i & k) == 0) ce_kp(x[i], p[i], x[l], p[l]); else ce_kp(x[l], p[l], x[i], p[i]); } }
                __builtin_amdgcn_sched_barrier(0); } } }
}
__device__ __forceinline__ void top16_row(const unsigned char* rowp, unsigned (&t)[16]) {
#pragma unroll
    for (int i = 0; i < 16; ++i) t[i] = 0u;
#pragma unroll 1
    for (int g = 0; g < 8; ++g) {
        unsigned w[8];
#pragma unroll
        for (int q = 0; q < 4; ++q) { const u32x2 v = *(const u32x2*)(rowp + g * 32 + q * 8); w[2 * q] = v.x; w[2 * q + 1] = v.y; }
        unsigned sk[16];
#pragma unroll
        for (int d = 0; d < 8; ++d) {
            const unsigned lo = w[d] << 16, hi = w[d];
            const unsigned xl = lo ^ ((unsigned)((int)lo >> 31) | 0x80000000u), xh = hi ^ ((unsigned)((int)hi >> 31) | 0x80000000u);
            sk[2 * d] = ((xl >> 9) & 0xFFFFFF80u) | (unsigned)(127 - (g * 16 + 2 * d));
            sk[2 * d + 1] = ((xh >> 9) & 0xFFFFFF80u) | (unsigned)(127 - (g * 16 + 2 * d + 1)); }
        bsort16(sk);
#pragma unroll
        for (int i = 0; i < 16; ++i) t[i] = t[i] > sk[15 - i] ? t[i] : sk[15 - i];
        bmerge16(t);
    }
}
__device__ __forceinline__ float key_val(unsigned key) { const unsigned y = (key << 9) & 0xFFFF0000u; return __uint_as_float((y ^ (~(unsigned)((int)y >> 31) | 0x80000000u)) & 0xFFFF0000u); }
__device__ __forceinline__ unsigned sum_key(float s, int c) { const unsigned u = __float_as_uint(s); return ((u ^ ((unsigned)((int)u >> 31) | 0x80000000u)) & ~63u) | (unsigned)(63 - c); }
__device__ __forceinline__ float sum_val(unsigned k) { const unsigned y = k & ~63u; return __uint_as_float(y ^ (~(unsigned)((int)y >> 31) | 0x80000000u)); }
typedef __bf16 bf2_t __attribute__((ext_vector_type(2)));
__device__ __forceinline__ float dot2_bf(unsigned a, unsigned b, float c) { return __builtin_amdgcn_fdot2_f32_bf16(__builtin_bit_cast(bf2_t, a), __builtin_bit_cast(bf2_t, b), c, false); }
__device__ __forceinline__ float dot32_f6b(u32x4 wa, u32x2 wb, u32x4 h0, u32x4 h1, u32x4 h2, u32x4 h3) {
    const bf16x32 dec = __builtin_amdgcn_cvt_scalef32_pk32_bf16_fp6((u32x6){wa.x, wa.y, wa.z, wa.w, wb.x, wb.y}, 1.0f);
    const u32x16 ud = __builtin_bit_cast(u32x16, dec);
    float acc = 0.f;
    acc = dot2_bf(ud.s0, h0.x, acc); acc = dot2_bf(ud.s1, h0.y, acc); acc = dot2_bf(ud.s2, h0.z, acc); acc = dot2_bf(ud.s3, h0.w, acc);
    acc = dot2_bf(ud.s4, h1.x, acc); acc = dot2_bf(ud.s5, h1.y, acc); acc = dot2_bf(ud.s6, h1.z, acc); acc = dot2_bf(ud.s7, h1.w, acc);
    acc = dot2_bf(ud.s8, h2.x, acc); acc = dot2_bf(ud.s9, h2.y, acc); acc = dot2_bf(ud.sa, h2.z, acc); acc = dot2_bf(ud.sb, h2.w, acc);
    acc = dot2_bf(ud.sc, h3.x, acc); acc = dot2_bf(ud.sd, h3.y, acc); acc = dot2_bf(ud.se, h3.z, acc); acc = dot2_bf(ud.sf, h3.w, acc);
    return acc;
}
__device__ const unsigned char g_cab[64] = {0, 1, 2, 3, 4, 5, 6, 7, 8, 9, 10, 11, 12, 13, 14, 15, 16, 17, 18, 19, 20, 21, 22, 23, 32, 33, 34, 35, 36, 48, 49, 50, 51, 64, 65, 66, 80, 81, 96, 97, 112, 113, 128, 144, 160, 176, 192, 208, 224, 240, 0, 0, 0, 0, 0, 0, 0, 0, 0, 0, 0, 0, 0, 0};
template <int PMODE = 0> __device__ __forceinline__ void phase10_peer(Frame& F) {
    F.lane = lane_now(); F.tid = F.wave * 64 + F.lane;
    const bf16_t* sub = (const bf16_t*)(F.ws + WS_SUB); const bf16_t* h2 = (const bf16_t*)(F.ws + WS_H2);
    const unsigned char* pu = F.ws + WS_PU; unsigned* pairs = (unsigned*)(F.ws + WS_PAIRS);
    const int gw = F.bid * 8 + F.wave, NGW = F.G * 8;
    unsigned char* wb = F.lds + F.wave * 19200;
    unsigned char* h2b = wb; unsigned short* gl16 = (unsigned short*)(wb + 16896); unsigned* hist = (unsigned*)(wb + 18944); unsigned* base = hist + 32;
    unsigned* tmp = (unsigned*)wb;
    unsigned* wls0 = (unsigned*)(F.ws + WS_WLS) + (size_t)gw * 1024;
    const int ntok = (MTOK - gw + NGW - 1) / NGW;
    constexpr int CA[50] = {0,0,0,0,0,0,0,0,0,0,0,0,0,0,0,0, 1,1,1,1,1,1,1,1, 2,2,2,2,2, 3,3,3,3, 4,4,4, 5,5, 6,6, 7,7, 8,9,10,11,12,13,14,15};
    constexpr int CB[50] = {0,1,2,3,4,5,6,7,8,9,10,11,12,13,14,15, 0,1,2,3,4,5,6,7, 0,1,2,3,4, 0,1,2,3, 0,1,2, 0,1, 0,1, 0,1, 0,0,0,0,0,0,0,0};
    for (int p0 = 0; p0 < ntok; p0 += 8) {
        int lane = F.lane; asm volatile("" : "+v"(lane));
        const int nt = (ntok - p0) < 8 ? (ntok - p0) : 8;
        {
            u32x4 st[16];
#define SEL_LOAD(half) do { asm volatile("" : "+v"(lane)); const int srow_l = lane >> 4, scol = lane & 15; _Pragma("unroll") for (int it = 0; it < 16; ++it) { const int r_ = it * 4 + srow_l; int ti_ = r_ >> 3; ti_ = ti_ < nt ? ti_ : nt - 1; \
                st[it] = *(const u32x4*)(sub + (size_t)(gw + (p0 + ti_) * NGW) * 2048 + (r_ & 7) * 256 + (half) * 128 + scol * 8); } } while (0)
#define SEL_STORE() do { const int srow_l = lane >> 4, scol = lane & 15; _Pragma("unroll") for (int it = 0; it < 16; ++it) { unsigned char* d_ = wb + (it * 4 + srow_l) * 264 + scol * 16; \
                *(u32x2*)d_ = (u32x2){st[it].x, st[it].y}; *(u32x2*)(d_ + 8) = (u32x2){st[it].z, st[it].w}; } } while (0)
            unsigned tA[16], tB[16];
            SEL_LOAD(0); SEL_STORE();
            __builtin_amdgcn_sched_barrier(0);
            top16_row(wb + lane * 264, tA);
            __builtin_amdgcn_sched_barrier(0);
            asm volatile("" : "+v"(tA[0]), "+v"(tA[1]), "+v"(tA[2]), "+v"(tA[3]), "+v"(tA[4]), "+v"(tA[5]), "+v"(tA[6]), "+v"(tA[7]), "+v"(tA[8]), "+v"(tA[9]), "+v"(tA[10]), "+v"(tA[11]), "+v"(tA[12]), "+v"(tA[13]), "+v"(tA[14]), "+v"(tA[15]) :: "memory");
            SEL_LOAD(1); SEL_STORE();
            __builtin_amdgcn_sched_barrier(0);
            top16_row(wb + lane * 264, tB);
            __builtin_amdgcn_sched_barrier(0);
#undef SEL_LOAD
#undef SEL_STORE
            float vA[16], vB[16];
            { unsigned pa[4] = {0u, 0u, 0u, 0u}, pb[4] = {0u, 0u, 0u, 0u};
#pragma unroll
              for (int i = 0; i < 16; ++i) { vA[i] = key_val(tA[i]); vB[i] = key_val(tB[i]); pa[i >> 2] |= (127u - (tA[i] & 127u)) << (8 * (i & 3)); pb[i >> 2] |= (127u - (tB[i] & 127u)) << (8 * (i & 3)); }
              unsigned char* rp = wb + lane * 264;
              *(u32x2*)rp = (u32x2){pa[0], pa[1]}; *(u32x2*)(rp + 8) = (u32x2){pa[2], pa[3]}; *(u32x2*)(rp + 16) = (u32x2){pb[0], pb[1]}; *(u32x2*)(rp + 24) = (u32x2){pb[2], pb[3]}; }
            unsigned tk[16];
#pragma unroll
            for (int c = 0; c < 16; ++c) tk[c] = sum_key(vA[CA[c]] + vB[CB[c]], c);
            bsort16(tk);
#pragma unroll
            for (int grp = 1; grp < 3; ++grp) {
                unsigned sk[16];
#pragma unroll
                for (int e = 0; e < 16; ++e) { const int c = grp * 16 + e; sk[e] = sum_key(vA[CA[c]] + vB[CB[c]], c); }
                bsort16(sk);
#pragma unroll
                for (int i = 0; i < 16; ++i) tk[i] = tk[i] > sk[15 - i] ? tk[i] : sk[15 - i];
                bmerge16(tk);
            }
#pragma unroll
            for (int c = 48; c < 50; ++c) { unsigned k = sum_key(vA[CA[c]] + vB[CB[c]], c);
#pragma unroll
                for (int i = 0; i < 16; ++i) ce_k(tk[i], k); }
            const float s0 = sum_val(tk[0]); float ev[16], esum = 0.f;
#pragma unroll
            for (int r = 0; r < 16; ++r) { ev[r] = __expf(sum_val(tk[r]) - s0); esum += ev[r]; }
            const float einv = 1.0f / esum;
            unsigned eid[16];
            { const unsigned char* rp = wb + lane * 264;
#pragma unroll
              for (int r = 0; r < 16; ++r) { const unsigned cab = g_cab[63u - (tk[r] & 63u)]; eid[r] = (unsigned)rp[cab >> 4] * 128u + (unsigned)rp[16 + (cab & 15u)]; } }
            if ((lane >> 3) < nt) {
#pragma unroll
                for (int r = 0; r < 16; ++r) { const int e = lane * 16 + r; tmp[e] = ((unsigned)e << 14) | eid[r]; gl16[e] = (unsigned short)(cvt_pk_bf16(ev[r] * einv, 0.f) & 0xffffu); } }
        }
        asm volatile("" : "+v"(lane));
        const int ne = nt * 128;
        {
            if (lane < 32) hist[lane] = 0u;
            unsigned ent[16]; unsigned rk[16];
#pragma unroll
            for (int q = 0; q < 16; ++q) { const int e = q * 64 + lane; ent[q] = (e < ne) ? tmp[e] : 0u; rk[q] = (e < ne) ? atomicAdd(&hist[(ent[q] & 0x3FFFu) >> 9], 1u) : 0u; }
            { int hv = lane < 32 ? (int)hist[lane] : 0; int x = hv;
              x += __builtin_amdgcn_update_dpp(0, x, 0x111, 0xF, 0xF, true); x += __builtin_amdgcn_update_dpp(0, x, 0x112, 0xF, 0xF, true);
              x += __builtin_amdgcn_update_dpp(0, x, 0x114, 0xF, 0xF, true); x += __builtin_amdgcn_update_dpp(0, x, 0x118, 0xF, 0xF, true);
              const int t0 = __builtin_amdgcn_readlane(x, 15); if (lane >= 16) x += t0;
              if (lane < 32) base[lane] = (unsigned)(x - hv); }
#pragma unroll
            for (int q = 0; q < 16; ++q) { const int e = q * 64 + lane; if (e < ne) wls0[base[(ent[q] & 0x3FFFu) >> 9] + rk[q]] = ent[q]; }
        }
        asm volatile("s_waitcnt vmcnt(0)" ::: "memory");
        asm volatile("" : "+v"(lane));
#pragma unroll 1
        for (int i = 0; i < nt; ++i) { const bf16_t* hr = h2 + (size_t)(gw + (p0 + i) * NGW) * 2048 + lane * 32;
            f32x4 v[8]; float m = 0.f;
#pragma unroll
            for (int q = 0; q < 4; ++q) { unpack8(*(const u32x4*)(hr + q * 8), v[2 * q], v[2 * q + 1]); }
#pragma unroll
            for (int q = 0; q < 8; ++q)
#pragma unroll
                for (int k = 0; k < 4; ++k) m = fmaxf(m, __builtin_fabsf(v[q][k]));
            int sb = (int)((__float_as_uint(m * 1.0666667f) >> 23) & 0xFFu) - 2; sb = sb < 1 ? 1 : (sb > 253 ? 253 : sb);
            const float inv = __uint_as_float((unsigned)(254 - sb) << 23);
            u32x16 pk;
#pragma unroll
            for (int q = 0; q < 8; ++q) { const f32x4 a = v[q] * inv; pk[2 * q] = cvt_pk_bf16(a[0], a[1]); pk[2 * q + 1] = cvt_pk_bf16(a[2], a[3]); }
            const u32x6 p6 = __builtin_amdgcn_cvt_scalef32_pk32_fp6_bf16(__builtin_bit_cast(bf16x32, pk), 1.0f);
            const int lp = (lane >> 2) + 16 * (lane & 3);
            *(u32x4*)(h2b + i * 2048 + lp * 16) = (u32x4){p6[0], p6[1], p6[2], p6[3]};
            *(u32x4*)(h2b + i * 2048 + 1024 + lp * 16) = (u32x4){p6[4], p6[5], (unsigned)sb, 0u}; }
        if (PMODE != 1) {
            const int dg = lane >> 4, dc = lane & 15;
            const bool dv = (dc >> 2) == dg; const int dr = dc & 3;
            const float w0 = (dv && dr == 0) ? 1.f : 0.f, w1 = (dv && dr == 1) ? 1.f : 0.f, w2 = (dv && dr == 2) ? 1.f : 0.f, w3 = (dv && dr == 3) ? 1.f : 0.f;
            unsigned entn = __hip_atomic_load(wls0 + lane, __ATOMIC_RELAXED, __HIP_MEMORY_SCOPE_AGENT);
#define U_LOAD(WA, WB, srcent, i0_) do { _Pragma("unroll") for (int jj = 0; jj < 8; ++jj) { const unsigned en_ = (unsigned)__builtin_amdgcn_readlane((int)(srcent), (i0_) + jj); \
                const unsigned char* ur = pu + (size_t)(en_ & 0x3FFFu) * 1536; WA[jj] = *(const u32x4*)(ur + lane * 16); WB[jj] = *(const u32x2*)(ur + 1024 + lane * 8); } } while (0)
#define U_COMP(WA, WB, i0_) do { float pr[8]; \
                _Pragma("unroll") for (int jj = 0; jj < 8; ++jj) { const unsigned en_ = (unsigned)__builtin_amdgcn_readlane((int)ent64, (i0_) + jj); const unsigned char* hp = h2b + ((en_ >> 21) & 7u) * 2048 + lane * 16; \
                    const u32x4 b0 = *(const u32x4*)hp, b1 = *(const u32x4*)(hp + 1024); \
                    const pg8::i32x8 A = (pg8::i32x8){(int)WA[jj].x, (int)WA[jj].y, (int)WA[jj].z, (int)WA[jj].w, (int)WB[jj].x, (int)WB[jj].y, 0, 0}; \
                    const pg8::i32x8 B = (pg8::i32x8){(int)b0.x, (int)b0.y, (int)b0.z, (int)b0.w, (int)b1.x, (int)b1.y, 0, 0}; \
                    const f32x4 D = __builtin_amdgcn_mfma_scale_f32_16x16x128_f8f6f4(A, B, (f32x4){0.f, 0.f, 0.f, 0.f}, 2  , 2  , 0, 0x7F7F7F7F, 0, (int)b1.z); \
                    pr[jj] = w0 * D[0] + w1 * D[1] + w2 * D[2] + w3 * D[3]; } \
                  \
                _Pragma("unroll") for (int i = 0; i < 4; ++i) pr[i] = swap32_pair(pr[i], pr[i + 4]); \
                _Pragma("unroll") for (int i = 0; i < 2; ++i) pr[i] = swap16_pair(pr[i], pr[i + 2]); \
                const bool b3 = (lane & 8) != 0; \
                { const float snd = b3 ? pr[0] : pr[1], kp = b3 ? pr[1] : pr[0]; pr[0] = kp + dpp_f<DPP_ROR8>(snd); } \
                float tot = pr[0]; tot += dpp_f<DPP_XOR1>(tot); tot += dpp_f<DPP_XOR2>(tot); tot += dpp_f<DPP_HMIRROR>(tot); \
                keep = ((lane & 7) == ((i0_) >> 3)) ? tot : keep;           \
            } while (0)
            u32x4 wA0[8], wA1[8]; u32x2 wB0[8], wB1[8];
            U_LOAD(wA0, wB0, entn, 0);
#pragma unroll 1
            for (int c = 0; c < ne; c += 64) {
                const unsigned ent64 = entn;
                const bool more = c + 64 < ne;
                if (more) entn = __hip_atomic_load(wls0 + c + 64 + lane, __ATOMIC_RELAXED, __HIP_MEMORY_SCOPE_AGENT);
                float keep = 0.f;
#pragma unroll 1
                for (int i0 = 0; i0 < 64; i0 += 16) {
                    U_LOAD(wA1, wB1, ent64, i0 + 8);
                    U_COMP(wA0, wB0, i0);
                    if (i0 + 16 < 64) U_LOAD(wA0, wB0, ent64, i0 + 16); else if (more) U_LOAD(wA0, wB0, entn, 0);
                    U_COMP(wA1, wB1, i0 + 8);
                }
                {
                    const unsigned em = (unsigned)__shfl((int)ent64, 8 * (lane & 7) + (lane >> 3));
                    const int ti = (int)(em >> 21), j = (int)((em >> 14) & 127u), row = gw + (p0 + ti) * NGW;
                    const float cf = gelu_erf(keep * (1.0f / 96.0f)) * __uint_as_float((unsigned)gl16[(em >> 14) & 1023u] << 16);
                    pairs[((size_t)(row >> 6) * 128 + j) * 64 + (row & 63)] = (((unsigned)__builtin_bit_cast(unsigned short, (_Float16)cf) << 16) & 0xFFFE0000u) | ((em & 0x3FFFu) << 3);
                }
            }
#undef U_LOAD
#undef U_COMP
        }
    }
}

__device__ __forceinline__ void phase11_peer_v(Frame& F, float* dst) {
    F.lane = lane_now(); F.tid = F.wave * 64 + F.lane;
    const unsigned* pairs = (const unsigned*)(F.ws + WS_PAIRS); const float* mf = (const float*)(F.ws + WS_MODF);
    unsigned long long* vs = (unsigned long long*)F.lds;
    for (int c0 = F.bid; c0 < DM / 8; c0 += F.G) {
        const int c = (c0 & 7) * 32 + (c0 >> 3);
        __syncthreads();
        { const u32x4* src = (const u32x4*)(F.ws + WS_PV + (size_t)c * NEXP * 8);
#pragma unroll 4
          for (int i = F.tid; i < NEXP * 8 / 16; i += 512) *(LAS u32x4*)(unsigned long long)(unsigned)(i * 16) = src[i]; }
        __syncthreads();
        typedef __fp16 h2_t __attribute__((__vector_size__(2 * sizeof(__fp16))));
#define P11_LOAD(dst, ptr) do { _Pragma("unroll") for (int jj = 0; jj < 16; ++jj) dst[jj] = (ptr)[jj * 64]; } while (0)
#define P11_FMA(A, X, C) asm("v_pk_fma_f16 %0, %1, %2, %0 op_sel:[0,1,0] op_sel_hi:[1,1,1]" : "+v"(C) : "v"(A), "v"(X))
#define P11_COMP(src) do { unsigned long long vv_[16]; \
                    _Pragma("unroll") for (int jj = 0; jj < 16; ++jj) vv_[jj] = *(const LAS unsigned long long*)(unsigned long long)(src[jj] & 0x1FFF8u);     \
                    __builtin_amdgcn_sched_barrier(0); \
                    _Pragma("unroll") for (int jj = 0; jj < 16; ++jj) { const int lo = (int)(unsigned)vv_[jj], hi = (int)(unsigned)(vv_[jj] >> 32); \
                    const h2_t c0_ = __builtin_amdgcn_cvt_scalef32_pk_f16_fp8(lo, 1.0f, false), c1_ = __builtin_amdgcn_cvt_scalef32_pk_f16_fp8(lo, 1.0f, true); \
                    const h2_t c2_ = __builtin_amdgcn_cvt_scalef32_pk_f16_fp8(hi, 1.0f, false), c3_ = __builtin_amdgcn_cvt_scalef32_pk_f16_fp8(hi, 1.0f, true); \
                    P11_FMA(c0_, src[jj], acc[0]); P11_FMA(c1_, src[jj], acc[1]); P11_FMA(c2_, src[jj], acc[2]); P11_FMA(c3_, src[jj], acc[3]); } } while (0)
#define P11_COMPX(src) do { unsigned long long vv_[16]; \
                    _Pragma("unroll") for (int jj = 0; jj < 16; ++jj) vv_[jj] = *(const LAS unsigned long long*)(unsigned long long)(src[jj] & 0x1FFF8u); \
                    __builtin_amdgcn_sched_barrier(0); \
                    _Pragma("unroll") for (int jj = 0; jj < 16; ++jj) { const int lo = (int)(unsigned)vv_[jj], hi = (int)(unsigned)(vv_[jj] >> 32); \
                    P11_FMA(lo, src[jj], acc[0]); P11_FMA(hi, src[jj], acc[1]); P11_FMA(lo, src[jj], acc[2]); P11_FMA(hi, src[jj], acc[3]); } } while (0)
        int lane = F.lane; asm volatile("" : "+v"(lane));
        unsigned pa[16], pb[16];
        f32x4 x0, x1;
        { const unsigned* pp = pairs + (size_t)F.wave * 128 * 64 + lane; P11_LOAD(pa, pp);
          const float* ip = F.out + (size_t)(F.wave * 64 + lane) * 2048 + c * 8; x0 = *(const f32x4*)ip; x1 = *(const f32x4*)(ip + 4); }
        for (int tile = F.wave; tile < MTOK / 64; tile += 8) {
            const unsigned* pp = pairs + (size_t)tile * 128 * 64 + lane;
            const int ntile = tile + 8 < MTOK / 64 ? tile + 8 : tile;
            const unsigned* npp = pairs + (size_t)ntile * 128 * 64 + lane;
            const int row = tile * 64 + lane;
            const float* gt2 = mf + (size_t)(tile / (SEQ / 64)) * 12288 + 10240 + c * 8;
            float* op = dst + (size_t)row * 2048 + c * 8;
            const f32x4 g0 = *(const f32x4*)gt2 * 0.25f, g1 = *(const f32x4*)(gt2 + 4) * 0.25f;
            h2_t acc[4];
#pragma unroll
            for (int i = 0; i < 4; ++i) acc[i] = (h2_t){(__fp16)0.f, (__fp16)0.f};
            f32x4 nx0 = x0, nx1 = x1;
#pragma unroll 1
            for (int j0 = 0; j0 < 128; j0 += 32) {
                P11_LOAD(pb, pp + (j0 + 16) * 64);
                P11_COMP(pa);
                const bool lastb = j0 + 32 >= 128;
                { const unsigned* np_ = lastb ? npp : pp + (j0 + 32) * 64; P11_LOAD(pa, np_); }
                if (lastb) { const float* nip = F.out + (size_t)(ntile * 64 + lane) * 2048 + c * 8; nx0 = *(const f32x4*)nip; nx1 = *(const f32x4*)(nip + 4); }
                P11_COMP(pb);
            }
#if PROBE_P11X == 1 || PROBE_P11X == 3
            { h2_t sv[4]; for (int i = 0; i < 4; ++i) sv[i] = acc[i];
#pragma unroll 1
              for (int j0 = 0; j0 < 128; j0 += 32) {
#pragma unroll
                for (int jj = 0; jj < 16; ++jj) { asm volatile("" : "+v"(pa[jj])); asm volatile("" : "+v"(pb[jj])); }
#if PROBE_P11X == 1
                P11_COMP(pa); P11_COMP(pb);
#else
                P11_COMPX(pa); P11_COMPX(pb);
#endif
              }
              asm volatile("" :: "v"(acc[0]), "v"(acc[1]), "v"(acc[2]), "v"(acc[3])); for (int i = 0; i < 4; ++i) acc[i] = sv[i]; }
#endif
            *(f32x4*)op = x0 + g0 * (f32x4){(float)acc[0][0], (float)acc[0][1], (float)acc[1][0], (float)acc[1][1]};
            *(f32x4*)(op + 4) = x1 + g1 * (f32x4){(float)acc[2][0], (float)acc[2][1], (float)acc[3][0], (float)acc[3][1]};
            x0 = nx0; x1 = nx1;
        }
#undef P11_LOAD
#undef P11_COMP
#undef P11_FMA
    }
}

__global__ void __launch_bounds__(512, 2) fwd_kernel(Args args) {
    extern __shared__ __attribute__((aligned(16))) unsigned char lds[];
    Frame F;
    F.lds = lds; F.ws = args.ws; F.tid = threadIdx.x; F.lane = F.tid & 63; F.wave = __builtin_amdgcn_readfirstlane(F.tid >> 6); F.G = gridDim.x; F.bid = blockIdx.x;
    F.x = args.in[0]; F.c = args.in[1]; F.w_ada = args.in[2]; F.b_ada = args.in[3]; F.g1 = args.in[4]; F.g2 = args.in[5]; F.w_in = args.in[6]; F.g_q = args.in[7]; F.g_k = args.in[8];
    F.rel_bias = args.in[9]; F.pool_w = args.in[10]; F.pool_scale = args.in[11]; F.w_ab = args.in[12]; F.w_pb = args.in[13]; F.w_out = args.in[14]; F.w_pq = args.in[15];
    F.peer_keys = args.in[16]; F.peer_u = args.in[17]; F.peer_v = args.in[18]; F.out = args.out;
    LAS unsigned char* ldsl = (LAS unsigned char*)lds;
    volatile LAS unsigned* misc = (volatile LAS unsigned*)(ldsl + MISC_OFF);
    if (F.tid < 4) misc[F.tid] = 0u;
    __syncthreads();
    unsigned* barw = (unsigned*)(args.ws + WS_CTL) + (size_t)args.li * XCD_BAR_WORDS;
    XcdBarrier bar; bar.bar = barw; bar.x = 0; bar.st = misc;
    const int lo = args.ph_lo, hi = args.ph_hi;
    if (hi - lo > 1) bar = xcd_barrier_post(barw, misc);
#define IN(k) (lo <= (k) && (k) < hi)
#define SEAM(k) do { if (IN(k) && IN((k) + 1)) xcd_barrier(bar, F.wave); } while (0)
    bf16_t* R0 = (bf16_t*)(F.ws + WS_R0);

#define PH2_BODY { \
        { pg8::Gemm g{(const bf16_t*)(F.ws + WS_H1F8), (const bf16_t*)(F.ws + WS_WIN8), MTOK, 5632, DM / 2, DM / 2, 0, nullptr, nullptr, 0, 0}; pg8::StaticOrder S; S.init(MTOK, 5632, F.G, F.bid); \
          EpiInproj<true> E{(bf16_t*)(F.ws + WS_QN), (bf16_t*)(F.ws + WS_KN), (bf16_t*)(F.ws + WS_V), (bf16_t*)(F.ws + WS_IQ), (bf16_t*)(F.ws + WS_IK), (bf16_t*)(F.ws + WS_PL), \
                    (bf16_t*)(F.ws + WS_GA), (bf16_t*)(F.ws + WS_GP), (float*)(F.ws + WS_IW)}; \
          pg8::gemm_phase<EpiInproj<true>, true>(ldsl, g, S, E, F.wave); } \
        { pg8::Gemm g{R0, (const bf16_t*)(F.ws + WS_WIN16), MTOK, 2304, DM, DM, 0, nullptr, nullptr, 0, 0}; pg8::StaticOrder S; S.init(MTOK, 2304, F.G, F.bid); \
          EpiInproj<false> E{(bf16_t*)(F.ws + WS_QN), (bf16_t*)(F.ws + WS_KN), (bf16_t*)(F.ws + WS_V), (bf16_t*)(F.ws + WS_IQ), (bf16_t*)(F.ws + WS_IK), (bf16_t*)(F.ws + WS_PL), \
                    (bf16_t*)(F.ws + WS_GA), (bf16_t*)(F.ws + WS_GP), (float*)(F.ws + WS_IW)}; \
          pg8::gemm_phase<EpiInproj<false>>(ldsl, g, S, E, F.wave); } }
#define PH3_BODY { phase3_pooled(F); phase3_indexer(F); __syncthreads(); }
#define PH4_BODY { \
        phase4_attention(F); \
        __syncthreads(); \
        pg8::Gemm g{(const bf16_t*)(F.ws + WS_POOLED), (const bf16_t*)(F.ws + WS_POOLW), MTOK, PW, 256, 1024, 256, nullptr, nullptr, 0, 0}; pg8::StaticOrder S; S.init(MTOK, PW, F.G, F.bid); \
        EpiF8Scale E{F.ws + WS_POOL2, 1024, F.pool_scale}; \
        pg8::gemm_phase<EpiF8Scale>(ldsl, g, S, E, F.wave); }
#define PH5_BODY { \
        pg8::Gemm g{(const bf16_t*)(F.ws + WS_ATTN), (const bf16_t*)(F.ws + WS_WAB), MTOK, DM, 1024, 512, 0, (const bf16_t*)(F.ws + WS_POOL2), (const bf16_t*)(F.ws + WS_WPB), 8, 512};     \
        pg8::StaticOrder S; S.init(MTOK, DM, F.G, F.bid); \
        EpiMerge E{(unsigned char*)R0, (const bf16_t*)(F.ws + WS_GA), (const bf16_t*)(F.ws + WS_GP)}; pg8::gemm_phase<EpiMerge, true>(ldsl, g, S, E, F.wave); }
#define PH6_BODY { \
        pg8::Gemm g{R0, (const bf16_t*)(F.ws + WS_WOUT), MTOK, DM, DM / 2, DM / 2, 0, nullptr, nullptr, 0, 0}; pg8::StaticOrder S; S.init(MTOK, DM, F.G, F.bid); \
        EpiResid E{F.x, F.out, (const float*)(F.ws + WS_MODF) + 4096}; pg8::gemm_phase<EpiResid, true>(ldsl, g, S, E, F.wave); }
#define PH8_BODY { \
        pg8::Gemm g{(const bf16_t*)(F.ws + WS_H2), (const bf16_t*)(F.ws + WS_WPQ), MTOK, DM, DM, DM, 0, nullptr, nullptr, 0, 0}; pg8::StaticOrder S; S.init(MTOK, DM, F.G, F.bid); \
        EpiBf16Scale E{R0, 2048, nullptr}; pg8::gemm_phase<EpiBf16Scale>(ldsl, g, S, E, F.wave); }
#define PH9_BODY { \
        pg8::Gemm g{R0, (const bf16_t*)(F.ws + WS_KEYSBD), MTOK, DM, 256, DM, 256, nullptr, nullptr, 0, 0}; pg8::StaticOrder S; S.init(MTOK, DM, F.G, F.bid); \
        EpiBf16Scale E{(bf16_t*)(F.ws + WS_SUB), 2048, nullptr}; pg8::gemm_phase<EpiBf16Scale>(ldsl, g, S, E, F.wave); }
#define REP(k) if constexpr (((PROBE_REP) >> (k)) & 1)

    if (IN(0)) { phase0_prep(F); REP(0) { __syncthreads(); phase0_prep(F); } }
    SEAM(0);
    if (IN(1)) { phase_modnorm<true>(F, F.x, F.g1, 0, 2048, R0, F.ws + WS_H1F8); REP(1) { phase_modnorm<true>(F, F.x, F.g1, 0, 2048, R0, F.ws + WS_H1F8); } }
    SEAM(1);
    if (IN(2)) { PH2_BODY REP(2) PH2_BODY }
    SEAM(2);
    if (IN(3)) { phase3_qknorm(F); PH3_BODY REP(3) PH3_BODY }
    SEAM(3);
    if (IN(4)) { PH4_BODY REP(4) PH4_BODY }
    SEAM(4);
    if (IN(5)) { PH5_BODY REP(5) PH5_BODY }
    SEAM(5);
    if (IN(6)) { PH6_BODY REP(6) PH6_BODY }
    SEAM(6);
    if (IN(7)) { phase_modnorm<false>(F, F.out, F.g2, 6144, 8192, (bf16_t*)(F.ws + WS_H2)); REP(7) { phase_modnorm<false>(F, F.out, F.g2, 6144, 8192, (bf16_t*)(F.ws + WS_H2)); } }
    SEAM(7);
    if (IN(8)) { PH8_BODY REP(8) PH8_BODY }
    SEAM(8);
    if (IN(9)) { PH9_BODY REP(9) PH9_BODY }
    SEAM(9);
    if (IN(10)) { phase10_peer(F); REP(10) phase10_peer<PROBE_P10M>(F); }
    SEAM(10);
    if (IN(11)) { REP(11) { phase11_peer_v(F, (float*)(F.ws + WS_SUB)); } phase11_peer_v(F, F.out); }
#undef IN
#undef SEAM
}

extern "C" void kernel_launch(void* const* d_in, const int* in_sizes, int n_in, void* d_out, int out_size, void* d_ws, size_t ws_size, hipStream_t stream) {
    static int grid = 0;
    if (grid == 0) {
        if (n_in != 19 || out_size != MTOK * DM || ws_size < WS_END) { fprintf(stderr, "kernel_launch: unexpected shapes (n_in %d out %d ws %zu)\n", n_in, out_size, ws_size); grid = -1; return; }
        int dev = 0, cus = 0, per_cu = 0;
        if (hipGetDevice(&dev) != hipSuccess || hipDeviceGetAttribute(&cus, hipDeviceAttributeMultiprocessorCount, dev) != hipSuccess) { grid = -1; return; }
        if (hipFuncSetAttribute((const void*)fwd_kernel, hipFuncAttributeMaxDynamicSharedMemorySize, LDS_BYTES) != hipSuccess) { fprintf(stderr, "kernel_launch: hipFuncSetAttribute failed\n"); grid = -1; return; }
        if (hipOccupancyMaxActiveBlocksPerMultiprocessor(&per_cu, (const void*)fwd_kernel, 512, LDS_BYTES) != hipSuccess || per_cu < 1) { fprintf(stderr, "kernel_launch: occupancy query says %d\n", per_cu); }
        (void)hipGetLastError();
        grid = cus;
    }
    if (grid < 0) return;
    (void)in_sizes;
    if (hipMemsetAsync((char*)d_ws + WS_CTL, 0, CTL_ZERO_BYTES, stream) != hipSuccess) return;
    Args a{};
    for (int i = 0; i < 19; ++i) a.in[i] = (const float*)d_in[i];
    a.out = (float*)d_out; a.ws = (unsigned char*)d_ws;
#if MK_PER_PHASE
    for (int p = 0; p < NPHASE; ++p) { a.ph_lo = p; a.ph_hi = p + 1; a.li = p; hipLaunchKernelGGL(fwd_kernel, dim3(grid), dim3(512), LDS_BYTES, stream, a); }
#else
    a.ph_lo = 0; a.ph_hi = NPHASE; a.li = 0;
    hipLaunchKernelGGL(fwd_kernel, dim3(grid), dim3(512), LDS_BYTES, stream, a);
#endif
}
```

```cpp
#include <hip/hip_runtime.h>
#include <cstdio>
#include <cstdint>

#ifndef MK_PER_PHASE
#define MK_PER_PHASE 0
#endif

#ifndef PROBE_REP
#define PROBE_REP 0
#endif
#ifndef PROBE_IDX
#define PROBE_IDX 0
#endif
#ifndef PROBE_P10M
#define PROBE_P10M 0
#endif
#ifndef PROBE_P11X
#define PROBE_P11X 0
#endif
#define LAS __attribute__((address_space(3)))
typedef unsigned short bf16_t;
typedef short bf16x8 __attribute__((ext_vector_type(8)));
typedef float f32x4 __attribute__((ext_vector_type(4)));
typedef float f32x2 __attribute__((ext_vector_type(2)));
typedef int v2i __attribute__((ext_vector_type(2)));
typedef unsigned u32x4 __attribute__((ext_vector_type(4)));
typedef unsigned u32x2 __attribute__((ext_vector_type(2)));
typedef unsigned u32x6 __attribute__((ext_vector_type(6)));
typedef unsigned u32x16 __attribute__((ext_vector_type(16)));
typedef __bf16 bf16x32 __attribute__((ext_vector_type(32)));

constexpr int BATCH = 8, SEQ = 4096, DM = 2048, MTOK = BATCH * SEQ;
constexpr int NHEAD = 8, HDIM = 128, AW = 1024, KVW = 256, IHEADS = 16, IDIM = 64, KSEL = 256;
constexpr int PW = 1024, PHEADS = 8, NEXP = 16384;
constexpr int INW = 7760;
constexpr float EPS = 1e-6f;
constexpr int NPHASE = 12;

constexpr size_t MiB = 1u << 20;
constexpr size_t WS_CTL = 0, CTL_ZERO_BYTES = 256 * 1024;
constexpr size_t WS_MODP = 2 * MiB;
constexpr size_t WS_MODF = 4 * MiB;
constexpr size_t WS_POOLW = 5 * MiB;
constexpr size_t WS_KEYSBD = 6 * MiB;
constexpr size_t WS_WIN16 = 8 * MiB;
constexpr size_t WS_WIN8 = 20 * MiB;
constexpr size_t WS_WAB = 40 * MiB, WS_WPB = 44 * MiB, WS_WOUT = 48 * MiB, WS_WPQ = 56 * MiB;
constexpr size_t WS_PU = 64 * MiB, WS_PV = 128 * MiB;
constexpr size_t WS_R0 = 192 * MiB;
constexpr size_t WS_GA = 320 * MiB, WS_GP = 448 * MiB;
constexpr size_t WS_SUB = 320 * MiB;
constexpr size_t WS_QN = 576 * MiB;
constexpr size_t WS_IQ = 640 * MiB;
constexpr size_t WS_PL = 704 * MiB;
constexpr size_t WS_KN = 768 * MiB, WS_V = 784 * MiB;
constexpr size_t WS_IK = 800 * MiB;
constexpr size_t WS_IW = 804 * MiB;
constexpr size_t WS_SEL = 806 * MiB;
constexpr size_t WS_POOLED = 822 * MiB;
constexpr size_t WS_H2 = 886 * MiB;
constexpr size_t WS_END = 1014 * MiB;
constexpr size_t WS_H1F8 = WS_H2 + 64 * MiB;
constexpr size_t WS_Q8 = WS_H2, WS_K8 = WS_H2 + 32 * MiB, WS_V8 = WS_H2 + 40 * MiB;
constexpr size_t WS_ATTN = WS_IQ, WS_POOL2 = WS_PL, WS_PAIRS = WS_QN, WS_WLS = WS_QN + 32 * MiB;

constexpr int LDS_BYTES = 160 * 1024;
constexpr int MISC_OFF = 159 * 1024;

__device__ __forceinline__ unsigned cvt_pk_bf16(float lo, float hi) { unsigned r; asm volatile("v_cvt_pk_bf16_f32 %0, %1, %2" : "=v"(r) : "v"(lo), "v"(hi)); return r; }
__device__ __forceinline__ float bf_lo(unsigned w) { return __uint_as_float(w << 16); }
__device__ __forceinline__ float bf_hi(unsigned w) { return __uint_as_float(w & 0xffff0000u); }
template <int CTRL> __device__ __forceinline__ float dpp_f(float x) { return __int_as_float(__builtin_amdgcn_update_dpp(0, __float_as_int(x), CTRL, 0xF, 0xF, true)); }
#define DPP_XOR1 0xB1
#define DPP_XOR2 0x4E
#define DPP_HMIRROR 0x141
#define DPP_MIRROR 0x140
#define DPP_ROR8 0x128
__device__ __forceinline__ float xor16_sum(float x) { const auto r = __builtin_amdgcn_permlane16_swap(__float_as_uint(x), __float_as_uint(x), false, false); return __uint_as_float(r[0]) + __uint_as_float(r[1]); }
__device__ __forceinline__ float xor32_sum(float x) { const auto r = __builtin_amdgcn_permlane32_swap(__float_as_uint(x), __float_as_uint(x), false, false); return __uint_as_float(r[0]) + __uint_as_float(r[1]); }
__device__ __forceinline__ float xor16_max(float x) { const auto r = __builtin_amdgcn_permlane16_swap(__float_as_uint(x), __float_as_uint(x), false, false); return fmaxf(__uint_as_float(r[0]), __uint_as_float(r[1])); }
__device__ __forceinline__ float swap32_pair(float a, float b) { const auto r = __builtin_amdgcn_permlane32_swap(__float_as_uint(a), __float_as_uint(b), false, false); return __uint_as_float(r[0]) + __uint_as_float(r[1]); }
__device__ __forceinline__ float swap16_pair(float a, float b) { const auto r = __builtin_amdgcn_permlane16_swap(__float_as_uint(a), __float_as_uint(b), false, false); return __uint_as_float(r[0]) + __uint_as_float(r[1]); }
__device__ __forceinline__ float row_sum16(float v) { v += dpp_f<DPP_XOR1>(v); v += dpp_f<DPP_XOR2>(v); v += dpp_f<DPP_HMIRROR>(v); v += dpp_f<DPP_MIRROR>(v); return v; }
__device__ __forceinline__ float row_max16(float v) { v = fmaxf(v, dpp_f<DPP_XOR1>(v)); v = fmaxf(v, dpp_f<DPP_XOR2>(v)); v = fmaxf(v, dpp_f<DPP_HMIRROR>(v)); v = fmaxf(v, dpp_f<DPP_MIRROR>(v)); return v; }
__device__ __forceinline__ float wave_sum(float v) { return xor32_sum(xor16_sum(row_sum16(v))); }
__device__ __forceinline__ float sigmoidf_(float x) { return __builtin_amdgcn_rcpf(1.0f + __expf(-x)); }
__device__ __forceinline__ float dot8(u32x4 w, const float* h) {
    return bf_lo(w.x) * h[0] + bf_hi(w.x) * h[1] + bf_lo(w.y) * h[2] + bf_hi(w.y) * h[3] + bf_lo(w.z) * h[4] + bf_hi(w.z) * h[5] + bf_lo(w.w) * h[6] + bf_hi(w.w) * h[7];
}

__device__ __forceinline__ int lane_now() { int l; asm volatile("v_mbcnt_lo_u32_b32 %0, -1, 0\n\tv_mbcnt_hi_u32_b32 %0, -1, %0" : "=v"(l)); return l; }

#define XB_TMO      128
#define XB_XCNT(j)  (256  + 64 * (j))
#define XB_XSUB(j)  (1280 + 64 * (j))
#define XB_XGEN(j)  (2304 + 64 * (j))
#define XB_TOP      3328
#define XB_TOPGEN   3392
#define XCD_BAR_WORDS 3456
#define XB_SPIN_CAP (1u << 18)

__device__ __forceinline__ unsigned xb_ld(unsigned* p)              { return __hip_atomic_load(p, __ATOMIC_RELAXED, __HIP_MEMORY_SCOPE_AGENT); }
__device__ __forceinline__ unsigned xb_add(unsigned* p, unsigned v) { return __hip_atomic_fetch_add(p, v, __ATOMIC_RELAXED, __HIP_MEMORY_SCOPE_AGENT); }
__device__ __forceinline__ unsigned xb_xcc_id() { return (unsigned)__builtin_amdgcn_s_getreg((3 << 11) | 20) & 0xFu; }
#define XB_SPIN(cond, bar) do { unsigned _sp = 0; while (cond) { __builtin_amdgcn_s_sleep(1); \
    if ((++_sp & 255u) == 0u) { if (xb_ld(&(bar)[XB_TMO])) break; if (_sp > XB_SPIN_CAP) { atomicAdd(&(bar)[XB_TMO], 1u); break; } } } } while (0)

struct XcdBarrier { unsigned* bar; unsigned x; volatile LAS unsigned* st; };

__device__ __forceinline__ XcdBarrier xcd_barrier_post(unsigned* bar, volatile LAS unsigned* st) {
    XcdBarrier b; b.bar = bar; b.x = xb_xcc_id(); b.st = st;
    if (threadIdx.x == 0) (void)xb_add(&bar[XB_XCNT(b.x)], 1u);
    return b;
}
__device__ __forceinline__ void xcd_barrier_complete(unsigned* bar, unsigned x, unsigned& nloc, unsigned& nx) {
    const unsigned G = gridDim.x * gridDim.y * gridDim.z;
    unsigned sum, cnt, mine, sp = 0u;
    for (;;) {
        sum = 0u; cnt = 0u; mine = 0u;
#pragma unroll
        for (unsigned j = 0; j < 16; ++j) { const unsigned c = xb_ld(&bar[XB_XCNT(j)]); sum += c; cnt += (c > 0u) ? 1u : 0u; mine = (j == x) ? c : mine; }
        if (sum == G) break;
        __builtin_amdgcn_s_sleep(1);
        if ((++sp & 255u) == 0u) { if (xb_ld(&bar[XB_TMO])) break; if (sp > XB_SPIN_CAP) { atomicAdd(&bar[XB_TMO], 1u); break; } }
    }
    nloc = mine > 0u ? mine : 1u; nx = cnt > 0u ? cnt : 1u;
}
__device__ __forceinline__ void xcd_barrier(const XcdBarrier& b, int wave) {
    asm volatile("s_waitcnt vmcnt(0)" ::: "memory");
    __syncthreads();
    if (wave == 0 && lane_now() == 0) {
        unsigned* bar = b.bar;
        __builtin_amdgcn_s_waitcnt(0);
        unsigned nloc = b.st[0], nx = b.st[1];
        if (nloc == 0u) { xcd_barrier_complete(bar, b.x, nloc, nx); b.st[0] = nloc; b.st[1] = nx; }
        const unsigned old = xb_add(&bar[XB_XSUB(b.x)], 1u);
        const unsigned gen = old / nloc;
        if (old + 1u == (gen + 1u) * nloc) {
            __builtin_amdgcn_fence(__ATOMIC_RELEASE, "agent");
            asm volatile("s_waitcnt vmcnt(0)" ::: "memory");
            const unsigned og = xb_add(&bar[XB_TOP], 1u);
            const unsigned tg = og / nx;
            if (og + 1u == (tg + 1u) * nx) xb_add(&bar[XB_TOPGEN], 1u);
            else XB_SPIN(xb_ld(&bar[XB_TOPGEN]) == tg, bar);
            __builtin_amdgcn_fence(__ATOMIC_ACQUIRE, "agent");
            xb_add(&bar[XB_XGEN(b.x)], 1u);
            asm volatile("s_waitcnt vmcnt(0)" ::: "memory");
        } else {
            XB_SPIN(xb_ld(&bar[XB_XGEN(b.x)]) == gen, bar);
            __builtin_amdgcn_fence(__ATOMIC_ACQUIRE, "agent");
            asm volatile("s_waitcnt vmcnt(0)" ::: "memory");
        }
    }
    __syncthreads();
}

namespace pg8 {
constexpr int BM = 256, BK = 64, HALF = 128, HTB = HALF * BK * 2, STAGE_BYTES = 8 * HTB, NXCD = 8, WGM = 8;
__device__ __forceinline__ int lds_byte(int r, int c) { const int st = (r >> 4) * 2 + (c >> 5), rr = r & 15, cc = c & 31, ob = rr * 64 + cc * 2; return st * 1024 + (ob ^ (((ob >> 9) & 1) << 5)); }
__device__ __forceinline__ void stage_rc(int b, int& R, int& C) { const int st = b / 1024, sb = b % 1024, swz = sb ^ (((sb >> 9) & 1) << 5); R = (st >> 1) * 16 + swz / 64; C = (st & 1) * 32 + (swz % 64) / 2; }
__device__ __forceinline__ int perm32(int rho) { const int n = rho >> 4, i = rho & 15; return 8 * (i >> 2) + 4 * n + (i & 3); }

struct Unit { int pm, pn; };
struct Gemm { const bf16_t* A; const bf16_t* Bt; int M, N, K, lda, a_pn_off; const bf16_t* A2; const bf16_t* Bt2; int ksplit, ldb; };

struct StaticOrder {
    int nM, nN, nwg, G, c;
    __device__ void init(int M, int N, int G_, int c_) { nM = M / BM; nN = N / BM; nwg = nM * nN; G = G_; c = c_; }
    __device__ bool next(int i, Unit& u) const {
        const long L = (long)i * G + c; if (L >= nwg) return false;
        int wgid = (int)L; { const int q = nwg / NXCD, r = nwg % NXCD, xcd = wgid % NXCD, off = wgid / NXCD; wgid = (xcd < r ? xcd * (q + 1) : r * (q + 1) + (xcd - r) * q) + off; }
        const int nig = WGM * nN, gid = wgid / nig, fm = gid * WGM, gsz = (nM - fm) < WGM ? (nM - fm) : WGM;
        u.pm = fm + ((wgid % nig) % gsz); u.pn = (wgid % nig) / gsz; return true;
    }
};

typedef int i32x4 __attribute__((ext_vector_type(4)));
typedef int i32x8 __attribute__((ext_vector_type(8)));
__device__ __forceinline__ bf16x8 lo8(i32x8 v) { return __builtin_bit_cast(bf16x8, (i32x4){v.s0, v.s1, v.s2, v.s3}); }
__device__ __forceinline__ bf16x8 hi8(i32x8 v) { return __builtin_bit_cast(bf16x8, (i32x4){v.s4, v.s5, v.s6, v.s7}); }
__device__ __forceinline__ i32x8 cat8(bf16x8 a, bf16x8 b) { const i32x4 x = __builtin_bit_cast(i32x4, a), y = __builtin_bit_cast(i32x4, b); return (i32x8){x.x, x.y, x.z, x.w, y.x, y.y, y.z, y.w}; }
template <class Epi, bool F8 = false>
__device__ __forceinline__ void gemm_phase(LAS unsigned char* lds, const Gemm g, const StaticOrder& S, const Epi& E, int wave) {
    const int lane = lane_now(), wid = wave, tid = wid * 64 + lane, wr = wid >> 2, wc = wid & 3, fr = lane & 15, fq = lane >> 4;
    const int K = g.K, nt = K / BK, lda = g.lda, ldb = g.ldb ? g.ldb : g.K, ksplit = g.ksplit;
    unsigned voffA, voffB;
    { int R, C; stage_rc(tid * 16, R, C); const int Rb = Epi::PERM ? ((R & ~31) + perm32(R & 31)) : R;
      voffA = (unsigned)(R * lda + C) * 2u; voffB = (unsigned)(Rb * ldb + C) * 2u; }
    const unsigned stepA = 64u * (unsigned)lda * 2u, stepB = 64u * (unsigned)ldb * 2u;
    const size_t kstep = (size_t)(BK * 2);
    const size_t hsA = (size_t)HALF * lda * 2, hsB = (size_t)HALF * ldb * 2;
    const size_t tsA = 2 * hsA, tsB = 2 * hsB;
    const unsigned ldsw = (unsigned)wid * 1024u, ldsbase = (unsigned)(unsigned long long)lds;
    const int aoff = lds_byte(wr * 64 + fr, fq * 8), boff = lds_byte(wc * 32 + fr, fq * 8);
#define PG8_SA(b, h) (((b) * 2 + (h)) * HTB)
#define PG8_SB(b, h) ((4 + (b) * 2 + (h)) * HTB)
#define PG8_STAGE(bufoff, gbase, voff) do { _Pragma("unroll") for (int _i = 0; _i < 2; ++_i) { \
        const char* sb_ = (const char*)(gbase) + (size_t)_i * PG8_STEP_##voff; const unsigned m0_ = ldsbase + (unsigned)(bufoff) + ldsw + (unsigned)_i * 8192u; \
        asm volatile("s_mov_b32 m0, %2\n\ts_nop 0\n\tglobal_load_lds_dwordx4 %0, %1" :: "v"(voff), "s"(sb_), "s"(m0_) : "memory"); } } while (0)
#define PG8_STEP_voffA stepA
#define PG8_STEP_voffB stepB
#define PG8_LDA(dst, b, h) do { _Pragma("unroll") for (int m = 0; m < 4; ++m) dst[m] = cat8(*(const LAS bf16x8*)(lds + PG8_SA(b, h) + aoff + m * 2048), *(const LAS bf16x8*)(lds + PG8_SA(b, h) + aoff + m * 2048 + 1024)); } while (0)
#define PG8_LDB(dst, b, h) do { _Pragma("unroll") for (int n = 0; n < 2; ++n) dst[n] = cat8(*(const LAS bf16x8*)(lds + PG8_SB(b, h) + boff + n * 2048), *(const LAS bf16x8*)(lds + PG8_SB(b, h) + boff + n * 2048 + 1024)); } while (0)
#define PG8_MMA(ai, bj, At, Bt) do { __builtin_amdgcn_s_setprio(1); _Pragma("unroll") for (int m = 0; m < 4; ++m) _Pragma("unroll") for (int n = 0; n < 2; ++n) { \
        if constexpr (F8) acc[ai][bj][m][n] = __builtin_amdgcn_mfma_scale_f32_16x16x128_f8f6f4(Bt[n], At[m], acc[ai][bj][m][n], 0, 0, 0, 0x7D7D7D7D  , 0, 0x7D7D7D7D); \
        else { acc[ai][bj][m][n] = __builtin_amdgcn_mfma_f32_16x16x32_bf16(lo8(Bt[n]), lo8(At[m]), acc[ai][bj][m][n], 0, 0, 0); \
               acc[ai][bj][m][n] = __builtin_amdgcn_mfma_f32_16x16x32_bf16(hi8(Bt[n]), hi8(At[m]), acc[ai][bj][m][n], 0, 0, 0); } } \
        __builtin_amdgcn_s_setprio(0); } while (0)
#define PG8_WAIT_V(n) asm volatile("s_waitcnt vmcnt(" #n ")" ::: "memory")
#define PG8_WAIT_L(n) asm volatile("s_waitcnt lgkmcnt(" #n ")" ::: "memory")
#define PG8_BAR __builtin_amdgcn_s_barrier()
#define PG8_SCHED __builtin_amdgcn_sched_barrier(0)
    Unit cur, nxt; int ui = 0;
    if (!S.next(0, cur)) return;
    f32x4 acc[2][2][4][2];
#pragma unroll
    for (int a = 0; a < 2; ++a)
#pragma unroll
        for (int b = 0; b < 2; ++b)
#pragma unroll
            for (int m = 0; m < 4; ++m)
#pragma unroll
                for (int n = 0; n < 2; ++n) acc[a][b][m][n] = (f32x4){0.f, 0.f, 0.f, 0.f};
    i32x8 At[4], B0[2], B1[2];
    const char* cA = (const char*)g.A + (size_t)cur.pm * tsA + (size_t)cur.pn * g.a_pn_off * 2; const char* cB = (const char*)g.Bt + (size_t)cur.pn * tsB;
    PG8_STAGE(PG8_SB(0, 0), cB, voffB); PG8_STAGE(PG8_SB(0, 1), cB + hsB, voffB); PG8_STAGE(PG8_SA(0, 0), cA, voffA); PG8_STAGE(PG8_SA(0, 1), cA + hsA, voffA);
    if (wr == 1) PG8_BAR;
    PG8_WAIT_V(2); PG8_BAR;
    PG8_STAGE(PG8_SB(1, 0), cB + kstep, voffB); PG8_STAGE(PG8_SA(1, 0), cA + kstep, voffA); PG8_STAGE(PG8_SB(1, 1), cB + hsB + kstep, voffB);
    PG8_WAIT_V(6); PG8_BAR;
    for (;;) {
        const bool has_next = S.next(ui + 1, nxt);
        const char* nA = has_next ? (const char*)g.A + (size_t)nxt.pm * tsA + (size_t)nxt.pn * g.a_pn_off * 2 : cA; const char* nB = has_next ? (const char*)g.Bt + (size_t)nxt.pn * tsB : cB;
        const char* cA2 = (const char*)g.A2 + (size_t)cur.pm * tsA; const char* cB2 = (const char*)g.Bt2 + (size_t)cur.pn * tsB;
#pragma clang loop unroll(disable)
        for (int t = 0; t < nt; t += 2) {
            const bool last = (t == nt - 2);
            const bool s1 = ksplit && (t >= ksplit), s2 = ksplit && (t + 2 >= ksplit);
            const char* a1 = (s1 ? cA2 + (size_t)(t - ksplit + 1) * kstep : cA + (size_t)(t + 1) * kstep);
            const char* a2 = last ? nA : (s2 ? cA2 + (size_t)(t + 2 - ksplit) * kstep : cA + (size_t)(t + 2) * kstep);
            const char* b2 = last ? nB : (s2 ? cB2 + (size_t)(t + 2 - ksplit) * kstep : cB + (size_t)(t + 2) * kstep);
            const char* a3 = a2 + kstep; const char* b3 = b2 + kstep;
            PG8_LDB(B0, 0, 0); PG8_LDB(B1, 0, 1); PG8_SCHED; PG8_LDA(At, 0, 0); PG8_STAGE(PG8_SA(1, 1), a1 + hsA, voffA);
            PG8_WAIT_V(8); PG8_WAIT_L(0); PG8_BAR; PG8_MMA(0, 0, At, B0); PG8_MMA(0, 1, At, B1); PG8_BAR; PG8_SCHED;
            PG8_LDA(At, 0, 1); PG8_STAGE(PG8_SB(0, 0), b2, voffB); PG8_STAGE(PG8_SB(0, 1), b2 + hsB, voffB); PG8_STAGE(PG8_SA(0, 0), a2, voffA);
            PG8_WAIT_V(8); PG8_WAIT_L(0); PG8_BAR; PG8_MMA(1, 0, At, B0); PG8_MMA(1, 1, At, B1); PG8_BAR; PG8_SCHED;
            PG8_LDB(B0, 1, 0); PG8_LDB(B1, 1, 1); PG8_SCHED; PG8_LDA(At, 1, 0); PG8_STAGE(PG8_SA(0, 1), a2 + hsA, voffA);
            PG8_WAIT_V(8); PG8_WAIT_L(0); PG8_BAR; PG8_MMA(0, 0, At, B0); PG8_MMA(0, 1, At, B1); PG8_BAR; PG8_SCHED;
            PG8_LDA(At, 1, 1); PG8_STAGE(PG8_SB(1, 0), b3, voffB); PG8_STAGE(PG8_SB(1, 1), b3 + hsB, voffB); PG8_STAGE(PG8_SA(1, 0), a3, voffA);
            PG8_WAIT_V(8); PG8_WAIT_L(0); PG8_BAR; PG8_MMA(1, 0, At, B0); PG8_MMA(1, 1, At, B1); PG8_BAR; PG8_SCHED;
            if constexpr (Epi::MID) { if (t + 2 == ksplit) E.mid(acc, cur, wr, wc, fr, fq); }
        }
        if (wr == 0) PG8_BAR;
        { const int l2 = lane_now(); E(acc, cur, wr, wc, l2 & 15, l2 >> 4); }
        if (!has_next) break;
#pragma unroll
        for (int a = 0; a < 2; ++a)
#pragma unroll
            for (int b = 0; b < 2; ++b)
#pragma unroll
                for (int m = 0; m < 4; ++m)
#pragma unroll
                    for (int n = 0; n < 2; ++n) acc[a][b][m][n] = (f32x4){0.f, 0.f, 0.f, 0.f};
        cur = nxt; cA = nA; cB = nB; ++ui;
        if (wr == 1) PG8_BAR;
    }
    PG8_WAIT_V(0);
    PG8_BAR;
#undef PG8_SA
#undef PG8_SB
#undef PG8_STAGE
#undef PG8_STEP_voffA
#undef PG8_STEP_voffB
#undef PG8_LDA
#undef PG8_LDB
#undef PG8_MMA
#undef PG8_WAIT_V
#undef PG8_WAIT_L
#undef PG8_BAR
#undef PG8_SCHED
}
}
using pg8::Unit;

typedef f32x4 AccT[2][2][4][2];
__device__ __forceinline__ u32x4 pack8(f32x4 a, f32x4 b) { u32x4 w; w.x = cvt_pk_bf16(a[0], a[1]); w.y = cvt_pk_bf16(a[2], a[3]); w.z = cvt_pk_bf16(b[0], b[1]); w.w = cvt_pk_bf16(b[2], b[3]); return w; }
__device__ __forceinline__ u32x2 pack8_fp8(f32x4 a, f32x4 b) {
    int w0 = __builtin_amdgcn_cvt_pk_fp8_f32(a[0], a[1], 0, false); w0 = __builtin_amdgcn_cvt_pk_fp8_f32(a[2], a[3], w0, true);
    int w1 = __builtin_amdgcn_cvt_pk_fp8_f32(b[0], b[1], 0, false); w1 = __builtin_amdgcn_cvt_pk_fp8_f32(b[2], b[3], w1, true);
    return (u32x2){(unsigned)w0, (unsigned)w1};
}
__device__ __forceinline__ void unpack8(u32x4 w, f32x4& a, f32x4& b) { a = (f32x4){bf_lo(w.x), bf_hi(w.x), bf_lo(w.y), bf_hi(w.y)}; b = (f32x4){bf_lo(w.z), bf_hi(w.z), bf_lo(w.w), bf_hi(w.w)}; }

template <bool SET8> struct EpiInproj {
    static constexpr bool PERM = true, MID = false;
    bf16_t *q, *k, *v, *iq, *ik, *pl, *ga, *gp; float* iw;
    __device__ __forceinline__ void operator()(const AccT& acc, const Unit& u, int wr, int wc, int fr, int fq) const {
        const int pn = u.pn, row0 = u.pm * 256 + wr * 64 + fr;
        if (!SET8 && pn == 4) {
            if (wc < 2) {
#pragma unroll
                for (int ai = 0; ai < 2; ++ai)
#pragma unroll
                    for (int m = 0; m < 4; ++m) { const size_t row = (size_t)(row0 + ai * 128 + m * 16);
                        *(u32x4*)(ik + row * 64 + wc * 32 + 8 * fq) = pack8(acc[ai][0][m][0], acc[ai][0][m][1]); }
            } else if (wc == 2) {
                if (fq < 2) {
#pragma unroll
                    for (int ai = 0; ai < 2; ++ai)
#pragma unroll
                        for (int m = 0; m < 4; ++m) { const size_t row = (size_t)(row0 + ai * 128 + m * 16);
                            *(f32x4*)(iw + row * 16 + 8 * fq) = acc[ai][0][m][0]; *(f32x4*)(iw + row * 16 + 8 * fq + 4) = acc[ai][0][m][1]; }
                }
            }
            return;
        }
        bf16_t* dst; int ld, tc; bool sg = false;
        if (SET8) {
            if (pn < 4) { dst = q; ld = 1024; tc = pn * 256; }
            else if (pn == 4) { dst = k; ld = 256; tc = 0; }
            else if (pn == 5) { dst = v; ld = 256; tc = 0; }
            else if (pn < 14) { dst = ga; ld = 2048; tc = (pn - 6) * 256; sg = true; }
            else { dst = gp; ld = 2048; tc = (pn - 14) * 256; sg = true; }
        } else {
            if (pn < 4) { dst = iq; ld = 1024; tc = pn * 256; }
            else { dst = pl; ld = 1024; tc = (pn - 5) * 256; }
        }
        const int col0 = tc + wc * 32 + 8 * fq;
#pragma unroll
        for (int ai = 0; ai < 2; ++ai)
#pragma unroll
            for (int m = 0; m < 4; ++m) { bf16_t* rowp = dst + (size_t)(row0 + ai * 128 + m * 16) * ld + col0;
#pragma unroll
                for (int bj = 0; bj < 2; ++bj) { f32x4 v0 = acc[ai][bj][m][0], v1 = acc[ai][bj][m][1];
                    if (sg) {
#pragma unroll
                        for (int j = 0; j < 4; ++j) { v0[j] = sigmoidf_(v0[j]); v1[j] = sigmoidf_(v1[j]); } }
                    *(u32x4*)(rowp + bj * 128) = pack8(v0, v1); } }
    }
};
struct EpiBf16Scale {
    static constexpr bool PERM = true, MID = false;
    bf16_t* O; int ldc; const float* cs;
    __device__ __forceinline__ void operator()(const AccT& acc, const Unit& u, int wr, int wc, int fr, int fq) const {
        const int row0 = u.pm * 256 + wr * 64 + fr, col0 = u.pn * 256 + wc * 32 + 8 * fq;
        f32x4 s[2][2];
#pragma unroll
        for (int bj = 0; bj < 2; ++bj)
#pragma unroll
            for (int n = 0; n < 2; ++n) s[bj][n] = cs ? *(const f32x4*)(cs + col0 + bj * 128 + 4 * n) : (f32x4){1.f, 1.f, 1.f, 1.f};
#pragma unroll
        for (int ai = 0; ai < 2; ++ai)
#pragma unroll
            for (int m = 0; m < 4; ++m) { bf16_t* rowp = O + (size_t)(row0 + ai * 128 + m * 16) * ldc + col0;
#pragma unroll
                for (int bj = 0; bj < 2; ++bj) *(u32x4*)(rowp + bj * 128) = pack8(acc[ai][bj][m][0] * s[bj][0], acc[ai][bj][m][1] * s[bj][1]); }
    }
};
struct EpiF8Scale {
    static constexpr bool PERM = true, MID = false;
    unsigned char* O; int ldc; const float* cs;
    __device__ __forceinline__ void operator()(const AccT& acc, const Unit& u, int wr, int wc, int fr, int fq) const {
        const int row0 = u.pm * 256 + wr * 64 + fr, col0 = u.pn * 256 + wc * 32 + 8 * fq;
        f32x4 s[2][2];
#pragma unroll
        for (int bj = 0; bj < 2; ++bj)
#pragma unroll
            for (int n = 0; n < 2; ++n) s[bj][n] = *(const f32x4*)(cs + col0 + bj * 128 + 4 * n);
#pragma unroll
        for (int ai = 0; ai < 2; ++ai)
#pragma unroll
            for (int m = 0; m < 4; ++m) { unsigned char* rowp = O + (size_t)(row0 + ai * 128 + m * 16) * ldc + col0;
#pragma unroll
                for (int bj = 0; bj < 2; ++bj) *(u32x2*)(rowp + bj * 128) = pack8_fp8(acc[ai][bj][m][0] * s[bj][0], acc[ai][bj][m][1] * s[bj][1]); }
    }
};
template <bool ADD> struct EpiGate {
    static constexpr bool PERM = true, MID = false;
    bf16_t* O; const bf16_t* gate;
    __device__ __forceinline__ void operator()(const AccT& acc, const Unit& u, int wr, int wc, int fr, int fq) const {
        const int row0 = u.pm * 256 + wr * 64 + fr, col0 = u.pn * 256 + wc * 32 + 8 * fq;
#pragma unroll
        for (int ai = 0; ai < 2; ++ai)
#pragma unroll
            for (int m = 0; m < 4; ++m) { const size_t off = (size_t)(row0 + ai * 128 + m * 16) * 2048 + col0;
#pragma unroll
                for (int bj = 0; bj < 2; ++bj) { f32x4 g0, g1; unpack8(*(const u32x4*)(gate + off + bj * 128), g0, g1);
                    f32x4 r0 = g0 * acc[ai][bj][m][0], r1 = g1 * acc[ai][bj][m][1];
                    if (ADD) { f32x4 o0, o1; unpack8(*(const u32x4*)(O + off + bj * 128), o0, o1); r0 += o0; r1 += o1; }
                    *(u32x4*)(O + off + bj * 128) = pack8(r0, r1); } }
    }
};
struct EpiMerge {
    static constexpr bool PERM = true, MID = true;
    unsigned char* O; const bf16_t* ga; const bf16_t* gp;
    __device__ __forceinline__ void mid(AccT& acc, const Unit& u, int wr, int wc, int fr, int fq) const {
        const auto ra = __builtin_amdgcn_make_buffer_rsrc((void*)ga, 0, 0x7FFFFFFF, 0x00020000), rp = __builtin_amdgcn_make_buffer_rsrc((void*)gp, 0, 0x7FFFFFFF, 0x00020000);
        const int voff = ((wr * 64 + fr) * 2048 + wc * 32 + 8 * fq) * 2;
        const int sbase = (u.pm * 256 * 2048 + u.pn * 256) * 2;
#pragma unroll
        for (int ai = 0; ai < 2; ++ai)
#pragma unroll
            for (int m = 0; m < 4; ++m)
#pragma unroll
                for (int bj = 0; bj < 2; ++bj) { const int so = sbase + ((ai * 128 + m * 16) * 2048 + bj * 128) * 2;
                    const u32x4 wa = __builtin_bit_cast(u32x4, __builtin_amdgcn_raw_buffer_load_b128(ra, voff, so, 0)), wp = __builtin_bit_cast(u32x4, __builtin_amdgcn_raw_buffer_load_b128(rp, voff, so, 0));
                    f32x4 a0, a1, p0, p1; unpack8(wa, a0, a1); unpack8(wp, p0, p1);
#pragma unroll
                    for (int j = 0; j < 4; ++j) { acc[ai][bj][m][0][j] *= a0[j] * __builtin_amdgcn_rcpf(p0[j]); acc[ai][bj][m][1][j] *= a1[j] * __builtin_amdgcn_rcpf(p1[j]); }
                    asm volatile("" : "+v"(acc[ai][bj][m][0]), "+v"(acc[ai][bj][m][1]) :: "memory"); }
    }
    __device__ __forceinline__ void operator()(const AccT& acc, const Unit& u, int wr, int wc, int fr, int fq) const {
        const int row0 = u.pm * 256 + wr * 64 + fr, col0 = u.pn * 256 + wc * 32 + 8 * fq;
#pragma unroll
        for (int ai = 0; ai < 2; ++ai)
#pragma unroll
            for (int m = 0; m < 4; ++m) { const size_t off = (size_t)(row0 + ai * 128 + m * 16) * 2048 + col0;
#pragma unroll
                for (int bj = 0; bj < 2; ++bj) { f32x4 p0, p1; unpack8(*(const u32x4*)(gp + off + bj * 128), p0, p1);
                    *(u32x2*)(O + off + bj * 128) = pack8_fp8(p0 * acc[ai][bj][m][0], p1 * acc[ai][bj][m][1]); } }
    }
};
struct EpiResid {
    static constexpr bool PERM = false, MID = false;
    const float* x; float* out; const float* gt;
    __device__ __forceinline__ void operator()(const AccT& acc, const Unit& u, int wr, int wc, int fr, int fq) const {
        const int row0 = u.pm * 256 + wr * 64 + fr, col0 = u.pn * 256 + wc * 32 + 4 * fq;
        const float* gtb = gt + (size_t)(u.pm / 16) * 12288;
        f32x4 g[2][2];
#pragma unroll
        for (int bj = 0; bj < 2; ++bj)
#pragma unroll
            for (int n = 0; n < 2; ++n) g[bj][n] = *(const f32x4*)(gtb + col0 + bj * 128 + n * 16);
#pragma unroll
        for (int ai = 0; ai < 2; ++ai)
#pragma unroll
            for (int m = 0; m < 4; ++m) { const size_t off = (size_t)(row0 + ai * 128 + m * 16) * 2048 + col0;
#pragma unroll
                for (int bj = 0; bj < 2; ++bj)
#pragma unroll
                    for (int n = 0; n < 2; ++n) { const f32x4 xv = *(const f32x4*)(x + off + bj * 128 + n * 16);
                        *(f32x4*)(out + off + bj * 128 + n * 16) = xv + g[bj][n] * acc[ai][bj][m][n]; } }
    }
};
struct EpiF32 {
    static constexpr bool PERM = false, MID = false;
    float* C; int ldc;
    __device__ __forceinline__ void operator()(const AccT& acc, const Unit& u, int wr, int wc, int fr, int fq) const {
        const int row0 = u.pm * 256 + wr * 64 + fr, col0 = u.pn * 256 + wc * 32 + 4 * fq;
#pragma unroll
        for (int ai = 0; ai < 2; ++ai)
#pragma unroll
            for (int m = 0; m < 4; ++m) { float* rowp = C + (size_t)(row0 + ai * 128 + m * 16) * ldc + col0;
#pragma unroll
                for (int bj = 0; bj < 2; ++bj)
#pragma unroll
                    for (int n = 0; n < 2; ++n) *(f32x4*)(rowp + bj * 128 + n * 16) = acc[ai][bj][m][n]; }
    }
};

struct Args { const float* in[19]; float* out; unsigned char* ws; int ph_lo, ph_hi; int li, pad; };
struct Frame {
    unsigned char* lds; unsigned char* ws;
    int tid, lane, wave, G, bid;
    const float *x, *c, *w_ada, *b_ada, *g1, *g2, *w_in, *g_q, *g_k, *rel_bias, *pool_w, *pool_scale, *w_ab, *w_pb, *w_out, *w_pq, *peer_keys, *peer_u, *peer_v;
    float* out;
};

template <bool F8OUT = false, class Fn> __device__ __forceinline__ void transpose_item(const float* W, int K, int N, void* WTv, int ldk, int drow0, int k0, float* scr, int lane, Fn srccol, float mul = 1.0f) {
    const int sc = srccol(drow0 + (lane & 31));
#pragma unroll 8
    for (int i = 0; i < 32; ++i) { const int kk = 2 * i + (lane >> 5); scr[kk * 33 + (lane & 31)] = sc >= 0 ? W[(size_t)(k0 + kk) * N + sc] * mul : 0.f; }
    asm volatile("s_waitcnt lgkmcnt(0)" ::: "memory");
    const int c = lane & 7;
#pragma unroll
    for (int j = 0; j < 4; ++j) { const int n = (lane >> 3) + 8 * j; const float* s = scr + (8 * c) * 33 + n;
        if constexpr (F8OUT) { *(u32x2*)((unsigned char*)WTv + (size_t)(drow0 + n) * ldk + k0 + 8 * c) = pack8_fp8((f32x4){s[0 * 33], s[1 * 33], s[2 * 33], s[3 * 33]}, (f32x4){s[4 * 33], s[5 * 33], s[6 * 33], s[7 * 33]}); }
        else { u32x4 o; o.x = cvt_pk_bf16(s[0 * 33], s[1 * 33]); o.y = cvt_pk_bf16(s[2 * 33], s[3 * 33]); o.z = cvt_pk_bf16(s[4 * 33], s[5 * 33]); o.w = cvt_pk_bf16(s[6 * 33], s[7 * 33]);
            *(u32x4*)((bf16_t*)WTv + (size_t)(drow0 + n) * ldk + k0 + 8 * c) = o; } }
    asm volatile("s_waitcnt lgkmcnt(0)" ::: "memory");
}
__device__ __forceinline__ void phase0_prep(Frame& F) {
    F.lane = lane_now(); F.tid = F.wave * 64 + F.lane;
    const int gw = F.bid * 8 + F.wave, NGW = F.G * 8;
    float* scr = (float*)(F.lds + F.wave * 16384);
    constexpr int I_IN16 = (2304 / 32) * (DM / 64), I_IN8 = (5632 / 32) * (DM / 64);
    constexpr int I_AB = (2048 / 32) * (1024 / 64), I_OUT = (2048 / 32) * (2048 / 64), I_PW = 4 * 8 * 4;
    constexpr int NIT = I_IN16 + I_IN8 + 2 * I_AB + 2 * I_OUT + I_PW;
    auto ident = [](int j) { return j; };
    for (int it = gw; it < NIT; it += NGW) {
        int r = it;
        if (r < I_IN16) { const int nb = r % 72, kb = r / 72;
            transpose_item(F.w_in, DM, INW, F.ws + WS_WIN16, DM, nb * 32, kb * 64, scr, F.lane, [](int j) { return j < 1104 ? j + 1536 : (j < 1280 ? -1 : j + 1360); }); continue; }
        r -= I_IN16;
        if (r < I_IN8) { const int nb = r % 176, kb = r / 176;
            transpose_item<true>(F.w_in, DM, INW, F.ws + WS_WIN8, DM, nb * 32, kb * 64, scr, F.lane, [](int j) { return j < 1536 ? j : j + 2128; }, 16.0f); continue; }
        r -= I_IN8;
        if (r < I_AB) { transpose_item<true>(F.w_ab, 1024, 2048, F.ws + WS_WAB, 1024, (r % 64) * 32, (r / 64) * 64, scr, F.lane, ident, 16.0f); continue; }
        r -= I_AB;
        if (r < I_AB) { transpose_item<true>(F.w_pb, 1024, 2048, F.ws + WS_WPB, 1024, (r % 64) * 32, (r / 64) * 64, scr, F.lane, ident, 16.0f); continue; }
        r -= I_AB;
        if (r < I_OUT) { transpose_item<true>(F.w_out, 2048, 2048, F.ws + WS_WOUT, 2048, (r % 64) * 32, (r / 64) * 64, scr, F.lane, ident, 16.0f); continue; }
        r -= I_OUT;
        if (r < I_OUT) { transpose_item(F.w_pq, 2048, 2048, (bf16_t*)(F.ws + WS_WPQ), 2048, (r % 64) * 32, (r / 64) * 64, scr, F.lane, ident); continue; }
        r -= I_OUT;
        { const int g = r / 32, q = r % 32, nb = q % 8, kb = q / 8;
          transpose_item(F.pool_w + (size_t)g * 65536, 256, 256, (bf16_t*)(F.ws + WS_POOLW) + (size_t)g * 65536, 256, nb * 32, kb * 64, scr, F.lane, ident); }
    }
    {
        bf16_t* kb = (bf16_t*)(F.ws + WS_KEYSBD);
        for (int i = F.bid * 512 + F.tid; i < 2048 * 32; i += F.G * 512) {
            const int row = i / 32, k8 = (i % 32) * 8, p = (row >> 7) & 1;
            u32x4 o = (u32x4){0u, 0u, 0u, 0u};
            if ((k8 >> 7) == p) { const float* s = F.peer_keys + (size_t)row * 128 + (k8 & 127); const f32x4 a = *(const f32x4*)s, b = *(const f32x4*)(s + 4); o = pack8(a, b); }
            *(u32x4*)(kb + (size_t)row * 256 + k8) = o;
        }
    }
    {
        unsigned char* pu = F.ws + WS_PU;
        for (size_t i = (size_t)F.bid * 512 + F.tid; i < (size_t)NEXP * 64; i += (size_t)F.G * 512) {
            const float* src = F.peer_u + i * 32;
            u32x16 pk;
#pragma unroll
            for (int k = 0; k < 8; ++k) { const f32x4 a = *(const f32x4*)(src + k * 4) * 96.0f; pk[2 * k] = cvt_pk_bf16(a[0], a[1]); pk[2 * k + 1] = cvt_pk_bf16(a[2], a[3]); }
            const u32x6 p6 = __builtin_amdgcn_cvt_scalef32_pk32_fp6_bf16(__builtin_bit_cast(bf16x32, pk), 1.0f);
            const int ci = (int)(i & 63), lp = (ci >> 2) + 16 * (ci & 3);
            unsigned char* dst = pu + (i >> 6) * 1536;
            *(u32x4*)(dst + lp * 16) = (u32x4){p6[0], p6[1], p6[2], p6[3]}; *(u32x2*)(dst + 1024 + lp * 8) = (u32x2){p6[4], p6[5]};
        }
        unsigned char* pv = F.ws + WS_PV;
        for (int it = gw; it < (NEXP / 64) * 128; it += NGW) {
            const int e = (it >> 7) * 64 + F.lane, ch = it & 127;
            u32x4 ov;
#pragma unroll
            for (int k = 0; k < 4; ++k) { const f32x4 c = *(const f32x4*)(F.peer_v + (size_t)e * DM + ch * 16 + k * 4) * 4.0f;
                int wv = __builtin_amdgcn_cvt_pk_fp8_f32(c[0], c[1], 0, false); wv = __builtin_amdgcn_cvt_pk_fp8_f32(c[2], c[3], wv, true); ov[k] = (unsigned)wv; }
            *(u32x2*)(pv + ((size_t)(2 * ch) * NEXP + e) * 8) = (u32x2){ov[0], ov[1]};
            *(u32x2*)(pv + ((size_t)(2 * ch + 1) * NEXP + e) * 8) = (u32x2){ov[2], ov[3]};
        }
    }
    {
        __syncthreads();
        float* cact = (float*)(F.lds + 131072);
        float* red = (float*)F.lds;
        float* mp = (float*)(F.ws + WS_MODP);
        for (int it = F.bid; it < 48 * 4; it += F.G) {
            const int cb = it % 48, ds = it / 48, d0 = ds * 512;
            for (int i = F.tid; i < 8 * 512; i += 512) { const int b = i >> 9, d = i & 511; const float cv = F.c[b * DM + d0 + d]; cact[i] = cv * sigmoidf_(cv); }
            __syncthreads();
            f32x4 a[8];
#pragma unroll
            for (int b = 0; b < 8; ++b) a[b] = (f32x4){0.f, 0.f, 0.f, 0.f};
            const float* wp = F.w_ada + (size_t)(d0 + F.wave * 64) * 12288 + cb * 256 + F.lane * 4;
#pragma unroll 4
            for (int d = 0; d < 64; ++d) { const f32x4 w = *(const f32x4*)(wp + (size_t)d * 12288);
#pragma unroll
                for (int b = 0; b < 8; ++b) a[b] += w * cact[b * 512 + F.wave * 64 + d]; }
#pragma unroll
            for (int b = 0; b < 8; ++b)
#pragma unroll
                for (int j = 0; j < 4; ++j) red[(F.wave * 32 + b * 4 + j) * 64 + F.lane] = a[b][j];
            __syncthreads();
            for (int i = F.tid; i < 2048; i += 512) { const int v = i >> 6, l = i & 63; float s = 0.f;
#pragma unroll
                for (int w = 0; w < 8; ++w) s += red[(w * 32 + v) * 64 + l];
                mp[((size_t)ds * 8 + (v >> 2)) * 12288 + cb * 256 + l * 4 + (v & 3)] = s; }
            __syncthreads();
        }
    }
}

template <bool FIRST> __device__ __forceinline__ void phase_modnorm(Frame& F, const float* xin, const float* gain, int off_sh, int off_sc, bf16_t* dst, unsigned char* dst8 = nullptr) {
    F.lane = lane_now(); F.tid = F.wave * 64 + F.lane;
    const float* mp = (const float*)(F.ws + WS_MODP); float* mf = (float*)(F.ws + WS_MODF);
    if (FIRST) {
        for (int i = F.bid * 512 + F.tid; i < 8 * 12288; i += F.G * 512) {
            float s = F.b_ada[i % 12288];
#pragma unroll
            for (int k = 0; k < 4; ++k) s += mp[(size_t)k * 8 * 12288 + i];
            mf[i] = s; }
    }
    float* cA = (float*)F.lds; float* cB = cA + 2048;
    for (int ch = F.bid; ch < MTOK / 128; ch += F.G) {
        const int b = ch / 32;
        __syncthreads();
        for (int col = F.tid; col < 2048; col += 512) {
            float sc, sh;
            if (FIRST) { sc = F.b_ada[off_sc + col]; sh = F.b_ada[off_sh + col];
#pragma unroll
                for (int k = 0; k < 4; ++k) { sc += mp[((size_t)k * 8 + b) * 12288 + off_sc + col]; sh += mp[((size_t)k * 8 + b) * 12288 + off_sh + col]; } }
            else { sc = mf[b * 12288 + off_sc + col]; sh = mf[b * 12288 + off_sh + col]; }
            cA[col] = gain[col] * (1.f + sc); cB[col] = sh; }
        __syncthreads();
        for (int r = F.wave; r < 128; r += 8) {
            const size_t row = (size_t)ch * 128 + r;
            const float* xr = xin + row * 2048 + F.lane * 8;
            f32x4 v[4][2]; float ss = 0.f;
#pragma unroll
            for (int i = 0; i < 4; ++i) { v[i][0] = *(const f32x4*)(xr + i * 512); v[i][1] = *(const f32x4*)(xr + i * 512 + 4);
#pragma unroll
                for (int j = 0; j < 4; ++j) ss += v[i][0][j] * v[i][0][j] + v[i][1][j] * v[i][1][j]; }
            ss = wave_sum(ss);
            const float rinv = 1.0f / sqrtf(ss * (1.0f / 2048.0f) + EPS);
#pragma unroll
            for (int i = 0; i < 4; ++i) { const int col = i * 512 + F.lane * 8;
                const f32x4 a0 = *(const f32x4*)(cA + col), a1 = *(const f32x4*)(cA + col + 4), b0 = *(const f32x4*)(cB + col), b1 = *(const f32x4*)(cB + col + 4);
                const f32x4 y0 = v[i][0] * rinv * a0 + b0, y1 = v[i][1] * rinv * a1 + b1;
                *(u32x4*)(dst + row * 2048 + col) = pack8(y0, y1);
                if (FIRST) *(u32x2*)(dst8 + row * 2048 + col) = pack8_fp8(y0, y1); }
        }
    }
}

__device__ __forceinline__ void phase3_qknorm(Frame& F) {
    F.lane = lane_now(); F.tid = F.wave * 64 + F.lane;
    const bf16_t* q = (const bf16_t*)(F.ws + WS_QN); const bf16_t* k = (const bf16_t*)(F.ws + WS_KN); const bf16_t* v = (const bf16_t*)(F.ws + WS_V);
    unsigned char* q8 = F.ws + WS_Q8; unsigned char* k8 = F.ws + WS_K8; unsigned char* v8 = F.ws + WS_V8;
    const int gw = F.bid * 8 + F.wave, NGW = F.G * 8;
    for (int row = gw; row < MTOK; row += NGW) {
#pragma unroll
        for (int i = 0; i < 2; ++i) { const int ci = i * 64 + F.lane;
            f32x4 a, b; unpack8(*(const u32x4*)(q + (size_t)row * 1024 + ci * 8), a, b);
            float ss = a[0] * a[0] + a[1] * a[1] + a[2] * a[2] + a[3] * a[3] + b[0] * b[0] + b[1] * b[1] + b[2] * b[2] + b[3] * b[3];
            ss = row_sum16(ss);
            const float rinv = 1.0f / sqrtf(ss * (1.0f / 128.0f) + EPS);
            const float* gp = F.g_q + (ci & 15) * 8; const f32x4 g0 = *(const f32x4*)gp, g1 = *(const f32x4*)(gp + 4);
            *(u32x2*)(q8 + (size_t)row * 1024 + ci * 8) = pack8_fp8(a * rinv * g0, b * rinv * g1); }
        { const int ci = F.lane & 31; const bool isk = F.lane < 32;
            f32x4 a, b; unpack8(*(const u32x4*)((isk ? k : v) + (size_t)row * 256 + ci * 8), a, b);
            float ss = a[0] * a[0] + a[1] * a[1] + a[2] * a[2] + a[3] * a[3] + b[0] * b[0] + b[1] * b[1] + b[2] * b[2] + b[3] * b[3];
            ss = row_sum16(ss);
            const float rinv = isk ? 1.0f / sqrtf(ss * (1.0f / 128.0f) + EPS) : 1.0f;
            const float* gp = F.g_k + (ci & 15) * 8; f32x4 g0 = *(const f32x4*)gp, g1 = *(const f32x4*)(gp + 4);
            if (!isk) { g0 = (f32x4){1.f, 1.f, 1.f, 1.f}; g1 = g0; }
            *(u32x2*)((isk ? k8 : v8) + (size_t)row * 256 + ci * 8) = pack8_fp8(a * rinv * g0, b * rinv * g1); }
    }
}
template <int W> __device__ __forceinline__ void pooled_item(const bf16_t* pl, bf16_t* po, int row, int c8) {
    const int t = row & (SEQ - 1);
    f32x4 s0 = (f32x4){0.f, 0.f, 0.f, 0.f}, s1 = s0, x0 = s0, x1 = s0;
    u32x4 v[W];
#pragma unroll
    for (int j = 0; j < W; ++j) v[j] = *(const u32x4*)(pl + (size_t)(row - (j <= t ? j : 0)) * 1024 + c8);
#pragma unroll
    for (int j = 0; j < W; ++j) { f32x4 a, b; unpack8(v[j], a, b); if (j == 0) { x0 = a; x1 = b; } if (j <= t) { s0 += a; s1 += b; } }
    const float inv = 1.0f / (float)((t + 1 < W) ? t + 1 : W);
    *(u32x4*)(po + (size_t)row * 1024 + c8) = pack8(s0 * inv - x0, s1 * inv - x1);
}
__device__ __forceinline__ void phase3_pooled(Frame& F) {
    F.lane = lane_now(); F.tid = F.wave * 64 + F.lane;
    const bf16_t* pl = (const bf16_t*)(F.ws + WS_PL); bf16_t* po = (bf16_t*)(F.ws + WS_POOLED);
    const int gw = F.bid * 8 + F.wave, NGW = F.G * 8;
    for (int it = gw; it < (MTOK / 2) * 4; it += NGW) {
        const int g = it & 3, row = (it >> 2) * 2 + (F.lane >> 5), c8 = g * 256 + (F.lane & 31) * 8;
        if (g == 0) pooled_item<2>(pl, po, row, c8); else if (g == 1) pooled_item<4>(pl, po, row, c8); else if (g == 2) pooled_item<8>(pl, po, row, c8); else pooled_item<16>(pl, po, row, c8);
    }
}
typedef float f32x16 __attribute__((ext_vector_type(16)));
__device__ __forceinline__ float wrelu_(float wh, float d, float acc) { return __builtin_fmaf(wh, d, __builtin_fmaf(wh, __builtin_fabsf(d), acc)); }
__device__ __forceinline__ int sel_code(float s, float smin, float scale) { const float c = (s - smin) * scale; return (int)fminf(fmaxf(c, 0.f), 65535.f); }
__device__ __forceinline__ void hist_find(const unsigned* hist, int lane, int K, int& bsel, int& above) {
    const u32x4 h = *(const u32x4*)(hist + lane * 4);
    const int S = (int)(h.x + h.y + h.z + h.w);
    int x = S;
    x += __builtin_amdgcn_update_dpp(0, x, 0x101, 0xF, 0xF, true);
    x += __builtin_amdgcn_update_dpp(0, x, 0x102, 0xF, 0xF, true);
    x += __builtin_amdgcn_update_dpp(0, x, 0x104, 0xF, 0xF, true);
    x += __builtin_amdgcn_update_dpp(0, x, 0x108, 0xF, 0xF, true);
    const int t1 = __builtin_amdgcn_readlane(x, 16), t2 = __builtin_amdgcn_readlane(x, 32), t3 = __builtin_amdgcn_readlane(x, 48);
    const int r = lane >> 4;
    x += (r == 0 ? t1 + t2 + t3 : (r == 1 ? t2 + t3 : (r == 2 ? t3 : 0)));
    const int sufn = x - S;
    const bool mine = (x >= K) && (sufn < K);
    int b = 0, ab = 0;
    { int c = sufn;
      if (c + (int)h.w >= K) { b = 3; ab = c; } else { c += (int)h.w;
      if (c + (int)h.z >= K) { b = 2; ab = c; } else { c += (int)h.z;
      if (c + (int)h.y >= K) { b = 1; ab = c; } else { c += (int)h.y; b = 0; ab = c; } } } }
    const unsigned long long m = __ballot(mine);
    const int src = m ? (int)__builtin_ctzll(m) : 0;
    bsel = __builtin_amdgcn_readlane(lane * 4 + b, src); above = __builtin_amdgcn_readlane(ab, src);
}
__device__ __forceinline__ int mask_prefix(unsigned long long m) { return (int)__builtin_amdgcn_mbcnt_hi((unsigned)(m >> 32), __builtin_amdgcn_mbcnt_lo((unsigned)m, 0u)); }
template <class Fn> __device__ __forceinline__ void sel_sweep(const f32x4* rb4, int n4, int lane, int t, Fn fn) {
    f32x4 cur = rb4[lane];
    for (int c4 = 0; c4 < n4 - 1; ++c4) { const f32x4 nxt = rb4[(c4 + 1) * 64 + lane];
#pragma unroll
        for (int k = 0; k < 4; ++k) fn(cur[k], (c4 * 4 + k) * 64 + lane, true);
        cur = nxt; }
    { const int c4 = n4 - 1;
#pragma unroll
      for (int k = 0; k < 4; ++k) { const int idx = (c4 * 4 + k) * 64 + lane; fn(cur[k], idx, idx <= t); } }
}
template <int MODE = 0> __device__ __forceinline__ void indexer_select(Frame& F, int b, int t, const float* rowbuf, unsigned* hist, float* eqv, int* eqi) {
    unsigned short* selrow = (unsigned short*)(F.ws + (MODE ? WS_R0 : WS_SEL)) + (size_t)(b * SEQ + t) * 256;
    int lane = F.lane; asm volatile("" : "+v"(lane));
    const int nch = t / 64 + 1, n4 = (nch + 3) >> 2;
    const f32x4* rb4 = (const f32x4*)rowbuf;
    float mn = __builtin_huge_valf(), mx = -__builtin_huge_valf();
    sel_sweep(rb4, n4, lane, t, [&](float v, int, bool valid) { mn = valid ? fminf(mn, v) : mn; mx = valid ? fmaxf(mx, v) : mx; });
    mx = xor16_max(row_max16(mx)); { const auto r = __builtin_amdgcn_permlane32_swap(__float_as_uint(mx), __float_as_uint(mx), false, false); mx = fmaxf(__uint_as_float(r[0]), __uint_as_float(r[1])); }
    mn = -mn; mn = xor16_max(row_max16(mn)); { const auto r = __builtin_amdgcn_permlane32_swap(__float_as_uint(mn), __float_as_uint(mn), false, false); mn = -fmaxf(__uint_as_float(r[0]), __uint_as_float(r[1])); }
    const float scale = (mx > mn) ? 65535.0f / (mx - mn) : 0.f;
    *(u32x4*)(hist + lane * 4) = (u32x4){0u, 0u, 0u, 0u};
    sel_sweep(rb4, n4, lane, t, [&](float v, int, bool valid) { if (valid) { if (MODE == 2) ((volatile unsigned*)hist)[sel_code(v, mn, scale) >> 8] = 1u; else atomicAdd(&hist[sel_code(v, mn, scale) >> 8], 1u); } });
    int b1, above1; hist_find(hist, lane, KSEL, b1, above1);
    *(u32x4*)(hist + lane * 4) = (u32x4){0u, 0u, 0u, 0u};
    sel_sweep(rb4, n4, lane, t, [&](float v, int, bool valid) { const int code = sel_code(v, mn, scale); if (valid && (code >> 8) == b1) atomicAdd(&hist[code & 255], 1u); });
    int b2, above2; hist_find(hist, lane, KSEL - above1, b2, above2);
    const int T16 = (b1 << 8) | b2, need = KSEL - above1 - above2, ceq = (int)hist[b2];
    const bool all_eq = (ceq == need), collect = !all_eq && (ceq <= 64);
    const int eq_budget = all_eq ? 0x7fffffff : (collect ? 0 : need);
    int pos = 0, eqseen = 0;
    sel_sweep(rb4, n4, lane, t, [&](float v, int idx, bool valid) {
        const int code = sel_code(v, mn, scale);
        const bool gt = valid && code > T16, eq = valid && code == T16;
        const unsigned long long mg = __ballot(gt);
        const unsigned p = (unsigned)(pos + mask_prefix(mg));
        if (gt && p < (unsigned)KSEL) selrow[p] = (unsigned short)idx;
        pos += __popcll(mg);
        const unsigned long long me = __ballot(eq);
        if (me) {
            const int er = eqseen + mask_prefix(me); const bool te = eq && er < eq_budget;
            if (collect && eq) { eqv[er] = v; eqi[er] = idx; }
            eqseen += __popcll(me);
            const unsigned long long mte = __ballot(te);
            const unsigned pe = (unsigned)(pos + mask_prefix(mte));
            if (te && pe < (unsigned)KSEL) selrow[pe] = (unsigned short)idx;
            pos += __popcll(mte);
        }
    });
    if (collect && lane < ceq) {
        const float sv = eqv[lane]; const int idx = eqi[lane]; int rank = 0;
        for (int m = 0; m < ceq; ++m) { const float ov = eqv[m]; const int oi = eqi[m]; rank += (ov > sv || (ov == sv && oi < idx)) ? 1 : 0; }
        if (rank < need) selrow[KSEL - need + rank] = (unsigned short)idx;
    }
}
__device__ __forceinline__ void indexer_tile(Frame& F, int b, int t0) {
    const bf16_t* iq = (const bf16_t*)(F.ws + WS_IQ); const bf16_t* ik = (const bf16_t*)(F.ws + WS_IK); const float* iw = (const float*)(F.ws + WS_IW);
    int lane = F.lane; asm volatile("" : "+v"(lane));
    const int w = F.wave;
    if (t0 < KSEL) {
        const int t = t0 + w; unsigned short* selrow = (unsigned short*)(F.ws + WS_SEL) + (size_t)(b * SEQ + t) * 256;
#pragma unroll
        for (int p = 0; p < 4; ++p) { const int j = p * 64 + lane; selrow[j] = (unsigned short)(j <= t ? j : 0xFFFF); }
        return;
    }
    float* rowbuf = (float*)F.lds;
    unsigned char* stage = F.lds + 131072;
    const int p = w & 3, kh = w >> 2, hi = lane >> 5, r = lane & 31;
    const size_t qrow = (size_t)b * SEQ + t0 + 2 * p + (r >> 4);
    bf16x8 a[4];
#pragma unroll
    for (int ks = 0; ks < 4; ++ks) a[ks] = *(const bf16x8*)(iq + qrow * 1024 + (r & 15) * 64 + ks * 16 + 8 * hi);
    float wq[2][8];
#pragma unroll
    for (int q = 0; q < 2; ++q)
#pragma unroll
        for (int i = 0; i < 8; ++i) wq[q][i] = 0.5f * iw[((size_t)b * SEQ + t0 + 2 * p + q) * 16 + (i & 3) + 8 * ((i >> 2) & 1) + 4 * hi];
    const int nchunks = (t0 + 7) / 64 + 1, nsteps = (nchunks + 1) >> 1;
    const unsigned char* gsrc = (const unsigned char*)(ik + (size_t)b * SEQ * 64) + F.tid * 16;
    const int skey = F.tid >> 3, sc16 = F.tid & 7, soff = skey * 128 + ((sc16 ^ ((skey >> 1) & 7)) << 4);
    u32x4 sa0 = *(const u32x4*)gsrc, sb0 = sa0, sa1 = sa0, sb1 = sa0;
    sb0 = *(const u32x4*)(gsrc + (size_t)min(1, nchunks - 1) * 8192);
    sa1 = *(const u32x4*)(gsrc + (size_t)min(2, nchunks - 1) * 8192);
    sb1 = *(const u32x4*)(gsrc + (size_t)min(3, nchunks - 1) * 8192);
    __syncthreads();
#if PROBE_IDX != 1 && PROBE_IDX != 5
#define IDX_LD(c) (*(const u32x4*)(gsrc + (size_t)(c) * 8192))
#endif
#define IDX_MMA(SA, SB, ss, D0, D1) do { const int s_ = (ss); unsigned char* sb = stage + (s_ & 1) * 16384; \
        *(u32x4*)(sb + soff) = SA; *(u32x4*)(sb + 8192 + soff) = SB; \
        __syncthreads(); \
        SA = IDX_LD(min(2 * s_ + 4, nchunks - 1)); \
        SB = IDX_LD(min(2 * s_ + 5, nchunks - 1)); \
        _Pragma("unroll") for (int i = 0; i < 16; ++i) { D0[i] = 0.f; D1[i] = 0.f; } \
        _Pragma("unroll") for (int ks = 0; ks < 4; ++ks) { const unsigned char* bp = sb + key * 128 + (((ks * 2 + hi) ^ ((key >> 1) & 7)) << 4); \
            const bf16x8 bf0 = *(const bf16x8*)bp, bf1 = *(const bf16x8*)(bp + 8192); \
            D0 = __builtin_amdgcn_mfma_f32_32x32x16_bf16(a[ks], bf0, D0, 0, 0, 0); D1 = __builtin_amdgcn_mfma_f32_32x32x16_bf16(a[ks], bf1, D1, 0, 0, 0); } } while (0)
#define IDX_RED(ss, D0, D1) do { const int s_ = (ss); float x0_ = 0.f, x1_ = 0.f, y0_ = 0.f, y1_ = 0.f; \
        _Pragma("unroll") for (int i = 0; i < 8; ++i) { x0_ = wrelu_(wq[0][i], D0[i], x0_); x1_ = wrelu_(wq[1][i], D0[8 + i], x1_); y0_ = wrelu_(wq[0][i], D1[i], y0_); y1_ = wrelu_(wq[1][i], D1[8 + i], y1_); } \
        const float scx = swap32_pair(x0_, x1_), scy = swap32_pair(y0_, y1_); \
        *(f32x2*)(rowbuf + (2 * p + hi) * 4096 + ((s_ >> 1) * 64 + key) * 4 + 2 * (s_ & 1)) = (f32x2){scx, scy}; } while (0)
    const int key = kh * 32 + r;
    f32x16 dA0, dA1, dB0, dB1;
#if PROBE_IDX == 1
#define IDX_LD(c) (*(const u32x4*)(gsrc + (size_t)(c) * 8192))
#elif PROBE_IDX == 5
#define IDX_LD(c) SAVED
#endif
#if PROBE_IDX == 1 || PROBE_IDX == 5
    { const u32x4 SAVED = sa0;
    IDX_MMA(sa0, sb0, 0, dA0, dA1);
    for (int s2 = 0; s2 < nsteps; s2 += 2) {
        if (s2 + 1 < nsteps) IDX_MMA(sa1, sb1, s2 + 1, dB0, dB1);
        IDX_RED(s2, dA0, dA1);
        if (s2 + 2 < nsteps) IDX_MMA(sa0, sb0, s2 + 2, dA0, dA1);
        if (s2 + 1 < nsteps) IDX_RED(s2 + 1, dB0, dB1);
    }
    __syncthreads();
    sa0 = *(const u32x4*)gsrc;
    sb0 = *(const u32x4*)(gsrc + (size_t)min(1, nchunks - 1) * 8192);
    sa1 = *(const u32x4*)(gsrc + (size_t)min(2, nchunks - 1) * 8192);
    sb1 = *(const u32x4*)(gsrc + (size_t)min(3, nchunks - 1) * 8192); }
#undef IDX_LD
#define IDX_LD(c) (*(const u32x4*)(gsrc + (size_t)(c) * 8192))
#endif
    IDX_MMA(sa0, sb0, 0, dA0, dA1);
    for (int s2 = 0; s2 < nsteps; s2 += 2) {
        if (s2 + 1 < nsteps) IDX_MMA(sa1, sb1, s2 + 1, dB0, dB1);
        IDX_RED(s2, dA0, dA1);
        if (s2 + 2 < nsteps) IDX_MMA(sa0, sb0, s2 + 2, dA0, dA1);
        if (s2 + 1 < nsteps) IDX_RED(s2 + 1, dB0, dB1);
    }
#undef IDX_MMA
#undef IDX_RED
#undef IDX_LD
    __syncthreads();
    indexer_select(F, b, t0 + w, rowbuf + w * 4096, (unsigned*)(F.lds + 147456) + w * 256, (float*)(F.lds + 155648) + w * 64, (int*)(F.lds + 155648 + 2048) + w * 64);
#if PROBE_IDX >= 2
    indexer_select<PROBE_IDX - 1>(F, b, t0 + w, rowbuf + w * 4096, (unsigned*)(F.lds + 147456) + w * 256, (float*)(F.lds + 155648) + w * 64, (int*)(F.lds + 155648 + 2048) + w * 64);
#endif
}
__device__ __forceinline__ void phase3_indexer(Frame& F) {
    F.lane = lane_now(); F.tid = F.wave * 64 + F.lane;
    volatile LAS unsigned* misc = (volatile LAS unsigned*)((LAS unsigned char*)F.lds + MISC_OFF);
    const unsigned keep0 = misc[0], keep1 = misc[1];
    __syncthreads();
    const int nit = BATCH * (SEQ / 8);
    for (int k = 0;; ++k) {
        const int l = k * F.G + ((k & 1) ? (F.G - 1 - F.bid) : F.bid);
        if (l >= nit) { if (k * F.G >= nit) break; else continue; }
        const int qb = (SEQ / 8 - 1) - (l >> 3), b = l & 7;
        indexer_tile(F, b, qb * 8);
    }
    __syncthreads();
    if (F.tid == 0) { misc[0] = keep0; misc[1] = keep1; }
}

__device__ const unsigned char g_bucket[128] = {0, 1, 2, 3, 4, 5, 6, 7, 8, 9, 10, 11, 12, 13, 14, 15, 16, 16, 16, 17, 17, 18, 18, 18, 19, 19, 19, 20, 20, 20, 20, 21, 21, 21, 21, 22, 22, 22, 22, 22, 23, 23, 23, 23, 23, 23, 24, 24, 24, 24, 24, 24, 25, 25, 25, 25, 25, 25, 25, 26, 26, 26, 26, 26, 26, 26, 26, 27, 27, 27, 27, 27, 27, 27, 27, 27, 27, 28, 28, 28, 28, 28, 28, 28, 28, 28, 28, 29, 29, 29, 29, 29, 29, 29, 29, 29, 29, 29, 29, 30, 30, 30, 30, 30, 30, 30, 30, 30, 30, 30, 30, 30, 30, 31, 31, 31, 31, 31, 31, 31, 31, 31, 31, 31, 31, 31, 31, 31};
__device__ __forceinline__ void at_pv_step(f32x4 (&D0)[8], f32x4 (&D1)[8], const u32x4 (&buf)[8], LAS unsigned char* vwr, LAS unsigned char* ard, LAS unsigned char* brd) {
#pragma unroll
    for (int c = 0; c < 8; ++c) *(LAS u32x4*)(vwr + c * 576) = buf[c];
    const long pb = __builtin_bit_cast(long, __builtin_amdgcn_ds_read_tr8_b64_v2i32((LAS v2i*)brd));
#pragma unroll
    for (int tl = 0; tl < 8; ++tl) { const long va = __builtin_bit_cast(long, __builtin_amdgcn_ds_read_tr8_b64_v2i32((LAS v2i*)(ard + tl * 16))); D0[tl] = __builtin_amdgcn_mfma_f32_16x16x32_fp8_fp8(va, pb, D0[tl], 0, 0, 0); }
#pragma unroll
    for (int tl = 0; tl < 8; ++tl) { const long va = __builtin_bit_cast(long, __builtin_amdgcn_ds_read_tr8_b64_v2i32((LAS v2i*)(ard + 4608 + tl * 16))); D1[tl] = __builtin_amdgcn_mfma_f32_16x16x32_fp8_fp8(va, pb, D1[tl], 0, 0, 0); }
}
__device__ __forceinline__ void phase4_attention(Frame& F) {
    F.lane = lane_now(); F.tid = F.wave * 64 + F.lane;
    const unsigned char* q8 = F.ws + WS_Q8; const unsigned char* k8 = F.ws + WS_K8; const unsigned char* v8 = F.ws + WS_V8;
    const unsigned short* sel = (const unsigned short*)(F.ws + WS_SEL); unsigned char* ao = F.ws + WS_ATTN;
    float* btab = (float*)F.lds;
    __syncthreads();
    for (int i = F.tid; i < 256; i += 512) btab[i] = F.rel_bias[i];
    __syncthreads();
    float* Pl = (float*)(F.lds + 4096 + F.wave * 12544); int* idl = (int*)((unsigned char*)Pl + 9216); float* psl = (float*)((unsigned char*)Pl + 12288); float* pml = psl + 8;
    LAS unsigned char* wl = (LAS unsigned char*)F.lds + 4096 + F.wave * 12544;
    const bool xmap = (F.G % 8) == 0;
    const int gw = xmap ? (F.bid / 8) * 8 + F.wave : F.bid * 8 + F.wave, NGW = xmap ? F.G : F.G * 8, nrows = xmap ? SEQ : MTOK;
    for (int rr = gw; rr < nrows; rr += NGW) {
        int lane = F.lane; asm volatile("" : "+v"(lane));
        const int row = xmap ? (F.bid & 7) * SEQ + rr : rr;
        const int b = row / SEQ, t = row % SEQ, r = lane & 31, hi = lane >> 5;
#pragma unroll
        for (int p = 0; p < 4; ++p) { idl[p * 64 + lane] = (int)sel[(size_t)row * 256 + p * 64 + lane]; }
        long a0[8], a1[8];
        { u32x4 qa[4];
#pragma unroll
          for (int i = 0; i < 4; ++i) qa[i] = (r < 8) ? *(const u32x4*)(q8 + (size_t)row * 1024 + r * 128 + hi * 64 + i * 16) : (u32x4){0u, 0u, 0u, 0u};
#pragma unroll
          for (int ks = 0; ks < 8; ++ks) { const unsigned lo = qa[ks >> 1][(ks & 1) * 2], hh = qa[ks >> 1][(ks & 1) * 2 + 1]; const long v = (long)(((unsigned long long)hh << 32) | lo);
              a0[ks] = (r < 4) ? v : 0l; a1[ks] = (r >= 4) ? v : 0l; } }
        f32x4 psum = (f32x4){0.f, 0.f, 0.f, 0.f}, pmax = psum;
#define AT_LOADK(buf, kb) do { const int key_ = idl[(kb) * 32 + r]; const int kc_ = key_ <= t ? key_ : 0; const unsigned char* kr_ = k8 + ((size_t)b * SEQ + kc_) * 256 + hi * 64; \
            _Pragma("unroll") for (int i = 0; i < 4; ++i) { buf[i] = *(const u32x4*)(kr_ + i * 16); buf[4 + i] = *(const u32x4*)(kr_ + 128 + i * 16); } } while (0)
#define AT_QK(buf, kb) do { const int key_ = idl[(kb) * 32 + r]; const bool valid_ = key_ <= t; const int kc_ = valid_ ? key_ : 0; \
            f32x16 d; _Pragma("unroll") for (int i = 0; i < 16; ++i) d[i] = 0.f; \
            _Pragma("unroll") for (int ks = 0; ks < 8; ++ks) { const long bv_ = (long)(((unsigned long long)buf[ks >> 1][(ks & 1) * 2 + 1] << 32) | buf[ks >> 1][(ks & 1) * 2]); d = __builtin_amdgcn_mfma_f32_32x32x16_fp8_fp8(a0[ks], bv_, d, 0, 0, 0); } \
            _Pragma("unroll") for (int ks = 0; ks < 8; ++ks) { const long bv_ = (long)(((unsigned long long)buf[4 + (ks >> 1)][(ks & 1) * 2 + 1] << 32) | buf[4 + (ks >> 1)][(ks & 1) * 2]); d = __builtin_amdgcn_mfma_f32_32x32x16_fp8_fp8(a1[ks], bv_, d, 0, 0, 0); } \
            const int dist_ = t - kc_; const int bkt_ = dist_ < 128 ? (int)g_bucket[dist_] : 31; \
            const f32x4 bias_ = *(const f32x4*)(btab + bkt_ * 8 + 4 * hi); f32x4 e_; \
            _Pragma("unroll") for (int i = 0; i < 4; ++i) e_[i] = valid_ ? __expf(d[i] * 0.08838834764831845f + bias_[i]) : 0.f; \
            psum += e_; _Pragma("unroll") for (int i = 0; i < 4; ++i) pmax[i] = fmaxf(pmax[i], e_[i]); *(f32x4*)(Pl + ((kb) * 32 + r) * 8 + 4 * hi) = e_; } while (0)
        {
            u32x4 kA[8], kB[8];
            AT_LOADK(kA, 0);
#pragma unroll 1
            for (int kb = 0; kb < 8; kb += 2) {
                AT_LOADK(kB, kb + 1);
                AT_QK(kA, kb);
                if (kb + 2 < 8) AT_LOADK(kA, kb + 2);
                AT_QK(kB, kb + 1);
            }
        }
#undef AT_LOADK
#undef AT_QK
#pragma unroll
        for (int i = 0; i < 4; ++i) { psum[i] = xor16_sum(row_sum16(psum[i])); pmax[i] = xor16_max(row_max16(pmax[i])); }
        if (r == 0) { *(f32x4*)(psl + 4 * hi) = psum; *(f32x4*)(pml + 4 * hi) = pmax; }
        const int fk = lane & 31, fg = lane >> 5, kq = lane >> 4, tq = (lane >> 1) & 7, tp = lane & 1;
        const int vg4 = lane >> 4, vch = lane & 15;
#define AT_LOADV(buf, ks_) do { _Pragma("unroll") for (int c = 0; c < 8; ++c) { const int key_ = idl[(ks_) * 32 + 4 * c + vg4]; const int kc_ = key_ <= t ? key_ : 0; \
            buf[c] = *(const u32x4*)(v8 + ((size_t)b * SEQ + kc_) * 256 + vch * 16); } } while (0)
        u32x4 vA[8], vB[8];
        AT_LOADV(vA, 0);
        { const f32x4 m0 = *(const f32x4*)pml, m1 = *(const f32x4*)(pml + 4);
          f32x4 r0, r1;
#pragma unroll
          for (int i = 0; i < 4; ++i) { r0[i] = __builtin_amdgcn_rcpf(m0[i]); r1[i] = __builtin_amdgcn_rcpf(m1[i]); }
#pragma unroll
          for (int i = 0; i < 4; ++i) { const int key = i * 64 + lane;
              *(LAS u32x2*)(wl + 10240 + key * 8) = pack8_fp8(*(const f32x4*)(Pl + key * 8) * r0, *(const f32x4*)(Pl + key * 8 + 4) * r1); } }
        f32x4 D0[8], D1[8];
#pragma unroll
        for (int tl = 0; tl < 8; ++tl) { D0[tl] = (f32x4){0.f, 0.f, 0.f, 0.f}; D1[tl] = D0[tl]; }
        LAS unsigned char* vwr = wl + (vch >> 3) * 4608 + vg4 * 144 + (vch & 7) * 16;
        LAS unsigned char* ard = wl + (kq * 8 + tq) * 144 + 8 * tp;
        LAS unsigned char* brd = wl + 10240 + (kq * 8 + tq) * 8;
#pragma unroll 1
        for (int ks = 0; ks < 8; ks += 2) {
            AT_LOADV(vB, ks + 1);
            at_pv_step(D0, D1, vA, vwr, ard, brd + ks * 256);
            if (ks + 2 < 8) AT_LOADV(vA, ks + 2);
            at_pv_step(D0, D1, vB, vwr, ard, brd + (ks + 1) * 256);
        }
#undef AT_LOADV
        { const int n = lane & 15, q4 = lane >> 4;
          if (n < 8) { const float sc = pml[n] / psl[n]; const bool g1 = n >= 4;
              unsigned char* op = ao + (size_t)row * 1024 + n * 128 + q4 * 4;
#pragma unroll
              for (int tl = 0; tl < 8; ++tl) { const f32x4 d = (g1 ? D1[tl] : D0[tl]) * sc;
                  int w = __builtin_amdgcn_cvt_pk_fp8_f32(d[0], d[1], 0, false); w = __builtin_amdgcn_cvt_pk_fp8_f32(d[2], d[3], w, true);
                  *(unsigned*)(op + tl * 16) = (unsigned)w; } } }
    }
}

__device__ __forceinline__ float dot16f8(u32x4 w, const float* h) {
    float s = 0.f;
#pragma unroll
    for (int d = 0; d < 4; ++d) { const f32x2 lo = __builtin_amdgcn_cvt_pk_f32_fp8((int)w[d], false), hi = __builtin_amdgcn_cvt_pk_f32_fp8((int)w[d], true);
        s += lo.x * h[4 * d] + lo.y * h[4 * d + 1] + hi.x * h[4 * d + 2] + hi.y * h[4 * d + 3]; }
    return s;
}
__device__ __forceinline__ void fma16f8(u32x4 w, float cf, float* acc) {
#pragma unroll
    for (int d = 0; d < 4; ++d) { const f32x2 lo = __builtin_amdgcn_cvt_pk_f32_fp8((int)w[d], false), hi = __builtin_amdgcn_cvt_pk_f32_fp8((int)w[d], true);
        acc[4 * d] += cf * lo.x; acc[4 * d + 1] += cf * lo.y; acc[4 * d + 2] += cf * hi.x; acc[4 * d + 3] += cf * hi.y; }
}
__device__ __forceinline__ float gelu_erf(float x) { return 0.5f * x * (1.0f + erff(x * 0.70710678118654752f)); }
__device__ __forceinline__ void ce_k(unsigned& a, unsigned& b) { const unsigned hi = a > b ? a : b, lo = a > b ? b : a; a = hi; b = lo; }
__device__ __forceinline__ void ce_kp(unsigned& ka, unsigned& pa, unsigned& kb, unsigned& pb) { const bool sw = kb > ka; const unsigned k0 = sw ? kb : ka, k1 = sw ? ka : kb, p0 = sw ? pb : pa, p1 = sw ? pa : pb; ka = k0; kb = k1; pa = p0; pb = p1; }
__device__ __forceinline__ void bmerge16(unsigned (&x)[16]) {
#pragma unroll
    for (int jj = 0; jj < 4; ++jj) { const int j = 8 >> jj;
#pragma unroll
        for (int i = 0; i < 16; ++i) { const int l = i ^ j; if (l > i) ce_k(x[i], x[l]); }
        __builtin_amdgcn_sched_barrier(0); }
}
__device__ __forceinline__ void bmerge16p(unsigned (&x)[16], unsigned (&p)[16]) {
#pragma unroll
    for (int jj = 0; jj < 4; ++jj) { const int j = 8 >> jj;
#pragma unroll
        for (int i = 0; i < 16; ++i) { const int l = i ^ j; if (l > i) ce_kp(x[i], p[i], x[l], p[l]); }
        __builtin_amdgcn_sched_barrier(0); }
}
__device__ __forceinline__ void bsort16(unsigned (&x)[16]) {
#pragma unroll
    for (int kk = 1; kk <= 4; ++kk) { const int k = 1 << kk;
#pragma unroll
        for (int jj = 0; jj < 4; ++jj) { const int j = (k >> 1) >> jj;
            if (j > 0) {
#pragma unroll
                for (int i = 0; i < 16; ++i) { const int l = i ^ j; if (l > i) { if ((i & k) == 0) ce_k(x[i], x[l]); else ce_k(x[l], x[i]); } }
                __builtin_amdgcn_sched_barrier(0); } } }
}
__device__ __forceinline__ void bsort16p(unsigned (&x)[16], unsigned (&p)[16]) {
#pragma unroll
    for (int kk = 1; kk <= 4; ++kk) { const int k = 1 << kk;
#pragma unroll
        for (int jj = 0; jj < 4; ++jj) { const int j = (k >> 1) >> jj;
            if (j > 0) {
#pragma unroll
                for (int i = 0; i < 16; ++i) { const int l = i ^ j; if (l > i) { if ((i & k) == 0) ce_kp(x[i], p[i], x[l], p[l]); else ce_kp(x[l], p[l], x[i], p[i]); } }
                __builtin_amdgcn_sched_barrier(0); } } }
}
__device__ __forceinline__ void top16_row(const unsigned char* rowp, unsigned (&t)[16]) {
#pragma unroll
    for (int i = 0; i < 16; ++i) t[i] = 0u;
#pragma unroll 1
    for (int g = 0; g < 8; ++g) {
        unsigned w[8];
#pragma unroll
        for (int q = 0; q < 4; ++q) { const u32x2 v = *(const u32x2*)(rowp + g * 32 + q * 8); w[2 * q] = v.x; w[2 * q + 1] = v.y; }
        unsigned sk[16];
#pragma unroll
        for (int d = 0; d < 8; ++d) {
            const unsigned lo = w[d] << 16, hi = w[d];
            const unsigned xl = lo ^ ((unsigned)((int)lo >> 31) | 0x80000000u), xh = hi ^ ((unsigned)((int)hi >> 31) | 0x80000000u);
            sk[2 * d] = ((xl >> 9) & 0xFFFFFF80u) | (unsigned)(127 - (g * 16 + 2 * d));
            sk[2 * d + 1] = ((xh >> 9) & 0xFFFFFF80u) | (unsigned)(127 - (g * 16 + 2 * d + 1)); }
        bsort16(sk);
#pragma unroll
        for (int i = 0; i < 16; ++i) t[i] = t[i] > sk[15 - i] ? t[i] : sk[15 - i];
        bmerge16(t);
    }
}
__device__ __forceinline__ float key_val(unsigned key) { const unsigned y = (key << 9) & 0xFFFF0000u; return __uint_as_float((y ^ (~(unsigned)((int)y >> 31) | 0x80000000u)) & 0xFFFF0000u); }
__device__ __forceinline__ unsigned sum_key(float s, int c) { const unsigned u = __float_as_uint(s); return ((u ^ ((unsigned)((int)u >> 31) | 0x80000000u)) & ~63u) | (unsigned)(63 - c); }
__device__ __forceinline__ float sum_val(unsigned k) { const unsigned y = k & ~63u; return __uint_as_float(y ^ (~(unsigned)((int)y >> 31) | 0x80000000u)); }
typedef __bf16 bf2_t __attribute__((ext_vector_type(2)));
__device__ __forceinline__ float dot2_bf(unsigned a, unsigned b, float c) { return __builtin_amdgcn_fdot2_f32_bf16(__builtin_bit_cast(bf2_t, a), __builtin_bit_cast(bf2_t, b), c, false); }
__device__ __forceinline__ float dot32_f6b(u32x4 wa, u32x2 wb, u32x4 h0, u32x4 h1, u32x4 h2, u32x4 h3) {
    const bf16x32 dec = __builtin_amdgcn_cvt_scalef32_pk32_bf16_fp6((u32x6){wa.x, wa.y, wa.z, wa.w, wb.x, wb.y}, 1.0f);
    const u32x16 ud = __builtin_bit_cast(u32x16, dec);
    float acc = 0.f;
    acc = dot2_bf(ud.s0, h0.x, acc); acc = dot2_bf(ud.s1, h0.y, acc); acc = dot2_bf(ud.s2, h0.z, acc); acc = dot2_bf(ud.s3, h0.w, acc);
    acc = dot2_bf(ud.s4, h1.x, acc); acc = dot2_bf(ud.s5, h1.y, acc); acc = dot2_bf(ud.s6, h1.z, acc); acc = dot2_bf(ud.s7, h1.w, acc);
    acc = dot2_bf(ud.s8, h2.x, acc); acc = dot2_bf(ud.s9, h2.y, acc); acc = dot2_bf(ud.sa, h2.z, acc); acc = dot2_bf(ud.sb, h2.w, acc);
    acc = dot2_bf(ud.sc, h3.x, acc); acc = dot2_bf(ud.sd, h3.y, acc); acc = dot2_bf(ud.se, h3.z, acc); acc = dot2_bf(ud.sf, h3.w, acc);
    return acc;
}
__device__ const unsigned char g_cab[64] = {0, 1, 2, 3, 4, 5, 6, 7, 8, 9, 10, 11, 12, 13, 14, 15, 16, 17, 18, 19, 20, 21, 22, 23, 32, 33, 34, 35, 36, 48, 49, 50, 51, 64, 65, 66, 80, 81, 96, 97, 112, 113, 128, 144, 160, 176, 192, 208, 224, 240, 0, 0, 0, 0, 0, 0, 0, 0, 0, 0, 0, 0, 0, 0};
template <int PMODE = 0> __device__ __forceinline__ void phase10_peer(Frame& F) {
    F.lane = lane_now(); F.tid = F.wave * 64 + F.lane;
    const bf16_t* sub = (const bf16_t*)(F.ws + WS_SUB); const bf16_t* h2 = (const bf16_t*)(F.ws + WS_H2);
    const unsigned char* pu = F.ws + WS_PU; unsigned* pairs = (unsigned*)(F.ws + WS_PAIRS);
    const int gw = F.bid * 8 + F.wave, NGW = F.G * 8;
    unsigned char* wb = F.lds + F.wave * 19200;
    unsigned char* h2b = wb; unsigned short* gl16 = (unsigned short*)(wb + 16896); unsigned* hist = (unsigned*)(wb + 18944); unsigned* base = hist + 32;
    unsigned* tmp = (unsigned*)wb;
    unsigned* wls0 = (unsigned*)(F.ws + WS_WLS) + (size_t)gw * 1024;
    const int ntok = (MTOK - gw + NGW - 1) / NGW;
    constexpr int CA[50] = {0,0,0,0,0,0,0,0,0,0,0,0,0,0,0,0, 1,1,1,1,1,1,1,1, 2,2,2,2,2, 3,3,3,3, 4,4,4, 5,5, 6,6, 7,7, 8,9,10,11,12,13,14,15};
    constexpr int CB[50] = {0,1,2,3,4,5,6,7,8,9,10,11,12,13,14,15, 0,1,2,3,4,5,6,7, 0,1,2,3,4, 0,1,2,3, 0,1,2, 0,1, 0,1, 0,1, 0,0,0,0,0,0,0,0};
    for (int p0 = 0; p0 < ntok; p0 += 8) {
        int lane = F.lane; asm volatile("" : "+v"(lane));
        const int nt = (ntok - p0) < 8 ? (ntok - p0) : 8;
        {
            u32x4 st[16];
#define SEL_LOAD(half) do { asm volatile("" : "+v"(lane)); const int srow_l = lane >> 4, scol = lane & 15; _Pragma("unroll") for (int it = 0; it < 16; ++it) { const int r_ = it * 4 + srow_l; int ti_ = r_ >> 3; ti_ = ti_ < nt ? ti_ : nt - 1; \
                st[it] = *(const u32x4*)(sub + (size_t)(gw + (p0 + ti_) * NGW) * 2048 + (r_ & 7) * 256 + (half) * 128 + scol * 8); } } while (0)
#define SEL_STORE() do { const int srow_l = lane >> 4, scol = lane & 15; _Pragma("unroll") for (int it = 0; it < 16; ++it) { unsigned char* d_ = wb + (it * 4 + srow_l) * 264 + scol * 16; \
                *(u32x2*)d_ = (u32x2){st[it].x, st[it].y}; *(u32x2*)(d_ + 8) = (u32x2){st[it].z, st[it].w}; } } while (0)
            unsigned tA[16], tB[16];
            SEL_LOAD(0); SEL_STORE();
            __builtin_amdgcn_sched_barrier(0);
            top16_row(wb + lane * 264, tA);
            __builtin_amdgcn_sched_barrier(0);
            asm volatile("" : "+v"(tA[0]), "+v"(tA[1]), "+v"(tA[2]), "+v"(tA[3]), "+v"(tA[4]), "+v"(tA[5]), "+v"(tA[6]), "+v"(tA[7]), "+v"(tA[8]), "+v"(tA[9]), "+v"(tA[10]), "+v"(tA[11]), "+v"(tA[12]), "+v"(tA[13]), "+v"(tA[14]), "+v"(tA[15]) :: "memory");
            SEL_LOAD(1); SEL_STORE();
            __builtin_amdgcn_sched_barrier(0);
            top16_row(wb + lane * 264, tB);
            __builtin_amdgcn_sched_barrier(0);
#undef SEL_LOAD
#undef SEL_STORE
            float vA[16], vB[16];
            { unsigned pa[4] = {0u, 0u, 0u, 0u}, pb[4] = {0u, 0u, 0u, 0u};
#pragma unroll
              for (int i = 0; i < 16; ++i) { vA[i] = key_val(tA[i]); vB[i] = key_val(tB[i]); pa[i >> 2] |= (127u - (tA[i] & 127u)) << (8 * (i & 3)); pb[i >> 2] |= (127u - (tB[i] & 127u)) << (8 * (i & 3)); }
              unsigned char* rp = wb + lane * 264;
              *(u32x2*)rp = (u32x2){pa[0], pa[1]}; *(u32x2*)(rp + 8) = (u32x2){pa[2], pa[3]}; *(u32x2*)(rp + 16) = (u32x2){pb[0], pb[1]}; *(u32x2*)(rp + 24) = (u32x2){pb[2], pb[3]}; }
            unsigned tk[16];
#pragma unroll
            for (int c = 0; c < 16; ++c) tk[c] = sum_key(vA[CA[c]] + vB[CB[c]], c);
            bsort16(tk);
#pragma unroll
            for (int grp = 1; grp < 3; ++grp) {
                unsigned sk[16];
#pragma unroll
                for (int e = 0; e < 16; ++e) { const int c = grp * 16 + e; sk[e] = sum_key(vA[CA[c]] + vB[CB[c]], c); }
                bsort16(sk);
#pragma unroll
                for (int i = 0; i < 16; ++i) tk[i] = tk[i] > sk[15 - i] ? tk[i] : sk[15 - i];
                bmerge16(tk);
            }
#pragma unroll
            for (int c = 48; c < 50; ++c) { unsigned k = sum_key(vA[CA[c]] + vB[CB[c]], c);
#pragma unroll
                for (int i = 0; i < 16; ++i) ce_k(tk[i], k); }
            const float s0 = sum_val(tk[0]); float ev[16], esum = 0.f;
#pragma unroll
            for (int r = 0; r < 16; ++r) { ev[r] = __expf(sum_val(tk[r]) - s0); esum += ev[r]; }
            const float einv = 1.0f / esum;
            unsigned eid[16];
            { const unsigned char* rp = wb + lane * 264;
#pragma unroll
              for (int r = 0; r < 16; ++r) { const unsigned cab = g_cab[63u - (tk[r] & 63u)]; eid[r] = (unsigned)rp[cab >> 4] * 128u + (unsigned)rp[16 + (cab & 15u)]; } }
            if ((lane >> 3) < nt) {
#pragma unroll
                for (int r = 0; r < 16; ++r) { const int e = lane * 16 + r; tmp[e] = ((unsigned)e << 14) | eid[r]; gl16[e] = (unsigned short)(cvt_pk_bf16(ev[r] * einv, 0.f) & 0xffffu); } }
        }
        asm volatile("" : "+v"(lane));
        const int ne = nt * 128;
        {
            if (lane < 32) hist[lane] = 0u;
            unsigned ent[16]; unsigned rk[16];
#pragma unroll
            for (int q = 0; q < 16; ++q) { const int e = q * 64 + lane; ent[q] = (e < ne) ? tmp[e] : 0u; rk[q] = (e < ne) ? atomicAdd(&hist[(ent[q] & 0x3FFFu) >> 9], 1u) : 0u; }
            { int hv = lane < 32 ? (int)hist[lane] : 0; int x = hv;
              x += __builtin_amdgcn_update_dpp(0, x, 0x111, 0xF, 0xF, true); x += __builtin_amdgcn_update_dpp(0, x, 0x112, 0xF, 0xF, true);
              x += __builtin_amdgcn_update_dpp(0, x, 0x114, 0xF, 0xF, true); x += __builtin_amdgcn_update_dpp(0, x, 0x118, 0xF, 0xF, true);
              const int t0 = __builtin_amdgcn_readlane(x, 15); if (lane >= 16) x += t0;
              if (lane < 32) base[lane] = (unsigned)(x - hv); }
#pragma unroll
            for (int q = 0; q < 16; ++q) { const int e = q * 64 + lane; if (e < ne) wls0[base[(ent[q] & 0x3FFFu) >> 9] + rk[q]] = ent[q]; }
        }
        asm volatile("s_waitcnt vmcnt(0)" ::: "memory");
        asm volatile("" : "+v"(lane));
#pragma unroll 1
        for (int i = 0; i < nt; ++i) { const bf16_t* hr = h2 + (size_t)(gw + (p0 + i) * NGW) * 2048 + lane * 32;
            f32x4 v[8]; float m = 0.f;
#pragma unroll
            for (int q = 0; q < 4; ++q) { unpack8(*(const u32x4*)(hr + q * 8), v[2 * q], v[2 * q + 1]); }
#pragma unroll
            for (int q = 0; q < 8; ++q)
#pragma unroll
                for (int k = 0; k < 4; ++k) m = fmaxf(m, __builtin_fabsf(v[q][k]));
            int sb = (int)((__float_as_uint(m * 1.0666667f) >> 23) & 0xFFu) - 2; sb = sb < 1 ? 1 : (sb > 253 ? 253 : sb);
            const float inv = __uint_as_float((unsigned)(254 - sb) << 23);
            u32x16 pk;
#pragma unroll
            for (int q = 0; q < 8; ++q) { const f32x4 a = v[q] * inv; pk[2 * q] = cvt_pk_bf16(a[0], a[1]); pk[2 * q + 1] = cvt_pk_bf16(a[2], a[3]); }
            const u32x6 p6 = __builtin_amdgcn_cvt_scalef32_pk32_fp6_bf16(__builtin_bit_cast(bf16x32, pk), 1.0f);
            const int lp = (lane >> 2) + 16 * (lane & 3);
            *(u32x4*)(h2b + i * 2048 + lp * 16) = (u32x4){p6[0], p6[1], p6[2], p6[3]};
            *(u32x4*)(h2b + i * 2048 + 1024 + lp * 16) = (u32x4){p6[4], p6[5], (unsigned)sb, 0u}; }
        if (PMODE != 1) {
            const int dg = lane >> 4, dc = lane & 15;
            const bool dv = (dc >> 2) == dg; const int dr = dc & 3;
            const float w0 = (dv && dr == 0) ? 1.f : 0.f, w1 = (dv && dr == 1) ? 1.f : 0.f, w2 = (dv && dr == 2) ? 1.f : 0.f, w3 = (dv && dr == 3) ? 1.f : 0.f;
            unsigned entn = __hip_atomic_load(wls0 + lane, __ATOMIC_RELAXED, __HIP_MEMORY_SCOPE_AGENT);
#define U_LOAD(WA, WB, srcent, i0_) do { _Pragma("unroll") for (int jj = 0; jj < 8; ++jj) { const unsigned en_ = (unsigned)__builtin_amdgcn_readlane((int)(srcent), (i0_) + jj); \
                const unsigned char* ur = pu + (size_t)(en_ & 0x3FFFu) * 1536; WA[jj] = *(const u32x4*)(ur + lane * 16); WB[jj] = *(const u32x2*)(ur + 1024 + lane * 8); } } while (0)
#define U_COMP(WA, WB, i0_) do { float pr[8]; \
                _Pragma("unroll") for (int jj = 0; jj < 8; ++jj) { const unsigned en_ = (unsigned)__builtin_amdgcn_readlane((int)ent64, (i0_) + jj); const unsigned char* hp = h2b + ((en_ >> 21) & 7u) * 2048 + lane * 16; \
                    const u32x4 b0 = *(const u32x4*)hp, b1 = *(const u32x4*)(hp + 1024); \
                    const pg8::i32x8 A = (pg8::i32x8){(int)WA[jj].x, (int)WA[jj].y, (int)WA[jj].z, (int)WA[jj].w, (int)WB[jj].x, (int)WB[jj].y, 0, 0}; \
                    const pg8::i32x8 B = (pg8::i32x8){(int)b0.x, (int)b0.y, (int)b0.z, (int)b0.w, (int)b1.x, (int)b1.y, 0, 0}; \
                    const f32x4 D = __builtin_amdgcn_mfma_scale_f32_16x16x128_f8f6f4(A, B, (f32x4){0.f, 0.f, 0.f, 0.f}, 2  , 2  , 0, 0x7F7F7F7F, 0, (int)b1.z); \
                    pr[jj] = w0 * D[0] + w1 * D[1] + w2 * D[2] + w3 * D[3]; } \
                  \
                _Pragma("unroll") for (int i = 0; i < 4; ++i) pr[i] = swap32_pair(pr[i], pr[i + 4]); \
                _Pragma("unroll") for (int i = 0; i < 2; ++i) pr[i] = swap16_pair(pr[i], pr[i + 2]); \
                const bool b3 = (lane & 8) != 0; \
                { const float snd = b3 ? pr[0] : pr[1], kp = b3 ? pr[1] : pr[0]; pr[0] = kp + dpp_f<DPP_ROR8>(snd); } \
                float tot = pr[0]; tot += dpp_f<DPP_XOR1>(tot); tot += dpp_f<DPP_XOR2>(tot); tot += dpp_f<DPP_HMIRROR>(tot); \
                keep = ((lane & 7) == ((i0_) >> 3)) ? tot : keep;           \
            } while (0)
            u32x4 wA0[8], wA1[8]; u32x2 wB0[8], wB1[8];
            U_LOAD(wA0, wB0, entn, 0);
#pragma unroll 1
            for (int c = 0; c < ne; c += 64) {
                const unsigned ent64 = entn;
                const bool more = c + 64 < ne;
                if (more) entn = __hip_atomic_load(wls0 + c + 64 + lane, __ATOMIC_RELAXED, __HIP_MEMORY_SCOPE_AGENT);
                float keep = 0.f;
#pragma unroll 1
                for (int i0 = 0; i0 < 64; i0 += 16) {
                    U_LOAD(wA1, wB1, ent64, i0 + 8);
                    U_COMP(wA0, wB0, i0);
                    if (i0 + 16 < 64) U_LOAD(wA0, wB0, ent64, i0 + 16); else if (more) U_LOAD(wA0, wB0, entn, 0);
                    U_COMP(wA1, wB1, i0 + 8);
                }
                {
                    const unsigned em = (unsigned)__shfl((int)ent64, 8 * (lane & 7) + (lane >> 3));
                    const int ti = (int)(em >> 21), j = (int)((em >> 14) & 127u), row = gw + (p0 + ti) * NGW;
                    const float cf = gelu_erf(keep * (1.0f / 96.0f)) * __uint_as_float((unsigned)gl16[(em >> 14) & 1023u] << 16);
                    pairs[((size_t)(row >> 6) * 128 + j) * 64 + (row & 63)] = (((unsigned)__builtin_bit_cast(unsigned short, (_Float16)cf) << 16) & 0xFFFE0000u) | ((em & 0x3FFFu) << 3);
                }
            }
#undef U_LOAD
#undef U_COMP
        }
    }
}

__device__ __forceinline__ void phase11_peer_v(Frame& F, float* dst) {
    F.lane = lane_now(); F.tid = F.wave * 64 + F.lane;
    const unsigned* pairs = (const unsigned*)(F.ws + WS_PAIRS); const float* mf = (const float*)(F.ws + WS_MODF);
    unsigned long long* vs = (unsigned long long*)F.lds;
    for (int c0 = F.bid; c0 < DM / 8; c0 += F.G) {
        const int c = (c0 & 7) * 32 + (c0 >> 3);
        __syncthreads();
        { const u32x4* src = (const u32x4*)(F.ws + WS_PV + (size_t)c * NEXP * 8);
#pragma unroll 4
          for (int i = F.tid; i < NEXP * 8 / 16; i += 512) *(LAS u32x4*)(unsigned long long)(unsigned)(i * 16) = src[i]; }
        __syncthreads();
        typedef __fp16 h2_t __attribute__((__vector_size__(2 * sizeof(__fp16))));
#define P11_LOAD(dst, ptr) do { _Pragma("unroll") for (int jj = 0; jj < 16; ++jj) dst[jj] = (ptr)[jj * 64]; } while (0)
#define P11_FMA(A, X, C) asm("v_pk_fma_f16 %0, %1, %2, %0 op_sel:[0,1,0] op_sel_hi:[1,1,1]" : "+v"(C) : "v"(A), "v"(X))
#define P11_COMP(src) do { unsigned long long vv_[16]; \
                    _Pragma("unroll") for (int jj = 0; jj < 16; ++jj) vv_[jj] = *(const LAS unsigned long long*)(unsigned long long)(src[jj] & 0x1FFF8u);     \
                    __builtin_amdgcn_sched_barrier(0); \
                    _Pragma("unroll") for (int jj = 0; jj < 16; ++jj) { const int lo = (int)(unsigned)vv_[jj], hi = (int)(unsigned)(vv_[jj] >> 32); \
                    const h2_t c0_ = __builtin_amdgcn_cvt_scalef32_pk_f16_fp8(lo, 1.0f, false), c1_ = __builtin_amdgcn_cvt_scalef32_pk_f16_fp8(lo, 1.0f, true); \
                    const h2_t c2_ = __builtin_amdgcn_cvt_scalef32_pk_f16_fp8(hi, 1.0f, false), c3_ = __builtin_amdgcn_cvt_scalef32_pk_f16_fp8(hi, 1.0f, true); \
                    P11_FMA(c0_, src[jj], acc[0]); P11_FMA(c1_, src[jj], acc[1]); P11_FMA(c2_, src[jj], acc[2]); P11_FMA(c3_, src[jj], acc[3]); } } while (0)
#define P11_COMPX(src) do { unsigned long long vv_[16]; \
                    _Pragma("unroll") for (int jj = 0; jj < 16; ++jj) vv_[jj] = *(const LAS unsigned long long*)(unsigned long long)(src[jj] & 0x1FFF8u); \
                    __builtin_amdgcn_sched_barrier(0); \
                    _Pragma("unroll") for (int jj = 0; jj < 16; ++jj) { const int lo = (int)(unsigned)vv_[jj], hi = (int)(unsigned)(vv_[jj] >> 32); \
                    P11_FMA(lo, src[jj], acc[0]); P11_FMA(hi, src[jj], acc[1]); P11_FMA(lo, src[jj], acc[2]); P11_FMA(hi, src[jj], acc[3]); } } while (0)
        int lane = F.lane; asm volatile("" : "+v"(lane));
        unsigned pa[16], pb[16];
        f32x4 x0, x1;
        { const unsigned* pp = pairs + (size_t)F.wave * 128 * 64 + lane; P11_LOAD(pa, pp);
          const float* ip = F.out + (size_t)(F.wave * 64 + lane) * 2048 + c * 8; x0 = *(const f32x4*)ip; x1 = *(const f32x4*)(ip + 4); }
        for (int tile = F.wave; tile < MTOK / 64; tile += 8) {
            const unsigned* pp = pairs + (size_t)tile * 128 * 64 + lane;
            const int ntile = tile + 8 < MTOK / 64 ? tile + 8 : tile;
            const unsigned* npp = pairs + (size_t)ntile * 128 * 64 + lane;
            const int row = tile * 64 + lane;
            const float* gt2 = mf + (size_t)(tile / (SEQ / 64)) * 12288 + 10240 + c * 8;
            float* op = dst + (size_t)row * 2048 + c * 8;
            const f32x4 g0 = *(const f32x4*)gt2 * 0.25f, g1 = *(const f32x4*)(gt2 + 4) * 0.25f;
            h2_t acc[4];
#pragma unroll
            for (int i = 0; i < 4; ++i) acc[i] = (h2_t){(__fp16)0.f, (__fp16)0.f};
            f32x4 nx0 = x0, nx1 = x1;
#pragma unroll 1
            for (int j0 = 0; j0 < 128; j0 += 32) {
                P11_LOAD(pb, pp + (j0 + 16) * 64);
                P11_COMP(pa);
                const bool lastb = j0 + 32 >= 128;
                { const unsigned* np_ = lastb ? npp : pp + (j0 + 32) * 64; P11_LOAD(pa, np_); }
                if (lastb) { const float* nip = F.out + (size_t)(ntile * 64 + lane) * 2048 + c * 8; nx0 = *(const f32x4*)nip; nx1 = *(const f32x4*)(nip + 4); }
                P11_COMP(pb);
            }
#if PROBE_P11X == 1 || PROBE_P11X == 3
            { h2_t sv[4]; for (int i = 0; i < 4; ++i) sv[i] = acc[i];
#pragma unroll 1
              for (int j0 = 0; j0 < 128; j0 += 32) {
#pragma unroll
                for (int jj = 0; jj < 16; ++jj) { asm volatile("" : "+v"(pa[jj])); asm volatile("" : "+v"(pb[jj])); }
#if PROBE_P11X == 1
                P11_COMP(pa); P11_COMP(pb);
#else
                P11_COMPX(pa); P11_COMPX(pb);
#endif
              }
              asm volatile("" :: "v"(acc[0]), "v"(acc[1]), "v"(acc[2]), "v"(acc[3])); for (int i = 0; i < 4; ++i) acc[i] = sv[i]; }
#endif
            *(f32x4*)op = x0 + g0 * (f32x4){(float)acc[0][0], (float)acc[0][1], (float)acc[1][0], (float)acc[1][1]};
            *(f32x4*)(op + 4) = x1 + g1 * (f32x4){(float)acc[2][0], (float)acc[2][1], (float)acc[3][0], (float)acc[3][1]};
            x0 = nx0; x1 = nx1;
        }
#undef P11_LOAD
#undef P11_COMP
#undef P11_FMA
    }
}

__global__ void __launch_bounds__(512, 2) fwd_kernel(Args args) {
    extern __shared__ __attribute__((aligned(16))) unsigned char lds[];
    Frame F;
    F.lds = lds; F.ws = args.ws; F.tid = threadIdx.x; F.lane = F.tid & 63; F.wave = __builtin_amdgcn_readfirstlane(F.tid >> 6); F.G = gridDim.x; F.bid = blockIdx.x;
    F.x = args.in[0]; F.c = args.in[1]; F.w_ada = args.in[2]; F.b_ada = args.in[3]; F.g1 = args.in[4]; F.g2 = args.in[5]; F.w_in = args.in[6]; F.g_q = args.in[7]; F.g_k = args.in[8];
    F.rel_bias = args.in[9]; F.pool_w = args.in[10]; F.pool_scale = args.in[11]; F.w_ab = args.in[12]; F.w_pb = args.in[13]; F.w_out = args.in[14]; F.w_pq = args.in[15];
    F.peer_keys = args.in[16]; F.peer_u = args.in[17]; F.peer_v = args.in[18]; F.out = args.out;
    LAS unsigned char* ldsl = (LAS unsigned char*)lds;
    volatile LAS unsigned* misc = (volatile LAS unsigned*)(ldsl + MISC_OFF);
    if (F.tid < 4) misc[F.tid] = 0u;
    __syncthreads();
    unsigned* barw = (unsigned*)(args.ws + WS_CTL) + (size_t)args.li * XCD_BAR_WORDS;
    XcdBarrier bar; bar.bar = barw; bar.x = 0; bar.st = misc;
    const int lo = args.ph_lo, hi = args.ph_hi;
    if (hi - lo > 1) bar = xcd_barrier_post(barw, misc);
#define IN(k) (lo <= (k) && (k) < hi)
#define SEAM(k) do { if (IN(k) && IN((k) + 1)) xcd_barrier(bar, F.wave); } while (0)
    bf16_t* R0 = (bf16_t*)(F.ws + WS_R0);

#define PH2_BODY { \
        { pg8::Gemm g{(const bf16_t*)(F.ws + WS_H1F8), (const bf16_t*)(F.ws + WS_WIN8), MTOK, 5632, DM / 2, DM / 2, 0, nullptr, nullptr, 0, 0}; pg8::StaticOrder S; S.init(MTOK, 5632, F.G, F.bid); \
          EpiInproj<true> E{(bf16_t*)(F.ws + WS_QN), (bf16_t*)(F.ws + WS_KN), (bf16_t*)(F.ws + WS_V), (bf16_t*)(F.ws + WS_IQ), (bf16_t*)(F.ws + WS_IK), (bf16_t*)(F.ws + WS_PL), \
                    (bf16_t*)(F.ws + WS_GA), (bf16_t*)(F.ws + WS_GP), (float*)(F.ws + WS_IW)}; \
          pg8::gemm_phase<EpiInproj<true>, true>(ldsl, g, S, E, F.wave); } \
        { pg8::Gemm g{R0, (const bf16_t*)(F.ws + WS_WIN16), MTOK, 2304, DM, DM, 0, nullptr, nullptr, 0, 0}; pg8::StaticOrder S; S.init(MTOK, 2304, F.G, F.bid); \
          EpiInproj<false> E{(bf16_t*)(F.ws + WS_QN), (bf16_t*)(F.ws + WS_KN), (bf16_t*)(F.ws + WS_V), (bf16_t*)(F.ws + WS_IQ), (bf16_t*)(F.ws + WS_IK), (bf16_t*)(F.ws + WS_PL), \
                    (bf16_t*)(F.ws + WS_GA), (bf16_t*)(F.ws + WS_GP), (float*)(F.ws + WS_IW)}; \
          pg8::gemm_phase<EpiInproj<false>>(ldsl, g, S, E, F.wave); } }
#define PH3_BODY { phase3_pooled(F); phase3_indexer(F); __syncthreads(); }
#define PH4_BODY { \
        phase4_attention(F); \
        __syncthreads(); \
        pg8::Gemm g{(const bf16_t*)(F.ws + WS_POOLED), (const bf16_t*)(F.ws + WS_POOLW), MTOK, PW, 256, 1024, 256, nullptr, nullptr, 0, 0}; pg8::StaticOrder S; S.init(MTOK, PW, F.G, F.bid); \
        EpiF8Scale E{F.ws + WS_POOL2, 1024, F.pool_scale}; \
        pg8::gemm_phase<EpiF8Scale>(ldsl, g, S, E, F.wave); }
#define PH5_BODY { \
        pg8::Gemm g{(const bf16_t*)(F.ws + WS_ATTN), (const bf16_t*)(F.ws + WS_WAB), MTOK, DM, 1024, 512, 0, (const bf16_t*)(F.ws + WS_POOL2), (const bf16_t*)(F.ws + WS_WPB), 8, 512};     \
        pg8::StaticOrder S; S.init(MTOK, DM, F.G, F.bid); \
        EpiMerge E{(unsigned char*)R0, (const bf16_t*)(F.ws + WS_GA), (const bf16_t*)(F.ws + WS_GP)}; pg8::gemm_phase<EpiMerge, true>(ldsl, g, S, E, F.wave); }
#define PH6_BODY { \
        pg8::Gemm g{R0, (const bf16_t*)(F.ws + WS_WOUT), MTOK, DM, DM / 2, DM / 2, 0, nullptr, nullptr, 0, 0}; pg8::StaticOrder S; S.init(MTOK, DM, F.G, F.bid); \
        EpiResid E{F.x, F.out, (const float*)(F.ws + WS_MODF) + 4096}; pg8::gemm_phase<EpiResid, true>(ldsl, g, S, E, F.wave); }
#define PH8_BODY { \
        pg8::Gemm g{(const bf16_t*)(F.ws + WS_H2), (const bf16_t*)(F.ws + WS_WPQ), MTOK, DM, DM, DM, 0, nullptr, nullptr, 0, 0}; pg8::StaticOrder S; S.init(MTOK, DM, F.G, F.bid); \
        EpiBf16Scale E{R0, 2048, nullptr}; pg8::gemm_phase<EpiBf16Scale>(ldsl, g, S, E, F.wave); }
#define PH9_BODY { \
        pg8::Gemm g{R0, (const bf16_t*)(F.ws + WS_KEYSBD), MTOK, DM, 256, DM, 256, nullptr, nullptr, 0, 0}; pg8::StaticOrder S; S.init(MTOK, DM, F.G, F.bid); \
        EpiBf16Scale E{(bf16_t*)(F.ws + WS_SUB), 2048, nullptr}; pg8::gemm_phase<EpiBf16Scale>(ldsl, g, S, E, F.wave); }
#define REP(k) if constexpr (((PROBE_REP) >> (k)) & 1)

    if (IN(0)) { phase0_prep(F); REP(0) { __syncthreads(); phase0_prep(F); } }
    SEAM(0);
    if (IN(1)) { phase_modnorm<true>(F, F.x, F.g1, 0, 2048, R0, F.ws + WS_H1F8); REP(1) { phase_modnorm<true>(F, F.x, F.g1, 0, 2048, R0, F.ws + WS_H1F8); } }
    SEAM(1);
    if (IN(2)) { PH2_BODY REP(2) PH2_BODY }
    SEAM(2);
    if (IN(3)) { phase3_qknorm(F); PH3_BODY REP(3) PH3_BODY }
    SEAM(3);
    if (IN(4)) { PH4_BODY REP(4) PH4_BODY }
    SEAM(4);
    if (IN(5)) { PH5_BODY REP(5) PH5_BODY }
    SEAM(5);
    if (IN(6)) { PH6_BODY REP(6) PH6_BODY }
    SEAM(6);
    if (IN(7)) { phase_modnorm<false>(F, F.out, F.g2, 6144, 8192, (bf16_t*)(F.ws + WS_H2)); REP(7) { phase_modnorm<false>(F, F.out, F.g2, 6144, 8192, (bf16_t*)(F.ws + WS_H2)); } }
    SEAM(7);
    if (IN(8)) { PH8_BODY REP(8) PH8_BODY }
    SEAM(8);
    if (IN(9)) { PH9_BODY REP(9) PH9_BODY }
    SEAM(9);
    if (IN(10)) { phase10_peer(F); REP(10) phase10_peer<PROBE_P10M>(F); }
    SEAM(10);
    if (IN(11)) { REP(11) { phase11_peer_v(F, (float*)(F.ws + WS_SUB)); } phase11_peer_v(F, F.out); }
#undef IN
#undef SEAM
}

extern "C" void kernel_launch(void* const* d_in, const int* in_sizes, int n_in, void* d_out, int out_size, void* d_ws, size_t ws_size, hipStream_t stream) {
    static int grid = 0;
    if (grid == 0) {
        if (n_in != 19 || out_size != MTOK * DM || ws_size < WS_END) { fprintf(stderr, "kernel_launch: unexpected shapes (n_in %d out %d ws %zu)\n", n_in, out_size, ws_size); grid = -1; return; }
        int dev = 0, cus = 0, per_cu = 0;
        if (hipGetDevice(&dev) != hipSuccess || hipDeviceGetAttribute(&cus, hipDeviceAttributeMultiprocessorCount, dev) != hipSuccess) { grid = -1; return; }
        if (hipFuncSetAttribute((const void*)fwd_kernel, hipFuncAttributeMaxDynamicSharedMemorySize, LDS_BYTES) != hipSuccess) { fprintf(stderr, "kernel_launch: hipFuncSetAttribute failed\n"); grid = -1; return; }
        if (hipOccupancyMaxActiveBlocksPerMultiprocessor(&per_cu, (const void*)fwd_kernel, 512, LDS_BYTES) != hipSuccess || per_cu < 1) { fprintf(stderr, "kernel_launch: occupancy query says %d\n", per_cu); }
        (void)hipGetLastError();
        grid = cus;
    }
    if (grid < 0) return;
    (void)in_sizes;
    if (hipMemsetAsync((char*)d_ws + WS_CTL, 0, CTL_ZERO_BYTES, stream) != hipSuccess) return;
    Args a{};
    for (int i = 0; i < 19; ++i) a.in[i] = (const float*)d_in[i];
    a.out = (float*)d_out; a.ws = (unsigned char*)d_ws;
#if MK_PER_PHASE
    for (int p = 0; p < NPHASE; ++p) { a.ph_lo = p; a.ph_hi = p + 1; a.li = p; hipLaunchKernelGGL(fwd_kernel, dim3(grid), dim3(512), LDS_BYTES, stream, a); }
#else
    a.ph_lo = 0; a.ph_hi = NPHASE; a.li = 0;
    hipLaunchKernelGGL(fwd_kernel, dim3(grid), dim3(512), LDS_BYTES, stream, a);
#endif
}
```

```cpp
#include <hip/hip_runtime.h>
#include <cstdio>
#include <cstdint>

#ifndef MK_PER_PHASE
#define MK_PER_PHASE 0
#endif

#ifndef PROBE_REP
#define PROBE_REP 0
#endif
#ifndef PROBE_IDX
#define PROBE_IDX 0
#endif
#ifndef PROBE_P10M
#define PROBE_P10M 0
#endif
#ifndef PROBE_P11X
#define PROBE_P11X 0
#endif
#define LAS __attribute__((address_space(3)))
typedef unsigned short bf16_t;
typedef short bf16x8 __attribute__((ext_vector_type(8)));
typedef float f32x4 __attribute__((ext_vector_type(4)));
typedef float f32x2 __attribute__((ext_vector_type(2)));
typedef int v2i __attribute__((ext_vector_type(2)));
typedef unsigned u32x4 __attribute__((ext_vector_type(4)));
typedef unsigned u32x2 __attribute__((ext_vector_type(2)));
typedef unsigned u32x6 __attribute__((ext_vector_type(6)));
typedef unsigned u32x16 __attribute__((ext_vector_type(16)));
typedef __bf16 bf16x32 __attribute__((ext_vector_type(32)));

constexpr int BATCH = 8, SEQ = 4096, DM = 2048, MTOK = BATCH * SEQ;
constexpr int NHEAD = 8, HDIM = 128, AW = 1024, KVW = 256, IHEADS = 16, IDIM = 64, KSEL = 256;
constexpr int PW = 1024, PHEADS = 8, NEXP = 16384;
constexpr int INW = 7760;
constexpr float EPS = 1e-6f;
constexpr int NPHASE = 12;

constexpr size_t MiB = 1u << 20;
constexpr size_t WS_CTL = 0, CTL_ZERO_BYTES = 256 * 1024;
constexpr size_t WS_MODP = 2 * MiB;
constexpr size_t WS_MODF = 4 * MiB;
constexpr size_t WS_POOLW = 5 * MiB;
constexpr size_t WS_KEYSBD = 6 * MiB;
constexpr size_t WS_WIN16 = 8 * MiB;
constexpr size_t WS_WIN8 = 20 * MiB;
constexpr size_t WS_WAB = 40 * MiB, WS_WPB = 44 * MiB, WS_WOUT = 48 * MiB, WS_WPQ = 56 * MiB;
constexpr size_t WS_PU = 64 * MiB, WS_PV = 128 * MiB;
constexpr size_t WS_R0 = 192 * MiB;
constexpr size_t WS_GA = 320 * MiB, WS_GP = 448 * MiB;
constexpr size_t WS_SUB = 320 * MiB;
constexpr size_t WS_QN = 576 * MiB;
constexpr size_t WS_IQ = 640 * MiB;
constexpr size_t WS_PL = 704 * MiB;
constexpr size_t WS_KN = 768 * MiB, WS_V = 784 * MiB;
constexpr size_t WS_IK = 800 * MiB;
constexpr size_t WS_IW = 804 * MiB;
constexpr size_t WS_SEL = 806 * MiB;
constexpr size_t WS_POOLED = 822 * MiB;
constexpr size_t WS_H2 = 886 * MiB;
constexpr size_t WS_END = 1014 * MiB;
constexpr size_t WS_H1F8 = WS_H2 + 64 * MiB;
constexpr size_t WS_Q8 = WS_H2, WS_K8 = WS_H2 + 32 * MiB, WS_V8 = WS_H2 + 40 * MiB;
constexpr size_t WS_ATTN = WS_IQ, WS_POOL2 = WS_PL, WS_PAIRS = WS_QN, WS_WLS = WS_QN + 32 * MiB;

constexpr int LDS_BYTES = 160 * 1024;
constexpr int MISC_OFF = 159 * 1024;

__device__ __forceinline__ unsigned cvt_pk_bf16(float lo, float hi) { unsigned r; asm volatile("v_cvt_pk_bf16_f32 %0, %1, %2" : "=v"(r) : "v"(lo), "v"(hi)); return r; }
__device__ __forceinline__ float bf_lo(unsigned w) { return __uint_as_float(w << 16); }
__device__ __forceinline__ float bf_hi(unsigned w) { return __uint_as_float(w & 0xffff0000u); }
template <int CTRL> __device__ __forceinline__ float dpp_f(float x) { return __int_as_float(__builtin_amdgcn_update_dpp(0, __float_as_int(x), CTRL, 0xF, 0xF, true)); }
#define DPP_XOR1 0xB1
#define DPP_XOR2 0x4E
#define DPP_HMIRROR 0x141
#define DPP_MIRROR 0x140
#define DPP_ROR8 0x128
__device__ __forceinline__ float xor16_sum(float x) { const auto r = __builtin_amdgcn_permlane16_swap(__float_as_uint(x), __float_as_uint(x), false, false); return __uint_as_float(r[0]) + __uint_as_float(r[1]); }
__device__ __forceinline__ float xor32_sum(float x) { const auto r = __builtin_amdgcn_permlane32_swap(__float_as_uint(x), __float_as_uint(x), false, false); return __uint_as_float(r[0]) + __uint_as_float(r[1]); }
__device__ __forceinline__ float xor16_max(float x) { const auto r = __builtin_amdgcn_permlane16_swap(__float_as_uint(x), __float_as_uint(x), false, false); return fmaxf(__uint_as_float(r[0]), __uint_as_float(r[1])); }
__device__ __forceinline__ float swap32_pair(float a, float b) { const auto r = __builtin_amdgcn_permlane32_swap(__float_as_uint(a), __float_as_uint(b), false, false); return __uint_as_float(r[0]) + __uint_as_float(r[1]); }
__device__ __forceinline__ float swap16_pair(float a, float b) { const auto r = __builtin_amdgcn_permlane16_swap(__float_as_uint(a), __float_as_uint(b), false, false); return __uint_as_float(r[0]) + __uint_as_float(r[1]); }
__device__ __forceinline__ float row_sum16(float v) { v += dpp_f<DPP_XOR1>(v); v += dpp_f<DPP_XOR2>(v); v += dpp_f<DPP_HMIRROR>(v); v += dpp_f<DPP_MIRROR>(v); return v; }
__device__ __forceinline__ float row_max16(float v) { v = fmaxf(v, dpp_f<DPP_XOR1>(v)); v = fmaxf(v, dpp_f<DPP_XOR2>(v)); v = fmaxf(v, dpp_f<DPP_HMIRROR>(v)); v = fmaxf(v, dpp_f<DPP_MIRROR>(v)); return v; }
__device__ __forceinline__ float wave_sum(float v) { return xor32_sum(xor16_sum(row_sum16(v))); }
__device__ __forceinline__ float sigmoidf_(float x) { return __builtin_amdgcn_rcpf(1.0f + __expf(-x)); }
__device__ __forceinline__ float dot8(u32x4 w, const float* h) {
    return bf_lo(w.x) * h[0] + bf_hi(w.x) * h[1] + bf_lo(w.y) * h[2] + bf_hi(w.y) * h[3] + bf_lo(w.z) * h[4] + bf_hi(w.z) * h[5] + bf_lo(w.w) * h[6] + bf_hi(w.w) * h[7];
}

__device__ __forceinline__ int lane_now() { int l; asm volatile("v_mbcnt_lo_u32_b32 %0, -1, 0\n\tv_mbcnt_hi_u32_b32 %0, -1, %0" : "=v"(l)); return l; }

#define XB_TMO      128
#define XB_XCNT(j)  (256  + 64 * (j))
#define XB_XSUB(j)  (1280 + 64 * (j))
#define XB_XGEN(j)  (2304 + 64 * (j))
#define XB_TOP      3328
#define XB_TOPGEN   3392
#define XCD_BAR_WORDS 3456
#define XB_SPIN_CAP (1u << 18)

__device__ __forceinline__ unsigned xb_ld(unsigned* p)              { return __hip_atomic_load(p, __ATOMIC_RELAXED, __HIP_MEMORY_SCOPE_AGENT); }
__device__ __forceinline__ unsigned xb_add(unsigned* p, unsigned v) { return __hip_atomic_fetch_add(p, v, __ATOMIC_RELAXED, __HIP_MEMORY_SCOPE_AGENT); }
__device__ __forceinline__ unsigned xb_xcc_id() { return (unsigned)__builtin_amdgcn_s_getreg((3 << 11) | 20) & 0xFu; }
#define XB_SPIN(cond, bar) do { unsigned _sp = 0; while (cond) { __builtin_amdgcn_s_sleep(1); \
    if ((++_sp & 255u) == 0u) { if (xb_ld(&(bar)[XB_TMO])) break; if (_sp > XB_SPIN_CAP) { atomicAdd(&(bar)[XB_TMO], 1u); break; } } } } while (0)

struct XcdBarrier { unsigned* bar; unsigned x; volatile LAS unsigned* st; };

__device__ __forceinline__ XcdBarrier xcd_barrier_post(unsigned* bar, volatile LAS unsigned* st) {
    XcdBarrier b; b.bar = bar; b.x = xb_xcc_id(); b.st = st;
    if (threadIdx.x == 0) (void)xb_add(&bar[XB_XCNT(b.x)], 1u);
    return b;
}
__device__ __forceinline__ void xcd_barrier_complete(unsigned* bar, unsigned x, unsigned& nloc, unsigned& nx) {
    const unsigned G = gridDim.x * gridDim.y * gridDim.z;
    unsigned sum, cnt, mine, sp = 0u;
    for (;;) {
        sum = 0u; cnt = 0u; mine = 0u;
#pragma unroll
        for (unsigned j = 0; j < 16; ++j) { const unsigned c = xb_ld(&bar[XB_XCNT(j)]); sum += c; cnt += (c > 0u) ? 1u : 0u; mine = (j == x) ? c : mine; }
        if (sum == G) break;
        __builtin_amdgcn_s_sleep(1);
        if ((++sp & 255u) == 0u) { if (xb_ld(&bar[XB_TMO])) break; if (sp > XB_SPIN_CAP) { atomicAdd(&bar[XB_TMO], 1u); break; } }
    }
    nloc = mine > 0u ? mine : 1u; nx = cnt > 0u ? cnt : 1u;
}
__device__ __forceinline__ void xcd_barrier(const XcdBarrier& b, int wave) {
    asm volatile("s_waitcnt vmcnt(0)" ::: "memory");
    __syncthreads();
    if (wave == 0 && lane_now() == 0) {
        unsigned* bar = b.bar;
        __builtin_amdgcn_s_waitcnt(0);
        unsigned nloc = b.st[0], nx = b.st[1];
        if (nloc == 0u) { xcd_barrier_complete(bar, b.x, nloc, nx); b.st[0] = nloc; b.st[1] = nx; }
        const unsigned old = xb_add(&bar[XB_XSUB(b.x)], 1u);
        const unsigned gen = old / nloc;
        if (old + 1u == (gen + 1u) * nloc) {
            __builtin_amdgcn_fence(__ATOMIC_RELEASE, "agent");
            asm volatile("s_waitcnt vmcnt(0)" ::: "memory");
            const unsigned og = xb_add(&bar[XB_TOP], 1u);
            const unsigned tg = og / nx;
            if (og + 1u == (tg + 1u) * nx) xb_add(&bar[XB_TOPGEN], 1u);
            else XB_SPIN(xb_ld(&bar[XB_TOPGEN]) == tg, bar);
            __builtin_amdgcn_fence(__ATOMIC_ACQUIRE, "agent");
            xb_add(&bar[XB_XGEN(b.x)], 1u);
            asm volatile("s_waitcnt vmcnt(0)" ::: "memory");
        } else {
            XB_SPIN(xb_ld(&bar[XB_XGEN(b.x)]) == gen, bar);
            __builtin_amdgcn_fence(__ATOMIC_ACQUIRE, "agent");
            asm volatile("s_waitcnt vmcnt(0)" ::: "memory");
        }
    }
    __syncthreads();
}

namespace pg8 {
constexpr int BM = 256, BK = 64, HALF = 128, HTB = HALF * BK * 2, STAGE_BYTES = 8 * HTB, NXCD = 8, WGM = 8;
__device__ __forceinline__ int lds_byte(int r, int c) { const int st = (r >> 4) * 2 + (c >> 5), rr = r & 15, cc = c & 31, ob = rr * 64 + cc * 2; return st * 1024 + (ob ^ (((ob >> 9) & 1) << 5)); }
__device__ __forceinline__ void stage_rc(int b, int& R, int& C) { const int st = b / 1024, sb = b % 1024, swz = sb ^ (((sb >> 9) & 1) << 5); R = (st >> 1) * 16 + swz / 64; C = (st & 1) * 32 + (swz % 64) / 2; }
__device__ __forceinline__ int perm32(int rho) { const int n = rho >> 4, i = rho & 15; return 8 * (i >> 2) + 4 * n + (i & 3); }

struct Unit { int pm, pn; };
struct Gemm { const bf16_t* A; const bf16_t* Bt; int M, N, K, lda, a_pn_off; const bf16_t* A2; const bf16_t* Bt2; int ksplit, ldb; };

struct StaticOrder {
    int nM, nN, nwg, G, c;
    __device__ void init(int M, int N, int G_, int c_) { nM = M / BM; nN = N / BM; nwg = nM * nN; G = G_; c = c_; }
    __device__ bool next(int i, Unit& u) const {
        const long L = (long)i * G + c; if (L >= nwg) return false;
        int wgid = (int)L; { const int q = nwg / NXCD, r = nwg % NXCD, xcd = wgid % NXCD, off = wgid / NXCD; wgid = (xcd < r ? xcd * (q + 1) : r * (q + 1) + (xcd - r) * q) + off; }
        const int nig = WGM * nN, gid = wgid / nig, fm = gid * WGM, gsz = (nM - fm) < WGM ? (nM - fm) : WGM;
        u.pm = fm + ((wgid % nig) % gsz); u.pn = (wgid % nig) / gsz; return true;
    }
};

typedef int i32x4 __attribute__((ext_vector_type(4)));
typedef int i32x8 __attribute__((ext_vector_type(8)));
__device__ __forceinline__ bf16x8 lo8(i32x8 v) { return __builtin_bit_cast(bf16x8, (i32x4){v.s0, v.s1, v.s2, v.s3}); }
__device__ __forceinline__ bf16x8 hi8(i32x8 v) { return __builtin_bit_cast(bf16x8, (i32x4){v.s4, v.s5, v.s6, v.s7}); }
__device__ __forceinline__ i32x8 cat8(bf16x8 a, bf16x8 b) { const i32x4 x = __builtin_bit_cast(i32x4, a), y = __builtin_bit_cast(i32x4, b); return (i32x8){x.x, x.y, x.z, x.w, y.x, y.y, y.z, y.w}; }
template <class Epi, bool F8 = false>
__device__ __forceinline__ void gemm_phase(LAS unsigned char* lds, const Gemm g, const StaticOrder& S, const Epi& E, int wave) {
    const int lane = lane_now(), wid = wave, tid = wid * 64 + lane, wr = wid >> 2, wc = wid & 3, fr = lane & 15, fq = lane >> 4;
    const int K = g.K, nt = K / BK, lda = g.lda, ldb = g.ldb ? g.ldb : g.K, ksplit = g.ksplit;
    unsigned voffA, voffB;
    { int R, C; stage_rc(tid * 16, R, C); const int Rb = Epi::PERM ? ((R & ~31) + perm32(R & 31)) : R;
      voffA = (unsigned)(R * lda + C) * 2u; voffB = (unsigned)(Rb * ldb + C) * 2u; }
    const unsigned stepA = 64u * (unsigned)lda * 2u, stepB = 64u * (unsigned)ldb * 2u;
    const size_t kstep = (size_t)(BK * 2);
    const size_t hsA = (size_t)HALF * lda * 2, hsB = (size_t)HALF * ldb * 2;
    const size_t tsA = 2 * hsA, tsB = 2 * hsB;
    const unsigned ldsw = (unsigned)wid * 1024u, ldsbase = (unsigned)(unsigned long long)lds;
    const int aoff = lds_byte(wr * 64 + fr, fq * 8), boff = lds_byte(wc * 32 + fr, fq * 8);
#define PG8_SA(b, h) (((b) * 2 + (h)) * HTB)
#define PG8_SB(b, h) ((4 + (b) * 2 + (h)) * HTB)
#define PG8_STAGE(bufoff, gbase, voff) do { _Pragma("unroll") for (int _i = 0; _i < 2; ++_i) { \
        const char* sb_ = (const char*)(gbase) + (size_t)_i * PG8_STEP_##voff; const unsigned m0_ = ldsbase + (unsigned)(bufoff) + ldsw + (unsigned)_i * 8192u; \
        asm volatile("s_mov_b32 m0, %2\n\ts_nop 0\n\tglobal_load_lds_dwordx4 %0, %1" :: "v"(voff), "s"(sb_), "s"(m0_) : "memory"); } } while (0)
#define PG8_STEP_voffA stepA
#define PG8_STEP_voffB stepB
#define PG8_LDA(dst, b, h) do { _Pragma("unroll") for (int m = 0; m < 4; ++m) dst[m] = cat8(*(const LAS bf16x8*)(lds + PG8_SA(b, h) + aoff + m * 2048), *(const LAS bf16x8*)(lds + PG8_SA(b, h) + aoff + m * 2048 + 1024)); } while (0)
#define PG8_LDB(dst, b, h) do { _Pragma("unroll") for (int n = 0; n < 2; ++n) dst[n] = cat8(*(const LAS bf16x8*)(lds + PG8_SB(b, h) + boff + n * 2048), *(const LAS bf16x8*)(lds + PG8_SB(b, h) + boff + n * 2048 + 1024)); } while (0)
#define PG8_MMA(ai, bj, At, Bt) do { __builtin_amdgcn_s_setprio(1); _Pragma("unroll") for (int m = 0; m < 4; ++m) _Pragma("unroll") for (int n = 0; n < 2; ++n) { \
        if constexpr (F8) acc[ai][bj][m][n] = __builtin_amdgcn_mfma_scale_f32_16x16x128_f8f6f4(Bt[n], At[m], acc[ai][bj][m][n], 0, 0, 0, 0x7D7D7D7D  , 0, 0x7D7D7D7D); \
        else { acc[ai][bj][m][n] = __builtin_amdgcn_mfma_f32_16x16x32_bf16(lo8(Bt[n]), lo8(At[m]), acc[ai][bj][m][n], 0, 0, 0); \
               acc[ai][bj][m][n] = __builtin_amdgcn_mfma_f32_16x16x32_bf16(hi8(Bt[n]), hi8(At[m]), acc[ai][bj][m][n], 0, 0, 0); } } \
        __builtin_amdgcn_s_setprio(0); } while (0)
#define PG8_WAIT_V(n) asm volatile("s_waitcnt vmcnt(" #n ")" ::: "memory")
#define PG8_WAIT_L(n) asm volatile("s_waitcnt lgkmcnt(" #n ")" ::: "memory")
#define PG8_BAR __builtin_amdgcn_s_barrier()
#define PG8_SCHED __builtin_amdgcn_sched_barrier(0)
    Unit cur, nxt; int ui = 0;
    if (!S.next(0, cur)) return;
    f32x4 acc[2][2][4][2];
#pragma unroll
    for (int a = 0; a < 2; ++a)
#pragma unroll
        for (int b = 0; b < 2; ++b)
#pragma unroll
            for (int m = 0; m < 4; ++m)
#pragma unroll
                for (int n = 0; n < 2; ++n) acc[a][b][m][n] = (f32x4){0.f, 0.f, 0.f, 0.f};
    i32x8 At[4], B0[2], B1[2];
    const char* cA = (const char*)g.A + (size_t)cur.pm * tsA + (size_t)cur.pn * g.a_pn_off * 2; const char* cB = (const char*)g.Bt + (size_t)cur.pn * tsB;
    PG8_STAGE(PG8_SB(0, 0), cB, voffB); PG8_STAGE(PG8_SB(0, 1), cB + hsB, voffB); PG8_STAGE(PG8_SA(0, 0), cA, voffA); PG8_STAGE(PG8_SA(0, 1), cA + hsA, voffA);
    if (wr == 1) PG8_BAR;
    PG8_WAIT_V(2); PG8_BAR;
    PG8_STAGE(PG8_SB(1, 0), cB + kstep, voffB); PG8_STAGE(PG8_SA(1, 0), cA + kstep, voffA); PG8_STAGE(PG8_SB(1, 1), cB + hsB + kstep, voffB);
    PG8_WAIT_V(6); PG8_BAR;
    for (;;) {
        const bool has_next = S.next(ui + 1, nxt);
        const char* nA = has_next ? (const char*)g.A + (size_t)nxt.pm * tsA + (size_t)nxt.pn * g.a_pn_off * 2 : cA; const char* nB = has_next ? (const char*)g.Bt + (size_t)nxt.pn * tsB : cB;
        const char* cA2 = (const char*)g.A2 + (size_t)cur.pm * tsA; const char* cB2 = (const char*)g.Bt2 + (size_t)cur.pn * tsB;
#pragma clang loop unroll(disable)
        for (int t = 0; t < nt; t += 2) {
            const bool last = (t == nt - 2);
            const bool s1 = ksplit && (t >= ksplit), s2 = ksplit && (t + 2 >= ksplit);
            const char* a1 = (s1 ? cA2 + (size_t)(t - ksplit + 1) * kstep : cA + (size_t)(t + 1) * kstep);
            const char* a2 = last ? nA : (s2 ? cA2 + (size_t)(t + 2 - ksplit) * kstep : cA + (size_t)(t + 2) * kstep);
            const char* b2 = last ? nB : (s2 ? cB2 + (size_t)(t + 2 - ksplit) * kstep : cB + (size_t)(t + 2) * kstep);
            const char* a3 = a2 + kstep; const char* b3 = b2 + kstep;
            PG8_LDB(B0, 0, 0); PG8_LDB(B1, 0, 1); PG8_SCHED; PG8_LDA(At, 0, 0); PG8_STAGE(PG8_SA(1, 1), a1 + hsA, voffA);
            PG8_WAIT_V(8); PG8_WAIT_L(0); PG8_BAR; PG8_MMA(0, 0, At, B0); PG8_MMA(0, 1, At, B1); PG8_BAR; PG8_SCHED;
            PG8_LDA(At, 0, 1); PG8_STAGE(PG8_SB(0, 0), b2, voffB); PG8_STAGE(PG8_SB(0, 1), b2 + hsB, voffB); PG8_STAGE(PG8_SA(0, 0), a2, voffA);
            PG8_WAIT_V(8); PG8_WAIT_L(0); PG8_BAR; PG8_MMA(1, 0, At, B0); PG8_MMA(1, 1, At, B1); PG8_BAR; PG8_SCHED;
            PG8_LDB(B0, 1, 0); PG8_LDB(B1, 1, 1); PG8_SCHED; PG8_LDA(At, 1, 0); PG8_STAGE(PG8_SA(0, 1), a2 + hsA, voffA);
            PG8_WAIT_V(8); PG8_WAIT_L(0); PG8_BAR; PG8_MMA(0, 0, At, B0); PG8_MMA(0, 1, At, B1); PG8_BAR; PG8_SCHED;
            PG8_LDA(At, 1, 1); PG8_STAGE(PG8_SB(1, 0), b3, voffB); PG8_STAGE(PG8_SB(1, 1), b3 + hsB, voffB); PG8_STAGE(PG8_SA(1, 0), a3, voffA);
            PG8_WAIT_V(8); PG8_WAIT_L(0); PG8_BAR; PG8_MMA(1, 0, At, B0); PG8_MMA(1, 1, At, B1); PG8_BAR; PG8_SCHED;
            if constexpr (Epi::MID) { if (t + 2 == ksplit) E.mid(acc, cur, wr, wc, fr, fq); }
        }
        if (wr == 0) PG8_BAR;
        { const int l2 = lane_now(); E(acc, cur, wr, wc, l2 & 15, l2 >> 4); }
        if (!has_next) break;
#pragma unroll
        for (int a = 0; a < 2; ++a)
#pragma unroll
            for (int b = 0; b < 2; ++b)
#pragma unroll
                for (int m = 0; m < 4; ++m)
#pragma unroll
                    for (int n = 0; n < 2; ++n) acc[a][b][m][n] = (f32x4){0.f, 0.f, 0.f, 0.f};
        cur = nxt; cA = nA; cB = nB; ++ui;
        if (wr == 1) PG8_BAR;
    }
    PG8_WAIT_V(0);
    PG8_BAR;
#undef PG8_SA
#undef PG8_SB
#undef PG8_STAGE
#undef PG8_STEP_voffA
#undef PG8_STEP_voffB
#undef PG8_LDA
#undef PG8_LDB
#undef PG8_MMA
#undef PG8_WAIT_V
#undef PG8_WAIT_L
#undef PG8_BAR
#undef PG8_SCHED
}
}
using pg8::Unit;

typedef f32x4 AccT[2][2][4][2];
__device__ __forceinline__ u32x4 pack8(f32x4 a, f32x4 b) { u32x4 w; w.x = cvt_pk_bf16(a[0], a[1]); w.y = cvt_pk_bf16(a[2], a[3]); w.z = cvt_pk_bf16(b[0], b[1]); w.w = cvt_pk_bf16(b[2], b[3]); return w; }
__device__ __forceinline__ u32x2 pack8_fp8(f32x4 a, f32x4 b) {
    int w0 = __builtin_amdgcn_cvt_pk_fp8_f32(a[0], a[1], 0, false); w0 = __builtin_amdgcn_cvt_pk_fp8_f32(a[2], a[3], w0, true);
    int w1 = __builtin_amdgcn_cvt_pk_fp8_f32(b[0], b[1], 0, false); w1 = __builtin_amdgcn_cvt_pk_fp8_f32(b[2], b[3], w1, true);
    return (u32x2){(unsigned)w0, (unsigned)w1};
}
__device__ __forceinline__ void unpack8(u32x4 w, f32x4& a, f32x4& b) { a = (f32x4){bf_lo(w.x), bf_hi(w.x), bf_lo(w.y), bf_hi(w.y)}; b = (f32x4){bf_lo(w.z), bf_hi(w.z), bf_lo(w.w), bf_hi(w.w)}; }

template <bool SET8> struct EpiInproj {
    static constexpr bool PERM = true, MID = false;
    bf16_t *q, *k, *v, *iq, *ik, *pl, *ga, *gp; float* iw;
    __device__ __forceinline__ void operator()(const AccT& acc, const Unit& u, int wr, int wc, int fr, int fq) const {
        const int pn = u.pn, row0 = u.pm * 256 + wr * 64 + fr;
        if (!SET8 && pn == 4) {
            if (wc < 2) {
#pragma unroll
                for (int ai = 0; ai < 2; ++ai)
#pragma unroll
                    for (int m = 0; m < 4; ++m) { const size_t row = (size_t)(row0 + ai * 128 + m * 16);
                        *(u32x4*)(ik + row * 64 + wc * 32 + 8 * fq) = pack8(acc[ai][0][m][0], acc[ai][0][m][1]); }
            } else if (wc == 2) {
                if (fq < 2) {
#pragma unroll
                    for (int ai = 0; ai < 2; ++ai)
#pragma unroll
                        for (int m = 0; m < 4; ++m) { const size_t row = (size_t)(row0 + ai * 128 + m * 16);
                            *(f32x4*)(iw + row * 16 + 8 * fq) = acc[ai][0][m][0]; *(f32x4*)(iw + row * 16 + 8 * fq + 4) = acc[ai][0][m][1]; }
                }
            }
            return;
        }
        bf16_t* dst; int ld, tc; bool sg = false;
        if (SET8) {
            if (pn < 4) { dst = q; ld = 1024; tc = pn * 256; }
            else if (pn == 4) { dst = k; ld = 256; tc = 0; }
            else if (pn == 5) { dst = v; ld = 256; tc = 0; }
            else if (pn < 14) { dst = ga; ld = 2048; tc = (pn - 6) * 256; sg = true; }
            else { dst = gp; ld = 2048; tc = (pn - 14) * 256; sg = true; }
        } else {
            if (pn < 4) { dst = iq; ld = 1024; tc = pn * 256; }
            else { dst = pl; ld = 1024; tc = (pn - 5) * 256; }
        }
        const int col0 = tc + wc * 32 + 8 * fq;
#pragma unroll
        for (int ai = 0; ai < 2; ++ai)
#pragma unroll
            for (int m = 0; m < 4; ++m) { bf16_t* rowp = dst + (size_t)(row0 + ai * 128 + m * 16) * ld + col0;
#pragma unroll
                for (int bj = 0; bj < 2; ++bj) { f32x4 v0 = acc[ai][bj][m][0], v1 = acc[ai][bj][m][1];
                    if (sg) {
#pragma unroll
                        for (int j = 0; j < 4; ++j) { v0[j] = sigmoidf_(v0[j]); v1[j] = sigmoidf_(v1[j]); } }
                    *(u32x4*)(rowp + bj * 128) = pack8(v0, v1); } }
    }
};
struct EpiBf16Scale {
    static constexpr bool PERM = true, MID = false;
    bf16_t* O; int ldc; const float* cs;
    __device__ __forceinline__ void operator()(const AccT& acc, const Unit& u, int wr, int wc, int fr, int fq) const {
        const int row0 = u.pm * 256 + wr * 64 + fr, col0 = u.pn * 256 + wc * 32 + 8 * fq;
        f32x4 s[2][2];
#pragma unroll
        for (int bj = 0; bj < 2; ++bj)
#pragma unroll
            for (int n = 0; n < 2; ++n) s[bj][n] = cs ? *(const f32x4*)(cs + col0 + bj * 128 + 4 * n) : (f32x4){1.f, 1.f, 1.f, 1.f};
#pragma unroll
        for (int ai = 0; ai < 2; ++ai)
#pragma unroll
            for (int m = 0; m < 4; ++m) { bf16_t* rowp = O + (size_t)(row0 + ai * 128 + m * 16) * ldc + col0;
#pragma unroll
                for (int bj = 0; bj < 2; ++bj) *(u32x4*)(rowp + bj * 128) = pack8(acc[ai][bj][m][0] * s[bj][0], acc[ai][bj][m][1] * s[bj][1]); }
    }
};
struct EpiF8Scale {
    static constexpr bool PERM = true, MID = false;
    unsigned char* O; int ldc; const float* cs;
    __device__ __forceinline__ void operator()(const AccT& acc, const Unit& u, int wr, int wc, int fr, int fq) const {
        const int row0 = u.pm * 256 + wr * 64 + fr, col0 = u.pn * 256 + wc * 32 + 8 * fq;
        f32x4 s[2][2];
#pragma unroll
        for (int bj = 0; bj < 2; ++bj)
#pragma unroll
            for (int n = 0; n < 2; ++n) s[bj][n] = *(const f32x4*)(cs + col0 + bj * 128 + 4 * n);
#pragma unroll
        for (int ai = 0; ai < 2; ++ai)
#pragma unroll
            for (int m = 0; m < 4; ++m) { unsigned char* rowp = O + (size_t)(row0 + ai * 128 + m * 16) * ldc + col0;
#pragma unroll
                for (int bj = 0; bj < 2; ++bj) *(u32x2*)(rowp + bj * 128) = pack8_fp8(acc[ai][bj][m][0] * s[bj][0], acc[ai][bj][m][1] * s[bj][1]); }
    }
};
template <bool ADD> struct EpiGate {
    static constexpr bool PERM = true, MID = false;
    bf16_t* O; const bf16_t* gate;
    __device__ __forceinline__ void operator()(const AccT& acc, const Unit& u, int wr, int wc, int fr, int fq) const {
        const int row0 = u.pm * 256 + wr * 64 + fr, col0 = u.pn * 256 + wc * 32 + 8 * fq;
#pragma unroll
        for (int ai = 0; ai < 2; ++ai)
#pragma unroll
            for (int m = 0; m < 4; ++m) { const size_t off = (size_t)(row0 + ai * 128 + m * 16) * 2048 + col0;
#pragma unroll
                for (int bj = 0; bj < 2; ++bj) { f32x4 g0, g1; unpack8(*(const u32x4*)(gate + off + bj * 128), g0, g1);
                    f32x4 r0 = g0 * acc[ai][bj][m][0], r1 = g1 * acc[ai][bj][m][1];
                    if (ADD) { f32x4 o0, o1; unpack8(*(const u32x4*)(O + off + bj * 128), o0, o1); r0 += o0; r1 += o1; }
                    *(u32x4*)(O + off + bj * 128) = pack8(r0, r1); } }
    }
};
struct EpiMerge {
    static constexpr bool PERM = true, MID = true;
    unsigned char* O; const bf16_t* ga; const bf16_t* gp;
    __device__ __forceinline__ void mid(AccT& acc, const Unit& u, int wr, int wc, int fr, int fq) const {
        const auto ra = __builtin_amdgcn_make_buffer_rsrc((void*)ga, 0, 0x7FFFFFFF, 0x00020000), rp = __builtin_amdgcn_make_buffer_rsrc((void*)gp, 0, 0x7FFFFFFF, 0x00020000);
        const int voff = ((wr * 64 + fr) * 2048 + wc * 32 + 8 * fq) * 2;
        const int sbase = (u.pm * 256 * 2048 + u.pn * 256) * 2;
#pragma unroll
        for (int ai = 0; ai < 2; ++ai)
#pragma unroll
            for (int m = 0; m < 4; ++m)
#pragma unroll
                for (int bj = 0; bj < 2; ++bj) { const int so = sbase + ((ai * 128 + m * 16) * 2048 + bj * 128) * 2;
                    const u32x4 wa = __builtin_bit_cast(u32x4, __builtin_amdgcn_raw_buffer_load_b128(ra, voff, so, 0)), wp = __builtin_bit_cast(u32x4, __builtin_amdgcn_raw_buffer_load_b128(rp, voff, so, 0));
                    f32x4 a0, a1, p0, p1; unpack8(wa, a0, a1); unpack8(wp, p0, p1);
#pragma unroll
                    for (int j = 0; j < 4; ++j) { acc[ai][bj][m][0][j] *= a0[j] * __builtin_amdgcn_rcpf(p0[j]); acc[ai][bj][m][1][j] *= a1[j] * __builtin_amdgcn_rcpf(p1[j]); }
                    asm volatile("" : "+v"(acc[ai][bj][m][0]), "+v"(acc[ai][bj][m][1]) :: "memory"); }
    }
    __device__ __forceinline__ void operator()(const AccT& acc, const Unit& u, int wr, int wc, int fr, int fq) const {
        const int row0 = u.pm * 256 + wr * 64 + fr, col0 = u.pn * 256 + wc * 32 + 8 * fq;
#pragma unroll
        for (int ai = 0; ai < 2; ++ai)
#pragma unroll
            for (int m = 0; m < 4; ++m) { const size_t off = (size_t)(row0 + ai * 128 + m * 16) * 2048 + col0;
#pragma unroll
                for (int bj = 0; bj < 2; ++bj) { f32x4 p0, p1; unpack8(*(const u32x4*)(gp + off + bj * 128), p0, p1);
                    *(u32x2*)(O + off + bj * 128) = pack8_fp8(p0 * acc[ai][bj][m][0], p1 * acc[ai][bj][m][1]); } }
    }
};
struct EpiResid {
    static constexpr bool PERM = false, MID = false;
    const float* x; float* out; const float* gt;
    __device__ __forceinline__ void operator()(const AccT& acc, const Unit& u, int wr, int wc, int fr, int fq) const {
        const int row0 = u.pm * 256 + wr * 64 + fr, col0 = u.pn * 256 + wc * 32 + 4 * fq;
        const float* gtb = gt + (size_t)(u.pm / 16) * 12288;
        f32x4 g[2][2];
#pragma unroll
        for (int bj = 0; bj < 2; ++bj)
#pragma unroll
            for (int n = 0; n < 2; ++n) g[bj][n] = *(const f32x4*)(gtb + col0 + bj * 128 + n * 16);
#pragma unroll
        for (int ai = 0; ai < 2; ++ai)
#pragma unroll
            for (int m = 0; m < 4; ++m) { const size_t off = (size_t)(row0 + ai * 128 + m * 16) * 2048 + col0;
#pragma unroll
                for (int bj = 0; bj < 2; ++bj)
#pragma unroll
                    for (int n = 0; n < 2; ++n) { const f32x4 xv = *(const f32x4*)(x + off + bj * 128 + n * 16);
                        *(f32x4*)(out + off + bj * 128 + n * 16) = xv + g[bj][n] * acc[ai][bj][m][n]; } }
    }
};
struct EpiF32 {
    static constexpr bool PERM = false, MID = false;
    float* C; int ldc;
    __device__ __forceinline__ void operator()(const AccT& acc, const Unit& u, int wr, int wc, int fr, int fq) const {
        const int row0 = u.pm * 256 + wr * 64 + fr, col0 = u.pn * 256 + wc * 32 + 4 * fq;
#pragma unroll
        for (int ai = 0; ai < 2; ++ai)
#pragma unroll
            for (int m = 0; m < 4; ++m) { float* rowp = C + (size_t)(row0 + ai * 128 + m * 16) * ldc + col0;
#pragma unroll
                for (int bj = 0; bj < 2; ++bj)
#pragma unroll
                    for (int n = 0; n < 2; ++n) *(f32x4*)(rowp + bj * 128 + n * 16) = acc[ai][bj][m][n]; }
    }
};

struct Args { const float* in[19]; float* out; unsigned char* ws; int ph_lo, ph_hi; int li, pad; };
struct Frame {
    unsigned char* lds; unsigned char* ws;
    int tid, lane, wave, G, bid;
    const float *x, *c, *w_ada, *b_ada, *g1, *g2, *w_in, *g_q, *g_k, *rel_bias, *pool_w, *pool_scale, *w_ab, *w_pb, *w_out, *w_pq, *peer_keys, *peer_u, *peer_v;
    float* out;
};

template <bool F8OUT = false, class Fn> __device__ __forceinline__ void transpose_item(const float* W, int K, int N, void* WTv, int ldk, int drow0, int k0, float* scr, int lane, Fn srccol, float mul = 1.0f) {
    const int sc = srccol(drow0 + (lane & 31));
#pragma unroll 8
    for (int i = 0; i < 32; ++i) { const int kk = 2 * i + (lane >> 5); scr[kk * 33 + (lane & 31)] = sc >= 0 ? W[(size_t)(k0 + kk) * N + sc] * mul : 0.f; }
    asm volatile("s_waitcnt lgkmcnt(0)" ::: "memory");
    const int c = lane & 7;
#pragma unroll
    for (int j = 0; j < 4; ++j) { const int n = (lane >> 3) + 8 * j; const float* s = scr + (8 * c) * 33 + n;
        if constexpr (F8OUT) { *(u32x2*)((unsigned char*)WTv + (size_t)(drow0 + n) * ldk + k0 + 8 * c) = pack8_fp8((f32x4){s[0 * 33], s[1 * 33], s[2 * 33], s[3 * 33]}, (f32x4){s[4 * 33], s[5 * 33], s[6 * 33], s[7 * 33]}); }
        else { u32x4 o; o.x = cvt_pk_bf16(s[0 * 33], s[1 * 33]); o.y = cvt_pk_bf16(s[2 * 33], s[3 * 33]); o.z = cvt_pk_bf16(s[4 * 33], s[5 * 33]); o.w = cvt_pk_bf16(s[6 * 33], s[7 * 33]);
            *(u32x4*)((bf16_t*)WTv + (size_t)(drow0 + n) * ldk + k0 + 8 * c) = o; } }
    asm volatile("s_waitcnt lgkmcnt(0)" ::: "memory");
}
__device__ __forceinline__ void phase0_prep(Frame& F) {
    F.lane = lane_now(); F.tid = F.wave * 64 + F.lane;
    const int gw = F.bid * 8 + F.wave, NGW = F.G * 8;
    float* scr = (float*)(F.lds + F.wave * 16384);
    constexpr int I_IN16 = (2304 / 32) * (DM / 64), I_IN8 = (5632 / 32) * (DM / 64);
    constexpr int I_AB = (2048 / 32) * (1024 / 64), I_OUT = (2048 / 32) * (2048 / 64), I_PW = 4 * 8 * 4;
    constexpr int NIT = I_IN16 + I_IN8 + 2 * I_AB + 2 * I_OUT + I_PW;
    auto ident = [](int j) { return j; };
    for (int it = gw; it < NIT; it += NGW) {
        int r = it;
        if (r < I_IN16) { const int nb = r % 72, kb = r / 72;
            transpose_item(F.w_in, DM, INW, F.ws + WS_WIN16, DM, nb * 32, kb * 64, scr, F.lane, [](int j) { return j < 1104 ? j + 1536 : (j < 1280 ? -1 : j + 1360); }); continue; }
        r -= I_IN16;
        if (r < I_IN8) { const int nb = r % 176, kb = r / 176;
            transpose_item<true>(F.w_in, DM, INW, F.ws + WS_WIN8, DM, nb * 32, kb * 64, scr, F.lane, [](int j) { return j < 1536 ? j : j + 2128; }, 16.0f); continue; }
        r -= I_IN8;
        if (r < I_AB) { transpose_item<true>(F.w_ab, 1024, 2048, F.ws + WS_WAB, 1024, (r % 64) * 32, (r / 64) * 64, scr, F.lane, ident, 16.0f); continue; }
        r -= I_AB;
        if (r < I_AB) { transpose_item<true>(F.w_pb, 1024, 2048, F.ws + WS_WPB, 1024, (r % 64) * 32, (r / 64) * 64, scr, F.lane, ident, 16.0f); continue; }
        r -= I_AB;
        if (r < I_OUT) { transpose_item<true>(F.w_out, 2048, 2048, F.ws + WS_WOUT, 2048, (r % 64) * 32, (r / 64) * 64, scr, F.lane, ident, 16.0f); continue; }
        r -= I_OUT;
        if (r < I_OUT) { transpose_item(F.w_pq, 2048, 2048, (bf16_t*)(F.ws + WS_WPQ), 2048, (r % 64) * 32, (r / 64) * 64, scr, F.lane, ident); continue; }
        r -= I_OUT;
        { const int g = r / 32, q = r % 32, nb = q % 8, kb = q / 8;
          transpose_item(F.pool_w + (size_t)g * 65536, 256, 256, (bf16_t*)(F.ws + WS_POOLW) + (size_t)g * 65536, 256, nb * 32, kb * 64, scr, F.lane, ident); }
    }
    {
        bf16_t* kb = (bf16_t*)(F.ws + WS_KEYSBD);
        for (int i = F.bid * 512 + F.tid; i < 2048 * 32; i += F.G * 512) {
            const int row = i / 32, k8 = (i % 32) * 8, p = (row >> 7) & 1;
            u32x4 o = (u32x4){0u, 0u, 0u, 0u};
            if ((k8 >> 7) == p) { const float* s = F.peer_keys + (size_t)row * 128 + (k8 & 127); const f32x4 a = *(const f32x4*)s, b = *(const f32x4*)(s + 4); o = pack8(a, b); }
            *(u32x4*)(kb + (size_t)row * 256 + k8) = o;
        }
    }
    {
        unsigned char* pu = F.ws + WS_PU;
        for (size_t i = (size_t)F.bid * 512 + F.tid; i < (size_t)NEXP * 64; i += (size_t)F.G * 512) {
            const float* src = F.peer_u + i * 32;
            u32x16 pk;
#pragma unroll
            for (int k = 0; k < 8; ++k) { const f32x4 a = *(const f32x4*)(src + k * 4) * 96.0f; pk[2 * k] = cvt_pk_bf16(a[0], a[1]); pk[2 * k + 1] = cvt_pk_bf16(a[2], a[3]); }
            const u32x6 p6 = __builtin_amdgcn_cvt_scalef32_pk32_fp6_bf16(__builtin_bit_cast(bf16x32, pk), 1.0f);
            const int ci = (int)(i & 63), lp = (ci >> 2) + 16 * (ci & 3);
            unsigned char* dst = pu + (i >> 6) * 1536;
            *(u32x4*)(dst + lp * 16) = (u32x4){p6[0], p6[1], p6[2], p6[3]}; *(u32x2*)(dst + 1024 + lp * 8) = (u32x2){p6[4], p6[5]};
        }
        unsigned char* pv = F.ws + WS_PV;
        for (int it = gw; it < (NEXP / 64) * 128; it += NGW) {
            const int e = (it >> 7) * 64 + F.lane, ch = it & 127;
            u32x4 ov;
#pragma unroll
            for (int k = 0; k < 4; ++k) { const f32x4 c = *(const f32x4*)(F.peer_v + (size_t)e * DM + ch * 16 + k * 4) * 4.0f;
                int wv = __builtin_amdgcn_cvt_pk_fp8_f32(c[0], c[1], 0, false); wv = __builtin_amdgcn_cvt_pk_fp8_f32(c[2], c[3], wv, true); ov[k] = (unsigned)wv; }
            *(u32x2*)(pv + ((size_t)(2 * ch) * NEXP + e) * 8) = (u32x2){ov[0], ov[1]};
            *(u32x2*)(pv + ((size_t)(2 * ch + 1) * NEXP + e) * 8) = (u32x2){ov[2], ov[3]};
        }
    }
    {
        __syncthreads();
        float* cact = (float*)(F.lds + 131072);
        float* red = (float*)F.lds;
        float* mp = (float*)(F.ws + WS_MODP);
        for (int it = F.bid; it < 48 * 4; it += F.G) {
            const int cb = it % 48, ds = it / 48, d0 = ds * 512;
            for (int i = F.tid; i < 8 * 512; i += 512) { const int b = i >> 9, d = i & 511; const float cv = F.c[b * DM + d0 + d]; cact[i] = cv * sigmoidf_(cv); }
            __syncthreads();
            f32x4 a[8];
#pragma unroll
            for (int b = 0; b < 8; ++b) a[b] = (f32x4){0.f, 0.f, 0.f, 0.f};
            const float* wp = F.w_ada + (size_t)(d0 + F.wave * 64) * 12288 + cb * 256 + F.lane * 4;
#pragma unroll 4
            for (int d = 0; d < 64; ++d) { const f32x4 w = *(const f32x4*)(wp + (size_t)d * 12288);
#pragma unroll
                for (int b = 0; b < 8; ++b) a[b] += w * cact[b * 512 + F.wave * 64 + d]; }
#pragma unroll
            for (int b = 0; b < 8; ++b)
#pragma unroll
                for (int j = 0; j < 4; ++j) red[(F.wave * 32 + b * 4 + j) * 64 + F.lane] = a[b][j];
            __syncthreads();
            for (int i = F.tid; i < 2048; i += 512) { const int v = i >> 6, l = i & 63; float s = 0.f;
#pragma unroll
                for (int w = 0; w < 8; ++w) s += red[(w * 32 + v) * 64 + l];
                mp[((size_t)ds * 8 + (v >> 2)) * 12288 + cb * 256 + l * 4 + (v & 3)] = s; }
            __syncthreads();
        }
    }
}

template <bool FIRST> __device__ __forceinline__ void phase_modnorm(Frame& F, const float* xin, const float* gain, int off_sh, int off_sc, bf16_t* dst, unsigned char* dst8 = nullptr) {
    F.lane = lane_now(); F.tid = F.wave * 64 + F.lane;
    const float* mp = (const float*)(F.ws + WS_MODP); float* mf = (float*)(F.ws + WS_MODF);
    if (FIRST) {
        for (int i = F.bid * 512 + F.tid; i < 8 * 12288; i += F.G * 512) {
            float s = F.b_ada[i % 12288];
#pragma unroll
            for (int k = 0; k < 4; ++k) s += mp[(size_t)k * 8 * 12288 + i];
            mf[i] = s; }
    }
    float* cA = (float*)F.lds; float* cB = cA + 2048;
    for (int ch = F.bid; ch < MTOK / 128; ch += F.G) {
        const int b = ch / 32;
        __syncthreads();
        for (int col = F.tid; col < 2048; col += 512) {
            float sc, sh;
            if (FIRST) { sc = F.b_ada[off_sc + col]; sh = F.b_ada[off_sh + col];
#pragma unroll
                for (int k = 0; k < 4; ++k) { sc += mp[((size_t)k * 8 + b) * 12288 + off_sc + col]; sh += mp[((size_t)k * 8 + b) * 12288 + off_sh + col]; } }
            else { sc = mf[b * 12288 + off_sc + col]; sh = mf[b * 12288 + off_sh + col]; }
            cA[col] = gain[col] * (1.f + sc); cB[col] = sh; }
        __syncthreads();
        for (int r = F.wave; r < 128; r += 8) {
            const size_t row = (size_t)ch * 128 + r;
            const float* xr = xin + row * 2048 + F.lane * 8;
            f32x4 v[4][2]; float ss = 0.f;
#pragma unroll
            for (int i = 0; i < 4; ++i) { v[i][0] = *(const f32x4*)(xr + i * 512); v[i][1] = *(const f32x4*)(xr + i * 512 + 4);
#pragma unroll
                for (int j = 0; j < 4; ++j) ss += v[i][0][j] * v[i][0][j] + v[i][1][j] * v[i][1][j]; }
            ss = wave_sum(ss);
            const float rinv = 1.0f / sqrtf(ss * (1.0f / 2048.0f) + EPS);
#pragma unroll
            for (int i = 0; i < 4; ++i) { const int col = i * 512 + F.lane * 8;
                const f32x4 a0 = *(const f32x4*)(cA + col), a1 = *(const f32x4*)(cA + col + 4), b0 = *(const f32x4*)(cB + col), b1 = *(const f32x4*)(cB + col + 4);
                const f32x4 y0 = v[i][0] * rinv * a0 + b0, y1 = v[i][1] * rinv * a1 + b1;
                *(u32x4*)(dst + row * 2048 + col) = pack8(y0, y1);
                if (FIRST) *(u32x2*)(dst8 + row * 2048 + col) = pack8_fp8(y0, y1); }
        }
    }
}

__device__ __forceinline__ void phase3_qknorm(Frame& F) {
    F.lane = lane_now(); F.tid = F.wave * 64 + F.lane;
    const bf16_t* q = (const bf16_t*)(F.ws + WS_QN); const bf16_t* k = (const bf16_t*)(F.ws + WS_KN); const bf16_t* v = (const bf16_t*)(F.ws + WS_V);
    unsigned char* q8 = F.ws + WS_Q8; unsigned char* k8 = F.ws + WS_K8; unsigned char* v8 = F.ws + WS_V8;
    const int gw = F.bid * 8 + F.wave, NGW = F.G * 8;
    for (int row = gw; row < MTOK; row += NGW) {
#pragma unroll
        for (int i = 0; i < 2; ++i) { const int ci = i * 64 + F.lane;
            f32x4 a, b; unpack8(*(const u32x4*)(q + (size_t)row * 1024 + ci * 8), a, b);
            float ss = a[0] * a[0] + a[1] * a[1] + a[2] * a[2] + a[3] * a[3] + b[0] * b[0] + b[1] * b[1] + b[2] * b[2] + b[3] * b[3];
            ss = row_sum16(ss);
            const float rinv = 1.0f / sqrtf(ss * (1.0f / 128.0f) + EPS);
            const float* gp = F.g_q + (ci & 15) * 8; const f32x4 g0 = *(const f32x4*)gp, g1 = *(const f32x4*)(gp + 4);
            *(u32x2*)(q8 + (size_t)row * 1024 + ci * 8) = pack8_fp8(a * rinv * g0, b * rinv * g1); }
        { const int ci = F.lane & 31; const bool isk = F.lane < 32;
            f32x4 a, b; unpack8(*(const u32x4*)((isk ? k : v) + (size_t)row * 256 + ci * 8), a, b);
            float ss = a[0] * a[0] + a[1] * a[1] + a[2] * a[2] + a[3] * a[3] + b[0] * b[0] + b[1] * b[1] + b[2] * b[2] + b[3] * b[3];
            ss = row_sum16(ss);
            const float rinv = isk ? 1.0f / sqrtf(ss * (1.0f / 128.0f) + EPS) : 1.0f;
            const float* gp = F.g_k + (ci & 15) * 8; f32x4 g0 = *(const f32x4*)gp, g1 = *(const f32x4*)(gp + 4);
            if (!isk) { g0 = (f32x4){1.f, 1.f, 1.f, 1.f}; g1 = g0; }
            *(u32x2*)((isk ? k8 : v8) + (size_t)row * 256 + ci * 8) = pack8_fp8(a * rinv * g0, b * rinv * g1); }
    }
}
template <int W> __device__ __forceinline__ void pooled_item(const bf16_t* pl, bf16_t* po, int row, int c8) {
    const int t = row & (SEQ - 1);
    f32x4 s0 = (f32x4){0.f, 0.f, 0.f, 0.f}, s1 = s0, x0 = s0, x1 = s0;
    u32x4 v[W];
#pragma unroll
    for (int j = 0; j < W; ++j) v[j] = *(const u32x4*)(pl + (size_t)(row - (j <= t ? j : 0)) * 1024 + c8);
#pragma unroll
    for (int j = 0; j < W; ++j) { f32x4 a, b; unpack8(v[j], a, b); if (j == 0) { x0 = a; x1 = b; } if (j <= t) { s0 += a; s1 += b; } }
    const float inv = 1.0f / (float)((t + 1 < W) ? t + 1 : W);
    *(u32x4*)(po + (size_t)row * 1024 + c8) = pack8(s0 * inv - x0, s1 * inv - x1);
}
__device__ __forceinline__ void phase3_pooled(Frame& F) {
    F.lane = lane_now(); F.tid = F.wave * 64 + F.lane;
    const bf16_t* pl = (const bf16_t*)(F.ws + WS_PL); bf16_t* po = (bf16_t*)(F.ws + WS_POOLED);
    const int gw = F.bid * 8 + F.wave, NGW = F.G * 8;
    for (int it = gw; it < (MTOK / 2) * 4; it += NGW) {
        const int g = it & 3, row = (it >> 2) * 2 + (F.lane >> 5), c8 = g * 256 + (F.lane & 31) * 8;
        if (g == 0) pooled_item<2>(pl, po, row, c8); else if (g == 1) pooled_item<4>(pl, po, row, c8); else if (g == 2) pooled_item<8>(pl, po, row, c8); else pooled_item<16>(pl, po, row, c8);
    }
}
typedef float f32x16 __attribute__((ext_vector_type(16)));
__device__ __forceinline__ float wrelu_(float wh, float d, float acc) { return __builtin_fmaf(wh, d, __builtin_fmaf(wh, __builtin_fabsf(d), acc)); }
__device__ __forceinline__ int sel_code(float s, float smin, float scale) { const float c = (s - smin) * scale; return (int)fminf(fmaxf(c, 0.f), 65535.f); }
__device__ __forceinline__ void hist_find(const unsigned* hist, int lane, int K, int& bsel, int& above) {
    const u32x4 h = *(const u32x4*)(hist + lane * 4);
    const int S = (int)(h.x + h.y + h.z + h.w);
    int x = S;
    x += __builtin_amdgcn_update_dpp(0, x, 0x101, 0xF, 0xF, true);
    x += __builtin_amdgcn_update_dpp(0, x, 0x102, 0xF, 0xF, true);
    x += __builtin_amdgcn_update_dpp(0, x, 0x104, 0xF, 0xF, true);
    x += __builtin_amdgcn_update_dpp(0, x, 0x108, 0xF, 0xF, true);
    const int t1 = __builtin_amdgcn_readlane(x, 16), t2 = __builtin_amdgcn_readlane(x, 32), t3 = __builtin_amdgcn_readlane(x, 48);
    const int r = lane >> 4;
    x += (r == 0 ? t1 + t2 + t3 : (r == 1 ? t2 + t3 : (r == 2 ? t3 : 0)));
    const int sufn = x - S;
    const bool mine = (x >= K) && (sufn < K);
    int b = 0, ab = 0;
    { int c = sufn;
      if (c + (int)h.w >= K) { b = 3; ab = c; } else { c += (int)h.w;
      if (c + (int)h.z >= K) { b = 2; ab = c; } else { c += (int)h.z;
      if (c + (int)h.y >= K) { b = 1; ab = c; } else { c += (int)h.y; b = 0; ab = c; } } } }
    const unsigned long long m = __ballot(mine);
    const int src = m ? (int)__builtin_ctzll(m) : 0;
    bsel = __builtin_amdgcn_readlane(lane * 4 + b, src); above = __builtin_amdgcn_readlane(ab, src);
}
__device__ __forceinline__ int mask_prefix(unsigned long long m) { return (int)__builtin_amdgcn_mbcnt_hi((unsigned)(m >> 32), __builtin_amdgcn_mbcnt_lo((unsigned)m, 0u)); }
template <class Fn> __device__ __forceinline__ void sel_sweep(const f32x4* rb4, int n4, int lane, int t, Fn fn) {
    f32x4 cur = rb4[lane];
    for (int c4 = 0; c4 < n4 - 1; ++c4) { const f32x4 nxt = rb4[(c4 + 1) * 64 + lane];
#pragma unroll
        for (int k = 0; k < 4; ++k) fn(cur[k], (c4 * 4 + k) * 64 + lane, true);
        cur = nxt; }
    { const int c4 = n4 - 1;
#pragma unroll
      for (int k = 0; k < 4; ++k) { const int idx = (c4 * 4 + k) * 64 + lane; fn(cur[k], idx, idx <= t); } }
}
template <int MODE = 0> __device__ __forceinline__ void indexer_select(Frame& F, int b, int t, const float* rowbuf, unsigned* hist, float* eqv, int* eqi) {
    unsigned short* selrow = (unsigned short*)(F.ws + (MODE ? WS_R0 : WS_SEL)) + (size_t)(b * SEQ + t) * 256;
    int lane = F.lane; asm volatile("" : "+v"(lane));
    const int nch = t / 64 + 1, n4 = (nch + 3) >> 2;
    const f32x4* rb4 = (const f32x4*)rowbuf;
    float mn = __builtin_huge_valf(), mx = -__builtin_huge_valf();
    sel_sweep(rb4, n4, lane, t, [&](float v, int, bool valid) { mn = valid ? fminf(mn, v) : mn; mx = valid ? fmaxf(mx, v) : mx; });
    mx = xor16_max(row_max16(mx)); { const auto r = __builtin_amdgcn_permlane32_swap(__float_as_uint(mx), __float_as_uint(mx), false, false); mx = fmaxf(__uint_as_float(r[0]), __uint_as_float(r[1])); }
    mn = -mn; mn = xor16_max(row_max16(mn)); { const auto r = __builtin_amdgcn_permlane32_swap(__float_as_uint(mn), __float_as_uint(mn), false, false); mn = -fmaxf(__uint_as_float(r[0]), __uint_as_float(r[1])); }
    const float scale = (mx > mn) ? 65535.0f / (mx - mn) : 0.f;
    *(u32x4*)(hist + lane * 4) = (u32x4){0u, 0u, 0u, 0u};
    sel_sweep(rb4, n4, lane, t, [&](float v, int, bool valid) { if (valid) { if (MODE == 2) ((volatile unsigned*)hist)[sel_code(v, mn, scale) >> 8] = 1u; else atomicAdd(&hist[sel_code(v, mn, scale) >> 8], 1u); } });
    int b1, above1; hist_find(hist, lane, KSEL, b1, above1);
    *(u32x4*)(hist + lane * 4) = (u32x4){0u, 0u, 0u, 0u};
    sel_sweep(rb4, n4, lane, t, [&](float v, int, bool valid) { const int code = sel_code(v, mn, scale); if (valid && (code >> 8) == b1) atomicAdd(&hist[code & 255], 1u); });
    int b2, above2; hist_find(hist, lane, KSEL - above1, b2, above2);
    const int T16 = (b1 << 8) | b2, need = KSEL - above1 - above2, ceq = (int)hist[b2];
    const bool all_eq = (ceq == need), collect = !all_eq && (ceq <= 64);
    const int eq_budget = all_eq ? 0x7fffffff : (collect ? 0 : need);
    int pos = 0, eqseen = 0;
    sel_sweep(rb4, n4, lane, t, [&](float v, int idx, bool valid) {
        const int code = sel_code(v, mn, scale);
        const bool gt = valid && code > T16, eq = valid && code == T16;
        const unsigned long long mg = __ballot(gt);
        const unsigned p = (unsigned)(pos + mask_prefix(mg));
        if (gt && p < (unsigned)KSEL) selrow[p] = (unsigned short)idx;
        pos += __popcll(mg);
        const unsigned long long me = __ballot(eq);
        if (me) {
            const int er = eqseen + mask_prefix(me); const bool te = eq && er < eq_budget;
            if (collect && eq) { eqv[er] = v; eqi[er] = idx; }
            eqseen += __popcll(me);
            const unsigned long long mte = __ballot(te);
            const unsigned pe = (unsigned)(pos + mask_prefix(mte));
            if (te && pe < (unsigned)KSEL) selrow[pe] = (unsigned short)idx;
            pos += __popcll(mte);
        }
    });
    if (collect && lane < ceq) {
        const float sv = eqv[lane]; const int idx = eqi[lane]; int rank = 0;
        for (int m = 0; m < ceq; ++m) { const float ov = eqv[m]; const int oi = eqi[m]; rank += (ov > sv || (ov == sv && oi < idx)) ? 1 : 0; }
        if (rank < need) selrow[KSEL - need + rank] = (unsigned short)idx;
    }
}
__device__ __forceinline__ void indexer_tile(Frame& F, int b, int t0) {
    const bf16_t* iq = (const bf16_t*)(F.ws + WS_IQ); const bf16_t* ik = (const bf16_t*)(F.ws + WS_IK); const float* iw = (const float*)(F.ws + WS_IW);
    int lane = F.lane; asm volatile("" : "+v"(lane));
    const int w = F.wave;
    if (t0 < KSEL) {
        const int t = t0 + w; unsigned short* selrow = (unsigned short*)(F.ws + WS_SEL) + (size_t)(b * SEQ + t) * 256;
#pragma unroll
        for (int p = 0; p < 4; ++p) { const int j = p * 64 + lane; selrow[j] = (unsigned short)(j <= t ? j : 0xFFFF); }
        return;
    }
    float* rowbuf = (float*)F.lds;
    unsigned char* stage = F.lds + 131072;
    const int p = w & 3, kh = w >> 2, hi = lane >> 5, r = lane & 31;
    const size_t qrow = (size_t)b * SEQ + t0 + 2 * p + (r >> 4);
    bf16x8 a[4];
#pragma unroll
    for (int ks = 0; ks < 4; ++ks) a[ks] = *(const bf16x8*)(iq + qrow * 1024 + (r & 15) * 64 + ks * 16 + 8 * hi);
    float wq[2][8];
#pragma unroll
    for (int q = 0; q < 2; ++q)
#pragma unroll
        for (int i = 0; i < 8; ++i) wq[q][i] = 0.5f * iw[((size_t)b * SEQ + t0 + 2 * p + q) * 16 + (i & 3) + 8 * ((i >> 2) & 1) + 4 * hi];
    const int nchunks = (t0 + 7) / 64 + 1, nsteps = (nchunks + 1) >> 1;
    const unsigned char* gsrc = (const unsigned char*)(ik + (size_t)b * SEQ * 64) + F.tid * 16;
    const int skey = F.tid >> 3, sc16 = F.tid & 7, soff = skey * 128 + ((sc16 ^ ((skey >> 1) & 7)) << 4);
    u32x4 sa0 = *(const u32x4*)gsrc, sb0 = sa0, sa1 = sa0, sb1 = sa0;
    sb0 = *(const u32x4*)(gsrc + (size_t)min(1, nchunks - 1) * 8192);
    sa1 = *(const u32x4*)(gsrc + (size_t)min(2, nchunks - 1) * 8192);
    sb1 = *(const u32x4*)(gsrc + (size_t)min(3, nchunks - 1) * 8192);
    __syncthreads();
#if PROBE_IDX != 1 && PROBE_IDX != 5
#define IDX_LD(c) (*(const u32x4*)(gsrc + (size_t)(c) * 8192))
#endif
#define IDX_MMA(SA, SB, ss, D0, D1) do { const int s_ = (ss); unsigned char* sb = stage + (s_ & 1) * 16384; \
        *(u32x4*)(sb + soff) = SA; *(u32x4*)(sb + 8192 + soff) = SB; \
        __syncthreads(); \
        SA = IDX_LD(min(2 * s_ + 4, nchunks - 1)); \
        SB = IDX_LD(min(2 * s_ + 5, nchunks - 1)); \
        _Pragma("unroll") for (int i = 0; i < 16; ++i) { D0[i] = 0.f; D1[i] = 0.f; } \
        _Pragma("unroll") for (int ks = 0; ks < 4; ++ks) { const unsigned char* bp = sb + key * 128 + (((ks * 2 + hi) ^ ((key >> 1) & 7)) << 4); \
            const bf16x8 bf0 = *(const bf16x8*)bp, bf1 = *(const bf16x8*)(bp + 8192); \
            D0 = __builtin_amdgcn_mfma_f32_32x32x16_bf16(a[ks], bf0, D0, 0, 0, 0); D1 = __builtin_amdgcn_mfma_f32_32x32x16_bf16(a[ks], bf1, D1, 0, 0, 0); } } while (0)
#define IDX_RED(ss, D0, D1) do { const int s_ = (ss); float x0_ = 0.f, x1_ = 0.f, y0_ = 0.f, y1_ = 0.f; \
        _Pragma("unroll") for (int i = 0; i < 8; ++i) { x0_ = wrelu_(wq[0][i], D0[i], x0_); x1_ = wrelu_(wq[1][i], D0[8 + i], x1_); y0_ = wrelu_(wq[0][i], D1[i], y0_); y1_ = wrelu_(wq[1][i], D1[8 + i], y1_); } \
        const float scx = swap32_pair(x0_, x1_), scy = swap32_pair(y0_, y1_); \
        *(f32x2*)(rowbuf + (2 * p + hi) * 4096 + ((s_ >> 1) * 64 + key) * 4 + 2 * (s_ & 1)) = (f32x2){scx, scy}; } while (0)
    const int key = kh * 32 + r;
    f32x16 dA0, dA1, dB0, dB1;
#if PROBE_IDX == 1
#define IDX_LD(c) (*(const u32x4*)(gsrc + (size_t)(c) * 8192))
#elif PROBE_IDX == 5
#define IDX_LD(c) SAVED
#endif
#if PROBE_IDX == 1 || PROBE_IDX == 5
    { const u32x4 SAVED = sa0;
    IDX_MMA(sa0, sb0, 0, dA0, dA1);
    for (int s2 = 0; s2 < nsteps; s2 += 2) {
        if (s2 + 1 < nsteps) IDX_MMA(sa1, sb1, s2 + 1, dB0, dB1);
        IDX_RED(s2, dA0, dA1);
        if (s2 + 2 < nsteps) IDX_MMA(sa0, sb0, s2 + 2, dA0, dA1);
        if (s2 + 1 < nsteps) IDX_RED(s2 + 1, dB0, dB1);
    }
    __syncthreads();
    sa0 = *(const u32x4*)gsrc;
    sb0 = *(const u32x4*)(gsrc + (size_t)min(1, nchunks - 1) * 8192);
    sa1 = *(const u32x4*)(gsrc + (size_t)min(2, nchunks - 1) * 8192);
    sb1 = *(const u32x4*)(gsrc + (size_t)min(3, nchunks - 1) * 8192); }
#undef IDX_LD
#define IDX_LD(c) (*(const u32x4*)(gsrc + (size_t)(c) * 8192))
#endif
    IDX_MMA(sa0, sb0, 0, dA0, dA1);
    for (int s2 = 0; s2 < nsteps; s2 += 2) {
        if (s2 + 1 < nsteps) IDX_MMA(sa1, sb1, s2 + 1, dB0, dB1);
        IDX_RED(s2, dA0, dA1);
        if (s2 + 2 < nsteps) IDX_MMA(sa0, sb0, s2 + 2, dA0, dA1);
        if (s2 + 1 < nsteps) IDX_RED(s2 + 1, dB0, dB1);
    }
#undef IDX_MMA
#undef IDX_RED
#undef IDX_LD
    __syncthreads();
    indexer_select(F, b, t0 + w, rowbuf + w * 4096, (unsigned*)(F.lds + 147456) + w * 256, (float*)(F.lds + 155648) + w * 64, (int*)(F.lds + 155648 + 2048) + w * 64);
#if PROBE_IDX >= 2
    indexer_select<PROBE_IDX - 1>(F, b, t0 + w, rowbuf + w * 4096, (unsigned*)(F.lds + 147456) + w * 256, (float*)(F.lds + 155648) + w * 64, (int*)(F.lds + 155648 + 2048) + w * 64);
#endif
}
__device__ __forceinline__ void phase3_indexer(Frame& F) {
    F.lane = lane_now(); F.tid = F.wave * 64 + F.lane;
    volatile LAS unsigned* misc = (volatile LAS unsigned*)((LAS unsigned char*)F.lds + MISC_OFF);
    const unsigned keep0 = misc[0], keep1 = misc[1];
    __syncthreads();
    const int nit = BATCH * (SEQ / 8);
    for (int k = 0;; ++k) {
        const int l = k * F.G + ((k & 1) ? (F.G - 1 - F.bid) : F.bid);
        if (l >= nit) { if (k * F.G >= nit) break; else continue; }
        const int qb = (SEQ / 8 - 1) - (l >> 3), b = l & 7;
        indexer_tile(F, b, qb * 8);
    }
    __syncthreads();
    if (F.tid == 0) { misc[0] = keep0; misc[1] = keep1; }
}

__device__ const unsigned char g_bucket[128] = {0, 1, 2, 3, 4, 5, 6, 7, 8, 9, 10, 11, 12, 13, 14, 15, 16, 16, 16, 17, 17, 18, 18, 18, 19, 19, 19, 20, 20, 20, 20, 21, 21, 21, 21, 22, 22, 22, 22, 22, 23, 23, 23, 23, 23, 23, 24, 24, 24, 24, 24, 24, 25, 25, 25, 25, 25, 25, 25, 26, 26, 26, 26, 26, 26, 26, 26, 27, 27, 27, 27, 27, 27, 27, 27, 27, 27, 28, 28, 28, 28, 28, 28, 28, 28, 28, 28, 29, 29, 29, 29, 29, 29, 29, 29, 29, 29, 29, 29, 30, 30, 30, 30, 30, 30, 30, 30, 30, 30, 30, 30, 30, 30, 31, 31, 31, 31, 31, 31, 31, 31, 31, 31, 31, 31, 31, 31, 31};
__device__ __forceinline__ void at_pv_step(f32x4 (&D0)[8], f32x4 (&D1)[8], const u32x4 (&buf)[8], LAS unsigned char* vwr, LAS unsigned char* ard, LAS unsigned char* brd) {
#pragma unroll
    for (int c = 0; c < 8; ++c) *(LAS u32x4*)(vwr + c * 576) = buf[c];
    const long pb = __builtin_bit_cast(long, __builtin_amdgcn_ds_read_tr8_b64_v2i32((LAS v2i*)brd));
#pragma unroll
    for (int tl = 0; tl < 8; ++tl) { const long va = __builtin_bit_cast(long, __builtin_amdgcn_ds_read_tr8_b64_v2i32((LAS v2i*)(ard + tl * 16))); D0[tl] = __builtin_amdgcn_mfma_f32_16x16x32_fp8_fp8(va, pb, D0[tl], 0, 0, 0); }
#pragma unroll
    for (int tl = 0; tl < 8; ++tl) { const long va = __builtin_bit_cast(long, __builtin_amdgcn_ds_read_tr8_b64_v2i32((LAS v2i*)(ard + 4608 + tl * 16))); D1[tl] = __builtin_amdgcn_mfma_f32_16x16x32_fp8_fp8(va, pb, D1[tl], 0, 0, 0); }
}
__device__ __forceinline__ void phase4_attention(Frame& F) {
    F.lane = lane_now(); F.tid = F.wave * 64 + F.lane;
    const unsigned char* q8 = F.ws + WS_Q8; const unsigned char* k8 = F.ws + WS_K8; const unsigned char* v8 = F.ws + WS_V8;
    const unsigned short* sel = (const unsigned short*)(F.ws + WS_SEL); unsigned char* ao = F.ws + WS_ATTN;
    float* btab = (float*)F.lds;
    __syncthreads();
    for (int i = F.tid; i < 256; i += 512) btab[i] = F.rel_bias[i];
    __syncthreads();
    constexpr int WST = 16512;
    unsigned char* wgp = F.lds + 4096 + F.wave * WST;
    bf16_t* Pb = (bf16_t*)(wgp + 9216); int* idl = (int*)(wgp + 13312); float* psl = (float*)(wgp + 16384); float* pml = psl + 8;
    LAS unsigned char* wl = (LAS unsigned char*)F.lds + 4096 + F.wave * WST;
    const bool xmap = (F.G % 8) == 0;
    const int gw = xmap ? (F.bid / 8) * 8 + F.wave : F.bid * 8 + F.wave, NGW = xmap ? F.G : F.G * 8, nrows = xmap ? SEQ : MTOK;
    for (int rr = gw; rr < nrows; rr += NGW) {
        int lane = F.lane; asm volatile("" : "+v"(lane));
        const int row = xmap ? (F.bid & 7) * SEQ + rr : rr;
        const int b = row / SEQ, t = row % SEQ, r = lane & 31, hi = lane >> 5;
#pragma unroll
        for (int p = 0; p < 4; ++p) { idl[p * 64 + lane] = (int)sel[(size_t)row * 256 + p * 64 + lane]; }
        long a0[8], a1[8];
        { u32x4 qa[4];
#pragma unroll
          for (int i = 0; i < 4; ++i) qa[i] = (r < 8) ? *(const u32x4*)(q8 + (size_t)row * 1024 + r * 128 + hi * 64 + i * 16) : (u32x4){0u, 0u, 0u, 0u};
#pragma unroll
          for (int ks = 0; ks < 8; ++ks) { const unsigned lo = qa[ks >> 1][(ks & 1) * 2], hh = qa[ks >> 1][(ks & 1) * 2 + 1]; const long v = (long)(((unsigned long long)hh << 32) | lo);
              a0[ks] = (r < 4) ? v : 0l; a1[ks] = (r >= 4) ? v : 0l; } }
        f32x4 psum = (f32x4){0.f, 0.f, 0.f, 0.f}, pmax = psum;
        const int vg4 = lane >> 4, vch = lane & 15;
#define AT_LOADK(buf, kb) do { _Pragma("unroll") for (int c = 0; c < 8; ++c) { const int key_ = idl[(kb) * 32 + 4 * c + vg4]; const int kc_ = key_ <= t ? key_ : 0; \
            buf[c] = *(const u32x4*)(k8 + ((size_t)b * SEQ + kc_) * 256 + vch * 16); } } while (0)
#define AT_QK(buf, kb) do { const int key_ = idl[(kb) * 32 + r]; const bool valid_ = key_ <= t; const int kc_ = valid_ ? key_ : 0; \
            _Pragma("unroll") for (int c = 0; c < 8; ++c) *(LAS u32x4*)(wl + (4 * c + vg4) * 272 + vch * 16) = buf[c]; \
            u32x4 g0_[4], g1_[4]; \
            _Pragma("unroll") for (int i = 0; i < 4; ++i) { g0_[i] = *(const LAS u32x4*)(wl + r * 272 + hi * 64 + i * 16); g1_[i] = *(const LAS u32x4*)(wl + r * 272 + 128 + hi * 64 + i * 16); } \
            f32x16 d; _Pragma("unroll") for (int i = 0; i < 16; ++i) d[i] = 0.f; \
            _Pragma("unroll") for (int ks = 0; ks < 8; ++ks) { const long bv_ = (long)(((unsigned long long)g0_[ks >> 1][(ks & 1) * 2 + 1] << 32) | g0_[ks >> 1][(ks & 1) * 2]); d = __builtin_amdgcn_mfma_f32_32x32x16_fp8_fp8(a0[ks], bv_, d, 0, 0, 0); } \
            _Pragma("unroll") for (int ks = 0; ks < 8; ++ks) { const long bv_ = (long)(((unsigned long long)g1_[ks >> 1][(ks & 1) * 2 + 1] << 32) | g1_[ks >> 1][(ks & 1) * 2]); d = __builtin_amdgcn_mfma_f32_32x32x16_fp8_fp8(a1[ks], bv_, d, 0, 0, 0); } \
            const int dist_ = t - kc_; const int bkt_ = dist_ < 128 ? (int)g_bucket[dist_] : 31; \
            const f32x4 bias_ = *(const f32x4*)(btab + bkt_ * 8 + 4 * hi); f32x4 e_; \
            _Pragma("unroll") for (int i = 0; i < 4; ++i) e_[i] = valid_ ? __expf(d[i] * 0.08838834764831845f + bias_[i]) : 0.f; \
            psum += e_; _Pragma("unroll") for (int i = 0; i < 4; ++i) pmax[i] = fmaxf(pmax[i], e_[i]); \
            *(u32x2*)(Pb + ((kb) * 32 + r) * 8 + 4 * hi) = (u32x2){cvt_pk_bf16(e_[0], e_[1]), cvt_pk_bf16(e_[2], e_[3])}; } while (0)
        {
            u32x4 kA[8], kB[8];
            AT_LOADK(kA, 0);
#pragma unroll 1
            for (int kb = 0; kb < 8; kb += 2) {
                AT_LOADK(kB, kb + 1);
                AT_QK(kA, kb);
                if (kb + 2 < 8) AT_LOADK(kA, kb + 2);
                AT_QK(kB, kb + 1);
            }
        }
#undef AT_LOADK
#undef AT_QK
#pragma unroll
        for (int i = 0; i < 4; ++i) { psum[i] = xor16_sum(row_sum16(psum[i])); pmax[i] = xor16_max(row_max16(pmax[i])); }
        if (r == 0) { *(f32x4*)(psl + 4 * hi) = psum; *(f32x4*)(pml + 4 * hi) = pmax; }
        const int kq = lane >> 4, tq = (lane >> 1) & 7, tp = lane & 1;
#define AT_LOADV(buf, ks_) do { _Pragma("unroll") for (int c = 0; c < 8; ++c) { const int key_ = idl[(ks_) * 32 + 4 * c + vg4]; const int kc_ = key_ <= t ? key_ : 0; \
            buf[c] = *(const u32x4*)(v8 + ((size_t)b * SEQ + kc_) * 256 + vch * 16); } } while (0)
        u32x4 vA[8], vB[8];
        AT_LOADV(vA, 0);
        { const f32x4 m0 = *(const f32x4*)pml, m1 = *(const f32x4*)(pml + 4);
          f32x4 r0, r1;
#pragma unroll
          for (int i = 0; i < 4; ++i) { r0[i] = __builtin_amdgcn_rcpf(m0[i]); r1[i] = __builtin_amdgcn_rcpf(m1[i]); }
#pragma unroll
          for (int i = 0; i < 4; ++i) { const int key = i * 64 + lane;
              f32x4 pa, pb; unpack8(*(const u32x4*)(Pb + key * 8), pa, pb);
              *(LAS u32x2*)(wl + 14336 + key * 8) = pack8_fp8(pa * r0, pb * r1); } }
        f32x4 D0[8], D1[8];
#pragma unroll
        for (int tl = 0; tl < 8; ++tl) { D0[tl] = (f32x4){0.f, 0.f, 0.f, 0.f}; D1[tl] = D0[tl]; }
        LAS unsigned char* vwr = wl + (vch >> 3) * 4608 + vg4 * 144 + (vch & 7) * 16;
        LAS unsigned char* ard = wl + (kq * 8 + tq) * 144 + 8 * tp;
        LAS unsigned char* brd = wl + 14336 + (kq * 8 + tq) * 8;
#pragma unroll 1
        for (int ks = 0; ks < 8; ks += 2) {
            AT_LOADV(vB, ks + 1);
            at_pv_step(D0, D1, vA, vwr, ard, brd + ks * 256);
            if (ks + 2 < 8) AT_LOADV(vA, ks + 2);
            at_pv_step(D0, D1, vB, vwr, ard, brd + (ks + 1) * 256);
        }
#undef AT_LOADV
        { const int n = lane & 15, q4 = lane >> 4;
          if (n < 8) { const float sc = pml[n] / psl[n]; const bool g1 = n >= 4;
              unsigned char* op = ao + (size_t)row * 1024 + n * 128 + q4 * 4;
#pragma unroll
              for (int tl = 0; tl < 8; ++tl) { const f32x4 d = (g1 ? D1[tl] : D0[tl]) * sc;
                  int w = __builtin_amdgcn_cvt_pk_fp8_f32(d[0], d[1], 0, false); w = __builtin_amdgcn_cvt_pk_fp8_f32(d[2], d[3], w, true);
                  *(unsigned*)(op + tl * 16) = (unsigned)w; } } }
    }
}

__device__ __forceinline__ float dot16f8(u32x4 w, const float* h) {
    float s = 0.f;
#pragma unroll
    for (int d = 0; d < 4; ++d) { const f32x2 lo = __builtin_amdgcn_cvt_pk_f32_fp8((int)w[d], false), hi = __builtin_amdgcn_cvt_pk_f32_fp8((int)w[d], true);
        s += lo.x * h[4 * d] + lo.y * h[4 * d + 1] + hi.x * h[4 * d + 2] + hi.y * h[4 * d + 3]; }
    return s;
}
__device__ __forceinline__ void fma16f8(u32x4 w, float cf, float* acc) {
#pragma unroll
    for (int d = 0; d < 4; ++d) { const f32x2 lo = __builtin_amdgcn_cvt_pk_f32_fp8((int)w[d], false), hi = __builtin_amdgcn_cvt_pk_f32_fp8((int)w[d], true);
        acc[4 * d] += cf * lo.x; acc[4 * d + 1] += cf * lo.y; acc[4 * d + 2] += cf * hi.x; acc[4 * d + 3] += cf * hi.y; }
}
__device__ __forceinline__ float gelu_erf(float x) { return 0.5f * x * (1.0f + erff(x * 0.70710678118654752f)); }
__device__ __forceinline__ void ce_k(unsigned& a, unsigned& b) { const unsigned hi = a > b ? a : b, lo = a > b ? b : a; a = hi; b = lo; }
__device__ __forceinline__ void ce_kp(unsigned& ka, unsigned& pa, unsigned& kb, unsigned& pb) { const bool sw = kb > ka; const unsigned k0 = sw ? kb : ka, k1 = sw ? ka : kb, p0 = sw ? pb : pa, p1 = sw ? pa : pb; ka = k0; kb = k1; pa = p0; pb = p1; }
__device__ __forceinline__ void bmerge16(unsigned (&x)[16]) {
#pragma unroll
    for (int jj = 0; jj < 4; ++jj) { const int j = 8 >> jj;
#pragma unroll
        for (int i = 0; i < 16; ++i) { const int l = i ^ j; if (l > i) ce_k(x[i], x[l]); }
        __builtin_amdgcn_sched_barrier(0); }
}
__device__ __forceinline__ void bmerge16p(unsigned (&x)[16], unsigned (&p)[16]) {
#pragma unroll
    for (int jj = 0; jj < 4; ++jj) { const int j = 8 >> jj;
#pragma unroll
        for (int i = 0; i < 16; ++i) { const int l = i ^ j; if (l > i) ce_kp(x[i], p[i], x[l], p[l]); }
        __builtin_amdgcn_sched_barrier(0); }
}
__device__ __forceinline__ void bsort16(unsigned (&x)[16]) {
#pragma unroll
    for (int kk = 1; kk <= 4; ++kk) { const int k = 1 << kk;
#pragma unroll
        for (int jj = 0; jj < 4; ++jj) { const int j = (k >> 1) >> jj;
            if (j > 0) {
#pragma unroll
                for (int i = 0; i < 16; ++i) { const int l = i ^ j; if (l > i) { if ((i & k) == 0) ce_k(x[i], x[l]); else ce_k(x[l], x[i]); } }
                __builtin_amdgcn_sched_barrier(0); } } }
}
__device__ __forceinline__ void bsort16p(unsigned (&x)[16], unsigned (&p)[16]) {
#pragma unroll
    for (int kk = 1; kk <= 4; ++kk) { const int k = 1 << kk;
#pragma unroll
        for (int jj = 0; jj < 4; ++jj) { const int j = (k >> 1) >> jj;
            if (j > 0) {
#pragma unroll
                for (int i = 0; i < 16; ++i) { const int l = i ^ j; if (l > i) { if ((i & k) == 0) ce_kp(x[i], p[i], x[l], p[l]); else ce_kp(x[l], p[l], x[i], p[i]); } }
                __builtin_amdgcn_sched_barrier(0); } } }
}
__device__ __forceinline__ void top16_row(const unsigned char* rowp, unsigned (&t)[16]) {
#pragma unroll
    for (int i = 0; i < 16; ++i) t[i] = 0u;
#pragma unroll 1
    for (int g = 0; g < 8; ++g) {
        unsigned w[8];
#pragma unroll
        for (int q = 0; q < 4; ++q) { const u32x2 v = *(const u32x2*)(rowp + g * 32 + q * 8); w[2 * q] = v.x; w[2 * q + 1] = v.y; }
        unsigned sk[16];
#pragma unroll
        for (int d = 0; d < 8; ++d) {
            const unsigned lo = w[d] << 16, hi = w[d];
            const unsigned xl = lo ^ ((unsigned)((int)lo >> 31) | 0x80000000u), xh = hi ^ ((unsigned)((int)hi >> 31) | 0x80000000u);
            sk[2 * d] = ((xl >> 9) & 0xFFFFFF80u) | (unsigned)(127 - (g * 16 + 2 * d));
            sk[2 * d + 1] = ((xh >> 9) & 0xFFFFFF80u) | (unsigned)(127 - (g * 16 + 2 * d + 1)); }
        bsort16(sk);
#pragma unroll
        for (int i = 0; i < 16; ++i) t[i] = t[i] > sk[15 - i] ? t[i] : sk[15 - i];
        bmerge16(t);
    }
}
__device__ __forceinline__ float key_val(unsigned key) { const unsigned y = (key << 9) & 0xFFFF0000u; return __uint_as_float((y ^ (~(unsigned)((int)y >> 31) | 0x80000000u)) & 0xFFFF0000u); }
__device__ __forceinline__ unsigned sum_key(float s, int c) { const unsigned u = __float_as_uint(s); return ((u ^ ((unsigned)((int)u >> 31) | 0x80000000u)) & ~63u) | (unsigned)(63 - c); }
__device__ __forceinline__ float sum_val(unsigned k) { const unsigned y = k & ~63u; return __uint_as_float(y ^ (~(unsigned)((int)y >> 31) | 0x80000000u)); }
typedef __bf16 bf2_t __attribute__((ext_vector_type(2)));
__device__ __forceinline__ float dot2_bf(unsigned a, unsigned b, float c) { return __builtin_amdgcn_fdot2_f32_bf16(__builtin_bit_cast(bf2_t, a), __builtin_bit_cast(bf2_t, b), c, false); }
__device__ __forceinline__ float dot32_f6b(u32x4 wa, u32x2 wb, u32x4 h0, u32x4 h1, u32x4 h2, u32x4 h3) {
    const bf16x32 dec = __builtin_amdgcn_cvt_scalef32_pk32_bf16_fp6((u32x6){wa.x, wa.y, wa.z, wa.w, wb.x, wb.y}, 1.0f);
    const u32x16 ud = __builtin_bit_cast(u32x16, dec);
    float acc = 0.f;
    acc = dot2_bf(ud.s0, h0.x, acc); acc = dot2_bf(ud.s1, h0.y, acc); acc = dot2_bf(ud.s2, h0.z, acc); acc = dot2_bf(ud.s3, h0.w, acc);
    acc = dot2_bf(ud.s4, h1.x, acc); acc = dot2_bf(ud.s5, h1.y, acc); acc = dot2_bf(ud.s6, h1.z, acc); acc = dot2_bf(ud.s7, h1.w, acc);
    acc = dot2_bf(ud.s8, h2.x, acc); acc = dot2_bf(ud.s9, h2.y, acc); acc = dot2_bf(ud.sa, h2.z, acc); acc = dot2_bf(ud.sb, h2.w, acc);
    acc = dot2_bf(ud.sc, h3.x, acc); acc = dot2_bf(ud.sd, h3.y, acc); acc = dot2_bf(ud.se, h3.z, acc); acc = dot2_bf(ud.sf, h3.w, acc);
    return acc;
}
__device__ const unsigned char g_cab[64] = {0, 1, 2, 3, 4, 5, 6, 7, 8, 9, 10, 11, 12, 13, 14, 15, 16, 17, 18, 19, 20, 21, 22, 23, 32, 33, 34, 35, 36, 48, 49, 50, 51, 64, 65, 66, 80, 81, 96, 97, 112, 113, 128, 144, 160, 176, 192, 208, 224, 240, 0, 0, 0, 0, 0, 0, 0, 0, 0, 0, 0, 0, 0, 0};
template <int PMODE = 0> __device__ __forceinline__ void phase10_peer(Frame& F) {
    F.lane = lane_now(); F.tid = F.wave * 64 + F.lane;
    const bf16_t* sub = (const bf16_t*)(F.ws + WS_SUB); const bf16_t* h2 = (const bf16_t*)(F.ws + WS_H2);
    const unsigned char* pu = F.ws + WS_PU; unsigned* pairs = (unsigned*)(F.ws + WS_PAIRS);
    const int gw = F.bid * 8 + F.wave, NGW = F.G * 8;
    unsigned char* wb = F.lds + F.wave * 19200;
    unsigned char* h2b = wb; unsigned short* gl16 = (unsigned short*)(wb + 16896); unsigned* hist = (unsigned*)(wb + 18944); unsigned* base = hist + 32;
    unsigned* tmp = (unsigned*)wb;
    unsigned* wls0 = (unsigned*)(F.ws + WS_WLS) + (size_t)gw * 1024;
    const int ntok = (MTOK - gw + NGW - 1) / NGW;
    constexpr int CA[50] = {0,0,0,0,0,0,0,0,0,0,0,0,0,0,0,0, 1,1,1,1,1,1,1,1, 2,2,2,2,2, 3,3,3,3, 4,4,4, 5,5, 6,6, 7,7, 8,9,10,11,12,13,14,15};
    constexpr int CB[50] = {0,1,2,3,4,5,6,7,8,9,10,11,12,13,14,15, 0,1,2,3,4,5,6,7, 0,1,2,3,4, 0,1,2,3, 0,1,2, 0,1, 0,1, 0,1, 0,0,0,0,0,0,0,0};
    for (int p0 = 0; p0 < ntok; p0 += 8) {
        int lane = F.lane; asm volatile("" : "+v"(lane));
        const int nt = (ntok - p0) < 8 ? (ntok - p0) : 8;
        {
            u32x4 st[16];
#define SEL_LOAD(half) do { asm volatile("" : "+v"(lane)); const int srow_l = lane >> 4, scol = lane & 15; _Pragma("unroll") for (int it = 0; it < 16; ++it) { const int r_ = it * 4 + srow_l; int ti_ = r_ >> 3; ti_ = ti_ < nt ? ti_ : nt - 1; \
                st[it] = *(const u32x4*)(sub + (size_t)(gw + (p0 + ti_) * NGW) * 2048 + (r_ & 7) * 256 + (half) * 128 + scol * 8); } } while (0)
#define SEL_STORE() do { const int srow_l = lane >> 4, scol = lane & 15; _Pragma("unroll") for (int it = 0; it < 16; ++it) { unsigned char* d_ = wb + (it * 4 + srow_l) * 264 + scol * 16; \
                *(u32x2*)d_ = (u32x2){st[it].x, st[it].y}; *(u32x2*)(d_ + 8) = (u32x2){st[it].z, st[it].w}; } } while (0)
            unsigned tA[16], tB[16];
            SEL_LOAD(0); SEL_STORE();
            __builtin_amdgcn_sched_barrier(0);
            top16_row(wb + lane * 264, tA);
            __builtin_amdgcn_sched_barrier(0);
            asm volatile("" : "+v"(tA[0]), "+v"(tA[1]), "+v"(tA[2]), "+v"(tA[3]), "+v"(tA[4]), "+v"(tA[5]), "+v"(tA[6]), "+v"(tA[7]), "+v"(tA[8]), "+v"(tA[9]), "+v"(tA[10]), "+v"(tA[11]), "+v"(tA[12]), "+v"(tA[13]), "+v"(tA[14]), "+v"(tA[15]) :: "memory");
            SEL_LOAD(1); SEL_STORE();
            __builtin_amdgcn_sched_barrier(0);
            top16_row(wb + lane * 264, tB);
            __builtin_amdgcn_sched_barrier(0);
#undef SEL_LOAD
#undef SEL_STORE
            float vA[16], vB[16];
            { unsigned pa[4] = {0u, 0u, 0u, 0u}, pb[4] = {0u, 0u, 0u, 0u};
#pragma unroll
              for (int i = 0; i < 16; ++i) { vA[i] = key_val(tA[i]); vB[i] = key_val(tB[i]); pa[i >> 2] |= (127u - (tA[i] & 127u)) << (8 * (i & 3)); pb[i >> 2] |= (127u - (tB[i] & 127u)) << (8 * (i & 3)); }
              unsigned char* rp = wb + lane * 264;
              *(u32x2*)rp = (u32x2){pa[0], pa[1]}; *(u32x2*)(rp + 8) = (u32x2){pa[2], pa[3]}; *(u32x2*)(rp + 16) = (u32x2){pb[0], pb[1]}; *(u32x2*)(rp + 24) = (u32x2){pb[2], pb[3]}; }
            unsigned tk[16];
#pragma unroll
            for (int c = 0; c < 16; ++c) tk[c] = sum_key(vA[CA[c]] + vB[CB[c]], c);
            bsort16(tk);
#pragma unroll
            for (int grp = 1; grp < 3; ++grp) {
                unsigned sk[16];
#pragma unroll
                for (int e = 0; e < 16; ++e) { const int c = grp * 16 + e; sk[e] = sum_key(vA[CA[c]] + vB[CB[c]], c); }
                bsort16(sk);
#pragma unroll
                for (int i = 0; i < 16; ++i) tk[i] = tk[i] > sk[15 - i] ? tk[i] : sk[15 - i];
                bmerge16(tk);
            }
#pragma unroll
            for (int c = 48; c < 50; ++c) { unsigned k = sum_key(vA[CA[c]] + vB[CB[c]], c);
#pragma unroll
                for (int i = 0; i < 16; ++i) ce_k(tk[i], k); }
            const float s0 = sum_val(tk[0]); float ev[16], esum = 0.f;
#pragma unroll
            for (int r = 0; r < 16; ++r) { ev[r] = __expf(sum_val(tk[r]) - s0); esum += ev[r]; }
            const float einv = 1.0f / esum;
            unsigned eid[16];
            { const unsigned char* rp = wb + lane * 264;
#pragma unroll
              for (int r = 0; r < 16; ++r) { const unsigned cab = g_cab[63u - (tk[r] & 63u)]; eid[r] = (unsigned)rp[cab >> 4] * 128u + (unsigned)rp[16 + (cab & 15u)]; } }
            if ((lane >> 3) < nt) {
#pragma unroll
                for (int r = 0; r < 16; ++r) { const int e = lane * 16 + r; tmp[e] = ((unsigned)e << 14) | eid[r]; gl16[e] = (unsigned short)(cvt_pk_bf16(ev[r] * einv, 0.f) & 0xffffu); } }
        }
        asm volatile("" : "+v"(lane));
        const int ne = nt * 128;
        {
            if (lane < 32) hist[lane] = 0u;
            unsigned ent[16]; unsigned rk[16];
#pragma unroll
            for (int q = 0; q < 16; ++q) { const int e = q * 64 + lane; ent[q] = (e < ne) ? tmp[e] : 0u; rk[q] = (e < ne) ? atomicAdd(&hist[(ent[q] & 0x3FFFu) >> 9], 1u) : 0u; }
            { int hv = lane < 32 ? (int)hist[lane] : 0; int x = hv;
              x += __builtin_amdgcn_update_dpp(0, x, 0x111, 0xF, 0xF, true); x += __builtin_amdgcn_update_dpp(0, x, 0x112, 0xF, 0xF, true);
              x += __builtin_amdgcn_update_dpp(0, x, 0x114, 0xF, 0xF, true); x += __builtin_amdgcn_update_dpp(0, x, 0x118, 0xF, 0xF, true);
              const int t0 = __builtin_amdgcn_readlane(x, 15); if (lane >= 16) x += t0;
              if (lane < 32) base[lane] = (unsigned)(x - hv); }
#pragma unroll
            for (int q = 0; q < 16; ++q) { const int e = q * 64 + lane; if (e < ne) wls0[base[(ent[q] & 0x3FFFu) >> 9] + rk[q]] = ent[q]; }
        }
        asm volatile("s_waitcnt vmcnt(0)" ::: "memory");
        asm volatile("" : "+v"(lane));
#pragma unroll 1
        for (int i = 0; i < nt; ++i) { const bf16_t* hr = h2 + (size_t)(gw + (p0 + i) * NGW) * 2048 + lane * 32;
            f32x4 v[8]; float m = 0.f;
#pragma unroll
            for (int q = 0; q < 4; ++q) { unpack8(*(const u32x4*)(hr + q * 8), v[2 * q], v[2 * q + 1]); }
#pragma unroll
            for (int q = 0; q < 8; ++q)
#pragma unroll
                for (int k = 0; k < 4; ++k) m = fmaxf(m, __builtin_fabsf(v[q][k]));
            int sb = (int)((__float_as_uint(m * 1.0666667f) >> 23) & 0xFFu) - 2; sb = sb < 1 ? 1 : (sb > 253 ? 253 : sb);
            const float inv = __uint_as_float((unsigned)(254 - sb) << 23);
            u32x16 pk;
#pragma unroll
            for (int q = 0; q < 8; ++q) { const f32x4 a = v[q] * inv; pk[2 * q] = cvt_pk_bf16(a[0], a[1]); pk[2 * q + 1] = cvt_pk_bf16(a[2], a[3]); }
            const u32x6 p6 = __builtin_amdgcn_cvt_scalef32_pk32_fp6_bf16(__builtin_bit_cast(bf16x32, pk), 1.0f);
            const int lp = (lane >> 2) + 16 * (lane & 3);
            *(u32x4*)(h2b + i * 2048 + lp * 16) = (u32x4){p6[0], p6[1], p6[2], p6[3]};
            *(u32x4*)(h2b + i * 2048 + 1024 + lp * 16) = (u32x4){p6[4], p6[5], (unsigned)sb, 0u}; }
        if (PMODE != 1) {
            const int dg = lane >> 4, dc = lane & 15;
            const bool dv = (dc >> 2) == dg; const int dr = dc & 3;
            const float w0 = (dv && dr == 0) ? 1.f : 0.f, w1 = (dv && dr == 1) ? 1.f : 0.f, w2 = (dv && dr == 2) ? 1.f : 0.f, w3 = (dv && dr == 3) ? 1.f : 0.f;
            unsigned entn = __hip_atomic_load(wls0 + lane, __ATOMIC_RELAXED, __HIP_MEMORY_SCOPE_AGENT);
#define U_LOAD(WA, WB, srcent, i0_) do { _Pragma("unroll") for (int jj = 0; jj < 8; ++jj) { const unsigned en_ = (unsigned)__builtin_amdgcn_readlane((int)(srcent), (i0_) + jj); \
                const unsigned char* ur = pu + (size_t)(en_ & 0x3FFFu) * 1536; WA[jj] = *(const u32x4*)(ur + lane * 16); WB[jj] = *(const u32x2*)(ur + 1024 + lane * 8); } } while (0)
#define U_COMP(WA, WB, i0_) do { float pr[8]; \
                _Pragma("unroll") for (int jj = 0; jj < 8; ++jj) { const unsigned en_ = (unsigned)__builtin_amdgcn_readlane((int)ent64, (i0_) + jj); const unsigned char* hp = h2b + ((en_ >> 21) & 7u) * 2048 + lane * 16; \
                    const u32x4 b0 = *(const u32x4*)hp, b1 = *(const u32x4*)(hp + 1024); \
                    const pg8::i32x8 A = (pg8::i32x8){(int)WA[jj].x, (int)WA[jj].y, (int)WA[jj].z, (int)WA[jj].w, (int)WB[jj].x, (int)WB[jj].y, 0, 0}; \
                    const pg8::i32x8 B = (pg8::i32x8){(int)b0.x, (int)b0.y, (int)b0.z, (int)b0.w, (int)b1.x, (int)b1.y, 0, 0}; \
                    const f32x4 D = __builtin_amdgcn_mfma_scale_f32_16x16x128_f8f6f4(A, B, (f32x4){0.f, 0.f, 0.f, 0.f}, 2  , 2  , 0, 0x7F7F7F7F, 0, (int)b1.z); \
                    pr[jj] = w0 * D[0] + w1 * D[1] + w2 * D[2] + w3 * D[3]; } \
                  \
                _Pragma("unroll") for (int i = 0; i < 4; ++i) pr[i] = swap32_pair(pr[i], pr[i + 4]); \
                _Pragma("unroll") for (int i = 0; i < 2; ++i) pr[i] = swap16_pair(pr[i], pr[i + 2]); \
                const bool b3 = (lane & 8) != 0; \
                { const float snd = b3 ? pr[0] : pr[1], kp = b3 ? pr[1] : pr[0]; pr[0] = kp + dpp_f<DPP_ROR8>(snd); } \
                float tot = pr[0]; tot += dpp_f<DPP_XOR1>(tot); tot += dpp_f<DPP_XOR2>(tot); tot += dpp_f<DPP_HMIRROR>(tot); \
                keep = ((lane & 7) == ((i0_) >> 3)) ? tot : keep;           \
            } while (0)
            u32x4 wA0[8], wA1[8]; u32x2 wB0[8], wB1[8];
            U_LOAD(wA0, wB0, entn, 0);
#pragma unroll 1
            for (int c = 0; c < ne; c += 64) {
                const unsigned ent64 = entn;
                const bool more = c + 64 < ne;
                if (more) entn = __hip_atomic_load(wls0 + c + 64 + lane, __ATOMIC_RELAXED, __HIP_MEMORY_SCOPE_AGENT);
                float keep = 0.f;
#pragma unroll 1
                for (int i0 = 0; i0 < 64; i0 += 16) {
                    U_LOAD(wA1, wB1, ent64, i0 + 8);
                    U_COMP(wA0, wB0, i0);
                    if (i0 + 16 < 64) U_LOAD(wA0, wB0, ent64, i0 + 16); else if (more) U_LOAD(wA0, wB0, entn, 0);
                    U_COMP(wA1, wB1, i0 + 8);
                }
                {
                    const unsigned em = (unsigned)__shfl((int)ent64, 8 * (lane & 7) + (lane >> 3));
                    const int ti = (int)(em >> 21), j = (int)((em >> 14) & 127u), row = gw + (p0 + ti) * NGW;
                    const float cf = gelu_erf(keep * (1.0f / 96.0f)) * __uint_as_float((unsigned)gl16[(em >> 14) & 1023u] << 16);
                    pairs[((size_t)(row >> 6) * 128 + j) * 64 + (row & 63)] = (((unsigned)__builtin_bit_cast(unsigned short, (_Float16)cf) << 16) & 0xFFFE0000u) | ((em & 0x3FFFu) << 3);
                }
            }
#undef U_LOAD
#undef U_COMP
        }
    }
}

__device__ __forceinline__ void phase11_peer_v(Frame& F, float* dst) {
    F.lane = lane_now(); F.tid = F.wave * 64 + F.lane;
    const unsigned* pairs = (const unsigned*)(F.ws + WS_PAIRS); const float* mf = (const float*)(F.ws + WS_MODF);
    unsigned long long* vs = (unsigned long long*)F.lds;
    for (int c0 = F.bid; c0 < DM / 8; c0 += F.G) {
        const int c = (c0 & 7) * 32 + (c0 >> 3);
        __syncthreads();
        { const u32x4* src = (const u32x4*)(F.ws + WS_PV + (size_t)c * NEXP * 8);
#pragma unroll 4
          for (int i = F.tid; i < NEXP * 8 / 16; i += 512) *(LAS u32x4*)(unsigned long long)(unsigned)(i * 16) = src[i]; }
        __syncthreads();
        typedef __fp16 h2_t __attribute__((__vector_size__(2 * sizeof(__fp16))));
#define P11_LOAD(dst, ptr) do { _Pragma("unroll") for (int jj = 0; jj < 16; ++jj) dst[jj] = (ptr)[jj * 64]; } while (0)
#define P11_FMA(A, X, C) asm("v_pk_fma_f16 %0, %1, %2, %0 op_sel:[0,1,0] op_sel_hi:[1,1,1]" : "+v"(C) : "v"(A), "v"(X))
#define P11_COMP(src) do { unsigned long long vv_[16]; \
                    _Pragma("unroll") for (int jj = 0; jj < 16; ++jj) vv_[jj] = *(const LAS unsigned long long*)(unsigned long long)(src[jj] & 0x1FFF8u);     \
                    __builtin_amdgcn_sched_barrier(0); \
                    _Pragma("unroll") for (int jj = 0; jj < 16; ++jj) { const int lo = (int)(unsigned)vv_[jj], hi = (int)(unsigned)(vv_[jj] >> 32); \
                    const h2_t c0_ = __builtin_amdgcn_cvt_scalef32_pk_f16_fp8(lo, 1.0f, false), c1_ = __builtin_amdgcn_cvt_scalef32_pk_f16_fp8(lo, 1.0f, true); \
                    const h2_t c2_ = __builtin_amdgcn_cvt_scalef32_pk_f16_fp8(hi, 1.0f, false), c3_ = __builtin_amdgcn_cvt_scalef32_pk_f16_fp8(hi, 1.0f, true); \
                    P11_FMA(c0_, src[jj], acc[0]); P11_FMA(c1_, src[jj], acc[1]); P11_FMA(c2_, src[jj], acc[2]); P11_FMA(c3_, src[jj], acc[3]); } } while (0)
#define P11_COMPX(src) do { unsigned long long vv_[16]; \
                    _Pragma("unroll") for (int jj = 0; jj < 16; ++jj) vv_[jj] = *(const LAS unsigned long long*)(unsigned long long)(src[jj] & 0x1FFF8u); \
                    __builtin_amdgcn_sched_barrier(0); \
                    _Pragma("unroll") for (int jj = 0; jj < 16; ++jj) { const int lo = (int)(unsigned)vv_[jj], hi = (int)(unsigned)(vv_[jj] >> 32); \
                    P11_FMA(lo, src[jj], acc[0]); P11_FMA(hi, src[jj], acc[1]); P11_FMA(lo, src[jj], acc[2]); P11_FMA(hi, src[jj], acc[3]); } } while (0)
        int lane = F.lane; asm volatile("" : "+v"(lane));
        unsigned pa[16], pb[16];
        f32x4 x0, x1;
        { const unsigned* pp = pairs + (size_t)F.wave * 128 * 64 + lane; P11_LOAD(pa, pp);
          const float* ip = F.out + (size_t)(F.wave * 64 + lane) * 2048 + c * 8; x0 = *(const f32x4*)ip; x1 = *(const f32x4*)(ip + 4); }
        for (int tile = F.wave; tile < MTOK / 64; tile += 8) {
            const unsigned* pp = pairs + (size_t)tile * 128 * 64 + lane;
            const int ntile = tile + 8 < MTOK / 64 ? tile + 8 : tile;
            const unsigned* npp = pairs + (size_t)ntile * 128 * 64 + lane;
            const int row = tile * 64 + lane;
            const float* gt2 = mf + (size_t)(tile / (SEQ / 64)) * 12288 + 10240 + c * 8;
            float* op = dst + (size_t)row * 2048 + c * 8;
            const f32x4 g0 = *(const f32x4*)gt2 * 0.25f, g1 = *(const f32x4*)(gt2 + 4) * 0.25f;
            h2_t acc[4];
#pragma unroll
            for (int i = 0; i < 4; ++i) acc[i] = (h2_t){(__fp16)0.f, (__fp16)0.f};
            f32x4 nx0 = x0, nx1 = x1;
#pragma unroll 1
            for (int j0 = 0; j0 < 128; j0 += 32) {
                P11_LOAD(pb, pp + (j0 + 16) * 64);
                P11_COMP(pa);
                const bool lastb = j0 + 32 >= 128;
                { const unsigned* np_ = lastb ? npp : pp + (j0 + 32) * 64; P11_LOAD(pa, np_); }
                if (lastb) { const float* nip = F.out + (size_t)(ntile * 64 + lane) * 2048 + c * 8; nx0 = *(const f32x4*)nip; nx1 = *(const f32x4*)(nip + 4); }
                P11_COMP(pb);
            }
#if PROBE_P11X == 1 || PROBE_P11X == 3
            { h2_t sv[4]; for (int i = 0; i < 4; ++i) sv[i] = acc[i];
#pragma unroll 1
              for (int j0 = 0; j0 < 128; j0 += 32) {
#pragma unroll
                for (int jj = 0; jj < 16; ++jj) { asm volatile("" : "+v"(pa[jj])); asm volatile("" : "+v"(pb[jj])); }
#if PROBE_P11X == 1
                P11_COMP(pa); P11_COMP(pb);
#else
                P11_COMPX(pa); P11_COMPX(pb);
#endif
              }
              asm volatile("" :: "v"(acc[0]), "v"(acc[1]), "v"(acc[2]), "v"(acc[3])); for (int i = 0; i < 4; ++i) acc[i] = sv[i]; }
#endif
            *(f32x4*)op = x0 + g0 * (f32x4){(float)acc[0][0], (float)acc[0][1], (float)acc[1][0], (float)acc[1][1]};
            *(f32x4*)(op + 4) = x1 + g1 * (f32x4){(float)acc[2][0], (float)acc[2][1], (float)acc[3][0], (float)acc[3][1]};
            x0 = nx0; x1 = nx1;
        }
#undef P11_LOAD
#undef P11_COMP
#undef P11_FMA
    }
}

__global__ void __launch_bounds__(512, 2) fwd_kernel(Args args) {
    extern __shared__ __attribute__((aligned(16))) unsigned char lds[];
    Frame F;
    F.lds = lds; F.ws = args.ws; F.tid = threadIdx.x; F.lane = F.tid & 63; F.wave = __builtin_amdgcn_readfirstlane(F.tid >> 6); F.G = gridDim.x; F.bid = blockIdx.x;
    F.x = args.in[0]; F.c = args.in[1]; F.w_ada = args.in[2]; F.b_ada = args.in[3]; F.g1 = args.in[4]; F.g2 = args.in[5]; F.w_in = args.in[6]; F.g_q = args.in[7]; F.g_k = args.in[8];
    F.rel_bias = args.in[9]; F.pool_w = args.in[10]; F.pool_scale = args.in[11]; F.w_ab = args.in[12]; F.w_pb = args.in[13]; F.w_out = args.in[14]; F.w_pq = args.in[15];
    F.peer_keys = args.in[16]; F.peer_u = args.in[17]; F.peer_v = args.in[18]; F.out = args.out;
    LAS unsigned char* ldsl = (LAS unsigned char*)lds;
    volatile LAS unsigned* misc = (volatile LAS unsigned*)(ldsl + MISC_OFF);
    if (F.tid < 4) misc[F.tid] = 0u;
    __syncthreads();
    unsigned* barw = (unsigned*)(args.ws + WS_CTL) + (size_t)args.li * XCD_BAR_WORDS;
    XcdBarrier bar; bar.bar = barw; bar.x = 0; bar.st = misc;
    const int lo = args.ph_lo, hi = args.ph_hi;
    if (hi - lo > 1) bar = xcd_barrier_post(barw, misc);
#define IN(k) (lo <= (k) && (k) < hi)
#define SEAM(k) do { if (IN(k) && IN((k) + 1)) xcd_barrier(bar, F.wave); } while (0)
    bf16_t* R0 = (bf16_t*)(F.ws + WS_R0);

#define PH2_BODY { \
        { pg8::Gemm g{(const bf16_t*)(F.ws + WS_H1F8), (const bf16_t*)(F.ws + WS_WIN8), MTOK, 5632, DM / 2, DM / 2, 0, nullptr, nullptr, 0, 0}; pg8::StaticOrder S; S.init(MTOK, 5632, F.G, F.bid); \
          EpiInproj<true> E{(bf16_t*)(F.ws + WS_QN), (bf16_t*)(F.ws + WS_KN), (bf16_t*)(F.ws + WS_V), (bf16_t*)(F.ws + WS_IQ), (bf16_t*)(F.ws + WS_IK), (bf16_t*)(F.ws + WS_PL), \
                    (bf16_t*)(F.ws + WS_GA), (bf16_t*)(F.ws + WS_GP), (float*)(F.ws + WS_IW)}; \
          pg8::gemm_phase<EpiInproj<true>, true>(ldsl, g, S, E, F.wave); } \
        { pg8::Gemm g{R0, (const bf16_t*)(F.ws + WS_WIN16), MTOK, 2304, DM, DM, 0, nullptr, nullptr, 0, 0}; pg8::StaticOrder S; S.init(MTOK, 2304, F.G, F.bid); \
          EpiInproj<false> E{(bf16_t*)(F.ws + WS_QN), (bf16_t*)(F.ws + WS_KN), (bf16_t*)(F.ws + WS_V), (bf16_t*)(F.ws + WS_IQ), (bf16_t*)(F.ws + WS_IK), (bf16_t*)(F.ws + WS_PL), \
                    (bf16_t*)(F.ws + WS_GA), (bf16_t*)(F.ws + WS_GP), (float*)(F.ws + WS_IW)}; \
          pg8::gemm_phase<EpiInproj<false>>(ldsl, g, S, E, F.wave); } }
#define PH3_BODY { phase3_pooled(F); phase3_indexer(F); __syncthreads(); }
#define PH4_BODY { \
        phase4_attention(F); \
        __syncthreads(); \
        pg8::Gemm g{(const bf16_t*)(F.ws + WS_POOLED), (const bf16_t*)(F.ws + WS_POOLW), MTOK, PW, 256, 1024, 256, nullptr, nullptr, 0, 0}; pg8::StaticOrder S; S.init(MTOK, PW, F.G, F.bid); \
        EpiF8Scale E{F.ws + WS_POOL2, 1024, F.pool_scale}; \
        pg8::gemm_phase<EpiF8Scale>(ldsl, g, S, E, F.wave); }
#define PH5_BODY { \
        pg8::Gemm g{(const bf16_t*)(F.ws + WS_ATTN), (const bf16_t*)(F.ws + WS_WAB), MTOK, DM, 1024, 512, 0, (const bf16_t*)(F.ws + WS_POOL2), (const bf16_t*)(F.ws + WS_WPB), 8, 512};     \
        pg8::StaticOrder S; S.init(MTOK, DM, F.G, F.bid); \
        EpiMerge E{(unsigned char*)R0, (const bf16_t*)(F.ws + WS_GA), (const bf16_t*)(F.ws + WS_GP)}; pg8::gemm_phase<EpiMerge, true>(ldsl, g, S, E, F.wave); }
#define PH6_BODY { \
        pg8::Gemm g{R0, (const bf16_t*)(F.ws + WS_WOUT), MTOK, DM, DM / 2, DM / 2, 0, nullptr, nullptr, 0, 0}; pg8::StaticOrder S; S.init(MTOK, DM, F.G, F.bid); \
        EpiResid E{F.x, F.out, (const float*)(F.ws + WS_MODF) + 4096}; pg8::gemm_phase<EpiResid, true>(ldsl, g, S, E, F.wave); }
#define PH8_BODY { \
        pg8::Gemm g{(const bf16_t*)(F.ws + WS_H2), (const bf16_t*)(F.ws + WS_WPQ), MTOK, DM, DM, DM, 0, nullptr, nullptr, 0, 0}; pg8::StaticOrder S; S.init(MTOK, DM, F.G, F.bid); \
        EpiBf16Scale E{R0, 2048, nullptr}; pg8::gemm_phase<EpiBf16Scale>(ldsl, g, S, E, F.wave); }
#define PH9_BODY { \
        pg8::Gemm g{R0, (const bf16_t*)(F.ws + WS_KEYSBD), MTOK, DM, 256, DM, 256, nullptr, nullptr, 0, 0}; pg8::StaticOrder S; S.init(MTOK, DM, F.G, F.bid); \
        EpiBf16Scale E{(bf16_t*)(F.ws + WS_SUB), 2048, nullptr}; pg8::gemm_phase<EpiBf16Scale>(ldsl, g, S, E, F.wave); }
#define REP(k) if constexpr (((PROBE_REP) >> (k)) & 1)

    if (IN(0)) { phase0_prep(F); REP(0) { __syncthreads(); phase0_prep(F); } }
    SEAM(0);
    if (IN(1)) { phase_modnorm<true>(F, F.x, F.g1, 0, 2048, R0, F.ws + WS_H1F8); REP(1) { phase_modnorm<true>(F, F.x, F.g1, 0, 2048, R0, F.ws + WS_H1F8); } }
    SEAM(1);
    if (IN(2)) { PH2_BODY REP(2) PH2_BODY }
    SEAM(2);
    if (IN(3)) { phase3_qknorm(F); PH3_BODY REP(3) PH3_BODY }
    SEAM(3);
    if (IN(4)) { PH4_BODY REP(4) PH4_BODY }
    SEAM(4);
    if (IN(5)) { PH5_BODY REP(5) PH5_BODY }
    SEAM(5);
    if (IN(6)) { PH6_BODY REP(6) PH6_BODY }
    SEAM(6);
    if (IN(7)) { phase_modnorm<false>(F, F.out, F.g2, 6144, 8192, (bf16_t*)(F.ws + WS_H2)); REP(7) { phase_modnorm<false>(F, F.out, F.g2, 6144, 8192, (bf16_t*)(F.ws + WS_H2)); } }
    SEAM(7);
    if (IN(8)) { PH8_BODY REP(8) PH8_BODY }
    SEAM(8);
    if (IN(9)) { PH9_BODY REP(9) PH9_BODY }
    SEAM(9);
    if (IN(10)) { phase10_peer(F); REP(10) phase10_peer<PROBE_P10M>(F); }
    SEAM(10);
    if (IN(11)) { REP(11) { phase11_peer_v(F, (float*)(F.ws + WS_SUB)); } phase11_peer_v(F, F.out); }
#undef IN
#undef SEAM
}

extern "C" void kernel_launch(void* const* d_in, const int* in_sizes, int n_in, void* d_out, int out_size, void* d_ws, size_t ws_size, hipStream_t stream) {
    static int grid = 0;
    if (grid == 0) {
        if (n_in != 19 || out_size != MTOK * DM || ws_size < WS_END) { fprintf(stderr, "kernel_launch: unexpected shapes (n_in %d out %d ws %zu)\n", n_in, out_size, ws_size); grid = -1; return; }
        int dev = 0, cus = 0, per_cu = 0;
        if (hipGetDevice(&dev) != hipSuccess || hipDeviceGetAttribute(&cus, hipDeviceAttributeMultiprocessorCount, dev) != hipSuccess) { grid = -1; return; }
        if (hipFuncSetAttribute((const void*)fwd_kernel, hipFuncAttributeMaxDynamicSharedMemorySize, LDS_BYTES) != hipSuccess) { fprintf(stderr, "kernel_launch: hipFuncSetAttribute failed\n"); grid = -1; return; }
        if (hipOccupancyMaxActiveBlocksPerMultiprocessor(&per_cu, (const void*)fwd_kernel, 512, LDS_BYTES) != hipSuccess || per_cu < 1) { fprintf(stderr, "kernel_launch: occupancy query says %d\n", per_cu); }
        (void)hipGetLastError();
        grid = cus;
    }
    if (grid < 0) return;
    (void)in_sizes;
    if (hipMemsetAsync((char*)d_ws + WS_CTL, 0, CTL_ZERO_BYTES, stream) != hipSuccess) return;
    Args a{};
    for (int i = 0; i < 19; ++i) a.in[i] = (const float*)d_in[i];
    a.out = (float*)d_out; a.ws = (unsigned char*)d_ws;
#if MK_PER_PHASE
    for (int p = 0; p < NPHASE; ++p) { a.ph_lo = p; a.ph_hi = p + 1; a.li = p; hipLaunchKernelGGL(fwd_kernel, dim3(grid), dim3(512), LDS_BYTES, stream, a); }
#else
    a.ph_lo = 0; a.ph_hi = NPHASE; a.li = 0;
    hipLaunchKernelGGL(fwd_kernel, dim3(grid), dim3(512), LDS_BYTES, stream, a);
#endif
}
```

```cpp
#include <hip/hip_runtime.h>
#include <cstdio>
#include <cstdint>

#ifndef MK_PER_PHASE
#define MK_PER_PHASE 0
#endif

#ifndef PROBE_REP
#define PROBE_REP 0
#endif
#ifndef PROBE_IDX
#define PROBE_IDX 0
#endif
#ifndef PROBE_P10M
#define PROBE_P10M 0
#endif
#ifndef PROBE_P11X
#define PROBE_P11X 0
#endif
#define LAS __attribute__((address_space(3)))
typedef unsigned short bf16_t;
typedef short bf16x8 __attribute__((ext_vector_type(8)));
typedef float f32x4 __attribute__((ext_vector_type(4)));
typedef float f32x2 __attribute__((ext_vector_type(2)));
typedef int v2i __attribute__((ext_vector_type(2)));
typedef unsigned u32x4 __attribute__((ext_vector_type(4)));
typedef unsigned u32x2 __attribute__((ext_vector_type(2)));
typedef unsigned u32x6 __attribute__((ext_vector_type(6)));
typedef unsigned u32x16 __attribute__((ext_vector_type(16)));
typedef __bf16 bf16x32 __attribute__((ext_vector_type(32)));

constexpr int BATCH = 8, SEQ = 4096, DM = 2048, MTOK = BATCH * SEQ;
constexpr int NHEAD = 8, HDIM = 128, AW = 1024, KVW = 256, IHEADS = 16, IDIM = 64, KSEL = 256;
constexpr int PW = 1024, PHEADS = 8, NEXP = 16384;
constexpr int INW = 7760;
constexpr float EPS = 1e-6f;
constexpr int NPHASE = 12;

constexpr size_t MiB = 1u << 20;
constexpr size_t WS_CTL = 0, CTL_ZERO_BYTES = 256 * 1024;
constexpr size_t WS_MODP = 2 * MiB;
constexpr size_t WS_MODF = 4 * MiB;
constexpr size_t WS_POOLW = 5 * MiB;
constexpr size_t WS_KEYSBD = 6 * MiB;
constexpr size_t WS_WIN16 = 8 * MiB;
constexpr size_t WS_WIN8 = 20 * MiB;
constexpr size_t WS_WAB = 40 * MiB, WS_WPB = 44 * MiB, WS_WOUT = 48 * MiB, WS_WPQ = 56 * MiB;
constexpr size_t WS_PU = 64 * MiB, WS_PV = 128 * MiB;
constexpr size_t WS_R0 = 192 * MiB;
constexpr size_t WS_GA = 320 * MiB, WS_GP = 448 * MiB;
constexpr size_t WS_SUB = 320 * MiB;
constexpr size_t WS_QN = 576 * MiB;
constexpr size_t WS_IQ = 640 * MiB;
constexpr size_t WS_PL = 704 * MiB;
constexpr size_t WS_KN = 768 * MiB, WS_V = 784 * MiB;
constexpr size_t WS_IK = 800 * MiB;
constexpr size_t WS_IW = 804 * MiB;
constexpr size_t WS_SEL = 806 * MiB;
constexpr size_t WS_POOLED = 822 * MiB;
constexpr size_t WS_H2 = 886 * MiB;
constexpr size_t WS_END = 1014 * MiB;
constexpr size_t WS_H1F8 = WS_H2 + 64 * MiB;
constexpr size_t WS_Q8 = WS_H2, WS_K8 = WS_H2 + 32 * MiB, WS_V8 = WS_H2 + 40 * MiB;
constexpr size_t WS_ATTN = WS_IQ, WS_POOL2 = WS_PL, WS_PAIRS = WS_QN, WS_WLS = WS_QN + 32 * MiB;

constexpr int LDS_BYTES = 160 * 1024;
constexpr int MISC_OFF = 159 * 1024;

__device__ __forceinline__ unsigned cvt_pk_bf16(float lo, float hi) { unsigned r; asm volatile("v_cvt_pk_bf16_f32 %0, %1, %2" : "=v"(r) : "v"(lo), "v"(hi)); return r; }
__device__ __forceinline__ float bf_lo(unsigned w) { return __uint_as_float(w << 16); }
__device__ __forceinline__ float bf_hi(unsigned w) { return __uint_as_float(w & 0xffff0000u); }
template <int CTRL> __device__ __forceinline__ float dpp_f(float x) { return __int_as_float(__builtin_amdgcn_update_dpp(0, __float_as_int(x), CTRL, 0xF, 0xF, true)); }
#define DPP_XOR1 0xB1
#define DPP_XOR2 0x4E
#define DPP_HMIRROR 0x141
#define DPP_MIRROR 0x140
#define DPP_ROR8 0x128
__device__ __forceinline__ float xor16_sum(float x) { const auto r = __builtin_amdgcn_permlane16_swap(__float_as_uint(x), __float_as_uint(x), false, false); return __uint_as_float(r[0]) + __uint_as_float(r[1]); }
__device__ __forceinline__ float xor32_sum(float x) { const auto r = __builtin_amdgcn_permlane32_swap(__float_as_uint(x), __float_as_uint(x), false, false); return __uint_as_float(r[0]) + __uint_as_float(r[1]); }
__device__ __forceinline__ float xor16_max(float x) { const auto r = __builtin_amdgcn_permlane16_swap(__float_as_uint(x), __float_as_uint(x), false, false); return fmaxf(__uint_as_float(r[0]), __uint_as_float(r[1])); }
__device__ __forceinline__ float swap32_pair(float a, float b) { const auto r = __builtin_amdgcn_permlane32_swap(__float_as_uint(a), __float_as_uint(b), false, false); return __uint_as_float(r[0]) + __uint_as_float(r[1]); }
__device__ __forceinline__ float swap16_pair(float a, float b) { const auto r = __builtin_amdgcn_permlane16_swap(__float_as_uint(a), __float_as_uint(b), false, false); return __uint_as_float(r[0]) + __uint_as_float(r[1]); }
__device__ __forceinline__ float row_sum16(float v) { v += dpp_f<DPP_XOR1>(v); v += dpp_f<DPP_XOR2>(v); v += dpp_f<DPP_HMIRROR>(v); v += dpp_f<DPP_MIRROR>(v); return v; }
__device__ __forceinline__ float row_max16(float v) { v = fmaxf(v, dpp_f<DPP_XOR1>(v)); v = fmaxf(v, dpp_f<DPP_XOR2>(v)); v = fmaxf(v, dpp_f<DPP_HMIRROR>(v)); v = fmaxf(v, dpp_f<DPP_MIRROR>(v)); return v; }
__device__ __forceinline__ float wave_sum(float v) { return xor32_sum(xor16_sum(row_sum16(v))); }
__device__ __forceinline__ float sigmoidf_(float x) { return __builtin_amdgcn_rcpf(1.0f + __expf(-x)); }
__device__ __forceinline__ float dot8(u32x4 w, const float* h) {
    return bf_lo(w.x) * h[0] + bf_hi(w.x) * h[1] + bf_lo(w.y) * h[2] + bf_hi(w.y) * h[3] + bf_lo(w.z) * h[4] + bf_hi(w.z) * h[5] + bf_lo(w.w) * h[6] + bf_hi(w.w) * h[7];
}

__device__ __forceinline__ int lane_now() { int l; asm volatile("v_mbcnt_lo_u32_b32 %0, -1, 0\n\tv_mbcnt_hi_u32_b32 %0, -1, %0" : "=v"(l)); return l; }

#define XB_TMO      128
#define XB_XCNT(j)  (256  + 64 * (j))
#define XB_XSUB(j)  (1280 + 64 * (j))
#define XB_XGEN(j)  (2304 + 64 * (j))
#define XB_TOP      3328
#define XB_TOPGEN   3392
#define XCD_BAR_WORDS 3456
#define XB_SPIN_CAP (1u << 18)

__device__ __forceinline__ unsigned xb_ld(unsigned* p)              { return __hip_atomic_load(p, __ATOMIC_RELAXED, __HIP_MEMORY_SCOPE_AGENT); }
__device__ __forceinline__ unsigned xb_add(unsigned* p, unsigned v) { return __hip_atomic_fetch_add(p, v, __ATOMIC_RELAXED, __HIP_MEMORY_SCOPE_AGENT); }
__device__ __forceinline__ unsigned xb_xcc_id() { return (unsigned)__builtin_amdgcn_s_getreg((3 << 11) | 20) & 0xFu; }
#define XB_SPIN(cond, bar) do { unsigned _sp = 0; while (cond) { __builtin_amdgcn_s_sleep(1); \
    if ((++_sp & 255u) == 0u) { if (xb_ld(&(bar)[XB_TMO])) break; if (_sp > XB_SPIN_CAP) { atomicAdd(&(bar)[XB_TMO], 1u); break; } } } } while (0)

struct XcdBarrier { unsigned* bar; unsigned x; volatile LAS unsigned* st; };

__device__ __forceinline__ XcdBarrier xcd_barrier_post(unsigned* bar, volatile LAS unsigned* st) {
    XcdBarrier b; b.bar = bar; b.x = xb_xcc_id(); b.st = st;
    if (threadIdx.x == 0) (void)xb_add(&bar[XB_XCNT(b.x)], 1u);
    return b;
}
__device__ __forceinline__ void xcd_barrier_complete(unsigned* bar, unsigned x, unsigned& nloc, unsigned& nx) {
    const unsigned G = gridDim.x * gridDim.y * gridDim.z;
    unsigned sum, cnt, mine, sp = 0u;
    for (;;) {
        sum = 0u; cnt = 0u; mine = 0u;
#pragma unroll
        for (unsigned j = 0; j < 16; ++j) { const unsigned c = xb_ld(&bar[XB_XCNT(j)]); sum += c; cnt += (c > 0u) ? 1u : 0u; mine = (j == x) ? c : mine; }
        if (sum == G) break;
        __builtin_amdgcn_s_sleep(1);
        if ((++sp & 255u) == 0u) { if (xb_ld(&bar[XB_TMO])) break; if (sp > XB_SPIN_CAP) { atomicAdd(&bar[XB_TMO], 1u); break; } }
    }
    nloc = mine > 0u ? mine : 1u; nx = cnt > 0u ? cnt : 1u;
}
__device__ __forceinline__ void xcd_barrier(const XcdBarrier& b, int wave) {
    asm volatile("s_waitcnt vmcnt(0)" ::: "memory");
    __syncthreads();
    if (wave == 0 && lane_now() == 0) {
        unsigned* bar = b.bar;
        __builtin_amdgcn_s_waitcnt(0);
        unsigned nloc = b.st[0], nx = b.st[1];
        if (nloc == 0u) { xcd_barrier_complete(bar, b.x, nloc, nx); b.st[0] = nloc; b.st[1] = nx; }
        const unsigned old = xb_add(&bar[XB_XSUB(b.x)], 1u);
        const unsigned gen = old / nloc;
        if (old + 1u == (gen + 1u) * nloc) {
            __builtin_amdgcn_fence(__ATOMIC_RELEASE, "agent");
            asm volatile("s_waitcnt vmcnt(0)" ::: "memory");
            const unsigned og = xb_add(&bar[XB_TOP], 1u);
            const unsigned tg = og / nx;
            if (og + 1u == (tg + 1u) * nx) xb_add(&bar[XB_TOPGEN], 1u);
            else XB_SPIN(xb_ld(&bar[XB_TOPGEN]) == tg, bar);
            __builtin_amdgcn_fence(__ATOMIC_ACQUIRE, "agent");
            xb_add(&bar[XB_XGEN(b.x)], 1u);
            asm volatile("s_waitcnt vmcnt(0)" ::: "memory");
        } else {
            XB_SPIN(xb_ld(&bar[XB_XGEN(b.x)]) == gen, bar);
            __builtin_amdgcn_fence(__ATOMIC_ACQUIRE, "agent");
            asm volatile("s_waitcnt vmcnt(0)" ::: "memory");
        }
    }
    __syncthreads();
}

namespace pg8 {
constexpr int BM = 256, BK = 64, HALF = 128, HTB = HALF * BK * 2, STAGE_BYTES = 8 * HTB, NXCD = 8, WGM = 8;
__device__ __forceinline__ int lds_byte(int r, int c) { const int st = (r >> 4) * 2 + (c >> 5), rr = r & 15, cc = c & 31, ob = rr * 64 + cc * 2; return st * 1024 + (ob ^ (((ob >> 9) & 1) << 5)); }
__device__ __forceinline__ void stage_rc(int b, int& R, int& C) { const int st = b / 1024, sb = b % 1024, swz = sb ^ (((sb >> 9) & 1) << 5); R = (st >> 1) * 16 + swz / 64; C = (st & 1) * 32 + (swz % 64) / 2; }
__device__ __forceinline__ int perm32(int rho) { const int n = rho >> 4, i = rho & 15; return 8 * (i >> 2) + 4 * n + (i & 3); }

struct Unit { int pm, pn; };
struct Gemm { const bf16_t* A; const bf16_t* Bt; int M, N, K, lda, a_pn_off; const bf16_t* A2; const bf16_t* Bt2; int ksplit, ldb; };

struct StaticOrder {
    int nM, nN, nwg, G, c;
    __device__ void init(int M, int N, int G_, int c_) { nM = M / BM; nN = N / BM; nwg = nM * nN; G = G_; c = c_; }
    __device__ bool next(int i, Unit& u) const {
        const long L = (long)i * G + c; if (L >= nwg) return false;
        int wgid = (int)L; { const int q = nwg / NXCD, r = nwg % NXCD, xcd = wgid % NXCD, off = wgid / NXCD; wgid = (xcd < r ? xcd * (q + 1) : r * (q + 1) + (xcd - r) * q) + off; }
        const int nig = WGM * nN, gid = wgid / nig, fm = gid * WGM, gsz = (nM - fm) < WGM ? (nM - fm) : WGM;
        u.pm = fm + ((wgid % nig) % gsz); u.pn = (wgid % nig) / gsz; return true;
    }
};

typedef int i32x4 __attribute__((ext_vector_type(4)));
typedef int i32x8 __attribute__((ext_vector_type(8)));
__device__ __forceinline__ bf16x8 lo8(i32x8 v) { return __builtin_bit_cast(bf16x8, (i32x4){v.s0, v.s1, v.s2, v.s3}); }
__device__ __forceinline__ bf16x8 hi8(i32x8 v) { return __builtin_bit_cast(bf16x8, (i32x4){v.s4, v.s5, v.s6, v.s7}); }
__device__ __forceinline__ i32x8 cat8(bf16x8 a, bf16x8 b) { const i32x4 x = __builtin_bit_cast(i32x4, a), y = __builtin_bit_cast(i32x4, b); return (i32x8){x.x, x.y, x.z, x.w, y.x, y.y, y.z, y.w}; }
template <class Epi, bool F8 = false>
__device__ __forceinline__ void gemm_phase(LAS unsigned char* lds, const Gemm g, const StaticOrder& S, const Epi& E, int wave) {
    const int lane = lane_now(), wid = wave, tid = wid * 64 + lane, wr = wid >> 2, wc = wid & 3, fr = lane & 15, fq = lane >> 4;
    const int K = g.K, nt = K / BK, lda = g.lda, ldb = g.ldb ? g.ldb : g.K, ksplit = g.ksplit;
    unsigned voffA, voffB;
    { int R, C; stage_rc(tid * 16, R, C); const int Rb = Epi::PERM ? ((R & ~31) + perm32(R & 31)) : R;
      voffA = (unsigned)(R * lda + C) * 2u; voffB = (unsigned)(Rb * ldb + C) * 2u; }
    const unsigned stepA = 64u * (unsigned)lda * 2u, stepB = 64u * (unsigned)ldb * 2u;
    const size_t kstep = (size_t)(BK * 2);
    const size_t hsA = (size_t)HALF * lda * 2, hsB = (size_t)HALF * ldb * 2;
    const size_t tsA = 2 * hsA, tsB = 2 * hsB;
    const unsigned ldsw = (unsigned)wid * 1024u, ldsbase = (unsigned)(unsigned long long)lds;
    const int aoff = lds_byte(wr * 64 + fr, fq * 8), boff = lds_byte(wc * 32 + fr, fq * 8);
#define PG8_SA(b, h) (((b) * 2 + (h)) * HTB)
#define PG8_SB(b, h) ((4 + (b) * 2 + (h)) * HTB)
#define PG8_STAGE(bufoff, gbase, voff) do { _Pragma("unroll") for (int _i = 0; _i < 2; ++_i) { \
        const char* sb_ = (const char*)(gbase) + (size_t)_i * PG8_STEP_##voff; const unsigned m0_ = ldsbase + (unsigned)(bufoff) + ldsw + (unsigned)_i * 8192u; \
        asm volatile("s_mov_b32 m0, %2\n\ts_nop 0\n\tglobal_load_lds_dwordx4 %0, %1" :: "v"(voff), "s"(sb_), "s"(m0_) : "memory"); } } while (0)
#define PG8_STEP_voffA stepA
#define PG8_STEP_voffB stepB
#define PG8_LDA(dst, b, h) do { _Pragma("unroll") for (int m = 0; m < 4; ++m) dst[m] = cat8(*(const LAS bf16x8*)(lds + PG8_SA(b, h) + aoff + m * 2048), *(const LAS bf16x8*)(lds + PG8_SA(b, h) + aoff + m * 2048 + 1024)); } while (0)
#define PG8_LDB(dst, b, h) do { _Pragma("unroll") for (int n = 0; n < 2; ++n) dst[n] = cat8(*(const LAS bf16x8*)(lds + PG8_SB(b, h) + boff + n * 2048), *(const LAS bf16x8*)(lds + PG8_SB(b, h) + boff + n * 2048 + 1024)); } while (0)
#define PG8_MMA(ai, bj, At, Bt) do { __builtin_amdgcn_s_setprio(1); _Pragma("unroll") for (int m = 0; m < 4; ++m) _Pragma("unroll") for (int n = 0; n < 2; ++n) { \
        if constexpr (F8) acc[ai][bj][m][n] = __builtin_amdgcn_mfma_scale_f32_16x16x128_f8f6f4(Bt[n], At[m], acc[ai][bj][m][n], 0, 0, 0, 0x7D7D7D7D  , 0, 0x7D7D7D7D); \
        else { acc[ai][bj][m][n] = __builtin_amdgcn_mfma_f32_16x16x32_bf16(lo8(Bt[n]), lo8(At[m]), acc[ai][bj][m][n], 0, 0, 0); \
               acc[ai][bj][m][n] = __builtin_amdgcn_mfma_f32_16x16x32_bf16(hi8(Bt[n]), hi8(At[m]), acc[ai][bj][m][n], 0, 0, 0); } } \
        __builtin_amdgcn_s_setprio(0); } while (0)
#define PG8_WAIT_V(n) asm volatile("s_waitcnt vmcnt(" #n ")" ::: "memory")
#define PG8_WAIT_L(n) asm volatile("s_waitcnt lgkmcnt(" #n ")" ::: "memory")
#define PG8_BAR __builtin_amdgcn_s_barrier()
#define PG8_SCHED __builtin_amdgcn_sched_barrier(0)
    Unit cur, nxt; int ui = 0;
    if (!S.next(0, cur)) return;
    f32x4 acc[2][2][4][2];
#pragma unroll
    for (int a = 0; a < 2; ++a)
#pragma unroll
        for (int b = 0; b < 2; ++b)
#pragma unroll
            for (int m = 0; m < 4; ++m)
#pragma unroll
                for (int n = 0; n < 2; ++n) acc[a][b][m][n] = (f32x4){0.f, 0.f, 0.f, 0.f};
    i32x8 At[4], B0[2], B1[2];
    const char* cA = (const char*)g.A + (size_t)cur.pm * tsA + (size_t)cur.pn * g.a_pn_off * 2; const char* cB = (const char*)g.Bt + (size_t)cur.pn * tsB;
    PG8_STAGE(PG8_SB(0, 0), cB, voffB); PG8_STAGE(PG8_SB(0, 1), cB + hsB, voffB); PG8_STAGE(PG8_SA(0, 0), cA, voffA); PG8_STAGE(PG8_SA(0, 1), cA + hsA, voffA);
    if (wr == 1) PG8_BAR;
    PG8_WAIT_V(2); PG8_BAR;
    PG8_STAGE(PG8_SB(1, 0), cB + kstep, voffB); PG8_STAGE(PG8_SA(1, 0), cA + kstep, voffA); PG8_STAGE(PG8_SB(1, 1), cB + hsB + kstep, voffB);
    PG8_WAIT_V(6); PG8_BAR;
    for (;;) {
        const bool has_next = S.next(ui + 1, nxt);
        const char* nA = has_next ? (const char*)g.A + (size_t)nxt.pm * tsA + (size_t)nxt.pn * g.a_pn_off * 2 : cA; const char* nB = has_next ? (const char*)g.Bt + (size_t)nxt.pn * tsB : cB;
        const char* cA2 = (const char*)g.A2 + (size_t)cur.pm * tsA; const char* cB2 = (const char*)g.Bt2 + (size_t)cur.pn * tsB;
#pragma clang loop unroll(disable)
        for (int t = 0; t < nt; t += 2) {
            const bool last = (t == nt - 2);
            const bool s1 = ksplit && (t >= ksplit), s2 = ksplit && (t + 2 >= ksplit);
            const char* a1 = (s1 ? cA2 + (size_t)(t - ksplit + 1) * kstep : cA + (size_t)(t + 1) * kstep);
            const char* a2 = last ? nA : (s2 ? cA2 + (size_t)(t + 2 - ksplit) * kstep : cA + (size_t)(t + 2) * kstep);
            const char* b2 = last ? nB : (s2 ? cB2 + (size_t)(t + 2 - ksplit) * kstep : cB + (size_t)(t + 2) * kstep);
            const char* a3 = a2 + kstep; const char* b3 = b2 + kstep;
            PG8_LDB(B0, 0, 0); PG8_LDB(B1, 0, 1); PG8_SCHED; PG8_LDA(At, 0, 0); PG8_STAGE(PG8_SA(1, 1), a1 + hsA, voffA);
            PG8_WAIT_V(8); PG8_WAIT_L(0); PG8_BAR; PG8_MMA(0, 0, At, B0); PG8_MMA(0, 1, At, B1); PG8_BAR; PG8_SCHED;
            PG8_LDA(At, 0, 1); PG8_STAGE(PG8_SB(0, 0), b2, voffB); PG8_STAGE(PG8_SB(0, 1), b2 + hsB, voffB); PG8_STAGE(PG8_SA(0, 0), a2, voffA);
            PG8_WAIT_V(8); PG8_WAIT_L(0); PG8_BAR; PG8_MMA(1, 0, At, B0); PG8_MMA(1, 1, At, B1); PG8_BAR; PG8_SCHED;
            PG8_LDB(B0, 1, 0); PG8_LDB(B1, 1, 1); PG8_SCHED; PG8_LDA(At, 1, 0); PG8_STAGE(PG8_SA(0, 1), a2 + hsA, voffA);
            PG8_WAIT_V(8); PG8_WAIT_L(0); PG8_BAR; PG8_MMA(0, 0, At, B0); PG8_MMA(0, 1, At, B1); PG8_BAR; PG8_SCHED;
            PG8_LDA(At, 1, 1); PG8_STAGE(PG8_SB(1, 0), b3, voffB); PG8_STAGE(PG8_SB(1, 1), b3 + hsB, voffB); PG8_STAGE(PG8_SA(1, 0), a3, voffA);
            PG8_WAIT_V(8); PG8_WAIT_L(0); PG8_BAR; PG8_MMA(1, 0, At, B0); PG8_MMA(1, 1, At, B1); PG8_BAR; PG8_SCHED;
            if constexpr (Epi::MID) { if (t + 2 == ksplit) E.mid(acc, cur, wr, wc, fr, fq); }
        }
        if (wr == 0) PG8_BAR;
        { const int l2 = lane_now(); E(acc, cur, wr, wc, l2 & 15, l2 >> 4); }
        if (!has_next) break;
#pragma unroll
        for (int a = 0; a < 2; ++a)
#pragma unroll
            for (int b = 0; b < 2; ++b)
#pragma unroll
                for (int m = 0; m < 4; ++m)
#pragma unroll
                    for (int n = 0; n < 2; ++n) acc[a][b][m][n] = (f32x4){0.f, 0.f, 0.f, 0.f};
        cur = nxt; cA = nA; cB = nB; ++ui;
        if (wr == 1) PG8_BAR;
    }
    PG8_WAIT_V(0);
    PG8_BAR;
#undef PG8_SA
#undef PG8_SB
#undef PG8_STAGE
#undef PG8_STEP_voffA
#undef PG8_STEP_voffB
#undef PG8_LDA
#undef PG8_LDB
#undef PG8_MMA
#undef PG8_WAIT_V
#undef PG8_WAIT_L
#undef PG8_BAR
#undef PG8_SCHED
}
}
using pg8::Unit;

typedef f32x4 AccT[2][2][4][2];
__device__ __forceinline__ u32x4 pack8(f32x4 a, f32x4 b) { u32x4 w; w.x = cvt_pk_bf16(a[0], a[1]); w.y = cvt_pk_bf16(a[2], a[3]); w.z = cvt_pk_bf16(b[0], b[1]); w.w = cvt_pk_bf16(b[2], b[3]); return w; }
__device__ __forceinline__ u32x2 pack8_fp8(f32x4 a, f32x4 b) {
    int w0 = __builtin_amdgcn_cvt_pk_fp8_f32(a[0], a[1], 0, false); w0 = __builtin_amdgcn_cvt_pk_fp8_f32(a[2], a[3], w0, true);
    int w1 = __builtin_amdgcn_cvt_pk_fp8_f32(b[0], b[1], 0, false); w1 = __builtin_amdgcn_cvt_pk_fp8_f32(b[2], b[3], w1, true);
    return (u32x2){(unsigned)w0, (unsigned)w1};
}
__device__ __forceinline__ void unpack8(u32x4 w, f32x4& a, f32x4& b) { a = (f32x4){bf_lo(w.x), bf_hi(w.x), bf_lo(w.y), bf_hi(w.y)}; b = (f32x4){bf_lo(w.z), bf_hi(w.z), bf_lo(w.w), bf_hi(w.w)}; }

template <bool SET8> struct EpiInproj {
    static constexpr bool PERM = true, MID = false;
    bf16_t *q, *k, *v, *iq, *ik, *pl, *ga, *gp; float* iw;
    __device__ __forceinline__ void operator()(const AccT& acc, const Unit& u, int wr, int wc, int fr, int fq) const {
        const int pn = u.pn, row0 = u.pm * 256 + wr * 64 + fr;
        if (!SET8 && pn == 4) {
            if (wc < 2) {
#pragma unroll
                for (int ai = 0; ai < 2; ++ai)
#pragma unroll
                    for (int m = 0; m < 4; ++m) { const size_t row = (size_t)(row0 + ai * 128 + m * 16);
                        *(u32x4*)(ik + row * 64 + wc * 32 + 8 * fq) = pack8(acc[ai][0][m][0], acc[ai][0][m][1]); }
            } else if (wc == 2) {
                if (fq < 2) {
#pragma unroll
                    for (int ai = 0; ai < 2; ++ai)
#pragma unroll
                        for (int m = 0; m < 4; ++m) { const size_t row = (size_t)(row0 + ai * 128 + m * 16);
                            *(f32x4*)(iw + row * 16 + 8 * fq) = acc[ai][0][m][0]; *(f32x4*)(iw + row * 16 + 8 * fq + 4) = acc[ai][0][m][1]; }
                }
            }
            return;
        }
        bf16_t* dst; int ld, tc; bool sg = false;
        if (SET8) {
            if (pn < 4) { dst = q; ld = 1024; tc = pn * 256; }
            else if (pn == 4) { dst = k; ld = 256; tc = 0; }
            else if (pn == 5) { dst = v; ld = 256; tc = 0; }
            else if (pn < 14) { dst = ga; ld = 2048; tc = (pn - 6) * 256; sg = true; }
            else { dst = gp; ld = 2048; tc = (pn - 14) * 256; sg = true; }
        } else {
            if (pn < 4) { dst = iq; ld = 1024; tc = pn * 256; }
            else { dst = pl; ld = 1024; tc = (pn - 5) * 256; }
        }
        const int col0 = tc + wc * 32 + 8 * fq;
#pragma unroll
        for (int ai = 0; ai < 2; ++ai)
#pragma unroll
            for (int m = 0; m < 4; ++m) { bf16_t* rowp = dst + (size_t)(row0 + ai * 128 + m * 16) * ld + col0;
#pragma unroll
                for (int bj = 0; bj < 2; ++bj) { f32x4 v0 = acc[ai][bj][m][0], v1 = acc[ai][bj][m][1];
                    if (sg) {
#pragma unroll
                        for (int j = 0; j < 4; ++j) { v0[j] = sigmoidf_(v0[j]); v1[j] = sigmoidf_(v1[j]); } }
                    *(u32x4*)(rowp + bj * 128) = pack8(v0, v1); } }
    }
};
struct EpiBf16Scale {
    static constexpr bool PERM = true, MID = false;
    bf16_t* O; int ldc; const float* cs;
    __device__ __forceinline__ void operator()(const AccT& acc, const Unit& u, int wr, int wc, int fr, int fq) const {
        const int row0 = u.pm * 256 + wr * 64 + fr, col0 = u.pn * 256 + wc * 32 + 8 * fq;
        f32x4 s[2][2];
#pragma unroll
        for (int bj = 0; bj < 2; ++bj)
#pragma unroll
            for (int n = 0; n < 2; ++n) s[bj][n] = cs ? *(const f32x4*)(cs + col0 + bj * 128 + 4 * n) : (f32x4){1.f, 1.f, 1.f, 1.f};
#pragma unroll
        for (int ai = 0; ai < 2; ++ai)
#pragma unroll
            for (int m = 0; m < 4; ++m) { bf16_t* rowp = O + (size_t)(row0 + ai * 128 + m * 16) * ldc + col0;
#pragma unroll
                for (int bj = 0; bj < 2; ++bj) *(u32x4*)(rowp + bj * 128) = pack8(acc[ai][bj][m][0] * s[bj][0], acc[ai][bj][m][1] * s[bj][1]); }
    }
};
struct EpiF8Scale {
    static constexpr bool PERM = true, MID = false;
    unsigned char* O; int ldc; const float* cs;
    __device__ __forceinline__ void operator()(const AccT& acc, const Unit& u, int wr, int wc, int fr, int fq) const {
        const int row0 = u.pm * 256 + wr * 64 + fr, col0 = u.pn * 256 + wc * 32 + 8 * fq;
        f32x4 s[2][2];
#pragma unroll
        for (int bj = 0; bj < 2; ++bj)
#pragma unroll
            for (int n = 0; n < 2; ++n) s[bj][n] = *(const f32x4*)(cs + col0 + bj * 128 + 4 * n);
#pragma unroll
        for (int ai = 0; ai < 2; ++ai)
#pragma unroll
            for (int m = 0; m < 4; ++m) { unsigned char* rowp = O + (size_t)(row0 + ai * 128 + m * 16) * ldc + col0;
#pragma unroll
                for (int bj = 0; bj < 2; ++bj) *(u32x2*)(rowp + bj * 128) = pack8_fp8(acc[ai][bj][m][0] * s[bj][0], acc[ai][bj][m][1] * s[bj][1]); }
    }
};
template <bool ADD> struct EpiGate {
    static constexpr bool PERM = true, MID = false;
    bf16_t* O; const bf16_t* gate;
    __device__ __forceinline__ void operator()(const AccT& acc, const Unit& u, int wr, int wc, int fr, int fq) const {
        const int row0 = u.pm * 256 + wr * 64 + fr, col0 = u.pn * 256 + wc * 32 + 8 * fq;
#pragma unroll
        for (int ai = 0; ai < 2; ++ai)
#pragma unroll
            for (int m = 0; m < 4; ++m) { const size_t off = (size_t)(row0 + ai * 128 + m * 16) * 2048 + col0;
#pragma unroll
                for (int bj = 0; bj < 2; ++bj) { f32x4 g0, g1; unpack8(*(const u32x4*)(gate + off + bj * 128), g0, g1);
                    f32x4 r0 = g0 * acc[ai][bj][m][0], r1 = g1 * acc[ai][bj][m][1];
                    if (ADD) { f32x4 o0, o1; unpack8(*(const u32x4*)(O + off + bj * 128), o0, o1); r0 += o0; r1 += o1; }
                    *(u32x4*)(O + off + bj * 128) = pack8(r0, r1); } }
    }
};
struct EpiMerge {
    static constexpr bool PERM = true, MID = true;
    unsigned char* O; const bf16_t* ga; const bf16_t* gp;
    __device__ __forceinline__ void mid(AccT& acc, const Unit& u, int wr, int wc, int fr, int fq) const {
        const auto ra = __builtin_amdgcn_make_buffer_rsrc((void*)ga, 0, 0x7FFFFFFF, 0x00020000), rp = __builtin_amdgcn_make_buffer_rsrc((void*)gp, 0, 0x7FFFFFFF, 0x00020000);
        const int voff = ((wr * 64 + fr) * 2048 + wc * 32 + 8 * fq) * 2;
        const int sbase = (u.pm * 256 * 2048 + u.pn * 256) * 2;
#pragma unroll
        for (int ai = 0; ai < 2; ++ai)
#pragma unroll
            for (int m = 0; m < 4; ++m)
#pragma unroll
                for (int bj = 0; bj < 2; ++bj) { const int so = sbase + ((ai * 128 + m * 16) * 2048 + bj * 128) * 2;
                    const u32x4 wa = __builtin_bit_cast(u32x4, __builtin_amdgcn_raw_buffer_load_b128(ra, voff, so, 0)), wp = __builtin_bit_cast(u32x4, __builtin_amdgcn_raw_buffer_load_b128(rp, voff, so, 0));
                    f32x4 a0, a1, p0, p1; unpack8(wa, a0, a1); unpack8(wp, p0, p1);
#pragma unroll
                    for (int j = 0; j < 4; ++j) { acc[ai][bj][m][0][j] *= a0[j] * __builtin_amdgcn_rcpf(p0[j]); acc[ai][bj][m][1][j] *= a1[j] * __builtin_amdgcn_rcpf(p1[j]); }
                    asm volatile("" : "+v"(acc[ai][bj][m][0]), "+v"(acc[ai][bj][m][1]) :: "memory"); }
    }
    __device__ __forceinline__ void operator()(const AccT& acc, const Unit& u, int wr, int wc, int fr, int fq) const {
        const int row0 = u.pm * 256 + wr * 64 + fr, col0 = u.pn * 256 + wc * 32 + 8 * fq;
#pragma unroll
        for (int ai = 0; ai < 2; ++ai)
#pragma unroll
            for (int m = 0; m < 4; ++m) { const size_t off = (size_t)(row0 + ai * 128 + m * 16) * 2048 + col0;
#pragma unroll
                for (int bj = 0; bj < 2; ++bj) { f32x4 p0, p1; unpack8(*(const u32x4*)(gp + off + bj * 128), p0, p1);
                    *(u32x2*)(O + off + bj * 128) = pack8_fp8(p0 * acc[ai][bj][m][0], p1 * acc[ai][bj][m][1]); } }
    }
};
struct EpiResid {
    static constexpr bool PERM = false, MID = false;
    const float* x; float* out; const float* gt;
    __device__ __forceinline__ void operator()(const AccT& acc, const Unit& u, int wr, int wc, int fr, int fq) const {
        const int row0 = u.pm * 256 + wr * 64 + fr, col0 = u.pn * 256 + wc * 32 + 4 * fq;
        const float* gtb = gt + (size_t)(u.pm / 16) * 12288;
        f32x4 g[2][2];
#pragma unroll
        for (int bj = 0; bj < 2; ++bj)
#pragma unroll
            for (int n = 0; n < 2; ++n) g[bj][n] = *(const f32x4*)(gtb + col0 + bj * 128 + n * 16);
#pragma unroll
        for (int ai = 0; ai < 2; ++ai)
#pragma unroll
            for (int m = 0; m < 4; ++m) { const size_t off = (size_t)(row0 + ai * 128 + m * 16) * 2048 + col0;
#pragma unroll
                for (int bj = 0; bj < 2; ++bj)
#pragma unroll
                    for (int n = 0; n < 2; ++n) { const f32x4 xv = *(const f32x4*)(x + off + bj * 128 + n * 16);
                        *(f32x4*)(out + off + bj * 128 + n * 16) = xv + g[bj][n] * acc[ai][bj][m][n]; } }
    }
};
struct EpiF32 {
    static constexpr bool PERM = false, MID = false;
    float* C; int ldc;
    __device__ __forceinline__ void operator()(const AccT& acc, const Unit& u, int wr, int wc, int fr, int fq) const {
        const int row0 = u.pm * 256 + wr * 64 + fr, col0 = u.pn * 256 + wc * 32 + 4 * fq;
#pragma unroll
        for (int ai = 0; ai < 2; ++ai)
#pragma unroll
            for (int m = 0; m < 4; ++m) { float* rowp = C + (size_t)(row0 + ai * 128 + m * 16) * ldc + col0;
#pragma unroll
                for (int bj = 0; bj < 2; ++bj)
#pragma unroll
                    for (int n = 0; n < 2; ++n) *(f32x4*)(rowp + bj * 128 + n * 16) = acc[ai][bj][m][n]; }
    }
};

struct Args { const float* in[19]; float* out; unsigned char* ws; int ph_lo, ph_hi; int li, pad; };
struct Frame {
    unsigned char* lds; unsigned char* ws;
    int tid, lane, wave, G, bid;
    const float *x, *c, *w_ada, *b_ada, *g1, *g2, *w_in, *g_q, *g_k, *rel_bias, *pool_w, *pool_scale, *w_ab, *w_pb, *w_out, *w_pq, *peer_keys, *peer_u, *peer_v;
    float* out;
};

template <bool F8OUT = false, class Fn> __device__ __forceinline__ void transpose_item(const float* W, int K, int N, void* WTv, int ldk, int drow0, int k0, float* scr, int lane, Fn srccol, float mul = 1.0f) {
    const int sc = srccol(drow0 + (lane & 31));
#pragma unroll 8
    for (int i = 0; i < 32; ++i) { const int kk = 2 * i + (lane >> 5); scr[kk * 33 + (lane & 31)] = sc >= 0 ? W[(size_t)(k0 + kk) * N + sc] * mul : 0.f; }
    asm volatile("s_waitcnt lgkmcnt(0)" ::: "memory");
    const int c = lane & 7;
#pragma unroll
    for (int j = 0; j < 4; ++j) { const int n = (lane >> 3) + 8 * j; const float* s = scr + (8 * c) * 33 + n;
        if constexpr (F8OUT) { *(u32x2*)((unsigned char*)WTv + (size_t)(drow0 + n) * ldk + k0 + 8 * c) = pack8_fp8((f32x4){s[0 * 33], s[1 * 33], s[2 * 33], s[3 * 33]}, (f32x4){s[4 * 33], s[5 * 33], s[6 * 33], s[7 * 33]}); }
        else { u32x4 o; o.x = cvt_pk_bf16(s[0 * 33], s[1 * 33]); o.y = cvt_pk_bf16(s[2 * 33], s[3 * 33]); o.z = cvt_pk_bf16(s[4 * 33], s[5 * 33]); o.w = cvt_pk_bf16(s[6 * 33], s[7 * 33]);
            *(u32x4*)((bf16_t*)WTv + (size_t)(drow0 + n) * ldk + k0 + 8 * c) = o; } }
    asm volatile("s_waitcnt lgkmcnt(0)" ::: "memory");
}
__device__ __forceinline__ void phase0_prep(Frame& F) {
    F.lane = lane_now(); F.tid = F.wave * 64 + F.lane;
    const int gw = F.bid * 8 + F.wave, NGW = F.G * 8;
    float* scr = (float*)(F.lds + F.wave * 16384);
    constexpr int I_IN16 = (2304 / 32) * (DM / 64), I_IN8 = (5632 / 32) * (DM / 64);
    constexpr int I_AB = (2048 / 32) * (1024 / 64), I_OUT = (2048 / 32) * (2048 / 64), I_PW = 4 * 8 * 4;
    constexpr int NIT = I_IN16 + I_IN8 + 2 * I_AB + 2 * I_OUT + I_PW;
    auto ident = [](int j) { return j; };
    for (int it = gw; it < NIT; it += NGW) {
        int r = it;
        if (r < I_IN16) { const int nb = r % 72, kb = r / 72;
            transpose_item(F.w_in, DM, INW, F.ws + WS_WIN16, DM, nb * 32, kb * 64, scr, F.lane, [](int j) { return j < 1104 ? j + 1536 : (j < 1280 ? -1 : j + 1360); }); continue; }
        r -= I_IN16;
        if (r < I_IN8) { const int nb = r % 176, kb = r / 176;
            transpose_item<true>(F.w_in, DM, INW, F.ws + WS_WIN8, DM, nb * 32, kb * 64, scr, F.lane, [](int j) { return j < 1536 ? j : j + 2128; }, 16.0f); continue; }
        r -= I_IN8;
        if (r < I_AB) { transpose_item<true>(F.w_ab, 1024, 2048, F.ws + WS_WAB, 1024, (r % 64) * 32, (r / 64) * 64, scr, F.lane, ident, 16.0f); continue; }
        r -= I_AB;
        if (r < I_AB) { transpose_item<true>(F.w_pb, 1024, 2048, F.ws + WS_WPB, 1024, (r % 64) * 32, (r / 64) * 64, scr, F.lane, ident, 16.0f); continue; }
        r -= I_AB;
        if (r < I_OUT) { transpose_item<true>(F.w_out, 2048, 2048, F.ws + WS_WOUT, 2048, (r % 64) * 32, (r / 64) * 64, scr, F.lane, ident, 16.0f); continue; }
        r -= I_OUT;
        if (r < I_OUT) { transpose_item(F.w_pq, 2048, 2048, (bf16_t*)(F.ws + WS_WPQ), 2048, (r % 64) * 32, (r / 64) * 64, scr, F.lane, ident); continue; }
        r -= I_OUT;
        { const int g = r / 32, q = r % 32, nb = q % 8, kb = q / 8;
          transpose_item(F.pool_w + (size_t)g * 65536, 256, 256, (bf16_t*)(F.ws + WS_POOLW) + (size_t)g * 65536, 256, nb * 32, kb * 64, scr, F.lane, ident); }
    }
    {
        bf16_t* kb = (bf16_t*)(F.ws + WS_KEYSBD);
        for (int i = F.bid * 512 + F.tid; i < 2048 * 32; i += F.G * 512) {
            const int row = i / 32, k8 = (i % 32) * 8, p = (row >> 7) & 1;
            u32x4 o = (u32x4){0u, 0u, 0u, 0u};
            if ((k8 >> 7) == p) { const float* s = F.peer_keys + (size_t)row * 128 + (k8 & 127); const f32x4 a = *(const f32x4*)s, b = *(const f32x4*)(s + 4); o = pack8(a, b); }
            *(u32x4*)(kb + (size_t)row * 256 + k8) = o;
        }
    }
    {
        unsigned char* pu = F.ws + WS_PU;
        for (size_t i = (size_t)F.bid * 512 + F.tid; i < (size_t)NEXP * 64; i += (size_t)F.G * 512) {
            const float* src = F.peer_u + i * 32;
            u32x16 pk;
#pragma unroll
            for (int k = 0; k < 8; ++k) { const f32x4 a = *(const f32x4*)(src + k * 4) * 96.0f; pk[2 * k] = cvt_pk_bf16(a[0], a[1]); pk[2 * k + 1] = cvt_pk_bf16(a[2], a[3]); }
            const u32x6 p6 = __builtin_amdgcn_cvt_scalef32_pk32_fp6_bf16(__builtin_bit_cast(bf16x32, pk), 1.0f);
            const int ci = (int)(i & 63), lp = (ci >> 2) + 16 * (ci & 3);
            unsigned char* dst = pu + (i >> 6) * 1536;
            *(u32x4*)(dst + lp * 16) = (u32x4){p6[0], p6[1], p6[2], p6[3]}; *(u32x2*)(dst + 1024 + lp * 8) = (u32x2){p6[4], p6[5]};
        }
        unsigned char* pv = F.ws + WS_PV;
        for (int it = gw; it < (NEXP / 64) * 128; it += NGW) {
            const int e = (it >> 7) * 64 + F.lane, ch = it & 127;
            u32x4 ov;
#pragma unroll
            for (int k = 0; k < 4; ++k) { const f32x4 c = *(const f32x4*)(F.peer_v + (size_t)e * DM + ch * 16 + k * 4) * 4.0f;
                int wv = __builtin_amdgcn_cvt_pk_fp8_f32(c[0], c[1], 0, false); wv = __builtin_amdgcn_cvt_pk_fp8_f32(c[2], c[3], wv, true); ov[k] = (unsigned)wv; }
            *(u32x2*)(pv + ((size_t)(2 * ch) * NEXP + e) * 8) = (u32x2){ov[0], ov[1]};
            *(u32x2*)(pv + ((size_t)(2 * ch + 1) * NEXP + e) * 8) = (u32x2){ov[2], ov[3]};
        }
    }
    {
        __syncthreads();
        float* cact = (float*)(F.lds + 131072);
        float* red = (float*)F.lds;
        float* mp = (float*)(F.ws + WS_MODP);
        for (int it = F.bid; it < 48 * 4; it += F.G) {
            const int cb = it % 48, ds = it / 48, d0 = ds * 512;
            for (int i = F.tid; i < 8 * 512; i += 512) { const int b = i >> 9, d = i & 511; const float cv = F.c[b * DM + d0 + d]; cact[i] = cv * sigmoidf_(cv); }
            __syncthreads();
            f32x4 a[8];
#pragma unroll
            for (int b = 0; b < 8; ++b) a[b] = (f32x4){0.f, 0.f, 0.f, 0.f};
            const float* wp = F.w_ada + (size_t)(d0 + F.wave * 64) * 12288 + cb * 256 + F.lane * 4;
#pragma unroll 4
            for (int d = 0; d < 64; ++d) { const f32x4 w = *(const f32x4*)(wp + (size_t)d * 12288);
#pragma unroll
                for (int b = 0; b < 8; ++b) a[b] += w * cact[b * 512 + F.wave * 64 + d]; }
#pragma unroll
            for (int b = 0; b < 8; ++b)
#pragma unroll
                for (int j = 0; j < 4; ++j) red[(F.wave * 32 + b * 4 + j) * 64 + F.lane] = a[b][j];
            __syncthreads();
            for (int i = F.tid; i < 2048; i += 512) { const int v = i >> 6, l = i & 63; float s = 0.f;
#pragma unroll
                for (int w = 0; w < 8; ++w) s += red[(w * 32 + v) * 64 + l];
                mp[((size_t)ds * 8 + (v >> 2)) * 12288 + cb * 256 + l * 4 + (v & 3)] = s; }
            __syncthreads();
        }
    }
}

template <bool FIRST> __device__ __forceinline__ void phase_modnorm(Frame& F, const float* xin, const float* gain, int off_sh, int off_sc, bf16_t* dst, unsigned char* dst8 = nullptr) {
    F.lane = lane_now(); F.tid = F.wave * 64 + F.lane;
    const float* mp = (const float*)(F.ws + WS_MODP); float* mf = (float*)(F.ws + WS_MODF);
    if (FIRST) {
        for (int i = F.bid * 512 + F.tid; i < 8 * 12288; i += F.G * 512) {
            float s = F.b_ada[i % 12288];
#pragma unroll
            for (int k = 0; k < 4; ++k) s += mp[(size_t)k * 8 * 12288 + i];
            mf[i] = s; }
    }
    float* cA = (float*)F.lds; float* cB = cA + 2048;
    for (int ch = F.bid; ch < MTOK / 128; ch += F.G) {
        const int b = ch / 32;
        __syncthreads();
        for (int col = F.tid; col < 2048; col += 512) {
            float sc, sh;
            if (FIRST) { sc = F.b_ada[off_sc + col]; sh = F.b_ada[off_sh + col];
#pragma unroll
                for (int k = 0; k < 4; ++k) { sc += mp[((size_t)k * 8 + b) * 12288 + off_sc + col]; sh += mp[((size_t)k * 8 + b) * 12288 + off_sh + col]; } }
            else { sc = mf[b * 12288 + off_sc + col]; sh = mf[b * 12288 + off_sh + col]; }
            cA[col] = gain[col] * (1.f + sc); cB[col] = sh; }
        __syncthreads();
        for (int r = F.wave; r < 128; r += 8) {
            const size_t row = (size_t)ch * 128 + r;
            const float* xr = xin + row * 2048 + F.lane * 8;
            f32x4 v[4][2]; float ss = 0.f;
#pragma unroll
            for (int i = 0; i < 4; ++i) { v[i][0] = *(const f32x4*)(xr + i * 512); v[i][1] = *(const f32x4*)(xr + i * 512 + 4);
#pragma unroll
                for (int j = 0; j < 4; ++j) ss += v[i][0][j] * v[i][0][j] + v[i][1][j] * v[i][1][j]; }
            ss = wave_sum(ss);
            const float rinv = 1.0f / sqrtf(ss * (1.0f / 2048.0f) + EPS);
#pragma unroll
            for (int i = 0; i < 4; ++i) { const int col = i * 512 + F.lane * 8;
                const f32x4 a0 = *(const f32x4*)(cA + col), a1 = *(const f32x4*)(cA + col + 4), b0 = *(const f32x4*)(cB + col), b1 = *(const f32x4*)(cB + col + 4);
                const f32x4 y0 = v[i][0] * rinv * a0 + b0, y1 = v[i][1] * rinv * a1 + b1;
                *(u32x4*)(dst + row * 2048 + col) = pack8(y0, y1);
                if (FIRST) *(u32x2*)(dst8 + row * 2048 + col) = pack8_fp8(y0, y1); }
        }
    }
}

__device__ __forceinline__ void phase3_qknorm(Frame& F) {
    F.lane = lane_now(); F.tid = F.wave * 64 + F.lane;
    const bf16_t* q = (const bf16_t*)(F.ws + WS_QN); const bf16_t* k = (const bf16_t*)(F.ws + WS_KN); const bf16_t* v = (const bf16_t*)(F.ws + WS_V);
    unsigned char* q8 = F.ws + WS_Q8; unsigned char* k8 = F.ws + WS_K8; unsigned char* v8 = F.ws + WS_V8;
    const int gw = F.bid * 8 + F.wave, NGW = F.G * 8;
    for (int row = gw; row < MTOK; row += NGW) {
#pragma unroll
        for (int i = 0; i < 2; ++i) { const int ci = i * 64 + F.lane;
            f32x4 a, b; unpack8(*(const u32x4*)(q + (size_t)row * 1024 + ci * 8), a, b);
            float ss = a[0] * a[0] + a[1] * a[1] + a[2] * a[2] + a[3] * a[3] + b[0] * b[0] + b[1] * b[1] + b[2] * b[2] + b[3] * b[3];
            ss = row_sum16(ss);
            const float rinv = 1.0f / sqrtf(ss * (1.0f / 128.0f) + EPS);
            const float* gp = F.g_q + (ci & 15) * 8; const f32x4 g0 = *(const f32x4*)gp, g1 = *(const f32x4*)(gp + 4);
            *(u32x2*)(q8 + (size_t)row * 1024 + ci * 8) = pack8_fp8(a * rinv * g0, b * rinv * g1); }
        { const int ci = F.lane & 31; const bool isk = F.lane < 32;
            f32x4 a, b; unpack8(*(const u32x4*)((isk ? k : v) + (size_t)row * 256 + ci * 8), a, b);
            float ss = a[0] * a[0] + a[1] * a[1] + a[2] * a[2] + a[3] * a[3] + b[0] * b[0] + b[1] * b[1] + b[2] * b[2] + b[3] * b[3];
            ss = row_sum16(ss);
            const float rinv = isk ? 1.0f / sqrtf(ss * (1.0f / 128.0f) + EPS) : 1.0f;
            const float* gp = F.g_k + (ci & 15) * 8; f32x4 g0 = *(const f32x4*)gp, g1 = *(const f32x4*)(gp + 4);
            if (!isk) { g0 = (f32x4){1.f, 1.f, 1.f, 1.f}; g1 = g0; }
            *(u32x2*)((isk ? k8 : v8) + (size_t)row * 256 + ci * 8) = pack8_fp8(a * rinv * g0, b * rinv * g1); }
    }
}
template <int W> __device__ __forceinline__ void pooled_item(const bf16_t* pl, bf16_t* po, int row, int c8) {
    const int t = row & (SEQ - 1);
    f32x4 s0 = (f32x4){0.f, 0.f, 0.f, 0.f}, s1 = s0, x0 = s0, x1 = s0;
    u32x4 v[W];
#pragma unroll
    for (int j = 0; j < W; ++j) v[j] = *(const u32x4*)(pl + (size_t)(row - (j <= t ? j : 0)) * 1024 + c8);
#pragma unroll
    for (int j = 0; j < W; ++j) { f32x4 a, b; unpack8(v[j], a, b); if (j == 0) { x0 = a; x1 = b; } if (j <= t) { s0 += a; s1 += b; } }
    const float inv = 1.0f / (float)((t + 1 < W) ? t + 1 : W);
    *(u32x4*)(po + (size_t)row * 1024 + c8) = pack8(s0 * inv - x0, s1 * inv - x1);
}
__device__ __forceinline__ void phase3_pooled(Frame& F) {
    F.lane = lane_now(); F.tid = F.wave * 64 + F.lane;
    const bf16_t* pl = (const bf16_t*)(F.ws + WS_PL); bf16_t* po = (bf16_t*)(F.ws + WS_POOLED);
    const int gw = F.bid * 8 + F.wave, NGW = F.G * 8;
    for (int it = gw; it < (MTOK / 2) * 4; it += NGW) {
        const int g = it & 3, row = (it >> 2) * 2 + (F.lane >> 5), c8 = g * 256 + (F.lane & 31) * 8;
        if (g == 0) pooled_item<2>(pl, po, row, c8); else if (g == 1) pooled_item<4>(pl, po, row, c8); else if (g == 2) pooled_item<8>(pl, po, row, c8); else pooled_item<16>(pl, po, row, c8);
    }
}
typedef float f32x16 __attribute__((ext_vector_type(16)));
__device__ __forceinline__ float wrelu_(float wh, float d, float acc) { return __builtin_fmaf(wh, d, __builtin_fmaf(wh, __builtin_fabsf(d), acc)); }
__device__ __forceinline__ int sel_code(float s, float smin, float scale) { const float c = (s - smin) * scale; return (int)fminf(fmaxf(c, 0.f), 65535.f); }
__device__ __forceinline__ void hist_find(const unsigned* hist, int lane, int K, int& bsel, int& above) {
    const u32x4 h = *(const u32x4*)(hist + lane * 4);
    const int S = (int)(h.x + h.y + h.z + h.w);
    int x = S;
    x += __builtin_amdgcn_update_dpp(0, x, 0x101, 0xF, 0xF, true);
    x += __builtin_amdgcn_update_dpp(0, x, 0x102, 0xF, 0xF, true);
    x += __builtin_amdgcn_update_dpp(0, x, 0x104, 0xF, 0xF, true);
    x += __builtin_amdgcn_update_dpp(0, x, 0x108, 0xF, 0xF, true);
    const int t1 = __builtin_amdgcn_readlane(x, 16), t2 = __builtin_amdgcn_readlane(x, 32), t3 = __builtin_amdgcn_readlane(x, 48);
    const int r = lane >> 4;
    x += (r == 0 ? t1 + t2 + t3 : (r == 1 ? t2 + t3 : (r == 2 ? t3 : 0)));
    const int sufn = x - S;
    const bool mine = (x >= K) && (sufn < K);
    int b = 0, ab = 0;
    { int c = sufn;
      if (c + (int)h.w >= K) { b = 3; ab = c; } else { c += (int)h.w;
      if (c + (int)h.z >= K) { b = 2; ab = c; } else { c += (int)h.z;
      if (c + (int)h.y >= K) { b = 1; ab = c; } else { c += (int)h.y; b = 0; ab = c; } } } }
    const unsigned long long m = __ballot(mine);
    const int src = m ? (int)__builtin_ctzll(m) : 0;
    bsel = __builtin_amdgcn_readlane(lane * 4 + b, src); above = __builtin_amdgcn_readlane(ab, src);
}
__device__ __forceinline__ int mask_prefix(unsigned long long m) { return (int)__builtin_amdgcn_mbcnt_hi((unsigned)(m >> 32), __builtin_amdgcn_mbcnt_lo((unsigned)m, 0u)); }
template <class Fn> __device__ __forceinline__ void sel_sweep(const f32x4* rb4, int n4, int lane, int t, Fn fn) {
    f32x4 cur = rb4[lane];
    for (int c4 = 0; c4 < n4 - 1; ++c4) { const f32x4 nxt = rb4[(c4 + 1) * 64 + lane];
#pragma unroll
        for (int k = 0; k < 4; ++k) fn(cur[k], (c4 * 4 + k) * 64 + lane, true);
        cur = nxt; }
    { const int c4 = n4 - 1;
#pragma unroll
      for (int k = 0; k < 4; ++k) { const int idx = (c4 * 4 + k) * 64 + lane; fn(cur[k], idx, idx <= t); } }
}
template <int MODE = 0> __device__ __forceinline__ void indexer_select(Frame& F, int b, int t, const float* rowbuf, unsigned* hist, float* eqv, int* eqi) {
    unsigned short* selrow = (unsigned short*)(F.ws + (MODE ? WS_R0 : WS_SEL)) + (size_t)(b * SEQ + t) * 256;
    int lane = F.lane; asm volatile("" : "+v"(lane));
    const int nch = t / 64 + 1, n4 = (nch + 3) >> 2;
    const f32x4* rb4 = (const f32x4*)rowbuf;
    float mn = __builtin_huge_valf(), mx = -__builtin_huge_valf();
    sel_sweep(rb4, n4, lane, t, [&](float v, int, bool valid) { mn = valid ? fminf(mn, v) : mn; mx = valid ? fmaxf(mx, v) : mx; });
    mx = xor16_max(row_max16(mx)); { const auto r = __builtin_amdgcn_permlane32_swap(__float_as_uint(mx), __float_as_uint(mx), false, false); mx = fmaxf(__uint_as_float(r[0]), __uint_as_float(r[1])); }
    mn = -mn; mn = xor16_max(row_max16(mn)); { const auto r = __builtin_amdgcn_permlane32_swap(__float_as_uint(mn), __float_as_uint(mn), false, false); mn = -fmaxf(__uint_as_float(r[0]), __uint_as_float(r[1])); }
    const float scale = (mx > mn) ? 65535.0f / (mx - mn) : 0.f;
    *(u32x4*)(hist + lane * 4) = (u32x4){0u, 0u, 0u, 0u};
    sel_sweep(rb4, n4, lane, t, [&](float v, int, bool valid) { if (valid) { if (MODE == 2) ((volatile unsigned*)hist)[sel_code(v, mn, scale) >> 8] = 1u; else atomicAdd(&hist[sel_code(v, mn, scale) >> 8], 1u); } });
    int b1, above1; hist_find(hist, lane, KSEL, b1, above1);
    *(u32x4*)(hist + lane * 4) = (u32x4){0u, 0u, 0u, 0u};
    sel_sweep(rb4, n4, lane, t, [&](float v, int, bool valid) { const int code = sel_code(v, mn, scale); if (valid && (code >> 8) == b1) atomicAdd(&hist[code & 255], 1u); });
    int b2, above2; hist_find(hist, lane, KSEL - above1, b2, above2);
    const int T16 = (b1 << 8) | b2, need = KSEL - above1 - above2, ceq = (int)hist[b2];
    const bool all_eq = (ceq == need), collect = !all_eq && (ceq <= 64);
    const int eq_budget = all_eq ? 0x7fffffff : (collect ? 0 : need);
    int pos = 0, eqseen = 0;
    sel_sweep(rb4, n4, lane, t, [&](float v, int idx, bool valid) {
        const int code = sel_code(v, mn, scale);
        const bool gt = valid && code > T16, eq = valid && code == T16;
        const unsigned long long mg = __ballot(gt);
        const unsigned p = (unsigned)(pos + mask_prefix(mg));
        if (gt && p < (unsigned)KSEL) selrow[p] = (unsigned short)idx;
        pos += __popcll(mg);
        const unsigned long long me = __ballot(eq);
        if (me) {
            const int er = eqseen + mask_prefix(me); const bool te = eq && er < eq_budget;
            if (collect && eq) { eqv[er] = v; eqi[er] = idx; }
            eqseen += __popcll(me);
            const unsigned long long mte = __ballot(te);
            const unsigned pe = (unsigned)(pos + mask_prefix(mte));
            if (te && pe < (unsigned)KSEL) selrow[pe] = (unsigned short)idx;
            pos += __popcll(mte);
        }
    });
    if (collect && lane < ceq) {
        const float sv = eqv[lane]; const int idx = eqi[lane]; int rank = 0;
        for (int m = 0; m < ceq; ++m) { const float ov = eqv[m]; const int oi = eqi[m]; rank += (ov > sv || (ov == sv && oi < idx)) ? 1 : 0; }
        if (rank < need) selrow[KSEL - need + rank] = (unsigned short)idx;
    }
}
__device__ __forceinline__ void indexer_tile(Frame& F, int b, int t0) {
    const bf16_t* iq = (const bf16_t*)(F.ws + WS_IQ); const bf16_t* ik = (const bf16_t*)(F.ws + WS_IK); const float* iw = (const float*)(F.ws + WS_IW);
    int lane = F.lane; asm volatile("" : "+v"(lane));
    const int w = F.wave;
    if (t0 < KSEL) {
        const int t = t0 + w; unsigned short* selrow = (unsigned short*)(F.ws + WS_SEL) + (size_t)(b * SEQ + t) * 256;
#pragma unroll
        for (int p = 0; p < 4; ++p) { const int j = p * 64 + lane; selrow[j] = (unsigned short)(j <= t ? j : 0xFFFF); }
        return;
    }
    float* rowbuf = (float*)F.lds;
    unsigned char* stage = F.lds + 131072;
    const int p = w & 3, kh = w >> 2, hi = lane >> 5, r = lane & 31;
    const size_t qrow = (size_t)b * SEQ + t0 + 2 * p + (r >> 4);
    bf16x8 a[4];
#pragma unroll
    for (int ks = 0; ks < 4; ++ks) a[ks] = *(const bf16x8*)(iq + qrow * 1024 + (r & 15) * 64 + ks * 16 + 8 * hi);
    float wq[2][8];
#pragma unroll
    for (int q = 0; q < 2; ++q)
#pragma unroll
        for (int i = 0; i < 8; ++i) wq[q][i] = 0.5f * iw[((size_t)b * SEQ + t0 + 2 * p + q) * 16 + (i & 3) + 8 * ((i >> 2) & 1) + 4 * hi];
    const int nchunks = (t0 + 7) / 64 + 1, nsteps = (nchunks + 1) >> 1;
    const unsigned char* gsrc = (const unsigned char*)(ik + (size_t)b * SEQ * 64) + F.tid * 16;
    const int skey = F.tid >> 3, sc16 = F.tid & 7, soff = skey * 128 + ((sc16 ^ ((skey >> 1) & 7)) << 4);
    u32x4 sa0 = *(const u32x4*)gsrc, sb0 = sa0, sa1 = sa0, sb1 = sa0;
    sb0 = *(const u32x4*)(gsrc + (size_t)min(1, nchunks - 1) * 8192);
    sa1 = *(const u32x4*)(gsrc + (size_t)min(2, nchunks - 1) * 8192);
    sb1 = *(const u32x4*)(gsrc + (size_t)min(3, nchunks - 1) * 8192);
    __syncthreads();
#if PROBE_IDX != 1 && PROBE_IDX != 5
#define IDX_LD(c) (*(const u32x4*)(gsrc + (size_t)(c) * 8192))
#endif
#define IDX_MMA(SA, SB, ss, D0, D1) do { const int s_ = (ss); unsigned char* sb = stage + (s_ & 1) * 16384; \
        *(u32x4*)(sb + soff) = SA; *(u32x4*)(sb + 8192 + soff) = SB; \
        __syncthreads(); \
        SA = IDX_LD(min(2 * s_ + 4, nchunks - 1)); \
        SB = IDX_LD(min(2 * s_ + 5, nchunks - 1)); \
        _Pragma("unroll") for (int i = 0; i < 16; ++i) { D0[i] = 0.f; D1[i] = 0.f; } \
        _Pragma("unroll") for (int ks = 0; ks < 4; ++ks) { const unsigned char* bp = sb + key * 128 + (((ks * 2 + hi) ^ ((key >> 1) & 7)) << 4); \
            const bf16x8 bf0 = *(const bf16x8*)bp, bf1 = *(const bf16x8*)(bp + 8192); \
            D0 = __builtin_amdgcn_mfma_f32_32x32x16_bf16(a[ks], bf0, D0, 0, 0, 0); D1 = __builtin_amdgcn_mfma_f32_32x32x16_bf16(a[ks], bf1, D1, 0, 0, 0); } } while (0)
#define IDX_RED(ss, D0, D1) do { const int s_ = (ss); float x0_ = 0.f, x1_ = 0.f, y0_ = 0.f, y1_ = 0.f; \
        _Pragma("unroll") for (int i = 0; i < 8; ++i) { x0_ = wrelu_(wq[0][i], D0[i], x0_); x1_ = wrelu_(wq[1][i], D0[8 + i], x1_); y0_ = wrelu_(wq[0][i], D1[i], y0_); y1_ = wrelu_(wq[1][i], D1[8 + i], y1_); } \
        const float scx = swap32_pair(x0_, x1_), scy = swap32_pair(y0_, y1_); \
        *(f32x2*)(rowbuf + (2 * p + hi) * 4096 + ((s_ >> 1) * 64 + key) * 4 + 2 * (s_ & 1)) = (f32x2){scx, scy}; } while (0)
    const int key = kh * 32 + r;
    f32x16 dA0, dA1, dB0, dB1;
#if PROBE_IDX == 1
#define IDX_LD(c) (*(const u32x4*)(gsrc + (size_t)(c) * 8192))
#elif PROBE_IDX == 5
#define IDX_LD(c) SAVED
#endif
#if PROBE_IDX == 1 || PROBE_IDX == 5
    { const u32x4 SAVED = sa0;
    IDX_MMA(sa0, sb0, 0, dA0, dA1);
    for (int s2 = 0; s2 < nsteps; s2 += 2) {
        if (s2 + 1 < nsteps) IDX_MMA(sa1, sb1, s2 + 1, dB0, dB1);
        IDX_RED(s2, dA0, dA1);
        if (s2 + 2 < nsteps) IDX_MMA(sa0, sb0, s2 + 2, dA0, dA1);
        if (s2 + 1 < nsteps) IDX_RED(s2 + 1, dB0, dB1);
    }
    __syncthreads();
    sa0 = *(const u32x4*)gsrc;
    sb0 = *(const u32x4*)(gsrc + (size_t)min(1, nchunks - 1) * 8192);
    sa1 = *(const u32x4*)(gsrc + (size_t)min(2, nchunks - 1) * 8192);
    sb1 = *(const u32x4*)(gsrc + (size_t)min(3, nchunks - 1) * 8192); }
#undef IDX_LD
#define IDX_LD(c) (*(const u32x4*)(gsrc + (size_t)(c) * 8192))
#endif
    IDX_MMA(sa0, sb0, 0, dA0, dA1);
    for (int s2 = 0; s2 < nsteps; s2 += 2) {
        if (s2 + 1 < nsteps) IDX_MMA(sa1, sb1, s2 + 1, dB0, dB1);
        IDX_RED(s2, dA0, dA1);
        if (s2 + 2 < nsteps) IDX_MMA(sa0, sb0, s2 + 2, dA0, dA1);
        if (s2 + 1 < nsteps) IDX_RED(s2 + 1, dB0, dB1);
    }
#undef IDX_MMA
#undef IDX_RED
#undef IDX_LD
    __syncthreads();
    indexer_select(F, b, t0 + w, rowbuf + w * 4096, (unsigned*)(F.lds + 147456) + w * 256, (float*)(F.lds + 155648) + w * 64, (int*)(F.lds + 155648 + 2048) + w * 64);
#if PROBE_IDX >= 2
    indexer_select<PROBE_IDX - 1>(F, b, t0 + w, rowbuf + w * 4096, (unsigned*)(F.lds + 147456) + w * 256, (float*)(F.lds + 155648) + w * 64, (int*)(F.lds + 155648 + 2048) + w * 64);
#endif
}
__device__ __forceinline__ void phase3_indexer(Frame& F) {
    F.lane = lane_now(); F.tid = F.wave * 64 + F.lane;
    volatile LAS unsigned* misc = (volatile LAS unsigned*)((LAS unsigned char*)F.lds + MISC_OFF);
    const unsigned keep0 = misc[0], keep1 = misc[1];
    __syncthreads();
    const int nit = BATCH * (SEQ / 8);
    for (int k = 0;; ++k) {
        const int l = k * F.G + ((k & 1) ? (F.G - 1 - F.bid) : F.bid);
        if (l >= nit) { if (k * F.G >= nit) break; else continue; }
        const int qb = (SEQ / 8 - 1) - (l >> 3), b = l & 7;
        indexer_tile(F, b, qb * 8);
    }
    __syncthreads();
    if (F.tid == 0) { misc[0] = keep0; misc[1] = keep1; }
}

__device__ const unsigned char g_bucket[128] = {0, 1, 2, 3, 4, 5, 6, 7, 8, 9, 10, 11, 12, 13, 14, 15, 16, 16, 16, 17, 17, 18, 18, 18, 19, 19, 19, 20, 20, 20, 20, 21, 21, 21, 21, 22, 22, 22, 22, 22, 23, 23, 23, 23, 23, 23, 24, 24, 24, 24, 24, 24, 25, 25, 25, 25, 25, 25, 25, 26, 26, 26, 26, 26, 26, 26, 26, 27, 27, 27, 27, 27, 27, 27, 27, 27, 27, 28, 28, 28, 28, 28, 28, 28, 28, 28, 28, 29, 29, 29, 29, 29, 29, 29, 29, 29, 29, 29, 29, 30, 30, 30, 30, 30, 30, 30, 30, 30, 30, 30, 30, 30, 30, 31, 31, 31, 31, 31, 31, 31, 31, 31, 31, 31, 31, 31, 31, 31};
__device__ __forceinline__ void at_pv_step(f32x4 (&D0)[8], f32x4 (&D1)[8], const u32x4 (&buf)[8], LAS unsigned char* vwr, LAS unsigned char* ard, LAS unsigned char* brd) {
#pragma unroll
    for (int c = 0; c < 8; ++c) *(LAS u32x4*)(vwr + c * 576) = buf[c];
    const long pb = __builtin_bit_cast(long, __builtin_amdgcn_ds_read_tr8_b64_v2i32((LAS v2i*)brd));
#pragma unroll
    for (int tl = 0; tl < 8; ++tl) { const long va = __builtin_bit_cast(long, __builtin_amdgcn_ds_read_tr8_b64_v2i32((LAS v2i*)(ard + tl * 16))); D0[tl] = __builtin_amdgcn_mfma_f32_16x16x32_fp8_fp8(va, pb, D0[tl], 0, 0, 0); }
#pragma unroll
    for (int tl = 0; tl < 8; ++tl) { const long va = __builtin_bit_cast(long, __builtin_amdgcn_ds_read_tr8_b64_v2i32((LAS v2i*)(ard + 4608 + tl * 16))); D1[tl] = __builtin_amdgcn_mfma_f32_16x16x32_fp8_fp8(va, pb, D1[tl], 0, 0, 0); }
}
__device__ __forceinline__ void phase4_attention(Frame& F) {
    F.lane = lane_now(); F.tid = F.wave * 64 + F.lane;
    const unsigned char* q8 = F.ws + WS_Q8; const unsigned char* k8 = F.ws + WS_K8; const unsigned char* v8 = F.ws + WS_V8;
    const unsigned short* sel = (const unsigned short*)(F.ws + WS_SEL); unsigned char* ao = F.ws + WS_ATTN;
    float* btab = (float*)F.lds;
    __syncthreads();
    for (int i = F.tid; i < 256; i += 512) btab[i] = F.rel_bias[i];
    __syncthreads();
    constexpr int WST = 16512;
    unsigned char* wgp = F.lds + 4096 + F.wave * WST;
    bf16_t* Pb = (bf16_t*)(wgp + 9216); int* idl = (int*)(wgp + 13312); float* psl = (float*)(wgp + 16384); float* pml = psl + 8;
    LAS unsigned char* wl = (LAS unsigned char*)F.lds + 4096 + F.wave * WST;
    const bool xmap = (F.G % 8) == 0;
    const int gw = xmap ? (F.bid / 8) * 8 + F.wave : F.bid * 8 + F.wave, NGW = xmap ? F.G : F.G * 8, nrows = xmap ? SEQ : MTOK;
    for (int rr = gw; rr < nrows; rr += NGW) {
        int lane = F.lane; asm volatile("" : "+v"(lane));
        const int row = xmap ? (F.bid & 7) * SEQ + rr : rr;
        const int b = row / SEQ, t = row % SEQ, r = lane & 31, hi = lane >> 5;
#pragma unroll
        for (int p = 0; p < 4; ++p) { idl[p * 64 + lane] = (int)sel[(size_t)row * 256 + p * 64 + lane]; }
        long a0[8], a1[8];
        { u32x4 qa[4];
#pragma unroll
          for (int i = 0; i < 4; ++i) qa[i] = (r < 8) ? *(const u32x4*)(q8 + (size_t)row * 1024 + r * 128 + hi * 64 + i * 16) : (u32x4){0u, 0u, 0u, 0u};
#pragma unroll
          for (int ks = 0; ks < 8; ++ks) { const unsigned lo = qa[ks >> 1][(ks & 1) * 2], hh = qa[ks >> 1][(ks & 1) * 2 + 1]; const long v = (long)(((unsigned long long)hh << 32) | lo);
              a0[ks] = (r < 4) ? v : 0l; a1[ks] = (r >= 4) ? v : 0l; } }
        f32x4 psum = (f32x4){0.f, 0.f, 0.f, 0.f}, pmax = psum;
        const int vg4 = lane >> 4, vch = lane & 15;
#define AT_LOADK(buf, kb) do { _Pragma("unroll") for (int c = 0; c < 8; ++c) { const int key_ = idl[(kb) * 32 + 4 * c + vg4]; const int kc_ = key_ <= t ? key_ : 0; \
            buf[c] = *(const u32x4*)(k8 + ((size_t)b * SEQ + kc_) * 256 + vch * 16); } } while (0)
#define AT_QK(buf, kb) do { const int key_ = idl[(kb) * 32 + r]; const bool valid_ = key_ <= t; const int kc_ = valid_ ? key_ : 0; \
            _Pragma("unroll") for (int c = 0; c < 8; ++c) *(LAS u32x4*)(wl + (4 * c + vg4) * 272 + vch * 16) = buf[c]; \
            u32x4 g0_[4], g1_[4]; \
            _Pragma("unroll") for (int i = 0; i < 4; ++i) { g0_[i] = *(const LAS u32x4*)(wl + r * 272 + hi * 64 + i * 16); g1_[i] = *(const LAS u32x4*)(wl + r * 272 + 128 + hi * 64 + i * 16); } \
            f32x16 d; _Pragma("unroll") for (int i = 0; i < 16; ++i) d[i] = 0.f; \
            _Pragma("unroll") for (int ks = 0; ks < 8; ++ks) { const long bv_ = (long)(((unsigned long long)g0_[ks >> 1][(ks & 1) * 2 + 1] << 32) | g0_[ks >> 1][(ks & 1) * 2]); d = __builtin_amdgcn_mfma_f32_32x32x16_fp8_fp8(a0[ks], bv_, d, 0, 0, 0); } \
            _Pragma("unroll") for (int ks = 0; ks < 8; ++ks) { const long bv_ = (long)(((unsigned long long)g1_[ks >> 1][(ks & 1) * 2 + 1] << 32) | g1_[ks >> 1][(ks & 1) * 2]); d = __builtin_amdgcn_mfma_f32_32x32x16_fp8_fp8(a1[ks], bv_, d, 0, 0, 0); } \
            const int dist_ = t - kc_; const int bkt_ = dist_ < 128 ? (int)g_bucket[dist_] : 31; \
            const f32x4 bias_ = *(const f32x4*)(btab + bkt_ * 8 + 4 * hi); f32x4 e_; \
            _Pragma("unroll") for (int i = 0; i < 4; ++i) e_[i] = valid_ ? __expf(d[i] * 0.08838834764831845f + bias_[i]) : 0.f; \
            psum += e_; _Pragma("unroll") for (int i = 0; i < 4; ++i) pmax[i] = fmaxf(pmax[i], e_[i]); \
            *(u32x2*)(Pb + ((kb) * 32 + r) * 8 + 4 * hi) = (u32x2){cvt_pk_bf16(e_[0], e_[1]), cvt_pk_bf16(e_[2], e_[3])}; } while (0)
        {
            u32x4 kA[8], kB[8];
            AT_LOADK(kA, 0);
#pragma unroll 1
            for (int kb = 0; kb < 8; kb += 2) {
                AT_LOADK(kB, kb + 1);
                AT_QK(kA, kb);
                if (kb + 2 < 8) AT_LOADK(kA, kb + 2);
                AT_QK(kB, kb + 1);
            }
        }
#undef AT_LOADK
#undef AT_QK
#pragma unroll
        for (int i = 0; i < 4; ++i) { psum[i] = xor16_sum(row_sum16(psum[i])); pmax[i] = xor16_max(row_max16(pmax[i])); }
        if (r == 0) { *(f32x4*)(psl + 4 * hi) = psum; *(f32x4*)(pml + 4 * hi) = pmax; }
        const int kq = lane >> 4, tq = (lane >> 1) & 7, tp = lane & 1;
#define AT_LOADV(buf, ks_) do { _Pragma("unroll") for (int c = 0; c < 8; ++c) { const int key_ = idl[(ks_) * 32 + 4 * c + vg4]; const int kc_ = key_ <= t ? key_ : 0; \
            buf[c] = *(const u32x4*)(v8 + ((size_t)b * SEQ + kc_) * 256 + vch * 16); } } while (0)
        u32x4 vA[8], vB[8];
        AT_LOADV(vA, 0);
        { const f32x4 m0 = *(const f32x4*)pml, m1 = *(const f32x4*)(pml + 4);
          f32x4 r0, r1;
#pragma unroll
          for (int i = 0; i < 4; ++i) { r0[i] = __builtin_amdgcn_rcpf(m0[i]); r1[i] = __builtin_amdgcn_rcpf(m1[i]); }
#pragma unroll
          for (int i = 0; i < 4; ++i) { const int key = i * 64 + lane;
              f32x4 pa, pb; unpack8(*(const u32x4*)(Pb + key * 8), pa, pb);
              *(LAS u32x2*)(wl + 14336 + key * 8) = pack8_fp8(pa * r0, pb * r1); } }
        f32x4 D0[8], D1[8];
#pragma unroll
        for (int tl = 0; tl < 8; ++tl) { D0[tl] = (f32x4){0.f, 0.f, 0.f, 0.f}; D1[tl] = D0[tl]; }
        LAS unsigned char* vwr = wl + (vch >> 3) * 4608 + vg4 * 144 + (vch & 7) * 16;
        LAS unsigned char* ard = wl + (kq * 8 + tq) * 144 + 8 * tp;
        LAS unsigned char* brd = wl + 14336 + (kq * 8 + tq) * 8;
#pragma unroll 1
        for (int ks = 0; ks < 8; ks += 2) {
            AT_LOADV(vB, ks + 1);
            at_pv_step(D0, D1, vA, vwr, ard, brd + ks * 256);
            if (ks + 2 < 8) AT_LOADV(vA, ks + 2);
            at_pv_step(D0, D1, vB, vwr, ard, brd + (ks + 1) * 256);
        }
#undef AT_LOADV
        { const int n = lane & 15, q4 = lane >> 4;
          if (n < 8) { const float sc = pml[n] / psl[n]; const bool g1 = n >= 4;
              unsigned char* op = ao + (size_t)row * 1024 + n * 128 + q4 * 4;
#pragma unroll
              for (int tl = 0; tl < 8; ++tl) { const f32x4 d = (g1 ? D1[tl] : D0[tl]) * sc;
                  int w = __builtin_amdgcn_cvt_pk_fp8_f32(d[0], d[1], 0, false); w = __builtin_amdgcn_cvt_pk_fp8_f32(d[2], d[3], w, true);
                  *(unsigned*)(op + tl * 16) = (unsigned)w; } } }
    }
}

__device__ __forceinline__ float dot16f8(u32x4 w, const float* h) {
    float s = 0.f;
#pragma unroll
    for (int d = 0; d < 4; ++d) { const f32x2 lo = __builtin_amdgcn_cvt_pk_f32_fp8((int)w[d], false), hi = __builtin_amdgcn_cvt_pk_f32_fp8((int)w[d], true);
        s += lo.x * h[4 * d] + lo.y * h[4 * d + 1] + hi.x * h[4 * d + 2] + hi.y * h[4 * d + 3]; }
    return s;
}
__device__ __forceinline__ void fma16f8(u32x4 w, float cf, float* acc) {
#pragma unroll
    for (int d = 0; d < 4; ++d) { const f32x2 lo = __builtin_amdgcn_cvt_pk_f32_fp8((int)w[d], false), hi = __builtin_amdgcn_cvt_pk_f32_fp8((int)w[d], true);
        acc[4 * d] += cf * lo.x; acc[4 * d + 1] += cf * lo.y; acc[4 * d + 2] += cf * hi.x; acc[4 * d + 3] += cf * hi.y; }
}
__device__ __forceinline__ float gelu_erf(float x) { return 0.5f * x * (1.0f + erff(x * 0.70710678118654752f)); }
__device__ __forceinline__ void ce_k(unsigned& a, unsigned& b) { const unsigned hi = a > b ? a : b, lo = a > b ? b : a; a = hi; b = lo; }
__device__ __forceinline__ void ce_kp(unsigned& ka, unsigned& pa, unsigned& kb, unsigned& pb) { const bool sw = kb > ka; const unsigned k0 = sw ? kb : ka, k1 = sw ? ka : kb, p0 = sw ? pb : pa, p1 = sw ? pa : pb; ka = k0; kb = k1; pa = p0; pb = p1; }
__device__ __forceinline__ void bmerge16(unsigned (&x)[16]) {
#pragma unroll
    for (int jj = 0; jj < 4; ++jj) { const int j = 8 >> jj;
#pragma unroll
        for (int i = 0; i < 16; ++i) { const int l = i ^ j; if (l > i) ce_k(x[i], x[l]); }
        __builtin_amdgcn_sched_barrier(0); }
}
__device__ __forceinline__ void bmerge16p(unsigned (&x)[16], unsigned (&p)[16]) {
#pragma unroll
    for (int jj = 0; jj < 4; ++jj) { const int j = 8 >> jj;
#pragma unroll
        for (int i = 0; i < 16; ++i) { const int l = i ^ j; if (l > i) ce_kp(x[i], p[i], x[l], p[l]); }
        __builtin_amdgcn_sched_barrier(0); }
}
__device__ __forceinline__ void bsort16(unsigned (&x)[16]) {
#pragma unroll
    for (int kk = 1; kk <= 4; ++kk) { const int k = 1 << kk;
#pragma unroll
        for (int jj = 0; jj < 4; ++jj) { const int j = (k >> 1) >> jj;
            if (j > 0) {
#pragma unroll
                for (int i = 0; i < 16; ++i) { const int l = i ^ j; if (l > i) { if ((i & k) == 0) ce_k(x[i], x[l]); else ce_k(x[l], x[i]); } }
                __builtin_amdgcn_sched_barrier(0); } } }
}
__device__ __forceinline__ void bsort16p(unsigned (&x)[16], unsigned (&p)[16]) {
#pragma unroll
    for (int kk = 1; kk <= 4; ++kk) { const int k = 1 << kk;
#pragma unroll
        for (int jj = 0; jj < 4; ++jj) { const int j = (k >> 1) >> jj;
            if (j > 0) {
#pragma unroll
                for (int i = 0; i < 16; ++i) { const int l = i ^ j; if (l > i) { if ((i & k) == 0) ce_kp(x[i], p[i], x[l], p[l]); else ce_kp(x[l], p[l], x[i], p[i]); } }
                __builtin_amdgcn_sched_barrier(0); } } }
}
__device__ __forceinline__ void top16_row(const unsigned char* rowp, unsigned (&t)[16]) {
#pragma unroll
    for (int i = 0; i < 16; ++i) t[i] = 0u;
#pragma unroll 1
    for (int g = 0; g < 8; ++g) {
        unsigned w[8];
#pragma unroll
        for (int q = 0; q < 4; ++q) { const u32x2 v = *(const u32x2*)(rowp + g * 32 + q * 8); w[2 * q] = v.x; w[2 * q + 1] = v.y; }
        unsigned sk[16];
#pragma unroll
        for (int d = 0; d < 8; ++d) {
            const unsigned lo = w[d] << 16, hi = w[d];
            const unsigned xl = lo ^ ((unsigned)((int)lo >> 31) | 0x80000000u), xh = hi ^ ((unsigned)((int)hi >> 31) | 0x80000000u);
            sk[2 * d] = ((xl >> 9) & 0xFFFFFF80u) | (unsigned)(127 - (g * 16 + 2 * d));
            sk[2 * d + 1] = ((xh >> 9) & 0xFFFFFF80u) | (unsigned)(127 - (g * 16 + 2 * d + 1)); }
        bsort16(sk);
#pragma unroll
        for (int i = 0; i < 16; ++i) t[i] = t[i] > sk[15 - i] ? t[i] : sk[15 - i];
        bmerge16(t);
    }
}
__device__ __forceinline__ float key_val(unsigned key) { const unsigned y = (key << 9) & 0xFFFF0000u; return __uint_as_float((y ^ (~(unsigned)((int)y >> 31) | 0x80000000u)) & 0xFFFF0000u); }
__device__ __forceinline__ unsigned sum_key(float s, int c) { const unsigned u = __float_as_uint(s); return ((u ^ ((unsigned)((int)u >> 31) | 0x80000000u)) & ~63u) | (unsigned)(63 - c); }
__device__ __forceinline__ float sum_val(unsigned k) { const unsigned y = k & ~63u; return __uint_as_float(y ^ (~(unsigned)((int)y >> 31) | 0x80000000u)); }
typedef __bf16 bf2_t __attribute__((ext_vector_type(2)));
__device__ __forceinline__ float dot2_bf(unsigned a, unsigned b, float c) { return __builtin_amdgcn_fdot2_f32_bf16(__builtin_bit_cast(bf2_t, a), __builtin_bit_cast(bf2_t, b), c, false); }
__device__ __forceinline__ float dot32_f6b(u32x4 wa, u32x2 wb, u32x4 h0, u32x4 h1, u32x4 h2, u32x4 h3) {
    const bf16x32 dec = __builtin_amdgcn_cvt_scalef32_pk32_bf16_fp6((u32x6){wa.x, wa.y, wa.z, wa.w, wb.x, wb.y}, 1.0f);
    const u32x16 ud = __builtin_bit_cast(u32x16, dec);
    float acc = 0.f;
    acc = dot2_bf(ud.s0, h0.x, acc); acc = dot2_bf(ud.s1, h0.y, acc); acc = dot2_bf(ud.s2, h0.z, acc); acc = dot2_bf(ud.s3, h0.w, acc);
    acc = dot2_bf(ud.s4, h1.x, acc); acc = dot2_bf(ud.s5, h1.y, acc); acc = dot2_bf(ud.s6, h1.z, acc); acc = dot2_bf(ud.s7, h1.w, acc);
    acc = dot2_bf(ud.s8, h2.x, acc); acc = dot2_bf(ud.s9, h2.y, acc); acc = dot2_bf(ud.sa, h2.z, acc); acc = dot2_bf(ud.sb, h2.w, acc);
    acc = dot2_bf(ud.sc, h3.x, acc); acc = dot2_bf(ud.sd, h3.y, acc); acc = dot2_bf(ud.se, h3.z, acc); acc = dot2_bf(ud.sf, h3.w, acc);
    return acc;
}
__device__ const unsigned char g_cab[64] = {0, 1, 2, 3, 4, 5, 6, 7, 8, 9, 10, 11, 12, 13, 14, 15, 16, 17, 18, 19, 20, 21, 22, 23, 32, 33, 34, 35, 36, 48, 49, 50, 51, 64, 65, 66, 80, 81, 96, 97, 112, 113, 128, 144, 160, 176, 192, 208, 224, 240, 0, 0, 0, 0, 0, 0, 0, 0, 0, 0, 0, 0, 0, 0};
template <int PMODE = 0> __device__ __forceinline__ void phase10_peer(Frame& F) {
    F.lane = lane_now(); F.tid = F.wave * 64 + F.lane;
    const bf16_t* sub = (const bf16_t*)(F.ws + WS_SUB); const bf16_t* h2 = (const bf16_t*)(F.ws + WS_H2);
    const unsigned char* pu = F.ws + WS_PU; unsigned* pairs = (unsigned*)(F.ws + WS_PAIRS);
    const int gw = F.bid * 8 + F.wave, NGW = F.G * 8;
    unsigned char* wb = F.lds + F.wave * 19200;
    unsigned char* h2b = wb; unsigned short* gl16 = (unsigned short*)(wb + 16896); unsigned* hist = (unsigned*)(wb + 18944); unsigned* base = hist + 32;
    unsigned* tmp = (unsigned*)wb;
    unsigned* wls0 = (unsigned*)(F.ws + WS_WLS) + (size_t)gw * 1024;
    const int ntok = (MTOK - gw + NGW - 1) / NGW;
    const bool wgsync = (MTOK % (NGW * 8)) == 0;
    constexpr int CA[50] = {0,0,0,0,0,0,0,0,0,0,0,0,0,0,0,0, 1,1,1,1,1,1,1,1, 2,2,2,2,2, 3,3,3,3, 4,4,4, 5,5, 6,6, 7,7, 8,9,10,11,12,13,14,15};
    constexpr int CB[50] = {0,1,2,3,4,5,6,7,8,9,10,11,12,13,14,15, 0,1,2,3,4,5,6,7, 0,1,2,3,4, 0,1,2,3, 0,1,2, 0,1, 0,1, 0,1, 0,0,0,0,0,0,0,0};
    for (int p0 = 0; p0 < ntok; p0 += 8) {
        int lane = F.lane; asm volatile("" : "+v"(lane));
        const int nt = (ntok - p0) < 8 ? (ntok - p0) : 8;
        {
            u32x4 st[16];
#define SEL_LOAD(half) do { asm volatile("" : "+v"(lane)); const int srow_l = lane >> 4, scol = lane & 15; _Pragma("unroll") for (int it = 0; it < 16; ++it) { const int r_ = it * 4 + srow_l; int ti_ = r_ >> 3; ti_ = ti_ < nt ? ti_ : nt - 1; \
                st[it] = *(const u32x4*)(sub + (size_t)(gw + (p0 + ti_) * NGW) * 2048 + (r_ & 7) * 256 + (half) * 128 + scol * 8); } } while (0)
#define SEL_STORE() do { const int srow_l = lane >> 4, scol = lane & 15; _Pragma("unroll") for (int it = 0; it < 16; ++it) { unsigned char* d_ = wb + (it * 4 + srow_l) * 264 + scol * 16; \
                *(u32x2*)d_ = (u32x2){st[it].x, st[it].y}; *(u32x2*)(d_ + 8) = (u32x2){st[it].z, st[it].w}; } } while (0)
            unsigned tA[16], tB[16];
            SEL_LOAD(0); SEL_STORE();
            __builtin_amdgcn_sched_barrier(0);
            top16_row(wb + lane * 264, tA);
            __builtin_amdgcn_sched_barrier(0);
            asm volatile("" : "+v"(tA[0]), "+v"(tA[1]), "+v"(tA[2]), "+v"(tA[3]), "+v"(tA[4]), "+v"(tA[5]), "+v"(tA[6]), "+v"(tA[7]), "+v"(tA[8]), "+v"(tA[9]), "+v"(tA[10]), "+v"(tA[11]), "+v"(tA[12]), "+v"(tA[13]), "+v"(tA[14]), "+v"(tA[15]) :: "memory");
            SEL_LOAD(1); SEL_STORE();
            __builtin_amdgcn_sched_barrier(0);
            top16_row(wb + lane * 264, tB);
            __builtin_amdgcn_sched_barrier(0);
#undef SEL_LOAD
#undef SEL_STORE
            float vA[16], vB[16];
            { unsigned pa[4] = {0u, 0u, 0u, 0u}, pb[4] = {0u, 0u, 0u, 0u};
#pragma unroll
              for (int i = 0; i < 16; ++i) { vA[i] = key_val(tA[i]); vB[i] = key_val(tB[i]); pa[i >> 2] |= (127u - (tA[i] & 127u)) << (8 * (i & 3)); pb[i >> 2] |= (127u - (tB[i] & 127u)) << (8 * (i & 3)); }
              unsigned char* rp = wb + lane * 264;
              *(u32x2*)rp = (u32x2){pa[0], pa[1]}; *(u32x2*)(rp + 8) = (u32x2){pa[2], pa[3]}; *(u32x2*)(rp + 16) = (u32x2){pb[0], pb[1]}; *(u32x2*)(rp + 24) = (u32x2){pb[2], pb[3]}; }
            unsigned tk[16];
#pragma unroll
            for (int c = 0; c < 16; ++c) tk[c] = sum_key(vA[CA[c]] + vB[CB[c]], c);
            bsort16(tk);
#pragma unroll
            for (int grp = 1; grp < 3; ++grp) {
                unsigned sk[16];
#pragma unroll
                for (int e = 0; e < 16; ++e) { const int c = grp * 16 + e; sk[e] = sum_key(vA[CA[c]] + vB[CB[c]], c); }
                bsort16(sk);
#pragma unroll
                for (int i = 0; i < 16; ++i) tk[i] = tk[i] > sk[15 - i] ? tk[i] : sk[15 - i];
                bmerge16(tk);
            }
#pragma unroll
            for (int c = 48; c < 50; ++c) { unsigned k = sum_key(vA[CA[c]] + vB[CB[c]], c);
#pragma unroll
                for (int i = 0; i < 16; ++i) ce_k(tk[i], k); }
            const float s0 = sum_val(tk[0]); float ev[16], esum = 0.f;
#pragma unroll
            for (int r = 0; r < 16; ++r) { ev[r] = __expf(sum_val(tk[r]) - s0); esum += ev[r]; }
            const float einv = 1.0f / esum;
            unsigned eid[16];
            { const unsigned char* rp = wb + lane * 264;
#pragma unroll
              for (int r = 0; r < 16; ++r) { const unsigned cab = g_cab[63u - (tk[r] & 63u)]; eid[r] = (unsigned)rp[cab >> 4] * 128u + (unsigned)rp[16 + (cab & 15u)]; } }
            if ((lane >> 3) < nt) {
#pragma unroll
                for (int r = 0; r < 16; ++r) { const int e = lane * 16 + r; tmp[e] = ((unsigned)e << 14) | eid[r]; gl16[e] = (unsigned short)(cvt_pk_bf16(ev[r] * einv, 0.f) & 0xffffu); } }
        }
        asm volatile("" : "+v"(lane));
        const int ne = nt * 128;
        {
            if (lane < 32) hist[lane] = 0u;
            unsigned ent[16]; unsigned rk[16];
#pragma unroll
            for (int q = 0; q < 16; ++q) { const int e = q * 64 + lane; ent[q] = (e < ne) ? tmp[e] : 0u; rk[q] = (e < ne) ? atomicAdd(&hist[(ent[q] & 0x3FFFu) >> 9], 1u) : 0u; }
            { int hv = lane < 32 ? (int)hist[lane] : 0; int x = hv;
              x += __builtin_amdgcn_update_dpp(0, x, 0x111, 0xF, 0xF, true); x += __builtin_amdgcn_update_dpp(0, x, 0x112, 0xF, 0xF, true);
              x += __builtin_amdgcn_update_dpp(0, x, 0x114, 0xF, 0xF, true); x += __builtin_amdgcn_update_dpp(0, x, 0x118, 0xF, 0xF, true);
              const int t0 = __builtin_amdgcn_readlane(x, 15); if (lane >= 16) x += t0;
              if (lane < 32) base[lane] = (unsigned)(x - hv); }
#pragma unroll
            for (int q = 0; q < 16; ++q) { const int e = q * 64 + lane; if (e < ne) wls0[base[(ent[q] & 0x3FFFu) >> 9] + rk[q]] = ent[q]; }
        }
        asm volatile("s_waitcnt vmcnt(0)" ::: "memory");
        asm volatile("" : "+v"(lane));
#pragma unroll 1
        for (int i = 0; i < nt; ++i) { const bf16_t* hr = h2 + (size_t)(gw + (p0 + i) * NGW) * 2048 + lane * 32;
            f32x4 v[8]; float m = 0.f;
#pragma unroll
            for (int q = 0; q < 4; ++q) { unpack8(*(const u32x4*)(hr + q * 8), v[2 * q], v[2 * q + 1]); }
#pragma unroll
            for (int q = 0; q < 8; ++q)
#pragma unroll
                for (int k = 0; k < 4; ++k) m = fmaxf(m, __builtin_fabsf(v[q][k]));
            int sb = (int)((__float_as_uint(m * 1.0666667f) >> 23) & 0xFFu) - 2; sb = sb < 1 ? 1 : (sb > 253 ? 253 : sb);
            const float inv = __uint_as_float((unsigned)(254 - sb) << 23);
            u32x16 pk;
#pragma unroll
            for (int q = 0; q < 8; ++q) { const f32x4 a = v[q] * inv; pk[2 * q] = cvt_pk_bf16(a[0], a[1]); pk[2 * q + 1] = cvt_pk_bf16(a[2], a[3]); }
            const u32x6 p6 = __builtin_amdgcn_cvt_scalef32_pk32_fp6_bf16(__builtin_bit_cast(bf16x32, pk), 1.0f);
            const int lp = (lane >> 2) + 16 * (lane & 3);
            *(u32x4*)(h2b + i * 2048 + lp * 16) = (u32x4){p6[0], p6[1], p6[2], p6[3]};
            *(u32x4*)(h2b + i * 2048 + 1024 + lp * 16) = (u32x4){p6[4], p6[5], (unsigned)sb, 0u}; }
        if (PMODE != 1) {
            const int dg = lane >> 4, dc = lane & 15;
            const bool dv = (dc >> 2) == dg; const int dr = dc & 3;
            const float w0 = (dv && dr == 0) ? 1.f : 0.f, w1 = (dv && dr == 1) ? 1.f : 0.f, w2 = (dv && dr == 2) ? 1.f : 0.f, w3 = (dv && dr == 3) ? 1.f : 0.f;
            unsigned entn = __hip_atomic_load(wls0 + lane, __ATOMIC_RELAXED, __HIP_MEMORY_SCOPE_AGENT);
#define U_LOAD(WA, WB, srcent, i0_) do { _Pragma("unroll") for (int jj = 0; jj < 8; ++jj) { const unsigned en_ = (unsigned)__builtin_amdgcn_readlane((int)(srcent), (i0_) + jj); \
                const unsigned char* ur = pu + (size_t)(en_ & 0x3FFFu) * 1536; WA[jj] = *(const u32x4*)(ur + lane * 16); WB[jj] = *(const u32x2*)(ur + 1024 + lane * 8); } } while (0)
#define U_COMP(WA, WB, i0_) do { float pr[8]; \
                _Pragma("unroll") for (int jj = 0; jj < 8; ++jj) { const unsigned en_ = (unsigned)__builtin_amdgcn_readlane((int)ent64, (i0_) + jj); const unsigned char* hp = h2b + ((en_ >> 21) & 7u) * 2048 + lane * 16; \
                    const u32x4 b0 = *(const u32x4*)hp, b1 = *(const u32x4*)(hp + 1024); \
                    const pg8::i32x8 A = (pg8::i32x8){(int)WA[jj].x, (int)WA[jj].y, (int)WA[jj].z, (int)WA[jj].w, (int)WB[jj].x, (int)WB[jj].y, 0, 0}; \
                    const pg8::i32x8 B = (pg8::i32x8){(int)b0.x, (int)b0.y, (int)b0.z, (int)b0.w, (int)b1.x, (int)b1.y, 0, 0}; \
                    const f32x4 D = __builtin_amdgcn_mfma_scale_f32_16x16x128_f8f6f4(A, B, (f32x4){0.f, 0.f, 0.f, 0.f}, 2  , 2  , 0, 0x7F7F7F7F, 0, (int)b1.z); \
                    pr[jj] = w0 * D[0] + w1 * D[1] + w2 * D[2] + w3 * D[3]; } \
                  \
                _Pragma("unroll") for (int i = 0; i < 4; ++i) pr[i] = swap32_pair(pr[i], pr[i + 4]); \
                _Pragma("unroll") for (int i = 0; i < 2; ++i) pr[i] = swap16_pair(pr[i], pr[i + 2]); \
                const bool b3 = (lane & 8) != 0; \
                { const float snd = b3 ? pr[0] : pr[1], kp = b3 ? pr[1] : pr[0]; pr[0] = kp + dpp_f<DPP_ROR8>(snd); } \
                float tot = pr[0]; tot += dpp_f<DPP_XOR1>(tot); tot += dpp_f<DPP_XOR2>(tot); tot += dpp_f<DPP_HMIRROR>(tot); \
                keep = ((lane & 7) == ((i0_) >> 3)) ? tot : keep;           \
            } while (0)
            u32x4 wA0[8], wA1[8]; u32x2 wB0[8], wB1[8];
            U_LOAD(wA0, wB0, entn, 0);
#pragma unroll 1
            for (int c = 0; c < ne; c += 64) {
                if (wgsync && (c & 255) == 0) __syncthreads();
                const unsigned ent64 = entn;
                const bool more = c + 64 < ne;
                if (more) entn = __hip_atomic_load(wls0 + c + 64 + lane, __ATOMIC_RELAXED, __HIP_MEMORY_SCOPE_AGENT);
                float keep = 0.f;
#pragma unroll 1
                for (int i0 = 0; i0 < 64; i0 += 16) {
                    U_LOAD(wA1, wB1, ent64, i0 + 8);
                    U_COMP(wA0, wB0, i0);
                    if (i0 + 16 < 64) U_LOAD(wA0, wB0, ent64, i0 + 16); else if (more) U_LOAD(wA0, wB0, entn, 0);
                    U_COMP(wA1, wB1, i0 + 8);
                }
                {
                    const unsigned em = (unsigned)__shfl((int)ent64, 8 * (lane & 7) + (lane >> 3));
                    const int ti = (int)(em >> 21), j = (int)((em >> 14) & 127u), row = gw + (p0 + ti) * NGW;
                    const float cf = gelu_erf(keep * (1.0f / 96.0f)) * __uint_as_float((unsigned)gl16[(em >> 14) & 1023u] << 16);
                    pairs[((size_t)(row >> 6) * 128 + j) * 64 + (row & 63)] = (((unsigned)__builtin_bit_cast(unsigned short, (_Float16)cf) << 16) & 0xFFFE0000u) | ((em & 0x3FFFu) << 3);
                }
            }
#undef U_LOAD
#undef U_COMP
        }
    }
}

__device__ __forceinline__ void phase11_peer_v(Frame& F, float* dst) {
    F.lane = lane_now(); F.tid = F.wave * 64 + F.lane;
    const unsigned* pairs = (const unsigned*)(F.ws + WS_PAIRS); const float* mf = (const float*)(F.ws + WS_MODF);
    unsigned long long* vs = (unsigned long long*)F.lds;
    for (int c0 = F.bid; c0 < DM / 8; c0 += F.G) {
        const int c = (c0 & 7) * 32 + (c0 >> 3);
        __syncthreads();
        { const u32x4* src = (const u32x4*)(F.ws + WS_PV + (size_t)c * NEXP * 8);
#pragma unroll 4
          for (int i = F.tid; i < NEXP * 8 / 16; i += 512) *(LAS u32x4*)(unsigned long long)(unsigned)(i * 16) = src[i]; }
        __syncthreads();
        typedef __fp16 h2_t __attribute__((__vector_size__(2 * sizeof(__fp16))));
#define P11_LOAD(dst, ptr) do { _Pragma("unroll") for (int jj = 0; jj < 16; ++jj) dst[jj] = (ptr)[jj * 64]; } while (0)
#define P11_FMA(A, X, C) asm("v_pk_fma_f16 %0, %1, %2, %0 op_sel:[0,1,0] op_sel_hi:[1,1,1]" : "+v"(C) : "v"(A), "v"(X))
#define P11_COMP(src) do { unsigned long long vv_[16]; \
                    _Pragma("unroll") for (int jj = 0; jj < 16; ++jj) vv_[jj] = *(const LAS unsigned long long*)(unsigned long long)(src[jj] & 0x1FFF8u);     \
                    __builtin_amdgcn_sched_barrier(0); \
                    _Pragma("unroll") for (int jj = 0; jj < 16; ++jj) { const int lo = (int)(unsigned)vv_[jj], hi = (int)(unsigned)(vv_[jj] >> 32); \
                    const h2_t c0_ = __builtin_amdgcn_cvt_scalef32_pk_f16_fp8(lo, 1.0f, false), c1_ = __builtin_amdgcn_cvt_scalef32_pk_f16_fp8(lo, 1.0f, true); \
                    const h2_t c2_ = __builtin_amdgcn_cvt_scalef32_pk_f16_fp8(hi, 1.0f, false), c3_ = __builtin_amdgcn_cvt_scalef32_pk_f16_fp8(hi, 1.0f, true); \
                    P11_FMA(c0_, src[jj], acc[0]); P11_FMA(c1_, src[jj], acc[1]); P11_FMA(c2_, src[jj], acc[2]); P11_FMA(c3_, src[jj], acc[3]); } } while (0)
#define P11_COMPX(src) do { unsigned long long vv_[16]; \
                    _Pragma("unroll") for (int jj = 0; jj < 16; ++jj) vv_[jj] = *(const LAS unsigned long long*)(unsigned long long)(src[jj] & 0x1FFF8u); \
                    __builtin_amdgcn_sched_barrier(0); \
                    _Pragma("unroll") for (int jj = 0; jj < 16; ++jj) { const int lo = (int)(unsigned)vv_[jj], hi = (int)(unsigned)(vv_[jj] >> 32); \
                    P11_FMA(lo, src[jj], acc[0]); P11_FMA(hi, src[jj], acc[1]); P11_FMA(lo, src[jj], acc[2]); P11_FMA(hi, src[jj], acc[3]); } } while (0)
        int lane = F.lane; asm volatile("" : "+v"(lane));
        unsigned pa[16], pb[16];
        f32x4 x0, x1;
        { const unsigned* pp = pairs + (size_t)F.wave * 128 * 64 + lane; P11_LOAD(pa, pp);
          const float* ip = F.out + (size_t)(F.wave * 64 + lane) * 2048 + c * 8; x0 = *(const f32x4*)ip; x1 = *(const f32x4*)(ip + 4); }
        for (int tile = F.wave; tile < MTOK / 64; tile += 8) {
            const unsigned* pp = pairs + (size_t)tile * 128 * 64 + lane;
            const int ntile = tile + 8 < MTOK / 64 ? tile + 8 : tile;
            const unsigned* npp = pairs + (size_t)ntile * 128 * 64 + lane;
            const int row = tile * 64 + lane;
            const float* gt2 = mf + (size_t)(tile / (SEQ / 64)) * 12288 + 10240 + c * 8;
            float* op = dst + (size_t)row * 2048 + c * 8;
            const f32x4 g0 = *(const f32x4*)gt2 * 0.25f, g1 = *(const f32x4*)(gt2 + 4) * 0.25f;
            h2_t acc[4];
#pragma unroll
            for (int i = 0; i < 4; ++i) acc[i] = (h2_t){(__fp16)0.f, (__fp16)0.f};
            f32x4 nx0 = x0, nx1 = x1;
#pragma unroll 1
            for (int j0 = 0; j0 < 128; j0 += 32) {
                P11_LOAD(pb, pp + (j0 + 16) * 64);
                P11_COMP(pa);
                const bool lastb = j0 + 32 >= 128;
                { const unsigned* np_ = lastb ? npp : pp + (j0 + 32) * 64; P11_LOAD(pa, np_); }
                if (lastb) { const float* nip = F.out + (size_t)(ntile * 64 + lane) * 2048 + c * 8; nx0 = *(const f32x4*)nip; nx1 = *(const f32x4*)(nip + 4); }
                P11_COMP(pb);
            }
#if PROBE_P11X == 1 || PROBE_P11X == 3
            { h2_t sv[4]; for (int i = 0; i < 4; ++i) sv[i] = acc[i];
#pragma unroll 1
              for (int j0 = 0; j0 < 128; j0 += 32) {
#pragma unroll
                for (int jj = 0; jj < 16; ++jj) { asm volatile("" : "+v"(pa[jj])); asm volatile("" : "+v"(pb[jj])); }
#if PROBE_P11X == 1
                P11_COMP(pa); P11_COMP(pb);
#else
                P11_COMPX(pa); P11_COMPX(pb);
#endif
              }
              asm volatile("" :: "v"(acc[0]), "v"(acc[1]), "v"(acc[2]), "v"(acc[3])); for (int i = 0; i < 4; ++i) acc[i] = sv[i]; }
#endif
            *(f32x4*)op = x0 + g0 * (f32x4){(float)acc[0][0], (float)acc[0][1], (float)acc[1][0], (float)acc[1][1]};
            *(f32x4*)(op + 4) = x1 + g1 * (f32x4){(float)acc[2][0], (float)acc[2][1], (float)acc[3][0], (float)acc[3][1]};
            x0 = nx0; x1 = nx1;
        }
#undef P11_LOAD
#undef P11_COMP
#undef P11_FMA
    }
}

__global__ void __launch_bounds__(512, 2) fwd_kernel(Args args) {
    extern __shared__ __attribute__((aligned(16))) unsigned char lds[];
    Frame F;
    F.lds = lds; F.ws = args.ws; F.tid = threadIdx.x; F.lane = F.tid & 63; F.wave = __builtin_amdgcn_readfirstlane(F.tid >> 6); F.G = gridDim.x; F.bid = blockIdx.x;
    F.x = args.in[0]; F.c = args.in[1]; F.w_ada = args.in[2]; F.b_ada = args.in[3]; F.g1 = args.in[4]; F.g2 = args.in[5]; F.w_in = args.in[6]; F.g_q = args.in[7]; F.g_k = args.in[8];
    F.rel_bias = args.in[9]; F.pool_w = args.in[10]; F.pool_scale = args.in[11]; F.w_ab = args.in[12]; F.w_pb = args.in[13]; F.w_out = args.in[14]; F.w_pq = args.in[15];
    F.peer_keys = args.in[16]; F.peer_u = args.in[17]; F.peer_v = args.in[18]; F.out = args.out;
    LAS unsigned char* ldsl = (LAS unsigned char*)lds;
    volatile LAS unsigned* misc = (volatile LAS unsigned*)(ldsl + MISC_OFF);
    if (F.tid < 4) misc[F.tid] = 0u;
    __syncthreads();
    unsigned* barw = (unsigned*)(args.ws + WS_CTL) + (size_t)args.li * XCD_BAR_WORDS;
    XcdBarrier bar; bar.bar = barw; bar.x = 0; bar.st = misc;
    const int lo = args.ph_lo, hi = args.ph_hi;
    if (hi - lo > 1) bar = xcd_barrier_post(barw, misc);
#define IN(k) (lo <= (k) && (k) < hi)
#define SEAM(k) do { if (IN(k) && IN((k) + 1)) xcd_barrier(bar, F.wave); } while (0)
    bf16_t* R0 = (bf16_t*)(F.ws + WS_R0);

#define PH2_BODY { \
        { pg8::Gemm g{(const bf16_t*)(F.ws + WS_H1F8), (const bf16_t*)(F.ws + WS_WIN8), MTOK, 5632, DM / 2, DM / 2, 0, nullptr, nullptr, 0, 0}; pg8::StaticOrder S; S.init(MTOK, 5632, F.G, F.bid); \
          EpiInproj<true> E{(bf16_t*)(F.ws + WS_QN), (bf16_t*)(F.ws + WS_KN), (bf16_t*)(F.ws + WS_V), (bf16_t*)(F.ws + WS_IQ), (bf16_t*)(F.ws + WS_IK), (bf16_t*)(F.ws + WS_PL), \
                    (bf16_t*)(F.ws + WS_GA), (bf16_t*)(F.ws + WS_GP), (float*)(F.ws + WS_IW)}; \
          pg8::gemm_phase<EpiInproj<true>, true>(ldsl, g, S, E, F.wave); } \
        { pg8::Gemm g{R0, (const bf16_t*)(F.ws + WS_WIN16), MTOK, 2304, DM, DM, 0, nullptr, nullptr, 0, 0}; pg8::StaticOrder S; S.init(MTOK, 2304, F.G, F.bid); \
          EpiInproj<false> E{(bf16_t*)(F.ws + WS_QN), (bf16_t*)(F.ws + WS_KN), (bf16_t*)(F.ws + WS_V), (bf16_t*)(F.ws + WS_IQ), (bf16_t*)(F.ws + WS_IK), (bf16_t*)(F.ws + WS_PL), \
                    (bf16_t*)(F.ws + WS_GA), (bf16_t*)(F.ws + WS_GP), (float*)(F.ws + WS_IW)}; \
          pg8::gemm_phase<EpiInproj<false>>(ldsl, g, S, E, F.wave); } }
#define PH3_BODY { phase3_pooled(F); phase3_indexer(F); __syncthreads(); }
#define PH4_BODY { \
        phase4_attention(F); \
        __syncthreads(); \
        pg8::Gemm g{(const bf16_t*)(F.ws + WS_POOLED), (const bf16_t*)(F.ws + WS_POOLW), MTOK, PW, 256, 1024, 256, nullptr, nullptr, 0, 0}; pg8::StaticOrder S; S.init(MTOK, PW, F.G, F.bid); \
        EpiF8Scale E{F.ws + WS_POOL2, 1024, F.pool_scale}; \
        pg8::gemm_phase<EpiF8Scale>(ldsl, g, S, E, F.wave); }
#define PH5_BODY { \
        pg8::Gemm g{(const bf16_t*)(F.ws + WS_ATTN), (const bf16_t*)(F.ws + WS_WAB), MTOK, DM, 1024, 512, 0, (const bf16_t*)(F.ws + WS_POOL2), (const bf16_t*)(F.ws + WS_WPB), 8, 512};     \
        pg8::StaticOrder S; S.init(MTOK, DM, F.G, F.bid); \
        EpiMerge E{(unsigned char*)R0, (const bf16_t*)(F.ws + WS_GA), (const bf16_t*)(F.ws + WS_GP)}; pg8::gemm_phase<EpiMerge, true>(ldsl, g, S, E, F.wave); }
#define PH6_BODY { \
        pg8::Gemm g{R0, (const bf16_t*)(F.ws + WS_WOUT), MTOK, DM, DM / 2, DM / 2, 0, nullptr, nullptr, 0, 0}; pg8::StaticOrder S; S.init(MTOK, DM, F.G, F.bid); \
        EpiResid E{F.x, F.out, (const float*)(F.ws + WS_MODF) + 4096}; pg8::gemm_phase<EpiResid, true>(ldsl, g, S, E, F.wave); }
#define PH8_BODY { \
        pg8::Gemm g{(const bf16_t*)(F.ws + WS_H2), (const bf16_t*)(F.ws + WS_WPQ), MTOK, DM, DM, DM, 0, nullptr, nullptr, 0, 0}; pg8::StaticOrder S; S.init(MTOK, DM, F.G, F.bid); \
        EpiBf16Scale E{R0, 2048, nullptr}; pg8::gemm_phase<EpiBf16Scale>(ldsl, g, S, E, F.wave); }
#define PH9_BODY { \
        pg8::Gemm g{R0, (const bf16_t*)(F.ws + WS_KEYSBD), MTOK, DM, 256, DM, 256, nullptr, nullptr, 0, 0}; pg8::StaticOrder S; S.init(MTOK, DM, F.G, F.bid); \
        EpiBf16Scale E{(bf16_t*)(F.ws + WS_SUB), 2048, nullptr}; pg8::gemm_phase<EpiBf16Scale>(ldsl, g, S, E, F.wave); }
#define REP(k) if constexpr (((PROBE_REP) >> (k)) & 1)

    if (IN(0)) { phase0_prep(F); REP(0) { __syncthreads(); phase0_prep(F); } }
    SEAM(0);
    if (IN(1)) { phase_modnorm<true>(F, F.x, F.g1, 0, 2048, R0, F.ws + WS_H1F8); REP(1) { phase_modnorm<true>(F, F.x, F.g1, 0, 2048, R0, F.ws + WS_H1F8); } }
    SEAM(1);
    if (IN(2)) { PH2_BODY REP(2) PH2_BODY }
    SEAM(2);
    if (IN(3)) { phase3_qknorm(F); PH3_BODY REP(3) PH3_BODY }
    SEAM(3);
    if (IN(4)) { PH4_BODY REP(4) PH4_BODY }
    SEAM(4);
    if (IN(5)) { PH5_BODY REP(5) PH5_BODY }
    SEAM(5);
    if (IN(6)) { PH6_BODY REP(6) PH6_BODY }
    SEAM(6);
    if (IN(7)) { phase_modnorm<false>(F, F.out, F.g2, 6144, 8192, (bf16_t*)(F.ws + WS_H2)); REP(7) { phase_modnorm<false>(F, F.out, F.g2, 6144, 8192, (bf16_t*)(F.ws + WS_H2)); } }
    SEAM(7);
    if (IN(8)) { PH8_BODY REP(8) PH8_BODY }
    SEAM(8);
    if (IN(9)) { PH9_BODY REP(9) PH9_BODY }
    SEAM(9);
    if (IN(10)) { phase10_peer(F); REP(10) phase10_peer<PROBE_P10M>(F); }
    SEAM(10);
    if (IN(11)) { REP(11) { phase11_peer_v(F, (float*)(F.ws + WS_SUB)); } phase11_peer_v(F, F.out); }
#undef IN
#undef SEAM
}

extern "C" void kernel_launch(void* const* d_in, const int* in_sizes, int n_in, void* d_out, int out_size, void* d_ws, size_t ws_size, hipStream_t stream) {
    static int grid = 0;
    if (grid == 0) {
        if (n_in != 19 || out_size != MTOK * DM || ws_size < WS_END) { fprintf(stderr, "kernel_launch: unexpected shapes (n_in %d out %d ws %zu)\n", n_in, out_size, ws_size); grid = -1; return; }
        int dev = 0, cus = 0, per_cu = 0;
        if (hipGetDevice(&dev) != hipSuccess || hipDeviceGetAttribute(&cus, hipDeviceAttributeMultiprocessorCount, dev) != hipSuccess) { grid = -1; return; }
        if (hipFuncSetAttribute((const void*)fwd_kernel, hipFuncAttributeMaxDynamicSharedMemorySize, LDS_BYTES) != hipSuccess) { fprintf(stderr, "kernel_launch: hipFuncSetAttribute failed\n"); grid = -1; return; }
        if (hipOccupancyMaxActiveBlocksPerMultiprocessor(&per_cu, (const void*)fwd_kernel, 512, LDS_BYTES) != hipSuccess || per_cu < 1) { fprintf(stderr, "kernel_launch: occupancy query says %d\n", per_cu); }
        (void)hipGetLastError();
        grid = cus;
    }
    if (grid < 0) return;
    (void)in_sizes;
    if (hipMemsetAsync((char*)d_ws + WS_CTL, 0, CTL_ZERO_BYTES, stream) != hipSuccess) return;
    Args a{};
    for (int i = 0; i < 19; ++i) a.in[i] = (const float*)d_in[i];
    a.out = (float*)d_out; a.ws = (unsigned char*)d_ws;
#if MK_PER_PHASE
    for (int p = 0; p < NPHASE; ++p) { a.ph_lo = p; a.ph_hi = p + 1; a.li = p; hipLaunchKernelGGL(fwd_kernel, dim3(grid), dim3(512), LDS_BYTES, stream, a); }
#else
    a.ph_lo = 0; a.ph_hi = NPHASE; a.li = 0;
    hipLaunchKernelGGL(fwd_kernel, dim3(grid), dim3(512), LDS_BYTES, stream, a);
#endif
}
```

```cpp
#include <hip/hip_runtime.h>
#include <cstdio>
#include <cstdint>

#ifndef MK_PER_PHASE
#define MK_PER_PHASE 0
#endif

#ifndef PROBE_REP
#define PROBE_REP 0
#endif
#ifndef PROBE_IDX
#define PROBE_IDX 0
#endif
#ifndef PROBE_P10M
#define PROBE_P10M 0
#endif
#ifndef PROBE_P11X
#define PROBE_P11X 0
#endif
#define LAS __attribute__((address_space(3)))
typedef unsigned short bf16_t;
typedef short bf16x8 __attribute__((ext_vector_type(8)));
typedef float f32x4 __attribute__((ext_vector_type(4)));
typedef float f32x2 __attribute__((ext_vector_type(2)));
typedef int v2i __attribute__((ext_vector_type(2)));
typedef unsigned u32x4 __attribute__((ext_vector_type(4)));
typedef unsigned u32x2 __attribute__((ext_vector_type(2)));
typedef unsigned u32x6 __attribute__((ext_vector_type(6)));
typedef unsigned u32x16 __attribute__((ext_vector_type(16)));
typedef __bf16 bf16x32 __attribute__((ext_vector_type(32)));

constexpr int BATCH = 8, SEQ = 4096, DM = 2048, MTOK = BATCH * SEQ;
constexpr int NHEAD = 8, HDIM = 128, AW = 1024, KVW = 256, IHEADS = 16, IDIM = 64, KSEL = 256;
constexpr int PW = 1024, PHEADS = 8, NEXP = 16384;
constexpr int INW = 7760;
constexpr float EPS = 1e-6f;
constexpr int NPHASE = 12;

constexpr size_t MiB = 1u << 20;
constexpr size_t WS_CTL = 0, CTL_ZERO_BYTES = 256 * 1024;
constexpr size_t WS_MODP = 2 * MiB;
constexpr size_t WS_MODF = 4 * MiB;
constexpr size_t WS_POOLW = 5 * MiB;
constexpr size_t WS_KEYSBD = 6 * MiB;
constexpr size_t WS_WIN16 = 8 * MiB;
constexpr size_t WS_WIN8 = 20 * MiB;
constexpr size_t WS_WAB = 40 * MiB, WS_WPB = 44 * MiB, WS_WOUT = 48 * MiB, WS_WPQ = 56 * MiB;
constexpr size_t WS_PU = 64 * MiB, WS_PV = 128 * MiB;
constexpr size_t WS_R0 = 192 * MiB;
constexpr size_t WS_GA = 320 * MiB, WS_GP = 448 * MiB;
constexpr size_t WS_SUB = 320 * MiB;
constexpr size_t WS_QN = 576 * MiB;
constexpr size_t WS_IQ = 640 * MiB;
constexpr size_t WS_PL = 704 * MiB;
constexpr size_t WS_KN = 768 * MiB, WS_V = 784 * MiB;
constexpr size_t WS_IK = 800 * MiB;
constexpr size_t WS_IW = 804 * MiB;
constexpr size_t WS_SEL = 806 * MiB;
constexpr size_t WS_POOLED = 822 * MiB;
constexpr size_t WS_H2 = 886 * MiB;
constexpr size_t WS_END = 1014 * MiB;
constexpr size_t WS_H1F8 = WS_H2 + 64 * MiB;
constexpr size_t WS_Q8 = WS_H2, WS_K8 = WS_H2 + 32 * MiB, WS_V8 = WS_H2 + 40 * MiB;
constexpr size_t WS_ATTN = WS_IQ, WS_POOL2 = WS_PL, WS_PAIRS = WS_QN, WS_WLS = WS_QN + 32 * MiB;

constexpr int LDS_BYTES = 160 * 1024;
constexpr int MISC_OFF = 159 * 1024;

__device__ __forceinline__ unsigned cvt_pk_bf16(float lo, float hi) { unsigned r; asm volatile("v_cvt_pk_bf16_f32 %0, %1, %2" : "=v"(r) : "v"(lo), "v"(hi)); return r; }
__device__ __forceinline__ float bf_lo(unsigned w) { return __uint_as_float(w << 16); }
__device__ __forceinline__ float bf_hi(unsigned w) { return __uint_as_float(w & 0xffff0000u); }
template <int CTRL> __device__ __forceinline__ float dpp_f(float x) { return __int_as_float(__builtin_amdgcn_update_dpp(0, __float_as_int(x), CTRL, 0xF, 0xF, true)); }
#define DPP_XOR1 0xB1
#define DPP_XOR2 0x4E
#define DPP_HMIRROR 0x141
#define DPP_MIRROR 0x140
#define DPP_ROR8 0x128
__device__ __forceinline__ float xor16_sum(float x) { const auto r = __builtin_amdgcn_permlane16_swap(__float_as_uint(x), __float_as_uint(x), false, false); return __uint_as_float(r[0]) + __uint_as_float(r[1]); }
__device__ __forceinline__ float xor32_sum(float x) { const auto r = __builtin_amdgcn_permlane32_swap(__float_as_uint(x), __float_as_uint(x), false, false); return __uint_as_float(r[0]) + __uint_as_float(r[1]); }
__device__ __forceinline__ float xor16_max(float x) { const auto r = __builtin_amdgcn_permlane16_swap(__float_as_uint(x), __float_as_uint(x), false, false); return fmaxf(__uint_as_float(r[0]), __uint_as_float(r[1])); }
__device__ __forceinline__ float swap32_pair(float a, float b) { const auto r = __builtin_amdgcn_permlane32_swap(__float_as_uint(a), __float_as_uint(b), false, false); return __uint_as_float(r[0]) + __uint_as_float(r[1]); }
__device__ __forceinline__ float swap16_pair(float a, float b) { const auto r = __builtin_amdgcn_permlane16_swap(__float_as_uint(a), __float_as_uint(b), false, false); return __uint_as_float(r[0]) + __uint_as_float(r[1]); }
__device__ __forceinline__ float row_sum16(float v) { v += dpp_f<DPP_XOR1>(v); v += dpp_f<DPP_XOR2>(v); v += dpp_f<DPP_HMIRROR>(v); v += dpp_f<DPP_MIRROR>(v); return v; }
__device__ __forceinline__ float row_max16(float v) { v = fmaxf(v, dpp_f<DPP_XOR1>(v)); v = fmaxf(v, dpp_f<DPP_XOR2>(v)); v = fmaxf(v, dpp_f<DPP_HMIRROR>(v)); v = fmaxf(v, dpp_f<DPP_MIRROR>(v)); return v; }
__device__ __forceinline__ float wave_sum(float v) { return xor32_sum(xor16_sum(row_sum16(v))); }
__device__ __forceinline__ float sigmoidf_(float x) { return __builtin_amdgcn_rcpf(1.0f + __expf(-x)); }
__device__ __forceinline__ float dot8(u32x4 w, const float* h) {
    return bf_lo(w.x) * h[0] + bf_hi(w.x) * h[1] + bf_lo(w.y) * h[2] + bf_hi(w.y) * h[3] + bf_lo(w.z) * h[4] + bf_hi(w.z) * h[5] + bf_lo(w.w) * h[6] + bf_hi(w.w) * h[7];
}

__device__ __forceinline__ int lane_now() { int l; asm volatile("v_mbcnt_lo_u32_b32 %0, -1, 0\n\tv_mbcnt_hi_u32_b32 %0, -1, %0" : "=v"(l)); return l; }

#define XB_TMO      128
#define XB_XCNT(j)  (256  + 64 * (j))
#define XB_XSUB(j)  (1280 + 64 * (j))
#define XB_XGEN(j)  (2304 + 64 * (j))
#define XB_TOP      3328
#define XB_TOPGEN   3392
#define XCD_BAR_WORDS 3456
#define XB_SPIN_CAP (1u << 18)

__device__ __forceinline__ unsigned xb_ld(unsigned* p)              { return __hip_atomic_load(p, __ATOMIC_RELAXED, __HIP_MEMORY_SCOPE_AGENT); }
__device__ __forceinline__ unsigned xb_add(unsigned* p, unsigned v) { return __hip_atomic_fetch_add(p, v, __ATOMIC_RELAXED, __HIP_MEMORY_SCOPE_AGENT); }
__device__ __forceinline__ unsigned xb_xcc_id() { return (unsigned)__builtin_amdgcn_s_getreg((3 << 11) | 20) & 0xFu; }
#define XB_SPIN(cond, bar) do { unsigned _sp = 0; while (cond) { __builtin_amdgcn_s_sleep(1); \
    if ((++_sp & 255u) == 0u) { if (xb_ld(&(bar)[XB_TMO])) break; if (_sp > XB_SPIN_CAP) { atomicAdd(&(bar)[XB_TMO], 1u); break; } } } } while (0)

struct XcdBarrier { unsigned* bar; unsigned x; volatile LAS unsigned* st; };

__device__ __forceinline__ XcdBarrier xcd_barrier_post(unsigned* bar, volatile LAS unsigned* st) {
    XcdBarrier b; b.bar = bar; b.x = xb_xcc_id(); b.st = st;
    if (threadIdx.x == 0) (void)xb_add(&bar[XB_XCNT(b.x)], 1u);
    return b;
}
__device__ __forceinline__ void xcd_barrier_complete(unsigned* bar, unsigned x, unsigned& nloc, unsigned& nx) {
    const unsigned G = gridDim.x * gridDim.y * gridDim.z;
    unsigned sum, cnt, mine, sp = 0u;
    for (;;) {
        sum = 0u; cnt = 0u; mine = 0u;
#pragma unroll
        for (unsigned j = 0; j < 16; ++j) { const unsigned c = xb_ld(&bar[XB_XCNT(j)]); sum += c; cnt += (c > 0u) ? 1u : 0u; mine = (j == x) ? c : mine; }
        if (sum == G) break;
        __builtin_amdgcn_s_sleep(1);
        if ((++sp & 255u) == 0u) { if (xb_ld(&bar[XB_TMO])) break; if (sp > XB_SPIN_CAP) { atomicAdd(&bar[XB_TMO], 1u); break; } }
    }
    nloc = mine > 0u ? mine : 1u; nx = cnt > 0u ? cnt : 1u;
}
__device__ __forceinline__ void xcd_barrier(const XcdBarrier& b, int wave) {
    asm volatile("s_waitcnt vmcnt(0)" ::: "memory");
    __syncthreads();
    if (wave == 0 && lane_now() == 0) {
        unsigned* bar = b.bar;
        __builtin_amdgcn_s_waitcnt(0);
        unsigned nloc = b.st[0], nx = b.st[1];
        if (nloc == 0u) { xcd_barrier_complete(bar, b.x, nloc, nx); b.st[0] = nloc; b.st[1] = nx; }
        const unsigned old = xb_add(&bar[XB_XSUB(b.x)], 1u);
        const unsigned gen = old / nloc;
        if (old + 1u == (gen + 1u) * nloc) {
            __builtin_amdgcn_fence(__ATOMIC_RELEASE, "agent");
            asm volatile("s_waitcnt vmcnt(0)" ::: "memory");
            const unsigned og = xb_add(&bar[XB_TOP], 1u);
            const unsigned tg = og / nx;
            if (og + 1u == (tg + 1u) * nx) xb_add(&bar[XB_TOPGEN], 1u);
            else XB_SPIN(xb_ld(&bar[XB_TOPGEN]) == tg, bar);
            __builtin_amdgcn_fence(__ATOMIC_ACQUIRE, "agent");
            xb_add(&bar[XB_XGEN(b.x)], 1u);
            asm volatile("s_waitcnt vmcnt(0)" ::: "memory");
        } else {
            XB_SPIN(xb_ld(&bar[XB_XGEN(b.x)]) == gen, bar);
            __builtin_amdgcn_fence(__ATOMIC_ACQUIRE, "agent");
            asm volatile("s_waitcnt vmcnt(0)" ::: "memory");
        }
    }
    __syncthreads();
}

namespace pg8 {
constexpr int BM = 256, BK = 64, HALF = 128, HTB = HALF * BK * 2, STAGE_BYTES = 8 * HTB, NXCD = 8, WGM = 8;
__device__ __forceinline__ int lds_byte(int r, int c) { const int st = (r >> 4) * 2 + (c >> 5), rr = r & 15, cc = c & 31, ob = rr * 64 + cc * 2; return st * 1024 + (ob ^ (((ob >> 9) & 1) << 5)); }
__device__ __forceinline__ void stage_rc(int b, int& R, int& C) { const int st = b / 1024, sb = b % 1024, swz = sb ^ (((sb >> 9) & 1) << 5); R = (st >> 1) * 16 + swz / 64; C = (st & 1) * 32 + (swz % 64) / 2; }
__device__ __forceinline__ int perm32(int rho) { const int n = rho >> 4, i = rho & 15; return 8 * (i >> 2) + 4 * n + (i & 3); }

struct Unit { int pm, pn; };
struct Gemm { const bf16_t* A; const bf16_t* Bt; int M, N, K, lda, a_pn_off; const bf16_t* A2; const bf16_t* Bt2; int ksplit, ldb; };

struct StaticOrder {
    int nM, nN, nwg, G, c;
    __device__ void init(int M, int N, int G_, int c_) { nM = M / BM; nN = N / BM; nwg = nM * nN; G = G_; c = c_; }
    __device__ bool next(int i, Unit& u) const {
        const long L = (long)i * G + c; if (L >= nwg) return false;
        int wgid = (int)L; { const int q = nwg / NXCD, r = nwg % NXCD, xcd = wgid % NXCD, off = wgid / NXCD; wgid = (xcd < r ? xcd * (q + 1) : r * (q + 1) + (xcd - r) * q) + off; }
        const int nig = WGM * nN, gid = wgid / nig, fm = gid * WGM, gsz = (nM - fm) < WGM ? (nM - fm) : WGM;
        u.pm = fm + ((wgid % nig) % gsz); u.pn = (wgid % nig) / gsz; return true;
    }
};

typedef int i32x4 __attribute__((ext_vector_type(4)));
typedef int i32x8 __attribute__((ext_vector_type(8)));
__device__ __forceinline__ bf16x8 lo8(i32x8 v) { return __builtin_bit_cast(bf16x8, (i32x4){v.s0, v.s1, v.s2, v.s3}); }
__device__ __forceinline__ bf16x8 hi8(i32x8 v) { return __builtin_bit_cast(bf16x8, (i32x4){v.s4, v.s5, v.s6, v.s7}); }
__device__ __forceinline__ i32x8 cat8(bf16x8 a, bf16x8 b) { const i32x4 x = __builtin_bit_cast(i32x4, a), y = __builtin_bit_cast(i32x4, b); return (i32x8){x.x, x.y, x.z, x.w, y.x, y.y, y.z, y.w}; }
template <class Epi, bool F8 = false>
__device__ __forceinline__ void gemm_phase(LAS unsigned char* lds, const Gemm g, const StaticOrder& S, const Epi& E, int wave) {
    const int lane = lane_now(), wid = wave, tid = wid * 64 + lane, wr = wid >> 2, wc = wid & 3, fr = lane & 15, fq = lane >> 4;
    const int K = g.K, nt = K / BK, lda = g.lda, ldb = g.ldb ? g.ldb : g.K, ksplit = g.ksplit;
    unsigned voffA, voffB;
    { int R, C; stage_rc(tid * 16, R, C); const int Rb = Epi::PERM ? ((R & ~31) + perm32(R & 31)) : R;
      voffA = (unsigned)(R * lda + C) * 2u; voffB = (unsigned)(Rb * ldb + C) * 2u; }
    const unsigned stepA = 64u * (unsigned)lda * 2u, stepB = 64u * (unsigned)ldb * 2u;
    const size_t kstep = (size_t)(BK * 2);
    const size_t hsA = (size_t)HALF * lda * 2, hsB = (size_t)HALF * ldb * 2;
    const size_t tsA = 2 * hsA, tsB = 2 * hsB;
    const unsigned ldsw = (unsigned)wid * 1024u, ldsbase = (unsigned)(unsigned long long)lds;
    const int aoff = lds_byte(wr * 64 + fr, fq * 8), boff = lds_byte(wc * 32 + fr, fq * 8);
#define PG8_SA(b, h) (((b) * 2 + (h)) * HTB)
#define PG8_SB(b, h) ((4 + (b) * 2 + (h)) * HTB)
#define PG8_STAGE(bufoff, gbase, voff) do { _Pragma("unroll") for (int _i = 0; _i < 2; ++_i) { \
        const char* sb_ = (const char*)(gbase) + (size_t)_i * PG8_STEP_##voff; const unsigned m0_ = ldsbase + (unsigned)(bufoff) + ldsw + (unsigned)_i * 8192u; \
        asm volatile("s_mov_b32 m0, %2\n\ts_nop 0\n\tglobal_load_lds_dwordx4 %0, %1" :: "v"(voff), "s"(sb_), "s"(m0_) : "memory"); } } while (0)
#define PG8_STEP_voffA stepA
#define PG8_STEP_voffB stepB
#define PG8_LDA(dst, b, h) do { _Pragma("unroll") for (int m = 0; m < 4; ++m) dst[m] = cat8(*(const LAS bf16x8*)(lds + PG8_SA(b, h) + aoff + m * 2048), *(const LAS bf16x8*)(lds + PG8_SA(b, h) + aoff + m * 2048 + 1024)); } while (0)
#define PG8_LDB(dst, b, h) do { _Pragma("unroll") for (int n = 0; n < 2; ++n) dst[n] = cat8(*(const LAS bf16x8*)(lds + PG8_SB(b, h) + boff + n * 2048), *(const LAS bf16x8*)(lds + PG8_SB(b, h) + boff + n * 2048 + 1024)); } while (0)
#define PG8_MMA(ai, bj, At, Bt) do { __builtin_amdgcn_s_setprio(1); _Pragma("unroll") for (int m = 0; m < 4; ++m) _Pragma("unroll") for (int n = 0; n < 2; ++n) { \
        if constexpr (F8) acc[ai][bj][m][n] = __builtin_amdgcn_mfma_scale_f32_16x16x128_f8f6f4(Bt[n], At[m], acc[ai][bj][m][n], 0, 0, 0, 0x7D7D7D7D  , 0, 0x7D7D7D7D); \
        else { acc[ai][bj][m][n] = __builtin_amdgcn_mfma_f32_16x16x32_bf16(lo8(Bt[n]), lo8(At[m]), acc[ai][bj][m][n], 0, 0, 0); \
               acc[ai][bj][m][n] = __builtin_amdgcn_mfma_f32_16x16x32_bf16(hi8(Bt[n]), hi8(At[m]), acc[ai][bj][m][n], 0, 0, 0); } } \
        __builtin_amdgcn_s_setprio(0); } while (0)
#define PG8_WAIT_V(n) asm volatile("s_waitcnt vmcnt(" #n ")" ::: "memory")
#define PG8_WAIT_L(n) asm volatile("s_waitcnt lgkmcnt(" #n ")" ::: "memory")
#define PG8_BAR __builtin_amdgcn_s_barrier()
#define PG8_SCHED __builtin_amdgcn_sched_barrier(0)
    Unit cur, nxt; int ui = 0;
    if (!S.next(0, cur)) return;
    f32x4 acc[2][2][4][2];
#pragma unroll
    for (int a = 0; a < 2; ++a)
#pragma unroll
        for (int b = 0; b < 2; ++b)
#pragma unroll
            for (int m = 0; m < 4; ++m)
#pragma unroll
                for (int n = 0; n < 2; ++n) acc[a][b][m][n] = (f32x4){0.f, 0.f, 0.f, 0.f};
    i32x8 At[4], B0[2], B1[2];
    const char* cA = (const char*)g.A + (size_t)cur.pm * tsA + (size_t)cur.pn * g.a_pn_off * 2; const char* cB = (const char*)g.Bt + (size_t)cur.pn * tsB;
    PG8_STAGE(PG8_SB(0, 0), cB, voffB); PG8_STAGE(PG8_SB(0, 1), cB + hsB, voffB); PG8_STAGE(PG8_SA(0, 0), cA, voffA); PG8_STAGE(PG8_SA(0, 1), cA + hsA, voffA);
    if (wr == 1) PG8_BAR;
    PG8_WAIT_V(2); PG8_BAR;
    PG8_STAGE(PG8_SB(1, 0), cB + kstep, voffB); PG8_STAGE(PG8_SA(1, 0), cA + kstep, voffA); PG8_STAGE(PG8_SB(1, 1), cB + hsB + kstep, voffB);
    PG8_WAIT_V(6); PG8_BAR;
    for (;;) {
        const bool has_next = S.next(ui + 1, nxt);
        const char* nA = has_next ? (const char*)g.A + (size_t)nxt.pm * tsA + (size_t)nxt.pn * g.a_pn_off * 2 : cA; const char* nB = has_next ? (const char*)g.Bt + (size_t)nxt.pn * tsB : cB;
        const char* cA2 = (const char*)g.A2 + (size_t)cur.pm * tsA; const char* cB2 = (const char*)g.Bt2 + (size_t)cur.pn * tsB;
#pragma clang loop unroll(disable)
        for (int t = 0; t < nt; t += 2) {
            const bool last = (t == nt - 2);
            const bool s1 = ksplit && (t >= ksplit), s2 = ksplit && (t + 2 >= ksplit);
            const char* a1 = (s1 ? cA2 + (size_t)(t - ksplit + 1) * kstep : cA + (size_t)(t + 1) * kstep);
            const char* a2 = last ? nA : (s2 ? cA2 + (size_t)(t + 2 - ksplit) * kstep : cA + (size_t)(t + 2) * kstep);
            const char* b2 = last ? nB : (s2 ? cB2 + (size_t)(t + 2 - ksplit) * kstep : cB + (size_t)(t + 2) * kstep);
            const char* a3 = a2 + kstep; const char* b3 = b2 + kstep;
            PG8_LDB(B0, 0, 0); PG8_LDB(B1, 0, 1); PG8_SCHED; PG8_LDA(At, 0, 0); PG8_STAGE(PG8_SA(1, 1), a1 + hsA, voffA);
            PG8_WAIT_V(8); PG8_WAIT_L(0); PG8_BAR; PG8_MMA(0, 0, At, B0); PG8_MMA(0, 1, At, B1); PG8_BAR; PG8_SCHED;
            PG8_LDA(At, 0, 1); PG8_STAGE(PG8_SB(0, 0), b2, voffB); PG8_STAGE(PG8_SB(0, 1), b2 + hsB, voffB); PG8_STAGE(PG8_SA(0, 0), a2, voffA);
            PG8_WAIT_V(8); PG8_WAIT_L(0); PG8_BAR; PG8_MMA(1, 0, At, B0); PG8_MMA(1, 1, At, B1); PG8_BAR; PG8_SCHED;
            PG8_LDB(B0, 1, 0); PG8_LDB(B1, 1, 1); PG8_SCHED; PG8_LDA(At, 1, 0); PG8_STAGE(PG8_SA(0, 1), a2 + hsA, voffA);
            PG8_WAIT_V(8); PG8_WAIT_L(0); PG8_BAR; PG8_MMA(0, 0, At, B0); PG8_MMA(0, 1, At, B1); PG8_BAR; PG8_SCHED;
            PG8_LDA(At, 1, 1); PG8_STAGE(PG8_SB(1, 0), b3, voffB); PG8_STAGE(PG8_SB(1, 1), b3 + hsB, voffB); PG8_STAGE(PG8_SA(1, 0), a3, voffA);
            PG8_WAIT_V(8); PG8_WAIT_L(0); PG8_BAR; PG8_MMA(1, 0, At, B0); PG8_MMA(1, 1, At, B1); PG8_BAR; PG8_SCHED;
            if constexpr (Epi::MID) { if (t + 2 == ksplit) E.mid(acc, cur, wr, wc, fr, fq); }
        }
        if (wr == 0) PG8_BAR;
        { const int l2 = lane_now(); E(acc, cur, wr, wc, l2 & 15, l2 >> 4); }
        if (!has_next) break;
#pragma unroll
        for (int a = 0; a < 2; ++a)
#pragma unroll
            for (int b = 0; b < 2; ++b)
#pragma unroll
                for (int m = 0; m < 4; ++m)
#pragma unroll
                    for (int n = 0; n < 2; ++n) acc[a][b][m][n] = (f32x4){0.f, 0.f, 0.f, 0.f};
        cur = nxt; cA = nA; cB = nB; ++ui;
        if (wr == 1) PG8_BAR;
    }
    PG8_WAIT_V(0);
    PG8_BAR;
#undef PG8_SA
#undef PG8_SB
#undef PG8_STAGE
#undef PG8_STEP_voffA
#undef PG8_STEP_voffB
#undef PG8_LDA
#undef PG8_LDB
#undef PG8_MMA
#undef PG8_WAIT_V
#undef PG8_WAIT_L
#undef PG8_BAR
#undef PG8_SCHED
}
}
using pg8::Unit;

typedef f32x4 AccT[2][2][4][2];
__device__ __forceinline__ u32x4 pack8(f32x4 a, f32x4 b) { u32x4 w; w.x = cvt_pk_bf16(a[0], a[1]); w.y = cvt_pk_bf16(a[2], a[3]); w.z = cvt_pk_bf16(b[0], b[1]); w.w = cvt_pk_bf16(b[2], b[3]); return w; }
__device__ __forceinline__ u32x2 pack8_fp8(f32x4 a, f32x4 b) {
    int w0 = __builtin_amdgcn_cvt_pk_fp8_f32(a[0], a[1], 0, false); w0 = __builtin_amdgcn_cvt_pk_fp8_f32(a[2], a[3], w0, true);
    int w1 = __builtin_amdgcn_cvt_pk_fp8_f32(b[0], b[1], 0, false); w1 = __builtin_amdgcn_cvt_pk_fp8_f32(b[2], b[3], w1, true);
    return (u32x2){(unsigned)w0, (unsigned)w1};
}
__device__ __forceinline__ void unpack8(u32x4 w, f32x4& a, f32x4& b) { a = (f32x4){bf_lo(w.x), bf_hi(w.x), bf_lo(w.y), bf_hi(w.y)}; b = (f32x4){bf_lo(w.z), bf_hi(w.z), bf_lo(w.w), bf_hi(w.w)}; }

template <bool SET8> struct EpiInproj {
    static constexpr bool PERM = true, MID = false;
    bf16_t *q, *k, *v, *iq, *ik, *pl, *ga, *gp; float* iw;
    __device__ __forceinline__ void operator()(const AccT& acc, const Unit& u, int wr, int wc, int fr, int fq) const {
        const int pn = u.pn, row0 = u.pm * 256 + wr * 64 + fr;
        if (!SET8 && pn == 4) {
            if (wc < 2) {
#pragma unroll
                for (int ai = 0; ai < 2; ++ai)
#pragma unroll
                    for (int m = 0; m < 4; ++m) { const size_t row = (size_t)(row0 + ai * 128 + m * 16);
                        *(u32x4*)(ik + row * 64 + wc * 32 + 8 * fq) = pack8(acc[ai][0][m][0], acc[ai][0][m][1]); }
            } else if (wc == 2) {
                if (fq < 2) {
#pragma unroll
                    for (int ai = 0; ai < 2; ++ai)
#pragma unroll
                        for (int m = 0; m < 4; ++m) { const size_t row = (size_t)(row0 + ai * 128 + m * 16);
                            *(f32x4*)(iw + row * 16 + 8 * fq) = acc[ai][0][m][0]; *(f32x4*)(iw + row * 16 + 8 * fq + 4) = acc[ai][0][m][1]; }
                }
            }
            return;
        }
        bf16_t* dst; int ld, tc; bool sg = false;
        if (SET8) {
            if (pn < 4) { dst = q; ld = 1024; tc = pn * 256; }
            else if (pn == 4) { dst = k; ld = 256; tc = 0; }
            else if (pn == 5) { dst = v; ld = 256; tc = 0; }
            else if (pn < 14) { dst = ga; ld = 2048; tc = (pn - 6) * 256; sg = true; }
            else { dst = gp; ld = 2048; tc = (pn - 14) * 256; sg = true; }
        } else {
            if (pn < 4) { dst = iq; ld = 1024; tc = pn * 256; }
            else { dst = pl; ld = 1024; tc = (pn - 5) * 256; }
        }
        const int col0 = tc + wc * 32 + 8 * fq;
#pragma unroll
        for (int ai = 0; ai < 2; ++ai)
#pragma unroll
            for (int m = 0; m < 4; ++m) { bf16_t* rowp = dst + (size_t)(row0 + ai * 128 + m * 16) * ld + col0;
#pragma unroll
                for (int bj = 0; bj < 2; ++bj) { f32x4 v0 = acc[ai][bj][m][0], v1 = acc[ai][bj][m][1];
                    if (sg) {
#pragma unroll
                        for (int j = 0; j < 4; ++j) { v0[j] = sigmoidf_(v0[j]); v1[j] = sigmoidf_(v1[j]); } }
                    *(u32x4*)(rowp + bj * 128) = pack8(v0, v1); } }
    }
};
struct EpiBf16Scale {
    static constexpr bool PERM = true, MID = false;
    bf16_t* O; int ldc; const float* cs;
    __device__ __forceinline__ void operator()(const AccT& acc, const Unit& u, int wr, int wc, int fr, int fq) const {
        const int row0 = u.pm * 256 + wr * 64 + fr, col0 = u.pn * 256 + wc * 32 + 8 * fq;
        f32x4 s[2][2];
#pragma unroll
        for (int bj = 0; bj < 2; ++bj)
#pragma unroll
            for (int n = 0; n < 2; ++n) s[bj][n] = cs ? *(const f32x4*)(cs + col0 + bj * 128 + 4 * n) : (f32x4){1.f, 1.f, 1.f, 1.f};
#pragma unroll
        for (int ai = 0; ai < 2; ++ai)
#pragma unroll
            for (int m = 0; m < 4; ++m) { bf16_t* rowp = O + (size_t)(row0 + ai * 128 + m * 16) * ldc + col0;
#pragma unroll
                for (int bj = 0; bj < 2; ++bj) *(u32x4*)(rowp + bj * 128) = pack8(acc[ai][bj][m][0] * s[bj][0], acc[ai][bj][m][1] * s[bj][1]); }
    }
};
struct EpiF8Scale {
    static constexpr bool PERM = true, MID = false;
    unsigned char* O; int ldc; const float* cs;
    __device__ __forceinline__ void operator()(const AccT& acc, const Unit& u, int wr, int wc, int fr, int fq) const {
        const int row0 = u.pm * 256 + wr * 64 + fr, col0 = u.pn * 256 + wc * 32 + 8 * fq;
        f32x4 s[2][2];
#pragma unroll
        for (int bj = 0; bj < 2; ++bj)
#pragma unroll
            for (int n = 0; n < 2; ++n) s[bj][n] = *(const f32x4*)(cs + col0 + bj * 128 + 4 * n);
#pragma unroll
        for (int ai = 0; ai < 2; ++ai)
#pragma unroll
            for (int m = 0; m < 4; ++m) { unsigned char* rowp = O + (size_t)(row0 + ai * 128 + m * 16) * ldc + col0;
#pragma unroll
                for (int bj = 0; bj < 2; ++bj) *(u32x2*)(rowp + bj * 128) = pack8_fp8(acc[ai][bj][m][0] * s[bj][0], acc[ai][bj][m][1] * s[bj][1]); }
    }
};
template <bool ADD> struct EpiGate {
    static constexpr bool PERM = true, MID = false;
    bf16_t* O; const bf16_t* gate;
    __device__ __forceinline__ void operator()(const AccT& acc, const Unit& u, int wr, int wc, int fr, int fq) const {
        const int row0 = u.pm * 256 + wr * 64 + fr, col0 = u.pn * 256 + wc * 32 + 8 * fq;
#pragma unroll
        for (int ai = 0; ai < 2; ++ai)
#pragma unroll
            for (int m = 0; m < 4; ++m) { const size_t off = (size_t)(row0 + ai * 128 + m * 16) * 2048 + col0;
#pragma unroll
                for (int bj = 0; bj < 2; ++bj) { f32x4 g0, g1; unpack8(*(const u32x4*)(gate + off + bj * 128), g0, g1);
                    f32x4 r0 = g0 * acc[ai][bj][m][0], r1 = g1 * acc[ai][bj][m][1];
                    if (ADD) { f32x4 o0, o1; unpack8(*(const u32x4*)(O + off + bj * 128), o0, o1); r0 += o0; r1 += o1; }
                    *(u32x4*)(O + off + bj * 128) = pack8(r0, r1); } }
    }
};
struct EpiMerge {
    static constexpr bool PERM = true, MID = true;
    unsigned char* O; const bf16_t* ga; const bf16_t* gp;
    __device__ __forceinline__ void mid(AccT& acc, const Unit& u, int wr, int wc, int fr, int fq) const {
        const auto ra = __builtin_amdgcn_make_buffer_rsrc((void*)ga, 0, 0x7FFFFFFF, 0x00020000), rp = __builtin_amdgcn_make_buffer_rsrc((void*)gp, 0, 0x7FFFFFFF, 0x00020000);
        const int voff = ((wr * 64 + fr) * 2048 + wc * 32 + 8 * fq) * 2;
        const int sbase = (u.pm * 256 * 2048 + u.pn * 256) * 2;
#pragma unroll
        for (int ai = 0; ai < 2; ++ai)
#pragma unroll
            for (int m = 0; m < 4; ++m)
#pragma unroll
                for (int bj = 0; bj < 2; ++bj) { const int so = sbase + ((ai * 128 + m * 16) * 2048 + bj * 128) * 2;
                    const u32x4 wa = __builtin_bit_cast(u32x4, __builtin_amdgcn_raw_buffer_load_b128(ra, voff, so, 0)), wp = __builtin_bit_cast(u32x4, __builtin_amdgcn_raw_buffer_load_b128(rp, voff, so, 0));
                    f32x4 a0, a1, p0, p1; unpack8(wa, a0, a1); unpack8(wp, p0, p1);
#pragma unroll
                    for (int j = 0; j < 4; ++j) { acc[ai][bj][m][0][j] *= a0[j] * __builtin_amdgcn_rcpf(p0[j]); acc[ai][bj][m][1][j] *= a1[j] * __builtin_amdgcn_rcpf(p1[j]); }
                    asm volatile("" : "+v"(acc[ai][bj][m][0]), "+v"(acc[ai][bj][m][1]) :: "memory"); }
    }
    __device__ __forceinline__ void operator()(const AccT& acc, const Unit& u, int wr, int wc, int fr, int fq) const {
        const int row0 = u.pm * 256 + wr * 64 + fr, col0 = u.pn * 256 + wc * 32 + 8 * fq;
#pragma unroll
        for (int ai = 0; ai < 2; ++ai)
#pragma unroll
            for (int m = 0; m < 4; ++m) { const size_t off = (size_t)(row0 + ai * 128 + m * 16) * 2048 + col0;
#pragma unroll
                for (int bj = 0; bj < 2; ++bj) { f32x4 p0, p1; unpack8(*(const u32x4*)(gp + off + bj * 128), p0, p1);
                    *(u32x2*)(O + off + bj * 128) = pack8_fp8(p0 * acc[ai][bj][m][0], p1 * acc[ai][bj][m][1]); } }
    }
};
struct EpiResid {
    static constexpr bool PERM = false, MID = false;
    const float* x; float* out; const float* gt;
    __device__ __forceinline__ void operator()(const AccT& acc, const Unit& u, int wr, int wc, int fr, int fq) const {
        const int row0 = u.pm * 256 + wr * 64 + fr, col0 = u.pn * 256 + wc * 32 + 4 * fq;
        const float* gtb = gt + (size_t)(u.pm / 16) * 12288;
        f32x4 g[2][2];
#pragma unroll
        for (int bj = 0; bj < 2; ++bj)
#pragma unroll
            for (int n = 0; n < 2; ++n) g[bj][n] = *(const f32x4*)(gtb + col0 + bj * 128 + n * 16);
#pragma unroll
        for (int ai = 0; ai < 2; ++ai)
#pragma unroll
            for (int m = 0; m < 4; ++m) { const size_t off = (size_t)(row0 + ai * 128 + m * 16) * 2048 + col0;
#pragma unroll
                for (int bj = 0; bj < 2; ++bj)
#pragma unroll
                    for (int n = 0; n < 2; ++n) { const f32x4 xv = *(const f32x4*)(x + off + bj * 128 + n * 16);
                        *(f32x4*)(out + off + bj * 128 + n * 16) = xv + g[bj][n] * acc[ai][bj][m][n]; } }
    }
};
struct EpiF32 {
    static constexpr bool PERM = false, MID = false;
    float* C; int ldc;
    __device__ __forceinline__ void operator()(const AccT& acc, const Unit& u, int wr, int wc, int fr, int fq) const {
        const int row0 = u.pm * 256 + wr * 64 + fr, col0 = u.pn * 256 + wc * 32 + 4 * fq;
#pragma unroll
        for (int ai = 0; ai < 2; ++ai)
#pragma unroll
            for (int m = 0; m < 4; ++m) { float* rowp = C + (size_t)(row0 + ai * 128 + m * 16) * ldc + col0;
#pragma unroll
                for (int bj = 0; bj < 2; ++bj)
#pragma unroll
                    for (int n = 0; n < 2; ++n) *(f32x4*)(rowp + bj * 128 + n * 16) = acc[ai][bj][m][n]; }
    }
};

struct Args { const float* in[19]; float* out; unsigned char* ws; int ph_lo, ph_hi; int li, pad; };
struct Frame {
    unsigned char* lds; unsigned char* ws;
    int tid, lane, wave, G, bid;
    const float *x, *c, *w_ada, *b_ada, *g1, *g2, *w_in, *g_q, *g_k, *rel_bias, *pool_w, *pool_scale, *w_ab, *w_pb, *w_out, *w_pq, *peer_keys, *peer_u, *peer_v;
    float* out;
};

template <bool F8OUT = false, class Fn> __device__ __forceinline__ void transpose_item(const float* W, int K, int N, void* WTv, int ldk, int drow0, int k0, float* scr, int lane, Fn srccol, float mul = 1.0f) {
    const int sc = srccol(drow0 + (lane & 31));
#pragma unroll 8
    for (int i = 0; i < 32; ++i) { const int kk = 2 * i + (lane >> 5); scr[kk * 33 + (lane & 31)] = sc >= 0 ? W[(size_t)(k0 + kk) * N + sc] * mul : 0.f; }
    asm volatile("s_waitcnt lgkmcnt(0)" ::: "memory");
    const int c = lane & 7;
#pragma unroll
    for (int j = 0; j < 4; ++j) { const int n = (lane >> 3) + 8 * j; const float* s = scr + (8 * c) * 33 + n;
        if constexpr (F8OUT) { *(u32x2*)((unsigned char*)WTv + (size_t)(drow0 + n) * ldk + k0 + 8 * c) = pack8_fp8((f32x4){s[0 * 33], s[1 * 33], s[2 * 33], s[3 * 33]}, (f32x4){s[4 * 33], s[5 * 33], s[6 * 33], s[7 * 33]}); }
        else { u32x4 o; o.x = cvt_pk_bf16(s[0 * 33], s[1 * 33]); o.y = cvt_pk_bf16(s[2 * 33], s[3 * 33]); o.z = cvt_pk_bf16(s[4 * 33], s[5 * 33]); o.w = cvt_pk_bf16(s[6 * 33], s[7 * 33]);
            *(u32x4*)((bf16_t*)WTv + (size_t)(drow0 + n) * ldk + k0 + 8 * c) = o; } }
    asm volatile("s_waitcnt lgkmcnt(0)" ::: "memory");
}
__device__ __forceinline__ void phase0_prep(Frame& F) {
    F.lane = lane_now(); F.tid = F.wave * 64 + F.lane;
    const int gw = F.bid * 8 + F.wave, NGW = F.G * 8;
    float* scr = (float*)(F.lds + F.wave * 16384);
    constexpr int I_IN16 = (2304 / 32) * (DM / 64), I_IN8 = (5632 / 32) * (DM / 64);
    constexpr int I_AB = (2048 / 32) * (1024 / 64), I_OUT = (2048 / 32) * (2048 / 64), I_PW = 4 * 8 * 4;
    constexpr int NIT = I_IN16 + I_IN8 + 2 * I_AB + 2 * I_OUT + I_PW;
    auto ident = [](int j) { return j; };
    for (int it = gw; it < NIT; it += NGW) {
        int r = it;
        if (r < I_IN16) { const int nb = r % 72, kb = r / 72;
            transpose_item(F.w_in, DM, INW, F.ws + WS_WIN16, DM, nb * 32, kb * 64, scr, F.lane, [](int j) { return j < 1104 ? j + 1536 : (j < 1280 ? -1 : j + 1360); }); continue; }
        r -= I_IN16;
        if (r < I_IN8) { const int nb = r % 176, kb = r / 176;
            transpose_item<true>(F.w_in, DM, INW, F.ws + WS_WIN8, DM, nb * 32, kb * 64, scr, F.lane, [](int j) { return j < 1536 ? j : j + 2128; }, 16.0f); continue; }
        r -= I_IN8;
        if (r < I_AB) { transpose_item<true>(F.w_ab, 1024, 2048, F.ws + WS_WAB, 1024, (r % 64) * 32, (r / 64) * 64, scr, F.lane, ident, 16.0f); continue; }
        r -= I_AB;
        if (r < I_AB) { transpose_item<true>(F.w_pb, 1024, 2048, F.ws + WS_WPB, 1024, (r % 64) * 32, (r / 64) * 64, scr, F.lane, ident, 16.0f); continue; }
        r -= I_AB;
        if (r < I_OUT) { transpose_item<true>(F.w_out, 2048, 2048, F.ws + WS_WOUT, 2048, (r % 64) * 32, (r / 64) * 64, scr, F.lane, ident, 16.0f); continue; }
        r -= I_OUT;
        if (r < I_OUT) { transpose_item(F.w_pq, 2048, 2048, (bf16_t*)(F.ws + WS_WPQ), 2048, (r % 64) * 32, (r / 64) * 64, scr, F.lane, ident); continue; }
        r -= I_OUT;
        { const int g = r / 32, q = r % 32, nb = q % 8, kb = q / 8;
          transpose_item(F.pool_w + (size_t)g * 65536, 256, 256, (bf16_t*)(F.ws + WS_POOLW) + (size_t)g * 65536, 256, nb * 32, kb * 64, scr, F.lane, ident); }
    }
    {
        bf16_t* kb = (bf16_t*)(F.ws + WS_KEYSBD);
        for (int i = F.bid * 512 + F.tid; i < 2048 * 32; i += F.G * 512) {
            const int row = i / 32, k8 = (i % 32) * 8, p = (row >> 7) & 1;
            u32x4 o = (u32x4){0u, 0u, 0u, 0u};
            if ((k8 >> 7) == p) { const float* s = F.peer_keys + (size_t)row * 128 + (k8 & 127); const f32x4 a = *(const f32x4*)s, b = *(const f32x4*)(s + 4); o = pack8(a, b); }
            *(u32x4*)(kb + (size_t)row * 256 + k8) = o;
        }
    }
    {
        unsigned char* pu = F.ws + WS_PU;
        for (size_t i = (size_t)F.bid * 512 + F.tid; i < (size_t)NEXP * 64; i += (size_t)F.G * 512) {
            const float* src = F.peer_u + i * 32;
            u32x16 pk;
#pragma unroll
            for (int k = 0; k < 8; ++k) { const f32x4 a = *(const f32x4*)(src + k * 4) * 96.0f; pk[2 * k] = cvt_pk_bf16(a[0], a[1]); pk[2 * k + 1] = cvt_pk_bf16(a[2], a[3]); }
            const u32x6 p6 = __builtin_amdgcn_cvt_scalef32_pk32_fp6_bf16(__builtin_bit_cast(bf16x32, pk), 1.0f);
            const int ci = (int)(i & 63), lp = (ci >> 2) + 16 * (ci & 3);
            unsigned char* dst = pu + (i >> 6) * 1536;
            *(u32x4*)(dst + lp * 16) = (u32x4){p6[0], p6[1], p6[2], p6[3]}; *(u32x2*)(dst + 1024 + lp * 8) = (u32x2){p6[4], p6[5]};
        }
        unsigned char* pv = F.ws + WS_PV;
        for (int it = gw; it < (NEXP / 64) * 128; it += NGW) {
            const int e = (it >> 7) * 64 + F.lane, ch = it & 127;
            u32x4 ov;
#pragma unroll
            for (int k = 0; k < 4; ++k) { const f32x4 c = *(const f32x4*)(F.peer_v + (size_t)e * DM + ch * 16 + k * 4) * 4.0f;
                int wv = __builtin_amdgcn_cvt_pk_fp8_f32(c[0], c[1], 0, false); wv = __builtin_amdgcn_cvt_pk_fp8_f32(c[2], c[3], wv, true); ov[k] = (unsigned)wv; }
            *(u32x2*)(pv + ((size_t)(2 * ch) * NEXP + e) * 8) = (u32x2){ov[0], ov[1]};
            *(u32x2*)(pv + ((size_t)(2 * ch + 1) * NEXP + e) * 8) = (u32x2){ov[2], ov[3]};
        }
    }
    {
        __syncthreads();
        float* cact = (float*)(F.lds + 131072);
        float* red = (float*)F.lds;
        float* mp = (float*)(F.ws + WS_MODP);
        for (int it = F.bid; it < 48 * 4; it += F.G) {
            const int cb = it % 48, ds = it / 48, d0 = ds * 512;
            for (int i = F.tid; i < 8 * 512; i += 512) { const int b = i >> 9, d = i & 511; const float cv = F.c[b * DM + d0 + d]; cact[i] = cv * sigmoidf_(cv); }
            __syncthreads();
            f32x4 a[8];
#pragma unroll
            for (int b = 0; b < 8; ++b) a[b] = (f32x4){0.f, 0.f, 0.f, 0.f};
            const float* wp = F.w_ada + (size_t)(d0 + F.wave * 64) * 12288 + cb * 256 + F.lane * 4;
#pragma unroll 4
            for (int d = 0; d < 64; ++d) { const f32x4 w = *(const f32x4*)(wp + (size_t)d * 12288);
#pragma unroll
                for (int b = 0; b < 8; ++b) a[b] += w * cact[b * 512 + F.wave * 64 + d]; }
#pragma unroll
            for (int b = 0; b < 8; ++b)
#pragma unroll
                for (int j = 0; j < 4; ++j) red[(F.wave * 32 + b * 4 + j) * 64 + F.lane] = a[b][j];
            __syncthreads();
            for (int i = F.tid; i < 2048; i += 512) { const int v = i >> 6, l = i & 63; float s = 0.f;
#pragma unroll
                for (int w = 0; w < 8; ++w) s += red[(w * 32 + v) * 64 + l];
                mp[((size_t)ds * 8 + (v >> 2)) * 12288 + cb * 256 + l * 4 + (v & 3)] = s; }
            __syncthreads();
        }
    }
}

template <bool FIRST> __device__ __forceinline__ void phase_modnorm(Frame& F, const float* xin, const float* gain, int off_sh, int off_sc, bf16_t* dst, unsigned char* dst8 = nullptr) {
    F.lane = lane_now(); F.tid = F.wave * 64 + F.lane;
    const float* mp = (const float*)(F.ws + WS_MODP); float* mf = (float*)(F.ws + WS_MODF);
    if (FIRST) {
        for (int i = F.bid * 512 + F.tid; i < 8 * 12288; i += F.G * 512) {
            float s = F.b_ada[i % 12288];
#pragma unroll
            for (int k = 0; k < 4; ++k) s += mp[(size_t)k * 8 * 12288 + i];
            mf[i] = s; }
    }
    float* cA = (float*)F.lds; float* cB = cA + 2048;
    for (int ch = F.bid; ch < MTOK / 128; ch += F.G) {
        const int b = ch / 32;
        __syncthreads();
        for (int col = F.tid; col < 2048; col += 512) {
            float sc, sh;
            if (FIRST) { sc = F.b_ada[off_sc + col]; sh = F.b_ada[off_sh + col];
#pragma unroll
                for (int k = 0; k < 4; ++k) { sc += mp[((size_t)k * 8 + b) * 12288 + off_sc + col]; sh += mp[((size_t)k * 8 + b) * 12288 + off_sh + col]; } }
            else { sc = mf[b * 12288 + off_sc + col]; sh = mf[b * 12288 + off_sh + col]; }
            cA[col] = gain[col] * (1.f + sc); cB[col] = sh; }
        __syncthreads();
        for (int r = F.wave; r < 128; r += 8) {
            const size_t row = (size_t)ch * 128 + r;
            const float* xr = xin + row * 2048 + F.lane * 8;
            f32x4 v[4][2]; float ss = 0.f;
#pragma unroll
            for (int i = 0; i < 4; ++i) { v[i][0] = *(const f32x4*)(xr + i * 512); v[i][1] = *(const f32x4*)(xr + i * 512 + 4);
#pragma unroll
                for (int j = 0; j < 4; ++j) ss += v[i][0][j] * v[i][0][j] + v[i][1][j] * v[i][1][j]; }
            ss = wave_sum(ss);
            const float rinv = 1.0f / sqrtf(ss * (1.0f / 2048.0f) + EPS);
#pragma unroll
            for (int i = 0; i < 4; ++i) { const int col = i * 512 + F.lane * 8;
                const f32x4 a0 = *(const f32x4*)(cA + col), a1 = *(const f32x4*)(cA + col + 4), b0 = *(const f32x4*)(cB + col), b1 = *(const f32x4*)(cB + col + 4);
                const f32x4 y0 = v[i][0] * rinv * a0 + b0, y1 = v[i][1] * rinv * a1 + b1;
                *(u32x4*)(dst + row * 2048 + col) = pack8(y0, y1);
                if (FIRST) *(u32x2*)(dst8 + row * 2048 + col) = pack8_fp8(y0, y1); }
        }
    }
}

__device__ __forceinline__ void phase3_qknorm(Frame& F) {
    F.lane = lane_now(); F.tid = F.wave * 64 + F.lane;
    const bf16_t* q = (const bf16_t*)(F.ws + WS_QN); const bf16_t* k = (const bf16_t*)(F.ws + WS_KN); const bf16_t* v = (const bf16_t*)(F.ws + WS_V);
    unsigned char* q8 = F.ws + WS_Q8; unsigned char* k8 = F.ws + WS_K8; unsigned char* v8 = F.ws + WS_V8;
    const int gw = F.bid * 8 + F.wave, NGW = F.G * 8;
    for (int row = gw; row < MTOK; row += NGW) {
#pragma unroll
        for (int i = 0; i < 2; ++i) { const int ci = i * 64 + F.lane;
            f32x4 a, b; unpack8(*(const u32x4*)(q + (size_t)row * 1024 + ci * 8), a, b);
            float ss = a[0] * a[0] + a[1] * a[1] + a[2] * a[2] + a[3] * a[3] + b[0] * b[0] + b[1] * b[1] + b[2] * b[2] + b[3] * b[3];
            ss = row_sum16(ss);
            const float rinv = 1.0f / sqrtf(ss * (1.0f / 128.0f) + EPS);
            const float* gp = F.g_q + (ci & 15) * 8; const f32x4 g0 = *(const f32x4*)gp, g1 = *(const f32x4*)(gp + 4);
            *(u32x2*)(q8 + (size_t)row * 1024 + ci * 8) = pack8_fp8(a * rinv * g0, b * rinv * g1); }
        { const int ci = F.lane & 31; const bool isk = F.lane < 32;
            f32x4 a, b; unpack8(*(const u32x4*)((isk ? k : v) + (size_t)row * 256 + ci * 8), a, b);
            float ss = a[0] * a[0] + a[1] * a[1] + a[2] * a[2] + a[3] * a[3] + b[0] * b[0] + b[1] * b[1] + b[2] * b[2] + b[3] * b[3];
            ss = row_sum16(ss);
            const float rinv = isk ? 1.0f / sqrtf(ss * (1.0f / 128.0f) + EPS) : 1.0f;
            const float* gp = F.g_k + (ci & 15) * 8; f32x4 g0 = *(const f32x4*)gp, g1 = *(const f32x4*)(gp + 4);
            if (!isk) { g0 = (f32x4){1.f, 1.f, 1.f, 1.f}; g1 = g0; }
            *(u32x2*)((isk ? k8 : v8) + (size_t)row * 256 + ci * 8) = pack8_fp8(a * rinv * g0, b * rinv * g1); }
    }
}
template <int W> __device__ __forceinline__ void pooled_item(const bf16_t* pl, bf16_t* po, int row, int c8) {
    const int t = row & (SEQ - 1);
    f32x4 s0 = (f32x4){0.f, 0.f, 0.f, 0.f}, s1 = s0, x0 = s0, x1 = s0;
    u32x4 v[W];
#pragma unroll
    for (int j = 0; j < W; ++j) v[j] = *(const u32x4*)(pl + (size_t)(row - (j <= t ? j : 0)) * 1024 + c8);
#pragma unroll
    for (int j = 0; j < W; ++j) { f32x4 a, b; unpack8(v[j], a, b); if (j == 0) { x0 = a; x1 = b; } if (j <= t) { s0 += a; s1 += b; } }
    const float inv = 1.0f / (float)((t + 1 < W) ? t + 1 : W);
    *(u32x4*)(po + (size_t)row * 1024 + c8) = pack8(s0 * inv - x0, s1 * inv - x1);
}
__device__ __forceinline__ void phase3_pooled(Frame& F) {
    F.lane = lane_now(); F.tid = F.wave * 64 + F.lane;
    const bf16_t* pl = (const bf16_t*)(F.ws + WS_PL); bf16_t* po = (bf16_t*)(F.ws + WS_POOLED);
    const int gw = F.bid * 8 + F.wave, NGW = F.G * 8;
    for (int it = gw; it < (MTOK / 2) * 4; it += NGW) {
        const int g = it & 3, row = (it >> 2) * 2 + (F.lane >> 5), c8 = g * 256 + (F.lane & 31) * 8;
        if (g == 0) pooled_item<2>(pl, po, row, c8); else if (g == 1) pooled_item<4>(pl, po, row, c8); else if (g == 2) pooled_item<8>(pl, po, row, c8); else pooled_item<16>(pl, po, row, c8);
    }
}
typedef float f32x16 __attribute__((ext_vector_type(16)));
__device__ __forceinline__ float wrelu_(float wh, float d, float acc) { return __builtin_fmaf(wh, d, __builtin_fmaf(wh, __builtin_fabsf(d), acc)); }
__device__ __forceinline__ int sel_code(float s, float smin, float scale) { const float c = (s - smin) * scale; return (int)fminf(fmaxf(c, 0.f), 65535.f); }
__device__ __forceinline__ void hist_find(const unsigned* hist, int lane, int K, int& bsel, int& above) {
    const u32x4 h = *(const u32x4*)(hist + lane * 4);
    const int S = (int)(h.x + h.y + h.z + h.w);
    int x = S;
    x += __builtin_amdgcn_update_dpp(0, x, 0x101, 0xF, 0xF, true);
    x += __builtin_amdgcn_update_dpp(0, x, 0x102, 0xF, 0xF, true);
    x += __builtin_amdgcn_update_dpp(0, x, 0x104, 0xF, 0xF, true);
    x += __builtin_amdgcn_update_dpp(0, x, 0x108, 0xF, 0xF, true);
    const int t1 = __builtin_amdgcn_readlane(x, 16), t2 = __builtin_amdgcn_readlane(x, 32), t3 = __builtin_amdgcn_readlane(x, 48);
    const int r = lane >> 4;
    x += (r == 0 ? t1 + t2 + t3 : (r == 1 ? t2 + t3 : (r == 2 ? t3 : 0)));
    const int sufn = x - S;
    const bool mine = (x >= K) && (sufn < K);
    int b = 0, ab = 0;
    { int c = sufn;
      if (c + (int)h.w >= K) { b = 3; ab = c; } else { c += (int)h.w;
      if (c + (int)h.z >= K) { b = 2; ab = c; } else { c += (int)h.z;
      if (c + (int)h.y >= K) { b = 1; ab = c; } else { c += (int)h.y; b = 0; ab = c; } } } }
    const unsigned long long m = __ballot(mine);
    const int src = m ? (int)__builtin_ctzll(m) : 0;
    bsel = __builtin_amdgcn_readlane(lane * 4 + b, src); above = __builtin_amdgcn_readlane(ab, src);
}
__device__ __forceinline__ int mask_prefix(unsigned long long m) { return (int)__builtin_amdgcn_mbcnt_hi((unsigned)(m >> 32), __builtin_amdgcn_mbcnt_lo((unsigned)m, 0u)); }
template <class Fn> __device__ __forceinline__ void sel_sweep(const f32x4* rb4, int n4, int lane, int t, Fn fn) {
    f32x4 cur = rb4[lane];
    for (int c4 = 0; c4 < n4 - 1; ++c4) { const f32x4 nxt = rb4[(c4 + 1) * 64 + lane];
#pragma unroll
        for (int k = 0; k < 4; ++k) fn(cur[k], (c4 * 4 + k) * 64 + lane, true);
        cur = nxt; }
    { const int c4 = n4 - 1;
#pragma unroll
      for (int k = 0; k < 4; ++k) { const int idx = (c4 * 4 + k) * 64 + lane; fn(cur[k], idx, idx <= t); } }
}
template <int MODE = 0> __device__ __forceinline__ void indexer_select(Frame& F, int b, int t, const float* rowbuf, unsigned* hist, float* eqv, int* eqi) {
    unsigned short* selrow = (unsigned short*)(F.ws + (MODE ? WS_R0 : WS_SEL)) + (size_t)(b * SEQ + t) * 256;
    int lane = F.lane; asm volatile("" : "+v"(lane));
    const int nch = t / 64 + 1, n4 = (nch + 3) >> 2;
    const f32x4* rb4 = (const f32x4*)rowbuf;
    float mn = __builtin_huge_valf(), mx = -__builtin_huge_valf();
    sel_sweep(rb4, n4, lane, t, [&](float v, int, bool valid) { mn = valid ? fminf(mn, v) : mn; mx = valid ? fmaxf(mx, v) : mx; });
    mx = xor16_max(row_max16(mx)); { const auto r = __builtin_amdgcn_permlane32_swap(__float_as_uint(mx), __float_as_uint(mx), false, false); mx = fmaxf(__uint_as_float(r[0]), __uint_as_float(r[1])); }
    mn = -mn; mn = xor16_max(row_max16(mn)); { const auto r = __builtin_amdgcn_permlane32_swap(__float_as_uint(mn), __float_as_uint(mn), false, false); mn = -fmaxf(__uint_as_float(r[0]), __uint_as_float(r[1])); }
    const float scale = (mx > mn) ? 65535.0f / (mx - mn) : 0.f;
    *(u32x4*)(hist + lane * 4) = (u32x4){0u, 0u, 0u, 0u};
    sel_sweep(rb4, n4, lane, t, [&](float v, int, bool valid) { if (valid) { if (MODE == 2) ((volatile unsigned*)hist)[sel_code(v, mn, scale) >> 8] = 1u; else atomicAdd(&hist[sel_code(v, mn, scale) >> 8], 1u); } });
    int b1, above1; hist_find(hist, lane, KSEL, b1, above1);
    *(u32x4*)(hist + lane * 4) = (u32x4){0u, 0u, 0u, 0u};
    sel_sweep(rb4, n4, lane, t, [&](float v, int, bool valid) { const int code = sel_code(v, mn, scale); if (valid && (code >> 8) == b1) atomicAdd(&hist[code & 255], 1u); });
    int b2, above2; hist_find(hist, lane, KSEL - above1, b2, above2);
    const int T16 = (b1 << 8) | b2, need = KSEL - above1 - above2, ceq = (int)hist[b2];
    const bool all_eq = (ceq == need), collect = !all_eq && (ceq <= 64);
    const int eq_budget = all_eq ? 0x7fffffff : (collect ? 0 : need);
    int pos = 0, eqseen = 0;
    sel_sweep(rb4, n4, lane, t, [&](float v, int idx, bool valid) {
        const int code = sel_code(v, mn, scale);
        const bool gt = valid && code > T16, eq = valid && code == T16;
        const unsigned long long mg = __ballot(gt);
        const unsigned p = (unsigned)(pos + mask_prefix(mg));
        if (gt && p < (unsigned)KSEL) selrow[p] = (unsigned short)idx;
        pos += __popcll(mg);
        const unsigned long long me = __ballot(eq);
        if (me) {
            const int er = eqseen + mask_prefix(me); const bool te = eq && er < eq_budget;
            if (collect && eq) { eqv[er] = v; eqi[er] = idx; }
            eqseen += __popcll(me);
            const unsigned long long mte = __ballot(te);
            const unsigned pe = (unsigned)(pos + mask_prefix(mte));
            if (te && pe < (unsigned)KSEL) selrow[pe] = (unsigned short)idx;
            pos += __popcll(mte);
        }
    });
    if (collect && lane < ceq) {
        const float sv = eqv[lane]; const int idx = eqi[lane]; int rank = 0;
        for (int m = 0; m < ceq; ++m) { const float ov = eqv[m]; const int oi = eqi[m]; rank += (ov > sv || (ov == sv && oi < idx)) ? 1 : 0; }
        if (rank < need) selrow[KSEL - need + rank] = (unsigned short)idx;
    }
}
__device__ __forceinline__ void indexer_tile(Frame& F, int b, int t0) {
    const bf16_t* iq = (const bf16_t*)(F.ws + WS_IQ); const bf16_t* ik = (const bf16_t*)(F.ws + WS_IK); const float* iw = (const float*)(F.ws + WS_IW);
    int lane = F.lane; asm volatile("" : "+v"(lane));
    const int w = F.wave;
    if (t0 < KSEL) {
        const int t = t0 + w; unsigned short* selrow = (unsigned short*)(F.ws + WS_SEL) + (size_t)(b * SEQ + t) * 256;
#pragma unroll
        for (int p = 0; p < 4; ++p) { const int j = p * 64 + lane; selrow[j] = (unsigned short)(j <= t ? j : 0xFFFF); }
        return;
    }
    float* rowbuf = (float*)F.lds;
    unsigned char* stage = F.lds + 131072;
    const int p = w & 3, kh = w >> 2, hi = lane >> 5, r = lane & 31;
    const size_t qrow = (size_t)b * SEQ + t0 + 2 * p + (r >> 4);
    bf16x8 a[4];
#pragma unroll
    for (int ks = 0; ks < 4; ++ks) a[ks] = *(const bf16x8*)(iq + qrow * 1024 + (r & 15) * 64 + ks * 16 + 8 * hi);
    float wq[2][8];
#pragma unroll
    for (int q = 0; q < 2; ++q)
#pragma unroll
        for (int i = 0; i < 8; ++i) wq[q][i] = 0.5f * iw[((size_t)b * SEQ + t0 + 2 * p + q) * 16 + (i & 3) + 8 * ((i >> 2) & 1) + 4 * hi];
    const int nchunks = (t0 + 7) / 64 + 1, nsteps = (nchunks + 1) >> 1;
    const unsigned char* gsrc = (const unsigned char*)(ik + (size_t)b * SEQ * 64) + F.tid * 16;
    const int skey = F.tid >> 3, sc16 = F.tid & 7, soff = skey * 128 + ((sc16 ^ ((skey >> 1) & 7)) << 4);
    u32x4 sa0 = *(const u32x4*)gsrc, sb0 = sa0, sa1 = sa0, sb1 = sa0;
    sb0 = *(const u32x4*)(gsrc + (size_t)min(1, nchunks - 1) * 8192);
    sa1 = *(const u32x4*)(gsrc + (size_t)min(2, nchunks - 1) * 8192);
    sb1 = *(const u32x4*)(gsrc + (size_t)min(3, nchunks - 1) * 8192);
    __syncthreads();
#if PROBE_IDX != 1 && PROBE_IDX != 5
#define IDX_LD(c) (*(const u32x4*)(gsrc + (size_t)(c) * 8192))
#endif
#define IDX_MMA(SA, SB, ss, D0, D1) do { const int s_ = (ss); unsigned char* sb = stage + (s_ & 1) * 16384; \
        *(u32x4*)(sb + soff) = SA; *(u32x4*)(sb + 8192 + soff) = SB; \
        __syncthreads(); \
        SA = IDX_LD(min(2 * s_ + 4, nchunks - 1)); \
        SB = IDX_LD(min(2 * s_ + 5, nchunks - 1)); \
        _Pragma("unroll") for (int i = 0; i < 16; ++i) { D0[i] = 0.f; D1[i] = 0.f; } \
        _Pragma("unroll") for (int ks = 0; ks < 4; ++ks) { const unsigned char* bp = sb + key * 128 + (((ks * 2 + hi) ^ ((key >> 1) & 7)) << 4); \
            const bf16x8 bf0 = *(const bf16x8*)bp, bf1 = *(const bf16x8*)(bp + 8192); \
            D0 = __builtin_amdgcn_mfma_f32_32x32x16_bf16(a[ks], bf0, D0, 0, 0, 0); D1 = __builtin_amdgcn_mfma_f32_32x32x16_bf16(a[ks], bf1, D1, 0, 0, 0); } } while (0)
#define IDX_RED(ss, D0, D1) do { const int s_ = (ss); float x0_ = 0.f, x1_ = 0.f, y0_ = 0.f, y1_ = 0.f; \
        _Pragma("unroll") for (int i = 0; i < 8; ++i) { x0_ = wrelu_(wq[0][i], D0[i], x0_); x1_ = wrelu_(wq[1][i], D0[8 + i], x1_); y0_ = wrelu_(wq[0][i], D1[i], y0_); y1_ = wrelu_(wq[1][i], D1[8 + i], y1_); } \
        const float scx = swap32_pair(x0_, x1_), scy = swap32_pair(y0_, y1_); \
        *(f32x2*)(rowbuf + (2 * p + hi) * 4096 + ((s_ >> 1) * 64 + key) * 4 + 2 * (s_ & 1)) = (f32x2){scx, scy}; } while (0)
    const int key = kh * 32 + r;
    f32x16 dA0, dA1, dB0, dB1;
#if PROBE_IDX == 1
#define IDX_LD(c) (*(const u32x4*)(gsrc + (size_t)(c) * 8192))
#elif PROBE_IDX == 5
#define IDX_LD(c) SAVED
#endif
#if PROBE_IDX == 1 || PROBE_IDX == 5
    { const u32x4 SAVED = sa0;
    IDX_MMA(sa0, sb0, 0, dA0, dA1);
    for (int s2 = 0; s2 < nsteps; s2 += 2) {
        if (s2 + 1 < nsteps) IDX_MMA(sa1, sb1, s2 + 1, dB0, dB1);
        IDX_RED(s2, dA0, dA1);
        if (s2 + 2 < nsteps) IDX_MMA(sa0, sb0, s2 + 2, dA0, dA1);
        if (s2 + 1 < nsteps) IDX_RED(s2 + 1, dB0, dB1);
    }
    __syncthreads();
    sa0 = *(const u32x4*)gsrc;
    sb0 = *(const u32x4*)(gsrc + (size_t)min(1, nchunks - 1) * 8192);
    sa1 = *(const u32x4*)(gsrc + (size_t)min(2, nchunks - 1) * 8192);
    sb1 = *(const u32x4*)(gsrc + (size_t)min(3, nchunks - 1) * 8192); }
#undef IDX_LD
#define IDX_LD(c) (*(const u32x4*)(gsrc + (size_t)(c) * 8192))
#endif
    IDX_MMA(sa0, sb0, 0, dA0, dA1);
    for (int s2 = 0; s2 < nsteps; s2 += 2) {
        if (s2 + 1 < nsteps) IDX_MMA(sa1, sb1, s2 + 1, dB0, dB1);
        IDX_RED(s2, dA0, dA1);
        if (s2 + 2 < nsteps) IDX_MMA(sa0, sb0, s2 + 2, dA0, dA1);
        if (s2 + 1 < nsteps) IDX_RED(s2 + 1, dB0, dB1);
    }
#undef IDX_MMA
#undef IDX_RED
#undef IDX_LD
    __syncthreads();
    indexer_select(F, b, t0 + w, rowbuf + w * 4096, (unsigned*)(F.lds + 147456) + w * 256, (float*)(F.lds + 155648) + w * 64, (int*)(F.lds + 155648 + 2048) + w * 64);
#if PROBE_IDX >= 2
    indexer_select<PROBE_IDX - 1>(F, b, t0 + w, rowbuf + w * 4096, (unsigned*)(F.lds + 147456) + w * 256, (float*)(F.lds + 155648) + w * 64, (int*)(F.lds + 155648 + 2048) + w * 64);
#endif
}
__device__ __forceinline__ void phase3_indexer(Frame& F) {
    F.lane = lane_now(); F.tid = F.wave * 64 + F.lane;
    volatile LAS unsigned* misc = (volatile LAS unsigned*)((LAS unsigned char*)F.lds + MISC_OFF);
    const unsigned keep0 = misc[0], keep1 = misc[1];
    __syncthreads();
    const int nit = BATCH * (SEQ / 8);
    for (int k = 0;; ++k) {
        const int l = k * F.G + ((k & 1) ? (F.G - 1 - F.bid) : F.bid);
        if (l >= nit) { if (k * F.G >= nit) break; else continue; }
        const int qb = (SEQ / 8 - 1) - (l >> 3), b = l & 7;
        indexer_tile(F, b, qb * 8);
    }
    __syncthreads();
    if (F.tid == 0) { misc[0] = keep0; misc[1] = keep1; }
}

__device__ const unsigned char g_bucket[128] = {0, 1, 2, 3, 4, 5, 6, 7, 8, 9, 10, 11, 12, 13, 14, 15, 16, 16, 16, 17, 17, 18, 18, 18, 19, 19, 19, 20, 20, 20, 20, 21, 21, 21, 21, 22, 22, 22, 22, 22, 23, 23, 23, 23, 23, 23, 24, 24, 24, 24, 24, 24, 25, 25, 25, 25, 25, 25, 25, 26, 26, 26, 26, 26, 26, 26, 26, 27, 27, 27, 27, 27, 27, 27, 27, 27, 27, 28, 28, 28, 28, 28, 28, 28, 28, 28, 28, 29, 29, 29, 29, 29, 29, 29, 29, 29, 29, 29, 29, 30, 30, 30, 30, 30, 30, 30, 30, 30, 30, 30, 30, 30, 30, 31, 31, 31, 31, 31, 31, 31, 31, 31, 31, 31, 31, 31, 31, 31};
__device__ __forceinline__ void at_pv_step(f32x4 (&D0)[8], f32x4 (&D1)[8], const u32x4 (&buf)[8], LAS unsigned char* vwr, LAS unsigned char* ard, LAS unsigned char* brd) {
#pragma unroll
    for (int c = 0; c < 8; ++c) *(LAS u32x4*)(vwr + c * 576) = buf[c];
    const long pb = __builtin_bit_cast(long, __builtin_amdgcn_ds_read_tr8_b64_v2i32((LAS v2i*)brd));
#pragma unroll
    for (int tl = 0; tl < 8; ++tl) { const long va = __builtin_bit_cast(long, __builtin_amdgcn_ds_read_tr8_b64_v2i32((LAS v2i*)(ard + tl * 16))); D0[tl] = __builtin_amdgcn_mfma_f32_16x16x32_fp8_fp8(va, pb, D0[tl], 0, 0, 0); }
#pragma unroll
    for (int tl = 0; tl < 8; ++tl) { const long va = __builtin_bit_cast(long, __builtin_amdgcn_ds_read_tr8_b64_v2i32((LAS v2i*)(ard + 4608 + tl * 16))); D1[tl] = __builtin_amdgcn_mfma_f32_16x16x32_fp8_fp8(va, pb, D1[tl], 0, 0, 0); }
}
__device__ __forceinline__ void phase4_attention(Frame& F) {
    F.lane = lane_now(); F.tid = F.wave * 64 + F.lane;
    const unsigned char* q8 = F.ws + WS_Q8; const unsigned char* k8 = F.ws + WS_K8; const unsigned char* v8 = F.ws + WS_V8;
    const unsigned short* sel = (const unsigned short*)(F.ws + WS_SEL); unsigned char* ao = F.ws + WS_ATTN;
    float* btab = (float*)F.lds;
    __syncthreads();
    for (int i = F.tid; i < 256; i += 512) btab[i] = F.rel_bias[i];
    __syncthreads();
    constexpr int WST = 16512;
    unsigned char* wgp = F.lds + 4096 + F.wave * WST;
    bf16_t* Pb = (bf16_t*)(wgp + 9216); int* idl = (int*)(wgp + 13312); float* psl = (float*)(wgp + 16384); float* pml = psl + 8;
    LAS unsigned char* wl = (LAS unsigned char*)F.lds + 4096 + F.wave * WST;
    const bool xmap = (F.G % 8) == 0;
    const int gw = xmap ? (F.bid / 8) * 8 + F.wave : F.bid * 8 + F.wave, NGW = xmap ? F.G : F.G * 8, nrows = xmap ? SEQ : MTOK;
    for (int rr = gw; rr < nrows; rr += NGW) {
        int lane = F.lane; asm volatile("" : "+v"(lane));
        const int row = xmap ? (F.bid & 7) * SEQ + rr : rr;
        const int b = row / SEQ, t = row % SEQ, r = lane & 31, hi = lane >> 5;
#pragma unroll
        for (int p = 0; p < 4; ++p) { idl[p * 64 + lane] = (int)sel[(size_t)row * 256 + p * 64 + lane]; }
        long a0[8], a1[8];
        { u32x4 qa[4];
#pragma unroll
          for (int i = 0; i < 4; ++i) qa[i] = (r < 8) ? *(const u32x4*)(q8 + (size_t)row * 1024 + r * 128 + hi * 64 + i * 16) : (u32x4){0u, 0u, 0u, 0u};
#pragma unroll
          for (int ks = 0; ks < 8; ++ks) { const unsigned lo = qa[ks >> 1][(ks & 1) * 2], hh = qa[ks >> 1][(ks & 1) * 2 + 1]; const long v = (long)(((unsigned long long)hh << 32) | lo);
              a0[ks] = (r < 4) ? v : 0l; a1[ks] = (r >= 4) ? v : 0l; } }
        f32x4 psum = (f32x4){0.f, 0.f, 0.f, 0.f}, pmax = psum;
        const int vg4 = lane >> 4, vch = lane & 15;
#define AT_LOADK(buf, kb) do { _Pragma("unroll") for (int c = 0; c < 8; ++c) { const int key_ = idl[(kb) * 32 + 4 * c + vg4]; const int kc_ = key_ <= t ? key_ : 0; \
            buf[c] = *(const u32x4*)(k8 + ((size_t)b * SEQ + kc_) * 256 + vch * 16); } } while (0)
#define AT_QK(buf, kb) do { const int key_ = idl[(kb) * 32 + r]; const bool valid_ = key_ <= t; const int kc_ = valid_ ? key_ : 0; \
            _Pragma("unroll") for (int c = 0; c < 8; ++c) *(LAS u32x4*)(wl + (4 * c + vg4) * 272 + vch * 16) = buf[c]; \
            u32x4 g0_[4], g1_[4]; \
            _Pragma("unroll") for (int i = 0; i < 4; ++i) { g0_[i] = *(const LAS u32x4*)(wl + r * 272 + hi * 64 + i * 16); g1_[i] = *(const LAS u32x4*)(wl + r * 272 + 128 + hi * 64 + i * 16); } \
            f32x16 d; _Pragma("unroll") for (int i = 0; i < 16; ++i) d[i] = 0.f; \
            _Pragma("unroll") for (int ks = 0; ks < 8; ++ks) { const long bv_ = (long)(((unsigned long long)g0_[ks >> 1][(ks & 1) * 2 + 1] << 32) | g0_[ks >> 1][(ks & 1) * 2]); d = __builtin_amdgcn_mfma_f32_32x32x16_fp8_fp8(a0[ks], bv_, d, 0, 0, 0); } \
            _Pragma("unroll") for (int ks = 0; ks < 8; ++ks) { const long bv_ = (long)(((unsigned long long)g1_[ks >> 1][(ks & 1) * 2 + 1] << 32) | g1_[ks >> 1][(ks & 1) * 2]); d = __builtin_amdgcn_mfma_f32_32x32x16_fp8_fp8(a1[ks], bv_, d, 0, 0, 0); } \
            const int dist_ = t - kc_; const int bkt_ = dist_ < 128 ? (int)g_bucket[dist_] : 31; \
            const f32x4 bias_ = *(const f32x4*)(btab + bkt_ * 8 + 4 * hi); f32x4 e_; \
            _Pragma("unroll") for (int i = 0; i < 4; ++i) e_[i] = valid_ ? __expf(d[i] * 0.08838834764831845f + bias_[i]) : 0.f; \
            psum += e_; _Pragma("unroll") for (int i = 0; i < 4; ++i) pmax[i] = fmaxf(pmax[i], e_[i]); \
            *(u32x2*)(Pb + ((kb) * 32 + r) * 8 + 4 * hi) = (u32x2){cvt_pk_bf16(e_[0], e_[1]), cvt_pk_bf16(e_[2], e_[3])}; } while (0)
        {
            u32x4 kA[8], kB[8];
            AT_LOADK(kA, 0);
#pragma unroll 1
            for (int kb = 0; kb < 8; kb += 2) {
                AT_LOADK(kB, kb + 1);
                AT_QK(kA, kb);
                if (kb + 2 < 8) AT_LOADK(kA, kb + 2);
                AT_QK(kB, kb + 1);
            }
        }
#undef AT_LOADK
#undef AT_QK
#pragma unroll
        for (int i = 0; i < 4; ++i) { psum[i] = xor16_sum(row_sum16(psum[i])); pmax[i] = xor16_max(row_max16(pmax[i])); }
        if (r == 0) { *(f32x4*)(psl + 4 * hi) = psum; *(f32x4*)(pml + 4 * hi) = pmax; }
        const int kq = lane >> 4, tq = (lane >> 1) & 7, tp = lane & 1;
#define AT_LOADV(buf, ks_) do { _Pragma("unroll") for (int c = 0; c < 8; ++c) { const int key_ = idl[(ks_) * 32 + 4 * c + vg4]; const int kc_ = key_ <= t ? key_ : 0; \
            buf[c] = *(const u32x4*)(v8 + ((size_t)b * SEQ + kc_) * 256 + vch * 16); } } while (0)
        u32x4 vA[8], vB[8];
        AT_LOADV(vA, 0);
        { const f32x4 m0 = *(const f32x4*)pml, m1 = *(const f32x4*)(pml + 4);
          f32x4 r0, r1;
#pragma unroll
          for (int i = 0; i < 4; ++i) { r0[i] = __builtin_amdgcn_rcpf(m0[i]); r1[i] = __builtin_amdgcn_rcpf(m1[i]); }
#pragma unroll
          for (int i = 0; i < 4; ++i) { const int key = i * 64 + lane;
              f32x4 pa, pb; unpack8(*(const u32x4*)(Pb + key * 8), pa, pb);
              *(LAS u32x2*)(wl + 14336 + key * 8) = pack8_fp8(pa * r0, pb * r1); } }
        f32x4 D0[8], D1[8];
#pragma unroll
        for (int tl = 0; tl < 8; ++tl) { D0[tl] = (f32x4){0.f, 0.f, 0.f, 0.f}; D1[tl] = D0[tl]; }
        LAS unsigned char* vwr = wl + (vch >> 3) * 4608 + vg4 * 144 + (vch & 7) * 16;
        LAS unsigned char* ard = wl + (kq * 8 + tq) * 144 + 8 * tp;
        LAS unsigned char* brd = wl + 14336 + (kq * 8 + tq) * 8;
#pragma unroll 1
        for (int ks = 0; ks < 8; ks += 2) {
            AT_LOADV(vB, ks + 1);
            at_pv_step(D0, D1, vA, vwr, ard, brd + ks * 256);
            if (ks + 2 < 8) AT_LOADV(vA, ks + 2);
            at_pv_step(D0, D1, vB, vwr, ard, brd + (ks + 1) * 256);
        }
#undef AT_LOADV
        { const int n = lane & 15, q4 = lane >> 4;
          if (n < 8) { const float sc = pml[n] / psl[n]; const bool g1 = n >= 4;
              unsigned char* op = ao + (size_t)row * 1024 + n * 128 + q4 * 4;
#pragma unroll
              for (int tl = 0; tl < 8; ++tl) { const f32x4 d = (g1 ? D1[tl] : D0[tl]) * sc;
                  int w = __builtin_amdgcn_cvt_pk_fp8_f32(d[0], d[1], 0, false); w = __builtin_amdgcn_cvt_pk_fp8_f32(d[2], d[3], w, true);
                  *(unsigned*)(op + tl * 16) = (unsigned)w; } } }
    }
}

__device__ __forceinline__ float dot16f8(u32x4 w, const float* h) {
    float s = 0.f;
#pragma unroll
    for (int d = 0; d < 4; ++d) { const f32x2 lo = __builtin_amdgcn_cvt_pk_f32_fp8((int)w[d], false), hi = __builtin_amdgcn_cvt_pk_f32_fp8((int)w[d], true);
        s += lo.x * h[4 * d] + lo.y * h[4 * d + 1] + hi.x * h[4 * d + 2] + hi.y * h[4 * d + 3]; }
    return s;
}
__device__ __forceinline__ void fma16f8(u32x4 w, float cf, float* acc) {
#pragma unroll
    for (int d = 0; d < 4; ++d) { const f32x2 lo = __builtin_amdgcn_cvt_pk_f32_fp8((int)w[d], false), hi = __builtin_amdgcn_cvt_pk_f32_fp8((int)w[d], true);
        acc[4 * d] += cf * lo.x; acc[4 * d + 1] += cf * lo.y; acc[4 * d + 2] += cf * hi.x; acc[4 * d + 3] += cf * hi.y; }
}
__device__ __forceinline__ float gelu_erf(float x) { return 0.5f * x * (1.0f + erff(x * 0.70710678118654752f)); }
__device__ __forceinline__ void ce_k(unsigned& a, unsigned& b) { const unsigned hi = a > b ? a : b, lo = a > b ? b : a; a = hi; b = lo; }
__device__ __forceinline__ void ce_kp(unsigned& ka, unsigned& pa, unsigned& kb, unsigned& pb) { const bool sw = kb > ka; const unsigned k0 = sw ? kb : ka, k1 = sw ? ka : kb, p0 = sw ? pb : pa, p1 = sw ? pa : pb; ka = k0; kb = k1; pa = p0; pb = p1; }
__device__ __forceinline__ void bmerge16(unsigned (&x)[16]) {
#pragma unroll
    for (int jj = 0; jj < 4; ++jj) { const int j = 8 >> jj;
#pragma unroll
        for (int i = 0; i < 16; ++i) { const int l = i ^ j; if (l > i) ce_k(x[i], x[l]); }
        __builtin_amdgcn_sched_barrier(0); }
}
__device__ __forceinline__ void bmerge16p(unsigned (&x)[16], unsigned (&p)[16]) {
#pragma unroll
    for (int jj = 0; jj < 4; ++jj) { const int j = 8 >> jj;
#pragma unroll
        for (int i = 0; i < 16; ++i) { const int l = i ^ j; if (l > i) ce_kp(x[i], p[i], x[l], p[l]); }
        __builtin_amdgcn_sched_barrier(0); }
}
__device__ __forceinline__ void bsort16(unsigned (&x)[16]) {
#pragma unroll
    for (int kk = 1; kk <= 4; ++kk) { const int k = 1 << kk;
#pragma unroll
        for (int jj = 0; jj < 4; ++jj) { const int j = (k >> 1) >> jj;
            if (j > 0) {
#pragma unroll
                for (int i = 0; i < 16; ++i) { const int l = i ^ j; if (l > i) { if ((i & k) == 0) ce_k(x[i], x[l]); else ce_k(x[l], x[i]); } }
                __builtin_amdgcn_sched_barrier(0); } } }
}
__device__ __forceinline__ void bsort16p(unsigned (&x)[16], unsigned (&p)[16]) {
#pragma unroll
    for (int kk = 1; kk <= 4; ++kk) { const int k = 1 << kk;
#pragma unroll
        for (int jj = 0; jj < 4; ++jj) { const int j = (k >> 1) >> jj;
            if (j > 0) {
#pragma unroll
                for (int i = 0; i < 16; ++i) { const int l = i ^ j; if (l > i) { if ((i & k) == 0) ce_kp(x[i], p[i], x[l], p[l]); else ce_kp(x[l], p[l], x[i], p[i]); } }
                __builtin_amdgcn_sched_barrier(0); } } }
}
__device__ __forceinline__ void top16_row(const unsigned char* rowp, unsigned (&t)[16]) {
#pragma unroll
    for (int i = 0; i < 16; ++i) t[i] = 0u;
#pragma unroll 1
    for (int g = 0; g < 8; ++g) {
        unsigned w[8];
#pragma unroll
        for (int q = 0; q < 4; ++q) { const u32x2 v = *(const u32x2*)(rowp + g * 32 + q * 8); w[2 * q] = v.x; w[2 * q + 1] = v.y; }
        unsigned sk[16];
#pragma unroll
        for (int d = 0; d < 8; ++d) {
            const unsigned lo = w[d] << 16, hi = w[d];
            const unsigned xl = lo ^ ((unsigned)((int)lo >> 31) | 0x80000000u), xh = hi ^ ((unsigned)((int)hi >> 31) | 0x80000000u);
            sk[2 * d] = ((xl >> 9) & 0xFFFFFF80u) | (unsigned)(127 - (g * 16 + 2 * d));
            sk[2 * d + 1] = ((xh >> 9) & 0xFFFFFF80u) | (unsigned)(127 - (g * 16 + 2 * d + 1)); }
        bsort16(sk);
#pragma unroll
        for (int i = 0; i < 16; ++i) t[i] = t[i] > sk[15 - i] ? t[i] : sk[15 - i];
        bmerge16(t);
    }
}
__device__ __forceinline__ float key_val(unsigned key) { const unsigned y = (key << 9) & 0xFFFF0000u; return __uint_as_float((y ^ (~(unsigned)((int)y >> 31) | 0x80000000u)) & 0xFFFF0000u); }
__device__ __forceinline__ unsigned sum_key(float s, int c) { const unsigned u = __float_as_uint(s); return ((u ^ ((unsigned)((int)u >> 31) | 0x80000000u)) & ~63u) | (unsigned)(63 - c); }
__device__ __forceinline__ float sum_val(unsigned k) { const unsigned y = k & ~63u; return __uint_as_float(y ^ (~(unsigned)((int)y >> 31) | 0x80000000u)); }
typedef __bf16 bf2_t __attribute__((ext_vector_type(2)));
__device__ __forceinline__ float dot2_bf(unsigned a, unsigned b, float c) { return __builtin_amdgcn_fdot2_f32_bf16(__builtin_bit_cast(bf2_t, a), __builtin_bit_cast(bf2_t, b), c, false); }
__device__ __forceinline__ float dot32_f6b(u32x4 wa, u32x2 wb, u32x4 h0, u32x4 h1, u32x4 h2, u32x4 h3) {
    const bf16x32 dec = __builtin_amdgcn_cvt_scalef32_pk32_bf16_fp6((u32x6){wa.x, wa.y, wa.z, wa.w, wb.x, wb.y}, 1.0f);
    const u32x16 ud = __builtin_bit_cast(u32x16, dec);
    float acc = 0.f;
    acc = dot2_bf(ud.s0, h0.x, acc); acc = dot2_bf(ud.s1, h0.y, acc); acc = dot2_bf(ud.s2, h0.z, acc); acc = dot2_bf(ud.s3, h0.w, acc);
    acc = dot2_bf(ud.s4, h1.x, acc); acc = dot2_bf(ud.s5, h1.y, acc); acc = dot2_bf(ud.s6, h1.z, acc); acc = dot2_bf(ud.s7, h1.w, acc);
    acc = dot2_bf(ud.s8, h2.x, acc); acc = dot2_bf(ud.s9, h2.y, acc); acc = dot2_bf(ud.sa, h2.z, acc); acc = dot2_bf(ud.sb, h2.w, acc);
    acc = dot2_bf(ud.sc, h3.x, acc); acc = dot2_bf(ud.sd, h3.y, acc); acc = dot2_bf(ud.se, h3.z, acc); acc = dot2_bf(ud.sf, h3.w, acc);
    return acc;
}
__device__ const unsigned char g_cab[64] = {0, 1, 2, 3, 4, 5, 6, 7, 8, 9, 10, 11, 12, 13, 14, 15, 16, 17, 18, 19, 20, 21, 22, 23, 32, 33, 34, 35, 36, 48, 49, 50, 51, 64, 65, 66, 80, 81, 96, 97, 112, 113, 128, 144, 160, 176, 192, 208, 224, 240, 0, 0, 0, 0, 0, 0, 0, 0, 0, 0, 0, 0, 0, 0};
template <int PMODE = 0> __device__ __forceinline__ void phase10_peer(Frame& F) {
    F.lane = lane_now(); F.tid = F.wave * 64 + F.lane;
    const bf16_t* sub = (const bf16_t*)(F.ws + WS_SUB); const bf16_t* h2 = (const bf16_t*)(F.ws + WS_H2);
    const unsigned char* pu = F.ws + WS_PU; unsigned* pairs = (unsigned*)(F.ws + WS_PAIRS);
    const int gw = F.bid * 8 + F.wave, NGW = F.G * 8;
    unsigned char* wb = F.lds + F.wave * 19200;
    unsigned char* h2b = wb; unsigned short* gl16 = (unsigned short*)(wb + 16896); unsigned* hist = (unsigned*)(wb + 18944); unsigned* base = hist + 32;
    unsigned* tmp = (unsigned*)wb;
    unsigned* wls0 = (unsigned*)(F.ws + WS_WLS) + (size_t)gw * 1024;
    const int ntok = (MTOK - gw + NGW - 1) / NGW;
    const bool wgsync = (MTOK % (NGW * 8)) == 0;
    constexpr int CA[50] = {0,0,0,0,0,0,0,0,0,0,0,0,0,0,0,0, 1,1,1,1,1,1,1,1, 2,2,2,2,2, 3,3,3,3, 4,4,4, 5,5, 6,6, 7,7, 8,9,10,11,12,13,14,15};
    constexpr int CB[50] = {0,1,2,3,4,5,6,7,8,9,10,11,12,13,14,15, 0,1,2,3,4,5,6,7, 0,1,2,3,4, 0,1,2,3, 0,1,2, 0,1, 0,1, 0,1, 0,0,0,0,0,0,0,0};
    for (int p0 = 0; p0 < ntok; p0 += 8) {
        int lane = F.lane; asm volatile("" : "+v"(lane));
        const int nt = (ntok - p0) < 8 ? (ntok - p0) : 8;
        {
            u32x4 st[16];
#define SEL_LOAD(half) do { asm volatile("" : "+v"(lane)); const int srow_l = lane >> 4, scol = lane & 15; _Pragma("unroll") for (int it = 0; it < 16; ++it) { const int r_ = it * 4 + srow_l; int ti_ = r_ >> 3; ti_ = ti_ < nt ? ti_ : nt - 1; \
                st[it] = *(const u32x4*)(sub + (size_t)(gw + (p0 + ti_) * NGW) * 2048 + (r_ & 7) * 256 + (half) * 128 + scol * 8); } } while (0)
#define SEL_STORE() do { const int srow_l = lane >> 4, scol = lane & 15; _Pragma("unroll") for (int it = 0; it < 16; ++it) { unsigned char* d_ = wb + (it * 4 + srow_l) * 264 + scol * 16; \
                *(u32x2*)d_ = (u32x2){st[it].x, st[it].y}; *(u32x2*)(d_ + 8) = (u32x2){st[it].z, st[it].w}; } } while (0)
            unsigned tA[16], tB[16];
            SEL_LOAD(0); SEL_STORE();
            __builtin_amdgcn_sched_barrier(0);
            top16_row(wb + lane * 264, tA);
            __builtin_amdgcn_sched_barrier(0);
            asm volatile("" : "+v"(tA[0]), "+v"(tA[1]), "+v"(tA[2]), "+v"(tA[3]), "+v"(tA[4]), "+v"(tA[5]), "+v"(tA[6]), "+v"(tA[7]), "+v"(tA[8]), "+v"(tA[9]), "+v"(tA[10]), "+v"(tA[11]), "+v"(tA[12]), "+v"(tA[13]), "+v"(tA[14]), "+v"(tA[15]) :: "memory");
            SEL_LOAD(1); SEL_STORE();
            __builtin_amdgcn_sched_barrier(0);
            top16_row(wb + lane * 264, tB);
            __builtin_amdgcn_sched_barrier(0);
#undef SEL_LOAD
#undef SEL_STORE
            float vA[16], vB[16];
            { unsigned pa[4] = {0u, 0u, 0u, 0u}, pb[4] = {0u, 0u, 0u, 0u};
#pragma unroll
              for (int i = 0; i < 16; ++i) { vA[i] = key_val(tA[i]); vB[i] = key_val(tB[i]); pa[i >> 2] |= (127u - (tA[i] & 127u)) << (8 * (i & 3)); pb[i >> 2] |= (127u - (tB[i] & 127u)) << (8 * (i & 3)); }
              unsigned char* rp = wb + lane * 264;
              *(u32x2*)rp = (u32x2){pa[0], pa[1]}; *(u32x2*)(rp + 8) = (u32x2){pa[2], pa[3]}; *(u32x2*)(rp + 16) = (u32x2){pb[0], pb[1]}; *(u32x2*)(rp + 24) = (u32x2){pb[2], pb[3]}; }
            unsigned tk[16];
#pragma unroll
            for (int c = 0; c < 16; ++c) tk[c] = sum_key(vA[CA[c]] + vB[CB[c]], c);
            bsort16(tk);
#pragma unroll
            for (int grp = 1; grp < 3; ++grp) {
                unsigned sk[16];
#pragma unroll
                for (int e = 0; e < 16; ++e) { const int c = grp * 16 + e; sk[e] = sum_key(vA[CA[c]] + vB[CB[c]], c); }
                bsort16(sk);
#pragma unroll
                for (int i = 0; i < 16; ++i) tk[i] = tk[i] > sk[15 - i] ? tk[i] : sk[15 - i];
                bmerge16(tk);
            }
#pragma unroll
            for (int c = 48; c < 50; ++c) { unsigned k = sum_key(vA[CA[c]] + vB[CB[c]], c);
#pragma unroll
                for (int i = 0; i < 16; ++i) ce_k(tk[i], k); }
            const float s0 = sum_val(tk[0]); float ev[16], esum = 0.f;
#pragma unroll
            for (int r = 0; r < 16; ++r) { ev[r] = __expf(sum_val(tk[r]) - s0); esum += ev[r]; }
            const float einv = 1.0f / esum;
            unsigned eid[16];
            { const unsigned char* rp = wb + lane * 264;
#pragma unroll
              for (int r = 0; r < 16; ++r) { const unsigned cab = g_cab[63u - (tk[r] & 63u)]; eid[r] = (unsigned)rp[cab >> 4] * 128u + (unsigned)rp[16 + (cab & 15u)]; } }
            if ((lane >> 3) < nt) {
#pragma unroll
                for (int r = 0; r < 16; ++r) { const int e = lane * 16 + r; tmp[e] = ((unsigned)e << 14) | eid[r]; gl16[e] = (unsigned short)(cvt_pk_bf16(ev[r] * einv, 0.f) & 0xffffu); } }
        }
        asm volatile("" : "+v"(lane));
        const int ne = nt * 128;
        {
            if (lane < 32) hist[lane] = 0u;
            unsigned ent[16]; unsigned rk[16];
#pragma unroll
            for (int q = 0; q < 16; ++q) { const int e = q * 64 + lane; ent[q] = (e < ne) ? tmp[e] : 0u; rk[q] = (e < ne) ? atomicAdd(&hist[(ent[q] & 0x3FFFu) >> 9], 1u) : 0u; }
            { int hv = lane < 32 ? (int)hist[lane] : 0; int x = hv;
              x += __builtin_amdgcn_update_dpp(0, x, 0x111, 0xF, 0xF, true); x += __builtin_amdgcn_update_dpp(0, x, 0x112, 0xF, 0xF, true);
              x += __builtin_amdgcn_update_dpp(0, x, 0x114, 0xF, 0xF, true); x += __builtin_amdgcn_update_dpp(0, x, 0x118, 0xF, 0xF, true);
              const int t0 = __builtin_amdgcn_readlane(x, 15); if (lane >= 16) x += t0;
              if (lane < 32) base[lane] = (unsigned)(x - hv); }
#pragma unroll
            for (int q = 0; q < 16; ++q) { const int e = q * 64 + lane; if (e < ne) wls0[base[(ent[q] & 0x3FFFu) >> 9] + rk[q]] = ent[q]; }
        }
        asm volatile("s_waitcnt vmcnt(0)" ::: "memory");
        asm volatile("" : "+v"(lane));
        u32x4 hraw[8][4];
#pragma unroll
        for (int i = 0; i < 8; ++i) { const int ic = i < nt ? i : nt - 1; const bf16_t* hr = h2 + (size_t)(gw + (p0 + ic) * NGW) * 2048 + lane * 32;
#pragma unroll
            for (int q = 0; q < 4; ++q) hraw[i][q] = *(const u32x4*)(hr + q * 8); }
#pragma unroll
        for (int i = 0; i < 8; ++i) { if (i >= nt) break;
            f32x4 v[8]; float m = 0.f;
#pragma unroll
            for (int q = 0; q < 4; ++q) { unpack8(hraw[i][q], v[2 * q], v[2 * q + 1]); }
#pragma unroll
            for (int q = 0; q < 8; ++q)
#pragma unroll
                for (int k = 0; k < 4; ++k) m = fmaxf(m, __builtin_fabsf(v[q][k]));
            int sb = (int)((__float_as_uint(m * 1.0666667f) >> 23) & 0xFFu) - 2; sb = sb < 1 ? 1 : (sb > 253 ? 253 : sb);
            const float inv = __uint_as_float((unsigned)(254 - sb) << 23);
            u32x16 pk;
#pragma unroll
            for (int q = 0; q < 8; ++q) { const f32x4 a = v[q] * inv; pk[2 * q] = cvt_pk_bf16(a[0], a[1]); pk[2 * q + 1] = cvt_pk_bf16(a[2], a[3]); }
            const u32x6 p6 = __builtin_amdgcn_cvt_scalef32_pk32_fp6_bf16(__builtin_bit_cast(bf16x32, pk), 1.0f);
            const int lp = (lane >> 2) + 16 * (lane & 3);
            *(u32x4*)(h2b + i * 2048 + lp * 16) = (u32x4){p6[0], p6[1], p6[2], p6[3]};
            *(u32x4*)(h2b + i * 2048 + 1024 + lp * 16) = (u32x4){p6[4], p6[5], (unsigned)sb, 0u}; }
        if (PMODE != 1) {
            const int dg = lane >> 4, dc = lane & 15;
            const bool dv = (dc >> 2) == dg; const int dr = dc & 3;
            const float w0 = (dv && dr == 0) ? 1.f : 0.f, w1 = (dv && dr == 1) ? 1.f : 0.f, w2 = (dv && dr == 2) ? 1.f : 0.f, w3 = (dv && dr == 3) ? 1.f : 0.f;
            unsigned entn = __hip_atomic_load(wls0 + lane, __ATOMIC_RELAXED, __HIP_MEMORY_SCOPE_AGENT);
#define U_LOAD(WA, WB, srcent, i0_) do { _Pragma("unroll") for (int jj = 0; jj < 8; ++jj) { const unsigned en_ = (unsigned)__builtin_amdgcn_readlane((int)(srcent), (i0_) + jj); \
                const unsigned char* ur = pu + (size_t)(en_ & 0x3FFFu) * 1536; WA[jj] = *(const u32x4*)(ur + lane * 16); WB[jj] = *(const u32x2*)(ur + 1024 + lane * 8); } } while (0)
#define U_COMP(WA, WB, i0_) do { float pr[8]; \
                _Pragma("unroll") for (int jj = 0; jj < 8; ++jj) { const unsigned en_ = (unsigned)__builtin_amdgcn_readlane((int)ent64, (i0_) + jj); const unsigned char* hp = h2b + ((en_ >> 21) & 7u) * 2048 + lane * 16; \
                    const u32x4 b0 = *(const u32x4*)hp, b1 = *(const u32x4*)(hp + 1024); \
                    const pg8::i32x8 A = (pg8::i32x8){(int)WA[jj].x, (int)WA[jj].y, (int)WA[jj].z, (int)WA[jj].w, (int)WB[jj].x, (int)WB[jj].y, 0, 0}; \
                    const pg8::i32x8 B = (pg8::i32x8){(int)b0.x, (int)b0.y, (int)b0.z, (int)b0.w, (int)b1.x, (int)b1.y, 0, 0}; \
                    const f32x4 D = __builtin_amdgcn_mfma_scale_f32_16x16x128_f8f6f4(A, B, (f32x4){0.f, 0.f, 0.f, 0.f}, 2  , 2  , 0, 0x7F7F7F7F, 0, (int)b1.z); \
                    pr[jj] = w0 * D[0] + w1 * D[1] + w2 * D[2] + w3 * D[3]; } \
                  \
                _Pragma("unroll") for (int i = 0; i < 4; ++i) pr[i] = swap32_pair(pr[i], pr[i + 4]); \
                _Pragma("unroll") for (int i = 0; i < 2; ++i) pr[i] = swap16_pair(pr[i], pr[i + 2]); \
                const bool b3 = (lane & 8) != 0; \
                { const float snd = b3 ? pr[0] : pr[1], kp = b3 ? pr[1] : pr[0]; pr[0] = kp + dpp_f<DPP_ROR8>(snd); } \
                float tot = pr[0]; tot += dpp_f<DPP_XOR1>(tot); tot += dpp_f<DPP_XOR2>(tot); tot += dpp_f<DPP_HMIRROR>(tot); \
                keep = ((lane & 7) == ((i0_) >> 3)) ? tot : keep;           \
            } while (0)
            u32x4 wA0[8], wA1[8]; u32x2 wB0[8], wB1[8];
            U_LOAD(wA0, wB0, entn, 0);
#pragma unroll 1
            for (int c = 0; c < ne; c += 64) {
                if (wgsync && (c & 255) == 0) __syncthreads();
                const unsigned ent64 = entn;
                const bool more = c + 64 < ne;
                if (more) entn = __hip_atomic_load(wls0 + c + 64 + lane, __ATOMIC_RELAXED, __HIP_MEMORY_SCOPE_AGENT);
                float keep = 0.f;
#pragma unroll 1
                for (int i0 = 0; i0 < 64; i0 += 16) {
                    U_LOAD(wA1, wB1, ent64, i0 + 8);
                    U_COMP(wA0, wB0, i0);
                    if (i0 + 16 < 64) U_LOAD(wA0, wB0, ent64, i0 + 16); else if (more) U_LOAD(wA0, wB0, entn, 0);
                    U_COMP(wA1, wB1, i0 + 8);
                }
                {
                    const unsigned em = (unsigned)__shfl((int)ent64, 8 * (lane & 7) + (lane >> 3));
                    const int ti = (int)(em >> 21), j = (int)((em >> 14) & 127u), row = gw + (p0 + ti) * NGW;
                    const float cf = gelu_erf(keep * (1.0f / 96.0f)) * __uint_as_float((unsigned)gl16[(em >> 14) & 1023u] << 16);
                    pairs[((size_t)(row >> 6) * 128 + j) * 64 + (row & 63)] = (((unsigned)__builtin_bit_cast(unsigned short, (_Float16)cf) << 16) & 0xFFFE0000u) | ((em & 0x3FFFu) << 3);
                }
            }
#undef U_LOAD
#undef U_COMP
        }
    }
}

__device__ __forceinline__ void phase11_peer_v(Frame& F, float* dst) {
    F.lane = lane_now(); F.tid = F.wave * 64 + F.lane;
    const unsigned* pairs = (const unsigned*)(F.ws + WS_PAIRS); const float* mf = (const float*)(F.ws + WS_MODF);
    unsigned long long* vs = (unsigned long long*)F.lds;
    for (int c0 = F.bid; c0 < DM / 8; c0 += F.G) {
        const int c = (c0 & 7) * 32 + (c0 >> 3);
        __syncthreads();
        { const u32x4* src = (const u32x4*)(F.ws + WS_PV + (size_t)c * NEXP * 8);
#pragma unroll 4
          for (int i = F.tid; i < NEXP * 8 / 16; i += 512) *(LAS u32x4*)(unsigned long long)(unsigned)(i * 16) = src[i]; }
        __syncthreads();
        typedef __fp16 h2_t __attribute__((__vector_size__(2 * sizeof(__fp16))));
#define P11_LOAD(dst, ptr) do { _Pragma("unroll") for (int jj = 0; jj < 16; ++jj) dst[jj] = (ptr)[jj * 64]; } while (0)
#define P11_FMA(A, X, C) asm("v_pk_fma_f16 %0, %1, %2, %0 op_sel:[0,1,0] op_sel_hi:[1,1,1]" : "+v"(C) : "v"(A), "v"(X))
#define P11_COMP(src) do { unsigned long long vv_[16]; \
                    _Pragma("unroll") for (int jj = 0; jj < 16; ++jj) vv_[jj] = *(const LAS unsigned long long*)(unsigned long long)(src[jj] & 0x1FFF8u);     \
                    __builtin_amdgcn_sched_barrier(0); \
                    _Pragma("unroll") for (int jj = 0; jj < 16; ++jj) { const int lo = (int)(unsigned)vv_[jj], hi = (int)(unsigned)(vv_[jj] >> 32); \
                    const h2_t c0_ = __builtin_amdgcn_cvt_scalef32_pk_f16_fp8(lo, 1.0f, false), c1_ = __builtin_amdgcn_cvt_scalef32_pk_f16_fp8(lo, 1.0f, true); \
                    const h2_t c2_ = __builtin_amdgcn_cvt_scalef32_pk_f16_fp8(hi, 1.0f, false), c3_ = __builtin_amdgcn_cvt_scalef32_pk_f16_fp8(hi, 1.0f, true); \
                    P11_FMA(c0_, src[jj], acc[0]); P11_FMA(c1_, src[jj], acc[1]); P11_FMA(c2_, src[jj], acc[2]); P11_FMA(c3_, src[jj], acc[3]); } } while (0)
#define P11_COMPX(src) do { unsigned long long vv_[16]; \
                    _Pragma("unroll") for (int jj = 0; jj < 16; ++jj) vv_[jj] = *(const LAS unsigned long long*)(unsigned long long)(src[jj] & 0x1FFF8u); \
                    __builtin_amdgcn_sched_barrier(0); \
                    _Pragma("unroll") for (int jj = 0; jj < 16; ++jj) { const int lo = (int)(unsigned)vv_[jj], hi = (int)(unsigned)(vv_[jj] >> 32); \
                    P11_FMA(lo, src[jj], acc[0]); P11_FMA(hi, src[jj], acc[1]); P11_FMA(lo, src[jj], acc[2]); P11_FMA(hi, src[jj], acc[3]); } } while (0)
        int lane = F.lane; asm volatile("" : "+v"(lane));
        unsigned pa[16], pb[16];
        f32x4 x0, x1;
        { const unsigned* pp = pairs + (size_t)F.wave * 128 * 64 + lane; P11_LOAD(pa, pp);
          const float* ip = F.out + (size_t)(F.wave * 64 + lane) * 2048 + c * 8; x0 = *(const f32x4*)ip; x1 = *(const f32x4*)(ip + 4); }
        for (int tile = F.wave; tile < MTOK / 64; tile += 8) {
            const unsigned* pp = pairs + (size_t)tile * 128 * 64 + lane;
            const int ntile = tile + 8 < MTOK / 64 ? tile + 8 : tile;
            const unsigned* npp = pairs + (size_t)ntile * 128 * 64 + lane;
            const int row = tile * 64 + lane;
            const float* gt2 = mf + (size_t)(tile / (SEQ / 64)) * 12288 + 10240 + c * 8;
            float* op = dst + (size_t)row * 2048 + c * 8;
            const f32x4 g0 = *(const f32x4*)gt2 * 0.25f, g1 = *(const f32x4*)(gt2 + 4) * 0.25f;
            h2_t acc[4];
#pragma unroll
            for (int i = 0; i < 4; ++i) acc[i] = (h2_t){(__fp16)0.f, (__fp16)0.f};
            f32x4 nx0 = x0, nx1 = x1;
#pragma unroll 1
            for (int j0 = 0; j0 < 128; j0 += 32) {
                P11_LOAD(pb, pp + (j0 + 16) * 64);
                P11_COMP(pa);
                const bool lastb = j0 + 32 >= 128;
                { const unsigned* np_ = lastb ? npp : pp + (j0 + 32) * 64; P11_LOAD(pa, np_); }
                if (lastb) { const float* nip = F.out + (size_t)(ntile * 64 + lane) * 2048 + c * 8; nx0 = *(const f32x4*)nip; nx1 = *(const f32x4*)(nip + 4); }
                P11_COMP(pb);
            }
#if PROBE_P11X == 1 || PROBE_P11X == 3
            { h2_t sv[4]; for (int i = 0; i < 4; ++i) sv[i] = acc[i];
#pragma unroll 1
              for (int j0 = 0; j0 < 128; j0 += 32) {
#pragma unroll
                for (int jj = 0; jj < 16; ++jj) { asm volatile("" : "+v"(pa[jj])); asm volatile("" : "+v"(pb[jj])); }
#if PROBE_P11X == 1
                P11_COMP(pa); P11_COMP(pb);
#else
                P11_COMPX(pa); P11_COMPX(pb);
#endif
              }
              asm volatile("" :: "v"(acc[0]), "v"(acc[1]), "v"(acc[2]), "v"(acc[3])); for (int i = 0; i < 4; ++i) acc[i] = sv[i]; }
#endif
            *(f32x4*)op = x0 + g0 * (f32x4){(float)acc[0][0], (float)acc[0][1], (float)acc[1][0], (float)acc[1][1]};
            *(f32x4*)(op + 4) = x1 + g1 * (f32x4){(float)acc[2][0], (float)acc[2][1], (float)acc[3][0], (float)acc[3][1]};
            x0 = nx0; x1 = nx1;
        }
#undef P11_LOAD
#undef P11_COMP
#undef P11_FMA
    }
}

__global__ void __launch_bounds__(512, 2) fwd_kernel(Args args) {
    extern __shared__ __attribute__((aligned(16))) unsigned char lds[];
    Frame F;
    F.lds = lds; F.ws = args.ws; F.tid = threadIdx.x; F.lane = F.tid & 63; F.wave = __builtin_amdgcn_readfirstlane(F.tid >> 6); F.G = gridDim.x; F.bid = blockIdx.x;
    F.x = args.in[0]; F.c = args.in[1]; F.w_ada = args.in[2]; F.b_ada = args.in[3]; F.g1 = args.in[4]; F.g2 = args.in[5]; F.w_in = args.in[6]; F.g_q = args.in[7]; F.g_k = args.in[8];
    F.rel_bias = args.in[9]; F.pool_w = args.in[10]; F.pool_scale = args.in[11]; F.w_ab = args.in[12]; F.w_pb = args.in[13]; F.w_out = args.in[14]; F.w_pq = args.in[15];
    F.peer_keys = args.in[16]; F.peer_u = args.in[17]; F.peer_v = args.in[18]; F.out = args.out;
    LAS unsigned char* ldsl = (LAS unsigned char*)lds;
    volatile LAS unsigned* misc = (volatile LAS unsigned*)(ldsl + MISC_OFF);
    if (F.tid < 4) misc[F.tid] = 0u;
    __syncthreads();
    unsigned* barw = (unsigned*)(args.ws + WS_CTL) + (size_t)args.li * XCD_BAR_WORDS;
    XcdBarrier bar; bar.bar = barw; bar.x = 0; bar.st = misc;
    const int lo = args.ph_lo, hi = args.ph_hi;
    if (hi - lo > 1) bar = xcd_barrier_post(barw, misc);
#define IN(k) (lo <= (k) && (k) < hi)
#define SEAM(k) do { if (IN(k) && IN((k) + 1)) xcd_barrier(bar, F.wave); } while (0)
    bf16_t* R0 = (bf16_t*)(F.ws + WS_R0);

#define PH2_BODY { \
        { pg8::Gemm g{(const bf16_t*)(F.ws + WS_H1F8), (const bf16_t*)(F.ws + WS_WIN8), MTOK, 5632, DM / 2, DM / 2, 0, nullptr, nullptr, 0, 0}; pg8::StaticOrder S; S.init(MTOK, 5632, F.G, F.bid); \
          EpiInproj<true> E{(bf16_t*)(F.ws + WS_QN), (bf16_t*)(F.ws + WS_KN), (bf16_t*)(F.ws + WS_V), (bf16_t*)(F.ws + WS_IQ), (bf16_t*)(F.ws + WS_IK), (bf16_t*)(F.ws + WS_PL), \
                    (bf16_t*)(F.ws + WS_GA), (bf16_t*)(F.ws + WS_GP), (float*)(F.ws + WS_IW)}; \
          pg8::gemm_phase<EpiInproj<true>, true>(ldsl, g, S, E, F.wave); } \
        { pg8::Gemm g{R0, (const bf16_t*)(F.ws + WS_WIN16), MTOK, 2304, DM, DM, 0, nullptr, nullptr, 0, 0}; pg8::StaticOrder S; S.init(MTOK, 2304, F.G, F.bid); \
          EpiInproj<false> E{(bf16_t*)(F.ws + WS_QN), (bf16_t*)(F.ws + WS_KN), (bf16_t*)(F.ws + WS_V), (bf16_t*)(F.ws + WS_IQ), (bf16_t*)(F.ws + WS_IK), (bf16_t*)(F.ws + WS_PL), \
                    (bf16_t*)(F.ws + WS_GA), (bf16_t*)(F.ws + WS_GP), (float*)(F.ws + WS_IW)}; \
          pg8::gemm_phase<EpiInproj<false>>(ldsl, g, S, E, F.wave); } }
#define PH3_BODY { phase3_pooled(F); phase3_indexer(F); __syncthreads(); }
#define PH4_BODY { \
        phase4_attention(F); \
        __syncthreads(); \
        pg8::Gemm g{(const bf16_t*)(F.ws + WS_POOLED), (const bf16_t*)(F.ws + WS_POOLW), MTOK, PW, 256, 1024, 256, nullptr, nullptr, 0, 0}; pg8::StaticOrder S; S.init(MTOK, PW, F.G, F.bid); \
        EpiF8Scale E{F.ws + WS_POOL2, 1024, F.pool_scale}; \
        pg8::gemm_phase<EpiF8Scale>(ldsl, g, S, E, F.wave); }
#define PH5_BODY { \
        pg8::Gemm g{(const bf16_t*)(F.ws + WS_ATTN), (const bf16_t*)(F.ws + WS_WAB), MTOK, DM, 1024, 512, 0, (const bf16_t*)(F.ws + WS_POOL2), (const bf16_t*)(F.ws + WS_WPB), 8, 512};     \
        pg8::StaticOrder S; S.init(MTOK, DM, F.G, F.bid); \
        EpiMerge E{(unsigned char*)R0, (const bf16_t*)(F.ws + WS_GA), (const bf16_t*)(F.ws + WS_GP)}; pg8::gemm_phase<EpiMerge, true>(ldsl, g, S, E, F.wave); }
#define PH6_BODY { \
        pg8::Gemm g{R0, (const bf16_t*)(F.ws + WS_WOUT), MTOK, DM, DM / 2, DM / 2, 0, nullptr, nullptr, 0, 0}; pg8::StaticOrder S; S.init(MTOK, DM, F.G, F.bid); \
        EpiResid E{F.x, F.out, (const float*)(F.ws + WS_MODF) + 4096}; pg8::gemm_phase<EpiResid, true>(ldsl, g, S, E, F.wave); }
#define PH8_BODY { \
        pg8::Gemm g{(const bf16_t*)(F.ws + WS_H2), (const bf16_t*)(F.ws + WS_WPQ), MTOK, DM, DM, DM, 0, nullptr, nullptr, 0, 0}; pg8::StaticOrder S; S.init(MTOK, DM, F.G, F.bid); \
        EpiBf16Scale E{R0, 2048, nullptr}; pg8::gemm_phase<EpiBf16Scale>(ldsl, g, S, E, F.wave); }
#define PH9_BODY { \
        pg8::Gemm g{R0, (const bf16_t*)(F.ws + WS_KEYSBD), MTOK, DM, 256, DM, 256, nullptr, nullptr, 0, 0}; pg8::StaticOrder S; S.init(MTOK, DM, F.G, F.bid); \
        EpiBf16Scale E{(bf16_t*)(F.ws + WS_SUB), 2048, nullptr}; pg8::gemm_phase<EpiBf16Scale>(ldsl, g, S, E, F.wave); }
#define REP(k) if constexpr (((PROBE_REP) >> (k)) & 1)

    if (IN(0)) { phase0_prep(F); REP(0) { __syncthreads(); phase0_prep(F); } }
    SEAM(0);
    if (IN(1)) { phase_modnorm<true>(F, F.x, F.g1, 0, 2048, R0, F.ws + WS_H1F8); REP(1) { phase_modnorm<true>(F, F.x, F.g1, 0, 2048, R0, F.ws + WS_H1F8); } }
    SEAM(1);
    if (IN(2)) { PH2_BODY REP(2) PH2_BODY }
    SEAM(2);
    if (IN(3)) { phase3_qknorm(F); PH3_BODY REP(3) PH3_BODY }
    SEAM(3);
    if (IN(4)) { PH4_BODY REP(4) PH4_BODY }
    SEAM(4);
    if (IN(5)) { PH5_BODY REP(5) PH5_BODY }
    SEAM(5);
    if (IN(6)) { PH6_BODY REP(6) PH6_BODY }
    SEAM(6);
    if (IN(7)) { phase_modnorm<false>(F, F.out, F.g2, 6144, 8192, (bf16_t*)(F.ws + WS_H2)); REP(7) { phase_modnorm<false>(F, F.out, F.g2, 6144, 8192, (bf16_t*)(F.ws + WS_H2)); } }
    SEAM(7);
    if (IN(8)) { PH8_BODY REP(8) PH8_BODY }
    SEAM(8);
    if (IN(9)) { PH9_BODY REP(9) PH9_BODY }
    SEAM(9);
    if (IN(10)) { phase10_peer(F); REP(10) phase10_peer<PROBE_P10M>(F); }
    SEAM(10);
    if (IN(11)) { REP(11) { phase11_peer_v(F, (float*)(F.ws + WS_SUB)); } phase11_peer_v(F, F.out); }
#undef IN
#undef SEAM
}

extern "C" void kernel_launch(void* const* d_in, const int* in_sizes, int n_in, void* d_out, int out_size, void* d_ws, size_t ws_size, hipStream_t stream) {
    static int grid = 0;
    if (grid == 0) {
        if (n_in != 19 || out_size != MTOK * DM || ws_size < WS_END) { fprintf(stderr, "kernel_launch: unexpected shapes (n_in %d out %d ws %zu)\n", n_in, out_size, ws_size); grid = -1; return; }
        int dev = 0, cus = 0, per_cu = 0;
        if (hipGetDevice(&dev) != hipSuccess || hipDeviceGetAttribute(&cus, hipDeviceAttributeMultiprocessorCount, dev) != hipSuccess) { grid = -1; return; }
        if (hipFuncSetAttribute((const void*)fwd_kernel, hipFuncAttributeMaxDynamicSharedMemorySize, LDS_BYTES) != hipSuccess) { fprintf(stderr, "kernel_launch: hipFuncSetAttribute failed\n"); grid = -1; return; }
        if (hipOccupancyMaxActiveBlocksPerMultiprocessor(&per_cu, (const void*)fwd_kernel, 512, LDS_BYTES) != hipSuccess || per_cu < 1) { fprintf(stderr, "kernel_launch: occupancy query says %d\n", per_cu); }
        (void)hipGetLastError();
        grid = cus;
    }
    if (grid < 0) return;
    (void)in_sizes;
    if (hipMemsetAsync((char*)d_ws + WS_CTL, 0, CTL_ZERO_BYTES, stream) != hipSuccess) return;
    Args a{};
    for (int i = 0; i < 19; ++i) a.in[i] = (const float*)d_in[i];
    a.out = (float*)d_out; a.ws = (unsigned char*)d_ws;
#if MK_PER_PHASE
    for (int p = 0; p < NPHASE; ++p) { a.ph_lo = p; a.ph_hi = p + 1; a.li = p; hipLaunchKernelGGL(fwd_kernel, dim3(grid), dim3(512), LDS_BYTES, stream, a); }
#else
    a.ph_lo = 0; a.ph_hi = NPHASE; a.li = 0;
    hipLaunchKernelGGL(fwd_kernel, dim3(grid), dim3(512), LDS_BYTES, stream, a);
#endif
}
```

```cpp
#include <hip/hip_runtime.h>
#include <cstdio>
#include <cstdint>

#ifndef MK_PER_PHASE
#define MK_PER_PHASE 0
#endif

#ifndef PROBE_REP
#define PROBE_REP 0
#endif
#ifndef PROBE_IDX
#define PROBE_IDX 0
#endif
#ifndef PROBE_P10M
#define PROBE_P10M 0
#endif
#ifndef PROBE_P11X
#define PROBE_P11X 0
#endif
#define LAS __attribute__((address_space(3)))
typedef unsigned short bf16_t;
typedef short bf16x8 __attribute__((ext_vector_type(8)));
typedef float f32x4 __attribute__((ext_vector_type(4)));
typedef float f32x2 __attribute__((ext_vector_type(2)));
typedef int v2i __attribute__((ext_vector_type(2)));
typedef unsigned u32x4 __attribute__((ext_vector_type(4)));
typedef unsigned u32x2 __attribute__((ext_vector_type(2)));
typedef unsigned u32x6 __attribute__((ext_vector_type(6)));
typedef unsigned u32x16 __attribute__((ext_vector_type(16)));
typedef __bf16 bf16x32 __attribute__((ext_vector_type(32)));

constexpr int BATCH = 8, SEQ = 4096, DM = 2048, MTOK = BATCH * SEQ;
constexpr int NHEAD = 8, HDIM = 128, AW = 1024, KVW = 256, IHEADS = 16, IDIM = 64, KSEL = 256;
constexpr int PW = 1024, PHEADS = 8, NEXP = 16384;
constexpr int INW = 7760;
constexpr float EPS = 1e-6f;
constexpr int NPHASE = 12;

constexpr size_t MiB = 1u << 20;
constexpr size_t WS_CTL = 0, CTL_ZERO_BYTES = 256 * 1024;
constexpr size_t WS_MODP = 2 * MiB;
constexpr size_t WS_MODF = 4 * MiB;
constexpr size_t WS_POOLW = 5 * MiB;
constexpr size_t WS_KEYSBD = 6 * MiB;
constexpr size_t WS_WIN16 = 8 * MiB;
constexpr size_t WS_WIN8 = 20 * MiB;
constexpr size_t WS_WAB = 40 * MiB, WS_WPB = 44 * MiB, WS_WOUT = 48 * MiB, WS_WPQ = 56 * MiB;
constexpr size_t WS_PU = 64 * MiB, WS_PV = 128 * MiB;
constexpr size_t WS_R0 = 192 * MiB;
constexpr size_t WS_GA = 320 * MiB, WS_GP = 448 * MiB;
constexpr size_t WS_SUB = 320 * MiB;
constexpr size_t WS_QN = 576 * MiB;
constexpr size_t WS_IQ = 640 * MiB;
constexpr size_t WS_PL = 704 * MiB;
constexpr size_t WS_KN = 768 * MiB, WS_V = 784 * MiB;
constexpr size_t WS_IK = 800 * MiB;
constexpr size_t WS_IW = 804 * MiB;
constexpr size_t WS_SEL = 806 * MiB;
constexpr size_t WS_POOLED = 822 * MiB;
constexpr size_t WS_H2 = 886 * MiB;
constexpr size_t WS_END = 1014 * MiB;
constexpr size_t WS_H1F8 = WS_H2 + 64 * MiB;
constexpr size_t WS_Q8 = WS_H2, WS_K8 = WS_H2 + 32 * MiB, WS_V8 = WS_H2 + 40 * MiB;
constexpr size_t WS_X1B = WS_IQ;
constexpr size_t WS_ATTN = WS_IQ, WS_POOL2 = WS_PL, WS_PAIRS = WS_QN, WS_WLS = WS_QN + 32 * MiB;

constexpr int LDS_BYTES = 160 * 1024;
constexpr int MISC_OFF = 159 * 1024;

__device__ __forceinline__ unsigned cvt_pk_bf16(float lo, float hi) { unsigned r; asm volatile("v_cvt_pk_bf16_f32 %0, %1, %2" : "=v"(r) : "v"(lo), "v"(hi)); return r; }
__device__ __forceinline__ float bf_lo(unsigned w) { return __uint_as_float(w << 16); }
__device__ __forceinline__ float bf_hi(unsigned w) { return __uint_as_float(w & 0xffff0000u); }
template <int CTRL> __device__ __forceinline__ float dpp_f(float x) { return __int_as_float(__builtin_amdgcn_update_dpp(0, __float_as_int(x), CTRL, 0xF, 0xF, true)); }
#define DPP_XOR1 0xB1
#define DPP_XOR2 0x4E
#define DPP_HMIRROR 0x141
#define DPP_MIRROR 0x140
#define DPP_ROR8 0x128
__device__ __forceinline__ float xor16_sum(float x) { const auto r = __builtin_amdgcn_permlane16_swap(__float_as_uint(x), __float_as_uint(x), false, false); return __uint_as_float(r[0]) + __uint_as_float(r[1]); }
__device__ __forceinline__ float xor32_sum(float x) { const auto r = __builtin_amdgcn_permlane32_swap(__float_as_uint(x), __float_as_uint(x), false, false); return __uint_as_float(r[0]) + __uint_as_float(r[1]); }
__device__ __forceinline__ float xor16_max(float x) { const auto r = __builtin_amdgcn_permlane16_swap(__float_as_uint(x), __float_as_uint(x), false, false); return fmaxf(__uint_as_float(r[0]), __uint_as_float(r[1])); }
__device__ __forceinline__ float swap32_pair(float a, float b) { const auto r = __builtin_amdgcn_permlane32_swap(__float_as_uint(a), __float_as_uint(b), false, false); return __uint_as_float(r[0]) + __uint_as_float(r[1]); }
__device__ __forceinline__ float swap16_pair(float a, float b) { const auto r = __builtin_amdgcn_permlane16_swap(__float_as_uint(a), __float_as_uint(b), false, false); return __uint_as_float(r[0]) + __uint_as_float(r[1]); }
__device__ __forceinline__ float row_sum16(float v) { v += dpp_f<DPP_XOR1>(v); v += dpp_f<DPP_XOR2>(v); v += dpp_f<DPP_HMIRROR>(v); v += dpp_f<DPP_MIRROR>(v); return v; }
__device__ __forceinline__ float row_max16(float v) { v = fmaxf(v, dpp_f<DPP_XOR1>(v)); v = fmaxf(v, dpp_f<DPP_XOR2>(v)); v = fmaxf(v, dpp_f<DPP_HMIRROR>(v)); v = fmaxf(v, dpp_f<DPP_MIRROR>(v)); return v; }
__device__ __forceinline__ float wave_sum(float v) { return xor32_sum(xor16_sum(row_sum16(v))); }
__device__ __forceinline__ float sigmoidf_(float x) { return __builtin_amdgcn_rcpf(1.0f + __expf(-x)); }
__device__ __forceinline__ float dot8(u32x4 w, const float* h) {
    return bf_lo(w.x) * h[0] + bf_hi(w.x) * h[1] + bf_lo(w.y) * h[2] + bf_hi(w.y) * h[3] + bf_lo(w.z) * h[4] + bf_hi(w.z) * h[5] + bf_lo(w.w) * h[6] + bf_hi(w.w) * h[7];
}

__device__ __forceinline__ int lane_now() { int l; asm volatile("v_mbcnt_lo_u32_b32 %0, -1, 0\n\tv_mbcnt_hi_u32_b32 %0, -1, %0" : "=v"(l)); return l; }

#define XB_TMO      128
#define XB_XCNT(j)  (256  + 64 * (j))
#define XB_XSUB(j)  (1280 + 64 * (j))
#define XB_XGEN(j)  (2304 + 64 * (j))
#define XB_TOP      3328
#define XB_TOPGEN   3392
#define XCD_BAR_WORDS 3456
#define XB_SPIN_CAP (1u << 18)

__device__ __forceinline__ unsigned xb_ld(unsigned* p)              { return __hip_atomic_load(p, __ATOMIC_RELAXED, __HIP_MEMORY_SCOPE_AGENT); }
__device__ __forceinline__ unsigned xb_add(unsigned* p, unsigned v) { return __hip_atomic_fetch_add(p, v, __ATOMIC_RELAXED, __HIP_MEMORY_SCOPE_AGENT); }
__device__ __forceinline__ unsigned xb_xcc_id() { return (unsigned)__builtin_amdgcn_s_getreg((3 << 11) | 20) & 0xFu; }
#define XB_SPIN(cond, bar) do { unsigned _sp = 0; while (cond) { __builtin_amdgcn_s_sleep(1); \
    if ((++_sp & 255u) == 0u) { if (xb_ld(&(bar)[XB_TMO])) break; if (_sp > XB_SPIN_CAP) { atomicAdd(&(bar)[XB_TMO], 1u); break; } } } } while (0)

struct XcdBarrier { unsigned* bar; unsigned x; volatile LAS unsigned* st; };

__device__ __forceinline__ XcdBarrier xcd_barrier_post(unsigned* bar, volatile LAS unsigned* st) {
    XcdBarrier b; b.bar = bar; b.x = xb_xcc_id(); b.st = st;
    if (threadIdx.x == 0) (void)xb_add(&bar[XB_XCNT(b.x)], 1u);
    return b;
}
__device__ __forceinline__ void xcd_barrier_complete(unsigned* bar, unsigned x, unsigned& nloc, unsigned& nx) {
    const unsigned G = gridDim.x * gridDim.y * gridDim.z;
    unsigned sum, cnt, mine, sp = 0u;
    for (;;) {
        sum = 0u; cnt = 0u; mine = 0u;
#pragma unroll
        for (unsigned j = 0; j < 16; ++j) { const unsigned c = xb_ld(&bar[XB_XCNT(j)]); sum += c; cnt += (c > 0u) ? 1u : 0u; mine = (j == x) ? c : mine; }
        if (sum == G) break;
        __builtin_amdgcn_s_sleep(1);
        if ((++sp & 255u) == 0u) { if (xb_ld(&bar[XB_TMO])) break; if (sp > XB_SPIN_CAP) { atomicAdd(&bar[XB_TMO], 1u); break; } }
    }
    nloc = mine > 0u ? mine : 1u; nx = cnt > 0u ? cnt : 1u;
}
__device__ __forceinline__ void xcd_barrier(const XcdBarrier& b, int wave) {
    asm volatile("s_waitcnt vmcnt(0)" ::: "memory");
    __syncthreads();
    if (wave == 0 && lane_now() == 0) {
        unsigned* bar = b.bar;
        __builtin_amdgcn_s_waitcnt(0);
        unsigned nloc = b.st[0], nx = b.st[1];
        if (nloc == 0u) { xcd_barrier_complete(bar, b.x, nloc, nx); b.st[0] = nloc; b.st[1] = nx; }
        const unsigned old = xb_add(&bar[XB_XSUB(b.x)], 1u);
        const unsigned gen = old / nloc;
        if (old + 1u == (gen + 1u) * nloc) {
            __builtin_amdgcn_fence(__ATOMIC_RELEASE, "agent");
            asm volatile("s_waitcnt vmcnt(0)" ::: "memory");
            const unsigned og = xb_add(&bar[XB_TOP], 1u);
            const unsigned tg = og / nx;
            if (og + 1u == (tg + 1u) * nx) xb_add(&bar[XB_TOPGEN], 1u);
            else XB_SPIN(xb_ld(&bar[XB_TOPGEN]) == tg, bar);
            __builtin_amdgcn_fence(__ATOMIC_ACQUIRE, "agent");
            xb_add(&bar[XB_XGEN(b.x)], 1u);
            asm volatile("s_waitcnt vmcnt(0)" ::: "memory");
        } else {
            XB_SPIN(xb_ld(&bar[XB_XGEN(b.x)]) == gen, bar);
            __builtin_amdgcn_fence(__ATOMIC_ACQUIRE, "agent");
            asm volatile("s_waitcnt vmcnt(0)" ::: "memory");
        }
    }
    __syncthreads();
}

namespace pg8 {
constexpr int BM = 256, BK = 64, HALF = 128, HTB = HALF * BK * 2, STAGE_BYTES = 8 * HTB, NXCD = 8, WGM = 8;
__device__ __forceinline__ int lds_byte(int r, int c) { const int st = (r >> 4) * 2 + (c >> 5), rr = r & 15, cc = c & 31, ob = rr * 64 + cc * 2; return st * 1024 + (ob ^ (((ob >> 9) & 1) << 5)); }
__device__ __forceinline__ void stage_rc(int b, int& R, int& C) { const int st = b / 1024, sb = b % 1024, swz = sb ^ (((sb >> 9) & 1) << 5); R = (st >> 1) * 16 + swz / 64; C = (st & 1) * 32 + (swz % 64) / 2; }
__device__ __forceinline__ int perm32(int rho) { const int n = rho >> 4, i = rho & 15; return 8 * (i >> 2) + 4 * n + (i & 3); }

struct Unit { int pm, pn; };
struct Gemm { const bf16_t* A; const bf16_t* Bt; int M, N, K, lda, a_pn_off; const bf16_t* A2; const bf16_t* Bt2; int ksplit, ldb; };

struct StaticOrder {
    int nM, nN, nwg, G, c;
    __device__ void init(int M, int N, int G_, int c_) { nM = M / BM; nN = N / BM; nwg = nM * nN; G = G_; c = c_; }
    __device__ bool next(int i, Unit& u) const {
        const long L = (long)i * G + c; if (L >= nwg) return false;
        int wgid = (int)L; { const int q = nwg / NXCD, r = nwg % NXCD, xcd = wgid % NXCD, off = wgid / NXCD; wgid = (xcd < r ? xcd * (q + 1) : r * (q + 1) + (xcd - r) * q) + off; }
        const int nig = WGM * nN, gid = wgid / nig, fm = gid * WGM, gsz = (nM - fm) < WGM ? (nM - fm) : WGM;
        u.pm = fm + ((wgid % nig) % gsz); u.pn = (wgid % nig) / gsz; return true;
    }
};

typedef int i32x4 __attribute__((ext_vector_type(4)));
typedef int i32x8 __attribute__((ext_vector_type(8)));
__device__ __forceinline__ bf16x8 lo8(i32x8 v) { return __builtin_bit_cast(bf16x8, (i32x4){v.s0, v.s1, v.s2, v.s3}); }
__device__ __forceinline__ bf16x8 hi8(i32x8 v) { return __builtin_bit_cast(bf16x8, (i32x4){v.s4, v.s5, v.s6, v.s7}); }
__device__ __forceinline__ i32x8 cat8(bf16x8 a, bf16x8 b) { const i32x4 x = __builtin_bit_cast(i32x4, a), y = __builtin_bit_cast(i32x4, b); return (i32x8){x.x, x.y, x.z, x.w, y.x, y.y, y.z, y.w}; }
template <class Epi, bool F8 = false>
__device__ __forceinline__ void gemm_phase(LAS unsigned char* lds, const Gemm g, const StaticOrder& S, const Epi& E, int wave) {
    const int lane = lane_now(), wid = wave, tid = wid * 64 + lane, wr = wid >> 2, wc = wid & 3, fr = lane & 15, fq = lane >> 4;
    const int K = g.K, nt = K / BK, lda = g.lda, ldb = g.ldb ? g.ldb : g.K, ksplit = g.ksplit;
    unsigned voffA, voffB;
    { int R, C; stage_rc(tid * 16, R, C); const int Rb = Epi::PERM ? ((R & ~31) + perm32(R & 31)) : R;
      voffA = (unsigned)(R * lda + C) * 2u; voffB = (unsigned)(Rb * ldb + C) * 2u; }
    const unsigned stepA = 64u * (unsigned)lda * 2u, stepB = 64u * (unsigned)ldb * 2u;
    const size_t kstep = (size_t)(BK * 2);
    const size_t hsA = (size_t)HALF * lda * 2, hsB = (size_t)HALF * ldb * 2;
    const size_t tsA = 2 * hsA, tsB = 2 * hsB;
    const unsigned ldsw = (unsigned)wid * 1024u, ldsbase = (unsigned)(unsigned long long)lds;
    const int aoff = lds_byte(wr * 64 + fr, fq * 8), boff = lds_byte(wc * 32 + fr, fq * 8);
#define PG8_SA(b, h) (((b) * 2 + (h)) * HTB)
#define PG8_SB(b, h) ((4 + (b) * 2 + (h)) * HTB)
#define PG8_STAGE(bufoff, gbase, voff) do { _Pragma("unroll") for (int _i = 0; _i < 2; ++_i) { \
        const char* sb_ = (const char*)(gbase) + (size_t)_i * PG8_STEP_##voff; const unsigned m0_ = ldsbase + (unsigned)(bufoff) + ldsw + (unsigned)_i * 8192u; \
        asm volatile("s_mov_b32 m0, %2\n\ts_nop 0\n\tglobal_load_lds_dwordx4 %0, %1" :: "v"(voff), "s"(sb_), "s"(m0_) : "memory"); } } while (0)
#define PG8_STEP_voffA stepA
#define PG8_STEP_voffB stepB
#define PG8_LDA(dst, b, h) do { _Pragma("unroll") for (int m = 0; m < 4; ++m) dst[m] = cat8(*(const LAS bf16x8*)(lds + PG8_SA(b, h) + aoff + m * 2048), *(const LAS bf16x8*)(lds + PG8_SA(b, h) + aoff + m * 2048 + 1024)); } while (0)
#define PG8_LDB(dst, b, h) do { _Pragma("unroll") for (int n = 0; n < 2; ++n) dst[n] = cat8(*(const LAS bf16x8*)(lds + PG8_SB(b, h) + boff + n * 2048), *(const LAS bf16x8*)(lds + PG8_SB(b, h) + boff + n * 2048 + 1024)); } while (0)
#define PG8_MMA(ai, bj, At, Bt) do { __builtin_amdgcn_s_setprio(1); _Pragma("unroll") for (int m = 0; m < 4; ++m) _Pragma("unroll") for (int n = 0; n < 2; ++n) { \
        if constexpr (F8) acc[ai][bj][m][n] = __builtin_amdgcn_mfma_scale_f32_16x16x128_f8f6f4(Bt[n], At[m], acc[ai][bj][m][n], 0, 0, 0, 0x7D7D7D7D  , 0, 0x7D7D7D7D); \
        else { acc[ai][bj][m][n] = __builtin_amdgcn_mfma_f32_16x16x32_bf16(lo8(Bt[n]), lo8(At[m]), acc[ai][bj][m][n], 0, 0, 0); \
               acc[ai][bj][m][n] = __builtin_amdgcn_mfma_f32_16x16x32_bf16(hi8(Bt[n]), hi8(At[m]), acc[ai][bj][m][n], 0, 0, 0); } } \
        __builtin_amdgcn_s_setprio(0); } while (0)
#define PG8_WAIT_V(n) asm volatile("s_waitcnt vmcnt(" #n ")" ::: "memory")
#define PG8_WAIT_L(n) asm volatile("s_waitcnt lgkmcnt(" #n ")" ::: "memory")
#define PG8_BAR __builtin_amdgcn_s_barrier()
#define PG8_SCHED __builtin_amdgcn_sched_barrier(0)
    Unit cur, nxt; int ui = 0;
    if (!S.next(0, cur)) return;
    f32x4 acc[2][2][4][2];
#pragma unroll
    for (int a = 0; a < 2; ++a)
#pragma unroll
        for (int b = 0; b < 2; ++b)
#pragma unroll
            for (int m = 0; m < 4; ++m)
#pragma unroll
                for (int n = 0; n < 2; ++n) acc[a][b][m][n] = (f32x4){0.f, 0.f, 0.f, 0.f};
    i32x8 At[4], B0[2], B1[2];
    const char* cA = (const char*)g.A + (size_t)cur.pm * tsA + (size_t)cur.pn * g.a_pn_off * 2; const char* cB = (const char*)g.Bt + (size_t)cur.pn * tsB;
    PG8_STAGE(PG8_SB(0, 0), cB, voffB); PG8_STAGE(PG8_SB(0, 1), cB + hsB, voffB); PG8_STAGE(PG8_SA(0, 0), cA, voffA); PG8_STAGE(PG8_SA(0, 1), cA + hsA, voffA);
    if (wr == 1) PG8_BAR;
    PG8_WAIT_V(2); PG8_BAR;
    PG8_STAGE(PG8_SB(1, 0), cB + kstep, voffB); PG8_STAGE(PG8_SA(1, 0), cA + kstep, voffA); PG8_STAGE(PG8_SB(1, 1), cB + hsB + kstep, voffB);
    PG8_WAIT_V(6); PG8_BAR;
    for (;;) {
        const bool has_next = S.next(ui + 1, nxt);
        const char* nA = has_next ? (const char*)g.A + (size_t)nxt.pm * tsA + (size_t)nxt.pn * g.a_pn_off * 2 : cA; const char* nB = has_next ? (const char*)g.Bt + (size_t)nxt.pn * tsB : cB;
        const char* cA2 = (const char*)g.A2 + (size_t)cur.pm * tsA; const char* cB2 = (const char*)g.Bt2 + (size_t)cur.pn * tsB;
#pragma clang loop unroll(disable)
        for (int t = 0; t < nt; t += 2) {
            const bool last = (t == nt - 2);
            const bool s1 = ksplit && (t >= ksplit), s2 = ksplit && (t + 2 >= ksplit);
            const char* a1 = (s1 ? cA2 + (size_t)(t - ksplit + 1) * kstep : cA + (size_t)(t + 1) * kstep);
            const char* a2 = last ? nA : (s2 ? cA2 + (size_t)(t + 2 - ksplit) * kstep : cA + (size_t)(t + 2) * kstep);
            const char* b2 = last ? nB : (s2 ? cB2 + (size_t)(t + 2 - ksplit) * kstep : cB + (size_t)(t + 2) * kstep);
            const char* a3 = a2 + kstep; const char* b3 = b2 + kstep;
            PG8_LDB(B0, 0, 0); PG8_LDB(B1, 0, 1); PG8_SCHED; PG8_LDA(At, 0, 0); PG8_STAGE(PG8_SA(1, 1), a1 + hsA, voffA);
            PG8_WAIT_V(8); PG8_WAIT_L(0); PG8_BAR; PG8_MMA(0, 0, At, B0); PG8_MMA(0, 1, At, B1); PG8_BAR; PG8_SCHED;
            PG8_LDA(At, 0, 1); PG8_STAGE(PG8_SB(0, 0), b2, voffB); PG8_STAGE(PG8_SB(0, 1), b2 + hsB, voffB); PG8_STAGE(PG8_SA(0, 0), a2, voffA);
            PG8_WAIT_V(8); PG8_WAIT_L(0); PG8_BAR; PG8_MMA(1, 0, At, B0); PG8_MMA(1, 1, At, B1); PG8_BAR; PG8_SCHED;
            PG8_LDB(B0, 1, 0); PG8_LDB(B1, 1, 1); PG8_SCHED; PG8_LDA(At, 1, 0); PG8_STAGE(PG8_SA(0, 1), a2 + hsA, voffA);
            PG8_WAIT_V(8); PG8_WAIT_L(0); PG8_BAR; PG8_MMA(0, 0, At, B0); PG8_MMA(0, 1, At, B1); PG8_BAR; PG8_SCHED;
            PG8_LDA(At, 1, 1); PG8_STAGE(PG8_SB(1, 0), b3, voffB); PG8_STAGE(PG8_SB(1, 1), b3 + hsB, voffB); PG8_STAGE(PG8_SA(1, 0), a3, voffA);
            PG8_WAIT_V(8); PG8_WAIT_L(0); PG8_BAR; PG8_MMA(1, 0, At, B0); PG8_MMA(1, 1, At, B1); PG8_BAR; PG8_SCHED;
            if constexpr (Epi::MID) { if (t + 2 == ksplit) E.mid(acc, cur, wr, wc, fr, fq); }
        }
        if (wr == 0) PG8_BAR;
        { const int l2 = lane_now(); E(acc, cur, wr, wc, l2 & 15, l2 >> 4); }
        if (!has_next) break;
#pragma unroll
        for (int a = 0; a < 2; ++a)
#pragma unroll
            for (int b = 0; b < 2; ++b)
#pragma unroll
                for (int m = 0; m < 4; ++m)
#pragma unroll
                    for (int n = 0; n < 2; ++n) acc[a][b][m][n] = (f32x4){0.f, 0.f, 0.f, 0.f};
        cur = nxt; cA = nA; cB = nB; ++ui;
        if (wr == 1) PG8_BAR;
    }
    PG8_WAIT_V(0);
    PG8_BAR;
#undef PG8_SA
#undef PG8_SB
#undef PG8_STAGE
#undef PG8_STEP_voffA
#undef PG8_STEP_voffB
#undef PG8_LDA
#undef PG8_LDB
#undef PG8_MMA
#undef PG8_WAIT_V
#undef PG8_WAIT_L
#undef PG8_BAR
#undef PG8_SCHED
}
}
using pg8::Unit;

typedef f32x4 AccT[2][2][4][2];
__device__ __forceinline__ u32x4 pack8(f32x4 a, f32x4 b) { u32x4 w; w.x = cvt_pk_bf16(a[0], a[1]); w.y = cvt_pk_bf16(a[2], a[3]); w.z = cvt_pk_bf16(b[0], b[1]); w.w = cvt_pk_bf16(b[2], b[3]); return w; }
__device__ __forceinline__ u32x2 pack8_fp8(f32x4 a, f32x4 b) {
    int w0 = __builtin_amdgcn_cvt_pk_fp8_f32(a[0], a[1], 0, false); w0 = __builtin_amdgcn_cvt_pk_fp8_f32(a[2], a[3], w0, true);
    int w1 = __builtin_amdgcn_cvt_pk_fp8_f32(b[0], b[1], 0, false); w1 = __builtin_amdgcn_cvt_pk_fp8_f32(b[2], b[3], w1, true);
    return (u32x2){(unsigned)w0, (unsigned)w1};
}
__device__ __forceinline__ void unpack8(u32x4 w, f32x4& a, f32x4& b) { a = (f32x4){bf_lo(w.x), bf_hi(w.x), bf_lo(w.y), bf_hi(w.y)}; b = (f32x4){bf_lo(w.z), bf_hi(w.z), bf_lo(w.w), bf_hi(w.w)}; }

template <bool SET8> struct EpiInproj {
    static constexpr bool PERM = true, MID = false;
    bf16_t *q, *k, *v, *iq, *ik, *pl, *ga, *gp; float* iw;
    __device__ __forceinline__ void operator()(const AccT& acc, const Unit& u, int wr, int wc, int fr, int fq) const {
        const int pn = u.pn, row0 = u.pm * 256 + wr * 64 + fr;
        if (!SET8 && pn == 4) {
            if (wc < 2) {
#pragma unroll
                for (int ai = 0; ai < 2; ++ai)
#pragma unroll
                    for (int m = 0; m < 4; ++m) { const size_t row = (size_t)(row0 + ai * 128 + m * 16);
                        *(u32x4*)(ik + row * 64 + wc * 32 + 8 * fq) = pack8(acc[ai][0][m][0], acc[ai][0][m][1]); }
            } else if (wc == 2) {
                if (fq < 2) {
#pragma unroll
                    for (int ai = 0; ai < 2; ++ai)
#pragma unroll
                        for (int m = 0; m < 4; ++m) { const size_t row = (size_t)(row0 + ai * 128 + m * 16);
                            *(f32x4*)(iw + row * 16 + 8 * fq) = acc[ai][0][m][0]; *(f32x4*)(iw + row * 16 + 8 * fq + 4) = acc[ai][0][m][1]; }
                }
            }
            return;
        }
        bf16_t* dst; int ld, tc; bool sg = false;
        if (SET8) {
            if (pn < 4) { dst = q; ld = 1024; tc = pn * 256; }
            else if (pn == 4) { dst = k; ld = 256; tc = 0; }
            else if (pn == 5) { dst = v; ld = 256; tc = 0; }
            else if (pn < 14) { dst = ga; ld = 2048; tc = (pn - 6) * 256; sg = true; }
            else { dst = gp; ld = 2048; tc = (pn - 14) * 256; sg = true; }
        } else {
            if (pn < 4) { dst = iq; ld = 1024; tc = pn * 256; }
            else { dst = pl; ld = 1024; tc = (pn - 5) * 256; }
        }
        const int col0 = tc + wc * 32 + 8 * fq;
#pragma unroll
        for (int ai = 0; ai < 2; ++ai)
#pragma unroll
            for (int m = 0; m < 4; ++m) { bf16_t* rowp = dst + (size_t)(row0 + ai * 128 + m * 16) * ld + col0;
#pragma unroll
                for (int bj = 0; bj < 2; ++bj) { f32x4 v0 = acc[ai][bj][m][0], v1 = acc[ai][bj][m][1];
                    if (sg) {
#pragma unroll
                        for (int j = 0; j < 4; ++j) { v0[j] = sigmoidf_(v0[j]); v1[j] = sigmoidf_(v1[j]); } }
                    *(u32x4*)(rowp + bj * 128) = pack8(v0, v1); } }
    }
};
struct EpiBf16Scale {
    static constexpr bool PERM = true, MID = false;
    bf16_t* O; int ldc; const float* cs;
    __device__ __forceinline__ void operator()(const AccT& acc, const Unit& u, int wr, int wc, int fr, int fq) const {
        const int row0 = u.pm * 256 + wr * 64 + fr, col0 = u.pn * 256 + wc * 32 + 8 * fq;
        f32x4 s[2][2];
#pragma unroll
        for (int bj = 0; bj < 2; ++bj)
#pragma unroll
            for (int n = 0; n < 2; ++n) s[bj][n] = cs ? *(const f32x4*)(cs + col0 + bj * 128 + 4 * n) : (f32x4){1.f, 1.f, 1.f, 1.f};
#pragma unroll
        for (int ai = 0; ai < 2; ++ai)
#pragma unroll
            for (int m = 0; m < 4; ++m) { bf16_t* rowp = O + (size_t)(row0 + ai * 128 + m * 16) * ldc + col0;
#pragma unroll
                for (int bj = 0; bj < 2; ++bj) *(u32x4*)(rowp + bj * 128) = pack8(acc[ai][bj][m][0] * s[bj][0], acc[ai][bj][m][1] * s[bj][1]); }
    }
};
struct EpiF8Scale {
    static constexpr bool PERM = true, MID = false;
    unsigned char* O; int ldc; const float* cs;
    __device__ __forceinline__ void operator()(const AccT& acc, const Unit& u, int wr, int wc, int fr, int fq) const {
        const int row0 = u.pm * 256 + wr * 64 + fr, col0 = u.pn * 256 + wc * 32 + 8 * fq;
        f32x4 s[2][2];
#pragma unroll
        for (int bj = 0; bj < 2; ++bj)
#pragma unroll
            for (int n = 0; n < 2; ++n) s[bj][n] = *(const f32x4*)(cs + col0 + bj * 128 + 4 * n);
#pragma unroll
        for (int ai = 0; ai < 2; ++ai)
#pragma unroll
            for (int m = 0; m < 4; ++m) { unsigned char* rowp = O + (size_t)(row0 + ai * 128 + m * 16) * ldc + col0;
#pragma unroll
                for (int bj = 0; bj < 2; ++bj) *(u32x2*)(rowp + bj * 128) = pack8_fp8(acc[ai][bj][m][0] * s[bj][0], acc[ai][bj][m][1] * s[bj][1]); }
    }
};
template <bool ADD> struct EpiGate {
    static constexpr bool PERM = true, MID = false;
    bf16_t* O; const bf16_t* gate;
    __device__ __forceinline__ void operator()(const AccT& acc, const Unit& u, int wr, int wc, int fr, int fq) const {
        const int row0 = u.pm * 256 + wr * 64 + fr, col0 = u.pn * 256 + wc * 32 + 8 * fq;
#pragma unroll
        for (int ai = 0; ai < 2; ++ai)
#pragma unroll
            for (int m = 0; m < 4; ++m) { const size_t off = (size_t)(row0 + ai * 128 + m * 16) * 2048 + col0;
#pragma unroll
                for (int bj = 0; bj < 2; ++bj) { f32x4 g0, g1; unpack8(*(const u32x4*)(gate + off + bj * 128), g0, g1);
                    f32x4 r0 = g0 * acc[ai][bj][m][0], r1 = g1 * acc[ai][bj][m][1];
                    if (ADD) { f32x4 o0, o1; unpack8(*(const u32x4*)(O + off + bj * 128), o0, o1); r0 += o0; r1 += o1; }
                    *(u32x4*)(O + off + bj * 128) = pack8(r0, r1); } }
    }
};
struct EpiMerge {
    static constexpr bool PERM = true, MID = true;
    unsigned char* O; const bf16_t* ga; const bf16_t* gp;
    __device__ __forceinline__ void mid(AccT& acc, const Unit& u, int wr, int wc, int fr, int fq) const {
        const auto ra = __builtin_amdgcn_make_buffer_rsrc((void*)ga, 0, 0x7FFFFFFF, 0x00020000), rp = __builtin_amdgcn_make_buffer_rsrc((void*)gp, 0, 0x7FFFFFFF, 0x00020000);
        const int voff = ((wr * 64 + fr) * 2048 + wc * 32 + 8 * fq) * 2;
        const int sbase = (u.pm * 256 * 2048 + u.pn * 256) * 2;
#pragma unroll
        for (int ai = 0; ai < 2; ++ai)
#pragma unroll
            for (int m = 0; m < 4; ++m)
#pragma unroll
                for (int bj = 0; bj < 2; ++bj) { const int so = sbase + ((ai * 128 + m * 16) * 2048 + bj * 128) * 2;
                    const u32x4 wa = __builtin_bit_cast(u32x4, __builtin_amdgcn_raw_buffer_load_b128(ra, voff, so, 0)), wp = __builtin_bit_cast(u32x4, __builtin_amdgcn_raw_buffer_load_b128(rp, voff, so, 0));
                    f32x4 a0, a1, p0, p1; unpack8(wa, a0, a1); unpack8(wp, p0, p1);
#pragma unroll
                    for (int j = 0; j < 4; ++j) { acc[ai][bj][m][0][j] *= a0[j] * __builtin_amdgcn_rcpf(p0[j]); acc[ai][bj][m][1][j] *= a1[j] * __builtin_amdgcn_rcpf(p1[j]); }
                    asm volatile("" : "+v"(acc[ai][bj][m][0]), "+v"(acc[ai][bj][m][1]) :: "memory"); }
    }
    __device__ __forceinline__ void operator()(const AccT& acc, const Unit& u, int wr, int wc, int fr, int fq) const {
        const int row0 = u.pm * 256 + wr * 64 + fr, col0 = u.pn * 256 + wc * 32 + 8 * fq;
#pragma unroll
        for (int ai = 0; ai < 2; ++ai)
#pragma unroll
            for (int m = 0; m < 4; ++m) { const size_t off = (size_t)(row0 + ai * 128 + m * 16) * 2048 + col0;
#pragma unroll
                for (int bj = 0; bj < 2; ++bj) { f32x4 p0, p1; unpack8(*(const u32x4*)(gp + off + bj * 128), p0, p1);
                    *(u32x2*)(O + off + bj * 128) = pack8_fp8(p0 * acc[ai][bj][m][0], p1 * acc[ai][bj][m][1]); } }
    }
};
struct EpiResid {
    static constexpr bool PERM = false, MID = false;
    const float* x; float* out; const float* gt;
    __device__ __forceinline__ void operator()(const AccT& acc, const Unit& u, int wr, int wc, int fr, int fq) const {
        const int row0 = u.pm * 256 + wr * 64 + fr, col0 = u.pn * 256 + wc * 32 + 4 * fq;
        const float* gtb = gt + (size_t)(u.pm / 16) * 12288;
        f32x4 g[2][2];
#pragma unroll
        for (int bj = 0; bj < 2; ++bj)
#pragma unroll
            for (int n = 0; n < 2; ++n) g[bj][n] = *(const f32x4*)(gtb + col0 + bj * 128 + n * 16);
#pragma unroll
        for (int ai = 0; ai < 2; ++ai)
#pragma unroll
            for (int m = 0; m < 4; ++m) { const size_t off = (size_t)(row0 + ai * 128 + m * 16) * 2048 + col0;
#pragma unroll
                for (int bj = 0; bj < 2; ++bj)
#pragma unroll
                    for (int n = 0; n < 2; ++n) { const f32x4 xv = *(const f32x4*)(x + off + bj * 128 + n * 16);
                        *(f32x4*)(out + off + bj * 128 + n * 16) = xv + g[bj][n] * acc[ai][bj][m][n]; } }
    }
};
struct EpiResidB {
    static constexpr bool PERM = true, MID = false;
    const float* x; bf16_t* out; const float* gt;
    __device__ __forceinline__ void operator()(const AccT& acc, const Unit& u, int wr, int wc, int fr, int fq) const {
        const int row0 = u.pm * 256 + wr * 64 + fr, col0 = u.pn * 256 + wc * 32 + 8 * fq;
        const float* gtb = gt + (size_t)(u.pm / 16) * 12288;
        f32x4 g[2][2];
#pragma unroll
        for (int bj = 0; bj < 2; ++bj)
#pragma unroll
            for (int n = 0; n < 2; ++n) g[bj][n] = *(const f32x4*)(gtb + col0 + bj * 128 + 4 * n);
#pragma unroll
        for (int ai = 0; ai < 2; ++ai)
#pragma unroll
            for (int m = 0; m < 4; ++m) { const size_t off = (size_t)(row0 + ai * 128 + m * 16) * 2048 + col0;
#pragma unroll
                for (int bj = 0; bj < 2; ++bj) { const f32x4 x0 = *(const f32x4*)(x + off + bj * 128), x1 = *(const f32x4*)(x + off + bj * 128 + 4);
                    *(u32x4*)(out + off + bj * 128) = pack8(x0 + g[bj][0] * acc[ai][bj][m][0], x1 + g[bj][1] * acc[ai][bj][m][1]); } }
    }
};
struct EpiF32 {
    static constexpr bool PERM = false, MID = false;
    float* C; int ldc;
    __device__ __forceinline__ void operator()(const AccT& acc, const Unit& u, int wr, int wc, int fr, int fq) const {
        const int row0 = u.pm * 256 + wr * 64 + fr, col0 = u.pn * 256 + wc * 32 + 4 * fq;
#pragma unroll
        for (int ai = 0; ai < 2; ++ai)
#pragma unroll
            for (int m = 0; m < 4; ++m) { float* rowp = C + (size_t)(row0 + ai * 128 + m * 16) * ldc + col0;
#pragma unroll
                for (int bj = 0; bj < 2; ++bj)
#pragma unroll
                    for (int n = 0; n < 2; ++n) *(f32x4*)(rowp + bj * 128 + n * 16) = acc[ai][bj][m][n]; }
    }
};

struct Args { const float* in[19]; float* out; unsigned char* ws; int ph_lo, ph_hi; int li, pad; };
struct Frame {
    unsigned char* lds; unsigned char* ws;
    int tid, lane, wave, G, bid;
    const float *x, *c, *w_ada, *b_ada, *g1, *g2, *w_in, *g_q, *g_k, *rel_bias, *pool_w, *pool_scale, *w_ab, *w_pb, *w_out, *w_pq, *peer_keys, *peer_u, *peer_v;
    float* out;
};

template <bool F8OUT = false, class Fn> __device__ __forceinline__ void transpose_item(const float* W, int K, int N, void* WTv, int ldk, int drow0, int k0, float* scr, int lane, Fn srccol, float mul = 1.0f) {
    const int sc = srccol(drow0 + (lane & 31));
#pragma unroll 8
    for (int i = 0; i < 32; ++i) { const int kk = 2 * i + (lane >> 5); scr[kk * 33 + (lane & 31)] = sc >= 0 ? W[(size_t)(k0 + kk) * N + sc] * mul : 0.f; }
    asm volatile("s_waitcnt lgkmcnt(0)" ::: "memory");
    const int c = lane & 7;
#pragma unroll
    for (int j = 0; j < 4; ++j) { const int n = (lane >> 3) + 8 * j; const float* s = scr + (8 * c) * 33 + n;
        if constexpr (F8OUT) { *(u32x2*)((unsigned char*)WTv + (size_t)(drow0 + n) * ldk + k0 + 8 * c) = pack8_fp8((f32x4){s[0 * 33], s[1 * 33], s[2 * 33], s[3 * 33]}, (f32x4){s[4 * 33], s[5 * 33], s[6 * 33], s[7 * 33]}); }
        else { u32x4 o; o.x = cvt_pk_bf16(s[0 * 33], s[1 * 33]); o.y = cvt_pk_bf16(s[2 * 33], s[3 * 33]); o.z = cvt_pk_bf16(s[4 * 33], s[5 * 33]); o.w = cvt_pk_bf16(s[6 * 33], s[7 * 33]);
            *(u32x4*)((bf16_t*)WTv + (size_t)(drow0 + n) * ldk + k0 + 8 * c) = o; } }
    asm volatile("s_waitcnt lgkmcnt(0)" ::: "memory");
}
__device__ __forceinline__ void phase0_prep(Frame& F) {
    F.lane = lane_now(); F.tid = F.wave * 64 + F.lane;
    const int gw = F.bid * 8 + F.wave, NGW = F.G * 8;
    float* scr = (float*)(F.lds + F.wave * 16384);
    constexpr int I_IN16 = (2304 / 32) * (DM / 64), I_IN8 = (5632 / 32) * (DM / 64);
    constexpr int I_AB = (2048 / 32) * (1024 / 64), I_OUT = (2048 / 32) * (2048 / 64), I_PW = 4 * 8 * 4;
    constexpr int NIT = I_IN16 + I_IN8 + 2 * I_AB + 2 * I_OUT + I_PW;
    auto ident = [](int j) { return j; };
    for (int it = gw; it < NIT; it += NGW) {
        int r = it;
        if (r < I_IN16) { const int nb = r % 72, kb = r / 72;
            transpose_item(F.w_in, DM, INW, F.ws + WS_WIN16, DM, nb * 32, kb * 64, scr, F.lane, [](int j) { return j < 1104 ? j + 1536 : (j < 1280 ? -1 : j + 1360); }); continue; }
        r -= I_IN16;
        if (r < I_IN8) { const int nb = r % 176, kb = r / 176;
            transpose_item<true>(F.w_in, DM, INW, F.ws + WS_WIN8, DM, nb * 32, kb * 64, scr, F.lane, [](int j) { return j < 1536 ? j : j + 2128; }, 16.0f); continue; }
        r -= I_IN8;
        if (r < I_AB) { transpose_item<true>(F.w_ab, 1024, 2048, F.ws + WS_WAB, 1024, (r % 64) * 32, (r / 64) * 64, scr, F.lane, ident, 16.0f); continue; }
        r -= I_AB;
        if (r < I_AB) { transpose_item<true>(F.w_pb, 1024, 2048, F.ws + WS_WPB, 1024, (r % 64) * 32, (r / 64) * 64, scr, F.lane, ident, 16.0f); continue; }
        r -= I_AB;
        if (r < I_OUT) { transpose_item<true>(F.w_out, 2048, 2048, F.ws + WS_WOUT, 2048, (r % 64) * 32, (r / 64) * 64, scr, F.lane, ident, 16.0f); continue; }
        r -= I_OUT;
        if (r < I_OUT) { transpose_item(F.w_pq, 2048, 2048, (bf16_t*)(F.ws + WS_WPQ), 2048, (r % 64) * 32, (r / 64) * 64, scr, F.lane, ident); continue; }
        r -= I_OUT;
        { const int g = r / 32, q = r % 32, nb = q % 8, kb = q / 8;
          transpose_item(F.pool_w + (size_t)g * 65536, 256, 256, (bf16_t*)(F.ws + WS_POOLW) + (size_t)g * 65536, 256, nb * 32, kb * 64, scr, F.lane, ident); }
    }
    {
        bf16_t* kb = (bf16_t*)(F.ws + WS_KEYSBD);
        for (int i = F.bid * 512 + F.tid; i < 2048 * 32; i += F.G * 512) {
            const int row = i / 32, k8 = (i % 32) * 8, p = (row >> 7) & 1;
            u32x4 o = (u32x4){0u, 0u, 0u, 0u};
            if ((k8 >> 7) == p) { const float* s = F.peer_keys + (size_t)row * 128 + (k8 & 127); const f32x4 a = *(const f32x4*)s, b = *(const f32x4*)(s + 4); o = pack8(a, b); }
            *(u32x4*)(kb + (size_t)row * 256 + k8) = o;
        }
    }
    {
        unsigned char* pu = F.ws + WS_PU;
        for (size_t i = (size_t)F.bid * 512 + F.tid; i < (size_t)NEXP * 64; i += (size_t)F.G * 512) {
            const float* src = F.peer_u + i * 32;
            u32x16 pk;
#pragma unroll
            for (int k = 0; k < 8; ++k) { const f32x4 a = *(const f32x4*)(src + k * 4) * 96.0f; pk[2 * k] = cvt_pk_bf16(a[0], a[1]); pk[2 * k + 1] = cvt_pk_bf16(a[2], a[3]); }
            const u32x6 p6 = __builtin_amdgcn_cvt_scalef32_pk32_fp6_bf16(__builtin_bit_cast(bf16x32, pk), 1.0f);
            const int ci = (int)(i & 63), lp = (ci >> 2) + 16 * (ci & 3);
            unsigned char* dst = pu + (i >> 6) * 1536;
            *(u32x4*)(dst + lp * 16) = (u32x4){p6[0], p6[1], p6[2], p6[3]}; *(u32x2*)(dst + 1024 + lp * 8) = (u32x2){p6[4], p6[5]};
        }
        unsigned char* pv = F.ws + WS_PV;
        for (int it = gw; it < (NEXP / 64) * 128; it += NGW) {
            const int e = (it >> 7) * 64 + F.lane, ch = it & 127;
            u32x4 ov;
#pragma unroll
            for (int k = 0; k < 4; ++k) { const f32x4 c = *(const f32x4*)(F.peer_v + (size_t)e * DM + ch * 16 + k * 4) * 4.0f;
                int wv = __builtin_amdgcn_cvt_pk_fp8_f32(c[0], c[1], 0, false); wv = __builtin_amdgcn_cvt_pk_fp8_f32(c[2], c[3], wv, true); ov[k] = (unsigned)wv; }
            *(u32x2*)(pv + ((size_t)(2 * ch) * NEXP + e) * 8) = (u32x2){ov[0], ov[1]};
            *(u32x2*)(pv + ((size_t)(2 * ch + 1) * NEXP + e) * 8) = (u32x2){ov[2], ov[3]};
        }
    }
    {
        __syncthreads();
        float* cact = (float*)(F.lds + 131072);
        float* red = (float*)F.lds;
        float* mp = (float*)(F.ws + WS_MODP);
        for (int it = F.bid; it < 48 * 4; it += F.G) {
            const int cb = it % 48, ds = it / 48, d0 = ds * 512;
            for (int i = F.tid; i < 8 * 512; i += 512) { const int b = i >> 9, d = i & 511; const float cv = F.c[b * DM + d0 + d]; cact[i] = cv * sigmoidf_(cv); }
            __syncthreads();
            f32x4 a[8];
#pragma unroll
            for (int b = 0; b < 8; ++b) a[b] = (f32x4){0.f, 0.f, 0.f, 0.f};
            const float* wp = F.w_ada + (size_t)(d0 + F.wave * 64) * 12288 + cb * 256 + F.lane * 4;
#pragma unroll 4
            for (int d = 0; d < 64; ++d) { const f32x4 w = *(const f32x4*)(wp + (size_t)d * 12288);
#pragma unroll
                for (int b = 0; b < 8; ++b) a[b] += w * cact[b * 512 + F.wave * 64 + d]; }
#pragma unroll
            for (int b = 0; b < 8; ++b)
#pragma unroll
                for (int j = 0; j < 4; ++j) red[(F.wave * 32 + b * 4 + j) * 64 + F.lane] = a[b][j];
            __syncthreads();
            for (int i = F.tid; i < 2048; i += 512) { const int v = i >> 6, l = i & 63; float s = 0.f;
#pragma unroll
                for (int w = 0; w < 8; ++w) s += red[(w * 32 + v) * 64 + l];
                mp[((size_t)ds * 8 + (v >> 2)) * 12288 + cb * 256 + l * 4 + (v & 3)] = s; }
            __syncthreads();
        }
    }
}

template <bool FIRST> __device__ __forceinline__ void phase_modnorm(Frame& F, const float* xin, const float* gain, int off_sh, int off_sc, bf16_t* dst, unsigned char* dst8 = nullptr) {
    F.lane = lane_now(); F.tid = F.wave * 64 + F.lane;
    const float* mp = (const float*)(F.ws + WS_MODP); float* mf = (float*)(F.ws + WS_MODF);
    if (FIRST) {
        for (int i = F.bid * 512 + F.tid; i < 8 * 12288; i += F.G * 512) {
            float s = F.b_ada[i % 12288];
#pragma unroll
            for (int k = 0; k < 4; ++k) s += mp[(size_t)k * 8 * 12288 + i];
            mf[i] = s; }
    }
    float* cA = (float*)F.lds; float* cB = cA + 2048;
    for (int ch = F.bid; ch < MTOK / 128; ch += F.G) {
        const int b = ch / 32;
        __syncthreads();
        for (int col = F.tid; col < 2048; col += 512) {
            float sc, sh;
            if (FIRST) { sc = F.b_ada[off_sc + col]; sh = F.b_ada[off_sh + col];
#pragma unroll
                for (int k = 0; k < 4; ++k) { sc += mp[((size_t)k * 8 + b) * 12288 + off_sc + col]; sh += mp[((size_t)k * 8 + b) * 12288 + off_sh + col]; } }
            else { sc = mf[b * 12288 + off_sc + col]; sh = mf[b * 12288 + off_sh + col]; }
            cA[col] = gain[col] * (1.f + sc); cB[col] = sh; }
        __syncthreads();
        for (int r = F.wave; r < 128; r += 8) {
            const size_t row = (size_t)ch * 128 + r;
            const float* xr = xin + row * 2048 + F.lane * 8; const bf16_t* xrb = (const bf16_t*)xin + row * 2048 + F.lane * 8;
            f32x4 v[4][2]; float ss = 0.f;
#pragma unroll
            for (int i = 0; i < 4; ++i) { if (FIRST) { v[i][0] = *(const f32x4*)(xr + i * 512); v[i][1] = *(const f32x4*)(xr + i * 512 + 4); } else unpack8(*(const u32x4*)(xrb + i * 512), v[i][0], v[i][1]);
#pragma unroll
                for (int j = 0; j < 4; ++j) ss += v[i][0][j] * v[i][0][j] + v[i][1][j] * v[i][1][j]; }
            ss = wave_sum(ss);
            const float rinv = 1.0f / sqrtf(ss * (1.0f / 2048.0f) + EPS);
#pragma unroll
            for (int i = 0; i < 4; ++i) { const int col = i * 512 + F.lane * 8;
                const f32x4 a0 = *(const f32x4*)(cA + col), a1 = *(const f32x4*)(cA + col + 4), b0 = *(const f32x4*)(cB + col), b1 = *(const f32x4*)(cB + col + 4);
                const f32x4 y0 = v[i][0] * rinv * a0 + b0, y1 = v[i][1] * rinv * a1 + b1;
                *(u32x4*)(dst + row * 2048 + col) = pack8(y0, y1);
                if (FIRST) *(u32x2*)(dst8 + row * 2048 + col) = pack8_fp8(y0, y1); }
        }
    }
}

__device__ __forceinline__ void phase3_qknorm(Frame& F) {
    F.lane = lane_now(); F.tid = F.wave * 64 + F.lane;
    const bf16_t* q = (const bf16_t*)(F.ws + WS_QN); const bf16_t* k = (const bf16_t*)(F.ws + WS_KN); const bf16_t* v = (const bf16_t*)(F.ws + WS_V);
    unsigned char* q8 = F.ws + WS_Q8; unsigned char* k8 = F.ws + WS_K8; unsigned char* v8 = F.ws + WS_V8;
    const int gw = F.bid * 8 + F.wave, NGW = F.G * 8;
    for (int row = gw; row < MTOK; row += NGW) {
#pragma unroll
        for (int i = 0; i < 2; ++i) { const int ci = i * 64 + F.lane;
            f32x4 a, b; unpack8(*(const u32x4*)(q + (size_t)row * 1024 + ci * 8), a, b);
            float ss = a[0] * a[0] + a[1] * a[1] + a[2] * a[2] + a[3] * a[3] + b[0] * b[0] + b[1] * b[1] + b[2] * b[2] + b[3] * b[3];
            ss = row_sum16(ss);
            const float rinv = 1.0f / sqrtf(ss * (1.0f / 128.0f) + EPS);
            const float* gp = F.g_q + (ci & 15) * 8; const f32x4 g0 = *(const f32x4*)gp, g1 = *(const f32x4*)(gp + 4);
            *(u32x2*)(q8 + (size_t)row * 1024 + ci * 8) = pack8_fp8(a * rinv * g0, b * rinv * g1); }
        { const int ci = F.lane & 31; const bool isk = F.lane < 32;
            f32x4 a, b; unpack8(*(const u32x4*)((isk ? k : v) + (size_t)row * 256 + ci * 8), a, b);
            float ss = a[0] * a[0] + a[1] * a[1] + a[2] * a[2] + a[3] * a[3] + b[0] * b[0] + b[1] * b[1] + b[2] * b[2] + b[3] * b[3];
            ss = row_sum16(ss);
            const float rinv = isk ? 1.0f / sqrtf(ss * (1.0f / 128.0f) + EPS) : 1.0f;
            const float* gp = F.g_k + (ci & 15) * 8; f32x4 g0 = *(const f32x4*)gp, g1 = *(const f32x4*)(gp + 4);
            if (!isk) { g0 = (f32x4){1.f, 1.f, 1.f, 1.f}; g1 = g0; }
            *(u32x2*)((isk ? k8 : v8) + (size_t)row * 256 + ci * 8) = pack8_fp8(a * rinv * g0, b * rinv * g1); }
    }
}
template <int W> __device__ __forceinline__ void pooled_item(const bf16_t* pl, bf16_t* po, int row, int c8) {
    const int t = row & (SEQ - 1);
    f32x4 s0 = (f32x4){0.f, 0.f, 0.f, 0.f}, s1 = s0, x0 = s0, x1 = s0;
    u32x4 v[W];
#pragma unroll
    for (int j = 0; j < W; ++j) v[j] = *(const u32x4*)(pl + (size_t)(row - (j <= t ? j : 0)) * 1024 + c8);
#pragma unroll
    for (int j = 0; j < W; ++j) { f32x4 a, b; unpack8(v[j], a, b); if (j == 0) { x0 = a; x1 = b; } if (j <= t) { s0 += a; s1 += b; } }
    const float inv = 1.0f / (float)((t + 1 < W) ? t + 1 : W);
    *(u32x4*)(po + (size_t)row * 1024 + c8) = pack8(s0 * inv - x0, s1 * inv - x1);
}
__device__ __forceinline__ void phase3_pooled(Frame& F) {
    F.lane = lane_now(); F.tid = F.wave * 64 + F.lane;
    const bf16_t* pl = (const bf16_t*)(F.ws + WS_PL); bf16_t* po = (bf16_t*)(F.ws + WS_POOLED);
    const int gw = F.bid * 8 + F.wave, NGW = F.G * 8;
    for (int it = gw; it < (MTOK / 2) * 4; it += NGW) {
        const int g = it & 3, row = (it >> 2) * 2 + (F.lane >> 5), c8 = g * 256 + (F.lane & 31) * 8;
        if (g == 0) pooled_item<2>(pl, po, row, c8); else if (g == 1) pooled_item<4>(pl, po, row, c8); else if (g == 2) pooled_item<8>(pl, po, row, c8); else pooled_item<16>(pl, po, row, c8);
    }
}
typedef float f32x16 __attribute__((ext_vector_type(16)));
__device__ __forceinline__ float wrelu_(float wh, float d, float acc) { return __builtin_fmaf(wh, d, __builtin_fmaf(wh, __builtin_fabsf(d), acc)); }
__device__ __forceinline__ int sel_code(float s, float smin, float scale) { const float c = (s - smin) * scale; return (int)fminf(fmaxf(c, 0.f), 65535.f); }
__device__ __forceinline__ void hist_find(const unsigned* hist, int lane, int K, int& bsel, int& above) {
    const u32x4 h = *(const u32x4*)(hist + lane * 4);
    const int S = (int)(h.x + h.y + h.z + h.w);
    int x = S;
    x += __builtin_amdgcn_update_dpp(0, x, 0x101, 0xF, 0xF, true);
    x += __builtin_amdgcn_update_dpp(0, x, 0x102, 0xF, 0xF, true);
    x += __builtin_amdgcn_update_dpp(0, x, 0x104, 0xF, 0xF, true);
    x += __builtin_amdgcn_update_dpp(0, x, 0x108, 0xF, 0xF, true);
    const int t1 = __builtin_amdgcn_readlane(x, 16), t2 = __builtin_amdgcn_readlane(x, 32), t3 = __builtin_amdgcn_readlane(x, 48);
    const int r = lane >> 4;
    x += (r == 0 ? t1 + t2 + t3 : (r == 1 ? t2 + t3 : (r == 2 ? t3 : 0)));
    const int sufn = x - S;
    const bool mine = (x >= K) && (sufn < K);
    int b = 0, ab = 0;
    { int c = sufn;
      if (c + (int)h.w >= K) { b = 3; ab = c; } else { c += (int)h.w;
      if (c + (int)h.z >= K) { b = 2; ab = c; } else { c += (int)h.z;
      if (c + (int)h.y >= K) { b = 1; ab = c; } else { c += (int)h.y; b = 0; ab = c; } } } }
    const unsigned long long m = __ballot(mine);
    const int src = m ? (int)__builtin_ctzll(m) : 0;
    bsel = __builtin_amdgcn_readlane(lane * 4 + b, src); above = __builtin_amdgcn_readlane(ab, src);
}
__device__ __forceinline__ int mask_prefix(unsigned long long m) { return (int)__builtin_amdgcn_mbcnt_hi((unsigned)(m >> 32), __builtin_amdgcn_mbcnt_lo((unsigned)m, 0u)); }
template <class Fn> __device__ __forceinline__ void sel_sweep(const f32x4* rb4, int n4, int lane, int t, Fn fn) {
    f32x4 cur = rb4[lane];
    for (int c4 = 0; c4 < n4 - 1; ++c4) { const f32x4 nxt = rb4[(c4 + 1) * 64 + lane];
#pragma unroll
        for (int k = 0; k < 4; ++k) fn(cur[k], (c4 * 4 + k) * 64 + lane, true);
        cur = nxt; }
    { const int c4 = n4 - 1;
#pragma unroll
      for (int k = 0; k < 4; ++k) { const int idx = (c4 * 4 + k) * 64 + lane; fn(cur[k], idx, idx <= t); } }
}
template <int MODE = 0> __device__ __forceinline__ void indexer_select(Frame& F, int b, int t, const float* rowbuf, unsigned* hist, float* eqv, int* eqi) {
    unsigned short* selrow = (unsigned short*)(F.ws + (MODE ? WS_R0 : WS_SEL)) + (size_t)(b * SEQ + t) * 256;
    int lane = F.lane; asm volatile("" : "+v"(lane));
    const int nch = t / 64 + 1, n4 = (nch + 3) >> 2;
    const f32x4* rb4 = (const f32x4*)rowbuf;
    float mn = __builtin_huge_valf(), mx = -__builtin_huge_valf();
    sel_sweep(rb4, n4, lane, t, [&](float v, int, bool valid) { mn = valid ? fminf(mn, v) : mn; mx = valid ? fmaxf(mx, v) : mx; });
    mx = xor16_max(row_max16(mx)); { const auto r = __builtin_amdgcn_permlane32_swap(__float_as_uint(mx), __float_as_uint(mx), false, false); mx = fmaxf(__uint_as_float(r[0]), __uint_as_float(r[1])); }
    mn = -mn; mn = xor16_max(row_max16(mn)); { const auto r = __builtin_amdgcn_permlane32_swap(__float_as_uint(mn), __float_as_uint(mn), false, false); mn = -fmaxf(__uint_as_float(r[0]), __uint_as_float(r[1])); }
    const float scale = (mx > mn) ? 65535.0f / (mx - mn) : 0.f;
    *(u32x4*)(hist + lane * 4) = (u32x4){0u, 0u, 0u, 0u};
    sel_sweep(rb4, n4, lane, t, [&](float v, int, bool valid) { if (valid) { if (MODE == 2) ((volatile unsigned*)hist)[sel_code(v, mn, scale) >> 8] = 1u; else atomicAdd(&hist[sel_code(v, mn, scale) >> 8], 1u); } });
    int b1, above1; hist_find(hist, lane, KSEL, b1, above1);
    *(u32x4*)(hist + lane * 4) = (u32x4){0u, 0u, 0u, 0u};
    sel_sweep(rb4, n4, lane, t, [&](float v, int, bool valid) { const int code = sel_code(v, mn, scale); if (valid && (code >> 8) == b1) atomicAdd(&hist[code & 255], 1u); });
    int b2, above2; hist_find(hist, lane, KSEL - above1, b2, above2);
    const int T16 = (b1 << 8) | b2, need = KSEL - above1 - above2, ceq = (int)hist[b2];
    const bool all_eq = (ceq == need), collect = !all_eq && (ceq <= 64);
    const int eq_budget = all_eq ? 0x7fffffff : (collect ? 0 : need);
    int pos = 0, eqseen = 0;
    sel_sweep(rb4, n4, lane, t, [&](float v, int idx, bool valid) {
        const int code = sel_code(v, mn, scale);
        const bool gt = valid && code > T16, eq = valid && code == T16;
        const unsigned long long mg = __ballot(gt);
        const unsigned p = (unsigned)(pos + mask_prefix(mg));
        if (gt && p < (unsigned)KSEL) selrow[p] = (unsigned short)idx;
        pos += __popcll(mg);
        const unsigned long long me = __ballot(eq);
        if (me) {
            const int er = eqseen + mask_prefix(me); const bool te = eq && er < eq_budget;
            if (collect && eq) { eqv[er] = v; eqi[er] = idx; }
            eqseen += __popcll(me);
            const unsigned long long mte = __ballot(te);
            const unsigned pe = (unsigned)(pos + mask_prefix(mte));
            if (te && pe < (unsigned)KSEL) selrow[pe] = (unsigned short)idx;
            pos += __popcll(mte);
        }
    });
    if (collect && lane < ceq) {
        const float sv = eqv[lane]; const int idx = eqi[lane]; int rank = 0;
        for (int m = 0; m < ceq; ++m) { const float ov = eqv[m]; const int oi = eqi[m]; rank += (ov > sv || (ov == sv && oi < idx)) ? 1 : 0; }
        if (rank < need) selrow[KSEL - need + rank] = (unsigned short)idx;
    }
}
__device__ __forceinline__ void indexer_tile(Frame& F, int b, int t0) {
    const bf16_t* iq = (const bf16_t*)(F.ws + WS_IQ); const bf16_t* ik = (const bf16_t*)(F.ws + WS_IK); const float* iw = (const float*)(F.ws + WS_IW);
    int lane = F.lane; asm volatile("" : "+v"(lane));
    const int w = F.wave;
    if (t0 < KSEL) {
        const int t = t0 + w; unsigned short* selrow = (unsigned short*)(F.ws + WS_SEL) + (size_t)(b * SEQ + t) * 256;
#pragma unroll
        for (int p = 0; p < 4; ++p) { const int j = p * 64 + lane; selrow[j] = (unsigned short)(j <= t ? j : 0xFFFF); }
        return;
    }
    float* rowbuf = (float*)F.lds;
    unsigned char* stage = F.lds + 131072;
    const int p = w & 3, kh = w >> 2, hi = lane >> 5, r = lane & 31;
    const size_t qrow = (size_t)b * SEQ + t0 + 2 * p + (r >> 4);
    bf16x8 a[4];
#pragma unroll
    for (int ks = 0; ks < 4; ++ks) a[ks] = *(const bf16x8*)(iq + qrow * 1024 + (r & 15) * 64 + ks * 16 + 8 * hi);
    float wq[2][8];
#pragma unroll
    for (int q = 0; q < 2; ++q)
#pragma unroll
        for (int i = 0; i < 8; ++i) wq[q][i] = 0.5f * iw[((size_t)b * SEQ + t0 + 2 * p + q) * 16 + (i & 3) + 8 * ((i >> 2) & 1) + 4 * hi];
    const int nchunks = (t0 + 7) / 64 + 1, nsteps = (nchunks + 1) >> 1;
    const unsigned char* gsrc = (const unsigned char*)(ik + (size_t)b * SEQ * 64) + F.tid * 16;
    const int skey = F.tid >> 3, sc16 = F.tid & 7, soff = skey * 128 + ((sc16 ^ ((skey >> 1) & 7)) << 4);
    u32x4 sa0 = *(const u32x4*)gsrc, sb0 = sa0, sa1 = sa0, sb1 = sa0;
    sb0 = *(const u32x4*)(gsrc + (size_t)min(1, nchunks - 1) * 8192);
    sa1 = *(const u32x4*)(gsrc + (size_t)min(2, nchunks - 1) * 8192);
    sb1 = *(const u32x4*)(gsrc + (size_t)min(3, nchunks - 1) * 8192);
    __syncthreads();
#if PROBE_IDX != 1 && PROBE_IDX != 5
#define IDX_LD(c) (*(const u32x4*)(gsrc + (size_t)(c) * 8192))
#endif
#define IDX_MMA(SA, SB, ss, D0, D1) do { const int s_ = (ss); unsigned char* sb = stage + (s_ & 1) * 16384; \
        *(u32x4*)(sb + soff) = SA; *(u32x4*)(sb + 8192 + soff) = SB; \
        __syncthreads(); \
        SA = IDX_LD(min(2 * s_ + 4, nchunks - 1)); \
        SB = IDX_LD(min(2 * s_ + 5, nchunks - 1)); \
        _Pragma("unroll") for (int i = 0; i < 16; ++i) { D0[i] = 0.f; D1[i] = 0.f; } \
        _Pragma("unroll") for (int ks = 0; ks < 4; ++ks) { const unsigned char* bp = sb + key * 128 + (((ks * 2 + hi) ^ ((key >> 1) & 7)) << 4); \
            const bf16x8 bf0 = *(const bf16x8*)bp, bf1 = *(const bf16x8*)(bp + 8192); \
            D0 = __builtin_amdgcn_mfma_f32_32x32x16_bf16(a[ks], bf0, D0, 0, 0, 0); D1 = __builtin_amdgcn_mfma_f32_32x32x16_bf16(a[ks], bf1, D1, 0, 0, 0); } } while (0)
#define IDX_RED(ss, D0, D1) do { const int s_ = (ss); float x0_ = 0.f, x1_ = 0.f, y0_ = 0.f, y1_ = 0.f; \
        _Pragma("unroll") for (int i = 0; i < 8; ++i) { x0_ = wrelu_(wq[0][i], D0[i], x0_); x1_ = wrelu_(wq[1][i], D0[8 + i], x1_); y0_ = wrelu_(wq[0][i], D1[i], y0_); y1_ = wrelu_(wq[1][i], D1[8 + i], y1_); } \
        const float scx = swap32_pair(x0_, x1_), scy = swap32_pair(y0_, y1_); \
        *(f32x2*)(rowbuf + (2 * p + hi) * 4096 + ((s_ >> 1) * 64 + key) * 4 + 2 * (s_ & 1)) = (f32x2){scx, scy}; } while (0)
    const int key = kh * 32 + r;
    f32x16 dA0, dA1, dB0, dB1;
#if PROBE_IDX == 1
#define IDX_LD(c) (*(const u32x4*)(gsrc + (size_t)(c) * 8192))
#elif PROBE_IDX == 5
#define IDX_LD(c) SAVED
#endif
#if PROBE_IDX == 1 || PROBE_IDX == 5
    { const u32x4 SAVED = sa0;
    IDX_MMA(sa0, sb0, 0, dA0, dA1);
    for (int s2 = 0; s2 < nsteps; s2 += 2) {
        if (s2 + 1 < nsteps) IDX_MMA(sa1, sb1, s2 + 1, dB0, dB1);
        IDX_RED(s2, dA0, dA1);
        if (s2 + 2 < nsteps) IDX_MMA(sa0, sb0, s2 + 2, dA0, dA1);
        if (s2 + 1 < nsteps) IDX_RED(s2 + 1, dB0, dB1);
    }
    __syncthreads();
    sa0 = *(const u32x4*)gsrc;
    sb0 = *(const u32x4*)(gsrc + (size_t)min(1, nchunks - 1) * 8192);
    sa1 = *(const u32x4*)(gsrc + (size_t)min(2, nchunks - 1) * 8192);
    sb1 = *(const u32x4*)(gsrc + (size_t)min(3, nchunks - 1) * 8192); }
#undef IDX_LD
#define IDX_LD(c) (*(const u32x4*)(gsrc + (size_t)(c) * 8192))
#endif
    IDX_MMA(sa0, sb0, 0, dA0, dA1);
    for (int s2 = 0; s2 < nsteps; s2 += 2) {
        if (s2 + 1 < nsteps) IDX_MMA(sa1, sb1, s2 + 1, dB0, dB1);
        IDX_RED(s2, dA0, dA1);
        if (s2 + 2 < nsteps) IDX_MMA(sa0, sb0, s2 + 2, dA0, dA1);
        if (s2 + 1 < nsteps) IDX_RED(s2 + 1, dB0, dB1);
    }
#undef IDX_MMA
#undef IDX_RED
#undef IDX_LD
    __syncthreads();
    indexer_select(F, b, t0 + w, rowbuf + w * 4096, (unsigned*)(F.lds + 147456) + w * 256, (float*)(F.lds + 155648) + w * 64, (int*)(F.lds + 155648 + 2048) + w * 64);
#if PROBE_IDX >= 2
    indexer_select<PROBE_IDX - 1>(F, b, t0 + w, rowbuf + w * 4096, (unsigned*)(F.lds + 147456) + w * 256, (float*)(F.lds + 155648) + w * 64, (int*)(F.lds + 155648 + 2048) + w * 64);
#endif
}
__device__ __forceinline__ void phase3_indexer(Frame& F) {
    F.lane = lane_now(); F.tid = F.wave * 64 + F.lane;
    volatile LAS unsigned* misc = (volatile LAS unsigned*)((LAS unsigned char*)F.lds + MISC_OFF);
    const unsigned keep0 = misc[0], keep1 = misc[1];
    __syncthreads();
    const int nit = BATCH * (SEQ / 8);
    for (int k = 0;; ++k) {
        const int l = k * F.G + ((k & 1) ? (F.G - 1 - F.bid) : F.bid);
        if (l >= nit) { if (k * F.G >= nit) break; else continue; }
        const int qb = (SEQ / 8 - 1) - (l >> 3), b = l & 7;
        indexer_tile(F, b, qb * 8);
    }
    __syncthreads();
    if (F.tid == 0) { misc[0] = keep0; misc[1] = keep1; }
}

__device__ const unsigned char g_bucket[128] = {0, 1, 2, 3, 4, 5, 6, 7, 8, 9, 10, 11, 12, 13, 14, 15, 16, 16, 16, 17, 17, 18, 18, 18, 19, 19, 19, 20, 20, 20, 20, 21, 21, 21, 21, 22, 22, 22, 22, 22, 23, 23, 23, 23, 23, 23, 24, 24, 24, 24, 24, 24, 25, 25, 25, 25, 25, 25, 25, 26, 26, 26, 26, 26, 26, 26, 26, 27, 27, 27, 27, 27, 27, 27, 27, 27, 27, 28, 28, 28, 28, 28, 28, 28, 28, 28, 28, 29, 29, 29, 29, 29, 29, 29, 29, 29, 29, 29, 29, 30, 30, 30, 30, 30, 30, 30, 30, 30, 30, 30, 30, 30, 30, 31, 31, 31, 31, 31, 31, 31, 31, 31, 31, 31, 31, 31, 31, 31};
__device__ __forceinline__ void at_pv_step(f32x4 (&D0)[8], f32x4 (&D1)[8], const u32x4 (&buf)[8], LAS unsigned char* vwr, LAS unsigned char* ard, LAS unsigned char* brd) {
#pragma unroll
    for (int c = 0; c < 8; ++c) *(LAS u32x4*)(vwr + c * 576) = buf[c];
    const long pb = __builtin_bit_cast(long, __builtin_amdgcn_ds_read_tr8_b64_v2i32((LAS v2i*)brd));
#pragma unroll
    for (int tl = 0; tl < 8; ++tl) { const long va = __builtin_bit_cast(long, __builtin_amdgcn_ds_read_tr8_b64_v2i32((LAS v2i*)(ard + tl * 16))); D0[tl] = __builtin_amdgcn_mfma_f32_16x16x32_fp8_fp8(va, pb, D0[tl], 0, 0, 0); }
#pragma unroll
    for (int tl = 0; tl < 8; ++tl) { const long va = __builtin_bit_cast(long, __builtin_amdgcn_ds_read_tr8_b64_v2i32((LAS v2i*)(ard + 4608 + tl * 16))); D1[tl] = __builtin_amdgcn_mfma_f32_16x16x32_fp8_fp8(va, pb, D1[tl], 0, 0, 0); }
}
__device__ __forceinline__ void phase4_attention(Frame& F) {
    F.lane = lane_now(); F.tid = F.wave * 64 + F.lane;
    const unsigned char* q8 = F.ws + WS_Q8; const unsigned char* k8 = F.ws + WS_K8; const unsigned char* v8 = F.ws + WS_V8;
    const unsigned short* sel = (const unsigned short*)(F.ws + WS_SEL); unsigned char* ao = F.ws + WS_ATTN;
    float* btab = (float*)F.lds;
    __syncthreads();
    for (int i = F.tid; i < 256; i += 512) btab[i] = F.rel_bias[i];
    __syncthreads();
    constexpr int WST = 16512;
    unsigned char* wgp = F.lds + 4096 + F.wave * WST;
    bf16_t* Pb = (bf16_t*)(wgp + 9216); int* idl = (int*)(wgp + 13312); float* psl = (float*)(wgp + 16384); float* pml = psl + 8;
    LAS unsigned char* wl = (LAS unsigned char*)F.lds + 4096 + F.wave * WST;
    const bool xmap = (F.G % 8) == 0;
    const int gw = xmap ? (F.bid / 8) * 8 + F.wave : F.bid * 8 + F.wave, NGW = xmap ? F.G : F.G * 8, nrows = xmap ? SEQ : MTOK;
    for (int rr = gw; rr < nrows; rr += NGW) {
        int lane = F.lane; asm volatile("" : "+v"(lane));
        const int row = xmap ? (F.bid & 7) * SEQ + rr : rr;
        const int b = row / SEQ, t = row % SEQ, r = lane & 31, hi = lane >> 5;
#pragma unroll
        for (int p = 0; p < 4; ++p) { idl[p * 64 + lane] = (int)sel[(size_t)row * 256 + p * 64 + lane]; }
        long a0[8], a1[8];
        { u32x4 qa[4];
#pragma unroll
          for (int i = 0; i < 4; ++i) qa[i] = (r < 8) ? *(const u32x4*)(q8 + (size_t)row * 1024 + r * 128 + hi * 64 + i * 16) : (u32x4){0u, 0u, 0u, 0u};
#pragma unroll
          for (int ks = 0; ks < 8; ++ks) { const unsigned lo = qa[ks >> 1][(ks & 1) * 2], hh = qa[ks >> 1][(ks & 1) * 2 + 1]; const long v = (long)(((unsigned long long)hh << 32) | lo);
              a0[ks] = (r < 4) ? v : 0l; a1[ks] = (r >= 4) ? v : 0l; } }
        f32x4 psum = (f32x4){0.f, 0.f, 0.f, 0.f}, pmax = psum;
        const int vg4 = lane >> 4, vch = lane & 15;
#define AT_LOADK(buf, kb) do { _Pragma("unroll") for (int c = 0; c < 8; ++c) { const int key_ = idl[(kb) * 32 + 4 * c + vg4]; const int kc_ = key_ <= t ? key_ : 0; \
            buf[c] = *(const u32x4*)(k8 + ((size_t)b * SEQ + kc_) * 256 + vch * 16); } } while (0)
#define AT_QK(buf, kb) do { const int key_ = idl[(kb) * 32 + r]; const bool valid_ = key_ <= t; const int kc_ = valid_ ? key_ : 0; \
            _Pragma("unroll") for (int c = 0; c < 8; ++c) *(LAS u32x4*)(wl + (4 * c + vg4) * 272 + vch * 16) = buf[c]; \
            u32x4 g0_[4], g1_[4]; \
            _Pragma("unroll") for (int i = 0; i < 4; ++i) { g0_[i] = *(const LAS u32x4*)(wl + r * 272 + hi * 64 + i * 16); g1_[i] = *(const LAS u32x4*)(wl + r * 272 + 128 + hi * 64 + i * 16); } \
            f32x16 d; _Pragma("unroll") for (int i = 0; i < 16; ++i) d[i] = 0.f; \
            _Pragma("unroll") for (int ks = 0; ks < 8; ++ks) { const long bv_ = (long)(((unsigned long long)g0_[ks >> 1][(ks & 1) * 2 + 1] << 32) | g0_[ks >> 1][(ks & 1) * 2]); d = __builtin_amdgcn_mfma_f32_32x32x16_fp8_fp8(a0[ks], bv_, d, 0, 0, 0); } \
            _Pragma("unroll") for (int ks = 0; ks < 8; ++ks) { const long bv_ = (long)(((unsigned long long)g1_[ks >> 1][(ks & 1) * 2 + 1] << 32) | g1_[ks >> 1][(ks & 1) * 2]); d = __builtin_amdgcn_mfma_f32_32x32x16_fp8_fp8(a1[ks], bv_, d, 0, 0, 0); } \
            const int dist_ = t - kc_; const int bkt_ = dist_ < 128 ? (int)g_bucket[dist_] : 31; \
            const f32x4 bias_ = *(const f32x4*)(btab + bkt_ * 8 + 4 * hi); f32x4 e_; \
            _Pragma("unroll") for (int i = 0; i < 4; ++i) e_[i] = valid_ ? __expf(d[i] * 0.08838834764831845f + bias_[i]) : 0.f; \
            psum += e_; _Pragma("unroll") for (int i = 0; i < 4; ++i) pmax[i] = fmaxf(pmax[i], e_[i]); \
            *(u32x2*)(Pb + ((kb) * 32 + r) * 8 + 4 * hi) = (u32x2){cvt_pk_bf16(e_[0], e_[1]), cvt_pk_bf16(e_[2], e_[3])}; } while (0)
        {
            u32x4 kA[8], kB[8];
            AT_LOADK(kA, 0);
#pragma unroll 1
            for (int kb = 0; kb < 8; kb += 2) {
                AT_LOADK(kB, kb + 1);
                AT_QK(kA, kb);
                if (kb + 2 < 8) AT_LOADK(kA, kb + 2);
                AT_QK(kB, kb + 1);
            }
        }
#undef AT_LOADK
#undef AT_QK
#pragma unroll
        for (int i = 0; i < 4; ++i) { psum[i] = xor16_sum(row_sum16(psum[i])); pmax[i] = xor16_max(row_max16(pmax[i])); }
        if (r == 0) { *(f32x4*)(psl + 4 * hi) = psum; *(f32x4*)(pml + 4 * hi) = pmax; }
        const int kq = lane >> 4, tq = (lane >> 1) & 7, tp = lane & 1;
#define AT_LOADV(buf, ks_) do { _Pragma("unroll") for (int c = 0; c < 8; ++c) { const int key_ = idl[(ks_) * 32 + 4 * c + vg4]; const int kc_ = key_ <= t ? key_ : 0; \
            buf[c] = *(const u32x4*)(v8 + ((size_t)b * SEQ + kc_) * 256 + vch * 16); } } while (0)
        u32x4 vA[8], vB[8];
        AT_LOADV(vA, 0);
        { const f32x4 m0 = *(const f32x4*)pml, m1 = *(const f32x4*)(pml + 4);
          f32x4 r0, r1;
#pragma unroll
          for (int i = 0; i < 4; ++i) { r0[i] = __builtin_amdgcn_rcpf(m0[i]); r1[i] = __builtin_amdgcn_rcpf(m1[i]); }
#pragma unroll
          for (int i = 0; i < 4; ++i) { const int key = i * 64 + lane;
              f32x4 pa, pb; unpack8(*(const u32x4*)(Pb + key * 8), pa, pb);
              *(LAS u32x2*)(wl + 14336 + key * 8) = pack8_fp8(pa * r0, pb * r1); } }
        f32x4 D0[8], D1[8];
#pragma unroll
        for (int tl = 0; tl < 8; ++tl) { D0[tl] = (f32x4){0.f, 0.f, 0.f, 0.f}; D1[tl] = D0[tl]; }
        LAS unsigned char* vwr = wl + (vch >> 3) * 4608 + vg4 * 144 + (vch & 7) * 16;
        LAS unsigned char* ard = wl + (kq * 8 + tq) * 144 + 8 * tp;
        LAS unsigned char* brd = wl + 14336 + (kq * 8 + tq) * 8;
#pragma unroll 1
        for (int ks = 0; ks < 8; ks += 2) {
            AT_LOADV(vB, ks + 1);
            at_pv_step(D0, D1, vA, vwr, ard, brd + ks * 256);
            if (ks + 2 < 8) AT_LOADV(vA, ks + 2);
            at_pv_step(D0, D1, vB, vwr, ard, brd + (ks + 1) * 256);
        }
#undef AT_LOADV
        { const int n = lane & 15, q4 = lane >> 4;
          if (n < 8) { const float sc = pml[n] / psl[n]; const bool g1 = n >= 4;
              unsigned char* op = ao + (size_t)row * 1024 + n * 128 + q4 * 4;
#pragma unroll
              for (int tl = 0; tl < 8; ++tl) { const f32x4 d = (g1 ? D1[tl] : D0[tl]) * sc;
                  int w = __builtin_amdgcn_cvt_pk_fp8_f32(d[0], d[1], 0, false); w = __builtin_amdgcn_cvt_pk_fp8_f32(d[2], d[3], w, true);
                  *(unsigned*)(op + tl * 16) = (unsigned)w; } } }
    }
}

__device__ __forceinline__ float dot16f8(u32x4 w, const float* h) {
    float s = 0.f;
#pragma unroll
    for (int d = 0; d < 4; ++d) { const f32x2 lo = __builtin_amdgcn_cvt_pk_f32_fp8((int)w[d], false), hi = __builtin_amdgcn_cvt_pk_f32_fp8((int)w[d], true);
        s += lo.x * h[4 * d] + lo.y * h[4 * d + 1] + hi.x * h[4 * d + 2] + hi.y * h[4 * d + 3]; }
    return s;
}
__device__ __forceinline__ void fma16f8(u32x4 w, float cf, float* acc) {
#pragma unroll
    for (int d = 0; d < 4; ++d) { const f32x2 lo = __builtin_amdgcn_cvt_pk_f32_fp8((int)w[d], false), hi = __builtin_amdgcn_cvt_pk_f32_fp8((int)w[d], true);
        acc[4 * d] += cf * lo.x; acc[4 * d + 1] += cf * lo.y; acc[4 * d + 2] += cf * hi.x; acc[4 * d + 3] += cf * hi.y; }
}
__device__ __forceinline__ float gelu_erf(float x) { return 0.5f * x * (1.0f + erff(x * 0.70710678118654752f)); }
__device__ __forceinline__ void ce_k(unsigned& a, unsigned& b) { const unsigned hi = a > b ? a : b, lo = a > b ? b : a; a = hi; b = lo; }
__device__ __forceinline__ void ce_kp(unsigned& ka, unsigned& pa, unsigned& kb, unsigned& pb) { const bool sw = kb > ka; const unsigned k0 = sw ? kb : ka, k1 = sw ? ka : kb, p0 = sw ? pb : pa, p1 = sw ? pa : pb; ka = k0; kb = k1; pa = p0; pb = p1; }
__device__ __forceinline__ void bmerge16(unsigned (&x)[16]) {
#pragma unroll
    for (int jj = 0; jj < 4; ++jj) { const int j = 8 >> jj;
#pragma unroll
        for (int i = 0; i < 16; ++i) { const int l = i ^ j; if (l > i) ce_k(x[i], x[l]); }
        __builtin_amdgcn_sched_barrier(0); }
}
__device__ __forceinline__ void bmerge16p(unsigned (&x)[16], unsigned (&p)[16]) {
#pragma unroll
    for (int jj = 0; jj < 4; ++jj) { const int j = 8 >> jj;
#pragma unroll
        for (int i = 0; i < 16; ++i) { const int l = i ^ j; if (l > i) ce_kp(x[i], p[i], x[l], p[l]); }
        __builtin_amdgcn_sched_barrier(0); }
}
__device__ __forceinline__ void bsort16(unsigned (&x)[16]) {
#pragma unroll
    for (int kk = 1; kk <= 4; ++kk) { const int k = 1 << kk;
#pragma unroll
        for (int jj = 0; jj < 4; ++jj) { const int j = (k >> 1) >> jj;
            if (j > 0) {
#pragma unroll
                for (int i = 0; i < 16; ++i) { const int l = i ^ j; if (l > i) { if ((i & k) == 0) ce_k(x[i], x[l]); else ce_k(x[l], x[i]); } }
                __builtin_amdgcn_sched_barrier(0); } } }
}
__device__ __forceinline__ void bsort16p(unsigned (&x)[16], unsigned (&p)[16]) {
#pragma unroll
    for (int kk = 1; kk <= 4; ++kk) { const int k = 1 << kk;
#pragma unroll
        for (int jj = 0; jj < 4; ++jj) { const int j = (k >> 1) >> jj;
            if (j > 0) {
#pragma unroll
                for (int i = 0; i < 16; ++i) { const int l = i ^ j; if (l > i) { if ((i & k) == 0) ce_kp(x[i], p[i], x[l], p[l]); else ce_kp(x[l], p[l], x[i], p[i]); } }
                __builtin_amdgcn_sched_barrier(0); } } }
}
__device__ __forceinline__ void top16_row(const unsigned char* rowp, unsigned (&t)[16]) {
#pragma unroll
    for (int i = 0; i < 16; ++i) t[i] = 0u;
#pragma unroll 1
    for (int g = 0; g < 8; ++g) {
        unsigned w[8];
#pragma unroll
        for (int q = 0; q < 4; ++q) { const u32x2 v = *(const u32x2*)(rowp + g * 32 + q * 8); w[2 * q] = v.x; w[2 * q + 1] = v.y; }
        unsigned sk[16];
#pragma unroll
        for (int d = 0; d < 8; ++d) {
            const unsigned lo = w[d] << 16, hi = w[d];
            const unsigned xl = lo ^ ((unsigned)((int)lo >> 31) | 0x80000000u), xh = hi ^ ((unsigned)((int)hi >> 31) | 0x80000000u);
            sk[2 * d] = ((xl >> 9) & 0xFFFFFF80u) | (unsigned)(127 - (g * 16 + 2 * d));
            sk[2 * d + 1] = ((xh >> 9) & 0xFFFFFF80u) | (unsigned)(127 - (g * 16 + 2 * d + 1)); }
        bsort16(sk);
#pragma unroll
        for (int i = 0; i < 16; ++i) t[i] = t[i] > sk[15 - i] ? t[i] : sk[15 - i];
        bmerge16(t);
    }
}
__device__ __forceinline__ float key_val(unsigned key) { const unsigned y = (key << 9) & 0xFFFF0000u; return __uint_as_float((y ^ (~(unsigned)((int)y >> 31) | 0x80000000u)) & 0xFFFF0000u); }
__device__ __forceinline__ unsigned sum_key(float s, int c) { const unsigned u = __float_as_uint(s); return ((u ^ ((unsigned)((int)u >> 31) | 0x80000000u)) & ~63u) | (unsigned)(63 - c); }
__device__ __forceinline__ float sum_val(unsigned k) { const unsigned y = k & ~63u; return __uint_as_float(y ^ (~(unsigned)((int)y >> 31) | 0x80000000u)); }
typedef __bf16 bf2_t __attribute__((ext_vector_type(2)));
__device__ __forceinline__ float dot2_bf(unsigned a, unsigned b, float c) { return __builtin_amdgcn_fdot2_f32_bf16(__builtin_bit_cast(bf2_t, a), __builtin_bit_cast(bf2_t, b), c, false); }
__device__ __forceinline__ float dot32_f6b(u32x4 wa, u32x2 wb, u32x4 h0, u32x4 h1, u32x4 h2, u32x4 h3) {
    const bf16x32 dec = __builtin_amdgcn_cvt_scalef32_pk32_bf16_fp6((u32x6){wa.x, wa.y, wa.z, wa.w, wb.x, wb.y}, 1.0f);
    const u32x16 ud = __builtin_bit_cast(u32x16, dec);
    float acc = 0.f;
    acc = dot2_bf(ud.s0, h0.x, acc); acc = dot2_bf(ud.s1, h0.y, acc); acc = dot2_bf(ud.s2, h0.z, acc); acc = dot2_bf(ud.s3, h0.w, acc);
    acc = dot2_bf(ud.s4, h1.x, acc); acc = dot2_bf(ud.s5, h1.y, acc); acc = dot2_bf(ud.s6, h1.z, acc); acc = dot2_bf(ud.s7, h1.w, acc);
    acc = dot2_bf(ud.s8, h2.x, acc); acc = dot2_bf(ud.s9, h2.y, acc); acc = dot2_bf(ud.sa, h2.z, acc); acc = dot2_bf(ud.sb, h2.w, acc);
    acc = dot2_bf(ud.sc, h3.x, acc); acc = dot2_bf(ud.sd, h3.y, acc); acc = dot2_bf(ud.se, h3.z, acc); acc = dot2_bf(ud.sf, h3.w, acc);
    return acc;
}
__device__ const unsigned char g_cab[64] = {0, 1, 2, 3, 4, 5, 6, 7, 8, 9, 10, 11, 12, 13, 14, 15, 16, 17, 18, 19, 20, 21, 22, 23, 32, 33, 34, 35, 36, 48, 49, 50, 51, 64, 65, 66, 80, 81, 96, 97, 112, 113, 128, 144, 160, 176, 192, 208, 224, 240, 0, 0, 0, 0, 0, 0, 0, 0, 0, 0, 0, 0, 0, 0};
template <int PMODE = 0> __device__ __forceinline__ void phase10_peer(Frame& F) {
    F.lane = lane_now(); F.tid = F.wave * 64 + F.lane;
    const bf16_t* sub = (const bf16_t*)(F.ws + WS_SUB); const bf16_t* h2 = (const bf16_t*)(F.ws + WS_H2);
    const unsigned char* pu = F.ws + WS_PU; unsigned* pairs = (unsigned*)(F.ws + WS_PAIRS);
    const int gw = F.bid * 8 + F.wave, NGW = F.G * 8;
    unsigned char* wb = F.lds + F.wave * 19200;
    unsigned char* h2b = wb; unsigned short* gl16 = (unsigned short*)(wb + 16896); unsigned* hist = (unsigned*)(wb + 18944); unsigned* base = hist + 32;
    unsigned* tmp = (unsigned*)wb;
    unsigned* wls0 = (unsigned*)(F.ws + WS_WLS) + (size_t)gw * 1024;
    const int ntok = (MTOK - gw + NGW - 1) / NGW;
    const bool wgsync = (MTOK % (NGW * 8)) == 0;
    constexpr int CA[50] = {0,0,0,0,0,0,0,0,0,0,0,0,0,0,0,0, 1,1,1,1,1,1,1,1, 2,2,2,2,2, 3,3,3,3, 4,4,4, 5,5, 6,6, 7,7, 8,9,10,11,12,13,14,15};
    constexpr int CB[50] = {0,1,2,3,4,5,6,7,8,9,10,11,12,13,14,15, 0,1,2,3,4,5,6,7, 0,1,2,3,4, 0,1,2,3, 0,1,2, 0,1, 0,1, 0,1, 0,0,0,0,0,0,0,0};
    for (int p0 = 0; p0 < ntok; p0 += 8) {
        int lane = F.lane; asm volatile("" : "+v"(lane));
        const int nt = (ntok - p0) < 8 ? (ntok - p0) : 8;
        {
            u32x4 st[16];
#define SEL_LOAD(half) do { asm volatile("" : "+v"(lane)); const int srow_l = lane >> 4, scol = lane & 15; _Pragma("unroll") for (int it = 0; it < 16; ++it) { const int r_ = it * 4 + srow_l; int ti_ = r_ >> 3; ti_ = ti_ < nt ? ti_ : nt - 1; \
                st[it] = *(const u32x4*)(sub + (size_t)(gw + (p0 + ti_) * NGW) * 2048 + (r_ & 7) * 256 + (half) * 128 + scol * 8); } } while (0)
#define SEL_STORE() do { const int srow_l = lane >> 4, scol = lane & 15; _Pragma("unroll") for (int it = 0; it < 16; ++it) { unsigned char* d_ = wb + (it * 4 + srow_l) * 264 + scol * 16; \
                *(u32x2*)d_ = (u32x2){st[it].x, st[it].y}; *(u32x2*)(d_ + 8) = (u32x2){st[it].z, st[it].w}; } } while (0)
            unsigned tA[16], tB[16];
            SEL_LOAD(0); SEL_STORE();
            __builtin_amdgcn_sched_barrier(0);
            top16_row(wb + lane * 264, tA);
            __builtin_amdgcn_sched_barrier(0);
            asm volatile("" : "+v"(tA[0]), "+v"(tA[1]), "+v"(tA[2]), "+v"(tA[3]), "+v"(tA[4]), "+v"(tA[5]), "+v"(tA[6]), "+v"(tA[7]), "+v"(tA[8]), "+v"(tA[9]), "+v"(tA[10]), "+v"(tA[11]), "+v"(tA[12]), "+v"(tA[13]), "+v"(tA[14]), "+v"(tA[15]) :: "memory");
            SEL_LOAD(1); SEL_STORE();
            __builtin_amdgcn_sched_barrier(0);
            top16_row(wb + lane * 264, tB);
            __builtin_amdgcn_sched_barrier(0);
#undef SEL_LOAD
#undef SEL_STORE
            float vA[16], vB[16];
            { unsigned pa[4] = {0u, 0u, 0u, 0u}, pb[4] = {0u, 0u, 0u, 0u};
#pragma unroll
              for (int i = 0; i < 16; ++i) { vA[i] = key_val(tA[i]); vB[i] = key_val(tB[i]); pa[i >> 2] |= (127u - (tA[i] & 127u)) << (8 * (i & 3)); pb[i >> 2] |= (127u - (tB[i] & 127u)) << (8 * (i & 3)); }
              unsigned char* rp = wb + lane * 264;
              *(u32x2*)rp = (u32x2){pa[0], pa[1]}; *(u32x2*)(rp + 8) = (u32x2){pa[2], pa[3]}; *(u32x2*)(rp + 16) = (u32x2){pb[0], pb[1]}; *(u32x2*)(rp + 24) = (u32x2){pb[2], pb[3]}; }
            unsigned tk[16];
#pragma unroll
            for (int c = 0; c < 16; ++c) tk[c] = sum_key(vA[CA[c]] + vB[CB[c]], c);
            bsort16(tk);
#pragma unroll
            for (int grp = 1; grp < 3; ++grp) {
                unsigned sk[16];
#pragma unroll
                for (int e = 0; e < 16; ++e) { const int c = grp * 16 + e; sk[e] = sum_key(vA[CA[c]] + vB[CB[c]], c); }
                bsort16(sk);
#pragma unroll
                for (int i = 0; i < 16; ++i) tk[i] = tk[i] > sk[15 - i] ? tk[i] : sk[15 - i];
                bmerge16(tk);
            }
#pragma unroll
            for (int c = 48; c < 50; ++c) { unsigned k = sum_key(vA[CA[c]] + vB[CB[c]], c);
#pragma unroll
                for (int i = 0; i < 16; ++i) ce_k(tk[i], k); }
            const float s0 = sum_val(tk[0]); float ev[16], esum = 0.f;
#pragma unroll
            for (int r = 0; r < 16; ++r) { ev[r] = __expf(sum_val(tk[r]) - s0); esum += ev[r]; }
            const float einv = 1.0f / esum;
            unsigned eid[16];
            { const unsigned char* rp = wb + lane * 264;
#pragma unroll
              for (int r = 0; r < 16; ++r) { const unsigned cab = g_cab[63u - (tk[r] & 63u)]; eid[r] = (unsigned)rp[cab >> 4] * 128u + (unsigned)rp[16 + (cab & 15u)]; } }
            if ((lane >> 3) < nt) {
#pragma unroll
                for (int r = 0; r < 16; ++r) { const int e = lane * 16 + r; tmp[e] = ((unsigned)e << 14) | eid[r]; gl16[e] = (unsigned short)(cvt_pk_bf16(ev[r] * einv, 0.f) & 0xffffu); } }
        }
        asm volatile("" : "+v"(lane));
        const int ne = nt * 128;
        {
            if (lane < 32) hist[lane] = 0u;
            unsigned ent[16]; unsigned rk[16];
#pragma unroll
            for (int q = 0; q < 16; ++q) { const int e = q * 64 + lane; ent[q] = (e < ne) ? tmp[e] : 0u; rk[q] = (e < ne) ? atomicAdd(&hist[(ent[q] & 0x3FFFu) >> 9], 1u) : 0u; }
            { int hv = lane < 32 ? (int)hist[lane] : 0; int x = hv;
              x += __builtin_amdgcn_update_dpp(0, x, 0x111, 0xF, 0xF, true); x += __builtin_amdgcn_update_dpp(0, x, 0x112, 0xF, 0xF, true);
              x += __builtin_amdgcn_update_dpp(0, x, 0x114, 0xF, 0xF, true); x += __builtin_amdgcn_update_dpp(0, x, 0x118, 0xF, 0xF, true);
              const int t0 = __builtin_amdgcn_readlane(x, 15); if (lane >= 16) x += t0;
              if (lane < 32) base[lane] = (unsigned)(x - hv); }
#pragma unroll
            for (int q = 0; q < 16; ++q) { const int e = q * 64 + lane; if (e < ne) wls0[base[(ent[q] & 0x3FFFu) >> 9] + rk[q]] = ent[q]; }
        }
        asm volatile("s_waitcnt vmcnt(0)" ::: "memory");
        asm volatile("" : "+v"(lane));
        u32x4 hraw[8][4];
#pragma unroll
        for (int i = 0; i < 8; ++i) { const int ic = i < nt ? i : nt - 1; const bf16_t* hr = h2 + (size_t)(gw + (p0 + ic) * NGW) * 2048 + lane * 32;
#pragma unroll
            for (int q = 0; q < 4; ++q) hraw[i][q] = *(const u32x4*)(hr + q * 8); }
#pragma unroll
        for (int i = 0; i < 8; ++i) { if (i >= nt) break;
            f32x4 v[8]; float m = 0.f;
#pragma unroll
            for (int q = 0; q < 4; ++q) { unpack8(hraw[i][q], v[2 * q], v[2 * q + 1]); }
#pragma unroll
            for (int q = 0; q < 8; ++q)
#pragma unroll
                for (int k = 0; k < 4; ++k) m = fmaxf(m, __builtin_fabsf(v[q][k]));
            int sb = (int)((__float_as_uint(m * 1.0666667f) >> 23) & 0xFFu) - 2; sb = sb < 1 ? 1 : (sb > 253 ? 253 : sb);
            const float inv = __uint_as_float((unsigned)(254 - sb) << 23);
            u32x16 pk;
#pragma unroll
            for (int q = 0; q < 8; ++q) { const f32x4 a = v[q] * inv; pk[2 * q] = cvt_pk_bf16(a[0], a[1]); pk[2 * q + 1] = cvt_pk_bf16(a[2], a[3]); }
            const u32x6 p6 = __builtin_amdgcn_cvt_scalef32_pk32_fp6_bf16(__builtin_bit_cast(bf16x32, pk), 1.0f);
            const int lp = (lane >> 2) + 16 * (lane & 3);
            *(u32x4*)(h2b + i * 2048 + lp * 16) = (u32x4){p6[0], p6[1], p6[2], p6[3]};
            *(u32x4*)(h2b + i * 2048 + 1024 + lp * 16) = (u32x4){p6[4], p6[5], (unsigned)sb, 0u}; }
        if (PMODE != 1) {
            const int dg = lane >> 4, dc = lane & 15;
            const bool dv = (dc >> 2) == dg; const int dr = dc & 3;
            const float w0 = (dv && dr == 0) ? 1.f : 0.f, w1 = (dv && dr == 1) ? 1.f : 0.f, w2 = (dv && dr == 2) ? 1.f : 0.f, w3 = (dv && dr == 3) ? 1.f : 0.f;
            unsigned entn = __hip_atomic_load(wls0 + lane, __ATOMIC_RELAXED, __HIP_MEMORY_SCOPE_AGENT);
#define U_LOAD(WA, WB, srcent, i0_) do { _Pragma("unroll") for (int jj = 0; jj < 8; ++jj) { const unsigned en_ = (unsigned)__builtin_amdgcn_readlane((int)(srcent), (i0_) + jj); \
                const unsigned char* ur = pu + (size_t)(en_ & 0x3FFFu) * 1536; WA[jj] = *(const u32x4*)(ur + lane * 16); WB[jj] = *(const u32x2*)(ur + 1024 + lane * 8); } } while (0)
#define U_COMP(WA, WB, i0_) do { float pr[8]; \
                _Pragma("unroll") for (int jj = 0; jj < 8; ++jj) { const unsigned en_ = (unsigned)__builtin_amdgcn_readlane((int)ent64, (i0_) + jj); const unsigned char* hp = h2b + ((en_ >> 21) & 7u) * 2048 + lane * 16; \
                    const u32x4 b0 = *(const u32x4*)hp, b1 = *(const u32x4*)(hp + 1024); \
                    const pg8::i32x8 A = (pg8::i32x8){(int)WA[jj].x, (int)WA[jj].y, (int)WA[jj].z, (int)WA[jj].w, (int)WB[jj].x, (int)WB[jj].y, 0, 0}; \
                    const pg8::i32x8 B = (pg8::i32x8){(int)b0.x, (int)b0.y, (int)b0.z, (int)b0.w, (int)b1.x, (int)b1.y, 0, 0}; \
                    const f32x4 D = __builtin_amdgcn_mfma_scale_f32_16x16x128_f8f6f4(A, B, (f32x4){0.f, 0.f, 0.f, 0.f}, 2  , 2  , 0, 0x7F7F7F7F, 0, (int)b1.z); \
                    pr[jj] = w0 * D[0] + w1 * D[1] + w2 * D[2] + w3 * D[3]; } \
                  \
                _Pragma("unroll") for (int i = 0; i < 4; ++i) pr[i] = swap32_pair(pr[i], pr[i + 4]); \
                _Pragma("unroll") for (int i = 0; i < 2; ++i) pr[i] = swap16_pair(pr[i], pr[i + 2]); \
                const bool b3 = (lane & 8) != 0; \
                { const float snd = b3 ? pr[0] : pr[1], kp = b3 ? pr[1] : pr[0]; pr[0] = kp + dpp_f<DPP_ROR8>(snd); } \
                float tot = pr[0]; tot += dpp_f<DPP_XOR1>(tot); tot += dpp_f<DPP_XOR2>(tot); tot += dpp_f<DPP_HMIRROR>(tot); \
                keep = ((lane & 7) == ((i0_) >> 3)) ? tot : keep;           \
            } while (0)
            u32x4 wA0[8], wA1[8]; u32x2 wB0[8], wB1[8];
            U_LOAD(wA0, wB0, entn, 0);
#pragma unroll 1
            for (int c = 0; c < ne; c += 64) {
                if (wgsync && (c & 255) == 0) __syncthreads();
                const unsigned ent64 = entn;
                const bool more = c + 64 < ne;
                if (more) entn = __hip_atomic_load(wls0 + c + 64 + lane, __ATOMIC_RELAXED, __HIP_MEMORY_SCOPE_AGENT);
                float keep = 0.f;
#pragma unroll 1
                for (int i0 = 0; i0 < 64; i0 += 16) {
                    U_LOAD(wA1, wB1, ent64, i0 + 8);
                    U_COMP(wA0, wB0, i0);
                    if (i0 + 16 < 64) U_LOAD(wA0, wB0, ent64, i0 + 16); else if (more) U_LOAD(wA0, wB0, entn, 0);
                    U_COMP(wA1, wB1, i0 + 8);
                }
                {
                    const unsigned em = (unsigned)__shfl((int)ent64, 8 * (lane & 7) + (lane >> 3));
                    const int ti = (int)(em >> 21), j = (int)((em >> 14) & 127u), row = gw + (p0 + ti) * NGW;
                    const float cf = gelu_erf(keep * (1.0f / 96.0f)) * __uint_as_float((unsigned)gl16[(em >> 14) & 1023u] << 16);
                    pairs[((size_t)(row >> 6) * 128 + j) * 64 + (row & 63)] = (((unsigned)__builtin_bit_cast(unsigned short, (_Float16)cf) << 16) & 0xFFFE0000u) | ((em & 0x3FFFu) << 3);
                }
            }
#undef U_LOAD
#undef U_COMP
        }
    }
}

__device__ __forceinline__ void phase11_peer_v(Frame& F, float* dst) {
    F.lane = lane_now(); F.tid = F.wave * 64 + F.lane;
    const unsigned* pairs = (const unsigned*)(F.ws + WS_PAIRS); const float* mf = (const float*)(F.ws + WS_MODF); const bf16_t* x1b = (const bf16_t*)(F.ws + WS_X1B);
    unsigned long long* vs = (unsigned long long*)F.lds;
    for (int c0 = F.bid; c0 < DM / 8; c0 += F.G) {
        const int c = (c0 & 7) * 32 + (c0 >> 3);
        __syncthreads();
        { const u32x4* src = (const u32x4*)(F.ws + WS_PV + (size_t)c * NEXP * 8);
#pragma unroll 4
          for (int i = F.tid; i < NEXP * 8 / 16; i += 512) *(LAS u32x4*)(unsigned long long)(unsigned)(i * 16) = src[i]; }
        __syncthreads();
        typedef __fp16 h2_t __attribute__((__vector_size__(2 * sizeof(__fp16))));
#define P11_LOAD(dst, ptr) do { _Pragma("unroll") for (int jj = 0; jj < 16; ++jj) dst[jj] = (ptr)[jj * 64]; } while (0)
#define P11_FMA(A, X, C) asm("v_pk_fma_f16 %0, %1, %2, %0 op_sel:[0,1,0] op_sel_hi:[1,1,1]" : "+v"(C) : "v"(A), "v"(X))
#define P11_COMP(src) do { unsigned long long vv_[16]; \
                    _Pragma("unroll") for (int jj = 0; jj < 16; ++jj) vv_[jj] = *(const LAS unsigned long long*)(unsigned long long)(src[jj] & 0x1FFF8u);     \
                    __builtin_amdgcn_sched_barrier(0); \
                    _Pragma("unroll") for (int jj = 0; jj < 16; ++jj) { const int lo = (int)(unsigned)vv_[jj], hi = (int)(unsigned)(vv_[jj] >> 32); \
                    const h2_t c0_ = __builtin_amdgcn_cvt_scalef32_pk_f16_fp8(lo, 1.0f, false), c1_ = __builtin_amdgcn_cvt_scalef32_pk_f16_fp8(lo, 1.0f, true); \
                    const h2_t c2_ = __builtin_amdgcn_cvt_scalef32_pk_f16_fp8(hi, 1.0f, false), c3_ = __builtin_amdgcn_cvt_scalef32_pk_f16_fp8(hi, 1.0f, true); \
                    P11_FMA(c0_, src[jj], acc[0]); P11_FMA(c1_, src[jj], acc[1]); P11_FMA(c2_, src[jj], acc[2]); P11_FMA(c3_, src[jj], acc[3]); } } while (0)
#define P11_COMPX(src) do { unsigned long long vv_[16]; \
                    _Pragma("unroll") for (int jj = 0; jj < 16; ++jj) vv_[jj] = *(const LAS unsigned long long*)(unsigned long long)(src[jj] & 0x1FFF8u); \
                    __builtin_amdgcn_sched_barrier(0); \
                    _Pragma("unroll") for (int jj = 0; jj < 16; ++jj) { const int lo = (int)(unsigned)vv_[jj], hi = (int)(unsigned)(vv_[jj] >> 32); \
                    P11_FMA(lo, src[jj], acc[0]); P11_FMA(hi, src[jj], acc[1]); P11_FMA(lo, src[jj], acc[2]); P11_FMA(hi, src[jj], acc[3]); } } while (0)
        int lane = F.lane; asm volatile("" : "+v"(lane));
        unsigned pa[16], pb[16];
        f32x4 x0, x1;
        { const unsigned* pp = pairs + (size_t)F.wave * 128 * 64 + lane; P11_LOAD(pa, pp);
          unpack8(*(const u32x4*)(x1b + (size_t)(F.wave * 64 + lane) * 2048 + c * 8), x0, x1); }
        for (int tile = F.wave; tile < MTOK / 64; tile += 8) {
            const unsigned* pp = pairs + (size_t)tile * 128 * 64 + lane;
            const int ntile = tile + 8 < MTOK / 64 ? tile + 8 : tile;
            const unsigned* npp = pairs + (size_t)ntile * 128 * 64 + lane;
            const int row = tile * 64 + lane;
            const float* gt2 = mf + (size_t)(tile / (SEQ / 64)) * 12288 + 10240 + c * 8;
            float* op = dst + (size_t)row * 2048 + c * 8;
            const f32x4 g0 = *(const f32x4*)gt2 * 0.25f, g1 = *(const f32x4*)(gt2 + 4) * 0.25f;
            h2_t acc[4];
#pragma unroll
            for (int i = 0; i < 4; ++i) acc[i] = (h2_t){(__fp16)0.f, (__fp16)0.f};
            u32x4 nxr = (u32x4){0u, 0u, 0u, 0u};
#pragma unroll 1
            for (int j0 = 0; j0 < 128; j0 += 32) {
                P11_LOAD(pb, pp + (j0 + 16) * 64);
                P11_COMP(pa);
                const bool lastb = j0 + 32 >= 128;
                { const unsigned* np_ = lastb ? npp : pp + (j0 + 32) * 64; P11_LOAD(pa, np_); }
                if (lastb) nxr = *(const u32x4*)(x1b + (size_t)(ntile * 64 + lane) * 2048 + c * 8);
                P11_COMP(pb);
            }
#if PROBE_P11X == 1 || PROBE_P11X == 3
            { h2_t sv[4]; for (int i = 0; i < 4; ++i) sv[i] = acc[i];
#pragma unroll 1
              for (int j0 = 0; j0 < 128; j0 += 32) {
#pragma unroll
                for (int jj = 0; jj < 16; ++jj) { asm volatile("" : "+v"(pa[jj])); asm volatile("" : "+v"(pb[jj])); }
#if PROBE_P11X == 1
                P11_COMP(pa); P11_COMP(pb);
#else
                P11_COMPX(pa); P11_COMPX(pb);
#endif
              }
              asm volatile("" :: "v"(acc[0]), "v"(acc[1]), "v"(acc[2]), "v"(acc[3])); for (int i = 0; i < 4; ++i) acc[i] = sv[i]; }
#endif
            *(f32x4*)op = x0 + g0 * (f32x4){(float)acc[0][0], (float)acc[0][1], (float)acc[1][0], (float)acc[1][1]};
            *(f32x4*)(op + 4) = x1 + g1 * (f32x4){(float)acc[2][0], (float)acc[2][1], (float)acc[3][0], (float)acc[3][1]};
            unpack8(nxr, x0, x1);
        }
#undef P11_LOAD
#undef P11_COMP
#undef P11_FMA
    }
}

__global__ void __launch_bounds__(512, 2) fwd_kernel(Args args) {
    extern __shared__ __attribute__((aligned(16))) unsigned char lds[];
    Frame F;
    F.lds = lds; F.ws = args.ws; F.tid = threadIdx.x; F.lane = F.tid & 63; F.wave = __builtin_amdgcn_readfirstlane(F.tid >> 6); F.G = gridDim.x; F.bid = blockIdx.x;
    F.x = args.in[0]; F.c = args.in[1]; F.w_ada = args.in[2]; F.b_ada = args.in[3]; F.g1 = args.in[4]; F.g2 = args.in[5]; F.w_in = args.in[6]; F.g_q = args.in[7]; F.g_k = args.in[8];
    F.rel_bias = args.in[9]; F.pool_w = args.in[10]; F.pool_scale = args.in[11]; F.w_ab = args.in[12]; F.w_pb = args.in[13]; F.w_out = args.in[14]; F.w_pq = args.in[15];
    F.peer_keys = args.in[16]; F.peer_u = args.in[17]; F.peer_v = args.in[18]; F.out = args.out;
    LAS unsigned char* ldsl = (LAS unsigned char*)lds;
    volatile LAS unsigned* misc = (volatile LAS unsigned*)(ldsl + MISC_OFF);
    if (F.tid < 4) misc[F.tid] = 0u;
    __syncthreads();
    unsigned* barw = (unsigned*)(args.ws + WS_CTL) + (size_t)args.li * XCD_BAR_WORDS;
    XcdBarrier bar; bar.bar = barw; bar.x = 0; bar.st = misc;
    const int lo = args.ph_lo, hi = args.ph_hi;
    if (hi - lo > 1) bar = xcd_barrier_post(barw, misc);
#define IN(k) (lo <= (k) && (k) < hi)
#define SEAM(k) do { if (IN(k) && IN((k) + 1)) xcd_barrier(bar, F.wave); } while (0)
    bf16_t* R0 = (bf16_t*)(F.ws + WS_R0);

#define PH2_BODY { \
        { pg8::Gemm g{(const bf16_t*)(F.ws + WS_H1F8), (const bf16_t*)(F.ws + WS_WIN8), MTOK, 5632, DM / 2, DM / 2, 0, nullptr, nullptr, 0, 0}; pg8::StaticOrder S; S.init(MTOK, 5632, F.G, F.bid); \
          EpiInproj<true> E{(bf16_t*)(F.ws + WS_QN), (bf16_t*)(F.ws + WS_KN), (bf16_t*)(F.ws + WS_V), (bf16_t*)(F.ws + WS_IQ), (bf16_t*)(F.ws + WS_IK), (bf16_t*)(F.ws + WS_PL), \
                    (bf16_t*)(F.ws + WS_GA), (bf16_t*)(F.ws + WS_GP), (float*)(F.ws + WS_IW)}; \
          pg8::gemm_phase<EpiInproj<true>, true>(ldsl, g, S, E, F.wave); } \
        { pg8::Gemm g{R0, (const bf16_t*)(F.ws + WS_WIN16), MTOK, 2304, DM, DM, 0, nullptr, nullptr, 0, 0}; pg8::StaticOrder S; S.init(MTOK, 2304, F.G, F.bid); \
          EpiInproj<false> E{(bf16_t*)(F.ws + WS_QN), (bf16_t*)(F.ws + WS_KN), (bf16_t*)(F.ws + WS_V), (bf16_t*)(F.ws + WS_IQ), (bf16_t*)(F.ws + WS_IK), (bf16_t*)(F.ws + WS_PL), \
                    (bf16_t*)(F.ws + WS_GA), (bf16_t*)(F.ws + WS_GP), (float*)(F.ws + WS_IW)}; \
          pg8::gemm_phase<EpiInproj<false>>(ldsl, g, S, E, F.wave); } }
#define PH3_BODY { phase3_pooled(F); phase3_indexer(F); __syncthreads(); }
#define PH4_BODY { \
        phase4_attention(F); \
        __syncthreads(); \
        pg8::Gemm g{(const bf16_t*)(F.ws + WS_POOLED), (const bf16_t*)(F.ws + WS_POOLW), MTOK, PW, 256, 1024, 256, nullptr, nullptr, 0, 0}; pg8::StaticOrder S; S.init(MTOK, PW, F.G, F.bid); \
        EpiF8Scale E{F.ws + WS_POOL2, 1024, F.pool_scale}; \
        pg8::gemm_phase<EpiF8Scale>(ldsl, g, S, E, F.wave); }
#define PH5_BODY { \
        pg8::Gemm g{(const bf16_t*)(F.ws + WS_ATTN), (const bf16_t*)(F.ws + WS_WAB), MTOK, DM, 1024, 512, 0, (const bf16_t*)(F.ws + WS_POOL2), (const bf16_t*)(F.ws + WS_WPB), 8, 512};     \
        pg8::StaticOrder S; S.init(MTOK, DM, F.G, F.bid); \
        EpiMerge E{(unsigned char*)R0, (const bf16_t*)(F.ws + WS_GA), (const bf16_t*)(F.ws + WS_GP)}; pg8::gemm_phase<EpiMerge, true>(ldsl, g, S, E, F.wave); }
#define PH6_BODY { \
        pg8::Gemm g{R0, (const bf16_t*)(F.ws + WS_WOUT), MTOK, DM, DM / 2, DM / 2, 0, nullptr, nullptr, 0, 0}; pg8::StaticOrder S; S.init(MTOK, DM, F.G, F.bid); \
        EpiResidB E{F.x, (bf16_t*)(F.ws + WS_X1B), (const float*)(F.ws + WS_MODF) + 4096}; pg8::gemm_phase<EpiResidB, true>(ldsl, g, S, E, F.wave); }
#define PH8_BODY { \
        pg8::Gemm g{(const bf16_t*)(F.ws + WS_H2), (const bf16_t*)(F.ws + WS_WPQ), MTOK, DM, DM, DM, 0, nullptr, nullptr, 0, 0}; pg8::StaticOrder S; S.init(MTOK, DM, F.G, F.bid); \
        EpiBf16Scale E{R0, 2048, nullptr}; pg8::gemm_phase<EpiBf16Scale>(ldsl, g, S, E, F.wave); }
#define PH9_BODY { \
        pg8::Gemm g{R0, (const bf16_t*)(F.ws + WS_KEYSBD), MTOK, DM, 256, DM, 256, nullptr, nullptr, 0, 0}; pg8::StaticOrder S; S.init(MTOK, DM, F.G, F.bid); \
        EpiBf16Scale E{(bf16_t*)(F.ws + WS_SUB), 2048, nullptr}; pg8::gemm_phase<EpiBf16Scale>(ldsl, g, S, E, F.wave); }
#define REP(k) if constexpr (((PROBE_REP) >> (k)) & 1)

    if (IN(0)) { phase0_prep(F); REP(0) { __syncthreads(); phase0_prep(F); } }
    SEAM(0);
    if (IN(1)) { phase_modnorm<true>(F, F.x, F.g1, 0, 2048, R0, F.ws + WS_H1F8); REP(1) { phase_modnorm<true>(F, F.x, F.g1, 0, 2048, R0, F.ws + WS_H1F8); } }
    SEAM(1);
    if (IN(2)) { PH2_BODY REP(2) PH2_BODY }
    SEAM(2);
    if (IN(3)) { phase3_qknorm(F); PH3_BODY REP(3) PH3_BODY }
    SEAM(3);
    if (IN(4)) { PH4_BODY REP(4) PH4_BODY }
    SEAM(4);
    if (IN(5)) { PH5_BODY REP(5) PH5_BODY }
    SEAM(5);
    if (IN(6)) { PH6_BODY REP(6) PH6_BODY }
    SEAM(6);
    if (IN(7)) { phase_modnorm<false>(F, (const float*)(F.ws + WS_X1B), F.g2, 6144, 8192, (bf16_t*)(F.ws + WS_H2)); REP(7) { phase_modnorm<false>(F, (const float*)(F.ws + WS_X1B), F.g2, 6144, 8192, (bf16_t*)(F.ws + WS_H2)); } }
    SEAM(7);
    if (IN(8)) { PH8_BODY REP(8) PH8_BODY }
    SEAM(8);
    if (IN(9)) { PH9_BODY REP(9) PH9_BODY }
    SEAM(9);
    if (IN(10)) { phase10_peer(F); REP(10) phase10_peer<PROBE_P10M>(F); }
    SEAM(10);
    if (IN(11)) { REP(11) { phase11_peer_v(F, (float*)(F.ws + WS_SUB)); } phase11_peer_v(F, F.out); }
#undef IN
#undef SEAM
}

extern "C" void kernel_launch(void* const* d_in, const int* in_sizes, int n_in, void* d_out, int out_size, void* d_ws, size_t ws_size, hipStream_t stream) {
    static int grid = 0;
    if (grid == 0) {
        if (n_in != 19 || out_size != MTOK * DM || ws_size < WS_END) { fprintf(stderr, "kernel_launch: unexpected shapes (n_in %d out %d ws %zu)\n", n_in, out_size, ws_size); grid = -1; return; }
        int dev = 0, cus = 0, per_cu = 0;
        if (hipGetDevice(&dev) != hipSuccess || hipDeviceGetAttribute(&cus, hipDeviceAttributeMultiprocessorCount, dev) != hipSuccess) { grid = -1; return; }
        if (hipFuncSetAttribute((const void*)fwd_kernel, hipFuncAttributeMaxDynamicSharedMemorySize, LDS_BYTES) != hipSuccess) { fprintf(stderr, "kernel_launch: hipFuncSetAttribute failed\n"); grid = -1; return; }
        if (hipOccupancyMaxActiveBlocksPerMultiprocessor(&per_cu, (const void*)fwd_kernel, 512, LDS_BYTES) != hipSuccess || per_cu < 1) { fprintf(stderr, "kernel_launch: occupancy query says %d\n", per_cu); }
        (void)hipGetLastError();
        grid = cus;
    }
    if (grid < 0) return;
    (void)in_sizes;
    if (hipMemsetAsync((char*)d_ws + WS_CTL, 0, CTL_ZERO_BYTES, stream) != hipSuccess) return;
    Args a{};
    for (int i = 0; i < 19; ++i) a.in[i] = (const float*)d_in[i];
    a.out = (float*)d_out; a.ws = (unsigned char*)d_ws;
#if MK_PER_PHASE
    for (int p = 0; p < NPHASE; ++p) { a.ph_lo = p; a.ph_hi = p + 1; a.li = p; hipLaunchKernelGGL(fwd_kernel, dim3(grid), dim3(512), LDS_BYTES, stream, a); }
#else
    a.ph_lo = 0; a.ph_hi = NPHASE; a.li = 0;
    hipLaunchKernelGGL(fwd_kernel, dim3(grid), dim3(512), LDS_BYTES, stream, a);
#endif
}
```

```cpp
#include <hip/hip_runtime.h>
#include <cstdio>
#include <cstdint>

#ifndef MK_PER_PHASE
#define MK_PER_PHASE 0
#endif

#ifndef PROBE_REP
#define PROBE_REP 0
#endif
#ifndef PROBE_IDX
#define PROBE_IDX 0
#endif
#ifndef PROBE_P10M
#define PROBE_P10M 0
#endif
#ifndef PROBE_P11X
#define PROBE_P11X 0
#endif
#define LAS __attribute__((address_space(3)))
typedef unsigned short bf16_t;
typedef short bf16x8 __attribute__((ext_vector_type(8)));
typedef float f32x4 __attribute__((ext_vector_type(4)));
typedef float f32x2 __attribute__((ext_vector_type(2)));
typedef int v2i __attribute__((ext_vector_type(2)));
typedef unsigned u32x4 __attribute__((ext_vector_type(4)));
typedef unsigned u32x2 __attribute__((ext_vector_type(2)));
typedef unsigned u32x6 __attribute__((ext_vector_type(6)));
typedef unsigned u32x16 __attribute__((ext_vector_type(16)));
typedef __bf16 bf16x32 __attribute__((ext_vector_type(32)));

constexpr int BATCH = 8, SEQ = 4096, DM = 2048, MTOK = BATCH * SEQ;
constexpr int NHEAD = 8, HDIM = 128, AW = 1024, KVW = 256, IHEADS = 16, IDIM = 64, KSEL = 256;
constexpr int PW = 1024, PHEADS = 8, NEXP = 16384;
constexpr int INW = 7760;
constexpr float EPS = 1e-6f;
constexpr int NPHASE = 12;

constexpr size_t MiB = 1u << 20;
constexpr size_t WS_CTL = 0, CTL_ZERO_BYTES = 256 * 1024;
constexpr size_t WS_MODP = 2 * MiB;
constexpr size_t WS_MODF = 4 * MiB;
constexpr size_t WS_POOLW = 5 * MiB;
constexpr size_t WS_KEYSBD = 6 * MiB;
constexpr size_t WS_WIN16 = 8 * MiB;
constexpr size_t WS_WIN8 = 20 * MiB;
constexpr size_t WS_WPBT16 = 52 * MiB;
constexpr size_t WS_W2 = 12 * MiB;
constexpr size_t WS_WAB = 40 * MiB, WS_WPB = 44 * MiB, WS_WOUT = 48 * MiB, WS_WPQ = 56 * MiB;
constexpr size_t WS_PU = 64 * MiB, WS_PV = 128 * MiB;
constexpr size_t WS_R0 = 192 * MiB;
constexpr size_t WS_GA = 320 * MiB, WS_GP = 448 * MiB;
constexpr size_t WS_SUB = 320 * MiB;
constexpr size_t WS_QN = 576 * MiB;
constexpr size_t WS_IQ = 640 * MiB;
constexpr size_t WS_PL = 704 * MiB;
constexpr size_t WS_KN = 768 * MiB, WS_V = 784 * MiB;
constexpr size_t WS_IK = 800 * MiB;
constexpr size_t WS_IW = 804 * MiB;
constexpr size_t WS_SEL = 806 * MiB;
constexpr size_t WS_POOLED = 822 * MiB;
constexpr size_t WS_H2 = 886 * MiB;
constexpr size_t WS_END = 1014 * MiB;
constexpr size_t WS_H1F8 = WS_H2 + 64 * MiB;
constexpr size_t WS_Q8 = WS_H2, WS_K8 = WS_H2 + 32 * MiB, WS_V8 = WS_H2 + 40 * MiB;
constexpr size_t WS_X1B = WS_IQ;
constexpr size_t WS_ATTN = WS_IQ, WS_POOL2 = WS_PL, WS_PAIRS = WS_QN, WS_WLS = WS_QN + 32 * MiB;

constexpr int LDS_BYTES = 160 * 1024;
constexpr int MISC_OFF = 159 * 1024;

__device__ __forceinline__ unsigned cvt_pk_bf16(float lo, float hi) { unsigned r; asm volatile("v_cvt_pk_bf16_f32 %0, %1, %2" : "=v"(r) : "v"(lo), "v"(hi)); return r; }
__device__ __forceinline__ float bf_lo(unsigned w) { return __uint_as_float(w << 16); }
__device__ __forceinline__ float bf_hi(unsigned w) { return __uint_as_float(w & 0xffff0000u); }
template <int CTRL> __device__ __forceinline__ float dpp_f(float x) { return __int_as_float(__builtin_amdgcn_update_dpp(0, __float_as_int(x), CTRL, 0xF, 0xF, true)); }
#define DPP_XOR1 0xB1
#define DPP_XOR2 0x4E
#define DPP_HMIRROR 0x141
#define DPP_MIRROR 0x140
#define DPP_ROR8 0x128
__device__ __forceinline__ float xor16_sum(float x) { const auto r = __builtin_amdgcn_permlane16_swap(__float_as_uint(x), __float_as_uint(x), false, false); return __uint_as_float(r[0]) + __uint_as_float(r[1]); }
__device__ __forceinline__ float xor32_sum(float x) { const auto r = __builtin_amdgcn_permlane32_swap(__float_as_uint(x), __float_as_uint(x), false, false); return __uint_as_float(r[0]) + __uint_as_float(r[1]); }
__device__ __forceinline__ float xor16_max(float x) { const auto r = __builtin_amdgcn_permlane16_swap(__float_as_uint(x), __float_as_uint(x), false, false); return fmaxf(__uint_as_float(r[0]), __uint_as_float(r[1])); }
__device__ __forceinline__ float swap32_pair(float a, float b) { const auto r = __builtin_amdgcn_permlane32_swap(__float_as_uint(a), __float_as_uint(b), false, false); return __uint_as_float(r[0]) + __uint_as_float(r[1]); }
__device__ __forceinline__ float swap16_pair(float a, float b) { const auto r = __builtin_amdgcn_permlane16_swap(__float_as_uint(a), __float_as_uint(b), false, false); return __uint_as_float(r[0]) + __uint_as_float(r[1]); }
__device__ __forceinline__ float row_sum16(float v) { v += dpp_f<DPP_XOR1>(v); v += dpp_f<DPP_XOR2>(v); v += dpp_f<DPP_HMIRROR>(v); v += dpp_f<DPP_MIRROR>(v); return v; }
__device__ __forceinline__ float row_max16(float v) { v = fmaxf(v, dpp_f<DPP_XOR1>(v)); v = fmaxf(v, dpp_f<DPP_XOR2>(v)); v = fmaxf(v, dpp_f<DPP_HMIRROR>(v)); v = fmaxf(v, dpp_f<DPP_MIRROR>(v)); return v; }
__device__ __forceinline__ float wave_sum(float v) { return xor32_sum(xor16_sum(row_sum16(v))); }
__device__ __forceinline__ float sigmoidf_(float x) { return __builtin_amdgcn_rcpf(1.0f + __expf(-x)); }
__device__ __forceinline__ float dot8(u32x4 w, const float* h) {
    return bf_lo(w.x) * h[0] + bf_hi(w.x) * h[1] + bf_lo(w.y) * h[2] + bf_hi(w.y) * h[3] + bf_lo(w.z) * h[4] + bf_hi(w.z) * h[5] + bf_lo(w.w) * h[6] + bf_hi(w.w) * h[7];
}

__device__ __forceinline__ int lane_now() { int l; asm volatile("v_mbcnt_lo_u32_b32 %0, -1, 0\n\tv_mbcnt_hi_u32_b32 %0, -1, %0" : "=v"(l)); return l; }

#define XB_TMO      128
#define XB_XCNT(j)  (256  + 64 * (j))
#define XB_XSUB(j)  (1280 + 64 * (j))
#define XB_XGEN(j)  (2304 + 64 * (j))
#define XB_TOP      3328
#define XB_TOPGEN   3392
#define XCD_BAR_WORDS 3456
#define XB_SPIN_CAP (1u << 18)

__device__ __forceinline__ unsigned xb_ld(unsigned* p)              { return __hip_atomic_load(p, __ATOMIC_RELAXED, __HIP_MEMORY_SCOPE_AGENT); }
__device__ __forceinline__ unsigned xb_add(unsigned* p, unsigned v) { return __hip_atomic_fetch_add(p, v, __ATOMIC_RELAXED, __HIP_MEMORY_SCOPE_AGENT); }
__device__ __forceinline__ unsigned xb_xcc_id() { return (unsigned)__builtin_amdgcn_s_getreg((3 << 11) | 20) & 0xFu; }
#define XB_SPIN(cond, bar) do { unsigned _sp = 0; while (cond) { __builtin_amdgcn_s_sleep(1); \
    if ((++_sp & 255u) == 0u) { if (xb_ld(&(bar)[XB_TMO])) break; if (_sp > XB_SPIN_CAP) { atomicAdd(&(bar)[XB_TMO], 1u); break; } } } } while (0)

struct XcdBarrier { unsigned* bar; unsigned x; volatile LAS unsigned* st; };

__device__ __forceinline__ XcdBarrier xcd_barrier_post(unsigned* bar, volatile LAS unsigned* st) {
    XcdBarrier b; b.bar = bar; b.x = xb_xcc_id(); b.st = st;
    if (threadIdx.x == 0) (void)xb_add(&bar[XB_XCNT(b.x)], 1u);
    return b;
}
__device__ __forceinline__ void xcd_barrier_complete(unsigned* bar, unsigned x, unsigned& nloc, unsigned& nx) {
    const unsigned G = gridDim.x * gridDim.y * gridDim.z;
    unsigned sum, cnt, mine, sp = 0u;
    for (;;) {
        sum = 0u; cnt = 0u; mine = 0u;
#pragma unroll
        for (unsigned j = 0; j < 16; ++j) { const unsigned c = xb_ld(&bar[XB_XCNT(j)]); sum += c; cnt += (c > 0u) ? 1u : 0u; mine = (j == x) ? c : mine; }
        if (sum == G) break;
        __builtin_amdgcn_s_sleep(1);
        if ((++sp & 255u) == 0u) { if (xb_ld(&bar[XB_TMO])) break; if (sp > XB_SPIN_CAP) { atomicAdd(&bar[XB_TMO], 1u); break; } }
    }
    nloc = mine > 0u ? mine : 1u; nx = cnt > 0u ? cnt : 1u;
}
__device__ __forceinline__ void xcd_barrier(const XcdBarrier& b, int wave) {
    asm volatile("s_waitcnt vmcnt(0)" ::: "memory");
    __syncthreads();
    if (wave == 0 && lane_now() == 0) {
        unsigned* bar = b.bar;
        __builtin_amdgcn_s_waitcnt(0);
        unsigned nloc = b.st[0], nx = b.st[1];
        if (nloc == 0u) { xcd_barrier_complete(bar, b.x, nloc, nx); b.st[0] = nloc; b.st[1] = nx; }
        const unsigned old = xb_add(&bar[XB_XSUB(b.x)], 1u);
        const unsigned gen = old / nloc;
        if (old + 1u == (gen + 1u) * nloc) {
            __builtin_amdgcn_fence(__ATOMIC_RELEASE, "agent");
            asm volatile("s_waitcnt vmcnt(0)" ::: "memory");
            const unsigned og = xb_add(&bar[XB_TOP], 1u);
            const unsigned tg = og / nx;
            if (og + 1u == (tg + 1u) * nx) xb_add(&bar[XB_TOPGEN], 1u);
            else XB_SPIN(xb_ld(&bar[XB_TOPGEN]) == tg, bar);
            __builtin_amdgcn_fence(__ATOMIC_ACQUIRE, "agent");
            xb_add(&bar[XB_XGEN(b.x)], 1u);
            asm volatile("s_waitcnt vmcnt(0)" ::: "memory");
        } else {
            XB_SPIN(xb_ld(&bar[XB_XGEN(b.x)]) == gen, bar);
            __builtin_amdgcn_fence(__ATOMIC_ACQUIRE, "agent");
            asm volatile("s_waitcnt vmcnt(0)" ::: "memory");
        }
    }
    __syncthreads();
}

namespace pg8 {
constexpr int BM = 256, BK = 64, HALF = 128, HTB = HALF * BK * 2, STAGE_BYTES = 8 * HTB, NXCD = 8, WGM = 8;
__device__ __forceinline__ int lds_byte(int r, int c) { const int st = (r >> 4) * 2 + (c >> 5), rr = r & 15, cc = c & 31, ob = rr * 64 + cc * 2; return st * 1024 + (ob ^ (((ob >> 9) & 1) << 5)); }
__device__ __forceinline__ void stage_rc(int b, int& R, int& C) { const int st = b / 1024, sb = b % 1024, swz = sb ^ (((sb >> 9) & 1) << 5); R = (st >> 1) * 16 + swz / 64; C = (st & 1) * 32 + (swz % 64) / 2; }
__device__ __forceinline__ int perm32(int rho) { const int n = rho >> 4, i = rho & 15; return 8 * (i >> 2) + 4 * n + (i & 3); }

struct Unit { int pm, pn; };
struct Gemm { const bf16_t* A; const bf16_t* Bt; int M, N, K, lda, a_pn_off; const bf16_t* A2; const bf16_t* Bt2; int ksplit, ldb, b_pm_off; };

struct StaticOrder {
    int nM, nN, nwg, G, c;
    __device__ void init(int M, int N, int G_, int c_) { nM = M / BM; nN = N / BM; nwg = nM * nN; G = G_; c = c_; }
    __device__ bool next(int i, Unit& u) const {
        const long L = (long)i * G + c; if (L >= nwg) return false;
        int wgid = (int)L; { const int q = nwg / NXCD, r = nwg % NXCD, xcd = wgid % NXCD, off = wgid / NXCD; wgid = (xcd < r ? xcd * (q + 1) : r * (q + 1) + (xcd - r) * q) + off; }
        const int nig = WGM * nN, gid = wgid / nig, fm = gid * WGM, gsz = (nM - fm) < WGM ? (nM - fm) : WGM;
        u.pm = fm + ((wgid % nig) % gsz); u.pn = (wgid % nig) / gsz; return true;
    }
};

typedef int i32x4 __attribute__((ext_vector_type(4)));
typedef int i32x8 __attribute__((ext_vector_type(8)));
__device__ __forceinline__ bf16x8 lo8(i32x8 v) { return __builtin_bit_cast(bf16x8, (i32x4){v.s0, v.s1, v.s2, v.s3}); }
__device__ __forceinline__ bf16x8 hi8(i32x8 v) { return __builtin_bit_cast(bf16x8, (i32x4){v.s4, v.s5, v.s6, v.s7}); }
__device__ __forceinline__ i32x8 cat8(bf16x8 a, bf16x8 b) { const i32x4 x = __builtin_bit_cast(i32x4, a), y = __builtin_bit_cast(i32x4, b); return (i32x8){x.x, x.y, x.z, x.w, y.x, y.y, y.z, y.w}; }
template <class Epi, bool F8 = false>
__device__ __forceinline__ void gemm_phase(LAS unsigned char* lds, const Gemm g, const StaticOrder& S, const Epi& E, int wave) {
    const int lane = lane_now(), wid = wave, tid = wid * 64 + lane, wr = wid >> 2, wc = wid & 3, fr = lane & 15, fq = lane >> 4;
    const int K = g.K, nt = K / BK, lda = g.lda, ldb = g.ldb ? g.ldb : g.K, ksplit = g.ksplit;
    unsigned voffA, voffB;
    { int R, C; stage_rc(tid * 16, R, C); const int Rb = Epi::PERM ? ((R & ~31) + perm32(R & 31)) : R;
      voffA = (unsigned)(R * lda + C) * 2u; voffB = (unsigned)(Rb * ldb + C) * 2u; }
    const unsigned stepA = 64u * (unsigned)lda * 2u, stepB = 64u * (unsigned)ldb * 2u;
    const size_t kstep = (size_t)(BK * 2);
    const size_t hsA = (size_t)HALF * lda * 2, hsB = (size_t)HALF * ldb * 2;
    const size_t tsA = 2 * hsA, tsB = 2 * hsB;
    const unsigned ldsw = (unsigned)wid * 1024u, ldsbase = (unsigned)(unsigned long long)lds;
    const int aoff = lds_byte(wr * 64 + fr, fq * 8), boff = lds_byte(wc * 32 + fr, fq * 8);
#define PG8_SA(b, h) (((b) * 2 + (h)) * HTB)
#define PG8_SB(b, h) ((4 + (b) * 2 + (h)) * HTB)
#define PG8_STAGE(bufoff, gbase, voff) do { _Pragma("unroll") for (int _i = 0; _i < 2; ++_i) { \
        const char* sb_ = (const char*)(gbase) + (size_t)_i * PG8_STEP_##voff; const unsigned m0_ = ldsbase + (unsigned)(bufoff) + ldsw + (unsigned)_i * 8192u; \
        asm volatile("s_mov_b32 m0, %2\n\ts_nop 0\n\tglobal_load_lds_dwordx4 %0, %1" :: "v"(voff), "s"(sb_), "s"(m0_) : "memory"); } } while (0)
#define PG8_STEP_voffA stepA
#define PG8_STEP_voffB stepB
#define PG8_LDA(dst, b, h) do { _Pragma("unroll") for (int m = 0; m < 4; ++m) dst[m] = cat8(*(const LAS bf16x8*)(lds + PG8_SA(b, h) + aoff + m * 2048), *(const LAS bf16x8*)(lds + PG8_SA(b, h) + aoff + m * 2048 + 1024)); } while (0)
#define PG8_LDB(dst, b, h) do { _Pragma("unroll") for (int n = 0; n < 2; ++n) dst[n] = cat8(*(const LAS bf16x8*)(lds + PG8_SB(b, h) + boff + n * 2048), *(const LAS bf16x8*)(lds + PG8_SB(b, h) + boff + n * 2048 + 1024)); } while (0)
#define PG8_MMA(ai, bj, At, Bt) do { __builtin_amdgcn_s_setprio(1); _Pragma("unroll") for (int m = 0; m < 4; ++m) _Pragma("unroll") for (int n = 0; n < 2; ++n) { \
        if constexpr (F8) acc[ai][bj][m][n] = __builtin_amdgcn_mfma_scale_f32_16x16x128_f8f6f4(Bt[n], At[m], acc[ai][bj][m][n], 0, 0, 0, 0x7D7D7D7D  , 0, 0x7D7D7D7D); \
        else { acc[ai][bj][m][n] = __builtin_amdgcn_mfma_f32_16x16x32_bf16(lo8(Bt[n]), lo8(At[m]), acc[ai][bj][m][n], 0, 0, 0); \
               acc[ai][bj][m][n] = __builtin_amdgcn_mfma_f32_16x16x32_bf16(hi8(Bt[n]), hi8(At[m]), acc[ai][bj][m][n], 0, 0, 0); } } \
        __builtin_amdgcn_s_setprio(0); } while (0)
#define PG8_WAIT_V(n) asm volatile("s_waitcnt vmcnt(" #n ")" ::: "memory")
#define PG8_WAIT_L(n) asm volatile("s_waitcnt lgkmcnt(" #n ")" ::: "memory")
#define PG8_BAR __builtin_amdgcn_s_barrier()
#define PG8_SCHED __builtin_amdgcn_sched_barrier(0)
    Unit cur, nxt; int ui = 0;
    if (!S.next(0, cur)) return;
    f32x4 acc[2][2][4][2];
#pragma unroll
    for (int a = 0; a < 2; ++a)
#pragma unroll
        for (int b = 0; b < 2; ++b)
#pragma unroll
            for (int m = 0; m < 4; ++m)
#pragma unroll
                for (int n = 0; n < 2; ++n) acc[a][b][m][n] = (f32x4){0.f, 0.f, 0.f, 0.f};
    i32x8 At[4], B0[2], B1[2];
    const char* cA = (const char*)g.A + (size_t)cur.pm * tsA + (size_t)cur.pn * g.a_pn_off * 2; const char* cB = (const char*)g.Bt + (size_t)cur.pn * tsB + (size_t)cur.pm * g.b_pm_off * 2;
    PG8_STAGE(PG8_SB(0, 0), cB, voffB); PG8_STAGE(PG8_SB(0, 1), cB + hsB, voffB); PG8_STAGE(PG8_SA(0, 0), cA, voffA); PG8_STAGE(PG8_SA(0, 1), cA + hsA, voffA);
    if (wr == 1) PG8_BAR;
    PG8_WAIT_V(2); PG8_BAR;
    PG8_STAGE(PG8_SB(1, 0), cB + kstep, voffB); PG8_STAGE(PG8_SA(1, 0), cA + kstep, voffA); PG8_STAGE(PG8_SB(1, 1), cB + hsB + kstep, voffB);
    PG8_WAIT_V(6); PG8_BAR;
    for (;;) {
        const bool has_next = S.next(ui + 1, nxt);
        const char* nA = has_next ? (const char*)g.A + (size_t)nxt.pm * tsA + (size_t)nxt.pn * g.a_pn_off * 2 : cA; const char* nB = has_next ? (const char*)g.Bt + (size_t)nxt.pn * tsB + (size_t)nxt.pm * g.b_pm_off * 2 : cB;
        const char* cA2 = (const char*)g.A2 + (size_t)cur.pm * tsA; const char* cB2 = (const char*)g.Bt2 + (size_t)cur.pn * tsB;
#pragma clang loop unroll(disable)
        for (int t = 0; t < nt; t += 2) {
            const bool last = (t == nt - 2);
            const bool s1 = ksplit && (t >= ksplit), s2 = ksplit && (t + 2 >= ksplit);
            const char* a1 = (s1 ? cA2 + (size_t)(t - ksplit + 1) * kstep : cA + (size_t)(t + 1) * kstep);
            const char* a2 = last ? nA : (s2 ? cA2 + (size_t)(t + 2 - ksplit) * kstep : cA + (size_t)(t + 2) * kstep);
            const char* b2 = last ? nB : (s2 ? cB2 + (size_t)(t + 2 - ksplit) * kstep : cB + (size_t)(t + 2) * kstep);
            const char* a3 = a2 + kstep; const char* b3 = b2 + kstep;
            PG8_LDB(B0, 0, 0); PG8_LDB(B1, 0, 1); PG8_SCHED; PG8_LDA(At, 0, 0); PG8_STAGE(PG8_SA(1, 1), a1 + hsA, voffA);
            PG8_WAIT_V(8); PG8_WAIT_L(0); PG8_BAR; PG8_MMA(0, 0, At, B0); PG8_MMA(0, 1, At, B1); PG8_BAR; PG8_SCHED;
            PG8_LDA(At, 0, 1); PG8_STAGE(PG8_SB(0, 0), b2, voffB); PG8_STAGE(PG8_SB(0, 1), b2 + hsB, voffB); PG8_STAGE(PG8_SA(0, 0), a2, voffA);
            PG8_WAIT_V(8); PG8_WAIT_L(0); PG8_BAR; PG8_MMA(1, 0, At, B0); PG8_MMA(1, 1, At, B1); PG8_BAR; PG8_SCHED;
            PG8_LDB(B0, 1, 0); PG8_LDB(B1, 1, 1); PG8_SCHED; PG8_LDA(At, 1, 0); PG8_STAGE(PG8_SA(0, 1), a2 + hsA, voffA);
            PG8_WAIT_V(8); PG8_WAIT_L(0); PG8_BAR; PG8_MMA(0, 0, At, B0); PG8_MMA(0, 1, At, B1); PG8_BAR; PG8_SCHED;
            PG8_LDA(At, 1, 1); PG8_STAGE(PG8_SB(1, 0), b3, voffB); PG8_STAGE(PG8_SB(1, 1), b3 + hsB, voffB); PG8_STAGE(PG8_SA(1, 0), a3, voffA);
            PG8_WAIT_V(8); PG8_WAIT_L(0); PG8_BAR; PG8_MMA(1, 0, At, B0); PG8_MMA(1, 1, At, B1); PG8_BAR; PG8_SCHED;
            if constexpr (Epi::MID) { if (t + 2 == ksplit) E.mid(acc, cur, wr, wc, fr, fq); }
        }
        if (wr == 0) PG8_BAR;
        { const int l2 = lane_now(); E(acc, cur, wr, wc, l2 & 15, l2 >> 4); }
        if (!has_next) break;
#pragma unroll
        for (int a = 0; a < 2; ++a)
#pragma unroll
            for (int b = 0; b < 2; ++b)
#pragma unroll
                for (int m = 0; m < 4; ++m)
#pragma unroll
                    for (int n = 0; n < 2; ++n) acc[a][b][m][n] = (f32x4){0.f, 0.f, 0.f, 0.f};
        cur = nxt; cA = nA; cB = nB; ++ui;
        if (wr == 1) PG8_BAR;
    }
    PG8_WAIT_V(0);
    PG8_BAR;
#undef PG8_SA
#undef PG8_SB
#undef PG8_STAGE
#undef PG8_STEP_voffA
#undef PG8_STEP_voffB
#undef PG8_LDA
#undef PG8_LDB
#undef PG8_MMA
#undef PG8_WAIT_V
#undef PG8_WAIT_L
#undef PG8_BAR
#undef PG8_SCHED
}
}
using pg8::Unit;

typedef f32x4 AccT[2][2][4][2];
__device__ __forceinline__ u32x4 pack8(f32x4 a, f32x4 b) { u32x4 w; w.x = cvt_pk_bf16(a[0], a[1]); w.y = cvt_pk_bf16(a[2], a[3]); w.z = cvt_pk_bf16(b[0], b[1]); w.w = cvt_pk_bf16(b[2], b[3]); return w; }
__device__ __forceinline__ u32x2 pack8_fp8(f32x4 a, f32x4 b) {
    int w0 = __builtin_amdgcn_cvt_pk_fp8_f32(a[0], a[1], 0, false); w0 = __builtin_amdgcn_cvt_pk_fp8_f32(a[2], a[3], w0, true);
    int w1 = __builtin_amdgcn_cvt_pk_fp8_f32(b[0], b[1], 0, false); w1 = __builtin_amdgcn_cvt_pk_fp8_f32(b[2], b[3], w1, true);
    return (u32x2){(unsigned)w0, (unsigned)w1};
}
__device__ __forceinline__ void unpack8(u32x4 w, f32x4& a, f32x4& b) { a = (f32x4){bf_lo(w.x), bf_hi(w.x), bf_lo(w.y), bf_hi(w.y)}; b = (f32x4){bf_lo(w.z), bf_hi(w.z), bf_lo(w.w), bf_hi(w.w)}; }

__device__ __forceinline__ void unpack8_fp8(u32x2 w, f32x4& a, f32x4& b) {
    const f32x2 a0 = __builtin_amdgcn_cvt_pk_f32_fp8((int)w.x, false), a1 = __builtin_amdgcn_cvt_pk_f32_fp8((int)w.x, true), b0 = __builtin_amdgcn_cvt_pk_f32_fp8((int)w.y, false), b1 = __builtin_amdgcn_cvt_pk_f32_fp8((int)w.y, true);
    a = (f32x4){a0.x, a0.y, a1.x, a1.y}; b = (f32x4){b0.x, b0.y, b1.x, b1.y};
}
template <bool SET8> struct EpiInproj {
    static constexpr bool PERM = true, MID = false;
    bf16_t *q, *k, *v, *iq, *ik, *pl, *ga, *gp; float* iw;
    __device__ __forceinline__ void operator()(const AccT& acc, const Unit& u, int wr, int wc, int fr, int fq) const {
        const int pn = u.pn, row0 = u.pm * 256 + wr * 64 + fr;
        if (SET8 && pn == 26) {
            if (wc < 2) {
#pragma unroll
                for (int ai = 0; ai < 2; ++ai)
#pragma unroll
                    for (int m = 0; m < 4; ++m) { const size_t row = (size_t)(row0 + ai * 128 + m * 16);
                        *(u32x4*)(ik + row * 64 + wc * 32 + 8 * fq) = pack8(acc[ai][0][m][0], acc[ai][0][m][1]); }
            } else if (wc == 2) {
                if (fq < 2) {
#pragma unroll
                    for (int ai = 0; ai < 2; ++ai)
#pragma unroll
                        for (int m = 0; m < 4; ++m) { const size_t row = (size_t)(row0 + ai * 128 + m * 16);
                            *(f32x4*)(iw + row * 16 + 8 * fq) = acc[ai][0][m][0]; *(f32x4*)(iw + row * 16 + 8 * fq + 4) = acc[ai][0][m][1]; }
                }
            }
            return;
        }
        bf16_t* dst; int ld, tc; bool sg = false, f8o = false;
        if (SET8) {
            if (pn < 4) { dst = q; ld = 1024; tc = pn * 256; }
            else if (pn == 4) { dst = k; ld = 256; tc = 0; }
            else if (pn == 5) { dst = v; ld = 256; tc = 0; f8o = true; }
            else if (pn < 14) { dst = ga; ld = 2048; tc = (pn - 6) * 256; sg = true; }
            else if (pn < 22) { dst = gp; ld = 2048; tc = (pn - 14) * 256; sg = true; }
            else { dst = iq; ld = 1024; tc = (pn - 22) * 256; }
        } else {
            dst = pl; ld = 1024; tc = pn * 256;
        }
        const int col0 = tc + wc * 32 + 8 * fq;
#pragma unroll
        for (int ai = 0; ai < 2; ++ai)
#pragma unroll
            for (int m = 0; m < 4; ++m) { bf16_t* rowp = dst + (size_t)(row0 + ai * 128 + m * 16) * ld + col0;
                if (sg) {
                    u32x2 h[2];
#pragma unroll
                    for (int bj = 0; bj < 2; ++bj) { f32x4 v0 = acc[ai][bj][m][0], v1 = acc[ai][bj][m][1];
#pragma unroll
                        for (int j = 0; j < 4; ++j) { v0[j] = fmaxf(sigmoidf_(v0[j]), 0.00390625f); v1[j] = fmaxf(sigmoidf_(v1[j]), 0.00390625f); }
                        h[bj] = pack8_fp8(v0, v1); }
                    *(u32x4*)((unsigned char*)dst + ((size_t)((u.pm * 8 + (tc >> 8)) * 8 + wr * 4 + wc) * 8 + (ai * 4 + m)) * 1024 + (fq * 16 + fr) * 16) = (u32x4){h[0].x, h[0].y, h[1].x, h[1].y};
                    continue; }
#pragma unroll
                for (int bj = 0; bj < 2; ++bj) { f32x4 v0 = acc[ai][bj][m][0], v1 = acc[ai][bj][m][1];
                    if (f8o) *(u32x2*)((unsigned char*)dst + (size_t)(row0 + ai * 128 + m * 16) * ld + col0 + bj * 128) = pack8_fp8(v0, v1);
                    else *(u32x4*)(rowp + bj * 128) = pack8(v0, v1); } }
    }
};
struct EpiBf16Scale {
    static constexpr bool PERM = true, MID = false;
    bf16_t* O; int ldc; const float* cs;
    __device__ __forceinline__ void operator()(const AccT& acc, const Unit& u, int wr, int wc, int fr, int fq) const {
        const int row0 = u.pm * 256 + wr * 64 + fr, col0 = u.pn * 256 + wc * 32 + 8 * fq;
        f32x4 s[2][2];
#pragma unroll
        for (int bj = 0; bj < 2; ++bj)
#pragma unroll
            for (int n = 0; n < 2; ++n) s[bj][n] = cs ? *(const f32x4*)(cs + col0 + bj * 128 + 4 * n) : (f32x4){1.f, 1.f, 1.f, 1.f};
#pragma unroll
        for (int ai = 0; ai < 2; ++ai)
#pragma unroll
            for (int m = 0; m < 4; ++m) { bf16_t* rowp = O + (size_t)(row0 + ai * 128 + m * 16) * ldc + col0;
#pragma unroll
                for (int bj = 0; bj < 2; ++bj) *(u32x4*)(rowp + bj * 128) = pack8(acc[ai][bj][m][0] * s[bj][0], acc[ai][bj][m][1] * s[bj][1]); }
    }
};
struct EpiF8Scale {
    static constexpr bool PERM = true, MID = false;
    unsigned char* O; int ldc; const float* cs;
    __device__ __forceinline__ void operator()(const AccT& acc, const Unit& u, int wr, int wc, int fr, int fq) const {
        const int row0 = u.pm * 256 + wr * 64 + fr, col0 = u.pn * 256 + wc * 32 + 8 * fq;
        f32x4 s[2][2];
#pragma unroll
        for (int bj = 0; bj < 2; ++bj)
#pragma unroll
            for (int n = 0; n < 2; ++n) s[bj][n] = *(const f32x4*)(cs + col0 + bj * 128 + 4 * n);
#pragma unroll
        for (int ai = 0; ai < 2; ++ai)
#pragma unroll
            for (int m = 0; m < 4; ++m) { unsigned char* rowp = O + (size_t)(row0 + ai * 128 + m * 16) * ldc + col0;
#pragma unroll
                for (int bj = 0; bj < 2; ++bj) *(u32x2*)(rowp + bj * 128) = pack8_fp8(acc[ai][bj][m][0] * s[bj][0], acc[ai][bj][m][1] * s[bj][1]); }
    }
};
struct EpiF8Mul {
    static constexpr bool PERM = true, MID = false;
    unsigned char* O; int ldc; float mul;
    __device__ __forceinline__ void operator()(const AccT& acc, const Unit& u, int wr, int wc, int fr, int fq) const {
        const int row0 = u.pm * 256 + wr * 64 + fr, col0 = u.pn * 256 + wc * 32 + 8 * fq;
#pragma unroll
        for (int ai = 0; ai < 2; ++ai)
#pragma unroll
            for (int m = 0; m < 4; ++m) { unsigned char* rowp = O + (size_t)(row0 + ai * 128 + m * 16) * ldc + col0;
#pragma unroll
                for (int bj = 0; bj < 2; ++bj) *(u32x2*)(rowp + bj * 128) = pack8_fp8(acc[ai][bj][m][0] * mul, acc[ai][bj][m][1] * mul); }
    }
};
template <bool ADD> struct EpiGate {
    static constexpr bool PERM = true, MID = false;
    bf16_t* O; const bf16_t* gate;
    __device__ __forceinline__ void operator()(const AccT& acc, const Unit& u, int wr, int wc, int fr, int fq) const {
        const int row0 = u.pm * 256 + wr * 64 + fr, col0 = u.pn * 256 + wc * 32 + 8 * fq;
#pragma unroll
        for (int ai = 0; ai < 2; ++ai)
#pragma unroll
            for (int m = 0; m < 4; ++m) { const size_t off = (size_t)(row0 + ai * 128 + m * 16) * 2048 + col0;
#pragma unroll
                for (int bj = 0; bj < 2; ++bj) { f32x4 g0, g1; unpack8(*(const u32x4*)(gate + off + bj * 128), g0, g1);
                    f32x4 r0 = g0 * acc[ai][bj][m][0], r1 = g1 * acc[ai][bj][m][1];
                    if (ADD) { f32x4 o0, o1; unpack8(*(const u32x4*)(O + off + bj * 128), o0, o1); r0 += o0; r1 += o1; }
                    *(u32x4*)(O + off + bj * 128) = pack8(r0, r1); } }
    }
};
struct EpiMerge {
    static constexpr bool PERM = true, MID = true;
    unsigned char* O; const unsigned char* ga; const unsigned char* gp;
    __device__ __forceinline__ void mid(AccT& acc, const Unit& u, int wr, int wc, int fr, int fq) const {
        const auto ra = __builtin_amdgcn_make_buffer_rsrc((void*)ga, 0, 0x7FFFFFFF, 0x00020000), rp = __builtin_amdgcn_make_buffer_rsrc((void*)gp, 0, 0x7FFFFFFF, 0x00020000);
        const int voff = (fq * 16 + fr) * 16;
        const int sbase = ((u.pm * 8 + u.pn) * 8 + wr * 4 + wc) * 8192;
#pragma unroll
        for (int ai = 0; ai < 2; ++ai)
#pragma unroll
            for (int m2 = 0; m2 < 4; m2 += 2) {
                u32x4 wa[2], wp[2];
#pragma unroll
                for (int k = 0; k < 2; ++k) { const int so = sbase + (ai * 4 + m2 + k) * 1024;
                    wa[k] = __builtin_bit_cast(u32x4, __builtin_amdgcn_raw_buffer_load_b128(ra, voff, so, 0)); wp[k] = __builtin_bit_cast(u32x4, __builtin_amdgcn_raw_buffer_load_b128(rp, voff, so, 0)); }
#pragma unroll
                for (int k = 0; k < 2; ++k) { const int m = m2 + k;
#pragma unroll
                    for (int bj = 0; bj < 2; ++bj) { f32x4 a0, a1, p0, p1; unpack8_fp8(bj ? (u32x2){wa[k].z, wa[k].w} : (u32x2){wa[k].x, wa[k].y}, a0, a1); unpack8_fp8(bj ? (u32x2){wp[k].z, wp[k].w} : (u32x2){wp[k].x, wp[k].y}, p0, p1);
#pragma unroll
                        for (int j = 0; j < 4; ++j) { acc[ai][bj][m][0][j] *= a0[j] * __builtin_amdgcn_rcpf(p0[j]); acc[ai][bj][m][1][j] *= a1[j] * __builtin_amdgcn_rcpf(p1[j]); }
                        asm volatile("" : "+v"(acc[ai][bj][m][0]), "+v"(acc[ai][bj][m][1])); } }
                asm volatile("" ::: "memory"); }
    }
    __device__ __forceinline__ void operator()(const AccT& acc, const Unit& u, int wr, int wc, int fr, int fq) const {
        const int row0 = u.pm * 256 + wr * 64 + fr, col0 = u.pn * 256 + wc * 32 + 8 * fq;
        const unsigned char* gpf = gp + (size_t)((u.pm * 8 + u.pn) * 8 + wr * 4 + wc) * 8192 + (fq * 16 + fr) * 16;
#pragma unroll
        for (int ai = 0; ai < 2; ++ai)
#pragma unroll
            for (int m = 0; m < 4; ++m) { const size_t off = (size_t)(row0 + ai * 128 + m * 16) * 2048 + col0; const u32x4 wp = *(const u32x4*)(gpf + (ai * 4 + m) * 1024);
#pragma unroll
                for (int bj = 0; bj < 2; ++bj) { f32x4 p0, p1; unpack8_fp8(bj ? (u32x2){wp.z, wp.w} : (u32x2){wp.x, wp.y}, p0, p1);
                    *(u32x2*)(O + off + bj * 128) = pack8_fp8(p0 * acc[ai][bj][m][0], p1 * acc[ai][bj][m][1]); } }
    }
};
struct EpiResidB {
    static constexpr bool PERM = true, MID = false;
    const float* x; bf16_t* out; const float* gt;
    __device__ __forceinline__ void operator()(const AccT& acc, const Unit& u, int wr, int wc, int fr, int fq) const {
        const int row0 = u.pm * 256 + wr * 64 + fr, col0 = u.pn * 256 + wc * 32 + 8 * fq;
        const float* gtb = gt + (size_t)(u.pm / 16) * 12288;
        f32x4 g[2][2];
#pragma unroll
        for (int bj = 0; bj < 2; ++bj)
#pragma unroll
            for (int n = 0; n < 2; ++n) g[bj][n] = *(const f32x4*)(gtb + col0 + bj * 128 + 4 * n);
#pragma unroll
        for (int ai = 0; ai < 2; ++ai)
#pragma unroll
            for (int m = 0; m < 4; ++m) { const size_t off = (size_t)(row0 + ai * 128 + m * 16) * 2048 + col0;
#pragma unroll
                for (int bj = 0; bj < 2; ++bj) { const f32x4 x0 = *(const f32x4*)(x + off + bj * 128), x1 = *(const f32x4*)(x + off + bj * 128 + 4);
                    *(u32x4*)(out + off + bj * 128) = pack8(x0 + g[bj][0] * acc[ai][bj][m][0], x1 + g[bj][1] * acc[ai][bj][m][1]); } }
    }
};
struct EpiF32 {
    static constexpr bool PERM = false, MID = false;
    float* C; int ldc;
    __device__ __forceinline__ void operator()(const AccT& acc, const Unit& u, int wr, int wc, int fr, int fq) const {
        const int row0 = u.pm * 256 + wr * 64 + fr, col0 = u.pn * 256 + wc * 32 + 4 * fq;
#pragma unroll
        for (int ai = 0; ai < 2; ++ai)
#pragma unroll
            for (int m = 0; m < 4; ++m) { float* rowp = C + (size_t)(row0 + ai * 128 + m * 16) * ldc + col0;
#pragma unroll
                for (int bj = 0; bj < 2; ++bj)
#pragma unroll
                    for (int n = 0; n < 2; ++n) *(f32x4*)(rowp + bj * 128 + n * 16) = acc[ai][bj][m][n]; }
    }
};

struct Args { const float* in[19]; float* out; unsigned char* ws; int ph_lo, ph_hi; int li, pad; };
struct Frame {
    unsigned char* lds; unsigned char* ws;
    int tid, lane, wave, G, bid;
    const float *x, *c, *w_ada, *b_ada, *g1, *g2, *w_in, *g_q, *g_k, *rel_bias, *pool_w, *pool_scale, *w_ab, *w_pb, *w_out, *w_pq, *peer_keys, *peer_u, *peer_v;
    float* out;
};

template <bool F8OUT = false, class Fn> __device__ __forceinline__ void transpose_item(const float* W, int K, int N, void* WTv, int ldk, int drow0, int k0, float* scr, int lane, Fn srccol, float mul = 1.0f, const float* rs = nullptr) {
    const int sc = srccol(drow0 + (lane & 31));
#pragma unroll 16
    for (int i = 0; i < 32; ++i) { const int kk = 2 * i + (lane >> 5); scr[kk * 33 + (lane & 31)] = sc >= 0 ? W[(size_t)(k0 + kk) * N + sc] * (rs ? mul * rs[k0 + kk] : mul) : 0.f; }
    asm volatile("s_waitcnt lgkmcnt(0)" ::: "memory");
    const int c = lane & 7;
#pragma unroll
    for (int j = 0; j < 4; ++j) { const int n = (lane >> 3) + 8 * j; const float* s = scr + (8 * c) * 33 + n;
        if constexpr (F8OUT) { *(u32x2*)((unsigned char*)WTv + (size_t)(drow0 + n) * ldk + k0 + 8 * c) = pack8_fp8((f32x4){s[0 * 33], s[1 * 33], s[2 * 33], s[3 * 33]}, (f32x4){s[4 * 33], s[5 * 33], s[6 * 33], s[7 * 33]}); }
        else { u32x4 o; o.x = cvt_pk_bf16(s[0 * 33], s[1 * 33]); o.y = cvt_pk_bf16(s[2 * 33], s[3 * 33]); o.z = cvt_pk_bf16(s[4 * 33], s[5 * 33]); o.w = cvt_pk_bf16(s[6 * 33], s[7 * 33]);
            *(u32x4*)((bf16_t*)WTv + (size_t)(drow0 + n) * ldk + k0 + 8 * c) = o; } }
    asm volatile("s_waitcnt lgkmcnt(0)" ::: "memory");
}
__device__ __forceinline__ void phase0_prep(Frame& F) {
    F.lane = lane_now(); F.tid = F.wave * 64 + F.lane;
    const int gw = F.bid * 8 + F.wave, NGW = F.G * 8;
    float* scr = (float*)(F.lds + F.wave * 16384);
    constexpr int I_IN16 = (1024 / 32) * (DM / 64), I_IN8 = (6912 / 32) * (DM / 64);
    constexpr int I_AB = (2048 / 32) * (1024 / 64), I_OUT = (2048 / 32) * (2048 / 64), I_PW = 4 * 8 * 4;
    constexpr int NIT = I_IN16 + I_IN8 + 2 * I_AB + 2 * I_OUT + I_PW;
    auto ident = [](int j) { return j; };
    for (int it = gw; it < NIT; it += NGW) {
        int r = it;
        if (r < I_IN16) { const int nb = r % 32, kb = r / 32;
            transpose_item(F.w_in, DM, INW, F.ws + WS_WIN16, DM, nb * 32, kb * 64, scr, F.lane, [](int j) { return j + 2640; }); continue; }
        r -= I_IN16;
        if (r < I_IN8) { const int nb = r % 216, kb = r / 216;
            transpose_item<true>(F.w_in, DM, INW, F.ws + WS_WIN8, DM, nb * 32, kb * 64, scr, F.lane, [](int j) { return j < 1536 ? j : (j < 5632 ? j + 2128 : (j < 6656 ? j - 4096 : (j < 6736 ? j - 4096 : -1))); }, 16.0f); continue; }
        r -= I_IN8;
        if (r < I_AB) { transpose_item<true>(F.w_ab, 1024, 2048, F.ws + WS_WAB, 1024, (r % 64) * 32, (r / 64) * 64, scr, F.lane, ident, 16.0f); continue; }
        r -= I_AB;
        if (r < I_AB) { transpose_item(F.w_pb, 1024, 2048, (bf16_t*)(F.ws + WS_WPBT16), 1024, (r % 64) * 32, (r / 64) * 64, scr, F.lane, ident, 1.0f, F.pool_scale); continue; }
        r -= I_AB;
        if (r < I_OUT) { transpose_item<true>(F.w_out, 2048, 2048, F.ws + WS_WOUT, 2048, (r % 64) * 32, (r / 64) * 64, scr, F.lane, ident, 16.0f); continue; }
        r -= I_OUT;
        if (r < I_OUT) {
            const float* src = F.w_pq + (size_t)r * 2048 + F.lane * 32; bf16_t* dstq = (bf16_t*)(F.ws + WS_WPQ) + (size_t)r * 2048 + F.lane * 32;
#pragma unroll
            for (int q = 0; q < 4; ++q) *(u32x4*)(dstq + q * 8) = pack8(*(const f32x4*)(src + q * 8), *(const f32x4*)(src + q * 8 + 4));
            continue; }
        r -= I_OUT;
        { const float* src = F.pool_w + (size_t)r * 2048 + F.lane * 32; bf16_t* dstp = (bf16_t*)(F.ws + WS_POOLW) + (size_t)r * 2048 + F.lane * 32;
#pragma unroll
          for (int q = 0; q < 4; ++q) *(u32x4*)(dstp + q * 8) = pack8(*(const f32x4*)(src + q * 8), *(const f32x4*)(src + q * 8 + 4)); }
    }
    {
        bf16_t* kb = (bf16_t*)(F.ws + WS_KEYSBD);
        for (int i = F.bid * 512 + F.tid; i < 2048 * 32; i += F.G * 512) {
            const int row = i / 32, k8 = (i % 32) * 8, p = (row >> 7) & 1;
            u32x4 o = (u32x4){0u, 0u, 0u, 0u};
            if ((k8 >> 7) == p) { const float* s = F.peer_keys + (size_t)row * 128 + (k8 & 127); const f32x4 a = *(const f32x4*)s, b = *(const f32x4*)(s + 4); o = pack8(a, b); }
            *(u32x4*)(kb + (size_t)row * 256 + k8) = o;
        }
    }
    {
        unsigned char* pu = F.ws + WS_PU;
        for (size_t i = (size_t)F.bid * 512 + F.tid; i < (size_t)NEXP * 64; i += (size_t)F.G * 512) {
            const float* src = F.peer_u + i * 32;
            u32x16 pk;
#pragma unroll
            for (int k = 0; k < 8; ++k) { const f32x4 a = *(const f32x4*)(src + k * 4) * 96.0f; pk[2 * k] = cvt_pk_bf16(a[0], a[1]); pk[2 * k + 1] = cvt_pk_bf16(a[2], a[3]); }
            const u32x6 p6 = __builtin_amdgcn_cvt_scalef32_pk32_fp6_bf16(__builtin_bit_cast(bf16x32, pk), 1.0f);
            const int ci = (int)(i & 63), lp = (ci >> 2) + 16 * (ci & 3);
            unsigned char* dst = pu + (i >> 6) * 1536;
            *(u32x4*)(dst + lp * 16) = (u32x4){p6[0], p6[1], p6[2], p6[3]}; *(u32x2*)(dst + 1024 + lp * 8) = (u32x2){p6[4], p6[5]};
        }
        unsigned char* pv = F.ws + WS_PV;
        for (int it = gw; it < (NEXP / 64) * 128; it += NGW) {
            const int e = (it >> 7) * 64 + F.lane, ch = it & 127;
            u32x4 ov;
#pragma unroll
            for (int k = 0; k < 4; ++k) { const f32x4 c = *(const f32x4*)(F.peer_v + (size_t)e * DM + ch * 16 + k * 4) * 4.0f;
                int wv = __builtin_amdgcn_cvt_pk_fp8_f32(c[0], c[1], 0, false); wv = __builtin_amdgcn_cvt_pk_fp8_f32(c[2], c[3], wv, true); ov[k] = (unsigned)wv; }
            *(u32x2*)(pv + ((size_t)(2 * ch) * NEXP + e) * 8) = (u32x2){ov[0], ov[1]};
            *(u32x2*)(pv + ((size_t)(2 * ch + 1) * NEXP + e) * 8) = (u32x2){ov[2], ov[3]};
        }
    }
    {
        __syncthreads();
        float* cact = (float*)(F.lds + 131072);
        float* red = (float*)F.lds;
        float* mp = (float*)(F.ws + WS_MODP);
        for (int it = F.bid; it < 48 * 4; it += F.G) {
            const int cb = it % 48, ds = it / 48, d0 = ds * 512;
            for (int i = F.tid; i < 8 * 512; i += 512) { const int b = i >> 9, d = i & 511; const float cv = F.c[b * DM + d0 + d]; cact[i] = cv * sigmoidf_(cv); }
            __syncthreads();
            f32x4 a[8];
#pragma unroll
            for (int b = 0; b < 8; ++b) a[b] = (f32x4){0.f, 0.f, 0.f, 0.f};
            const float* wp = F.w_ada + (size_t)(d0 + F.wave * 64) * 12288 + cb * 256 + F.lane * 4;
#pragma unroll 8
            for (int d = 0; d < 64; ++d) { const f32x4 w = *(const f32x4*)(wp + (size_t)d * 12288);
#pragma unroll
                for (int b = 0; b < 8; ++b) a[b] += w * cact[b * 512 + F.wave * 64 + d]; }
#pragma unroll
            for (int b = 0; b < 8; ++b)
#pragma unroll
                for (int j = 0; j < 4; ++j) red[(F.wave * 32 + b * 4 + j) * 64 + F.lane] = a[b][j];
            __syncthreads();
            for (int i = F.tid; i < 2048; i += 512) { const int v = i >> 6, l = i & 63; float s = 0.f;
#pragma unroll
                for (int w = 0; w < 8; ++w) s += red[(w * 32 + v) * 64 + l];
                mp[((size_t)ds * 8 + (v >> 2)) * 12288 + cb * 256 + l * 4 + (v & 3)] = s; }
            __syncthreads();
        }
    }
}

template <bool FIRST> __device__ __forceinline__ void phase_modnorm(Frame& F, const float* xin, const float* gain, int off_sh, int off_sc, bf16_t* dst, unsigned char* dst8 = nullptr) {
    F.lane = lane_now(); F.tid = F.wave * 64 + F.lane;
    const float* mp = (const float*)(F.ws + WS_MODP); float* mf = (float*)(F.ws + WS_MODF);
    if (FIRST) {
        for (int i = F.bid * 512 + F.tid; i < 8 * 12288; i += F.G * 512) {
            float s = F.b_ada[i % 12288];
#pragma unroll
            for (int k = 0; k < 4; ++k) s += mp[(size_t)k * 8 * 12288 + i];
            mf[i] = s; }
    }
    float* cA = (float*)F.lds; float* cB = cA + 2048;
    for (int ch = F.bid; ch < MTOK / 128; ch += F.G) {
        const int b = ch / 32;
        __syncthreads();
        for (int col = F.tid; col < 2048; col += 512) {
            float sc, sh;
            if (FIRST) { sc = F.b_ada[off_sc + col]; sh = F.b_ada[off_sh + col];
#pragma unroll
                for (int k = 0; k < 4; ++k) { sc += mp[((size_t)k * 8 + b) * 12288 + off_sc + col]; sh += mp[((size_t)k * 8 + b) * 12288 + off_sh + col]; } }
            else { sc = mf[b * 12288 + off_sc + col]; sh = mf[b * 12288 + off_sh + col]; }
            cA[col] = gain[col] * (1.f + sc); cB[col] = sh; }
        __syncthreads();
        for (int r = F.wave; r < 128; r += 8) {
            const size_t row = (size_t)ch * 128 + r;
            const float* xr = xin + row * 2048 + F.lane * 8; const bf16_t* xrb = (const bf16_t*)xin + row * 2048 + F.lane * 8;
            f32x4 v[4][2]; float ss = 0.f;
#pragma unroll
            for (int i = 0; i < 4; ++i) { if (FIRST) { v[i][0] = *(const f32x4*)(xr + i * 512); v[i][1] = *(const f32x4*)(xr + i * 512 + 4); } else unpack8(*(const u32x4*)(xrb + i * 512), v[i][0], v[i][1]);
#pragma unroll
                for (int j = 0; j < 4; ++j) ss += v[i][0][j] * v[i][0][j] + v[i][1][j] * v[i][1][j]; }
            ss = wave_sum(ss);
            const float rinv = 1.0f / sqrtf(ss * (1.0f / 2048.0f) + EPS);
#pragma unroll
            for (int i = 0; i < 4; ++i) { const int col = i * 512 + F.lane * 8;
                const f32x4 a0 = *(const f32x4*)(cA + col), a1 = *(const f32x4*)(cA + col + 4), b0 = *(const f32x4*)(cB + col), b1 = *(const f32x4*)(cB + col + 4);
                const f32x4 y0 = v[i][0] * rinv * a0 + b0, y1 = v[i][1] * rinv * a1 + b1;
                *(u32x4*)(dst + row * 2048 + col) = pack8(y0, y1);
                if (FIRST) *(u32x2*)(dst8 + row * 2048 + col) = pack8_fp8(y0, y1); }
        }
    }
}

__device__ __forceinline__ void phase3_qknorm(Frame& F) {
    F.lane = lane_now(); F.tid = F.wave * 64 + F.lane;
    const bf16_t* q = (const bf16_t*)(F.ws + WS_QN); const bf16_t* k = (const bf16_t*)(F.ws + WS_KN); const bf16_t* v = (const bf16_t*)(F.ws + WS_V);
    unsigned char* q8 = F.ws + WS_Q8; unsigned char* k8 = F.ws + WS_K8; unsigned char* v8 = F.ws + WS_V8;
    const int gw = F.bid * 8 + F.wave, NGW = F.G * 8;
    for (int row2 = gw; row2 < MTOK / 2; row2 += NGW) { const int row = row2 * 2 + (F.lane >> 5), ci = F.lane & 31;
        f32x4 a, b; unpack8(*(const u32x4*)(k + (size_t)row * 256 + ci * 8), a, b);
        float ss = a[0] * a[0] + a[1] * a[1] + a[2] * a[2] + a[3] * a[3] + b[0] * b[0] + b[1] * b[1] + b[2] * b[2] + b[3] * b[3];
        ss = row_sum16(ss);
        const float rinv = 1.0f / sqrtf(ss * (1.0f / 128.0f) + EPS);
        const float* gp = F.g_k + (ci & 15) * 8; const f32x4 g0 = *(const f32x4*)gp, g1 = *(const f32x4*)(gp + 4);
        *(u32x2*)(k8 + (size_t)row * 256 + ci * 8) = pack8_fp8(a * rinv * g0, b * rinv * g1); }
}
template <int W> __device__ __forceinline__ void pooled_run(const bf16_t* pl, unsigned char* po, int r0, int c8) {
    const int t0 = r0 & (SEQ - 1);
    f32x4 s0 = (f32x4){0.f, 0.f, 0.f, 0.f}, s1 = s0;
    { u32x4 v[W];
#pragma unroll
      for (int i = 1; i <= W; ++i) v[i - 1] = *(const u32x4*)(pl + (size_t)(r0 - (i <= t0 ? i : 0)) * 1024 + c8);
#pragma unroll
      for (int i = 1; i <= W; ++i) { f32x4 a, b; unpack8(v[i - 1], a, b); if (i <= t0) { s0 += a; s1 += b; } } }
#pragma unroll 1
    for (int j0 = 0; j0 < 32; j0 += 8) {
        u32x4 xv[8], sv[8];
#pragma unroll
        for (int jj = 0; jj < 8; ++jj) { const int j = j0 + jj; xv[jj] = *(const u32x4*)(pl + (size_t)(r0 + j) * 1024 + c8);
            sv[jj] = *(const u32x4*)(pl + (size_t)(r0 + j - (t0 + j >= W ? W : 0)) * 1024 + c8); }
#pragma unroll
        for (int jj = 0; jj < 8; ++jj) { const int j = j0 + jj, t = t0 + j; f32x4 a, b, c, d; unpack8(xv[jj], a, b); unpack8(sv[jj], c, d);
            s0 += a; s1 += b; if (t >= W) { s0 -= c; s1 -= d; }
            const float inv = 1.0f / (float)((t + 1 < W) ? t + 1 : W);
            *(u32x2*)(po + (size_t)(r0 + j) * 1024 + c8) = pack8_fp8(s0 * inv - a, s1 * inv - b); }
    }
}
__device__ __forceinline__ void phase3_pooled(Frame& F) {
    F.lane = lane_now(); F.tid = F.wave * 64 + F.lane;
    const bf16_t* pl = (const bf16_t*)(F.ws + WS_PL); unsigned char* po = F.ws + WS_POOLED;
    const int gw = F.bid * 8 + F.wave, NGW = F.G * 8;
    for (int it = gw; it < (MTOK / 64) * 4; it += NGW) {
        const int g = it & 3, r0 = ((it >> 2) * 2 + (F.lane >> 5)) * 32, c8 = g * 256 + (F.lane & 31) * 8;
        if (g == 0) pooled_run<2>(pl, po, r0, c8); else if (g == 1) pooled_run<4>(pl, po, r0, c8); else if (g == 2) pooled_run<8>(pl, po, r0, c8); else pooled_run<16>(pl, po, r0, c8);
    }
}
typedef float f32x16 __attribute__((ext_vector_type(16)));
__device__ __forceinline__ float wrelu_(float wh, float d, float acc) { return __builtin_fmaf(wh, d, __builtin_fmaf(wh, __builtin_fabsf(d), acc)); }
__device__ __forceinline__ int sel_code(float s, float smin, float scale) { const float c = (s - smin) * scale; return (int)fminf(fmaxf(c, 0.f), 65535.f); }
__device__ __forceinline__ void hist_find(const unsigned* hist, int lane, int K, int& bsel, int& above) {
    const u32x4 h = *(const u32x4*)(hist + lane * 4);
    const int S = (int)(h.x + h.y + h.z + h.w);
    int x = S;
    x += __builtin_amdgcn_update_dpp(0, x, 0x101, 0xF, 0xF, true);
    x += __builtin_amdgcn_update_dpp(0, x, 0x102, 0xF, 0xF, true);
    x += __builtin_amdgcn_update_dpp(0, x, 0x104, 0xF, 0xF, true);
    x += __builtin_amdgcn_update_dpp(0, x, 0x108, 0xF, 0xF, true);
    const int t1 = __builtin_amdgcn_readlane(x, 16), t2 = __builtin_amdgcn_readlane(x, 32), t3 = __builtin_amdgcn_readlane(x, 48);
    const int r = lane >> 4;
    x += (r == 0 ? t1 + t2 + t3 : (r == 1 ? t2 + t3 : (r == 2 ? t3 : 0)));
    const int sufn = x - S;
    const bool mine = (x >= K) && (sufn < K);
    int b = 0, ab = 0;
    { int c = sufn;
      if (c + (int)h.w >= K) { b = 3; ab = c; } else { c += (int)h.w;
      if (c + (int)h.z >= K) { b = 2; ab = c; } else { c += (int)h.z;
      if (c + (int)h.y >= K) { b = 1; ab = c; } else { c += (int)h.y; b = 0; ab = c; } } } }
    const unsigned long long m = __ballot(mine);
    const int src = m ? (int)__builtin_ctzll(m) : 0;
    bsel = __builtin_amdgcn_readlane(lane * 4 + b, src); above = __builtin_amdgcn_readlane(ab, src);
}
__device__ __forceinline__ int mask_prefix(unsigned long long m) { return (int)__builtin_amdgcn_mbcnt_hi((unsigned)(m >> 32), __builtin_amdgcn_mbcnt_lo((unsigned)m, 0u)); }
template <class Fn> __device__ __forceinline__ void sel_sweep(const f32x4* rb4, int n4, int lane, int t, Fn fn) {
    f32x4 cur = rb4[lane];
    for (int c4 = 0; c4 < n4 - 1; ++c4) { const f32x4 nxt = rb4[(c4 + 1) * 64 + lane];
#pragma unroll
        for (int k = 0; k < 4; ++k) fn(cur[k], (c4 * 4 + k) * 64 + lane, true);
        cur = nxt; }
    { const int c4 = n4 - 1;
#pragma unroll
      for (int k = 0; k < 4; ++k) { const int idx = (c4 * 4 + k) * 64 + lane; fn(cur[k], idx, idx <= t); } }
}
template <int MODE = 0> __device__ __forceinline__ void indexer_select(Frame& F, int b, int t, const float* rowbuf, unsigned* hist, float* eqv, int* eqi) {
    unsigned short* selrow = (unsigned short*)(F.ws + (MODE ? WS_R0 : WS_SEL)) + (size_t)(b * SEQ + t) * 256;
    int lane = F.lane; asm volatile("" : "+v"(lane));
    const int nch = t / 64 + 1, n4 = (nch + 3) >> 2;
    const f32x4* rb4 = (const f32x4*)rowbuf;
    float mn = __builtin_huge_valf(), mx = -__builtin_huge_valf();
    sel_sweep(rb4, n4, lane, t, [&](float v, int, bool valid) { mn = valid ? fminf(mn, v) : mn; mx = valid ? fmaxf(mx, v) : mx; });
    mx = xor16_max(row_max16(mx)); { const auto r = __builtin_amdgcn_permlane32_swap(__float_as_uint(mx), __float_as_uint(mx), false, false); mx = fmaxf(__uint_as_float(r[0]), __uint_as_float(r[1])); }
    mn = -mn; mn = xor16_max(row_max16(mn)); { const auto r = __builtin_amdgcn_permlane32_swap(__float_as_uint(mn), __float_as_uint(mn), false, false); mn = -fmaxf(__uint_as_float(r[0]), __uint_as_float(r[1])); }
    const float scale = (mx > mn) ? 65535.0f / (mx - mn) : 0.f;
    *(u32x4*)(hist + lane * 4) = (u32x4){0u, 0u, 0u, 0u};
    sel_sweep(rb4, n4, lane, t, [&](float v, int, bool valid) { if (valid) { if (MODE == 2) ((volatile unsigned*)hist)[sel_code(v, mn, scale) >> 8] = 1u; else atomicAdd(&hist[sel_code(v, mn, scale) >> 8], 1u); } });
    int b1, above1; hist_find(hist, lane, KSEL, b1, above1);
    *(u32x4*)(hist + lane * 4) = (u32x4){0u, 0u, 0u, 0u};
    sel_sweep(rb4, n4, lane, t, [&](float v, int, bool valid) { const int code = sel_code(v, mn, scale); if (valid && (code >> 8) == b1) atomicAdd(&hist[code & 255], 1u); });
    int b2, above2; hist_find(hist, lane, KSEL - above1, b2, above2);
    const int T16 = (b1 << 8) | b2, need = KSEL - above1 - above2, ceq = (int)hist[b2];
    const bool all_eq = (ceq == need), collect = !all_eq && (ceq <= 64);
    const int eq_budget = all_eq ? 0x7fffffff : (collect ? 0 : need);
    int pos = 0, eqseen = 0;
    sel_sweep(rb4, n4, lane, t, [&](float v, int idx, bool valid) {
        const int code = sel_code(v, mn, scale);
        const bool gt = valid && code > T16, eq = valid && code == T16;
        const unsigned long long mg = __ballot(gt);
        const unsigned p = (unsigned)(pos + mask_prefix(mg));
        if (gt && p < (unsigned)KSEL) selrow[p] = (unsigned short)idx;
        pos += __popcll(mg);
        const unsigned long long me = __ballot(eq);
        if (me) {
            const int er = eqseen + mask_prefix(me); const bool te = eq && er < eq_budget;
            if (collect && eq) { eqv[er] = v; eqi[er] = idx; }
            eqseen += __popcll(me);
            const unsigned long long mte = __ballot(te);
            const unsigned pe = (unsigned)(pos + mask_prefix(mte));
            if (te && pe < (unsigned)KSEL) selrow[pe] = (unsigned short)idx;
            pos += __popcll(mte);
        }
    });
    if (collect && lane < ceq) {
        const float sv = eqv[lane]; const int idx = eqi[lane]; int rank = 0;
        for (int m = 0; m < ceq; ++m) { const float ov = eqv[m]; const int oi = eqi[m]; rank += (ov > sv || (ov == sv && oi < idx)) ? 1 : 0; }
        if (rank < need) selrow[KSEL - need + rank] = (unsigned short)idx;
    }
}
__device__ __forceinline__ void indexer_tile(Frame& F, int b, int t0) {
    const bf16_t* iq = (const bf16_t*)(F.ws + WS_IQ); const bf16_t* ik = (const bf16_t*)(F.ws + WS_IK); const float* iw = (const float*)(F.ws + WS_IW);
    int lane = F.lane; asm volatile("" : "+v"(lane));
    const int w = F.wave;
    if (t0 < KSEL) {
        const int t = t0 + w; unsigned short* selrow = (unsigned short*)(F.ws + WS_SEL) + (size_t)(b * SEQ + t) * 256;
#pragma unroll
        for (int p = 0; p < 4; ++p) { const int j = p * 64 + lane; selrow[j] = (unsigned short)(j <= t ? j : 0xFFFF); }
        return;
    }
    float* rowbuf = (float*)F.lds;
    unsigned char* stage = F.lds + 131072;
    const int p = w & 3, kh = w >> 2, hi = lane >> 5, r = lane & 31;
    const size_t qrow = (size_t)b * SEQ + t0 + 2 * p + (r >> 4);
    bf16x8 a[4];
#pragma unroll
    for (int ks = 0; ks < 4; ++ks) a[ks] = *(const bf16x8*)(iq + qrow * 1024 + (r & 15) * 64 + ks * 16 + 8 * hi);
    float wq[2][8];
#pragma unroll
    for (int q = 0; q < 2; ++q)
#pragma unroll
        for (int i = 0; i < 8; ++i) wq[q][i] = 0.5f * iw[((size_t)b * SEQ + t0 + 2 * p + q) * 16 + (i & 3) + 8 * ((i >> 2) & 1) + 4 * hi];
    const int nchunks = (t0 + 7) / 64 + 1, nsteps = (nchunks + 1) >> 1;
    const unsigned char* gsrc = (const unsigned char*)(ik + (size_t)b * SEQ * 64) + F.tid * 16;
    const int skey = F.tid >> 3, sc16 = F.tid & 7, soff = skey * 128 + ((sc16 ^ ((skey >> 1) & 7)) << 4);
    u32x4 sa0 = *(const u32x4*)gsrc, sb0 = sa0, sa1 = sa0, sb1 = sa0;
    sb0 = *(const u32x4*)(gsrc + (size_t)min(1, nchunks - 1) * 8192);
    sa1 = *(const u32x4*)(gsrc + (size_t)min(2, nchunks - 1) * 8192);
    sb1 = *(const u32x4*)(gsrc + (size_t)min(3, nchunks - 1) * 8192);
    __syncthreads();
#if PROBE_IDX != 1 && PROBE_IDX != 5
#define IDX_LD(c) (*(const u32x4*)(gsrc + (size_t)(c) * 8192))
#endif
#define IDX_MMA(SA, SB, ss, D0, D1) do { const int s_ = (ss); unsigned char* sb = stage + (s_ & 1) * 16384; \
        *(u32x4*)(sb + soff) = SA; *(u32x4*)(sb + 8192 + soff) = SB; \
        __syncthreads(); \
        SA = IDX_LD(min(2 * s_ + 4, nchunks - 1)); \
        SB = IDX_LD(min(2 * s_ + 5, nchunks - 1)); \
        _Pragma("unroll") for (int i = 0; i < 16; ++i) { D0[i] = 0.f; D1[i] = 0.f; } \
        _Pragma("unroll") for (int ks = 0; ks < 4; ++ks) { const unsigned char* bp = sb + key * 128 + (((ks * 2 + hi) ^ ((key >> 1) & 7)) << 4); \
            const bf16x8 bf0 = *(const bf16x8*)bp, bf1 = *(const bf16x8*)(bp + 8192); \
            D0 = __builtin_amdgcn_mfma_f32_32x32x16_bf16(a[ks], bf0, D0, 0, 0, 0); D1 = __builtin_amdgcn_mfma_f32_32x32x16_bf16(a[ks], bf1, D1, 0, 0, 0); } } while (0)
#define IDX_RED(ss, D0, D1) do { const int s_ = (ss); float x0_ = 0.f, x1_ = 0.f, y0_ = 0.f, y1_ = 0.f; \
        _Pragma("unroll") for (int i = 0; i < 8; ++i) { x0_ = wrelu_(wq[0][i], D0[i], x0_); x1_ = wrelu_(wq[1][i], D0[8 + i], x1_); y0_ = wrelu_(wq[0][i], D1[i], y0_); y1_ = wrelu_(wq[1][i], D1[8 + i], y1_); } \
        const float scx = swap32_pair(x0_, x1_), scy = swap32_pair(y0_, y1_); \
        *(f32x2*)(rowbuf + (2 * p + hi) * 4096 + ((s_ >> 1) * 64 + key) * 4 + 2 * (s_ & 1)) = (f32x2){scx, scy}; } while (0)
    const int key = kh * 32 + r;
    f32x16 dA0, dA1, dB0, dB1;
#if PROBE_IDX == 1
#define IDX_LD(c) (*(const u32x4*)(gsrc + (size_t)(c) * 8192))
#elif PROBE_IDX == 5
#define IDX_LD(c) SAVED
#endif
#if PROBE_IDX == 1 || PROBE_IDX == 5
    { const u32x4 SAVED = sa0;
    IDX_MMA(sa0, sb0, 0, dA0, dA1);
    for (int s2 = 0; s2 < nsteps; s2 += 2) {
        if (s2 + 1 < nsteps) IDX_MMA(sa1, sb1, s2 + 1, dB0, dB1);
        IDX_RED(s2, dA0, dA1);
        if (s2 + 2 < nsteps) IDX_MMA(sa0, sb0, s2 + 2, dA0, dA1);
        if (s2 + 1 < nsteps) IDX_RED(s2 + 1, dB0, dB1);
    }
    __syncthreads();
    sa0 = *(const u32x4*)gsrc;
    sb0 = *(const u32x4*)(gsrc + (size_t)min(1, nchunks - 1) * 8192);
    sa1 = *(const u32x4*)(gsrc + (size_t)min(2, nchunks - 1) * 8192);
    sb1 = *(const u32x4*)(gsrc + (size_t)min(3, nchunks - 1) * 8192); }
#undef IDX_LD
#define IDX_LD(c) (*(const u32x4*)(gsrc + (size_t)(c) * 8192))
#endif
    IDX_MMA(sa0, sb0, 0, dA0, dA1);
    for (int s2 = 0; s2 < nsteps; s2 += 2) {
        if (s2 + 1 < nsteps) IDX_MMA(sa1, sb1, s2 + 1, dB0, dB1);
        IDX_RED(s2, dA0, dA1);
        if (s2 + 2 < nsteps) IDX_MMA(sa0, sb0, s2 + 2, dA0, dA1);
        if (s2 + 1 < nsteps) IDX_RED(s2 + 1, dB0, dB1);
    }
#undef IDX_MMA
#undef IDX_RED
#undef IDX_LD
    __syncthreads();
    indexer_select(F, b, t0 + w, rowbuf + w * 4096, (unsigned*)(F.lds + 147456) + w * 256, (float*)(F.lds + 155648) + w * 64, (int*)(F.lds + 155648 + 2048) + w * 64);
#if PROBE_IDX >= 2
    indexer_select<PROBE_IDX - 1>(F, b, t0 + w, rowbuf + w * 4096, (unsigned*)(F.lds + 147456) + w * 256, (float*)(F.lds + 155648) + w * 64, (int*)(F.lds + 155648 + 2048) + w * 64);
#endif
}
__device__ __forceinline__ void phase3_indexer(Frame& F) {
    F.lane = lane_now(); F.tid = F.wave * 64 + F.lane;
    volatile LAS unsigned* misc = (volatile LAS unsigned*)((LAS unsigned char*)F.lds + MISC_OFF);
    const unsigned keep0 = misc[0], keep1 = misc[1];
    __syncthreads();
    const int nit = BATCH * (SEQ / 8);
    for (int k = 0;; ++k) {
        const int l = k * F.G + ((k & 1) ? (F.G - 1 - F.bid) : F.bid);
        if (l >= nit) { if (k * F.G >= nit) break; else continue; }
        const int qb = (SEQ / 8 - 1) - (l >> 3), b = l & 7;
        indexer_tile(F, b, qb * 8);
    }
    __syncthreads();
    if (F.tid == 0) { misc[0] = keep0; misc[1] = keep1; }
}

__device__ const unsigned char g_bucket[128] = {0, 1, 2, 3, 4, 5, 6, 7, 8, 9, 10, 11, 12, 13, 14, 15, 16, 16, 16, 17, 17, 18, 18, 18, 19, 19, 19, 20, 20, 20, 20, 21, 21, 21, 21, 22, 22, 22, 22, 22, 23, 23, 23, 23, 23, 23, 24, 24, 24, 24, 24, 24, 25, 25, 25, 25, 25, 25, 25, 26, 26, 26, 26, 26, 26, 26, 26, 27, 27, 27, 27, 27, 27, 27, 27, 27, 27, 28, 28, 28, 28, 28, 28, 28, 28, 28, 28, 29, 29, 29, 29, 29, 29, 29, 29, 29, 29, 29, 29, 30, 30, 30, 30, 30, 30, 30, 30, 30, 30, 30, 30, 30, 30, 31, 31, 31, 31, 31, 31, 31, 31, 31, 31, 31, 31, 31, 31, 31};
__device__ __forceinline__ void at_pv_step(f32x4 (&D0)[8], f32x4 (&D1)[8], const u32x4 (&buf)[8], LAS unsigned char* vwr, LAS unsigned char* ard, LAS unsigned char* brd) {
#pragma unroll
    for (int c = 0; c < 8; ++c) *(LAS u32x4*)(vwr + c * 576) = buf[c];
    const long pb = __builtin_bit_cast(long, __builtin_amdgcn_ds_read_tr8_b64_v2i32((LAS v2i*)brd));
#pragma unroll
    for (int tl = 0; tl < 8; ++tl) { const long va = __builtin_bit_cast(long, __builtin_amdgcn_ds_read_tr8_b64_v2i32((LAS v2i*)(ard + tl * 16))); D0[tl] = __builtin_amdgcn_mfma_f32_16x16x32_fp8_fp8(va, pb, D0[tl], 0, 0, 0); }
#pragma unroll
    for (int tl = 0; tl < 8; ++tl) { const long va = __builtin_bit_cast(long, __builtin_amdgcn_ds_read_tr8_b64_v2i32((LAS v2i*)(ard + 4608 + tl * 16))); D1[tl] = __builtin_amdgcn_mfma_f32_16x16x32_fp8_fp8(va, pb, D1[tl], 0, 0, 0); }
}
__device__ __forceinline__ void phase4_attention(Frame& F) {
    F.lane = lane_now(); F.tid = F.wave * 64 + F.lane;
    const bf16_t* qb = (const bf16_t*)(F.ws + WS_QN); const unsigned char* k8 = F.ws + WS_K8; const unsigned char* v8 = F.ws + WS_V8;
    const unsigned short* sel = (const unsigned short*)(F.ws + WS_SEL); unsigned char* ao = F.ws + WS_ATTN;
    float* btab = (float*)F.lds;
    __syncthreads();
    for (int i = F.tid; i < 256; i += 512) btab[i] = F.rel_bias[i];
    __syncthreads();
    constexpr int WST = 16512;
    unsigned char* wgp = F.lds + 4096 + F.wave * WST;
    bf16_t* Pb = (bf16_t*)(wgp + 9216); int* idl = (int*)(wgp + 13312); float* psl = (float*)(wgp + 16384); float* pml = psl + 8;
    LAS unsigned char* wl = (LAS unsigned char*)F.lds + 4096 + F.wave * WST;
    const bool xmap = (F.G % 8) == 0;
    const int gw = xmap ? (F.bid / 8) * 8 + F.wave : F.bid * 8 + F.wave, NGW = xmap ? F.G : F.G * 8, nrows = xmap ? SEQ : MTOK;
    for (int rr = gw; rr < nrows; rr += NGW) {
        int lane = F.lane; asm volatile("" : "+v"(lane));
        const int row = xmap ? (F.bid & 7) * SEQ + rr : rr;
        const int b = row / SEQ, t = row % SEQ, r = lane & 31, hi = lane >> 5;
#pragma unroll
        for (int p = 0; p < 4; ++p) { idl[p * 64 + lane] = (int)sel[(size_t)row * 256 + p * 64 + lane]; }
        long a0[8], a1[8];
        { u32x4 qa[4];
          { const bf16_t* qp = qb + (size_t)row * 1024 + (r & 7) * 128 + hi * 64; u32x4 raw[8];
#pragma unroll
            for (int i = 0; i < 8; ++i) raw[i] = *(const u32x4*)(qp + i * 8);
            float ss = 0.f;
#pragma unroll
            for (int i = 0; i < 8; ++i) { f32x4 a, b2; unpack8(raw[i], a, b2);
#pragma unroll
                for (int j = 0; j < 4; ++j) ss += a[j] * a[j] + b2[j] * b2[j]; }
            ss = xor32_sum(ss);
            const float rinv = 1.0f / sqrtf(ss * (1.0f / 128.0f) + EPS);
#pragma unroll
            for (int i = 0; i < 4; ++i) { f32x4 a, b2, c, d; unpack8(raw[2 * i], a, b2); unpack8(raw[2 * i + 1], c, d);
                const float* gp = F.g_q + hi * 64 + i * 16;
                const u32x2 w0 = pack8_fp8(a * rinv * *(const f32x4*)gp, b2 * rinv * *(const f32x4*)(gp + 4)), w1 = pack8_fp8(c * rinv * *(const f32x4*)(gp + 8), d * rinv * *(const f32x4*)(gp + 12));
                qa[i] = (r < 8) ? (u32x4){w0.x, w0.y, w1.x, w1.y} : (u32x4){0u, 0u, 0u, 0u}; } }
#pragma unroll
          for (int ks = 0; ks < 8; ++ks) { const unsigned lo = qa[ks >> 1][(ks & 1) * 2], hh = qa[ks >> 1][(ks & 1) * 2 + 1]; const long v = (long)(((unsigned long long)hh << 32) | lo);
              a0[ks] = (r < 4) ? v : 0l; a1[ks] = (r >= 4) ? v : 0l; } }
        f32x4 psum = (f32x4){0.f, 0.f, 0.f, 0.f}, pmax = psum;
        const int vg4 = lane >> 4, vch = lane & 15;
#define AT_LOADK(buf, kb) do { _Pragma("unroll") for (int c = 0; c < 8; ++c) { const int key_ = idl[(kb) * 32 + 4 * c + vg4]; const int kc_ = key_ <= t ? key_ : 0; \
            buf[c] = *(const u32x4*)(k8 + ((size_t)b * SEQ + kc_) * 256 + vch * 16); } } while (0)
#define AT_QK(buf, kb) do { const int key_ = idl[(kb) * 32 + r]; const bool valid_ = key_ <= t; const int kc_ = valid_ ? key_ : 0; \
            _Pragma("unroll") for (int c = 0; c < 8; ++c) *(LAS u32x4*)(wl + (4 * c + vg4) * 272 + vch * 16) = buf[c]; \
            u32x4 g0_[4], g1_[4]; \
            _Pragma("unroll") for (int i = 0; i < 4; ++i) { g0_[i] = *(const LAS u32x4*)(wl + r * 272 + hi * 64 + i * 16); g1_[i] = *(const LAS u32x4*)(wl + r * 272 + 128 + hi * 64 + i * 16); } \
            f32x16 d; _Pragma("unroll") for (int i = 0; i < 16; ++i) d[i] = 0.f; \
            _Pragma("unroll") for (int ks = 0; ks < 8; ++ks) { const long bv_ = (long)(((unsigned long long)g0_[ks >> 1][(ks & 1) * 2 + 1] << 32) | g0_[ks >> 1][(ks & 1) * 2]); d = __builtin_amdgcn_mfma_f32_32x32x16_fp8_fp8(a0[ks], bv_, d, 0, 0, 0); } \
            _Pragma("unroll") for (int ks = 0; ks < 8; ++ks) { const long bv_ = (long)(((unsigned long long)g1_[ks >> 1][(ks & 1) * 2 + 1] << 32) | g1_[ks >> 1][(ks & 1) * 2]); d = __builtin_amdgcn_mfma_f32_32x32x16_fp8_fp8(a1[ks], bv_, d, 0, 0, 0); } \
            const int dist_ = t - kc_; const int bkt_ = dist_ < 128 ? (int)g_bucket[dist_] : 31; \
            const f32x4 bias_ = *(const f32x4*)(btab + bkt_ * 8 + 4 * hi); f32x4 e_; \
            _Pragma("unroll") for (int i = 0; i < 4; ++i) e_[i] = valid_ ? __expf(d[i] * 0.08838834764831845f + bias_[i]) : 0.f; \
            psum += e_; _Pragma("unroll") for (int i = 0; i < 4; ++i) pmax[i] = fmaxf(pmax[i], e_[i]); \
            *(u32x2*)(Pb + ((kb) * 32 + r) * 8 + 4 * hi) = (u32x2){cvt_pk_bf16(e_[0], e_[1]), cvt_pk_bf16(e_[2], e_[3])}; } while (0)
        {
            u32x4 kA[8], kB[8];
            AT_LOADK(kA, 0);
#pragma unroll 1
            for (int kb = 0; kb < 8; kb += 2) {
                AT_LOADK(kB, kb + 1);
                AT_QK(kA, kb);
                if (kb + 2 < 8) AT_LOADK(kA, kb + 2);
                AT_QK(kB, kb + 1);
            }
        }
#undef AT_LOADK
#undef AT_QK
#pragma unroll
        for (int i = 0; i < 4; ++i) { psum[i] = xor16_sum(row_sum16(psum[i])); pmax[i] = xor16_max(row_max16(pmax[i])); }
        if (r == 0) { *(f32x4*)(psl + 4 * hi) = psum; *(f32x4*)(pml + 4 * hi) = pmax; }
        const int kq = lane >> 4, tq = (lane >> 1) & 7, tp = lane & 1;
#define AT_LOADV(buf, ks_) do { _Pragma("unroll") for (int c = 0; c < 8; ++c) { const int key_ = idl[(ks_) * 32 + 4 * c + vg4]; const int kc_ = key_ <= t ? key_ : 0; \
            buf[c] = *(const u32x4*)(v8 + ((size_t)b * SEQ + kc_) * 256 + vch * 16); } } while (0)
        u32x4 vA[8], vB[8];
        AT_LOADV(vA, 0);
        { const f32x4 m0 = *(const f32x4*)pml, m1 = *(const f32x4*)(pml + 4);
          f32x4 r0, r1;
#pragma unroll
          for (int i = 0; i < 4; ++i) { r0[i] = __builtin_amdgcn_rcpf(m0[i]); r1[i] = __builtin_amdgcn_rcpf(m1[i]); }
#pragma unroll
          for (int i = 0; i < 4; ++i) { const int key = i * 64 + lane;
              f32x4 pa, pb; unpack8(*(const u32x4*)(Pb + key * 8), pa, pb);
              *(LAS u32x2*)(wl + 14336 + key * 8) = pack8_fp8(pa * r0, pb * r1); } }
        f32x4 D0[8], D1[8];
#pragma unroll
        for (int tl = 0; tl < 8; ++tl) { D0[tl] = (f32x4){0.f, 0.f, 0.f, 0.f}; D1[tl] = D0[tl]; }
        LAS unsigned char* vwr = wl + (vch >> 3) * 4608 + vg4 * 144 + (vch & 7) * 16;
        LAS unsigned char* ard = wl + (kq * 8 + tq) * 144 + 8 * tp;
        LAS unsigned char* brd = wl + 14336 + (kq * 8 + tq) * 8;
#pragma unroll 1
        for (int ks = 0; ks < 8; ks += 2) {
            AT_LOADV(vB, ks + 1);
            at_pv_step(D0, D1, vA, vwr, ard, brd + ks * 256);
            if (ks + 2 < 8) AT_LOADV(vA, ks + 2);
            at_pv_step(D0, D1, vB, vwr, ard, brd + (ks + 1) * 256);
        }
#undef AT_LOADV
        { const int n = lane & 15, q4 = lane >> 4;
          if (n < 8) { const float sc = pml[n] / psl[n]; const bool g1 = n >= 4;
              unsigned char* op = ao + (size_t)row * 1024 + n * 128 + q4 * 4;
#pragma unroll
              for (int tl = 0; tl < 8; ++tl) { const f32x4 d = (g1 ? D1[tl] : D0[tl]) * sc;
                  int w = __builtin_amdgcn_cvt_pk_fp8_f32(d[0], d[1], 0, false); w = __builtin_amdgcn_cvt_pk_fp8_f32(d[2], d[3], w, true);
                  *(unsigned*)(op + tl * 16) = (unsigned)w; } } }
    }
}

__device__ __forceinline__ float dot16f8(u32x4 w, const float* h) {
    float s = 0.f;
#pragma unroll
    for (int d = 0; d < 4; ++d) { const f32x2 lo = __builtin_amdgcn_cvt_pk_f32_fp8((int)w[d], false), hi = __builtin_amdgcn_cvt_pk_f32_fp8((int)w[d], true);
        s += lo.x * h[4 * d] + lo.y * h[4 * d + 1] + hi.x * h[4 * d + 2] + hi.y * h[4 * d + 3]; }
    return s;
}
__device__ __forceinline__ void fma16f8(u32x4 w, float cf, float* acc) {
#pragma unroll
    for (int d = 0; d < 4; ++d) { const f32x2 lo = __builtin_amdgcn_cvt_pk_f32_fp8((int)w[d], false), hi = __builtin_amdgcn_cvt_pk_f32_fp8((int)w[d], true);
        acc[4 * d] += cf * lo.x; acc[4 * d + 1] += cf * lo.y; acc[4 * d + 2] += cf * hi.x; acc[4 * d + 3] += cf * hi.y; }
}
__device__ __forceinline__ float gelu_erf(float x) { return 0.5f * x * (1.0f + erff(x * 0.70710678118654752f)); }
__device__ __forceinline__ void ce_k(unsigned& a, unsigned& b) { const unsigned hi = a > b ? a : b, lo = a > b ? b : a; a = hi; b = lo; }
__device__ __forceinline__ void ce_kp(unsigned& ka, unsigned& pa, unsigned& kb, unsigned& pb) { const bool sw = kb > ka; const unsigned k0 = sw ? kb : ka, k1 = sw ? ka : kb, p0 = sw ? pb : pa, p1 = sw ? pa : pb; ka = k0; kb = k1; pa = p0; pb = p1; }
__device__ __forceinline__ void bmerge16(unsigned (&x)[16]) {
#pragma unroll
    for (int jj = 0; jj < 4; ++jj) { const int j = 8 >> jj;
#pragma unroll
        for (int i = 0; i < 16; ++i) { const int l = i ^ j; if (l > i) ce_k(x[i], x[l]); }
        __builtin_amdgcn_sched_barrier(0); }
}
__device__ __forceinline__ void bmerge16p(unsigned (&x)[16], unsigned (&p)[16]) {
#pragma unroll
    for (int jj = 0; jj < 4; ++jj) { const int j = 8 >> jj;
#pragma unroll
        for (int i = 0; i < 16; ++i) { const int l = i ^ j; if (l > i) ce_kp(x[i], p[i], x[l], p[l]); }
        __builtin_amdgcn_sched_barrier(0); }
}
__device__ __forceinline__ void bsort16(unsigned (&x)[16]) {
#pragma unroll
    for (int kk = 1; kk <= 4; ++kk) { const int k = 1 << kk;
#pragma unroll
        for (int jj = 0; jj < 4; ++jj) { const int j = (k >> 1) >> jj;
            if (j > 0) {
#pragma unroll
                for (int i = 0; i < 16; ++i) { const int l = i ^ j; if (l > i) { if ((i & k) == 0) ce_k(x[i], x[l]); else ce_k(x[l], x[i]); } }
                __builtin_amdgcn_sched_barrier(0); } } }
}
__device__ __forceinline__ void bsort16p(unsigned (&x)[16], unsigned (&p)[16]) {
#pragma unroll
    for (int kk = 1; kk <= 4; ++kk) { const int k = 1 << kk;
#pragma unroll
        for (int jj = 0; jj < 4; ++jj) { const int j = (k >> 1) >> jj;
            if (j > 0) {
#pragma unroll
                for (int i = 0; i < 16; ++i) { const int l = i ^ j; if (l > i) { if ((i & k) == 0) ce_kp(x[i], p[i], x[l], p[l]); else ce_kp(x[l], p[l], x[i], p[i]); } }
                __builtin_amdgcn_sched_barrier(0); } } }
}
__device__ __forceinline__ void top16_row(const unsigned char* rowp, unsigned (&t)[16]) {
#pragma unroll
    for (int i = 0; i < 16; ++i) t[i] = 0u;
#pragma unroll 1
    for (int g = 0; g < 8; ++g) {
        unsigned w[8];
#pragma unroll
        for (int q = 0; q < 4; ++q) { const u32x2 v = *(const u32x2*)(rowp + g * 32 + q * 8); w[2 * q] = v.x; w[2 * q + 1] = v.y; }
        unsigned sk[16];
#pragma unroll
        for (int d = 0; d < 8; ++d) {
            const unsigned lo = w[d] << 16, hi = w[d];
            const unsigned xl = lo ^ ((unsigned)((int)lo >> 31) | 0x80000000u), xh = hi ^ ((unsigned)((int)hi >> 31) | 0x80000000u);
            sk[2 * d] = ((xl >> 9) & 0xFFFFFF80u) | (unsigned)(127 - (g * 16 + 2 * d));
            sk[2 * d + 1] = ((xh >> 9) & 0xFFFFFF80u) | (unsigned)(127 - (g * 16 + 2 * d + 1)); }
        bsort16(sk);
#pragma unroll
        for (int i = 0; i < 16; ++i) t[i] = t[i] > sk[15 - i] ? t[i] : sk[15 - i];
        bmerge16(t);
    }
}
__device__ __forceinline__ float key_val(unsigned key) { const unsigned y = (key << 9) & 0xFFFF0000u; return __uint_as_float((y ^ (~(unsigned)((int)y >> 31) | 0x80000000u)) & 0xFFFF0000u); }
__device__ __forceinline__ unsigned sum_key(float s, int c) { const unsigned u = __float_as_uint(s); return ((u ^ ((unsigned)((int)u >> 31) | 0x80000000u)) & ~63u) | (unsigned)(63 - c); }
__device__ __forceinline__ float sum_val(unsigned k) { const unsigned y = k & ~63u; return __uint_as_float(y ^ (~(unsigned)((int)y >> 31) | 0x80000000u)); }
typedef __bf16 bf2_t __attribute__((ext_vector_type(2)));
__device__ __forceinline__ float dot2_bf(unsigned a, unsigned b, float c) { return __builtin_amdgcn_fdot2_f32_bf16(__builtin_bit_cast(bf2_t, a), __builtin_bit_cast(bf2_t, b), c, false); }
__device__ __forceinline__ float dot32_f6b(u32x4 wa, u32x2 wb, u32x4 h0, u32x4 h1, u32x4 h2, u32x4 h3) {
    const bf16x32 dec = __builtin_amdgcn_cvt_scalef32_pk32_bf16_fp6((u32x6){wa.x, wa.y, wa.z, wa.w, wb.x, wb.y}, 1.0f);
    const u32x16 ud = __builtin_bit_cast(u32x16, dec);
    float acc = 0.f;
    acc = dot2_bf(ud.s0, h0.x, acc); acc = dot2_bf(ud.s1, h0.y, acc); acc = dot2_bf(ud.s2, h0.z, acc); acc = dot2_bf(ud.s3, h0.w, acc);
    acc = dot2_bf(ud.s4, h1.x, acc); acc = dot2_bf(ud.s5, h1.y, acc); acc = dot2_bf(ud.s6, h1.z, acc); acc = dot2_bf(ud.s7, h1.w, acc);
    acc = dot2_bf(ud.s8, h2.x, acc); acc = dot2_bf(ud.s9, h2.y, acc); acc = dot2_bf(ud.sa, h2.z, acc); acc = dot2_bf(ud.sb, h2.w, acc);
    acc = dot2_bf(ud.sc, h3.x, acc); acc = dot2_bf(ud.sd, h3.y, acc); acc = dot2_bf(ud.se, h3.z, acc); acc = dot2_bf(ud.sf, h3.w, acc);
    return acc;
}
__device__ const unsigned char g_cab[64] = {0, 1, 2, 3, 4, 5, 6, 7, 8, 9, 10, 11, 12, 13, 14, 15, 16, 17, 18, 19, 20, 21, 22, 23, 32, 33, 34, 35, 36, 48, 49, 50, 51, 64, 65, 66, 80, 81, 96, 97, 112, 113, 128, 144, 160, 176, 192, 208, 224, 240, 0, 0, 0, 0, 0, 0, 0, 0, 0, 0, 0, 0, 0, 0};
template <int PMODE = 0> __device__ __forceinline__ void phase10_peer(Frame& F) {
    F.lane = lane_now(); F.tid = F.wave * 64 + F.lane;
    const bf16_t* sub = (const bf16_t*)(F.ws + WS_SUB); const bf16_t* h2 = (const bf16_t*)(F.ws + WS_H2);
    const unsigned char* pu = F.ws + WS_PU; unsigned* pairs = (unsigned*)(F.ws + WS_PAIRS);
    const int gw = F.bid * 8 + F.wave, NGW = F.G * 8;
    unsigned char* wb = F.lds + F.wave * 19200;
    unsigned char* h2b = wb; unsigned short* gl16 = (unsigned short*)(wb + 16896); unsigned* hist = (unsigned*)(wb + 18944); unsigned* base = hist + 32;
    unsigned* tmp = (unsigned*)wb;
    unsigned* wls0 = (unsigned*)(F.ws + WS_WLS) + (size_t)gw * 1024;
    const int ntok = (MTOK - gw + NGW - 1) / NGW;
    const bool wgsync = (MTOK % (NGW * 8)) == 0;
    constexpr int CA[50] = {0,0,0,0,0,0,0,0,0,0,0,0,0,0,0,0, 1,1,1,1,1,1,1,1, 2,2,2,2,2, 3,3,3,3, 4,4,4, 5,5, 6,6, 7,7, 8,9,10,11,12,13,14,15};
    constexpr int CB[50] = {0,1,2,3,4,5,6,7,8,9,10,11,12,13,14,15, 0,1,2,3,4,5,6,7, 0,1,2,3,4, 0,1,2,3, 0,1,2, 0,1, 0,1, 0,1, 0,0,0,0,0,0,0,0};
    for (int p0 = 0; p0 < ntok; p0 += 8) {
        int lane = F.lane; asm volatile("" : "+v"(lane));
        const int nt = (ntok - p0) < 8 ? (ntok - p0) : 8;
        {
            u32x4 st[16];
#define SEL_LOAD(half) do { asm volatile("" : "+v"(lane)); const int srow_l = lane >> 4, scol = lane & 15; _Pragma("unroll") for (int it = 0; it < 16; ++it) { const int r_ = it * 4 + srow_l; int ti_ = r_ >> 3; ti_ = ti_ < nt ? ti_ : nt - 1; \
                st[it] = *(const u32x4*)(sub + (size_t)(gw + (p0 + ti_) * NGW) * 2048 + (r_ & 7) * 256 + (half) * 128 + scol * 8); } } while (0)
#define SEL_STORE() do { const int srow_l = lane >> 4, scol = lane & 15; _Pragma("unroll") for (int it = 0; it < 16; ++it) { unsigned char* d_ = wb + (it * 4 + srow_l) * 264 + scol * 16; \
                *(u32x2*)d_ = (u32x2){st[it].x, st[it].y}; *(u32x2*)(d_ + 8) = (u32x2){st[it].z, st[it].w}; } } while (0)
            unsigned tA[16], tB[16];
            SEL_LOAD(0); SEL_STORE();
            __builtin_amdgcn_sched_barrier(0);
            top16_row(wb + lane * 264, tA);
            __builtin_amdgcn_sched_barrier(0);
            asm volatile("" : "+v"(tA[0]), "+v"(tA[1]), "+v"(tA[2]), "+v"(tA[3]), "+v"(tA[4]), "+v"(tA[5]), "+v"(tA[6]), "+v"(tA[7]), "+v"(tA[8]), "+v"(tA[9]), "+v"(tA[10]), "+v"(tA[11]), "+v"(tA[12]), "+v"(tA[13]), "+v"(tA[14]), "+v"(tA[15]) :: "memory");
            SEL_LOAD(1); SEL_STORE();
            __builtin_amdgcn_sched_barrier(0);
            top16_row(wb + lane * 264, tB);
            __builtin_amdgcn_sched_barrier(0);
#undef SEL_LOAD
#undef SEL_STORE
            float vA[16], vB[16];
            { unsigned pa[4] = {0u, 0u, 0u, 0u}, pb[4] = {0u, 0u, 0u, 0u};
#pragma unroll
              for (int i = 0; i < 16; ++i) { vA[i] = key_val(tA[i]); vB[i] = key_val(tB[i]); pa[i >> 2] |= (127u - (tA[i] & 127u)) << (8 * (i & 3)); pb[i >> 2] |= (127u - (tB[i] & 127u)) << (8 * (i & 3)); }
              unsigned char* rp = wb + lane * 264;
              *(u32x2*)rp = (u32x2){pa[0], pa[1]}; *(u32x2*)(rp + 8) = (u32x2){pa[2], pa[3]}; *(u32x2*)(rp + 16) = (u32x2){pb[0], pb[1]}; *(u32x2*)(rp + 24) = (u32x2){pb[2], pb[3]}; }
            unsigned tk[16];
#pragma unroll
            for (int c = 0; c < 16; ++c) tk[c] = sum_key(vA[CA[c]] + vB[CB[c]], c);
            bsort16(tk);
#pragma unroll
            for (int grp = 1; grp < 3; ++grp) {
                unsigned sk[16];
#pragma unroll
                for (int e = 0; e < 16; ++e) { const int c = grp * 16 + e; sk[e] = sum_key(vA[CA[c]] + vB[CB[c]], c); }
                bsort16(sk);
#pragma unroll
                for (int i = 0; i < 16; ++i) tk[i] = tk[i] > sk[15 - i] ? tk[i] : sk[15 - i];
                bmerge16(tk);
            }
#pragma unroll
            for (int c = 48; c < 50; ++c) { unsigned k = sum_key(vA[CA[c]] + vB[CB[c]], c);
#pragma unroll
                for (int i = 0; i < 16; ++i) ce_k(tk[i], k); }
            const float s0 = sum_val(tk[0]); float ev[16], esum = 0.f;
#pragma unroll
            for (int r = 0; r < 16; ++r) { ev[r] = __expf(sum_val(tk[r]) - s0); esum += ev[r]; }
            const float einv = 1.0f / esum;
            unsigned eid[16];
            { const unsigned char* rp = wb + lane * 264;
#pragma unroll
              for (int r = 0; r < 16; ++r) { const unsigned cab = g_cab[63u - (tk[r] & 63u)]; eid[r] = (unsigned)rp[cab >> 4] * 128u + (unsigned)rp[16 + (cab & 15u)]; } }
            if ((lane >> 3) < nt) {
#pragma unroll
                for (int r = 0; r < 16; ++r) { const int e = lane * 16 + r; tmp[e] = ((unsigned)e << 14) | eid[r]; gl16[e] = (unsigned short)(cvt_pk_bf16(ev[r] * einv, 0.f) & 0xffffu); } }
        }
        asm volatile("" : "+v"(lane));
        const int ne = nt * 128;
        {
            if (lane < 32) hist[lane] = 0u;
            unsigned ent[16]; unsigned rk[16];
#pragma unroll
            for (int q = 0; q < 16; ++q) { const int e = q * 64 + lane; ent[q] = (e < ne) ? tmp[e] : 0u; rk[q] = (e < ne) ? atomicAdd(&hist[(ent[q] & 0x3FFFu) >> 9], 1u) : 0u; }
            { int hv = lane < 32 ? (int)hist[lane] : 0; int x = hv;
              x += __builtin_amdgcn_update_dpp(0, x, 0x111, 0xF, 0xF, true); x += __builtin_amdgcn_update_dpp(0, x, 0x112, 0xF, 0xF, true);
              x += __builtin_amdgcn_update_dpp(0, x, 0x114, 0xF, 0xF, true); x += __builtin_amdgcn_update_dpp(0, x, 0x118, 0xF, 0xF, true);
              const int t0 = __builtin_amdgcn_readlane(x, 15); if (lane >= 16) x += t0;
              if (lane < 32) base[lane] = (unsigned)(x - hv); }
#pragma unroll
            for (int q = 0; q < 16; ++q) { const int e = q * 64 + lane; if (e < ne) wls0[base[(ent[q] & 0x3FFFu) >> 9] + rk[q]] = ent[q]; }
        }
        asm volatile("s_waitcnt vmcnt(0)" ::: "memory");
        asm volatile("" : "+v"(lane));
        u32x4 hraw[8][4];
#pragma unroll
        for (int i = 0; i < 8; ++i) { const int ic = i < nt ? i : nt - 1; const bf16_t* hr = h2 + (size_t)(gw + (p0 + ic) * NGW) * 2048 + lane * 32;
#pragma unroll
            for (int q = 0; q < 4; ++q) hraw[i][q] = *(const u32x4*)(hr + q * 8); }
#pragma unroll
        for (int i = 0; i < 8; ++i) { if (i >= nt) break;
            f32x4 v[8]; float m = 0.f;
#pragma unroll
            for (int q = 0; q < 4; ++q) { unpack8(hraw[i][q], v[2 * q], v[2 * q + 1]); }
#pragma unroll
            for (int q = 0; q < 8; ++q)
#pragma unroll
                for (int k = 0; k < 4; ++k) m = fmaxf(m, __builtin_fabsf(v[q][k]));
            int sb = (int)((__float_as_uint(m * 1.0666667f) >> 23) & 0xFFu) - 2; sb = sb < 1 ? 1 : (sb > 253 ? 253 : sb);
            const float inv = __uint_as_float((unsigned)(254 - sb) << 23);
            u32x16 pk;
#pragma unroll
            for (int q = 0; q < 8; ++q) { const f32x4 a = v[q] * inv; pk[2 * q] = cvt_pk_bf16(a[0], a[1]); pk[2 * q + 1] = cvt_pk_bf16(a[2], a[3]); }
            const u32x6 p6 = __builtin_amdgcn_cvt_scalef32_pk32_fp6_bf16(__builtin_bit_cast(bf16x32, pk), 1.0f);
            const int lp = (lane >> 2) + 16 * (lane & 3);
            *(u32x4*)(h2b + i * 2048 + lp * 16) = (u32x4){p6[0], p6[1], p6[2], p6[3]};
            *(u32x2*)(h2b + i * 2048 + 1024 + lp * 8) = (u32x2){p6[4], p6[5]};
            *(unsigned*)(h2b + i * 2048 + 1536 + lp * 4) = (unsigned)sb; }
        if (PMODE != 1) {
            const int dg = lane >> 4, dc = lane & 15;
            const bool dv = (dc >> 2) == dg; const int dr = dc & 3;
            const float w0 = (dv && dr == 0) ? 1.f : 0.f, w1 = (dv && dr == 1) ? 1.f : 0.f, w2 = (dv && dr == 2) ? 1.f : 0.f, w3 = (dv && dr == 3) ? 1.f : 0.f;
            unsigned entn = __hip_atomic_load(wls0 + lane, __ATOMIC_RELAXED, __HIP_MEMORY_SCOPE_AGENT);
#define U_LOAD(WA, WB, srcent, i0_) do { _Pragma("unroll") for (int jj = 0; jj < 8; ++jj) { const unsigned en_ = (unsigned)__builtin_amdgcn_readlane((int)(srcent), (i0_) + jj); \
                const unsigned char* ur = pu + (size_t)(en_ & 0x3FFFu) * 1536; WA[jj] = *(const u32x4*)(ur + lane * 16); WB[jj] = *(const u32x2*)(ur + 1024 + lane * 8); } } while (0)
#define U_COMP(WA, WB, i0_) do { float pr[8]; u32x4 b0_[8]; u32x2 b1_[8]; unsigned bs_[8]; f32x4 D_[8]; \
                  \
                _Pragma("unroll") for (int jj = 0; jj < 8; ++jj) { const unsigned en_ = (unsigned)__builtin_amdgcn_readlane((int)ent64, (i0_) + jj); const unsigned char* hp = h2b + ((en_ >> 21) & 7u) * 2048; \
                    b0_[jj] = *(const u32x4*)(hp + lane * 16); b1_[jj] = *(const u32x2*)(hp + 1024 + lane * 8); bs_[jj] = *(const unsigned*)(hp + 1536 + lane * 4); } \
                __builtin_amdgcn_sched_barrier(0); \
                _Pragma("unroll") for (int jj = 0; jj < 8; ++jj) { \
                    const pg8::i32x8 A = (pg8::i32x8){(int)WA[jj].x, (int)WA[jj].y, (int)WA[jj].z, (int)WA[jj].w, (int)WB[jj].x, (int)WB[jj].y, 0, 0}; \
                    const pg8::i32x8 B = (pg8::i32x8){(int)b0_[jj].x, (int)b0_[jj].y, (int)b0_[jj].z, (int)b0_[jj].w, (int)b1_[jj].x, (int)b1_[jj].y, 0, 0}; \
                    D_[jj] = __builtin_amdgcn_mfma_scale_f32_16x16x128_f8f6f4(A, B, (f32x4){0.f, 0.f, 0.f, 0.f}, 2  , 2  , 0, 0x7F7F7F7F, 0, (int)bs_[jj]); } \
                __builtin_amdgcn_sched_barrier(0); \
                _Pragma("unroll") for (int jj = 0; jj < 8; ++jj) pr[jj] = w0 * D_[jj][0] + w1 * D_[jj][1] + w2 * D_[jj][2] + w3 * D_[jj][3]; \
                  \
                _Pragma("unroll") for (int i = 0; i < 4; ++i) pr[i] = swap32_pair(pr[i], pr[i + 4]); \
                _Pragma("unroll") for (int i = 0; i < 2; ++i) pr[i] = swap16_pair(pr[i], pr[i + 2]); \
                const bool b3 = (lane & 8) != 0; \
                { const float snd = b3 ? pr[0] : pr[1], kp = b3 ? pr[1] : pr[0]; pr[0] = kp + dpp_f<DPP_ROR8>(snd); } \
                float tot = pr[0]; tot += dpp_f<DPP_XOR1>(tot); tot += dpp_f<DPP_XOR2>(tot); tot += dpp_f<DPP_HMIRROR>(tot); \
                keep = ((lane & 7) == ((i0_) >> 3)) ? tot : keep;           \
            } while (0)
            u32x4 wA0[8], wA1[8]; u32x2 wB0[8], wB1[8];
            U_LOAD(wA0, wB0, entn, 0);
#pragma unroll 1
            for (int c = 0; c < ne; c += 64) {
                if (wgsync && (c & 255) == 0) __syncthreads();
                const unsigned ent64 = entn;
                const bool more = c + 64 < ne;
                if (more) entn = __hip_atomic_load(wls0 + c + 64 + lane, __ATOMIC_RELAXED, __HIP_MEMORY_SCOPE_AGENT);
                float keep = 0.f;
#pragma unroll 1
                for (int i0 = 0; i0 < 64; i0 += 16) {
                    U_LOAD(wA1, wB1, ent64, i0 + 8);
                    U_COMP(wA0, wB0, i0);
                    if (i0 + 16 < 64) U_LOAD(wA0, wB0, ent64, i0 + 16); else if (more) U_LOAD(wA0, wB0, entn, 0);
                    U_COMP(wA1, wB1, i0 + 8);
                }
                {
                    const unsigned em = (unsigned)__shfl((int)ent64, 8 * (lane & 7) + (lane >> 3));
                    const int ti = (int)(em >> 21), j = (int)((em >> 14) & 127u), row = gw + (p0 + ti) * NGW;
                    const float cf = gelu_erf(keep * (1.0f / 96.0f)) * __uint_as_float((unsigned)gl16[(em >> 14) & 1023u] << 16);
                    pairs[((size_t)(row >> 6) * 32 + (j >> 2)) * 256 + (row & 63) * 4 + (j & 3)] = (((unsigned)__builtin_bit_cast(unsigned short, (_Float16)cf) << 16) & 0xFFFE0000u) | ((em & 0x3FFFu) << 3);
                }
            }
#undef U_LOAD
#undef U_COMP
        }
    }
}

__device__ __forceinline__ void phase11_peer_v(Frame& F, float* dst) {
    F.lane = lane_now(); F.tid = F.wave * 64 + F.lane;
    const unsigned* pairs = (const unsigned*)(F.ws + WS_PAIRS); const float* mf = (const float*)(F.ws + WS_MODF); const bf16_t* x1b = (const bf16_t*)(F.ws + WS_X1B);
    unsigned long long* vs = (unsigned long long*)F.lds;
    for (int c0 = F.bid; c0 < DM / 8; c0 += F.G) {
        const int c = (c0 & 7) * 32 + (c0 >> 3);
        __syncthreads();
        { const u32x4* src = (const u32x4*)(F.ws + WS_PV + (size_t)c * NEXP * 8);
#pragma unroll 16
          for (int i = F.tid; i < NEXP * 8 / 16; i += 512) *(LAS u32x4*)(unsigned long long)(unsigned)(i * 16) = src[i]; }
        __syncthreads();
        typedef __fp16 h2_t __attribute__((__vector_size__(2 * sizeof(__fp16))));
#define P11_LOAD(dst, ptr) do { _Pragma("unroll") for (int q_ = 0; q_ < 4; ++q_) { const u32x4 t_ = *(const u32x4*)((ptr) + q_ * 256); dst[4 * q_] = t_.x; dst[4 * q_ + 1] = t_.y; dst[4 * q_ + 2] = t_.z; dst[4 * q_ + 3] = t_.w; } } while (0)
#define P11_FMA(A, X, C) asm("v_pk_fma_f16 %0, %1, %2, %0 op_sel:[0,1,0] op_sel_hi:[1,1,1]" : "+v"(C) : "v"(A), "v"(X))
#define P11_COMP(src) do { unsigned long long vv_[16]; \
                    _Pragma("unroll") for (int jj = 0; jj < 16; ++jj) vv_[jj] = *(const LAS unsigned long long*)(unsigned long long)(src[jj] & 0x1FFF8u);     \
                    __builtin_amdgcn_sched_barrier(0); \
                    _Pragma("unroll") for (int jj = 0; jj < 16; ++jj) { const int lo = (int)(unsigned)vv_[jj], hi = (int)(unsigned)(vv_[jj] >> 32); \
                    const h2_t c0_ = __builtin_amdgcn_cvt_scalef32_pk_f16_fp8(lo, 1.0f, false), c1_ = __builtin_amdgcn_cvt_scalef32_pk_f16_fp8(lo, 1.0f, true); \
                    const h2_t c2_ = __builtin_amdgcn_cvt_scalef32_pk_f16_fp8(hi, 1.0f, false), c3_ = __builtin_amdgcn_cvt_scalef32_pk_f16_fp8(hi, 1.0f, true); \
                    P11_FMA(c0_, src[jj], acc[0]); P11_FMA(c1_, src[jj], acc[1]); P11_FMA(c2_, src[jj], acc[2]); P11_FMA(c3_, src[jj], acc[3]); } } while (0)
#define P11_COMPX(src) do { unsigned long long vv_[16]; \
                    _Pragma("unroll") for (int jj = 0; jj < 16; ++jj) vv_[jj] = *(const LAS unsigned long long*)(unsigned long long)(src[jj] & 0x1FFF8u); \
                    __builtin_amdgcn_sched_barrier(0); \
                    _Pragma("unroll") for (int jj = 0; jj < 16; ++jj) { const int lo = (int)(unsigned)vv_[jj], hi = (int)(unsigned)(vv_[jj] >> 32); \
                    P11_FMA(lo, src[jj], acc[0]); P11_FMA(hi, src[jj], acc[1]); P11_FMA(lo, src[jj], acc[2]); P11_FMA(hi, src[jj], acc[3]); } } while (0)
        int lane = F.lane; asm volatile("" : "+v"(lane));
        unsigned pa[16], pb[16];
        f32x4 x0, x1;
        { const unsigned* pp = pairs + (size_t)F.wave * 128 * 64 + lane * 4; P11_LOAD(pa, pp);
          unpack8(*(const u32x4*)(x1b + (size_t)(F.wave * 64 + lane) * 2048 + c * 8), x0, x1); }
        for (int tile = F.wave; tile < MTOK / 64; tile += 8) {
            const unsigned* pp = pairs + (size_t)tile * 128 * 64 + lane * 4;
            const int ntile = tile + 8 < MTOK / 64 ? tile + 8 : tile;
            const unsigned* npp = pairs + (size_t)ntile * 128 * 64 + lane * 4;
            const int row = tile * 64 + lane;
            const float* gt2 = mf + (size_t)(tile / (SEQ / 64)) * 12288 + 10240 + c * 8;
            float* op = dst + (size_t)row * 2048 + c * 8;
            const f32x4 g0 = *(const f32x4*)gt2 * 0.25f, g1 = *(const f32x4*)(gt2 + 4) * 0.25f;
            h2_t acc[4];
#pragma unroll
            for (int i = 0; i < 4; ++i) acc[i] = (h2_t){(__fp16)0.f, (__fp16)0.f};
            u32x4 nxr = (u32x4){0u, 0u, 0u, 0u};
#pragma unroll 1
            for (int j0 = 0; j0 < 128; j0 += 32) {
                P11_LOAD(pb, pp + (j0 + 16) * 64);
                P11_COMP(pa);
                const bool lastb = j0 + 32 >= 128;
                { const unsigned* np_ = lastb ? npp : pp + (j0 + 32) * 64; P11_LOAD(pa, np_); }
                if (lastb) nxr = *(const u32x4*)(x1b + (size_t)(ntile * 64 + lane) * 2048 + c * 8);
                P11_COMP(pb);
            }
#if PROBE_P11X == 1 || PROBE_P11X == 3
            { h2_t sv[4]; for (int i = 0; i < 4; ++i) sv[i] = acc[i];
#pragma unroll 1
              for (int j0 = 0; j0 < 128; j0 += 32) {
#pragma unroll
                for (int jj = 0; jj < 16; ++jj) { asm volatile("" : "+v"(pa[jj])); asm volatile("" : "+v"(pb[jj])); }
#if PROBE_P11X == 1
                P11_COMP(pa); P11_COMP(pb);
#else
                P11_COMPX(pa); P11_COMPX(pb);
#endif
              }
              asm volatile("" :: "v"(acc[0]), "v"(acc[1]), "v"(acc[2]), "v"(acc[3])); for (int i = 0; i < 4; ++i) acc[i] = sv[i]; }
#endif
            *(f32x4*)op = x0 + g0 * (f32x4){(float)acc[0][0], (float)acc[0][1], (float)acc[1][0], (float)acc[1][1]};
            *(f32x4*)(op + 4) = x1 + g1 * (f32x4){(float)acc[2][0], (float)acc[2][1], (float)acc[3][0], (float)acc[3][1]};
            unpack8(nxr, x0, x1);
        }
#undef P11_LOAD
#undef P11_COMP
#undef P11_FMA
    }
}

__global__ void __launch_bounds__(512, 2) fwd_kernel(Args args) {
    extern __shared__ __attribute__((aligned(16))) unsigned char lds[];
    Frame F;
    F.lds = lds; F.ws = args.ws; F.tid = threadIdx.x; F.lane = F.tid & 63; F.wave = __builtin_amdgcn_readfirstlane(F.tid >> 6); F.G = gridDim.x; F.bid = blockIdx.x;
    F.x = args.in[0]; F.c = args.in[1]; F.w_ada = args.in[2]; F.b_ada = args.in[3]; F.g1 = args.in[4]; F.g2 = args.in[5]; F.w_in = args.in[6]; F.g_q = args.in[7]; F.g_k = args.in[8];
    F.rel_bias = args.in[9]; F.pool_w = args.in[10]; F.pool_scale = args.in[11]; F.w_ab = args.in[12]; F.w_pb = args.in[13]; F.w_out = args.in[14]; F.w_pq = args.in[15];
    F.peer_keys = args.in[16]; F.peer_u = args.in[17]; F.peer_v = args.in[18]; F.out = args.out;
    LAS unsigned char* ldsl = (LAS unsigned char*)lds;
    volatile LAS unsigned* misc = (volatile LAS unsigned*)(ldsl + MISC_OFF);
    if (F.tid < 4) misc[F.tid] = 0u;
    __syncthreads();
    unsigned* barw = (unsigned*)(args.ws + WS_CTL) + (size_t)args.li * XCD_BAR_WORDS;
    XcdBarrier bar; bar.bar = barw; bar.x = 0; bar.st = misc;
    const int lo = args.ph_lo, hi = args.ph_hi;
    if (hi - lo > 1) bar = xcd_barrier_post(barw, misc);
#define IN(k) (lo <= (k) && (k) < hi)
#define SEAM(k) do { if (IN(k) && IN((k) + 1)) xcd_barrier(bar, F.wave); } while (0)
    bf16_t* R0 = (bf16_t*)(F.ws + WS_R0);

#define PH2_BODY { \
        { pg8::Gemm g{(const bf16_t*)(F.ws + WS_H1F8), (const bf16_t*)(F.ws + WS_WIN8), MTOK, 6912, DM / 2, DM / 2, 0, nullptr, nullptr, 0, 0}; pg8::StaticOrder S; S.init(MTOK, 6912, F.G, F.bid); \
          EpiInproj<true> E{(bf16_t*)(F.ws + WS_QN), (bf16_t*)(F.ws + WS_KN), (bf16_t*)(F.ws + WS_V8), (bf16_t*)(F.ws + WS_IQ), (bf16_t*)(F.ws + WS_IK), (bf16_t*)(F.ws + WS_PL), \
                    (bf16_t*)(F.ws + WS_GA), (bf16_t*)(F.ws + WS_GP), (float*)(F.ws + WS_IW)}; \
          pg8::gemm_phase<EpiInproj<true>, true>(ldsl, g, S, E, F.wave); } \
        { pg8::Gemm g{R0, (const bf16_t*)(F.ws + WS_WIN16), MTOK, 1024, DM, DM, 0, nullptr, nullptr, 0, 0}; pg8::StaticOrder S; S.init(MTOK, 1024, F.G, F.bid); \
          EpiInproj<false> E{(bf16_t*)(F.ws + WS_QN), (bf16_t*)(F.ws + WS_KN), (bf16_t*)(F.ws + WS_V8), (bf16_t*)(F.ws + WS_IQ), (bf16_t*)(F.ws + WS_IK), (bf16_t*)(F.ws + WS_PL), \
                    (bf16_t*)(F.ws + WS_GA), (bf16_t*)(F.ws + WS_GP), (float*)(F.ws + WS_IW)}; \
          pg8::gemm_phase<EpiInproj<false>>(ldsl, g, S, E, F.wave); } }
#define PH3_BODY { phase3_pooled(F); phase3_indexer(F); __syncthreads(); }
#define PHFOLD_BODY { \
        pg8::Gemm g{(const bf16_t*)(F.ws + WS_WPBT16), (const bf16_t*)(F.ws + WS_POOLW), DM, PW, 256, 1024, 256, nullptr, nullptr, 0, 256, 0}; pg8::StaticOrder S; S.init(DM, PW, F.G, (F.bid + F.G - F.G / 2) % F.G); \
        EpiF8Mul E{F.ws + WS_WPB, 1024, 16.0f}; pg8::gemm_phase<EpiF8Mul>(ldsl, g, S, E, F.wave); }
#define PH4_BODY { phase4_attention(F); __syncthreads(); }
#define PH5_BODY { \
        pg8::Gemm g{(const bf16_t*)(F.ws + WS_ATTN), (const bf16_t*)(F.ws + WS_WAB), MTOK, DM, 1024, 512, 0, (const bf16_t*)(F.ws + WS_POOLED), (const bf16_t*)(F.ws + WS_WPB), 8, 512};     \
        pg8::StaticOrder S; S.init(MTOK, DM, F.G, F.bid); \
        EpiMerge E{(unsigned char*)R0, F.ws + WS_GA, F.ws + WS_GP}; pg8::gemm_phase<EpiMerge, true>(ldsl, g, S, E, F.wave); }
#define PH6_BODY { \
        pg8::Gemm g{R0, (const bf16_t*)(F.ws + WS_WOUT), MTOK, DM, DM / 2, DM / 2, 0, nullptr, nullptr, 0, 0}; pg8::StaticOrder S; S.init(MTOK, DM, F.G, F.bid); \
        EpiResidB E{F.x, (bf16_t*)(F.ws + WS_X1B), (const float*)(F.ws + WS_MODF) + 4096}; pg8::gemm_phase<EpiResidB, true>(ldsl, g, S, E, F.wave); }
#define PHW2_BODY { \
        pg8::Gemm g{(const bf16_t*)(F.ws + WS_KEYSBD), (const bf16_t*)(F.ws + WS_WPQ), DM, DM, 256, 256, 0, nullptr, nullptr, 0, DM, 256}; pg8::StaticOrder S; S.init(DM, DM, F.G, (F.bid + F.G - (5 * F.G) / 8) % F.G); \
        EpiBf16Scale E{(bf16_t*)(F.ws + WS_W2), 2048, nullptr}; pg8::gemm_phase<EpiBf16Scale>(ldsl, g, S, E, F.wave); }
#define PH8_BODY { \
        pg8::Gemm g{(const bf16_t*)(F.ws + WS_H2), (const bf16_t*)(F.ws + WS_W2), MTOK, DM, DM, DM, 0, nullptr, nullptr, 0, 0}; pg8::StaticOrder S; S.init(MTOK, DM, F.G, F.bid); \
        EpiBf16Scale E{(bf16_t*)(F.ws + WS_SUB), 2048, nullptr}; pg8::gemm_phase<EpiBf16Scale>(ldsl, g, S, E, F.wave); }
#define PH9_BODY { }
#define REP(k) if constexpr (((PROBE_REP) >> (k)) & 1)

    if (IN(0)) { phase0_prep(F); REP(0) { __syncthreads(); phase0_prep(F); } }
    SEAM(0);
    if (IN(1)) { phase_modnorm<true>(F, F.x, F.g1, 0, 2048, R0, F.ws + WS_H1F8); REP(1) { phase_modnorm<true>(F, F.x, F.g1, 0, 2048, R0, F.ws + WS_H1F8); } }
    SEAM(1);
    if (IN(2)) { PH2_BODY PHFOLD_BODY PHW2_BODY REP(2) PH2_BODY }
    SEAM(2);
    if (IN(3)) { phase3_qknorm(F); PH3_BODY REP(3) PH3_BODY }
    SEAM(3);
    if (IN(4)) { PH4_BODY REP(4) PH4_BODY }
    SEAM(4);
    if (IN(5)) { PH5_BODY REP(5) PH5_BODY }
    SEAM(5);
    if (IN(6)) { PH6_BODY REP(6) PH6_BODY }
    SEAM(6);
    if (IN(7)) { phase_modnorm<false>(F, (const float*)(F.ws + WS_X1B), F.g2, 6144, 8192, (bf16_t*)(F.ws + WS_H2)); REP(7) { phase_modnorm<false>(F, (const float*)(F.ws + WS_X1B), F.g2, 6144, 8192, (bf16_t*)(F.ws + WS_H2)); } }
    SEAM(7);
    if (IN(8)) { PH8_BODY REP(8) PH8_BODY }
    if (IN(9)) { PH9_BODY REP(9) PH9_BODY }
    SEAM(9);
    if (IN(10)) { phase10_peer(F); REP(10) phase10_peer<PROBE_P10M>(F); }
    SEAM(10);
    if (IN(11)) { REP(11) { phase11_peer_v(F, (float*)(F.ws + WS_SUB)); } phase11_peer_v(F, F.out); }
#undef IN
#undef SEAM
}

extern "C" void kernel_launch(void* const* d_in, const int* in_sizes, int n_in, void* d_out, int out_size, void* d_ws, size_t ws_size, hipStream_t stream) {
    static int grid = 0;
    if (grid == 0) {
        if (n_in != 19 || out_size != MTOK * DM || ws_size < WS_END) { fprintf(stderr, "kernel_launch: unexpected shapes (n_in %d out %d ws %zu)\n", n_in, out_size, ws_size); grid = -1; return; }
        int dev = 0, cus = 0, per_cu = 0;
        if (hipGetDevice(&dev) != hipSuccess || hipDeviceGetAttribute(&cus, hipDeviceAttributeMultiprocessorCount, dev) != hipSuccess) { grid = -1; return; }
        if (hipFuncSetAttribute((const void*)fwd_kernel, hipFuncAttributeMaxDynamicSharedMemorySize, LDS_BYTES) != hipSuccess) { fprintf(stderr, "kernel_launch: hipFuncSetAttribute failed\n"); grid = -1; return; }
        if (hipOccupancyMaxActiveBlocksPerMultiprocessor(&per_cu, (const void*)fwd_kernel, 512, LDS_BYTES) != hipSuccess || per_cu < 1) { fprintf(stderr, "kernel_launch: occupancy query says %d\n", per_cu); }
        (void)hipGetLastError();
        grid = cus;
    }
    if (grid < 0) return;
    (void)in_sizes;
    if (hipMemsetAsync((char*)d_ws + WS_CTL, 0, CTL_ZERO_BYTES, stream) != hipSuccess) return;
    Args a{};
    for (int i = 0; i < 19; ++i) a.in[i] = (const float*)d_in[i];
    a.out = (float*)d_out; a.ws = (unsigned char*)d_ws;
#if MK_PER_PHASE
    for (int p = 0; p < NPHASE; ++p) { a.ph_lo = p; a.ph_hi = p + 1; a.li = p; hipLaunchKernelGGL(fwd_kernel, dim3(grid), dim3(512), LDS_BYTES, stream, a); }
#else
    a.ph_lo = 0; a.ph_hi = NPHASE; a.li = 0;
    hipLaunchKernelGGL(fwd_kernel, dim3(grid), dim3(512), LDS_BYTES, stream, a);
#endif
}
```
